# Optimizing an MI355X kernel written in HIP

```python
import math
import jax
import jax.numpy as jnp
from jax import lax
import numpy as np

D_MODEL = 1024
BATCH = 8
SEQ = 4096
DEPTH = 4

GRID_W = 64
CTX_LEN = 256
D_MIX = D_MODEL
D_GROUP = D_MIX // 4
N_MOD = 6

FOURIER_HEADS = 4
FOURIER_HD = D_GROUP // FOURIER_HEADS

S5_CH = 16
S5_GROUPS = D_GROUP // S5_CH
S5_STATE = 64

GLA_HEADS = 4
GLA_DK = D_GROUP // (2 * GLA_HEADS)
GLA_DV = D_GROUP // GLA_HEADS
GLA_RANK = 16
GLA_TAU = 16.0
GLA_CHUNK = 64

SSD_HEADS = 4
SSD_HD = D_GROUP // SSD_HEADS
SSD_GROUPS = 2
SSD_STATE = 64
SSD_CONV = 5
SSD_CHUNK = 64
SSD_XBC = D_GROUP + 2 * SSD_GROUPS * SSD_STATE

N_EXPERTS = 32
TOP_K = 4
D_EXPERT = D_MODEL
SWIGLU_LIMIT = 7.0
SWIGLU_ALPHA = 1.702
MOE_BLOCK = 256

EPS = 1e-6

IN_SPLIT = (D_GROUP, D_GROUP, GLA_HEADS * GLA_DK, GLA_HEADS * GLA_DK, D_GROUP, D_GROUP,
            2 * GLA_RANK, D_GROUP, SSD_XBC, 2 * SSD_HEADS)
D_IN_PROJ = (2 * D_GROUP + 2 * GLA_HEADS * GLA_DK + 2 * D_GROUP + 2 * GLA_RANK
             + D_GROUP + SSD_XBC + 2 * SSD_HEADS)

kernel_name = 'hybrid_flow_backbone_fourier_s5_gla_ssd_moe'


def _rmsnorm(x, g):
    xf = x.astype(jnp.float32)
    y = xf * lax.rsqrt(jnp.mean(xf * xf, axis=-1, keepdims=True) + EPS)
    return (y * g.astype(jnp.float32)).astype(x.dtype)


def _modulate(h, shift, scale):
    return h * (1.0 + scale) + shift


def _ada(cond, w, b):
    m = cond @ w + b
    return [t[:, None, :] for t in jnp.split(m, N_MOD, axis=-1)]


def _split_in(p):
    return jnp.split(p, np.cumsum(IN_SPLIT)[:-1].tolist(), axis=-1)


def _flip(t, rev):
    return jnp.flip(t, axis=1) if rev else t


def _tril(n):
    return jnp.tril(jnp.ones((n, n), dtype=bool))


def fourier_mixer(u, w):
    bsz, seq_len, _ = u.shape
    uh = u.astype(jnp.float32).reshape(bsz, seq_len, FOURIER_HEADS, FOURIER_HD)
    f = jnp.fft.fft2(uh, axes=(1, 3), norm='ortho').real
    return (f.reshape(bsz, seq_len, D_GROUP) @ w.astype(jnp.float32)).astype(u.dtype)


def _s5_combine(left, right):
    a_l, b_l = left
    a_r, b_r = right
    return a_r * a_l, a_r * b_l + b_r


def _s5_scan(a_bar, lam_dt, bu, h0):
    seq_len = bu.shape[1]
    a = jnp.broadcast_to(a_bar, bu.shape)
    _, h = lax.associative_scan(_s5_combine, (a, bu), axis=1)
    if h0 is None:
        return h
    steps = jnp.arange(1, seq_len + 1, dtype=jnp.float32)[:, None, None]
    return h + jnp.exp(lam_dt * steps)[None] * h0[:, None]


def s5_mixer(u_c, u_l, lam_re, lam_im, log_dt, b_re, b_im, c_re, c_im, d_skip, w_glu, ctx_out):
    f32 = jnp.float32

    def groups(u):
        return u.astype(f32).reshape(u.shape[0], u.shape[1], S5_GROUPS, S5_CH)

    uc, ul = groups(u_c), groups(u_l)
    y_c, y_l = [], []
    for r in range(2):
        rev = r == 1
        lam = lax.complex(lam_re[r].astype(f32), lam_im[r].astype(f32))
        lam_dt = lam * jnp.exp(log_dt[r].astype(f32))[:, None]
        a_bar = jnp.exp(lam_dt)
        b_bar = ((a_bar - 1.0) / lam)[..., None] * lax.complex(b_re[r].astype(f32), b_im[r].astype(f32))
        c_mat = lax.complex(c_re[r].astype(f32), c_im[r].astype(f32))
        h_c = _s5_scan(a_bar, lam_dt, jnp.einsum('blgh,gph->blgp', _flip(uc, rev), b_bar), None)
        h_l = _s5_scan(a_bar, lam_dt, jnp.einsum('blgh,gph->blgp', _flip(ul, rev), b_bar), h_c[:, -1])
        y_l.append(_flip(jnp.einsum('blgp,ghp->blgh', h_l, c_mat).real, rev))
        if ctx_out:
            y_c.append(_flip(jnp.einsum('blgp,ghp->blgh', h_c, c_mat).real, rev))

    def finish(u, u_g, ys):
        y = (ys[0] + ys[1] + d_skip.astype(f32).reshape(S5_GROUPS, S5_CH) * u_g).reshape(u.shape)
        act = jax.nn.gelu(y)
        return (act * jax.nn.sigmoid(act @ w_glu.astype(f32))).astype(u.dtype)

    return (finish(u_c, uc, y_c) if ctx_out else None), finish(u_l, ul, y_l)


def _chunk_states(k_dec, v, chunk_decay, s0):
    ds = jnp.einsum('bnchk,bnchv->bnhkv', k_dec, v)

    def step(s, inp):
        dec, d = inp
        return dec[..., None] * s + d, s

    s_final, s_enter = lax.scan(step, s0, (jnp.moveaxis(chunk_decay, 1, 0), jnp.moveaxis(ds, 1, 0)))
    return jnp.moveaxis(s_enter, 0, 1), s_final


def _gla_direction(q, k, v, log_a, s0, with_out):
    bsz, seq_len, nh, dk = q.shape
    csz = min(GLA_CHUNK, seq_len)
    nc = seq_len // csz
    q, k, v, log_a = (t.reshape(bsz, nc, csz, nh, t.shape[-1]) for t in (q, k, v, log_a))
    b = jnp.cumsum(log_a, axis=2)
    b_last = b[:, :, -1]
    s_enter, s_final = _chunk_states(k * jnp.exp(b_last[:, :, None] - b), v, jnp.exp(b_last), s0)
    if not with_out:
        return None, s_final
    q_in = q * jnp.exp(b)
    k_in = k * jnp.exp(-b)
    att = jnp.where(_tril(csz), jnp.einsum('bnthk,bnshk->bnhts', q_in, k_in), 0.0)
    o = (jnp.einsum('bnhts,bnshv->bnthv', att, v)
         + jnp.einsum('bnthk,bnhkv->bnthv', q_in, s_enter))
    return o.reshape(bsz, seq_len, nh, v.shape[-1]), s_final


def gla_mixer(pc, pl, a2, a_b, norm_g, ctx_out):
    f32 = jnp.float32

    def prep(p):
        q, k, v, r, a1 = p
        bsz, seq_len, _ = q.shape
        z = jnp.einsum('blzr,zrk->blzk', a1.astype(f32).reshape(bsz, seq_len, 2, GLA_RANK),
                       a2.astype(f32)) + a_b.astype(f32)
        log_a = (jax.nn.log_sigmoid(z) / GLA_TAU).reshape(bsz, seq_len, 2, GLA_HEADS, GLA_DK)
        qh = q.astype(f32).reshape(bsz, seq_len, GLA_HEADS, GLA_DK) * GLA_DK ** -0.5
        kh = k.astype(f32).reshape(bsz, seq_len, GLA_HEADS, GLA_DK)
        vh = v.astype(f32).reshape(bsz, seq_len, GLA_HEADS, GLA_DV)
        return qh, kh, vh, log_a, r

    qc, kc, vc, lac, rc = prep(pc)
    ql, kl, vl, lal, rl = prep(pl)
    s0 = jnp.zeros((qc.shape[0], GLA_HEADS, GLA_DK, GLA_DV), f32)
    o_c, o_l = [], []
    for r in range(2):
        rev = r == 1
        oc, s_c = _gla_direction(_flip(qc, rev), _flip(kc, rev), _flip(vc, rev), _flip(lac[:, :, r], rev), s0, ctx_out)
        ol, _ = _gla_direction(_flip(ql, rev), _flip(kl, rev), _flip(vl, rev), _flip(lal[:, :, r], rev), s_c, True)
        o_l.append(_flip(ol, rev))
        if ctx_out:
            o_c.append(_flip(oc, rev))

    def finish(os_, r):
        o = _rmsnorm(os_[0] + os_[1], norm_g)
        return (o.reshape(r.shape) * jax.nn.silu(r.astype(f32))).astype(r.dtype)

    return (finish(o_c, rc) if ctx_out else None), finish(o_l, rl)


def _dwconv(x, w, b):
    y = lax.conv_general_dilated(x, w[:, None, :], window_strides=(1,),
                                 padding=[(SSD_CONV // 2, SSD_CONV // 2)],
                                 dimension_numbers=('NWC', 'WIO', 'NWC'),
                                 feature_group_count=x.shape[-1])
    return y + b


def _ssd_direction(x, bm, cm, dt, a, s0, with_out):
    bsz, seq_len, nh, hd = x.shape
    csz = min(SSD_CHUNK, seq_len)
    nc = seq_len // csz
    x, bm, cm = (t.reshape(bsz, nc, csz, nh, t.shape[-1]) for t in (x, bm, cm))
    dt = dt.reshape(bsz, nc, csz, nh)
    cum = jnp.cumsum(dt * a, axis=2)
    xdt = x * dt[..., None]
    s_enter, s_final = _chunk_states(bm * jnp.exp(cum[:, :, -1:] - cum)[..., None], xdt,
                                     jnp.exp(cum[:, :, -1])[..., None], s0)
    if not with_out:
        return None, s_final
    seg = cum[:, :, :, None, :] - cum[:, :, None, :, :]
    decay = jnp.exp(jnp.where(_tril(csz)[..., None], seg, -jnp.inf))
    scores = jnp.einsum('bnthd,bnshd->bntsh', cm, bm) * decay
    y = (jnp.einsum('bntsh,bnshp->bnthp', scores, xdt)
         + jnp.einsum('bnthd,bnhdp->bnthp', cm * jnp.exp(cum)[..., None], s_enter))
    return y.reshape(bsz, seq_len, nh, hd), s_final


def ssd_mixer(pc, pl, conv_w, conv_b, a_log, dt_bias, d_skip, norm_g, ctx_out):
    f32 = jnp.float32
    w, bconv = conv_w.astype(f32), conv_b.astype(f32)

    def conv_ctx(t):
        return _dwconv(t, w, bconv)

    def conv_lat(t):
        bsz, seq_len, ch = t.shape
        rows = seq_len // GRID_W
        return _dwconv(t.reshape(bsz * rows, GRID_W, ch), w, bconv).reshape(bsz, seq_len, ch)

    def prep(p, conv):
        z, xbc, dt_raw = p
        bsz, seq_len, _ = z.shape
        xbc = jax.nn.silu(conv(xbc.astype(f32)))
        xs, bm, cm = jnp.split(xbc, [D_GROUP, D_GROUP + SSD_GROUPS * SSD_STATE], axis=-1)
        rep = SSD_HEADS // SSD_GROUPS

        def grp(t):
            return jnp.repeat(t.reshape(bsz, seq_len, SSD_GROUPS, SSD_STATE), rep, axis=2)

        dt = jax.nn.softplus(dt_raw.astype(f32).reshape(bsz, seq_len, 2, SSD_HEADS) + dt_bias.astype(f32))
        return xs.reshape(bsz, seq_len, SSD_HEADS, SSD_HD), grp(bm), grp(cm), dt, z

    xc, bc, cc, dtc, zc = prep(pc, conv_ctx)
    xl, bl, cl, dtl, zl = prep(pl, conv_lat)
    a = -jnp.exp(a_log.astype(f32))
    s0 = jnp.zeros((xc.shape[0], SSD_HEADS, SSD_STATE, SSD_HD), f32)
    y_c, y_l = [], []
    for r in range(2):
        rev = r == 1
        yc, s_c = _ssd_direction(_flip(xc, rev), _flip(bc, rev), _flip(cc, rev), _flip(dtc[:, :, r], rev), a[r], s0, ctx_out)
        yl, _ = _ssd_direction(_flip(xl, rev), _flip(bl, rev), _flip(cl, rev), _flip(dtl[:, :, r], rev), a[r], s_c, True)
        y_l.append(_flip(yl, rev))
        if ctx_out:
            y_c.append(_flip(yc, rev))
    dsk = d_skip.astype(f32)

    def finish(x_h, ys, z):
        y = (ys[0] + ys[1] + dsk[:, None] * x_h).reshape(z.shape)
        return _rmsnorm(y * jax.nn.silu(z.astype(f32)), norm_g).astype(z.dtype)

    return (finish(xc, y_c, zc) if ctx_out else None), finish(xl, y_l, zl)


def moe_ffn(h, router_w, router_b, w_gu, b_gu, w_dn, b_dn):
    n_tok, dm = h.shape
    logits = (h @ router_w + router_b).astype(jnp.float32)
    top_logit, top_idx = lax.top_k(logits, TOP_K)
    gates = jax.nn.softmax(top_logit, axis=-1)
    e_flat = top_idx.reshape(-1)
    order = jnp.argsort(e_flat)
    e_sorted = e_flat[order]
    tok_sorted = order // TOP_K
    counts = jnp.bincount(e_flat, length=N_EXPERTS)
    padded = (counts + MOE_BLOCK - 1) // MOE_BLOCK * MOE_BLOCK
    seg_start = jnp.cumsum(counts) - counts
    pad_end = jnp.cumsum(padded)
    dest = (pad_end - padded)[e_sorted] + jnp.arange(n_tok * TOP_K) - seg_start[e_sorted]
    n_blocks = -(-(n_tok * TOP_K) // MOE_BLOCK) + N_EXPERTS
    buf = jnp.zeros((n_blocks * MOE_BLOCK, dm), h.dtype).at[dest].set(h[tok_sorted])
    block_expert = jnp.minimum(jnp.searchsorted(pad_end, jnp.arange(n_blocks) * MOE_BLOCK, side='right'),
                               N_EXPERTS - 1)

    def run_block(args):
        xb, e = args
        gu = xb @ w_gu[e] + b_gu[e]
        gate = jnp.minimum(gu[:, 0::2], SWIGLU_LIMIT)
        up = jnp.clip(gu[:, 1::2], -SWIGLU_LIMIT, SWIGLU_LIMIT)
        act = (up + 1.0) * gate * jax.nn.sigmoid(SWIGLU_ALPHA * gate)
        return act @ w_dn[e] + b_dn[e]

    y_buf = lax.map(run_block, (buf.reshape(n_blocks, MOE_BLOCK, dm), block_expert)).reshape(-1, dm)
    y_pairs = y_buf[dest] * gates.reshape(-1)[order][:, None].astype(h.dtype)
    return jnp.zeros((n_tok, dm), h.dtype).at[tok_sorted].add(y_pairs)


def setup_inputs(seed: int = 0) -> dict:
    key = jax.random.key(seed)
    ks = jax.random.split(key, 36)
    f32 = jnp.float32
    nl = DEPTH

    def nrm(k, shape, scale):
        return jax.random.normal(k, shape, f32) * scale

    def gain(k, shape):
        return 1.0 + nrm(k, shape, 0.05)

    s5_n = jnp.arange(S5_STATE, dtype=f32)
    ssd_dt = jnp.exp(jax.random.uniform(ks[26], (nl, 2, SSD_HEADS), f32, math.log(1e-3), math.log(1e-1)))
    return {
        'x': nrm(ks[0], (BATCH, SEQ, D_MODEL), 1.0),
        'c': nrm(ks[1], (BATCH, D_MODEL), 1.0),
        'ctx': nrm(ks[2], (BATCH, CTX_LEN, D_MODEL), 1.0),
        'c_ctx': nrm(ks[3], (D_MODEL,), 1.0),
        'ada_w': nrm(ks[4], (nl, D_MODEL, N_MOD * D_MODEL), 0.5 * D_MODEL ** -0.5),
        'ada_b': nrm(ks[5], (nl, N_MOD * D_MODEL), 0.02),
        'norm_mix_g': gain(ks[6], (nl, D_MODEL)),
        'norm_ffn_g': gain(ks[7], (nl, D_MODEL)),
        'w_in': nrm(ks[8], (nl, D_MODEL, D_IN_PROJ), D_MODEL ** -0.5),
        'w_out': nrm(ks[9], (nl, D_MIX, D_MODEL), D_MIX ** -0.5),
        'four_w': nrm(ks[10], (nl, D_GROUP, D_GROUP), D_GROUP ** -0.5),
        's5_lam_re': -0.5 + nrm(ks[11], (nl, 2, S5_GROUPS, S5_STATE), 0.01),
        's5_lam_im': math.pi * s5_n + nrm(ks[12], (nl, 2, S5_GROUPS, S5_STATE), 0.01),
        's5_log_dt': jax.random.uniform(ks[13], (nl, 2, S5_GROUPS), f32, math.log(1e-3), math.log(1e-1)),
        's5_b_re': nrm(ks[14], (nl, 2, S5_GROUPS, S5_STATE, S5_CH), (2 * S5_CH) ** -0.5),
        's5_b_im': nrm(ks[15], (nl, 2, S5_GROUPS, S5_STATE, S5_CH), (2 * S5_CH) ** -0.5),
        's5_c_re': nrm(ks[16], (nl, 2, S5_GROUPS, S5_CH, S5_STATE), S5_STATE ** -0.5),
        's5_c_im': nrm(ks[17], (nl, 2, S5_GROUPS, S5_CH, S5_STATE), S5_STATE ** -0.5),
        's5_d': nrm(ks[18], (nl, D_GROUP), 1.0),
        's5_w_glu': nrm(ks[19], (nl, D_GROUP, D_GROUP), D_GROUP ** -0.5),
        'gla_a2': nrm(ks[20], (nl, 2, GLA_RANK, GLA_HEADS * GLA_DK), GLA_RANK ** -0.5),
        'gla_a_b': nrm(ks[21], (nl, 2, GLA_HEADS * GLA_DK), 0.1),
        'gla_norm_g': gain(ks[22], (nl, GLA_DV)),
        'ssd_conv_w': nrm(ks[23], (nl, SSD_CONV, SSD_XBC), SSD_CONV ** -0.5),
        'ssd_conv_b': nrm(ks[24], (nl, SSD_XBC), 0.02),
        'ssd_a_log': jnp.log(jax.random.uniform(ks[25], (nl, 2, SSD_HEADS), f32, 1.0, 16.0)),
        'ssd_dt_bias': ssd_dt + jnp.log(-jnp.expm1(-ssd_dt)),
        'ssd_d': 1.0 + nrm(ks[27], (nl, SSD_HEADS), 0.1),
        'ssd_norm_g': gain(ks[28], (nl, D_GROUP)),
        'router_w': nrm(ks[29], (nl, D_MODEL, N_EXPERTS), D_MODEL ** -0.5),
        'router_b': nrm(ks[30], (nl, N_EXPERTS), 0.01),
        'exp_w_gu': nrm(ks[31], (nl, N_EXPERTS, D_MODEL, 2 * D_EXPERT), D_MODEL ** -0.5),
        'exp_b_gu': nrm(ks[32], (nl, N_EXPERTS, 2 * D_EXPERT), 0.02),
        'exp_w_dn': nrm(ks[33], (nl, N_EXPERTS, D_EXPERT, D_MODEL), D_EXPERT ** -0.5),
        'exp_b_dn': nrm(ks[34], (nl, N_EXPERTS, D_MODEL), 0.02),
        'final_g': gain(ks[35], (D_MODEL,)),
    }


def reference(x, c, ctx, c_ctx, ada_w, ada_b, norm_mix_g, norm_ffn_g, w_in, w_out, four_w,
              s5_lam_re, s5_lam_im, s5_log_dt, s5_b_re, s5_b_im, s5_c_re, s5_c_im, s5_d, s5_w_glu,
              gla_a2, gla_a_b, gla_norm_g, ssd_conv_w, ssd_conv_b, ssd_a_log, ssd_dt_bias, ssd_d,
              ssd_norm_g, router_w, router_b, exp_w_gu, exp_b_gu, exp_w_dn, exp_b_dn, final_g):
    x_lat, x_ctx = x, ctx
    cond_lat = jax.nn.silu(c)
    cond_ctx = jax.nn.silu(c_ctx)[None, :]
    for i in range(DEPTH):
        ctx_out = i < DEPTH - 1
        m_l = _ada(cond_lat, ada_w[i], ada_b[i])
        m_c = _ada(cond_ctx, ada_w[i], ada_b[i])
        pl = _split_in(_modulate(_rmsnorm(x_lat, norm_mix_g[i]), m_l[0], m_l[1]) @ w_in[i])
        pc = _split_in(_modulate(_rmsnorm(x_ctx, norm_mix_g[i]), m_c[0], m_c[1]) @ w_in[i])
        s5_c, s5_l = s5_mixer(pc[1], pl[1], s5_lam_re[i], s5_lam_im[i], s5_log_dt[i], s5_b_re[i], s5_b_im[i],
                              s5_c_re[i], s5_c_im[i], s5_d[i], s5_w_glu[i], ctx_out)
        gla_c, gla_l = gla_mixer(pc[2:7], pl[2:7], gla_a2[i], gla_a_b[i], gla_norm_g[i], ctx_out)
        ssd_c, ssd_l = ssd_mixer(pc[7:], pl[7:], ssd_conv_w[i], ssd_conv_b[i], ssd_a_log[i], ssd_dt_bias[i],
                                 ssd_d[i], ssd_norm_g[i], ctx_out)
        mix_l = jnp.concatenate([fourier_mixer(pl[0], four_w[i]), s5_l, gla_l, ssd_l], axis=-1)
        x_lat = x_lat + m_l[2] * (mix_l @ w_out[i])
        h_l = _modulate(_rmsnorm(x_lat, norm_ffn_g[i]), m_l[3], m_l[4])
        if ctx_out:
            mix_c = jnp.concatenate([fourier_mixer(pc[0], four_w[i]), s5_c, gla_c, ssd_c], axis=-1)
            x_ctx = x_ctx + m_c[2] * (mix_c @ w_out[i])
            h_c = _modulate(_rmsnorm(x_ctx, norm_ffn_g[i]), m_c[3], m_c[4])
            n_c = h_c.shape[0] * h_c.shape[1]
            f = moe_ffn(jnp.concatenate([h_c.reshape(n_c, D_MODEL), h_l.reshape(-1, D_MODEL)], axis=0),
                        router_w[i], router_b[i], exp_w_gu[i], exp_b_gu[i], exp_w_dn[i], exp_b_dn[i])
            x_ctx = x_ctx + m_c[5] * f[:n_c].reshape(x_ctx.shape)
            f_l = f[n_c:].reshape(x_lat.shape)
        else:
            f_l = moe_ffn(h_l.reshape(-1, D_MODEL), router_w[i], router_b[i], exp_w_gu[i], exp_b_gu[i],
                          exp_w_dn[i], exp_b_dn[i]).reshape(x_lat.shape)
        x_lat = x_lat + m_l[5] * f_l
    return _rmsnorm(x_lat, final_g)
```

```cpp
#include <hip/hip_runtime.h>
#include <cstdio>
#include <cstdint>

#define GAS __attribute__((address_space(1)))
#define LAS __attribute__((address_space(3)))
typedef unsigned short bf16;
typedef short bf16x8 __attribute__((ext_vector_type(8)));
typedef short s16x4 __attribute__((ext_vector_type(4)));
typedef float f32x4 __attribute__((ext_vector_type(4)));
typedef float f32x2 __attribute__((ext_vector_type(2)));
typedef unsigned u32x4 __attribute__((ext_vector_type(4)));
typedef unsigned u32x2 __attribute__((ext_vector_type(2)));

namespace pg8 {
#define PG8_LAS __attribute__((address_space(3)))
typedef unsigned short bf16_t;
constexpr int BM = 256, BK = 64, HALF = 128, HTB = HALF * BK * 2  , STAGE_BYTES = 8 * HTB;

__host__ __device__ __forceinline__ int lds_byte(int r, int c) { const int st = (r >> 4) * 2 + (c >> 5), rr = r & 15, cc = c & 31, ob = rr * 64 + cc * 2; return st * 1024 + (ob ^ (((ob >> 9) & 1) << 5)); }
__host__ __device__ __forceinline__ void stage_rc(int b, int& R, int& C) { const int st = b / 1024, sb = b % 1024, swz = sb ^ (((sb >> 9) & 1) << 5); R = (st >> 1) * 16 + swz / 64; C = (st & 1) * 32 + (swz % 64) / 2; }
__host__ __device__ __forceinline__ int perm32(int rho) { const int n = rho >> 4, i = rho & 15; return 8 * (i >> 2) + 4 * n + (i & 3); }

struct Unit { int pm, pn, grp; size_t aoff, boff; };
struct Gemm { const bf16_t* A; const bf16_t* Bt; int lda, ldb, K; };

__device__ __forceinline__ unsigned cvt_pk_bf16(float lo, float hi) { unsigned r; asm volatile("v_cvt_pk_bf16_f32 %0, %1, %2" : "=v"(r) : "v"(lo), "v"(hi)); return r; }

template <class Epi, class Sched, bool ALIGN_EPI = true, bool SP2 = true>
__device__ __forceinline__ void gemm_phase(PG8_LAS unsigned char* lds, const Gemm g, const Sched& S, const Epi& E) {
    int tid = threadIdx.x; asm volatile("" : "+v"(tid));
    const int wid = __builtin_amdgcn_readfirstlane(tid >> 6), lane = tid & 63, wr = wid >> 2, wc = wid & 3, fr = lane & 15, fq = lane >> 4;
    const int K = g.K, nt = K / BK;
    unsigned voffA[2], voffB[2];
#pragma unroll
    for (int i = 0; i < 2; ++i) { int R, C; stage_rc(tid * 16 + i * 8192, R, C); const int Rb = Epi::PERM ? ((R & ~31) + perm32(R & 31)) : R;
        voffA[i] = (unsigned)(R * g.lda + C) * 2u; voffB[i] = (unsigned)(Rb * g.ldb + C) * 2u; }
    const size_t kstep = (size_t)(BK * 2);
    const size_t hstepA = (size_t)HALF * g.lda * 2, hstepB = (size_t)HALF * g.ldb * 2;
    const unsigned ldsw = (unsigned)wid * 1024u;
    const int aoff = lds_byte(wr * 64 + fr, fq * 8), boff = lds_byte(wc * 32 + fr, fq * 8);
#define PG8_SA(b, h) (((b) * 2 + (h)) * HTB)
#define PG8_SB(b, h) ((4 + (b) * 2 + (h)) * HTB)
#define PG8_STAGE(bufoff, gbase, voff) do { _Pragma("unroll") for (int _i = 0; _i < 2; ++_i) \
        __builtin_amdgcn_global_load_lds((const unsigned*)((const char*)(gbase) + (voff)[_i]), (PG8_LAS unsigned*)(lds + (bufoff) + ldsw + _i * 8192), 16, 0, 0); } while (0)
#define PG8_LDA(dst, b, h) do { _Pragma("unroll") for (int m = 0; m < 4; ++m) _Pragma("unroll") for (int k = 0; k < 2; ++k) dst[m][k] = *(const PG8_LAS bf16x8*)(lds + PG8_SA(b, h) + aoff + m * 2048 + k * 1024); } while (0)
#define PG8_LDB(dst, b, h) do { _Pragma("unroll") for (int n = 0; n < 2; ++n) _Pragma("unroll") for (int k = 0; k < 2; ++k) dst[n][k] = *(const PG8_LAS bf16x8*)(lds + PG8_SB(b, h) + boff + n * 2048 + k * 1024); } while (0)
#define PG8_MMA(ai, bj, At, Bt) do { __builtin_amdgcn_s_setprio(1); _Pragma("unroll") for (int m = 0; m < 4; ++m) _Pragma("unroll") for (int n = 0; n < 2; ++n) _Pragma("unroll") for (int k = 0; k < 2; ++k) \
        acc[ai][bj][m][n] = __builtin_amdgcn_mfma_f32_16x16x32_bf16(Bt[n][k], At[m][k], acc[ai][bj][m][n], 0, 0, 0); __builtin_amdgcn_s_setprio(0); } while (0)
#define PG8_WAIT_V(n) asm volatile("s_waitcnt vmcnt(" #n ")" ::: "memory")
#define PG8_WAIT_L(n) asm volatile("s_waitcnt lgkmcnt(" #n ")" ::: "memory")
#define PG8_BAR __builtin_amdgcn_s_barrier()
#define PG8_SCHED __builtin_amdgcn_sched_barrier(0)
    Unit cur, nxt; int cursor = 0;
    if (!S.next(cursor, cur)) return;
    f32x4 acc[2][2][4][2];
#pragma unroll
    for (int a = 0; a < 2; ++a)
#pragma unroll
        for (int b = 0; b < 2; ++b)
#pragma unroll
            for (int m = 0; m < 4; ++m)
#pragma unroll
                for (int n = 0; n < 2; ++n) acc[a][b][m][n] = (f32x4){0.f, 0.f, 0.f, 0.f};
    bf16x8 At[4][2], B0[2][2], B1[2][2];
    const char* cA = (const char*)g.A + cur.aoff; const char* cB = (const char*)g.Bt + cur.boff;
    if constexpr (SP2) {
        PG8_STAGE(PG8_SB(0, 0), cB, voffB); PG8_STAGE(PG8_SB(0, 1), cB + hstepB, voffB); PG8_STAGE(PG8_SA(0, 0), cA, voffA); PG8_STAGE(PG8_SA(0, 1), cA + hstepA, voffA);
        if (wr == 1) PG8_BAR;
        PG8_WAIT_V(2); PG8_BAR;
        PG8_STAGE(PG8_SB(1, 0), cB + kstep, voffB); PG8_STAGE(PG8_SA(1, 0), cA + kstep, voffA); PG8_STAGE(PG8_SB(1, 1), cB + hstepB + kstep, voffB);
        PG8_WAIT_V(6); PG8_BAR;
    } else {
        PG8_STAGE(PG8_SB(0, 0), cB, voffB); PG8_STAGE(PG8_SA(0, 0), cA, voffA); PG8_STAGE(PG8_SB(0, 1), cB + hstepB, voffB); PG8_STAGE(PG8_SA(0, 1), cA + hstepA, voffA);
        if (wr == 1) PG8_BAR;
        PG8_WAIT_V(4); PG8_BAR;
        PG8_STAGE(PG8_SB(1, 0), cB + kstep, voffB); PG8_STAGE(PG8_SA(1, 0), cA + kstep, voffA); PG8_STAGE(PG8_SB(1, 1), cB + hstepB + kstep, voffB);
        PG8_WAIT_V(6); PG8_BAR;
    }
    for (;;) {
        const bool has_next = S.next(cursor, nxt);
        const char* nA = has_next ? (const char*)g.A + nxt.aoff : cA; const char* nB = has_next ? (const char*)g.Bt + nxt.boff : cB;
        for (int t = 0; t < nt; t += 2) {
            const bool last = (t == nt - 2);
            const char* a1 = cA + (size_t)(t + 1) * kstep;
            const char* a2 = last ? nA : cA + (size_t)(t + 2) * kstep; const char* b2 = last ? nB : cB + (size_t)(t + 2) * kstep;
            const char* a3 = a2 + kstep; const char* b3 = b2 + kstep;
            if constexpr (SP2) {
            PG8_LDB(B0, 0, 0); PG8_LDB(B1, 0, 1); PG8_SCHED; PG8_LDA(At, 0, 0); PG8_STAGE(PG8_SA(1, 1), a1 + hstepA, voffA);
            PG8_WAIT_V(8); PG8_WAIT_L(0); PG8_BAR; PG8_MMA(0, 0, At, B0); PG8_MMA(0, 1, At, B1); PG8_BAR; PG8_SCHED;
            PG8_LDA(At, 0, 1); PG8_STAGE(PG8_SB(0, 0), b2, voffB); PG8_STAGE(PG8_SB(0, 1), b2 + hstepB, voffB); PG8_STAGE(PG8_SA(0, 0), a2, voffA);
            PG8_WAIT_V(8); PG8_WAIT_L(0); PG8_BAR; PG8_MMA(1, 0, At, B0); PG8_MMA(1, 1, At, B1); PG8_BAR; PG8_SCHED;
            PG8_LDB(B0, 1, 0); PG8_LDB(B1, 1, 1); PG8_SCHED; PG8_LDA(At, 1, 0); PG8_STAGE(PG8_SA(0, 1), a2 + hstepA, voffA);
            PG8_WAIT_V(8); PG8_WAIT_L(0); PG8_BAR; PG8_MMA(0, 0, At, B0); PG8_MMA(0, 1, At, B1); PG8_BAR; PG8_SCHED;
            PG8_LDA(At, 1, 1); PG8_STAGE(PG8_SB(1, 0), b3, voffB); PG8_STAGE(PG8_SB(1, 1), b3 + hstepB, voffB); PG8_STAGE(PG8_SA(1, 0), a3, voffA);
            PG8_WAIT_V(8); PG8_WAIT_L(0); PG8_BAR; PG8_MMA(1, 0, At, B0); PG8_MMA(1, 1, At, B1); PG8_BAR; PG8_SCHED;
            } else {
            PG8_LDB(B0, 0, 0); PG8_SCHED; PG8_LDA(At, 0, 0); PG8_STAGE(PG8_SA(1, 1), a1 + hstepA, voffA);
            PG8_WAIT_L(8); PG8_BAR; PG8_WAIT_L(0); PG8_MMA(0, 0, At, B0); PG8_BAR; PG8_SCHED;
            PG8_LDB(B1, 0, 1); PG8_STAGE(PG8_SB(0, 0), b2, voffB);
            PG8_BAR; PG8_WAIT_L(0); PG8_MMA(0, 1, At, B1); PG8_BAR;
            PG8_LDA(At, 0, 1); PG8_STAGE(PG8_SA(0, 0), a2, voffA);
            PG8_BAR; PG8_WAIT_L(0); PG8_MMA(1, 0, At, B0); PG8_BAR; PG8_SCHED;
            PG8_STAGE(PG8_SB(0, 1), b2 + hstepB, voffB);
            PG8_WAIT_V(6); PG8_BAR; PG8_MMA(1, 1, At, B1); PG8_BAR;
            PG8_LDB(B0, 1, 0); PG8_SCHED; PG8_LDA(At, 1, 0); PG8_STAGE(PG8_SA(0, 1), a2 + hstepA, voffA);
            PG8_WAIT_L(8); PG8_BAR; PG8_WAIT_L(0); PG8_MMA(0, 0, At, B0); PG8_BAR; PG8_SCHED;
            PG8_LDB(B1, 1, 1); PG8_STAGE(PG8_SB(1, 0), b3, voffB);
            PG8_BAR; PG8_WAIT_L(0); PG8_MMA(0, 1, At, B1); PG8_BAR;
            PG8_LDA(At, 1, 1); PG8_STAGE(PG8_SA(1, 0), a3, voffA);
            PG8_BAR; PG8_WAIT_L(0); PG8_MMA(1, 0, At, B0); PG8_BAR; PG8_SCHED;
            PG8_STAGE(PG8_SB(1, 1), b3 + hstepB, voffB);
            PG8_WAIT_V(6); PG8_BAR; PG8_MMA(1, 1, At, B1); PG8_BAR;
            }
        }
        if constexpr (ALIGN_EPI) { if (wr == 0) PG8_BAR; }
        E(acc, cur, wr, wc, fr, fq);
        if (!has_next) break;
#pragma unroll
        for (int a = 0; a < 2; ++a)
#pragma unroll
            for (int b = 0; b < 2; ++b)
#pragma unroll
                for (int m = 0; m < 4; ++m)
#pragma unroll
                    for (int n = 0; n < 2; ++n) acc[a][b][m][n] = (f32x4){0.f, 0.f, 0.f, 0.f};
        cur = nxt; cA = nA; cB = nB;
        if constexpr (ALIGN_EPI) { if (wr == 1) PG8_BAR; }
    }
    PG8_WAIT_V(0);
    if constexpr (!ALIGN_EPI) { if (wr == 0) PG8_BAR; }
    PG8_BAR;
#undef PG8_SA
#undef PG8_SB
#undef PG8_STAGE
#undef PG8_LDA
#undef PG8_LDB
#undef PG8_MMA
#undef PG8_WAIT_V
#undef PG8_WAIT_L
#undef PG8_BAR
#undef PG8_SCHED
}
}
#define XB_TMO      128
#define XB_XCNT(j)  (256  + 64 * (j))
#define XB_XSUB(j)  (1280 + 64 * (j))
#define XB_XGEN(j)  (2304 + 64 * (j))
#define XB_TOP      3328
#define XB_TOPGEN   3392
#define XCD_BAR_WORDS 3456
#define XB_SPIN_CAP (1u << 18)

__device__ __forceinline__ unsigned xb_ld(unsigned* p)              { return __hip_atomic_load(p, __ATOMIC_RELAXED, __HIP_MEMORY_SCOPE_AGENT); }
__device__ __forceinline__ unsigned xb_add(unsigned* p, unsigned v) { return __hip_atomic_fetch_add(p, v, __ATOMIC_RELAXED, __HIP_MEMORY_SCOPE_AGENT); }
__device__ __forceinline__ unsigned xb_xcc_id() { return (unsigned)__builtin_amdgcn_s_getreg((3 << 11) | 20) & 0xFu; }
#define XB_SPIN(cond, bar) do { unsigned _sp = 0; while (cond) { __builtin_amdgcn_s_sleep(1); \
    if ((++_sp & 255u) == 0u) { if (xb_ld(&(bar)[XB_TMO])) break; if (_sp > XB_SPIN_CAP) { atomicAdd(&(bar)[XB_TMO], 1u); break; } } } } while (0)

struct XcdBarrier {
    unsigned* bar; unsigned x;
    volatile LAS unsigned* st;
};

__device__ __forceinline__ XcdBarrier xcd_barrier_post(unsigned* bar, volatile LAS unsigned* st) {
    XcdBarrier b; b.bar = bar; b.x = xb_xcc_id(); b.st = st;
    if (threadIdx.x == 0) (void)xb_add(&bar[XB_XCNT(b.x)], 1u);
    return b;
}
__device__ __forceinline__ void xcd_barrier_complete(unsigned* bar, unsigned x, unsigned& nloc, unsigned& nx) {
    const unsigned G = gridDim.x * gridDim.y * gridDim.z;
    unsigned sum, cnt, mine, sp = 0u;
    for (;;) {
        sum = 0u; cnt = 0u; mine = 0u;
#pragma unroll
        for (unsigned j = 0; j < 16; ++j) { const unsigned c = xb_ld(&bar[XB_XCNT(j)]); sum += c; cnt += (c > 0u) ? 1u : 0u; mine = (j == x) ? c : mine; }
        if (sum == G) break;
        __builtin_amdgcn_s_sleep(1);
        if ((++sp & 255u) == 0u) { if (xb_ld(&bar[XB_TMO])) break; if (sp > XB_SPIN_CAP) { atomicAdd(&bar[XB_TMO], 1u); break; } }
    }
    nloc = mine > 0u ? mine : 1u; nx = cnt > 0u ? cnt : 1u;
}

__device__ __forceinline__ void xcd_barrier(const XcdBarrier& b) {
    asm volatile("s_waitcnt vmcnt(0)" ::: "memory");
    __syncthreads();
    if (threadIdx.x == 0) {
        unsigned* bar = b.bar;
        __builtin_amdgcn_s_waitcnt(0);
        unsigned nloc = b.st[0], nx = b.st[1];
        if (nloc == 0u) { xcd_barrier_complete(bar, b.x, nloc, nx); b.st[0] = nloc; b.st[1] = nx; }
        const unsigned old = xb_add(&bar[XB_XSUB(b.x)], 1u);
        const unsigned gen = old / nloc;
        if (old + 1u == (gen + 1u) * nloc) {
            __builtin_amdgcn_fence(__ATOMIC_RELEASE, "agent");
            asm volatile("s_waitcnt vmcnt(0)" ::: "memory");
            const unsigned og = xb_add(&bar[XB_TOP], 1u);
            const unsigned tg = og / nx;
            if (og + 1u == (tg + 1u) * nx) xb_add(&bar[XB_TOPGEN], 1u);
            else XB_SPIN(xb_ld(&bar[XB_TOPGEN]) == tg, bar);
            __builtin_amdgcn_fence(__ATOMIC_ACQUIRE, "agent");
            xb_add(&bar[XB_XGEN(b.x)], 1u);
            asm volatile("s_waitcnt vmcnt(0)" ::: "memory");
        } else {
            XB_SPIN(xb_ld(&bar[XB_XGEN(b.x)]) == gen, bar);
            __builtin_amdgcn_fence(__ATOMIC_ACQUIRE, "agent");
            asm volatile("s_waitcnt vmcnt(0)" ::: "memory");
        }
    }
    __syncthreads();
}

constexpr int NWAVES = 8, NTHR = 512;
constexpr int DM = 1024, NB = 8, SEQ = 4096, CTXL = 256, DEPTH = 4;
constexpr int NLAT = NB * SEQ, NCTX = NB * CTXL, NT = NLAT + NCTX;
constexpr int PW = 2304;
constexpr int MW = 1280;
constexpr int NEXP = 32, MAXBLK = 576;
constexpr int NCHK = 544;
constexpr int S5ROWS = 2304;
constexpr int PC_FU = 0, PC_S5 = 256, PC_Q = 512, PC_K = 640, PC_V = 768, PC_R = 1024, PC_Z = 1280, PC_XBC = 1536, PC_A1 = 2048, PC_DT = 2080;
enum { I_X = 0, I_C, I_CTX, I_CCTX, I_ADAW, I_ADAB, I_NMG, I_NFG, I_WIN, I_WOUT, I_FOURW, I_S5LRE, I_S5LIM, I_S5LDT, I_S5BRE, I_S5BIM, I_S5CRE, I_S5CIM, I_S5D, I_S5GLU,
       I_GLAA2, I_GLAAB, I_GLANG, I_SSDCW, I_SSDCB, I_SSDALOG, I_SSDDTB, I_SSDD, I_SSDNG, I_RW, I_RB, I_WGU, I_BGU, I_WDN, I_BDN, I_FING, N_IN };

constexpr size_t al256(size_t x) { return (x + 255) & ~(size_t)255; }
constexpr size_t WS_CTL = 0, CTL_BYTES = 1u << 20;
constexpr size_t WS_MOD = WS_CTL + CTL_BYTES;
constexpr size_t WS_TAB = WS_MOD + al256((size_t)DEPTH * 9 * 6144 * 4);
constexpr size_t TAB_F64 = 0, TAB_TW = 16384, TAB_D256 = 16384 + 32768, TAB_BYTES = 65536;
constexpr size_t WS_A16 = WS_TAB + TAB_BYTES;
constexpr size_t WS_WIN = WS_A16 + al256((size_t)DEPTH * 2 * 16 * 64 * 2 * 4);
constexpr size_t WS_WOUT = WS_WIN + (size_t)DEPTH * PW * DM * 2;
constexpr size_t WS_WGLU = WS_WOUT + (size_t)DEPTH * DM * MW * 2;
constexpr size_t WS_S5P = WS_WGLU + (size_t)DEPTH * 256 * 256 * 2;
constexpr size_t WS_S5B2 = WS_S5P + (size_t)DEPTH * 16 * 256 * 256 * 2;
constexpr size_t WS_WGU = WS_S5B2 + (size_t)DEPTH * 16 * 256 * 512 * 2;
constexpr size_t WS_WDN = WS_WGU + (size_t)DEPTH * NEXP * 2048 * DM * 2;
constexpr size_t WS_XS = WS_WDN + (size_t)DEPTH * NEXP * DM * DM * 2;
constexpr size_t WS_H = WS_XS + (size_t)NT * DM * 4;
constexpr size_t WS_PBUF = WS_H + (size_t)NT * DM * 2;
constexpr size_t WS_A2 = WS_PBUF + (size_t)NT * PW * 2;
constexpr size_t WS_S5S = WS_A2 + (size_t)16 * S5ROWS * 512 * 2;
constexpr size_t WS_ACT5 = WS_S5S + (size_t)16 * S5ROWS * 256 * 4;
constexpr size_t WS_MIX = WS_ACT5 + (size_t)NT * 256 * 2;
constexpr size_t WS_GDS = WS_MIX + (size_t)NT * MW * 2;
constexpr size_t WS_GDEC = WS_GDS + (size_t)NCHK * 8 * 2048 * 4;
constexpr size_t WS_GSE = WS_GDEC + al256((size_t)NCHK * 8 * 32 * 4);
constexpr size_t WS_SDS = WS_GSE + (size_t)NCHK * 8 * 2048 * 2;
constexpr size_t WS_SDEC = WS_SDS + (size_t)NCHK * 8 * 4096 * 4;
constexpr size_t WS_SSE = WS_SDEC + al256((size_t)NCHK * 8 * 4);
constexpr size_t WS_PE = WS_SSE + (size_t)NCHK * 8 * 4096 * 2;
constexpr size_t WS_PR = WS_PE + (size_t)NT * 4 * 4;
constexpr size_t WS_PG = WS_PR + (size_t)NT * 4 * 4;
constexpr size_t WS_PS = WS_PG + (size_t)NT * 4 * 4;
constexpr size_t WS_SG = WS_PS + (size_t)NT * 4 * 4;
constexpr size_t WS_BUF = WS_SG + (size_t)MAXBLK * 256 * 4;
constexpr size_t WS_ACT = WS_BUF + (size_t)MAXBLK * 256 * DM * 2;
constexpr size_t WS_Y = WS_ACT + (size_t)MAXBLK * 256 * DM * 2;
constexpr size_t WS_END = WS_Y + (size_t)MAXBLK * 256 * DM * 2;
constexpr int CW_QUEUE = 64;
constexpr int CW_CNT = 1024;
constexpr int CW_BLKE = 2048;
constexpr int CW_BAR = 8192;

constexpr int LDS_BYTES = 163840, MISC_OFF = LDS_BYTES - 256;

#define RLX_AGENT __ATOMIC_RELAXED, __HIP_MEMORY_SCOPE_AGENT
__device__ __forceinline__ unsigned f2bf(float f) { unsigned u = __builtin_bit_cast(unsigned, f); return (u + 0x7fffu + ((u >> 16) & 1u)) >> 16; }
__device__ __forceinline__ unsigned pk2(float lo, float hi) { return f2bf(lo) | (f2bf(hi) << 16); }
__device__ __forceinline__ float bf2f(unsigned short b) { return __builtin_bit_cast(float, (unsigned)b << 16); }
__device__ __forceinline__ float bflo(unsigned w) { return __builtin_bit_cast(float, w << 16); }
__device__ __forceinline__ float bfhi(unsigned w) { return __builtin_bit_cast(float, w & 0xffff0000u); }
template <int M> __device__ __forceinline__ float swz_xor(float v) { return __builtin_bit_cast(float, __builtin_amdgcn_ds_swizzle(__builtin_bit_cast(int, v), (M << 10) | 0x1F)); }
__device__ __forceinline__ float xor32f(float v, int lane) { return __builtin_bit_cast(float, __builtin_amdgcn_ds_bpermute((lane ^ 32) << 2, __builtin_bit_cast(int, v))); }
__device__ __forceinline__ float wave_sum(float v, int lane) { v += swz_xor<1>(v); v += swz_xor<2>(v); v += swz_xor<4>(v); v += swz_xor<8>(v); v += swz_xor<16>(v); v += xor32f(v, lane); return v; }
__device__ __forceinline__ float wave_max(float v, int lane) { v = fmaxf(v, swz_xor<1>(v)); v = fmaxf(v, swz_xor<2>(v)); v = fmaxf(v, swz_xor<4>(v)); v = fmaxf(v, swz_xor<8>(v)); v = fmaxf(v, swz_xor<16>(v)); v = fmaxf(v, xor32f(v, lane)); return v; }
__device__ __forceinline__ float sigmoidf_(float x) { return 1.f / (1.f + __expf(-x)); }
__device__ __forceinline__ float siluf_(float x) { return x / (1.f + __expf(-x)); }

template <class Fill> struct SgOrder {
    int nblk, nN, R, x, r, xs; Fill f;
    __device__ __forceinline__ void init(int nblk_, int nN_, int G, int c) { nblk = nblk_; nN = nN_; if ((G & 7) == 0) { R = G >> 3; x = c & 7; r = c >> 3; xs = 8; } else { R = G; x = 0; r = c; xs = 1; } }
    __device__ __forceinline__ bool next(int& cursor, pg8::Unit& u) const {
        const int ups = 8 * nN, nsg = (nblk + 7) >> 3;
        for (;;) {
            const int v = r + R * cursor; ++cursor;
            const int sgl = v / ups, uu = v - sgl * ups, sg = x + xs * sgl;
            if (sg >= nsg) return false;
            const int blk = sg * 8 + (uu & 7), pn = uu >> 3;
            if (blk >= nblk) continue;
            u.pm = blk; u.pn = pn; f(u); return true;
        }
    }
};
struct FillPlain { size_t astep, bstep; __device__ __forceinline__ void operator()(pg8::Unit& u) const { u.grp = 0; u.aoff = (size_t)u.pm * astep; u.boff = (size_t)u.pn * bstep; } };
struct FillS5 { size_t bgrp; __device__ __forceinline__ void operator()(pg8::Unit& u) const { const int g = u.pm / 9, t = u.pm - g * 9; u.grp = g; u.pm = t; u.aoff = ((size_t)g * S5ROWS + (size_t)t * 256) * 512 * 2; u.boff = (size_t)g * bgrp; } };
struct FillMoe { const unsigned* blke; int erows; __device__ __forceinline__ void operator()(pg8::Unit& u) const { const int e = (int)blke[1 + u.pm]; u.grp = e; u.aoff = (size_t)u.pm * 256 * DM * 2; u.boff = ((size_t)e * erows + (size_t)u.pn * 256) * DM * 2; } };

using pg8::cvt_pk_bf16;
struct EpiInproj {
    static constexpr bool PERM = true;
    bf16* P; bf16* A2;
    __device__ __forceinline__ void operator()(const f32x4 (&acc)[2][2][4][2], const pg8::Unit& u, int wr, int wc, int fr, int fq) const {
        const int row0 = u.pm * 256 + wr * 64 + fr, col0 = u.pn * 256 + wc * 32 + 8 * fq;
#pragma unroll
        for (int ai = 0; ai < 2; ++ai)
#pragma unroll
            for (int m = 0; m < 4; ++m) {
                const int row = row0 + ai * 128 + m * 16;
#pragma unroll
                for (int bj = 0; bj < 2; ++bj) {
                    const f32x4 v0 = acc[ai][bj][m][0], v1 = acc[ai][bj][m][1];
                    u32x4 w; w.x = cvt_pk_bf16(v0[0], v0[1]); w.y = cvt_pk_bf16(v0[2], v0[3]); w.z = cvt_pk_bf16(v1[0], v1[1]); w.w = cvt_pk_bf16(v1[2], v1[3]);
                    const int col = col0 + bj * 128;
                    if (u.pn == 1) {
                        const int cc = col - 256, g = cc >> 4, hp = cc & 15;
                        const int crow = row < NLAT ? (row >> 4) : (2048 + ((row - NLAT) >> 4)), s = row & 15;
                        *(u32x4*)(A2 + ((size_t)g * S5ROWS + crow) * 512 + s * 16 + hp) = w;
                    } else *(u32x4*)(P + (size_t)row * PW + col) = w;
                }
            }
    }
};
struct EpiOutproj {
    static constexpr bool PERM = false;
    const float* xin; const float* ctxin; float* XS; const float* modL; int first;
    __device__ __forceinline__ void operator()(const f32x4 (&acc)[2][2][4][2], const pg8::Unit& u, int wr, int wc, int fr, int fq) const {
        const int rowt = u.pm * 256, bi = rowt < NLAT ? (rowt >> 12) : 8;
        const int row0 = rowt + wr * 64 + fr, col0 = u.pn * 256 + wc * 32 + 4 * fq;
        const float* gate = modL + (size_t)bi * 6144 + 2 * 1024;
        f32x4 gv[2][2];
#pragma unroll
        for (int bj = 0; bj < 2; ++bj)
#pragma unroll
            for (int n = 0; n < 2; ++n) gv[bj][n] = *(const f32x4*)(gate + col0 + bj * 128 + n * 16);
#pragma unroll
        for (int ai = 0; ai < 2; ++ai)
#pragma unroll
            for (int m = 0; m < 4; ++m) {
                const int row = row0 + ai * 128 + m * 16;
                const float* src = first ? (row < NLAT ? xin + (size_t)row * DM : ctxin + (size_t)(row - NLAT) * DM) : XS + (size_t)row * DM;
                float* dst = XS + (size_t)row * DM;
#pragma unroll
                for (int bj = 0; bj < 2; ++bj)
#pragma unroll
                    for (int n = 0; n < 2; ++n) { const int c = col0 + bj * 128 + n * 16; const f32x4 xo = *(const f32x4*)(src + c); *(f32x4*)(dst + c) = xo + gv[bj][n] * acc[ai][bj][m][n]; }
            }
    }
};
struct EpiSwiglu {
    static constexpr bool PERM = true;
    bf16* ACT; const float* bgu;
    __device__ __forceinline__ void operator()(const f32x4 (&acc)[2][2][4][2], const pg8::Unit& u, int wr, int wc, int fr, int fq) const {
        const int row0 = u.pm * 256 + wr * 64 + fr, i0 = u.pn * 128 + wc * 32 + 8 * fq;
        const float* bb = bgu + (size_t)u.grp * 2048 + 2 * i0;
        const f32x4 b0 = *(const f32x4*)(bb), b1 = *(const f32x4*)(bb + 4), b2 = *(const f32x4*)(bb + 8), b3 = *(const f32x4*)(bb + 12);
        const float bg[8] = {b0[0], b0[2], b1[0], b1[2], b2[0], b2[2], b3[0], b3[2]}, bu[8] = {b0[1], b0[3], b1[1], b1[3], b2[1], b2[3], b3[1], b3[3]};
#pragma unroll
        for (int ai = 0; ai < 2; ++ai)
#pragma unroll
            for (int m = 0; m < 4; ++m) {
                const int row = row0 + ai * 128 + m * 16;
                float o[8];
#pragma unroll
                for (int n = 0; n < 2; ++n)
#pragma unroll
                    for (int j = 0; j < 4; ++j) {
                        const int q = 4 * n + j;
                        const float gt = fminf(acc[ai][0][m][n][j] + bg[q], 7.0f);
                        const float up = fminf(fmaxf(acc[ai][1][m][n][j] + bu[q], -7.0f), 7.0f);
                        o[q] = (up + 1.0f) * gt * sigmoidf_(1.702f * gt);
                    }
                u32x4 w; w.x = cvt_pk_bf16(o[0], o[1]); w.y = cvt_pk_bf16(o[2], o[3]); w.z = cvt_pk_bf16(o[4], o[5]); w.w = cvt_pk_bf16(o[6], o[7]);
                *(u32x4*)(ACT + (size_t)row * DM + i0) = w;
            }
    }
};
struct EpiDown {
    static constexpr bool PERM = true;
    bf16* Y; const float* bdn; const float* sg;
    __device__ __forceinline__ void operator()(const f32x4 (&acc)[2][2][4][2], const pg8::Unit& u, int wr, int wc, int fr, int fq) const {
        const int row0 = u.pm * 256 + wr * 64 + fr, col0 = u.pn * 256 + wc * 32 + 8 * fq;
        const float* bb = bdn + (size_t)u.grp * DM + col0;
        f32x4 bv[2][2];
#pragma unroll
        for (int bj = 0; bj < 2; ++bj)
#pragma unroll
            for (int n = 0; n < 2; ++n) bv[bj][n] = *(const f32x4*)(bb + bj * 128 + 4 * n);
#pragma unroll
        for (int ai = 0; ai < 2; ++ai)
#pragma unroll
            for (int m = 0; m < 4; ++m) {
                const int row = row0 + ai * 128 + m * 16; const float gt = sg[row];
#pragma unroll
                for (int bj = 0; bj < 2; ++bj) {
                    const f32x4 v0 = (acc[ai][bj][m][0] + bv[bj][0]) * gt, v1 = (acc[ai][bj][m][1] + bv[bj][1]) * gt;
                    u32x4 w; w.x = cvt_pk_bf16(v0[0], v0[1]); w.y = cvt_pk_bf16(v0[2], v0[3]); w.z = cvt_pk_bf16(v1[0], v1[1]); w.w = cvt_pk_bf16(v1[2], v1[3]);
                    *(u32x4*)(Y + (size_t)row * DM + col0 + bj * 128) = w;
                }
            }
    }
};
struct EpiS5S {
    static constexpr bool PERM = false;
    float* S;
    __device__ __forceinline__ void operator()(const f32x4 (&acc)[2][2][4][2], const pg8::Unit& u, int wr, int wc, int fr, int fq) const {
        const int row0 = u.pm * 256 + wr * 64 + fr, col0 = wc * 32 + 4 * fq;
        float* base = S + (size_t)u.grp * S5ROWS * 256;
#pragma unroll
        for (int ai = 0; ai < 2; ++ai)
#pragma unroll
            for (int m = 0; m < 4; ++m) { float* rp = base + (size_t)(row0 + ai * 128 + m * 16) * 256 + col0;
#pragma unroll
                for (int bj = 0; bj < 2; ++bj)
#pragma unroll
                    for (int n = 0; n < 2; ++n) *(f32x4*)(rp + bj * 128 + n * 16) = acc[ai][bj][m][n]; }
    }
};
__device__ __forceinline__ float gelu_tanh(float x) { const float t = 0.7978845608f * (x + 0.044715f * x * x * x); const float e = __expf(2.f * t); return 0.5f * x * (1.f + (1.f - 2.f / (e + 1.f))); }
struct EpiS5Y {
    static constexpr bool PERM = true;
    bf16* ACT5;
    __device__ __forceinline__ void operator()(const f32x4 (&acc)[2][2][4][2], const pg8::Unit& u, int wr, int wc, int fr, int fq) const {
        const int row0 = u.pm * 256 + wr * 64 + fr, col0 = wc * 32 + 8 * fq;
#pragma unroll
        for (int ai = 0; ai < 2; ++ai)
#pragma unroll
            for (int m = 0; m < 4; ++m) {
                const int crow = row0 + ai * 128 + m * 16;
                if (crow >= 2176) continue;
                const int tok0 = crow < 2048 ? crow * 16 : NLAT + (crow - 2048) * 16;
#pragma unroll
                for (int bj = 0; bj < 2; ++bj) {
                    const int col = col0 + bj * 128, j = col >> 4, h = col & 15;
                    const f32x4 v0 = acc[ai][bj][m][0], v1 = acc[ai][bj][m][1];
                    u32x4 w; w.x = cvt_pk_bf16(gelu_tanh(v0[0]), gelu_tanh(v0[1])); w.y = cvt_pk_bf16(gelu_tanh(v0[2]), gelu_tanh(v0[3]));
                    w.z = cvt_pk_bf16(gelu_tanh(v1[0]), gelu_tanh(v1[1])); w.w = cvt_pk_bf16(gelu_tanh(v1[2]), gelu_tanh(v1[3]));
                    *(u32x4*)(ACT5 + (size_t)(tok0 + j) * 256 + u.grp * 16 + h) = w;
                }
            }
    }
};
struct EpiGlu {
    static constexpr bool PERM = true;
    const bf16* ACT5; bf16* MIX;
    __device__ __forceinline__ void operator()(const f32x4 (&acc)[2][2][4][2], const pg8::Unit& u, int wr, int wc, int fr, int fq) const {
        const int row0 = u.pm * 256 + wr * 64 + fr, col0 = wc * 32 + 8 * fq;
#pragma unroll
        for (int ai = 0; ai < 2; ++ai)
#pragma unroll
            for (int m = 0; m < 4; ++m) {
                const int row = row0 + ai * 128 + m * 16;
#pragma unroll
                for (int bj = 0; bj < 2; ++bj) {
                    const int col = col0 + bj * 128;
                    const u32x4 a = *(const u32x4*)(ACT5 + (size_t)row * 256 + col);
                    const f32x4 v0 = acc[ai][bj][m][0], v1 = acc[ai][bj][m][1];
                    u32x4 w;
                    w.x = cvt_pk_bf16(bflo(a.x) * sigmoidf_(v0[0]), bfhi(a.x) * sigmoidf_(v0[1])); w.y = cvt_pk_bf16(bflo(a.y) * sigmoidf_(v0[2]), bfhi(a.y) * sigmoidf_(v0[3]));
                    w.z = cvt_pk_bf16(bflo(a.z) * sigmoidf_(v1[0]), bfhi(a.z) * sigmoidf_(v1[1])); w.w = cvt_pk_bf16(bflo(a.w) * sigmoidf_(v1[2]), bfhi(a.w) * sigmoidf_(v1[3]));
                    *(u32x4*)(MIX + (size_t)row * MW + 512 + col) = w;
                }
            }
    }
};

struct Args { const float* in[N_IN]; float* out; unsigned char* ws; int ph_lo, ph_hi; };
struct Frame {
    LAS unsigned char* lds; volatile LAS unsigned* MISC; unsigned* ctl; unsigned char* ws;
    int tid, lane, wave, G, bid;
};

template <class Map> __device__ __forceinline__ void transpose_tile(const float* W, int ldw, int ncols, int k0, int n0, bf16* WT, int ldt, int kd0, const Map& map, LAS float* scr, int lane) {
    const int nn = n0 + lane;
#pragma unroll 16
    for (int kk = 0; kk < 64; ++kk) scr[kk * 65 + lane] = nn < ncols ? W[(size_t)(k0 + kk) * ldw + nn] : 0.f;
    asm volatile("s_waitcnt lgkmcnt(0)" ::: "memory");
    const int c = lane & 7;
#pragma unroll
    for (int j = 0; j < 8; ++j) {
        const int n = (lane >> 3) + 8 * j; const LAS float* s = scr + (8 * c) * 65 + n;
        u32x4 o; o.x = pk2(s[0], s[65]); o.y = pk2(s[2 * 65], s[3 * 65]); o.z = pk2(s[4 * 65], s[5 * 65]); o.w = pk2(s[6 * 65], s[7 * 65]);
        const int dr = (n0 + n) < ncols ? map(n0 + n) : -1;
        if (dr >= 0) *(u32x4*)(WT + (size_t)dr * ldt + kd0 + 8 * c) = o;
    }
    asm volatile("s_waitcnt lgkmcnt(0)" ::: "memory");
}
struct MapId { __device__ __forceinline__ int operator()(int n) const { return n; } };
struct MapWin { __device__ __forceinline__ int operator()(int c) const { return c < 1280 ? c : (c < 1312 ? 2048 + (c - 1280) : (c < 2080 ? c - 32 : c)); } };
struct MapGu { __device__ __forceinline__ int operator()(int n) const { const int i = n >> 1; return (i >> 7) * 256 + (n & 1) * 128 + (i & 127); } };

constexpr int PI_ADA = 48, PI_TAB = 1, PI_S5 = 64, PI_FOLD = 256, PI_ZERO = 4;
constexpr int TW_WIN = 16 * 33, TW_GU = 32 * 16 * 32, TW_DN = 32 * 16 * 16, TW_WOUT = 12 * 16, TW_GLU = 16, TW_LAYER = TW_WIN + TW_GU + TW_DN + TW_WOUT + TW_GLU;
constexpr int PI_TR = (DEPTH * TW_LAYER + 7) / 8;
constexpr int PI_B_TAB = PI_ADA, PI_B_S5 = PI_B_TAB + PI_TAB, PI_B_FOLD = PI_B_S5 + PI_S5, PI_B_ZERO = PI_B_FOLD + PI_FOLD, PI_B_TR = PI_B_ZERO + PI_ZERO, PI_TOTAL = PI_B_TR + PI_TR;

__device__ __forceinline__ void pro_adaln(Frame& F, const Args& a, int it) {
    const int L = it / 12, cb = it % 12;
    LAS float* cond = (LAS float*)F.lds;
    for (int i = F.tid; i < 9 * 1024; i += NTHR) { const int r = i >> 10, k = i & 1023; const float v = r < 8 ? a.in[I_C][r * 1024 + k] : a.in[I_CCTX][k]; cond[i] = siluf_(v); }
    __syncthreads();
    const int n = cb * 512 + F.tid;
    const float* w = a.in[I_ADAW] + (size_t)L * 1024 * 6144 + n;
    float acc[9];
    const float b = a.in[I_ADAB][L * 6144 + n];
#pragma unroll
    for (int r = 0; r < 9; ++r) acc[r] = b;
#pragma unroll 2
    for (int k = 0; k < 1024; k += 4) {
        const float w0 = w[(size_t)k * 6144], w1 = w[(size_t)(k + 1) * 6144], w2 = w[(size_t)(k + 2) * 6144], w3 = w[(size_t)(k + 3) * 6144];
#pragma unroll
        for (int r = 0; r < 9; ++r) { const f32x4 c4 = *(const LAS f32x4*)(cond + r * 1024 + k); acc[r] += c4[0] * w0 + c4[1] * w1 + c4[2] * w2 + c4[3] * w3; }
    }
    float* mod = (float*)(F.ws + WS_MOD) + (size_t)L * 9 * 6144 + n;
#pragma unroll
    for (int r = 0; r < 9; ++r) mod[(size_t)r * 6144] = acc[r];
    __syncthreads();
}
__device__ __forceinline__ void pro_tables(Frame& F) {
    bf16* f64 = (bf16*)(F.ws + WS_TAB + TAB_F64);
    for (int i = F.tid; i < 4096; i += NTHR) { const int k = i >> 6, n = i & 63; float s, c; sincospif((float)((k * n) & 63) / 32.f, &s, &c); f64[i] = (bf16)f2bf(c); f64[4096 + i] = (bf16)f2bf(s); }
    float* tw = (float*)(F.ws + WS_TAB + TAB_TW);
    for (int i = F.tid; i < 4096; i += NTHR) { float s, c; sincospif((float)i / 2048.f, &s, &c); tw[2 * i] = c; tw[2 * i + 1] = s; }
    float* d256 = (float*)(F.ws + WS_TAB + TAB_D256);
    for (int i = F.tid; i < 256; i += NTHR) { float s, c; sincospif((float)i / 128.f, &s, &c); d256[2 * i] = c; d256[2 * i + 1] = s; }
}
__device__ __forceinline__ void pro_fold(Frame& F, const Args& a, int it) {
    const int L = it >> 6, h = (it >> 4) & 3, nb = it & 15, n0 = nb * 64;
    LAS float* fw = (LAS float*)F.lds;
    LAS float* ct = fw + 64 * 65;
    if (F.tid < 64) ct[F.tid] = cospif((float)F.tid / 32.f);
    const float* four = a.in[I_FOURW] + (size_t)L * 256 * 256, *wo = a.in[I_WOUT] + (size_t)L * 1024 * 1024;
    const int n = F.tid & 63, cg = F.tid >> 6;
    { float s[8];
#pragma unroll
      for (int i = 0; i < 8; ++i) s[i] = 0.f;
      for (int j = 0; j < 256; ++j) { const float wv = wo[(size_t)j * 1024 + n0 + n];
#pragma unroll
          for (int i = 0; i < 8; ++i) s[i] += four[(size_t)(h * 64 + cg * 8 + i) * 256 + j] * wv; }
#pragma unroll
      for (int i = 0; i < 8; ++i) fw[(cg * 8 + i) * 65 + n] = s[i]; }
    __syncthreads();
    float oc[8], os[8];
#pragma unroll
    for (int i = 0; i < 8; ++i) { oc[i] = 0.f; os[i] = 0.f; }
    for (int kc = 0; kc < 64; ++kc) { const float v = fw[kc * 65 + n];
#pragma unroll
        for (int i = 0; i < 8; ++i) { const int mm = (kc * (cg * 8 + i)) & 63; oc[i] += ct[mm] * v; os[i] += ct[(mm + 48) & 63] * v; } }
    bf16* wt = (bf16*)(F.ws + WS_WOUT) + (size_t)L * DM * MW + (size_t)(n0 + n) * MW + h * 64 + cg * 8;
    u32x4 w; w.x = pk2(oc[0] * 0.125f, oc[1] * 0.125f); w.y = pk2(oc[2] * 0.125f, oc[3] * 0.125f); w.z = pk2(oc[4] * 0.125f, oc[5] * 0.125f); w.w = pk2(oc[6] * 0.125f, oc[7] * 0.125f);
    *(u32x4*)wt = w;
    w.x = pk2(os[0] * 0.125f, os[1] * 0.125f); w.y = pk2(os[2] * 0.125f, os[3] * 0.125f); w.z = pk2(os[4] * 0.125f, os[5] * 0.125f); w.w = pk2(os[6] * 0.125f, os[7] * 0.125f);
    *(u32x4*)(wt + 256) = w;
    __syncthreads();
}
__device__ __forceinline__ void pro_s5(Frame& F, const Args& a, int it) {
    const int L = it >> 4, g = it & 15;
    LAS float* pw = (LAS float*)F.lds;
    LAS float* bb = pw + 2 * 64 * 17 * 2;
    LAS float* cm = bb + 2 * 64 * 16 * 2;
    LAS float* kt = cm + 2 * 16 * 64 * 2;
    for (int i = F.tid; i < 2 * 64 * 17; i += NTHR) {
        const int r = i / (64 * 17), p = (i / 17) & 63, e = i % 17; const size_t q = ((size_t)(L * 2 + r) * 16 + g) * 64 + p;
        const float dt = __expf(a.in[I_S5LDT][(L * 2 + r) * 16 + g]); const float lr = a.in[I_S5LRE][q] * dt, li = a.in[I_S5LIM][q] * dt;
        float s, c; sincosf(li * (float)e, &s, &c); const float m = expf(lr * (float)e); pw[2 * i] = m * c; pw[2 * i + 1] = m * s;
    }
    for (int i = F.tid; i < 2 * 64 * 16; i += NTHR) {
        const int r = i >> 10, p = (i >> 4) & 63, h = i & 15; const size_t q = ((size_t)(L * 2 + r) * 16 + g) * 64 + p;
        const float dt = __expf(a.in[I_S5LDT][(L * 2 + r) * 16 + g]); const float lre = a.in[I_S5LRE][q], lim = a.in[I_S5LIM][q];
        float s, c; sincosf(lim * dt, &s, &c); const float m = expf(lre * dt); const float ar = m * c - 1.f, ai = m * s;
        const float den = 1.f / (lre * lre + lim * lim); const float cr = (ar * lre + ai * lim) * den, ci = (ai * lre - ar * lim) * den;
        const float br = a.in[I_S5BRE][q * 16 + h], bi = a.in[I_S5BIM][q * 16 + h];
        bb[2 * i] = cr * br - ci * bi; bb[2 * i + 1] = cr * bi + ci * br;
    }
    for (int i = F.tid; i < 2 * 16 * 64; i += NTHR) {
        const int r = i >> 10, h = (i >> 6) & 15, p = i & 63; const size_t q = (((size_t)(L * 2 + r) * 16 + g) * 16 + h) * 64 + p;
        cm[2 * i] = a.in[I_S5CRE][q]; cm[2 * i + 1] = a.in[I_S5CIM][q];
    }
    __syncthreads();
    for (int i = F.tid; i < 2 * 16 * 256; i += NTHR) {
        const int r = i >> 12, tau = (i >> 8) & 15, h = (i >> 4) & 15, hp = i & 15; float s = 0.f;
        for (int p = 0; p < 64; ++p) { const float cr = cm[2 * ((r * 16 + h) * 64 + p)], ci = cm[2 * ((r * 16 + h) * 64 + p) + 1];
            const float ar = pw[2 * ((r * 64 + p) * 17 + tau)], ai = pw[2 * ((r * 64 + p) * 17 + tau) + 1]; const float br = bb[2 * ((r * 64 + p) * 16 + hp)], bi = bb[2 * ((r * 64 + p) * 16 + hp) + 1];
            const float tr = cr * ar - ci * ai, ti = cr * ai + ci * ar; s += tr * br - ti * bi; }
        kt[i] = s;
    }
    __syncthreads();
    bf16* pt = (bf16*)(F.ws + WS_S5P) + (size_t)(L * 16 + g) * 256 * 256;
    for (int i = F.tid; i < 65536; i += NTHR) {
        const int np = i >> 8, k = i & 255, r = np >> 7, cpx = (np >> 6) & 1, p = np & 63, s = k >> 4, hp = k & 15, e = r ? s : 15 - s;
        const float ar = pw[2 * ((r * 64 + p) * 17 + e)], ai = pw[2 * ((r * 64 + p) * 17 + e) + 1]; const float br = bb[2 * ((r * 64 + p) * 16 + hp)], bi = bb[2 * ((r * 64 + p) * 16 + hp) + 1];
        pt[i] = (bf16)f2bf(cpx ? ar * bi + ai * br : ar * br - ai * bi);
    }
    bf16* b2 = (bf16*)(F.ws + WS_S5B2) + (size_t)(L * 16 + g) * 256 * 512;
    const float* dsk = a.in[I_S5D] + L * 256 + g * 16;
    for (int i = F.tid; i < 131072; i += NTHR) {
        const int n = i >> 9, k = i & 511, j = n >> 4, h = n & 15; float v;
        if (k < 256) { const int s = k >> 4, hp = k & 15; v = 0.f;
            if (j >= s) v += kt[((0 * 16 + (j - s)) * 16 + h) * 16 + hp];
            if (j <= s) v += kt[((1 * 16 + (s - j)) * 16 + h) * 16 + hp];
            if (j == s && h == hp) v += dsk[h];
        } else { const int kk = k - 256, r = kk >> 7, cpx = (kk >> 6) & 1, p = kk & 63, e = r ? 16 - j : j + 1;
            const float cr = cm[2 * ((r * 16 + h) * 64 + p)], ci = cm[2 * ((r * 16 + h) * 64 + p) + 1]; const float ar = pw[2 * ((r * 64 + p) * 17 + e)], ai = pw[2 * ((r * 64 + p) * 17 + e) + 1];
            v = cpx ? -(cr * ai + ci * ar) : (cr * ar - ci * ai); }
        b2[i] = (bf16)f2bf(v);
    }
    float* a16 = (float*)(F.ws + WS_A16) + (size_t)((L * 2) * 16 + g) * 128;
    if (F.tid < 128) { const int r = F.tid >> 6, p = F.tid & 63; float* o = a16 + (size_t)r * 16 * 128 + p * 2; o[0] = pw[2 * ((r * 64 + p) * 17 + 16)]; o[1] = pw[2 * ((r * 64 + p) * 17 + 16) + 1]; }
    __syncthreads();
}
__device__ __forceinline__ void pro_transposes(Frame& F, const Args& a, int wg_item) {
    LAS float* scr = (LAS float*)F.lds + F.wave * (64 * 65);
    const int wi = wg_item * 8 + F.wave;
    if (wi >= DEPTH * TW_LAYER) return;
    const int L = wi / TW_LAYER; int r = wi % TW_LAYER;
    if (r < TW_WIN) { const int kb = r / 33, nb = r % 33; transpose_tile(a.in[I_WIN] + (size_t)L * DM * 2088, 2088, 2088, kb * 64, nb * 64, (bf16*)(F.ws + WS_WIN) + (size_t)L * PW * DM, DM, kb * 64, MapWin(), scr, F.lane); return; } r -= TW_WIN;
    if (r < TW_GU) { const int e = r >> 9, kb = (r >> 5) & 15, nb = r & 31; transpose_tile(a.in[I_WGU] + ((size_t)L * NEXP + e) * DM * 2048, 2048, 2048, kb * 64, nb * 64, (bf16*)(F.ws + WS_WGU) + ((size_t)L * NEXP + e) * 2048 * DM, DM, kb * 64, MapGu(), scr, F.lane); return; } r -= TW_GU;
    if (r < TW_DN) { const int e = r >> 8, kb = (r >> 4) & 15, nb = r & 15; transpose_tile(a.in[I_WDN] + ((size_t)L * NEXP + e) * DM * DM, DM, DM, kb * 64, nb * 64, (bf16*)(F.ws + WS_WDN) + ((size_t)L * NEXP + e) * DM * DM, DM, kb * 64, MapId(), scr, F.lane); return; } r -= TW_DN;
    if (r < TW_WOUT) { const int kb = r >> 4, nb = r & 15; transpose_tile(a.in[I_WOUT] + (size_t)L * DM * DM + (size_t)256 * DM, DM, DM, kb * 64, nb * 64, (bf16*)(F.ws + WS_WOUT) + (size_t)L * DM * MW, MW, 512 + kb * 64, MapId(), scr, F.lane); return; } r -= TW_WOUT;
    { const int kb = r >> 2, nb = r & 3; transpose_tile(a.in[I_S5GLU] + (size_t)L * 256 * 256, 256, 256, kb * 64, nb * 64, (bf16*)(F.ws + WS_WGLU) + (size_t)L * 256 * 256, 256, kb * 64, MapId(), scr, F.lane); }
}
__device__ __forceinline__ void p_prologue(Frame& F, const Args& a) {
    for (;;) {
        if (F.tid == 0) F.MISC[0] = __hip_atomic_fetch_add(F.ctl + CW_QUEUE, 1u, RLX_AGENT);
        __syncthreads();
        const int it = (int)F.MISC[0];
        __syncthreads();
        if (it >= PI_TOTAL) break;
        if (it < PI_B_TAB) pro_adaln(F, a, it);
        else if (it < PI_B_S5) pro_tables(F);
        else if (it < PI_B_FOLD) pro_s5(F, a, it - PI_B_S5);
        else if (it < PI_B_ZERO) pro_fold(F, a, it - PI_B_FOLD);
        else if (it < PI_B_TR) { const int L = it - PI_B_ZERO; u32x4* z = (u32x4*)((bf16*)(F.ws + WS_WIN) + (size_t)L * PW * DM + (size_t)2088 * DM); for (int i = F.tid; i < (PW - 2088) * DM / 8; i += NTHR) z[i] = (u32x4){0u, 0u, 0u, 0u}; }
        else pro_transposes(F, a, it - PI_B_TR);
    }
}

__device__ __forceinline__ void p_norm1(Frame& F, const Args& a, int L) {
    const int gw = F.bid * NWAVES + F.wave, NGW = F.G * NWAVES;
    float* XS = (float*)(F.ws + WS_XS); bf16* H = (bf16*)(F.ws + WS_H);
    const float* mod = (const float*)(F.ws + WS_MOD) + (size_t)L * 9 * 6144; const float* modp = mod - 9 * 6144;
    const int* PS = (const int*)(F.ws + WS_PS); const bf16* Y = (const bf16*)(F.ws + WS_Y);
    const float* g = a.in[I_NMG] + L * DM;
    f32x4 gv[4];
#pragma unroll
    for (int j = 0; j < 4; ++j) gv[j] = *(const f32x4*)(g + 4 * F.lane + 256 * j);
    for (int row = gw; row < NT; row += NGW) {
        const int bi = row < NLAT ? (row >> 12) : 8;
        f32x4 v[4];
        if (L == 0) { const float* src = row < NLAT ? a.in[I_X] + (size_t)row * DM : a.in[I_CTX] + (size_t)(row - NLAT) * DM;
#pragma unroll
            for (int j = 0; j < 4; ++j) v[j] = *(const f32x4*)(src + 4 * F.lane + 256 * j);
        } else {
            float* xr = XS + (size_t)row * DM;
#pragma unroll
            for (int j = 0; j < 4; ++j) v[j] = *(const f32x4*)(xr + 4 * F.lane + 256 * j);
            f32x4 s[4];
#pragma unroll
            for (int j = 0; j < 4; ++j) s[j] = (f32x4){0.f, 0.f, 0.f, 0.f};
#pragma unroll
            for (int k = 0; k < 4; ++k) { const int slot = PS[row * 4 + k]; const bf16* yr = Y + (size_t)slot * DM;
#pragma unroll
                for (int j = 0; j < 4; ++j) { const u32x2 w = *(const u32x2*)(yr + 4 * F.lane + 256 * j); s[j] += (f32x4){bflo(w.x), bfhi(w.x), bflo(w.y), bfhi(w.y)}; } }
            const float* m5 = modp + (size_t)bi * 6144 + 5 * 1024;
#pragma unroll
            for (int j = 0; j < 4; ++j) { v[j] += *(const f32x4*)(m5 + 4 * F.lane + 256 * j) * s[j]; *(f32x4*)(xr + 4 * F.lane + 256 * j) = v[j]; }
        }
        float ss = 0.f;
#pragma unroll
        for (int j = 0; j < 4; ++j) ss += v[j][0] * v[j][0] + v[j][1] * v[j][1] + v[j][2] * v[j][2] + v[j][3] * v[j][3];
        const float rs = rsqrtf(wave_sum(ss, F.lane) * (1.f / DM) + 1e-6f);
        const float* sh = mod + (size_t)bi * 6144, *sc = sh + 1024;
        bf16* hr = H + (size_t)row * DM;
#pragma unroll
        for (int j = 0; j < 4; ++j) { const f32x4 s4 = *(const f32x4*)(sc + 4 * F.lane + 256 * j), h4 = *(const f32x4*)(sh + 4 * F.lane + 256 * j);
            const f32x4 o = v[j] * rs * gv[j] * (s4 + 1.f) + h4; u32x2 w; w.x = pk2(o[0], o[1]); w.y = pk2(o[2], o[3]); *(u32x2*)(hr + 4 * F.lane + 256 * j) = w; }
    }
}
__device__ __forceinline__ void p_norm2(Frame& F, const Args& a, int L, int nrows) {
    LAS float* rwt = (LAS float*)F.lds;
    const float* rw = a.in[I_RW] + (size_t)L * DM * NEXP;
    for (int i = F.tid; i < DM * NEXP; i += NTHR) { const int k = i >> 5, e = i & 31; rwt[e * 1024 + k] = rw[i]; }
    __syncthreads();
    const int gw = F.bid * NWAVES + F.wave, NGW = F.G * NWAVES;
    const float* XS = (const float*)(F.ws + WS_XS); bf16* H = (bf16*)(F.ws + WS_H);
    const float* mod = (const float*)(F.ws + WS_MOD) + (size_t)L * 9 * 6144;
    int* PE = (int*)(F.ws + WS_PE); int* PR = (int*)(F.ws + WS_PR); float* PG = (float*)(F.ws + WS_PG);
    unsigned* cnt = F.ctl + CW_CNT + L * 64;
    const float* g = a.in[I_NFG] + L * DM;
    const float rb = a.in[I_RB][L * NEXP + (F.lane >> 1)];
    f32x4 gv[4];
#pragma unroll
    for (int j = 0; j < 4; ++j) gv[j] = *(const f32x4*)(g + 4 * F.lane + 256 * j);
    for (int row = gw; row < nrows; row += NGW) {
        const int bi = row < NLAT ? (row >> 12) : 8;
        const float* xr = XS + (size_t)row * DM;
        f32x4 v[4]; float ss = 0.f;
#pragma unroll
        for (int j = 0; j < 4; ++j) { v[j] = *(const f32x4*)(xr + 4 * F.lane + 256 * j); ss += v[j][0] * v[j][0] + v[j][1] * v[j][1] + v[j][2] * v[j][2] + v[j][3] * v[j][3]; }
        const float rs = rsqrtf(wave_sum(ss, F.lane) * (1.f / DM) + 1e-6f);
        const float* sh = mod + (size_t)bi * 6144 + 3 * 1024, *sc = sh + 1024;
        bf16* hr = H + (size_t)row * DM;
#pragma unroll
        for (int j = 0; j < 4; ++j) { const f32x4 s4 = *(const f32x4*)(sc + 4 * F.lane + 256 * j), h4 = *(const f32x4*)(sh + 4 * F.lane + 256 * j);
            v[j] = v[j] * rs * gv[j] * (s4 + 1.f) + h4; u32x2 w; w.x = pk2(v[j][0], v[j][1]); w.y = pk2(v[j][2], v[j][3]); *(u32x2*)(hr + 4 * F.lane + 256 * j) = w; }
        float p[32];
#pragma unroll
        for (int e = 0; e < 32; ++e) { float s = 0.f;
#pragma unroll
            for (int j = 0; j < 4; ++j) { const f32x4 w4 = *(const LAS f32x4*)(rwt + e * 1024 + 4 * F.lane + 256 * j); s += v[j][0] * w4[0] + v[j][1] * w4[1] + v[j][2] * w4[2] + v[j][3] * w4[3]; }
            p[e] = s; if ((e & 3) == 3) asm volatile("" : "+v"(p[e]), "+v"(p[e - 1]), "+v"(p[e - 2]), "+v"(p[e - 3]) :: "memory"); }
#define RED_LEVEL(NKEEP, BIT, XCH) { const bool hi = (F.lane & (BIT)) != 0; _Pragma("unroll") for (int e = 0; e < (NKEEP); ++e) { const float send = hi ? p[e] : p[e + (NKEEP)], keep = hi ? p[e + (NKEEP)] : p[e]; p[e] = keep + XCH; } }
        RED_LEVEL(16, 32, xor32f(send, F.lane)) RED_LEVEL(8, 16, swz_xor<16>(send)) RED_LEVEL(4, 8, swz_xor<8>(send)) RED_LEVEL(2, 4, swz_xor<4>(send)) RED_LEVEL(1, 2, swz_xor<2>(send))
#undef RED_LEVEL
        float logit = p[0] + swz_xor<1>(p[0]) + rb;
        int es[4]; float ls[4];
#pragma unroll
        for (int k = 0; k < 4; ++k) {
            const float m = wave_max(logit, F.lane);
            const unsigned long long bal = __ballot(logit == m);
            const int fl = __builtin_ctzll(bal); es[k] = fl >> 1; ls[k] = m;
            if ((F.lane >> 1) == es[k]) logit = -3.0e38f;
        }
        const float e1 = __expf(ls[1] - ls[0]), e2 = __expf(ls[2] - ls[0]), e3 = __expf(ls[3] - ls[0]); const float inv = 1.f / (1.f + e1 + e2 + e3);
        if (F.lane < 4) {
            const int e = F.lane == 0 ? es[0] : (F.lane == 1 ? es[1] : (F.lane == 2 ? es[2] : es[3]));
            const float gt = (F.lane == 0 ? 1.f : (F.lane == 1 ? e1 : (F.lane == 2 ? e2 : e3))) * inv;
            const unsigned rk = __hip_atomic_fetch_add(cnt + e, 1u, RLX_AGENT);
            PE[row * 4 + F.lane] = e; PR[row * 4 + F.lane] = (int)rk; PG[row * 4 + F.lane] = gt;
        }
    }
    __syncthreads();
}
__device__ __forceinline__ void p_dispatch(Frame& F, int L, int nrows) {
    LAS int* base = (LAS int*)F.lds;
    unsigned* cnt = F.ctl + CW_CNT + L * 64; unsigned* blke = F.ctl + CW_BLKE + L * 1024;
    if (F.tid == 0) { int acc = 0; for (int e = 0; e < NEXP; ++e) { base[e] = acc; const int c = (int)__hip_atomic_load(cnt + e, RLX_AGENT); acc += (c + 255) & ~255; } base[32] = acc; }
    __syncthreads();
    if (F.bid == 0) { const int nblk = base[32] >> 8; if (F.tid == 0) blke[0] = (unsigned)nblk;
        for (int i = F.tid; i < nblk; i += NTHR) { int e = 0; for (int q = 1; q < NEXP; ++q) if (base[q] <= i * 256) e = q; blke[1 + i] = (unsigned)e; } }
    const int gw = F.bid * NWAVES + F.wave, NGW = F.G * NWAVES;
    const int* PE = (const int*)(F.ws + WS_PE); const int* PR = (const int*)(F.ws + WS_PR); const float* PG = (const float*)(F.ws + WS_PG);
    int* PS = (int*)(F.ws + WS_PS); float* SG = (float*)(F.ws + WS_SG);
    const bf16* H = (const bf16*)(F.ws + WS_H); bf16* BUF = (bf16*)(F.ws + WS_BUF);
    for (int pr = gw; pr < nrows * 4; pr += NGW) {
        const int e = PE[pr], slot = base[e] + PR[pr];
        const u32x4* src = (const u32x4*)(H + (size_t)(pr >> 2) * DM); u32x4* dst = (u32x4*)(BUF + (size_t)slot * DM);
        const u32x4 v0 = src[F.lane], v1 = src[64 + F.lane]; dst[F.lane] = v0; dst[64 + F.lane] = v1;
        if (F.lane == 0) { PS[pr] = slot; SG[slot] = PG[pr]; }
    }
    __syncthreads();
}
__device__ __forceinline__ void p_final(Frame& F, const Args& a) {
    const int gw = F.bid * NWAVES + F.wave, NGW = F.G * NWAVES;
    const float* XS = (const float*)(F.ws + WS_XS);
    const float* modp = (const float*)(F.ws + WS_MOD) + (size_t)(DEPTH - 1) * 9 * 6144;
    const int* PS = (const int*)(F.ws + WS_PS); const bf16* Y = (const bf16*)(F.ws + WS_Y);
    const float* g = a.in[I_FING];
    f32x4 gv[4];
#pragma unroll
    for (int j = 0; j < 4; ++j) gv[j] = *(const f32x4*)(g + 4 * F.lane + 256 * j);
    for (int row = gw; row < NLAT; row += NGW) {
        const int bi = row >> 12;
        const float* xr = XS + (size_t)row * DM;
        f32x4 v[4], s[4];
#pragma unroll
        for (int j = 0; j < 4; ++j) { v[j] = *(const f32x4*)(xr + 4 * F.lane + 256 * j); s[j] = (f32x4){0.f, 0.f, 0.f, 0.f}; }
#pragma unroll
        for (int k = 0; k < 4; ++k) { const int slot = PS[row * 4 + k]; const bf16* yr = Y + (size_t)slot * DM;
#pragma unroll
            for (int j = 0; j < 4; ++j) { const u32x2 w = *(const u32x2*)(yr + 4 * F.lane + 256 * j); s[j] += (f32x4){bflo(w.x), bfhi(w.x), bflo(w.y), bfhi(w.y)}; } }
        const float* m5 = modp + (size_t)bi * 6144 + 5 * 1024;
        float ss = 0.f;
#pragma unroll
        for (int j = 0; j < 4; ++j) { v[j] += *(const f32x4*)(m5 + 4 * F.lane + 256 * j) * s[j]; ss += v[j][0] * v[j][0] + v[j][1] * v[j][1] + v[j][2] * v[j][2] + v[j][3] * v[j][3]; }
        const float rs = rsqrtf(wave_sum(ss, F.lane) * (1.f / DM) + 1e-6f);
        float* orow = a.out + (size_t)row * DM;
#pragma unroll
        for (int j = 0; j < 4; ++j) *(f32x4*)(orow + 4 * F.lane + 256 * j) = v[j] * rs * gv[j];
    }
}

#define MFMA16(a, b, c) __builtin_amdgcn_mfma_f32_16x16x32_bf16((a), (b), (c), 0, 0, 0)
typedef short v4i16_t __attribute__((ext_vector_type(4)));
__device__ __forceinline__ s16x4 trread(const LAS void* p) { return __builtin_bit_cast(s16x4, __builtin_amdgcn_ds_read_tr16_b64_v4i16((LAS v4i16_t*)p)); }
__device__ __forceinline__ bf16x8 cat8(s16x4 a, s16x4 b) { return __builtin_shufflevector(a, b, 0, 1, 2, 3, 4, 5, 6, 7); }
__device__ __forceinline__ bf16x8 pack8(const float* v) { u32x4 w; w.x = pg8::cvt_pk_bf16(v[0], v[1]); w.y = pg8::cvt_pk_bf16(v[2], v[3]); w.z = pg8::cvt_pk_bf16(v[4], v[5]); w.w = pg8::cvt_pk_bf16(v[6], v[7]); return __builtin_bit_cast(bf16x8, w); }
__device__ __forceinline__ void unpack8(bf16x8 x, float* v) { const u32x4 w = __builtin_bit_cast(u32x4, x); v[0] = bflo(w.x); v[1] = bfhi(w.x); v[2] = bflo(w.y); v[3] = bfhi(w.y); v[4] = bflo(w.z); v[5] = bfhi(w.z); v[6] = bflo(w.w); v[7] = bfhi(w.w); }
#define OPQ(x) ({ int o_ = (x); asm volatile("" : "+s"(o_)); o_; })
#define LAUNDER_F(F0) Frame F = F0; { int t_ = threadIdx.x; asm volatile("" : "+v"(t_)); F.tid = t_; F.lane = t_ & 63; F.wave = __builtin_amdgcn_readfirstlane(t_ >> 6); }
__device__ __forceinline__ int chunk_tok0(int cid) { return cid < 512 ? cid * 64 : NLAT + (cid - 512) * 64; }

constexpr int GL_QS = 136, GL_VS = 264, GL_BS = 260;
constexpr int GL_Q = 0, GL_K = GL_Q + 64 * GL_QS * 2, GL_V = GL_K + 64 * GL_QS * 2, GL_A1 = GL_V + 64 * GL_VS * 2, GL_B = GL_A1 + 64 * 32 * 2, GL_END = GL_B + 64 * GL_BS * 4;
static_assert(GL_END <= MISC_OFF, "GLA LDS");
template <bool OUT> __device__ __forceinline__ void gla_chunk(Frame& F0, const Args& a, int L, int cid) {
    LAUNDER_F(F0)
    const int tok0 = chunk_tok0(cid);
    const bf16* P = (const bf16*)(F.ws + WS_PBUF) + (size_t)tok0 * PW;
    LAS bf16* sq = (LAS bf16*)(F.lds + GL_Q); LAS bf16* sk = (LAS bf16*)(F.lds + GL_K); LAS bf16* sv = (LAS bf16*)(F.lds + GL_V); LAS bf16* sa1 = (LAS bf16*)(F.lds + GL_A1); LAS float* sB = (LAS float*)(F.lds + GL_B);
    __syncthreads();
    for (int i = F.tid; i < 1024; i += NTHR) { const int t = i >> 4, pc = i & 15; *(LAS u32x4*)(sq + t * GL_QS + pc * 8) = *(const u32x4*)(P + (size_t)t * PW + PC_Q + pc * 8); *(LAS u32x4*)(sk + t * GL_QS + pc * 8) = *(const u32x4*)(P + (size_t)t * PW + PC_K + pc * 8); }
    for (int i = F.tid; i < 2048; i += NTHR) { const int t = i >> 5, pc = i & 31; *(LAS u32x4*)(sv + t * GL_VS + pc * 8) = *(const u32x4*)(P + (size_t)t * PW + PC_V + pc * 8); }
    if (F.tid < 256) { const int t = F.tid >> 2, pc = F.tid & 3; *(LAS u32x4*)(sa1 + t * 32 + pc * 8) = *(const u32x4*)(P + (size_t)t * PW + PC_A1 + pc * 8); }
    __syncthreads();
    {
        const int col = F.tid & 255, r = col >> 7, c = col & 127, th = F.tid >> 8;
        float a2v[16];
#pragma unroll
        for (int i = 0; i < 16; ++i) a2v[i] = a.in[I_GLAA2][((size_t)(L * 2 + r) * 16 + i) * 128 + c];
        const float ab = a.in[I_GLAAB][(L * 2 + r) * 128 + c];
        for (int i = 0; i < 32; ++i) { const int t = th * 32 + i; float z = ab; float av[8];
            unpack8(*(const LAS bf16x8*)(sa1 + t * 32 + r * 16), av);
#pragma unroll
            for (int q = 0; q < 8; ++q) z += av[q] * a2v[q];
            unpack8(*(const LAS bf16x8*)(sa1 + t * 32 + r * 16 + 8), av);
#pragma unroll
            for (int q = 0; q < 8; ++q) z += av[q] * a2v[8 + q];
            const float ls = fminf(z, 0.f) - __logf(1.f + __expf(-fabsf(z)));
            sB[t * GL_BS + col] = ls * (1.f / 16.f); }
    }
    __syncthreads();
    if (F.tid < 256) { const int col = F.tid, r = col >> 7; float b = 0.f;
        for (int i = 0; i < 64; ++i) { const int t = r ? 63 - i : i; b += sB[t * GL_BS + col]; sB[t * GL_BS + col] = b; } }
    __syncthreads();
    const int hh = F.wave & 3, r = F.wave >> 2, lr = F.lane & 15, g = F.lane >> 4;
    const int bc = r * 128 + hh * 32;
    const size_t ub = ((size_t)cid * 4 + hh) * 2 + r;
    if constexpr (!OUT) {
        const int tl = r ? 0 : 63;
        f32x4 acc[2][4];
#pragma unroll
        for (int mc = 0; mc < 2; ++mc)
#pragma unroll
            for (int d = 0; d < 4; ++d) acc[mc][d] = (f32x4){0.f, 0.f, 0.f, 0.f};
#pragma unroll
        for (int sg = 0; sg < 2; ++sg) {
            bf16x8 vf[4];
#pragma unroll
            for (int d = 0; d < 4; ++d) { const LAS bf16* p0 = sv + (32 * sg + 8 * g + ((F.lane & 15) >> 2)) * GL_VS + hh * 64 + 16 * d + 4 * (F.lane & 3); vf[d] = cat8(trread(p0), trread(p0 + 4 * GL_VS)); }
#pragma unroll
            for (int mc = 0; mc < 2; ++mc) {
                const LAS bf16* p0 = sk + (32 * sg + 8 * g + ((F.lane & 15) >> 2)) * GL_QS + hh * 32 + 16 * mc + 4 * (F.lane & 3);
                const s16x4 k0 = trread(p0), k1 = trread(p0 + 4 * GL_QS);
                const int c = 16 * mc + lr; const float bl = sB[tl * GL_BS + bc + c];
                float kv[8];
#pragma unroll
                for (int e = 0; e < 4; ++e) { kv[e] = bf2f((unsigned short)k0[e]) * __expf(bl - sB[(32 * sg + 8 * g + e) * GL_BS + bc + c]); kv[4 + e] = bf2f((unsigned short)k1[e]) * __expf(bl - sB[(32 * sg + 8 * g + 4 + e) * GL_BS + bc + c]); }
                const bf16x8 kf = pack8(kv);
#pragma unroll
                for (int d = 0; d < 4; ++d) acc[mc][d] = MFMA16(kf, vf[d], acc[mc][d]);
            }
        }
        float* ds = (float*)(F.ws + WS_GDS) + ub * 2048;
#pragma unroll
        for (int mc = 0; mc < 2; ++mc)
#pragma unroll
            for (int d = 0; d < 4; ++d) *(f32x4*)(ds + (16 * d + lr) * 32 + 16 * mc + 4 * g) = acc[mc][d];
        if (F.lane < 32) ((float*)(F.ws + WS_GDEC))[ub * 32 + F.lane] = __expf(sB[tl * GL_BS + bc + F.lane]);
    } else {
        bf16x8 qf[4], kf[4];
#pragma unroll
        for (int m = 0; m < 4; ++m) { const int t = 16 * m + lr; float qv[8], kv[8], bv[8];
            unpack8(*(const LAS bf16x8*)(sq + t * GL_QS + hh * 32 + 8 * g), qv); unpack8(*(const LAS bf16x8*)(sk + t * GL_QS + hh * 32 + 8 * g), kv);
            *(f32x4*)bv = *(const LAS f32x4*)(sB + t * GL_BS + bc + 8 * g); *(f32x4*)(bv + 4) = *(const LAS f32x4*)(sB + t * GL_BS + bc + 8 * g + 4);
#pragma unroll
            for (int e = 0; e < 8; ++e) { const float ex = __expf(bv[e]); qv[e] *= 0.17677669529663687f * ex; kv[e] *= __frcp_rn(ex); }
            qf[m] = pack8(qv); kf[m] = pack8(kv); }
        f32x4 o[4][4];
#pragma unroll
        for (int m = 0; m < 4; ++m)
#pragma unroll
            for (int d = 0; d < 4; ++d) o[m][d] = (f32x4){0.f, 0.f, 0.f, 0.f};
        {
            const bf16* se = (const bf16*)(F.ws + WS_GSE) + ub * 2048;
#pragma unroll
            for (int d = 0; d < 4; ++d) { const bf16x8 sf = *(const bf16x8*)(se + (16 * d + lr) * 32 + 8 * g);
#pragma unroll
                for (int m = 0; m < 4; ++m) o[m][d] = MFMA16(qf[m], sf, o[m][d]); }
        }
        bf16x8 vf[2][4];
#pragma unroll
        for (int sg = 0; sg < 2; ++sg)
#pragma unroll
            for (int d = 0; d < 4; ++d) { const LAS bf16* p0 = sv + (32 * sg + 4 * g + ((F.lane & 15) >> 2)) * GL_VS + hh * 64 + 16 * d + 4 * (F.lane & 3); vf[sg][d] = cat8(trread(p0), trread(p0 + 16 * GL_VS)); }
        const f32x4 zero4 = (f32x4){0.f, 0.f, 0.f, 0.f};
#pragma unroll
        for (int m = 0; m < 4; ++m) {
            const int t = 16 * m + lr;
#pragma unroll
            for (int sg = 0; sg < 2; ++sg) {
                f32x4 p0 = MFMA16(kf[2 * sg], qf[m], zero4), p1 = MFMA16(kf[2 * sg + 1], qf[m], zero4);
                float pv[8];
#pragma unroll
                for (int j = 0; j < 4; ++j) { const int s0 = 32 * sg + 4 * g + j, s1 = s0 + 16; pv[j] = (r ? s0 >= t : s0 <= t) ? p0[j] : 0.f; pv[4 + j] = (r ? s1 >= t : s1 <= t) ? p1[j] : 0.f; }
                const bf16x8 pf = pack8(pv);
#pragma unroll
                for (int d = 0; d < 4; ++d) o[m][d] = MFMA16(pf, vf[sg][d], o[m][d]);
            }
        }
        __syncthreads();
        LAS float* ox = (LAS float*)(F.lds + GL_B);
        LAS bf16* ot = (LAS bf16*)(F.lds + GL_Q);
        if (r == 1) {
#pragma unroll
            for (int m = 0; m < 4; ++m)
#pragma unroll
                for (int d = 0; d < 4; ++d)
#pragma unroll
                    for (int j = 0; j < 4; ++j) ox[(hh * 64 + 16 * m + 4 * g + j) * 65 + 16 * d + lr] = o[m][d][j];
        }
        __syncthreads();
        if (r == 0) {
            const float* ng = a.in[I_GLANG] + L * 64;
            float gn[4];
#pragma unroll
            for (int d = 0; d < 4; ++d) gn[d] = ng[16 * d + lr];
#pragma unroll
            for (int m = 0; m < 4; ++m)
#pragma unroll
                for (int j = 0; j < 4; ++j) {
                    const int t = 16 * m + 4 * g + j; float v[4], ss = 0.f;
#pragma unroll
                    for (int d = 0; d < 4; ++d) { v[d] = o[m][d][j] + ox[(hh * 64 + t) * 65 + 16 * d + lr]; ss += v[d] * v[d]; }
                    ss += swz_xor<1>(ss); ss += swz_xor<2>(ss); ss += swz_xor<4>(ss); ss += swz_xor<8>(ss);
                    const float rs = rsqrtf(ss * (1.f / 64.f) + 1e-6f);
#pragma unroll
                    for (int d = 0; d < 4; ++d) { const float rg = bf2f(P[(size_t)t * PW + PC_R + hh * 64 + 16 * d + lr]); ot[t * 264 + hh * 64 + 16 * d + lr] = (bf16)f2bf(v[d] * rs * gn[d] * siluf_(rg)); }
                    asm volatile("" ::: "memory");
                }
        }
        __syncthreads();
        bf16* MX = (bf16*)(F.ws + WS_MIX) + (size_t)tok0 * MW + 768;
        for (int i = F.tid; i < 2048; i += NTHR) { const int t = i >> 5, pc = i & 31; *(u32x4*)(MX + (size_t)t * MW + pc * 8) = *(const LAS u32x4*)(ot + t * 264 + pc * 8); }
    }
}

constexpr int SD_RS = 520;
constexpr int SD_RAW = 0, SD_XC = SD_RAW + 68 * SD_RS * 2, SD_DT = SD_XC + 64 * SD_RS * 2, SD_CUM = SD_DT + 64 * 8 * 4, SD_W = SD_CUM + 8 * 64 * 4, SD_END = SD_W + 8 * 64 * 4;
static_assert(SD_END <= MISC_OFF && 64 * 260 * 4 <= 68 * SD_RS * 2, "SSD LDS");
template <bool OUT> __device__ __forceinline__ void ssd_chunk(Frame& F0, const Args& a, int L, int cid) {
    LAUNDER_F(F0)
    const int tok0 = chunk_tok0(cid);
    const bf16* PB = (const bf16*)(F.ws + WS_PBUF);
    LAS bf16* raw = (LAS bf16*)(F.lds + SD_RAW); LAS bf16* xc = (LAS bf16*)(F.lds + SD_XC); LAS float* sdt = (LAS float*)(F.lds + SD_DT); LAS float* scum = (LAS float*)(F.lds + SD_CUM); LAS float* sw = (LAS float*)(F.lds + SD_W);
    __syncthreads();
    {
        const int isctx = cid >= 512, c4 = (cid - 512) & 3;
        for (int i = F.tid; i < 68 * 64; i += NTHR) { const int rr = i >> 6, pc = i & 63, t = rr - 2; u32x4 v = (u32x4){0u, 0u, 0u, 0u};
            bool ok = t >= 0 && t < 64; if (isctx) { const int tt = c4 * 64 + t; ok = tt >= 0 && tt < 256; }
            if (ok) v = *(const u32x4*)(PB + (size_t)(tok0 + t) * PW + PC_XBC + pc * 8);
            *(LAS u32x4*)(raw + rr * SD_RS + pc * 8) = v; }
        if (F.tid < 64) { float dv[8]; unpack8(*(const bf16x8*)(PB + (size_t)(tok0 + F.tid) * PW + PC_DT), dv);
#pragma unroll
            for (int q = 0; q < 8; ++q) { const float z = dv[q] + a.in[I_SSDDTB][L * 8 + q]; sdt[F.tid * 8 + q] = z > 20.f ? z : __logf(1.f + __expf(z)); } }
    }
    __syncthreads();
    {
        const int ch = F.tid; float w[5];
#pragma unroll
        for (int k = 0; k < 5; ++k) w[k] = a.in[I_SSDCW][((size_t)L * 5 + k) * 512 + ch];
        const float cb = a.in[I_SSDCB][L * 512 + ch];
        float x0 = bf2f(raw[0 * SD_RS + ch]), x1 = bf2f(raw[1 * SD_RS + ch]), x2 = bf2f(raw[2 * SD_RS + ch]), x3 = bf2f(raw[3 * SD_RS + ch]);
        for (int t = 0; t < 64; ++t) { const float x4 = bf2f(raw[(t + 4) * SD_RS + ch]); const float y = cb + w[0] * x0 + w[1] * x1 + w[2] * x2 + w[3] * x3 + w[4] * x4;
            xc[t * SD_RS + ch] = (bf16)f2bf(siluf_(y)); x0 = x1; x1 = x2; x2 = x3; x3 = x4; }
        if (F.tid < 8) { const int rr = F.tid >> 2; const float aa = -__expf(a.in[I_SSDALOG][L * 8 + F.tid]); float c = 0.f;
            for (int i = 0; i < 64; ++i) { const int t = rr ? 63 - i : i; c += sdt[t * 8 + F.tid] * aa; scum[F.tid * 64 + t] = c; }
            const float cl = c;
            for (int t = 0; t < 64; ++t) sw[F.tid * 64 + t] = __expf(cl - scum[F.tid * 64 + t]) * sdt[t * 8 + F.tid]; }
    }
    __syncthreads();
    const int h = F.wave & 3, r = F.wave >> 2, lr = F.lane & 15, g = F.lane >> 4, gp = h >> 1, rh = r * 4 + h;
    const size_t ub = ((size_t)cid * 4 + h) * 2 + r;
    if constexpr (!OUT) {
        f32x4 acc[4][4];
#pragma unroll
        for (int ms = 0; ms < 4; ++ms)
#pragma unroll
            for (int d = 0; d < 4; ++d) acc[ms][d] = (f32x4){0.f, 0.f, 0.f, 0.f};
#pragma unroll
        for (int sg = 0; sg < 2; ++sg) {
            const int trow = 32 * sg + 8 * g;
            bf16x8 xf[4];
#pragma unroll
            for (int d = 0; d < 4; ++d) { const LAS bf16* p0 = xc + (trow + ((F.lane & 15) >> 2)) * SD_RS + h * 64 + 16 * d + 4 * (F.lane & 3); xf[d] = cat8(trread(p0), trread(p0 + 4 * SD_RS)); }
            float wv[8];
            *(f32x4*)wv = *(const LAS f32x4*)(sw + rh * 64 + trow); *(f32x4*)(wv + 4) = *(const LAS f32x4*)(sw + rh * 64 + trow + 4);
#pragma unroll
            for (int ms = 0; ms < 4; ++ms) {
                const LAS bf16* p0 = xc + (trow + ((F.lane & 15) >> 2)) * SD_RS + 256 + gp * 64 + 16 * ms + 4 * (F.lane & 3);
                const s16x4 b0 = trread(p0), b1 = trread(p0 + 4 * SD_RS);
                float bv[8];
#pragma unroll
                for (int e = 0; e < 4; ++e) { bv[e] = bf2f((unsigned short)b0[e]) * wv[e]; bv[4 + e] = bf2f((unsigned short)b1[e]) * wv[4 + e]; }
                const bf16x8 bf = pack8(bv);
#pragma unroll
                for (int d = 0; d < 4; ++d) acc[ms][d] = MFMA16(bf, xf[d], acc[ms][d]);
            }
        }
        float* ds = (float*)(F.ws + WS_SDS) + ub * 4096;
#pragma unroll
        for (int ms = 0; ms < 4; ++ms)
#pragma unroll
            for (int d = 0; d < 4; ++d) *(f32x4*)(ds + (16 * d + lr) * 64 + 16 * ms + 4 * g) = acc[ms][d];
        if (F.lane == 0) ((float*)(F.ws + WS_SDEC))[ub] = __expf(scum[rh * 64 + (r ? 0 : 63)]);
    } else {
        bf16x8 bfr[4][2], cfr[4][2];
#pragma unroll
        for (int m = 0; m < 4; ++m)
#pragma unroll
            for (int ks = 0; ks < 2; ++ks) { bfr[m][ks] = *(const LAS bf16x8*)(xc + (16 * m + lr) * SD_RS + 256 + gp * 64 + 32 * ks + 8 * g); cfr[m][ks] = *(const LAS bf16x8*)(xc + (16 * m + lr) * SD_RS + 384 + gp * 64 + 32 * ks + 8 * g); }
        f32x4 y[4][4];
#pragma unroll
        for (int m = 0; m < 4; ++m)
#pragma unroll
            for (int d = 0; d < 4; ++d) y[m][d] = (f32x4){0.f, 0.f, 0.f, 0.f};
        {
            const bf16* se = (const bf16*)(F.ws + WS_SSE) + ub * 4096;
            bf16x8 cs[4][2];
#pragma unroll
            for (int m = 0; m < 4; ++m) { const float ec = __expf(scum[rh * 64 + 16 * m + lr]);
#pragma unroll
                for (int ks = 0; ks < 2; ++ks) { float cv[8]; unpack8(cfr[m][ks], cv);
#pragma unroll
                    for (int e = 0; e < 8; ++e) cv[e] *= ec;
                    cs[m][ks] = pack8(cv); } }
#pragma unroll
            for (int d = 0; d < 4; ++d) {
                const bf16x8 sf0 = *(const bf16x8*)(se + (16 * d + lr) * 64 + 8 * g), sf1 = *(const bf16x8*)(se + (16 * d + lr) * 64 + 32 + 8 * g);
#pragma unroll
                for (int m = 0; m < 4; ++m) { y[m][d] = MFMA16(cs[m][0], sf0, y[m][d]); y[m][d] = MFMA16(cs[m][1], sf1, y[m][d]); }
            }
        }
        asm volatile("" ::: "memory");
        bf16x8 xf[2][4];
#pragma unroll
        for (int sg = 0; sg < 2; ++sg)
#pragma unroll
            for (int d = 0; d < 4; ++d) { const LAS bf16* p0 = xc + (32 * sg + 4 * g + ((F.lane & 15) >> 2)) * SD_RS + h * 64 + 16 * d + 4 * (F.lane & 3); xf[sg][d] = cat8(trread(p0), trread(p0 + 16 * SD_RS)); }
        const f32x4 zero4 = (f32x4){0.f, 0.f, 0.f, 0.f};
#pragma unroll
        for (int m = 0; m < 4; ++m) {
            const int t = 16 * m + lr; const float ct = scum[rh * 64 + t];
#pragma unroll
            for (int sg = 0; sg < 2; ++sg) {
                f32x4 p0 = MFMA16(bfr[2 * sg][0], cfr[m][0], zero4), p1 = MFMA16(bfr[2 * sg + 1][0], cfr[m][0], zero4);
                p0 = MFMA16(bfr[2 * sg][1], cfr[m][1], p0); p1 = MFMA16(bfr[2 * sg + 1][1], cfr[m][1], p1);
                float pv[8];
#pragma unroll
                for (int j = 0; j < 4; ++j) { const int s0 = 32 * sg + 4 * g + j, s1 = s0 + 16;
                    pv[j] = (r ? s0 >= t : s0 <= t) ? p0[j] * __expf(ct - scum[rh * 64 + s0]) * sdt[s0 * 8 + rh] : 0.f;
                    pv[4 + j] = (r ? s1 >= t : s1 <= t) ? p1[j] * __expf(ct - scum[rh * 64 + s1]) * sdt[s1 * 8 + rh] : 0.f; }
                const bf16x8 pf = pack8(pv);
#pragma unroll
                for (int d = 0; d < 4; ++d) y[m][d] = MFMA16(pf, xf[sg][d], y[m][d]);
            }
        }
        __syncthreads();
        LAS float* yx = (LAS float*)(F.lds + SD_RAW);
        if (r == 1) {
#pragma unroll
            for (int m = 0; m < 4; ++m)
#pragma unroll
                for (int d = 0; d < 4; ++d)
#pragma unroll
                    for (int j = 0; j < 4; ++j) yx[(16 * m + 4 * g + j) * 260 + h * 64 + 16 * d + lr] = y[m][d][j];
        }
        __syncthreads();
        if (r == 0) { const float dsk = a.in[I_SSDD][L * 4 + h];
#pragma unroll
            for (int m = 0; m < 4; ++m)
#pragma unroll
                for (int d = 0; d < 4; ++d)
#pragma unroll
                    for (int j = 0; j < 4; ++j) { const int t = 16 * m + 4 * g + j, c = h * 64 + 16 * d + lr; yx[t * 260 + c] += y[m][d][j] + dsk * bf2f(xc[t * SD_RS + c]); asm volatile("" ::: "memory"); }
        }
        __syncthreads();
        { const int t = F.tid >> 3, c0 = (F.tid & 7) * 32; const bf16* zr = PB + (size_t)(tok0 + t) * PW + PC_Z + c0; const float* ng = a.in[I_SSDNG] + L * 256 + c0;
          float v[32]; float ss = 0.f;
#pragma unroll
          for (int q = 0; q < 4; ++q) { float zv[8]; unpack8(*(const bf16x8*)(zr + 8 * q), zv);
#pragma unroll
              for (int e = 0; e < 8; ++e) { const float u = yx[t * 260 + c0 + 8 * q + e] * siluf_(zv[e]); v[8 * q + e] = u; ss += u * u; } }
          ss += swz_xor<1>(ss); ss += swz_xor<2>(ss); ss += swz_xor<4>(ss);
          const float rs = rsqrtf(ss * (1.f / 256.f) + 1e-6f);
          bf16* MX = (bf16*)(F.ws + WS_MIX) + (size_t)(tok0 + t) * MW + 1024 + c0;
#pragma unroll
          for (int q = 0; q < 4; ++q) { float o8[8];
#pragma unroll
              for (int e = 0; e < 8; ++e) o8[e] = v[8 * q + e] * rs * ng[8 * q + e];
              *(bf16x8*)(MX + 8 * q) = pack8(o8); } }
    }
}

constexpr int FF_XP = 0, FF_TR = FF_XP + 16 * 64 * 16 * 2, FF_TI = FF_TR + 16 * 64 * 16 * 2, FF_END = FF_TI + 16 * 64 * 16 * 2;
__device__ __forceinline__ void fft_unit(Frame& F0, int u) {
    LAUNDER_F(F0)
    const int b = u >> 6, cg = (u >> 2) & 15, kb = u & 3, lr = F.lane & 15, g = F.lane >> 4;
    const bf16* PB = (const bf16*)(F.ws + WS_PBUF) + (size_t)b * SEQ * PW + PC_FU + 16 * cg;
    const bf16* f64 = (const bf16*)(F.ws + WS_TAB + TAB_F64); const float* tw = (const float*)(F.ws + WS_TAB + TAB_TW);
    LAS bf16* xp = (LAS bf16*)(F.lds + FF_XP); LAS bf16* tr = (LAS bf16*)(F.lds + FF_TR); LAS bf16* ti = (LAS bf16*)(F.lds + FF_TI);
    bf16x8 fc1[2], fs1[2];
#pragma unroll
    for (int ks = 0; ks < 2; ++ks) { fc1[ks] = *(const bf16x8*)(f64 + (16 * kb + lr) * 64 + 32 * ks + 8 * g); fs1[ks] = *(const bf16x8*)(f64 + 4096 + (16 * kb + lr) * 64 + 32 * ks + 8 * g); }
    const f32x4 zero4 = (f32x4){0.f, 0.f, 0.f, 0.f};
    for (int pa = 0; pa < 4; ++pa) {
        __syncthreads();
        for (int i = F.tid; i < 2048; i += NTHR) { const int n2l = i >> 7, n1 = (i >> 1) & 63, hf = i & 1;
            *(LAS u32x4*)(xp + (n2l * 64 + n1) * 16 + hf * 8) = *(const u32x4*)(PB + (size_t)(64 * n1 + 16 * pa + n2l) * PW + hf * 8); }
        __syncthreads();
#pragma unroll
        for (int q = 0; q < 2; ++q) {
            const int n2l = 2 * F.wave + q, n2 = 16 * pa + n2l;
            f32x4 tc = zero4, ts = zero4;
#pragma unroll
            for (int ks = 0; ks < 2; ++ks) { const LAS bf16* p0 = xp + (n2l * 64 + 32 * ks + 8 * g + ((F.lane & 15) >> 2)) * 16 + 4 * (F.lane & 3); const bf16x8 xb = cat8(trread(p0), trread(p0 + 4 * 16));
                tc = MFMA16(fc1[ks], xb, tc); ts = MFMA16(fs1[ks], xb, ts); }
#pragma unroll
            for (int j = 0; j < 4; ++j) { const int k1l = 4 * g + j, k1 = 16 * kb + k1l; const f32x2 w = *(const f32x2*)(tw + 2 * (n2 * k1));
                tr[(k1l * 64 + n2) * 16 + lr] = (bf16)f2bf(tc[j] * w[0] - ts[j] * w[1]); ti[(k1l * 64 + n2) * 16 + lr] = (bf16)f2bf(-(tc[j] * w[1] + ts[j] * w[0])); }
        }
    }
    __syncthreads();
    bf16* MX = (bf16*)(F.ws + WS_MIX) + (size_t)b * SEQ * MW + 16 * cg + lr;
#pragma unroll
    for (int q = 0; q < 2; ++q) {
        const int k1l = 2 * F.wave + q, k1 = 16 * kb + k1l;
        bf16x8 br[2], bi[2];
#pragma unroll
        for (int ks = 0; ks < 2; ++ks) { const int off = (k1l * 64 + 32 * ks + 8 * g + ((F.lane & 15) >> 2)) * 16 + 4 * (F.lane & 3); br[ks] = cat8(trread(tr + off), trread(tr + off + 64)); bi[ks] = cat8(trread(ti + off), trread(ti + off + 64)); }
#pragma unroll
        for (int m = 0; m < 4; ++m) {
            f32x4 yr = zero4, y1 = zero4, y2 = zero4;
#pragma unroll
            for (int ks = 0; ks < 2; ++ks) { const bf16x8 fc = *(const bf16x8*)(f64 + (16 * m + lr) * 64 + 32 * ks + 8 * g), fs = *(const bf16x8*)(f64 + 4096 + (16 * m + lr) * 64 + 32 * ks + 8 * g);
                yr = MFMA16(fc, br[ks], yr); yr = MFMA16(fs, bi[ks], yr); y1 = MFMA16(fc, bi[ks], y1); y2 = MFMA16(fs, br[ks], y2); }
#pragma unroll
            for (int j = 0; j < 4; ++j) { const int k2 = 16 * m + 4 * g + j; bf16* o = MX + (size_t)(64 * k2 + k1) * MW; o[0] = (bf16)f2bf(yr[j] * (1.f / 64.f)); o[256] = (bf16)f2bf((y1[j] - y2[j]) * (1.f / 64.f)); }
        }
    }
}
__device__ __forceinline__ void dft_ctx_unit(Frame& F0, int u) {
    LAUNDER_F(F0)
    const int b = u >> 3, kblk = u & 7;
    LAS float* tab = (LAS float*)F.lds;
    __syncthreads();
    if (F.tid < 256) { const f32x2 v = *(const f32x2*)((const float*)(F.ws + WS_TAB + TAB_D256) + 2 * F.tid); tab[2 * F.tid] = v[0]; tab[2 * F.tid + 1] = v[1]; }
    __syncthreads();
    const int c = F.tid & 255, k0 = kblk * 32 + (F.tid >> 8) * 16;
    const bf16* PB = (const bf16*)(F.ws + WS_PBUF) + (size_t)(NLAT + b * CTXL) * PW + PC_FU + c;
    float ar[16], ai[16];
#pragma unroll
    for (int i = 0; i < 16; ++i) { ar[i] = 0.f; ai[i] = 0.f; }
    for (int n = 0; n < 256; ++n) { const float uv = bf2f(PB[(size_t)n * PW]);
#pragma unroll
        for (int i = 0; i < 16; ++i) { const int m = ((k0 + i) * n) & 255; ar[i] += uv * tab[2 * m]; ai[i] -= uv * tab[2 * m + 1]; } }
    bf16* MX = (bf16*)(F.ws + WS_MIX) + (size_t)(NLAT + b * CTXL + k0) * MW + c;
#pragma unroll
    for (int i = 0; i < 16; ++i) { MX[(size_t)i * MW] = (bf16)f2bf(ar[i] * (1.f / 16.f)); MX[(size_t)i * MW + 256] = (bf16)f2bf(ai[i] * (1.f / 16.f)); }
}

__device__ __forceinline__ void p_mix_a(Frame& F, const Args& a, int L) {
    {
        pg8::Gemm g{(const bf16*)(F.ws + WS_A2), (const bf16*)(F.ws + WS_S5P) + (size_t)L * 16 * 256 * 256, 512, 256, OPQ(256)};
        SgOrder<FillS5> S; S.init(144, 1, F.G, F.bid); S.f = FillS5{(size_t)256 * 256 * 2};
        EpiS5S E{(float*)(F.ws + WS_S5S)};
        pg8::gemm_phase(F.lds, g, S, E);
    }
    for (int u = F.bid; u < NCHK; u += F.G) gla_chunk<false>(F, a, L, u);
    for (int u = (F.bid + 32) % F.G; u < NCHK; u += F.G) ssd_chunk<false>(F, a, L, u);
    __syncthreads();
}
__device__ __forceinline__ void p_mix_b(Frame& F, const Args& a, int L) {
    { const int wu = F.wave * F.G + F.bid;
      if (wu < 256) { const int b = wu >> 5, g = (wu >> 1) & 15, r = wu & 1;
          const f32x2 a16 = *(const f32x2*)((const float*)(F.ws + WS_A16) + ((size_t)((L * 2 + r) * 16 + g) * 64 + F.lane) * 2);
          const float* S = (const float*)(F.ws + WS_S5S) + (size_t)g * S5ROWS * 256 + r * 128 + F.lane; bf16* A2 = (bf16*)(F.ws + WS_A2) + (size_t)g * S5ROWS * 512 + 256 + r * 128 + F.lane;
          float hr = 0.f, hi = 0.f;
#pragma unroll 4
          for (int i = 0; i < 272; ++i) { const int row = i < 16 ? 2048 + 16 * b + (r ? 15 - i : i) : 256 * b + (r ? 271 - i : i - 16);
              const float sr = S[(size_t)row * 256], si = S[(size_t)row * 256 + 64];
              A2[(size_t)row * 512] = (bf16)f2bf(hr); A2[(size_t)row * 512 + 64] = (bf16)f2bf(hi);
              const float nr = a16[0] * hr - a16[1] * hi + sr, ni = a16[0] * hi + a16[1] * hr + si; hr = nr; hi = ni; } } }
    for (int u = F.bid; u < 256; u += F.G) { const int sq = u >> 2, b = sq >> 3, hh = (sq >> 1) & 3, r = sq & 1, e = (u & 3) * 512 + F.tid, c = e & 31;
        const float* ds = (const float*)(F.ws + WS_GDS); const float* dc = (const float*)(F.ws + WS_GDEC); bf16* se = (bf16*)(F.ws + WS_GSE);
        float s = 0.f;
#pragma unroll 4
        for (int i = 0; i < 68; ++i) { const int cid = i < 4 ? 512 + b * 4 + (r ? 3 - i : i) : b * 64 + (r ? 67 - i : i - 4); const size_t ub = ((size_t)cid * 4 + hh) * 2 + r;
            se[ub * 2048 + e] = (bf16)f2bf(s); s = dc[ub * 32 + c] * s + ds[ub * 2048 + e]; } }
    for (int u = F.bid; u < 512; u += F.G) { const int sq = u >> 3, b = sq >> 3, h = (sq >> 1) & 3, r = sq & 1, e = (u & 7) * 512 + F.tid;
        const float* ds = (const float*)(F.ws + WS_SDS); const float* dc = (const float*)(F.ws + WS_SDEC); bf16* se = (bf16*)(F.ws + WS_SSE);
        float s = 0.f;
#pragma unroll 4
        for (int i = 0; i < 68; ++i) { const int cid = i < 4 ? 512 + b * 4 + (r ? 3 - i : i) : b * 64 + (r ? 67 - i : i - 4); const size_t ub = ((size_t)cid * 4 + h) * 2 + r;
            se[ub * 4096 + e] = (bf16)f2bf(s); s = dc[ub] * s + ds[ub * 4096 + e]; } }
    for (int u = F.bid; u < 512; u += F.G) fft_unit(F, u);
    for (int u = (F.bid + 64) % F.G; u < 64; u += F.G) dft_ctx_unit(F, u);
    __syncthreads();
}
__device__ __forceinline__ void p_mix_c(Frame& F, const Args& a, int L) {
#ifndef MIXC_PARTS
#define MIXC_PARTS 7
#endif
    if (MIXC_PARTS & 1) {
        pg8::Gemm g{(const bf16*)(F.ws + WS_A2), (const bf16*)(F.ws + WS_S5B2) + (size_t)L * 16 * 256 * 512, 512, 512, OPQ(512)};
        SgOrder<FillS5> S; S.init(144, 1, F.G, F.bid); S.f = FillS5{(size_t)256 * 512 * 2};
        EpiS5Y E{(bf16*)(F.ws + WS_ACT5)};
        pg8::gemm_phase(F.lds, g, S, E);
    }
    const int nch = (L == DEPTH - 1) ? 512 : NCHK;
    if (MIXC_PARTS & 2) for (int u = F.bid; u < nch; u += F.G) gla_chunk<true>(F, a, L, u);
    if (MIXC_PARTS & 4) for (int u = (F.bid + 32) % F.G; u < nch; u += F.G) ssd_chunk<true>(F, a, L, u);
    __syncthreads();
}

constexpr int NPH = 11, PH_TOTAL = 2 + DEPTH * NPH;
#ifndef PHASE_MASK
#define PHASE_MASK 0xFFFF
#endif
#define PM(i) ((PHASE_MASK >> (i)) & 1)
#ifndef MK_ONE_LAUNCH
#define MK_ONE_LAUNCH 0
#endif

__global__ void __launch_bounds__(NTHR, 2) mk_fwd(Args args) {
    extern __shared__ __attribute__((aligned(16))) unsigned char lds_raw[];
    Frame F;
    F.lds = (LAS unsigned char*)lds_raw; F.MISC = (volatile LAS unsigned*)(F.lds + MISC_OFF);
    F.tid = threadIdx.x; F.lane = F.tid & 63; F.wave = __builtin_amdgcn_readfirstlane(F.tid >> 6); F.G = gridDim.x; F.bid = blockIdx.x;
    F.ws = args.ws; F.ctl = (unsigned*)(args.ws + WS_CTL);
    if (F.tid < 64) F.MISC[F.tid] = 0u;
    __syncthreads();
#if MK_ONE_LAUNCH
    XcdBarrier bar = xcd_barrier_post(F.ctl + CW_BAR, F.MISC + 8);
#define GRID_BAR() xcd_barrier(bar)
#else
#define GRID_BAR() do { } while (0)
#endif
    const int lo = args.ph_lo, hi = args.ph_hi;
#define IN(k) (lo <= (k) && (k) < hi)
#define FRESH() do { int t_ = threadIdx.x; asm volatile("" : "+v"(t_)); F.tid = t_; F.lane = t_ & 63; F.wave = __builtin_amdgcn_readfirstlane(t_ >> 6); } while (0)
#define SEAM(k) do { if (IN(k) && IN((k) + 1)) GRID_BAR(); } while (0)
    if (PM(0) && IN(0)) { FRESH(); p_prologue(F, args); } SEAM(0);
    for (int L = 0; L < DEPTH; ++L) {
        const int pb = 1 + L * NPH;
        const int mrows = (L == DEPTH - 1) ? NLAT : NT;
        if (PM(1) && IN(pb + 0)) { FRESH(); p_norm1(F, args, OPQ(L)); } SEAM(pb + 0);
        if (PM(2) && IN(pb + 1)) { const int Lg = OPQ(L);
            pg8::Gemm g{(const bf16*)(F.ws + WS_H), (const bf16*)(F.ws + WS_WIN) + (size_t)Lg * PW * DM, DM, DM, OPQ(DM)};
            SgOrder<FillPlain> S; S.init(NT / 256, PW / 256, F.G, F.bid); S.f = FillPlain{(size_t)256 * DM * 2, (size_t)256 * DM * 2};
            EpiInproj E{(bf16*)(F.ws + WS_PBUF), (bf16*)(F.ws + WS_A2)};
            pg8::gemm_phase(F.lds, g, S, E);
        } SEAM(pb + 1);
#ifndef ABL_NO_MIXERS
        if (PM(3) && IN(pb + 2)) { FRESH(); p_mix_a(F, args, OPQ(L)); } SEAM(pb + 2);
        if (PM(4) && IN(pb + 3)) { FRESH(); p_mix_b(F, args, OPQ(L)); } SEAM(pb + 3);
        if (PM(5) && IN(pb + 4)) { FRESH(); p_mix_c(F, args, OPQ(L)); } SEAM(pb + 4);
        if (PM(6) && IN(pb + 5)) { const int Lg = OPQ(L);
            pg8::Gemm g{(const bf16*)(F.ws + WS_ACT5), (const bf16*)(F.ws + WS_WGLU) + (size_t)Lg * 256 * 256, 256, 256, OPQ(256)};
            SgOrder<FillPlain> S; S.init(NT / 256, 1, F.G, F.bid); S.f = FillPlain{(size_t)256 * 256 * 2, 0};
            EpiGlu E{(const bf16*)(F.ws + WS_ACT5), (bf16*)(F.ws + WS_MIX)};
            pg8::gemm_phase(F.lds, g, S, E);
        } SEAM(pb + 5);
        if (PM(7) && IN(pb + 6)) { const int Lg = OPQ(L);
            pg8::Gemm g{(const bf16*)(F.ws + WS_MIX), (const bf16*)(F.ws + WS_WOUT) + (size_t)Lg * DM * MW, MW, MW, OPQ(MW)};
            SgOrder<FillPlain> S; S.init((Lg == DEPTH - 1 ? NLAT : NT) / 256, DM / 256, F.G, F.bid); S.f = FillPlain{(size_t)256 * MW * 2, (size_t)256 * MW * 2};
            EpiOutproj E{args.in[I_X], args.in[I_CTX], (float*)(F.ws + WS_XS), (const float*)(F.ws + WS_MOD) + (size_t)Lg * 9 * 6144, Lg == 0 ? 1 : 0};
            pg8::gemm_phase(F.lds, g, S, E);
        } SEAM(pb + 6);
#else
        if (IN(pb + 6) && L == 0) {
            const int gw = F.bid * NWAVES + F.wave, NGW = F.G * NWAVES; float* XS = (float*)(F.ws + WS_XS);
            for (int row = gw; row < NT; row += NGW) { const float* src = row < NLAT ? args.in[I_X] + (size_t)row * DM : args.in[I_CTX] + (size_t)(row - NLAT) * DM;
                for (int j = 0; j < 4; ++j) *(f32x4*)(XS + (size_t)row * DM + 4 * F.lane + 256 * j) = *(const f32x4*)(src + 4 * F.lane + 256 * j); }
        } SEAM(pb + 6);
#endif
        if (PM(8) && IN(pb + 7)) { FRESH(); p_norm2(F, args, OPQ(L), OPQ(mrows)); } SEAM(pb + 7);
        if (PM(9) && IN(pb + 8)) { FRESH(); p_dispatch(F, OPQ(L), OPQ(mrows)); } SEAM(pb + 8);
        if (PM(10) && IN(pb + 9)) { const int Lg = OPQ(L);
            const unsigned* blke = F.ctl + CW_BLKE + Lg * 1024; const int nblk = (int)__hip_atomic_load(blke, RLX_AGENT);
            pg8::Gemm g{(const bf16*)(F.ws + WS_BUF), (const bf16*)(F.ws + WS_WGU) + (size_t)Lg * NEXP * 2048 * DM, DM, DM, OPQ(DM)};
            SgOrder<FillMoe> S; S.init(nblk, 8, F.G, F.bid); S.f = FillMoe{blke, 2048};
            EpiSwiglu E{(bf16*)(F.ws + WS_ACT), args.in[I_BGU] + (size_t)Lg * NEXP * 2048};
            pg8::gemm_phase(F.lds, g, S, E);
        } SEAM(pb + 9);
        if (PM(11) && IN(pb + 10)) { const int Lg = OPQ(L);
            const unsigned* blke = F.ctl + CW_BLKE + Lg * 1024; const int nblk = (int)__hip_atomic_load(blke, RLX_AGENT);
            pg8::Gemm g{(const bf16*)(F.ws + WS_ACT), (const bf16*)(F.ws + WS_WDN) + (size_t)Lg * NEXP * DM * DM, DM, DM, OPQ(DM)};
            SgOrder<FillMoe> S; S.init(nblk, 4, F.G, F.bid); S.f = FillMoe{blke, 1024};
            EpiDown E{(bf16*)(F.ws + WS_Y), args.in[I_BDN] + (size_t)Lg * NEXP * DM, (const float*)(F.ws + WS_SG)};
            pg8::gemm_phase(F.lds, g, S, E);
        } SEAM(pb + 10);
    }
    if (PM(12) && IN(PH_TOTAL - 1)) { FRESH(); p_final(F, args); }
#undef IN
#undef SEAM
}

extern "C" void kernel_launch(void* const* d_in, const int* in_sizes, int n_in, void* d_out, int out_size, void* d_ws, size_t ws_size, hipStream_t stream) {
    static int grid = 0;
    if (grid == 0) {
        if (n_in != N_IN || out_size != NLAT * DM || ws_size < WS_END) { fprintf(stderr, "kernel_launch: unexpected shapes (n_in %d, out %d, ws %zu < %zu); nothing launched\n", n_in, out_size, ws_size, (size_t)WS_END); grid = -1; return; }
        int dev = 0, cus = 0, per_cu = 0;
        if (hipGetDevice(&dev) != hipSuccess || hipDeviceGetAttribute(&cus, hipDeviceAttributeMultiprocessorCount, dev) != hipSuccess) { grid = -1; return; }
        if (hipFuncSetAttribute((const void*)mk_fwd, hipFuncAttributeMaxDynamicSharedMemorySize, LDS_BYTES) != hipSuccess) { fprintf(stderr, "kernel_launch: hipFuncSetAttribute failed\n"); grid = -1; return; }
        if (hipOccupancyMaxActiveBlocksPerMultiprocessor(&per_cu, (const void*)mk_fwd, NTHR, LDS_BYTES) != hipSuccess || per_cu < 1) fprintf(stderr, "kernel_launch: occupancy query says %d\n", per_cu);
        (void)hipGetLastError();
        grid = cus;
    }
    if (grid < 0) return;
    (void)hipMemsetAsync((char*)d_ws + WS_CTL, 0, CTL_BYTES, stream);
    Args a{};
    for (int i = 0; i < N_IN; ++i) a.in[i] = (const float*)d_in[i];
    a.out = (float*)d_out; a.ws = (unsigned char*)d_ws;
#if MK_ONE_LAUNCH
    a.ph_lo = 0; a.ph_hi = PH_TOTAL;
    hipLaunchKernelGGL(mk_fwd, dim3(grid), dim3(NTHR), LDS_BYTES, stream, a);
#else
    for (int p = 0; p < PH_TOTAL; ++p) { a.ph_lo = p; a.ph_hi = p + 1; hipLaunchKernelGGL(mk_fwd, dim3(grid), dim3(NTHR), LDS_BYTES, stream, a); }
#endif
}
```

```cpp
#define MK_ONE_LAUNCH 1
#include <hip/hip_runtime.h>
#include <cstdio>
#include <cstdint>

#define GAS __attribute__((address_space(1)))
#define LAS __attribute__((address_space(3)))
typedef unsigned short bf16;
typedef short bf16x8 __attribute__((ext_vector_type(8)));
typedef short s16x4 __attribute__((ext_vector_type(4)));
typedef float f32x4 __attribute__((ext_vector_type(4)));
typedef float f32x2 __attribute__((ext_vector_type(2)));
typedef unsigned u32x4 __attribute__((ext_vector_type(4)));
typedef unsigned u32x2 __attribute__((ext_vector_type(2)));

namespace pg8 {
#define PG8_LAS __attribute__((address_space(3)))
typedef unsigned short bf16_t;
constexpr int BM = 256, BK = 64, HALF = 128, HTB = HALF * BK * 2  , STAGE_BYTES = 8 * HTB;

__host__ __device__ __forceinline__ int lds_byte(int r, int c) { const int st = (r >> 4) * 2 + (c >> 5), rr = r & 15, cc = c & 31, ob = rr * 64 + cc * 2; return st * 1024 + (ob ^ (((ob >> 9) & 1) << 5)); }
__host__ __device__ __forceinline__ void stage_rc(int b, int& R, int& C) { const int st = b / 1024, sb = b % 1024, swz = sb ^ (((sb >> 9) & 1) << 5); R = (st >> 1) * 16 + swz / 64; C = (st & 1) * 32 + (swz % 64) / 2; }
__host__ __device__ __forceinline__ int perm32(int rho) { const int n = rho >> 4, i = rho & 15; return 8 * (i >> 2) + 4 * n + (i & 3); }

struct Unit { int pm, pn, grp; size_t aoff, boff; };
struct Gemm { const bf16_t* A; const bf16_t* Bt; int lda, ldb, K; };

__device__ __forceinline__ unsigned cvt_pk_bf16(float lo, float hi) { unsigned r; asm volatile("v_cvt_pk_bf16_f32 %0, %1, %2" : "=v"(r) : "v"(lo), "v"(hi)); return r; }

template <class Epi, class Sched, bool ALIGN_EPI = true, bool SP2 = true>
__device__ __forceinline__ void gemm_phase(PG8_LAS unsigned char* lds, const Gemm g, const Sched& S, const Epi& E) {
    int tid = threadIdx.x; asm volatile("" : "+v"(tid));
    const int wid = __builtin_amdgcn_readfirstlane(tid >> 6), lane = tid & 63, wr = wid >> 2, wc = wid & 3, fr = lane & 15, fq = lane >> 4;
    const int K = g.K, nt = K / BK;
    unsigned voffA[2], voffB[2];
#pragma unroll
    for (int i = 0; i < 2; ++i) { int R, C; stage_rc(tid * 16 + i * 8192, R, C); const int Rb = Epi::PERM ? ((R & ~31) + perm32(R & 31)) : R;
        voffA[i] = (unsigned)(R * g.lda + C) * 2u; voffB[i] = (unsigned)(Rb * g.ldb + C) * 2u; }
    const size_t kstep = (size_t)(BK * 2);
    const size_t hstepA = (size_t)HALF * g.lda * 2, hstepB = (size_t)HALF * g.ldb * 2;
    const unsigned ldsw = (unsigned)wid * 1024u;
    const int aoff = lds_byte(wr * 64 + fr, fq * 8), boff = lds_byte(wc * 32 + fr, fq * 8);
#define PG8_SA(b, h) (((b) * 2 + (h)) * HTB)
#define PG8_SB(b, h) ((4 + (b) * 2 + (h)) * HTB)
#define PG8_STAGE(bufoff, gbase, voff) do { _Pragma("unroll") for (int _i = 0; _i < 2; ++_i) \
        __builtin_amdgcn_global_load_lds((const unsigned*)((const char*)(gbase) + (voff)[_i]), (PG8_LAS unsigned*)(lds + (bufoff) + ldsw + _i * 8192), 16, 0, 0); } while (0)
#define PG8_LDA(dst, b, h) do { _Pragma("unroll") for (int m = 0; m < 4; ++m) _Pragma("unroll") for (int k = 0; k < 2; ++k) dst[m][k] = *(const PG8_LAS bf16x8*)(lds + PG8_SA(b, h) + aoff + m * 2048 + k * 1024); } while (0)
#define PG8_LDB(dst, b, h) do { _Pragma("unroll") for (int n = 0; n < 2; ++n) _Pragma("unroll") for (int k = 0; k < 2; ++k) dst[n][k] = *(const PG8_LAS bf16x8*)(lds + PG8_SB(b, h) + boff + n * 2048 + k * 1024); } while (0)
#define PG8_MMA(ai, bj, At, Bt) do { __builtin_amdgcn_s_setprio(1); _Pragma("unroll") for (int m = 0; m < 4; ++m) _Pragma("unroll") for (int n = 0; n < 2; ++n) _Pragma("unroll") for (int k = 0; k < 2; ++k) \
        acc[ai][bj][m][n] = __builtin_amdgcn_mfma_f32_16x16x32_bf16(Bt[n][k], At[m][k], acc[ai][bj][m][n], 0, 0, 0); __builtin_amdgcn_s_setprio(0); } while (0)
#define PG8_WAIT_V(n) asm volatile("s_waitcnt vmcnt(" #n ")" ::: "memory")
#define PG8_WAIT_L(n) asm volatile("s_waitcnt lgkmcnt(" #n ")" ::: "memory")
#define PG8_BAR __builtin_amdgcn_s_barrier()
#define PG8_SCHED __builtin_amdgcn_sched_barrier(0)
    Unit cur, nxt; int cursor = 0;
    if (!S.next(cursor, cur)) return;
    f32x4 acc[2][2][4][2];
#pragma unroll
    for (int a = 0; a < 2; ++a)
#pragma unroll
        for (int b = 0; b < 2; ++b)
#pragma unroll
            for (int m = 0; m < 4; ++m)
#pragma unroll
                for (int n = 0; n < 2; ++n) acc[a][b][m][n] = (f32x4){0.f, 0.f, 0.f, 0.f};
    bf16x8 At[4][2], B0[2][2], B1[2][2];
    const char* cA = (const char*)g.A + cur.aoff; const char* cB = (const char*)g.Bt + cur.boff;
    if constexpr (SP2) {
        PG8_STAGE(PG8_SB(0, 0), cB, voffB); PG8_STAGE(PG8_SB(0, 1), cB + hstepB, voffB); PG8_STAGE(PG8_SA(0, 0), cA, voffA); PG8_STAGE(PG8_SA(0, 1), cA + hstepA, voffA);
        if (wr == 1) PG8_BAR;
        PG8_WAIT_V(2); PG8_BAR;
        PG8_STAGE(PG8_SB(1, 0), cB + kstep, voffB); PG8_STAGE(PG8_SA(1, 0), cA + kstep, voffA); PG8_STAGE(PG8_SB(1, 1), cB + hstepB + kstep, voffB);
        PG8_WAIT_V(6); PG8_BAR;
    } else {
        PG8_STAGE(PG8_SB(0, 0), cB, voffB); PG8_STAGE(PG8_SA(0, 0), cA, voffA); PG8_STAGE(PG8_SB(0, 1), cB + hstepB, voffB); PG8_STAGE(PG8_SA(0, 1), cA + hstepA, voffA);
        if (wr == 1) PG8_BAR;
        PG8_WAIT_V(4); PG8_BAR;
        PG8_STAGE(PG8_SB(1, 0), cB + kstep, voffB); PG8_STAGE(PG8_SA(1, 0), cA + kstep, voffA); PG8_STAGE(PG8_SB(1, 1), cB + hstepB + kstep, voffB);
        PG8_WAIT_V(6); PG8_BAR;
    }
    for (;;) {
        const bool has_next = S.next(cursor, nxt);
        const char* nA = has_next ? (const char*)g.A + nxt.aoff : cA; const char* nB = has_next ? (const char*)g.Bt + nxt.boff : cB;
        for (int t = 0; t < nt; t += 2) {
            const bool last = (t == nt - 2);
            const char* a1 = cA + (size_t)(t + 1) * kstep;
            const char* a2 = last ? nA : cA + (size_t)(t + 2) * kstep; const char* b2 = last ? nB : cB + (size_t)(t + 2) * kstep;
            const char* a3 = a2 + kstep; const char* b3 = b2 + kstep;
            if constexpr (SP2) {
            PG8_LDB(B0, 0, 0); PG8_LDB(B1, 0, 1); PG8_SCHED; PG8_LDA(At, 0, 0); PG8_STAGE(PG8_SA(1, 1), a1 + hstepA, voffA);
            PG8_WAIT_V(8); PG8_WAIT_L(0); PG8_BAR; PG8_MMA(0, 0, At, B0); PG8_MMA(0, 1, At, B1); PG8_BAR; PG8_SCHED;
            PG8_LDA(At, 0, 1); PG8_STAGE(PG8_SB(0, 0), b2, voffB); PG8_STAGE(PG8_SB(0, 1), b2 + hstepB, voffB); PG8_STAGE(PG8_SA(0, 0), a2, voffA);
            PG8_WAIT_V(8); PG8_WAIT_L(0); PG8_BAR; PG8_MMA(1, 0, At, B0); PG8_MMA(1, 1, At, B1); PG8_BAR; PG8_SCHED;
            PG8_LDB(B0, 1, 0); PG8_LDB(B1, 1, 1); PG8_SCHED; PG8_LDA(At, 1, 0); PG8_STAGE(PG8_SA(0, 1), a2 + hstepA, voffA);
            PG8_WAIT_V(8); PG8_WAIT_L(0); PG8_BAR; PG8_MMA(0, 0, At, B0); PG8_MMA(0, 1, At, B1); PG8_BAR; PG8_SCHED;
            PG8_LDA(At, 1, 1); PG8_STAGE(PG8_SB(1, 0), b3, voffB); PG8_STAGE(PG8_SB(1, 1), b3 + hstepB, voffB); PG8_STAGE(PG8_SA(1, 0), a3, voffA);
            PG8_WAIT_V(8); PG8_WAIT_L(0); PG8_BAR; PG8_MMA(1, 0, At, B0); PG8_MMA(1, 1, At, B1); PG8_BAR; PG8_SCHED;
            } else {
            PG8_LDB(B0, 0, 0); PG8_SCHED; PG8_LDA(At, 0, 0); PG8_STAGE(PG8_SA(1, 1), a1 + hstepA, voffA);
            PG8_WAIT_L(8); PG8_BAR; PG8_WAIT_L(0); PG8_MMA(0, 0, At, B0); PG8_BAR; PG8_SCHED;
            PG8_LDB(B1, 0, 1); PG8_STAGE(PG8_SB(0, 0), b2, voffB);
            PG8_BAR; PG8_WAIT_L(0); PG8_MMA(0, 1, At, B1); PG8_BAR;
            PG8_LDA(At, 0, 1); PG8_STAGE(PG8_SA(0, 0), a2, voffA);
            PG8_BAR; PG8_WAIT_L(0); PG8_MMA(1, 0, At, B0); PG8_BAR; PG8_SCHED;
            PG8_STAGE(PG8_SB(0, 1), b2 + hstepB, voffB);
            PG8_WAIT_V(6); PG8_BAR; PG8_MMA(1, 1, At, B1); PG8_BAR;
            PG8_LDB(B0, 1, 0); PG8_SCHED; PG8_LDA(At, 1, 0); PG8_STAGE(PG8_SA(0, 1), a2 + hstepA, voffA);
            PG8_WAIT_L(8); PG8_BAR; PG8_WAIT_L(0); PG8_MMA(0, 0, At, B0); PG8_BAR; PG8_SCHED;
            PG8_LDB(B1, 1, 1); PG8_STAGE(PG8_SB(1, 0), b3, voffB);
            PG8_BAR; PG8_WAIT_L(0); PG8_MMA(0, 1, At, B1); PG8_BAR;
            PG8_LDA(At, 1, 1); PG8_STAGE(PG8_SA(1, 0), a3, voffA);
            PG8_BAR; PG8_WAIT_L(0); PG8_MMA(1, 0, At, B0); PG8_BAR; PG8_SCHED;
            PG8_STAGE(PG8_SB(1, 1), b3 + hstepB, voffB);
            PG8_WAIT_V(6); PG8_BAR; PG8_MMA(1, 1, At, B1); PG8_BAR;
            }
        }
        if constexpr (ALIGN_EPI) { if (wr == 0) PG8_BAR; }
        E(acc, cur, wr, wc, fr, fq);
        if (!has_next) break;
#pragma unroll
        for (int a = 0; a < 2; ++a)
#pragma unroll
            for (int b = 0; b < 2; ++b)
#pragma unroll
                for (int m = 0; m < 4; ++m)
#pragma unroll
                    for (int n = 0; n < 2; ++n) acc[a][b][m][n] = (f32x4){0.f, 0.f, 0.f, 0.f};
        cur = nxt; cA = nA; cB = nB;
        if constexpr (ALIGN_EPI) { if (wr == 1) PG8_BAR; }
    }
    PG8_WAIT_V(0);
    if constexpr (!ALIGN_EPI) { if (wr == 0) PG8_BAR; }
    PG8_BAR;
#undef PG8_SA
#undef PG8_SB
#undef PG8_STAGE
#undef PG8_LDA
#undef PG8_LDB
#undef PG8_MMA
#undef PG8_WAIT_V
#undef PG8_WAIT_L
#undef PG8_BAR
#undef PG8_SCHED
}
}
#define XB_TMO      128
#define XB_XCNT(j)  (256  + 64 * (j))
#define XB_XSUB(j)  (1280 + 64 * (j))
#define XB_XGEN(j)  (2304 + 64 * (j))
#define XB_TOP      3328
#define XB_TOPGEN   3392
#define XCD_BAR_WORDS 3456
#define XB_SPIN_CAP (1u << 18)

__device__ __forceinline__ unsigned xb_ld(unsigned* p)              { return __hip_atomic_load(p, __ATOMIC_RELAXED, __HIP_MEMORY_SCOPE_AGENT); }
__device__ __forceinline__ unsigned xb_add(unsigned* p, unsigned v) { return __hip_atomic_fetch_add(p, v, __ATOMIC_RELAXED, __HIP_MEMORY_SCOPE_AGENT); }
__device__ __forceinline__ unsigned xb_xcc_id() { return (unsigned)__builtin_amdgcn_s_getreg((3 << 11) | 20) & 0xFu; }
#define XB_SPIN(cond, bar) do { unsigned _sp = 0; while (cond) { __builtin_amdgcn_s_sleep(1); \
    if ((++_sp & 255u) == 0u) { if (xb_ld(&(bar)[XB_TMO])) break; if (_sp > XB_SPIN_CAP) { atomicAdd(&(bar)[XB_TMO], 1u); break; } } } } while (0)

struct XcdBarrier {
    unsigned* bar; unsigned x;
    volatile LAS unsigned* st;
};

__device__ __forceinline__ XcdBarrier xcd_barrier_post(unsigned* bar, volatile LAS unsigned* st) {
    XcdBarrier b; b.bar = bar; b.x = xb_xcc_id(); b.st = st;
    if (threadIdx.x == 0) (void)xb_add(&bar[XB_XCNT(b.x)], 1u);
    return b;
}
__device__ __forceinline__ void xcd_barrier_complete(unsigned* bar, unsigned x, unsigned& nloc, unsigned& nx) {
    const unsigned G = gridDim.x * gridDim.y * gridDim.z;
    unsigned sum, cnt, mine, sp = 0u;
    for (;;) {
        sum = 0u; cnt = 0u; mine = 0u;
#pragma unroll
        for (unsigned j = 0; j < 16; ++j) { const unsigned c = xb_ld(&bar[XB_XCNT(j)]); sum += c; cnt += (c > 0u) ? 1u : 0u; mine = (j == x) ? c : mine; }
        if (sum == G) break;
        __builtin_amdgcn_s_sleep(1);
        if ((++sp & 255u) == 0u) { if (xb_ld(&bar[XB_TMO])) break; if (sp > XB_SPIN_CAP) { atomicAdd(&bar[XB_TMO], 1u); break; } }
    }
    nloc = mine > 0u ? mine : 1u; nx = cnt > 0u ? cnt : 1u;
}

__device__ __forceinline__ void xcd_barrier(const XcdBarrier& b) {
    asm volatile("s_waitcnt vmcnt(0)" ::: "memory");
    __syncthreads();
    if (threadIdx.x == 0) {
        unsigned* bar = b.bar;
        __builtin_amdgcn_s_waitcnt(0);
        unsigned nloc = b.st[0], nx = b.st[1];
        if (nloc == 0u) { xcd_barrier_complete(bar, b.x, nloc, nx); b.st[0] = nloc; b.st[1] = nx; }
        const unsigned old = xb_add(&bar[XB_XSUB(b.x)], 1u);
        const unsigned gen = old / nloc;
        if (old + 1u == (gen + 1u) * nloc) {
            __builtin_amdgcn_fence(__ATOMIC_RELEASE, "agent");
            asm volatile("s_waitcnt vmcnt(0)" ::: "memory");
            const unsigned og = xb_add(&bar[XB_TOP], 1u);
            const unsigned tg = og / nx;
            if (og + 1u == (tg + 1u) * nx) xb_add(&bar[XB_TOPGEN], 1u);
            else XB_SPIN(xb_ld(&bar[XB_TOPGEN]) == tg, bar);
            __builtin_amdgcn_fence(__ATOMIC_ACQUIRE, "agent");
            xb_add(&bar[XB_XGEN(b.x)], 1u);
            asm volatile("s_waitcnt vmcnt(0)" ::: "memory");
        } else {
            XB_SPIN(xb_ld(&bar[XB_XGEN(b.x)]) == gen, bar);
            __builtin_amdgcn_fence(__ATOMIC_ACQUIRE, "agent");
            asm volatile("s_waitcnt vmcnt(0)" ::: "memory");
        }
    }
    __syncthreads();
}

constexpr int NWAVES = 8, NTHR = 512;
constexpr int DM = 1024, NB = 8, SEQ = 4096, CTXL = 256, DEPTH = 4;
constexpr int NLAT = NB * SEQ, NCTX = NB * CTXL, NT = NLAT + NCTX;
constexpr int PW = 2304;
constexpr int MW = 1280;
constexpr int NEXP = 32, MAXBLK = 576;
constexpr int NCHK = 544;
constexpr int S5ROWS = 2304;
constexpr int PC_FU = 0, PC_S5 = 256, PC_Q = 512, PC_K = 640, PC_V = 768, PC_R = 1024, PC_Z = 1280, PC_XBC = 1536, PC_A1 = 2048, PC_DT = 2080;
enum { I_X = 0, I_C, I_CTX, I_CCTX, I_ADAW, I_ADAB, I_NMG, I_NFG, I_WIN, I_WOUT, I_FOURW, I_S5LRE, I_S5LIM, I_S5LDT, I_S5BRE, I_S5BIM, I_S5CRE, I_S5CIM, I_S5D, I_S5GLU,
       I_GLAA2, I_GLAAB, I_GLANG, I_SSDCW, I_SSDCB, I_SSDALOG, I_SSDDTB, I_SSDD, I_SSDNG, I_RW, I_RB, I_WGU, I_BGU, I_WDN, I_BDN, I_FING, N_IN };

constexpr size_t al256(size_t x) { return (x + 255) & ~(size_t)255; }
constexpr size_t WS_CTL = 0, CTL_BYTES = 1u << 20;
constexpr size_t WS_MOD = WS_CTL + CTL_BYTES;
constexpr size_t WS_TAB = WS_MOD + al256((size_t)DEPTH * 9 * 6144 * 4);
constexpr size_t TAB_F64 = 0, TAB_TW = 16384, TAB_D256 = 16384 + 32768, TAB_BYTES = 65536;
constexpr size_t WS_A16 = WS_TAB + TAB_BYTES;
constexpr size_t WS_WIN = WS_A16 + al256((size_t)DEPTH * 2 * 16 * 64 * 2 * 4);
constexpr size_t WS_WOUT = WS_WIN + (size_t)DEPTH * PW * DM * 2;
constexpr size_t WS_WGLU = WS_WOUT + (size_t)DEPTH * DM * MW * 2;
constexpr size_t WS_S5P = WS_WGLU + (size_t)DEPTH * 256 * 256 * 2;
constexpr size_t WS_S5B2 = WS_S5P + (size_t)DEPTH * 16 * 256 * 256 * 2;
constexpr size_t WS_WGU = WS_S5B2 + (size_t)DEPTH * 16 * 256 * 512 * 2;
constexpr size_t WS_WDN = WS_WGU + (size_t)DEPTH * NEXP * 2048 * DM * 2;
constexpr size_t WS_XS = WS_WDN + (size_t)DEPTH * NEXP * DM * DM * 2;
constexpr size_t WS_H = WS_XS + (size_t)NT * DM * 4;
constexpr size_t WS_PBUF = WS_H + (size_t)NT * DM * 2;
constexpr size_t WS_A2 = WS_PBUF + (size_t)NT * PW * 2;
constexpr size_t WS_S5S = WS_A2 + (size_t)16 * S5ROWS * 512 * 2;
constexpr size_t WS_ACT5 = WS_S5S + (size_t)16 * S5ROWS * 256 * 4;
constexpr size_t WS_MIX = WS_ACT5 + (size_t)NT * 256 * 2;
constexpr size_t WS_GDS = WS_MIX + (size_t)NT * MW * 2;
constexpr size_t WS_GDEC = WS_GDS + (size_t)NCHK * 8 * 2048 * 4;
constexpr size_t WS_GSE = WS_GDEC + al256((size_t)NCHK * 8 * 32 * 4);
constexpr size_t WS_SDS = WS_GSE + (size_t)NCHK * 8 * 2048 * 2;
constexpr size_t WS_SDEC = WS_SDS + (size_t)NCHK * 8 * 4096 * 4;
constexpr size_t WS_SSE = WS_SDEC + al256((size_t)NCHK * 8 * 4);
constexpr size_t WS_PE = WS_SSE + (size_t)NCHK * 8 * 4096 * 2;
constexpr size_t WS_PR = WS_PE + (size_t)NT * 4 * 4;
constexpr size_t WS_PG = WS_PR + (size_t)NT * 4 * 4;
constexpr size_t WS_PS = WS_PG + (size_t)NT * 4 * 4;
constexpr size_t WS_SG = WS_PS + (size_t)NT * 4 * 4;
constexpr size_t WS_BUF = WS_SG + (size_t)MAXBLK * 256 * 4;
constexpr size_t WS_ACT = WS_BUF + (size_t)MAXBLK * 256 * DM * 2;
constexpr size_t WS_Y = WS_ACT + (size_t)MAXBLK * 256 * DM * 2;
constexpr size_t WS_END = WS_Y + (size_t)MAXBLK * 256 * DM * 2;
constexpr int CW_QUEUE = 64;
constexpr int CW_CNT = 1024;
constexpr int CW_BLKE = 2048;
constexpr int CW_BAR = 8192;

constexpr int LDS_BYTES = 163840, MISC_OFF = LDS_BYTES - 256;

#define RLX_AGENT __ATOMIC_RELAXED, __HIP_MEMORY_SCOPE_AGENT
__device__ __forceinline__ unsigned f2bf(float f) { unsigned u = __builtin_bit_cast(unsigned, f); return (u + 0x7fffu + ((u >> 16) & 1u)) >> 16; }
__device__ __forceinline__ unsigned pk2(float lo, float hi) { return f2bf(lo) | (f2bf(hi) << 16); }
__device__ __forceinline__ float bf2f(unsigned short b) { return __builtin_bit_cast(float, (unsigned)b << 16); }
__device__ __forceinline__ float bflo(unsigned w) { return __builtin_bit_cast(float, w << 16); }
__device__ __forceinline__ float bfhi(unsigned w) { return __builtin_bit_cast(float, w & 0xffff0000u); }
template <int M> __device__ __forceinline__ float swz_xor(float v) { return __builtin_bit_cast(float, __builtin_amdgcn_ds_swizzle(__builtin_bit_cast(int, v), (M << 10) | 0x1F)); }
__device__ __forceinline__ float xor32f(float v, int lane) { return __builtin_bit_cast(float, __builtin_amdgcn_ds_bpermute((lane ^ 32) << 2, __builtin_bit_cast(int, v))); }
__device__ __forceinline__ float wave_sum(float v, int lane) { v += swz_xor<1>(v); v += swz_xor<2>(v); v += swz_xor<4>(v); v += swz_xor<8>(v); v += swz_xor<16>(v); v += xor32f(v, lane); return v; }
__device__ __forceinline__ float wave_max(float v, int lane) { v = fmaxf(v, swz_xor<1>(v)); v = fmaxf(v, swz_xor<2>(v)); v = fmaxf(v, swz_xor<4>(v)); v = fmaxf(v, swz_xor<8>(v)); v = fmaxf(v, swz_xor<16>(v)); v = fmaxf(v, xor32f(v, lane)); return v; }
__device__ __forceinline__ float sigmoidf_(float x) { return 1.f / (1.f + __expf(-x)); }
__device__ __forceinline__ float siluf_(float x) { return x / (1.f + __expf(-x)); }

template <class Fill> struct SgOrder {
    int nblk, nN, R, x, r, xs; Fill f;
    __device__ __forceinline__ void init(int nblk_, int nN_, int G, int c) { nblk = nblk_; nN = nN_; if ((G & 7) == 0) { R = G >> 3; x = c & 7; r = c >> 3; xs = 8; } else { R = G; x = 0; r = c; xs = 1; } }
    __device__ __forceinline__ bool next(int& cursor, pg8::Unit& u) const {
        const int ups = 8 * nN, nsg = (nblk + 7) >> 3;
        for (;;) {
            const int v = r + R * cursor; ++cursor;
            const int sgl = v / ups, uu = v - sgl * ups, sg = x + xs * sgl;
            if (sg >= nsg) return false;
            const int blk = sg * 8 + (uu & 7), pn = uu >> 3;
            if (blk >= nblk) continue;
            u.pm = blk; u.pn = pn; f(u); return true;
        }
    }
};
struct FillPlain { size_t astep, bstep; __device__ __forceinline__ void operator()(pg8::Unit& u) const { u.grp = 0; u.aoff = (size_t)u.pm * astep; u.boff = (size_t)u.pn * bstep; } };
struct FillS5 { size_t bgrp; __device__ __forceinline__ void operator()(pg8::Unit& u) const { const int g = u.pm / 9, t = u.pm - g * 9; u.grp = g; u.pm = t; u.aoff = ((size_t)g * S5ROWS + (size_t)t * 256) * 512 * 2; u.boff = (size_t)g * bgrp; } };
struct FillMoe { const unsigned* blke; int erows; __device__ __forceinline__ void operator()(pg8::Unit& u) const { const int e = (int)blke[1 + u.pm]; u.grp = e; u.aoff = (size_t)u.pm * 256 * DM * 2; u.boff = ((size_t)e * erows + (size_t)u.pn * 256) * DM * 2; } };

using pg8::cvt_pk_bf16;
struct EpiInproj {
    static constexpr bool PERM = true;
    bf16* P; bf16* A2;
    __device__ __forceinline__ void operator()(const f32x4 (&acc)[2][2][4][2], const pg8::Unit& u, int wr, int wc, int fr, int fq) const {
        const int row0 = u.pm * 256 + wr * 64 + fr, col0 = u.pn * 256 + wc * 32 + 8 * fq;
#pragma unroll
        for (int ai = 0; ai < 2; ++ai)
#pragma unroll
            for (int m = 0; m < 4; ++m) {
                const int row = row0 + ai * 128 + m * 16;
#pragma unroll
                for (int bj = 0; bj < 2; ++bj) {
                    const f32x4 v0 = acc[ai][bj][m][0], v1 = acc[ai][bj][m][1];
                    u32x4 w; w.x = cvt_pk_bf16(v0[0], v0[1]); w.y = cvt_pk_bf16(v0[2], v0[3]); w.z = cvt_pk_bf16(v1[0], v1[1]); w.w = cvt_pk_bf16(v1[2], v1[3]);
                    const int col = col0 + bj * 128;
                    if (u.pn == 1) {
                        const int cc = col - 256, g = cc >> 4, hp = cc & 15;
                        const int crow = row < NLAT ? (row >> 4) : (2048 + ((row - NLAT) >> 4)), s = row & 15;
                        *(u32x4*)(A2 + ((size_t)g * S5ROWS + crow) * 512 + s * 16 + hp) = w;
                    } else *(u32x4*)(P + (size_t)row * PW + col) = w;
                }
            }
    }
};
struct EpiOutproj {
    static constexpr bool PERM = false;
    const float* xin; const float* ctxin; float* XS; const float* modL; int first;
    __device__ __forceinline__ void operator()(const f32x4 (&acc)[2][2][4][2], const pg8::Unit& u, int wr, int wc, int fr, int fq) const {
        const int rowt = u.pm * 256, bi = rowt < NLAT ? (rowt >> 12) : 8;
        const int row0 = rowt + wr * 64 + fr, col0 = u.pn * 256 + wc * 32 + 4 * fq;
        const float* gate = modL + (size_t)bi * 6144 + 2 * 1024;
        f32x4 gv[2][2];
#pragma unroll
        for (int bj = 0; bj < 2; ++bj)
#pragma unroll
            for (int n = 0; n < 2; ++n) gv[bj][n] = *(const f32x4*)(gate + col0 + bj * 128 + n * 16);
#pragma unroll
        for (int ai = 0; ai < 2; ++ai)
#pragma unroll
            for (int m = 0; m < 4; ++m) {
                const int row = row0 + ai * 128 + m * 16;
                const float* src = first ? (row < NLAT ? xin + (size_t)row * DM : ctxin + (size_t)(row - NLAT) * DM) : XS + (size_t)row * DM;
                float* dst = XS + (size_t)row * DM;
#pragma unroll
                for (int bj = 0; bj < 2; ++bj)
#pragma unroll
                    for (int n = 0; n < 2; ++n) { const int c = col0 + bj * 128 + n * 16; const f32x4 xo = *(const f32x4*)(src + c); *(f32x4*)(dst + c) = xo + gv[bj][n] * acc[ai][bj][m][n]; }
            }
    }
};
struct EpiSwiglu {
    static constexpr bool PERM = true;
    bf16* ACT; const float* bgu;
    __device__ __forceinline__ void operator()(const f32x4 (&acc)[2][2][4][2], const pg8::Unit& u, int wr, int wc, int fr, int fq) const {
        const int row0 = u.pm * 256 + wr * 64 + fr, i0 = u.pn * 128 + wc * 32 + 8 * fq;
        const float* bb = bgu + (size_t)u.grp * 2048 + 2 * i0;
        const f32x4 b0 = *(const f32x4*)(bb), b1 = *(const f32x4*)(bb + 4), b2 = *(const f32x4*)(bb + 8), b3 = *(const f32x4*)(bb + 12);
        const float bg[8] = {b0[0], b0[2], b1[0], b1[2], b2[0], b2[2], b3[0], b3[2]}, bu[8] = {b0[1], b0[3], b1[1], b1[3], b2[1], b2[3], b3[1], b3[3]};
#pragma unroll
        for (int ai = 0; ai < 2; ++ai)
#pragma unroll
            for (int m = 0; m < 4; ++m) {
                const int row = row0 + ai * 128 + m * 16;
                float o[8];
#pragma unroll
                for (int n = 0; n < 2; ++n)
#pragma unroll
                    for (int j = 0; j < 4; ++j) {
                        const int q = 4 * n + j;
                        const float gt = fminf(acc[ai][0][m][n][j] + bg[q], 7.0f);
                        const float up = fminf(fmaxf(acc[ai][1][m][n][j] + bu[q], -7.0f), 7.0f);
                        o[q] = (up + 1.0f) * gt * sigmoidf_(1.702f * gt);
                    }
                u32x4 w; w.x = cvt_pk_bf16(o[0], o[1]); w.y = cvt_pk_bf16(o[2], o[3]); w.z = cvt_pk_bf16(o[4], o[5]); w.w = cvt_pk_bf16(o[6], o[7]);
                *(u32x4*)(ACT + (size_t)row * DM + i0) = w;
            }
    }
};
struct EpiDown {
    static constexpr bool PERM = true;
    bf16* Y; const float* bdn; const float* sg;
    __device__ __forceinline__ void operator()(const f32x4 (&acc)[2][2][4][2], const pg8::Unit& u, int wr, int wc, int fr, int fq) const {
        const int row0 = u.pm * 256 + wr * 64 + fr, col0 = u.pn * 256 + wc * 32 + 8 * fq;
        const float* bb = bdn + (size_t)u.grp * DM + col0;
        f32x4 bv[2][2];
#pragma unroll
        for (int bj = 0; bj < 2; ++bj)
#pragma unroll
            for (int n = 0; n < 2; ++n) bv[bj][n] = *(const f32x4*)(bb + bj * 128 + 4 * n);
#pragma unroll
        for (int ai = 0; ai < 2; ++ai)
#pragma unroll
            for (int m = 0; m < 4; ++m) {
                const int row = row0 + ai * 128 + m * 16; const float gt = sg[row];
#pragma unroll
                for (int bj = 0; bj < 2; ++bj) {
                    const f32x4 v0 = (acc[ai][bj][m][0] + bv[bj][0]) * gt, v1 = (acc[ai][bj][m][1] + bv[bj][1]) * gt;
                    u32x4 w; w.x = cvt_pk_bf16(v0[0], v0[1]); w.y = cvt_pk_bf16(v0[2], v0[3]); w.z = cvt_pk_bf16(v1[0], v1[1]); w.w = cvt_pk_bf16(v1[2], v1[3]);
                    *(u32x4*)(Y + (size_t)row * DM + col0 + bj * 128) = w;
                }
            }
    }
};
struct EpiS5S {
    static constexpr bool PERM = false;
    float* S;
    __device__ __forceinline__ void operator()(const f32x4 (&acc)[2][2][4][2], const pg8::Unit& u, int wr, int wc, int fr, int fq) const {
        const int row0 = u.pm * 256 + wr * 64 + fr, col0 = wc * 32 + 4 * fq;
        float* base = S + (size_t)u.grp * S5ROWS * 256;
#pragma unroll
        for (int ai = 0; ai < 2; ++ai)
#pragma unroll
            for (int m = 0; m < 4; ++m) { float* rp = base + (size_t)(row0 + ai * 128 + m * 16) * 256 + col0;
#pragma unroll
                for (int bj = 0; bj < 2; ++bj)
#pragma unroll
                    for (int n = 0; n < 2; ++n) *(f32x4*)(rp + bj * 128 + n * 16) = acc[ai][bj][m][n]; }
    }
};
__device__ __forceinline__ float gelu_tanh(float x) { const float t = 0.7978845608f * (x + 0.044715f * x * x * x); const float e = __expf(2.f * t); return 0.5f * x * (1.f + (1.f - 2.f / (e + 1.f))); }
struct EpiS5Y {
    static constexpr bool PERM = true;
    bf16* ACT5;
    __device__ __forceinline__ void operator()(const f32x4 (&acc)[2][2][4][2], const pg8::Unit& u, int wr, int wc, int fr, int fq) const {
        const int row0 = u.pm * 256 + wr * 64 + fr, col0 = wc * 32 + 8 * fq;
#pragma unroll
        for (int ai = 0; ai < 2; ++ai)
#pragma unroll
            for (int m = 0; m < 4; ++m) {
                const int crow = row0 + ai * 128 + m * 16;
                if (crow >= 2176) continue;
                const int tok0 = crow < 2048 ? crow * 16 : NLAT + (crow - 2048) * 16;
#pragma unroll
                for (int bj = 0; bj < 2; ++bj) {
                    const int col = col0 + bj * 128, j = col >> 4, h = col & 15;
                    const f32x4 v0 = acc[ai][bj][m][0], v1 = acc[ai][bj][m][1];
                    u32x4 w; w.x = cvt_pk_bf16(gelu_tanh(v0[0]), gelu_tanh(v0[1])); w.y = cvt_pk_bf16(gelu_tanh(v0[2]), gelu_tanh(v0[3]));
                    w.z = cvt_pk_bf16(gelu_tanh(v1[0]), gelu_tanh(v1[1])); w.w = cvt_pk_bf16(gelu_tanh(v1[2]), gelu_tanh(v1[3]));
                    *(u32x4*)(ACT5 + (size_t)(tok0 + j) * 256 + u.grp * 16 + h) = w;
                }
            }
    }
};
struct EpiGlu {
    static constexpr bool PERM = true;
    const bf16* ACT5; bf16* MIX;
    __device__ __forceinline__ void operator()(const f32x4 (&acc)[2][2][4][2], const pg8::Unit& u, int wr, int wc, int fr, int fq) const {
        const int row0 = u.pm * 256 + wr * 64 + fr, col0 = wc * 32 + 8 * fq;
#pragma unroll
        for (int ai = 0; ai < 2; ++ai)
#pragma unroll
            for (int m = 0; m < 4; ++m) {
                const int row = row0 + ai * 128 + m * 16;
#pragma unroll
                for (int bj = 0; bj < 2; ++bj) {
                    const int col = col0 + bj * 128;
                    const u32x4 a = *(const u32x4*)(ACT5 + (size_t)row * 256 + col);
                    const f32x4 v0 = acc[ai][bj][m][0], v1 = acc[ai][bj][m][1];
                    u32x4 w;
                    w.x = cvt_pk_bf16(bflo(a.x) * sigmoidf_(v0[0]), bfhi(a.x) * sigmoidf_(v0[1])); w.y = cvt_pk_bf16(bflo(a.y) * sigmoidf_(v0[2]), bfhi(a.y) * sigmoidf_(v0[3]));
                    w.z = cvt_pk_bf16(bflo(a.z) * sigmoidf_(v1[0]), bfhi(a.z) * sigmoidf_(v1[1])); w.w = cvt_pk_bf16(bflo(a.w) * sigmoidf_(v1[2]), bfhi(a.w) * sigmoidf_(v1[3]));
                    *(u32x4*)(MIX + (size_t)row * MW + 512 + col) = w;
                }
            }
    }
};

struct Args { const float* in[N_IN]; float* out; unsigned char* ws; int ph_lo, ph_hi; };
struct Frame {
    LAS unsigned char* lds; volatile LAS unsigned* MISC; unsigned* ctl; unsigned char* ws;
    int tid, lane, wave, G, bid;
};

template <class Map> __device__ __forceinline__ void transpose_tile(const float* W, int ldw, int ncols, int k0, int n0, bf16* WT, int ldt, int kd0, const Map& map, LAS float* scr, int lane) {
    const int nn = n0 + lane;
#pragma unroll 16
    for (int kk = 0; kk < 64; ++kk) scr[kk * 65 + lane] = nn < ncols ? W[(size_t)(k0 + kk) * ldw + nn] : 0.f;
    asm volatile("s_waitcnt lgkmcnt(0)" ::: "memory");
    const int c = lane & 7;
#pragma unroll
    for (int j = 0; j < 8; ++j) {
        const int n = (lane >> 3) + 8 * j; const LAS float* s = scr + (8 * c) * 65 + n;
        u32x4 o; o.x = pk2(s[0], s[65]); o.y = pk2(s[2 * 65], s[3 * 65]); o.z = pk2(s[4 * 65], s[5 * 65]); o.w = pk2(s[6 * 65], s[7 * 65]);
        const int dr = (n0 + n) < ncols ? map(n0 + n) : -1;
        if (dr >= 0) *(u32x4*)(WT + (size_t)dr * ldt + kd0 + 8 * c) = o;
    }
    asm volatile("s_waitcnt lgkmcnt(0)" ::: "memory");
}
struct MapId { __device__ __forceinline__ int operator()(int n) const { return n; } };
struct MapWin { __device__ __forceinline__ int operator()(int c) const { return c < 1280 ? c : (c < 1312 ? 2048 + (c - 1280) : (c < 2080 ? c - 32 : c)); } };
struct MapGu { __device__ __forceinline__ int operator()(int n) const { const int i = n >> 1; return (i >> 7) * 256 + (n & 1) * 128 + (i & 127); } };

constexpr int PI_ADA = 48, PI_TAB = 1, PI_S5 = 64, PI_FOLD = 256, PI_ZERO = 4;
constexpr int TW_WIN = 16 * 33, TW_GU = 32 * 16 * 32, TW_DN = 32 * 16 * 16, TW_WOUT = 12 * 16, TW_GLU = 16, TW_LAYER = TW_WIN + TW_GU + TW_DN + TW_WOUT + TW_GLU;
constexpr int PI_TR = (DEPTH * TW_LAYER + 7) / 8;
constexpr int PI_B_TAB = PI_ADA, PI_B_S5 = PI_B_TAB + PI_TAB, PI_B_FOLD = PI_B_S5 + PI_S5, PI_B_ZERO = PI_B_FOLD + PI_FOLD, PI_B_TR = PI_B_ZERO + PI_ZERO, PI_TOTAL = PI_B_TR + PI_TR;

__device__ __forceinline__ void pro_adaln(Frame& F, const Args& a, int it) {
    const int L = it / 12, cb = it % 12;
    LAS float* cond = (LAS float*)F.lds;
    for (int i = F.tid; i < 9 * 1024; i += NTHR) { const int r = i >> 10, k = i & 1023; const float v = r < 8 ? a.in[I_C][r * 1024 + k] : a.in[I_CCTX][k]; cond[i] = siluf_(v); }
    __syncthreads();
    const int n = cb * 512 + F.tid;
    const float* w = a.in[I_ADAW] + (size_t)L * 1024 * 6144 + n;
    float acc[9];
    const float b = a.in[I_ADAB][L * 6144 + n];
#pragma unroll
    for (int r = 0; r < 9; ++r) acc[r] = b;
#pragma unroll 2
    for (int k = 0; k < 1024; k += 4) {
        const float w0 = w[(size_t)k * 6144], w1 = w[(size_t)(k + 1) * 6144], w2 = w[(size_t)(k + 2) * 6144], w3 = w[(size_t)(k + 3) * 6144];
#pragma unroll
        for (int r = 0; r < 9; ++r) { const f32x4 c4 = *(const LAS f32x4*)(cond + r * 1024 + k); acc[r] += c4[0] * w0 + c4[1] * w1 + c4[2] * w2 + c4[3] * w3; }
    }
    float* mod = (float*)(F.ws + WS_MOD) + (size_t)L * 9 * 6144 + n;
#pragma unroll
    for (int r = 0; r < 9; ++r) mod[(size_t)r * 6144] = acc[r];
    __syncthreads();
}
__device__ __forceinline__ void pro_tables(Frame& F) {
    bf16* f64 = (bf16*)(F.ws + WS_TAB + TAB_F64);
    for (int i = F.tid; i < 4096; i += NTHR) { const int k = i >> 6, n = i & 63; float s, c; sincospif((float)((k * n) & 63) / 32.f, &s, &c); f64[i] = (bf16)f2bf(c); f64[4096 + i] = (bf16)f2bf(s); }
    float* tw = (float*)(F.ws + WS_TAB + TAB_TW);
    for (int i = F.tid; i < 4096; i += NTHR) { float s, c; sincospif((float)i / 2048.f, &s, &c); tw[2 * i] = c; tw[2 * i + 1] = s; }
    float* d256 = (float*)(F.ws + WS_TAB + TAB_D256);
    for (int i = F.tid; i < 256; i += NTHR) { float s, c; sincospif((float)i / 128.f, &s, &c); d256[2 * i] = c; d256[2 * i + 1] = s; }
}
__device__ __forceinline__ void pro_fold(Frame& F, const Args& a, int it) {
    const int L = it >> 6, h = (it >> 4) & 3, nb = it & 15, n0 = nb * 64;
    LAS float* fw = (LAS float*)F.lds;
    LAS float* ct = fw + 64 * 65;
    if (F.tid < 64) ct[F.tid] = cospif((float)F.tid / 32.f);
    const float* four = a.in[I_FOURW] + (size_t)L * 256 * 256, *wo = a.in[I_WOUT] + (size_t)L * 1024 * 1024;
    const int n = F.tid & 63, cg = F.tid >> 6;
    { float s[8];
#pragma unroll
      for (int i = 0; i < 8; ++i) s[i] = 0.f;
      for (int j = 0; j < 256; ++j) { const float wv = wo[(size_t)j * 1024 + n0 + n];
#pragma unroll
          for (int i = 0; i < 8; ++i) s[i] += four[(size_t)(h * 64 + cg * 8 + i) * 256 + j] * wv; }
#pragma unroll
      for (int i = 0; i < 8; ++i) fw[(cg * 8 + i) * 65 + n] = s[i]; }
    __syncthreads();
    float oc[8], os[8];
#pragma unroll
    for (int i = 0; i < 8; ++i) { oc[i] = 0.f; os[i] = 0.f; }
    for (int kc = 0; kc < 64; ++kc) { const float v = fw[kc * 65 + n];
#pragma unroll
        for (int i = 0; i < 8; ++i) { const int mm = (kc * (cg * 8 + i)) & 63; oc[i] += ct[mm] * v; os[i] += ct[(mm + 48) & 63] * v; } }
    bf16* wt = (bf16*)(F.ws + WS_WOUT) + (size_t)L * DM * MW + (size_t)(n0 + n) * MW + h * 64 + cg * 8;
    u32x4 w; w.x = pk2(oc[0] * 0.125f, oc[1] * 0.125f); w.y = pk2(oc[2] * 0.125f, oc[3] * 0.125f); w.z = pk2(oc[4] * 0.125f, oc[5] * 0.125f); w.w = pk2(oc[6] * 0.125f, oc[7] * 0.125f);
    *(u32x4*)wt = w;
    w.x = pk2(os[0] * 0.125f, os[1] * 0.125f); w.y = pk2(os[2] * 0.125f, os[3] * 0.125f); w.z = pk2(os[4] * 0.125f, os[5] * 0.125f); w.w = pk2(os[6] * 0.125f, os[7] * 0.125f);
    *(u32x4*)(wt + 256) = w;
    __syncthreads();
}
__device__ __forceinline__ void pro_s5(Frame& F, const Args& a, int it) {
    const int L = it >> 4, g = it & 15;
    LAS float* pw = (LAS float*)F.lds;
    LAS float* bb = pw + 2 * 64 * 17 * 2;
    LAS float* cm = bb + 2 * 64 * 16 * 2;
    LAS float* kt = cm + 2 * 16 * 64 * 2;
    for (int i = F.tid; i < 2 * 64 * 17; i += NTHR) {
        const int r = i / (64 * 17), p = (i / 17) & 63, e = i % 17; const size_t q = ((size_t)(L * 2 + r) * 16 + g) * 64 + p;
        const float dt = __expf(a.in[I_S5LDT][(L * 2 + r) * 16 + g]); const float lr = a.in[I_S5LRE][q] * dt, li = a.in[I_S5LIM][q] * dt;
        float s, c; sincosf(li * (float)e, &s, &c); const float m = expf(lr * (float)e); pw[2 * i] = m * c; pw[2 * i + 1] = m * s;
    }
    for (int i = F.tid; i < 2 * 64 * 16; i += NTHR) {
        const int r = i >> 10, p = (i >> 4) & 63, h = i & 15; const size_t q = ((size_t)(L * 2 + r) * 16 + g) * 64 + p;
        const float dt = __expf(a.in[I_S5LDT][(L * 2 + r) * 16 + g]); const float lre = a.in[I_S5LRE][q], lim = a.in[I_S5LIM][q];
        float s, c; sincosf(lim * dt, &s, &c); const float m = expf(lre * dt); const float ar = m * c - 1.f, ai = m * s;
        const float den = 1.f / (lre * lre + lim * lim); const float cr = (ar * lre + ai * lim) * den, ci = (ai * lre - ar * lim) * den;
        const float br = a.in[I_S5BRE][q * 16 + h], bi = a.in[I_S5BIM][q * 16 + h];
        bb[2 * i] = cr * br - ci * bi; bb[2 * i + 1] = cr * bi + ci * br;
    }
    for (int i = F.tid; i < 2 * 16 * 64; i += NTHR) {
        const int r = i >> 10, h = (i >> 6) & 15, p = i & 63; const size_t q = (((size_t)(L * 2 + r) * 16 + g) * 16 + h) * 64 + p;
        cm[2 * i] = a.in[I_S5CRE][q]; cm[2 * i + 1] = a.in[I_S5CIM][q];
    }
    __syncthreads();
    for (int i = F.tid; i < 2 * 16 * 256; i += NTHR) {
        const int r = i >> 12, tau = (i >> 8) & 15, h = (i >> 4) & 15, hp = i & 15; float s = 0.f;
        for (int p = 0; p < 64; ++p) { const float cr = cm[2 * ((r * 16 + h) * 64 + p)], ci = cm[2 * ((r * 16 + h) * 64 + p) + 1];
            const float ar = pw[2 * ((r * 64 + p) * 17 + tau)], ai = pw[2 * ((r * 64 + p) * 17 + tau) + 1]; const float br = bb[2 * ((r * 64 + p) * 16 + hp)], bi = bb[2 * ((r * 64 + p) * 16 + hp) + 1];
            const float tr = cr * ar - ci * ai, ti = cr * ai + ci * ar; s += tr * br - ti * bi; }
        kt[i] = s;
    }
    __syncthreads();
    bf16* pt = (bf16*)(F.ws + WS_S5P) + (size_t)(L * 16 + g) * 256 * 256;
    for (int i = F.tid; i < 65536; i += NTHR) {
        const int np = i >> 8, k = i & 255, r = np >> 7, cpx = (np >> 6) & 1, p = np & 63, s = k >> 4, hp = k & 15, e = r ? s : 15 - s;
        const float ar = pw[2 * ((r * 64 + p) * 17 + e)], ai = pw[2 * ((r * 64 + p) * 17 + e) + 1]; const float br = bb[2 * ((r * 64 + p) * 16 + hp)], bi = bb[2 * ((r * 64 + p) * 16 + hp) + 1];
        pt[i] = (bf16)f2bf(cpx ? ar * bi + ai * br : ar * br - ai * bi);
    }
    bf16* b2 = (bf16*)(F.ws + WS_S5B2) + (size_t)(L * 16 + g) * 256 * 512;
    const float* dsk = a.in[I_S5D] + L * 256 + g * 16;
    for (int i = F.tid; i < 131072; i += NTHR) {
        const int n = i >> 9, k = i & 511, j = n >> 4, h = n & 15; float v;
        if (k < 256) { const int s = k >> 4, hp = k & 15; v = 0.f;
            if (j >= s) v += kt[((0 * 16 + (j - s)) * 16 + h) * 16 + hp];
            if (j <= s) v += kt[((1 * 16 + (s - j)) * 16 + h) * 16 + hp];
            if (j == s && h == hp) v += dsk[h];
        } else { const int kk = k - 256, r = kk >> 7, cpx = (kk >> 6) & 1, p = kk & 63, e = r ? 16 - j : j + 1;
            const float cr = cm[2 * ((r * 16 + h) * 64 + p)], ci = cm[2 * ((r * 16 + h) * 64 + p) + 1]; const float ar = pw[2 * ((r * 64 + p) * 17 + e)], ai = pw[2 * ((r * 64 + p) * 17 + e) + 1];
            v = cpx ? -(cr * ai + ci * ar) : (cr * ar - ci * ai); }
        b2[i] = (bf16)f2bf(v);
    }
    float* a16 = (float*)(F.ws + WS_A16) + (size_t)((L * 2) * 16 + g) * 128;
    if (F.tid < 128) { const int r = F.tid >> 6, p = F.tid & 63; float* o = a16 + (size_t)r * 16 * 128 + p * 2; o[0] = pw[2 * ((r * 64 + p) * 17 + 16)]; o[1] = pw[2 * ((r * 64 + p) * 17 + 16) + 1]; }
    __syncthreads();
}
__device__ __forceinline__ void pro_transposes(Frame& F, const Args& a, int wg_item) {
    LAS float* scr = (LAS float*)F.lds + F.wave * (64 * 65);
    const int wi = wg_item * 8 + F.wave;
    if (wi >= DEPTH * TW_LAYER) return;
    const int L = wi / TW_LAYER; int r = wi % TW_LAYER;
    if (r < TW_WIN) { const int kb = r / 33, nb = r % 33; transpose_tile(a.in[I_WIN] + (size_t)L * DM * 2088, 2088, 2088, kb * 64, nb * 64, (bf16*)(F.ws + WS_WIN) + (size_t)L * PW * DM, DM, kb * 64, MapWin(), scr, F.lane); return; } r -= TW_WIN;
    if (r < TW_GU) { const int e = r >> 9, kb = (r >> 5) & 15, nb = r & 31; transpose_tile(a.in[I_WGU] + ((size_t)L * NEXP + e) * DM * 2048, 2048, 2048, kb * 64, nb * 64, (bf16*)(F.ws + WS_WGU) + ((size_t)L * NEXP + e) * 2048 * DM, DM, kb * 64, MapGu(), scr, F.lane); return; } r -= TW_GU;
    if (r < TW_DN) { const int e = r >> 8, kb = (r >> 4) & 15, nb = r & 15; transpose_tile(a.in[I_WDN] + ((size_t)L * NEXP + e) * DM * DM, DM, DM, kb * 64, nb * 64, (bf16*)(F.ws + WS_WDN) + ((size_t)L * NEXP + e) * DM * DM, DM, kb * 64, MapId(), scr, F.lane); return; } r -= TW_DN;
    if (r < TW_WOUT) { const int kb = r >> 4, nb = r & 15; transpose_tile(a.in[I_WOUT] + (size_t)L * DM * DM + (size_t)256 * DM, DM, DM, kb * 64, nb * 64, (bf16*)(F.ws + WS_WOUT) + (size_t)L * DM * MW, MW, 512 + kb * 64, MapId(), scr, F.lane); return; } r -= TW_WOUT;
    { const int kb = r >> 2, nb = r & 3; transpose_tile(a.in[I_S5GLU] + (size_t)L * 256 * 256, 256, 256, kb * 64, nb * 64, (bf16*)(F.ws + WS_WGLU) + (size_t)L * 256 * 256, 256, kb * 64, MapId(), scr, F.lane); }
}
__device__ __forceinline__ void p_prologue(Frame& F, const Args& a) {
    for (;;) {
        if (F.tid == 0) F.MISC[0] = __hip_atomic_fetch_add(F.ctl + CW_QUEUE, 1u, RLX_AGENT);
        __syncthreads();
        const int it = (int)F.MISC[0];
        __syncthreads();
        if (it >= PI_TOTAL) break;
        if (it < PI_B_TAB) pro_adaln(F, a, it);
        else if (it < PI_B_S5) pro_tables(F);
        else if (it < PI_B_FOLD) pro_s5(F, a, it - PI_B_S5);
        else if (it < PI_B_ZERO) pro_fold(F, a, it - PI_B_FOLD);
        else if (it < PI_B_TR) { const int L = it - PI_B_ZERO; u32x4* z = (u32x4*)((bf16*)(F.ws + WS_WIN) + (size_t)L * PW * DM + (size_t)2088 * DM); for (int i = F.tid; i < (PW - 2088) * DM / 8; i += NTHR) z[i] = (u32x4){0u, 0u, 0u, 0u}; }
        else pro_transposes(F, a, it - PI_B_TR);
    }
}

__device__ __forceinline__ void p_norm1(Frame& F, const Args& a, int L) {
    const int gw = F.bid * NWAVES + F.wave, NGW = F.G * NWAVES;
    float* XS = (float*)(F.ws + WS_XS); bf16* H = (bf16*)(F.ws + WS_H);
    const float* mod = (const float*)(F.ws + WS_MOD) + (size_t)L * 9 * 6144; const float* modp = mod - 9 * 6144;
    const int* PS = (const int*)(F.ws + WS_PS); const bf16* Y = (const bf16*)(F.ws + WS_Y);
    const float* g = a.in[I_NMG] + L * DM;
    f32x4 gv[4];
#pragma unroll
    for (int j = 0; j < 4; ++j) gv[j] = *(const f32x4*)(g + 4 * F.lane + 256 * j);
    for (int row = gw; row < NT; row += NGW) {
        const int bi = row < NLAT ? (row >> 12) : 8;
        f32x4 v[4];
        if (L == 0) { const float* src = row < NLAT ? a.in[I_X] + (size_t)row * DM : a.in[I_CTX] + (size_t)(row - NLAT) * DM;
#pragma unroll
            for (int j = 0; j < 4; ++j) v[j] = *(const f32x4*)(src + 4 * F.lane + 256 * j);
        } else {
            float* xr = XS + (size_t)row * DM;
#pragma unroll
            for (int j = 0; j < 4; ++j) v[j] = *(const f32x4*)(xr + 4 * F.lane + 256 * j);
            f32x4 s[4];
#pragma unroll
            for (int j = 0; j < 4; ++j) s[j] = (f32x4){0.f, 0.f, 0.f, 0.f};
#pragma unroll
            for (int k = 0; k < 4; ++k) { const int slot = PS[row * 4 + k]; const bf16* yr = Y + (size_t)slot * DM;
#pragma unroll
                for (int j = 0; j < 4; ++j) { const u32x2 w = *(const u32x2*)(yr + 4 * F.lane + 256 * j); s[j] += (f32x4){bflo(w.x), bfhi(w.x), bflo(w.y), bfhi(w.y)}; } }
            const float* m5 = modp + (size_t)bi * 6144 + 5 * 1024;
#pragma unroll
            for (int j = 0; j < 4; ++j) { v[j] += *(const f32x4*)(m5 + 4 * F.lane + 256 * j) * s[j]; *(f32x4*)(xr + 4 * F.lane + 256 * j) = v[j]; }
        }
        float ss = 0.f;
#pragma unroll
        for (int j = 0; j < 4; ++j) ss += v[j][0] * v[j][0] + v[j][1] * v[j][1] + v[j][2] * v[j][2] + v[j][3] * v[j][3];
        const float rs = rsqrtf(wave_sum(ss, F.lane) * (1.f / DM) + 1e-6f);
        const float* sh = mod + (size_t)bi * 6144, *sc = sh + 1024;
        bf16* hr = H + (size_t)row * DM;
#pragma unroll
        for (int j = 0; j < 4; ++j) { const f32x4 s4 = *(const f32x4*)(sc + 4 * F.lane + 256 * j), h4 = *(const f32x4*)(sh + 4 * F.lane + 256 * j);
            const f32x4 o = v[j] * rs * gv[j] * (s4 + 1.f) + h4; u32x2 w; w.x = pk2(o[0], o[1]); w.y = pk2(o[2], o[3]); *(u32x2*)(hr + 4 * F.lane + 256 * j) = w; }
    }
}
__device__ __forceinline__ void p_norm2(Frame& F, const Args& a, int L, int nrows) {
    LAS float* rwt = (LAS float*)F.lds;
    const float* rw = a.in[I_RW] + (size_t)L * DM * NEXP;
    for (int i = F.tid; i < DM * NEXP; i += NTHR) { const int k = i >> 5, e = i & 31; rwt[e * 1024 + k] = rw[i]; }
    __syncthreads();
    const int gw = F.bid * NWAVES + F.wave, NGW = F.G * NWAVES;
    const float* XS = (const float*)(F.ws + WS_XS); bf16* H = (bf16*)(F.ws + WS_H);
    const float* mod = (const float*)(F.ws + WS_MOD) + (size_t)L * 9 * 6144;
    int* PE = (int*)(F.ws + WS_PE); int* PR = (int*)(F.ws + WS_PR); float* PG = (float*)(F.ws + WS_PG);
    unsigned* cnt = F.ctl + CW_CNT + L * 64;
    const float* g = a.in[I_NFG] + L * DM;
    const float rb = a.in[I_RB][L * NEXP + (F.lane >> 1)];
    f32x4 gv[4];
#pragma unroll
    for (int j = 0; j < 4; ++j) gv[j] = *(const f32x4*)(g + 4 * F.lane + 256 * j);
    for (int row = gw; row < nrows; row += NGW) {
        const int bi = row < NLAT ? (row >> 12) : 8;
        const float* xr = XS + (size_t)row * DM;
        f32x4 v[4]; float ss = 0.f;
#pragma unroll
        for (int j = 0; j < 4; ++j) { v[j] = *(const f32x4*)(xr + 4 * F.lane + 256 * j); ss += v[j][0] * v[j][0] + v[j][1] * v[j][1] + v[j][2] * v[j][2] + v[j][3] * v[j][3]; }
        const float rs = rsqrtf(wave_sum(ss, F.lane) * (1.f / DM) + 1e-6f);
        const float* sh = mod + (size_t)bi * 6144 + 3 * 1024, *sc = sh + 1024;
        bf16* hr = H + (size_t)row * DM;
#pragma unroll
        for (int j = 0; j < 4; ++j) { const f32x4 s4 = *(const f32x4*)(sc + 4 * F.lane + 256 * j), h4 = *(const f32x4*)(sh + 4 * F.lane + 256 * j);
            v[j] = v[j] * rs * gv[j] * (s4 + 1.f) + h4; u32x2 w; w.x = pk2(v[j][0], v[j][1]); w.y = pk2(v[j][2], v[j][3]); *(u32x2*)(hr + 4 * F.lane + 256 * j) = w; }
        float p[32];
#pragma unroll
        for (int e = 0; e < 32; ++e) { float s = 0.f;
#pragma unroll
            for (int j = 0; j < 4; ++j) { const f32x4 w4 = *(const LAS f32x4*)(rwt + e * 1024 + 4 * F.lane + 256 * j); s += v[j][0] * w4[0] + v[j][1] * w4[1] + v[j][2] * w4[2] + v[j][3] * w4[3]; }
            p[e] = s; if ((e & 3) == 3) asm volatile("" : "+v"(p[e]), "+v"(p[e - 1]), "+v"(p[e - 2]), "+v"(p[e - 3]) :: "memory"); }
#define RED_LEVEL(NKEEP, BIT, XCH) { const bool hi = (F.lane & (BIT)) != 0; _Pragma("unroll") for (int e = 0; e < (NKEEP); ++e) { const float send = hi ? p[e] : p[e + (NKEEP)], keep = hi ? p[e + (NKEEP)] : p[e]; p[e] = keep + XCH; } }
        RED_LEVEL(16, 32, xor32f(send, F.lane)) RED_LEVEL(8, 16, swz_xor<16>(send)) RED_LEVEL(4, 8, swz_xor<8>(send)) RED_LEVEL(2, 4, swz_xor<4>(send)) RED_LEVEL(1, 2, swz_xor<2>(send))
#undef RED_LEVEL
        float logit = p[0] + swz_xor<1>(p[0]) + rb;
        int es[4]; float ls[4];
#pragma unroll
        for (int k = 0; k < 4; ++k) {
            const float m = wave_max(logit, F.lane);
            const unsigned long long bal = __ballot(logit == m);
            const int fl = __builtin_ctzll(bal); es[k] = fl >> 1; ls[k] = m;
            if ((F.lane >> 1) == es[k]) logit = -3.0e38f;
        }
        const float e1 = __expf(ls[1] - ls[0]), e2 = __expf(ls[2] - ls[0]), e3 = __expf(ls[3] - ls[0]); const float inv = 1.f / (1.f + e1 + e2 + e3);
        if (F.lane < 4) {
            const int e = F.lane == 0 ? es[0] : (F.lane == 1 ? es[1] : (F.lane == 2 ? es[2] : es[3]));
            const float gt = (F.lane == 0 ? 1.f : (F.lane == 1 ? e1 : (F.lane == 2 ? e2 : e3))) * inv;
            const unsigned rk = __hip_atomic_fetch_add(cnt + e, 1u, RLX_AGENT);
            PE[row * 4 + F.lane] = e; PR[row * 4 + F.lane] = (int)rk; PG[row * 4 + F.lane] = gt;
        }
    }
    __syncthreads();
}
__device__ __forceinline__ void p_dispatch(Frame& F, int L, int nrows) {
    LAS int* base = (LAS int*)F.lds;
    unsigned* cnt = F.ctl + CW_CNT + L * 64; unsigned* blke = F.ctl + CW_BLKE + L * 1024;
    if (F.tid == 0) { int acc = 0; for (int e = 0; e < NEXP; ++e) { base[e] = acc; const int c = (int)__hip_atomic_load(cnt + e, RLX_AGENT); acc += (c + 255) & ~255; } base[32] = acc; }
    __syncthreads();
    if (F.bid == 0) { const int nblk = base[32] >> 8; if (F.tid == 0) blke[0] = (unsigned)nblk;
        for (int i = F.tid; i < nblk; i += NTHR) { int e = 0; for (int q = 1; q < NEXP; ++q) if (base[q] <= i * 256) e = q; blke[1 + i] = (unsigned)e; } }
    const int gw = F.bid * NWAVES + F.wave, NGW = F.G * NWAVES;
    const int* PE = (const int*)(F.ws + WS_PE); const int* PR = (const int*)(F.ws + WS_PR); const float* PG = (const float*)(F.ws + WS_PG);
    int* PS = (int*)(F.ws + WS_PS); float* SG = (float*)(F.ws + WS_SG);
    const bf16* H = (const bf16*)(F.ws + WS_H); bf16* BUF = (bf16*)(F.ws + WS_BUF);
    for (int pr = gw; pr < nrows * 4; pr += NGW) {
        const int e = PE[pr], slot = base[e] + PR[pr];
        const u32x4* src = (const u32x4*)(H + (size_t)(pr >> 2) * DM); u32x4* dst = (u32x4*)(BUF + (size_t)slot * DM);
        const u32x4 v0 = src[F.lane], v1 = src[64 + F.lane]; dst[F.lane] = v0; dst[64 + F.lane] = v1;
        if (F.lane == 0) { PS[pr] = slot; SG[slot] = PG[pr]; }
    }
    __syncthreads();
}
__device__ __forceinline__ void p_final(Frame& F, const Args& a) {
    const int gw = F.bid * NWAVES + F.wave, NGW = F.G * NWAVES;
    const float* XS = (const float*)(F.ws + WS_XS);
    const float* modp = (const float*)(F.ws + WS_MOD) + (size_t)(DEPTH - 1) * 9 * 6144;
    const int* PS = (const int*)(F.ws + WS_PS); const bf16* Y = (const bf16*)(F.ws + WS_Y);
    const float* g = a.in[I_FING];
    f32x4 gv[4];
#pragma unroll
    for (int j = 0; j < 4; ++j) gv[j] = *(const f32x4*)(g + 4 * F.lane + 256 * j);
    for (int row = gw; row < NLAT; row += NGW) {
        const int bi = row >> 12;
        const float* xr = XS + (size_t)row * DM;
        f32x4 v[4], s[4];
#pragma unroll
        for (int j = 0; j < 4; ++j) { v[j] = *(const f32x4*)(xr + 4 * F.lane + 256 * j); s[j] = (f32x4){0.f, 0.f, 0.f, 0.f}; }
#pragma unroll
        for (int k = 0; k < 4; ++k) { const int slot = PS[row * 4 + k]; const bf16* yr = Y + (size_t)slot * DM;
#pragma unroll
            for (int j = 0; j < 4; ++j) { const u32x2 w = *(const u32x2*)(yr + 4 * F.lane + 256 * j); s[j] += (f32x4){bflo(w.x), bfhi(w.x), bflo(w.y), bfhi(w.y)}; } }
        const float* m5 = modp + (size_t)bi * 6144 + 5 * 1024;
        float ss = 0.f;
#pragma unroll
        for (int j = 0; j < 4; ++j) { v[j] += *(const f32x4*)(m5 + 4 * F.lane + 256 * j) * s[j]; ss += v[j][0] * v[j][0] + v[j][1] * v[j][1] + v[j][2] * v[j][2] + v[j][3] * v[j][3]; }
        const float rs = rsqrtf(wave_sum(ss, F.lane) * (1.f / DM) + 1e-6f);
        float* orow = a.out + (size_t)row * DM;
#pragma unroll
        for (int j = 0; j < 4; ++j) *(f32x4*)(orow + 4 * F.lane + 256 * j) = v[j] * rs * gv[j];
    }
}

#define MFMA16(a, b, c) __builtin_amdgcn_mfma_f32_16x16x32_bf16((a), (b), (c), 0, 0, 0)
typedef short v4i16_t __attribute__((ext_vector_type(4)));
__device__ __forceinline__ s16x4 trread(const LAS void* p) { return __builtin_bit_cast(s16x4, __builtin_amdgcn_ds_read_tr16_b64_v4i16((LAS v4i16_t*)p)); }
__device__ __forceinline__ bf16x8 cat8(s16x4 a, s16x4 b) { return __builtin_shufflevector(a, b, 0, 1, 2, 3, 4, 5, 6, 7); }
__device__ __forceinline__ bf16x8 pack8(const float* v) { u32x4 w; w.x = pg8::cvt_pk_bf16(v[0], v[1]); w.y = pg8::cvt_pk_bf16(v[2], v[3]); w.z = pg8::cvt_pk_bf16(v[4], v[5]); w.w = pg8::cvt_pk_bf16(v[6], v[7]); return __builtin_bit_cast(bf16x8, w); }
__device__ __forceinline__ void unpack8(bf16x8 x, float* v) { const u32x4 w = __builtin_bit_cast(u32x4, x); v[0] = bflo(w.x); v[1] = bfhi(w.x); v[2] = bflo(w.y); v[3] = bfhi(w.y); v[4] = bflo(w.z); v[5] = bfhi(w.z); v[6] = bflo(w.w); v[7] = bfhi(w.w); }
#define OPQ(x) ({ int o_ = (x); asm volatile("" : "+s"(o_)); o_; })
#define LAUNDER_F(F0) Frame F = F0; { int t_ = threadIdx.x; asm volatile("" : "+v"(t_)); F.tid = t_; F.lane = t_ & 63; F.wave = __builtin_amdgcn_readfirstlane(t_ >> 6); }
__device__ __forceinline__ int chunk_tok0(int cid) { return cid < 512 ? cid * 64 : NLAT + (cid - 512) * 64; }

constexpr int GL_QS = 136, GL_VS = 264, GL_BS = 260;
constexpr int GL_Q = 0, GL_K = GL_Q + 64 * GL_QS * 2, GL_V = GL_K + 64 * GL_QS * 2, GL_A1 = GL_V + 64 * GL_VS * 2, GL_B = GL_A1 + 64 * 32 * 2, GL_END = GL_B + 64 * GL_BS * 4;
static_assert(GL_END <= MISC_OFF, "GLA LDS");
template <bool OUT> __device__ __forceinline__ void gla_chunk(Frame& F0, const Args& a, int L, int cid) {
    LAUNDER_F(F0)
    const int tok0 = chunk_tok0(cid);
    const bf16* P = (const bf16*)(F.ws + WS_PBUF) + (size_t)tok0 * PW;
    LAS bf16* sq = (LAS bf16*)(F.lds + GL_Q); LAS bf16* sk = (LAS bf16*)(F.lds + GL_K); LAS bf16* sv = (LAS bf16*)(F.lds + GL_V); LAS bf16* sa1 = (LAS bf16*)(F.lds + GL_A1); LAS float* sB = (LAS float*)(F.lds + GL_B);
    __syncthreads();
    for (int i = F.tid; i < 1024; i += NTHR) { const int t = i >> 4, pc = i & 15; *(LAS u32x4*)(sq + t * GL_QS + pc * 8) = *(const u32x4*)(P + (size_t)t * PW + PC_Q + pc * 8); *(LAS u32x4*)(sk + t * GL_QS + pc * 8) = *(const u32x4*)(P + (size_t)t * PW + PC_K + pc * 8); }
    for (int i = F.tid; i < 2048; i += NTHR) { const int t = i >> 5, pc = i & 31; *(LAS u32x4*)(sv + t * GL_VS + pc * 8) = *(const u32x4*)(P + (size_t)t * PW + PC_V + pc * 8); }
    if (F.tid < 256) { const int t = F.tid >> 2, pc = F.tid & 3; *(LAS u32x4*)(sa1 + t * 32 + pc * 8) = *(const u32x4*)(P + (size_t)t * PW + PC_A1 + pc * 8); }
    __syncthreads();
    {
        const int col = F.tid & 255, r = col >> 7, c = col & 127, th = F.tid >> 8;
        float a2v[16];
#pragma unroll
        for (int i = 0; i < 16; ++i) a2v[i] = a.in[I_GLAA2][((size_t)(L * 2 + r) * 16 + i) * 128 + c];
        const float ab = a.in[I_GLAAB][(L * 2 + r) * 128 + c];
        for (int i = 0; i < 32; ++i) { const int t = th * 32 + i; float z = ab; float av[8];
            unpack8(*(const LAS bf16x8*)(sa1 + t * 32 + r * 16), av);
#pragma unroll
            for (int q = 0; q < 8; ++q) z += av[q] * a2v[q];
            unpack8(*(const LAS bf16x8*)(sa1 + t * 32 + r * 16 + 8), av);
#pragma unroll
            for (int q = 0; q < 8; ++q) z += av[q] * a2v[8 + q];
            const float ls = fminf(z, 0.f) - __logf(1.f + __expf(-fabsf(z)));
            sB[t * GL_BS + col] = ls * (1.f / 16.f); }
    }
    __syncthreads();
    if (F.tid < 256) { const int col = F.tid, r = col >> 7; float b = 0.f;
        for (int i = 0; i < 64; ++i) { const int t = r ? 63 - i : i; b += sB[t * GL_BS + col]; sB[t * GL_BS + col] = b; } }
    __syncthreads();
    const int hh = F.wave & 3, r = F.wave >> 2, lr = F.lane & 15, g = F.lane >> 4;
    const int bc = r * 128 + hh * 32;
    const size_t ub = ((size_t)cid * 4 + hh) * 2 + r;
    if constexpr (!OUT) {
        const int tl = r ? 0 : 63;
        f32x4 acc[2][4];
#pragma unroll
        for (int mc = 0; mc < 2; ++mc)
#pragma unroll
            for (int d = 0; d < 4; ++d) acc[mc][d] = (f32x4){0.f, 0.f, 0.f, 0.f};
#pragma unroll
        for (int sg = 0; sg < 2; ++sg) {
            bf16x8 vf[4];
#pragma unroll
            for (int d = 0; d < 4; ++d) { const LAS bf16* p0 = sv + (32 * sg + 8 * g + ((F.lane & 15) >> 2)) * GL_VS + hh * 64 + 16 * d + 4 * (F.lane & 3); vf[d] = cat8(trread(p0), trread(p0 + 4 * GL_VS)); }
#pragma unroll
            for (int mc = 0; mc < 2; ++mc) {
                const LAS bf16* p0 = sk + (32 * sg + 8 * g + ((F.lane & 15) >> 2)) * GL_QS + hh * 32 + 16 * mc + 4 * (F.lane & 3);
                const s16x4 k0 = trread(p0), k1 = trread(p0 + 4 * GL_QS);
                const int c = 16 * mc + lr; const float bl = sB[tl * GL_BS + bc + c];
                float kv[8];
#pragma unroll
                for (int e = 0; e < 4; ++e) { kv[e] = bf2f((unsigned short)k0[e]) * __expf(bl - sB[(32 * sg + 8 * g + e) * GL_BS + bc + c]); kv[4 + e] = bf2f((unsigned short)k1[e]) * __expf(bl - sB[(32 * sg + 8 * g + 4 + e) * GL_BS + bc + c]); }
                const bf16x8 kf = pack8(kv);
#pragma unroll
                for (int d = 0; d < 4; ++d) acc[mc][d] = MFMA16(kf, vf[d], acc[mc][d]);
            }
        }
        float* ds = (float*)(F.ws + WS_GDS) + ub * 2048;
#pragma unroll
        for (int mc = 0; mc < 2; ++mc)
#pragma unroll
            for (int d = 0; d < 4; ++d) *(f32x4*)(ds + (16 * d + lr) * 32 + 16 * mc + 4 * g) = acc[mc][d];
        if (F.lane < 32) ((float*)(F.ws + WS_GDEC))[ub * 32 + F.lane] = __expf(sB[tl * GL_BS + bc + F.lane]);
    } else {
        bf16x8 qf[4], kf[4];
#pragma unroll
        for (int m = 0; m < 4; ++m) { const int t = 16 * m + lr; float qv[8], kv[8], bv[8];
            unpack8(*(const LAS bf16x8*)(sq + t * GL_QS + hh * 32 + 8 * g), qv); unpack8(*(const LAS bf16x8*)(sk + t * GL_QS + hh * 32 + 8 * g), kv);
            *(f32x4*)bv = *(const LAS f32x4*)(sB + t * GL_BS + bc + 8 * g); *(f32x4*)(bv + 4) = *(const LAS f32x4*)(sB + t * GL_BS + bc + 8 * g + 4);
#pragma unroll
            for (int e = 0; e < 8; ++e) { const float ex = __expf(bv[e]); qv[e] *= 0.17677669529663687f * ex; kv[e] *= __frcp_rn(ex); }
            qf[m] = pack8(qv); kf[m] = pack8(kv); }
        f32x4 o[4][4];
#pragma unroll
        for (int m = 0; m < 4; ++m)
#pragma unroll
            for (int d = 0; d < 4; ++d) o[m][d] = (f32x4){0.f, 0.f, 0.f, 0.f};
        {
            const bf16* se = (const bf16*)(F.ws + WS_GSE) + ub * 2048;
#pragma unroll
            for (int d = 0; d < 4; ++d) { const bf16x8 sf = *(const bf16x8*)(se + (16 * d + lr) * 32 + 8 * g);
#pragma unroll
                for (int m = 0; m < 4; ++m) o[m][d] = MFMA16(qf[m], sf, o[m][d]); }
        }
        bf16x8 vf[2][4];
#pragma unroll
        for (int sg = 0; sg < 2; ++sg)
#pragma unroll
            for (int d = 0; d < 4; ++d) { const LAS bf16* p0 = sv + (32 * sg + 4 * g + ((F.lane & 15) >> 2)) * GL_VS + hh * 64 + 16 * d + 4 * (F.lane & 3); vf[sg][d] = cat8(trread(p0), trread(p0 + 16 * GL_VS)); }
        const f32x4 zero4 = (f32x4){0.f, 0.f, 0.f, 0.f};
#pragma unroll
        for (int m = 0; m < 4; ++m) {
            const int t = 16 * m + lr;
#pragma unroll
            for (int sg = 0; sg < 2; ++sg) {
                f32x4 p0 = MFMA16(kf[2 * sg], qf[m], zero4), p1 = MFMA16(kf[2 * sg + 1], qf[m], zero4);
                float pv[8];
#pragma unroll
                for (int j = 0; j < 4; ++j) { const int s0 = 32 * sg + 4 * g + j, s1 = s0 + 16; pv[j] = (r ? s0 >= t : s0 <= t) ? p0[j] : 0.f; pv[4 + j] = (r ? s1 >= t : s1 <= t) ? p1[j] : 0.f; }
                const bf16x8 pf = pack8(pv);
#pragma unroll
                for (int d = 0; d < 4; ++d) o[m][d] = MFMA16(pf, vf[sg][d], o[m][d]);
            }
        }
        __syncthreads();
        LAS float* ox = (LAS float*)(F.lds + GL_B);
        LAS bf16* ot = (LAS bf16*)(F.lds + GL_Q);
        if (r == 1) {
#pragma unroll
            for (int m = 0; m < 4; ++m)
#pragma unroll
                for (int d = 0; d < 4; ++d)
#pragma unroll
                    for (int j = 0; j < 4; ++j) ox[(hh * 64 + 16 * m + 4 * g + j) * 65 + 16 * d + lr] = o[m][d][j];
        }
        __syncthreads();
        if (r == 0) {
            const float* ng = a.in[I_GLANG] + L * 64;
            float gn[4];
#pragma unroll
            for (int d = 0; d < 4; ++d) gn[d] = ng[16 * d + lr];
#pragma unroll
            for (int m = 0; m < 4; ++m)
#pragma unroll
                for (int j = 0; j < 4; ++j) {
                    const int t = 16 * m + 4 * g + j; float v[4], ss = 0.f;
#pragma unroll
                    for (int d = 0; d < 4; ++d) { v[d] = o[m][d][j] + ox[(hh * 64 + t) * 65 + 16 * d + lr]; ss += v[d] * v[d]; }
                    ss += swz_xor<1>(ss); ss += swz_xor<2>(ss); ss += swz_xor<4>(ss); ss += swz_xor<8>(ss);
                    const float rs = rsqrtf(ss * (1.f / 64.f) + 1e-6f);
#pragma unroll
                    for (int d = 0; d < 4; ++d) { const float rg = bf2f(P[(size_t)t * PW + PC_R + hh * 64 + 16 * d + lr]); ot[t * 264 + hh * 64 + 16 * d + lr] = (bf16)f2bf(v[d] * rs * gn[d] * siluf_(rg)); }
                    asm volatile("" ::: "memory");
                }
        }
        __syncthreads();
        bf16* MX = (bf16*)(F.ws + WS_MIX) + (size_t)tok0 * MW + 768;
        for (int i = F.tid; i < 2048; i += NTHR) { const int t = i >> 5, pc = i & 31; *(u32x4*)(MX + (size_t)t * MW + pc * 8) = *(const LAS u32x4*)(ot + t * 264 + pc * 8); }
    }
}

constexpr int SD_RS = 520;
constexpr int SD_RAW = 0, SD_XC = SD_RAW + 68 * SD_RS * 2, SD_DT = SD_XC + 64 * SD_RS * 2, SD_CUM = SD_DT + 64 * 8 * 4, SD_W = SD_CUM + 8 * 64 * 4, SD_END = SD_W + 8 * 64 * 4;
static_assert(SD_END <= MISC_OFF && 64 * 260 * 4 <= 68 * SD_RS * 2, "SSD LDS");
template <bool OUT> __device__ __forceinline__ void ssd_chunk(Frame& F0, const Args& a, int L, int cid) {
    LAUNDER_F(F0)
    const int tok0 = chunk_tok0(cid);
    const bf16* PB = (const bf16*)(F.ws + WS_PBUF);
    LAS bf16* raw = (LAS bf16*)(F.lds + SD_RAW); LAS bf16* xc = (LAS bf16*)(F.lds + SD_XC); LAS float* sdt = (LAS float*)(F.lds + SD_DT); LAS float* scum = (LAS float*)(F.lds + SD_CUM); LAS float* sw = (LAS float*)(F.lds + SD_W);
    __syncthreads();
    {
        const int isctx = cid >= 512, c4 = (cid - 512) & 3;
        for (int i = F.tid; i < 68 * 64; i += NTHR) { const int rr = i >> 6, pc = i & 63, t = rr - 2; u32x4 v = (u32x4){0u, 0u, 0u, 0u};
            bool ok = t >= 0 && t < 64; if (isctx) { const int tt = c4 * 64 + t; ok = tt >= 0 && tt < 256; }
            if (ok) v = *(const u32x4*)(PB + (size_t)(tok0 + t) * PW + PC_XBC + pc * 8);
            *(LAS u32x4*)(raw + rr * SD_RS + pc * 8) = v; }
        if (F.tid < 64) { float dv[8]; unpack8(*(const bf16x8*)(PB + (size_t)(tok0 + F.tid) * PW + PC_DT), dv);
#pragma unroll
            for (int q = 0; q < 8; ++q) { const float z = dv[q] + a.in[I_SSDDTB][L * 8 + q]; sdt[F.tid * 8 + q] = z > 20.f ? z : __logf(1.f + __expf(z)); } }
    }
    __syncthreads();
    {
        const int ch = F.tid; float w[5];
#pragma unroll
        for (int k = 0; k < 5; ++k) w[k] = a.in[I_SSDCW][((size_t)L * 5 + k) * 512 + ch];
        const float cb = a.in[I_SSDCB][L * 512 + ch];
        float x0 = bf2f(raw[0 * SD_RS + ch]), x1 = bf2f(raw[1 * SD_RS + ch]), x2 = bf2f(raw[2 * SD_RS + ch]), x3 = bf2f(raw[3 * SD_RS + ch]);
        for (int t = 0; t < 64; ++t) { const float x4 = bf2f(raw[(t + 4) * SD_RS + ch]); const float y = cb + w[0] * x0 + w[1] * x1 + w[2] * x2 + w[3] * x3 + w[4] * x4;
            xc[t * SD_RS + ch] = (bf16)f2bf(siluf_(y)); x0 = x1; x1 = x2; x2 = x3; x3 = x4; }
        if (F.tid < 8) { const int rr = F.tid >> 2; const float aa = -__expf(a.in[I_SSDALOG][L * 8 + F.tid]); float c = 0.f;
            for (int i = 0; i < 64; ++i) { const int t = rr ? 63 - i : i; c += sdt[t * 8 + F.tid] * aa; scum[F.tid * 64 + t] = c; }
            const float cl = c;
            for (int t = 0; t < 64; ++t) sw[F.tid * 64 + t] = __expf(cl - scum[F.tid * 64 + t]) * sdt[t * 8 + F.tid]; }
    }
    __syncthreads();
    const int h = F.wave & 3, r = F.wave >> 2, lr = F.lane & 15, g = F.lane >> 4, gp = h >> 1, rh = r * 4 + h;
    const size_t ub = ((size_t)cid * 4 + h) * 2 + r;
    if constexpr (!OUT) {
        f32x4 acc[4][4];
#pragma unroll
        for (int ms = 0; ms < 4; ++ms)
#pragma unroll
            for (int d = 0; d < 4; ++d) acc[ms][d] = (f32x4){0.f, 0.f, 0.f, 0.f};
#pragma unroll
        for (int sg = 0; sg < 2; ++sg) {
            const int trow = 32 * sg + 8 * g;
            bf16x8 xf[4];
#pragma unroll
            for (int d = 0; d < 4; ++d) { const LAS bf16* p0 = xc + (trow + ((F.lane & 15) >> 2)) * SD_RS + h * 64 + 16 * d + 4 * (F.lane & 3); xf[d] = cat8(trread(p0), trread(p0 + 4 * SD_RS)); }
            float wv[8];
            *(f32x4*)wv = *(const LAS f32x4*)(sw + rh * 64 + trow); *(f32x4*)(wv + 4) = *(const LAS f32x4*)(sw + rh * 64 + trow + 4);
#pragma unroll
            for (int ms = 0; ms < 4; ++ms) {
                const LAS bf16* p0 = xc + (trow + ((F.lane & 15) >> 2)) * SD_RS + 256 + gp * 64 + 16 * ms + 4 * (F.lane & 3);
                const s16x4 b0 = trread(p0), b1 = trread(p0 + 4 * SD_RS);
                float bv[8];
#pragma unroll
                for (int e = 0; e < 4; ++e) { bv[e] = bf2f((unsigned short)b0[e]) * wv[e]; bv[4 + e] = bf2f((unsigned short)b1[e]) * wv[4 + e]; }
                const bf16x8 bf = pack8(bv);
#pragma unroll
                for (int d = 0; d < 4; ++d) acc[ms][d] = MFMA16(bf, xf[d], acc[ms][d]);
            }
        }
        float* ds = (float*)(F.ws + WS_SDS) + ub * 4096;
#pragma unroll
        for (int ms = 0; ms < 4; ++ms)
#pragma unroll
            for (int d = 0; d < 4; ++d) *(f32x4*)(ds + (16 * d + lr) * 64 + 16 * ms + 4 * g) = acc[ms][d];
        if (F.lane == 0) ((float*)(F.ws + WS_SDEC))[ub] = __expf(scum[rh * 64 + (r ? 0 : 63)]);
    } else {
        bf16x8 bfr[4][2], cfr[4][2];
#pragma unroll
        for (int m = 0; m < 4; ++m)
#pragma unroll
            for (int ks = 0; ks < 2; ++ks) { bfr[m][ks] = *(const LAS bf16x8*)(xc + (16 * m + lr) * SD_RS + 256 + gp * 64 + 32 * ks + 8 * g); cfr[m][ks] = *(const LAS bf16x8*)(xc + (16 * m + lr) * SD_RS + 384 + gp * 64 + 32 * ks + 8 * g); }
        f32x4 y[4][4];
#pragma unroll
        for (int m = 0; m < 4; ++m)
#pragma unroll
            for (int d = 0; d < 4; ++d) y[m][d] = (f32x4){0.f, 0.f, 0.f, 0.f};
        {
            const bf16* se = (const bf16*)(F.ws + WS_SSE) + ub * 4096;
            bf16x8 cs[4][2];
#pragma unroll
            for (int m = 0; m < 4; ++m) { const float ec = __expf(scum[rh * 64 + 16 * m + lr]);
#pragma unroll
                for (int ks = 0; ks < 2; ++ks) { float cv[8]; unpack8(cfr[m][ks], cv);
#pragma unroll
                    for (int e = 0; e < 8; ++e) cv[e] *= ec;
                    cs[m][ks] = pack8(cv); } }
#pragma unroll
            for (int d = 0; d < 4; ++d) {
                const bf16x8 sf0 = *(const bf16x8*)(se + (16 * d + lr) * 64 + 8 * g), sf1 = *(const bf16x8*)(se + (16 * d + lr) * 64 + 32 + 8 * g);
#pragma unroll
                for (int m = 0; m < 4; ++m) { y[m][d] = MFMA16(cs[m][0], sf0, y[m][d]); y[m][d] = MFMA16(cs[m][1], sf1, y[m][d]); }
            }
        }
        asm volatile("" ::: "memory");
        bf16x8 xf[2][4];
#pragma unroll
        for (int sg = 0; sg < 2; ++sg)
#pragma unroll
            for (int d = 0; d < 4; ++d) { const LAS bf16* p0 = xc + (32 * sg + 4 * g + ((F.lane & 15) >> 2)) * SD_RS + h * 64 + 16 * d + 4 * (F.lane & 3); xf[sg][d] = cat8(trread(p0), trread(p0 + 16 * SD_RS)); }
        const f32x4 zero4 = (f32x4){0.f, 0.f, 0.f, 0.f};
#pragma unroll
        for (int m = 0; m < 4; ++m) {
            const int t = 16 * m + lr; const float ct = scum[rh * 64 + t];
#pragma unroll
            for (int sg = 0; sg < 2; ++sg) {
                f32x4 p0 = MFMA16(bfr[2 * sg][0], cfr[m][0], zero4), p1 = MFMA16(bfr[2 * sg + 1][0], cfr[m][0], zero4);
                p0 = MFMA16(bfr[2 * sg][1], cfr[m][1], p0); p1 = MFMA16(bfr[2 * sg + 1][1], cfr[m][1], p1);
                float pv[8];
#pragma unroll
                for (int j = 0; j < 4; ++j) { const int s0 = 32 * sg + 4 * g + j, s1 = s0 + 16;
                    pv[j] = (r ? s0 >= t : s0 <= t) ? p0[j] * __expf(ct - scum[rh * 64 + s0]) * sdt[s0 * 8 + rh] : 0.f;
                    pv[4 + j] = (r ? s1 >= t : s1 <= t) ? p1[j] * __expf(ct - scum[rh * 64 + s1]) * sdt[s1 * 8 + rh] : 0.f; }
                const bf16x8 pf = pack8(pv);
#pragma unroll
                for (int d = 0; d < 4; ++d) y[m][d] = MFMA16(pf, xf[sg][d], y[m][d]);
            }
        }
        __syncthreads();
        LAS float* yx = (LAS float*)(F.lds + SD_RAW);
        if (r == 1) {
#pragma unroll
            for (int m = 0; m < 4; ++m)
#pragma unroll
                for (int d = 0; d < 4; ++d)
#pragma unroll
                    for (int j = 0; j < 4; ++j) yx[(16 * m + 4 * g + j) * 260 + h * 64 + 16 * d + lr] = y[m][d][j];
        }
        __syncthreads();
        if (r == 0) { const float dsk = a.in[I_SSDD][L * 4 + h];
#pragma unroll
            for (int m = 0; m < 4; ++m)
#pragma unroll
                for (int d = 0; d < 4; ++d)
#pragma unroll
                    for (int j = 0; j < 4; ++j) { const int t = 16 * m + 4 * g + j, c = h * 64 + 16 * d + lr; yx[t * 260 + c] += y[m][d][j] + dsk * bf2f(xc[t * SD_RS + c]); asm volatile("" ::: "memory"); }
        }
        __syncthreads();
        { const int t = F.tid >> 3, c0 = (F.tid & 7) * 32; const bf16* zr = PB + (size_t)(tok0 + t) * PW + PC_Z + c0; const float* ng = a.in[I_SSDNG] + L * 256 + c0;
          float v[32]; float ss = 0.f;
#pragma unroll
          for (int q = 0; q < 4; ++q) { float zv[8]; unpack8(*(const bf16x8*)(zr + 8 * q), zv);
#pragma unroll
              for (int e = 0; e < 8; ++e) { const float u = yx[t * 260 + c0 + 8 * q + e] * siluf_(zv[e]); v[8 * q + e] = u; ss += u * u; } }
          ss += swz_xor<1>(ss); ss += swz_xor<2>(ss); ss += swz_xor<4>(ss);
          const float rs = rsqrtf(ss * (1.f / 256.f) + 1e-6f);
          bf16* MX = (bf16*)(F.ws + WS_MIX) + (size_t)(tok0 + t) * MW + 1024 + c0;
#pragma unroll
          for (int q = 0; q < 4; ++q) { float o8[8];
#pragma unroll
              for (int e = 0; e < 8; ++e) o8[e] = v[8 * q + e] * rs * ng[8 * q + e];
              *(bf16x8*)(MX + 8 * q) = pack8(o8); } }
    }
}

constexpr int FF_XP = 0, FF_TR = FF_XP + 16 * 64 * 16 * 2, FF_TI = FF_TR + 16 * 64 * 16 * 2, FF_END = FF_TI + 16 * 64 * 16 * 2;
__device__ __forceinline__ void fft_unit(Frame& F0, int u) {
    LAUNDER_F(F0)
    const int b = u >> 6, cg = (u >> 2) & 15, kb = u & 3, lr = F.lane & 15, g = F.lane >> 4;
    const bf16* PB = (const bf16*)(F.ws + WS_PBUF) + (size_t)b * SEQ * PW + PC_FU + 16 * cg;
    const bf16* f64 = (const bf16*)(F.ws + WS_TAB + TAB_F64); const float* tw = (const float*)(F.ws + WS_TAB + TAB_TW);
    LAS bf16* xp = (LAS bf16*)(F.lds + FF_XP); LAS bf16* tr = (LAS bf16*)(F.lds + FF_TR); LAS bf16* ti = (LAS bf16*)(F.lds + FF_TI);
    bf16x8 fc1[2], fs1[2];
#pragma unroll
    for (int ks = 0; ks < 2; ++ks) { fc1[ks] = *(const bf16x8*)(f64 + (16 * kb + lr) * 64 + 32 * ks + 8 * g); fs1[ks] = *(const bf16x8*)(f64 + 4096 + (16 * kb + lr) * 64 + 32 * ks + 8 * g); }
    const f32x4 zero4 = (f32x4){0.f, 0.f, 0.f, 0.f};
    for (int pa = 0; pa < 4; ++pa) {
        __syncthreads();
        for (int i = F.tid; i < 2048; i += NTHR) { const int n2l = i >> 7, n1 = (i >> 1) & 63, hf = i & 1;
            *(LAS u32x4*)(xp + (n2l * 64 + n1) * 16 + hf * 8) = *(const u32x4*)(PB + (size_t)(64 * n1 + 16 * pa + n2l) * PW + hf * 8); }
        __syncthreads();
#pragma unroll
        for (int q = 0; q < 2; ++q) {
            const int n2l = 2 * F.wave + q, n2 = 16 * pa + n2l;
            f32x4 tc = zero4, ts = zero4;
#pragma unroll
            for (int ks = 0; ks < 2; ++ks) { const LAS bf16* p0 = xp + (n2l * 64 + 32 * ks + 8 * g + ((F.lane & 15) >> 2)) * 16 + 4 * (F.lane & 3); const bf16x8 xb = cat8(trread(p0), trread(p0 + 4 * 16));
                tc = MFMA16(fc1[ks], xb, tc); ts = MFMA16(fs1[ks], xb, ts); }
#pragma unroll
            for (int j = 0; j < 4; ++j) { const int k1l = 4 * g + j, k1 = 16 * kb + k1l; const f32x2 w = *(const f32x2*)(tw + 2 * (n2 * k1));
                tr[(k1l * 64 + n2) * 16 + lr] = (bf16)f2bf(tc[j] * w[0] - ts[j] * w[1]); ti[(k1l * 64 + n2) * 16 + lr] = (bf16)f2bf(-(tc[j] * w[1] + ts[j] * w[0])); }
        }
    }
    __syncthreads();
    bf16* MX = (bf16*)(F.ws + WS_MIX) + (size_t)b * SEQ * MW + 16 * cg + lr;
#pragma unroll
    for (int q = 0; q < 2; ++q) {
        const int k1l = 2 * F.wave + q, k1 = 16 * kb + k1l;
        bf16x8 br[2], bi[2];
#pragma unroll
        for (int ks = 0; ks < 2; ++ks) { const int off = (k1l * 64 + 32 * ks + 8 * g + ((F.lane & 15) >> 2)) * 16 + 4 * (F.lane & 3); br[ks] = cat8(trread(tr + off), trread(tr + off + 64)); bi[ks] = cat8(trread(ti + off), trread(ti + off + 64)); }
#pragma unroll
        for (int m = 0; m < 4; ++m) {
            f32x4 yr = zero4, y1 = zero4, y2 = zero4;
#pragma unroll
            for (int ks = 0; ks < 2; ++ks) { const bf16x8 fc = *(const bf16x8*)(f64 + (16 * m + lr) * 64 + 32 * ks + 8 * g), fs = *(const bf16x8*)(f64 + 4096 + (16 * m + lr) * 64 + 32 * ks + 8 * g);
                yr = MFMA16(fc, br[ks], yr); yr = MFMA16(fs, bi[ks], yr); y1 = MFMA16(fc, bi[ks], y1); y2 = MFMA16(fs, br[ks], y2); }
#pragma unroll
            for (int j = 0; j < 4; ++j) { const int k2 = 16 * m + 4 * g + j; bf16* o = MX + (size_t)(64 * k2 + k1) * MW; o[0] = (bf16)f2bf(yr[j] * (1.f / 64.f)); o[256] = (bf16)f2bf((y1[j] - y2[j]) * (1.f / 64.f)); }
        }
    }
}
__device__ __forceinline__ void dft_ctx_unit(Frame& F0, int u) {
    LAUNDER_F(F0)
    const int b = u >> 3, kblk = u & 7;
    LAS float* tab = (LAS float*)F.lds;
    __syncthreads();
    if (F.tid < 256) { const f32x2 v = *(const f32x2*)((const float*)(F.ws + WS_TAB + TAB_D256) + 2 * F.tid); tab[2 * F.tid] = v[0]; tab[2 * F.tid + 1] = v[1]; }
    __syncthreads();
    const int c = F.tid & 255, k0 = kblk * 32 + (F.tid >> 8) * 16;
    const bf16* PB = (const bf16*)(F.ws + WS_PBUF) + (size_t)(NLAT + b * CTXL) * PW + PC_FU + c;
    float ar[16], ai[16];
#pragma unroll
    for (int i = 0; i < 16; ++i) { ar[i] = 0.f; ai[i] = 0.f; }
    for (int n = 0; n < 256; ++n) { const float uv = bf2f(PB[(size_t)n * PW]);
#pragma unroll
        for (int i = 0; i < 16; ++i) { const int m = ((k0 + i) * n) & 255; ar[i] += uv * tab[2 * m]; ai[i] -= uv * tab[2 * m + 1]; } }
    bf16* MX = (bf16*)(F.ws + WS_MIX) + (size_t)(NLAT + b * CTXL + k0) * MW + c;
#pragma unroll
    for (int i = 0; i < 16; ++i) { MX[(size_t)i * MW] = (bf16)f2bf(ar[i] * (1.f / 16.f)); MX[(size_t)i * MW + 256] = (bf16)f2bf(ai[i] * (1.f / 16.f)); }
}

__device__ __forceinline__ void p_mix_a(Frame& F, const Args& a, int L) {
    {
        pg8::Gemm g{(const bf16*)(F.ws + WS_A2), (const bf16*)(F.ws + WS_S5P) + (size_t)L * 16 * 256 * 256, 512, 256, OPQ(256)};
        SgOrder<FillS5> S; S.init(144, 1, F.G, F.bid); S.f = FillS5{(size_t)256 * 256 * 2};
        EpiS5S E{(float*)(F.ws + WS_S5S)};
        pg8::gemm_phase(F.lds, g, S, E);
    }
    for (int u = F.bid; u < NCHK; u += F.G) gla_chunk<false>(F, a, L, u);
    for (int u = (F.bid + 32) % F.G; u < NCHK; u += F.G) ssd_chunk<false>(F, a, L, u);
    __syncthreads();
}
__device__ __forceinline__ void p_mix_b(Frame& F, const Args& a, int L) {
    { const int wu = F.wave * F.G + F.bid;
      if (wu < 256) { const int b = wu >> 5, g = (wu >> 1) & 15, r = wu & 1;
          const f32x2 a16 = *(const f32x2*)((const float*)(F.ws + WS_A16) + ((size_t)((L * 2 + r) * 16 + g) * 64 + F.lane) * 2);
          const float* S = (const float*)(F.ws + WS_S5S) + (size_t)g * S5ROWS * 256 + r * 128 + F.lane; bf16* A2 = (bf16*)(F.ws + WS_A2) + (size_t)g * S5ROWS * 512 + 256 + r * 128 + F.lane;
          float hr = 0.f, hi = 0.f;
#pragma unroll 4
          for (int i = 0; i < 272; ++i) { const int row = i < 16 ? 2048 + 16 * b + (r ? 15 - i : i) : 256 * b + (r ? 271 - i : i - 16);
              const float sr = S[(size_t)row * 256], si = S[(size_t)row * 256 + 64];
              A2[(size_t)row * 512] = (bf16)f2bf(hr); A2[(size_t)row * 512 + 64] = (bf16)f2bf(hi);
              const float nr = a16[0] * hr - a16[1] * hi + sr, ni = a16[0] * hi + a16[1] * hr + si; hr = nr; hi = ni; } } }
    for (int u = F.bid; u < 256; u += F.G) { const int sq = u >> 2, b = sq >> 3, hh = (sq >> 1) & 3, r = sq & 1, e = (u & 3) * 512 + F.tid, c = e & 31;
        const float* ds = (const float*)(F.ws + WS_GDS); const float* dc = (const float*)(F.ws + WS_GDEC); bf16* se = (bf16*)(F.ws + WS_GSE);
        float s = 0.f;
#pragma unroll 4
        for (int i = 0; i < 68; ++i) { const int cid = i < 4 ? 512 + b * 4 + (r ? 3 - i : i) : b * 64 + (r ? 67 - i : i - 4); const size_t ub = ((size_t)cid * 4 + hh) * 2 + r;
            se[ub * 2048 + e] = (bf16)f2bf(s); s = dc[ub * 32 + c] * s + ds[ub * 2048 + e]; } }
    for (int u = F.bid; u < 512; u += F.G) { const int sq = u >> 3, b = sq >> 3, h = (sq >> 1) & 3, r = sq & 1, e = (u & 7) * 512 + F.tid;
        const float* ds = (const float*)(F.ws + WS_SDS); const float* dc = (const float*)(F.ws + WS_SDEC); bf16* se = (bf16*)(F.ws + WS_SSE);
        float s = 0.f;
#pragma unroll 4
        for (int i = 0; i < 68; ++i) { const int cid = i < 4 ? 512 + b * 4 + (r ? 3 - i : i) : b * 64 + (r ? 67 - i : i - 4); const size_t ub = ((size_t)cid * 4 + h) * 2 + r;
            se[ub * 4096 + e] = (bf16)f2bf(s); s = dc[ub] * s + ds[ub * 4096 + e]; } }
    for (int u = F.bid; u < 512; u += F.G) fft_unit(F, u);
    for (int u = (F.bid + 64) % F.G; u < 64; u += F.G) dft_ctx_unit(F, u);
    __syncthreads();
}
__device__ __forceinline__ void p_mix_c(Frame& F, const Args& a, int L) {
#ifndef MIXC_PARTS
#define MIXC_PARTS 7
#endif
    if (MIXC_PARTS & 1) {
        pg8::Gemm g{(const bf16*)(F.ws + WS_A2), (const bf16*)(F.ws + WS_S5B2) + (size_t)L * 16 * 256 * 512, 512, 512, OPQ(512)};
        SgOrder<FillS5> S; S.init(144, 1, F.G, F.bid); S.f = FillS5{(size_t)256 * 512 * 2};
        EpiS5Y E{(bf16*)(F.ws + WS_ACT5)};
        pg8::gemm_phase(F.lds, g, S, E);
    }
    const int nch = (L == DEPTH - 1) ? 512 : NCHK;
    if (MIXC_PARTS & 2) for (int u = F.bid; u < nch; u += F.G) gla_chunk<true>(F, a, L, u);
    if (MIXC_PARTS & 4) for (int u = (F.bid + 32) % F.G; u < nch; u += F.G) ssd_chunk<true>(F, a, L, u);
    __syncthreads();
}

constexpr int NPH = 11, PH_TOTAL = 2 + DEPTH * NPH;
#ifndef PHASE_MASK
#define PHASE_MASK 0xFFFF
#endif
#define PM(i) ((PHASE_MASK >> (i)) & 1)
#ifndef MK_ONE_LAUNCH
#define MK_ONE_LAUNCH 0
#endif

__global__ void __launch_bounds__(NTHR, 2) mk_fwd(Args args) {
    extern __shared__ __attribute__((aligned(16))) unsigned char lds_raw[];
    Frame F;
    F.lds = (LAS unsigned char*)lds_raw; F.MISC = (volatile LAS unsigned*)(F.lds + MISC_OFF);
    F.tid = threadIdx.x; F.lane = F.tid & 63; F.wave = __builtin_amdgcn_readfirstlane(F.tid >> 6); F.G = gridDim.x; F.bid = blockIdx.x;
    F.ws = args.ws; F.ctl = (unsigned*)(args.ws + WS_CTL);
    if (F.tid < 64) F.MISC[F.tid] = 0u;
    __syncthreads();
#if MK_ONE_LAUNCH
    XcdBarrier bar = xcd_barrier_post(F.ctl + CW_BAR, F.MISC + 8);
#define GRID_BAR() xcd_barrier(bar)
#else
#define GRID_BAR() do { } while (0)
#endif
    const int lo = args.ph_lo, hi = args.ph_hi;
#define IN(k) (lo <= (k) && (k) < hi)
#define FRESH() do { int t_ = threadIdx.x; asm volatile("" : "+v"(t_)); F.tid = t_; F.lane = t_ & 63; F.wave = __builtin_amdgcn_readfirstlane(t_ >> 6); } while (0)
#define SEAM(k) do { if (IN(k) && IN((k) + 1)) GRID_BAR(); } while (0)
    if (PM(0) && IN(0)) { FRESH(); p_prologue(F, args); } SEAM(0);
    for (int L = 0; L < DEPTH; ++L) {
        const int pb = 1 + L * NPH;
        const int mrows = (L == DEPTH - 1) ? NLAT : NT;
        if (PM(1) && IN(pb + 0)) { FRESH(); p_norm1(F, args, OPQ(L)); } SEAM(pb + 0);
        if (PM(2) && IN(pb + 1)) { const int Lg = OPQ(L);
            pg8::Gemm g{(const bf16*)(F.ws + WS_H), (const bf16*)(F.ws + WS_WIN) + (size_t)Lg * PW * DM, DM, DM, OPQ(DM)};
            SgOrder<FillPlain> S; S.init(NT / 256, PW / 256, F.G, F.bid); S.f = FillPlain{(size_t)256 * DM * 2, (size_t)256 * DM * 2};
            EpiInproj E{(bf16*)(F.ws + WS_PBUF), (bf16*)(F.ws + WS_A2)};
            pg8::gemm_phase(F.lds, g, S, E);
        } SEAM(pb + 1);
#ifndef ABL_NO_MIXERS
        if (PM(3) && IN(pb + 2)) { FRESH(); p_mix_a(F, args, OPQ(L)); } SEAM(pb + 2);
        if (PM(4) && IN(pb + 3)) { FRESH(); p_mix_b(F, args, OPQ(L)); } SEAM(pb + 3);
        if (PM(5) && IN(pb + 4)) { FRESH(); p_mix_c(F, args, OPQ(L)); } SEAM(pb + 4);
        if (PM(6) && IN(pb + 5)) { const int Lg = OPQ(L);
            pg8::Gemm g{(const bf16*)(F.ws + WS_ACT5), (const bf16*)(F.ws + WS_WGLU) + (size_t)Lg * 256 * 256, 256, 256, OPQ(256)};
            SgOrder<FillPlain> S; S.init(NT / 256, 1, F.G, F.bid); S.f = FillPlain{(size_t)256 * 256 * 2, 0};
            EpiGlu E{(const bf16*)(F.ws + WS_ACT5), (bf16*)(F.ws + WS_MIX)};
            pg8::gemm_phase(F.lds, g, S, E);
        } SEAM(pb + 5);
        if (PM(7) && IN(pb + 6)) { const int Lg = OPQ(L);
            pg8::Gemm g{(const bf16*)(F.ws + WS_MIX), (const bf16*)(F.ws + WS_WOUT) + (size_t)Lg * DM * MW, MW, MW, OPQ(MW)};
            SgOrder<FillPlain> S; S.init((Lg == DEPTH - 1 ? NLAT : NT) / 256, DM / 256, F.G, F.bid); S.f = FillPlain{(size_t)256 * MW * 2, (size_t)256 * MW * 2};
            EpiOutproj E{args.in[I_X], args.in[I_CTX], (float*)(F.ws + WS_XS), (const float*)(F.ws + WS_MOD) + (size_t)Lg * 9 * 6144, Lg == 0 ? 1 : 0};
            pg8::gemm_phase(F.lds, g, S, E);
        } SEAM(pb + 6);
#else
        if (IN(pb + 6) && L == 0) {
            const int gw = F.bid * NWAVES + F.wave, NGW = F.G * NWAVES; float* XS = (float*)(F.ws + WS_XS);
            for (int row = gw; row < NT; row += NGW) { const float* src = row < NLAT ? args.in[I_X] + (size_t)row * DM : args.in[I_CTX] + (size_t)(row - NLAT) * DM;
                for (int j = 0; j < 4; ++j) *(f32x4*)(XS + (size_t)row * DM + 4 * F.lane + 256 * j) = *(const f32x4*)(src + 4 * F.lane + 256 * j); }
        } SEAM(pb + 6);
#endif
        if (PM(8) && IN(pb + 7)) { FRESH(); p_norm2(F, args, OPQ(L), OPQ(mrows)); } SEAM(pb + 7);
        if (PM(9) && IN(pb + 8)) { FRESH(); p_dispatch(F, OPQ(L), OPQ(mrows)); } SEAM(pb + 8);
        if (PM(10) && IN(pb + 9)) { const int Lg = OPQ(L);
            const unsigned* blke = F.ctl + CW_BLKE + Lg * 1024; const int nblk = (int)__hip_atomic_load(blke, RLX_AGENT);
            pg8::Gemm g{(const bf16*)(F.ws + WS_BUF), (const bf16*)(F.ws + WS_WGU) + (size_t)Lg * NEXP * 2048 * DM, DM, DM, OPQ(DM)};
            SgOrder<FillMoe> S; S.init(nblk, 8, F.G, F.bid); S.f = FillMoe{blke, 2048};
            EpiSwiglu E{(bf16*)(F.ws + WS_ACT), args.in[I_BGU] + (size_t)Lg * NEXP * 2048};
            pg8::gemm_phase(F.lds, g, S, E);
        } SEAM(pb + 9);
        if (PM(11) && IN(pb + 10)) { const int Lg = OPQ(L);
            const unsigned* blke = F.ctl + CW_BLKE + Lg * 1024; const int nblk = (int)__hip_atomic_load(blke, RLX_AGENT);
            pg8::Gemm g{(const bf16*)(F.ws + WS_ACT), (const bf16*)(F.ws + WS_WDN) + (size_t)Lg * NEXP * DM * DM, DM, DM, OPQ(DM)};
            SgOrder<FillMoe> S; S.init(nblk, 4, F.G, F.bid); S.f = FillMoe{blke, 1024};
            EpiDown E{(bf16*)(F.ws + WS_Y), args.in[I_BDN] + (size_t)Lg * NEXP * DM, (const float*)(F.ws + WS_SG)};
            pg8::gemm_phase(F.lds, g, S, E);
        } SEAM(pb + 10);
    }
    if (PM(12) && IN(PH_TOTAL - 1)) { FRESH(); p_final(F, args); }
#undef IN
#undef SEAM
}

extern "C" void kernel_launch(void* const* d_in, const int* in_sizes, int n_in, void* d_out, int out_size, void* d_ws, size_t ws_size, hipStream_t stream) {
    static int grid = 0;
    if (grid == 0) {
        if (n_in != N_IN || out_size != NLAT * DM || ws_size < WS_END) { fprintf(stderr, "kernel_launch: unexpected shapes (n_in %d, out %d, ws %zu < %zu); nothing launched\n", n_in, out_size, ws_size, (size_t)WS_END); grid = -1; return; }
        int dev = 0, cus = 0, per_cu = 0;
        if (hipGetDevice(&dev) != hipSuccess || hipDeviceGetAttribute(&cus, hipDeviceAttributeMultiprocessorCount, dev) != hipSuccess) { grid = -1; return; }
        if (hipFuncSetAttribute((const void*)mk_fwd, hipFuncAttributeMaxDynamicSharedMemorySize, LDS_BYTES) != hipSuccess) { fprintf(stderr, "kernel_launch: hipFuncSetAttribute failed\n"); grid = -1; return; }
        if (hipOccupancyMaxActiveBlocksPerMultiprocessor(&per_cu, (const void*)mk_fwd, NTHR, LDS_BYTES) != hipSuccess || per_cu < 1) fprintf(stderr, "kernel_launch: occupancy query says %d\n", per_cu);
        (void)hipGetLastError();
        grid = cus;
    }
    if (grid < 0) return;
    (void)hipMemsetAsync((char*)d_ws + WS_CTL, 0, CTL_BYTES, stream);
    Args a{};
    for (int i = 0; i < N_IN; ++i) a.in[i] = (const float*)d_in[i];
    a.out = (float*)d_out; a.ws = (unsigned char*)d_ws;
#if MK_ONE_LAUNCH
    a.ph_lo = 0; a.ph_hi = PH_TOTAL;
    hipLaunchKernelGGL(mk_fwd, dim3(grid), dim3(NTHR), LDS_BYTES, stream, a);
#else
    for (int p = 0; p < PH_TOTAL; ++p) { a.ph_lo = p; a.ph_hi = p + 1; hipLaunchKernelGGL(mk_fwd, dim3(grid), dim3(NTHR), LDS_BYTES, stream, a); }
#endif
}
```

```cpp
#define MK_ONE_LAUNCH 1
#define F8_ALIGN true
#define F8_SP2 true
#include <hip/hip_runtime.h>
#include <cstdio>
#include <cstdint>

#define GAS __attribute__((address_space(1)))
#define LAS __attribute__((address_space(3)))
typedef unsigned short bf16;
typedef short bf16x8 __attribute__((ext_vector_type(8)));
typedef short s16x4 __attribute__((ext_vector_type(4)));
typedef float f32x4 __attribute__((ext_vector_type(4)));
typedef float f32x2 __attribute__((ext_vector_type(2)));
typedef unsigned u32x4 __attribute__((ext_vector_type(4)));
typedef unsigned u32x2 __attribute__((ext_vector_type(2)));

namespace pg8 {
#define PG8_LAS __attribute__((address_space(3)))
typedef unsigned short bf16_t;
constexpr int BM = 256, BK = 64, HALF = 128, HTB = HALF * BK * 2  , STAGE_BYTES = 8 * HTB;

__host__ __device__ __forceinline__ int lds_byte(int r, int c) { const int st = (r >> 4) * 2 + (c >> 5), rr = r & 15, cc = c & 31, ob = rr * 64 + cc * 2; return st * 1024 + (ob ^ (((ob >> 9) & 1) << 5)); }
__host__ __device__ __forceinline__ void stage_rc(int b, int& R, int& C) { const int st = b / 1024, sb = b % 1024, swz = sb ^ (((sb >> 9) & 1) << 5); R = (st >> 1) * 16 + swz / 64; C = (st & 1) * 32 + (swz % 64) / 2; }
__host__ __device__ __forceinline__ int perm32(int rho) { const int n = rho >> 4, i = rho & 15; return 8 * (i >> 2) + 4 * n + (i & 3); }

struct Unit { int pm, pn, grp; size_t aoff, boff; };
struct Gemm { const void* A; const void* Bt; int lda, ldb, K; };

__device__ __forceinline__ unsigned cvt_pk_bf16(float lo, float hi) { unsigned r; asm volatile("v_cvt_pk_bf16_f32 %0, %1, %2" : "=v"(r) : "v"(lo), "v"(hi)); return r; }

typedef int v8i_t __attribute__((ext_vector_type(8)));
typedef int v4i_t __attribute__((ext_vector_type(4)));
template <class Epi, class Sched, bool F8 = false, bool ALIGN_EPI = true, bool SP2 = true>
__device__ __forceinline__ void gemm_phase(PG8_LAS unsigned char* lds, const Gemm g, const Sched& S, const Epi& E, int tid_in) {
    int tid = tid_in; asm volatile("" : "+v"(tid));
    const int wid = __builtin_amdgcn_readfirstlane(tid >> 6), lane = tid & 63, wr = wid >> 2, wc = wid & 3, fr = lane & 15, fq = lane >> 4;
    const int K = g.K, nt = K / BK;
    unsigned voffA[2], voffB[2];
#pragma unroll
    for (int i = 0; i < 2; ++i) { int R, C; stage_rc(tid * 16 + i * 8192, R, C); const int Rb = Epi::PERM ? ((R & ~31) + perm32(R & 31)) : R;
        voffA[i] = (unsigned)(R * g.lda + C * 2); voffB[i] = (unsigned)(Rb * g.ldb + C * 2); }
    const size_t kstep = (size_t)(BK * 2);
    const size_t hstepA = (size_t)HALF * g.lda, hstepB = (size_t)HALF * g.ldb;
    const unsigned ldsw = (unsigned)wid * 1024u;
    const int aoff = F8 ? lds_byte(wr * 64 + fr, fq * 16) : lds_byte(wr * 64 + fr, fq * 8), boff = F8 ? lds_byte(wc * 32 + fr, fq * 16) : lds_byte(wc * 32 + fr, fq * 8);
    const int aoff1 = lds_byte(wr * 64 + fr, fq * 16 + 8), boff1 = lds_byte(wc * 32 + fr, fq * 16 + 8);
#define PG8_SA(b, h) (((b) * 2 + (h)) * HTB)
#define PG8_SB(b, h) ((4 + (b) * 2 + (h)) * HTB)
#define PG8_STAGE(bufoff, gbase, voff) do { _Pragma("unroll") for (int _i = 0; _i < 2; ++_i) \
        __builtin_amdgcn_global_load_lds((const unsigned*)((const char*)(gbase) + (voff)[_i]), (PG8_LAS unsigned*)(lds + (bufoff) + ldsw + _i * 8192), 16, 0, 0); } while (0)
#define PG8_LD16(off) (*(const PG8_LAS v4i_t*)(lds + (off)))
#define PG8_LDA(dst, b, h) do { if constexpr (F8) { _Pragma("unroll") for (int m = 0; m < 4; ++m) A8[m] = __builtin_shufflevector(PG8_LD16(PG8_SA(b, h) + aoff + m * 2048), PG8_LD16(PG8_SA(b, h) + aoff1 + m * 2048), 0, 1, 2, 3, 4, 5, 6, 7); } \
        else { _Pragma("unroll") for (int m = 0; m < 4; ++m) _Pragma("unroll") for (int k = 0; k < 2; ++k) dst[m][k] = *(const PG8_LAS bf16x8*)(lds + PG8_SA(b, h) + aoff + m * 2048 + k * 1024); } } while (0)
#define PG8_LDB(dst, b, h) do { if constexpr (F8) { _Pragma("unroll") for (int n = 0; n < 2; ++n) dst##8[n] = __builtin_shufflevector(PG8_LD16(PG8_SB(b, h) + boff + n * 2048), PG8_LD16(PG8_SB(b, h) + boff1 + n * 2048), 0, 1, 2, 3, 4, 5, 6, 7); } \
        else { _Pragma("unroll") for (int n = 0; n < 2; ++n) _Pragma("unroll") for (int k = 0; k < 2; ++k) dst[n][k] = *(const PG8_LAS bf16x8*)(lds + PG8_SB(b, h) + boff + n * 2048 + k * 1024); } } while (0)
#define PG8_MMA(ai, bj, At, Bt) do { __builtin_amdgcn_s_setprio(1); \
        if constexpr (F8) { _Pragma("unroll") for (int m = 0; m < 4; ++m) _Pragma("unroll") for (int n = 0; n < 2; ++n) \
            asm volatile("v_mfma_scale_f32_16x16x128_f8f6f4 %0, %1, %2, %0, %3, %3 op_sel_hi:[0,0,0]" : "+v"(acc[ai][bj][m][n]) : "v"(Bt##8[n]), "v"(A8[m]), "v"(one_scale)); } \
        else { _Pragma("unroll") for (int m = 0; m < 4; ++m) _Pragma("unroll") for (int n = 0; n < 2; ++n) _Pragma("unroll") for (int k = 0; k < 2; ++k) \
            acc[ai][bj][m][n] = __builtin_amdgcn_mfma_f32_16x16x32_bf16(Bt[n][k], At[m][k], acc[ai][bj][m][n], 0, 0, 0); } \
        __builtin_amdgcn_s_setprio(0); } while (0)
#define PG8_WAIT_V(n) asm volatile("s_waitcnt vmcnt(" #n ")" ::: "memory")
#define PG8_WAIT_L(n) asm volatile("s_waitcnt lgkmcnt(" #n ")" ::: "memory")
#define PG8_BAR __builtin_amdgcn_s_barrier()
#define PG8_SCHED __builtin_amdgcn_sched_barrier(0)
    Unit cur, nxt; int cursor = 0;
    if (!S.next(cursor, cur)) return;
    f32x4 acc[2][2][4][2];
#pragma unroll
    for (int a = 0; a < 2; ++a)
#pragma unroll
        for (int b = 0; b < 2; ++b)
#pragma unroll
            for (int m = 0; m < 4; ++m)
#pragma unroll
                for (int n = 0; n < 2; ++n) acc[a][b][m][n] = (f32x4){0.f, 0.f, 0.f, 0.f};
    bf16x8 At[4][2], B0[2][2], B1[2][2];
    v8i_t A8[4], B08[2], B18[2];
    int one_scale = 0x7F7F7F7F; asm volatile("" : "+v"(one_scale));
    const char* cA = (const char*)g.A + cur.aoff; const char* cB = (const char*)g.Bt + cur.boff;
    if constexpr (SP2) {
        PG8_STAGE(PG8_SB(0, 0), cB, voffB); PG8_STAGE(PG8_SB(0, 1), cB + hstepB, voffB); PG8_STAGE(PG8_SA(0, 0), cA, voffA); PG8_STAGE(PG8_SA(0, 1), cA + hstepA, voffA);
        if (wr == 1) PG8_BAR;
        PG8_WAIT_V(2); PG8_BAR;
        PG8_STAGE(PG8_SB(1, 0), cB + kstep, voffB); PG8_STAGE(PG8_SA(1, 0), cA + kstep, voffA); PG8_STAGE(PG8_SB(1, 1), cB + hstepB + kstep, voffB);
        PG8_WAIT_V(6); PG8_BAR;
    } else {
        PG8_STAGE(PG8_SB(0, 0), cB, voffB); PG8_STAGE(PG8_SA(0, 0), cA, voffA); PG8_STAGE(PG8_SB(0, 1), cB + hstepB, voffB); PG8_STAGE(PG8_SA(0, 1), cA + hstepA, voffA);
        if (wr == 1) PG8_BAR;
        PG8_WAIT_V(4); PG8_BAR;
        PG8_STAGE(PG8_SB(1, 0), cB + kstep, voffB); PG8_STAGE(PG8_SA(1, 0), cA + kstep, voffA); PG8_STAGE(PG8_SB(1, 1), cB + hstepB + kstep, voffB);
        PG8_WAIT_V(6); PG8_BAR;
    }
    for (;;) {
        const bool has_next = S.next(cursor, nxt);
        const char* nA = has_next ? (const char*)g.A + nxt.aoff : cA; const char* nB = has_next ? (const char*)g.Bt + nxt.boff : cB;
        for (int t = 0; t < nt; t += 2) {
            const bool last = (t == nt - 2);
            const char* a1 = cA + (size_t)(t + 1) * kstep;
            const char* a2 = last ? nA : cA + (size_t)(t + 2) * kstep; const char* b2 = last ? nB : cB + (size_t)(t + 2) * kstep;
            const char* a3 = a2 + kstep; const char* b3 = b2 + kstep;
            if constexpr (SP2) {
            PG8_LDB(B0, 0, 0); PG8_LDB(B1, 0, 1); PG8_SCHED; PG8_LDA(At, 0, 0); PG8_STAGE(PG8_SA(1, 1), a1 + hstepA, voffA);
            PG8_WAIT_V(8); PG8_WAIT_L(0); PG8_BAR; PG8_MMA(0, 0, At, B0); PG8_MMA(0, 1, At, B1); PG8_BAR; PG8_SCHED;
            PG8_LDA(At, 0, 1); PG8_STAGE(PG8_SB(0, 0), b2, voffB); PG8_STAGE(PG8_SB(0, 1), b2 + hstepB, voffB); PG8_STAGE(PG8_SA(0, 0), a2, voffA);
            PG8_WAIT_V(8); PG8_WAIT_L(0); PG8_BAR; PG8_MMA(1, 0, At, B0); PG8_MMA(1, 1, At, B1); PG8_BAR; PG8_SCHED;
            PG8_LDB(B0, 1, 0); PG8_LDB(B1, 1, 1); PG8_SCHED; PG8_LDA(At, 1, 0); PG8_STAGE(PG8_SA(0, 1), a2 + hstepA, voffA);
            PG8_WAIT_V(8); PG8_WAIT_L(0); PG8_BAR; PG8_MMA(0, 0, At, B0); PG8_MMA(0, 1, At, B1); PG8_BAR; PG8_SCHED;
            PG8_LDA(At, 1, 1); PG8_STAGE(PG8_SB(1, 0), b3, voffB); PG8_STAGE(PG8_SB(1, 1), b3 + hstepB, voffB); PG8_STAGE(PG8_SA(1, 0), a3, voffA);
            PG8_WAIT_V(8); PG8_WAIT_L(0); PG8_BAR; PG8_MMA(1, 0, At, B0); PG8_MMA(1, 1, At, B1); PG8_BAR; PG8_SCHED;
            } else {
            PG8_LDB(B0, 0, 0); PG8_SCHED; PG8_LDA(At, 0, 0); PG8_STAGE(PG8_SA(1, 1), a1 + hstepA, voffA);
            PG8_WAIT_L(8); PG8_BAR; PG8_WAIT_L(0); PG8_MMA(0, 0, At, B0); PG8_BAR; PG8_SCHED;
            PG8_LDB(B1, 0, 1); PG8_STAGE(PG8_SB(0, 0), b2, voffB);
            PG8_BAR; PG8_WAIT_L(0); PG8_MMA(0, 1, At, B1); PG8_BAR;
            PG8_LDA(At, 0, 1); PG8_STAGE(PG8_SA(0, 0), a2, voffA);
            PG8_BAR; PG8_WAIT_L(0); PG8_MMA(1, 0, At, B0); PG8_BAR; PG8_SCHED;
            PG8_STAGE(PG8_SB(0, 1), b2 + hstepB, voffB);
            PG8_WAIT_V(6); PG8_BAR; PG8_MMA(1, 1, At, B1); PG8_BAR;
            PG8_LDB(B0, 1, 0); PG8_SCHED; PG8_LDA(At, 1, 0); PG8_STAGE(PG8_SA(0, 1), a2 + hstepA, voffA);
            PG8_WAIT_L(8); PG8_BAR; PG8_WAIT_L(0); PG8_MMA(0, 0, At, B0); PG8_BAR; PG8_SCHED;
            PG8_LDB(B1, 1, 1); PG8_STAGE(PG8_SB(1, 0), b3, voffB);
            PG8_BAR; PG8_WAIT_L(0); PG8_MMA(0, 1, At, B1); PG8_BAR;
            PG8_LDA(At, 1, 1); PG8_STAGE(PG8_SA(1, 0), a3, voffA);
            PG8_BAR; PG8_WAIT_L(0); PG8_MMA(1, 0, At, B0); PG8_BAR; PG8_SCHED;
            PG8_STAGE(PG8_SB(1, 1), b3 + hstepB, voffB);
            PG8_WAIT_V(6); PG8_BAR; PG8_MMA(1, 1, At, B1); PG8_BAR;
            }
        }
        if constexpr (F8) asm volatile("s_nop 15\n\ts_nop 15" ::: "memory");
        if constexpr (ALIGN_EPI) { if (wr == 0) PG8_BAR; }
        E(acc, cur, wr, wc, fr, fq);
        if (!has_next) break;
#pragma unroll
        for (int a = 0; a < 2; ++a)
#pragma unroll
            for (int b = 0; b < 2; ++b)
#pragma unroll
                for (int m = 0; m < 4; ++m)
#pragma unroll
                    for (int n = 0; n < 2; ++n) acc[a][b][m][n] = (f32x4){0.f, 0.f, 0.f, 0.f};
        cur = nxt; cA = nA; cB = nB;
        if constexpr (ALIGN_EPI) { if (wr == 1) PG8_BAR; }
    }
    PG8_WAIT_V(0);
    if constexpr (!ALIGN_EPI) { if (wr == 0) PG8_BAR; }
    PG8_BAR;
#undef PG8_SA
#undef PG8_SB
#undef PG8_STAGE
#undef PG8_LDA
#undef PG8_LDB
#undef PG8_MMA
#undef PG8_LD16
#undef PG8_WAIT_V
#undef PG8_WAIT_L
#undef PG8_BAR
#undef PG8_SCHED
}
}

#define XB_TMO      128
#define XB_XCNT(j)  (256  + 64 * (j))
#define XB_XSUB(j)  (1280 + 64 * (j))
#define XB_XGEN(j)  (2304 + 64 * (j))
#define XB_TOP      3328
#define XB_TOPGEN   3392
#define XCD_BAR_WORDS 3456
#define XB_SPIN_CAP (1u << 18)

__device__ __forceinline__ unsigned xb_ld(unsigned* p)              { return __hip_atomic_load(p, __ATOMIC_RELAXED, __HIP_MEMORY_SCOPE_AGENT); }
__device__ __forceinline__ unsigned xb_add(unsigned* p, unsigned v) { return __hip_atomic_fetch_add(p, v, __ATOMIC_RELAXED, __HIP_MEMORY_SCOPE_AGENT); }
__device__ __forceinline__ unsigned xb_xcc_id() { return (unsigned)__builtin_amdgcn_s_getreg((3 << 11) | 20) & 0xFu; }
#define XB_SPIN(cond, bar) do { unsigned _sp = 0; while (cond) { __builtin_amdgcn_s_sleep(1); \
    if ((++_sp & 255u) == 0u) { if (xb_ld(&(bar)[XB_TMO])) break; if (_sp > XB_SPIN_CAP) { atomicAdd(&(bar)[XB_TMO], 1u); break; } } } } while (0)

struct XcdBarrier {
    unsigned* bar; unsigned x;
    volatile LAS unsigned* st;
};

__device__ __forceinline__ XcdBarrier xcd_barrier_post(unsigned* bar, volatile LAS unsigned* st) {
    XcdBarrier b; b.bar = bar; b.x = xb_xcc_id(); b.st = st;
    if (threadIdx.x == 0) (void)xb_add(&bar[XB_XCNT(b.x)], 1u);
    return b;
}
__device__ __forceinline__ void xcd_barrier_complete(unsigned* bar, unsigned x, unsigned& nloc, unsigned& nx) {
    const unsigned G = gridDim.x * gridDim.y * gridDim.z;
    unsigned sum, cnt, mine, sp = 0u;
    for (;;) {
        sum = 0u; cnt = 0u; mine = 0u;
#pragma unroll
        for (unsigned j = 0; j < 16; ++j) { const unsigned c = xb_ld(&bar[XB_XCNT(j)]); sum += c; cnt += (c > 0u) ? 1u : 0u; mine = (j == x) ? c : mine; }
        if (sum == G) break;
        __builtin_amdgcn_s_sleep(1);
        if ((++sp & 255u) == 0u) { if (xb_ld(&bar[XB_TMO])) break; if (sp > XB_SPIN_CAP) { atomicAdd(&bar[XB_TMO], 1u); break; } }
    }
    nloc = mine > 0u ? mine : 1u; nx = cnt > 0u ? cnt : 1u;
}

__device__ __forceinline__ void xcd_barrier(const XcdBarrier& b) {
    asm volatile("s_waitcnt vmcnt(0)" ::: "memory");
    __syncthreads();
    if (threadIdx.x == 0) {
        unsigned* bar = b.bar;
        __builtin_amdgcn_s_waitcnt(0);
        unsigned nloc = b.st[0], nx = b.st[1];
        if (nloc == 0u) { xcd_barrier_complete(bar, b.x, nloc, nx); b.st[0] = nloc; b.st[1] = nx; }
        const unsigned old = xb_add(&bar[XB_XSUB(b.x)], 1u);
        const unsigned gen = old / nloc;
        if (old + 1u == (gen + 1u) * nloc) {
            __builtin_amdgcn_fence(__ATOMIC_RELEASE, "agent");
            asm volatile("s_waitcnt vmcnt(0)" ::: "memory");
            const unsigned og = xb_add(&bar[XB_TOP], 1u);
            const unsigned tg = og / nx;
            if (og + 1u == (tg + 1u) * nx) xb_add(&bar[XB_TOPGEN], 1u);
            else XB_SPIN(xb_ld(&bar[XB_TOPGEN]) == tg, bar);
            __builtin_amdgcn_fence(__ATOMIC_ACQUIRE, "agent");
            xb_add(&bar[XB_XGEN(b.x)], 1u);
            asm volatile("s_waitcnt vmcnt(0)" ::: "memory");
        } else {
            XB_SPIN(xb_ld(&bar[XB_XGEN(b.x)]) == gen, bar);
            __builtin_amdgcn_fence(__ATOMIC_ACQUIRE, "agent");
            asm volatile("s_waitcnt vmcnt(0)" ::: "memory");
        }
    }
    __syncthreads();
}

constexpr int NWAVES = 8, NTHR = 512;
constexpr int DM = 1024, NB = 8, SEQ = 4096, CTXL = 256, DEPTH = 4;
constexpr int NLAT = NB * SEQ, NCTX = NB * CTXL, NT = NLAT + NCTX;
constexpr int PW = 2304;
constexpr int MW = 1280;
constexpr int NEXP = 32, MAXBLK = 576;
constexpr int NCHK = 544;
constexpr int S5ROWS = 2304;
constexpr int PC_FU = 0, PC_S5 = 256, PC_Q = 512, PC_K = 640, PC_V = 768, PC_R = 1024, PC_Z = 1280, PC_XBC = 1536, PC_A1 = 2048, PC_DT = 2080;
enum { I_X = 0, I_C, I_CTX, I_CCTX, I_ADAW, I_ADAB, I_NMG, I_NFG, I_WIN, I_WOUT, I_FOURW, I_S5LRE, I_S5LIM, I_S5LDT, I_S5BRE, I_S5BIM, I_S5CRE, I_S5CIM, I_S5D, I_S5GLU,
       I_GLAA2, I_GLAAB, I_GLANG, I_SSDCW, I_SSDCB, I_SSDALOG, I_SSDDTB, I_SSDD, I_SSDNG, I_RW, I_RB, I_WGU, I_BGU, I_WDN, I_BDN, I_FING, N_IN };

constexpr size_t al256(size_t x) { return (x + 255) & ~(size_t)255; }
constexpr size_t WS_CTL = 0, CTL_BYTES = 1u << 20;
constexpr size_t WS_MOD = WS_CTL + CTL_BYTES;
constexpr size_t WS_TAB = WS_MOD + al256((size_t)DEPTH * 9 * 6144 * 4);
constexpr size_t TAB_F64 = 0, TAB_TW = 16384, TAB_D256 = 16384 + 32768, TAB_BYTES = 65536;
constexpr size_t WS_A16 = WS_TAB + TAB_BYTES;
constexpr size_t WS_WIN = WS_A16 + al256((size_t)DEPTH * 2 * 16 * 64 * 2 * 4);
constexpr size_t WS_WOUT = WS_WIN + (size_t)DEPTH * PW * DM * 2;
constexpr size_t WS_WGLU = WS_WOUT + (size_t)DEPTH * DM * MW * 2;
constexpr size_t WS_S5P = WS_WGLU + (size_t)DEPTH * 256 * 256 * 2;
constexpr size_t WS_S5B2 = WS_S5P + (size_t)DEPTH * 16 * 256 * 256 * 2;
constexpr size_t WS_WGU = WS_S5B2 + (size_t)DEPTH * 16 * 256 * 512 * 2;
constexpr size_t WS_WDN = WS_WGU + (size_t)DEPTH * NEXP * 2048 * DM;
constexpr size_t WS_XS = WS_WDN + (size_t)DEPTH * NEXP * DM * DM;
constexpr size_t WS_H = WS_XS + (size_t)NT * DM * 4;
constexpr size_t WS_PBUF = WS_H + (size_t)NT * DM * 2;
constexpr size_t WS_A2 = WS_PBUF + (size_t)NT * PW * 2;
constexpr size_t WS_S5S = WS_A2 + (size_t)16 * S5ROWS * 512 * 2;
constexpr size_t WS_ACT5 = WS_S5S + (size_t)16 * S5ROWS * 256 * 4;
constexpr size_t WS_MIX = WS_ACT5 + (size_t)NT * 256 * 2;
constexpr size_t WS_GDS = WS_MIX + (size_t)NT * MW * 2;
constexpr size_t WS_GDEC = WS_GDS + (size_t)NCHK * 8 * 2048 * 4;
constexpr size_t WS_GSE = WS_GDEC + al256((size_t)NCHK * 8 * 32 * 4);
constexpr size_t WS_SDS = WS_GSE + (size_t)NCHK * 8 * 2048 * 2;
constexpr size_t WS_SDEC = WS_SDS + (size_t)NCHK * 8 * 4096 * 4;
constexpr size_t WS_SSE = WS_SDEC + al256((size_t)NCHK * 8 * 4);
constexpr size_t WS_PE = WS_SSE + (size_t)NCHK * 8 * 4096 * 2;
constexpr size_t WS_PR = WS_PE + (size_t)NT * 4 * 4;
constexpr size_t WS_PG = WS_PR + (size_t)NT * 4 * 4;
constexpr size_t WS_PS = WS_PG + (size_t)NT * 4 * 4;
constexpr size_t WS_SG = WS_PS + (size_t)NT * 4 * 4;
constexpr size_t WS_H8 = WS_SG + (size_t)MAXBLK * 256 * 4;
constexpr size_t WS_BUF = WS_H8 + (size_t)NT * DM;
constexpr size_t WS_ACT = WS_BUF + (size_t)MAXBLK * 256 * DM;
constexpr size_t WS_Y = WS_ACT + (size_t)MAXBLK * 256 * DM;
constexpr size_t WS_END = WS_Y + (size_t)MAXBLK * 256 * DM * 2;
constexpr int CW_QUEUE = 64;
constexpr int CW_CNT = 1024;
constexpr int CW_BLKE = 2048;
constexpr int CW_BAR = 8192;

constexpr int LDS_BYTES = 163840, MISC_OFF = LDS_BYTES - 256;

constexpr float W8_SCALE = 32.f, H8_SCALE = 8.f, A8_SCALE = 4.f;
__device__ __forceinline__ unsigned pk4f8(float a, float b, float c, float d) { int w = 0; w = __builtin_amdgcn_cvt_pk_fp8_f32(a, b, w, false); w = __builtin_amdgcn_cvt_pk_fp8_f32(c, d, w, true); return (unsigned)w; }
#define RLX_AGENT __ATOMIC_RELAXED, __HIP_MEMORY_SCOPE_AGENT
__device__ __forceinline__ int fresh_tid(int wave0) { int l = (int)__builtin_amdgcn_mbcnt_hi(~0u, __builtin_amdgcn_mbcnt_lo(~0u, 0u)); asm volatile("" : "+v"(l)); return wave0 * 64 + l; }
__device__ __forceinline__ unsigned f2bf(float f) { unsigned u = __builtin_bit_cast(unsigned, f); return (u + 0x7fffu + ((u >> 16) & 1u)) >> 16; }
__device__ __forceinline__ unsigned pk2(float lo, float hi) { return f2bf(lo) | (f2bf(hi) << 16); }
__device__ __forceinline__ float bf2f(unsigned short b) { return __builtin_bit_cast(float, (unsigned)b << 16); }
__device__ __forceinline__ float bflo(unsigned w) { return __builtin_bit_cast(float, w << 16); }
__device__ __forceinline__ float bfhi(unsigned w) { return __builtin_bit_cast(float, w & 0xffff0000u); }
template <int M> __device__ __forceinline__ float swz_xor(float v) { return __builtin_bit_cast(float, __builtin_amdgcn_ds_swizzle(__builtin_bit_cast(int, v), (M << 10) | 0x1F)); }
__device__ __forceinline__ float xor32f(float v, int lane) { return __builtin_bit_cast(float, __builtin_amdgcn_ds_bpermute((lane ^ 32) << 2, __builtin_bit_cast(int, v))); }
__device__ __forceinline__ float wave_sum(float v, int lane) { v += swz_xor<1>(v); v += swz_xor<2>(v); v += swz_xor<4>(v); v += swz_xor<8>(v); v += swz_xor<16>(v); v += xor32f(v, lane); return v; }
__device__ __forceinline__ float wave_max(float v, int lane) { v = fmaxf(v, swz_xor<1>(v)); v = fmaxf(v, swz_xor<2>(v)); v = fmaxf(v, swz_xor<4>(v)); v = fmaxf(v, swz_xor<8>(v)); v = fmaxf(v, swz_xor<16>(v)); v = fmaxf(v, xor32f(v, lane)); return v; }
__device__ __forceinline__ float sigmoidf_(float x) { return 1.f / (1.f + __expf(-x)); }
__device__ __forceinline__ float siluf_(float x) { return x / (1.f + __expf(-x)); }

template <class Fill> struct SgOrder {
    int nblk, nN, R, x, r, xs; Fill f;
    __device__ __forceinline__ void init(int nblk_, int nN_, int G, int c) { nblk = nblk_; nN = nN_; if ((G & 7) == 0) { R = G >> 3; x = c & 7; r = c >> 3; xs = 8; } else { R = G; x = 0; r = c; xs = 1; } }
    __device__ __forceinline__ bool next(int& cursor, pg8::Unit& u) const {
        const int ups = 8 * nN, nsg = (nblk + 7) >> 3;
        for (;;) {
            const int v = r + R * cursor; ++cursor;
            const int sgl = v / ups, uu = v - sgl * ups, sg = x + xs * sgl;
            if (sg >= nsg) return false;
            const int blk = sg * 8 + (uu & 7), pn = uu >> 3;
            if (blk >= nblk) continue;
            u.pm = blk; u.pn = pn; f(u); return true;
        }
    }
};
struct FillPlain { size_t astep, bstep; __device__ __forceinline__ void operator()(pg8::Unit& u) const { u.grp = 0; u.aoff = (size_t)u.pm * astep; u.boff = (size_t)u.pn * bstep; } };
struct FillS5 { size_t bgrp; __device__ __forceinline__ void operator()(pg8::Unit& u) const { const int g = u.pm / 9, t = u.pm - g * 9; u.grp = g; u.pm = t; u.aoff = ((size_t)g * S5ROWS + (size_t)t * 256) * 512 * 2; u.boff = (size_t)g * bgrp; } };
struct FillMoe { const unsigned* blke; int erows; __device__ __forceinline__ void operator()(pg8::Unit& u) const { const int e = (int)blke[1 + u.pm]; u.grp = e; u.aoff = (size_t)u.pm * 256 * DM; u.boff = ((size_t)e * erows + (size_t)u.pn * 256) * DM; } };

using pg8::cvt_pk_bf16;
struct EpiInproj {
    static constexpr bool PERM = true;
    bf16* P; bf16* A2;
    __device__ __forceinline__ void operator()(const f32x4 (&acc)[2][2][4][2], const pg8::Unit& u, int wr, int wc, int fr, int fq) const {
        const int row0 = u.pm * 256 + wr * 64 + fr, col0 = u.pn * 256 + wc * 32 + 8 * fq;
#pragma unroll
        for (int ai = 0; ai < 2; ++ai)
#pragma unroll
            for (int m = 0; m < 4; ++m) {
                const int row = row0 + ai * 128 + m * 16;
#pragma unroll
                for (int bj = 0; bj < 2; ++bj) {
                    const f32x4 v0 = acc[ai][bj][m][0], v1 = acc[ai][bj][m][1];
                    u32x4 w; w.x = cvt_pk_bf16(v0[0], v0[1]); w.y = cvt_pk_bf16(v0[2], v0[3]); w.z = cvt_pk_bf16(v1[0], v1[1]); w.w = cvt_pk_bf16(v1[2], v1[3]);
                    const int col = col0 + bj * 128;
                    if (u.pn == 1) {
                        const int cc = col - 256, g = cc >> 4, hp = cc & 15;
                        const int crow = row < NLAT ? (row >> 4) : (2048 + ((row - NLAT) >> 4)), s = row & 15;
                        *(u32x4*)(A2 + ((size_t)g * S5ROWS + crow) * 512 + s * 16 + hp) = w;
                    } else *(u32x4*)(P + (size_t)row * PW + col) = w;
                }
            }
    }
};
struct EpiOutproj {
    static constexpr bool PERM = false;
    const float* xin; const float* ctxin; float* XS; const float* modL; int first;
    __device__ __forceinline__ void operator()(const f32x4 (&acc)[2][2][4][2], const pg8::Unit& u, int wr, int wc, int fr, int fq) const {
        const int rowt = u.pm * 256, bi = rowt < NLAT ? (rowt >> 12) : 8;
        const int row0 = rowt + wr * 64 + fr, col0 = u.pn * 256 + wc * 32 + 4 * fq;
        const float* gate = modL + (size_t)bi * 6144 + 2 * 1024;
        f32x4 gv[2][2];
#pragma unroll
        for (int bj = 0; bj < 2; ++bj)
#pragma unroll
            for (int n = 0; n < 2; ++n) gv[bj][n] = *(const f32x4*)(gate + col0 + bj * 128 + n * 16);
#pragma unroll
        for (int ai = 0; ai < 2; ++ai)
#pragma unroll
            for (int m = 0; m < 4; ++m) {
                const int row = row0 + ai * 128 + m * 16;
                const float* src = first ? (row < NLAT ? xin + (size_t)row * DM : ctxin + (size_t)(row - NLAT) * DM) : XS + (size_t)row * DM;
                float* dst = XS + (size_t)row * DM;
#pragma unroll
                for (int bj = 0; bj < 2; ++bj)
#pragma unroll
                    for (int n = 0; n < 2; ++n) { const int c = col0 + bj * 128 + n * 16; const f32x4 xo = *(const f32x4*)(src + c); *(f32x4*)(dst + c) = xo + gv[bj][n] * acc[ai][bj][m][n]; }
            }
    }
};
struct EpiSwiglu {
    static constexpr bool PERM = true;
    unsigned char* ACT; const float* bgu;
    __device__ __forceinline__ void operator()(const f32x4 (&acc)[2][2][4][2], const pg8::Unit& u, int wr, int wc, int fr, int fq) const {
        const int row0 = u.pm * 256 + wr * 64 + fr, i0 = u.pn * 128 + wc * 32 + 8 * fq;
        const float* bb = bgu + (size_t)u.grp * 2048 + 2 * i0;
        const f32x4 b0 = *(const f32x4*)(bb), b1 = *(const f32x4*)(bb + 4), b2 = *(const f32x4*)(bb + 8), b3 = *(const f32x4*)(bb + 12);
        const float bg[8] = {b0[0], b0[2], b1[0], b1[2], b2[0], b2[2], b3[0], b3[2]}, bu[8] = {b0[1], b0[3], b1[1], b1[3], b2[1], b2[3], b3[1], b3[3]};
        constexpr float inv = 1.f / (H8_SCALE * W8_SCALE);
#pragma unroll
        for (int ai = 0; ai < 2; ++ai)
#pragma unroll
            for (int m = 0; m < 4; ++m) {
                const int row = row0 + ai * 128 + m * 16;
                float o[8];
#pragma unroll
                for (int n = 0; n < 2; ++n)
#pragma unroll
                    for (int j = 0; j < 4; ++j) {
                        const int q = 4 * n + j;
                        const float gt = fminf(acc[ai][0][m][n][j] * inv + bg[q], 7.0f);
                        const float up = fminf(fmaxf(acc[ai][1][m][n][j] * inv + bu[q], -7.0f), 7.0f);
                        o[q] = (up + 1.0f) * gt * sigmoidf_(1.702f * gt) * A8_SCALE;
                    }
                u32x2 w; w.x = pk4f8(o[0], o[1], o[2], o[3]); w.y = pk4f8(o[4], o[5], o[6], o[7]);
                *(u32x2*)(ACT + (size_t)row * DM + i0) = w;
            }
    }
};
struct EpiDown {
    static constexpr bool PERM = true;
    bf16* Y; const float* bdn; const float* sg;
    __device__ __forceinline__ void operator()(const f32x4 (&acc)[2][2][4][2], const pg8::Unit& u, int wr, int wc, int fr, int fq) const {
        const int row0 = u.pm * 256 + wr * 64 + fr, col0 = u.pn * 256 + wc * 32 + 8 * fq;
        const float* bb = bdn + (size_t)u.grp * DM + col0;
        constexpr float inv = 1.f / (A8_SCALE * W8_SCALE);
        f32x4 bv[2][2];
#pragma unroll
        for (int bj = 0; bj < 2; ++bj)
#pragma unroll
            for (int n = 0; n < 2; ++n) bv[bj][n] = *(const f32x4*)(bb + bj * 128 + 4 * n);
#pragma unroll
        for (int ai = 0; ai < 2; ++ai)
#pragma unroll
            for (int m = 0; m < 4; ++m) {
                const int row = row0 + ai * 128 + m * 16; const float gt = sg[row];
#pragma unroll
                for (int bj = 0; bj < 2; ++bj) {
                    const f32x4 v0 = (acc[ai][bj][m][0] * inv + bv[bj][0]) * gt, v1 = (acc[ai][bj][m][1] * inv + bv[bj][1]) * gt;
                    u32x4 w; w.x = cvt_pk_bf16(v0[0], v0[1]); w.y = cvt_pk_bf16(v0[2], v0[3]); w.z = cvt_pk_bf16(v1[0], v1[1]); w.w = cvt_pk_bf16(v1[2], v1[3]);
                    *(u32x4*)(Y + (size_t)row * DM + col0 + bj * 128) = w;
                }
            }
    }
};
struct EpiS5S {
    static constexpr bool PERM = false;
    float* S;
    __device__ __forceinline__ void operator()(const f32x4 (&acc)[2][2][4][2], const pg8::Unit& u, int wr, int wc, int fr, int fq) const {
        const int row0 = u.pm * 256 + wr * 64 + fr, col0 = wc * 32 + 4 * fq;
        float* base = S + (size_t)u.grp * S5ROWS * 256;
#pragma unroll
        for (int ai = 0; ai < 2; ++ai)
#pragma unroll
            for (int m = 0; m < 4; ++m) { float* rp = base + (size_t)(row0 + ai * 128 + m * 16) * 256 + col0;
#pragma unroll
                for (int bj = 0; bj < 2; ++bj)
#pragma unroll
                    for (int n = 0; n < 2; ++n) *(f32x4*)(rp + bj * 128 + n * 16) = acc[ai][bj][m][n]; }
    }
};
__device__ __forceinline__ float gelu_tanh(float x) { const float t = 0.7978845608f * (x + 0.044715f * x * x * x); const float e = __expf(2.f * t); return 0.5f * x * (1.f + (1.f - 2.f / (e + 1.f))); }
struct EpiS5Y {
    static constexpr bool PERM = true;
    bf16* ACT5;
    __device__ __forceinline__ void operator()(const f32x4 (&acc)[2][2][4][2], const pg8::Unit& u, int wr, int wc, int fr, int fq) const {
        const int row0 = u.pm * 256 + wr * 64 + fr, col0 = wc * 32 + 8 * fq;
#pragma unroll
        for (int ai = 0; ai < 2; ++ai)
#pragma unroll
            for (int m = 0; m < 4; ++m) {
                const int crow = row0 + ai * 128 + m * 16;
                if (crow >= 2176) continue;
                const int tok0 = crow < 2048 ? crow * 16 : NLAT + (crow - 2048) * 16;
#pragma unroll
                for (int bj = 0; bj < 2; ++bj) {
                    const int col = col0 + bj * 128, j = col >> 4, h = col & 15;
                    const f32x4 v0 = acc[ai][bj][m][0], v1 = acc[ai][bj][m][1];
                    u32x4 w; w.x = cvt_pk_bf16(gelu_tanh(v0[0]), gelu_tanh(v0[1])); w.y = cvt_pk_bf16(gelu_tanh(v0[2]), gelu_tanh(v0[3]));
                    w.z = cvt_pk_bf16(gelu_tanh(v1[0]), gelu_tanh(v1[1])); w.w = cvt_pk_bf16(gelu_tanh(v1[2]), gelu_tanh(v1[3]));
                    *(u32x4*)(ACT5 + (size_t)(tok0 + j) * 256 + u.grp * 16 + h) = w;
                }
            }
    }
};
struct EpiGlu {
    static constexpr bool PERM = true;
    const bf16* ACT5; bf16* MIX;
    __device__ __forceinline__ void operator()(const f32x4 (&acc)[2][2][4][2], const pg8::Unit& u, int wr, int wc, int fr, int fq) const {
        const int row0 = u.pm * 256 + wr * 64 + fr, col0 = wc * 32 + 8 * fq;
#pragma unroll
        for (int ai = 0; ai < 2; ++ai)
#pragma unroll
            for (int m = 0; m < 4; ++m) {
                const int row = row0 + ai * 128 + m * 16;
#pragma unroll
                for (int bj = 0; bj < 2; ++bj) {
                    const int col = col0 + bj * 128;
                    const u32x4 a = *(const u32x4*)(ACT5 + (size_t)row * 256 + col);
                    const f32x4 v0 = acc[ai][bj][m][0], v1 = acc[ai][bj][m][1];
                    u32x4 w;
                    w.x = cvt_pk_bf16(bflo(a.x) * sigmoidf_(v0[0]), bfhi(a.x) * sigmoidf_(v0[1])); w.y = cvt_pk_bf16(bflo(a.y) * sigmoidf_(v0[2]), bfhi(a.y) * sigmoidf_(v0[3]));
                    w.z = cvt_pk_bf16(bflo(a.z) * sigmoidf_(v1[0]), bfhi(a.z) * sigmoidf_(v1[1])); w.w = cvt_pk_bf16(bflo(a.w) * sigmoidf_(v1[2]), bfhi(a.w) * sigmoidf_(v1[3]));
                    *(u32x4*)(MIX + (size_t)row * MW + 512 + col) = w;
                }
            }
    }
};

struct Args { const float* in[N_IN]; float* out; unsigned char* ws; int ph_lo, ph_hi; };
typedef const __attribute__((address_space(4))) Args CArgs;
__device__ __forceinline__ CArgs* fresh_args() { CArgs* p = (CArgs*)__builtin_amdgcn_kernarg_segment_ptr(); asm volatile("" : "+s"(p)); return p; }
struct Frame {
    LAS unsigned char* lds; volatile LAS unsigned* MISC; unsigned* ctl; unsigned char* ws;
    int tid, lane, wave, G, bid;
};

template <class Map> __device__ __forceinline__ void transpose_tile(const float* W, int ldw, int ncols, int k0, int n0, bf16* WT, int ldt, int kd0, const Map& map, LAS float* scr, int lane) {
    const int nn = n0 + lane;
#pragma unroll 16
    for (int kk = 0; kk < 64; ++kk) scr[kk * 65 + lane] = nn < ncols ? W[(size_t)(k0 + kk) * ldw + nn] : 0.f;
    asm volatile("s_waitcnt lgkmcnt(0)" ::: "memory");
    const int c = lane & 7;
#pragma unroll
    for (int j = 0; j < 8; ++j) {
        const int n = (lane >> 3) + 8 * j; const LAS float* s = scr + (8 * c) * 65 + n;
        u32x4 o; o.x = pk2(s[0], s[65]); o.y = pk2(s[2 * 65], s[3 * 65]); o.z = pk2(s[4 * 65], s[5 * 65]); o.w = pk2(s[6 * 65], s[7 * 65]);
        const int dr = (n0 + n) < ncols ? map(n0 + n) : -1;
        if (dr >= 0) *(u32x4*)(WT + (size_t)dr * ldt + kd0 + 8 * c) = o;
    }
    asm volatile("s_waitcnt lgkmcnt(0)" ::: "memory");
}
struct MapId { __device__ __forceinline__ int operator()(int n) const { return n; } };
struct MapWin { __device__ __forceinline__ int operator()(int c) const { return c < 1280 ? c : (c < 1312 ? 2048 + (c - 1280) : (c < 2080 ? c - 32 : c)); } };
struct MapGu { __device__ __forceinline__ int operator()(int n) const { const int i = n >> 1; return (i >> 7) * 256 + (n & 1) * 128 + (i & 127); } };

template <class Map> __device__ __forceinline__ void transpose_tile_f8(const float* W, int ldw, int k0, int n0, unsigned char* WT, int ldt, const Map& map, LAS float* scr, int lane) {
#pragma unroll 16
    for (int kk = 0; kk < 64; ++kk) scr[kk * 65 + lane] = W[(size_t)(k0 + kk) * ldw + n0 + lane];
    asm volatile("s_waitcnt lgkmcnt(0)" ::: "memory");
    const int c = lane & 7;
#pragma unroll
    for (int j = 0; j < 8; ++j) {
        const int n = (lane >> 3) + 8 * j; const LAS float* s = scr + (8 * c) * 65 + n;
        u32x2 o; o.x = pk4f8(s[0] * W8_SCALE, s[65] * W8_SCALE, s[2 * 65] * W8_SCALE, s[3 * 65] * W8_SCALE); o.y = pk4f8(s[4 * 65] * W8_SCALE, s[5 * 65] * W8_SCALE, s[6 * 65] * W8_SCALE, s[7 * 65] * W8_SCALE);
        *(u32x2*)(WT + (size_t)map(n0 + n) * ldt + k0 + 8 * c) = o;
    }
    asm volatile("s_waitcnt lgkmcnt(0)" ::: "memory");
}
constexpr int PI_ADA = 48, PI_TAB = 1, PI_S5 = 64, PI_FOLD = 256, PI_ZERO = 4;
constexpr int TW_WIN = 16 * 33, TW_GU = 32 * 16 * 32, TW_DN = 32 * 16 * 16, TW_WOUT = 12 * 16, TW_GLU = 16, TW_LAYER = TW_WIN + TW_GU + TW_DN + TW_WOUT + TW_GLU;
constexpr int PI_TR = (DEPTH * TW_LAYER + 7) / 8;
constexpr int PI_B_TAB = PI_ADA, PI_B_S5 = PI_B_TAB + PI_TAB, PI_B_FOLD = PI_B_S5 + PI_S5, PI_B_ZERO = PI_B_FOLD + PI_FOLD, PI_B_TR = PI_B_ZERO + PI_ZERO, PI_TOTAL = PI_B_TR + PI_TR;

__device__ __forceinline__ void pro_adaln(Frame& F, CArgs& a, int it) {
    const int L = it / 12, cb = it % 12;
    LAS float* cond = (LAS float*)F.lds;
    for (int i = F.tid; i < 9 * 1024; i += NTHR) { const int r = i >> 10, k = i & 1023; const float v = r < 8 ? a.in[I_C][r * 1024 + k] : a.in[I_CCTX][k]; cond[i] = siluf_(v); }
    __syncthreads();
    const int n = cb * 512 + F.tid;
    const float* w = a.in[I_ADAW] + (size_t)L * 1024 * 6144 + n;
    float acc[9];
    const float b = a.in[I_ADAB][L * 6144 + n];
#pragma unroll
    for (int r = 0; r < 9; ++r) acc[r] = b;
#pragma unroll 2
    for (int k = 0; k < 1024; k += 4) {
        const float w0 = w[(size_t)k * 6144], w1 = w[(size_t)(k + 1) * 6144], w2 = w[(size_t)(k + 2) * 6144], w3 = w[(size_t)(k + 3) * 6144];
#pragma unroll
        for (int r = 0; r < 9; ++r) { const f32x4 c4 = *(const LAS f32x4*)(cond + r * 1024 + k); acc[r] += c4[0] * w0 + c4[1] * w1 + c4[2] * w2 + c4[3] * w3; }
    }
    float* mod = (float*)(F.ws + WS_MOD) + (size_t)L * 9 * 6144 + n;
#pragma unroll
    for (int r = 0; r < 9; ++r) mod[(size_t)r * 6144] = acc[r];
    __syncthreads();
}
__device__ __forceinline__ void pro_tables(Frame& F) {
    bf16* f64 = (bf16*)(F.ws + WS_TAB + TAB_F64);
    for (int i = F.tid; i < 4096; i += NTHR) { const int k = i >> 6, n = i & 63; float s, c; sincospif((float)((k * n) & 63) / 32.f, &s, &c); f64[i] = (bf16)f2bf(c); f64[4096 + i] = (bf16)f2bf(s); }
    float* tw = (float*)(F.ws + WS_TAB + TAB_TW);
    for (int i = F.tid; i < 4096; i += NTHR) { float s, c; sincospif((float)i / 2048.f, &s, &c); tw[2 * i] = c; tw[2 * i + 1] = s; }
    float* d256 = (float*)(F.ws + WS_TAB + TAB_D256);
    for (int i = F.tid; i < 256; i += NTHR) { float s, c; sincospif((float)i / 128.f, &s, &c); d256[2 * i] = c; d256[2 * i + 1] = s; }
}
__device__ __forceinline__ void pro_fold(Frame& F, CArgs& a, int it) {
    const int L = it >> 6, h = (it >> 4) & 3, nb = it & 15, n0 = nb * 64;
    LAS float* fw = (LAS float*)F.lds;
    LAS float* ct = fw + 64 * 65;
    if (F.tid < 64) ct[F.tid] = cospif((float)F.tid / 32.f);
    const float* four = a.in[I_FOURW] + (size_t)L * 256 * 256, *wo = a.in[I_WOUT] + (size_t)L * 1024 * 1024;
    const int n = F.tid & 63, cg = F.tid >> 6;
    { float s[8];
#pragma unroll
      for (int i = 0; i < 8; ++i) s[i] = 0.f;
      for (int j = 0; j < 256; ++j) { const float wv = wo[(size_t)j * 1024 + n0 + n];
#pragma unroll
          for (int i = 0; i < 8; ++i) s[i] += four[(size_t)(h * 64 + cg * 8 + i) * 256 + j] * wv; }
#pragma unroll
      for (int i = 0; i < 8; ++i) fw[(cg * 8 + i) * 65 + n] = s[i]; }
    __syncthreads();
    float oc[8], os[8];
#pragma unroll
    for (int i = 0; i < 8; ++i) { oc[i] = 0.f; os[i] = 0.f; }
    for (int kc = 0; kc < 64; ++kc) { const float v = fw[kc * 65 + n];
#pragma unroll
        for (int i = 0; i < 8; ++i) { const int mm = (kc * (cg * 8 + i)) & 63; oc[i] += ct[mm] * v; os[i] += ct[(mm + 48) & 63] * v; } }
    bf16* wt = (bf16*)(F.ws + WS_WOUT) + (size_t)L * DM * MW + (size_t)(n0 + n) * MW + h * 64 + cg * 8;
    u32x4 w; w.x = pk2(oc[0] * 0.125f, oc[1] * 0.125f); w.y = pk2(oc[2] * 0.125f, oc[3] * 0.125f); w.z = pk2(oc[4] * 0.125f, oc[5] * 0.125f); w.w = pk2(oc[6] * 0.125f, oc[7] * 0.125f);
    *(u32x4*)wt = w;
    w.x = pk2(os[0] * 0.125f, os[1] * 0.125f); w.y = pk2(os[2] * 0.125f, os[3] * 0.125f); w.z = pk2(os[4] * 0.125f, os[5] * 0.125f); w.w = pk2(os[6] * 0.125f, os[7] * 0.125f);
    *(u32x4*)(wt + 256) = w;
    __syncthreads();
}
__device__ __forceinline__ void pro_s5(Frame& F, CArgs& a, int it) {
    const int L = it >> 4, g = it & 15;
    LAS float* pw = (LAS float*)F.lds;
    LAS float* bb = pw + 2 * 64 * 17 * 2;
    LAS float* cm = bb + 2 * 64 * 16 * 2;
    LAS float* kt = cm + 2 * 16 * 64 * 2;
    for (int i = F.tid; i < 2 * 64 * 17; i += NTHR) {
        const int r = i / (64 * 17), p = (i / 17) & 63, e = i % 17; const size_t q = ((size_t)(L * 2 + r) * 16 + g) * 64 + p;
        const float dt = __expf(a.in[I_S5LDT][(L * 2 + r) * 16 + g]); const float lr = a.in[I_S5LRE][q] * dt, li = a.in[I_S5LIM][q] * dt;
        float s, c; sincosf(li * (float)e, &s, &c); const float m = expf(lr * (float)e); pw[2 * i] = m * c; pw[2 * i + 1] = m * s;
    }
    for (int i = F.tid; i < 2 * 64 * 16; i += NTHR) {
        const int r = i >> 10, p = (i >> 4) & 63, h = i & 15; const size_t q = ((size_t)(L * 2 + r) * 16 + g) * 64 + p;
        const float dt = __expf(a.in[I_S5LDT][(L * 2 + r) * 16 + g]); const float lre = a.in[I_S5LRE][q], lim = a.in[I_S5LIM][q];
        float s, c; sincosf(lim * dt, &s, &c); const float m = expf(lre * dt); const float ar = m * c - 1.f, ai = m * s;
        const float den = 1.f / (lre * lre + lim * lim); const float cr = (ar * lre + ai * lim) * den, ci = (ai * lre - ar * lim) * den;
        const float br = a.in[I_S5BRE][q * 16 + h], bi = a.in[I_S5BIM][q * 16 + h];
        bb[2 * i] = cr * br - ci * bi; bb[2 * i + 1] = cr * bi + ci * br;
    }
    for (int i = F.tid; i < 2 * 16 * 64; i += NTHR) {
        const int r = i >> 10, h = (i >> 6) & 15, p = i & 63; const size_t q = (((size_t)(L * 2 + r) * 16 + g) * 16 + h) * 64 + p;
        cm[2 * i] = a.in[I_S5CRE][q]; cm[2 * i + 1] = a.in[I_S5CIM][q];
    }
    __syncthreads();
    for (int i = F.tid; i < 2 * 16 * 256; i += NTHR) {
        const int r = i >> 12, tau = (i >> 8) & 15, h = (i >> 4) & 15, hp = i & 15; float s = 0.f;
        for (int p = 0; p < 64; ++p) { const float cr = cm[2 * ((r * 16 + h) * 64 + p)], ci = cm[2 * ((r * 16 + h) * 64 + p) + 1];
            const float ar = pw[2 * ((r * 64 + p) * 17 + tau)], ai = pw[2 * ((r * 64 + p) * 17 + tau) + 1]; const float br = bb[2 * ((r * 64 + p) * 16 + hp)], bi = bb[2 * ((r * 64 + p) * 16 + hp) + 1];
            const float tr = cr * ar - ci * ai, ti = cr * ai + ci * ar; s += tr * br - ti * bi; }
        kt[i] = s;
    }
    __syncthreads();
    bf16* pt = (bf16*)(F.ws + WS_S5P) + (size_t)(L * 16 + g) * 256 * 256;
    for (int i = F.tid; i < 65536; i += NTHR) {
        const int np = i >> 8, k = i & 255, r = np >> 7, cpx = (np >> 6) & 1, p = np & 63, s = k >> 4, hp = k & 15, e = r ? s : 15 - s;
        const float ar = pw[2 * ((r * 64 + p) * 17 + e)], ai = pw[2 * ((r * 64 + p) * 17 + e) + 1]; const float br = bb[2 * ((r * 64 + p) * 16 + hp)], bi = bb[2 * ((r * 64 + p) * 16 + hp) + 1];
        pt[i] = (bf16)f2bf(cpx ? ar * bi + ai * br : ar * br - ai * bi);
    }
    bf16* b2 = (bf16*)(F.ws + WS_S5B2) + (size_t)(L * 16 + g) * 256 * 512;
    const float* dsk = a.in[I_S5D] + L * 256 + g * 16;
    for (int i = F.tid; i < 131072; i += NTHR) {
        const int n = i >> 9, k = i & 511, j = n >> 4, h = n & 15; float v;
        if (k < 256) { const int s = k >> 4, hp = k & 15; v = 0.f;
            if (j >= s) v += kt[((0 * 16 + (j - s)) * 16 + h) * 16 + hp];
            if (j <= s) v += kt[((1 * 16 + (s - j)) * 16 + h) * 16 + hp];
            if (j == s && h == hp) v += dsk[h];
        } else { const int kk = k - 256, r = kk >> 7, cpx = (kk >> 6) & 1, p = kk & 63, e = r ? 16 - j : j + 1;
            const float cr = cm[2 * ((r * 16 + h) * 64 + p)], ci = cm[2 * ((r * 16 + h) * 64 + p) + 1]; const float ar = pw[2 * ((r * 64 + p) * 17 + e)], ai = pw[2 * ((r * 64 + p) * 17 + e) + 1];
            v = cpx ? -(cr * ai + ci * ar) : (cr * ar - ci * ai); }
        b2[i] = (bf16)f2bf(v);
    }
    float* a16 = (float*)(F.ws + WS_A16) + (size_t)((L * 2) * 16 + g) * 128;
    if (F.tid < 128) { const int r = F.tid >> 6, p = F.tid & 63; float* o = a16 + (size_t)r * 16 * 128 + p * 2; o[0] = pw[2 * ((r * 64 + p) * 17 + 16)]; o[1] = pw[2 * ((r * 64 + p) * 17 + 16) + 1]; }
    __syncthreads();
}
__device__ __forceinline__ void pro_transposes(Frame& F, CArgs& a, int wg_item) {
    LAS float* scr = (LAS float*)F.lds + F.wave * (64 * 65);
    const int wi = wg_item * 8 + F.wave;
    if (wi >= DEPTH * TW_LAYER) return;
    const int L = wi / TW_LAYER; int r = wi % TW_LAYER;
    if (r < TW_WIN) { const int kb = r / 33, nb = r % 33; transpose_tile(fresh_args()->in[I_WIN] + (size_t)L * DM * 2088, 2088, 2088, kb * 64, nb * 64, (bf16*)(F.ws + WS_WIN) + (size_t)L * PW * DM, DM, kb * 64, MapWin(), scr, F.lane); return; } r -= TW_WIN;
    if (r < TW_GU) { const int e = r >> 9, kb = (r >> 5) & 15, nb = r & 31; transpose_tile_f8(fresh_args()->in[I_WGU] + ((size_t)L * NEXP + e) * DM * 2048, 2048, kb * 64, nb * 64, (unsigned char*)(F.ws + WS_WGU) + ((size_t)L * NEXP + e) * 2048 * DM, DM, MapGu(), scr, F.lane); return; } r -= TW_GU;
    if (r < TW_DN) { const int e = r >> 8, kb = (r >> 4) & 15, nb = r & 15; transpose_tile_f8(fresh_args()->in[I_WDN] + ((size_t)L * NEXP + e) * DM * DM, DM, kb * 64, nb * 64, (unsigned char*)(F.ws + WS_WDN) + ((size_t)L * NEXP + e) * DM * DM, DM, MapId(), scr, F.lane); return; } r -= TW_DN;
    if (r < TW_WOUT) { const int kb = r >> 4, nb = r & 15; transpose_tile(fresh_args()->in[I_WOUT] + (size_t)L * DM * DM + (size_t)256 * DM, DM, DM, kb * 64, nb * 64, (bf16*)(F.ws + WS_WOUT) + (size_t)L * DM * MW, MW, 512 + kb * 64, MapId(), scr, F.lane); return; } r -= TW_WOUT;
    { const int kb = r >> 2, nb = r & 3; transpose_tile(fresh_args()->in[I_S5GLU] + (size_t)L * 256 * 256, 256, 256, kb * 64, nb * 64, (bf16*)(F.ws + WS_WGLU) + (size_t)L * 256 * 256, 256, kb * 64, MapId(), scr, F.lane); }
}
__device__ __forceinline__ void p_prologue(Frame& F0, CArgs& a, int qw = CW_QUEUE) {
    for (;;) {
        if (F0.tid == 0) F0.MISC[0] = __hip_atomic_fetch_add(F0.ctl + qw, 1u, RLX_AGENT);
        __syncthreads();
        const int it = (int)F0.MISC[0];
        __syncthreads();
        if (it >= PI_TOTAL) break;
        Frame F = F0; { const int t_ = fresh_tid(F.wave); F.tid = t_; F.lane = t_ & 63; }
        if (it < PI_B_TAB) pro_adaln(F, *fresh_args(), it);
        else if (it < PI_B_S5) pro_tables(F);
        else if (it < PI_B_FOLD) pro_s5(F, *fresh_args(), it - PI_B_S5);
        else if (it < PI_B_ZERO) pro_fold(F, *fresh_args(), it - PI_B_FOLD);
        else if (it < PI_B_TR) { const int L = it - PI_B_ZERO; u32x4* z = (u32x4*)((bf16*)(F.ws + WS_WIN) + (size_t)L * PW * DM + (size_t)2088 * DM); for (int i = F.tid; i < (PW - 2088) * DM / 8; i += NTHR) z[i] = (u32x4){0u, 0u, 0u, 0u}; }
        else pro_transposes(F, *fresh_args(), it - PI_B_TR);
    }
}

__device__ __forceinline__ void p_norm1(Frame& F, CArgs& a, int L) {
    const int gw = F.bid * NWAVES + F.wave, NGW = F.G * NWAVES;
    float* XS = (float*)(F.ws + WS_XS); bf16* H = (bf16*)(F.ws + WS_H);
    const float* mod = (const float*)(F.ws + WS_MOD) + (size_t)L * 9 * 6144; const float* modp = mod - 9 * 6144;
    const int* PS = (const int*)(F.ws + WS_PS); const bf16* Y = (const bf16*)(F.ws + WS_Y);
    const float* g = a.in[I_NMG] + L * DM;
    f32x4 gv[4];
#pragma unroll
    for (int j = 0; j < 4; ++j) gv[j] = *(const f32x4*)(g + 4 * F.lane + 256 * j);
    for (int row = gw; row < NT; row += NGW) {
        const int bi = row < NLAT ? (row >> 12) : 8;
        f32x4 v[4];
        if (L == 0) { const float* src = row < NLAT ? a.in[I_X] + (size_t)row * DM : a.in[I_CTX] + (size_t)(row - NLAT) * DM;
#pragma unroll
            for (int j = 0; j < 4; ++j) v[j] = *(const f32x4*)(src + 4 * F.lane + 256 * j);
        } else {
            float* xr = XS + (size_t)row * DM;
#pragma unroll
            for (int j = 0; j < 4; ++j) v[j] = *(const f32x4*)(xr + 4 * F.lane + 256 * j);
            f32x4 s[4];
#pragma unroll
            for (int j = 0; j < 4; ++j) s[j] = (f32x4){0.f, 0.f, 0.f, 0.f};
#pragma unroll
            for (int k = 0; k < 4; ++k) { const int slot = PS[row * 4 + k]; const bf16* yr = Y + (size_t)slot * DM;
#pragma unroll
                for (int j = 0; j < 4; ++j) { const u32x2 w = *(const u32x2*)(yr + 4 * F.lane + 256 * j); s[j] += (f32x4){bflo(w.x), bfhi(w.x), bflo(w.y), bfhi(w.y)}; } }
            const float* m5 = modp + (size_t)bi * 6144 + 5 * 1024;
#pragma unroll
            for (int j = 0; j < 4; ++j) { v[j] += *(const f32x4*)(m5 + 4 * F.lane + 256 * j) * s[j]; *(f32x4*)(xr + 4 * F.lane + 256 * j) = v[j]; }
        }
        float ss = 0.f;
#pragma unroll
        for (int j = 0; j < 4; ++j) ss += v[j][0] * v[j][0] + v[j][1] * v[j][1] + v[j][2] * v[j][2] + v[j][3] * v[j][3];
        const float rs = rsqrtf(wave_sum(ss, F.lane) * (1.f / DM) + 1e-6f);
        const float* sh = mod + (size_t)bi * 6144, *sc = sh + 1024;
        bf16* hr = H + (size_t)row * DM;
#pragma unroll
        for (int j = 0; j < 4; ++j) { const f32x4 s4 = *(const f32x4*)(sc + 4 * F.lane + 256 * j), h4 = *(const f32x4*)(sh + 4 * F.lane + 256 * j);
            const f32x4 o = v[j] * rs * gv[j] * (s4 + 1.f) + h4; u32x2 w; w.x = pk2(o[0], o[1]); w.y = pk2(o[2], o[3]); *(u32x2*)(hr + 4 * F.lane + 256 * j) = w; }
    }
}
__device__ __forceinline__ void p_norm2(Frame& F, CArgs& a, int L, int nrows) {
    LAS float* rwt = (LAS float*)F.lds;
    const float* rw = a.in[I_RW] + (size_t)L * DM * NEXP;
    for (int i = F.tid; i < DM * NEXP; i += NTHR) { const int k = i >> 5, e = i & 31; rwt[e * 1024 + k] = rw[i]; }
    __syncthreads();
    const int gw = F.bid * NWAVES + F.wave, NGW = F.G * NWAVES;
    const float* XS = (const float*)(F.ws + WS_XS); unsigned char* H8 = (unsigned char*)(F.ws + WS_H8);
    const float* mod = (const float*)(F.ws + WS_MOD) + (size_t)L * 9 * 6144;
    int* PE = (int*)(F.ws + WS_PE); int* PR = (int*)(F.ws + WS_PR); float* PG = (float*)(F.ws + WS_PG);
    unsigned* cnt = F.ctl + CW_CNT + L * 64;
    const float* g = a.in[I_NFG] + L * DM;
    const float rb = a.in[I_RB][L * NEXP + (F.lane >> 1)];
    f32x4 gv[4];
#pragma unroll
    for (int j = 0; j < 4; ++j) gv[j] = *(const f32x4*)(g + 4 * F.lane + 256 * j);
    for (int row = gw; row < nrows; row += NGW) {
        const int bi = row < NLAT ? (row >> 12) : 8;
        const float* xr = XS + (size_t)row * DM;
        f32x4 v[4]; float ss = 0.f;
#pragma unroll
        for (int j = 0; j < 4; ++j) { v[j] = *(const f32x4*)(xr + 4 * F.lane + 256 * j); ss += v[j][0] * v[j][0] + v[j][1] * v[j][1] + v[j][2] * v[j][2] + v[j][3] * v[j][3]; }
        const float rs = rsqrtf(wave_sum(ss, F.lane) * (1.f / DM) + 1e-6f);
        const float* sh = mod + (size_t)bi * 6144 + 3 * 1024, *sc = sh + 1024;
        unsigned char* hr = H8 + (size_t)row * DM;
#pragma unroll
        for (int j = 0; j < 4; ++j) { const f32x4 s4 = *(const f32x4*)(sc + 4 * F.lane + 256 * j), h4 = *(const f32x4*)(sh + 4 * F.lane + 256 * j);
            v[j] = v[j] * rs * gv[j] * (s4 + 1.f) + h4; *(unsigned*)(hr + 4 * F.lane + 256 * j) = pk4f8(v[j][0] * H8_SCALE, v[j][1] * H8_SCALE, v[j][2] * H8_SCALE, v[j][3] * H8_SCALE); }
        float p[32];
#pragma unroll
        for (int e = 0; e < 32; ++e) { float s = 0.f;
#pragma unroll
            for (int j = 0; j < 4; ++j) { const f32x4 w4 = *(const LAS f32x4*)(rwt + e * 1024 + 4 * F.lane + 256 * j); s += v[j][0] * w4[0] + v[j][1] * w4[1] + v[j][2] * w4[2] + v[j][3] * w4[3]; }
            p[e] = s; if ((e & 3) == 3) asm volatile("" : "+v"(p[e]), "+v"(p[e - 1]), "+v"(p[e - 2]), "+v"(p[e - 3]) :: "memory"); }
#define RED_LEVEL(NKEEP, BIT, XCH) { const bool hi = (F.lane & (BIT)) != 0; _Pragma("unroll") for (int e = 0; e < (NKEEP); ++e) { const float send = hi ? p[e] : p[e + (NKEEP)], keep = hi ? p[e + (NKEEP)] : p[e]; p[e] = keep + XCH; } }
        RED_LEVEL(16, 32, xor32f(send, F.lane)) RED_LEVEL(8, 16, swz_xor<16>(send)) RED_LEVEL(4, 8, swz_xor<8>(send)) RED_LEVEL(2, 4, swz_xor<4>(send)) RED_LEVEL(1, 2, swz_xor<2>(send))
#undef RED_LEVEL
        float logit = p[0] + swz_xor<1>(p[0]) + rb;
        int es[4]; float ls[4];
#pragma unroll
        for (int k = 0; k < 4; ++k) {
            const float m = wave_max(logit, F.lane);
            const unsigned long long bal = __ballot(logit == m);
            const int fl = __builtin_ctzll(bal); es[k] = fl >> 1; ls[k] = m;
            if ((F.lane >> 1) == es[k]) logit = -3.0e38f;
        }
        const float e1 = __expf(ls[1] - ls[0]), e2 = __expf(ls[2] - ls[0]), e3 = __expf(ls[3] - ls[0]); const float inv = 1.f / (1.f + e1 + e2 + e3);
        if (F.lane < 4) {
            const int e = F.lane == 0 ? es[0] : (F.lane == 1 ? es[1] : (F.lane == 2 ? es[2] : es[3]));
            const float gt = (F.lane == 0 ? 1.f : (F.lane == 1 ? e1 : (F.lane == 2 ? e2 : e3))) * inv;
            const unsigned rk = __hip_atomic_fetch_add(cnt + e, 1u, RLX_AGENT);
            PE[row * 4 + F.lane] = e; PR[row * 4 + F.lane] = (int)rk; PG[row * 4 + F.lane] = gt;
        }
    }
    __syncthreads();
}
__device__ __forceinline__ void p_dispatch(Frame& F, int L, int nrows) {
    LAS int* base = (LAS int*)F.lds;
    unsigned* cnt = F.ctl + CW_CNT + L * 64; unsigned* blke = F.ctl + CW_BLKE + L * 1024;
    if (F.tid == 0) { int acc = 0; for (int e = 0; e < NEXP; ++e) { base[e] = acc; const int c = (int)__hip_atomic_load(cnt + e, RLX_AGENT); acc += (c + 255) & ~255; } base[32] = acc; }
    __syncthreads();
    if (F.bid == 0) { const int nblk = base[32] >> 8; if (F.tid == 0) blke[0] = (unsigned)nblk;
        for (int i = F.tid; i < nblk; i += NTHR) { int e = 0; for (int q = 1; q < NEXP; ++q) if (base[q] <= i * 256) e = q; blke[1 + i] = (unsigned)e; } }
    const int gw = F.bid * NWAVES + F.wave, NGW = F.G * NWAVES;
    const int* PE = (const int*)(F.ws + WS_PE); const int* PR = (const int*)(F.ws + WS_PR); const float* PG = (const float*)(F.ws + WS_PG);
    int* PS = (int*)(F.ws + WS_PS); float* SG = (float*)(F.ws + WS_SG);
    const unsigned char* H8 = (const unsigned char*)(F.ws + WS_H8); unsigned char* BUF = (unsigned char*)(F.ws + WS_BUF);
    for (int pr = gw; pr < nrows * 4; pr += NGW) {
        const int e = PE[pr], slot = base[e] + PR[pr];
        const u32x4* src = (const u32x4*)(H8 + (size_t)(pr >> 2) * DM); u32x4* dst = (u32x4*)(BUF + (size_t)slot * DM);
        dst[F.lane] = src[F.lane];
        if (F.lane == 0) { PS[pr] = slot; SG[slot] = PG[pr]; }
    }
    __syncthreads();
}
__device__ __forceinline__ void p_final(Frame& F, CArgs& a) {
    const int gw = F.bid * NWAVES + F.wave, NGW = F.G * NWAVES;
    const float* XS = (const float*)(F.ws + WS_XS);
    const float* modp = (const float*)(F.ws + WS_MOD) + (size_t)(DEPTH - 1) * 9 * 6144;
    const int* PS = (const int*)(F.ws + WS_PS); const bf16* Y = (const bf16*)(F.ws + WS_Y);
    const float* g = a.in[I_FING];
    f32x4 gv[4];
#pragma unroll
    for (int j = 0; j < 4; ++j) gv[j] = *(const f32x4*)(g + 4 * F.lane + 256 * j);
    for (int row = gw; row < NLAT; row += NGW) {
        const int bi = row >> 12;
        const float* xr = XS + (size_t)row * DM;
        f32x4 v[4], s[4];
#pragma unroll
        for (int j = 0; j < 4; ++j) { v[j] = *(const f32x4*)(xr + 4 * F.lane + 256 * j); s[j] = (f32x4){0.f, 0.f, 0.f, 0.f}; }
#pragma unroll
        for (int k = 0; k < 4; ++k) { const int slot = PS[row * 4 + k]; const bf16* yr = Y + (size_t)slot * DM;
#pragma unroll
            for (int j = 0; j < 4; ++j) { const u32x2 w = *(const u32x2*)(yr + 4 * F.lane + 256 * j); s[j] += (f32x4){bflo(w.x), bfhi(w.x), bflo(w.y), bfhi(w.y)}; } }
        const float* m5 = modp + (size_t)bi * 6144 + 5 * 1024;
        float ss = 0.f;
#pragma unroll
        for (int j = 0; j < 4; ++j) { v[j] += *(const f32x4*)(m5 + 4 * F.lane + 256 * j) * s[j]; ss += v[j][0] * v[j][0] + v[j][1] * v[j][1] + v[j][2] * v[j][2] + v[j][3] * v[j][3]; }
        const float rs = rsqrtf(wave_sum(ss, F.lane) * (1.f / DM) + 1e-6f);
        float* orow = a.out + (size_t)row * DM;
#pragma unroll
        for (int j = 0; j < 4; ++j) *(f32x4*)(orow + 4 * F.lane + 256 * j) = v[j] * rs * gv[j];
    }
}

#define MFMA16(a, b, c) __builtin_amdgcn_mfma_f32_16x16x32_bf16((a), (b), (c), 0, 0, 0)
typedef short v4i16_t __attribute__((ext_vector_type(4)));
__device__ __forceinline__ s16x4 trread(const LAS void* p) { return __builtin_bit_cast(s16x4, __builtin_amdgcn_ds_read_tr16_b64_v4i16((LAS v4i16_t*)p)); }
__device__ __forceinline__ bf16x8 cat8(s16x4 a, s16x4 b) { return __builtin_shufflevector(a, b, 0, 1, 2, 3, 4, 5, 6, 7); }
__device__ __forceinline__ bf16x8 pack8(const float* v) { u32x4 w; w.x = pg8::cvt_pk_bf16(v[0], v[1]); w.y = pg8::cvt_pk_bf16(v[2], v[3]); w.z = pg8::cvt_pk_bf16(v[4], v[5]); w.w = pg8::cvt_pk_bf16(v[6], v[7]); return __builtin_bit_cast(bf16x8, w); }
__device__ __forceinline__ void unpack8(bf16x8 x, float* v) { const u32x4 w = __builtin_bit_cast(u32x4, x); v[0] = bflo(w.x); v[1] = bfhi(w.x); v[2] = bflo(w.y); v[3] = bfhi(w.y); v[4] = bflo(w.z); v[5] = bfhi(w.z); v[6] = bflo(w.w); v[7] = bfhi(w.w); }
#define OPQ(x) ({ int o_ = (x); asm volatile("" : "+s"(o_)); o_; })
#define LAUNDER_F(F0) Frame F = F0; { const int t_ = fresh_tid(F.wave); F.tid = t_; F.lane = t_ & 63; }
__device__ __forceinline__ int chunk_tok0(int cid) { return cid < 512 ? cid * 64 : NLAT + (cid - 512) * 64; }

constexpr int GL_QS = 136, GL_VS = 264, GL_BS = 260;
constexpr int GL_Q = 0, GL_K = GL_Q + 64 * GL_QS * 2, GL_V = GL_K + 64 * GL_QS * 2, GL_A1 = GL_V + 64 * GL_VS * 2, GL_B = GL_A1 + 64 * 32 * 2, GL_END = GL_B + 64 * GL_BS * 4;
static_assert(GL_END <= MISC_OFF, "GLA LDS");
template <bool OUT> __device__ __forceinline__ void gla_chunk(Frame& F0, CArgs& a, int L, int cid) {
    LAUNDER_F(F0)
    const int tok0 = chunk_tok0(cid);
    const bf16* P = (const bf16*)(F.ws + WS_PBUF) + (size_t)tok0 * PW;
    LAS bf16* sq = (LAS bf16*)(F.lds + GL_Q); LAS bf16* sk = (LAS bf16*)(F.lds + GL_K); LAS bf16* sv = (LAS bf16*)(F.lds + GL_V); LAS bf16* sa1 = (LAS bf16*)(F.lds + GL_A1); LAS float* sB = (LAS float*)(F.lds + GL_B);
    __syncthreads();
    {   u32x4 rq[2], rk[2], rv[4], ra = (u32x4){0u, 0u, 0u, 0u};
#pragma unroll
        for (int k = 0; k < 2; ++k) { const int i = F.tid + k * NTHR, t = i >> 4, pc = i & 15; rq[k] = *(const u32x4*)(P + (size_t)t * PW + PC_Q + pc * 8); rk[k] = *(const u32x4*)(P + (size_t)t * PW + PC_K + pc * 8); }
#pragma unroll
        for (int k = 0; k < 4; ++k) { const int i = F.tid + k * NTHR, t = i >> 5, pc = i & 31; rv[k] = *(const u32x4*)(P + (size_t)t * PW + PC_V + pc * 8); }
        if (F.tid < 256) { const int t = F.tid >> 2, pc = F.tid & 3; ra = *(const u32x4*)(P + (size_t)t * PW + PC_A1 + pc * 8); }
#pragma unroll
        for (int k = 0; k < 2; ++k) { const int i = F.tid + k * NTHR, t = i >> 4, pc = i & 15; *(LAS u32x4*)(sq + t * GL_QS + pc * 8) = rq[k]; *(LAS u32x4*)(sk + t * GL_QS + pc * 8) = rk[k]; }
#pragma unroll
        for (int k = 0; k < 4; ++k) { const int i = F.tid + k * NTHR, t = i >> 5, pc = i & 31; *(LAS u32x4*)(sv + t * GL_VS + pc * 8) = rv[k]; }
        if (F.tid < 256) { const int t = F.tid >> 2, pc = F.tid & 3; *(LAS u32x4*)(sa1 + t * 32 + pc * 8) = ra; }
    }
    __syncthreads();
    {
        const int col = F.tid & 255, r = col >> 7, c = col & 127, th = F.tid >> 8;
        float a2v[16];
#pragma unroll
        for (int i = 0; i < 16; ++i) a2v[i] = a.in[I_GLAA2][((size_t)(L * 2 + r) * 16 + i) * 128 + c];
        const float ab = a.in[I_GLAAB][(L * 2 + r) * 128 + c];
        for (int i = 0; i < 32; ++i) { const int t = th * 32 + i; float z = ab; float av[8];
            unpack8(*(const LAS bf16x8*)(sa1 + t * 32 + r * 16), av);
#pragma unroll
            for (int q = 0; q < 8; ++q) z += av[q] * a2v[q];
            unpack8(*(const LAS bf16x8*)(sa1 + t * 32 + r * 16 + 8), av);
#pragma unroll
            for (int q = 0; q < 8; ++q) z += av[q] * a2v[8 + q];
            const float ls = fminf(z, 0.f) - __logf(1.f + __expf(-fabsf(z)));
            sB[t * GL_BS + col] = ls * (1.f / 16.f); }
    }
    __syncthreads();
    if (F.tid < 256) { const int col = F.tid, r = col >> 7; float b = 0.f;
        for (int i = 0; i < 64; ++i) { const int t = r ? 63 - i : i; b += sB[t * GL_BS + col]; sB[t * GL_BS + col] = b; } }
    __syncthreads();
    const int hh = F.wave & 3, r = F.wave >> 2, lr = F.lane & 15, g = F.lane >> 4;
    const int bc = r * 128 + hh * 32;
    const size_t ub = ((size_t)cid * 4 + hh) * 2 + r;
    if constexpr (!OUT) {
        const int tl = r ? 0 : 63;
        f32x4 acc[2][4];
#pragma unroll
        for (int mc = 0; mc < 2; ++mc)
#pragma unroll
            for (int d = 0; d < 4; ++d) acc[mc][d] = (f32x4){0.f, 0.f, 0.f, 0.f};
#pragma unroll
        for (int sg = 0; sg < 2; ++sg) {
            bf16x8 vf[4];
#pragma unroll
            for (int d = 0; d < 4; ++d) { const LAS bf16* p0 = sv + (32 * sg + 8 * g + ((F.lane & 15) >> 2)) * GL_VS + hh * 64 + 16 * d + 4 * (F.lane & 3); vf[d] = cat8(trread(p0), trread(p0 + 4 * GL_VS)); }
#pragma unroll
            for (int mc = 0; mc < 2; ++mc) {
                const LAS bf16* p0 = sk + (32 * sg + 8 * g + ((F.lane & 15) >> 2)) * GL_QS + hh * 32 + 16 * mc + 4 * (F.lane & 3);
                const s16x4 k0 = trread(p0), k1 = trread(p0 + 4 * GL_QS);
                const int c = 16 * mc + lr; const float bl = sB[tl * GL_BS + bc + c];
                float kv[8];
#pragma unroll
                for (int e = 0; e < 4; ++e) { kv[e] = bf2f((unsigned short)k0[e]) * __expf(bl - sB[(32 * sg + 8 * g + e) * GL_BS + bc + c]); kv[4 + e] = bf2f((unsigned short)k1[e]) * __expf(bl - sB[(32 * sg + 8 * g + 4 + e) * GL_BS + bc + c]); }
                const bf16x8 kf = pack8(kv);
#pragma unroll
                for (int d = 0; d < 4; ++d) acc[mc][d] = MFMA16(kf, vf[d], acc[mc][d]);
            }
        }
        float* ds = (float*)(F.ws + WS_GDS) + ub * 2048;
#pragma unroll
        for (int mc = 0; mc < 2; ++mc)
#pragma unroll
            for (int d = 0; d < 4; ++d) *(f32x4*)(ds + (16 * d + lr) * 32 + 16 * mc + 4 * g) = acc[mc][d];
        if (F.lane < 32) ((float*)(F.ws + WS_GDEC))[ub * 32 + F.lane] = __expf(sB[tl * GL_BS + bc + F.lane]);
    } else {
        bf16x8 qf[4], kf[4];
#pragma unroll
        for (int m = 0; m < 4; ++m) { const int t = 16 * m + lr; float qv[8], kv[8], bv[8];
            unpack8(*(const LAS bf16x8*)(sq + t * GL_QS + hh * 32 + 8 * g), qv); unpack8(*(const LAS bf16x8*)(sk + t * GL_QS + hh * 32 + 8 * g), kv);
            *(f32x4*)bv = *(const LAS f32x4*)(sB + t * GL_BS + bc + 8 * g); *(f32x4*)(bv + 4) = *(const LAS f32x4*)(sB + t * GL_BS + bc + 8 * g + 4);
#pragma unroll
            for (int e = 0; e < 8; ++e) { const float ex = __expf(bv[e]); qv[e] *= 0.17677669529663687f * ex; kv[e] *= __frcp_rn(ex); }
            qf[m] = pack8(qv); kf[m] = pack8(kv); }
        f32x4 o[4][4];
#pragma unroll
        for (int m = 0; m < 4; ++m)
#pragma unroll
            for (int d = 0; d < 4; ++d) o[m][d] = (f32x4){0.f, 0.f, 0.f, 0.f};
        {
            const bf16* se = (const bf16*)(F.ws + WS_GSE) + ub * 2048;
#pragma unroll
            for (int d = 0; d < 4; ++d) { const bf16x8 sf = *(const bf16x8*)(se + (16 * d + lr) * 32 + 8 * g);
#pragma unroll
                for (int m = 0; m < 4; ++m) o[m][d] = MFMA16(qf[m], sf, o[m][d]); }
        }
        bf16x8 vf[2][4];
#pragma unroll
        for (int sg = 0; sg < 2; ++sg)
#pragma unroll
            for (int d = 0; d < 4; ++d) { const LAS bf16* p0 = sv + (32 * sg + 4 * g + ((F.lane & 15) >> 2)) * GL_VS + hh * 64 + 16 * d + 4 * (F.lane & 3); vf[sg][d] = cat8(trread(p0), trread(p0 + 16 * GL_VS)); }
        const f32x4 zero4 = (f32x4){0.f, 0.f, 0.f, 0.f};
#pragma unroll
        for (int m = 0; m < 4; ++m) {
            const int t = 16 * m + lr;
#pragma unroll
            for (int sg = 0; sg < 2; ++sg) {
                f32x4 p0 = MFMA16(kf[2 * sg], qf[m], zero4), p1 = MFMA16(kf[2 * sg + 1], qf[m], zero4);
                float pv[8];
#pragma unroll
                for (int j = 0; j < 4; ++j) { const int s0 = 32 * sg + 4 * g + j, s1 = s0 + 16; pv[j] = (r ? s0 >= t : s0 <= t) ? p0[j] : 0.f; pv[4 + j] = (r ? s1 >= t : s1 <= t) ? p1[j] : 0.f; }
                const bf16x8 pf = pack8(pv);
#pragma unroll
                for (int d = 0; d < 4; ++d) o[m][d] = MFMA16(pf, vf[sg][d], o[m][d]);
            }
        }
        __syncthreads();
        LAS float* ox = (LAS float*)(F.lds + GL_B);
        LAS bf16* ot = (LAS bf16*)(F.lds + GL_Q);
        LAS bf16* srg = (LAS bf16*)(F.lds + GL_V);
        for (int i = F.tid; i < 2048; i += NTHR) { const int t = i >> 5, pc = i & 31; *(LAS u32x4*)(srg + t * GL_VS + pc * 8) = *(const u32x4*)(P + (size_t)t * PW + PC_R + pc * 8); }
        if (r == 1) {
#pragma unroll
            for (int m = 0; m < 4; ++m)
#pragma unroll
                for (int d = 0; d < 4; ++d)
#pragma unroll
                    for (int j = 0; j < 4; ++j) ox[(hh * 64 + 16 * m + 4 * g + j) * 65 + 16 * d + lr] = o[m][d][j];
        }
        __syncthreads();
        if (r == 0) {
            const float* ng = a.in[I_GLANG] + L * 64;
            float gn[4];
#pragma unroll
            for (int d = 0; d < 4; ++d) gn[d] = ng[16 * d + lr];
#pragma unroll
            for (int m = 0; m < 4; ++m)
#pragma unroll
                for (int j = 0; j < 4; ++j) {
                    const int t = 16 * m + 4 * g + j; float v[4], ss = 0.f;
#pragma unroll
                    for (int d = 0; d < 4; ++d) { v[d] = o[m][d][j] + ox[(hh * 64 + t) * 65 + 16 * d + lr]; ss += v[d] * v[d]; }
                    ss += swz_xor<1>(ss); ss += swz_xor<2>(ss); ss += swz_xor<4>(ss); ss += swz_xor<8>(ss);
                    const float rs = rsqrtf(ss * (1.f / 64.f) + 1e-6f);
#pragma unroll
                    for (int d = 0; d < 4; ++d) { const float rg = bf2f(srg[t * GL_VS + hh * 64 + 16 * d + lr]); ot[t * 264 + hh * 64 + 16 * d + lr] = (bf16)f2bf(v[d] * rs * gn[d] * siluf_(rg)); }
                }
        }
        __syncthreads();
        bf16* MX = (bf16*)(F.ws + WS_MIX) + (size_t)tok0 * MW + 768;
        for (int i = F.tid; i < 2048; i += NTHR) { const int t = i >> 5, pc = i & 31; *(u32x4*)(MX + (size_t)t * MW + pc * 8) = *(const LAS u32x4*)(ot + t * 264 + pc * 8); }
    }
}

constexpr int SD_RS = 520;
constexpr int SD_RAW = 0, SD_XC = SD_RAW + 68 * SD_RS * 2, SD_DT = SD_XC + 64 * SD_RS * 2, SD_CUM = SD_DT + 64 * 8 * 4, SD_W = SD_CUM + 8 * 64 * 4, SD_END = SD_W + 8 * 64 * 4;
static_assert(SD_END <= MISC_OFF && 64 * 260 * 4 <= 68 * SD_RS * 2, "SSD LDS");
template <bool OUT> __device__ __forceinline__ void ssd_chunk(Frame& F0, CArgs& a, int L, int cid) {
    LAUNDER_F(F0)
    const int tok0 = chunk_tok0(cid);
    const bf16* PB = (const bf16*)(F.ws + WS_PBUF);
    LAS bf16* raw = (LAS bf16*)(F.lds + SD_RAW); LAS bf16* xc = (LAS bf16*)(F.lds + SD_XC); LAS float* sdt = (LAS float*)(F.lds + SD_DT); LAS float* scum = (LAS float*)(F.lds + SD_CUM); LAS float* sw = (LAS float*)(F.lds + SD_W);
    __syncthreads();
    {
        const int isctx = cid >= 512, c4 = (cid - 512) & 3;
        u32x4 rv[9];
#pragma unroll
        for (int k = 0; k < 9; ++k) { const int i = F.tid + k * NTHR, rr = i >> 6, pc = i & 63, t = rr - 2; rv[k] = (u32x4){0u, 0u, 0u, 0u};
            bool ok = t >= 0 && t < 64 && i < 68 * 64; if (isctx) { const int tt = c4 * 64 + t; ok = tt >= 0 && tt < 256 && i < 68 * 64; }
            if (ok) rv[k] = *(const u32x4*)(PB + (size_t)(tok0 + t) * PW + PC_XBC + pc * 8); }
#pragma unroll
        for (int k = 0; k < 9; ++k) { const int i = F.tid + k * NTHR, rr = i >> 6, pc = i & 63; if (i < 68 * 64) *(LAS u32x4*)(raw + rr * SD_RS + pc * 8) = rv[k]; }
        if (F.tid < 64) { float dv[8]; unpack8(*(const bf16x8*)(PB + (size_t)(tok0 + F.tid) * PW + PC_DT), dv);
#pragma unroll
            for (int q = 0; q < 8; ++q) { const float z = dv[q] + a.in[I_SSDDTB][L * 8 + q]; sdt[F.tid * 8 + q] = z > 20.f ? z : __logf(1.f + __expf(z)); } }
    }
    __syncthreads();
    {
        const int ch = F.tid; float w[5];
#pragma unroll
        for (int k = 0; k < 5; ++k) w[k] = a.in[I_SSDCW][((size_t)L * 5 + k) * 512 + ch];
        const float cb = a.in[I_SSDCB][L * 512 + ch];
        float x0 = bf2f(raw[0 * SD_RS + ch]), x1 = bf2f(raw[1 * SD_RS + ch]), x2 = bf2f(raw[2 * SD_RS + ch]), x3 = bf2f(raw[3 * SD_RS + ch]);
        for (int t = 0; t < 64; ++t) { const float x4 = bf2f(raw[(t + 4) * SD_RS + ch]); const float y = cb + w[0] * x0 + w[1] * x1 + w[2] * x2 + w[3] * x3 + w[4] * x4;
            xc[t * SD_RS + ch] = (bf16)f2bf(siluf_(y)); x0 = x1; x1 = x2; x2 = x3; x3 = x4; }
    }
    {
        const int q = F.wave, rr = q >> 2, t = rr ? 63 - F.lane : F.lane;
        const float aa = -__expf(a.in[I_SSDALOG][L * 8 + q]); const float dtv = sdt[t * 8 + q];
        float c = dtv * aa;
        { float o;
          o = __builtin_bit_cast(float, __builtin_amdgcn_ds_bpermute((F.lane - 1) << 2, __builtin_bit_cast(int, c))); if (F.lane >= 1) c += o;
          o = __builtin_bit_cast(float, __builtin_amdgcn_ds_bpermute((F.lane - 2) << 2, __builtin_bit_cast(int, c))); if (F.lane >= 2) c += o;
          o = __builtin_bit_cast(float, __builtin_amdgcn_ds_bpermute((F.lane - 4) << 2, __builtin_bit_cast(int, c))); if (F.lane >= 4) c += o;
          o = __builtin_bit_cast(float, __builtin_amdgcn_ds_bpermute((F.lane - 8) << 2, __builtin_bit_cast(int, c))); if (F.lane >= 8) c += o;
          o = __builtin_bit_cast(float, __builtin_amdgcn_ds_bpermute((F.lane - 16) << 2, __builtin_bit_cast(int, c))); if (F.lane >= 16) c += o;
          o = __builtin_bit_cast(float, __builtin_amdgcn_ds_bpermute((F.lane - 32) << 2, __builtin_bit_cast(int, c))); if (F.lane >= 32) c += o; }
        const float cl = __builtin_bit_cast(float, __builtin_amdgcn_ds_bpermute(63 << 2, __builtin_bit_cast(int, c)));
        scum[q * 64 + t] = c; sw[q * 64 + t] = __expf(cl - c) * dtv;
    }
    __syncthreads();
    const int h = F.wave & 3, r = F.wave >> 2, lr = F.lane & 15, g = F.lane >> 4, gp = h >> 1, rh = r * 4 + h;
    const size_t ub = ((size_t)cid * 4 + h) * 2 + r;
    if constexpr (!OUT) {
        f32x4 acc[4][4];
#pragma unroll
        for (int ms = 0; ms < 4; ++ms)
#pragma unroll
            for (int d = 0; d < 4; ++d) acc[ms][d] = (f32x4){0.f, 0.f, 0.f, 0.f};
#pragma unroll
        for (int sg = 0; sg < 2; ++sg) {
            const int trow = 32 * sg + 8 * g;
            bf16x8 xf[4];
#pragma unroll
            for (int d = 0; d < 4; ++d) { const LAS bf16* p0 = xc + (trow + ((F.lane & 15) >> 2)) * SD_RS + h * 64 + 16 * d + 4 * (F.lane & 3); xf[d] = cat8(trread(p0), trread(p0 + 4 * SD_RS)); }
            float wv[8];
            *(f32x4*)wv = *(const LAS f32x4*)(sw + rh * 64 + trow); *(f32x4*)(wv + 4) = *(const LAS f32x4*)(sw + rh * 64 + trow + 4);
#pragma unroll
            for (int ms = 0; ms < 4; ++ms) {
                const LAS bf16* p0 = xc + (trow + ((F.lane & 15) >> 2)) * SD_RS + 256 + gp * 64 + 16 * ms + 4 * (F.lane & 3);
                const s16x4 b0 = trread(p0), b1 = trread(p0 + 4 * SD_RS);
                float bv[8];
#pragma unroll
                for (int e = 0; e < 4; ++e) { bv[e] = bf2f((unsigned short)b0[e]) * wv[e]; bv[4 + e] = bf2f((unsigned short)b1[e]) * wv[4 + e]; }
                const bf16x8 bf = pack8(bv);
#pragma unroll
                for (int d = 0; d < 4; ++d) acc[ms][d] = MFMA16(bf, xf[d], acc[ms][d]);
            }
        }
        float* ds = (float*)(F.ws + WS_SDS) + ub * 4096;
#pragma unroll
        for (int ms = 0; ms < 4; ++ms)
#pragma unroll
            for (int d = 0; d < 4; ++d) *(f32x4*)(ds + (16 * d + lr) * 64 + 16 * ms + 4 * g) = acc[ms][d];
        if (F.lane == 0) ((float*)(F.ws + WS_SDEC))[ub] = __expf(scum[rh * 64 + (r ? 0 : 63)]);
    } else {
        bf16x8 bfr[4][2], cfr[4][2];
#pragma unroll
        for (int m = 0; m < 4; ++m)
#pragma unroll
            for (int ks = 0; ks < 2; ++ks) { bfr[m][ks] = *(const LAS bf16x8*)(xc + (16 * m + lr) * SD_RS + 256 + gp * 64 + 32 * ks + 8 * g); cfr[m][ks] = *(const LAS bf16x8*)(xc + (16 * m + lr) * SD_RS + 384 + gp * 64 + 32 * ks + 8 * g); }
        f32x4 y[4][4];
#pragma unroll
        for (int m = 0; m < 4; ++m)
#pragma unroll
            for (int d = 0; d < 4; ++d) y[m][d] = (f32x4){0.f, 0.f, 0.f, 0.f};
        {
            const bf16* se = (const bf16*)(F.ws + WS_SSE) + ub * 4096;
            bf16x8 cs[4][2];
#pragma unroll
            for (int m = 0; m < 4; ++m) { const float ec = __expf(scum[rh * 64 + 16 * m + lr]);
#pragma unroll
                for (int ks = 0; ks < 2; ++ks) { float cv[8]; unpack8(cfr[m][ks], cv);
#pragma unroll
                    for (int e = 0; e < 8; ++e) cv[e] *= ec;
                    cs[m][ks] = pack8(cv); } }
#pragma unroll
            for (int d = 0; d < 4; ++d) {
                const bf16x8 sf0 = *(const bf16x8*)(se + (16 * d + lr) * 64 + 8 * g), sf1 = *(const bf16x8*)(se + (16 * d + lr) * 64 + 32 + 8 * g);
#pragma unroll
                for (int m = 0; m < 4; ++m) { y[m][d] = MFMA16(cs[m][0], sf0, y[m][d]); y[m][d] = MFMA16(cs[m][1], sf1, y[m][d]); }
            }
        }
        asm volatile("" ::: "memory");
        bf16x8 xf[2][4];
#pragma unroll
        for (int sg = 0; sg < 2; ++sg)
#pragma unroll
            for (int d = 0; d < 4; ++d) { const LAS bf16* p0 = xc + (32 * sg + 4 * g + ((F.lane & 15) >> 2)) * SD_RS + h * 64 + 16 * d + 4 * (F.lane & 3); xf[sg][d] = cat8(trread(p0), trread(p0 + 16 * SD_RS)); }
        const f32x4 zero4 = (f32x4){0.f, 0.f, 0.f, 0.f};
#pragma unroll
        for (int m = 0; m < 4; ++m) {
            const int t = 16 * m + lr; const float ct = scum[rh * 64 + t];
#pragma unroll
            for (int sg = 0; sg < 2; ++sg) {
                f32x4 p0 = MFMA16(bfr[2 * sg][0], cfr[m][0], zero4), p1 = MFMA16(bfr[2 * sg + 1][0], cfr[m][0], zero4);
                p0 = MFMA16(bfr[2 * sg][1], cfr[m][1], p0); p1 = MFMA16(bfr[2 * sg + 1][1], cfr[m][1], p1);
                float pv[8];
#pragma unroll
                for (int j = 0; j < 4; ++j) { const int s0 = 32 * sg + 4 * g + j, s1 = s0 + 16;
                    pv[j] = (r ? s0 >= t : s0 <= t) ? p0[j] * __expf(ct - scum[rh * 64 + s0]) * sdt[s0 * 8 + rh] : 0.f;
                    pv[4 + j] = (r ? s1 >= t : s1 <= t) ? p1[j] * __expf(ct - scum[rh * 64 + s1]) * sdt[s1 * 8 + rh] : 0.f; }
                const bf16x8 pf = pack8(pv);
#pragma unroll
                for (int d = 0; d < 4; ++d) y[m][d] = MFMA16(pf, xf[sg][d], y[m][d]);
            }
        }
        __syncthreads();
        LAS float* yx = (LAS float*)(F.lds + SD_RAW);
        if (r == 1) {
#pragma unroll
            for (int m = 0; m < 4; ++m)
#pragma unroll
                for (int d = 0; d < 4; ++d)
#pragma unroll
                    for (int j = 0; j < 4; ++j) yx[(16 * m + 4 * g + j) * 260 + h * 64 + 16 * d + lr] = y[m][d][j];
        }
        __syncthreads();
        if (r == 0) { const float dsk = a.in[I_SSDD][L * 4 + h];
#pragma unroll
            for (int m = 0; m < 4; ++m)
#pragma unroll
                for (int d = 0; d < 4; ++d)
#pragma unroll
                    for (int j = 0; j < 4; ++j) { const int t = 16 * m + 4 * g + j, c = h * 64 + 16 * d + lr; yx[t * 260 + c] += y[m][d][j] + dsk * bf2f(xc[t * SD_RS + c]); asm volatile("" ::: "memory"); }
        }
        __syncthreads();
        { const int t = F.tid >> 3, c0 = (F.tid & 7) * 32; const bf16* zr = PB + (size_t)(tok0 + t) * PW + PC_Z + c0; const float* ng = a.in[I_SSDNG] + L * 256 + c0;
          float v[32]; float ss = 0.f;
#pragma unroll
          for (int q = 0; q < 4; ++q) { float zv[8]; unpack8(*(const bf16x8*)(zr + 8 * q), zv);
#pragma unroll
              for (int e = 0; e < 8; ++e) { const float u = yx[t * 260 + c0 + 8 * q + e] * siluf_(zv[e]); v[8 * q + e] = u; ss += u * u; } }
          ss += swz_xor<1>(ss); ss += swz_xor<2>(ss); ss += swz_xor<4>(ss);
          const float rs = rsqrtf(ss * (1.f / 256.f) + 1e-6f);
          bf16* MX = (bf16*)(F.ws + WS_MIX) + (size_t)(tok0 + t) * MW + 1024 + c0;
#pragma unroll
          for (int q = 0; q < 4; ++q) { float o8[8];
#pragma unroll
              for (int e = 0; e < 8; ++e) o8[e] = v[8 * q + e] * rs * ng[8 * q + e];
              *(bf16x8*)(MX + 8 * q) = pack8(o8); } }
    }
}

constexpr int FF_XP = 0, FF_TR = FF_XP + 16 * 64 * 16 * 2, FF_TI = FF_TR + 16 * 64 * 16 * 2, FF_END = FF_TI + 16 * 64 * 16 * 2;
__device__ __forceinline__ void fft_unit(Frame& F0, int u) {
    LAUNDER_F(F0)
    const int b = u >> 6, cg = (u >> 2) & 15, kb = u & 3, lr = F.lane & 15, g = F.lane >> 4;
    const bf16* PB = (const bf16*)(F.ws + WS_PBUF) + (size_t)b * SEQ * PW + PC_FU + 16 * cg;
    const bf16* f64 = (const bf16*)(F.ws + WS_TAB + TAB_F64); const float* tw = (const float*)(F.ws + WS_TAB + TAB_TW);
    LAS bf16* xp = (LAS bf16*)(F.lds + FF_XP); LAS bf16* tr = (LAS bf16*)(F.lds + FF_TR); LAS bf16* ti = (LAS bf16*)(F.lds + FF_TI);
    bf16x8 fc1[2], fs1[2];
#pragma unroll
    for (int ks = 0; ks < 2; ++ks) { fc1[ks] = *(const bf16x8*)(f64 + (16 * kb + lr) * 64 + 32 * ks + 8 * g); fs1[ks] = *(const bf16x8*)(f64 + 4096 + (16 * kb + lr) * 64 + 32 * ks + 8 * g); }
    const f32x4 zero4 = (f32x4){0.f, 0.f, 0.f, 0.f};
    u32x4 xr[4];
#pragma unroll
    for (int k = 0; k < 4; ++k) { const int i = F.tid + k * NTHR, n2l = i >> 7, n1 = (i >> 1) & 63, hf = i & 1; xr[k] = *(const u32x4*)(PB + (size_t)(64 * n1 + n2l) * PW + hf * 8); }
    for (int pa = 0; pa < 4; ++pa) {
        __syncthreads();
#pragma unroll
        for (int k = 0; k < 4; ++k) { const int i = F.tid + k * NTHR, n2l = i >> 7, n1 = (i >> 1) & 63, hf = i & 1; *(LAS u32x4*)(xp + (n2l * 64 + n1) * 16 + hf * 8) = xr[k]; }
        if (pa < 3) {
#pragma unroll
            for (int k = 0; k < 4; ++k) { const int i = F.tid + k * NTHR, n2l = i >> 7, n1 = (i >> 1) & 63, hf = i & 1; xr[k] = *(const u32x4*)(PB + (size_t)(64 * n1 + 16 * (pa + 1) + n2l) * PW + hf * 8); }
        }
        __syncthreads();
#pragma unroll
        for (int q = 0; q < 2; ++q) {
            const int n2l = 2 * F.wave + q, n2 = 16 * pa + n2l;
            f32x4 tc = zero4, ts = zero4;
#pragma unroll
            for (int ks = 0; ks < 2; ++ks) { const LAS bf16* p0 = xp + (n2l * 64 + 32 * ks + 8 * g + ((F.lane & 15) >> 2)) * 16 + 4 * (F.lane & 3); const bf16x8 xb = cat8(trread(p0), trread(p0 + 4 * 16));
                tc = MFMA16(fc1[ks], xb, tc); ts = MFMA16(fs1[ks], xb, ts); }
#pragma unroll
            for (int j = 0; j < 4; ++j) { const int k1l = 4 * g + j, k1 = 16 * kb + k1l; const f32x2 w = *(const f32x2*)(tw + 2 * (n2 * k1));
                tr[(k1l * 64 + n2) * 16 + lr] = (bf16)f2bf(tc[j] * w[0] - ts[j] * w[1]); ti[(k1l * 64 + n2) * 16 + lr] = (bf16)f2bf(-(tc[j] * w[1] + ts[j] * w[0])); }
        }
    }
    __syncthreads();
    bf16* MX = (bf16*)(F.ws + WS_MIX) + (size_t)b * SEQ * MW + 16 * cg + lr;
#pragma unroll
    for (int q = 0; q < 2; ++q) {
        const int k1l = 2 * F.wave + q, k1 = 16 * kb + k1l;
        bf16x8 br[2], bi[2];
#pragma unroll
        for (int ks = 0; ks < 2; ++ks) { const int off = (k1l * 64 + 32 * ks + 8 * g + ((F.lane & 15) >> 2)) * 16 + 4 * (F.lane & 3); br[ks] = cat8(trread(tr + off), trread(tr + off + 64)); bi[ks] = cat8(trread(ti + off), trread(ti + off + 64)); }
#pragma unroll
        for (int m = 0; m < 4; ++m) {
            f32x4 yr = zero4, y1 = zero4, y2 = zero4;
#pragma unroll
            for (int ks = 0; ks < 2; ++ks) { const bf16x8 fc = *(const bf16x8*)(f64 + (16 * m + lr) * 64 + 32 * ks + 8 * g), fs = *(const bf16x8*)(f64 + 4096 + (16 * m + lr) * 64 + 32 * ks + 8 * g);
                yr = MFMA16(fc, br[ks], yr); yr = MFMA16(fs, bi[ks], yr); y1 = MFMA16(fc, bi[ks], y1); y2 = MFMA16(fs, br[ks], y2); }
#pragma unroll
            for (int j = 0; j < 4; ++j) { const int k2 = 16 * m + 4 * g + j; bf16* o = MX + (size_t)(64 * k2 + k1) * MW; o[0] = (bf16)f2bf(yr[j] * (1.f / 64.f)); o[256] = (bf16)f2bf((y1[j] - y2[j]) * (1.f / 64.f)); }
        }
    }
}
__device__ __forceinline__ void dft_ctx_unit(Frame& F0, int u) {
    LAUNDER_F(F0)
    const int b = u >> 5, kblk = u & 31;
    LAS bf16* sl = (LAS bf16*)F.lds;
    const bf16* PB = (const bf16*)(F.ws + WS_PBUF) + (size_t)(NLAT + b * CTXL) * PW + PC_FU;
    __syncthreads();
#pragma unroll
    for (int h = 0; h < 2; ++h) { u32x4 v[8];
#pragma unroll
        for (int k = 0; k < 8; ++k) { const int i = F.tid + (h * 8 + k) * NTHR, n = i >> 5, pc = i & 31; v[k] = *(const u32x4*)(PB + (size_t)n * PW + pc * 8); }
#pragma unroll
        for (int k = 0; k < 8; ++k) { const int i = F.tid + (h * 8 + k) * NTHR, n = i >> 5, pc = i & 31; *(LAS u32x4*)(sl + n * 256 + pc * 8) = v[k]; } }
    __syncthreads();
    const int c = F.tid & 255, k0 = kblk * 8 + (F.tid >> 8) * 4;
    const float* d256 = (const float*)(F.ws + WS_TAB + TAB_D256);
    float wr[4], wi[4], sr[4], si[4], ar[4], ai[4];
#pragma unroll
    for (int i = 0; i < 4; ++i) { sr[i] = d256[2 * (k0 + i)]; si[i] = -d256[2 * (k0 + i) + 1]; wr[i] = 1.f; wi[i] = 0.f; ar[i] = 0.f; ai[i] = 0.f; }
#pragma unroll 4
    for (int n = 0; n < 256; ++n) { const float uv = bf2f(sl[n * 256 + c]);
#pragma unroll
        for (int i = 0; i < 4; ++i) { ar[i] += uv * wr[i]; ai[i] += uv * wi[i]; const float nr = wr[i] * sr[i] - wi[i] * si[i], ni = wr[i] * si[i] + wi[i] * sr[i]; wr[i] = nr; wi[i] = ni; } }
    bf16* MX = (bf16*)(F.ws + WS_MIX) + (size_t)(NLAT + b * CTXL + k0) * MW + c;
#pragma unroll
    for (int i = 0; i < 4; ++i) { MX[(size_t)i * MW] = (bf16)f2bf(ar[i] * (1.f / 16.f)); MX[(size_t)i * MW + 256] = (bf16)f2bf(ai[i] * (1.f / 16.f)); }
}

__device__ __forceinline__ void p_mix_a(Frame& F, CArgs& a, int L) {
    {
        pg8::Gemm g{(const bf16*)(F.ws + WS_A2), (const bf16*)(F.ws + WS_S5P) + (size_t)L * 16 * 256 * 256, 1024, 512, OPQ(256)};
        SgOrder<FillS5> S; S.init(144, 1, F.G, F.bid); S.f = FillS5{(size_t)256 * 256 * 2};
        EpiS5S E{(float*)(F.ws + WS_S5S)};
        pg8::gemm_phase(F.lds, g, S, E, fresh_tid(F.wave));
    }
    for (int u = F.bid; u < NCHK; u += F.G) gla_chunk<false>(F, a, L, u);
    for (int u = (F.bid + 32) % F.G; u < NCHK; u += F.G) ssd_chunk<false>(F, a, L, u);
    __syncthreads();
}
__device__ __forceinline__ void p_mix_b(Frame& F, CArgs& a, int L) {
    for (int u = F.bid; u < 256; u += F.G) {
        const int vz = F.tid >> 9, uv = u + vz, wv = (F.tid >> 6);
        const int b = uv >> 5, g = (uv >> 1) & 15, r = uv & 1;
        const f32x2 a16 = *(const f32x2*)((const float*)(F.ws + WS_A16) + ((size_t)((L * 2 + r) * 16 + g) * 64 + F.lane) * 2);
        const float* S = (const float*)(F.ws + WS_S5S) + (size_t)g * S5ROWS * 256 + r * 128 + F.lane; bf16* A2 = (bf16*)(F.ws + WS_A2) + (size_t)g * S5ROWS * 512 + 256 + r * 128 + F.lane;
        LAS float* ex = (LAS float*)F.lds;
        LAS float* sl = ex + 17 * 128;
        __syncthreads();
#pragma unroll 1
        for (int sg = wv; sg < 17; sg += 8) {
            float sr[16], si[16];
#pragma unroll
            for (int n = 0; n < 16; ++n) { const int i = 16 * sg + n; const int row = i < 16 ? 2048 + 16 * b + (r ? 15 - i : i) : 256 * b + (r ? 271 - i : i - 16); sr[n] = S[(size_t)row * 256]; si[n] = S[(size_t)row * 256 + 64]; }
            float hr = 0.f, hi = 0.f;
#pragma unroll
            for (int n = 0; n < 16; ++n) { sl[((16 * sg + n) * 64 + F.lane) * 2] = sr[n]; sl[((16 * sg + n) * 64 + F.lane) * 2 + 1] = si[n];
                const float nr = a16[0] * hr - a16[1] * hi + sr[n], ni = a16[0] * hi + a16[1] * hr + si[n]; hr = nr; hi = ni; }
            ex[(sg * 64 + F.lane) * 2] = hr; ex[(sg * 64 + F.lane) * 2 + 1] = hi;
        }
        __syncthreads();
        float pr = a16[0], pi = a16[1];
#pragma unroll
        for (int q = 0; q < 4; ++q) { const float nr = pr * pr - pi * pi, ni = 2.f * pr * pi; pr = nr; pi = ni; }
#pragma unroll 1
        for (int sg = wv; sg < 17; sg += 8) {
            float hr = 0.f, hi = 0.f;
            for (int j = 0; j < sg; ++j) { const float er = ex[(j * 64 + F.lane) * 2], ei = ex[(j * 64 + F.lane) * 2 + 1]; const float nr = pr * hr - pi * hi + er, ni = pr * hi + pi * hr + ei; hr = nr; hi = ni; }
#pragma unroll 4
            for (int n = 0; n < 16; ++n) { const int i = 16 * sg + n; const int row = i < 16 ? 2048 + 16 * b + (r ? 15 - i : i) : 256 * b + (r ? 271 - i : i - 16);
                A2[(size_t)row * 512] = (bf16)f2bf(hr); A2[(size_t)row * 512 + 64] = (bf16)f2bf(hi);
                const float xr_ = sl[(i * 64 + F.lane) * 2], xi_ = sl[(i * 64 + F.lane) * 2 + 1];
                const float nr = a16[0] * hr - a16[1] * hi + xr_, ni = a16[0] * hi + a16[1] * hr + xi_; hr = nr; hi = ni; }
        }
    }
    for (int u = F.bid; u < 256; u += F.G) { const int uv = u + (F.tid >> 9), sq = uv >> 2, b = sq >> 3, hh = (sq >> 1) & 3, r = sq & 1, e = (uv & 3) * 512 + F.tid, c = e & 31;
        const float* ds = (const float*)(F.ws + WS_GDS); const float* dc = (const float*)(F.ws + WS_GDEC); bf16* se = (bf16*)(F.ws + WS_GSE);
        float s = 0.f;
        for (int i0 = 0; i0 < 68; i0 += 17) { float dv[17], cv[17];
#pragma unroll
            for (int k = 0; k < 17; ++k) { const int i = i0 + k; const int cid = i < 4 ? 512 + b * 4 + (r ? 3 - i : i) : b * 64 + (r ? 67 - i : i - 4); const size_t ub = ((size_t)cid * 4 + hh) * 2 + r; dv[k] = ds[ub * 2048 + e]; cv[k] = dc[ub * 32 + c]; }
#pragma unroll
            for (int k = 0; k < 17; ++k) { const int i = i0 + k; const int cid = i < 4 ? 512 + b * 4 + (r ? 3 - i : i) : b * 64 + (r ? 67 - i : i - 4); const size_t ub = ((size_t)cid * 4 + hh) * 2 + r; se[ub * 2048 + e] = (bf16)f2bf(s); s = cv[k] * s + dv[k]; } } }
    for (int u = F.bid; u < 512; u += F.G) { const int uv = u + (F.tid >> 9), sq = uv >> 3, b = sq >> 3, h = (sq >> 1) & 3, r = sq & 1, e = (uv & 7) * 512 + F.tid;
        const float* ds = (const float*)(F.ws + WS_SDS); const float* dc = (const float*)(F.ws + WS_SDEC); bf16* se = (bf16*)(F.ws + WS_SSE);
        float s = 0.f;
        for (int i0 = 0; i0 < 68; i0 += 17) { float dv[17], cv[17];
#pragma unroll
            for (int k = 0; k < 17; ++k) { const int i = i0 + k; const int cid = i < 4 ? 512 + b * 4 + (r ? 3 - i : i) : b * 64 + (r ? 67 - i : i - 4); const size_t ub = ((size_t)cid * 4 + h) * 2 + r; dv[k] = ds[ub * 4096 + e]; cv[k] = dc[ub]; }
#pragma unroll
            for (int k = 0; k < 17; ++k) { const int i = i0 + k; const int cid = i < 4 ? 512 + b * 4 + (r ? 3 - i : i) : b * 64 + (r ? 67 - i : i - 4); const size_t ub = ((size_t)cid * 4 + h) * 2 + r; se[ub * 4096 + e] = (bf16)f2bf(s); s = cv[k] * s + dv[k]; } } }
    for (int u = F.bid; u < 512; u += F.G) fft_unit(F, u);
    for (int u = F.bid; u < 256; u += F.G) dft_ctx_unit(F, u);
    __syncthreads();
}
__device__ __forceinline__ void p_mix_c(Frame& F, CArgs& a, int L) {
#ifndef MIXC_PARTS
#define MIXC_PARTS 7
#endif
    if (MIXC_PARTS & 1) {
        pg8::Gemm g{(const bf16*)(F.ws + WS_A2), (const bf16*)(F.ws + WS_S5B2) + (size_t)L * 16 * 256 * 512, 1024, 1024, OPQ(512)};
        SgOrder<FillS5> S; S.init(144, 1, F.G, F.bid); S.f = FillS5{(size_t)256 * 512 * 2};
        EpiS5Y E{(bf16*)(F.ws + WS_ACT5)};
        pg8::gemm_phase(F.lds, g, S, E, fresh_tid(F.wave));
    }
    const int nch = (L == DEPTH - 1) ? 512 : NCHK;
    if (MIXC_PARTS & 2) for (int u = F.bid; u < nch; u += F.G) gla_chunk<true>(F, a, L, u);
    if (MIXC_PARTS & 4) for (int u = (F.bid + 32) % F.G; u < nch; u += F.G) ssd_chunk<true>(F, a, L, u);
    __syncthreads();
}

constexpr int NPH = 11, PH_TOTAL = 2 + DEPTH * NPH;
#ifndef PHASE_MASK
#define PHASE_MASK 0xFFFF
#endif
#define PM(i) ((PHASE_MASK >> (i)) & 1)
#ifndef DUP_MASK
#define DUP_MASK 0
#endif
#define NREP(k) (((DUP_MASK >> (k)) & 1) ? 2 : 1)
#ifndef MK_ONE_LAUNCH
#define MK_ONE_LAUNCH 0
#endif

__global__ void __launch_bounds__(NTHR, 2) mk_fwd(Args args_by_value) {
#define args (*fresh_args())
    extern __shared__ __attribute__((aligned(16))) unsigned char lds_raw[];
    Frame F;
    F.lds = (LAS unsigned char*)lds_raw; F.MISC = (volatile LAS unsigned*)(F.lds + MISC_OFF);
    F.tid = threadIdx.x; F.lane = F.tid & 63; F.wave = __builtin_amdgcn_readfirstlane(F.tid >> 6); F.G = gridDim.x; F.bid = blockIdx.x;
    F.ws = args_by_value.ws; F.ctl = (unsigned*)(args_by_value.ws + WS_CTL);
    if (F.tid < 64) F.MISC[F.tid] = 0u;
    __syncthreads();
#if MK_ONE_LAUNCH
    XcdBarrier bar = xcd_barrier_post(F.ctl + CW_BAR, F.MISC + 8);
#define GRID_BAR() xcd_barrier(bar)
#else
#define GRID_BAR() do { } while (0)
#endif
    const int lo = args_by_value.ph_lo, hi = args_by_value.ph_hi;
#define IN(k) (lo <= (k) && (k) < hi)
#define FRESH() do { const int t_ = fresh_tid(F.wave); F.tid = t_; F.lane = t_ & 63; } while (0)
#define SEAM(k) do { if (IN(k) && IN((k) + 1)) GRID_BAR(); } while (0)
    if (PM(0) && IN(0)) { FRESH(); p_prologue(F, args); }
#ifdef DUP_PROLOGUE
    GRID_BAR(); if (PM(0) && IN(0)) { FRESH(); p_prologue(F, args, CW_QUEUE + 64); }
#endif
    SEAM(0);
    {
        const int pb = 1 + 0 * NPH;
        const int mrows = (0 == DEPTH - 1) ? NLAT : NT;
        if (PM(1) && IN(pb + 0)) { FRESH(); p_norm1(F, args, OPQ(0)); } SEAM(pb + 0);
        if (PM(2) && IN(pb + 1)) for (int rep_ = 0; rep_ < NREP(2); ++rep_) { if (rep_) GRID_BAR(); const int Lg = OPQ(0);
            pg8::Gemm g{(const bf16*)(F.ws + WS_H), (const bf16*)(F.ws + WS_WIN) + (size_t)Lg * PW * DM, DM * 2, DM * 2, OPQ(DM)};
            SgOrder<FillPlain> S; S.init(NT / 256, PW / 256, F.G, F.bid); S.f = FillPlain{(size_t)256 * DM * 2, (size_t)256 * DM * 2};
            EpiInproj E{(bf16*)(F.ws + WS_PBUF), (bf16*)(F.ws + WS_A2)};
            pg8::gemm_phase(F.lds, g, S, E, fresh_tid(F.wave));
        } SEAM(pb + 1);
        if (PM(3) && IN(pb + 2)) for (int rep_ = 0; rep_ < NREP(3); ++rep_) { if (rep_) GRID_BAR(); FRESH(); p_mix_a(F, args, OPQ(0)); } SEAM(pb + 2);
        if (PM(4) && IN(pb + 3)) for (int rep_ = 0; rep_ < NREP(4); ++rep_) { if (rep_) GRID_BAR(); FRESH(); p_mix_b(F, args, OPQ(0)); } SEAM(pb + 3);
        if (PM(5) && IN(pb + 4)) for (int rep_ = 0; rep_ < NREP(5); ++rep_) { if (rep_) GRID_BAR(); FRESH(); p_mix_c(F, args, OPQ(0)); } SEAM(pb + 4);
        if (PM(6) && IN(pb + 5)) for (int rep_ = 0; rep_ < NREP(6); ++rep_) { if (rep_) GRID_BAR(); const int Lg = OPQ(0);
            pg8::Gemm g{(const bf16*)(F.ws + WS_ACT5), (const bf16*)(F.ws + WS_WGLU) + (size_t)Lg * 256 * 256, 512, 512, OPQ(256)};
            SgOrder<FillPlain> S; S.init(NT / 256, 1, F.G, F.bid); S.f = FillPlain{(size_t)256 * 256 * 2, 0};
            EpiGlu E{(const bf16*)(F.ws + WS_ACT5), (bf16*)(F.ws + WS_MIX)};
            pg8::gemm_phase(F.lds, g, S, E, fresh_tid(F.wave));
        } SEAM(pb + 5);
        if (PM(7) && IN(pb + 6)) { const int Lg = OPQ(0);
            pg8::Gemm g{(const bf16*)(F.ws + WS_MIX), (const bf16*)(F.ws + WS_WOUT) + (size_t)Lg * DM * MW, MW * 2, MW * 2, OPQ(MW)};
            SgOrder<FillPlain> S; S.init((Lg == DEPTH - 1 ? NLAT : NT) / 256, DM / 256, F.G, F.bid); S.f = FillPlain{(size_t)256 * MW * 2, (size_t)256 * MW * 2};
            EpiOutproj E{args.in[I_X], args.in[I_CTX], (float*)(F.ws + WS_XS), (const float*)(F.ws + WS_MOD) + (size_t)Lg * 9 * 6144, Lg == 0 ? 1 : 0};
            pg8::gemm_phase(F.lds, g, S, E, fresh_tid(F.wave));
        } SEAM(pb + 6);
        if (PM(8) && IN(pb + 7)) { FRESH(); p_norm2(F, args, OPQ(0), OPQ(mrows)); } SEAM(pb + 7);
        if (PM(9) && IN(pb + 8)) for (int rep_ = 0; rep_ < NREP(9); ++rep_) { if (rep_) GRID_BAR(); FRESH(); p_dispatch(F, OPQ(0), OPQ(mrows)); } SEAM(pb + 8);
        if (PM(10) && IN(pb + 9)) for (int rep_ = 0; rep_ < NREP(10); ++rep_) { if (rep_) GRID_BAR(); const int Lg = OPQ(0);
            const unsigned* blke = F.ctl + CW_BLKE + Lg * 1024; const int nblk = (int)__hip_atomic_load(blke, RLX_AGENT);
            pg8::Gemm g{F.ws + WS_BUF, F.ws + WS_WGU + (size_t)Lg * NEXP * 2048 * DM, DM, DM, OPQ(DM / 2)};
            SgOrder<FillMoe> S; S.init(nblk, 8, F.G, F.bid); S.f = FillMoe{blke, 2048};
            EpiSwiglu E{(unsigned char*)(F.ws + WS_ACT), args.in[I_BGU] + (size_t)Lg * NEXP * 2048};
            pg8::gemm_phase<EpiSwiglu, SgOrder<FillMoe>, true, F8_ALIGN, F8_SP2>(F.lds, g, S, E, fresh_tid(F.wave));
        } SEAM(pb + 9);
        if (PM(11) && IN(pb + 10)) for (int rep_ = 0; rep_ < NREP(11); ++rep_) { if (rep_) GRID_BAR(); const int Lg = OPQ(0);
            const unsigned* blke = F.ctl + CW_BLKE + Lg * 1024; const int nblk = (int)__hip_atomic_load(blke, RLX_AGENT);
            pg8::Gemm g{F.ws + WS_ACT, F.ws + WS_WDN + (size_t)Lg * NEXP * DM * DM, DM, DM, OPQ(DM / 2)};
            SgOrder<FillMoe> S; S.init(nblk, 4, F.G, F.bid); S.f = FillMoe{blke, 1024};
            EpiDown E{(bf16*)(F.ws + WS_Y), args.in[I_BDN] + (size_t)Lg * NEXP * DM, (const float*)(F.ws + WS_SG)};
            pg8::gemm_phase<EpiDown, SgOrder<FillMoe>, true, F8_ALIGN, F8_SP2>(F.lds, g, S, E, fresh_tid(F.wave));
        } SEAM(pb + 10);
        }
    {
        const int pb = 1 + 1 * NPH;
        const int mrows = (1 == DEPTH - 1) ? NLAT : NT;
        if (PM(1) && IN(pb + 0)) { FRESH(); p_norm1(F, args, OPQ(1)); } SEAM(pb + 0);
        if (PM(2) && IN(pb + 1)) for (int rep_ = 0; rep_ < NREP(2); ++rep_) { if (rep_) GRID_BAR(); const int Lg = OPQ(1);
            pg8::Gemm g{(const bf16*)(F.ws + WS_H), (const bf16*)(F.ws + WS_WIN) + (size_t)Lg * PW * DM, DM * 2, DM * 2, OPQ(DM)};
            SgOrder<FillPlain> S; S.init(NT / 256, PW / 256, F.G, F.bid); S.f = FillPlain{(size_t)256 * DM * 2, (size_t)256 * DM * 2};
            EpiInproj E{(bf16*)(F.ws + WS_PBUF), (bf16*)(F.ws + WS_A2)};
            pg8::gemm_phase(F.lds, g, S, E, fresh_tid(F.wave));
        } SEAM(pb + 1);
        if (PM(3) && IN(pb + 2)) for (int rep_ = 0; rep_ < NREP(3); ++rep_) { if (rep_) GRID_BAR(); FRESH(); p_mix_a(F, args, OPQ(1)); } SEAM(pb + 2);
        if (PM(4) && IN(pb + 3)) for (int rep_ = 0; rep_ < NREP(4); ++rep_) { if (rep_) GRID_BAR(); FRESH(); p_mix_b(F, args, OPQ(1)); } SEAM(pb + 3);
        if (PM(5) && IN(pb + 4)) for (int rep_ = 0; rep_ < NREP(5); ++rep_) { if (rep_) GRID_BAR(); FRESH(); p_mix_c(F, args, OPQ(1)); } SEAM(pb + 4);
        if (PM(6) && IN(pb + 5)) for (int rep_ = 0; rep_ < NREP(6); ++rep_) { if (rep_) GRID_BAR(); const int Lg = OPQ(1);
            pg8::Gemm g{(const bf16*)(F.ws + WS_ACT5), (const bf16*)(F.ws + WS_WGLU) + (size_t)Lg * 256 * 256, 512, 512, OPQ(256)};
            SgOrder<FillPlain> S; S.init(NT / 256, 1, F.G, F.bid); S.f = FillPlain{(size_t)256 * 256 * 2, 0};
            EpiGlu E{(const bf16*)(F.ws + WS_ACT5), (bf16*)(F.ws + WS_MIX)};
            pg8::gemm_phase(F.lds, g, S, E, fresh_tid(F.wave));
        } SEAM(pb + 5);
        if (PM(7) && IN(pb + 6)) { const int Lg = OPQ(1);
            pg8::Gemm g{(const bf16*)(F.ws + WS_MIX), (const bf16*)(F.ws + WS_WOUT) + (size_t)Lg * DM * MW, MW * 2, MW * 2, OPQ(MW)};
            SgOrder<FillPlain> S; S.init((Lg == DEPTH - 1 ? NLAT : NT) / 256, DM / 256, F.G, F.bid); S.f = FillPlain{(size_t)256 * MW * 2, (size_t)256 * MW * 2};
            EpiOutproj E{args.in[I_X], args.in[I_CTX], (float*)(F.ws + WS_XS), (const float*)(F.ws + WS_MOD) + (size_t)Lg * 9 * 6144, Lg == 0 ? 1 : 0};
            pg8::gemm_phase(F.lds, g, S, E, fresh_tid(F.wave));
        } SEAM(pb + 6);
        if (PM(8) && IN(pb + 7)) { FRESH(); p_norm2(F, args, OPQ(1), OPQ(mrows)); } SEAM(pb + 7);
        if (PM(9) && IN(pb + 8)) for (int rep_ = 0; rep_ < NREP(9); ++rep_) { if (rep_) GRID_BAR(); FRESH(); p_dispatch(F, OPQ(1), OPQ(mrows)); } SEAM(pb + 8);
        if (PM(10) && IN(pb + 9)) for (int rep_ = 0; rep_ < NREP(10); ++rep_) { if (rep_) GRID_BAR(); const int Lg = OPQ(1);
            const unsigned* blke = F.ctl + CW_BLKE + Lg * 1024; const int nblk = (int)__hip_atomic_load(blke, RLX_AGENT);
            pg8::Gemm g{F.ws + WS_BUF, F.ws + WS_WGU + (size_t)Lg * NEXP * 2048 * DM, DM, DM, OPQ(DM / 2)};
            SgOrder<FillMoe> S; S.init(nblk, 8, F.G, F.bid); S.f = FillMoe{blke, 2048};
            EpiSwiglu E{(unsigned char*)(F.ws + WS_ACT), args.in[I_BGU] + (size_t)Lg * NEXP * 2048};
            pg8::gemm_phase<EpiSwiglu, SgOrder<FillMoe>, true, F8_ALIGN, F8_SP2>(F.lds, g, S, E, fresh_tid(F.wave));
        } SEAM(pb + 9);
        if (PM(11) && IN(pb + 10)) for (int rep_ = 0; rep_ < NREP(11); ++rep_) { if (rep_) GRID_BAR(); const int Lg = OPQ(1);
            const unsigned* blke = F.ctl + CW_BLKE + Lg * 1024; const int nblk = (int)__hip_atomic_load(blke, RLX_AGENT);
            pg8::Gemm g{F.ws + WS_ACT, F.ws + WS_WDN + (size_t)Lg * NEXP * DM * DM, DM, DM, OPQ(DM / 2)};
            SgOrder<FillMoe> S; S.init(nblk, 4, F.G, F.bid); S.f = FillMoe{blke, 1024};
            EpiDown E{(bf16*)(F.ws + WS_Y), args.in[I_BDN] + (size_t)Lg * NEXP * DM, (const float*)(F.ws + WS_SG)};
            pg8::gemm_phase<EpiDown, SgOrder<FillMoe>, true, F8_ALIGN, F8_SP2>(F.lds, g, S, E, fresh_tid(F.wave));
        } SEAM(pb + 10);
        }
    {
        const int pb = 1 + 2 * NPH;
        const int mrows = (2 == DEPTH - 1) ? NLAT : NT;
        if (PM(1) && IN(pb + 0)) { FRESH(); p_norm1(F, args, OPQ(2)); } SEAM(pb + 0);
        if (PM(2) && IN(pb + 1)) for (int rep_ = 0; rep_ < NREP(2); ++rep_) { if (rep_) GRID_BAR(); const int Lg = OPQ(2);
            pg8::Gemm g{(const bf16*)(F.ws + WS_H), (const bf16*)(F.ws + WS_WIN) + (size_t)Lg * PW * DM, DM * 2, DM * 2, OPQ(DM)};
            SgOrder<FillPlain> S; S.init(NT / 256, PW / 256, F.G, F.bid); S.f = FillPlain{(size_t)256 * DM * 2, (size_t)256 * DM * 2};
            EpiInproj E{(bf16*)(F.ws + WS_PBUF), (bf16*)(F.ws + WS_A2)};
            pg8::gemm_phase(F.lds, g, S, E, fresh_tid(F.wave));
        } SEAM(pb + 1);
        if (PM(3) && IN(pb + 2)) for (int rep_ = 0; rep_ < NREP(3); ++rep_) { if (rep_) GRID_BAR(); FRESH(); p_mix_a(F, args, OPQ(2)); } SEAM(pb + 2);
        if (PM(4) && IN(pb + 3)) for (int rep_ = 0; rep_ < NREP(4); ++rep_) { if (rep_) GRID_BAR(); FRESH(); p_mix_b(F, args, OPQ(2)); } SEAM(pb + 3);
        if (PM(5) && IN(pb + 4)) for (int rep_ = 0; rep_ < NREP(5); ++rep_) { if (rep_) GRID_BAR(); FRESH(); p_mix_c(F, args, OPQ(2)); } SEAM(pb + 4);
        if (PM(6) && IN(pb + 5)) for (int rep_ = 0; rep_ < NREP(6); ++rep_) { if (rep_) GRID_BAR(); const int Lg = OPQ(2);
            pg8::Gemm g{(const bf16*)(F.ws + WS_ACT5), (const bf16*)(F.ws + WS_WGLU) + (size_t)Lg * 256 * 256, 512, 512, OPQ(256)};
            SgOrder<FillPlain> S; S.init(NT / 256, 1, F.G, F.bid); S.f = FillPlain{(size_t)256 * 256 * 2, 0};
            EpiGlu E{(const bf16*)(F.ws + WS_ACT5), (bf16*)(F.ws + WS_MIX)};
            pg8::gemm_phase(F.lds, g, S, E, fresh_tid(F.wave));
        } SEAM(pb + 5);
        if (PM(7) && IN(pb + 6)) { const int Lg = OPQ(2);
            pg8::Gemm g{(const bf16*)(F.ws + WS_MIX), (const bf16*)(F.ws + WS_WOUT) + (size_t)Lg * DM * MW, MW * 2, MW * 2, OPQ(MW)};
            SgOrder<FillPlain> S; S.init((Lg == DEPTH - 1 ? NLAT : NT) / 256, DM / 256, F.G, F.bid); S.f = FillPlain{(size_t)256 * MW * 2, (size_t)256 * MW * 2};
            EpiOutproj E{args.in[I_X], args.in[I_CTX], (float*)(F.ws + WS_XS), (const float*)(F.ws + WS_MOD) + (size_t)Lg * 9 * 6144, Lg == 0 ? 1 : 0};
            pg8::gemm_phase(F.lds, g, S, E, fresh_tid(F.wave));
        } SEAM(pb + 6);
        if (PM(8) && IN(pb + 7)) { FRESH(); p_norm2(F, args, OPQ(2), OPQ(mrows)); } SEAM(pb + 7);
        if (PM(9) && IN(pb + 8)) for (int rep_ = 0; rep_ < NREP(9); ++rep_) { if (rep_) GRID_BAR(); FRESH(); p_dispatch(F, OPQ(2), OPQ(mrows)); } SEAM(pb + 8);
        if (PM(10) && IN(pb + 9)) for (int rep_ = 0; rep_ < NREP(10); ++rep_) { if (rep_) GRID_BAR(); const int Lg = OPQ(2);
            const unsigned* blke = F.ctl + CW_BLKE + Lg * 1024; const int nblk = (int)__hip_atomic_load(blke, RLX_AGENT);
            pg8::Gemm g{F.ws + WS_BUF, F.ws + WS_WGU + (size_t)Lg * NEXP * 2048 * DM, DM, DM, OPQ(DM / 2)};
            SgOrder<FillMoe> S; S.init(nblk, 8, F.G, F.bid); S.f = FillMoe{blke, 2048};
            EpiSwiglu E{(unsigned char*)(F.ws + WS_ACT), args.in[I_BGU] + (size_t)Lg * NEXP * 2048};
            pg8::gemm_phase<EpiSwiglu, SgOrder<FillMoe>, true, F8_ALIGN, F8_SP2>(F.lds, g, S, E, fresh_tid(F.wave));
        } SEAM(pb + 9);
        if (PM(11) && IN(pb + 10)) for (int rep_ = 0; rep_ < NREP(11); ++rep_) { if (rep_) GRID_BAR(); const int Lg = OPQ(2);
            const unsigned* blke = F.ctl + CW_BLKE + Lg * 1024; const int nblk = (int)__hip_atomic_load(blke, RLX_AGENT);
            pg8::Gemm g{F.ws + WS_ACT, F.ws + WS_WDN + (size_t)Lg * NEXP * DM * DM, DM, DM, OPQ(DM / 2)};
            SgOrder<FillMoe> S; S.init(nblk, 4, F.G, F.bid); S.f = FillMoe{blke, 1024};
            EpiDown E{(bf16*)(F.ws + WS_Y), args.in[I_BDN] + (size_t)Lg * NEXP * DM, (const float*)(F.ws + WS_SG)};
            pg8::gemm_phase<EpiDown, SgOrder<FillMoe>, true, F8_ALIGN, F8_SP2>(F.lds, g, S, E, fresh_tid(F.wave));
        } SEAM(pb + 10);
        }
    {
        const int pb = 1 + 3 * NPH;
        const int mrows = (3 == DEPTH - 1) ? NLAT : NT;
        if (PM(1) && IN(pb + 0)) { FRESH(); p_norm1(F, args, OPQ(3)); } SEAM(pb + 0);
        if (PM(2) && IN(pb + 1)) for (int rep_ = 0; rep_ < NREP(2); ++rep_) { if (rep_) GRID_BAR(); const int Lg = OPQ(3);
            pg8::Gemm g{(const bf16*)(F.ws + WS_H), (const bf16*)(F.ws + WS_WIN) + (size_t)Lg * PW * DM, DM * 2, DM * 2, OPQ(DM)};
            SgOrder<FillPlain> S; S.init(NT / 256, PW / 256, F.G, F.bid); S.f = FillPlain{(size_t)256 * DM * 2, (size_t)256 * DM * 2};
            EpiInproj E{(bf16*)(F.ws + WS_PBUF), (bf16*)(F.ws + WS_A2)};
            pg8::gemm_phase(F.lds, g, S, E, fresh_tid(F.wave));
        } SEAM(pb + 1);
        if (PM(3) && IN(pb + 2)) for (int rep_ = 0; rep_ < NREP(3); ++rep_) { if (rep_) GRID_BAR(); FRESH(); p_mix_a(F, args, OPQ(3)); } SEAM(pb + 2);
        if (PM(4) && IN(pb + 3)) for (int rep_ = 0; rep_ < NREP(4); ++rep_) { if (rep_) GRID_BAR(); FRESH(); p_mix_b(F, args, OPQ(3)); } SEAM(pb + 3);
        if (PM(5) && IN(pb + 4)) for (int rep_ = 0; rep_ < NREP(5); ++rep_) { if (rep_) GRID_BAR(); FRESH(); p_mix_c(F, args, OPQ(3)); } SEAM(pb + 4);
        if (PM(6) && IN(pb + 5)) for (int rep_ = 0; rep_ < NREP(6); ++rep_) { if (rep_) GRID_BAR(); const int Lg = OPQ(3);
            pg8::Gemm g{(const bf16*)(F.ws + WS_ACT5), (const bf16*)(F.ws + WS_WGLU) + (size_t)Lg * 256 * 256, 512, 512, OPQ(256)};
            SgOrder<FillPlain> S; S.init(NT / 256, 1, F.G, F.bid); S.f = FillPlain{(size_t)256 * 256 * 2, 0};
            EpiGlu E{(const bf16*)(F.ws + WS_ACT5), (bf16*)(F.ws + WS_MIX)};
            pg8::gemm_phase(F.lds, g, S, E, fresh_tid(F.wave));
        } SEAM(pb + 5);
        if (PM(7) && IN(pb + 6)) { const int Lg = OPQ(3);
            pg8::Gemm g{(const bf16*)(F.ws + WS_MIX), (const bf16*)(F.ws + WS_WOUT) + (size_t)Lg * DM * MW, MW * 2, MW * 2, OPQ(MW)};
            SgOrder<FillPlain> S; S.init((Lg == DEPTH - 1 ? NLAT : NT) / 256, DM / 256, F.G, F.bid); S.f = FillPlain{(size_t)256 * MW * 2, (size_t)256 * MW * 2};
            EpiOutproj E{args.in[I_X], args.in[I_CTX], (float*)(F.ws + WS_XS), (const float*)(F.ws + WS_MOD) + (size_t)Lg * 9 * 6144, Lg == 0 ? 1 : 0};
            pg8::gemm_phase(F.lds, g, S, E, fresh_tid(F.wave));
        } SEAM(pb + 6);
        if (PM(8) && IN(pb + 7)) { FRESH(); p_norm2(F, args, OPQ(3), OPQ(mrows)); } SEAM(pb + 7);
        if (PM(9) && IN(pb + 8)) for (int rep_ = 0; rep_ < NREP(9); ++rep_) { if (rep_) GRID_BAR(); FRESH(); p_dispatch(F, OPQ(3), OPQ(mrows)); } SEAM(pb + 8);
        if (PM(10) && IN(pb + 9)) for (int rep_ = 0; rep_ < NREP(10); ++rep_) { if (rep_) GRID_BAR(); const int Lg = OPQ(3);
            const unsigned* blke = F.ctl + CW_BLKE + Lg * 1024; const int nblk = (int)__hip_atomic_load(blke, RLX_AGENT);
            pg8::Gemm g{F.ws + WS_BUF, F.ws + WS_WGU + (size_t)Lg * NEXP * 2048 * DM, DM, DM, OPQ(DM / 2)};
            SgOrder<FillMoe> S; S.init(nblk, 8, F.G, F.bid); S.f = FillMoe{blke, 2048};
            EpiSwiglu E{(unsigned char*)(F.ws + WS_ACT), args.in[I_BGU] + (size_t)Lg * NEXP * 2048};
            pg8::gemm_phase<EpiSwiglu, SgOrder<FillMoe>, true, F8_ALIGN, F8_SP2>(F.lds, g, S, E, fresh_tid(F.wave));
        } SEAM(pb + 9);
        if (PM(11) && IN(pb + 10)) for (int rep_ = 0; rep_ < NREP(11); ++rep_) { if (rep_) GRID_BAR(); const int Lg = OPQ(3);
            const unsigned* blke = F.ctl + CW_BLKE + Lg * 1024; const int nblk = (int)__hip_atomic_load(blke, RLX_AGENT);
            pg8::Gemm g{F.ws + WS_ACT, F.ws + WS_WDN + (size_t)Lg * NEXP * DM * DM, DM, DM, OPQ(DM / 2)};
            SgOrder<FillMoe> S; S.init(nblk, 4, F.G, F.bid); S.f = FillMoe{blke, 1024};
            EpiDown E{(bf16*)(F.ws + WS_Y), args.in[I_BDN] + (size_t)Lg * NEXP * DM, (const float*)(F.ws + WS_SG)};
            pg8::gemm_phase<EpiDown, SgOrder<FillMoe>, true, F8_ALIGN, F8_SP2>(F.lds, g, S, E, fresh_tid(F.wave));
        } SEAM(pb + 10);
        }
    if (PM(12) && IN(PH_TOTAL - 1)) { FRESH(); p_final(F, args); }
#undef IN
#undef SEAM
#undef args
}

extern "C" void kernel_launch(void* const* d_in, const int* in_sizes, int n_in, void* d_out, int out_size, void* d_ws, size_t ws_size, hipStream_t stream) {
    static int grid = 0;
    if (grid == 0) {
        if (n_in != N_IN || out_size != NLAT * DM || ws_size < WS_END) { fprintf(stderr, "kernel_launch: unexpected shapes (n_in %d, out %d, ws %zu < %zu); nothing launched\n", n_in, out_size, ws_size, (size_t)WS_END); grid = -1; return; }
        int dev = 0, cus = 0, per_cu = 0;
        if (hipGetDevice(&dev) != hipSuccess || hipDeviceGetAttribute(&cus, hipDeviceAttributeMultiprocessorCount, dev) != hipSuccess) { grid = -1; return; }
        if (hipFuncSetAttribute((const void*)mk_fwd, hipFuncAttributeMaxDynamicSharedMemorySize, LDS_BYTES) != hipSuccess) { fprintf(stderr, "kernel_launch: hipFuncSetAttribute failed\n"); grid = -1; return; }
        if (hipOccupancyMaxActiveBlocksPerMultiprocessor(&per_cu, (const void*)mk_fwd, NTHR, LDS_BYTES) != hipSuccess || per_cu < 1) fprintf(stderr, "kernel_launch: occupancy query says %d\n", per_cu);
        (void)hipGetLastError();
        grid = cus;
    }
    if (grid < 0) return;
    (void)hipMemsetAsync((char*)d_ws + WS_CTL, 0, CTL_BYTES, stream);
    Args a{};
    for (int i = 0; i < N_IN; ++i) a.in[i] = (const float*)d_in[i];
    a.out = (float*)d_out; a.ws = (unsigned char*)d_ws;
#if MK_ONE_LAUNCH
    a.ph_lo = 0; a.ph_hi = PH_TOTAL;
    hipLaunchKernelGGL(mk_fwd, dim3(grid), dim3(NTHR), LDS_BYTES, stream, a);
#else
    for (int p = 0; p < PH_TOTAL; ++p) { a.ph_lo = p; a.ph_hi = p + 1; hipLaunchKernelGGL(mk_fwd, dim3(grid), dim3(NTHR), LDS_BYTES, stream, a); }
#endif
}
```

```cpp
#define MK_ONE_LAUNCH 1
#define F8_ALIGN true
#define F8_SP2 true
#include <hip/hip_runtime.h>
#include <cstdio>
#include <cstdint>

#define GAS __attribute__((address_space(1)))
#define LAS __attribute__((address_space(3)))
typedef unsigned short bf16;
typedef short bf16x8 __attribute__((ext_vector_type(8)));
typedef short s16x4 __attribute__((ext_vector_type(4)));
typedef float f32x4 __attribute__((ext_vector_type(4)));
typedef float f32x2 __attribute__((ext_vector_type(2)));
typedef unsigned u32x4 __attribute__((ext_vector_type(4)));
typedef unsigned u32x2 __attribute__((ext_vector_type(2)));

namespace pg8 {
#define PG8_LAS __attribute__((address_space(3)))
typedef unsigned short bf16_t;
constexpr int BM = 256, BK = 64, HALF = 128, HTB = HALF * BK * 2  , STAGE_BYTES = 8 * HTB;

__host__ __device__ __forceinline__ int lds_byte(int r, int c) { const int st = (r >> 4) * 2 + (c >> 5), rr = r & 15, cc = c & 31, ob = rr * 64 + cc * 2; return st * 1024 + (ob ^ (((ob >> 9) & 1) << 5)); }
__host__ __device__ __forceinline__ void stage_rc(int b, int& R, int& C) { const int st = b / 1024, sb = b % 1024, swz = sb ^ (((sb >> 9) & 1) << 5); R = (st >> 1) * 16 + swz / 64; C = (st & 1) * 32 + (swz % 64) / 2; }
__host__ __device__ __forceinline__ int perm32(int rho) { const int n = rho >> 4, i = rho & 15; return 8 * (i >> 2) + 4 * n + (i & 3); }

struct Unit { int pm, pn, grp; size_t aoff, boff; };
struct Gemm { const void* A; const void* Bt; int lda, ldb, K; };

__device__ __forceinline__ unsigned cvt_pk_bf16(float lo, float hi) { unsigned r; asm volatile("v_cvt_pk_bf16_f32 %0, %1, %2" : "=v"(r) : "v"(lo), "v"(hi)); return r; }

typedef int v8i_t __attribute__((ext_vector_type(8)));
typedef int v4i_t __attribute__((ext_vector_type(4)));
template <class Epi, class Sched, bool F8 = false, bool ALIGN_EPI = true, bool SP2 = true>
__device__ __forceinline__ void gemm_phase(PG8_LAS unsigned char* lds, const Gemm g, const Sched& S, const Epi& E, int tid_in) {
    int tid = tid_in; asm volatile("" : "+v"(tid));
    const int wid = __builtin_amdgcn_readfirstlane(tid >> 6), lane = tid & 63, wr = wid >> 2, wc = wid & 3, fr = lane & 15, fq = lane >> 4;
    const int K = g.K, nt = K / BK;
    unsigned voffA[2], voffB[2];
#pragma unroll
    for (int i = 0; i < 2; ++i) { int R, C; stage_rc(tid * 16 + i * 8192, R, C); const int Rb = Epi::PERM ? ((R & ~31) + perm32(R & 31)) : R;
        voffA[i] = (unsigned)(R * g.lda + C * 2); voffB[i] = (unsigned)(Rb * g.ldb + C * 2); }
    const size_t kstep = (size_t)(BK * 2);
    const size_t hstepA = (size_t)HALF * g.lda, hstepB = (size_t)HALF * g.ldb;
    const unsigned ldsw = (unsigned)wid * 1024u;
    const int aoff = F8 ? lds_byte(wr * 64 + fr, fq * 16) : lds_byte(wr * 64 + fr, fq * 8), boff = F8 ? lds_byte(wc * 32 + fr, fq * 16) : lds_byte(wc * 32 + fr, fq * 8);
    const int aoff1 = lds_byte(wr * 64 + fr, fq * 16 + 8), boff1 = lds_byte(wc * 32 + fr, fq * 16 + 8);
#define PG8_SA(b, h) (((b) * 2 + (h)) * HTB)
#define PG8_SB(b, h) ((4 + (b) * 2 + (h)) * HTB)
#define PG8_STAGE(bufoff, gbase, voff) do { _Pragma("unroll") for (int _i = 0; _i < 2; ++_i) \
        __builtin_amdgcn_global_load_lds((const unsigned*)((const char*)(gbase) + (voff)[_i]), (PG8_LAS unsigned*)(lds + (bufoff) + ldsw + _i * 8192), 16, 0, 0); } while (0)
#define PG8_LD16(off) (*(const PG8_LAS v4i_t*)(lds + (off)))
#define PG8_LDA(dst, b, h) do { if constexpr (F8) { _Pragma("unroll") for (int m = 0; m < 4; ++m) A8[m] = __builtin_shufflevector(PG8_LD16(PG8_SA(b, h) + aoff + m * 2048), PG8_LD16(PG8_SA(b, h) + aoff1 + m * 2048), 0, 1, 2, 3, 4, 5, 6, 7); } \
        else { _Pragma("unroll") for (int m = 0; m < 4; ++m) _Pragma("unroll") for (int k = 0; k < 2; ++k) dst[m][k] = *(const PG8_LAS bf16x8*)(lds + PG8_SA(b, h) + aoff + m * 2048 + k * 1024); } } while (0)
#define PG8_LDB(dst, b, h) do { if constexpr (F8) { _Pragma("unroll") for (int n = 0; n < 2; ++n) dst##8[n] = __builtin_shufflevector(PG8_LD16(PG8_SB(b, h) + boff + n * 2048), PG8_LD16(PG8_SB(b, h) + boff1 + n * 2048), 0, 1, 2, 3, 4, 5, 6, 7); } \
        else { _Pragma("unroll") for (int n = 0; n < 2; ++n) _Pragma("unroll") for (int k = 0; k < 2; ++k) dst[n][k] = *(const PG8_LAS bf16x8*)(lds + PG8_SB(b, h) + boff + n * 2048 + k * 1024); } } while (0)
#define PG8_MMA(ai, bj, At, Bt) do { __builtin_amdgcn_s_setprio(1); \
        if constexpr (F8) { _Pragma("unroll") for (int m = 0; m < 4; ++m) _Pragma("unroll") for (int n = 0; n < 2; ++n) \
            asm volatile("v_mfma_scale_f32_16x16x128_f8f6f4 %0, %1, %2, %0, %3, %3 op_sel_hi:[0,0,0]" : "+v"(acc[ai][bj][m][n]) : "v"(Bt##8[n]), "v"(A8[m]), "v"(one_scale)); } \
        else { _Pragma("unroll") for (int m = 0; m < 4; ++m) _Pragma("unroll") for (int n = 0; n < 2; ++n) _Pragma("unroll") for (int k = 0; k < 2; ++k) \
            acc[ai][bj][m][n] = __builtin_amdgcn_mfma_f32_16x16x32_bf16(Bt[n][k], At[m][k], acc[ai][bj][m][n], 0, 0, 0); } \
        __builtin_amdgcn_s_setprio(0); } while (0)
#define PG8_WAIT_V(n) asm volatile("s_waitcnt vmcnt(" #n ")" ::: "memory")
#define PG8_WAIT_L(n) asm volatile("s_waitcnt lgkmcnt(" #n ")" ::: "memory")
#define PG8_BAR __builtin_amdgcn_s_barrier()
#define PG8_SCHED __builtin_amdgcn_sched_barrier(0)
    Unit cur, nxt; int cursor = 0;
    if (!S.next(cursor, cur)) return;
    f32x4 acc[2][2][4][2];
#pragma unroll
    for (int a = 0; a < 2; ++a)
#pragma unroll
        for (int b = 0; b < 2; ++b)
#pragma unroll
            for (int m = 0; m < 4; ++m)
#pragma unroll
                for (int n = 0; n < 2; ++n) acc[a][b][m][n] = (f32x4){0.f, 0.f, 0.f, 0.f};
    bf16x8 At[4][2], B0[2][2], B1[2][2];
    v8i_t A8[4], B08[2], B18[2];
    int one_scale = 0x7F7F7F7F; asm volatile("" : "+v"(one_scale));
    const char* cA = (const char*)g.A + cur.aoff; const char* cB = (const char*)g.Bt + cur.boff;
    if constexpr (SP2) {
        PG8_STAGE(PG8_SB(0, 0), cB, voffB); PG8_STAGE(PG8_SB(0, 1), cB + hstepB, voffB); PG8_STAGE(PG8_SA(0, 0), cA, voffA); PG8_STAGE(PG8_SA(0, 1), cA + hstepA, voffA);
        if (wr == 1) PG8_BAR;
        PG8_WAIT_V(2); PG8_BAR;
        PG8_STAGE(PG8_SB(1, 0), cB + kstep, voffB); PG8_STAGE(PG8_SA(1, 0), cA + kstep, voffA); PG8_STAGE(PG8_SB(1, 1), cB + hstepB + kstep, voffB);
        PG8_WAIT_V(6); PG8_BAR;
    } else {
        PG8_STAGE(PG8_SB(0, 0), cB, voffB); PG8_STAGE(PG8_SA(0, 0), cA, voffA); PG8_STAGE(PG8_SB(0, 1), cB + hstepB, voffB); PG8_STAGE(PG8_SA(0, 1), cA + hstepA, voffA);
        if (wr == 1) PG8_BAR;
        PG8_WAIT_V(4); PG8_BAR;
        PG8_STAGE(PG8_SB(1, 0), cB + kstep, voffB); PG8_STAGE(PG8_SA(1, 0), cA + kstep, voffA); PG8_STAGE(PG8_SB(1, 1), cB + hstepB + kstep, voffB);
        PG8_WAIT_V(6); PG8_BAR;
    }
    for (;;) {
        const bool has_next = S.next(cursor, nxt);
        const char* nA = has_next ? (const char*)g.A + nxt.aoff : cA; const char* nB = has_next ? (const char*)g.Bt + nxt.boff : cB;
        for (int t = 0; t < nt; t += 2) {
            const bool last = (t == nt - 2);
            const char* a1 = cA + (size_t)(t + 1) * kstep;
            const char* a2 = last ? nA : cA + (size_t)(t + 2) * kstep; const char* b2 = last ? nB : cB + (size_t)(t + 2) * kstep;
            const char* a3 = a2 + kstep; const char* b3 = b2 + kstep;
            if constexpr (SP2) {
            PG8_LDB(B0, 0, 0); PG8_LDB(B1, 0, 1); PG8_SCHED; PG8_LDA(At, 0, 0); PG8_STAGE(PG8_SA(1, 1), a1 + hstepA, voffA);
            PG8_WAIT_V(8); PG8_WAIT_L(0); PG8_BAR; PG8_MMA(0, 0, At, B0); PG8_MMA(0, 1, At, B1); PG8_BAR; PG8_SCHED;
            PG8_LDA(At, 0, 1); PG8_STAGE(PG8_SB(0, 0), b2, voffB); PG8_STAGE(PG8_SB(0, 1), b2 + hstepB, voffB); PG8_STAGE(PG8_SA(0, 0), a2, voffA);
            PG8_WAIT_V(8); PG8_WAIT_L(0); PG8_BAR; PG8_MMA(1, 0, At, B0); PG8_MMA(1, 1, At, B1); PG8_BAR; PG8_SCHED;
            PG8_LDB(B0, 1, 0); PG8_LDB(B1, 1, 1); PG8_SCHED; PG8_LDA(At, 1, 0); PG8_STAGE(PG8_SA(0, 1), a2 + hstepA, voffA);
            PG8_WAIT_V(8); PG8_WAIT_L(0); PG8_BAR; PG8_MMA(0, 0, At, B0); PG8_MMA(0, 1, At, B1); PG8_BAR; PG8_SCHED;
            PG8_LDA(At, 1, 1); PG8_STAGE(PG8_SB(1, 0), b3, voffB); PG8_STAGE(PG8_SB(1, 1), b3 + hstepB, voffB); PG8_STAGE(PG8_SA(1, 0), a3, voffA);
            PG8_WAIT_V(8); PG8_WAIT_L(0); PG8_BAR; PG8_MMA(1, 0, At, B0); PG8_MMA(1, 1, At, B1); PG8_BAR; PG8_SCHED;
            } else {
            PG8_LDB(B0, 0, 0); PG8_SCHED; PG8_LDA(At, 0, 0); PG8_STAGE(PG8_SA(1, 1), a1 + hstepA, voffA);
            PG8_WAIT_L(8); PG8_BAR; PG8_WAIT_L(0); PG8_MMA(0, 0, At, B0); PG8_BAR; PG8_SCHED;
            PG8_LDB(B1, 0, 1); PG8_STAGE(PG8_SB(0, 0), b2, voffB);
            PG8_BAR; PG8_WAIT_L(0); PG8_MMA(0, 1, At, B1); PG8_BAR;
            PG8_LDA(At, 0, 1); PG8_STAGE(PG8_SA(0, 0), a2, voffA);
            PG8_BAR; PG8_WAIT_L(0); PG8_MMA(1, 0, At, B0); PG8_BAR; PG8_SCHED;
            PG8_STAGE(PG8_SB(0, 1), b2 + hstepB, voffB);
            PG8_WAIT_V(6); PG8_BAR; PG8_MMA(1, 1, At, B1); PG8_BAR;
            PG8_LDB(B0, 1, 0); PG8_SCHED; PG8_LDA(At, 1, 0); PG8_STAGE(PG8_SA(0, 1), a2 + hstepA, voffA);
            PG8_WAIT_L(8); PG8_BAR; PG8_WAIT_L(0); PG8_MMA(0, 0, At, B0); PG8_BAR; PG8_SCHED;
            PG8_LDB(B1, 1, 1); PG8_STAGE(PG8_SB(1, 0), b3, voffB);
            PG8_BAR; PG8_WAIT_L(0); PG8_MMA(0, 1, At, B1); PG8_BAR;
            PG8_LDA(At, 1, 1); PG8_STAGE(PG8_SA(1, 0), a3, voffA);
            PG8_BAR; PG8_WAIT_L(0); PG8_MMA(1, 0, At, B0); PG8_BAR; PG8_SCHED;
            PG8_STAGE(PG8_SB(1, 1), b3 + hstepB, voffB);
            PG8_WAIT_V(6); PG8_BAR; PG8_MMA(1, 1, At, B1); PG8_BAR;
            }
        }
        if constexpr (F8) asm volatile("s_nop 15\n\ts_nop 15" ::: "memory");
        if constexpr (ALIGN_EPI) { if (wr == 0) PG8_BAR; }
        E(acc, cur, wr, wc, fr, fq);
        if (!has_next) break;
#pragma unroll
        for (int a = 0; a < 2; ++a)
#pragma unroll
            for (int b = 0; b < 2; ++b)
#pragma unroll
                for (int m = 0; m < 4; ++m)
#pragma unroll
                    for (int n = 0; n < 2; ++n) acc[a][b][m][n] = (f32x4){0.f, 0.f, 0.f, 0.f};
        cur = nxt; cA = nA; cB = nB;
        if constexpr (ALIGN_EPI) { if (wr == 1) PG8_BAR; }
    }
    PG8_WAIT_V(0);
    if constexpr (!ALIGN_EPI) { if (wr == 0) PG8_BAR; }
    PG8_BAR;
#undef PG8_SA
#undef PG8_SB
#undef PG8_STAGE
#undef PG8_LDA
#undef PG8_LDB
#undef PG8_MMA
#undef PG8_LD16
#undef PG8_WAIT_V
#undef PG8_WAIT_L
#undef PG8_BAR
#undef PG8_SCHED
}
}

#define XB_TMO      128
#define XB_XCNT(j)  (256  + 64 * (j))
#define XB_XSUB(j)  (1280 + 64 * (j))
#define XB_XGEN(j)  (2304 + 64 * (j))
#define XB_TOP      3328
#define XB_TOPGEN   3392
#define XCD_BAR_WORDS 3456
#define XB_SPIN_CAP (1u << 18)

__device__ __forceinline__ unsigned xb_ld(unsigned* p)              { return __hip_atomic_load(p, __ATOMIC_RELAXED, __HIP_MEMORY_SCOPE_AGENT); }
__device__ __forceinline__ unsigned xb_add(unsigned* p, unsigned v) { return __hip_atomic_fetch_add(p, v, __ATOMIC_RELAXED, __HIP_MEMORY_SCOPE_AGENT); }
__device__ __forceinline__ unsigned xb_xcc_id() { return (unsigned)__builtin_amdgcn_s_getreg((3 << 11) | 20) & 0xFu; }
#define XB_SPIN(cond, bar) do { unsigned _sp = 0; while (cond) { __builtin_amdgcn_s_sleep(1); \
    if ((++_sp & 255u) == 0u) { if (xb_ld(&(bar)[XB_TMO])) break; if (_sp > XB_SPIN_CAP) { atomicAdd(&(bar)[XB_TMO], 1u); break; } } } } while (0)

struct XcdBarrier {
    unsigned* bar; unsigned x;
    volatile LAS unsigned* st;
};

__device__ __forceinline__ XcdBarrier xcd_barrier_post(unsigned* bar, volatile LAS unsigned* st) {
    XcdBarrier b; b.bar = bar; b.x = xb_xcc_id(); b.st = st;
    if (threadIdx.x == 0) (void)xb_add(&bar[XB_XCNT(b.x)], 1u);
    return b;
}
__device__ __forceinline__ void xcd_barrier_complete(unsigned* bar, unsigned x, unsigned& nloc, unsigned& nx) {
    const unsigned G = gridDim.x * gridDim.y * gridDim.z;
    unsigned sum, cnt, mine, sp = 0u;
    for (;;) {
        sum = 0u; cnt = 0u; mine = 0u;
#pragma unroll
        for (unsigned j = 0; j < 16; ++j) { const unsigned c = xb_ld(&bar[XB_XCNT(j)]); sum += c; cnt += (c > 0u) ? 1u : 0u; mine = (j == x) ? c : mine; }
        if (sum == G) break;
        __builtin_amdgcn_s_sleep(1);
        if ((++sp & 255u) == 0u) { if (xb_ld(&bar[XB_TMO])) break; if (sp > XB_SPIN_CAP) { atomicAdd(&bar[XB_TMO], 1u); break; } }
    }
    nloc = mine > 0u ? mine : 1u; nx = cnt > 0u ? cnt : 1u;
}

__device__ __forceinline__ void xcd_barrier(const XcdBarrier& b) {
    asm volatile("s_waitcnt vmcnt(0)" ::: "memory");
    __syncthreads();
    if (threadIdx.x == 0) {
        unsigned* bar = b.bar;
        __builtin_amdgcn_s_waitcnt(0);
        unsigned nloc = b.st[0], nx = b.st[1];
        if (nloc == 0u) { xcd_barrier_complete(bar, b.x, nloc, nx); b.st[0] = nloc; b.st[1] = nx; }
        const unsigned old = xb_add(&bar[XB_XSUB(b.x)], 1u);
        const unsigned gen = old / nloc;
        if (old + 1u == (gen + 1u) * nloc) {
            __builtin_amdgcn_fence(__ATOMIC_RELEASE, "agent");
            asm volatile("s_waitcnt vmcnt(0)" ::: "memory");
            const unsigned og = xb_add(&bar[XB_TOP], 1u);
            const unsigned tg = og / nx;
            if (og + 1u == (tg + 1u) * nx) xb_add(&bar[XB_TOPGEN], 1u);
            else XB_SPIN(xb_ld(&bar[XB_TOPGEN]) == tg, bar);
            __builtin_amdgcn_fence(__ATOMIC_ACQUIRE, "agent");
            xb_add(&bar[XB_XGEN(b.x)], 1u);
            asm volatile("s_waitcnt vmcnt(0)" ::: "memory");
        } else {
            XB_SPIN(xb_ld(&bar[XB_XGEN(b.x)]) == gen, bar);
            __builtin_amdgcn_fence(__ATOMIC_ACQUIRE, "agent");
            asm volatile("s_waitcnt vmcnt(0)" ::: "memory");
        }
    }
    __syncthreads();
}

constexpr int NWAVES = 8, NTHR = 512;
constexpr int DM = 1024, NB = 8, SEQ = 4096, CTXL = 256, DEPTH = 4;
constexpr int NLAT = NB * SEQ, NCTX = NB * CTXL, NT = NLAT + NCTX;
constexpr int PW = 2304;
constexpr int MW = 1280;
constexpr int NEXP = 32, MAXBLK = 576;
constexpr int NCHK = 544;
constexpr int S5ROWS = 2304;
constexpr int PC_FU = 0, PC_S5 = 256, PC_Q = 512, PC_K = 640, PC_V = 768, PC_R = 1024, PC_Z = 1280, PC_XBC = 1536, PC_A1 = 2048, PC_DT = 2080;
enum { I_X = 0, I_C, I_CTX, I_CCTX, I_ADAW, I_ADAB, I_NMG, I_NFG, I_WIN, I_WOUT, I_FOURW, I_S5LRE, I_S5LIM, I_S5LDT, I_S5BRE, I_S5BIM, I_S5CRE, I_S5CIM, I_S5D, I_S5GLU,
       I_GLAA2, I_GLAAB, I_GLANG, I_SSDCW, I_SSDCB, I_SSDALOG, I_SSDDTB, I_SSDD, I_SSDNG, I_RW, I_RB, I_WGU, I_BGU, I_WDN, I_BDN, I_FING, N_IN };

constexpr size_t al256(size_t x) { return (x + 255) & ~(size_t)255; }
constexpr size_t WS_CTL = 0, CTL_BYTES = 1u << 20;
constexpr size_t WS_MOD = WS_CTL + CTL_BYTES;
constexpr size_t WS_TAB = WS_MOD + al256((size_t)DEPTH * 9 * 6144 * 4);
constexpr size_t TAB_F64 = 0, TAB_TW = 16384, TAB_D256 = 16384 + 32768, TAB_BYTES = 65536;
constexpr size_t WS_A16 = WS_TAB + TAB_BYTES;
constexpr size_t WS_WIN = WS_A16 + al256((size_t)DEPTH * 2 * 16 * 64 * 2 * 4);
constexpr size_t WS_WOUT = WS_WIN + (size_t)DEPTH * PW * DM * 2;
constexpr size_t WS_WGLU = WS_WOUT + (size_t)DEPTH * DM * MW * 2;
constexpr size_t WS_S5P = WS_WGLU + (size_t)DEPTH * 256 * 256 * 2;
constexpr size_t WS_S5B2 = WS_S5P + (size_t)DEPTH * 16 * 256 * 256 * 2;
constexpr size_t WS_WGU = WS_S5B2 + (size_t)DEPTH * 16 * 256 * 512 * 2;
constexpr size_t WS_WDN = WS_WGU + (size_t)DEPTH * NEXP * 2048 * DM;
constexpr size_t WS_XS = WS_WDN + (size_t)DEPTH * NEXP * DM * DM;
constexpr size_t WS_H = WS_XS + (size_t)NT * DM * 4;
constexpr size_t WS_PBUF = WS_H + (size_t)NT * DM * 2;
constexpr size_t WS_A2 = WS_PBUF + (size_t)NT * PW * 2;
constexpr size_t WS_S5S = WS_A2 + (size_t)16 * S5ROWS * 512 * 2;
constexpr size_t WS_ACT5 = WS_S5S + (size_t)16 * S5ROWS * 256 * 4;
constexpr size_t WS_MIX = WS_ACT5 + (size_t)NT * 256 * 2;
constexpr size_t WS_GDS = WS_MIX + (size_t)NT * MW * 2;
constexpr size_t WS_GDEC = WS_GDS + (size_t)NCHK * 8 * 2048 * 4;
constexpr size_t WS_GSE = WS_GDEC + al256((size_t)NCHK * 8 * 32 * 4);
constexpr size_t WS_SDS = WS_GSE + (size_t)NCHK * 8 * 2048 * 2;
constexpr size_t WS_SDEC = WS_SDS + (size_t)NCHK * 8 * 4096 * 4;
constexpr size_t WS_SSE = WS_SDEC + al256((size_t)NCHK * 8 * 4);
constexpr size_t WS_PE = WS_SSE + (size_t)NCHK * 8 * 4096 * 2;
constexpr size_t WS_PR = WS_PE + (size_t)NT * 4 * 4;
constexpr size_t WS_PG = WS_PR + (size_t)NT * 4 * 4;
constexpr size_t WS_PS = WS_PG + (size_t)NT * 4 * 4;
constexpr size_t WS_SG = WS_PS + (size_t)NT * 4 * 4;
constexpr size_t WS_H8 = WS_SG + (size_t)MAXBLK * 256 * 4;
constexpr size_t WS_BUF = WS_H8 + (size_t)NT * DM;
constexpr size_t WS_ACT = WS_BUF + (size_t)MAXBLK * 256 * DM;
constexpr size_t WS_Y = WS_ACT + (size_t)MAXBLK * 256 * DM;
constexpr size_t WS_END = WS_Y + (size_t)MAXBLK * 256 * DM * 2;
constexpr int CW_QUEUE = 64;
constexpr int CW_CNT = 1024;
constexpr int CW_BLKE = 2048;
constexpr int CW_BAR = 8192;

constexpr int LDS_BYTES = 163840, MISC_OFF = LDS_BYTES - 256;

constexpr float W8_SCALE = 32.f, H8_SCALE = 8.f, A8_SCALE = 4.f;
__device__ __forceinline__ unsigned pk4f8(float a, float b, float c, float d) { int w = 0; w = __builtin_amdgcn_cvt_pk_fp8_f32(a, b, w, false); w = __builtin_amdgcn_cvt_pk_fp8_f32(c, d, w, true); return (unsigned)w; }
#define RLX_AGENT __ATOMIC_RELAXED, __HIP_MEMORY_SCOPE_AGENT
__device__ __forceinline__ int fresh_tid(int wave0) { int l = (int)__builtin_amdgcn_mbcnt_hi(~0u, __builtin_amdgcn_mbcnt_lo(~0u, 0u)); asm volatile("" : "+v"(l)); return wave0 * 64 + l; }
__device__ __forceinline__ unsigned f2bf(float f) { unsigned u = __builtin_bit_cast(unsigned, f); return (u + 0x7fffu + ((u >> 16) & 1u)) >> 16; }
__device__ __forceinline__ unsigned pk2(float lo, float hi) { return f2bf(lo) | (f2bf(hi) << 16); }
__device__ __forceinline__ float bf2f(unsigned short b) { return __builtin_bit_cast(float, (unsigned)b << 16); }
__device__ __forceinline__ float bflo(unsigned w) { return __builtin_bit_cast(float, w << 16); }
__device__ __forceinline__ float bfhi(unsigned w) { return __builtin_bit_cast(float, w & 0xffff0000u); }
template <int M> __device__ __forceinline__ float swz_xor(float v) { return __builtin_bit_cast(float, __builtin_amdgcn_ds_swizzle(__builtin_bit_cast(int, v), (M << 10) | 0x1F)); }
__device__ __forceinline__ float xor32f(float v, int lane) { return __builtin_bit_cast(float, __builtin_amdgcn_ds_bpermute((lane ^ 32) << 2, __builtin_bit_cast(int, v))); }
__device__ __forceinline__ float wave_sum(float v, int lane) { v += swz_xor<1>(v); v += swz_xor<2>(v); v += swz_xor<4>(v); v += swz_xor<8>(v); v += swz_xor<16>(v); v += xor32f(v, lane); return v; }
__device__ __forceinline__ float wave_max(float v, int lane) { v = fmaxf(v, swz_xor<1>(v)); v = fmaxf(v, swz_xor<2>(v)); v = fmaxf(v, swz_xor<4>(v)); v = fmaxf(v, swz_xor<8>(v)); v = fmaxf(v, swz_xor<16>(v)); v = fmaxf(v, xor32f(v, lane)); return v; }
__device__ __forceinline__ float sigmoidf_(float x) { return 1.f / (1.f + __expf(-x)); }
__device__ __forceinline__ float siluf_(float x) { return x / (1.f + __expf(-x)); }

template <class Fill> struct SgOrder {
    int nblk, nN, R, r, lo, hi; Fill f;
    __device__ __forceinline__ void init(int nblk_, int nN_, int G, int c) { nblk = nblk_; nN = nN_; const int U = nblk * nN; int x, nx;
        if ((G & 7) == 0) { R = G >> 3; x = c & 7; r = c >> 3; nx = 8; } else { R = G; x = 0; r = c; nx = 1; }
        lo = (int)(((long)x * U) / nx); hi = (int)(((long)(x + 1) * U) / nx); }
    __device__ __forceinline__ bool next(int& cursor, pg8::Unit& u) const {
        const int q = lo + r + R * cursor; ++cursor;
        if (q >= hi) return false;
        const int ups = 8 * nN, sg = q / ups, ql = q - sg * ups, nb = (nblk - sg * 8) < 8 ? (nblk - sg * 8) : 8;
        u.pm = sg * 8 + ql % nb; u.pn = ql / nb; f(u); return true;
    }
};
struct FillPlain { size_t astep, bstep; __device__ __forceinline__ void operator()(pg8::Unit& u) const { u.grp = 0; u.aoff = (size_t)u.pm * astep; u.boff = (size_t)u.pn * bstep; } };
struct FillS5 { size_t bgrp; __device__ __forceinline__ void operator()(pg8::Unit& u) const { const int g = u.pm / 9, t = u.pm - g * 9; u.grp = g; u.pm = t; u.aoff = ((size_t)g * S5ROWS + (size_t)t * 256) * 512 * 2; u.boff = (size_t)g * bgrp; } };
struct FillMoe { const unsigned* blke; int erows; __device__ __forceinline__ void operator()(pg8::Unit& u) const { const int e = (int)blke[1 + u.pm]; u.grp = e; u.aoff = (size_t)u.pm * 256 * DM; u.boff = ((size_t)e * erows + (size_t)u.pn * 256) * DM; } };

using pg8::cvt_pk_bf16;
struct EpiInproj {
    static constexpr bool PERM = true;
    bf16* P; bf16* A2;
    __device__ __forceinline__ void operator()(const f32x4 (&acc)[2][2][4][2], const pg8::Unit& u, int wr, int wc, int fr, int fq) const {
        const int row0 = u.pm * 256 + wr * 64 + fr, col0 = u.pn * 256 + wc * 32 + 8 * fq;
#pragma unroll
        for (int ai = 0; ai < 2; ++ai)
#pragma unroll
            for (int m = 0; m < 4; ++m) {
                const int row = row0 + ai * 128 + m * 16;
#pragma unroll
                for (int bj = 0; bj < 2; ++bj) {
                    const f32x4 v0 = acc[ai][bj][m][0], v1 = acc[ai][bj][m][1];
                    u32x4 w; w.x = cvt_pk_bf16(v0[0], v0[1]); w.y = cvt_pk_bf16(v0[2], v0[3]); w.z = cvt_pk_bf16(v1[0], v1[1]); w.w = cvt_pk_bf16(v1[2], v1[3]);
                    const int col = col0 + bj * 128;
                    if (u.pn == 1) {
                        const int cc = col - 256, g = cc >> 4, hp = cc & 15;
                        const int crow = row < NLAT ? (row >> 4) : (2048 + ((row - NLAT) >> 4)), s = row & 15;
                        *(u32x4*)(A2 + ((size_t)g * S5ROWS + crow) * 512 + s * 16 + hp) = w;
                    } else *(u32x4*)(P + (size_t)row * PW + col) = w;
                }
            }
    }
};
struct EpiOutproj {
    static constexpr bool PERM = false;
    const float* xin; const float* ctxin; float* XS; const float* modL; int first;
    __device__ __forceinline__ void operator()(const f32x4 (&acc)[2][2][4][2], const pg8::Unit& u, int wr, int wc, int fr, int fq) const {
        const int rowt = u.pm * 256, bi = rowt < NLAT ? (rowt >> 12) : 8;
        const int row0 = rowt + wr * 64 + fr, col0 = u.pn * 256 + wc * 32 + 4 * fq;
        const float* gate = modL + (size_t)bi * 6144 + 2 * 1024;
        f32x4 gv[2][2];
#pragma unroll
        for (int bj = 0; bj < 2; ++bj)
#pragma unroll
            for (int n = 0; n < 2; ++n) gv[bj][n] = *(const f32x4*)(gate + col0 + bj * 128 + n * 16);
#pragma unroll
        for (int ai = 0; ai < 2; ++ai)
#pragma unroll
            for (int m = 0; m < 4; ++m) {
                const int row = row0 + ai * 128 + m * 16;
                const float* src = first ? (row < NLAT ? xin + (size_t)row * DM : ctxin + (size_t)(row - NLAT) * DM) : XS + (size_t)row * DM;
                float* dst = XS + (size_t)row * DM;
#pragma unroll
                for (int bj = 0; bj < 2; ++bj)
#pragma unroll
                    for (int n = 0; n < 2; ++n) { const int c = col0 + bj * 128 + n * 16; const f32x4 xo = *(const f32x4*)(src + c); *(f32x4*)(dst + c) = xo + gv[bj][n] * acc[ai][bj][m][n]; }
            }
    }
};
struct EpiSwiglu {
    static constexpr bool PERM = true;
    unsigned char* ACT; const float* bgu;
    __device__ __forceinline__ void operator()(const f32x4 (&acc)[2][2][4][2], const pg8::Unit& u, int wr, int wc, int fr, int fq) const {
        const int row0 = u.pm * 256 + wr * 64 + fr, i0 = u.pn * 128 + wc * 32 + 8 * fq;
        const float* bb = bgu + (size_t)u.grp * 2048 + 2 * i0;
        const f32x4 b0 = *(const f32x4*)(bb), b1 = *(const f32x4*)(bb + 4), b2 = *(const f32x4*)(bb + 8), b3 = *(const f32x4*)(bb + 12);
        const float bg[8] = {b0[0], b0[2], b1[0], b1[2], b2[0], b2[2], b3[0], b3[2]}, bu[8] = {b0[1], b0[3], b1[1], b1[3], b2[1], b2[3], b3[1], b3[3]};
        constexpr float inv = 1.f / (H8_SCALE * W8_SCALE);
#pragma unroll
        for (int ai = 0; ai < 2; ++ai)
#pragma unroll
            for (int m = 0; m < 4; ++m) {
                const int row = row0 + ai * 128 + m * 16;
                float o[8];
#pragma unroll
                for (int n = 0; n < 2; ++n)
#pragma unroll
                    for (int j = 0; j < 4; ++j) {
                        const int q = 4 * n + j;
                        const float gt = fminf(acc[ai][0][m][n][j] * inv + bg[q], 7.0f);
                        const float up = fminf(fmaxf(acc[ai][1][m][n][j] * inv + bu[q], -7.0f), 7.0f);
                        o[q] = (up + 1.0f) * gt * sigmoidf_(1.702f * gt) * A8_SCALE;
                    }
                u32x2 w; w.x = pk4f8(o[0], o[1], o[2], o[3]); w.y = pk4f8(o[4], o[5], o[6], o[7]);
                *(u32x2*)(ACT + (size_t)row * DM + i0) = w;
            }
    }
};
struct EpiDown {
    static constexpr bool PERM = true;
    bf16* Y; const float* bdn; const float* sg;
    __device__ __forceinline__ void operator()(const f32x4 (&acc)[2][2][4][2], const pg8::Unit& u, int wr, int wc, int fr, int fq) const {
        const int row0 = u.pm * 256 + wr * 64 + fr, col0 = u.pn * 256 + wc * 32 + 8 * fq;
        const float* bb = bdn + (size_t)u.grp * DM + col0;
        constexpr float inv = 1.f / (A8_SCALE * W8_SCALE);
        f32x4 bv[2][2];
#pragma unroll
        for (int bj = 0; bj < 2; ++bj)
#pragma unroll
            for (int n = 0; n < 2; ++n) bv[bj][n] = *(const f32x4*)(bb + bj * 128 + 4 * n);
#pragma unroll
        for (int ai = 0; ai < 2; ++ai)
#pragma unroll
            for (int m = 0; m < 4; ++m) {
                const int row = row0 + ai * 128 + m * 16; const float gt = sg[row];
#pragma unroll
                for (int bj = 0; bj < 2; ++bj) {
                    const f32x4 v0 = (acc[ai][bj][m][0] * inv + bv[bj][0]) * gt, v1 = (acc[ai][bj][m][1] * inv + bv[bj][1]) * gt;
                    u32x4 w; w.x = cvt_pk_bf16(v0[0], v0[1]); w.y = cvt_pk_bf16(v0[2], v0[3]); w.z = cvt_pk_bf16(v1[0], v1[1]); w.w = cvt_pk_bf16(v1[2], v1[3]);
                    *(u32x4*)(Y + (size_t)row * DM + col0 + bj * 128) = w;
                }
            }
    }
};
struct EpiS5S {
    static constexpr bool PERM = false;
    float* S;
    __device__ __forceinline__ void operator()(const f32x4 (&acc)[2][2][4][2], const pg8::Unit& u, int wr, int wc, int fr, int fq) const {
        const int row0 = u.pm * 256 + wr * 64 + fr, col0 = wc * 32 + 4 * fq;
        float* base = S + (size_t)u.grp * S5ROWS * 256;
#pragma unroll
        for (int ai = 0; ai < 2; ++ai)
#pragma unroll
            for (int m = 0; m < 4; ++m) { float* rp = base + (size_t)(row0 + ai * 128 + m * 16) * 256 + col0;
#pragma unroll
                for (int bj = 0; bj < 2; ++bj)
#pragma unroll
                    for (int n = 0; n < 2; ++n) *(f32x4*)(rp + bj * 128 + n * 16) = acc[ai][bj][m][n]; }
    }
};
__device__ __forceinline__ float gelu_tanh(float x) { const float t = 0.7978845608f * (x + 0.044715f * x * x * x); const float e = __expf(2.f * t); return 0.5f * x * (1.f + (1.f - 2.f / (e + 1.f))); }
struct EpiS5Y {
    static constexpr bool PERM = true;
    bf16* ACT5;
    __device__ __forceinline__ void operator()(const f32x4 (&acc)[2][2][4][2], const pg8::Unit& u, int wr, int wc, int fr, int fq) const {
        const int row0 = u.pm * 256 + wr * 64 + fr, col0 = wc * 32 + 8 * fq;
#pragma unroll
        for (int ai = 0; ai < 2; ++ai)
#pragma unroll
            for (int m = 0; m < 4; ++m) {
                const int crow = row0 + ai * 128 + m * 16;
                if (crow >= 2176) continue;
                const int tok0 = crow < 2048 ? crow * 16 : NLAT + (crow - 2048) * 16;
#pragma unroll
                for (int bj = 0; bj < 2; ++bj) {
                    const int col = col0 + bj * 128, j = col >> 4, h = col & 15;
                    const f32x4 v0 = acc[ai][bj][m][0], v1 = acc[ai][bj][m][1];
                    u32x4 w; w.x = cvt_pk_bf16(gelu_tanh(v0[0]), gelu_tanh(v0[1])); w.y = cvt_pk_bf16(gelu_tanh(v0[2]), gelu_tanh(v0[3]));
                    w.z = cvt_pk_bf16(gelu_tanh(v1[0]), gelu_tanh(v1[1])); w.w = cvt_pk_bf16(gelu_tanh(v1[2]), gelu_tanh(v1[3]));
                    *(u32x4*)(ACT5 + (size_t)(tok0 + j) * 256 + u.grp * 16 + h) = w;
                }
            }
    }
};
struct EpiGlu {
    static constexpr bool PERM = true;
    const bf16* ACT5; bf16* MIX;
    __device__ __forceinline__ void operator()(const f32x4 (&acc)[2][2][4][2], const pg8::Unit& u, int wr, int wc, int fr, int fq) const {
        const int row0 = u.pm * 256 + wr * 64 + fr, col0 = wc * 32 + 8 * fq;
#pragma unroll
        for (int ai = 0; ai < 2; ++ai)
#pragma unroll
            for (int m = 0; m < 4; ++m) {
                const int row = row0 + ai * 128 + m * 16;
#pragma unroll
                for (int bj = 0; bj < 2; ++bj) {
                    const int col = col0 + bj * 128;
                    const u32x4 a = *(const u32x4*)(ACT5 + (size_t)row * 256 + col);
                    const f32x4 v0 = acc[ai][bj][m][0], v1 = acc[ai][bj][m][1];
                    u32x4 w;
                    w.x = cvt_pk_bf16(bflo(a.x) * sigmoidf_(v0[0]), bfhi(a.x) * sigmoidf_(v0[1])); w.y = cvt_pk_bf16(bflo(a.y) * sigmoidf_(v0[2]), bfhi(a.y) * sigmoidf_(v0[3]));
                    w.z = cvt_pk_bf16(bflo(a.z) * sigmoidf_(v1[0]), bfhi(a.z) * sigmoidf_(v1[1])); w.w = cvt_pk_bf16(bflo(a.w) * sigmoidf_(v1[2]), bfhi(a.w) * sigmoidf_(v1[3]));
                    *(u32x4*)(MIX + (size_t)row * MW + 512 + col) = w;
                }
            }
    }
};

struct Args { const float* in[N_IN]; float* out; unsigned char* ws; int ph_lo, ph_hi; };
typedef const __attribute__((address_space(4))) Args CArgs;
__device__ __forceinline__ CArgs* fresh_args() { CArgs* p = (CArgs*)__builtin_amdgcn_kernarg_segment_ptr(); asm volatile("" : "+s"(p)); return p; }
struct Frame {
    LAS unsigned char* lds; volatile LAS unsigned* MISC; unsigned* ctl; unsigned char* ws;
    int tid, lane, wave, G, bid;
};

template <class Map> __device__ __forceinline__ void transpose_tile(const float* W, int ldw, int ncols, int k0, int n0, bf16* WT, int ldt, int kd0, const Map& map, LAS float* scr, int lane) {
    const int nn = n0 + lane;
#pragma unroll 16
    for (int kk = 0; kk < 64; ++kk) scr[kk * 65 + lane] = nn < ncols ? W[(size_t)(k0 + kk) * ldw + nn] : 0.f;
    asm volatile("s_waitcnt lgkmcnt(0)" ::: "memory");
    const int c = lane & 7;
#pragma unroll
    for (int j = 0; j < 8; ++j) {
        const int n = (lane >> 3) + 8 * j; const LAS float* s = scr + (8 * c) * 65 + n;
        u32x4 o; o.x = pk2(s[0], s[65]); o.y = pk2(s[2 * 65], s[3 * 65]); o.z = pk2(s[4 * 65], s[5 * 65]); o.w = pk2(s[6 * 65], s[7 * 65]);
        const int dr = (n0 + n) < ncols ? map(n0 + n) : -1;
        if (dr >= 0) *(u32x4*)(WT + (size_t)dr * ldt + kd0 + 8 * c) = o;
    }
    asm volatile("s_waitcnt lgkmcnt(0)" ::: "memory");
}
struct MapId { __device__ __forceinline__ int operator()(int n) const { return n; } };
struct MapWin { __device__ __forceinline__ int operator()(int c) const { return c < 1280 ? c : (c < 1312 ? 2048 + (c - 1280) : (c < 2080 ? c - 32 : c)); } };
struct MapGu { __device__ __forceinline__ int operator()(int n) const { const int i = n >> 1; return (i >> 7) * 256 + (n & 1) * 128 + (i & 127); } };

template <class Map> __device__ __forceinline__ void transpose_tile_f8(const float* W, int ldw, int k0, int n0, unsigned char* WT, int ldt, const Map& map, LAS float* scr, int lane) {
#pragma unroll 16
    for (int kk = 0; kk < 64; ++kk) scr[kk * 65 + lane] = W[(size_t)(k0 + kk) * ldw + n0 + lane];
    asm volatile("s_waitcnt lgkmcnt(0)" ::: "memory");
    const int c = lane & 7;
#pragma unroll
    for (int j = 0; j < 8; ++j) {
        const int n = (lane >> 3) + 8 * j; const LAS float* s = scr + (8 * c) * 65 + n;
        u32x2 o; o.x = pk4f8(s[0] * W8_SCALE, s[65] * W8_SCALE, s[2 * 65] * W8_SCALE, s[3 * 65] * W8_SCALE); o.y = pk4f8(s[4 * 65] * W8_SCALE, s[5 * 65] * W8_SCALE, s[6 * 65] * W8_SCALE, s[7 * 65] * W8_SCALE);
        *(u32x2*)(WT + (size_t)map(n0 + n) * ldt + k0 + 8 * c) = o;
    }
    asm volatile("s_waitcnt lgkmcnt(0)" ::: "memory");
}
constexpr int PI_ADA = 48, PI_TAB = 1, PI_S5 = 64, PI_FOLD = 256, PI_ZERO = 4;
constexpr int TW_WIN = 16 * 33, TW_GU = 32 * 16 * 32, TW_DN = 32 * 16 * 16, TW_WOUT = 12 * 16, TW_GLU = 16, TW_LAYER = TW_WIN + TW_GU + TW_DN + TW_WOUT + TW_GLU;
constexpr int PI_TR = (DEPTH * TW_LAYER + 7) / 8;
constexpr int PI_B_TAB = PI_ADA, PI_B_S5 = PI_B_TAB + PI_TAB, PI_B_FOLD = PI_B_S5 + PI_S5, PI_B_ZERO = PI_B_FOLD + PI_FOLD, PI_B_TR = PI_B_ZERO + PI_ZERO, PI_TOTAL = PI_B_TR + PI_TR;

__device__ __forceinline__ void pro_adaln(Frame& F, CArgs& a, int it) {
    const int L = it / 12, cb = it % 12;
    LAS float* cond = (LAS float*)F.lds;
    for (int i = F.tid; i < 9 * 1024; i += NTHR) { const int r = i >> 10, k = i & 1023; const float v = r < 8 ? a.in[I_C][r * 1024 + k] : a.in[I_CCTX][k]; cond[i] = siluf_(v); }
    __syncthreads();
    const int n = cb * 512 + F.tid;
    const float* w = a.in[I_ADAW] + (size_t)L * 1024 * 6144 + n;
    float acc[9];
    const float b = a.in[I_ADAB][L * 6144 + n];
#pragma unroll
    for (int r = 0; r < 9; ++r) acc[r] = b;
#pragma unroll 2
    for (int k = 0; k < 1024; k += 4) {
        const float w0 = w[(size_t)k * 6144], w1 = w[(size_t)(k + 1) * 6144], w2 = w[(size_t)(k + 2) * 6144], w3 = w[(size_t)(k + 3) * 6144];
#pragma unroll
        for (int r = 0; r < 9; ++r) { const f32x4 c4 = *(const LAS f32x4*)(cond + r * 1024 + k); acc[r] += c4[0] * w0 + c4[1] * w1 + c4[2] * w2 + c4[3] * w3; }
    }
    float* mod = (float*)(F.ws + WS_MOD) + (size_t)L * 9 * 6144 + n;
#pragma unroll
    for (int r = 0; r < 9; ++r) mod[(size_t)r * 6144] = acc[r];
    __syncthreads();
}
__device__ __forceinline__ void pro_tables(Frame& F) {
    bf16* f64 = (bf16*)(F.ws + WS_TAB + TAB_F64);
    for (int i = F.tid; i < 4096; i += NTHR) { const int k = i >> 6, n = i & 63; float s, c; sincospif((float)((k * n) & 63) / 32.f, &s, &c); f64[i] = (bf16)f2bf(c); f64[4096 + i] = (bf16)f2bf(s); }
    float* tw = (float*)(F.ws + WS_TAB + TAB_TW);
    for (int i = F.tid; i < 4096; i += NTHR) { float s, c; sincospif((float)i / 2048.f, &s, &c); tw[2 * i] = c; tw[2 * i + 1] = s; }
    float* d256 = (float*)(F.ws + WS_TAB + TAB_D256);
    for (int i = F.tid; i < 256; i += NTHR) { float s, c; sincospif((float)i / 128.f, &s, &c); d256[2 * i] = c; d256[2 * i + 1] = s; }
}
__device__ __forceinline__ void pro_fold(Frame& F, CArgs& a, int it) {
    const int L = it >> 6, h = (it >> 4) & 3, nb = it & 15, n0 = nb * 64;
    LAS float* fw = (LAS float*)F.lds;
    LAS float* ct = fw + 64 * 65;
    if (F.tid < 64) ct[F.tid] = cospif((float)F.tid / 32.f);
    const float* four = a.in[I_FOURW] + (size_t)L * 256 * 256, *wo = a.in[I_WOUT] + (size_t)L * 1024 * 1024;
    const int n = F.tid & 63, cg = F.tid >> 6;
    { float s[8];
#pragma unroll
      for (int i = 0; i < 8; ++i) s[i] = 0.f;
      for (int j = 0; j < 256; ++j) { const float wv = wo[(size_t)j * 1024 + n0 + n];
#pragma unroll
          for (int i = 0; i < 8; ++i) s[i] += four[(size_t)(h * 64 + cg * 8 + i) * 256 + j] * wv; }
#pragma unroll
      for (int i = 0; i < 8; ++i) fw[(cg * 8 + i) * 65 + n] = s[i]; }
    __syncthreads();
    float oc[8], os[8];
#pragma unroll
    for (int i = 0; i < 8; ++i) { oc[i] = 0.f; os[i] = 0.f; }
    for (int kc = 0; kc < 64; ++kc) { const float v = fw[kc * 65 + n];
#pragma unroll
        for (int i = 0; i < 8; ++i) { const int mm = (kc * (cg * 8 + i)) & 63; oc[i] += ct[mm] * v; os[i] += ct[(mm + 48) & 63] * v; } }
    bf16* wt = (bf16*)(F.ws + WS_WOUT) + (size_t)L * DM * MW + (size_t)(n0 + n) * MW + h * 64 + cg * 8;
    u32x4 w; w.x = pk2(oc[0] * 0.125f, oc[1] * 0.125f); w.y = pk2(oc[2] * 0.125f, oc[3] * 0.125f); w.z = pk2(oc[4] * 0.125f, oc[5] * 0.125f); w.w = pk2(oc[6] * 0.125f, oc[7] * 0.125f);
    *(u32x4*)wt = w;
    w.x = pk2(os[0] * 0.125f, os[1] * 0.125f); w.y = pk2(os[2] * 0.125f, os[3] * 0.125f); w.z = pk2(os[4] * 0.125f, os[5] * 0.125f); w.w = pk2(os[6] * 0.125f, os[7] * 0.125f);
    *(u32x4*)(wt + 256) = w;
    __syncthreads();
}
__device__ __forceinline__ void pro_s5(Frame& F, CArgs& a, int it) {
    const int L = it >> 4, g = it & 15;
    LAS float* pw = (LAS float*)F.lds;
    LAS float* bb = pw + 2 * 64 * 17 * 2;
    LAS float* cm = bb + 2 * 64 * 16 * 2;
    LAS float* kt = cm + 2 * 16 * 64 * 2;
    for (int i = F.tid; i < 2 * 64 * 17; i += NTHR) {
        const int r = i / (64 * 17), p = (i / 17) & 63, e = i % 17; const size_t q = ((size_t)(L * 2 + r) * 16 + g) * 64 + p;
        const float dt = __expf(a.in[I_S5LDT][(L * 2 + r) * 16 + g]); const float lr = a.in[I_S5LRE][q] * dt, li = a.in[I_S5LIM][q] * dt;
        float s, c; sincosf(li * (float)e, &s, &c); const float m = expf(lr * (float)e); pw[2 * i] = m * c; pw[2 * i + 1] = m * s;
    }
    for (int i = F.tid; i < 2 * 64 * 16; i += NTHR) {
        const int r = i >> 10, p = (i >> 4) & 63, h = i & 15; const size_t q = ((size_t)(L * 2 + r) * 16 + g) * 64 + p;
        const float dt = __expf(a.in[I_S5LDT][(L * 2 + r) * 16 + g]); const float lre = a.in[I_S5LRE][q], lim = a.in[I_S5LIM][q];
        float s, c; sincosf(lim * dt, &s, &c); const float m = expf(lre * dt); const float ar = m * c - 1.f, ai = m * s;
        const float den = 1.f / (lre * lre + lim * lim); const float cr = (ar * lre + ai * lim) * den, ci = (ai * lre - ar * lim) * den;
        const float br = a.in[I_S5BRE][q * 16 + h], bi = a.in[I_S5BIM][q * 16 + h];
        bb[2 * i] = cr * br - ci * bi; bb[2 * i + 1] = cr * bi + ci * br;
    }
    for (int i = F.tid; i < 2 * 16 * 64; i += NTHR) {
        const int r = i >> 10, h = (i >> 6) & 15, p = i & 63; const size_t q = (((size_t)(L * 2 + r) * 16 + g) * 16 + h) * 64 + p;
        cm[2 * i] = a.in[I_S5CRE][q]; cm[2 * i + 1] = a.in[I_S5CIM][q];
    }
    __syncthreads();
    for (int i = F.tid; i < 2 * 16 * 256; i += NTHR) {
        const int r = i >> 12, tau = (i >> 8) & 15, h = (i >> 4) & 15, hp = i & 15; float s = 0.f;
        for (int p = 0; p < 64; ++p) { const float cr = cm[2 * ((r * 16 + h) * 64 + p)], ci = cm[2 * ((r * 16 + h) * 64 + p) + 1];
            const float ar = pw[2 * ((r * 64 + p) * 17 + tau)], ai = pw[2 * ((r * 64 + p) * 17 + tau) + 1]; const float br = bb[2 * ((r * 64 + p) * 16 + hp)], bi = bb[2 * ((r * 64 + p) * 16 + hp) + 1];
            const float tr = cr * ar - ci * ai, ti = cr * ai + ci * ar; s += tr * br - ti * bi; }
        kt[i] = s;
    }
    __syncthreads();
    bf16* pt = (bf16*)(F.ws + WS_S5P) + (size_t)(L * 16 + g) * 256 * 256;
    for (int i = F.tid; i < 65536; i += NTHR) {
        const int np = i >> 8, k = i & 255, r = np >> 7, cpx = (np >> 6) & 1, p = np & 63, s = k >> 4, hp = k & 15, e = r ? s : 15 - s;
        const float ar = pw[2 * ((r * 64 + p) * 17 + e)], ai = pw[2 * ((r * 64 + p) * 17 + e) + 1]; const float br = bb[2 * ((r * 64 + p) * 16 + hp)], bi = bb[2 * ((r * 64 + p) * 16 + hp) + 1];
        pt[i] = (bf16)f2bf(cpx ? ar * bi + ai * br : ar * br - ai * bi);
    }
    bf16* b2 = (bf16*)(F.ws + WS_S5B2) + (size_t)(L * 16 + g) * 256 * 512;
    const float* dsk = a.in[I_S5D] + L * 256 + g * 16;
    for (int i = F.tid; i < 131072; i += NTHR) {
        const int n = i >> 9, k = i & 511, j = n >> 4, h = n & 15; float v;
        if (k < 256) { const int s = k >> 4, hp = k & 15; v = 0.f;
            if (j >= s) v += kt[((0 * 16 + (j - s)) * 16 + h) * 16 + hp];
            if (j <= s) v += kt[((1 * 16 + (s - j)) * 16 + h) * 16 + hp];
            if (j == s && h == hp) v += dsk[h];
        } else { const int kk = k - 256, r = kk >> 7, cpx = (kk >> 6) & 1, p = kk & 63, e = r ? 16 - j : j + 1;
            const float cr = cm[2 * ((r * 16 + h) * 64 + p)], ci = cm[2 * ((r * 16 + h) * 64 + p) + 1]; const float ar = pw[2 * ((r * 64 + p) * 17 + e)], ai = pw[2 * ((r * 64 + p) * 17 + e) + 1];
            v = cpx ? -(cr * ai + ci * ar) : (cr * ar - ci * ai); }
        b2[i] = (bf16)f2bf(v);
    }
    float* a16 = (float*)(F.ws + WS_A16) + (size_t)((L * 2) * 16 + g) * 128;
    if (F.tid < 128) { const int r = F.tid >> 6, p = F.tid & 63; float* o = a16 + (size_t)r * 16 * 128 + p * 2; o[0] = pw[2 * ((r * 64 + p) * 17 + 16)]; o[1] = pw[2 * ((r * 64 + p) * 17 + 16) + 1]; }
    __syncthreads();
}
__device__ __forceinline__ void pro_transposes(Frame& F, CArgs& a, int wg_item) {
    LAS float* scr = (LAS float*)F.lds + F.wave * (64 * 65);
    const int wi = wg_item * 8 + F.wave;
    if (wi >= DEPTH * TW_LAYER) return;
    const int L = wi / TW_LAYER; int r = wi % TW_LAYER;
    if (r < TW_WIN) { const int kb = r / 33, nb = r % 33; transpose_tile(fresh_args()->in[I_WIN] + (size_t)L * DM * 2088, 2088, 2088, kb * 64, nb * 64, (bf16*)(F.ws + WS_WIN) + (size_t)L * PW * DM, DM, kb * 64, MapWin(), scr, F.lane); return; } r -= TW_WIN;
    if (r < TW_GU) { const int e = r >> 9, kb = (r >> 5) & 15, nb = r & 31; transpose_tile_f8(fresh_args()->in[I_WGU] + ((size_t)L * NEXP + e) * DM * 2048, 2048, kb * 64, nb * 64, (unsigned char*)(F.ws + WS_WGU) + ((size_t)L * NEXP + e) * 2048 * DM, DM, MapGu(), scr, F.lane); return; } r -= TW_GU;
    if (r < TW_DN) { const int e = r >> 8, kb = (r >> 4) & 15, nb = r & 15; transpose_tile_f8(fresh_args()->in[I_WDN] + ((size_t)L * NEXP + e) * DM * DM, DM, kb * 64, nb * 64, (unsigned char*)(F.ws + WS_WDN) + ((size_t)L * NEXP + e) * DM * DM, DM, MapId(), scr, F.lane); return; } r -= TW_DN;
    if (r < TW_WOUT) { const int kb = r >> 4, nb = r & 15; transpose_tile(fresh_args()->in[I_WOUT] + (size_t)L * DM * DM + (size_t)256 * DM, DM, DM, kb * 64, nb * 64, (bf16*)(F.ws + WS_WOUT) + (size_t)L * DM * MW, MW, 512 + kb * 64, MapId(), scr, F.lane); return; } r -= TW_WOUT;
    { const int kb = r >> 2, nb = r & 3; transpose_tile(fresh_args()->in[I_S5GLU] + (size_t)L * 256 * 256, 256, 256, kb * 64, nb * 64, (bf16*)(F.ws + WS_WGLU) + (size_t)L * 256 * 256, 256, kb * 64, MapId(), scr, F.lane); }
}
__device__ __forceinline__ void p_prologue(Frame& F0, CArgs& a, int qw = CW_QUEUE) {
    for (;;) {
        if (F0.tid == 0) F0.MISC[0] = __hip_atomic_fetch_add(F0.ctl + qw, 1u, RLX_AGENT);
        __syncthreads();
        const int it = (int)F0.MISC[0];
        __syncthreads();
        if (it >= PI_TOTAL) break;
        Frame F = F0; { const int t_ = fresh_tid(F.wave); F.tid = t_; F.lane = t_ & 63; }
        if (it < PI_B_TAB) pro_adaln(F, *fresh_args(), it);
        else if (it < PI_B_S5) pro_tables(F);
        else if (it < PI_B_FOLD) pro_s5(F, *fresh_args(), it - PI_B_S5);
        else if (it < PI_B_ZERO) pro_fold(F, *fresh_args(), it - PI_B_FOLD);
        else if (it < PI_B_TR) { const int L = it - PI_B_ZERO; u32x4* z = (u32x4*)((bf16*)(F.ws + WS_WIN) + (size_t)L * PW * DM + (size_t)2088 * DM); for (int i = F.tid; i < (PW - 2088) * DM / 8; i += NTHR) z[i] = (u32x4){0u, 0u, 0u, 0u}; }
        else pro_transposes(F, *fresh_args(), it - PI_B_TR);
    }
}

__device__ __forceinline__ void p_norm1(Frame& F, CArgs& a, int L, bool dry = false) {
    const int gw = F.bid * NWAVES + F.wave, NGW = F.G * NWAVES;
    float* XS = (float*)(F.ws + WS_XS); bf16* H = (bf16*)(F.ws + WS_H);
    const float* mod = (const float*)(F.ws + WS_MOD) + (size_t)L * 9 * 6144; const float* modp = mod - 9 * 6144;
    const int* PS = (const int*)(F.ws + WS_PS); const bf16* Y = (const bf16*)(F.ws + WS_Y);
    const float* g = a.in[I_NMG] + L * DM;
    f32x4 gv[4];
#pragma unroll
    for (int j = 0; j < 4; ++j) gv[j] = *(const f32x4*)(g + 4 * F.lane + 256 * j);
    for (int row = gw; row < NT; row += NGW) {
        const int bi = row < NLAT ? (row >> 12) : 8;
        f32x4 v[4];
        if (L == 0) { const float* src = row < NLAT ? a.in[I_X] + (size_t)row * DM : a.in[I_CTX] + (size_t)(row - NLAT) * DM;
#pragma unroll
            for (int j = 0; j < 4; ++j) v[j] = *(const f32x4*)(src + 4 * F.lane + 256 * j);
        } else {
            float* xr = XS + (size_t)row * DM;
#pragma unroll
            for (int j = 0; j < 4; ++j) v[j] = *(const f32x4*)(xr + 4 * F.lane + 256 * j);
            f32x4 s[4];
#pragma unroll
            for (int j = 0; j < 4; ++j) s[j] = (f32x4){0.f, 0.f, 0.f, 0.f};
#pragma unroll
            for (int k = 0; k < 4; ++k) { const int slot = PS[row * 4 + k]; const bf16* yr = Y + (size_t)slot * DM;
#pragma unroll
                for (int j = 0; j < 4; ++j) { const u32x2 w = *(const u32x2*)(yr + 4 * F.lane + 256 * j); s[j] += (f32x4){bflo(w.x), bfhi(w.x), bflo(w.y), bfhi(w.y)}; } }
            const float* m5 = modp + (size_t)bi * 6144 + 5 * 1024;
#pragma unroll
            for (int j = 0; j < 4; ++j) { v[j] += *(const f32x4*)(m5 + 4 * F.lane + 256 * j) * s[j]; if (!dry) *(f32x4*)(xr + 4 * F.lane + 256 * j) = v[j]; }
        }
        float ss = 0.f;
#pragma unroll
        for (int j = 0; j < 4; ++j) ss += v[j][0] * v[j][0] + v[j][1] * v[j][1] + v[j][2] * v[j][2] + v[j][3] * v[j][3];
        const float rs = rsqrtf(wave_sum(ss, F.lane) * (1.f / DM) + 1e-6f);
        const float* sh = mod + (size_t)bi * 6144, *sc = sh + 1024;
        bf16* hr = H + (size_t)row * DM;
#pragma unroll
        for (int j = 0; j < 4; ++j) { const f32x4 s4 = *(const f32x4*)(sc + 4 * F.lane + 256 * j), h4 = *(const f32x4*)(sh + 4 * F.lane + 256 * j);
            const f32x4 o = v[j] * rs * gv[j] * (s4 + 1.f) + h4; u32x2 w; w.x = pk2(o[0], o[1]); w.y = pk2(o[2], o[3]); if (!dry) *(u32x2*)(hr + 4 * F.lane + 256 * j) = w; else if (o[0] == 12345.678f) *(u32x2*)(hr + 4 * F.lane + 256 * j) = w; }
    }
}
__device__ __forceinline__ void p_norm2(Frame& F, CArgs& a, int L, int nrows, int cw = CW_CNT) {
    LAS float* rwt = (LAS float*)F.lds;
    LAS unsigned* lcnt = (LAS unsigned*)(F.lds + 32 * 1024 * 4);
    if (F.tid < 64) lcnt[F.tid] = 0u;
    const float* rw = a.in[I_RW] + (size_t)L * DM * NEXP;
    for (int i = F.tid; i < DM * NEXP; i += NTHR) { const int k = i >> 5, e = i & 31; rwt[e * 1024 + k] = rw[i]; }
    __syncthreads();
    const int gw = F.bid * NWAVES + F.wave, NGW = F.G * NWAVES;
    const float* XS = (const float*)(F.ws + WS_XS); unsigned char* H8 = (unsigned char*)(F.ws + WS_H8);
    const float* mod = (const float*)(F.ws + WS_MOD) + (size_t)L * 9 * 6144;
    int* PE = (int*)(F.ws + WS_PE); int* PR = (int*)(F.ws + WS_PR); float* PG = (float*)(F.ws + WS_PG);
    unsigned* cnt = F.ctl + cw + L * 64;
    const float* g = a.in[I_NFG] + L * DM;
    const float rb = a.in[I_RB][L * NEXP + (F.lane >> 1)];
    f32x4 gv[4];
#pragma unroll
    for (int j = 0; j < 4; ++j) gv[j] = *(const f32x4*)(g + 4 * F.lane + 256 * j);
    for (int row = gw; row < nrows; row += NGW) {
        const int bi = row < NLAT ? (row >> 12) : 8;
        const float* xr = XS + (size_t)row * DM;
        f32x4 v[4]; float ss = 0.f;
#pragma unroll
        for (int j = 0; j < 4; ++j) { v[j] = *(const f32x4*)(xr + 4 * F.lane + 256 * j); ss += v[j][0] * v[j][0] + v[j][1] * v[j][1] + v[j][2] * v[j][2] + v[j][3] * v[j][3]; }
        const float rs = rsqrtf(wave_sum(ss, F.lane) * (1.f / DM) + 1e-6f);
        const float* sh = mod + (size_t)bi * 6144 + 3 * 1024, *sc = sh + 1024;
        unsigned char* hr = H8 + (size_t)row * DM;
#pragma unroll
        for (int j = 0; j < 4; ++j) { const f32x4 s4 = *(const f32x4*)(sc + 4 * F.lane + 256 * j), h4 = *(const f32x4*)(sh + 4 * F.lane + 256 * j);
            v[j] = v[j] * rs * gv[j] * (s4 + 1.f) + h4; *(unsigned*)(hr + 4 * F.lane + 256 * j) = pk4f8(v[j][0] * H8_SCALE, v[j][1] * H8_SCALE, v[j][2] * H8_SCALE, v[j][3] * H8_SCALE); }
        float p[32];
#pragma unroll
        for (int e = 0; e < 32; ++e) { float s = 0.f;
#pragma unroll
            for (int j = 0; j < 4; ++j) { const f32x4 w4 = *(const LAS f32x4*)(rwt + e * 1024 + 4 * F.lane + 256 * j); s += v[j][0] * w4[0] + v[j][1] * w4[1] + v[j][2] * w4[2] + v[j][3] * w4[3]; }
            p[e] = s; if ((e & 3) == 3) asm volatile("" : "+v"(p[e]), "+v"(p[e - 1]), "+v"(p[e - 2]), "+v"(p[e - 3]) :: "memory"); }
#define RED_LEVEL(NKEEP, BIT, XCH) { const bool hi = (F.lane & (BIT)) != 0; _Pragma("unroll") for (int e = 0; e < (NKEEP); ++e) { const float send = hi ? p[e] : p[e + (NKEEP)], keep = hi ? p[e + (NKEEP)] : p[e]; p[e] = keep + XCH; } }
        RED_LEVEL(16, 32, xor32f(send, F.lane)) RED_LEVEL(8, 16, swz_xor<16>(send)) RED_LEVEL(4, 8, swz_xor<8>(send)) RED_LEVEL(2, 4, swz_xor<4>(send)) RED_LEVEL(1, 2, swz_xor<2>(send))
#undef RED_LEVEL
        float logit = p[0] + swz_xor<1>(p[0]) + rb;
        int es[4]; float ls[4];
#pragma unroll
        for (int k = 0; k < 4; ++k) {
            const float m = wave_max(logit, F.lane);
            const unsigned long long bal = __ballot(logit == m);
            const int fl = __builtin_ctzll(bal); es[k] = fl >> 1; ls[k] = m;
            if ((F.lane >> 1) == es[k]) logit = -3.0e38f;
        }
        const float e1 = __expf(ls[1] - ls[0]), e2 = __expf(ls[2] - ls[0]), e3 = __expf(ls[3] - ls[0]); const float inv = 1.f / (1.f + e1 + e2 + e3);
        if (F.lane < 4) {
            const int e = F.lane == 0 ? es[0] : (F.lane == 1 ? es[1] : (F.lane == 2 ? es[2] : es[3]));
            const float gt = (F.lane == 0 ? 1.f : (F.lane == 1 ? e1 : (F.lane == 2 ? e2 : e3))) * inv;
            const unsigned rk = __hip_atomic_fetch_add(lcnt + e, 1u, __ATOMIC_RELAXED, __HIP_MEMORY_SCOPE_WORKGROUP);
            PE[row * 4 + F.lane] = e; PR[row * 4 + F.lane] = (int)rk; PG[row * 4 + F.lane] = gt;
        }
    }
    __syncthreads();
    if (F.tid < 32) lcnt[32 + F.tid] = __hip_atomic_fetch_add(cnt + F.tid, lcnt[F.tid], RLX_AGENT);
    __syncthreads();
    for (int row = gw; row < nrows; row += NGW) { if (F.lane < 4) { const int i = row * 4 + F.lane; PR[i] += (int)lcnt[32 + PE[i]]; } }
    __syncthreads();
}
__device__ __forceinline__ void p_dispatch(Frame& F, int L, int nrows) {
    LAS int* base = (LAS int*)F.lds;
    unsigned* cnt = F.ctl + CW_CNT + L * 64; unsigned* blke = F.ctl + CW_BLKE + L * 1024;
    if (F.tid == 0) { int acc = 0; for (int e = 0; e < NEXP; ++e) { base[e] = acc; const int c = (int)__hip_atomic_load(cnt + e, RLX_AGENT); acc += (c + 255) & ~255; } base[32] = acc; }
    __syncthreads();
    if (F.bid == 0) { const int nblk = base[32] >> 8; if (F.tid == 0) blke[0] = (unsigned)nblk;
        for (int i = F.tid; i < nblk; i += NTHR) { int e = 0; for (int q = 1; q < NEXP; ++q) if (base[q] <= i * 256) e = q; blke[1 + i] = (unsigned)e; } }
    const int gw = F.bid * NWAVES + F.wave, NGW = F.G * NWAVES;
    const int* PE = (const int*)(F.ws + WS_PE); const int* PR = (const int*)(F.ws + WS_PR); const float* PG = (const float*)(F.ws + WS_PG);
    int* PS = (int*)(F.ws + WS_PS); float* SG = (float*)(F.ws + WS_SG);
    const unsigned char* H8 = (const unsigned char*)(F.ws + WS_H8); unsigned char* BUF = (unsigned char*)(F.ws + WS_BUF);
    for (int pr = gw; pr < nrows * 4; pr += NGW) {
        const int e = PE[pr], slot = base[e] + PR[pr];
        const u32x4* src = (const u32x4*)(H8 + (size_t)(pr >> 2) * DM); u32x4* dst = (u32x4*)(BUF + (size_t)slot * DM);
        dst[F.lane] = src[F.lane];
        if (F.lane == 0) { PS[pr] = slot; SG[slot] = PG[pr]; }
    }
    __syncthreads();
}
__device__ __forceinline__ void p_final(Frame& F, CArgs& a) {
    const int gw = F.bid * NWAVES + F.wave, NGW = F.G * NWAVES;
    const float* XS = (const float*)(F.ws + WS_XS);
    const float* modp = (const float*)(F.ws + WS_MOD) + (size_t)(DEPTH - 1) * 9 * 6144;
    const int* PS = (const int*)(F.ws + WS_PS); const bf16* Y = (const bf16*)(F.ws + WS_Y);
    const float* g = a.in[I_FING];
    f32x4 gv[4];
#pragma unroll
    for (int j = 0; j < 4; ++j) gv[j] = *(const f32x4*)(g + 4 * F.lane + 256 * j);
    for (int row = gw; row < NLAT; row += NGW) {
        const int bi = row >> 12;
        const float* xr = XS + (size_t)row * DM;
        f32x4 v[4], s[4];
#pragma unroll
        for (int j = 0; j < 4; ++j) { v[j] = *(const f32x4*)(xr + 4 * F.lane + 256 * j); s[j] = (f32x4){0.f, 0.f, 0.f, 0.f}; }
#pragma unroll
        for (int k = 0; k < 4; ++k) { const int slot = PS[row * 4 + k]; const bf16* yr = Y + (size_t)slot * DM;
#pragma unroll
            for (int j = 0; j < 4; ++j) { const u32x2 w = *(const u32x2*)(yr + 4 * F.lane + 256 * j); s[j] += (f32x4){bflo(w.x), bfhi(w.x), bflo(w.y), bfhi(w.y)}; } }
        const float* m5 = modp + (size_t)bi * 6144 + 5 * 1024;
        float ss = 0.f;
#pragma unroll
        for (int j = 0; j < 4; ++j) { v[j] += *(const f32x4*)(m5 + 4 * F.lane + 256 * j) * s[j]; ss += v[j][0] * v[j][0] + v[j][1] * v[j][1] + v[j][2] * v[j][2] + v[j][3] * v[j][3]; }
        const float rs = rsqrtf(wave_sum(ss, F.lane) * (1.f / DM) + 1e-6f);
        float* orow = a.out + (size_t)row * DM;
#pragma unroll
        for (int j = 0; j < 4; ++j) *(f32x4*)(orow + 4 * F.lane + 256 * j) = v[j] * rs * gv[j];
    }
}

#define MFMA16(a, b, c) __builtin_amdgcn_mfma_f32_16x16x32_bf16((a), (b), (c), 0, 0, 0)
typedef short v4i16_t __attribute__((ext_vector_type(4)));
__device__ __forceinline__ s16x4 trread(const LAS void* p) { return __builtin_bit_cast(s16x4, __builtin_amdgcn_ds_read_tr16_b64_v4i16((LAS v4i16_t*)p)); }
__device__ __forceinline__ bf16x8 cat8(s16x4 a, s16x4 b) { return __builtin_shufflevector(a, b, 0, 1, 2, 3, 4, 5, 6, 7); }
__device__ __forceinline__ bf16x8 pack8(const float* v) { u32x4 w; w.x = pg8::cvt_pk_bf16(v[0], v[1]); w.y = pg8::cvt_pk_bf16(v[2], v[3]); w.z = pg8::cvt_pk_bf16(v[4], v[5]); w.w = pg8::cvt_pk_bf16(v[6], v[7]); return __builtin_bit_cast(bf16x8, w); }
__device__ __forceinline__ void unpack8(bf16x8 x, float* v) { const u32x4 w = __builtin_bit_cast(u32x4, x); v[0] = bflo(w.x); v[1] = bfhi(w.x); v[2] = bflo(w.y); v[3] = bfhi(w.y); v[4] = bflo(w.z); v[5] = bfhi(w.z); v[6] = bflo(w.w); v[7] = bfhi(w.w); }
#define OPQ(x) ({ int o_ = (x); asm volatile("" : "+s"(o_)); o_; })
#define LAUNDER_F(F0) Frame F = F0; { const int t_ = fresh_tid(F.wave); F.tid = t_; F.lane = t_ & 63; }
__device__ __forceinline__ int chunk_tok0(int cid) { return cid < 512 ? cid * 64 : NLAT + (cid - 512) * 64; }

constexpr int GL_QS = 136, GL_VS = 264, GL_BS = 260;
constexpr int GL_Q = 0, GL_K = GL_Q + 64 * GL_QS * 2, GL_V = GL_K + 64 * GL_QS * 2, GL_A1 = GL_V + 64 * GL_VS * 2, GL_B = GL_A1 + 64 * 32 * 2, GL_END = GL_B + 64 * GL_BS * 4;
static_assert(GL_END <= MISC_OFF, "GLA LDS");
template <bool OUT> __device__ __forceinline__ void gla_chunk(Frame& F0, CArgs& a, int L, int cid) {
    LAUNDER_F(F0)
    const int tok0 = chunk_tok0(cid);
    const bf16* P = (const bf16*)(F.ws + WS_PBUF) + (size_t)tok0 * PW;
    LAS bf16* sq = (LAS bf16*)(F.lds + GL_Q); LAS bf16* sk = (LAS bf16*)(F.lds + GL_K); LAS bf16* sv = (LAS bf16*)(F.lds + GL_V); LAS bf16* sa1 = (LAS bf16*)(F.lds + GL_A1); LAS float* sB = (LAS float*)(F.lds + GL_B);
    __syncthreads();
    {   u32x4 rq[2], rk[2], rv[4], ra = (u32x4){0u, 0u, 0u, 0u};
#pragma unroll
        for (int k = 0; k < 2; ++k) { const int i = F.tid + k * NTHR, t = i >> 4, pc = i & 15; rq[k] = *(const u32x4*)(P + (size_t)t * PW + PC_Q + pc * 8); rk[k] = *(const u32x4*)(P + (size_t)t * PW + PC_K + pc * 8); }
#pragma unroll
        for (int k = 0; k < 4; ++k) { const int i = F.tid + k * NTHR, t = i >> 5, pc = i & 31; rv[k] = *(const u32x4*)(P + (size_t)t * PW + PC_V + pc * 8); }
        if (F.tid < 256) { const int t = F.tid >> 2, pc = F.tid & 3; ra = *(const u32x4*)(P + (size_t)t * PW + PC_A1 + pc * 8); }
#pragma unroll
        for (int k = 0; k < 2; ++k) { const int i = F.tid + k * NTHR, t = i >> 4, pc = i & 15; *(LAS u32x4*)(sq + t * GL_QS + pc * 8) = rq[k]; *(LAS u32x4*)(sk + t * GL_QS + pc * 8) = rk[k]; }
#pragma unroll
        for (int k = 0; k < 4; ++k) { const int i = F.tid + k * NTHR, t = i >> 5, pc = i & 31; *(LAS u32x4*)(sv + t * GL_VS + pc * 8) = rv[k]; }
        if (F.tid < 256) { const int t = F.tid >> 2, pc = F.tid & 3; *(LAS u32x4*)(sa1 + t * 32 + pc * 8) = ra; }
    }
    __syncthreads();
    {
        const int col = F.tid & 255, r = col >> 7, c = col & 127, th = F.tid >> 8;
        float a2v[16];
#pragma unroll
        for (int i = 0; i < 16; ++i) a2v[i] = a.in[I_GLAA2][((size_t)(L * 2 + r) * 16 + i) * 128 + c];
        const float ab = a.in[I_GLAAB][(L * 2 + r) * 128 + c];
        for (int i = 0; i < 32; ++i) { const int t = th * 32 + i; float z = ab; float av[8];
            unpack8(*(const LAS bf16x8*)(sa1 + t * 32 + r * 16), av);
#pragma unroll
            for (int q = 0; q < 8; ++q) z += av[q] * a2v[q];
            unpack8(*(const LAS bf16x8*)(sa1 + t * 32 + r * 16 + 8), av);
#pragma unroll
            for (int q = 0; q < 8; ++q) z += av[q] * a2v[8 + q];
            const float ls = fminf(z, 0.f) - __logf(1.f + __expf(-fabsf(z)));
            sB[t * GL_BS + col] = ls * (1.f / 16.f); }
    }
    __syncthreads();
    if (F.tid < 256) { const int col = F.tid, r = col >> 7; float b = 0.f;
        for (int i = 0; i < 64; ++i) { const int t = r ? 63 - i : i; b += sB[t * GL_BS + col]; sB[t * GL_BS + col] = b; } }
    __syncthreads();
    const int hh = F.wave & 3, r = F.wave >> 2, lr = F.lane & 15, g = F.lane >> 4;
    const int bc = r * 128 + hh * 32;
    const size_t ub = ((size_t)cid * 4 + hh) * 2 + r;
    if constexpr (!OUT) {
        const int tl = r ? 0 : 63;
        f32x4 acc[2][4];
#pragma unroll
        for (int mc = 0; mc < 2; ++mc)
#pragma unroll
            for (int d = 0; d < 4; ++d) acc[mc][d] = (f32x4){0.f, 0.f, 0.f, 0.f};
#pragma unroll
        for (int sg = 0; sg < 2; ++sg) {
            bf16x8 vf[4];
#pragma unroll
            for (int d = 0; d < 4; ++d) { const LAS bf16* p0 = sv + (32 * sg + 8 * g + ((F.lane & 15) >> 2)) * GL_VS + hh * 64 + 16 * d + 4 * (F.lane & 3); vf[d] = cat8(trread(p0), trread(p0 + 4 * GL_VS)); }
#pragma unroll
            for (int mc = 0; mc < 2; ++mc) {
                const LAS bf16* p0 = sk + (32 * sg + 8 * g + ((F.lane & 15) >> 2)) * GL_QS + hh * 32 + 16 * mc + 4 * (F.lane & 3);
                const s16x4 k0 = trread(p0), k1 = trread(p0 + 4 * GL_QS);
                const int c = 16 * mc + lr; const float bl = sB[tl * GL_BS + bc + c];
                float kv[8];
#pragma unroll
                for (int e = 0; e < 4; ++e) { kv[e] = bf2f((unsigned short)k0[e]) * __expf(bl - sB[(32 * sg + 8 * g + e) * GL_BS + bc + c]); kv[4 + e] = bf2f((unsigned short)k1[e]) * __expf(bl - sB[(32 * sg + 8 * g + 4 + e) * GL_BS + bc + c]); }
                const bf16x8 kf = pack8(kv);
#pragma unroll
                for (int d = 0; d < 4; ++d) acc[mc][d] = MFMA16(kf, vf[d], acc[mc][d]);
            }
        }
        float* ds = (float*)(F.ws + WS_GDS) + ub * 2048;
#pragma unroll
        for (int mc = 0; mc < 2; ++mc)
#pragma unroll
            for (int d = 0; d < 4; ++d) *(f32x4*)(ds + (16 * d + lr) * 32 + 16 * mc + 4 * g) = acc[mc][d];
        if (F.lane < 32) ((float*)(F.ws + WS_GDEC))[ub * 32 + F.lane] = __expf(sB[tl * GL_BS + bc + F.lane]);
    } else {
        bf16x8 qf[4], kf[4];
#pragma unroll
        for (int m = 0; m < 4; ++m) { const int t = 16 * m + lr; float qv[8], kv[8], bv[8];
            unpack8(*(const LAS bf16x8*)(sq + t * GL_QS + hh * 32 + 8 * g), qv); unpack8(*(const LAS bf16x8*)(sk + t * GL_QS + hh * 32 + 8 * g), kv);
            *(f32x4*)bv = *(const LAS f32x4*)(sB + t * GL_BS + bc + 8 * g); *(f32x4*)(bv + 4) = *(const LAS f32x4*)(sB + t * GL_BS + bc + 8 * g + 4);
#pragma unroll
            for (int e = 0; e < 8; ++e) { const float ex = __expf(bv[e]); qv[e] *= 0.17677669529663687f * ex; kv[e] *= __frcp_rn(ex); }
            qf[m] = pack8(qv); kf[m] = pack8(kv); }
        f32x4 o[4][4];
#pragma unroll
        for (int m = 0; m < 4; ++m)
#pragma unroll
            for (int d = 0; d < 4; ++d) o[m][d] = (f32x4){0.f, 0.f, 0.f, 0.f};
        {
            const bf16* se = (const bf16*)(F.ws + WS_GSE) + ub * 2048;
#pragma unroll
            for (int d = 0; d < 4; ++d) { const bf16x8 sf = *(const bf16x8*)(se + (16 * d + lr) * 32 + 8 * g);
#pragma unroll
                for (int m = 0; m < 4; ++m) o[m][d] = MFMA16(qf[m], sf, o[m][d]); }
        }
        bf16x8 vf[2][4];
#pragma unroll
        for (int sg = 0; sg < 2; ++sg)
#pragma unroll
            for (int d = 0; d < 4; ++d) { const LAS bf16* p0 = sv + (32 * sg + 4 * g + ((F.lane & 15) >> 2)) * GL_VS + hh * 64 + 16 * d + 4 * (F.lane & 3); vf[sg][d] = cat8(trread(p0), trread(p0 + 16 * GL_VS)); }
        const f32x4 zero4 = (f32x4){0.f, 0.f, 0.f, 0.f};
#pragma unroll
        for (int m = 0; m < 4; ++m) {
            const int t = 16 * m + lr;
#pragma unroll
            for (int sg = 0; sg < 2; ++sg) {
                f32x4 p0 = MFMA16(kf[2 * sg], qf[m], zero4), p1 = MFMA16(kf[2 * sg + 1], qf[m], zero4);
                float pv[8];
#pragma unroll
                for (int j = 0; j < 4; ++j) { const int s0 = 32 * sg + 4 * g + j, s1 = s0 + 16; pv[j] = (r ? s0 >= t : s0 <= t) ? p0[j] : 0.f; pv[4 + j] = (r ? s1 >= t : s1 <= t) ? p1[j] : 0.f; }
                const bf16x8 pf = pack8(pv);
#pragma unroll
                for (int d = 0; d < 4; ++d) o[m][d] = MFMA16(pf, vf[sg][d], o[m][d]);
            }
        }
        __syncthreads();
        LAS float* ox = (LAS float*)(F.lds + GL_B);
        LAS bf16* ot = (LAS bf16*)(F.lds + GL_Q);
        LAS bf16* srg = (LAS bf16*)(F.lds + GL_V);
        for (int i = F.tid; i < 2048; i += NTHR) { const int t = i >> 5, pc = i & 31; *(LAS u32x4*)(srg + t * GL_VS + pc * 8) = *(const u32x4*)(P + (size_t)t * PW + PC_R + pc * 8); }
        if (r == 1) {
#pragma unroll
            for (int m = 0; m < 4; ++m)
#pragma unroll
                for (int d = 0; d < 4; ++d)
#pragma unroll
                    for (int j = 0; j < 4; ++j) ox[(hh * 64 + 16 * m + 4 * g + j) * 65 + 16 * d + lr] = o[m][d][j];
        }
        __syncthreads();
        if (r == 0) {
            const float* ng = a.in[I_GLANG] + L * 64;
            float gn[4];
#pragma unroll
            for (int d = 0; d < 4; ++d) gn[d] = ng[16 * d + lr];
#pragma unroll
            for (int m = 0; m < 4; ++m)
#pragma unroll
                for (int j = 0; j < 4; ++j) {
                    const int t = 16 * m + 4 * g + j; float v[4], ss = 0.f;
#pragma unroll
                    for (int d = 0; d < 4; ++d) { v[d] = o[m][d][j] + ox[(hh * 64 + t) * 65 + 16 * d + lr]; ss += v[d] * v[d]; }
                    ss += swz_xor<1>(ss); ss += swz_xor<2>(ss); ss += swz_xor<4>(ss); ss += swz_xor<8>(ss);
                    const float rs = rsqrtf(ss * (1.f / 64.f) + 1e-6f);
#pragma unroll
                    for (int d = 0; d < 4; ++d) { const float rg = bf2f(srg[t * GL_VS + hh * 64 + 16 * d + lr]); ot[t * 264 + hh * 64 + 16 * d + lr] = (bf16)f2bf(v[d] * rs * gn[d] * siluf_(rg)); }
                }
        }
        __syncthreads();
        bf16* MX = (bf16*)(F.ws + WS_MIX) + (size_t)tok0 * MW + 768;
        for (int i = F.tid; i < 2048; i += NTHR) { const int t = i >> 5, pc = i & 31; *(u32x4*)(MX + (size_t)t * MW + pc * 8) = *(const LAS u32x4*)(ot + t * 264 + pc * 8); }
    }
}

constexpr int SD_RS = 520;
constexpr int SD_RAW = 0, SD_XC = SD_RAW + 68 * SD_RS * 2, SD_DT = SD_XC + 64 * SD_RS * 2, SD_CUM = SD_DT + 64 * 8 * 4, SD_W = SD_CUM + 8 * 64 * 4, SD_END = SD_W + 8 * 64 * 4;
static_assert(SD_END <= MISC_OFF && 64 * 260 * 4 <= 68 * SD_RS * 2, "SSD LDS");
template <bool OUT> __device__ __forceinline__ void ssd_chunk(Frame& F0, CArgs& a, int L, int cid) {
    LAUNDER_F(F0)
    const int tok0 = chunk_tok0(cid);
    const bf16* PB = (const bf16*)(F.ws + WS_PBUF);
    LAS bf16* raw = (LAS bf16*)(F.lds + SD_RAW); LAS bf16* xc = (LAS bf16*)(F.lds + SD_XC); LAS float* sdt = (LAS float*)(F.lds + SD_DT); LAS float* scum = (LAS float*)(F.lds + SD_CUM); LAS float* sw = (LAS float*)(F.lds + SD_W);
    __syncthreads();
    {
        const int isctx = cid >= 512, c4 = (cid - 512) & 3;
        u32x4 rv[9];
#pragma unroll
        for (int k = 0; k < 9; ++k) { const int i = F.tid + k * NTHR, rr = i >> 6, pc = i & 63, t = rr - 2; rv[k] = (u32x4){0u, 0u, 0u, 0u};
            bool ok = t >= 0 && t < 64 && i < 68 * 64; if (isctx) { const int tt = c4 * 64 + t; ok = tt >= 0 && tt < 256 && i < 68 * 64; }
            if (ok) rv[k] = *(const u32x4*)(PB + (size_t)(tok0 + t) * PW + PC_XBC + pc * 8); }
#pragma unroll
        for (int k = 0; k < 9; ++k) { const int i = F.tid + k * NTHR, rr = i >> 6, pc = i & 63; if (i < 68 * 64) *(LAS u32x4*)(raw + rr * SD_RS + pc * 8) = rv[k]; }
        if (F.tid < 64) { float dv[8]; unpack8(*(const bf16x8*)(PB + (size_t)(tok0 + F.tid) * PW + PC_DT), dv);
#pragma unroll
            for (int q = 0; q < 8; ++q) { const float z = dv[q] + a.in[I_SSDDTB][L * 8 + q]; sdt[F.tid * 8 + q] = z > 20.f ? z : __logf(1.f + __expf(z)); } }
    }
    __syncthreads();
    {
        const int ch = F.tid; float w[5];
#pragma unroll
        for (int k = 0; k < 5; ++k) w[k] = a.in[I_SSDCW][((size_t)L * 5 + k) * 512 + ch];
        const float cb = a.in[I_SSDCB][L * 512 + ch];
        float x0 = bf2f(raw[0 * SD_RS + ch]), x1 = bf2f(raw[1 * SD_RS + ch]), x2 = bf2f(raw[2 * SD_RS + ch]), x3 = bf2f(raw[3 * SD_RS + ch]);
        for (int t = 0; t < 64; ++t) { const float x4 = bf2f(raw[(t + 4) * SD_RS + ch]); const float y = cb + w[0] * x0 + w[1] * x1 + w[2] * x2 + w[3] * x3 + w[4] * x4;
            xc[t * SD_RS + ch] = (bf16)f2bf(siluf_(y)); x0 = x1; x1 = x2; x2 = x3; x3 = x4; }
    }
    {
        const int q = F.wave, rr = q >> 2, t = rr ? 63 - F.lane : F.lane;
        const float aa = -__expf(a.in[I_SSDALOG][L * 8 + q]); const float dtv = sdt[t * 8 + q];
        float c = dtv * aa;
        { float o;
          o = __builtin_bit_cast(float, __builtin_amdgcn_ds_bpermute((F.lane - 1) << 2, __builtin_bit_cast(int, c))); if (F.lane >= 1) c += o;
          o = __builtin_bit_cast(float, __builtin_amdgcn_ds_bpermute((F.lane - 2) << 2, __builtin_bit_cast(int, c))); if (F.lane >= 2) c += o;
          o = __builtin_bit_cast(float, __builtin_amdgcn_ds_bpermute((F.lane - 4) << 2, __builtin_bit_cast(int, c))); if (F.lane >= 4) c += o;
          o = __builtin_bit_cast(float, __builtin_amdgcn_ds_bpermute((F.lane - 8) << 2, __builtin_bit_cast(int, c))); if (F.lane >= 8) c += o;
          o = __builtin_bit_cast(float, __builtin_amdgcn_ds_bpermute((F.lane - 16) << 2, __builtin_bit_cast(int, c))); if (F.lane >= 16) c += o;
          o = __builtin_bit_cast(float, __builtin_amdgcn_ds_bpermute((F.lane - 32) << 2, __builtin_bit_cast(int, c))); if (F.lane >= 32) c += o; }
        const float cl = __builtin_bit_cast(float, __builtin_amdgcn_ds_bpermute(63 << 2, __builtin_bit_cast(int, c)));
        scum[q * 64 + t] = c; sw[q * 64 + t] = __expf(cl - c) * dtv;
    }
    __syncthreads();
    const int h = F.wave & 3, r = F.wave >> 2, lr = F.lane & 15, g = F.lane >> 4, gp = h >> 1, rh = r * 4 + h;
    const size_t ub = ((size_t)cid * 4 + h) * 2 + r;
    if constexpr (!OUT) {
        f32x4 acc[4][4];
#pragma unroll
        for (int ms = 0; ms < 4; ++ms)
#pragma unroll
            for (int d = 0; d < 4; ++d) acc[ms][d] = (f32x4){0.f, 0.f, 0.f, 0.f};
#pragma unroll
        for (int sg = 0; sg < 2; ++sg) {
            const int trow = 32 * sg + 8 * g;
            bf16x8 xf[4];
#pragma unroll
            for (int d = 0; d < 4; ++d) { const LAS bf16* p0 = xc + (trow + ((F.lane & 15) >> 2)) * SD_RS + h * 64 + 16 * d + 4 * (F.lane & 3); xf[d] = cat8(trread(p0), trread(p0 + 4 * SD_RS)); }
            float wv[8];
            *(f32x4*)wv = *(const LAS f32x4*)(sw + rh * 64 + trow); *(f32x4*)(wv + 4) = *(const LAS f32x4*)(sw + rh * 64 + trow + 4);
#pragma unroll
            for (int ms = 0; ms < 4; ++ms) {
                const LAS bf16* p0 = xc + (trow + ((F.lane & 15) >> 2)) * SD_RS + 256 + gp * 64 + 16 * ms + 4 * (F.lane & 3);
                const s16x4 b0 = trread(p0), b1 = trread(p0 + 4 * SD_RS);
                float bv[8];
#pragma unroll
                for (int e = 0; e < 4; ++e) { bv[e] = bf2f((unsigned short)b0[e]) * wv[e]; bv[4 + e] = bf2f((unsigned short)b1[e]) * wv[4 + e]; }
                const bf16x8 bf = pack8(bv);
#pragma unroll
                for (int d = 0; d < 4; ++d) acc[ms][d] = MFMA16(bf, xf[d], acc[ms][d]);
            }
        }
        float* ds = (float*)(F.ws + WS_SDS) + ub * 4096;
#pragma unroll
        for (int ms = 0; ms < 4; ++ms)
#pragma unroll
            for (int d = 0; d < 4; ++d) *(f32x4*)(ds + (16 * d + lr) * 64 + 16 * ms + 4 * g) = acc[ms][d];
        if (F.lane == 0) ((float*)(F.ws + WS_SDEC))[ub] = __expf(scum[rh * 64 + (r ? 0 : 63)]);
    } else {
        bf16x8 bfr[4][2], cfr[4][2];
#pragma unroll
        for (int m = 0; m < 4; ++m)
#pragma unroll
            for (int ks = 0; ks < 2; ++ks) { bfr[m][ks] = *(const LAS bf16x8*)(xc + (16 * m + lr) * SD_RS + 256 + gp * 64 + 32 * ks + 8 * g); cfr[m][ks] = *(const LAS bf16x8*)(xc + (16 * m + lr) * SD_RS + 384 + gp * 64 + 32 * ks + 8 * g); }
        f32x4 y[4][4];
#pragma unroll
        for (int m = 0; m < 4; ++m)
#pragma unroll
            for (int d = 0; d < 4; ++d) y[m][d] = (f32x4){0.f, 0.f, 0.f, 0.f};
        {
            const bf16* se = (const bf16*)(F.ws + WS_SSE) + ub * 4096;
            bf16x8 cs[4][2];
#pragma unroll
            for (int m = 0; m < 4; ++m) { const float ec = __expf(scum[rh * 64 + 16 * m + lr]);
#pragma unroll
                for (int ks = 0; ks < 2; ++ks) { float cv[8]; unpack8(cfr[m][ks], cv);
#pragma unroll
                    for (int e = 0; e < 8; ++e) cv[e] *= ec;
                    cs[m][ks] = pack8(cv); } }
#pragma unroll
            for (int d = 0; d < 4; ++d) {
                const bf16x8 sf0 = *(const bf16x8*)(se + (16 * d + lr) * 64 + 8 * g), sf1 = *(const bf16x8*)(se + (16 * d + lr) * 64 + 32 + 8 * g);
#pragma unroll
                for (int m = 0; m < 4; ++m) { y[m][d] = MFMA16(cs[m][0], sf0, y[m][d]); y[m][d] = MFMA16(cs[m][1], sf1, y[m][d]); }
            }
        }
        asm volatile("" ::: "memory");
        bf16x8 xf[2][4];
#pragma unroll
        for (int sg = 0; sg < 2; ++sg)
#pragma unroll
            for (int d = 0; d < 4; ++d) { const LAS bf16* p0 = xc + (32 * sg + 4 * g + ((F.lane & 15) >> 2)) * SD_RS + h * 64 + 16 * d + 4 * (F.lane & 3); xf[sg][d] = cat8(trread(p0), trread(p0 + 16 * SD_RS)); }
        const f32x4 zero4 = (f32x4){0.f, 0.f, 0.f, 0.f};
#pragma unroll
        for (int m = 0; m < 4; ++m) {
            const int t = 16 * m + lr; const float ct = scum[rh * 64 + t];
#pragma unroll
            for (int sg = 0; sg < 2; ++sg) {
                f32x4 p0 = MFMA16(bfr[2 * sg][0], cfr[m][0], zero4), p1 = MFMA16(bfr[2 * sg + 1][0], cfr[m][0], zero4);
                p0 = MFMA16(bfr[2 * sg][1], cfr[m][1], p0); p1 = MFMA16(bfr[2 * sg + 1][1], cfr[m][1], p1);
                float pv[8];
#pragma unroll
                for (int j = 0; j < 4; ++j) { const int s0 = 32 * sg + 4 * g + j, s1 = s0 + 16;
                    pv[j] = (r ? s0 >= t : s0 <= t) ? p0[j] * __expf(ct - scum[rh * 64 + s0]) * sdt[s0 * 8 + rh] : 0.f;
                    pv[4 + j] = (r ? s1 >= t : s1 <= t) ? p1[j] * __expf(ct - scum[rh * 64 + s1]) * sdt[s1 * 8 + rh] : 0.f; }
                const bf16x8 pf = pack8(pv);
#pragma unroll
                for (int d = 0; d < 4; ++d) y[m][d] = MFMA16(pf, xf[sg][d], y[m][d]);
            }
        }
        __syncthreads();
        LAS float* yx = (LAS float*)(F.lds + SD_RAW);
        if (r == 1) {
#pragma unroll
            for (int m = 0; m < 4; ++m)
#pragma unroll
                for (int d = 0; d < 4; ++d)
#pragma unroll
                    for (int j = 0; j < 4; ++j) yx[(16 * m + 4 * g + j) * 260 + h * 64 + 16 * d + lr] = y[m][d][j];
        }
        __syncthreads();
        if (r == 0) { const float dsk = a.in[I_SSDD][L * 4 + h];
#pragma unroll
            for (int m = 0; m < 4; ++m)
#pragma unroll
                for (int d = 0; d < 4; ++d)
#pragma unroll
                    for (int j = 0; j < 4; ++j) { const int t = 16 * m + 4 * g + j, c = h * 64 + 16 * d + lr; yx[t * 260 + c] += y[m][d][j] + dsk * bf2f(xc[t * SD_RS + c]); asm volatile("" ::: "memory"); }
        }
        __syncthreads();
        { const int t = F.tid >> 3, c0 = (F.tid & 7) * 32; const bf16* zr = PB + (size_t)(tok0 + t) * PW + PC_Z + c0; const float* ng = a.in[I_SSDNG] + L * 256 + c0;
          float v[32]; float ss = 0.f;
#pragma unroll
          for (int q = 0; q < 4; ++q) { float zv[8]; unpack8(*(const bf16x8*)(zr + 8 * q), zv);
#pragma unroll
              for (int e = 0; e < 8; ++e) { const float u = yx[t * 260 + c0 + 8 * q + e] * siluf_(zv[e]); v[8 * q + e] = u; ss += u * u; } }
          ss += swz_xor<1>(ss); ss += swz_xor<2>(ss); ss += swz_xor<4>(ss);
          const float rs = rsqrtf(ss * (1.f / 256.f) + 1e-6f);
          bf16* MX = (bf16*)(F.ws + WS_MIX) + (size_t)(tok0 + t) * MW + 1024 + c0;
#pragma unroll
          for (int q = 0; q < 4; ++q) { float o8[8];
#pragma unroll
              for (int e = 0; e < 8; ++e) o8[e] = v[8 * q + e] * rs * ng[8 * q + e];
              *(bf16x8*)(MX + 8 * q) = pack8(o8); } }
    }
}

constexpr int FF_XP = 0, FF_TR = FF_XP + 16 * 64 * 16 * 2, FF_TI = FF_TR + 16 * 64 * 16 * 2, FF_END = FF_TI + 16 * 64 * 16 * 2;
__device__ __forceinline__ void fft_unit(Frame& F0, int u) {
    LAUNDER_F(F0)
    const int b = u >> 6, cg = (u >> 2) & 15, kb = u & 3, lr = F.lane & 15, g = F.lane >> 4;
    const bf16* PB = (const bf16*)(F.ws + WS_PBUF) + (size_t)b * SEQ * PW + PC_FU + 16 * cg;
    const bf16* f64 = (const bf16*)(F.ws + WS_TAB + TAB_F64); const float* tw = (const float*)(F.ws + WS_TAB + TAB_TW);
    LAS bf16* xp = (LAS bf16*)(F.lds + FF_XP); LAS bf16* tr = (LAS bf16*)(F.lds + FF_TR); LAS bf16* ti = (LAS bf16*)(F.lds + FF_TI);
    bf16x8 fc1[2], fs1[2];
#pragma unroll
    for (int ks = 0; ks < 2; ++ks) { fc1[ks] = *(const bf16x8*)(f64 + (16 * kb + lr) * 64 + 32 * ks + 8 * g); fs1[ks] = *(const bf16x8*)(f64 + 4096 + (16 * kb + lr) * 64 + 32 * ks + 8 * g); }
    const f32x4 zero4 = (f32x4){0.f, 0.f, 0.f, 0.f};
    u32x4 xr[4];
#pragma unroll
    for (int k = 0; k < 4; ++k) { const int i = F.tid + k * NTHR, n2l = i >> 7, n1 = (i >> 1) & 63, hf = i & 1; xr[k] = *(const u32x4*)(PB + (size_t)(64 * n1 + n2l) * PW + hf * 8); }
    for (int pa = 0; pa < 4; ++pa) {
        __syncthreads();
#pragma unroll
        for (int k = 0; k < 4; ++k) { const int i = F.tid + k * NTHR, n2l = i >> 7, n1 = (i >> 1) & 63, hf = i & 1; *(LAS u32x4*)(xp + (n2l * 64 + n1) * 16 + hf * 8) = xr[k]; }
        if (pa < 3) {
#pragma unroll
            for (int k = 0; k < 4; ++k) { const int i = F.tid + k * NTHR, n2l = i >> 7, n1 = (i >> 1) & 63, hf = i & 1; xr[k] = *(const u32x4*)(PB + (size_t)(64 * n1 + 16 * (pa + 1) + n2l) * PW + hf * 8); }
        }
        __syncthreads();
#pragma unroll
        for (int q = 0; q < 2; ++q) {
            const int n2l = 2 * F.wave + q, n2 = 16 * pa + n2l;
            f32x4 tc = zero4, ts = zero4;
#pragma unroll
            for (int ks = 0; ks < 2; ++ks) { const LAS bf16* p0 = xp + (n2l * 64 + 32 * ks + 8 * g + ((F.lane & 15) >> 2)) * 16 + 4 * (F.lane & 3); const bf16x8 xb = cat8(trread(p0), trread(p0 + 4 * 16));
                tc = MFMA16(fc1[ks], xb, tc); ts = MFMA16(fs1[ks], xb, ts); }
#pragma unroll
            for (int j = 0; j < 4; ++j) { const int k1l = 4 * g + j, k1 = 16 * kb + k1l; const f32x2 w = *(const f32x2*)(tw + 2 * (n2 * k1));
                tr[(k1l * 64 + n2) * 16 + lr] = (bf16)f2bf(tc[j] * w[0] - ts[j] * w[1]); ti[(k1l * 64 + n2) * 16 + lr] = (bf16)f2bf(-(tc[j] * w[1] + ts[j] * w[0])); }
        }
    }
    __syncthreads();
    bf16* MX = (bf16*)(F.ws + WS_MIX) + (size_t)b * SEQ * MW + 16 * cg + lr;
#pragma unroll
    for (int q = 0; q < 2; ++q) {
        const int k1l = 2 * F.wave + q, k1 = 16 * kb + k1l;
        bf16x8 br[2], bi[2];
#pragma unroll
        for (int ks = 0; ks < 2; ++ks) { const int off = (k1l * 64 + 32 * ks + 8 * g + ((F.lane & 15) >> 2)) * 16 + 4 * (F.lane & 3); br[ks] = cat8(trread(tr + off), trread(tr + off + 64)); bi[ks] = cat8(trread(ti + off), trread(ti + off + 64)); }
#pragma unroll
        for (int m = 0; m < 4; ++m) {
            f32x4 yr = zero4, y1 = zero4, y2 = zero4;
#pragma unroll
            for (int ks = 0; ks < 2; ++ks) { const bf16x8 fc = *(const bf16x8*)(f64 + (16 * m + lr) * 64 + 32 * ks + 8 * g), fs = *(const bf16x8*)(f64 + 4096 + (16 * m + lr) * 64 + 32 * ks + 8 * g);
                yr = MFMA16(fc, br[ks], yr); yr = MFMA16(fs, bi[ks], yr); y1 = MFMA16(fc, bi[ks], y1); y2 = MFMA16(fs, br[ks], y2); }
#pragma unroll
            for (int j = 0; j < 4; ++j) { const int k2 = 16 * m + 4 * g + j; bf16* o = MX + (size_t)(64 * k2 + k1) * MW; o[0] = (bf16)f2bf(yr[j] * (1.f / 64.f)); o[256] = (bf16)f2bf((y1[j] - y2[j]) * (1.f / 64.f)); }
        }
    }
}
__device__ __forceinline__ void dft_ctx_unit(Frame& F0, int u) {
    LAUNDER_F(F0)
    const int b = u >> 5, kblk = u & 31;
    LAS bf16* sl = (LAS bf16*)F.lds;
    const bf16* PB = (const bf16*)(F.ws + WS_PBUF) + (size_t)(NLAT + b * CTXL) * PW + PC_FU;
    __syncthreads();
#pragma unroll
    for (int h = 0; h < 2; ++h) { u32x4 v[8];
#pragma unroll
        for (int k = 0; k < 8; ++k) { const int i = F.tid + (h * 8 + k) * NTHR, n = i >> 5, pc = i & 31; v[k] = *(const u32x4*)(PB + (size_t)n * PW + pc * 8); }
#pragma unroll
        for (int k = 0; k < 8; ++k) { const int i = F.tid + (h * 8 + k) * NTHR, n = i >> 5, pc = i & 31; *(LAS u32x4*)(sl + n * 256 + pc * 8) = v[k]; } }
    __syncthreads();
    const int c = F.tid & 255, k0 = kblk * 8 + (F.tid >> 8) * 4;
    const float* d256 = (const float*)(F.ws + WS_TAB + TAB_D256);
    float wr[4], wi[4], sr[4], si[4], ar[4], ai[4];
#pragma unroll
    for (int i = 0; i < 4; ++i) { sr[i] = d256[2 * (k0 + i)]; si[i] = -d256[2 * (k0 + i) + 1]; wr[i] = 1.f; wi[i] = 0.f; ar[i] = 0.f; ai[i] = 0.f; }
#pragma unroll 4
    for (int n = 0; n < 256; ++n) { const float uv = bf2f(sl[n * 256 + c]);
#pragma unroll
        for (int i = 0; i < 4; ++i) { ar[i] += uv * wr[i]; ai[i] += uv * wi[i]; const float nr = wr[i] * sr[i] - wi[i] * si[i], ni = wr[i] * si[i] + wi[i] * sr[i]; wr[i] = nr; wi[i] = ni; } }
    bf16* MX = (bf16*)(F.ws + WS_MIX) + (size_t)(NLAT + b * CTXL + k0) * MW + c;
#pragma unroll
    for (int i = 0; i < 4; ++i) { MX[(size_t)i * MW] = (bf16)f2bf(ar[i] * (1.f / 16.f)); MX[(size_t)i * MW + 256] = (bf16)f2bf(ai[i] * (1.f / 16.f)); }
}

__device__ __forceinline__ void p_mix_a(Frame& F, CArgs& a, int L) {
    {
        pg8::Gemm g{(const bf16*)(F.ws + WS_A2), (const bf16*)(F.ws + WS_S5P) + (size_t)L * 16 * 256 * 256, 1024, 512, OPQ(256)};
        SgOrder<FillS5> S; S.init(144, 1, F.G, F.bid); S.f = FillS5{(size_t)256 * 256 * 2};
        EpiS5S E{(float*)(F.ws + WS_S5S)};
        pg8::gemm_phase(F.lds, g, S, E, fresh_tid(F.wave));
    }
    for (int u = F.bid; u < NCHK; u += F.G) gla_chunk<false>(F, a, L, u);
    for (int u = (F.bid + 32) % F.G; u < NCHK; u += F.G) ssd_chunk<false>(F, a, L, u);
    __syncthreads();
}
__device__ __forceinline__ void p_mix_b(Frame& F, CArgs& a, int L) {
    for (int u = F.bid; u < 256; u += F.G) {
        const int vz = F.tid >> 9, uv = u + vz, wv = (F.tid >> 6);
        const int b = uv >> 5, g = (uv >> 1) & 15, r = uv & 1;
        const f32x2 a16 = *(const f32x2*)((const float*)(F.ws + WS_A16) + ((size_t)((L * 2 + r) * 16 + g) * 64 + F.lane) * 2);
        const float* S = (const float*)(F.ws + WS_S5S) + (size_t)g * S5ROWS * 256 + r * 128 + F.lane; bf16* A2 = (bf16*)(F.ws + WS_A2) + (size_t)g * S5ROWS * 512 + 256 + r * 128 + F.lane;
        LAS float* ex = (LAS float*)F.lds;
        LAS float* sl = ex + 17 * 128;
        __syncthreads();
#pragma unroll 1
        for (int sg = wv; sg < 17; sg += 8) {
            float sr[16], si[16];
#pragma unroll
            for (int n = 0; n < 16; ++n) { const int i = 16 * sg + n; const int row = i < 16 ? 2048 + 16 * b + (r ? 15 - i : i) : 256 * b + (r ? 271 - i : i - 16); sr[n] = S[(size_t)row * 256]; si[n] = S[(size_t)row * 256 + 64]; }
            float hr = 0.f, hi = 0.f;
#pragma unroll
            for (int n = 0; n < 16; ++n) { sl[((16 * sg + n) * 64 + F.lane) * 2] = sr[n]; sl[((16 * sg + n) * 64 + F.lane) * 2 + 1] = si[n];
                const float nr = a16[0] * hr - a16[1] * hi + sr[n], ni = a16[0] * hi + a16[1] * hr + si[n]; hr = nr; hi = ni; }
            ex[(sg * 64 + F.lane) * 2] = hr; ex[(sg * 64 + F.lane) * 2 + 1] = hi;
        }
        __syncthreads();
        float pr = a16[0], pi = a16[1];
#pragma unroll
        for (int q = 0; q < 4; ++q) { const float nr = pr * pr - pi * pi, ni = 2.f * pr * pi; pr = nr; pi = ni; }
#pragma unroll 1
        for (int sg = wv; sg < 17; sg += 8) {
            float hr = 0.f, hi = 0.f;
            for (int j = 0; j < sg; ++j) { const float er = ex[(j * 64 + F.lane) * 2], ei = ex[(j * 64 + F.lane) * 2 + 1]; const float nr = pr * hr - pi * hi + er, ni = pr * hi + pi * hr + ei; hr = nr; hi = ni; }
#pragma unroll 4
            for (int n = 0; n < 16; ++n) { const int i = 16 * sg + n; const int row = i < 16 ? 2048 + 16 * b + (r ? 15 - i : i) : 256 * b + (r ? 271 - i : i - 16);
                A2[(size_t)row * 512] = (bf16)f2bf(hr); A2[(size_t)row * 512 + 64] = (bf16)f2bf(hi);
                const float xr_ = sl[(i * 64 + F.lane) * 2], xi_ = sl[(i * 64 + F.lane) * 2 + 1];
                const float nr = a16[0] * hr - a16[1] * hi + xr_, ni = a16[0] * hi + a16[1] * hr + xi_; hr = nr; hi = ni; }
        }
    }
    for (int u = F.bid; u < 256; u += F.G) { const int uv = u + (F.tid >> 9), sq = uv >> 2, b = sq >> 3, hh = (sq >> 1) & 3, r = sq & 1, e = (uv & 3) * 512 + F.tid, c = e & 31;
        const float* ds = (const float*)(F.ws + WS_GDS); const float* dc = (const float*)(F.ws + WS_GDEC); bf16* se = (bf16*)(F.ws + WS_GSE);
        float s = 0.f;
        for (int i0 = 0; i0 < 68; i0 += 17) { float dv[17], cv[17];
#pragma unroll
            for (int k = 0; k < 17; ++k) { const int i = i0 + k; const int cid = i < 4 ? 512 + b * 4 + (r ? 3 - i : i) : b * 64 + (r ? 67 - i : i - 4); const size_t ub = ((size_t)cid * 4 + hh) * 2 + r; dv[k] = ds[ub * 2048 + e]; cv[k] = dc[ub * 32 + c]; }
#pragma unroll
            for (int k = 0; k < 17; ++k) { const int i = i0 + k; const int cid = i < 4 ? 512 + b * 4 + (r ? 3 - i : i) : b * 64 + (r ? 67 - i : i - 4); const size_t ub = ((size_t)cid * 4 + hh) * 2 + r; se[ub * 2048 + e] = (bf16)f2bf(s); s = cv[k] * s + dv[k]; } } }
    for (int u = F.bid; u < 512; u += F.G) { const int uv = u + (F.tid >> 9), sq = uv >> 3, b = sq >> 3, h = (sq >> 1) & 3, r = sq & 1, e = (uv & 7) * 512 + F.tid;
        const float* ds = (const float*)(F.ws + WS_SDS); const float* dc = (const float*)(F.ws + WS_SDEC); bf16* se = (bf16*)(F.ws + WS_SSE);
        float s = 0.f;
        for (int i0 = 0; i0 < 68; i0 += 17) { float dv[17], cv[17];
#pragma unroll
            for (int k = 0; k < 17; ++k) { const int i = i0 + k; const int cid = i < 4 ? 512 + b * 4 + (r ? 3 - i : i) : b * 64 + (r ? 67 - i : i - 4); const size_t ub = ((size_t)cid * 4 + h) * 2 + r; dv[k] = ds[ub * 4096 + e]; cv[k] = dc[ub]; }
#pragma unroll
            for (int k = 0; k < 17; ++k) { const int i = i0 + k; const int cid = i < 4 ? 512 + b * 4 + (r ? 3 - i : i) : b * 64 + (r ? 67 - i : i - 4); const size_t ub = ((size_t)cid * 4 + h) * 2 + r; se[ub * 4096 + e] = (bf16)f2bf(s); s = cv[k] * s + dv[k]; } } }
    for (int u = F.bid; u < 512; u += F.G) fft_unit(F, u);
    for (int u = F.bid; u < 256; u += F.G) dft_ctx_unit(F, u);
    __syncthreads();
}
__device__ __forceinline__ void p_mix_c(Frame& F, CArgs& a, int L) {
#ifndef MIXC_PARTS
#define MIXC_PARTS 7
#endif
    if (MIXC_PARTS & 1) {
        pg8::Gemm g{(const bf16*)(F.ws + WS_A2), (const bf16*)(F.ws + WS_S5B2) + (size_t)L * 16 * 256 * 512, 1024, 1024, OPQ(512)};
        SgOrder<FillS5> S; S.init(144, 1, F.G, F.bid); S.f = FillS5{(size_t)256 * 512 * 2};
        EpiS5Y E{(bf16*)(F.ws + WS_ACT5)};
        pg8::gemm_phase(F.lds, g, S, E, fresh_tid(F.wave));
    }
    const int nch = (L == DEPTH - 1) ? 512 : NCHK;
    if (MIXC_PARTS & 2) for (int u = F.bid; u < nch; u += F.G) gla_chunk<true>(F, a, L, u);
    if (MIXC_PARTS & 4) for (int u = (F.bid + 32) % F.G; u < nch; u += F.G) ssd_chunk<true>(F, a, L, u);
    __syncthreads();
}

constexpr int NPH = 11, PH_TOTAL = 2 + DEPTH * NPH;
#ifndef PHASE_MASK
#define PHASE_MASK 0xFFFF
#endif
#define PM(i) ((PHASE_MASK >> (i)) & 1)
#ifndef DUP_MASK
#define DUP_MASK 0
#endif
#define NREP(k) (((DUP_MASK >> (k)) & 1) ? 2 : 1)
#ifndef MK_ONE_LAUNCH
#define MK_ONE_LAUNCH 0
#endif

__global__ void __launch_bounds__(NTHR, 2) mk_fwd(Args args_by_value) {
#define args (*fresh_args())
    extern __shared__ __attribute__((aligned(16))) unsigned char lds_raw[];
    Frame F;
    F.lds = (LAS unsigned char*)lds_raw; F.MISC = (volatile LAS unsigned*)(F.lds + MISC_OFF);
    F.tid = threadIdx.x; F.lane = F.tid & 63; F.wave = __builtin_amdgcn_readfirstlane(F.tid >> 6); F.G = gridDim.x; F.bid = blockIdx.x;
    F.ws = args_by_value.ws; F.ctl = (unsigned*)(args_by_value.ws + WS_CTL);
    if (F.tid < 64) F.MISC[F.tid] = 0u;
    __syncthreads();
#if MK_ONE_LAUNCH
    XcdBarrier bar = xcd_barrier_post(F.ctl + CW_BAR, F.MISC + 8);
#define GRID_BAR() xcd_barrier(bar)
#else
#define GRID_BAR() do { } while (0)
#endif
    const int lo = args_by_value.ph_lo, hi = args_by_value.ph_hi;
#define IN(k) (lo <= (k) && (k) < hi)
#define FRESH() do { const int t_ = fresh_tid(F.wave); F.tid = t_; F.lane = t_ & 63; } while (0)
#define SEAM(k) do { if (IN(k) && IN((k) + 1)) GRID_BAR(); } while (0)
    if (PM(0) && IN(0)) { FRESH(); p_prologue(F, args); }
#ifdef DUP_PROLOGUE
    GRID_BAR(); if (PM(0) && IN(0)) { FRESH(); p_prologue(F, args, CW_QUEUE + 64); }
#endif
    SEAM(0);
    {
        const int pb = 1 + 0 * NPH;
        const int mrows = (0 == DEPTH - 1) ? NLAT : NT;
        if (PM(1) && IN(pb + 0)) { FRESH(); p_norm1(F, args, OPQ(0)); }
#ifdef DUP_NORM1
        GRID_BAR(); if (PM(1) && IN(pb + 0)) { FRESH(); p_norm1(F, args, OPQ(0), true); }
#endif
 SEAM(pb + 0);
        if (PM(2) && IN(pb + 1)) for (int rep_ = 0; rep_ < NREP(2); ++rep_) { if (rep_) GRID_BAR(); const int Lg = OPQ(0);
            pg8::Gemm g{(const bf16*)(F.ws + WS_H), (const bf16*)(F.ws + WS_WIN) + (size_t)Lg * PW * DM, DM * 2, DM * 2, OPQ(DM)};
            SgOrder<FillPlain> S; S.init(NT / 256, PW / 256, F.G, F.bid); S.f = FillPlain{(size_t)256 * DM * 2, (size_t)256 * DM * 2};
            EpiInproj E{(bf16*)(F.ws + WS_PBUF), (bf16*)(F.ws + WS_A2)};
            pg8::gemm_phase(F.lds, g, S, E, fresh_tid(F.wave));
        } SEAM(pb + 1);
        if (PM(3) && IN(pb + 2)) for (int rep_ = 0; rep_ < NREP(3); ++rep_) { if (rep_) GRID_BAR(); FRESH(); p_mix_a(F, args, OPQ(0)); } SEAM(pb + 2);
        if (PM(4) && IN(pb + 3)) for (int rep_ = 0; rep_ < NREP(4); ++rep_) { if (rep_) GRID_BAR(); FRESH(); p_mix_b(F, args, OPQ(0)); } SEAM(pb + 3);
        if (PM(5) && IN(pb + 4)) for (int rep_ = 0; rep_ < NREP(5); ++rep_) { if (rep_) GRID_BAR(); FRESH(); p_mix_c(F, args, OPQ(0)); } SEAM(pb + 4);
        if (PM(6) && IN(pb + 5)) for (int rep_ = 0; rep_ < NREP(6); ++rep_) { if (rep_) GRID_BAR(); const int Lg = OPQ(0);
            pg8::Gemm g{(const bf16*)(F.ws + WS_ACT5), (const bf16*)(F.ws + WS_WGLU) + (size_t)Lg * 256 * 256, 512, 512, OPQ(256)};
            SgOrder<FillPlain> S; S.init(NT / 256, 1, F.G, F.bid); S.f = FillPlain{(size_t)256 * 256 * 2, 0};
            EpiGlu E{(const bf16*)(F.ws + WS_ACT5), (bf16*)(F.ws + WS_MIX)};
            pg8::gemm_phase(F.lds, g, S, E, fresh_tid(F.wave));
        } SEAM(pb + 5);
        if (PM(7) && IN(pb + 6)) { const int Lg = OPQ(0);
            pg8::Gemm g{(const bf16*)(F.ws + WS_MIX), (const bf16*)(F.ws + WS_WOUT) + (size_t)Lg * DM * MW, MW * 2, MW * 2, OPQ(MW)};
            SgOrder<FillPlain> S; S.init((Lg == DEPTH - 1 ? NLAT : NT) / 256, DM / 256, F.G, F.bid); S.f = FillPlain{(size_t)256 * MW * 2, (size_t)256 * MW * 2};
            EpiOutproj E{args.in[I_X], args.in[I_CTX], (float*)(F.ws + WS_XS), (const float*)(F.ws + WS_MOD) + (size_t)Lg * 9 * 6144, Lg == 0 ? 1 : 0};
            pg8::gemm_phase(F.lds, g, S, E, fresh_tid(F.wave));
        } SEAM(pb + 6);
        if (PM(8) && IN(pb + 7)) { FRESH(); p_norm2(F, args, OPQ(0), OPQ(mrows)); }
#ifdef DUP_NORM2
        GRID_BAR(); if (PM(8) && IN(pb + 7)) { FRESH(); p_norm2(F, args, OPQ(0), OPQ(mrows), 6400); }
#endif
 SEAM(pb + 7);
        if (PM(9) && IN(pb + 8)) for (int rep_ = 0; rep_ < NREP(9); ++rep_) { if (rep_) GRID_BAR(); FRESH(); p_dispatch(F, OPQ(0), OPQ(mrows)); } SEAM(pb + 8);
        if (PM(10) && IN(pb + 9)) for (int rep_ = 0; rep_ < NREP(10); ++rep_) { if (rep_) GRID_BAR(); const int Lg = OPQ(0);
            const unsigned* blke = F.ctl + CW_BLKE + Lg * 1024; const int nblk = (int)__hip_atomic_load(blke, RLX_AGENT);
            pg8::Gemm g{F.ws + WS_BUF, F.ws + WS_WGU + (size_t)Lg * NEXP * 2048 * DM, DM, DM, OPQ(DM / 2)};
            SgOrder<FillMoe> S; S.init(nblk, 8, F.G, F.bid); S.f = FillMoe{blke, 2048};
            EpiSwiglu E{(unsigned char*)(F.ws + WS_ACT), args.in[I_BGU] + (size_t)Lg * NEXP * 2048};
            pg8::gemm_phase<EpiSwiglu, SgOrder<FillMoe>, true, F8_ALIGN, F8_SP2>(F.lds, g, S, E, fresh_tid(F.wave));
        } SEAM(pb + 9);
        if (PM(11) && IN(pb + 10)) for (int rep_ = 0; rep_ < NREP(11); ++rep_) { if (rep_) GRID_BAR(); const int Lg = OPQ(0);
            const unsigned* blke = F.ctl + CW_BLKE + Lg * 1024; const int nblk = (int)__hip_atomic_load(blke, RLX_AGENT);
            pg8::Gemm g{F.ws + WS_ACT, F.ws + WS_WDN + (size_t)Lg * NEXP * DM * DM, DM, DM, OPQ(DM / 2)};
            SgOrder<FillMoe> S; S.init(nblk, 4, F.G, F.bid); S.f = FillMoe{blke, 1024};
            EpiDown E{(bf16*)(F.ws + WS_Y), args.in[I_BDN] + (size_t)Lg * NEXP * DM, (const float*)(F.ws + WS_SG)};
            pg8::gemm_phase<EpiDown, SgOrder<FillMoe>, true, F8_ALIGN, F8_SP2>(F.lds, g, S, E, fresh_tid(F.wave));
        } SEAM(pb + 10);
        }
    {
        const int pb = 1 + 1 * NPH;
        const int mrows = (1 == DEPTH - 1) ? NLAT : NT;
        if (PM(1) && IN(pb + 0)) { FRESH(); p_norm1(F, args, OPQ(1)); }
#ifdef DUP_NORM1
        GRID_BAR(); if (PM(1) && IN(pb + 0)) { FRESH(); p_norm1(F, args, OPQ(1), true); }
#endif
 SEAM(pb + 0);
        if (PM(2) && IN(pb + 1)) for (int rep_ = 0; rep_ < NREP(2); ++rep_) { if (rep_) GRID_BAR(); const int Lg = OPQ(1);
            pg8::Gemm g{(const bf16*)(F.ws + WS_H), (const bf16*)(F.ws + WS_WIN) + (size_t)Lg * PW * DM, DM * 2, DM * 2, OPQ(DM)};
            SgOrder<FillPlain> S; S.init(NT / 256, PW / 256, F.G, F.bid); S.f = FillPlain{(size_t)256 * DM * 2, (size_t)256 * DM * 2};
            EpiInproj E{(bf16*)(F.ws + WS_PBUF), (bf16*)(F.ws + WS_A2)};
            pg8::gemm_phase(F.lds, g, S, E, fresh_tid(F.wave));
        } SEAM(pb + 1);
        if (PM(3) && IN(pb + 2)) for (int rep_ = 0; rep_ < NREP(3); ++rep_) { if (rep_) GRID_BAR(); FRESH(); p_mix_a(F, args, OPQ(1)); } SEAM(pb + 2);
        if (PM(4) && IN(pb + 3)) for (int rep_ = 0; rep_ < NREP(4); ++rep_) { if (rep_) GRID_BAR(); FRESH(); p_mix_b(F, args, OPQ(1)); } SEAM(pb + 3);
        if (PM(5) && IN(pb + 4)) for (int rep_ = 0; rep_ < NREP(5); ++rep_) { if (rep_) GRID_BAR(); FRESH(); p_mix_c(F, args, OPQ(1)); } SEAM(pb + 4);
        if (PM(6) && IN(pb + 5)) for (int rep_ = 0; rep_ < NREP(6); ++rep_) { if (rep_) GRID_BAR(); const int Lg = OPQ(1);
            pg8::Gemm g{(const bf16*)(F.ws + WS_ACT5), (const bf16*)(F.ws + WS_WGLU) + (size_t)Lg * 256 * 256, 512, 512, OPQ(256)};
            SgOrder<FillPlain> S; S.init(NT / 256, 1, F.G, F.bid); S.f = FillPlain{(size_t)256 * 256 * 2, 0};
            EpiGlu E{(const bf16*)(F.ws + WS_ACT5), (bf16*)(F.ws + WS_MIX)};
            pg8::gemm_phase(F.lds, g, S, E, fresh_tid(F.wave));
        } SEAM(pb + 5);
        if (PM(7) && IN(pb + 6)) { const int Lg = OPQ(1);
            pg8::Gemm g{(const bf16*)(F.ws + WS_MIX), (const bf16*)(F.ws + WS_WOUT) + (size_t)Lg * DM * MW, MW * 2, MW * 2, OPQ(MW)};
            SgOrder<FillPlain> S; S.init((Lg == DEPTH - 1 ? NLAT : NT) / 256, DM / 256, F.G, F.bid); S.f = FillPlain{(size_t)256 * MW * 2, (size_t)256 * MW * 2};
            EpiOutproj E{args.in[I_X], args.in[I_CTX], (float*)(F.ws + WS_XS), (const float*)(F.ws + WS_MOD) + (size_t)Lg * 9 * 6144, Lg == 0 ? 1 : 0};
            pg8::gemm_phase(F.lds, g, S, E, fresh_tid(F.wave));
        } SEAM(pb + 6);
        if (PM(8) && IN(pb + 7)) { FRESH(); p_norm2(F, args, OPQ(1), OPQ(mrows)); }
#ifdef DUP_NORM2
        GRID_BAR(); if (PM(8) && IN(pb + 7)) { FRESH(); p_norm2(F, args, OPQ(1), OPQ(mrows), 6400); }
#endif
 SEAM(pb + 7);
        if (PM(9) && IN(pb + 8)) for (int rep_ = 0; rep_ < NREP(9); ++rep_) { if (rep_) GRID_BAR(); FRESH(); p_dispatch(F, OPQ(1), OPQ(mrows)); } SEAM(pb + 8);
        if (PM(10) && IN(pb + 9)) for (int rep_ = 0; rep_ < NREP(10); ++rep_) { if (rep_) GRID_BAR(); const int Lg = OPQ(1);
            const unsigned* blke = F.ctl + CW_BLKE + Lg * 1024; const int nblk = (int)__hip_atomic_load(blke, RLX_AGENT);
            pg8::Gemm g{F.ws + WS_BUF, F.ws + WS_WGU + (size_t)Lg * NEXP * 2048 * DM, DM, DM, OPQ(DM / 2)};
            SgOrder<FillMoe> S; S.init(nblk, 8, F.G, F.bid); S.f = FillMoe{blke, 2048};
            EpiSwiglu E{(unsigned char*)(F.ws + WS_ACT), args.in[I_BGU] + (size_t)Lg * NEXP * 2048};
            pg8::gemm_phase<EpiSwiglu, SgOrder<FillMoe>, true, F8_ALIGN, F8_SP2>(F.lds, g, S, E, fresh_tid(F.wave));
        } SEAM(pb + 9);
        if (PM(11) && IN(pb + 10)) for (int rep_ = 0; rep_ < NREP(11); ++rep_) { if (rep_) GRID_BAR(); const int Lg = OPQ(1);
            const unsigned* blke = F.ctl + CW_BLKE + Lg * 1024; const int nblk = (int)__hip_atomic_load(blke, RLX_AGENT);
            pg8::Gemm g{F.ws + WS_ACT, F.ws + WS_WDN + (size_t)Lg * NEXP * DM * DM, DM, DM, OPQ(DM / 2)};
            SgOrder<FillMoe> S; S.init(nblk, 4, F.G, F.bid); S.f = FillMoe{blke, 1024};
            EpiDown E{(bf16*)(F.ws + WS_Y), args.in[I_BDN] + (size_t)Lg * NEXP * DM, (const float*)(F.ws + WS_SG)};
            pg8::gemm_phase<EpiDown, SgOrder<FillMoe>, true, F8_ALIGN, F8_SP2>(F.lds, g, S, E, fresh_tid(F.wave));
        } SEAM(pb + 10);
        }
    {
        const int pb = 1 + 2 * NPH;
        const int mrows = (2 == DEPTH - 1) ? NLAT : NT;
        if (PM(1) && IN(pb + 0)) { FRESH(); p_norm1(F, args, OPQ(2)); }
#ifdef DUP_NORM1
        GRID_BAR(); if (PM(1) && IN(pb + 0)) { FRESH(); p_norm1(F, args, OPQ(2), true); }
#endif
 SEAM(pb + 0);
        if (PM(2) && IN(pb + 1)) for (int rep_ = 0; rep_ < NREP(2); ++rep_) { if (rep_) GRID_BAR(); const int Lg = OPQ(2);
            pg8::Gemm g{(const bf16*)(F.ws + WS_H), (const bf16*)(F.ws + WS_WIN) + (size_t)Lg * PW * DM, DM * 2, DM * 2, OPQ(DM)};
            SgOrder<FillPlain> S; S.init(NT / 256, PW / 256, F.G, F.bid); S.f = FillPlain{(size_t)256 * DM * 2, (size_t)256 * DM * 2};
            EpiInproj E{(bf16*)(F.ws + WS_PBUF), (bf16*)(F.ws + WS_A2)};
            pg8::gemm_phase(F.lds, g, S, E, fresh_tid(F.wave));
        } SEAM(pb + 1);
        if (PM(3) && IN(pb + 2)) for (int rep_ = 0; rep_ < NREP(3); ++rep_) { if (rep_) GRID_BAR(); FRESH(); p_mix_a(F, args, OPQ(2)); } SEAM(pb + 2);
        if (PM(4) && IN(pb + 3)) for (int rep_ = 0; rep_ < NREP(4); ++rep_) { if (rep_) GRID_BAR(); FRESH(); p_mix_b(F, args, OPQ(2)); } SEAM(pb + 3);
        if (PM(5) && IN(pb + 4)) for (int rep_ = 0; rep_ < NREP(5); ++rep_) { if (rep_) GRID_BAR(); FRESH(); p_mix_c(F, args, OPQ(2)); } SEAM(pb + 4);
        if (PM(6) && IN(pb + 5)) for (int rep_ = 0; rep_ < NREP(6); ++rep_) { if (rep_) GRID_BAR(); const int Lg = OPQ(2);
            pg8::Gemm g{(const bf16*)(F.ws + WS_ACT5), (const bf16*)(F.ws + WS_WGLU) + (size_t)Lg * 256 * 256, 512, 512, OPQ(256)};
            SgOrder<FillPlain> S; S.init(NT / 256, 1, F.G, F.bid); S.f = FillPlain{(size_t)256 * 256 * 2, 0};
            EpiGlu E{(const bf16*)(F.ws + WS_ACT5), (bf16*)(F.ws + WS_MIX)};
            pg8::gemm_phase(F.lds, g, S, E, fresh_tid(F.wave));
        } SEAM(pb + 5);
        if (PM(7) && IN(pb + 6)) { const int Lg = OPQ(2);
            pg8::Gemm g{(const bf16*)(F.ws + WS_MIX), (const bf16*)(F.ws + WS_WOUT) + (size_t)Lg * DM * MW, MW * 2, MW * 2, OPQ(MW)};
            SgOrder<FillPlain> S; S.init((Lg == DEPTH - 1 ? NLAT : NT) / 256, DM / 256, F.G, F.bid); S.f = FillPlain{(size_t)256 * MW * 2, (size_t)256 * MW * 2};
            EpiOutproj E{args.in[I_X], args.in[I_CTX], (float*)(F.ws + WS_XS), (const float*)(F.ws + WS_MOD) + (size_t)Lg * 9 * 6144, Lg == 0 ? 1 : 0};
            pg8::gemm_phase(F.lds, g, S, E, fresh_tid(F.wave));
        } SEAM(pb + 6);
        if (PM(8) && IN(pb + 7)) { FRESH(); p_norm2(F, args, OPQ(2), OPQ(mrows)); }
#ifdef DUP_NORM2
        GRID_BAR(); if (PM(8) && IN(pb + 7)) { FRESH(); p_norm2(F, args, OPQ(2), OPQ(mrows), 6400); }
#endif
 SEAM(pb + 7);
        if (PM(9) && IN(pb + 8)) for (int rep_ = 0; rep_ < NREP(9); ++rep_) { if (rep_) GRID_BAR(); FRESH(); p_dispatch(F, OPQ(2), OPQ(mrows)); } SEAM(pb + 8);
        if (PM(10) && IN(pb + 9)) for (int rep_ = 0; rep_ < NREP(10); ++rep_) { if (rep_) GRID_BAR(); const int Lg = OPQ(2);
            const unsigned* blke = F.ctl + CW_BLKE + Lg * 1024; const int nblk = (int)__hip_atomic_load(blke, RLX_AGENT);
            pg8::Gemm g{F.ws + WS_BUF, F.ws + WS_WGU + (size_t)Lg * NEXP * 2048 * DM, DM, DM, OPQ(DM / 2)};
            SgOrder<FillMoe> S; S.init(nblk, 8, F.G, F.bid); S.f = FillMoe{blke, 2048};
            EpiSwiglu E{(unsigned char*)(F.ws + WS_ACT), args.in[I_BGU] + (size_t)Lg * NEXP * 2048};
            pg8::gemm_phase<EpiSwiglu, SgOrder<FillMoe>, true, F8_ALIGN, F8_SP2>(F.lds, g, S, E, fresh_tid(F.wave));
        } SEAM(pb + 9);
        if (PM(11) && IN(pb + 10)) for (int rep_ = 0; rep_ < NREP(11); ++rep_) { if (rep_) GRID_BAR(); const int Lg = OPQ(2);
            const unsigned* blke = F.ctl + CW_BLKE + Lg * 1024; const int nblk = (int)__hip_atomic_load(blke, RLX_AGENT);
            pg8::Gemm g{F.ws + WS_ACT, F.ws + WS_WDN + (size_t)Lg * NEXP * DM * DM, DM, DM, OPQ(DM / 2)};
            SgOrder<FillMoe> S; S.init(nblk, 4, F.G, F.bid); S.f = FillMoe{blke, 1024};
            EpiDown E{(bf16*)(F.ws + WS_Y), args.in[I_BDN] + (size_t)Lg * NEXP * DM, (const float*)(F.ws + WS_SG)};
            pg8::gemm_phase<EpiDown, SgOrder<FillMoe>, true, F8_ALIGN, F8_SP2>(F.lds, g, S, E, fresh_tid(F.wave));
        } SEAM(pb + 10);
        }
    {
        const int pb = 1 + 3 * NPH;
        const int mrows = (3 == DEPTH - 1) ? NLAT : NT;
        if (PM(1) && IN(pb + 0)) { FRESH(); p_norm1(F, args, OPQ(3)); }
#ifdef DUP_NORM1
        GRID_BAR(); if (PM(1) && IN(pb + 0)) { FRESH(); p_norm1(F, args, OPQ(3), true); }
#endif
 SEAM(pb + 0);
        if (PM(2) && IN(pb + 1)) for (int rep_ = 0; rep_ < NREP(2); ++rep_) { if (rep_) GRID_BAR(); const int Lg = OPQ(3);
            pg8::Gemm g{(const bf16*)(F.ws + WS_H), (const bf16*)(F.ws + WS_WIN) + (size_t)Lg * PW * DM, DM * 2, DM * 2, OPQ(DM)};
            SgOrder<FillPlain> S; S.init(NT / 256, PW / 256, F.G, F.bid); S.f = FillPlain{(size_t)256 * DM * 2, (size_t)256 * DM * 2};
            EpiInproj E{(bf16*)(F.ws + WS_PBUF), (bf16*)(F.ws + WS_A2)};
            pg8::gemm_phase(F.lds, g, S, E, fresh_tid(F.wave));
        } SEAM(pb + 1);
        if (PM(3) && IN(pb + 2)) for (int rep_ = 0; rep_ < NREP(3); ++rep_) { if (rep_) GRID_BAR(); FRESH(); p_mix_a(F, args, OPQ(3)); } SEAM(pb + 2);
        if (PM(4) && IN(pb + 3)) for (int rep_ = 0; rep_ < NREP(4); ++rep_) { if (rep_) GRID_BAR(); FRESH(); p_mix_b(F, args, OPQ(3)); } SEAM(pb + 3);
        if (PM(5) && IN(pb + 4)) for (int rep_ = 0; rep_ < NREP(5); ++rep_) { if (rep_) GRID_BAR(); FRESH(); p_mix_c(F, args, OPQ(3)); } SEAM(pb + 4);
        if (PM(6) && IN(pb + 5)) for (int rep_ = 0; rep_ < NREP(6); ++rep_) { if (rep_) GRID_BAR(); const int Lg = OPQ(3);
            pg8::Gemm g{(const bf16*)(F.ws + WS_ACT5), (const bf16*)(F.ws + WS_WGLU) + (size_t)Lg * 256 * 256, 512, 512, OPQ(256)};
            SgOrder<FillPlain> S; S.init(NT / 256, 1, F.G, F.bid); S.f = FillPlain{(size_t)256 * 256 * 2, 0};
            EpiGlu E{(const bf16*)(F.ws + WS_ACT5), (bf16*)(F.ws + WS_MIX)};
            pg8::gemm_phase(F.lds, g, S, E, fresh_tid(F.wave));
        } SEAM(pb + 5);
        if (PM(7) && IN(pb + 6)) { const int Lg = OPQ(3);
            pg8::Gemm g{(const bf16*)(F.ws + WS_MIX), (const bf16*)(F.ws + WS_WOUT) + (size_t)Lg * DM * MW, MW * 2, MW * 2, OPQ(MW)};
            SgOrder<FillPlain> S; S.init((Lg == DEPTH - 1 ? NLAT : NT) / 256, DM / 256, F.G, F.bid); S.f = FillPlain{(size_t)256 * MW * 2, (size_t)256 * MW * 2};
            EpiOutproj E{args.in[I_X], args.in[I_CTX], (float*)(F.ws + WS_XS), (const float*)(F.ws + WS_MOD) + (size_t)Lg * 9 * 6144, Lg == 0 ? 1 : 0};
            pg8::gemm_phase(F.lds, g, S, E, fresh_tid(F.wave));
        } SEAM(pb + 6);
        if (PM(8) && IN(pb + 7)) { FRESH(); p_norm2(F, args, OPQ(3), OPQ(mrows)); }
#ifdef DUP_NORM2
        GRID_BAR(); if (PM(8) && IN(pb + 7)) { FRESH(); p_norm2(F, args, OPQ(3), OPQ(mrows), 6400); }
#endif
 SEAM(pb + 7);
        if (PM(9) && IN(pb + 8)) for (int rep_ = 0; rep_ < NREP(9); ++rep_) { if (rep_) GRID_BAR(); FRESH(); p_dispatch(F, OPQ(3), OPQ(mrows)); } SEAM(pb + 8);
        if (PM(10) && IN(pb + 9)) for (int rep_ = 0; rep_ < NREP(10); ++rep_) { if (rep_) GRID_BAR(); const int Lg = OPQ(3);
            const unsigned* blke = F.ctl + CW_BLKE + Lg * 1024; const int nblk = (int)__hip_atomic_load(blke, RLX_AGENT);
            pg8::Gemm g{F.ws + WS_BUF, F.ws + WS_WGU + (size_t)Lg * NEXP * 2048 * DM, DM, DM, OPQ(DM / 2)};
            SgOrder<FillMoe> S; S.init(nblk, 8, F.G, F.bid); S.f = FillMoe{blke, 2048};
            EpiSwiglu E{(unsigned char*)(F.ws + WS_ACT), args.in[I_BGU] + (size_t)Lg * NEXP * 2048};
            pg8::gemm_phase<EpiSwiglu, SgOrder<FillMoe>, true, F8_ALIGN, F8_SP2>(F.lds, g, S, E, fresh_tid(F.wave));
        } SEAM(pb + 9);
        if (PM(11) && IN(pb + 10)) for (int rep_ = 0; rep_ < NREP(11); ++rep_) { if (rep_) GRID_BAR(); const int Lg = OPQ(3);
            const unsigned* blke = F.ctl + CW_BLKE + Lg * 1024; const int nblk = (int)__hip_atomic_load(blke, RLX_AGENT);
            pg8::Gemm g{F.ws + WS_ACT, F.ws + WS_WDN + (size_t)Lg * NEXP * DM * DM, DM, DM, OPQ(DM / 2)};
            SgOrder<FillMoe> S; S.init(nblk, 4, F.G, F.bid); S.f = FillMoe{blke, 1024};
            EpiDown E{(bf16*)(F.ws + WS_Y), args.in[I_BDN] + (size_t)Lg * NEXP * DM, (const float*)(F.ws + WS_SG)};
            pg8::gemm_phase<EpiDown, SgOrder<FillMoe>, true, F8_ALIGN, F8_SP2>(F.lds, g, S, E, fresh_tid(F.wave));
        } SEAM(pb + 10);
        }
    if (PM(12) && IN(PH_TOTAL - 1)) { FRESH(); p_final(F, args); }
#undef IN
#undef SEAM
#undef args
}

extern "C" void kernel_launch(void* const* d_in, const int* in_sizes, int n_in, void* d_out, int out_size, void* d_ws, size_t ws_size, hipStream_t stream) {
    static int grid = 0;
    if (grid == 0) {
        if (n_in != N_IN || out_size != NLAT * DM || ws_size < WS_END) { fprintf(stderr, "kernel_launch: unexpected shapes (n_in %d, out %d, ws %zu < %zu); nothing launched\n", n_in, out_size, ws_size, (size_t)WS_END); grid = -1; return; }
        int dev = 0, cus = 0, per_cu = 0;
        if (hipGetDevice(&dev) != hipSuccess || hipDeviceGetAttribute(&cus, hipDeviceAttributeMultiprocessorCount, dev) != hipSuccess) { grid = -1; return; }
        if (hipFuncSetAttribute((const void*)mk_fwd, hipFuncAttributeMaxDynamicSharedMemorySize, LDS_BYTES) != hipSuccess) { fprintf(stderr, "kernel_launch: hipFuncSetAttribute failed\n"); grid = -1; return; }
        if (hipOccupancyMaxActiveBlocksPerMultiprocessor(&per_cu, (const void*)mk_fwd, NTHR, LDS_BYTES) != hipSuccess || per_cu < 1) fprintf(stderr, "kernel_launch: occupancy query says %d\n", per_cu);
        (void)hipGetLastError();
        grid = cus;
    }
    if (grid < 0) return;
    (void)hipMemsetAsync((char*)d_ws + WS_CTL, 0, CTL_BYTES, stream);
    Args a{};
    for (int i = 0; i < N_IN; ++i) a.in[i] = (const float*)d_in[i];
    a.out = (float*)d_out; a.ws = (unsigned char*)d_ws;
#if MK_ONE_LAUNCH
    a.ph_lo = 0; a.ph_hi = PH_TOTAL;
    hipLaunchKernelGGL(mk_fwd, dim3(grid), dim3(NTHR), LDS_BYTES, stream, a);
#else
    for (int p = 0; p < PH_TOTAL; ++p) { a.ph_lo = p; a.ph_hi = p + 1; hipLaunchKernelGGL(mk_fwd, dim3(grid), dim3(NTHR), LDS_BYTES, stream, a); }
#endif
}
```

```cpp
#define MK_ONE_LAUNCH 1
#define F8_ALIGN true
#define F8_SP2 true
#include <hip/hip_runtime.h>
#include <cstdio>
#include <cstdint>

#define GAS __attribute__((address_space(1)))
#define LAS __attribute__((address_space(3)))
typedef unsigned short bf16;
typedef short bf16x8 __attribute__((ext_vector_type(8)));
typedef short s16x4 __attribute__((ext_vector_type(4)));
typedef float f32x4 __attribute__((ext_vector_type(4)));
typedef float f32x2 __attribute__((ext_vector_type(2)));
typedef unsigned u32x4 __attribute__((ext_vector_type(4)));
typedef unsigned u32x2 __attribute__((ext_vector_type(2)));

namespace pg8 {
#define PG8_LAS __attribute__((address_space(3)))
typedef unsigned short bf16_t;
constexpr int BM = 256, BK = 64, HALF = 128, HTB = HALF * BK * 2  , STAGE_BYTES = 8 * HTB;

__host__ __device__ __forceinline__ int lds_byte(int r, int c) { const int st = (r >> 4) * 2 + (c >> 5), rr = r & 15, cc = c & 31, ob = rr * 64 + cc * 2; return st * 1024 + (ob ^ (((ob >> 9) & 1) << 5)); }
__host__ __device__ __forceinline__ void stage_rc(int b, int& R, int& C) { const int st = b / 1024, sb = b % 1024, swz = sb ^ (((sb >> 9) & 1) << 5); R = (st >> 1) * 16 + swz / 64; C = (st & 1) * 32 + (swz % 64) / 2; }
__host__ __device__ __forceinline__ int lds_byte_f8(int r, int c) { const int st = (r >> 4) * 2 + (c >> 5), rr = r & 15, cc = c & 31, ob = rr * 64 + cc * 2; return st * 1024 + (ob ^ (((ob >> 9) & 1) << 4)); }
__host__ __device__ __forceinline__ void stage_rc_f8(int b, int& R, int& C) { const int st = b / 1024, sb = b % 1024, swz = sb ^ (((sb >> 9) & 1) << 4); R = (st >> 1) * 16 + swz / 64; C = (st & 1) * 32 + (swz % 64) / 2; }
__host__ __device__ __forceinline__ int perm32(int rho) { const int n = rho >> 4, i = rho & 15; return 8 * (i >> 2) + 4 * n + (i & 3); }

struct Unit { int pm, pn, grp; size_t aoff, boff; };
struct Gemm { const void* A; const void* Bt; int lda, ldb, K; };

__device__ __forceinline__ unsigned cvt_pk_bf16(float lo, float hi) { unsigned r; asm volatile("v_cvt_pk_bf16_f32 %0, %1, %2" : "=v"(r) : "v"(lo), "v"(hi)); return r; }

typedef int v8i_t __attribute__((ext_vector_type(8)));
typedef int v4i_t __attribute__((ext_vector_type(4)));
template <class Epi, class Sched, bool F8 = false, bool ALIGN_EPI = true, bool SP2 = true>
__device__ __forceinline__ void gemm_phase(PG8_LAS unsigned char* lds, const Gemm g, const Sched& S, const Epi& E, int tid_in) {
    int tid = tid_in; asm volatile("" : "+v"(tid));
    const int wid = __builtin_amdgcn_readfirstlane(tid >> 6), lane = tid & 63, wr = wid >> 2, wc = wid & 3, fr = lane & 15, fq = lane >> 4;
    const int K = g.K, nt = K / BK;
    unsigned voffA[2], voffB[2];
#pragma unroll
    for (int i = 0; i < 2; ++i) { int R, C; if constexpr (F8) stage_rc_f8(tid * 16 + i * 8192, R, C); else stage_rc(tid * 16 + i * 8192, R, C); const int Rb = Epi::PERM ? ((R & ~31) + perm32(R & 31)) : R;
        voffA[i] = (unsigned)(R * g.lda + C * 2); voffB[i] = (unsigned)(Rb * g.ldb + C * 2); }
    const size_t kstep = (size_t)(BK * 2);
    const size_t hstepA = (size_t)HALF * g.lda, hstepB = (size_t)HALF * g.ldb;
    const unsigned ldsw = (unsigned)wid * 1024u;
    const int aoff = F8 ? lds_byte_f8(wr * 64 + fr, fq * 16) : lds_byte(wr * 64 + fr, fq * 8), boff = F8 ? lds_byte_f8(wc * 32 + fr, fq * 16) : lds_byte(wc * 32 + fr, fq * 8);
    const int aoff1 = lds_byte_f8(wr * 64 + fr, fq * 16 + 8), boff1 = lds_byte_f8(wc * 32 + fr, fq * 16 + 8);
#define PG8_SA(b, h) (((b) * 2 + (h)) * HTB)
#define PG8_SB(b, h) ((4 + (b) * 2 + (h)) * HTB)
#define PG8_STAGE(bufoff, gbase, voff) do { _Pragma("unroll") for (int _i = 0; _i < 2; ++_i) \
        __builtin_amdgcn_global_load_lds((const unsigned*)((const char*)(gbase) + (voff)[_i]), (PG8_LAS unsigned*)(lds + (bufoff) + ldsw + _i * 8192), 16, 0, 0); } while (0)
#define PG8_LD16(off) (*(const PG8_LAS v4i_t*)(lds + (off)))
#define PG8_LDA(dst, b, h) do { if constexpr (F8) { _Pragma("unroll") for (int m = 0; m < 4; ++m) A8[m] = __builtin_shufflevector(PG8_LD16(PG8_SA(b, h) + aoff + m * 2048), PG8_LD16(PG8_SA(b, h) + aoff1 + m * 2048), 0, 1, 2, 3, 4, 5, 6, 7); } \
        else { _Pragma("unroll") for (int m = 0; m < 4; ++m) _Pragma("unroll") for (int k = 0; k < 2; ++k) dst[m][k] = *(const PG8_LAS bf16x8*)(lds + PG8_SA(b, h) + aoff + m * 2048 + k * 1024); } } while (0)
#define PG8_LDB(dst, b, h) do { if constexpr (F8) { _Pragma("unroll") for (int n = 0; n < 2; ++n) dst##8[n] = __builtin_shufflevector(PG8_LD16(PG8_SB(b, h) + boff + n * 2048), PG8_LD16(PG8_SB(b, h) + boff1 + n * 2048), 0, 1, 2, 3, 4, 5, 6, 7); } \
        else { _Pragma("unroll") for (int n = 0; n < 2; ++n) _Pragma("unroll") for (int k = 0; k < 2; ++k) dst[n][k] = *(const PG8_LAS bf16x8*)(lds + PG8_SB(b, h) + boff + n * 2048 + k * 1024); } } while (0)
#define PG8_MMA(ai, bj, At, Bt) do { __builtin_amdgcn_s_setprio(1); \
        if constexpr (F8) { _Pragma("unroll") for (int m = 0; m < 4; ++m) _Pragma("unroll") for (int n = 0; n < 2; ++n) \
            asm volatile("v_mfma_scale_f32_16x16x128_f8f6f4 %0, %1, %2, %0, %3, %3 op_sel_hi:[0,0,0]" : "+v"(acc[ai][bj][m][n]) : "v"(Bt##8[n]), "v"(A8[m]), "v"(one_scale)); } \
        else { _Pragma("unroll") for (int m = 0; m < 4; ++m) _Pragma("unroll") for (int n = 0; n < 2; ++n) _Pragma("unroll") for (int k = 0; k < 2; ++k) \
            acc[ai][bj][m][n] = __builtin_amdgcn_mfma_f32_16x16x32_bf16(Bt[n][k], At[m][k], acc[ai][bj][m][n], 0, 0, 0); } \
        __builtin_amdgcn_s_setprio(0); } while (0)
#define PG8_WAIT_V(n) asm volatile("s_waitcnt vmcnt(" #n ")" ::: "memory")
#define PG8_WAIT_L(n) asm volatile("s_waitcnt lgkmcnt(" #n ")" ::: "memory")
#define PG8_BAR __builtin_amdgcn_s_barrier()
#define PG8_SCHED __builtin_amdgcn_sched_barrier(0)
    Unit cur, nxt; int cursor = 0;
    if (!S.next(cursor, cur)) return;
    f32x4 acc[2][2][4][2];
#pragma unroll
    for (int a = 0; a < 2; ++a)
#pragma unroll
        for (int b = 0; b < 2; ++b)
#pragma unroll
            for (int m = 0; m < 4; ++m)
#pragma unroll
                for (int n = 0; n < 2; ++n) acc[a][b][m][n] = (f32x4){0.f, 0.f, 0.f, 0.f};
    bf16x8 At[4][2], B0[2][2], B1[2][2];
    v8i_t A8[4], B08[2], B18[2];
    int one_scale = 0x7F7F7F7F; asm volatile("" : "+v"(one_scale));
    const char* cA = (const char*)g.A + cur.aoff; const char* cB = (const char*)g.Bt + cur.boff;
    if constexpr (SP2) {
        PG8_STAGE(PG8_SB(0, 0), cB, voffB); PG8_STAGE(PG8_SB(0, 1), cB + hstepB, voffB); PG8_STAGE(PG8_SA(0, 0), cA, voffA); PG8_STAGE(PG8_SA(0, 1), cA + hstepA, voffA);
        if (wr == 1) PG8_BAR;
        PG8_WAIT_V(2); PG8_BAR;
        PG8_STAGE(PG8_SB(1, 0), cB + kstep, voffB); PG8_STAGE(PG8_SA(1, 0), cA + kstep, voffA); PG8_STAGE(PG8_SB(1, 1), cB + hstepB + kstep, voffB);
        PG8_WAIT_V(6); PG8_BAR;
    } else {
        PG8_STAGE(PG8_SB(0, 0), cB, voffB); PG8_STAGE(PG8_SA(0, 0), cA, voffA); PG8_STAGE(PG8_SB(0, 1), cB + hstepB, voffB); PG8_STAGE(PG8_SA(0, 1), cA + hstepA, voffA);
        if (wr == 1) PG8_BAR;
        PG8_WAIT_V(4); PG8_BAR;
        PG8_STAGE(PG8_SB(1, 0), cB + kstep, voffB); PG8_STAGE(PG8_SA(1, 0), cA + kstep, voffA); PG8_STAGE(PG8_SB(1, 1), cB + hstepB + kstep, voffB);
        PG8_WAIT_V(6); PG8_BAR;
    }
    for (;;) {
        const bool has_next = S.next(cursor, nxt);
        const char* nA = has_next ? (const char*)g.A + nxt.aoff : cA; const char* nB = has_next ? (const char*)g.Bt + nxt.boff : cB;
        for (int t = 0; t < nt; t += 2) {
            const bool last = (t == nt - 2);
            const char* a1 = cA + (size_t)(t + 1) * kstep;
            const char* a2 = last ? nA : cA + (size_t)(t + 2) * kstep; const char* b2 = last ? nB : cB + (size_t)(t + 2) * kstep;
            const char* a3 = a2 + kstep; const char* b3 = b2 + kstep;
            if constexpr (SP2) {
            PG8_LDB(B0, 0, 0); PG8_LDB(B1, 0, 1); PG8_SCHED; PG8_LDA(At, 0, 0); PG8_STAGE(PG8_SA(1, 1), a1 + hstepA, voffA);
            PG8_WAIT_V(8); PG8_WAIT_L(0); PG8_BAR; PG8_MMA(0, 0, At, B0); PG8_MMA(0, 1, At, B1); PG8_BAR; PG8_SCHED;
            PG8_LDA(At, 0, 1); PG8_STAGE(PG8_SB(0, 0), b2, voffB); PG8_STAGE(PG8_SB(0, 1), b2 + hstepB, voffB); PG8_STAGE(PG8_SA(0, 0), a2, voffA);
            PG8_WAIT_V(8); PG8_WAIT_L(0); PG8_BAR; PG8_MMA(1, 0, At, B0); PG8_MMA(1, 1, At, B1); PG8_BAR; PG8_SCHED;
            PG8_LDB(B0, 1, 0); PG8_LDB(B1, 1, 1); PG8_SCHED; PG8_LDA(At, 1, 0); PG8_STAGE(PG8_SA(0, 1), a2 + hstepA, voffA);
            PG8_WAIT_V(8); PG8_WAIT_L(0); PG8_BAR; PG8_MMA(0, 0, At, B0); PG8_MMA(0, 1, At, B1); PG8_BAR; PG8_SCHED;
            PG8_LDA(At, 1, 1); PG8_STAGE(PG8_SB(1, 0), b3, voffB); PG8_STAGE(PG8_SB(1, 1), b3 + hstepB, voffB); PG8_STAGE(PG8_SA(1, 0), a3, voffA);
            PG8_WAIT_V(8); PG8_WAIT_L(0); PG8_BAR; PG8_MMA(1, 0, At, B0); PG8_MMA(1, 1, At, B1); PG8_BAR; PG8_SCHED;
            } else {
            PG8_LDB(B0, 0, 0); PG8_SCHED; PG8_LDA(At, 0, 0); PG8_STAGE(PG8_SA(1, 1), a1 + hstepA, voffA);
            PG8_WAIT_L(8); PG8_BAR; PG8_WAIT_L(0); PG8_MMA(0, 0, At, B0); PG8_BAR; PG8_SCHED;
            PG8_LDB(B1, 0, 1); PG8_STAGE(PG8_SB(0, 0), b2, voffB);
            PG8_BAR; PG8_WAIT_L(0); PG8_MMA(0, 1, At, B1); PG8_BAR;
            PG8_LDA(At, 0, 1); PG8_STAGE(PG8_SA(0, 0), a2, voffA);
            PG8_BAR; PG8_WAIT_L(0); PG8_MMA(1, 0, At, B0); PG8_BAR; PG8_SCHED;
            PG8_STAGE(PG8_SB(0, 1), b2 + hstepB, voffB);
            PG8_WAIT_V(6); PG8_BAR; PG8_MMA(1, 1, At, B1); PG8_BAR;
            PG8_LDB(B0, 1, 0); PG8_SCHED; PG8_LDA(At, 1, 0); PG8_STAGE(PG8_SA(0, 1), a2 + hstepA, voffA);
            PG8_WAIT_L(8); PG8_BAR; PG8_WAIT_L(0); PG8_MMA(0, 0, At, B0); PG8_BAR; PG8_SCHED;
            PG8_LDB(B1, 1, 1); PG8_STAGE(PG8_SB(1, 0), b3, voffB);
            PG8_BAR; PG8_WAIT_L(0); PG8_MMA(0, 1, At, B1); PG8_BAR;
            PG8_LDA(At, 1, 1); PG8_STAGE(PG8_SA(1, 0), a3, voffA);
            PG8_BAR; PG8_WAIT_L(0); PG8_MMA(1, 0, At, B0); PG8_BAR; PG8_SCHED;
            PG8_STAGE(PG8_SB(1, 1), b3 + hstepB, voffB);
            PG8_WAIT_V(6); PG8_BAR; PG8_MMA(1, 1, At, B1); PG8_BAR;
            }
        }
        if constexpr (F8) asm volatile("s_nop 15\n\ts_nop 15" ::: "memory");
        if constexpr (ALIGN_EPI) { if (wr == 0) PG8_BAR; }
        E(acc, cur, wr, wc, fr, fq);
        if (!has_next) break;
#pragma unroll
        for (int a = 0; a < 2; ++a)
#pragma unroll
            for (int b = 0; b < 2; ++b)
#pragma unroll
                for (int m = 0; m < 4; ++m)
#pragma unroll
                    for (int n = 0; n < 2; ++n) acc[a][b][m][n] = (f32x4){0.f, 0.f, 0.f, 0.f};
        cur = nxt; cA = nA; cB = nB;
        if constexpr (ALIGN_EPI) { if (wr == 1) PG8_BAR; }
    }
    PG8_WAIT_V(0);
    if constexpr (!ALIGN_EPI) { if (wr == 0) PG8_BAR; }
    PG8_BAR;
#undef PG8_SA
#undef PG8_SB
#undef PG8_STAGE
#undef PG8_LDA
#undef PG8_LDB
#undef PG8_MMA
#undef PG8_LD16
#undef PG8_WAIT_V
#undef PG8_WAIT_L
#undef PG8_BAR
#undef PG8_SCHED
}
}

#define XB_TMO      128
#define XB_XCNT(j)  (256  + 64 * (j))
#define XB_XSUB(j)  (1280 + 64 * (j))
#define XB_XGEN(j)  (2304 + 64 * (j))
#define XB_TOP      3328
#define XB_TOPGEN   3392
#define XCD_BAR_WORDS 3456
#define XB_SPIN_CAP (1u << 18)

__device__ __forceinline__ unsigned xb_ld(unsigned* p)              { return __hip_atomic_load(p, __ATOMIC_RELAXED, __HIP_MEMORY_SCOPE_AGENT); }
__device__ __forceinline__ unsigned xb_add(unsigned* p, unsigned v) { return __hip_atomic_fetch_add(p, v, __ATOMIC_RELAXED, __HIP_MEMORY_SCOPE_AGENT); }
__device__ __forceinline__ unsigned xb_xcc_id() { return (unsigned)__builtin_amdgcn_s_getreg((3 << 11) | 20) & 0xFu; }
#define XB_SPIN(cond, bar) do { unsigned _sp = 0; while (cond) { __builtin_amdgcn_s_sleep(1); \
    if ((++_sp & 255u) == 0u) { if (xb_ld(&(bar)[XB_TMO])) break; if (_sp > XB_SPIN_CAP) { atomicAdd(&(bar)[XB_TMO], 1u); break; } } } } while (0)

struct XcdBarrier {
    unsigned* bar; unsigned x;
    volatile LAS unsigned* st;
};

__device__ __forceinline__ XcdBarrier xcd_barrier_post(unsigned* bar, volatile LAS unsigned* st) {
    XcdBarrier b; b.bar = bar; b.x = xb_xcc_id(); b.st = st;
    if (threadIdx.x == 0) (void)xb_add(&bar[XB_XCNT(b.x)], 1u);
    return b;
}
__device__ __forceinline__ void xcd_barrier_complete(unsigned* bar, unsigned x, unsigned& nloc, unsigned& nx) {
    const unsigned G = gridDim.x * gridDim.y * gridDim.z;
    unsigned sum, cnt, mine, sp = 0u;
    for (;;) {
        sum = 0u; cnt = 0u; mine = 0u;
#pragma unroll
        for (unsigned j = 0; j < 16; ++j) { const unsigned c = xb_ld(&bar[XB_XCNT(j)]); sum += c; cnt += (c > 0u) ? 1u : 0u; mine = (j == x) ? c : mine; }
        if (sum == G) break;
        __builtin_amdgcn_s_sleep(1);
        if ((++sp & 255u) == 0u) { if (xb_ld(&bar[XB_TMO])) break; if (sp > XB_SPIN_CAP) { atomicAdd(&bar[XB_TMO], 1u); break; } }
    }
    nloc = mine > 0u ? mine : 1u; nx = cnt > 0u ? cnt : 1u;
}

__device__ __forceinline__ void xcd_barrier(const XcdBarrier& b) {
    asm volatile("s_waitcnt vmcnt(0)" ::: "memory");
    __syncthreads();
    if (threadIdx.x == 0) {
        unsigned* bar = b.bar;
        __builtin_amdgcn_s_waitcnt(0);
        unsigned nloc = b.st[0], nx = b.st[1];
        if (nloc == 0u) { xcd_barrier_complete(bar, b.x, nloc, nx); b.st[0] = nloc; b.st[1] = nx; }
        const unsigned old = xb_add(&bar[XB_XSUB(b.x)], 1u);
        const unsigned gen = old / nloc;
        if (old + 1u == (gen + 1u) * nloc) {
            __builtin_amdgcn_fence(__ATOMIC_RELEASE, "agent");
            asm volatile("s_waitcnt vmcnt(0)" ::: "memory");
            const unsigned og = xb_add(&bar[XB_TOP], 1u);
            const unsigned tg = og / nx;
            if (og + 1u == (tg + 1u) * nx) xb_add(&bar[XB_TOPGEN], 1u);
            else XB_SPIN(xb_ld(&bar[XB_TOPGEN]) == tg, bar);
            __builtin_amdgcn_fence(__ATOMIC_ACQUIRE, "agent");
            xb_add(&bar[XB_XGEN(b.x)], 1u);
            asm volatile("s_waitcnt vmcnt(0)" ::: "memory");
        } else {
            XB_SPIN(xb_ld(&bar[XB_XGEN(b.x)]) == gen, bar);
            __builtin_amdgcn_fence(__ATOMIC_ACQUIRE, "agent");
            asm volatile("s_waitcnt vmcnt(0)" ::: "memory");
        }
    }
    __syncthreads();
}

constexpr int NWAVES = 8, NTHR = 512;
constexpr int DM = 1024, NB = 8, SEQ = 4096, CTXL = 256, DEPTH = 4;
constexpr int NLAT = NB * SEQ, NCTX = NB * CTXL, NT = NLAT + NCTX;
constexpr int PW = 2304;
constexpr int MW = 1280;
constexpr int NEXP = 32, MAXBLK = 576;
constexpr int NCHK = 544;
constexpr int S5ROWS = 2304;
constexpr int PC_FU = 0, PC_S5 = 256, PC_Q = 512, PC_K = 640, PC_V = 768, PC_R = 1024, PC_Z = 1280, PC_XBC = 1536, PC_A1 = 2048, PC_DT = 2080;
enum { I_X = 0, I_C, I_CTX, I_CCTX, I_ADAW, I_ADAB, I_NMG, I_NFG, I_WIN, I_WOUT, I_FOURW, I_S5LRE, I_S5LIM, I_S5LDT, I_S5BRE, I_S5BIM, I_S5CRE, I_S5CIM, I_S5D, I_S5GLU,
       I_GLAA2, I_GLAAB, I_GLANG, I_SSDCW, I_SSDCB, I_SSDALOG, I_SSDDTB, I_SSDD, I_SSDNG, I_RW, I_RB, I_WGU, I_BGU, I_WDN, I_BDN, I_FING, N_IN };

constexpr size_t al256(size_t x) { return (x + 255) & ~(size_t)255; }
constexpr size_t WS_CTL = 0, CTL_BYTES = 1u << 20;
constexpr size_t WS_MOD = WS_CTL + CTL_BYTES;
constexpr size_t WS_TAB = WS_MOD + al256((size_t)DEPTH * 9 * 6144 * 4);
constexpr size_t TAB_F64 = 0, TAB_TW = 16384, TAB_D256 = 16384 + 32768, TAB_BYTES = 65536;
constexpr size_t WS_A16 = WS_TAB + TAB_BYTES;
constexpr size_t WS_WIN = WS_A16 + al256((size_t)DEPTH * 2 * 16 * 64 * 2 * 4);
constexpr size_t WS_WOUT = WS_WIN + (size_t)DEPTH * PW * DM * 2;
constexpr size_t WS_WGLU = WS_WOUT + (size_t)DEPTH * DM * MW * 2;
constexpr size_t WS_S5P = WS_WGLU + (size_t)DEPTH * 256 * 256 * 2;
constexpr size_t WS_S5B2 = WS_S5P + (size_t)DEPTH * 16 * 256 * 256 * 2;
constexpr size_t WS_WGU = WS_S5B2 + (size_t)DEPTH * 16 * 256 * 512 * 2;
constexpr size_t WS_WDN = WS_WGU + (size_t)DEPTH * NEXP * 2048 * DM;
constexpr size_t WS_XS = WS_WDN + (size_t)DEPTH * NEXP * DM * DM;
constexpr size_t WS_H = WS_XS + (size_t)NT * DM * 2;
constexpr size_t WS_PBUF = WS_H + (size_t)NT * DM * 2;
constexpr size_t WS_A2 = WS_PBUF + (size_t)NT * PW * 2;
constexpr size_t WS_S5S = WS_A2 + (size_t)16 * S5ROWS * 512 * 2;
constexpr size_t WS_ACT5 = WS_S5S + (size_t)16 * S5ROWS * 256 * 4;
constexpr size_t WS_MIX = WS_ACT5 + (size_t)NT * 256 * 2;
constexpr size_t WS_GDS = WS_MIX + (size_t)NT * MW * 2;
constexpr size_t WS_GDEC = WS_GDS + (size_t)NCHK * 8 * 2048 * 4;
constexpr size_t WS_GSE = WS_GDEC + al256((size_t)NCHK * 8 * 32 * 4);
constexpr size_t WS_SDS = WS_GSE + (size_t)NCHK * 8 * 2048 * 2;
constexpr size_t WS_SDEC = WS_SDS + (size_t)NCHK * 8 * 4096 * 4;
constexpr size_t WS_SSE = WS_SDEC + al256((size_t)NCHK * 8 * 4);
constexpr size_t WS_PE = WS_SSE + (size_t)NCHK * 8 * 4096 * 2;
constexpr size_t WS_PR = WS_PE + (size_t)NT * 4 * 4;
constexpr size_t WS_PG = WS_PR + (size_t)NT * 4 * 4;
constexpr size_t WS_PS = WS_PG + (size_t)NT * 4 * 4;
constexpr size_t WS_SG = WS_PS + (size_t)NT * 4 * 4;
constexpr size_t WS_H8 = WS_SG + (size_t)MAXBLK * 256 * 4;
constexpr size_t WS_BUF = WS_H8 + (size_t)NT * DM;
constexpr size_t WS_ACT = WS_BUF + (size_t)MAXBLK * 256 * DM;
constexpr size_t WS_Y = WS_ACT + (size_t)MAXBLK * 256 * DM;
constexpr size_t WS_END = WS_Y + (size_t)MAXBLK * 256 * DM * 2;
constexpr int CW_QUEUE = 64;
constexpr int CW_CNT = 1024;
constexpr int CW_BLKE = 2048;
constexpr int CW_BAR = 8192;

constexpr int LDS_BYTES = 163840, MISC_OFF = LDS_BYTES - 256;

constexpr float W8_SCALE = 32.f, H8_SCALE = 8.f, A8_SCALE = 4.f;
__device__ __forceinline__ unsigned pk4f8(float a, float b, float c, float d) { int w = 0; w = __builtin_amdgcn_cvt_pk_fp8_f32(a, b, w, false); w = __builtin_amdgcn_cvt_pk_fp8_f32(c, d, w, true); return (unsigned)w; }
#define RLX_AGENT __ATOMIC_RELAXED, __HIP_MEMORY_SCOPE_AGENT
__device__ __forceinline__ int fresh_tid(int wave0) { int l = (int)__builtin_amdgcn_mbcnt_hi(~0u, __builtin_amdgcn_mbcnt_lo(~0u, 0u)); asm volatile("" : "+v"(l)); return wave0 * 64 + l; }
__device__ __forceinline__ unsigned f2bf(float f) { unsigned u = __builtin_bit_cast(unsigned, f); return (u + 0x7fffu + ((u >> 16) & 1u)) >> 16; }
__device__ __forceinline__ unsigned pk2(float lo, float hi) { return f2bf(lo) | (f2bf(hi) << 16); }
__device__ __forceinline__ float bf2f(unsigned short b) { return __builtin_bit_cast(float, (unsigned)b << 16); }
__device__ __forceinline__ f32x4 bf4(u32x2 w) { return (f32x4){__builtin_bit_cast(float, w.x << 16), __builtin_bit_cast(float, w.x & 0xffff0000u), __builtin_bit_cast(float, w.y << 16), __builtin_bit_cast(float, w.y & 0xffff0000u)}; }
__device__ __forceinline__ float bflo(unsigned w) { return __builtin_bit_cast(float, w << 16); }
__device__ __forceinline__ float bfhi(unsigned w) { return __builtin_bit_cast(float, w & 0xffff0000u); }
template <int M> __device__ __forceinline__ float swz_xor(float v) { return __builtin_bit_cast(float, __builtin_amdgcn_ds_swizzle(__builtin_bit_cast(int, v), (M << 10) | 0x1F)); }
__device__ __forceinline__ float xor32f(float v, int lane) { return __builtin_bit_cast(float, __builtin_amdgcn_ds_bpermute((lane ^ 32) << 2, __builtin_bit_cast(int, v))); }
__device__ __forceinline__ float wave_sum(float v, int lane) { v += swz_xor<1>(v); v += swz_xor<2>(v); v += swz_xor<4>(v); v += swz_xor<8>(v); v += swz_xor<16>(v); v += xor32f(v, lane); return v; }
__device__ __forceinline__ float wave_max(float v, int lane) { v = fmaxf(v, swz_xor<1>(v)); v = fmaxf(v, swz_xor<2>(v)); v = fmaxf(v, swz_xor<4>(v)); v = fmaxf(v, swz_xor<8>(v)); v = fmaxf(v, swz_xor<16>(v)); v = fmaxf(v, xor32f(v, lane)); return v; }
__device__ __forceinline__ float fexp_(float x) { return __builtin_amdgcn_exp2f(1.4426950408889634f * x); }
__device__ __forceinline__ float frcp_(float x) { return __builtin_amdgcn_rcpf(x); }
__device__ __forceinline__ float sigmoidf_(float x) { return frcp_(1.f + fexp_(-x)); }
__device__ __forceinline__ float siluf_(float x) { return x * frcp_(1.f + fexp_(-x)); }

template <class Fill> struct SgOrder {
    int nblk, nN, R, r, lo, hi; Fill f;
    __device__ __forceinline__ void init(int nblk_, int nN_, int G, int c) { nblk = nblk_; nN = nN_; const int U = nblk * nN; int x, nx;
        if ((G & 7) == 0) { R = G >> 3; x = c & 7; r = c >> 3; nx = 8; } else { R = G; x = 0; r = c; nx = 1; }
        lo = (int)(((long)x * U) / nx); hi = (int)(((long)(x + 1) * U) / nx); }
    __device__ __forceinline__ bool next(int& cursor, pg8::Unit& u) const {
        const int q = lo + r + R * cursor; ++cursor;
        if (q >= hi) return false;
        const int ups = 8 * nN, sg = q / ups, ql = q - sg * ups, nb = (nblk - sg * 8) < 8 ? (nblk - sg * 8) : 8;
        u.pm = sg * 8 + ql % nb; u.pn = ql / nb; f(u); return true;
    }
};
struct FillPlain { size_t astep, bstep; __device__ __forceinline__ void operator()(pg8::Unit& u) const { u.grp = 0; u.aoff = (size_t)u.pm * astep; u.boff = (size_t)u.pn * bstep; } };
struct FillS5 { size_t bgrp; __device__ __forceinline__ void operator()(pg8::Unit& u) const { const int g = u.pm / 9, t = u.pm - g * 9; u.grp = g; u.pm = t; u.aoff = ((size_t)g * S5ROWS + (size_t)t * 256) * 512 * 2; u.boff = (size_t)g * bgrp; } };
struct FillMoe { const unsigned* blke; int erows; bool hot = false; __device__ __forceinline__ void operator()(pg8::Unit& u) const { const int e = (int)blke[1 + u.pm]; u.grp = e; u.aoff = hot ? 0 : (size_t)u.pm * 256 * DM; u.boff = hot ? 0 : ((size_t)e * erows + (size_t)u.pn * 256) * DM; } };

using pg8::cvt_pk_bf16;
struct EpiInproj {
    static constexpr bool PERM = true;
    bf16* P; bf16* A2;
    __device__ __forceinline__ void operator()(const f32x4 (&acc)[2][2][4][2], const pg8::Unit& u, int wr, int wc, int fr, int fq) const {
        const int row0 = u.pm * 256 + wr * 64 + fr, col0 = u.pn * 256 + wc * 32 + 8 * fq;
#pragma unroll
        for (int ai = 0; ai < 2; ++ai)
#pragma unroll
            for (int m = 0; m < 4; ++m) {
                const int row = row0 + ai * 128 + m * 16;
#pragma unroll
                for (int bj = 0; bj < 2; ++bj) {
                    const f32x4 v0 = acc[ai][bj][m][0], v1 = acc[ai][bj][m][1];
                    u32x4 w; w.x = cvt_pk_bf16(v0[0], v0[1]); w.y = cvt_pk_bf16(v0[2], v0[3]); w.z = cvt_pk_bf16(v1[0], v1[1]); w.w = cvt_pk_bf16(v1[2], v1[3]);
                    const int col = col0 + bj * 128;
                    if (u.pn == 1) {
                        const int cc = col - 256, g = cc >> 4, hp = cc & 15;
                        const int crow = row < NLAT ? (row >> 4) : (2048 + ((row - NLAT) >> 4)), s = row & 15;
                        *(u32x4*)(A2 + ((size_t)g * S5ROWS + crow) * 512 + s * 16 + hp) = w;
                    } else *(u32x4*)(P + (size_t)row * PW + col) = w;
                }
            }
    }
};
struct EpiOutproj {
    static constexpr bool PERM = true;
    const float* xin; const float* ctxin; bf16* XS; const float* modL; int first;
    __device__ __forceinline__ void operator()(const f32x4 (&acc)[2][2][4][2], const pg8::Unit& u, int wr, int wc, int fr, int fq) const {
        const int rowt = u.pm * 256, bi = rowt < NLAT ? (rowt >> 12) : 8;
        const int row0 = rowt + wr * 64 + fr, col0 = u.pn * 256 + wc * 32 + 8 * fq;
        const float* gate = modL + (size_t)bi * 6144 + 2 * 1024;
        f32x4 gv[2][2];
#pragma unroll
        for (int bj = 0; bj < 2; ++bj)
#pragma unroll
            for (int n = 0; n < 2; ++n) gv[bj][n] = *(const f32x4*)(gate + col0 + bj * 128 + 4 * n);
#pragma unroll
        for (int ai = 0; ai < 2; ++ai)
#pragma unroll
            for (int m = 0; m < 4; ++m) {
                const int row = row0 + ai * 128 + m * 16;
                bf16* dst = XS + (size_t)row * DM;
#pragma unroll
                for (int bj = 0; bj < 2; ++bj) { const int c = col0 + bj * 128; f32x4 x0, x1;
                    if (first) { const float* src = (row < NLAT ? xin + (size_t)row * DM : ctxin + (size_t)(row - NLAT) * DM) + c; x0 = *(const f32x4*)src; x1 = *(const f32x4*)(src + 4); }
                    else { const u32x4 w = *(const u32x4*)(dst + c); x0 = bf4((u32x2){w.x, w.y}); x1 = bf4((u32x2){w.z, w.w}); }
                    x0 += gv[bj][0] * acc[ai][bj][m][0]; x1 += gv[bj][1] * acc[ai][bj][m][1];
                    u32x4 o; o.x = cvt_pk_bf16(x0[0], x0[1]); o.y = cvt_pk_bf16(x0[2], x0[3]); o.z = cvt_pk_bf16(x1[0], x1[1]); o.w = cvt_pk_bf16(x1[2], x1[3]);
                    *(u32x4*)(dst + c) = o; }
            }
    }
};
struct EpiSwiglu {
    static constexpr bool PERM = true;
    unsigned char* ACT; const float* bgu;
    __device__ __forceinline__ void operator()(const f32x4 (&acc)[2][2][4][2], const pg8::Unit& u, int wr, int wc, int fr, int fq) const {
        const int row0 = u.pm * 256 + wr * 64 + fr, i0 = u.pn * 128 + wc * 32 + 8 * fq;
        const float* bb = bgu + (size_t)u.grp * 2048 + 2 * i0;
        const f32x4 b0 = *(const f32x4*)(bb), b1 = *(const f32x4*)(bb + 4), b2 = *(const f32x4*)(bb + 8), b3 = *(const f32x4*)(bb + 12);
        const float bg[8] = {b0[0], b0[2], b1[0], b1[2], b2[0], b2[2], b3[0], b3[2]}, bu[8] = {b0[1], b0[3], b1[1], b1[3], b2[1], b2[3], b3[1], b3[3]};
        constexpr float inv = 1.f / (H8_SCALE * W8_SCALE);
#pragma unroll
        for (int ai = 0; ai < 2; ++ai)
#pragma unroll
            for (int m = 0; m < 4; ++m) {
                const int row = row0 + ai * 128 + m * 16;
                float o[8];
#pragma unroll
                for (int n = 0; n < 2; ++n)
#pragma unroll
                    for (int j = 0; j < 4; ++j) {
                        const int q = 4 * n + j;
                        const float gt = fminf(acc[ai][0][m][n][j] * inv + bg[q], 7.0f);
                        const float up = fminf(fmaxf(acc[ai][1][m][n][j] * inv + bu[q], -7.0f), 7.0f);
                        o[q] = (up + 1.0f) * gt * frcp_(1.f + __builtin_amdgcn_exp2f(-1.702f * 1.4426950408889634f * gt)) * A8_SCALE;
                    }
                u32x2 w; w.x = pk4f8(o[0], o[1], o[2], o[3]); w.y = pk4f8(o[4], o[5], o[6], o[7]);
                *(u32x2*)(ACT + (size_t)row * DM + i0) = w;
            }
    }
};
struct EpiDown {
    static constexpr bool PERM = true;
    bf16* Y; const float* bdn; const float* sg;
    __device__ __forceinline__ void operator()(const f32x4 (&acc)[2][2][4][2], const pg8::Unit& u, int wr, int wc, int fr, int fq) const {
        const int row0 = u.pm * 256 + wr * 64 + fr, col0 = u.pn * 256 + wc * 32 + 8 * fq;
        const float* bb = bdn + (size_t)u.grp * DM + col0;
        constexpr float inv = 1.f / (A8_SCALE * W8_SCALE);
        f32x4 bv[2][2];
#pragma unroll
        for (int bj = 0; bj < 2; ++bj)
#pragma unroll
            for (int n = 0; n < 2; ++n) bv[bj][n] = *(const f32x4*)(bb + bj * 128 + 4 * n);
#pragma unroll
        for (int ai = 0; ai < 2; ++ai)
#pragma unroll
            for (int m = 0; m < 4; ++m) {
                const int row = row0 + ai * 128 + m * 16; const float gt = sg[row];
#pragma unroll
                for (int bj = 0; bj < 2; ++bj) {
                    const f32x4 v0 = (acc[ai][bj][m][0] * inv + bv[bj][0]) * gt, v1 = (acc[ai][bj][m][1] * inv + bv[bj][1]) * gt;
                    u32x4 w; w.x = cvt_pk_bf16(v0[0], v0[1]); w.y = cvt_pk_bf16(v0[2], v0[3]); w.z = cvt_pk_bf16(v1[0], v1[1]); w.w = cvt_pk_bf16(v1[2], v1[3]);
                    *(u32x4*)(Y + (size_t)row * DM + col0 + bj * 128) = w;
                }
            }
    }
};
struct EpiNull { static constexpr bool PERM = true; float* sink;
    __device__ __forceinline__ void operator()(const f32x4 (&acc)[2][2][4][2], const pg8::Unit& u, int wr, int wc, int fr, int fq) const { float s = 0.f;
#pragma unroll
        for (int ai = 0; ai < 2; ++ai)
#pragma unroll
            for (int bj = 0; bj < 2; ++bj)
#pragma unroll
                for (int m = 0; m < 4; ++m)
#pragma unroll
                    for (int n = 0; n < 2; ++n) s += acc[ai][bj][m][n][0];
        if (s == 12345.678f) sink[u.pm] = s; } };
struct EpiS5S {
    static constexpr bool PERM = false;
    float* S;
    __device__ __forceinline__ void operator()(const f32x4 (&acc)[2][2][4][2], const pg8::Unit& u, int wr, int wc, int fr, int fq) const {
        const int row0 = u.pm * 256 + wr * 64 + fr, col0 = wc * 32 + 4 * fq;
        float* base = S + (size_t)u.grp * S5ROWS * 256;
#pragma unroll
        for (int ai = 0; ai < 2; ++ai)
#pragma unroll
            for (int m = 0; m < 4; ++m) { float* rp = base + (size_t)(row0 + ai * 128 + m * 16) * 256 + col0;
#pragma unroll
                for (int bj = 0; bj < 2; ++bj)
#pragma unroll
                    for (int n = 0; n < 2; ++n) *(f32x4*)(rp + bj * 128 + n * 16) = acc[ai][bj][m][n]; }
    }
};
__device__ __forceinline__ float gelu_tanh(float x) { const float t = 0.7978845608f * (x + 0.044715f * x * x * x); return x * frcp_(1.f + fexp_(-2.f * t)); }
struct EpiS5Y {
    static constexpr bool PERM = true;
    bf16* ACT5;
    __device__ __forceinline__ void operator()(const f32x4 (&acc)[2][2][4][2], const pg8::Unit& u, int wr, int wc, int fr, int fq) const {
        const int row0 = u.pm * 256 + wr * 64 + fr, col0 = wc * 32 + 8 * fq;
#pragma unroll
        for (int ai = 0; ai < 2; ++ai)
#pragma unroll
            for (int m = 0; m < 4; ++m) {
                const int crow = row0 + ai * 128 + m * 16;
                if (crow >= 2176) continue;
                const int tok0 = crow < 2048 ? crow * 16 : NLAT + (crow - 2048) * 16;
#pragma unroll
                for (int bj = 0; bj < 2; ++bj) {
                    const int col = col0 + bj * 128, j = col >> 4, h = col & 15;
                    const f32x4 v0 = acc[ai][bj][m][0], v1 = acc[ai][bj][m][1];
                    u32x4 w; w.x = cvt_pk_bf16(gelu_tanh(v0[0]), gelu_tanh(v0[1])); w.y = cvt_pk_bf16(gelu_tanh(v0[2]), gelu_tanh(v0[3]));
                    w.z = cvt_pk_bf16(gelu_tanh(v1[0]), gelu_tanh(v1[1])); w.w = cvt_pk_bf16(gelu_tanh(v1[2]), gelu_tanh(v1[3]));
                    *(u32x4*)(ACT5 + (size_t)(tok0 + j) * 256 + u.grp * 16 + h) = w;
                }
            }
    }
};
struct EpiGlu {
    static constexpr bool PERM = true;
    const bf16* ACT5; bf16* MIX;
    __device__ __forceinline__ void operator()(const f32x4 (&acc)[2][2][4][2], const pg8::Unit& u, int wr, int wc, int fr, int fq) const {
        const int row0 = u.pm * 256 + wr * 64 + fr, col0 = wc * 32 + 8 * fq;
#pragma unroll
        for (int ai = 0; ai < 2; ++ai)
#pragma unroll
            for (int m = 0; m < 4; ++m) {
                const int row = row0 + ai * 128 + m * 16;
#pragma unroll
                for (int bj = 0; bj < 2; ++bj) {
                    const int col = col0 + bj * 128;
                    const u32x4 a = *(const u32x4*)(ACT5 + (size_t)row * 256 + col);
                    const f32x4 v0 = acc[ai][bj][m][0], v1 = acc[ai][bj][m][1];
                    u32x4 w;
                    w.x = cvt_pk_bf16(bflo(a.x) * sigmoidf_(v0[0]), bfhi(a.x) * sigmoidf_(v0[1])); w.y = cvt_pk_bf16(bflo(a.y) * sigmoidf_(v0[2]), bfhi(a.y) * sigmoidf_(v0[3]));
                    w.z = cvt_pk_bf16(bflo(a.z) * sigmoidf_(v1[0]), bfhi(a.z) * sigmoidf_(v1[1])); w.w = cvt_pk_bf16(bflo(a.w) * sigmoidf_(v1[2]), bfhi(a.w) * sigmoidf_(v1[3]));
                    *(u32x4*)(MIX + (size_t)row * MW + 512 + col) = w;
                }
            }
    }
};

struct Args { const float* in[N_IN]; float* out; unsigned char* ws; int ph_lo, ph_hi; };
typedef const __attribute__((address_space(4))) Args CArgs;
__device__ __forceinline__ CArgs* fresh_args() { CArgs* p = (CArgs*)__builtin_amdgcn_kernarg_segment_ptr(); asm volatile("" : "+s"(p)); return p; }
struct Frame {
    LAS unsigned char* lds; volatile LAS unsigned* MISC; unsigned* ctl; unsigned char* ws;
    int tid, lane, wave, G, bid;
};

template <class Map> __device__ __forceinline__ void transpose_tile(const float* W, int ldw, int ncols, int k0, int n0, bf16* WT, int ldt, int kd0, const Map& map, LAS float* scr, int lane) {
    { const int c4 = (lane & 15) * 4, r4 = lane >> 4; const bool ok = n0 + c4 < ncols;
#pragma unroll
      for (int q = 0; q < 16; ++q) { const int kk = q * 4 + r4; const f32x4 v = ok ? *(const f32x4*)(W + (size_t)(k0 + kk) * ldw + n0 + c4) : (f32x4){0.f, 0.f, 0.f, 0.f};
          scr[kk * 65 + c4] = v[0]; scr[kk * 65 + c4 + 1] = v[1]; scr[kk * 65 + c4 + 2] = v[2]; scr[kk * 65 + c4 + 3] = v[3]; } }
    asm volatile("s_waitcnt lgkmcnt(0)" ::: "memory");
    const int c = lane & 7;
#pragma unroll
    for (int j = 0; j < 8; ++j) {
        const int n = (lane >> 3) + 8 * j; const LAS float* s = scr + (8 * c) * 65 + n;
        u32x4 o; o.x = pk2(s[0], s[65]); o.y = pk2(s[2 * 65], s[3 * 65]); o.z = pk2(s[4 * 65], s[5 * 65]); o.w = pk2(s[6 * 65], s[7 * 65]);
        const int dr = (n0 + n) < ncols ? map(n0 + n) : -1;
        if (dr >= 0) *(u32x4*)(WT + (size_t)dr * ldt + kd0 + 8 * c) = o;
    }
    asm volatile("s_waitcnt lgkmcnt(0)" ::: "memory");
}
struct MapId { __device__ __forceinline__ int operator()(int n) const { return n; } };
struct MapWin { __device__ __forceinline__ int operator()(int c) const { return c < 1280 ? c : (c < 1312 ? 2048 + (c - 1280) : (c < 2080 ? c - 32 : c)); } };
struct MapGu { __device__ __forceinline__ int operator()(int n) const { const int i = n >> 1; return (i >> 7) * 256 + (n & 1) * 128 + (i & 127); } };

template <class Map> __device__ __forceinline__ void transpose_tile_f8(const float* W, int ldw, int k0, int n0, unsigned char* WT, int ldt, const Map& map, LAS float* scr, int lane) {
    { const int c4 = (lane & 15) * 4, r4 = lane >> 4;
#pragma unroll
      for (int q = 0; q < 16; ++q) { const int kk = q * 4 + r4; const f32x4 v = *(const f32x4*)(W + (size_t)(k0 + kk) * ldw + n0 + c4);
          scr[kk * 65 + c4] = v[0]; scr[kk * 65 + c4 + 1] = v[1]; scr[kk * 65 + c4 + 2] = v[2]; scr[kk * 65 + c4 + 3] = v[3]; } }
    asm volatile("s_waitcnt lgkmcnt(0)" ::: "memory");
    const int c = lane & 7;
#pragma unroll
    for (int j = 0; j < 8; ++j) {
        const int n = (lane >> 3) + 8 * j; const LAS float* s = scr + (8 * c) * 65 + n;
        u32x2 o; o.x = pk4f8(s[0] * W8_SCALE, s[65] * W8_SCALE, s[2 * 65] * W8_SCALE, s[3 * 65] * W8_SCALE); o.y = pk4f8(s[4 * 65] * W8_SCALE, s[5 * 65] * W8_SCALE, s[6 * 65] * W8_SCALE, s[7 * 65] * W8_SCALE);
        *(u32x2*)(WT + (size_t)map(n0 + n) * ldt + k0 + 8 * c) = o;
    }
    asm volatile("s_waitcnt lgkmcnt(0)" ::: "memory");
}
constexpr int PI_ADA = 48, PI_TAB = 1, PI_S5 = 64, PI_FOLD = 256, PI_ZERO = 4;
constexpr int TW_WIN = 16 * 33, TW_GU = 32 * 16 * 32, TW_DN = 32 * 16 * 16, TW_WOUT = 12 * 16, TW_GLU = 16, TW_LAYER = TW_WIN + TW_GU + TW_DN + TW_WOUT + TW_GLU;
constexpr int PI_TR = (DEPTH * TW_LAYER + 7) / 8;
constexpr int PI_B_TAB = PI_ADA, PI_B_S5 = PI_B_TAB + PI_TAB, PI_B_FOLD = PI_B_S5 + PI_S5, PI_B_ZERO = PI_B_FOLD + PI_FOLD, PI_B_TR = PI_B_ZERO + PI_ZERO, PI_TOTAL = PI_B_TR + (PI_TR + 3) / 4;

__device__ __forceinline__ void pro_adaln(Frame& F, CArgs& a, int it) {
    const int L = it / 12, cb = it % 12;
    LAS float* cond = (LAS float*)F.lds;
    for (int i = F.tid; i < 9 * 1024; i += NTHR) { const int r = i >> 10, k = i & 1023; const float v = r < 8 ? a.in[I_C][r * 1024 + k] : a.in[I_CCTX][k]; cond[i] = siluf_(v); }
    __syncthreads();
    const int n = cb * 512 + F.tid;
    const float* w = a.in[I_ADAW] + (size_t)L * 1024 * 6144 + n;
    float acc[9];
    const float b = a.in[I_ADAB][L * 6144 + n];
#pragma unroll
    for (int r = 0; r < 9; ++r) acc[r] = b;
#pragma unroll 2
    for (int k = 0; k < 1024; k += 4) {
        const float w0 = w[(size_t)k * 6144], w1 = w[(size_t)(k + 1) * 6144], w2 = w[(size_t)(k + 2) * 6144], w3 = w[(size_t)(k + 3) * 6144];
#pragma unroll
        for (int r = 0; r < 9; ++r) { const f32x4 c4 = *(const LAS f32x4*)(cond + r * 1024 + k); acc[r] += c4[0] * w0 + c4[1] * w1 + c4[2] * w2 + c4[3] * w3; }
    }
    float* mod = (float*)(F.ws + WS_MOD) + (size_t)L * 9 * 6144 + n;
#pragma unroll
    for (int r = 0; r < 9; ++r) mod[(size_t)r * 6144] = acc[r];
    __syncthreads();
}
__device__ __forceinline__ void pro_tables(Frame& F) {
    bf16* f64 = (bf16*)(F.ws + WS_TAB + TAB_F64);
    for (int i = F.tid; i < 4096; i += NTHR) { const int k = i >> 6, n = i & 63; float s, c; sincospif((float)((k * n) & 63) / 32.f, &s, &c); f64[i] = (bf16)f2bf(c); f64[4096 + i] = (bf16)f2bf(s); }
    float* tw = (float*)(F.ws + WS_TAB + TAB_TW);
    for (int i = F.tid; i < 4096; i += NTHR) { float s, c; sincospif((float)i / 2048.f, &s, &c); tw[2 * i] = c; tw[2 * i + 1] = s; }
    float* d256 = (float*)(F.ws + WS_TAB + TAB_D256);
    for (int i = F.tid; i < 256; i += NTHR) { float s, c; sincospif((float)i / 128.f, &s, &c); d256[2 * i] = c; d256[2 * i + 1] = s; }
}
__device__ __forceinline__ void pro_fold(Frame& F, CArgs& a, int it) {
    const int L = it >> 6, h = (it >> 4) & 3, nb = it & 15, n0 = nb * 64;
    LAS float* fw = (LAS float*)F.lds;
    LAS float* ct = fw + 64 * 65;
    if (F.tid < 64) ct[F.tid] = cospif((float)F.tid / 32.f);
    const float* four = a.in[I_FOURW] + (size_t)L * 256 * 256, *wo = a.in[I_WOUT] + (size_t)L * 1024 * 1024;
    const int n = F.tid & 63, cg = F.tid >> 6;
    { float s[8];
#pragma unroll
      for (int i = 0; i < 8; ++i) s[i] = 0.f;
      for (int j = 0; j < 256; ++j) { const float wv = wo[(size_t)j * 1024 + n0 + n];
#pragma unroll
          for (int i = 0; i < 8; ++i) s[i] += four[(size_t)(h * 64 + cg * 8 + i) * 256 + j] * wv; }
#pragma unroll
      for (int i = 0; i < 8; ++i) fw[(cg * 8 + i) * 65 + n] = s[i]; }
    __syncthreads();
    float oc[8], os[8];
#pragma unroll
    for (int i = 0; i < 8; ++i) { oc[i] = 0.f; os[i] = 0.f; }
    for (int kc = 0; kc < 64; ++kc) { const float v = fw[kc * 65 + n];
#pragma unroll
        for (int i = 0; i < 8; ++i) { const int mm = (kc * (cg * 8 + i)) & 63; oc[i] += ct[mm] * v; os[i] += ct[(mm + 48) & 63] * v; } }
    bf16* wt = (bf16*)(F.ws + WS_WOUT) + (size_t)L * DM * MW + (size_t)(n0 + n) * MW + h * 64 + cg * 8;
    u32x4 w; w.x = pk2(oc[0] * 0.125f, oc[1] * 0.125f); w.y = pk2(oc[2] * 0.125f, oc[3] * 0.125f); w.z = pk2(oc[4] * 0.125f, oc[5] * 0.125f); w.w = pk2(oc[6] * 0.125f, oc[7] * 0.125f);
    *(u32x4*)wt = w;
    w.x = pk2(os[0] * 0.125f, os[1] * 0.125f); w.y = pk2(os[2] * 0.125f, os[3] * 0.125f); w.z = pk2(os[4] * 0.125f, os[5] * 0.125f); w.w = pk2(os[6] * 0.125f, os[7] * 0.125f);
    *(u32x4*)(wt + 256) = w;
    __syncthreads();
}
__device__ __forceinline__ void pro_s5(Frame& F, CArgs& a, int it) {
    const int L = it >> 4, g = it & 15;
    LAS float* pw = (LAS float*)F.lds;
    LAS float* bb = pw + 2 * 64 * 17 * 2;
    LAS float* cm = bb + 2 * 64 * 16 * 2;
    LAS float* kt = cm + 2 * 16 * 64 * 2;
    for (int i = F.tid; i < 2 * 64 * 17; i += NTHR) {
        const int r = i / (64 * 17), p = (i / 17) & 63, e = i % 17; const size_t q = ((size_t)(L * 2 + r) * 16 + g) * 64 + p;
        const float dt = __expf(a.in[I_S5LDT][(L * 2 + r) * 16 + g]); const float lr = a.in[I_S5LRE][q] * dt, li = a.in[I_S5LIM][q] * dt;
        float s, c; sincosf(li * (float)e, &s, &c); const float m = expf(lr * (float)e); pw[2 * i] = m * c; pw[2 * i + 1] = m * s;
    }
    for (int i = F.tid; i < 2 * 64 * 16; i += NTHR) {
        const int r = i >> 10, p = (i >> 4) & 63, h = i & 15; const size_t q = ((size_t)(L * 2 + r) * 16 + g) * 64 + p;
        const float dt = __expf(a.in[I_S5LDT][(L * 2 + r) * 16 + g]); const float lre = a.in[I_S5LRE][q], lim = a.in[I_S5LIM][q];
        float s, c; sincosf(lim * dt, &s, &c); const float m = expf(lre * dt); const float ar = m * c - 1.f, ai = m * s;
        const float den = 1.f / (lre * lre + lim * lim); const float cr = (ar * lre + ai * lim) * den, ci = (ai * lre - ar * lim) * den;
        const float br = a.in[I_S5BRE][q * 16 + h], bi = a.in[I_S5BIM][q * 16 + h];
        bb[2 * i] = cr * br - ci * bi; bb[2 * i + 1] = cr * bi + ci * br;
    }
    for (int i = F.tid; i < 2 * 16 * 64; i += NTHR) {
        const int r = i >> 10, h = (i >> 6) & 15, p = i & 63; const size_t q = (((size_t)(L * 2 + r) * 16 + g) * 16 + h) * 64 + p;
        cm[2 * i] = a.in[I_S5CRE][q]; cm[2 * i + 1] = a.in[I_S5CIM][q];
    }
    __syncthreads();
    for (int i = F.tid; i < 2 * 16 * 256; i += NTHR) {
        const int r = i >> 12, tau = (i >> 8) & 15, h = (i >> 4) & 15, hp = i & 15; float s = 0.f;
        for (int p = 0; p < 64; ++p) { const float cr = cm[2 * ((r * 16 + h) * 64 + p)], ci = cm[2 * ((r * 16 + h) * 64 + p) + 1];
            const float ar = pw[2 * ((r * 64 + p) * 17 + tau)], ai = pw[2 * ((r * 64 + p) * 17 + tau) + 1]; const float br = bb[2 * ((r * 64 + p) * 16 + hp)], bi = bb[2 * ((r * 64 + p) * 16 + hp) + 1];
            const float tr = cr * ar - ci * ai, ti = cr * ai + ci * ar; s += tr * br - ti * bi; }
        kt[i] = s;
    }
    __syncthreads();
    bf16* pt = (bf16*)(F.ws + WS_S5P) + (size_t)(L * 16 + g) * 256 * 256;
    for (int i = F.tid; i < 65536; i += NTHR) {
        const int np = i >> 8, k = i & 255, r = np >> 7, cpx = (np >> 6) & 1, p = np & 63, s = k >> 4, hp = k & 15, e = r ? s : 15 - s;
        const float ar = pw[2 * ((r * 64 + p) * 17 + e)], ai = pw[2 * ((r * 64 + p) * 17 + e) + 1]; const float br = bb[2 * ((r * 64 + p) * 16 + hp)], bi = bb[2 * ((r * 64 + p) * 16 + hp) + 1];
        pt[i] = (bf16)f2bf(cpx ? ar * bi + ai * br : ar * br - ai * bi);
    }
    bf16* b2 = (bf16*)(F.ws + WS_S5B2) + (size_t)(L * 16 + g) * 256 * 512;
    const float* dsk = a.in[I_S5D] + L * 256 + g * 16;
    for (int i = F.tid; i < 131072; i += NTHR) {
        const int n = i >> 9, k = i & 511, j = n >> 4, h = n & 15; float v;
        if (k < 256) { const int s = k >> 4, hp = k & 15; v = 0.f;
            if (j >= s) v += kt[((0 * 16 + (j - s)) * 16 + h) * 16 + hp];
            if (j <= s) v += kt[((1 * 16 + (s - j)) * 16 + h) * 16 + hp];
            if (j == s && h == hp) v += dsk[h];
        } else { const int kk = k - 256, r = kk >> 7, cpx = (kk >> 6) & 1, p = kk & 63, e = r ? 16 - j : j + 1;
            const float cr = cm[2 * ((r * 16 + h) * 64 + p)], ci = cm[2 * ((r * 16 + h) * 64 + p) + 1]; const float ar = pw[2 * ((r * 64 + p) * 17 + e)], ai = pw[2 * ((r * 64 + p) * 17 + e) + 1];
            v = cpx ? -(cr * ai + ci * ar) : (cr * ar - ci * ai); }
        b2[i] = (bf16)f2bf(v);
    }
    float* a16 = (float*)(F.ws + WS_A16) + (size_t)((L * 2) * 16 + g) * 128;
    if (F.tid < 128) { const int r = F.tid >> 6, p = F.tid & 63; float* o = a16 + (size_t)r * 16 * 128 + p * 2; o[0] = pw[2 * ((r * 64 + p) * 17 + 16)]; o[1] = pw[2 * ((r * 64 + p) * 17 + 16) + 1]; }
    __syncthreads();
}
__device__ __forceinline__ void pro_transposes(Frame& F, CArgs& a, int wg_item) {
    LAS float* scr = (LAS float*)F.lds + F.wave * (64 * 65);
    const int wi = wg_item * 8 + F.wave;
    if (wi >= DEPTH * TW_LAYER) return;
    const int L = wi / TW_LAYER; int r = wi % TW_LAYER;
    if (r < TW_WIN) { const int kb = r / 33, nb = r % 33; transpose_tile(fresh_args()->in[I_WIN] + (size_t)L * DM * 2088, 2088, 2088, kb * 64, nb * 64, (bf16*)(F.ws + WS_WIN) + (size_t)L * PW * DM, DM, kb * 64, MapWin(), scr, F.lane); return; } r -= TW_WIN;
    if (r < TW_GU) { const int e = r >> 9, kb = (r >> 5) & 15, nb = r & 31; transpose_tile_f8(fresh_args()->in[I_WGU] + ((size_t)L * NEXP + e) * DM * 2048, 2048, kb * 64, nb * 64, (unsigned char*)(F.ws + WS_WGU) + ((size_t)L * NEXP + e) * 2048 * DM, DM, MapGu(), scr, F.lane); return; } r -= TW_GU;
    if (r < TW_DN) { const int e = r >> 8, kb = (r >> 4) & 15, nb = r & 15; transpose_tile_f8(fresh_args()->in[I_WDN] + ((size_t)L * NEXP + e) * DM * DM, DM, kb * 64, nb * 64, (unsigned char*)(F.ws + WS_WDN) + ((size_t)L * NEXP + e) * DM * DM, DM, MapId(), scr, F.lane); return; } r -= TW_DN;
    if (r < TW_WOUT) { const int kb = r >> 4, nb = r & 15; transpose_tile(fresh_args()->in[I_WOUT] + (size_t)L * DM * DM + (size_t)256 * DM, DM, DM, kb * 64, nb * 64, (bf16*)(F.ws + WS_WOUT) + (size_t)L * DM * MW, MW, 512 + kb * 64, MapId(), scr, F.lane); return; } r -= TW_WOUT;
    { const int kb = r >> 2, nb = r & 3; transpose_tile(fresh_args()->in[I_S5GLU] + (size_t)L * 256 * 256, 256, 256, kb * 64, nb * 64, (bf16*)(F.ws + WS_WGLU) + (size_t)L * 256 * 256, 256, kb * 64, MapId(), scr, F.lane); }
}
__device__ __forceinline__ void p_prologue(Frame& F0, CArgs& a, int qw = CW_QUEUE) {
    for (;;) {
        if (F0.tid == 0) F0.MISC[0] = __hip_atomic_fetch_add(F0.ctl + qw, 1u, RLX_AGENT);
        __syncthreads();
        const int it = (int)F0.MISC[0];
        __syncthreads();
        if (it >= PI_TOTAL) break;
        Frame F = F0; { const int t_ = fresh_tid(F.wave); F.tid = t_; F.lane = t_ & 63; }
        if (it < PI_B_TAB) pro_adaln(F, *fresh_args(), it);
        else if (it < PI_B_S5) pro_tables(F);
        else if (it < PI_B_FOLD) pro_s5(F, *fresh_args(), it - PI_B_S5);
        else if (it < PI_B_ZERO) pro_fold(F, *fresh_args(), it - PI_B_FOLD);
        else if (it < PI_B_TR) { const int L = it - PI_B_ZERO; u32x4* z = (u32x4*)((bf16*)(F.ws + WS_WIN) + (size_t)L * PW * DM + (size_t)2088 * DM); for (int i = F.tid; i < (PW - 2088) * DM / 8; i += NTHR) z[i] = (u32x4){0u, 0u, 0u, 0u}; }
        else { for (int q = 0; q < 4; ++q) pro_transposes(F, *fresh_args(), (it - PI_B_TR) * 4 + q); }
    }
}

__device__ __forceinline__ void p_norm1(Frame& F, CArgs& a, int L, bool dry = false) {
    const int gw = F.bid * NWAVES + F.wave, NGW = F.G * NWAVES;
    bf16* XS = (bf16*)(F.ws + WS_XS); bf16* H = (bf16*)(F.ws + WS_H);
    const float* mod = (const float*)(F.ws + WS_MOD) + (size_t)L * 9 * 6144; const float* modp = mod - 9 * 6144;
    const int* PS = (const int*)(F.ws + WS_PS); const bf16* Y = (const bf16*)(F.ws + WS_Y);
    const float* g = a.in[I_NMG] + L * DM;
    const float* xin = a.in[I_X]; const float* cin = a.in[I_CTX];
    f32x4 gv[4];
#pragma unroll
    for (int j = 0; j < 4; ++j) gv[j] = *(const f32x4*)(g + 4 * F.lane + 256 * j);
    f32x4 xn[4]; u32x2 xb[4]; u32x2 yn[4][4]; int psn[4] = {0, 0, 0, 0};
#define N1_LOADX(dst, row) do { if (L == 0) { const float* s_ = (row) < NLAT ? xin + (size_t)(row) * DM : cin + (size_t)((row) - NLAT) * DM; _Pragma("unroll") for (int j = 0; j < 4; ++j) dst[j] = *(const f32x4*)(s_ + 4 * F.lane + 256 * j); } \
        else { const bf16* s_ = XS + (size_t)(row) * DM; _Pragma("unroll") for (int j = 0; j < 4; ++j) xb[j] = *(const u32x2*)(s_ + 4 * F.lane + 256 * j); } } while (0)
#define N1_LOADY(dst, ps) do { _Pragma("unroll") for (int k = 0; k < 4; ++k) { const bf16* yr_ = Y + (size_t)(ps)[k] * DM; _Pragma("unroll") for (int j = 0; j < 4; ++j) dst[k][j] = *(const u32x2*)(yr_ + 4 * F.lane + 256 * j); } } while (0)
#define N1_LOADPS(dst, row) do { const int4 p_ = *(const int4*)(PS + (size_t)(row) * 4); dst[0] = p_.x; dst[1] = p_.y; dst[2] = p_.z; dst[3] = p_.w; } while (0)
    int row = gw;
    if (row < NT) { N1_LOADX(xn, row); if (L > 0) { N1_LOADPS(psn, row); N1_LOADY(yn, psn); if (row + NGW < NT) N1_LOADPS(psn, row + NGW); } }
    while (row < NT) {
        const int nrow = row + NGW; const int bi = row < NLAT ? (row >> 12) : 8;
        f32x4 v[4]; u32x2 yc[4][4];
#pragma unroll
        for (int j = 0; j < 4; ++j) { v[j] = (L == 0) ? xn[j] : bf4(xb[j]);
#pragma unroll
            for (int k = 0; k < 4; ++k) yc[k][j] = yn[k][j]; }
        if (nrow < NT) { N1_LOADX(xn, nrow); if (L > 0) { N1_LOADY(yn, psn); if (nrow + NGW < NT) N1_LOADPS(psn, nrow + NGW); } }
        if (L > 0) {
            bf16* xr = XS + (size_t)row * DM; const float* m5 = modp + (size_t)bi * 6144 + 5 * 1024;
#pragma unroll
            for (int j = 0; j < 4; ++j) { f32x4 s = (f32x4){0.f, 0.f, 0.f, 0.f};
#pragma unroll
                for (int k = 0; k < 4; ++k) s += (f32x4){bflo(yc[k][j].x), bfhi(yc[k][j].x), bflo(yc[k][j].y), bfhi(yc[k][j].y)};
                v[j] += *(const f32x4*)(m5 + 4 * F.lane + 256 * j) * s; if (!dry) { u32x2 w; w.x = pk2(v[j][0], v[j][1]); w.y = pk2(v[j][2], v[j][3]); *(u32x2*)(xr + 4 * F.lane + 256 * j) = w; } }
        }
        float ss = 0.f;
#pragma unroll
        for (int j = 0; j < 4; ++j) ss += v[j][0] * v[j][0] + v[j][1] * v[j][1] + v[j][2] * v[j][2] + v[j][3] * v[j][3];
        const float rs = rsqrtf(wave_sum(ss, F.lane) * (1.f / DM) + 1e-6f);
        const float* sh = mod + (size_t)bi * 6144, *sc = sh + 1024;
        bf16* hr = H + (size_t)row * DM;
#pragma unroll
        for (int j = 0; j < 4; ++j) { const f32x4 s4 = *(const f32x4*)(sc + 4 * F.lane + 256 * j), h4 = *(const f32x4*)(sh + 4 * F.lane + 256 * j);
            const f32x4 o = v[j] * rs * gv[j] * (s4 + 1.f) + h4; u32x2 w; w.x = pk2(o[0], o[1]); w.y = pk2(o[2], o[3]); if (!dry) *(u32x2*)(hr + 4 * F.lane + 256 * j) = w; else if (o[0] == 12345.678f) *(u32x2*)(hr + 4 * F.lane + 256 * j) = w; }
        row = nrow;
    }
#undef N1_LOADX
#undef N1_LOADY
#undef N1_LOADPS
}
__device__ __forceinline__ void p_norm2(Frame& F, CArgs& a, int L, int nrows, int cw = CW_CNT) {
    LAS float* rwt = (LAS float*)F.lds;
    LAS unsigned* lcnt = (LAS unsigned*)(F.lds + 32 * 1024 * 4);
    if (F.tid < 64) lcnt[F.tid] = 0u;
    const float* rw = a.in[I_RW] + (size_t)L * DM * NEXP;
    for (int i = F.tid; i < DM * NEXP; i += NTHR) { const int k = i >> 5, e = i & 31; rwt[e * 1024 + k] = rw[i]; }
    __syncthreads();
    const int gw = F.bid * NWAVES + F.wave, NGW = F.G * NWAVES;
    const bf16* XS = (const bf16*)(F.ws + WS_XS); unsigned char* H8 = (unsigned char*)(F.ws + WS_H8);
    const float* mod = (const float*)(F.ws + WS_MOD) + (size_t)L * 9 * 6144;
    int* PE = (int*)(F.ws + WS_PE); int* PR = (int*)(F.ws + WS_PR); float* PG = (float*)(F.ws + WS_PG);
    unsigned* cnt = F.ctl + cw + L * 64;
    const float* g = a.in[I_NFG] + L * DM;
    const float rb = a.in[I_RB][L * NEXP + (F.lane >> 1)];
    f32x4 gv[4];
#pragma unroll
    for (int j = 0; j < 4; ++j) gv[j] = *(const f32x4*)(g + 4 * F.lane + 256 * j);
    u32x2 xn[4];
    if (gw < nrows) {
#pragma unroll
        for (int j = 0; j < 4; ++j) xn[j] = *(const u32x2*)(XS + (size_t)gw * DM + 4 * F.lane + 256 * j); }
    for (int row = gw; row < nrows; row += NGW) {
        const int bi = row < NLAT ? (row >> 12) : 8;
        f32x4 v[4]; float ss = 0.f;
#pragma unroll
        for (int j = 0; j < 4; ++j) { v[j] = bf4(xn[j]); ss += v[j][0] * v[j][0] + v[j][1] * v[j][1] + v[j][2] * v[j][2] + v[j][3] * v[j][3]; }
        if (row + NGW < nrows) {
#pragma unroll
            for (int j = 0; j < 4; ++j) xn[j] = *(const u32x2*)(XS + (size_t)(row + NGW) * DM + 4 * F.lane + 256 * j); }
        const float rs = rsqrtf(wave_sum(ss, F.lane) * (1.f / DM) + 1e-6f);
        const float* sh = mod + (size_t)bi * 6144 + 3 * 1024, *sc = sh + 1024;
        unsigned char* hr = H8 + (size_t)row * DM;
#pragma unroll
        for (int j = 0; j < 4; ++j) { const f32x4 s4 = *(const f32x4*)(sc + 4 * F.lane + 256 * j), h4 = *(const f32x4*)(sh + 4 * F.lane + 256 * j);
            v[j] = v[j] * rs * gv[j] * (s4 + 1.f) + h4; *(unsigned*)(hr + 4 * F.lane + 256 * j) = pk4f8(v[j][0] * H8_SCALE, v[j][1] * H8_SCALE, v[j][2] * H8_SCALE, v[j][3] * H8_SCALE); }
        float p[32];
#pragma unroll
        for (int e = 0; e < 32; ++e) { float s = 0.f;
#pragma unroll
            for (int j = 0; j < 4; ++j) { const f32x4 w4 = *(const LAS f32x4*)(rwt + e * 1024 + 4 * F.lane + 256 * j); s += v[j][0] * w4[0] + v[j][1] * w4[1] + v[j][2] * w4[2] + v[j][3] * w4[3]; }
            p[e] = s; if ((e & 3) == 3) asm volatile("" : "+v"(p[e]), "+v"(p[e - 1]), "+v"(p[e - 2]), "+v"(p[e - 3]) :: "memory"); }
#define RED_LEVEL(NKEEP, BIT, XCH) { const bool hi = (F.lane & (BIT)) != 0; _Pragma("unroll") for (int e = 0; e < (NKEEP); ++e) { const float send = hi ? p[e] : p[e + (NKEEP)], keep = hi ? p[e + (NKEEP)] : p[e]; p[e] = keep + XCH; } }
        RED_LEVEL(16, 32, xor32f(send, F.lane)) RED_LEVEL(8, 16, swz_xor<16>(send)) RED_LEVEL(4, 8, swz_xor<8>(send)) RED_LEVEL(2, 4, swz_xor<4>(send)) RED_LEVEL(1, 2, swz_xor<2>(send))
#undef RED_LEVEL
        float logit = p[0] + swz_xor<1>(p[0]) + rb;
        int es[4]; float ls[4];
#pragma unroll
        for (int k = 0; k < 4; ++k) {
            const float m = wave_max(logit, F.lane);
            const unsigned long long bal = __ballot(logit == m);
            const int fl = __builtin_ctzll(bal); es[k] = fl >> 1; ls[k] = m;
            if ((F.lane >> 1) == es[k]) logit = -3.0e38f;
        }
        const float e1 = __expf(ls[1] - ls[0]), e2 = __expf(ls[2] - ls[0]), e3 = __expf(ls[3] - ls[0]); const float inv = 1.f / (1.f + e1 + e2 + e3);
        if (F.lane < 4) {
            const int e = F.lane == 0 ? es[0] : (F.lane == 1 ? es[1] : (F.lane == 2 ? es[2] : es[3]));
            const float gt = (F.lane == 0 ? 1.f : (F.lane == 1 ? e1 : (F.lane == 2 ? e2 : e3))) * inv;
            const unsigned rk = __hip_atomic_fetch_add(lcnt + e, 1u, __ATOMIC_RELAXED, __HIP_MEMORY_SCOPE_WORKGROUP);
            PE[row * 4 + F.lane] = e; PR[row * 4 + F.lane] = (int)rk; PG[row * 4 + F.lane] = gt;
        }
    }
    __syncthreads();
    if (F.tid < 32) lcnt[32 + F.tid] = __hip_atomic_fetch_add(cnt + F.tid, lcnt[F.tid], RLX_AGENT);
    __syncthreads();
    for (int row = gw; row < nrows; row += NGW) { if (F.lane < 4) { const int i = row * 4 + F.lane; PR[i] += (int)lcnt[32 + PE[i]]; } }
    __syncthreads();
}
__device__ __forceinline__ void p_dispatch(Frame& F, int L, int nrows) {
    LAS int* base = (LAS int*)F.lds;
    unsigned* cnt = F.ctl + CW_CNT + L * 64; unsigned* blke = F.ctl + CW_BLKE + L * 1024;
    if (F.tid == 0) { int acc = 0; for (int e = 0; e < NEXP; ++e) { base[e] = acc; const int c = (int)__hip_atomic_load(cnt + e, RLX_AGENT); acc += (c + 255) & ~255; } base[32] = acc; }
    __syncthreads();
    if (F.bid == 0) { const int nblk = base[32] >> 8; if (F.tid == 0) blke[0] = (unsigned)nblk;
        for (int i = F.tid; i < nblk; i += NTHR) { int e = 0; for (int q = 1; q < NEXP; ++q) if (base[q] <= i * 256) e = q; blke[1 + i] = (unsigned)e; } }
    const int gw = F.bid * NWAVES + F.wave, NGW = F.G * NWAVES;
    const int* PE = (const int*)(F.ws + WS_PE); const int* PR = (const int*)(F.ws + WS_PR); const float* PG = (const float*)(F.ws + WS_PG);
    int* PS = (int*)(F.ws + WS_PS); float* SG = (float*)(F.ws + WS_SG);
    const unsigned char* H8 = (const unsigned char*)(F.ws + WS_H8); unsigned char* BUF = (unsigned char*)(F.ws + WS_BUF);
    for (int pr = gw; pr < nrows * 4; pr += NGW) {
        const int e = PE[pr], slot = base[e] + PR[pr];
        const u32x4* src = (const u32x4*)(H8 + (size_t)(pr >> 2) * DM); u32x4* dst = (u32x4*)(BUF + (size_t)slot * DM);
        dst[F.lane] = src[F.lane];
        if (F.lane == 0) { PS[pr] = slot; SG[slot] = PG[pr]; }
    }
    __syncthreads();
}
__device__ __forceinline__ void p_final(Frame& F, CArgs& a) {
    const int gw = F.bid * NWAVES + F.wave, NGW = F.G * NWAVES;
    const bf16* XS = (const bf16*)(F.ws + WS_XS);
    const float* modp = (const float*)(F.ws + WS_MOD) + (size_t)(DEPTH - 1) * 9 * 6144;
    const int* PS = (const int*)(F.ws + WS_PS); const bf16* Y = (const bf16*)(F.ws + WS_Y);
    const float* g = a.in[I_FING];
    f32x4 gv[4];
#pragma unroll
    for (int j = 0; j < 4; ++j) gv[j] = *(const f32x4*)(g + 4 * F.lane + 256 * j);
    for (int row = gw; row < NLAT; row += NGW) {
        const int bi = row >> 12;
        const bf16* xr = XS + (size_t)row * DM;
        f32x4 v[4], s[4];
#pragma unroll
        for (int j = 0; j < 4; ++j) { v[j] = bf4(*(const u32x2*)(xr + 4 * F.lane + 256 * j)); s[j] = (f32x4){0.f, 0.f, 0.f, 0.f}; }
#pragma unroll
        for (int k = 0; k < 4; ++k) { const int slot = PS[row * 4 + k]; const bf16* yr = Y + (size_t)slot * DM;
#pragma unroll
            for (int j = 0; j < 4; ++j) { const u32x2 w = *(const u32x2*)(yr + 4 * F.lane + 256 * j); s[j] += (f32x4){bflo(w.x), bfhi(w.x), bflo(w.y), bfhi(w.y)}; } }
        const float* m5 = modp + (size_t)bi * 6144 + 5 * 1024;
        float ss = 0.f;
#pragma unroll
        for (int j = 0; j < 4; ++j) { v[j] += *(const f32x4*)(m5 + 4 * F.lane + 256 * j) * s[j]; ss += v[j][0] * v[j][0] + v[j][1] * v[j][1] + v[j][2] * v[j][2] + v[j][3] * v[j][3]; }
        const float rs = rsqrtf(wave_sum(ss, F.lane) * (1.f / DM) + 1e-6f);
        float* orow = a.out + (size_t)row * DM;
#pragma unroll
        for (int j = 0; j < 4; ++j) *(f32x4*)(orow + 4 * F.lane + 256 * j) = v[j] * rs * gv[j];
    }
}

#define MFMA16(a, b, c) __builtin_amdgcn_mfma_f32_16x16x32_bf16((a), (b), (c), 0, 0, 0)
typedef short v4i16_t __attribute__((ext_vector_type(4)));
__device__ __forceinline__ s16x4 trread(const LAS void* p) { return __builtin_bit_cast(s16x4, __builtin_amdgcn_ds_read_tr16_b64_v4i16((LAS v4i16_t*)p)); }
__device__ __forceinline__ bf16x8 cat8(s16x4 a, s16x4 b) { return __builtin_shufflevector(a, b, 0, 1, 2, 3, 4, 5, 6, 7); }
__device__ __forceinline__ bf16x8 pack8(const float* v) { u32x4 w; w.x = pg8::cvt_pk_bf16(v[0], v[1]); w.y = pg8::cvt_pk_bf16(v[2], v[3]); w.z = pg8::cvt_pk_bf16(v[4], v[5]); w.w = pg8::cvt_pk_bf16(v[6], v[7]); return __builtin_bit_cast(bf16x8, w); }
__device__ __forceinline__ void unpack8(bf16x8 x, float* v) { const u32x4 w = __builtin_bit_cast(u32x4, x); v[0] = bflo(w.x); v[1] = bfhi(w.x); v[2] = bflo(w.y); v[3] = bfhi(w.y); v[4] = bflo(w.z); v[5] = bfhi(w.z); v[6] = bflo(w.w); v[7] = bfhi(w.w); }
#define OPQ(x) ({ int o_ = (x); asm volatile("" : "+s"(o_)); o_; })
#define LAUNDER_F(F0) Frame F = F0; { const int t_ = fresh_tid(F.wave); F.tid = t_; F.lane = t_ & 63; }
__device__ __forceinline__ int chunk_tok0(int cid) { return cid < 512 ? cid * 64 : NLAT + (cid - 512) * 64; }

constexpr int GL_QS = 136, GL_VS = 264, GL_BS = 260;
constexpr int GL_Q = 0, GL_K = GL_Q + 64 * GL_QS * 2, GL_V = GL_K + 64 * GL_QS * 2, GL_A1 = GL_V + 64 * GL_VS * 2, GL_B = GL_A1 + 64 * 32 * 2, GL_END = GL_B + 64 * GL_BS * 4;
static_assert(GL_END <= MISC_OFF, "GLA LDS");
template <bool OUT> __device__ __forceinline__ void gla_chunk(Frame& F0, CArgs& a, int L, int cid) {
    LAUNDER_F(F0)
    const int tok0 = chunk_tok0(cid);
    const bf16* P = (const bf16*)(F.ws + WS_PBUF) + (size_t)tok0 * PW;
    LAS bf16* sq = (LAS bf16*)(F.lds + GL_Q); LAS bf16* sk = (LAS bf16*)(F.lds + GL_K); LAS bf16* sv = (LAS bf16*)(F.lds + GL_V); LAS bf16* sa1 = (LAS bf16*)(F.lds + GL_A1); LAS float* sB = (LAS float*)(F.lds + GL_B);
    __syncthreads();
    {   u32x4 rq[2], rk[2], rv[4], ra = (u32x4){0u, 0u, 0u, 0u};
#pragma unroll
        for (int k = 0; k < 2; ++k) { const int i = F.tid + k * NTHR, t = i >> 4, pc = i & 15; rq[k] = *(const u32x4*)(P + (size_t)t * PW + PC_Q + pc * 8); rk[k] = *(const u32x4*)(P + (size_t)t * PW + PC_K + pc * 8); }
#pragma unroll
        for (int k = 0; k < 4; ++k) { const int i = F.tid + k * NTHR, t = i >> 5, pc = i & 31; rv[k] = *(const u32x4*)(P + (size_t)t * PW + PC_V + pc * 8); }
        if (F.tid < 256) { const int t = F.tid >> 2, pc = F.tid & 3; ra = *(const u32x4*)(P + (size_t)t * PW + PC_A1 + pc * 8); }
#pragma unroll
        for (int k = 0; k < 2; ++k) { const int i = F.tid + k * NTHR, t = i >> 4, pc = i & 15; *(LAS u32x4*)(sq + t * GL_QS + pc * 8) = rq[k]; *(LAS u32x4*)(sk + t * GL_QS + pc * 8) = rk[k]; }
#pragma unroll
        for (int k = 0; k < 4; ++k) { const int i = F.tid + k * NTHR, t = i >> 5, pc = i & 31; *(LAS u32x4*)(sv + t * GL_VS + pc * 8) = rv[k]; }
        if (F.tid < 256) { const int t = F.tid >> 2, pc = F.tid & 3; *(LAS u32x4*)(sa1 + t * 32 + pc * 8) = ra; }
    }
    __syncthreads();
    {
        const int col = F.tid & 255, r = col >> 7, c = col & 127, th = F.tid >> 8;
        float a2v[16];
#pragma unroll
        for (int i = 0; i < 16; ++i) a2v[i] = a.in[I_GLAA2][((size_t)(L * 2 + r) * 16 + i) * 128 + c];
        const float ab = a.in[I_GLAAB][(L * 2 + r) * 128 + c];
        for (int i = 0; i < 32; ++i) { const int t = th * 32 + i; float z = ab; float av[8];
            unpack8(*(const LAS bf16x8*)(sa1 + t * 32 + r * 16), av);
#pragma unroll
            for (int q = 0; q < 8; ++q) z += av[q] * a2v[q];
            unpack8(*(const LAS bf16x8*)(sa1 + t * 32 + r * 16 + 8), av);
#pragma unroll
            for (int q = 0; q < 8; ++q) z += av[q] * a2v[8 + q];
            const float ls = fminf(z, 0.f) - __logf(1.f + __expf(-fabsf(z)));
            sB[t * GL_BS + col] = ls * (1.f / 16.f); }
    }
    __syncthreads();
    if (F.tid < 256) { const int col = F.tid, r = col >> 7; float b = 0.f;
        for (int i = 0; i < 64; ++i) { const int t = r ? 63 - i : i; b += sB[t * GL_BS + col]; sB[t * GL_BS + col] = b; } }
    __syncthreads();
    const int hh = F.wave & 3, r = F.wave >> 2, lr = F.lane & 15, g = F.lane >> 4;
    const int bc = r * 128 + hh * 32;
    const size_t ub = ((size_t)cid * 4 + hh) * 2 + r;
    if constexpr (!OUT) {
        const int tl = r ? 0 : 63;
        f32x4 acc[2][4];
#pragma unroll
        for (int mc = 0; mc < 2; ++mc)
#pragma unroll
            for (int d = 0; d < 4; ++d) acc[mc][d] = (f32x4){0.f, 0.f, 0.f, 0.f};
#pragma unroll
        for (int sg = 0; sg < 2; ++sg) {
            bf16x8 vf[4];
#pragma unroll
            for (int d = 0; d < 4; ++d) { const LAS bf16* p0 = sv + (32 * sg + 8 * g + ((F.lane & 15) >> 2)) * GL_VS + hh * 64 + 16 * d + 4 * (F.lane & 3); vf[d] = cat8(trread(p0), trread(p0 + 4 * GL_VS)); }
#pragma unroll
            for (int mc = 0; mc < 2; ++mc) {
                const LAS bf16* p0 = sk + (32 * sg + 8 * g + ((F.lane & 15) >> 2)) * GL_QS + hh * 32 + 16 * mc + 4 * (F.lane & 3);
                const s16x4 k0 = trread(p0), k1 = trread(p0 + 4 * GL_QS);
                const int c = 16 * mc + lr; const float bl = sB[tl * GL_BS + bc + c];
                float kv[8];
#pragma unroll
                for (int e = 0; e < 4; ++e) { kv[e] = bf2f((unsigned short)k0[e]) * __expf(bl - sB[(32 * sg + 8 * g + e) * GL_BS + bc + c]); kv[4 + e] = bf2f((unsigned short)k1[e]) * __expf(bl - sB[(32 * sg + 8 * g + 4 + e) * GL_BS + bc + c]); }
                const bf16x8 kf = pack8(kv);
#pragma unroll
                for (int d = 0; d < 4; ++d) acc[mc][d] = MFMA16(kf, vf[d], acc[mc][d]);
            }
        }
        float* ds = (float*)(F.ws + WS_GDS) + ub * 2048;
#pragma unroll
        for (int mc = 0; mc < 2; ++mc)
#pragma unroll
            for (int d = 0; d < 4; ++d) *(f32x4*)(ds + (16 * d + lr) * 32 + 16 * mc + 4 * g) = acc[mc][d];
        if (F.lane < 32) ((float*)(F.ws + WS_GDEC))[ub * 32 + F.lane] = __expf(sB[tl * GL_BS + bc + F.lane]);
    } else {
        bf16x8 qf[4], kf[4];
#pragma unroll
        for (int m = 0; m < 4; ++m) { const int t = 16 * m + lr; float qv[8], kv[8], bv[8];
            unpack8(*(const LAS bf16x8*)(sq + t * GL_QS + hh * 32 + 8 * g), qv); unpack8(*(const LAS bf16x8*)(sk + t * GL_QS + hh * 32 + 8 * g), kv);
            *(f32x4*)bv = *(const LAS f32x4*)(sB + t * GL_BS + bc + 8 * g); *(f32x4*)(bv + 4) = *(const LAS f32x4*)(sB + t * GL_BS + bc + 8 * g + 4);
#pragma unroll
            for (int e = 0; e < 8; ++e) { const float ex = __expf(bv[e]); qv[e] *= 0.17677669529663687f * ex; kv[e] *= __frcp_rn(ex); }
            qf[m] = pack8(qv); kf[m] = pack8(kv); }
        f32x4 o[4][4];
#pragma unroll
        for (int m = 0; m < 4; ++m)
#pragma unroll
            for (int d = 0; d < 4; ++d) o[m][d] = (f32x4){0.f, 0.f, 0.f, 0.f};
        {
            const bf16* se = (const bf16*)(F.ws + WS_GSE) + ub * 2048;
#pragma unroll
            for (int d = 0; d < 4; ++d) { const bf16x8 sf = *(const bf16x8*)(se + (16 * d + lr) * 32 + 8 * g);
#pragma unroll
                for (int m = 0; m < 4; ++m) o[m][d] = MFMA16(qf[m], sf, o[m][d]); }
        }
        bf16x8 vf[2][4];
#pragma unroll
        for (int sg = 0; sg < 2; ++sg)
#pragma unroll
            for (int d = 0; d < 4; ++d) { const LAS bf16* p0 = sv + (32 * sg + 4 * g + ((F.lane & 15) >> 2)) * GL_VS + hh * 64 + 16 * d + 4 * (F.lane & 3); vf[sg][d] = cat8(trread(p0), trread(p0 + 16 * GL_VS)); }
        const f32x4 zero4 = (f32x4){0.f, 0.f, 0.f, 0.f};
#pragma unroll
        for (int m = 0; m < 4; ++m) {
            const int t = 16 * m + lr;
#pragma unroll
            for (int sg = 0; sg < 2; ++sg) {
                f32x4 p0 = MFMA16(kf[2 * sg], qf[m], zero4), p1 = MFMA16(kf[2 * sg + 1], qf[m], zero4);
                float pv[8];
#pragma unroll
                for (int j = 0; j < 4; ++j) { const int s0 = 32 * sg + 4 * g + j, s1 = s0 + 16; pv[j] = (r ? s0 >= t : s0 <= t) ? p0[j] : 0.f; pv[4 + j] = (r ? s1 >= t : s1 <= t) ? p1[j] : 0.f; }
                const bf16x8 pf = pack8(pv);
#pragma unroll
                for (int d = 0; d < 4; ++d) o[m][d] = MFMA16(pf, vf[sg][d], o[m][d]);
            }
        }
        __syncthreads();
        LAS float* ox = (LAS float*)(F.lds + GL_B);
        LAS bf16* ot = (LAS bf16*)(F.lds + GL_Q);
        LAS bf16* srg = (LAS bf16*)(F.lds + GL_V);
        for (int i = F.tid; i < 2048; i += NTHR) { const int t = i >> 5, pc = i & 31; *(LAS u32x4*)(srg + t * GL_VS + pc * 8) = *(const u32x4*)(P + (size_t)t * PW + PC_R + pc * 8); }
        if (r == 1) {
#pragma unroll
            for (int m = 0; m < 4; ++m)
#pragma unroll
                for (int d = 0; d < 4; ++d)
#pragma unroll
                    for (int j = 0; j < 4; ++j) ox[(hh * 64 + 16 * m + 4 * g + j) * 65 + 16 * d + lr] = o[m][d][j];
        }
        __syncthreads();
        if (r == 0) {
            const float* ng = a.in[I_GLANG] + L * 64;
            float gn[4];
#pragma unroll
            for (int d = 0; d < 4; ++d) gn[d] = ng[16 * d + lr];
#pragma unroll
            for (int m = 0; m < 4; ++m)
#pragma unroll
                for (int j = 0; j < 4; ++j) {
                    const int t = 16 * m + 4 * g + j; float v[4], ss = 0.f;
#pragma unroll
                    for (int d = 0; d < 4; ++d) { v[d] = o[m][d][j] + ox[(hh * 64 + t) * 65 + 16 * d + lr]; ss += v[d] * v[d]; }
                    ss += swz_xor<1>(ss); ss += swz_xor<2>(ss); ss += swz_xor<4>(ss); ss += swz_xor<8>(ss);
                    const float rs = rsqrtf(ss * (1.f / 64.f) + 1e-6f);
#pragma unroll
                    for (int d = 0; d < 4; ++d) { const float rg = bf2f(srg[t * GL_VS + hh * 64 + 16 * d + lr]); ot[t * 264 + hh * 64 + 16 * d + lr] = (bf16)f2bf(v[d] * rs * gn[d] * siluf_(rg)); }
                }
        }
        __syncthreads();
        bf16* MX = (bf16*)(F.ws + WS_MIX) + (size_t)tok0 * MW + 768;
        for (int i = F.tid; i < 2048; i += NTHR) { const int t = i >> 5, pc = i & 31; *(u32x4*)(MX + (size_t)t * MW + pc * 8) = *(const LAS u32x4*)(ot + t * 264 + pc * 8); }
    }
}

constexpr int SD_RS = 520;
constexpr int SD_RAW = 0, SD_XC = SD_RAW + 68 * SD_RS * 2, SD_DT = SD_XC + 64 * SD_RS * 2, SD_CUM = SD_DT + 64 * 8 * 4, SD_W = SD_CUM + 8 * 64 * 4, SD_END = SD_W + 8 * 64 * 4;
static_assert(SD_END <= MISC_OFF && 64 * 260 * 4 <= 68 * SD_RS * 2, "SSD LDS");
template <bool OUT> __device__ __forceinline__ void ssd_chunk(Frame& F0, CArgs& a, int L, int cid) {
    LAUNDER_F(F0)
    const int tok0 = chunk_tok0(cid);
    const bf16* PB = (const bf16*)(F.ws + WS_PBUF);
    LAS bf16* raw = (LAS bf16*)(F.lds + SD_RAW); LAS bf16* xc = (LAS bf16*)(F.lds + SD_XC); LAS float* sdt = (LAS float*)(F.lds + SD_DT); LAS float* scum = (LAS float*)(F.lds + SD_CUM); LAS float* sw = (LAS float*)(F.lds + SD_W);
    __syncthreads();
    {
        const int isctx = cid >= 512, c4 = (cid - 512) & 3;
        u32x4 rv[9];
#pragma unroll
        for (int k = 0; k < 9; ++k) { const int i = F.tid + k * NTHR, rr = i >> 6, pc = i & 63, t = rr - 2; rv[k] = (u32x4){0u, 0u, 0u, 0u};
            bool ok = t >= 0 && t < 64 && i < 68 * 64; if (isctx) { const int tt = c4 * 64 + t; ok = tt >= 0 && tt < 256 && i < 68 * 64; }
            if (ok) rv[k] = *(const u32x4*)(PB + (size_t)(tok0 + t) * PW + PC_XBC + pc * 8); }
#pragma unroll
        for (int k = 0; k < 9; ++k) { const int i = F.tid + k * NTHR, rr = i >> 6, pc = i & 63; if (i < 68 * 64) *(LAS u32x4*)(raw + rr * SD_RS + pc * 8) = rv[k]; }
        if (F.tid < 64) { float dv[8]; unpack8(*(const bf16x8*)(PB + (size_t)(tok0 + F.tid) * PW + PC_DT), dv);
#pragma unroll
            for (int q = 0; q < 8; ++q) { const float z = dv[q] + a.in[I_SSDDTB][L * 8 + q]; sdt[F.tid * 8 + q] = z > 20.f ? z : __logf(1.f + __expf(z)); } }
    }
    __syncthreads();
    {
        const int ch = F.tid; float w[5];
#pragma unroll
        for (int k = 0; k < 5; ++k) w[k] = a.in[I_SSDCW][((size_t)L * 5 + k) * 512 + ch];
        const float cb = a.in[I_SSDCB][L * 512 + ch];
        float x0 = bf2f(raw[0 * SD_RS + ch]), x1 = bf2f(raw[1 * SD_RS + ch]), x2 = bf2f(raw[2 * SD_RS + ch]), x3 = bf2f(raw[3 * SD_RS + ch]);
        for (int t = 0; t < 64; ++t) { const float x4 = bf2f(raw[(t + 4) * SD_RS + ch]); const float y = cb + w[0] * x0 + w[1] * x1 + w[2] * x2 + w[3] * x3 + w[4] * x4;
            xc[t * SD_RS + ch] = (bf16)f2bf(siluf_(y)); x0 = x1; x1 = x2; x2 = x3; x3 = x4; }
    }
    {
        const int q = F.wave, rr = q >> 2, t = rr ? 63 - F.lane : F.lane;
        const float aa = -__expf(a.in[I_SSDALOG][L * 8 + q]); const float dtv = sdt[t * 8 + q];
        float c = dtv * aa;
        { float o;
          o = __builtin_bit_cast(float, __builtin_amdgcn_ds_bpermute((F.lane - 1) << 2, __builtin_bit_cast(int, c))); if (F.lane >= 1) c += o;
          o = __builtin_bit_cast(float, __builtin_amdgcn_ds_bpermute((F.lane - 2) << 2, __builtin_bit_cast(int, c))); if (F.lane >= 2) c += o;
          o = __builtin_bit_cast(float, __builtin_amdgcn_ds_bpermute((F.lane - 4) << 2, __builtin_bit_cast(int, c))); if (F.lane >= 4) c += o;
          o = __builtin_bit_cast(float, __builtin_amdgcn_ds_bpermute((F.lane - 8) << 2, __builtin_bit_cast(int, c))); if (F.lane >= 8) c += o;
          o = __builtin_bit_cast(float, __builtin_amdgcn_ds_bpermute((F.lane - 16) << 2, __builtin_bit_cast(int, c))); if (F.lane >= 16) c += o;
          o = __builtin_bit_cast(float, __builtin_amdgcn_ds_bpermute((F.lane - 32) << 2, __builtin_bit_cast(int, c))); if (F.lane >= 32) c += o; }
        const float cl = __builtin_bit_cast(float, __builtin_amdgcn_ds_bpermute(63 << 2, __builtin_bit_cast(int, c)));
        scum[q * 64 + t] = c; sw[q * 64 + t] = __expf(cl - c) * dtv;
    }
    __syncthreads();
    const int h = F.wave & 3, r = F.wave >> 2, lr = F.lane & 15, g = F.lane >> 4, gp = h >> 1, rh = r * 4 + h;
    const size_t ub = ((size_t)cid * 4 + h) * 2 + r;
    if constexpr (!OUT) {
        f32x4 acc[4][4];
#pragma unroll
        for (int ms = 0; ms < 4; ++ms)
#pragma unroll
            for (int d = 0; d < 4; ++d) acc[ms][d] = (f32x4){0.f, 0.f, 0.f, 0.f};
#pragma unroll
        for (int sg = 0; sg < 2; ++sg) {
            const int trow = 32 * sg + 8 * g;
            bf16x8 xf[4];
#pragma unroll
            for (int d = 0; d < 4; ++d) { const LAS bf16* p0 = xc + (trow + ((F.lane & 15) >> 2)) * SD_RS + h * 64 + 16 * d + 4 * (F.lane & 3); xf[d] = cat8(trread(p0), trread(p0 + 4 * SD_RS)); }
            float wv[8];
            *(f32x4*)wv = *(const LAS f32x4*)(sw + rh * 64 + trow); *(f32x4*)(wv + 4) = *(const LAS f32x4*)(sw + rh * 64 + trow + 4);
#pragma unroll
            for (int ms = 0; ms < 4; ++ms) {
                const LAS bf16* p0 = xc + (trow + ((F.lane & 15) >> 2)) * SD_RS + 256 + gp * 64 + 16 * ms + 4 * (F.lane & 3);
                const s16x4 b0 = trread(p0), b1 = trread(p0 + 4 * SD_RS);
                float bv[8];
#pragma unroll
                for (int e = 0; e < 4; ++e) { bv[e] = bf2f((unsigned short)b0[e]) * wv[e]; bv[4 + e] = bf2f((unsigned short)b1[e]) * wv[4 + e]; }
                const bf16x8 bf = pack8(bv);
#pragma unroll
                for (int d = 0; d < 4; ++d) acc[ms][d] = MFMA16(bf, xf[d], acc[ms][d]);
            }
        }
        float* ds = (float*)(F.ws + WS_SDS) + ub * 4096;
#pragma unroll
        for (int ms = 0; ms < 4; ++ms)
#pragma unroll
            for (int d = 0; d < 4; ++d) *(f32x4*)(ds + (16 * d + lr) * 64 + 16 * ms + 4 * g) = acc[ms][d];
        if (F.lane == 0) ((float*)(F.ws + WS_SDEC))[ub] = __expf(scum[rh * 64 + (r ? 0 : 63)]);
    } else {
        bf16x8 bfr[4][2], cfr[4][2];
#pragma unroll
        for (int m = 0; m < 4; ++m)
#pragma unroll
            for (int ks = 0; ks < 2; ++ks) { bfr[m][ks] = *(const LAS bf16x8*)(xc + (16 * m + lr) * SD_RS + 256 + gp * 64 + 32 * ks + 8 * g); cfr[m][ks] = *(const LAS bf16x8*)(xc + (16 * m + lr) * SD_RS + 384 + gp * 64 + 32 * ks + 8 * g); }
        f32x4 y[4][4];
#pragma unroll
        for (int m = 0; m < 4; ++m)
#pragma unroll
            for (int d = 0; d < 4; ++d) y[m][d] = (f32x4){0.f, 0.f, 0.f, 0.f};
        {
            const bf16* se = (const bf16*)(F.ws + WS_SSE) + ub * 4096;
            bf16x8 cs[4][2];
#pragma unroll
            for (int m = 0; m < 4; ++m) { const float ec = __expf(scum[rh * 64 + 16 * m + lr]);
#pragma unroll
                for (int ks = 0; ks < 2; ++ks) { float cv[8]; unpack8(cfr[m][ks], cv);
#pragma unroll
                    for (int e = 0; e < 8; ++e) cv[e] *= ec;
                    cs[m][ks] = pack8(cv); } }
#pragma unroll
            for (int d = 0; d < 4; ++d) {
                const bf16x8 sf0 = *(const bf16x8*)(se + (16 * d + lr) * 64 + 8 * g), sf1 = *(const bf16x8*)(se + (16 * d + lr) * 64 + 32 + 8 * g);
#pragma unroll
                for (int m = 0; m < 4; ++m) { y[m][d] = MFMA16(cs[m][0], sf0, y[m][d]); y[m][d] = MFMA16(cs[m][1], sf1, y[m][d]); }
            }
        }
        asm volatile("" ::: "memory");
        bf16x8 xf[2][4];
#pragma unroll
        for (int sg = 0; sg < 2; ++sg)
#pragma unroll
            for (int d = 0; d < 4; ++d) { const LAS bf16* p0 = xc + (32 * sg + 4 * g + ((F.lane & 15) >> 2)) * SD_RS + h * 64 + 16 * d + 4 * (F.lane & 3); xf[sg][d] = cat8(trread(p0), trread(p0 + 16 * SD_RS)); }
        const f32x4 zero4 = (f32x4){0.f, 0.f, 0.f, 0.f};
#pragma unroll
        for (int m = 0; m < 4; ++m) {
            const int t = 16 * m + lr; const float ct = scum[rh * 64 + t];
#pragma unroll
            for (int sg = 0; sg < 2; ++sg) {
                f32x4 p0 = MFMA16(bfr[2 * sg][0], cfr[m][0], zero4), p1 = MFMA16(bfr[2 * sg + 1][0], cfr[m][0], zero4);
                p0 = MFMA16(bfr[2 * sg][1], cfr[m][1], p0); p1 = MFMA16(bfr[2 * sg + 1][1], cfr[m][1], p1);
                float pv[8];
#pragma unroll
                for (int j = 0; j < 4; ++j) { const int s0 = 32 * sg + 4 * g + j, s1 = s0 + 16;
                    pv[j] = (r ? s0 >= t : s0 <= t) ? p0[j] * __expf(ct - scum[rh * 64 + s0]) * sdt[s0 * 8 + rh] : 0.f;
                    pv[4 + j] = (r ? s1 >= t : s1 <= t) ? p1[j] * __expf(ct - scum[rh * 64 + s1]) * sdt[s1 * 8 + rh] : 0.f; }
                const bf16x8 pf = pack8(pv);
#pragma unroll
                for (int d = 0; d < 4; ++d) y[m][d] = MFMA16(pf, xf[sg][d], y[m][d]);
            }
        }
        __syncthreads();
        LAS float* yx = (LAS float*)(F.lds + SD_RAW);
        if (r == 1) {
#pragma unroll
            for (int m = 0; m < 4; ++m)
#pragma unroll
                for (int d = 0; d < 4; ++d)
#pragma unroll
                    for (int j = 0; j < 4; ++j) yx[(16 * m + 4 * g + j) * 260 + h * 64 + 16 * d + lr] = y[m][d][j];
        }
        __syncthreads();
        if (r == 0) { const float dsk = a.in[I_SSDD][L * 4 + h];
#pragma unroll
            for (int m = 0; m < 4; ++m)
#pragma unroll
                for (int d = 0; d < 4; ++d)
#pragma unroll
                    for (int j = 0; j < 4; ++j) { const int t = 16 * m + 4 * g + j, c = h * 64 + 16 * d + lr; yx[t * 260 + c] += y[m][d][j] + dsk * bf2f(xc[t * SD_RS + c]); asm volatile("" ::: "memory"); }
        }
        __syncthreads();
        { const int t = F.tid >> 3, c0 = (F.tid & 7) * 32; const bf16* zr = PB + (size_t)(tok0 + t) * PW + PC_Z + c0; const float* ng = a.in[I_SSDNG] + L * 256 + c0;
          float v[32]; float ss = 0.f;
#pragma unroll
          for (int q = 0; q < 4; ++q) { float zv[8]; unpack8(*(const bf16x8*)(zr + 8 * q), zv);
#pragma unroll
              for (int e = 0; e < 8; ++e) { const float u = yx[t * 260 + c0 + 8 * q + e] * siluf_(zv[e]); v[8 * q + e] = u; ss += u * u; } }
          ss += swz_xor<1>(ss); ss += swz_xor<2>(ss); ss += swz_xor<4>(ss);
          const float rs = rsqrtf(ss * (1.f / 256.f) + 1e-6f);
          bf16* MX = (bf16*)(F.ws + WS_MIX) + (size_t)(tok0 + t) * MW + 1024 + c0;
#pragma unroll
          for (int q = 0; q < 4; ++q) { float o8[8];
#pragma unroll
              for (int e = 0; e < 8; ++e) o8[e] = v[8 * q + e] * rs * ng[8 * q + e];
              *(bf16x8*)(MX + 8 * q) = pack8(o8); } }
    }
}

constexpr int FF_XP = 0, FF_TR = FF_XP + 16 * 64 * 16 * 2, FF_TI = FF_TR + 16 * 64 * 16 * 2, FF_END = FF_TI + 16 * 64 * 16 * 2;
__device__ __forceinline__ void fft_unit(Frame& F0, int u) {
    LAUNDER_F(F0)
    const int b = u >> 6, cg = (u >> 2) & 15, kb = u & 3, lr = F.lane & 15, g = F.lane >> 4;
    const bf16* PB = (const bf16*)(F.ws + WS_PBUF) + (size_t)b * SEQ * PW + PC_FU + 16 * cg;
    const bf16* f64 = (const bf16*)(F.ws + WS_TAB + TAB_F64); const float* tw = (const float*)(F.ws + WS_TAB + TAB_TW);
    LAS bf16* xp = (LAS bf16*)(F.lds + FF_XP); LAS bf16* tr = (LAS bf16*)(F.lds + FF_TR); LAS bf16* ti = (LAS bf16*)(F.lds + FF_TI);
    bf16x8 fc1[2], fs1[2];
#pragma unroll
    for (int ks = 0; ks < 2; ++ks) { fc1[ks] = *(const bf16x8*)(f64 + (16 * kb + lr) * 64 + 32 * ks + 8 * g); fs1[ks] = *(const bf16x8*)(f64 + 4096 + (16 * kb + lr) * 64 + 32 * ks + 8 * g); }
    const f32x4 zero4 = (f32x4){0.f, 0.f, 0.f, 0.f};
    u32x4 xr[4];
#pragma unroll
    for (int k = 0; k < 4; ++k) { const int i = F.tid + k * NTHR, n2l = i >> 7, n1 = (i >> 1) & 63, hf = i & 1; xr[k] = *(const u32x4*)(PB + (size_t)(64 * n1 + n2l) * PW + hf * 8); }
    for (int pa = 0; pa < 4; ++pa) {
        __syncthreads();
#pragma unroll
        for (int k = 0; k < 4; ++k) { const int i = F.tid + k * NTHR, n2l = i >> 7, n1 = (i >> 1) & 63, hf = i & 1; *(LAS u32x4*)(xp + (n2l * 64 + n1) * 16 + hf * 8) = xr[k]; }
        if (pa < 3) {
#pragma unroll
            for (int k = 0; k < 4; ++k) { const int i = F.tid + k * NTHR, n2l = i >> 7, n1 = (i >> 1) & 63, hf = i & 1; xr[k] = *(const u32x4*)(PB + (size_t)(64 * n1 + 16 * (pa + 1) + n2l) * PW + hf * 8); }
        }
        __syncthreads();
#pragma unroll
        for (int q = 0; q < 2; ++q) {
            const int n2l = 2 * F.wave + q, n2 = 16 * pa + n2l;
            f32x4 tc = zero4, ts = zero4;
#pragma unroll
            for (int ks = 0; ks < 2; ++ks) { const LAS bf16* p0 = xp + (n2l * 64 + 32 * ks + 8 * g + ((F.lane & 15) >> 2)) * 16 + 4 * (F.lane & 3); const bf16x8 xb = cat8(trread(p0), trread(p0 + 4 * 16));
                tc = MFMA16(fc1[ks], xb, tc); ts = MFMA16(fs1[ks], xb, ts); }
#pragma unroll
            for (int j = 0; j < 4; ++j) { const int k1l = 4 * g + j, k1 = 16 * kb + k1l; const f32x2 w = *(const f32x2*)(tw + 2 * (n2 * k1));
                tr[(k1l * 64 + n2) * 16 + lr] = (bf16)f2bf(tc[j] * w[0] - ts[j] * w[1]); ti[(k1l * 64 + n2) * 16 + lr] = (bf16)f2bf(-(tc[j] * w[1] + ts[j] * w[0])); }
        }
    }
    __syncthreads();
    bf16* MX = (bf16*)(F.ws + WS_MIX) + (size_t)b * SEQ * MW + 16 * cg + lr;
#pragma unroll
    for (int q = 0; q < 2; ++q) {
        const int k1l = 2 * F.wave + q, k1 = 16 * kb + k1l;
        bf16x8 br[2], bi[2];
#pragma unroll
        for (int ks = 0; ks < 2; ++ks) { const int off = (k1l * 64 + 32 * ks + 8 * g + ((F.lane & 15) >> 2)) * 16 + 4 * (F.lane & 3); br[ks] = cat8(trread(tr + off), trread(tr + off + 64)); bi[ks] = cat8(trread(ti + off), trread(ti + off + 64)); }
#pragma unroll
        for (int m = 0; m < 4; ++m) {
            f32x4 yr = zero4, y1 = zero4, y2 = zero4;
#pragma unroll
            for (int ks = 0; ks < 2; ++ks) { const bf16x8 fc = *(const bf16x8*)(f64 + (16 * m + lr) * 64 + 32 * ks + 8 * g), fs = *(const bf16x8*)(f64 + 4096 + (16 * m + lr) * 64 + 32 * ks + 8 * g);
                yr = MFMA16(fc, br[ks], yr); yr = MFMA16(fs, bi[ks], yr); y1 = MFMA16(fc, bi[ks], y1); y2 = MFMA16(fs, br[ks], y2); }
#pragma unroll
            for (int j = 0; j < 4; ++j) { const int k2 = 16 * m + 4 * g + j; bf16* o = MX + (size_t)(64 * k2 + k1) * MW; o[0] = (bf16)f2bf(yr[j] * (1.f / 64.f)); o[256] = (bf16)f2bf((y1[j] - y2[j]) * (1.f / 64.f)); }
        }
    }
}
__device__ __forceinline__ void dft_ctx_unit(Frame& F0, int u) {
    LAUNDER_F(F0)
    const int b = u >> 5, kblk = u & 31;
    LAS bf16* sl = (LAS bf16*)F.lds;
    const bf16* PB = (const bf16*)(F.ws + WS_PBUF) + (size_t)(NLAT + b * CTXL) * PW + PC_FU;
    __syncthreads();
#pragma unroll
    for (int h = 0; h < 2; ++h) { u32x4 v[8];
#pragma unroll
        for (int k = 0; k < 8; ++k) { const int i = F.tid + (h * 8 + k) * NTHR, n = i >> 5, pc = i & 31; v[k] = *(const u32x4*)(PB + (size_t)n * PW + pc * 8); }
#pragma unroll
        for (int k = 0; k < 8; ++k) { const int i = F.tid + (h * 8 + k) * NTHR, n = i >> 5, pc = i & 31; *(LAS u32x4*)(sl + n * 256 + pc * 8) = v[k]; } }
    __syncthreads();
    const int c = F.tid & 255, k0 = kblk * 8 + (F.tid >> 8) * 4;
    const float* d256 = (const float*)(F.ws + WS_TAB + TAB_D256);
    float wr[4], wi[4], sr[4], si[4], ar[4], ai[4];
#pragma unroll
    for (int i = 0; i < 4; ++i) { sr[i] = d256[2 * (k0 + i)]; si[i] = -d256[2 * (k0 + i) + 1]; wr[i] = 1.f; wi[i] = 0.f; ar[i] = 0.f; ai[i] = 0.f; }
#pragma unroll 4
    for (int n = 0; n < 256; ++n) { const float uv = bf2f(sl[n * 256 + c]);
#pragma unroll
        for (int i = 0; i < 4; ++i) { ar[i] += uv * wr[i]; ai[i] += uv * wi[i]; const float nr = wr[i] * sr[i] - wi[i] * si[i], ni = wr[i] * si[i] + wi[i] * sr[i]; wr[i] = nr; wi[i] = ni; } }
    bf16* MX = (bf16*)(F.ws + WS_MIX) + (size_t)(NLAT + b * CTXL + k0) * MW + c;
#pragma unroll
    for (int i = 0; i < 4; ++i) { MX[(size_t)i * MW] = (bf16)f2bf(ar[i] * (1.f / 16.f)); MX[(size_t)i * MW + 256] = (bf16)f2bf(ai[i] * (1.f / 16.f)); }
}

#ifndef SUBMASK
#define SUBMASK 0xFFFF
#endif
#define SUB(bit) (rep == 0 || ((SUBMASK >> (bit)) & 1))
__device__ __forceinline__ void p_mix_a(Frame& F, CArgs& a, int L, int rep = 0) {
    if (SUB(0)) {
        pg8::Gemm g{(const bf16*)(F.ws + WS_A2), (const bf16*)(F.ws + WS_S5P) + (size_t)L * 16 * 256 * 256, 1024, 512, OPQ(256)};
        SgOrder<FillS5> S; S.init(144, 1, F.G, F.bid); S.f = FillS5{(size_t)256 * 256 * 2};
        EpiS5S E{(float*)(F.ws + WS_S5S)};
        pg8::gemm_phase(F.lds, g, S, E, fresh_tid(F.wave));
    }
    if (SUB(1)) for (int u = F.bid; u < NCHK; u += F.G) gla_chunk<false>(F, a, L, u);
    if (SUB(2)) for (int u = (F.bid + 32) % F.G; u < NCHK; u += F.G) ssd_chunk<false>(F, a, L, u);
    __syncthreads();
}
__device__ __forceinline__ void p_mix_b(Frame& F, CArgs& a, int L, int rep = 0) {
    if (SUB(3)) for (int u = F.bid; u < 256; u += F.G) {
        const int vz = F.tid >> 9, uv = u + vz, wv = (F.tid >> 6);
        const int b = uv >> 5, g = (uv >> 1) & 15, r = uv & 1;
        const f32x2 a16 = *(const f32x2*)((const float*)(F.ws + WS_A16) + ((size_t)((L * 2 + r) * 16 + g) * 64 + F.lane) * 2);
        const float* S = (const float*)(F.ws + WS_S5S) + (size_t)g * S5ROWS * 256 + r * 128 + F.lane; bf16* A2 = (bf16*)(F.ws + WS_A2) + (size_t)g * S5ROWS * 512 + 256 + r * 128 + F.lane;
        LAS float* ex = (LAS float*)F.lds;
        LAS float* sl = ex + 17 * 128;
        __syncthreads();
#pragma unroll 1
        for (int sg = wv; sg < 17; sg += 8) {
            float sr[16], si[16];
#pragma unroll
            for (int n = 0; n < 16; ++n) { const int i = 16 * sg + n; const int row = i < 16 ? 2048 + 16 * b + (r ? 15 - i : i) : 256 * b + (r ? 271 - i : i - 16); sr[n] = S[(size_t)row * 256]; si[n] = S[(size_t)row * 256 + 64]; }
            float hr = 0.f, hi = 0.f;
#pragma unroll
            for (int n = 0; n < 16; ++n) { sl[((16 * sg + n) * 64 + F.lane) * 2] = sr[n]; sl[((16 * sg + n) * 64 + F.lane) * 2 + 1] = si[n];
                const float nr = a16[0] * hr - a16[1] * hi + sr[n], ni = a16[0] * hi + a16[1] * hr + si[n]; hr = nr; hi = ni; }
            ex[(sg * 64 + F.lane) * 2] = hr; ex[(sg * 64 + F.lane) * 2 + 1] = hi;
        }
        __syncthreads();
        float pr = a16[0], pi = a16[1];
#pragma unroll
        for (int q = 0; q < 4; ++q) { const float nr = pr * pr - pi * pi, ni = 2.f * pr * pi; pr = nr; pi = ni; }
#pragma unroll 1
        for (int sg = wv; sg < 17; sg += 8) {
            float hr = 0.f, hi = 0.f;
            for (int j = 0; j < sg; ++j) { const float er = ex[(j * 64 + F.lane) * 2], ei = ex[(j * 64 + F.lane) * 2 + 1]; const float nr = pr * hr - pi * hi + er, ni = pr * hi + pi * hr + ei; hr = nr; hi = ni; }
#pragma unroll 4
            for (int n = 0; n < 16; ++n) { const int i = 16 * sg + n; const int row = i < 16 ? 2048 + 16 * b + (r ? 15 - i : i) : 256 * b + (r ? 271 - i : i - 16);
                A2[(size_t)row * 512] = (bf16)f2bf(hr); A2[(size_t)row * 512 + 64] = (bf16)f2bf(hi);
                const float xr_ = sl[(i * 64 + F.lane) * 2], xi_ = sl[(i * 64 + F.lane) * 2 + 1];
                const float nr = a16[0] * hr - a16[1] * hi + xr_, ni = a16[0] * hi + a16[1] * hr + xi_; hr = nr; hi = ni; }
        }
    }
    if (SUB(3)) for (int u = F.bid; u < 256; u += F.G) { const int uv = u + (F.tid >> 9), sq = uv >> 2, b = sq >> 3, hh = (sq >> 1) & 3, r = sq & 1, e = (uv & 3) * 512 + F.tid, c = e & 31;
        const float* ds = (const float*)(F.ws + WS_GDS); const float* dc = (const float*)(F.ws + WS_GDEC); bf16* se = (bf16*)(F.ws + WS_GSE);
        float s = 0.f;
        for (int i0 = 0; i0 < 68; i0 += 17) { float dv[17], cv[17];
#pragma unroll
            for (int k = 0; k < 17; ++k) { const int i = i0 + k; const int cid = i < 4 ? 512 + b * 4 + (r ? 3 - i : i) : b * 64 + (r ? 67 - i : i - 4); const size_t ub = ((size_t)cid * 4 + hh) * 2 + r; dv[k] = ds[ub * 2048 + e]; cv[k] = dc[ub * 32 + c]; }
#pragma unroll
            for (int k = 0; k < 17; ++k) { const int i = i0 + k; const int cid = i < 4 ? 512 + b * 4 + (r ? 3 - i : i) : b * 64 + (r ? 67 - i : i - 4); const size_t ub = ((size_t)cid * 4 + hh) * 2 + r; se[ub * 2048 + e] = (bf16)f2bf(s); s = cv[k] * s + dv[k]; } } }
    if (SUB(3)) for (int u = F.bid; u < 512; u += F.G) { const int uv = u + (F.tid >> 9), sq = uv >> 3, b = sq >> 3, h = (sq >> 1) & 3, r = sq & 1, e = (uv & 7) * 512 + F.tid;
        const float* ds = (const float*)(F.ws + WS_SDS); const float* dc = (const float*)(F.ws + WS_SDEC); bf16* se = (bf16*)(F.ws + WS_SSE);
        float s = 0.f;
        for (int i0 = 0; i0 < 68; i0 += 17) { float dv[17], cv[17];
#pragma unroll
            for (int k = 0; k < 17; ++k) { const int i = i0 + k; const int cid = i < 4 ? 512 + b * 4 + (r ? 3 - i : i) : b * 64 + (r ? 67 - i : i - 4); const size_t ub = ((size_t)cid * 4 + h) * 2 + r; dv[k] = ds[ub * 4096 + e]; cv[k] = dc[ub]; }
#pragma unroll
            for (int k = 0; k < 17; ++k) { const int i = i0 + k; const int cid = i < 4 ? 512 + b * 4 + (r ? 3 - i : i) : b * 64 + (r ? 67 - i : i - 4); const size_t ub = ((size_t)cid * 4 + h) * 2 + r; se[ub * 4096 + e] = (bf16)f2bf(s); s = cv[k] * s + dv[k]; } } }
    if (SUB(4)) for (int u = F.bid; u < 512; u += F.G) fft_unit(F, u);
    if (SUB(5)) for (int u = F.bid; u < 256; u += F.G) dft_ctx_unit(F, u);
    __syncthreads();
}
__device__ __forceinline__ void p_mix_c(Frame& F, CArgs& a, int L, int rep = 0) {
#ifndef MIXC_PARTS
#define MIXC_PARTS 7
#endif
    if ((MIXC_PARTS & 1) && SUB(6)) {
        pg8::Gemm g{(const bf16*)(F.ws + WS_A2), (const bf16*)(F.ws + WS_S5B2) + (size_t)L * 16 * 256 * 512, 1024, 1024, OPQ(512)};
        SgOrder<FillS5> S; S.init(144, 1, F.G, F.bid); S.f = FillS5{(size_t)256 * 512 * 2};
        EpiS5Y E{(bf16*)(F.ws + WS_ACT5)};
        pg8::gemm_phase(F.lds, g, S, E, fresh_tid(F.wave));
    }
    const int nch = (L == DEPTH - 1) ? 512 : NCHK;
    if ((MIXC_PARTS & 2) && SUB(7)) for (int u = F.bid; u < nch; u += F.G) gla_chunk<true>(F, a, L, u);
    if ((MIXC_PARTS & 4) && SUB(8)) for (int u = (F.bid + 32) % F.G; u < nch; u += F.G) ssd_chunk<true>(F, a, L, u);
    __syncthreads();
}

constexpr int NPH = 11, PH_TOTAL = 2 + DEPTH * NPH;
#ifndef PHASE_MASK
#define PHASE_MASK 0xFFFF
#endif
#define PM(i) ((PHASE_MASK >> (i)) & 1)
#ifndef DUP_MASK
#define DUP_MASK 0
#endif
#define NREP(k) (((DUP_MASK >> (k)) & 1) ? 2 : 1)
#ifndef MK_ONE_LAUNCH
#define MK_ONE_LAUNCH 0
#endif

__global__ void __launch_bounds__(NTHR, 2) mk_fwd(Args args_by_value) {
#define args (*fresh_args())
    extern __shared__ __attribute__((aligned(16))) unsigned char lds_raw[];
    Frame F;
    F.lds = (LAS unsigned char*)lds_raw; F.MISC = (volatile LAS unsigned*)(F.lds + MISC_OFF);
    F.tid = threadIdx.x; F.lane = F.tid & 63; F.wave = __builtin_amdgcn_readfirstlane(F.tid >> 6); F.G = gridDim.x; F.bid = blockIdx.x;
    F.ws = args_by_value.ws; F.ctl = (unsigned*)(args_by_value.ws + WS_CTL);
    if (F.tid < 64) F.MISC[F.tid] = 0u;
    __syncthreads();
#if MK_ONE_LAUNCH
    XcdBarrier bar = xcd_barrier_post(F.ctl + CW_BAR, F.MISC + 8);
#define GRID_BAR() xcd_barrier(bar)
#else
#define GRID_BAR() do { } while (0)
#endif
    const int lo = args_by_value.ph_lo, hi = args_by_value.ph_hi;
#define IN(k) (lo <= (k) && (k) < hi)
#define FRESH() do { const int t_ = fresh_tid(F.wave); F.tid = t_; F.lane = t_ & 63; } while (0)
#define SEAM(k) do { if (IN(k) && IN((k) + 1)) GRID_BAR(); } while (0)
    if (PM(0) && IN(0)) { FRESH(); p_prologue(F, args); }
#ifdef DUP_PROLOGUE
    GRID_BAR(); if (PM(0) && IN(0)) { FRESH(); p_prologue(F, args, CW_QUEUE + 64); }
#endif
    SEAM(0);
    {
        const int pb = 1 + 0 * NPH;
        const int mrows = (0 == DEPTH - 1) ? NLAT : NT;
        if (PM(1) && IN(pb + 0)) { FRESH(); p_norm1(F, args, OPQ(0)); }
#ifdef DUP_NORM1
        GRID_BAR(); if (PM(1) && IN(pb + 0)) { FRESH(); p_norm1(F, args, OPQ(0), true); }
#endif
 SEAM(pb + 0);
        if (PM(2) && IN(pb + 1)) for (int rep_ = 0; rep_ < NREP(2); ++rep_) { if (rep_) GRID_BAR(); const int Lg = OPQ(0);
            pg8::Gemm g{(const bf16*)(F.ws + WS_H), (const bf16*)(F.ws + WS_WIN) + (size_t)Lg * PW * DM, DM * 2, DM * 2, OPQ(DM)};
            SgOrder<FillPlain> S; S.init(NT / 256, PW / 256, F.G, F.bid); S.f = FillPlain{(size_t)256 * DM * 2, (size_t)256 * DM * 2};
            EpiInproj E{(bf16*)(F.ws + WS_PBUF), (bf16*)(F.ws + WS_A2)};
            pg8::gemm_phase(F.lds, g, S, E, fresh_tid(F.wave));
        } SEAM(pb + 1);
        if (PM(3) && IN(pb + 2)) for (int rep_ = 0; rep_ < NREP(3); ++rep_) { if (rep_) GRID_BAR(); FRESH(); p_mix_a(F, args, OPQ(0), rep_); } SEAM(pb + 2);
        if (PM(4) && IN(pb + 3)) for (int rep_ = 0; rep_ < NREP(4); ++rep_) { if (rep_) GRID_BAR(); FRESH(); p_mix_b(F, args, OPQ(0), rep_); } SEAM(pb + 3);
        if (PM(5) && IN(pb + 4)) for (int rep_ = 0; rep_ < NREP(5); ++rep_) { if (rep_) GRID_BAR(); FRESH(); p_mix_c(F, args, OPQ(0), rep_); } SEAM(pb + 4);
        if (PM(6) && IN(pb + 5)) for (int rep_ = 0; rep_ < NREP(6); ++rep_) { if (rep_) GRID_BAR(); const int Lg = OPQ(0);
            pg8::Gemm g{(const bf16*)(F.ws + WS_ACT5), (const bf16*)(F.ws + WS_WGLU) + (size_t)Lg * 256 * 256, 512, 512, OPQ(256)};
            SgOrder<FillPlain> S; S.init(NT / 256, 1, F.G, F.bid); S.f = FillPlain{(size_t)256 * 256 * 2, 0};
            EpiGlu E{(const bf16*)(F.ws + WS_ACT5), (bf16*)(F.ws + WS_MIX)};
            pg8::gemm_phase(F.lds, g, S, E, fresh_tid(F.wave));
        } SEAM(pb + 5);
        if (PM(7) && IN(pb + 6)) { const int Lg = OPQ(0);
            pg8::Gemm g{(const bf16*)(F.ws + WS_MIX), (const bf16*)(F.ws + WS_WOUT) + (size_t)Lg * DM * MW, MW * 2, MW * 2, OPQ(MW)};
            SgOrder<FillPlain> S; S.init((Lg == DEPTH - 1 ? NLAT : NT) / 256, DM / 256, F.G, F.bid); S.f = FillPlain{(size_t)256 * MW * 2, (size_t)256 * MW * 2};
            EpiOutproj E{args.in[I_X], args.in[I_CTX], (bf16*)(F.ws + WS_XS), (const float*)(F.ws + WS_MOD) + (size_t)Lg * 9 * 6144, Lg == 0 ? 1 : 0};
            pg8::gemm_phase(F.lds, g, S, E, fresh_tid(F.wave));
        } SEAM(pb + 6);
        if (PM(8) && IN(pb + 7)) { FRESH(); p_norm2(F, args, OPQ(0), OPQ(mrows)); }
#ifdef DUP_NORM2
        GRID_BAR(); if (PM(8) && IN(pb + 7)) { FRESH(); p_norm2(F, args, OPQ(0), OPQ(mrows), 6400); }
#endif
 SEAM(pb + 7);
        if (PM(9) && IN(pb + 8)) for (int rep_ = 0; rep_ < NREP(9); ++rep_) { if (rep_) GRID_BAR(); FRESH(); p_dispatch(F, OPQ(0), OPQ(mrows)); } SEAM(pb + 8);
        if (PM(10) && IN(pb + 9)) for (int rep_ = 0; rep_ < NREP(10); ++rep_) { if (rep_) GRID_BAR(); const int Lg = OPQ(0);
            const unsigned* blke = F.ctl + CW_BLKE + Lg * 1024; const int nblk = (int)__hip_atomic_load(blke, RLX_AGENT);
            pg8::Gemm g{F.ws + WS_BUF, F.ws + WS_WGU + (size_t)Lg * NEXP * 2048 * DM, DM, DM, OPQ(DM / 2)};
            SgOrder<FillMoe> S; S.init(nblk, 8, F.G, F.bid); S.f = FillMoe{blke, 2048};
            EpiSwiglu E{(unsigned char*)(F.ws + WS_ACT), args.in[I_BGU] + (size_t)Lg * NEXP * 2048};
            pg8::gemm_phase<EpiSwiglu, SgOrder<FillMoe>, true, F8_ALIGN, F8_SP2>(F.lds, g, S, E, fresh_tid(F.wave));
        }
#if defined(SHADOW_GU)
        if (PM(10) && IN(pb + 9)) { GRID_BAR(); const int Lg = OPQ(0);
            const unsigned* blke = F.ctl + CW_BLKE + Lg * 1024; const int nblk = (int)__hip_atomic_load(blke, RLX_AGENT);
            pg8::Gemm g{F.ws + WS_BUF, F.ws + WS_WGU + (size_t)Lg * NEXP * 2048 * DM, DM, DM, OPQ(DM / 2)};
            SgOrder<FillMoe> S; S.init(nblk, 8, F.G, F.bid); S.f = FillMoe{blke, 2048, SHADOW_GU == 2};
#if SHADOW_GU == 3
            EpiNull E{(float*)(F.ws + WS_Y)};
            pg8::gemm_phase<EpiNull, SgOrder<FillMoe>, true, F8_ALIGN, F8_SP2>(F.lds, g, S, E, fresh_tid(F.wave));
#else
            EpiSwiglu E{(unsigned char*)(F.ws + WS_Y), args.in[I_BGU] + (size_t)Lg * NEXP * 2048};
            pg8::gemm_phase<EpiSwiglu, SgOrder<FillMoe>, true, F8_ALIGN, F8_SP2>(F.lds, g, S, E, fresh_tid(F.wave));
#endif
        }
#endif
        SEAM(pb + 9);
        if (PM(11) && IN(pb + 10)) for (int rep_ = 0; rep_ < NREP(11); ++rep_) { if (rep_) GRID_BAR(); const int Lg = OPQ(0);
            const unsigned* blke = F.ctl + CW_BLKE + Lg * 1024; const int nblk = (int)__hip_atomic_load(blke, RLX_AGENT);
            pg8::Gemm g{F.ws + WS_ACT, F.ws + WS_WDN + (size_t)Lg * NEXP * DM * DM, DM, DM, OPQ(DM / 2)};
            SgOrder<FillMoe> S; S.init(nblk, 4, F.G, F.bid); S.f = FillMoe{blke, 1024};
            EpiDown E{(bf16*)(F.ws + WS_Y), args.in[I_BDN] + (size_t)Lg * NEXP * DM, (const float*)(F.ws + WS_SG)};
            pg8::gemm_phase<EpiDown, SgOrder<FillMoe>, true, F8_ALIGN, F8_SP2>(F.lds, g, S, E, fresh_tid(F.wave));
        } SEAM(pb + 10);
        }
    {
        const int pb = 1 + 1 * NPH;
        const int mrows = (1 == DEPTH - 1) ? NLAT : NT;
        if (PM(1) && IN(pb + 0)) { FRESH(); p_norm1(F, args, OPQ(1)); }
#ifdef DUP_NORM1
        GRID_BAR(); if (PM(1) && IN(pb + 0)) { FRESH(); p_norm1(F, args, OPQ(1), true); }
#endif
 SEAM(pb + 0);
        if (PM(2) && IN(pb + 1)) for (int rep_ = 0; rep_ < NREP(2); ++rep_) { if (rep_) GRID_BAR(); const int Lg = OPQ(1);
            pg8::Gemm g{(const bf16*)(F.ws + WS_H), (const bf16*)(F.ws + WS_WIN) + (size_t)Lg * PW * DM, DM * 2, DM * 2, OPQ(DM)};
            SgOrder<FillPlain> S; S.init(NT / 256, PW / 256, F.G, F.bid); S.f = FillPlain{(size_t)256 * DM * 2, (size_t)256 * DM * 2};
            EpiInproj E{(bf16*)(F.ws + WS_PBUF), (bf16*)(F.ws + WS_A2)};
            pg8::gemm_phase(F.lds, g, S, E, fresh_tid(F.wave));
        } SEAM(pb + 1);
        if (PM(3) && IN(pb + 2)) for (int rep_ = 0; rep_ < NREP(3); ++rep_) { if (rep_) GRID_BAR(); FRESH(); p_mix_a(F, args, OPQ(1), rep_); } SEAM(pb + 2);
        if (PM(4) && IN(pb + 3)) for (int rep_ = 0; rep_ < NREP(4); ++rep_) { if (rep_) GRID_BAR(); FRESH(); p_mix_b(F, args, OPQ(1), rep_); } SEAM(pb + 3);
        if (PM(5) && IN(pb + 4)) for (int rep_ = 0; rep_ < NREP(5); ++rep_) { if (rep_) GRID_BAR(); FRESH(); p_mix_c(F, args, OPQ(1), rep_); } SEAM(pb + 4);
        if (PM(6) && IN(pb + 5)) for (int rep_ = 0; rep_ < NREP(6); ++rep_) { if (rep_) GRID_BAR(); const int Lg = OPQ(1);
            pg8::Gemm g{(const bf16*)(F.ws + WS_ACT5), (const bf16*)(F.ws + WS_WGLU) + (size_t)Lg * 256 * 256, 512, 512, OPQ(256)};
            SgOrder<FillPlain> S; S.init(NT / 256, 1, F.G, F.bid); S.f = FillPlain{(size_t)256 * 256 * 2, 0};
            EpiGlu E{(const bf16*)(F.ws + WS_ACT5), (bf16*)(F.ws + WS_MIX)};
            pg8::gemm_phase(F.lds, g, S, E, fresh_tid(F.wave));
        } SEAM(pb + 5);
        if (PM(7) && IN(pb + 6)) { const int Lg = OPQ(1);
            pg8::Gemm g{(const bf16*)(F.ws + WS_MIX), (const bf16*)(F.ws + WS_WOUT) + (size_t)Lg * DM * MW, MW * 2, MW * 2, OPQ(MW)};
            SgOrder<FillPlain> S; S.init((Lg == DEPTH - 1 ? NLAT : NT) / 256, DM / 256, F.G, F.bid); S.f = FillPlain{(size_t)256 * MW * 2, (size_t)256 * MW * 2};
            EpiOutproj E{args.in[I_X], args.in[I_CTX], (bf16*)(F.ws + WS_XS), (const float*)(F.ws + WS_MOD) + (size_t)Lg * 9 * 6144, Lg == 0 ? 1 : 0};
            pg8::gemm_phase(F.lds, g, S, E, fresh_tid(F.wave));
        } SEAM(pb + 6);
        if (PM(8) && IN(pb + 7)) { FRESH(); p_norm2(F, args, OPQ(1), OPQ(mrows)); }
#ifdef DUP_NORM2
        GRID_BAR(); if (PM(8) && IN(pb + 7)) { FRESH(); p_norm2(F, args, OPQ(1), OPQ(mrows), 6400); }
#endif
 SEAM(pb + 7);
        if (PM(9) && IN(pb + 8)) for (int rep_ = 0; rep_ < NREP(9); ++rep_) { if (rep_) GRID_BAR(); FRESH(); p_dispatch(F, OPQ(1), OPQ(mrows)); } SEAM(pb + 8);
        if (PM(10) && IN(pb + 9)) for (int rep_ = 0; rep_ < NREP(10); ++rep_) { if (rep_) GRID_BAR(); const int Lg = OPQ(1);
            const unsigned* blke = F.ctl + CW_BLKE + Lg * 1024; const int nblk = (int)__hip_atomic_load(blke, RLX_AGENT);
            pg8::Gemm g{F.ws + WS_BUF, F.ws + WS_WGU + (size_t)Lg * NEXP * 2048 * DM, DM, DM, OPQ(DM / 2)};
            SgOrder<FillMoe> S; S.init(nblk, 8, F.G, F.bid); S.f = FillMoe{blke, 2048};
            EpiSwiglu E{(unsigned char*)(F.ws + WS_ACT), args.in[I_BGU] + (size_t)Lg * NEXP * 2048};
            pg8::gemm_phase<EpiSwiglu, SgOrder<FillMoe>, true, F8_ALIGN, F8_SP2>(F.lds, g, S, E, fresh_tid(F.wave));
        }
#if defined(SHADOW_GU)
        if (PM(10) && IN(pb + 9)) { GRID_BAR(); const int Lg = OPQ(1);
            const unsigned* blke = F.ctl + CW_BLKE + Lg * 1024; const int nblk = (int)__hip_atomic_load(blke, RLX_AGENT);
            pg8::Gemm g{F.ws + WS_BUF, F.ws + WS_WGU + (size_t)Lg * NEXP * 2048 * DM, DM, DM, OPQ(DM / 2)};
            SgOrder<FillMoe> S; S.init(nblk, 8, F.G, F.bid); S.f = FillMoe{blke, 2048, SHADOW_GU == 2};
#if SHADOW_GU == 3
            EpiNull E{(float*)(F.ws + WS_Y)};
            pg8::gemm_phase<EpiNull, SgOrder<FillMoe>, true, F8_ALIGN, F8_SP2>(F.lds, g, S, E, fresh_tid(F.wave));
#else
            EpiSwiglu E{(unsigned char*)(F.ws + WS_Y), args.in[I_BGU] + (size_t)Lg * NEXP * 2048};
            pg8::gemm_phase<EpiSwiglu, SgOrder<FillMoe>, true, F8_ALIGN, F8_SP2>(F.lds, g, S, E, fresh_tid(F.wave));
#endif
        }
#endif
        SEAM(pb + 9);
        if (PM(11) && IN(pb + 10)) for (int rep_ = 0; rep_ < NREP(11); ++rep_) { if (rep_) GRID_BAR(); const int Lg = OPQ(1);
            const unsigned* blke = F.ctl + CW_BLKE + Lg * 1024; const int nblk = (int)__hip_atomic_load(blke, RLX_AGENT);
            pg8::Gemm g{F.ws + WS_ACT, F.ws + WS_WDN + (size_t)Lg * NEXP * DM * DM, DM, DM, OPQ(DM / 2)};
            SgOrder<FillMoe> S; S.init(nblk, 4, F.G, F.bid); S.f = FillMoe{blke, 1024};
            EpiDown E{(bf16*)(F.ws + WS_Y), args.in[I_BDN] + (size_t)Lg * NEXP * DM, (const float*)(F.ws + WS_SG)};
            pg8::gemm_phase<EpiDown, SgOrder<FillMoe>, true, F8_ALIGN, F8_SP2>(F.lds, g, S, E, fresh_tid(F.wave));
        } SEAM(pb + 10);
        }
    {
        const int pb = 1 + 2 * NPH;
        const int mrows = (2 == DEPTH - 1) ? NLAT : NT;
        if (PM(1) && IN(pb + 0)) { FRESH(); p_norm1(F, args, OPQ(2)); }
#ifdef DUP_NORM1
        GRID_BAR(); if (PM(1) && IN(pb + 0)) { FRESH(); p_norm1(F, args, OPQ(2), true); }
#endif
 SEAM(pb + 0);
        if (PM(2) && IN(pb + 1)) for (int rep_ = 0; rep_ < NREP(2); ++rep_) { if (rep_) GRID_BAR(); const int Lg = OPQ(2);
            pg8::Gemm g{(const bf16*)(F.ws + WS_H), (const bf16*)(F.ws + WS_WIN) + (size_t)Lg * PW * DM, DM * 2, DM * 2, OPQ(DM)};
            SgOrder<FillPlain> S; S.init(NT / 256, PW / 256, F.G, F.bid); S.f = FillPlain{(size_t)256 * DM * 2, (size_t)256 * DM * 2};
            EpiInproj E{(bf16*)(F.ws + WS_PBUF), (bf16*)(F.ws + WS_A2)};
            pg8::gemm_phase(F.lds, g, S, E, fresh_tid(F.wave));
        } SEAM(pb + 1);
        if (PM(3) && IN(pb + 2)) for (int rep_ = 0; rep_ < NREP(3); ++rep_) { if (rep_) GRID_BAR(); FRESH(); p_mix_a(F, args, OPQ(2), rep_); } SEAM(pb + 2);
        if (PM(4) && IN(pb + 3)) for (int rep_ = 0; rep_ < NREP(4); ++rep_) { if (rep_) GRID_BAR(); FRESH(); p_mix_b(F, args, OPQ(2), rep_); } SEAM(pb + 3);
        if (PM(5) && IN(pb + 4)) for (int rep_ = 0; rep_ < NREP(5); ++rep_) { if (rep_) GRID_BAR(); FRESH(); p_mix_c(F, args, OPQ(2), rep_); } SEAM(pb + 4);
        if (PM(6) && IN(pb + 5)) for (int rep_ = 0; rep_ < NREP(6); ++rep_) { if (rep_) GRID_BAR(); const int Lg = OPQ(2);
            pg8::Gemm g{(const bf16*)(F.ws + WS_ACT5), (const bf16*)(F.ws + WS_WGLU) + (size_t)Lg * 256 * 256, 512, 512, OPQ(256)};
            SgOrder<FillPlain> S; S.init(NT / 256, 1, F.G, F.bid); S.f = FillPlain{(size_t)256 * 256 * 2, 0};
            EpiGlu E{(const bf16*)(F.ws + WS_ACT5), (bf16*)(F.ws + WS_MIX)};
            pg8::gemm_phase(F.lds, g, S, E, fresh_tid(F.wave));
        } SEAM(pb + 5);
        if (PM(7) && IN(pb + 6)) { const int Lg = OPQ(2);
            pg8::Gemm g{(const bf16*)(F.ws + WS_MIX), (const bf16*)(F.ws + WS_WOUT) + (size_t)Lg * DM * MW, MW * 2, MW * 2, OPQ(MW)};
            SgOrder<FillPlain> S; S.init((Lg == DEPTH - 1 ? NLAT : NT) / 256, DM / 256, F.G, F.bid); S.f = FillPlain{(size_t)256 * MW * 2, (size_t)256 * MW * 2};
            EpiOutproj E{args.in[I_X], args.in[I_CTX], (bf16*)(F.ws + WS_XS), (const float*)(F.ws + WS_MOD) + (size_t)Lg * 9 * 6144, Lg == 0 ? 1 : 0};
            pg8::gemm_phase(F.lds, g, S, E, fresh_tid(F.wave));
        } SEAM(pb + 6);
        if (PM(8) && IN(pb + 7)) { FRESH(); p_norm2(F, args, OPQ(2), OPQ(mrows)); }
#ifdef DUP_NORM2
        GRID_BAR(); if (PM(8) && IN(pb + 7)) { FRESH(); p_norm2(F, args, OPQ(2), OPQ(mrows), 6400); }
#endif
 SEAM(pb + 7);
        if (PM(9) && IN(pb + 8)) for (int rep_ = 0; rep_ < NREP(9); ++rep_) { if (rep_) GRID_BAR(); FRESH(); p_dispatch(F, OPQ(2), OPQ(mrows)); } SEAM(pb + 8);
        if (PM(10) && IN(pb + 9)) for (int rep_ = 0; rep_ < NREP(10); ++rep_) { if (rep_) GRID_BAR(); const int Lg = OPQ(2);
            const unsigned* blke = F.ctl + CW_BLKE + Lg * 1024; const int nblk = (int)__hip_atomic_load(blke, RLX_AGENT);
            pg8::Gemm g{F.ws + WS_BUF, F.ws + WS_WGU + (size_t)Lg * NEXP * 2048 * DM, DM, DM, OPQ(DM / 2)};
            SgOrder<FillMoe> S; S.init(nblk, 8, F.G, F.bid); S.f = FillMoe{blke, 2048};
            EpiSwiglu E{(unsigned char*)(F.ws + WS_ACT), args.in[I_BGU] + (size_t)Lg * NEXP * 2048};
            pg8::gemm_phase<EpiSwiglu, SgOrder<FillMoe>, true, F8_ALIGN, F8_SP2>(F.lds, g, S, E, fresh_tid(F.wave));
        }
#if defined(SHADOW_GU)
        if (PM(10) && IN(pb + 9)) { GRID_BAR(); const int Lg = OPQ(2);
            const unsigned* blke = F.ctl + CW_BLKE + Lg * 1024; const int nblk = (int)__hip_atomic_load(blke, RLX_AGENT);
            pg8::Gemm g{F.ws + WS_BUF, F.ws + WS_WGU + (size_t)Lg * NEXP * 2048 * DM, DM, DM, OPQ(DM / 2)};
            SgOrder<FillMoe> S; S.init(nblk, 8, F.G, F.bid); S.f = FillMoe{blke, 2048, SHADOW_GU == 2};
#if SHADOW_GU == 3
            EpiNull E{(float*)(F.ws + WS_Y)};
            pg8::gemm_phase<EpiNull, SgOrder<FillMoe>, true, F8_ALIGN, F8_SP2>(F.lds, g, S, E, fresh_tid(F.wave));
#else
            EpiSwiglu E{(unsigned char*)(F.ws + WS_Y), args.in[I_BGU] + (size_t)Lg * NEXP * 2048};
            pg8::gemm_phase<EpiSwiglu, SgOrder<FillMoe>, true, F8_ALIGN, F8_SP2>(F.lds, g, S, E, fresh_tid(F.wave));
#endif
        }
#endif
        SEAM(pb + 9);
        if (PM(11) && IN(pb + 10)) for (int rep_ = 0; rep_ < NREP(11); ++rep_) { if (rep_) GRID_BAR(); const int Lg = OPQ(2);
            const unsigned* blke = F.ctl + CW_BLKE + Lg * 1024; const int nblk = (int)__hip_atomic_load(blke, RLX_AGENT);
            pg8::Gemm g{F.ws + WS_ACT, F.ws + WS_WDN + (size_t)Lg * NEXP * DM * DM, DM, DM, OPQ(DM / 2)};
            SgOrder<FillMoe> S; S.init(nblk, 4, F.G, F.bid); S.f = FillMoe{blke, 1024};
            EpiDown E{(bf16*)(F.ws + WS_Y), args.in[I_BDN] + (size_t)Lg * NEXP * DM, (const float*)(F.ws + WS_SG)};
            pg8::gemm_phase<EpiDown, SgOrder<FillMoe>, true, F8_ALIGN, F8_SP2>(F.lds, g, S, E, fresh_tid(F.wave));
        } SEAM(pb + 10);
        }
    {
        const int pb = 1 + 3 * NPH;
        const int mrows = (3 == DEPTH - 1) ? NLAT : NT;
        if (PM(1) && IN(pb + 0)) { FRESH(); p_norm1(F, args, OPQ(3)); }
#ifdef DUP_NORM1
        GRID_BAR(); if (PM(1) && IN(pb + 0)) { FRESH(); p_norm1(F, args, OPQ(3), true); }
#endif
 SEAM(pb + 0);
        if (PM(2) && IN(pb + 1)) for (int rep_ = 0; rep_ < NREP(2); ++rep_) { if (rep_) GRID_BAR(); const int Lg = OPQ(3);
            pg8::Gemm g{(const bf16*)(F.ws + WS_H), (const bf16*)(F.ws + WS_WIN) + (size_t)Lg * PW * DM, DM * 2, DM * 2, OPQ(DM)};
            SgOrder<FillPlain> S; S.init(NT / 256, PW / 256, F.G, F.bid); S.f = FillPlain{(size_t)256 * DM * 2, (size_t)256 * DM * 2};
            EpiInproj E{(bf16*)(F.ws + WS_PBUF), (bf16*)(F.ws + WS_A2)};
            pg8::gemm_phase(F.lds, g, S, E, fresh_tid(F.wave));
        } SEAM(pb + 1);
        if (PM(3) && IN(pb + 2)) for (int rep_ = 0; rep_ < NREP(3); ++rep_) { if (rep_) GRID_BAR(); FRESH(); p_mix_a(F, args, OPQ(3), rep_); } SEAM(pb + 2);
        if (PM(4) && IN(pb + 3)) for (int rep_ = 0; rep_ < NREP(4); ++rep_) { if (rep_) GRID_BAR(); FRESH(); p_mix_b(F, args, OPQ(3), rep_); } SEAM(pb + 3);
        if (PM(5) && IN(pb + 4)) for (int rep_ = 0; rep_ < NREP(5); ++rep_) { if (rep_) GRID_BAR(); FRESH(); p_mix_c(F, args, OPQ(3), rep_); } SEAM(pb + 4);
        if (PM(6) && IN(pb + 5)) for (int rep_ = 0; rep_ < NREP(6); ++rep_) { if (rep_) GRID_BAR(); const int Lg = OPQ(3);
            pg8::Gemm g{(const bf16*)(F.ws + WS_ACT5), (const bf16*)(F.ws + WS_WGLU) + (size_t)Lg * 256 * 256, 512, 512, OPQ(256)};
            SgOrder<FillPlain> S; S.init(NT / 256, 1, F.G, F.bid); S.f = FillPlain{(size_t)256 * 256 * 2, 0};
            EpiGlu E{(const bf16*)(F.ws + WS_ACT5), (bf16*)(F.ws + WS_MIX)};
            pg8::gemm_phase(F.lds, g, S, E, fresh_tid(F.wave));
        } SEAM(pb + 5);
        if (PM(7) && IN(pb + 6)) { const int Lg = OPQ(3);
            pg8::Gemm g{(const bf16*)(F.ws + WS_MIX), (const bf16*)(F.ws + WS_WOUT) + (size_t)Lg * DM * MW, MW * 2, MW * 2, OPQ(MW)};
            SgOrder<FillPlain> S; S.init((Lg == DEPTH - 1 ? NLAT : NT) / 256, DM / 256, F.G, F.bid); S.f = FillPlain{(size_t)256 * MW * 2, (size_t)256 * MW * 2};
            EpiOutproj E{args.in[I_X], args.in[I_CTX], (bf16*)(F.ws + WS_XS), (const float*)(F.ws + WS_MOD) + (size_t)Lg * 9 * 6144, Lg == 0 ? 1 : 0};
            pg8::gemm_phase(F.lds, g, S, E, fresh_tid(F.wave));
        } SEAM(pb + 6);
        if (PM(8) && IN(pb + 7)) { FRESH(); p_norm2(F, args, OPQ(3), OPQ(mrows)); }
#ifdef DUP_NORM2
        GRID_BAR(); if (PM(8) && IN(pb + 7)) { FRESH(); p_norm2(F, args, OPQ(3), OPQ(mrows), 6400); }
#endif
 SEAM(pb + 7);
        if (PM(9) && IN(pb + 8)) for (int rep_ = 0; rep_ < NREP(9); ++rep_) { if (rep_) GRID_BAR(); FRESH(); p_dispatch(F, OPQ(3), OPQ(mrows)); } SEAM(pb + 8);
        if (PM(10) && IN(pb + 9)) for (int rep_ = 0; rep_ < NREP(10); ++rep_) { if (rep_) GRID_BAR(); const int Lg = OPQ(3);
            const unsigned* blke = F.ctl + CW_BLKE + Lg * 1024; const int nblk = (int)__hip_atomic_load(blke, RLX_AGENT);
            pg8::Gemm g{F.ws + WS_BUF, F.ws + WS_WGU + (size_t)Lg * NEXP * 2048 * DM, DM, DM, OPQ(DM / 2)};
            SgOrder<FillMoe> S; S.init(nblk, 8, F.G, F.bid); S.f = FillMoe{blke, 2048};
            EpiSwiglu E{(unsigned char*)(F.ws + WS_ACT), args.in[I_BGU] + (size_t)Lg * NEXP * 2048};
            pg8::gemm_phase<EpiSwiglu, SgOrder<FillMoe>, true, F8_ALIGN, F8_SP2>(F.lds, g, S, E, fresh_tid(F.wave));
        }
#if defined(SHADOW_GU)
        if (PM(10) && IN(pb + 9)) { GRID_BAR(); const int Lg = OPQ(3);
            const unsigned* blke = F.ctl + CW_BLKE + Lg * 1024; const int nblk = (int)__hip_atomic_load(blke, RLX_AGENT);
            pg8::Gemm g{F.ws + WS_BUF, F.ws + WS_WGU + (size_t)Lg * NEXP * 2048 * DM, DM, DM, OPQ(DM / 2)};
            SgOrder<FillMoe> S; S.init(nblk, 8, F.G, F.bid); S.f = FillMoe{blke, 2048, SHADOW_GU == 2};
#if SHADOW_GU == 3
            EpiNull E{(float*)(F.ws + WS_Y)};
            pg8::gemm_phase<EpiNull, SgOrder<FillMoe>, true, F8_ALIGN, F8_SP2>(F.lds, g, S, E, fresh_tid(F.wave));
#else
            EpiSwiglu E{(unsigned char*)(F.ws + WS_Y), args.in[I_BGU] + (size_t)Lg * NEXP * 2048};
            pg8::gemm_phase<EpiSwiglu, SgOrder<FillMoe>, true, F8_ALIGN, F8_SP2>(F.lds, g, S, E, fresh_tid(F.wave));
#endif
        }
#endif
        SEAM(pb + 9);
        if (PM(11) && IN(pb + 10)) for (int rep_ = 0; rep_ < NREP(11); ++rep_) { if (rep_) GRID_BAR(); const int Lg = OPQ(3);
            const unsigned* blke = F.ctl + CW_BLKE + Lg * 1024; const int nblk = (int)__hip_atomic_load(blke, RLX_AGENT);
            pg8::Gemm g{F.ws + WS_ACT, F.ws + WS_WDN + (size_t)Lg * NEXP * DM * DM, DM, DM, OPQ(DM / 2)};
            SgOrder<FillMoe> S; S.init(nblk, 4, F.G, F.bid); S.f = FillMoe{blke, 1024};
            EpiDown E{(bf16*)(F.ws + WS_Y), args.in[I_BDN] + (size_t)Lg * NEXP * DM, (const float*)(F.ws + WS_SG)};
            pg8::gemm_phase<EpiDown, SgOrder<FillMoe>, true, F8_ALIGN, F8_SP2>(F.lds, g, S, E, fresh_tid(F.wave));
        } SEAM(pb + 10);
        }
    if (PM(12) && IN(PH_TOTAL - 1)) { FRESH(); p_final(F, args); }
#undef IN
#undef SEAM
#undef args
}

extern "C" void kernel_launch(void* const* d_in, const int* in_sizes, int n_in, void* d_out, int out_size, void* d_ws, size_t ws_size, hipStream_t stream) {
    static int grid = 0;
    if (grid == 0) {
        if (n_in != N_IN || out_size != NLAT * DM || ws_size < WS_END) { fprintf(stderr, "kernel_launch: unexpected shapes (n_in %d, out %d, ws %zu < %zu); nothing launched\n", n_in, out_size, ws_size, (size_t)WS_END); grid = -1; return; }
        int dev = 0, cus = 0, per_cu = 0;
        if (hipGetDevice(&dev) != hipSuccess || hipDeviceGetAttribute(&cus, hipDeviceAttributeMultiprocessorCount, dev) != hipSuccess) { grid = -1; return; }
        if (hipFuncSetAttribute((const void*)mk_fwd, hipFuncAttributeMaxDynamicSharedMemorySize, LDS_BYTES) != hipSuccess) { fprintf(stderr, "kernel_launch: hipFuncSetAttribute failed\n"); grid = -1; return; }
        if (hipOccupancyMaxActiveBlocksPerMultiprocessor(&per_cu, (const void*)mk_fwd, NTHR, LDS_BYTES) != hipSuccess || per_cu < 1) fprintf(stderr, "kernel_launch: occupancy query says %d\n", per_cu);
        (void)hipGetLastError();
        grid = cus;
    }
    if (grid < 0) return;
    (void)hipMemsetAsync((char*)d_ws + WS_CTL, 0, CTL_BYTES, stream);
    Args a{};
    for (int i = 0; i < N_IN; ++i) a.in[i] = (const float*)d_in[i];
    a.out = (float*)d_out; a.ws = (unsigned char*)d_ws;
#if MK_ONE_LAUNCH
    a.ph_lo = 0; a.ph_hi = PH_TOTAL;
    hipLaunchKernelGGL(mk_fwd, dim3(grid), dim3(NTHR), LDS_BYTES, stream, a);
#else
    for (int p = 0; p < PH_TOTAL; ++p) { a.ph_lo = p; a.ph_hi = p + 1; hipLaunchKernelGGL(mk_fwd, dim3(grid), dim3(NTHR), LDS_BYTES, stream, a); }
#endif
}
```

```cpp
#define MK_ONE_LAUNCH 1
#define F8_ALIGN true
#define F8_SP2 true
#include <hip/hip_runtime.h>
#include <cstdio>
#include <cstdint>

#define GAS __attribute__((address_space(1)))
#define LAS __attribute__((address_space(3)))
typedef unsigned short bf16;
typedef short bf16x8 __attribute__((ext_vector_type(8)));
typedef short s16x4 __attribute__((ext_vector_type(4)));
typedef float f32x4 __attribute__((ext_vector_type(4)));
typedef float f32x2 __attribute__((ext_vector_type(2)));
typedef unsigned u32x4 __attribute__((ext_vector_type(4)));
typedef unsigned u32x2 __attribute__((ext_vector_type(2)));

namespace pg8 {
#define PG8_LAS __attribute__((address_space(3)))
typedef unsigned short bf16_t;
constexpr int BM = 256, BK = 64, HALF = 128, HTB = HALF * BK * 2  , STAGE_BYTES = 8 * HTB;

__host__ __device__ __forceinline__ int lds_byte(int r, int c) { const int st = (r >> 4) * 2 + (c >> 5), rr = r & 15, cc = c & 31, ob = rr * 64 + cc * 2; return st * 1024 + (ob ^ (((ob >> 9) & 1) << 5)); }
__host__ __device__ __forceinline__ void stage_rc(int b, int& R, int& C) { const int st = b / 1024, sb = b % 1024, swz = sb ^ (((sb >> 9) & 1) << 5); R = (st >> 1) * 16 + swz / 64; C = (st & 1) * 32 + (swz % 64) / 2; }
__host__ __device__ __forceinline__ int lds_byte_f8(int r, int c) { const int st = (r >> 4) * 2 + (c >> 5), rr = r & 15, cc = c & 31, ob = rr * 64 + cc * 2; return st * 1024 + (ob ^ (((ob >> 9) & 1) << 4)); }
__host__ __device__ __forceinline__ void stage_rc_f8(int b, int& R, int& C) { const int st = b / 1024, sb = b % 1024, swz = sb ^ (((sb >> 9) & 1) << 4); R = (st >> 1) * 16 + swz / 64; C = (st & 1) * 32 + (swz % 64) / 2; }
__host__ __device__ __forceinline__ int perm32(int rho) { const int n = rho >> 4, i = rho & 15; return 8 * (i >> 2) + 4 * n + (i & 3); }

struct Unit { int pm, pn, grp; size_t aoff, boff; };
struct Gemm { const void* A; const void* Bt; int lda, ldb, K; };

__device__ __forceinline__ unsigned cvt_pk_bf16(float lo, float hi) { unsigned r; asm volatile("v_cvt_pk_bf16_f32 %0, %1, %2" : "=v"(r) : "v"(lo), "v"(hi)); return r; }

typedef int v8i_t __attribute__((ext_vector_type(8)));
typedef int v4i_t __attribute__((ext_vector_type(4)));
template <class Epi, class Sched, bool F8 = false, bool ALIGN_EPI = true, bool SP2 = true, bool GATHER = false>
__device__ __forceinline__ void gemm_phase(PG8_LAS unsigned char* lds, const Gemm g, const Sched& S, const Epi& E, int tid_in, const PG8_LAS unsigned* gat = nullptr) {
    static_assert(!GATHER || SP2, "gather is written for the SP2 loop");
    int tid = tid_in; asm volatile("" : "+v"(tid));
    const int wid = __builtin_amdgcn_readfirstlane(tid >> 6), lane = tid & 63, wr = wid >> 2, wc = wid & 3, fr = lane & 15, fq = lane >> 4;
    const int K = g.K, nt = K / BK;
    unsigned voffA[2], voffB[2];
#pragma unroll
    for (int i = 0; i < 2; ++i) { int R, C; if constexpr (F8) stage_rc_f8(tid * 16 + i * 8192, R, C); else stage_rc(tid * 16 + i * 8192, R, C); const int Rb = Epi::PERM ? ((R & ~31) + perm32(R & 31)) : R;
        voffA[i] = GATHER ? (unsigned)(R * 65536 + C * 2) : (unsigned)(R * g.lda + C * 2); voffB[i] = (unsigned)(Rb * g.ldb + C * 2); }
    unsigned vA0[2], vA1[2];
    const size_t kstep = (size_t)(BK * 2);
    const size_t hstepA = (size_t)HALF * g.lda, hstepB = (size_t)HALF * g.ldb;
#define PG8_GLOAD(ui_) do { _Pragma("unroll") for (int _i = 0; _i < 2; ++_i) { const int r_ = (int)(voffA[_i] >> 16); const unsigned c_ = voffA[_i] & 0xffffu; \
        vA0[_i] = gat[(ui_) * 256 + r_] + c_; vA1[_i] = gat[(ui_) * 256 + 128 + r_] + c_; } } while (0)
    if constexpr (GATHER) PG8_GLOAD(0); else { vA0[0] = voffA[0]; vA0[1] = voffA[1]; vA1[0] = voffA[0] + (unsigned)hstepA; vA1[1] = voffA[1] + (unsigned)hstepA; }
    int ui = 0;
    const unsigned ldsw = (unsigned)wid * 1024u;
    const int aoff = F8 ? lds_byte_f8(wr * 64 + fr, fq * 16) : lds_byte(wr * 64 + fr, fq * 8), boff = F8 ? lds_byte_f8(wc * 32 + fr, fq * 16) : lds_byte(wc * 32 + fr, fq * 8);
    const int aoff1 = lds_byte_f8(wr * 64 + fr, fq * 16 + 8), boff1 = lds_byte_f8(wc * 32 + fr, fq * 16 + 8);
#define PG8_SA(b, h) (((b) * 2 + (h)) * HTB)
#define PG8_SB(b, h) ((4 + (b) * 2 + (h)) * HTB)
#define PG8_STAGE(bufoff, gbase, voff) do { _Pragma("unroll") for (int _i = 0; _i < 2; ++_i) \
        __builtin_amdgcn_global_load_lds((const unsigned*)((const char*)(gbase) + (voff)[_i]), (PG8_LAS unsigned*)(lds + (bufoff) + ldsw + _i * 8192), 16, 0, 0); } while (0)
#define PG8_LD16(off) (*(const PG8_LAS v4i_t*)(lds + (off)))
#define PG8_LDA(dst, b, h) do { if constexpr (F8) { _Pragma("unroll") for (int m = 0; m < 4; ++m) A8[m] = __builtin_shufflevector(PG8_LD16(PG8_SA(b, h) + aoff + m * 2048), PG8_LD16(PG8_SA(b, h) + aoff1 + m * 2048), 0, 1, 2, 3, 4, 5, 6, 7); } \
        else { _Pragma("unroll") for (int m = 0; m < 4; ++m) _Pragma("unroll") for (int k = 0; k < 2; ++k) dst[m][k] = *(const PG8_LAS bf16x8*)(lds + PG8_SA(b, h) + aoff + m * 2048 + k * 1024); } } while (0)
#define PG8_LDB(dst, b, h) do { if constexpr (F8) { _Pragma("unroll") for (int n = 0; n < 2; ++n) dst##8[n] = __builtin_shufflevector(PG8_LD16(PG8_SB(b, h) + boff + n * 2048), PG8_LD16(PG8_SB(b, h) + boff1 + n * 2048), 0, 1, 2, 3, 4, 5, 6, 7); } \
        else { _Pragma("unroll") for (int n = 0; n < 2; ++n) _Pragma("unroll") for (int k = 0; k < 2; ++k) dst[n][k] = *(const PG8_LAS bf16x8*)(lds + PG8_SB(b, h) + boff + n * 2048 + k * 1024); } } while (0)
#define PG8_MMA(ai, bj, At, Bt) do { __builtin_amdgcn_s_setprio(1); \
        if constexpr (F8) { _Pragma("unroll") for (int m = 0; m < 4; ++m) _Pragma("unroll") for (int n = 0; n < 2; ++n) \
            asm volatile("v_mfma_scale_f32_16x16x128_f8f6f4 %0, %1, %2, %0, %3, %3 op_sel_hi:[0,0,0]" : "+v"(acc[ai][bj][m][n]) : "v"(Bt##8[n]), "v"(A8[m]), "v"(one_scale)); } \
        else { _Pragma("unroll") for (int m = 0; m < 4; ++m) _Pragma("unroll") for (int n = 0; n < 2; ++n) _Pragma("unroll") for (int k = 0; k < 2; ++k) \
            acc[ai][bj][m][n] = __builtin_amdgcn_mfma_f32_16x16x32_bf16(Bt[n][k], At[m][k], acc[ai][bj][m][n], 0, 0, 0); } \
        __builtin_amdgcn_s_setprio(0); } while (0)
#define PG8_WAIT_V(n) asm volatile("s_waitcnt vmcnt(" #n ")" ::: "memory")
#define PG8_WAIT_L(n) asm volatile("s_waitcnt lgkmcnt(" #n ")" ::: "memory")
#define PG8_BAR __builtin_amdgcn_s_barrier()
#define PG8_SCHED __builtin_amdgcn_sched_barrier(0)
    Unit cur, nxt; int cursor = 0;
    if (!S.next(cursor, cur)) return;
    f32x4 acc[2][2][4][2];
#pragma unroll
    for (int a = 0; a < 2; ++a)
#pragma unroll
        for (int b = 0; b < 2; ++b)
#pragma unroll
            for (int m = 0; m < 4; ++m)
#pragma unroll
                for (int n = 0; n < 2; ++n) acc[a][b][m][n] = (f32x4){0.f, 0.f, 0.f, 0.f};
    bf16x8 At[4][2], B0[2][2], B1[2][2];
    v8i_t A8[4], B08[2], B18[2];
    int one_scale = 0x7F7F7F7F; asm volatile("" : "+v"(one_scale));
    const char* cA = (const char*)g.A + (GATHER ? (size_t)0 : cur.aoff); const char* cB = (const char*)g.Bt + cur.boff;
    if constexpr (SP2) {
        PG8_STAGE(PG8_SB(0, 0), cB, voffB); PG8_STAGE(PG8_SB(0, 1), cB + hstepB, voffB); PG8_STAGE(PG8_SA(0, 0), cA, vA0); PG8_STAGE(PG8_SA(0, 1), cA, vA1);
        if (wr == 1) PG8_BAR;
        PG8_WAIT_V(2); PG8_BAR;
        PG8_STAGE(PG8_SB(1, 0), cB + kstep, voffB); PG8_STAGE(PG8_SA(1, 0), cA + kstep, vA0); PG8_STAGE(PG8_SB(1, 1), cB + hstepB + kstep, voffB);
        PG8_WAIT_V(6); PG8_BAR;
    } else {
        PG8_STAGE(PG8_SB(0, 0), cB, voffB); PG8_STAGE(PG8_SA(0, 0), cA, voffA); PG8_STAGE(PG8_SB(0, 1), cB + hstepB, voffB); PG8_STAGE(PG8_SA(0, 1), cA + hstepA, voffA);
        if (wr == 1) PG8_BAR;
        PG8_WAIT_V(4); PG8_BAR;
        PG8_STAGE(PG8_SB(1, 0), cB + kstep, voffB); PG8_STAGE(PG8_SA(1, 0), cA + kstep, vA0); PG8_STAGE(PG8_SB(1, 1), cB + hstepB + kstep, voffB);
        PG8_WAIT_V(6); PG8_BAR;
    }
    for (;;) {
        const bool has_next = S.next(cursor, nxt);
        const char* nA = (has_next && !GATHER) ? (const char*)g.A + nxt.aoff : cA; const char* nB = has_next ? (const char*)g.Bt + nxt.boff : cB;
        for (int t = 0; t < nt; t += 2) {
            const bool last = (t == nt - 2);
            const char* a1 = cA + (size_t)(t + 1) * kstep;
            const char* a2 = last ? nA : cA + (size_t)(t + 2) * kstep; const char* b2 = last ? nB : cB + (size_t)(t + 2) * kstep;
            const char* a3 = a2 + kstep; const char* b3 = b2 + kstep;
            if constexpr (SP2) {
            PG8_LDB(B0, 0, 0); PG8_LDB(B1, 0, 1); PG8_SCHED; PG8_LDA(At, 0, 0); PG8_STAGE(PG8_SA(1, 1), a1, vA1);
            if constexpr (GATHER) { if (last && has_next) PG8_GLOAD(ui + 1); }
            PG8_WAIT_V(8); PG8_WAIT_L(0); PG8_BAR; PG8_MMA(0, 0, At, B0); PG8_MMA(0, 1, At, B1); PG8_BAR; PG8_SCHED;
            PG8_LDA(At, 0, 1); PG8_STAGE(PG8_SB(0, 0), b2, voffB); PG8_STAGE(PG8_SB(0, 1), b2 + hstepB, voffB); PG8_STAGE(PG8_SA(0, 0), a2, vA0);
            PG8_WAIT_V(8); PG8_WAIT_L(0); PG8_BAR; PG8_MMA(1, 0, At, B0); PG8_MMA(1, 1, At, B1); PG8_BAR; PG8_SCHED;
            PG8_LDB(B0, 1, 0); PG8_LDB(B1, 1, 1); PG8_SCHED; PG8_LDA(At, 1, 0); PG8_STAGE(PG8_SA(0, 1), a2, vA1);
            PG8_WAIT_V(8); PG8_WAIT_L(0); PG8_BAR; PG8_MMA(0, 0, At, B0); PG8_MMA(0, 1, At, B1); PG8_BAR; PG8_SCHED;
            PG8_LDA(At, 1, 1); PG8_STAGE(PG8_SB(1, 0), b3, voffB); PG8_STAGE(PG8_SB(1, 1), b3 + hstepB, voffB); PG8_STAGE(PG8_SA(1, 0), a3, vA0);
            PG8_WAIT_V(8); PG8_WAIT_L(0); PG8_BAR; PG8_MMA(1, 0, At, B0); PG8_MMA(1, 1, At, B1); PG8_BAR; PG8_SCHED;
            } else {
            PG8_LDB(B0, 0, 0); PG8_SCHED; PG8_LDA(At, 0, 0); PG8_STAGE(PG8_SA(1, 1), a1, vA1);
            PG8_WAIT_L(8); PG8_BAR; PG8_WAIT_L(0); PG8_MMA(0, 0, At, B0); PG8_BAR; PG8_SCHED;
            PG8_LDB(B1, 0, 1); PG8_STAGE(PG8_SB(0, 0), b2, voffB);
            PG8_BAR; PG8_WAIT_L(0); PG8_MMA(0, 1, At, B1); PG8_BAR;
            PG8_LDA(At, 0, 1); PG8_STAGE(PG8_SA(0, 0), a2, vA0);
            PG8_BAR; PG8_WAIT_L(0); PG8_MMA(1, 0, At, B0); PG8_BAR; PG8_SCHED;
            PG8_STAGE(PG8_SB(0, 1), b2 + hstepB, voffB);
            PG8_WAIT_V(6); PG8_BAR; PG8_MMA(1, 1, At, B1); PG8_BAR;
            PG8_LDB(B0, 1, 0); PG8_SCHED; PG8_LDA(At, 1, 0); PG8_STAGE(PG8_SA(0, 1), a2, vA1);
            PG8_WAIT_L(8); PG8_BAR; PG8_WAIT_L(0); PG8_MMA(0, 0, At, B0); PG8_BAR; PG8_SCHED;
            PG8_LDB(B1, 1, 1); PG8_STAGE(PG8_SB(1, 0), b3, voffB);
            PG8_BAR; PG8_WAIT_L(0); PG8_MMA(0, 1, At, B1); PG8_BAR;
            PG8_LDA(At, 1, 1); PG8_STAGE(PG8_SA(1, 0), a3, vA0);
            PG8_BAR; PG8_WAIT_L(0); PG8_MMA(1, 0, At, B0); PG8_BAR; PG8_SCHED;
            PG8_STAGE(PG8_SB(1, 1), b3 + hstepB, voffB);
            PG8_WAIT_V(6); PG8_BAR; PG8_MMA(1, 1, At, B1); PG8_BAR;
            }
        }
        if constexpr (F8) asm volatile("s_nop 15\n\ts_nop 15" ::: "memory");
        if constexpr (ALIGN_EPI) { if (wr == 0) PG8_BAR; }
        E(acc, cur, wr, wc, fr, fq);
        if (!has_next) break;
#pragma unroll
        for (int a = 0; a < 2; ++a)
#pragma unroll
            for (int b = 0; b < 2; ++b)
#pragma unroll
                for (int m = 0; m < 4; ++m)
#pragma unroll
                    for (int n = 0; n < 2; ++n) acc[a][b][m][n] = (f32x4){0.f, 0.f, 0.f, 0.f};
        cur = nxt; cA = nA; cB = nB; ++ui;
        if constexpr (ALIGN_EPI) { if (wr == 1) PG8_BAR; }
    }
    PG8_WAIT_V(0);
    if constexpr (!ALIGN_EPI) { if (wr == 0) PG8_BAR; }
    PG8_BAR;
#undef PG8_GLOAD
#undef PG8_SA
#undef PG8_SB
#undef PG8_STAGE
#undef PG8_LDA
#undef PG8_LDB
#undef PG8_MMA
#undef PG8_LD16
#undef PG8_WAIT_V
#undef PG8_WAIT_L
#undef PG8_BAR
#undef PG8_SCHED
}
}

#define XB_TMO      128
#define XB_XCNT(j)  (256  + 64 * (j))
#define XB_XSUB(j)  (1280 + 64 * (j))
#define XB_XGEN(j)  (2304 + 64 * (j))
#define XB_TOP      3328
#define XB_TOPGEN   3392
#define XCD_BAR_WORDS 3456
#define XB_SPIN_CAP (1u << 18)

__device__ __forceinline__ unsigned xb_ld(unsigned* p)              { return __hip_atomic_load(p, __ATOMIC_RELAXED, __HIP_MEMORY_SCOPE_AGENT); }
__device__ __forceinline__ unsigned xb_add(unsigned* p, unsigned v) { return __hip_atomic_fetch_add(p, v, __ATOMIC_RELAXED, __HIP_MEMORY_SCOPE_AGENT); }
__device__ __forceinline__ unsigned xb_xcc_id() { return (unsigned)__builtin_amdgcn_s_getreg((3 << 11) | 20) & 0xFu; }
#define XB_SPIN(cond, bar) do { unsigned _sp = 0; while (cond) { __builtin_amdgcn_s_sleep(1); \
    if ((++_sp & 255u) == 0u) { if (xb_ld(&(bar)[XB_TMO])) break; if (_sp > XB_SPIN_CAP) { atomicAdd(&(bar)[XB_TMO], 1u); break; } } } } while (0)

struct XcdBarrier {
    unsigned* bar; unsigned x;
    volatile LAS unsigned* st;
};

__device__ __forceinline__ XcdBarrier xcd_barrier_post(unsigned* bar, volatile LAS unsigned* st) {
    XcdBarrier b; b.bar = bar; b.x = xb_xcc_id(); b.st = st;
    if (threadIdx.x == 0) (void)xb_add(&bar[XB_XCNT(b.x)], 1u);
    return b;
}
__device__ __forceinline__ void xcd_barrier_complete(unsigned* bar, unsigned x, unsigned& nloc, unsigned& nx) {
    const unsigned G = gridDim.x * gridDim.y * gridDim.z;
    unsigned sum, cnt, mine, sp = 0u;
    for (;;) {
        sum = 0u; cnt = 0u; mine = 0u;
#pragma unroll
        for (unsigned j = 0; j < 16; ++j) { const unsigned c = xb_ld(&bar[XB_XCNT(j)]); sum += c; cnt += (c > 0u) ? 1u : 0u; mine = (j == x) ? c : mine; }
        if (sum == G) break;
        __builtin_amdgcn_s_sleep(1);
        if ((++sp & 255u) == 0u) { if (xb_ld(&bar[XB_TMO])) break; if (sp > XB_SPIN_CAP) { atomicAdd(&bar[XB_TMO], 1u); break; } }
    }
    nloc = mine > 0u ? mine : 1u; nx = cnt > 0u ? cnt : 1u;
}

__device__ __forceinline__ void xcd_barrier(const XcdBarrier& b) {
    asm volatile("s_waitcnt vmcnt(0)" ::: "memory");
    __syncthreads();
    if (threadIdx.x == 0) {
        unsigned* bar = b.bar;
        __builtin_amdgcn_s_waitcnt(0);
        unsigned nloc = b.st[0], nx = b.st[1];
        if (nloc == 0u) { xcd_barrier_complete(bar, b.x, nloc, nx); b.st[0] = nloc; b.st[1] = nx; }
        const unsigned old = xb_add(&bar[XB_XSUB(b.x)], 1u);
        const unsigned gen = old / nloc;
        if (old + 1u == (gen + 1u) * nloc) {
            __builtin_amdgcn_fence(__ATOMIC_RELEASE, "agent");
            asm volatile("s_waitcnt vmcnt(0)" ::: "memory");
            const unsigned og = xb_add(&bar[XB_TOP], 1u);
            const unsigned tg = og / nx;
            if (og + 1u == (tg + 1u) * nx) xb_add(&bar[XB_TOPGEN], 1u);
            else XB_SPIN(xb_ld(&bar[XB_TOPGEN]) == tg, bar);
            __builtin_amdgcn_fence(__ATOMIC_ACQUIRE, "agent");
            xb_add(&bar[XB_XGEN(b.x)], 1u);
            asm volatile("s_waitcnt vmcnt(0)" ::: "memory");
        } else {
            XB_SPIN(xb_ld(&bar[XB_XGEN(b.x)]) == gen, bar);
            __builtin_amdgcn_fence(__ATOMIC_ACQUIRE, "agent");
            asm volatile("s_waitcnt vmcnt(0)" ::: "memory");
        }
    }
    __syncthreads();
}

constexpr int NWAVES = 8, NTHR = 512;
constexpr int DM = 1024, NB = 8, SEQ = 4096, CTXL = 256, DEPTH = 4;
constexpr int NLAT = NB * SEQ, NCTX = NB * CTXL, NT = NLAT + NCTX;
constexpr int PW = 2304;
constexpr int MW = 1280;
constexpr int NEXP = 32, MAXBLK = 576;
constexpr int NCHK = 544;
constexpr int S5ROWS = 2304;
constexpr int PC_FU = 0, PC_S5 = 256, PC_Q = 512, PC_K = 640, PC_V = 768, PC_R = 1024, PC_Z = 1280, PC_XBC = 1536, PC_A1 = 2048, PC_DT = 2080;
enum { I_X = 0, I_C, I_CTX, I_CCTX, I_ADAW, I_ADAB, I_NMG, I_NFG, I_WIN, I_WOUT, I_FOURW, I_S5LRE, I_S5LIM, I_S5LDT, I_S5BRE, I_S5BIM, I_S5CRE, I_S5CIM, I_S5D, I_S5GLU,
       I_GLAA2, I_GLAAB, I_GLANG, I_SSDCW, I_SSDCB, I_SSDALOG, I_SSDDTB, I_SSDD, I_SSDNG, I_RW, I_RB, I_WGU, I_BGU, I_WDN, I_BDN, I_FING, N_IN };

constexpr size_t al256(size_t x) { return (x + 255) & ~(size_t)255; }
constexpr size_t WS_CTL = 0, CTL_BYTES = 1u << 20;
constexpr size_t WS_MOD = WS_CTL + CTL_BYTES;
constexpr size_t WS_TAB = WS_MOD + al256((size_t)DEPTH * 9 * 6144 * 4);
constexpr size_t TAB_F64 = 0, TAB_TW = 16384, TAB_D256 = 16384 + 32768, TAB_BYTES = 65536;
constexpr size_t WS_A16 = WS_TAB + TAB_BYTES;
constexpr size_t WS_WIN = WS_A16 + al256((size_t)DEPTH * 2 * 16 * 64 * 2 * 4);
constexpr size_t WS_WOUT = WS_WIN + (size_t)DEPTH * PW * DM * 2;
constexpr size_t WS_WGLU = WS_WOUT + (size_t)DEPTH * DM * MW * 2;
constexpr size_t WS_S5P = WS_WGLU + (size_t)DEPTH * 256 * 256 * 2;
constexpr size_t WS_S5B2 = WS_S5P + (size_t)DEPTH * 16 * 256 * 256 * 2;
constexpr size_t WS_WGU = WS_S5B2 + (size_t)DEPTH * 16 * 256 * 512 * 2;
constexpr size_t WS_WDN = WS_WGU + (size_t)DEPTH * NEXP * 2048 * DM;
constexpr size_t WS_XS = WS_WDN + (size_t)DEPTH * NEXP * DM * DM;
constexpr size_t WS_H = WS_XS + (size_t)NT * DM * 2;
constexpr size_t WS_PBUF = WS_H + (size_t)NT * DM * 2;
constexpr size_t WS_A2 = WS_PBUF + (size_t)NT * PW * 2;
constexpr size_t WS_S5S = WS_A2 + (size_t)16 * S5ROWS * 512 * 2;
constexpr size_t WS_ACT5 = WS_S5S + (size_t)16 * S5ROWS * 256 * 4;
constexpr size_t WS_MIX = WS_ACT5 + (size_t)NT * 256 * 2;
constexpr size_t WS_GDS = WS_MIX + (size_t)NT * MW * 2;
constexpr size_t WS_GDEC = WS_GDS + (size_t)NCHK * 8 * 2048 * 4;
constexpr size_t WS_GSE = WS_GDEC + al256((size_t)NCHK * 8 * 32 * 4);
constexpr size_t WS_SDS = WS_GSE + (size_t)NCHK * 8 * 2048 * 2;
constexpr size_t WS_SDEC = WS_SDS + (size_t)NCHK * 8 * 4096 * 4;
constexpr size_t WS_SSE = WS_SDEC + al256((size_t)NCHK * 8 * 4);
constexpr size_t WS_PE = WS_SSE + (size_t)NCHK * 8 * 4096 * 2;
constexpr size_t WS_PR = WS_PE + (size_t)NT * 4 * 4;
constexpr size_t WS_PG = WS_PR + (size_t)NT * 4 * 4;
constexpr size_t WS_PS = WS_PG + (size_t)NT * 4 * 4;
constexpr size_t WS_SG = WS_PS + (size_t)NT * 4 * 4;
constexpr size_t WS_H8 = WS_SG + (size_t)MAXBLK * 256 * 4;
constexpr size_t WS_TM = WS_H8 + (size_t)NT * DM;
constexpr size_t WS_ACT = WS_TM + (size_t)NEXP * NT * 4;
constexpr size_t WS_Y = WS_ACT + (size_t)MAXBLK * 256 * DM;
constexpr size_t WS_END = WS_Y + (size_t)MAXBLK * 256 * DM * 2;
constexpr int CW_QUEUE = 64;
constexpr int CW_CNT = 1024;
constexpr int CW_BLKE = 2048;
constexpr int CW_BAR = 8192;

constexpr int LDS_BYTES = 163840, MISC_OFF = LDS_BYTES - 256;

constexpr float W8_SCALE = 32.f, H8_SCALE = 8.f, A8_SCALE = 4.f;
__device__ __forceinline__ unsigned pk4f8(float a, float b, float c, float d) { int w = 0; w = __builtin_amdgcn_cvt_pk_fp8_f32(a, b, w, false); w = __builtin_amdgcn_cvt_pk_fp8_f32(c, d, w, true); return (unsigned)w; }
#define RLX_AGENT __ATOMIC_RELAXED, __HIP_MEMORY_SCOPE_AGENT
__device__ __forceinline__ int fresh_tid(int wave0) { int l = (int)__builtin_amdgcn_mbcnt_hi(~0u, __builtin_amdgcn_mbcnt_lo(~0u, 0u)); asm volatile("" : "+v"(l)); return wave0 * 64 + l; }
__device__ __forceinline__ unsigned f2bf(float f) { unsigned u = __builtin_bit_cast(unsigned, f); return (u + 0x7fffu + ((u >> 16) & 1u)) >> 16; }
__device__ __forceinline__ unsigned pk2(float lo, float hi) { return f2bf(lo) | (f2bf(hi) << 16); }
__device__ __forceinline__ float bf2f(unsigned short b) { return __builtin_bit_cast(float, (unsigned)b << 16); }
__device__ __forceinline__ f32x4 bf4(u32x2 w) { return (f32x4){__builtin_bit_cast(float, w.x << 16), __builtin_bit_cast(float, w.x & 0xffff0000u), __builtin_bit_cast(float, w.y << 16), __builtin_bit_cast(float, w.y & 0xffff0000u)}; }
__device__ __forceinline__ float bflo(unsigned w) { return __builtin_bit_cast(float, w << 16); }
__device__ __forceinline__ float bfhi(unsigned w) { return __builtin_bit_cast(float, w & 0xffff0000u); }
template <int M> __device__ __forceinline__ float swz_xor(float v) { return __builtin_bit_cast(float, __builtin_amdgcn_ds_swizzle(__builtin_bit_cast(int, v), (M << 10) | 0x1F)); }
__device__ __forceinline__ float xor32f(float v, int lane) { return __builtin_bit_cast(float, __builtin_amdgcn_ds_bpermute((lane ^ 32) << 2, __builtin_bit_cast(int, v))); }
__device__ __forceinline__ float wave_sum(float v, int lane) { v += swz_xor<1>(v); v += swz_xor<2>(v); v += swz_xor<4>(v); v += swz_xor<8>(v); v += swz_xor<16>(v); v += xor32f(v, lane); return v; }
__device__ __forceinline__ float wave_max(float v, int lane) { v = fmaxf(v, swz_xor<1>(v)); v = fmaxf(v, swz_xor<2>(v)); v = fmaxf(v, swz_xor<4>(v)); v = fmaxf(v, swz_xor<8>(v)); v = fmaxf(v, swz_xor<16>(v)); v = fmaxf(v, xor32f(v, lane)); return v; }
__device__ __forceinline__ float fexp_(float x) { return __builtin_amdgcn_exp2f(1.4426950408889634f * x); }
__device__ __forceinline__ float frcp_(float x) { return __builtin_amdgcn_rcpf(x); }
__device__ __forceinline__ float sigmoidf_(float x) { return frcp_(1.f + fexp_(-x)); }
__device__ __forceinline__ float siluf_(float x) { return x * frcp_(1.f + fexp_(-x)); }

struct Frame {
    LAS unsigned char* lds; volatile LAS unsigned* MISC; unsigned* ctl; unsigned char* ws;
    int tid, lane, wave, G, bid;
};


template <class Fill> struct SgOrder {
    int nblk, nN, R, r, lo, hi; Fill f;
    __device__ __forceinline__ void init(int nblk_, int nN_, int G, int c) { nblk = nblk_; nN = nN_; const int U = nblk * nN; int x, nx;
        if ((G & 7) == 0) { R = G >> 3; x = c & 7; r = c >> 3; nx = 8; } else { R = G; x = 0; r = c; nx = 1; }
        lo = (int)(((long)x * U) / nx); hi = (int)(((long)(x + 1) * U) / nx); }
    __device__ __forceinline__ bool next(int& cursor, pg8::Unit& u) const {
        const int q = lo + r + R * cursor; ++cursor;
        if (q >= hi) return false;
        const int ups = 8 * nN, sg = q / ups, ql = q - sg * ups, nb = (nblk - sg * 8) < 8 ? (nblk - sg * 8) : 8;
        u.pm = sg * 8 + ql % nb; u.pn = ql / nb; f(u); return true;
    }
};
struct FillPlain { size_t astep, bstep; __device__ __forceinline__ void operator()(pg8::Unit& u) const { u.grp = 0; u.aoff = (size_t)u.pm * astep; u.boff = (size_t)u.pn * bstep; } };
struct FillS5 { size_t bgrp; __device__ __forceinline__ void operator()(pg8::Unit& u) const { const int g = u.pm / 9, t = u.pm - g * 9; u.grp = g; u.pm = t; u.aoff = ((size_t)g * S5ROWS + (size_t)t * 256) * 512 * 2; u.boff = (size_t)g * bgrp; } };
struct FillMoe { const LAS unsigned* lblk; int erows; __device__ __forceinline__ void operator()(pg8::Unit& u) const { const int e = (int)lblk[u.pm]; u.grp = e; u.aoff = (size_t)u.pm * 256 * DM; u.boff = ((size_t)e * erows + (size_t)u.pn * 256) * DM; } };
constexpr int MOE_LB = 131072, MOE_LC = MOE_LB + 256, MOE_LBLK = MOE_LC + 256, MOE_GAT = MOE_LBLK + 2560, MOE_MAXU = 26;
static_assert(MOE_GAT + MOE_MAXU * 1024 <= MISC_OFF, "MoE LDS tables");
__device__ __forceinline__ int moe_tables(Frame& F, int L) {
    LAS int* lb = (LAS int*)(F.lds + MOE_LB); LAS int* lc = (LAS int*)(F.lds + MOE_LC); LAS unsigned* lblk = (LAS unsigned*)(F.lds + MOE_LBLK);
    const unsigned* cnt = F.ctl + CW_CNT + L * 64;
    __syncthreads();
    if (F.tid == 0) { int acc = 0; for (int e = 0; e < NEXP; ++e) { lb[e] = acc; const int c = (int)__hip_atomic_load(cnt + e, RLX_AGENT); lc[e] = c; acc += (c + 255) & ~255; } lb[32] = acc; }
    __syncthreads();
    const int nblk = lb[32] >> 8;
    for (int i = F.tid; i < nblk; i += NTHR) { int e = 0; for (int q = 1; q < NEXP; ++q) if (lb[q] <= i * 256) e = q; lblk[i] = (unsigned)e; }
    __syncthreads();
    return nblk;
}
using pg8::cvt_pk_bf16;
struct EpiInproj {
    static constexpr bool PERM = true;
    bf16* P; bf16* A2;
    __device__ __forceinline__ void operator()(const f32x4 (&acc)[2][2][4][2], const pg8::Unit& u, int wr, int wc, int fr, int fq) const {
        const int row0 = u.pm * 256 + wr * 64 + fr, col0 = u.pn * 256 + wc * 32 + 8 * fq;
#pragma unroll
        for (int ai = 0; ai < 2; ++ai)
#pragma unroll
            for (int m = 0; m < 4; ++m) {
                const int row = row0 + ai * 128 + m * 16;
#pragma unroll
                for (int bj = 0; bj < 2; ++bj) {
                    const f32x4 v0 = acc[ai][bj][m][0], v1 = acc[ai][bj][m][1];
                    u32x4 w; w.x = cvt_pk_bf16(v0[0], v0[1]); w.y = cvt_pk_bf16(v0[2], v0[3]); w.z = cvt_pk_bf16(v1[0], v1[1]); w.w = cvt_pk_bf16(v1[2], v1[3]);
                    const int col = col0 + bj * 128;
                    if (u.pn == 1) {
                        const int cc = col - 256, g = cc >> 4, hp = cc & 15;
                        const int crow = row < NLAT ? (row >> 4) : (2048 + ((row - NLAT) >> 4)), s = row & 15;
                        *(u32x4*)(A2 + ((size_t)g * S5ROWS + crow) * 512 + s * 16 + hp) = w;
                    } else *(u32x4*)(P + (size_t)row * PW + col) = w;
                }
            }
    }
};
struct EpiOutproj {
    static constexpr bool PERM = true;
    const float* xin; const float* ctxin; bf16* XS; const float* modL; int first;
    __device__ __forceinline__ void operator()(const f32x4 (&acc)[2][2][4][2], const pg8::Unit& u, int wr, int wc, int fr, int fq) const {
        const int rowt = u.pm * 256, bi = rowt < NLAT ? (rowt >> 12) : 8;
        const int row0 = rowt + wr * 64 + fr, col0 = u.pn * 256 + wc * 32 + 8 * fq;
        const float* gate = modL + (size_t)bi * 6144 + 2 * 1024;
        f32x4 gv[2][2];
#pragma unroll
        for (int bj = 0; bj < 2; ++bj)
#pragma unroll
            for (int n = 0; n < 2; ++n) gv[bj][n] = *(const f32x4*)(gate + col0 + bj * 128 + 4 * n);
#pragma unroll
        for (int ai = 0; ai < 2; ++ai)
#pragma unroll
            for (int m = 0; m < 4; ++m) {
                const int row = row0 + ai * 128 + m * 16;
                bf16* dst = XS + (size_t)row * DM;
#pragma unroll
                for (int bj = 0; bj < 2; ++bj) { const int c = col0 + bj * 128; f32x4 x0, x1;
                    if (first) { const float* src = (row < NLAT ? xin + (size_t)row * DM : ctxin + (size_t)(row - NLAT) * DM) + c; x0 = *(const f32x4*)src; x1 = *(const f32x4*)(src + 4); }
                    else { const u32x4 w = *(const u32x4*)(dst + c); x0 = bf4((u32x2){w.x, w.y}); x1 = bf4((u32x2){w.z, w.w}); }
                    x0 += gv[bj][0] * acc[ai][bj][m][0]; x1 += gv[bj][1] * acc[ai][bj][m][1];
                    u32x4 o; o.x = cvt_pk_bf16(x0[0], x0[1]); o.y = cvt_pk_bf16(x0[2], x0[3]); o.z = cvt_pk_bf16(x1[0], x1[1]); o.w = cvt_pk_bf16(x1[2], x1[3]);
                    *(u32x4*)(dst + c) = o; }
            }
    }
};
struct EpiSwiglu {
    static constexpr bool PERM = true;
    unsigned char* ACT; const float* bgu;
    __device__ __forceinline__ void operator()(const f32x4 (&acc)[2][2][4][2], const pg8::Unit& u, int wr, int wc, int fr, int fq) const {
        const int row0 = u.pm * 256 + wr * 64 + fr, i0 = u.pn * 128 + wc * 32 + 8 * fq;
        const float* bb = bgu + (size_t)u.grp * 2048 + 2 * i0;
        const f32x4 b0 = *(const f32x4*)(bb), b1 = *(const f32x4*)(bb + 4), b2 = *(const f32x4*)(bb + 8), b3 = *(const f32x4*)(bb + 12);
        const float bg[8] = {b0[0], b0[2], b1[0], b1[2], b2[0], b2[2], b3[0], b3[2]}, bu[8] = {b0[1], b0[3], b1[1], b1[3], b2[1], b2[3], b3[1], b3[3]};
        constexpr float inv = 1.f / (H8_SCALE * W8_SCALE);
#pragma unroll
        for (int ai = 0; ai < 2; ++ai)
#pragma unroll
            for (int m = 0; m < 4; ++m) {
                const int row = row0 + ai * 128 + m * 16;
                float o[8];
#pragma unroll
                for (int n = 0; n < 2; ++n)
#pragma unroll
                    for (int jp = 0; jp < 2; ++jp) {
                        const int q = 4 * n + 2 * jp;
                        f32x2 gt = (f32x2){acc[ai][0][m][n][2 * jp], acc[ai][0][m][n][2 * jp + 1]} * inv + (f32x2){bg[q], bg[q + 1]};
                        f32x2 up = (f32x2){acc[ai][1][m][n][2 * jp], acc[ai][1][m][n][2 * jp + 1]} * inv + (f32x2){bu[q], bu[q + 1]};
                        gt.x = fminf(gt.x, 7.0f); gt.y = fminf(gt.y, 7.0f);
                        up.x = __builtin_amdgcn_fmed3f(up.x, -7.0f, 7.0f); up.y = __builtin_amdgcn_fmed3f(up.y, -7.0f, 7.0f);
                        const f32x2 ea = gt * (-1.702f * 1.4426950408889634f);
                        f32x2 den; den.x = __builtin_amdgcn_exp2f(ea.x); den.y = __builtin_amdgcn_exp2f(ea.y); den = den + 1.0f;
                        f32x2 sg; sg.x = __builtin_amdgcn_rcpf(den.x); sg.y = __builtin_amdgcn_rcpf(den.y);
                        const f32x2 r = (up * A8_SCALE + A8_SCALE) * gt * sg;
                        o[q] = r.x; o[q + 1] = r.y;
                    }
                u32x2 w; w.x = pk4f8(o[0], o[1], o[2], o[3]); w.y = pk4f8(o[4], o[5], o[6], o[7]);
                *(u32x2*)(ACT + (size_t)row * DM + i0) = w;
            }
    }
};
struct EpiDown {
    static constexpr bool PERM = true;
    bf16* Y; const float* bdn; const float* sg;
    __device__ __forceinline__ void operator()(const f32x4 (&acc)[2][2][4][2], const pg8::Unit& u, int wr, int wc, int fr, int fq) const {
        const int row0 = u.pm * 256 + wr * 64 + fr, col0 = u.pn * 256 + wc * 32 + 8 * fq;
        const float* bb = bdn + (size_t)u.grp * DM + col0;
        constexpr float inv = 1.f / (A8_SCALE * W8_SCALE);
        f32x4 bv[2][2];
#pragma unroll
        for (int bj = 0; bj < 2; ++bj)
#pragma unroll
            for (int n = 0; n < 2; ++n) bv[bj][n] = *(const f32x4*)(bb + bj * 128 + 4 * n);
#pragma unroll
        for (int ai = 0; ai < 2; ++ai)
#pragma unroll
            for (int m = 0; m < 4; ++m) {
                const int row = row0 + ai * 128 + m * 16; const float gt = sg[row];
#pragma unroll
                for (int bj = 0; bj < 2; ++bj) {
                    const f32x4 v0 = (acc[ai][bj][m][0] * inv + bv[bj][0]) * gt, v1 = (acc[ai][bj][m][1] * inv + bv[bj][1]) * gt;
                    u32x4 w; w.x = cvt_pk_bf16(v0[0], v0[1]); w.y = cvt_pk_bf16(v0[2], v0[3]); w.z = cvt_pk_bf16(v1[0], v1[1]); w.w = cvt_pk_bf16(v1[2], v1[3]);
                    *(u32x4*)(Y + (size_t)row * DM + col0 + bj * 128) = w;
                }
            }
    }
};
struct EpiNull { static constexpr bool PERM = true; float* sink;
    __device__ __forceinline__ void operator()(const f32x4 (&acc)[2][2][4][2], const pg8::Unit& u, int wr, int wc, int fr, int fq) const { float s = 0.f;
#pragma unroll
        for (int ai = 0; ai < 2; ++ai)
#pragma unroll
            for (int bj = 0; bj < 2; ++bj)
#pragma unroll
                for (int m = 0; m < 4; ++m)
#pragma unroll
                    for (int n = 0; n < 2; ++n) s += acc[ai][bj][m][n][0];
        if (s == 12345.678f) sink[u.pm] = s; } };
struct EpiS5S {
    static constexpr bool PERM = false;
    float* S;
    __device__ __forceinline__ void operator()(const f32x4 (&acc)[2][2][4][2], const pg8::Unit& u, int wr, int wc, int fr, int fq) const {
        const int row0 = u.pm * 256 + wr * 64 + fr, col0 = wc * 32 + 4 * fq;
        float* base = S + (size_t)u.grp * S5ROWS * 256;
#pragma unroll
        for (int ai = 0; ai < 2; ++ai)
#pragma unroll
            for (int m = 0; m < 4; ++m) { float* rp = base + (size_t)(row0 + ai * 128 + m * 16) * 256 + col0;
#pragma unroll
                for (int bj = 0; bj < 2; ++bj)
#pragma unroll
                    for (int n = 0; n < 2; ++n) *(f32x4*)(rp + bj * 128 + n * 16) = acc[ai][bj][m][n]; }
    }
};
__device__ __forceinline__ float gelu_tanh(float x) { const float t = 0.7978845608f * (x + 0.044715f * x * x * x); return x * frcp_(1.f + fexp_(-2.f * t)); }
struct EpiS5Y {
    static constexpr bool PERM = true;
    bf16* ACT5;
    __device__ __forceinline__ void operator()(const f32x4 (&acc)[2][2][4][2], const pg8::Unit& u, int wr, int wc, int fr, int fq) const {
        const int row0 = u.pm * 256 + wr * 64 + fr, col0 = wc * 32 + 8 * fq;
#pragma unroll
        for (int ai = 0; ai < 2; ++ai)
#pragma unroll
            for (int m = 0; m < 4; ++m) {
                const int crow = row0 + ai * 128 + m * 16;
                if (crow >= 2176) continue;
                const int tok0 = crow < 2048 ? crow * 16 : NLAT + (crow - 2048) * 16;
#pragma unroll
                for (int bj = 0; bj < 2; ++bj) {
                    const int col = col0 + bj * 128, j = col >> 4, h = col & 15;
                    const f32x4 v0 = acc[ai][bj][m][0], v1 = acc[ai][bj][m][1];
                    u32x4 w; w.x = cvt_pk_bf16(gelu_tanh(v0[0]), gelu_tanh(v0[1])); w.y = cvt_pk_bf16(gelu_tanh(v0[2]), gelu_tanh(v0[3]));
                    w.z = cvt_pk_bf16(gelu_tanh(v1[0]), gelu_tanh(v1[1])); w.w = cvt_pk_bf16(gelu_tanh(v1[2]), gelu_tanh(v1[3]));
                    *(u32x4*)(ACT5 + (size_t)(tok0 + j) * 256 + u.grp * 16 + h) = w;
                }
            }
    }
};
struct EpiGlu {
    static constexpr bool PERM = true;
    const bf16* ACT5; bf16* MIX;
    __device__ __forceinline__ void operator()(const f32x4 (&acc)[2][2][4][2], const pg8::Unit& u, int wr, int wc, int fr, int fq) const {
        const int row0 = u.pm * 256 + wr * 64 + fr, col0 = wc * 32 + 8 * fq;
#pragma unroll
        for (int ai = 0; ai < 2; ++ai)
#pragma unroll
            for (int m = 0; m < 4; ++m) {
                const int row = row0 + ai * 128 + m * 16;
#pragma unroll
                for (int bj = 0; bj < 2; ++bj) {
                    const int col = col0 + bj * 128;
                    const u32x4 a = *(const u32x4*)(ACT5 + (size_t)row * 256 + col);
                    const f32x4 v0 = acc[ai][bj][m][0], v1 = acc[ai][bj][m][1];
                    u32x4 w;
                    w.x = cvt_pk_bf16(bflo(a.x) * sigmoidf_(v0[0]), bfhi(a.x) * sigmoidf_(v0[1])); w.y = cvt_pk_bf16(bflo(a.y) * sigmoidf_(v0[2]), bfhi(a.y) * sigmoidf_(v0[3]));
                    w.z = cvt_pk_bf16(bflo(a.z) * sigmoidf_(v1[0]), bfhi(a.z) * sigmoidf_(v1[1])); w.w = cvt_pk_bf16(bflo(a.w) * sigmoidf_(v1[2]), bfhi(a.w) * sigmoidf_(v1[3]));
                    *(u32x4*)(MIX + (size_t)row * MW + 512 + col) = w;
                }
            }
    }
};

struct Args { const float* in[N_IN]; float* out; unsigned char* ws; int ph_lo, ph_hi; };
typedef const __attribute__((address_space(4))) Args CArgs;
__device__ __forceinline__ CArgs* fresh_args() { CArgs* p = (CArgs*)__builtin_amdgcn_kernarg_segment_ptr(); asm volatile("" : "+s"(p)); return p; }

template <class Map> __device__ __forceinline__ void transpose_tile(const float* W, int ldw, int ncols, int k0, int n0, bf16* WT, int ldt, int kd0, const Map& map, LAS float* scr, int lane) {
    { const int c4 = (lane & 15) * 4, r4 = lane >> 4; const bool ok = n0 + c4 < ncols;
#pragma unroll
      for (int q = 0; q < 16; ++q) { const int kk = q * 4 + r4; const f32x4 v = ok ? *(const f32x4*)(W + (size_t)(k0 + kk) * ldw + n0 + c4) : (f32x4){0.f, 0.f, 0.f, 0.f};
          scr[kk * 65 + c4] = v[0]; scr[kk * 65 + c4 + 1] = v[1]; scr[kk * 65 + c4 + 2] = v[2]; scr[kk * 65 + c4 + 3] = v[3]; } }
    asm volatile("s_waitcnt lgkmcnt(0)" ::: "memory");
    const int c = lane & 7;
#pragma unroll
    for (int j = 0; j < 8; ++j) {
        const int n = (lane >> 3) + 8 * j; const LAS float* s = scr + (8 * c) * 65 + n;
        u32x4 o; o.x = pk2(s[0], s[65]); o.y = pk2(s[2 * 65], s[3 * 65]); o.z = pk2(s[4 * 65], s[5 * 65]); o.w = pk2(s[6 * 65], s[7 * 65]);
        const int dr = (n0 + n) < ncols ? map(n0 + n) : -1;
        if (dr >= 0) *(u32x4*)(WT + (size_t)dr * ldt + kd0 + 8 * c) = o;
    }
    asm volatile("s_waitcnt lgkmcnt(0)" ::: "memory");
}
struct MapId { __device__ __forceinline__ int operator()(int n) const { return n; } };
struct MapWin { __device__ __forceinline__ int operator()(int c) const { return c < 1280 ? c : (c < 1312 ? 2048 + (c - 1280) : (c < 2080 ? c - 32 : c)); } };
struct MapGu { __device__ __forceinline__ int operator()(int n) const { const int i = n >> 1; return (i >> 7) * 256 + (n & 1) * 128 + (i & 127); } };

template <class Map> __device__ __forceinline__ void transpose_tile_f8(const float* W, int ldw, int k0, int n0, unsigned char* WT, int ldt, const Map& map, LAS float* scr, int lane) {
    { const int c4 = (lane & 15) * 4, r4 = lane >> 4;
#pragma unroll
      for (int q = 0; q < 16; ++q) { const int kk = q * 4 + r4; const f32x4 v = *(const f32x4*)(W + (size_t)(k0 + kk) * ldw + n0 + c4);
          scr[kk * 65 + c4] = v[0]; scr[kk * 65 + c4 + 1] = v[1]; scr[kk * 65 + c4 + 2] = v[2]; scr[kk * 65 + c4 + 3] = v[3]; } }
    asm volatile("s_waitcnt lgkmcnt(0)" ::: "memory");
    const int c = lane & 7;
#pragma unroll
    for (int j = 0; j < 8; ++j) {
        const int n = (lane >> 3) + 8 * j; const LAS float* s = scr + (8 * c) * 65 + n;
        u32x2 o; o.x = pk4f8(s[0] * W8_SCALE, s[65] * W8_SCALE, s[2 * 65] * W8_SCALE, s[3 * 65] * W8_SCALE); o.y = pk4f8(s[4 * 65] * W8_SCALE, s[5 * 65] * W8_SCALE, s[6 * 65] * W8_SCALE, s[7 * 65] * W8_SCALE);
        *(u32x2*)(WT + (size_t)map(n0 + n) * ldt + k0 + 8 * c) = o;
    }
    asm volatile("s_waitcnt lgkmcnt(0)" ::: "memory");
}
constexpr int PI_ADA = 48, PI_TAB = 1, PI_S5 = 64, PI_FOLD = 256, PI_ZERO = 4;
constexpr int TW_WIN = 16 * 33, TW_GU = 32 * 16 * 32, TW_DN = 32 * 16 * 16, TW_WOUT = 12 * 16, TW_GLU = 16, TW_LAYER = TW_WIN + TW_GU + TW_DN + TW_WOUT + TW_GLU;
constexpr int PI_TR = (DEPTH * TW_LAYER + 7) / 8;
constexpr int PI_B_TAB = PI_ADA, PI_B_S5 = PI_B_TAB + PI_TAB, PI_B_FOLD = PI_B_S5 + PI_S5, PI_B_ZERO = PI_B_FOLD + PI_FOLD, PI_B_TR = PI_B_ZERO + PI_ZERO, PI_TOTAL = PI_B_TR + (PI_TR + 3) / 4;

__device__ __forceinline__ void pro_adaln(Frame& F, CArgs& a, int it) {
    const int L = it / 12, cb = it % 12;
    LAS float* cond = (LAS float*)F.lds;
    for (int i = F.tid; i < 9 * 1024; i += NTHR) { const int r = i >> 10, k = i & 1023; const float v = r < 8 ? a.in[I_C][r * 1024 + k] : a.in[I_CCTX][k]; cond[i] = siluf_(v); }
    __syncthreads();
    const int n = cb * 512 + F.tid;
    const float* w = a.in[I_ADAW] + (size_t)L * 1024 * 6144 + n;
    float acc[9];
    const float b = a.in[I_ADAB][L * 6144 + n];
#pragma unroll
    for (int r = 0; r < 9; ++r) acc[r] = b;
#pragma unroll 2
    for (int k = 0; k < 1024; k += 4) {
        const float w0 = w[(size_t)k * 6144], w1 = w[(size_t)(k + 1) * 6144], w2 = w[(size_t)(k + 2) * 6144], w3 = w[(size_t)(k + 3) * 6144];
#pragma unroll
        for (int r = 0; r < 9; ++r) { const f32x4 c4 = *(const LAS f32x4*)(cond + r * 1024 + k); acc[r] += c4[0] * w0 + c4[1] * w1 + c4[2] * w2 + c4[3] * w3; }
    }
    float* mod = (float*)(F.ws + WS_MOD) + (size_t)L * 9 * 6144 + n;
#pragma unroll
    for (int r = 0; r < 9; ++r) mod[(size_t)r * 6144] = acc[r];
    __syncthreads();
}
__device__ __forceinline__ void pro_tables(Frame& F) {
    bf16* f64 = (bf16*)(F.ws + WS_TAB + TAB_F64);
    for (int i = F.tid; i < 4096; i += NTHR) { const int k = i >> 6, n = i & 63; float s, c; sincospif((float)((k * n) & 63) / 32.f, &s, &c); f64[i] = (bf16)f2bf(c); f64[4096 + i] = (bf16)f2bf(s); }
    float* tw = (float*)(F.ws + WS_TAB + TAB_TW);
    for (int i = F.tid; i < 4096; i += NTHR) { float s, c; sincospif((float)i / 2048.f, &s, &c); tw[2 * i] = c; tw[2 * i + 1] = s; }
    float* d256 = (float*)(F.ws + WS_TAB + TAB_D256);
    for (int i = F.tid; i < 256; i += NTHR) { float s, c; sincospif((float)i / 128.f, &s, &c); d256[2 * i] = c; d256[2 * i + 1] = s; }
}
__device__ __forceinline__ void pro_fold(Frame& F, CArgs& a, int it) {
    const int L = it >> 6, h = (it >> 4) & 3, nb = it & 15, n0 = nb * 64;
    LAS float* fw = (LAS float*)F.lds;
    LAS float* ct = fw + 64 * 65;
    if (F.tid < 64) ct[F.tid] = cospif((float)F.tid / 32.f);
    const float* four = a.in[I_FOURW] + (size_t)L * 256 * 256, *wo = a.in[I_WOUT] + (size_t)L * 1024 * 1024;
    const int n = F.tid & 63, cg = F.tid >> 6;
    { float s[8];
#pragma unroll
      for (int i = 0; i < 8; ++i) s[i] = 0.f;
      for (int j = 0; j < 256; ++j) { const float wv = wo[(size_t)j * 1024 + n0 + n];
#pragma unroll
          for (int i = 0; i < 8; ++i) s[i] += four[(size_t)(h * 64 + cg * 8 + i) * 256 + j] * wv; }
#pragma unroll
      for (int i = 0; i < 8; ++i) fw[(cg * 8 + i) * 65 + n] = s[i]; }
    __syncthreads();
    float oc[8], os[8];
#pragma unroll
    for (int i = 0; i < 8; ++i) { oc[i] = 0.f; os[i] = 0.f; }
    for (int kc = 0; kc < 64; ++kc) { const float v = fw[kc * 65 + n];
#pragma unroll
        for (int i = 0; i < 8; ++i) { const int mm = (kc * (cg * 8 + i)) & 63; oc[i] += ct[mm] * v; os[i] += ct[(mm + 48) & 63] * v; } }
    bf16* wt = (bf16*)(F.ws + WS_WOUT) + (size_t)L * DM * MW + (size_t)(n0 + n) * MW + h * 64 + cg * 8;
    u32x4 w; w.x = pk2(oc[0] * 0.125f, oc[1] * 0.125f); w.y = pk2(oc[2] * 0.125f, oc[3] * 0.125f); w.z = pk2(oc[4] * 0.125f, oc[5] * 0.125f); w.w = pk2(oc[6] * 0.125f, oc[7] * 0.125f);
    *(u32x4*)wt = w;
    w.x = pk2(os[0] * 0.125f, os[1] * 0.125f); w.y = pk2(os[2] * 0.125f, os[3] * 0.125f); w.z = pk2(os[4] * 0.125f, os[5] * 0.125f); w.w = pk2(os[6] * 0.125f, os[7] * 0.125f);
    *(u32x4*)(wt + 256) = w;
    __syncthreads();
}
__device__ __forceinline__ void pro_s5(Frame& F, CArgs& a, int it) {
    const int L = it >> 4, g = it & 15;
    LAS float* pw = (LAS float*)F.lds;
    LAS float* bb = pw + 2 * 64 * 17 * 2;
    LAS float* cm = bb + 2 * 64 * 16 * 2;
    LAS float* kt = cm + 2 * 16 * 64 * 2;
    for (int i = F.tid; i < 2 * 64 * 17; i += NTHR) {
        const int r = i / (64 * 17), p = (i / 17) & 63, e = i % 17; const size_t q = ((size_t)(L * 2 + r) * 16 + g) * 64 + p;
        const float dt = __expf(a.in[I_S5LDT][(L * 2 + r) * 16 + g]); const float lr = a.in[I_S5LRE][q] * dt, li = a.in[I_S5LIM][q] * dt;
        float s, c; sincosf(li * (float)e, &s, &c); const float m = expf(lr * (float)e); pw[2 * i] = m * c; pw[2 * i + 1] = m * s;
    }
    for (int i = F.tid; i < 2 * 64 * 16; i += NTHR) {
        const int r = i >> 10, p = (i >> 4) & 63, h = i & 15; const size_t q = ((size_t)(L * 2 + r) * 16 + g) * 64 + p;
        const float dt = __expf(a.in[I_S5LDT][(L * 2 + r) * 16 + g]); const float lre = a.in[I_S5LRE][q], lim = a.in[I_S5LIM][q];
        float s, c; sincosf(lim * dt, &s, &c); const float m = expf(lre * dt); const float ar = m * c - 1.f, ai = m * s;
        const float den = 1.f / (lre * lre + lim * lim); const float cr = (ar * lre + ai * lim) * den, ci = (ai * lre - ar * lim) * den;
        const float br = a.in[I_S5BRE][q * 16 + h], bi = a.in[I_S5BIM][q * 16 + h];
        bb[2 * i] = cr * br - ci * bi; bb[2 * i + 1] = cr * bi + ci * br;
    }
    for (int i = F.tid; i < 2 * 16 * 64; i += NTHR) {
        const int r = i >> 10, h = (i >> 6) & 15, p = i & 63; const size_t q = (((size_t)(L * 2 + r) * 16 + g) * 16 + h) * 64 + p;
        cm[2 * i] = a.in[I_S5CRE][q]; cm[2 * i + 1] = a.in[I_S5CIM][q];
    }
    __syncthreads();
    for (int i = F.tid; i < 2 * 16 * 256; i += NTHR) {
        const int r = i >> 12, tau = (i >> 8) & 15, h = (i >> 4) & 15, hp = i & 15; float s = 0.f;
        for (int p = 0; p < 64; ++p) { const float cr = cm[2 * ((r * 16 + h) * 64 + p)], ci = cm[2 * ((r * 16 + h) * 64 + p) + 1];
            const float ar = pw[2 * ((r * 64 + p) * 17 + tau)], ai = pw[2 * ((r * 64 + p) * 17 + tau) + 1]; const float br = bb[2 * ((r * 64 + p) * 16 + hp)], bi = bb[2 * ((r * 64 + p) * 16 + hp) + 1];
            const float tr = cr * ar - ci * ai, ti = cr * ai + ci * ar; s += tr * br - ti * bi; }
        kt[i] = s;
    }
    __syncthreads();
    bf16* pt = (bf16*)(F.ws + WS_S5P) + (size_t)(L * 16 + g) * 256 * 256;
    for (int i = F.tid; i < 65536; i += NTHR) {
        const int np = i >> 8, k = i & 255, r = np >> 7, cpx = (np >> 6) & 1, p = np & 63, s = k >> 4, hp = k & 15, e = r ? s : 15 - s;
        const float ar = pw[2 * ((r * 64 + p) * 17 + e)], ai = pw[2 * ((r * 64 + p) * 17 + e) + 1]; const float br = bb[2 * ((r * 64 + p) * 16 + hp)], bi = bb[2 * ((r * 64 + p) * 16 + hp) + 1];
        pt[i] = (bf16)f2bf(cpx ? ar * bi + ai * br : ar * br - ai * bi);
    }
    bf16* b2 = (bf16*)(F.ws + WS_S5B2) + (size_t)(L * 16 + g) * 256 * 512;
    const float* dsk = a.in[I_S5D] + L * 256 + g * 16;
    for (int i = F.tid; i < 131072; i += NTHR) {
        const int n = i >> 9, k = i & 511, j = n >> 4, h = n & 15; float v;
        if (k < 256) { const int s = k >> 4, hp = k & 15; v = 0.f;
            if (j >= s) v += kt[((0 * 16 + (j - s)) * 16 + h) * 16 + hp];
            if (j <= s) v += kt[((1 * 16 + (s - j)) * 16 + h) * 16 + hp];
            if (j == s && h == hp) v += dsk[h];
        } else { const int kk = k - 256, r = kk >> 7, cpx = (kk >> 6) & 1, p = kk & 63, e = r ? 16 - j : j + 1;
            const float cr = cm[2 * ((r * 16 + h) * 64 + p)], ci = cm[2 * ((r * 16 + h) * 64 + p) + 1]; const float ar = pw[2 * ((r * 64 + p) * 17 + e)], ai = pw[2 * ((r * 64 + p) * 17 + e) + 1];
            v = cpx ? -(cr * ai + ci * ar) : (cr * ar - ci * ai); }
        b2[i] = (bf16)f2bf(v);
    }
    float* a16 = (float*)(F.ws + WS_A16) + (size_t)((L * 2) * 16 + g) * 128;
    if (F.tid < 128) { const int r = F.tid >> 6, p = F.tid & 63; float* o = a16 + (size_t)r * 16 * 128 + p * 2; o[0] = pw[2 * ((r * 64 + p) * 17 + 16)]; o[1] = pw[2 * ((r * 64 + p) * 17 + 16) + 1]; }
    __syncthreads();
}
__device__ __forceinline__ void pro_transposes(Frame& F, CArgs& a, int wg_item) {
    LAS float* scr = (LAS float*)F.lds + F.wave * (64 * 65);
    const int wi = wg_item * 8 + F.wave;
    if (wi >= DEPTH * TW_LAYER) return;
    const int L = wi / TW_LAYER; int r = wi % TW_LAYER;
    if (r < TW_WIN) { const int kb = r / 33, nb = r % 33; transpose_tile(fresh_args()->in[I_WIN] + (size_t)L * DM * 2088, 2088, 2088, kb * 64, nb * 64, (bf16*)(F.ws + WS_WIN) + (size_t)L * PW * DM, DM, kb * 64, MapWin(), scr, F.lane); return; } r -= TW_WIN;
    if (r < TW_GU) { const int e = r >> 9, kb = (r >> 5) & 15, nb = r & 31; transpose_tile_f8(fresh_args()->in[I_WGU] + ((size_t)L * NEXP + e) * DM * 2048, 2048, kb * 64, nb * 64, (unsigned char*)(F.ws + WS_WGU) + ((size_t)L * NEXP + e) * 2048 * DM, DM, MapGu(), scr, F.lane); return; } r -= TW_GU;
    if (r < TW_DN) { const int e = r >> 8, kb = (r >> 4) & 15, nb = r & 15; transpose_tile_f8(fresh_args()->in[I_WDN] + ((size_t)L * NEXP + e) * DM * DM, DM, kb * 64, nb * 64, (unsigned char*)(F.ws + WS_WDN) + ((size_t)L * NEXP + e) * DM * DM, DM, MapId(), scr, F.lane); return; } r -= TW_DN;
    if (r < TW_WOUT) { const int kb = r >> 4, nb = r & 15; transpose_tile(fresh_args()->in[I_WOUT] + (size_t)L * DM * DM + (size_t)256 * DM, DM, DM, kb * 64, nb * 64, (bf16*)(F.ws + WS_WOUT) + (size_t)L * DM * MW, MW, 512 + kb * 64, MapId(), scr, F.lane); return; } r -= TW_WOUT;
    { const int kb = r >> 2, nb = r & 3; transpose_tile(fresh_args()->in[I_S5GLU] + (size_t)L * 256 * 256, 256, 256, kb * 64, nb * 64, (bf16*)(F.ws + WS_WGLU) + (size_t)L * 256 * 256, 256, kb * 64, MapId(), scr, F.lane); }
}
__device__ __forceinline__ void p_prologue(Frame& F0, CArgs& a, int qw = CW_QUEUE) {
    for (;;) {
        if (F0.tid == 0) F0.MISC[0] = __hip_atomic_fetch_add(F0.ctl + qw, 1u, RLX_AGENT);
        __syncthreads();
        const int it = (int)F0.MISC[0];
        __syncthreads();
        if (it >= PI_TOTAL) break;
        Frame F = F0; { const int t_ = fresh_tid(F.wave); F.tid = t_; F.lane = t_ & 63; }
        if (it < PI_B_TAB) pro_adaln(F, *fresh_args(), it);
        else if (it < PI_B_S5) pro_tables(F);
        else if (it < PI_B_FOLD) pro_s5(F, *fresh_args(), it - PI_B_S5);
        else if (it < PI_B_ZERO) pro_fold(F, *fresh_args(), it - PI_B_FOLD);
        else if (it < PI_B_TR) { const int L = it - PI_B_ZERO; u32x4* z = (u32x4*)((bf16*)(F.ws + WS_WIN) + (size_t)L * PW * DM + (size_t)2088 * DM); for (int i = F.tid; i < (PW - 2088) * DM / 8; i += NTHR) z[i] = (u32x4){0u, 0u, 0u, 0u}; }
        else { for (int q = 0; q < 4; ++q) pro_transposes(F, *fresh_args(), (it - PI_B_TR) * 4 + q); }
    }
}

__device__ __forceinline__ void p_norm1(Frame& F, CArgs& a, int L, bool dry = false) {
    const int gw = F.bid * NWAVES + F.wave, NGW = F.G * NWAVES;
    bf16* XS = (bf16*)(F.ws + WS_XS); bf16* H = (bf16*)(F.ws + WS_H);
    const float* mod = (const float*)(F.ws + WS_MOD) + (size_t)L * 9 * 6144; const float* modp = mod - 9 * 6144;
    const int* PS = (const int*)(F.ws + WS_PS); const bf16* Y = (const bf16*)(F.ws + WS_Y);
    const float* g = a.in[I_NMG] + L * DM;
    const float* xin = a.in[I_X]; const float* cin = a.in[I_CTX];
    f32x4 gv[4];
#pragma unroll
    for (int j = 0; j < 4; ++j) gv[j] = *(const f32x4*)(g + 4 * F.lane + 256 * j);
    f32x4 xn[4]; u32x2 xb[4]; u32x2 yn[4][4]; int psn[4] = {0, 0, 0, 0};
#define N1_LOADX(dst, row) do { if (L == 0) { const float* s_ = (row) < NLAT ? xin + (size_t)(row) * DM : cin + (size_t)((row) - NLAT) * DM; _Pragma("unroll") for (int j = 0; j < 4; ++j) dst[j] = *(const f32x4*)(s_ + 4 * F.lane + 256 * j); } \
        else { const bf16* s_ = XS + (size_t)(row) * DM; _Pragma("unroll") for (int j = 0; j < 4; ++j) xb[j] = *(const u32x2*)(s_ + 4 * F.lane + 256 * j); } } while (0)
#define N1_LOADY(dst, ps) do { _Pragma("unroll") for (int k = 0; k < 4; ++k) { const bf16* yr_ = Y + (size_t)(ps)[k] * DM; _Pragma("unroll") for (int j = 0; j < 4; ++j) dst[k][j] = *(const u32x2*)(yr_ + 4 * F.lane + 256 * j); } } while (0)
#define N1_LOADPS(dst, row) do { const int4 p_ = *(const int4*)(PS + (size_t)(row) * 4); dst[0] = p_.x; dst[1] = p_.y; dst[2] = p_.z; dst[3] = p_.w; } while (0)
    int row = gw;
    if (row < NT) { N1_LOADX(xn, row); if (L > 0) { N1_LOADPS(psn, row); N1_LOADY(yn, psn); if (row + NGW < NT) N1_LOADPS(psn, row + NGW); } }
    while (row < NT) {
        const int nrow = row + NGW; const int bi = row < NLAT ? (row >> 12) : 8;
        f32x4 v[4]; u32x2 yc[4][4];
#pragma unroll
        for (int j = 0; j < 4; ++j) { v[j] = (L == 0) ? xn[j] : bf4(xb[j]);
#pragma unroll
            for (int k = 0; k < 4; ++k) yc[k][j] = yn[k][j]; }
        if (nrow < NT) { N1_LOADX(xn, nrow); if (L > 0) { N1_LOADY(yn, psn); if (nrow + NGW < NT) N1_LOADPS(psn, nrow + NGW); } }
        if (L > 0) {
            bf16* xr = XS + (size_t)row * DM; const float* m5 = modp + (size_t)bi * 6144 + 5 * 1024;
#pragma unroll
            for (int j = 0; j < 4; ++j) { f32x4 s = (f32x4){0.f, 0.f, 0.f, 0.f};
#pragma unroll
                for (int k = 0; k < 4; ++k) s += (f32x4){bflo(yc[k][j].x), bfhi(yc[k][j].x), bflo(yc[k][j].y), bfhi(yc[k][j].y)};
                v[j] += *(const f32x4*)(m5 + 4 * F.lane + 256 * j) * s; if (!dry) { u32x2 w; w.x = pk2(v[j][0], v[j][1]); w.y = pk2(v[j][2], v[j][3]); *(u32x2*)(xr + 4 * F.lane + 256 * j) = w; } }
        }
        float ss = 0.f;
#pragma unroll
        for (int j = 0; j < 4; ++j) ss += v[j][0] * v[j][0] + v[j][1] * v[j][1] + v[j][2] * v[j][2] + v[j][3] * v[j][3];
        const float rs = rsqrtf(wave_sum(ss, F.lane) * (1.f / DM) + 1e-6f);
        const float* sh = mod + (size_t)bi * 6144, *sc = sh + 1024;
        bf16* hr = H + (size_t)row * DM;
#pragma unroll
        for (int j = 0; j < 4; ++j) { const f32x4 s4 = *(const f32x4*)(sc + 4 * F.lane + 256 * j), h4 = *(const f32x4*)(sh + 4 * F.lane + 256 * j);
            const f32x4 o = v[j] * rs * gv[j] * (s4 + 1.f) + h4; u32x2 w; w.x = pk2(o[0], o[1]); w.y = pk2(o[2], o[3]); if (!dry) *(u32x2*)(hr + 4 * F.lane + 256 * j) = w; else if (o[0] == 12345.678f) *(u32x2*)(hr + 4 * F.lane + 256 * j) = w; }
        row = nrow;
    }
#undef N1_LOADX
#undef N1_LOADY
#undef N1_LOADPS
}
__device__ __forceinline__ void p_norm2(Frame& F, CArgs& a, int L, int nrows, int cw = CW_CNT) {
    LAS float* rwt = (LAS float*)F.lds;
    LAS unsigned* lcnt = (LAS unsigned*)(F.lds + 32 * 1024 * 4);
    if (F.tid < 64) lcnt[F.tid] = 0u;
    const float* rw = a.in[I_RW] + (size_t)L * DM * NEXP;
    for (int i = F.tid; i < DM * NEXP; i += NTHR) { const int k = i >> 5, e = i & 31; rwt[e * 1024 + k] = rw[i]; }
    __syncthreads();
    const int gw = F.bid * NWAVES + F.wave, NGW = F.G * NWAVES;
    const bf16* XS = (const bf16*)(F.ws + WS_XS); unsigned char* H8 = (unsigned char*)(F.ws + WS_H8);
    const float* mod = (const float*)(F.ws + WS_MOD) + (size_t)L * 9 * 6144;
    int* PE = (int*)(F.ws + WS_PE); int* PR = (int*)(F.ws + WS_PR); float* PG = (float*)(F.ws + WS_PG);
    unsigned* cnt = F.ctl + cw + L * 64;
    const float* g = a.in[I_NFG] + L * DM;
    const float rb = a.in[I_RB][L * NEXP + (F.lane >> 1)];
    f32x4 gv[4];
#pragma unroll
    for (int j = 0; j < 4; ++j) gv[j] = *(const f32x4*)(g + 4 * F.lane + 256 * j);
    u32x2 xn[4];
    if (gw < nrows) {
#pragma unroll
        for (int j = 0; j < 4; ++j) xn[j] = *(const u32x2*)(XS + (size_t)gw * DM + 4 * F.lane + 256 * j); }
    for (int row = gw; row < nrows; row += NGW) {
        const int bi = row < NLAT ? (row >> 12) : 8;
        f32x4 v[4]; float ss = 0.f;
#pragma unroll
        for (int j = 0; j < 4; ++j) { v[j] = bf4(xn[j]); ss += v[j][0] * v[j][0] + v[j][1] * v[j][1] + v[j][2] * v[j][2] + v[j][3] * v[j][3]; }
        if (row + NGW < nrows) {
#pragma unroll
            for (int j = 0; j < 4; ++j) xn[j] = *(const u32x2*)(XS + (size_t)(row + NGW) * DM + 4 * F.lane + 256 * j); }
        const float rs = rsqrtf(wave_sum(ss, F.lane) * (1.f / DM) + 1e-6f);
        const float* sh = mod + (size_t)bi * 6144 + 3 * 1024, *sc = sh + 1024;
        unsigned char* hr = H8 + (size_t)row * DM;
#pragma unroll
        for (int j = 0; j < 4; ++j) { const f32x4 s4 = *(const f32x4*)(sc + 4 * F.lane + 256 * j), h4 = *(const f32x4*)(sh + 4 * F.lane + 256 * j);
            v[j] = v[j] * rs * gv[j] * (s4 + 1.f) + h4; *(unsigned*)(hr + 4 * F.lane + 256 * j) = pk4f8(v[j][0] * H8_SCALE, v[j][1] * H8_SCALE, v[j][2] * H8_SCALE, v[j][3] * H8_SCALE); }
        float p[32];
#pragma unroll
        for (int e = 0; e < 32; ++e) { float s = 0.f;
#pragma unroll
            for (int j = 0; j < 4; ++j) { const f32x4 w4 = *(const LAS f32x4*)(rwt + e * 1024 + 4 * F.lane + 256 * j); s += v[j][0] * w4[0] + v[j][1] * w4[1] + v[j][2] * w4[2] + v[j][3] * w4[3]; }
            p[e] = s; if ((e & 3) == 3) asm volatile("" : "+v"(p[e]), "+v"(p[e - 1]), "+v"(p[e - 2]), "+v"(p[e - 3]) :: "memory"); }
#define RED_LEVEL(NKEEP, BIT, XCH) { const bool hi = (F.lane & (BIT)) != 0; _Pragma("unroll") for (int e = 0; e < (NKEEP); ++e) { const float send = hi ? p[e] : p[e + (NKEEP)], keep = hi ? p[e + (NKEEP)] : p[e]; p[e] = keep + XCH; } }
        RED_LEVEL(16, 32, xor32f(send, F.lane)) RED_LEVEL(8, 16, swz_xor<16>(send)) RED_LEVEL(4, 8, swz_xor<8>(send)) RED_LEVEL(2, 4, swz_xor<4>(send)) RED_LEVEL(1, 2, swz_xor<2>(send))
#undef RED_LEVEL
        float logit = p[0] + swz_xor<1>(p[0]) + rb;
        int es[4]; float ls[4];
#pragma unroll
        for (int k = 0; k < 4; ++k) {
            const float m = wave_max(logit, F.lane);
            const unsigned long long bal = __ballot(logit == m);
            const int fl = __builtin_ctzll(bal); es[k] = fl >> 1; ls[k] = m;
            if ((F.lane >> 1) == es[k]) logit = -3.0e38f;
        }
        const float e1 = __expf(ls[1] - ls[0]), e2 = __expf(ls[2] - ls[0]), e3 = __expf(ls[3] - ls[0]); const float inv = 1.f / (1.f + e1 + e2 + e3);
        if (F.lane < 4) {
            const int e = F.lane == 0 ? es[0] : (F.lane == 1 ? es[1] : (F.lane == 2 ? es[2] : es[3]));
            const float gt = (F.lane == 0 ? 1.f : (F.lane == 1 ? e1 : (F.lane == 2 ? e2 : e3))) * inv;
            const unsigned rk = __hip_atomic_fetch_add(lcnt + e, 1u, __ATOMIC_RELAXED, __HIP_MEMORY_SCOPE_WORKGROUP);
            PE[row * 4 + F.lane] = e; PR[row * 4 + F.lane] = (int)rk; PG[row * 4 + F.lane] = gt;
        }
    }
    __syncthreads();
    if (F.tid < 32) lcnt[32 + F.tid] = __hip_atomic_fetch_add(cnt + F.tid, lcnt[F.tid], RLX_AGENT);
    __syncthreads();
    int* TM = (int*)(F.ws + WS_TM);
    for (int row = gw; row < nrows; row += NGW) { if (F.lane < 4) { const int i = row * 4 + F.lane, e = PE[i], rk = PR[i] + (int)lcnt[32 + e]; TM[(size_t)e * NT + rk] = i; } }
    __syncthreads();
}
__device__ __forceinline__ void p_final(Frame& F, CArgs& a) {
    const int gw = F.bid * NWAVES + F.wave, NGW = F.G * NWAVES;
    const bf16* XS = (const bf16*)(F.ws + WS_XS);
    const float* modp = (const float*)(F.ws + WS_MOD) + (size_t)(DEPTH - 1) * 9 * 6144;
    const int* PS = (const int*)(F.ws + WS_PS); const bf16* Y = (const bf16*)(F.ws + WS_Y);
    const float* g = a.in[I_FING];
    f32x4 gv[4];
#pragma unroll
    for (int j = 0; j < 4; ++j) gv[j] = *(const f32x4*)(g + 4 * F.lane + 256 * j);
    u32x2 xb[4], yn[4][4]; int psn[4] = {0, 0, 0, 0};
#define FN_LOADX(row) do { const bf16* s_ = XS + (size_t)(row) * DM; _Pragma("unroll") for (int j = 0; j < 4; ++j) xb[j] = *(const u32x2*)(s_ + 4 * F.lane + 256 * j); } while (0)
#define FN_LOADY(ps) do { _Pragma("unroll") for (int k = 0; k < 4; ++k) { const bf16* yr_ = Y + (size_t)(ps)[k] * DM; _Pragma("unroll") for (int j = 0; j < 4; ++j) yn[k][j] = *(const u32x2*)(yr_ + 4 * F.lane + 256 * j); } } while (0)
#define FN_LOADPS(row) do { const int4 p_ = *(const int4*)(PS + (size_t)(row) * 4); psn[0] = p_.x; psn[1] = p_.y; psn[2] = p_.z; psn[3] = p_.w; } while (0)
    int row = gw;
    if (row < NLAT) { FN_LOADX(row); FN_LOADPS(row); FN_LOADY(psn); if (row + NGW < NLAT) FN_LOADPS(row + NGW); }
    while (row < NLAT) {
        const int nrow = row + NGW, bi = row >> 12;
        f32x4 v[4], s[4];
#pragma unroll
        for (int j = 0; j < 4; ++j) { v[j] = bf4(xb[j]); s[j] = (f32x4){0.f, 0.f, 0.f, 0.f};
#pragma unroll
            for (int k = 0; k < 4; ++k) s[j] += bf4(yn[k][j]); }
        if (nrow < NLAT) { FN_LOADX(nrow); FN_LOADY(psn); if (nrow + NGW < NLAT) FN_LOADPS(nrow + NGW); }
        const float* m5 = modp + (size_t)bi * 6144 + 5 * 1024;
        float ss = 0.f;
#pragma unroll
        for (int j = 0; j < 4; ++j) { v[j] += *(const f32x4*)(m5 + 4 * F.lane + 256 * j) * s[j]; ss += v[j][0] * v[j][0] + v[j][1] * v[j][1] + v[j][2] * v[j][2] + v[j][3] * v[j][3]; }
        const float rs = rsqrtf(wave_sum(ss, F.lane) * (1.f / DM) + 1e-6f);
        float* orow = a.out + (size_t)row * DM;
#pragma unroll
        for (int j = 0; j < 4; ++j) *(f32x4*)(orow + 4 * F.lane + 256 * j) = v[j] * rs * gv[j];
        row = nrow;
    }
#undef FN_LOADX
#undef FN_LOADY
#undef FN_LOADPS
}

#define MFMA16(a, b, c) __builtin_amdgcn_mfma_f32_16x16x32_bf16((a), (b), (c), 0, 0, 0)
typedef short v4i16_t __attribute__((ext_vector_type(4)));
__device__ __forceinline__ s16x4 trread(const LAS void* p) { return __builtin_bit_cast(s16x4, __builtin_amdgcn_ds_read_tr16_b64_v4i16((LAS v4i16_t*)p)); }
__device__ __forceinline__ bf16x8 cat8(s16x4 a, s16x4 b) { return __builtin_shufflevector(a, b, 0, 1, 2, 3, 4, 5, 6, 7); }
__device__ __forceinline__ bf16x8 pack8(const float* v) { u32x4 w; w.x = pg8::cvt_pk_bf16(v[0], v[1]); w.y = pg8::cvt_pk_bf16(v[2], v[3]); w.z = pg8::cvt_pk_bf16(v[4], v[5]); w.w = pg8::cvt_pk_bf16(v[6], v[7]); return __builtin_bit_cast(bf16x8, w); }
__device__ __forceinline__ void unpack8(bf16x8 x, float* v) { const u32x4 w = __builtin_bit_cast(u32x4, x); v[0] = bflo(w.x); v[1] = bfhi(w.x); v[2] = bflo(w.y); v[3] = bfhi(w.y); v[4] = bflo(w.z); v[5] = bfhi(w.z); v[6] = bflo(w.w); v[7] = bfhi(w.w); }
#define OPQ(x) ({ int o_ = (x); asm volatile("" : "+s"(o_)); o_; })
#define LAUNDER_F(F0) Frame F = F0; { const int t_ = fresh_tid(F.wave); F.tid = t_; F.lane = t_ & 63; }
__device__ __forceinline__ int chunk_tok0(int cid) { return cid < 512 ? cid * 64 : NLAT + (cid - 512) * 64; }

constexpr int GL_QS = 136, GL_VS = 264, GL_BS = 260;
constexpr int GL_Q = 0, GL_K = GL_Q + 64 * GL_QS * 2, GL_V = GL_K + 64 * GL_QS * 2, GL_A1 = GL_V + 64 * GL_VS * 2, GL_B = GL_A1 + 64 * 32 * 2, GL_END = GL_B + 64 * GL_BS * 4;
static_assert(GL_END <= MISC_OFF, "GLA LDS");
template <bool OUT> __device__ __forceinline__ void gla_chunk(Frame& F0, CArgs& a, int L, int cid) {
    LAUNDER_F(F0)
    const int tok0 = chunk_tok0(cid);
    const bf16* P = (const bf16*)(F.ws + WS_PBUF) + (size_t)tok0 * PW;
    LAS bf16* sq = (LAS bf16*)(F.lds + GL_Q); LAS bf16* sk = (LAS bf16*)(F.lds + GL_K); LAS bf16* sv = (LAS bf16*)(F.lds + GL_V); LAS bf16* sa1 = (LAS bf16*)(F.lds + GL_A1); LAS float* sB = (LAS float*)(F.lds + GL_B);
    __syncthreads();
    u32x4 rgate[4]; bf16x8 sfr[4];
    if constexpr (OUT) {
#pragma unroll
        for (int k = 0; k < 4; ++k) { const int i = F.tid + k * NTHR, t = i >> 5, pc = i & 31; rgate[k] = *(const u32x4*)(P + (size_t)t * PW + PC_R + pc * 8); }
        const bf16* se = (const bf16*)(F.ws + WS_GSE) + (((size_t)cid * 4 + (F.wave & 3)) * 2 + (F.wave >> 2)) * 2048;
#pragma unroll
        for (int d = 0; d < 4; ++d) sfr[d] = *(const bf16x8*)(se + (16 * d + (F.lane & 15)) * 32 + 8 * (F.lane >> 4));
    }
    {   u32x4 rq[2], rk[2], rv[4], ra = (u32x4){0u, 0u, 0u, 0u};
#pragma unroll
        for (int k = 0; k < 2; ++k) { const int i = F.tid + k * NTHR, t = i >> 4, pc = i & 15; rq[k] = *(const u32x4*)(P + (size_t)t * PW + PC_Q + pc * 8); rk[k] = *(const u32x4*)(P + (size_t)t * PW + PC_K + pc * 8); }
#pragma unroll
        for (int k = 0; k < 4; ++k) { const int i = F.tid + k * NTHR, t = i >> 5, pc = i & 31; rv[k] = *(const u32x4*)(P + (size_t)t * PW + PC_V + pc * 8); }
        if (F.tid < 256) { const int t = F.tid >> 2, pc = F.tid & 3; ra = *(const u32x4*)(P + (size_t)t * PW + PC_A1 + pc * 8); }
#pragma unroll
        for (int k = 0; k < 2; ++k) { const int i = F.tid + k * NTHR, t = i >> 4, pc = i & 15; *(LAS u32x4*)(sq + t * GL_QS + pc * 8) = rq[k]; *(LAS u32x4*)(sk + t * GL_QS + pc * 8) = rk[k]; }
#pragma unroll
        for (int k = 0; k < 4; ++k) { const int i = F.tid + k * NTHR, t = i >> 5, pc = i & 31; *(LAS u32x4*)(sv + t * GL_VS + pc * 8) = rv[k]; }
        if (F.tid < 256) { const int t = F.tid >> 2, pc = F.tid & 3; *(LAS u32x4*)(sa1 + t * 32 + pc * 8) = ra; }
    }
    __syncthreads();
    {
        const int col = F.tid & 255, r = col >> 7, c = col & 127, th = F.tid >> 8;
        float a2v[16];
#pragma unroll
        for (int i = 0; i < 16; ++i) a2v[i] = a.in[I_GLAA2][((size_t)(L * 2 + r) * 16 + i) * 128 + c];
        const float ab = a.in[I_GLAAB][(L * 2 + r) * 128 + c];
#pragma unroll 4
        for (int i = 0; i < 32; ++i) { const int t = th * 32 + i; float z = ab; float av[8];
            unpack8(*(const LAS bf16x8*)(sa1 + t * 32 + r * 16), av);
#pragma unroll
            for (int q = 0; q < 8; ++q) z += av[q] * a2v[q];
            unpack8(*(const LAS bf16x8*)(sa1 + t * 32 + r * 16 + 8), av);
#pragma unroll
            for (int q = 0; q < 8; ++q) z += av[q] * a2v[8 + q];
            const float ls = fminf(z, 0.f) - __logf(1.f + __expf(-fabsf(z)));
            sB[t * GL_BS + col] = ls * (1.f / 16.f); }
    }
    __syncthreads();
    if (F.tid < 256) { const int col = F.tid, r = col >> 7; float bv[64];
#pragma unroll
        for (int i = 0; i < 64; ++i) bv[i] = sB[i * GL_BS + col];
        if (r == 0) {
#pragma unroll
            for (int i = 1; i < 64; ++i) bv[i] += bv[i - 1];
        } else {
#pragma unroll
            for (int i = 62; i >= 0; --i) bv[i] += bv[i + 1];
        }
#pragma unroll
        for (int i = 0; i < 64; ++i) sB[i * GL_BS + col] = bv[i]; }
    __syncthreads();
    const int hh = F.wave & 3, r = F.wave >> 2, lr = F.lane & 15, g = F.lane >> 4;
    const int bc = r * 128 + hh * 32;
    const size_t ub = ((size_t)cid * 4 + hh) * 2 + r;
    if constexpr (!OUT) {
        const int tl = r ? 0 : 63;
        f32x4 acc[2][4];
#pragma unroll
        for (int mc = 0; mc < 2; ++mc)
#pragma unroll
            for (int d = 0; d < 4; ++d) acc[mc][d] = (f32x4){0.f, 0.f, 0.f, 0.f};
#pragma unroll
        for (int sg = 0; sg < 2; ++sg) {
            bf16x8 vf[4];
#pragma unroll
            for (int d = 0; d < 4; ++d) { const LAS bf16* p0 = sv + (32 * sg + 8 * g + ((F.lane & 15) >> 2)) * GL_VS + hh * 64 + 16 * d + 4 * (F.lane & 3); vf[d] = cat8(trread(p0), trread(p0 + 4 * GL_VS)); }
#pragma unroll
            for (int mc = 0; mc < 2; ++mc) {
                const LAS bf16* p0 = sk + (32 * sg + 8 * g + ((F.lane & 15) >> 2)) * GL_QS + hh * 32 + 16 * mc + 4 * (F.lane & 3);
                const s16x4 k0 = trread(p0), k1 = trread(p0 + 4 * GL_QS);
                const int c = 16 * mc + lr; const float bl = sB[tl * GL_BS + bc + c];
                float kv[8];
#pragma unroll
                for (int e = 0; e < 4; ++e) { kv[e] = bf2f((unsigned short)k0[e]) * __expf(bl - sB[(32 * sg + 8 * g + e) * GL_BS + bc + c]); kv[4 + e] = bf2f((unsigned short)k1[e]) * __expf(bl - sB[(32 * sg + 8 * g + 4 + e) * GL_BS + bc + c]); }
                const bf16x8 kf = pack8(kv);
#pragma unroll
                for (int d = 0; d < 4; ++d) acc[mc][d] = MFMA16(kf, vf[d], acc[mc][d]);
            }
        }
        float* ds = (float*)(F.ws + WS_GDS) + ub * 2048;
#pragma unroll
        for (int mc = 0; mc < 2; ++mc)
#pragma unroll
            for (int d = 0; d < 4; ++d) *(f32x4*)(ds + (16 * d + lr) * 32 + 16 * mc + 4 * g) = acc[mc][d];
        if (F.lane < 32) ((float*)(F.ws + WS_GDEC))[ub * 32 + F.lane] = __expf(sB[tl * GL_BS + bc + F.lane]);
    } else {
        bf16x8 qf[4], kf[4];
#pragma unroll
        for (int m = 0; m < 4; ++m) { const int t = 16 * m + lr; float qv[8], kv[8], bv[8];
            unpack8(*(const LAS bf16x8*)(sq + t * GL_QS + hh * 32 + 8 * g), qv); unpack8(*(const LAS bf16x8*)(sk + t * GL_QS + hh * 32 + 8 * g), kv);
            *(f32x4*)bv = *(const LAS f32x4*)(sB + t * GL_BS + bc + 8 * g); *(f32x4*)(bv + 4) = *(const LAS f32x4*)(sB + t * GL_BS + bc + 8 * g + 4);
#pragma unroll
            for (int e = 0; e < 8; ++e) { const float ex = __expf(bv[e]); qv[e] *= 0.17677669529663687f * ex; kv[e] *= __frcp_rn(ex); }
            qf[m] = pack8(qv); kf[m] = pack8(kv); }
        f32x4 o[4][4];
#pragma unroll
        for (int m = 0; m < 4; ++m)
#pragma unroll
            for (int d = 0; d < 4; ++d) o[m][d] = (f32x4){0.f, 0.f, 0.f, 0.f};
        {
#pragma unroll
            for (int d = 0; d < 4; ++d) {
#pragma unroll
                for (int m = 0; m < 4; ++m) o[m][d] = MFMA16(qf[m], sfr[d], o[m][d]); }
        }
        bf16x8 vf[2][4];
#pragma unroll
        for (int sg = 0; sg < 2; ++sg)
#pragma unroll
            for (int d = 0; d < 4; ++d) { const LAS bf16* p0 = sv + (32 * sg + 4 * g + ((F.lane & 15) >> 2)) * GL_VS + hh * 64 + 16 * d + 4 * (F.lane & 3); vf[sg][d] = cat8(trread(p0), trread(p0 + 16 * GL_VS)); }
        const f32x4 zero4 = (f32x4){0.f, 0.f, 0.f, 0.f};
#pragma unroll
        for (int m = 0; m < 4; ++m) {
            const int t = 16 * m + lr;
#pragma unroll
            for (int sg = 0; sg < 2; ++sg) {
                f32x4 p0 = MFMA16(kf[2 * sg], qf[m], zero4), p1 = MFMA16(kf[2 * sg + 1], qf[m], zero4);
                float pv[8];
#pragma unroll
                for (int j = 0; j < 4; ++j) { const int s0 = 32 * sg + 4 * g + j, s1 = s0 + 16; pv[j] = (r ? s0 >= t : s0 <= t) ? p0[j] : 0.f; pv[4 + j] = (r ? s1 >= t : s1 <= t) ? p1[j] : 0.f; }
                const bf16x8 pf = pack8(pv);
#pragma unroll
                for (int d = 0; d < 4; ++d) o[m][d] = MFMA16(pf, vf[sg][d], o[m][d]);
            }
        }
        __syncthreads();
        LAS float* ox = (LAS float*)(F.lds + GL_B);
        LAS bf16* ot = (LAS bf16*)(F.lds + GL_Q);
        LAS bf16* srg = (LAS bf16*)(F.lds + GL_V);
#pragma unroll
        for (int k = 0; k < 4; ++k) { const int i = F.tid + k * NTHR, t = i >> 5, pc = i & 31; *(LAS u32x4*)(srg + t * GL_VS + pc * 8) = rgate[k]; }
        if (r == 1) {
#pragma unroll
            for (int m = 0; m < 4; ++m)
#pragma unroll
                for (int d = 0; d < 4; ++d)
#pragma unroll
                    for (int j = 0; j < 4; ++j) ox[(hh * 64 + 16 * m + 4 * g + j) * 65 + 16 * d + lr] = o[m][d][j];
        }
        __syncthreads();
        if (r == 0) {
            const float* ng = a.in[I_GLANG] + L * 64;
            float gn[4];
#pragma unroll
            for (int d = 0; d < 4; ++d) gn[d] = ng[16 * d + lr];
#pragma unroll
            for (int m = 0; m < 4; ++m)
#pragma unroll
                for (int j = 0; j < 4; ++j) {
                    const int t = 16 * m + 4 * g + j; float v[4], ss = 0.f;
#pragma unroll
                    for (int d = 0; d < 4; ++d) { v[d] = o[m][d][j] + ox[(hh * 64 + t) * 65 + 16 * d + lr]; ss += v[d] * v[d]; }
                    ss += swz_xor<1>(ss); ss += swz_xor<2>(ss); ss += swz_xor<4>(ss); ss += swz_xor<8>(ss);
                    const float rs = rsqrtf(ss * (1.f / 64.f) + 1e-6f);
#pragma unroll
                    for (int d = 0; d < 4; ++d) { const float rg = bf2f(srg[t * GL_VS + hh * 64 + 16 * d + lr]); ot[t * 264 + hh * 64 + 16 * d + lr] = (bf16)f2bf(v[d] * rs * gn[d] * siluf_(rg)); }
                }
        }
        __syncthreads();
        bf16* MX = (bf16*)(F.ws + WS_MIX) + (size_t)tok0 * MW + 768;
        for (int i = F.tid; i < 2048; i += NTHR) { const int t = i >> 5, pc = i & 31; *(u32x4*)(MX + (size_t)t * MW + pc * 8) = *(const LAS u32x4*)(ot + t * 264 + pc * 8); }
    }
}

constexpr int SD_RS = 520;
constexpr int SD_RAW = 0, SD_XC = SD_RAW + 68 * SD_RS * 2, SD_DT = SD_XC + 64 * SD_RS * 2, SD_CUM = SD_DT + 64 * 8 * 4, SD_W = SD_CUM + 8 * 64 * 4, SD_END = SD_W + 8 * 64 * 4;
static_assert(SD_END <= MISC_OFF && 64 * 260 * 4 <= 68 * SD_RS * 2, "SSD LDS");
template <bool OUT> __device__ __forceinline__ void ssd_chunk(Frame& F0, CArgs& a, int L, int cid) {
    LAUNDER_F(F0)
    const int tok0 = chunk_tok0(cid);
    const bf16* PB = (const bf16*)(F.ws + WS_PBUF);
    LAS bf16* raw = (LAS bf16*)(F.lds + SD_RAW); LAS bf16* xc = (LAS bf16*)(F.lds + SD_XC); LAS float* sdt = (LAS float*)(F.lds + SD_DT); LAS float* scum = (LAS float*)(F.lds + SD_CUM); LAS float* sw = (LAS float*)(F.lds + SD_W);
    bf16x8 sfr[4][2];
    if constexpr (OUT) { const bf16* se = (const bf16*)(F.ws + WS_SSE) + (((size_t)cid * 4 + (F.wave & 3)) * 2 + (F.wave >> 2)) * 4096;
#pragma unroll
        for (int d = 0; d < 4; ++d) { sfr[d][0] = *(const bf16x8*)(se + (16 * d + (F.lane & 15)) * 64 + 8 * (F.lane >> 4)); sfr[d][1] = *(const bf16x8*)(se + (16 * d + (F.lane & 15)) * 64 + 32 + 8 * (F.lane >> 4)); } }
    __syncthreads();
    {
        const int isctx = cid >= 512, c4 = (cid - 512) & 3;
        u32x4 rv[9];
#pragma unroll
        for (int k = 0; k < 9; ++k) { const int i = F.tid + k * NTHR, rr = i >> 6, pc = i & 63, t = rr - 2; rv[k] = (u32x4){0u, 0u, 0u, 0u};
            bool ok = t >= 0 && t < 64 && i < 68 * 64; if (isctx) { const int tt = c4 * 64 + t; ok = tt >= 0 && tt < 256 && i < 68 * 64; }
            if (ok) rv[k] = *(const u32x4*)(PB + (size_t)(tok0 + t) * PW + PC_XBC + pc * 8); }
#pragma unroll
        for (int k = 0; k < 9; ++k) { const int i = F.tid + k * NTHR, rr = i >> 6, pc = i & 63; if (i < 68 * 64) *(LAS u32x4*)(raw + rr * SD_RS + pc * 8) = rv[k]; }
        if (F.tid < 64) { float dv[8]; unpack8(*(const bf16x8*)(PB + (size_t)(tok0 + F.tid) * PW + PC_DT), dv);
#pragma unroll
            for (int q = 0; q < 8; ++q) { const float z = dv[q] + a.in[I_SSDDTB][L * 8 + q]; sdt[F.tid * 8 + q] = z > 20.f ? z : __logf(1.f + __expf(z)); } }
    }
    __syncthreads();
    {
        const int ch = F.tid; float w[5];
#pragma unroll
        for (int k = 0; k < 5; ++k) w[k] = a.in[I_SSDCW][((size_t)L * 5 + k) * 512 + ch];
        const float cb = a.in[I_SSDCB][L * 512 + ch];
        float x0 = bf2f(raw[0 * SD_RS + ch]), x1 = bf2f(raw[1 * SD_RS + ch]), x2 = bf2f(raw[2 * SD_RS + ch]), x3 = bf2f(raw[3 * SD_RS + ch]);
        for (int t0 = 0; t0 < 64; t0 += 16) { float xv[16];
#pragma unroll
            for (int k = 0; k < 16; ++k) xv[k] = bf2f(raw[(t0 + k + 4) * SD_RS + ch]);
#pragma unroll
            for (int k = 0; k < 16; ++k) { const float x4 = xv[k]; const float y = cb + w[0] * x0 + w[1] * x1 + w[2] * x2 + w[3] * x3 + w[4] * x4;
                xc[(t0 + k) * SD_RS + ch] = (bf16)f2bf(siluf_(y)); x0 = x1; x1 = x2; x2 = x3; x3 = x4; } }
    }
    {
        const int q = F.wave, rr = q >> 2, t = rr ? 63 - F.lane : F.lane;
        const float aa = -__expf(a.in[I_SSDALOG][L * 8 + q]); const float dtv = sdt[t * 8 + q];
        float c = dtv * aa;
        { float o;
          o = __builtin_bit_cast(float, __builtin_amdgcn_ds_bpermute((F.lane - 1) << 2, __builtin_bit_cast(int, c))); if (F.lane >= 1) c += o;
          o = __builtin_bit_cast(float, __builtin_amdgcn_ds_bpermute((F.lane - 2) << 2, __builtin_bit_cast(int, c))); if (F.lane >= 2) c += o;
          o = __builtin_bit_cast(float, __builtin_amdgcn_ds_bpermute((F.lane - 4) << 2, __builtin_bit_cast(int, c))); if (F.lane >= 4) c += o;
          o = __builtin_bit_cast(float, __builtin_amdgcn_ds_bpermute((F.lane - 8) << 2, __builtin_bit_cast(int, c))); if (F.lane >= 8) c += o;
          o = __builtin_bit_cast(float, __builtin_amdgcn_ds_bpermute((F.lane - 16) << 2, __builtin_bit_cast(int, c))); if (F.lane >= 16) c += o;
          o = __builtin_bit_cast(float, __builtin_amdgcn_ds_bpermute((F.lane - 32) << 2, __builtin_bit_cast(int, c))); if (F.lane >= 32) c += o; }
        const float cl = __builtin_bit_cast(float, __builtin_amdgcn_ds_bpermute(63 << 2, __builtin_bit_cast(int, c)));
        scum[q * 64 + t] = c; sw[q * 64 + t] = __expf(cl - c) * dtv;
    }
    __syncthreads();
    const int h = F.wave & 3, r = F.wave >> 2, lr = F.lane & 15, g = F.lane >> 4, gp = h >> 1, rh = r * 4 + h;
    const size_t ub = ((size_t)cid * 4 + h) * 2 + r;
    if constexpr (!OUT) {
        f32x4 acc[4][4];
#pragma unroll
        for (int ms = 0; ms < 4; ++ms)
#pragma unroll
            for (int d = 0; d < 4; ++d) acc[ms][d] = (f32x4){0.f, 0.f, 0.f, 0.f};
#pragma unroll
        for (int sg = 0; sg < 2; ++sg) {
            const int trow = 32 * sg + 8 * g;
            bf16x8 xf[4];
#pragma unroll
            for (int d = 0; d < 4; ++d) { const LAS bf16* p0 = xc + (trow + ((F.lane & 15) >> 2)) * SD_RS + h * 64 + 16 * d + 4 * (F.lane & 3); xf[d] = cat8(trread(p0), trread(p0 + 4 * SD_RS)); }
            float wv[8];
            *(f32x4*)wv = *(const LAS f32x4*)(sw + rh * 64 + trow); *(f32x4*)(wv + 4) = *(const LAS f32x4*)(sw + rh * 64 + trow + 4);
#pragma unroll
            for (int ms = 0; ms < 4; ++ms) {
                const LAS bf16* p0 = xc + (trow + ((F.lane & 15) >> 2)) * SD_RS + 256 + gp * 64 + 16 * ms + 4 * (F.lane & 3);
                const s16x4 b0 = trread(p0), b1 = trread(p0 + 4 * SD_RS);
                float bv[8];
#pragma unroll
                for (int e = 0; e < 4; ++e) { bv[e] = bf2f((unsigned short)b0[e]) * wv[e]; bv[4 + e] = bf2f((unsigned short)b1[e]) * wv[4 + e]; }
                const bf16x8 bf = pack8(bv);
#pragma unroll
                for (int d = 0; d < 4; ++d) acc[ms][d] = MFMA16(bf, xf[d], acc[ms][d]);
            }
        }
        float* ds = (float*)(F.ws + WS_SDS) + ub * 4096;
#pragma unroll
        for (int ms = 0; ms < 4; ++ms)
#pragma unroll
            for (int d = 0; d < 4; ++d) *(f32x4*)(ds + (16 * d + lr) * 64 + 16 * ms + 4 * g) = acc[ms][d];
        if (F.lane == 0) ((float*)(F.ws + WS_SDEC))[ub] = __expf(scum[rh * 64 + (r ? 0 : 63)]);
    } else {
        bf16x8 bfr[4][2], cfr[4][2];
#pragma unroll
        for (int m = 0; m < 4; ++m)
#pragma unroll
            for (int ks = 0; ks < 2; ++ks) { bfr[m][ks] = *(const LAS bf16x8*)(xc + (16 * m + lr) * SD_RS + 256 + gp * 64 + 32 * ks + 8 * g); cfr[m][ks] = *(const LAS bf16x8*)(xc + (16 * m + lr) * SD_RS + 384 + gp * 64 + 32 * ks + 8 * g); }
        f32x4 y[4][4];
#pragma unroll
        for (int m = 0; m < 4; ++m)
#pragma unroll
            for (int d = 0; d < 4; ++d) y[m][d] = (f32x4){0.f, 0.f, 0.f, 0.f};
        {
            bf16x8 cs[4][2];
#pragma unroll
            for (int m = 0; m < 4; ++m) { const float ec = __expf(scum[rh * 64 + 16 * m + lr]);
#pragma unroll
                for (int ks = 0; ks < 2; ++ks) { float cv[8]; unpack8(cfr[m][ks], cv);
#pragma unroll
                    for (int e = 0; e < 8; ++e) cv[e] *= ec;
                    cs[m][ks] = pack8(cv); } }
#pragma unroll
            for (int d = 0; d < 4; ++d) {
#pragma unroll
                for (int m = 0; m < 4; ++m) { y[m][d] = MFMA16(cs[m][0], sfr[d][0], y[m][d]); y[m][d] = MFMA16(cs[m][1], sfr[d][1], y[m][d]); }
            }
        }
        asm volatile("" ::: "memory");
        bf16x8 xf[2][4];
#pragma unroll
        for (int sg = 0; sg < 2; ++sg)
#pragma unroll
            for (int d = 0; d < 4; ++d) { const LAS bf16* p0 = xc + (32 * sg + 4 * g + ((F.lane & 15) >> 2)) * SD_RS + h * 64 + 16 * d + 4 * (F.lane & 3); xf[sg][d] = cat8(trread(p0), trread(p0 + 16 * SD_RS)); }
        const f32x4 zero4 = (f32x4){0.f, 0.f, 0.f, 0.f};
#pragma unroll
        for (int m = 0; m < 4; ++m) {
            const int t = 16 * m + lr; const float ct = scum[rh * 64 + t];
#pragma unroll
            for (int sg = 0; sg < 2; ++sg) {
                f32x4 p0 = MFMA16(bfr[2 * sg][0], cfr[m][0], zero4), p1 = MFMA16(bfr[2 * sg + 1][0], cfr[m][0], zero4);
                p0 = MFMA16(bfr[2 * sg][1], cfr[m][1], p0); p1 = MFMA16(bfr[2 * sg + 1][1], cfr[m][1], p1);
                float pv[8];
#pragma unroll
                for (int j = 0; j < 4; ++j) { const int s0 = 32 * sg + 4 * g + j, s1 = s0 + 16;
                    pv[j] = (r ? s0 >= t : s0 <= t) ? p0[j] * __expf(ct - scum[rh * 64 + s0]) * sdt[s0 * 8 + rh] : 0.f;
                    pv[4 + j] = (r ? s1 >= t : s1 <= t) ? p1[j] * __expf(ct - scum[rh * 64 + s1]) * sdt[s1 * 8 + rh] : 0.f; }
                const bf16x8 pf = pack8(pv);
#pragma unroll
                for (int d = 0; d < 4; ++d) y[m][d] = MFMA16(pf, xf[sg][d], y[m][d]);
            }
        }
        __syncthreads();
        LAS float* yx = (LAS float*)(F.lds + SD_RAW);
        if (r == 1) {
#pragma unroll
            for (int m = 0; m < 4; ++m)
#pragma unroll
                for (int d = 0; d < 4; ++d)
#pragma unroll
                    for (int j = 0; j < 4; ++j) yx[(16 * m + 4 * g + j) * 260 + h * 64 + 16 * d + lr] = y[m][d][j];
        }
        __syncthreads();
        if (r == 0) { const float dsk = a.in[I_SSDD][L * 4 + h];
#pragma unroll
            for (int m = 0; m < 4; ++m)
#pragma unroll
                for (int d = 0; d < 4; ++d)
#pragma unroll
                    for (int j = 0; j < 4; ++j) { const int t = 16 * m + 4 * g + j, c = h * 64 + 16 * d + lr; yx[t * 260 + c] += y[m][d][j] + dsk * bf2f(xc[t * SD_RS + c]); asm volatile("" ::: "memory"); }
        }
        __syncthreads();
        { const int t = F.tid >> 3, c0 = (F.tid & 7) * 32; const bf16* zr = PB + (size_t)(tok0 + t) * PW + PC_Z + c0; const float* ng = a.in[I_SSDNG] + L * 256 + c0;
          float v[32]; float ss = 0.f;
#pragma unroll
          for (int q = 0; q < 4; ++q) { float zv[8]; unpack8(*(const bf16x8*)(zr + 8 * q), zv);
#pragma unroll
              for (int e = 0; e < 8; ++e) { const float u = yx[t * 260 + c0 + 8 * q + e] * siluf_(zv[e]); v[8 * q + e] = u; ss += u * u; } }
          ss += swz_xor<1>(ss); ss += swz_xor<2>(ss); ss += swz_xor<4>(ss);
          const float rs = rsqrtf(ss * (1.f / 256.f) + 1e-6f);
          bf16* MX = (bf16*)(F.ws + WS_MIX) + (size_t)(tok0 + t) * MW + 1024 + c0;
#pragma unroll
          for (int q = 0; q < 4; ++q) { float o8[8];
#pragma unroll
              for (int e = 0; e < 8; ++e) o8[e] = v[8 * q + e] * rs * ng[8 * q + e];
              *(bf16x8*)(MX + 8 * q) = pack8(o8); } }
    }
}

constexpr int FF_XP = 0, FF_TR = FF_XP + 16 * 64 * 16 * 2, FF_TI = FF_TR + 16 * 64 * 16 * 2, FF_END = FF_TI + 16 * 64 * 16 * 2;
__device__ __forceinline__ void fft_unit(Frame& F0, int u) {
    LAUNDER_F(F0)
    const int b = u >> 6, cg = (u >> 2) & 15, kb = u & 3, lr = F.lane & 15, g = F.lane >> 4;
    const bf16* PB = (const bf16*)(F.ws + WS_PBUF) + (size_t)b * SEQ * PW + PC_FU + 16 * cg;
    const bf16* f64 = (const bf16*)(F.ws + WS_TAB + TAB_F64); const float* tw = (const float*)(F.ws + WS_TAB + TAB_TW);
    LAS bf16* xp = (LAS bf16*)(F.lds + FF_XP); LAS bf16* tr = (LAS bf16*)(F.lds + FF_TR); LAS bf16* ti = (LAS bf16*)(F.lds + FF_TI);
    bf16x8 fc1[2], fs1[2];
#pragma unroll
    for (int ks = 0; ks < 2; ++ks) { fc1[ks] = *(const bf16x8*)(f64 + (16 * kb + lr) * 64 + 32 * ks + 8 * g); fs1[ks] = *(const bf16x8*)(f64 + 4096 + (16 * kb + lr) * 64 + 32 * ks + 8 * g); }
    const f32x4 zero4 = (f32x4){0.f, 0.f, 0.f, 0.f};
    u32x4 xr[4];
#pragma unroll
    for (int k = 0; k < 4; ++k) { const int i = F.tid + k * NTHR, n2l = i >> 7, n1 = (i >> 1) & 63, hf = i & 1; xr[k] = *(const u32x4*)(PB + (size_t)(64 * n1 + n2l) * PW + hf * 8); }
    for (int pa = 0; pa < 4; ++pa) {
        __syncthreads();
#pragma unroll
        for (int k = 0; k < 4; ++k) { const int i = F.tid + k * NTHR, n2l = i >> 7, n1 = (i >> 1) & 63, hf = i & 1; *(LAS u32x4*)(xp + (n2l * 64 + n1) * 16 + hf * 8) = xr[k]; }
        if (pa < 3) {
#pragma unroll
            for (int k = 0; k < 4; ++k) { const int i = F.tid + k * NTHR, n2l = i >> 7, n1 = (i >> 1) & 63, hf = i & 1; xr[k] = *(const u32x4*)(PB + (size_t)(64 * n1 + 16 * (pa + 1) + n2l) * PW + hf * 8); }
        }
        __syncthreads();
#pragma unroll
        for (int q = 0; q < 2; ++q) {
            const int n2l = 2 * F.wave + q, n2 = 16 * pa + n2l;
            f32x4 tc = zero4, ts = zero4;
#pragma unroll
            for (int ks = 0; ks < 2; ++ks) { const LAS bf16* p0 = xp + (n2l * 64 + 32 * ks + 8 * g + ((F.lane & 15) >> 2)) * 16 + 4 * (F.lane & 3); const bf16x8 xb = cat8(trread(p0), trread(p0 + 4 * 16));
                tc = MFMA16(fc1[ks], xb, tc); ts = MFMA16(fs1[ks], xb, ts); }
#pragma unroll
            for (int j = 0; j < 4; ++j) { const int k1l = 4 * g + j, k1 = 16 * kb + k1l; const f32x2 w = *(const f32x2*)(tw + 2 * (n2 * k1));
                tr[(k1l * 64 + n2) * 16 + lr] = (bf16)f2bf(tc[j] * w[0] - ts[j] * w[1]); ti[(k1l * 64 + n2) * 16 + lr] = (bf16)f2bf(-(tc[j] * w[1] + ts[j] * w[0])); }
        }
    }
    __syncthreads();
    bf16* MX = (bf16*)(F.ws + WS_MIX) + (size_t)b * SEQ * MW + 16 * cg + lr;
#pragma unroll
    for (int q = 0; q < 2; ++q) {
        const int k1l = 2 * F.wave + q, k1 = 16 * kb + k1l;
        bf16x8 br[2], bi[2];
#pragma unroll
        for (int ks = 0; ks < 2; ++ks) { const int off = (k1l * 64 + 32 * ks + 8 * g + ((F.lane & 15) >> 2)) * 16 + 4 * (F.lane & 3); br[ks] = cat8(trread(tr + off), trread(tr + off + 64)); bi[ks] = cat8(trread(ti + off), trread(ti + off + 64)); }
#pragma unroll
        for (int m = 0; m < 4; ++m) {
            f32x4 yr = zero4, y1 = zero4, y2 = zero4;
#pragma unroll
            for (int ks = 0; ks < 2; ++ks) { const bf16x8 fc = *(const bf16x8*)(f64 + (16 * m + lr) * 64 + 32 * ks + 8 * g), fs = *(const bf16x8*)(f64 + 4096 + (16 * m + lr) * 64 + 32 * ks + 8 * g);
                yr = MFMA16(fc, br[ks], yr); yr = MFMA16(fs, bi[ks], yr); y1 = MFMA16(fc, bi[ks], y1); y2 = MFMA16(fs, br[ks], y2); }
#pragma unroll
            for (int j = 0; j < 4; ++j) { const int k2 = 16 * m + 4 * g + j; bf16* o = MX + (size_t)(64 * k2 + k1) * MW; o[0] = (bf16)f2bf(yr[j] * (1.f / 64.f)); o[256] = (bf16)f2bf((y1[j] - y2[j]) * (1.f / 64.f)); }
        }
    }
}
__device__ __forceinline__ void dft_ctx_unit(Frame& F0, int u) {
    LAUNDER_F(F0)
    const int b = u >> 5, kblk = u & 31;
    LAS bf16* sl = (LAS bf16*)F.lds;
    const bf16* PB = (const bf16*)(F.ws + WS_PBUF) + (size_t)(NLAT + b * CTXL) * PW + PC_FU;
    __syncthreads();
#pragma unroll
    for (int h = 0; h < 2; ++h) { u32x4 v[8];
#pragma unroll
        for (int k = 0; k < 8; ++k) { const int i = F.tid + (h * 8 + k) * NTHR, n = i >> 5, pc = i & 31; v[k] = *(const u32x4*)(PB + (size_t)n * PW + pc * 8); }
#pragma unroll
        for (int k = 0; k < 8; ++k) { const int i = F.tid + (h * 8 + k) * NTHR, n = i >> 5, pc = i & 31; *(LAS u32x4*)(sl + n * 256 + pc * 8) = v[k]; } }
    __syncthreads();
    const int c = F.tid & 255, k0 = kblk * 8 + (F.tid >> 8) * 4;
    const float* d256 = (const float*)(F.ws + WS_TAB + TAB_D256);
    float wr[4], wi[4], sr[4], si[4], ar[4], ai[4];
#pragma unroll
    for (int i = 0; i < 4; ++i) { sr[i] = d256[2 * (k0 + i)]; si[i] = -d256[2 * (k0 + i) + 1]; wr[i] = 1.f; wi[i] = 0.f; ar[i] = 0.f; ai[i] = 0.f; }
#pragma unroll 4
    for (int n = 0; n < 256; ++n) { const float uv = bf2f(sl[n * 256 + c]);
#pragma unroll
        for (int i = 0; i < 4; ++i) { ar[i] += uv * wr[i]; ai[i] += uv * wi[i]; const float nr = wr[i] * sr[i] - wi[i] * si[i], ni = wr[i] * si[i] + wi[i] * sr[i]; wr[i] = nr; wi[i] = ni; } }
    bf16* MX = (bf16*)(F.ws + WS_MIX) + (size_t)(NLAT + b * CTXL + k0) * MW + c;
#pragma unroll
    for (int i = 0; i < 4; ++i) { MX[(size_t)i * MW] = (bf16)f2bf(ar[i] * (1.f / 16.f)); MX[(size_t)i * MW + 256] = (bf16)f2bf(ai[i] * (1.f / 16.f)); }
}

#ifndef SUBMASK
#define SUBMASK 0xFFFF
#endif
#define SUB(bit) (rep == 0 || ((SUBMASK >> (bit)) & 1))
__device__ __forceinline__ void p_mix_a(Frame& F, CArgs& a, int L, int rep = 0) {
    if (SUB(0)) {
        pg8::Gemm g{(const bf16*)(F.ws + WS_A2), (const bf16*)(F.ws + WS_S5P) + (size_t)L * 16 * 256 * 256, 1024, 512, OPQ(256)};
        SgOrder<FillS5> S; S.init(144, 1, F.G, F.bid); S.f = FillS5{(size_t)256 * 256 * 2};
        EpiS5S E{(float*)(F.ws + WS_S5S)};
        pg8::gemm_phase(F.lds, g, S, E, fresh_tid(F.wave));
    }
    if (SUB(1)) for (int u = F.bid; u < NCHK; u += F.G) gla_chunk<false>(F, a, L, u);
    if (SUB(2)) for (int u = (F.bid + 32) % F.G; u < NCHK; u += F.G) ssd_chunk<false>(F, a, L, u);
    __syncthreads();
}
__device__ __forceinline__ void p_mix_b(Frame& F, CArgs& a, int L, int rep = 0) {
    if (SUB(3)) for (int u = F.bid; u < 256; u += F.G) {
        const int vz = F.tid >> 9, uv = u + vz, wv = (F.tid >> 6);
        const int b = uv >> 5, g = (uv >> 1) & 15, r = uv & 1;
        const f32x2 a16 = *(const f32x2*)((const float*)(F.ws + WS_A16) + ((size_t)((L * 2 + r) * 16 + g) * 64 + F.lane) * 2);
        const float* S = (const float*)(F.ws + WS_S5S) + (size_t)g * S5ROWS * 256 + r * 128 + F.lane; bf16* A2 = (bf16*)(F.ws + WS_A2) + (size_t)g * S5ROWS * 512 + 256 + r * 128 + F.lane;
        LAS float* ex = (LAS float*)F.lds;
        LAS float* sl = ex + 17 * 128;
        __syncthreads();
#pragma unroll 1
        for (int sg = wv; sg < 17; sg += 8) {
            float sr[16], si[16];
#pragma unroll
            for (int n = 0; n < 16; ++n) { const int i = 16 * sg + n; const int row = i < 16 ? 2048 + 16 * b + (r ? 15 - i : i) : 256 * b + (r ? 271 - i : i - 16); sr[n] = S[(size_t)row * 256]; si[n] = S[(size_t)row * 256 + 64]; }
            float hr = 0.f, hi = 0.f;
#pragma unroll
            for (int n = 0; n < 16; ++n) { sl[((16 * sg + n) * 64 + F.lane) * 2] = sr[n]; sl[((16 * sg + n) * 64 + F.lane) * 2 + 1] = si[n];
                const float nr = a16[0] * hr - a16[1] * hi + sr[n], ni = a16[0] * hi + a16[1] * hr + si[n]; hr = nr; hi = ni; }
            ex[(sg * 64 + F.lane) * 2] = hr; ex[(sg * 64 + F.lane) * 2 + 1] = hi;
        }
        __syncthreads();
        float pr = a16[0], pi = a16[1];
#pragma unroll
        for (int q = 0; q < 4; ++q) { const float nr = pr * pr - pi * pi, ni = 2.f * pr * pi; pr = nr; pi = ni; }
#pragma unroll 1
        for (int sg = wv; sg < 17; sg += 8) {
            float hr = 0.f, hi = 0.f;
            for (int j = 0; j < sg; ++j) { const float er = ex[(j * 64 + F.lane) * 2], ei = ex[(j * 64 + F.lane) * 2 + 1]; const float nr = pr * hr - pi * hi + er, ni = pr * hi + pi * hr + ei; hr = nr; hi = ni; }
#pragma unroll 4
            for (int n = 0; n < 16; ++n) { const int i = 16 * sg + n; const int row = i < 16 ? 2048 + 16 * b + (r ? 15 - i : i) : 256 * b + (r ? 271 - i : i - 16);
                A2[(size_t)row * 512] = (bf16)f2bf(hr); A2[(size_t)row * 512 + 64] = (bf16)f2bf(hi);
                const float xr_ = sl[(i * 64 + F.lane) * 2], xi_ = sl[(i * 64 + F.lane) * 2 + 1];
                const float nr = a16[0] * hr - a16[1] * hi + xr_, ni = a16[0] * hi + a16[1] * hr + xi_; hr = nr; hi = ni; }
        }
    }
    if (SUB(3)) for (int u = F.bid; u < 256; u += F.G) { const int uv = u + (F.tid >> 9), sq = uv >> 2, b = sq >> 3, hh = (sq >> 1) & 3, r = sq & 1, e = (uv & 3) * 512 + F.tid, c = e & 31;
        const float* ds = (const float*)(F.ws + WS_GDS); const float* dc = (const float*)(F.ws + WS_GDEC); bf16* se = (bf16*)(F.ws + WS_GSE);
        float s = 0.f;
        for (int i0 = 0; i0 < 68; i0 += 17) { float dv[17], cv[17];
#pragma unroll
            for (int k = 0; k < 17; ++k) { const int i = i0 + k; const int cid = i < 4 ? 512 + b * 4 + (r ? 3 - i : i) : b * 64 + (r ? 67 - i : i - 4); const size_t ub = ((size_t)cid * 4 + hh) * 2 + r; dv[k] = ds[ub * 2048 + e]; cv[k] = dc[ub * 32 + c]; }
#pragma unroll
            for (int k = 0; k < 17; ++k) { const int i = i0 + k; const int cid = i < 4 ? 512 + b * 4 + (r ? 3 - i : i) : b * 64 + (r ? 67 - i : i - 4); const size_t ub = ((size_t)cid * 4 + hh) * 2 + r; se[ub * 2048 + e] = (bf16)f2bf(s); s = cv[k] * s + dv[k]; } } }
    if (SUB(3)) for (int u = F.bid; u < 512; u += F.G) { const int uv = u + (F.tid >> 9), sq = uv >> 3, b = sq >> 3, h = (sq >> 1) & 3, r = sq & 1, e = (uv & 7) * 512 + F.tid;
        const float* ds = (const float*)(F.ws + WS_SDS); const float* dc = (const float*)(F.ws + WS_SDEC); bf16* se = (bf16*)(F.ws + WS_SSE);
        float s = 0.f;
        for (int i0 = 0; i0 < 68; i0 += 17) { float dv[17], cv[17];
#pragma unroll
            for (int k = 0; k < 17; ++k) { const int i = i0 + k; const int cid = i < 4 ? 512 + b * 4 + (r ? 3 - i : i) : b * 64 + (r ? 67 - i : i - 4); const size_t ub = ((size_t)cid * 4 + h) * 2 + r; dv[k] = ds[ub * 4096 + e]; cv[k] = dc[ub]; }
#pragma unroll
            for (int k = 0; k < 17; ++k) { const int i = i0 + k; const int cid = i < 4 ? 512 + b * 4 + (r ? 3 - i : i) : b * 64 + (r ? 67 - i : i - 4); const size_t ub = ((size_t)cid * 4 + h) * 2 + r; se[ub * 4096 + e] = (bf16)f2bf(s); s = cv[k] * s + dv[k]; } } }
    if (SUB(4)) for (int u = F.bid; u < 512; u += F.G) fft_unit(F, u);
    if (SUB(5)) for (int u = F.bid; u < 256; u += F.G) dft_ctx_unit(F, u);
    __syncthreads();
}
__device__ __forceinline__ void p_mix_c(Frame& F, CArgs& a, int L, int rep = 0) {
#ifndef MIXC_PARTS
#define MIXC_PARTS 7
#endif
    if ((MIXC_PARTS & 1) && SUB(6)) {
        pg8::Gemm g{(const bf16*)(F.ws + WS_A2), (const bf16*)(F.ws + WS_S5B2) + (size_t)L * 16 * 256 * 512, 1024, 1024, OPQ(512)};
        SgOrder<FillS5> S; S.init(144, 1, F.G, F.bid); S.f = FillS5{(size_t)256 * 512 * 2};
        EpiS5Y E{(bf16*)(F.ws + WS_ACT5)};
        pg8::gemm_phase(F.lds, g, S, E, fresh_tid(F.wave));
    }
    const int nch = (L == DEPTH - 1) ? 512 : NCHK;
    if ((MIXC_PARTS & 2) && SUB(7)) for (int u = F.bid; u < nch; u += F.G) gla_chunk<true>(F, a, L, u);
    if ((MIXC_PARTS & 4) && SUB(8)) for (int u = (F.bid + 32) % F.G; u < nch; u += F.G) ssd_chunk<true>(F, a, L, u);
    __syncthreads();
}

constexpr int NPH = 11, PH_TOTAL = 2 + DEPTH * NPH;
#ifndef PHASE_MASK
#define PHASE_MASK 0xFFFF
#endif
#define PM(i) ((PHASE_MASK >> (i)) & 1)
#ifndef DUP_MASK
#define DUP_MASK 0
#endif
#define NREP(k) (((DUP_MASK >> (k)) & 1) ? 2 : 1)
#ifndef MK_ONE_LAUNCH
#define MK_ONE_LAUNCH 0
#endif

__global__ void __launch_bounds__(NTHR, 2) mk_fwd(Args args_by_value) {
#define args (*fresh_args())
    extern __shared__ __attribute__((aligned(16))) unsigned char lds_raw[];
    Frame F;
    F.lds = (LAS unsigned char*)lds_raw; F.MISC = (volatile LAS unsigned*)(F.lds + MISC_OFF);
    F.tid = threadIdx.x; F.lane = F.tid & 63; F.wave = __builtin_amdgcn_readfirstlane(F.tid >> 6); F.G = gridDim.x; F.bid = blockIdx.x;
    F.ws = args_by_value.ws; F.ctl = (unsigned*)(args_by_value.ws + WS_CTL);
    if (F.tid < 64) F.MISC[F.tid] = 0u;
    __syncthreads();
#if MK_ONE_LAUNCH
    XcdBarrier bar = xcd_barrier_post(F.ctl + CW_BAR, F.MISC + 8);
#define GRID_BAR() xcd_barrier(bar)
#else
#define GRID_BAR() do { } while (0)
#endif
    const int lo = args_by_value.ph_lo, hi = args_by_value.ph_hi;
#define IN(k) (lo <= (k) && (k) < hi)
#define FRESH() do { const int t_ = fresh_tid(F.wave); F.tid = t_; F.lane = t_ & 63; } while (0)
#define SEAM(k) do { if (IN(k) && IN((k) + 1)) GRID_BAR(); } while (0)
    if (PM(0) && IN(0)) { FRESH(); p_prologue(F, args); }
#ifdef DUP_PROLOGUE
    GRID_BAR(); if (PM(0) && IN(0)) { FRESH(); p_prologue(F, args, CW_QUEUE + 64); }
#endif
    SEAM(0);
    {
        const int pb = 1 + 0 * NPH;
        const int mrows = (0 == DEPTH - 1) ? NLAT : NT;
        if (PM(1) && IN(pb + 0)) { FRESH(); p_norm1(F, args, OPQ(0)); }
#ifdef DUP_NORM1
        GRID_BAR(); if (PM(1) && IN(pb + 0)) { FRESH(); p_norm1(F, args, OPQ(0), true); }
#endif
 SEAM(pb + 0);
        if (PM(2) && IN(pb + 1)) for (int rep_ = 0; rep_ < NREP(2); ++rep_) { if (rep_) GRID_BAR(); const int Lg = OPQ(0);
            pg8::Gemm g{(const bf16*)(F.ws + WS_H), (const bf16*)(F.ws + WS_WIN) + (size_t)Lg * PW * DM, DM * 2, DM * 2, OPQ(DM)};
            SgOrder<FillPlain> S; S.init(NT / 256, PW / 256, F.G, F.bid); S.f = FillPlain{(size_t)256 * DM * 2, (size_t)256 * DM * 2};
            EpiInproj E{(bf16*)(F.ws + WS_PBUF), (bf16*)(F.ws + WS_A2)};
            pg8::gemm_phase(F.lds, g, S, E, fresh_tid(F.wave));
        }
#if defined(SHADOW_IN)
        if (PM(2) && IN(pb + 1)) { GRID_BAR(); const int Lg = OPQ(0);
            pg8::Gemm g{(const bf16*)(F.ws + WS_H), (const bf16*)(F.ws + WS_WIN) + (size_t)Lg * PW * DM, DM * 2, DM * 2, OPQ(DM)};
            SgOrder<FillPlain> S; S.init(NT / 256, PW / 256, F.G, F.bid); S.f = FillPlain{(size_t)256 * DM * 2, (size_t)256 * DM * 2};
            EpiNull E{(float*)(F.ws + WS_Y)};
            pg8::gemm_phase(F.lds, g, S, E, fresh_tid(F.wave));
        }
#endif
        SEAM(pb + 1);
        if (PM(3) && IN(pb + 2)) for (int rep_ = 0; rep_ < NREP(3); ++rep_) { if (rep_) GRID_BAR(); FRESH(); p_mix_a(F, args, OPQ(0), rep_); } SEAM(pb + 2);
        if (PM(4) && IN(pb + 3)) for (int rep_ = 0; rep_ < NREP(4); ++rep_) { if (rep_) GRID_BAR(); FRESH(); p_mix_b(F, args, OPQ(0), rep_); } SEAM(pb + 3);
        if (PM(5) && IN(pb + 4)) for (int rep_ = 0; rep_ < NREP(5); ++rep_) { if (rep_) GRID_BAR(); FRESH(); p_mix_c(F, args, OPQ(0), rep_); } SEAM(pb + 4);
        if (PM(6) && IN(pb + 5)) for (int rep_ = 0; rep_ < NREP(6); ++rep_) { if (rep_) GRID_BAR(); const int Lg = OPQ(0);
            pg8::Gemm g{(const bf16*)(F.ws + WS_ACT5), (const bf16*)(F.ws + WS_WGLU) + (size_t)Lg * 256 * 256, 512, 512, OPQ(256)};
            SgOrder<FillPlain> S; S.init(NT / 256, 1, F.G, F.bid); S.f = FillPlain{(size_t)256 * 256 * 2, 0};
            EpiGlu E{(const bf16*)(F.ws + WS_ACT5), (bf16*)(F.ws + WS_MIX)};
            pg8::gemm_phase(F.lds, g, S, E, fresh_tid(F.wave));
        } SEAM(pb + 5);
        if (PM(7) && IN(pb + 6)) { const int Lg = OPQ(0);
            pg8::Gemm g{(const bf16*)(F.ws + WS_MIX), (const bf16*)(F.ws + WS_WOUT) + (size_t)Lg * DM * MW, MW * 2, MW * 2, OPQ(MW)};
            SgOrder<FillPlain> S; S.init((Lg == DEPTH - 1 ? NLAT : NT) / 256, DM / 256, F.G, F.bid); S.f = FillPlain{(size_t)256 * MW * 2, (size_t)256 * MW * 2};
            EpiOutproj E{args.in[I_X], args.in[I_CTX], (bf16*)(F.ws + WS_XS), (const float*)(F.ws + WS_MOD) + (size_t)Lg * 9 * 6144, Lg == 0 ? 1 : 0};
            pg8::gemm_phase(F.lds, g, S, E, fresh_tid(F.wave));
        } SEAM(pb + 6);
        if (PM(8) && IN(pb + 7)) { FRESH(); p_norm2(F, args, OPQ(0), OPQ(mrows)); }
#ifdef DUP_NORM2
        GRID_BAR(); if (PM(8) && IN(pb + 7)) { FRESH(); p_norm2(F, args, OPQ(0), OPQ(mrows), 6400); }
#endif
 SEAM(pb + 7);
        if (PM(10) && IN(pb + 9)) { const int Lg = OPQ(0); FRESH();
            const int nblk = moe_tables(F, Lg);
            LAS int* lbs = (LAS int*)(F.lds + MOE_LB); LAS int* lcs = (LAS int*)(F.lds + MOE_LC); LAS unsigned* gat = (LAS unsigned*)(F.lds + MOE_GAT);
            SgOrder<FillMoe> S; S.init(nblk, 8, F.G, F.bid); S.f = FillMoe{(const LAS unsigned*)(F.lds + MOE_LBLK), 2048};
            { const int* TM = (const int*)(F.ws + WS_TM); const float* PG = (const float*)(F.ws + WS_PG); int* PS = (int*)(F.ws + WS_PS); float* SG = (float*)(F.ws + WS_SG);
              pg8::Unit u; int cursor = 0;
              for (int ui = 0; ui < MOE_MAXU && S.next(cursor, u); ++ui) {
                  if (F.tid < 256) { const int e = u.grp, rk = u.pm * 256 - lbs[e] + F.tid; const bool ok = rk < lcs[e];
                      const int id = ok ? TM[(size_t)e * NT + rk] : 0;
                      gat[ui * 256 + F.tid] = (unsigned)(id >> 2) * (unsigned)DM;
                      if (ok && u.pn == 0) { const int slot = u.pm * 256 + F.tid; PS[id] = slot; SG[slot] = PG[id]; } } } }
            __syncthreads();
            pg8::Gemm g{F.ws + WS_H8, F.ws + WS_WGU + (size_t)Lg * NEXP * 2048 * DM, DM, DM, OPQ(DM / 2)};
            EpiSwiglu E{(unsigned char*)(F.ws + WS_ACT), args.in[I_BGU] + (size_t)Lg * NEXP * 2048};
            pg8::gemm_phase<EpiSwiglu, SgOrder<FillMoe>, true, F8_ALIGN, F8_SP2, true>(F.lds, g, S, E, fresh_tid(F.wave), gat);
        } SEAM(pb + 9);
        if (PM(11) && IN(pb + 10)) for (int rep_ = 0; rep_ < NREP(11); ++rep_) { if (rep_) GRID_BAR(); const int Lg = OPQ(0); FRESH();
            const int nblk = moe_tables(F, Lg);
            pg8::Gemm g{F.ws + WS_ACT, F.ws + WS_WDN + (size_t)Lg * NEXP * DM * DM, DM, DM, OPQ(DM / 2)};
            SgOrder<FillMoe> S; S.init(nblk, 4, F.G, F.bid); S.f = FillMoe{(const LAS unsigned*)(F.lds + MOE_LBLK), 1024};
            EpiDown E{(bf16*)(F.ws + WS_Y), args.in[I_BDN] + (size_t)Lg * NEXP * DM, (const float*)(F.ws + WS_SG)};
            pg8::gemm_phase<EpiDown, SgOrder<FillMoe>, true, F8_ALIGN, F8_SP2>(F.lds, g, S, E, fresh_tid(F.wave));
        } SEAM(pb + 10);
        }
    {
        const int pb = 1 + 1 * NPH;
        const int mrows = (1 == DEPTH - 1) ? NLAT : NT;
        if (PM(1) && IN(pb + 0)) { FRESH(); p_norm1(F, args, OPQ(1)); }
#ifdef DUP_NORM1
        GRID_BAR(); if (PM(1) && IN(pb + 0)) { FRESH(); p_norm1(F, args, OPQ(1), true); }
#endif
 SEAM(pb + 0);
        if (PM(2) && IN(pb + 1)) for (int rep_ = 0; rep_ < NREP(2); ++rep_) { if (rep_) GRID_BAR(); const int Lg = OPQ(1);
            pg8::Gemm g{(const bf16*)(F.ws + WS_H), (const bf16*)(F.ws + WS_WIN) + (size_t)Lg * PW * DM, DM * 2, DM * 2, OPQ(DM)};
            SgOrder<FillPlain> S; S.init(NT / 256, PW / 256, F.G, F.bid); S.f = FillPlain{(size_t)256 * DM * 2, (size_t)256 * DM * 2};
            EpiInproj E{(bf16*)(F.ws + WS_PBUF), (bf16*)(F.ws + WS_A2)};
            pg8::gemm_phase(F.lds, g, S, E, fresh_tid(F.wave));
        }
#if defined(SHADOW_IN)
        if (PM(2) && IN(pb + 1)) { GRID_BAR(); const int Lg = OPQ(1);
            pg8::Gemm g{(const bf16*)(F.ws + WS_H), (const bf16*)(F.ws + WS_WIN) + (size_t)Lg * PW * DM, DM * 2, DM * 2, OPQ(DM)};
            SgOrder<FillPlain> S; S.init(NT / 256, PW / 256, F.G, F.bid); S.f = FillPlain{(size_t)256 * DM * 2, (size_t)256 * DM * 2};
            EpiNull E{(float*)(F.ws + WS_Y)};
            pg8::gemm_phase(F.lds, g, S, E, fresh_tid(F.wave));
        }
#endif
        SEAM(pb + 1);
        if (PM(3) && IN(pb + 2)) for (int rep_ = 0; rep_ < NREP(3); ++rep_) { if (rep_) GRID_BAR(); FRESH(); p_mix_a(F, args, OPQ(1), rep_); } SEAM(pb + 2);
        if (PM(4) && IN(pb + 3)) for (int rep_ = 0; rep_ < NREP(4); ++rep_) { if (rep_) GRID_BAR(); FRESH(); p_mix_b(F, args, OPQ(1), rep_); } SEAM(pb + 3);
        if (PM(5) && IN(pb + 4)) for (int rep_ = 0; rep_ < NREP(5); ++rep_) { if (rep_) GRID_BAR(); FRESH(); p_mix_c(F, args, OPQ(1), rep_); } SEAM(pb + 4);
        if (PM(6) && IN(pb + 5)) for (int rep_ = 0; rep_ < NREP(6); ++rep_) { if (rep_) GRID_BAR(); const int Lg = OPQ(1);
            pg8::Gemm g{(const bf16*)(F.ws + WS_ACT5), (const bf16*)(F.ws + WS_WGLU) + (size_t)Lg * 256 * 256, 512, 512, OPQ(256)};
            SgOrder<FillPlain> S; S.init(NT / 256, 1, F.G, F.bid); S.f = FillPlain{(size_t)256 * 256 * 2, 0};
            EpiGlu E{(const bf16*)(F.ws + WS_ACT5), (bf16*)(F.ws + WS_MIX)};
            pg8::gemm_phase(F.lds, g, S, E, fresh_tid(F.wave));
        } SEAM(pb + 5);
        if (PM(7) && IN(pb + 6)) { const int Lg = OPQ(1);
            pg8::Gemm g{(const bf16*)(F.ws + WS_MIX), (const bf16*)(F.ws + WS_WOUT) + (size_t)Lg * DM * MW, MW * 2, MW * 2, OPQ(MW)};
            SgOrder<FillPlain> S; S.init((Lg == DEPTH - 1 ? NLAT : NT) / 256, DM / 256, F.G, F.bid); S.f = FillPlain{(size_t)256 * MW * 2, (size_t)256 * MW * 2};
            EpiOutproj E{args.in[I_X], args.in[I_CTX], (bf16*)(F.ws + WS_XS), (const float*)(F.ws + WS_MOD) + (size_t)Lg * 9 * 6144, Lg == 0 ? 1 : 0};
            pg8::gemm_phase(F.lds, g, S, E, fresh_tid(F.wave));
        } SEAM(pb + 6);
        if (PM(8) && IN(pb + 7)) { FRESH(); p_norm2(F, args, OPQ(1), OPQ(mrows)); }
#ifdef DUP_NORM2
        GRID_BAR(); if (PM(8) && IN(pb + 7)) { FRESH(); p_norm2(F, args, OPQ(1), OPQ(mrows), 6400); }
#endif
 SEAM(pb + 7);
        if (PM(10) && IN(pb + 9)) { const int Lg = OPQ(1); FRESH();
            const int nblk = moe_tables(F, Lg);
            LAS int* lbs = (LAS int*)(F.lds + MOE_LB); LAS int* lcs = (LAS int*)(F.lds + MOE_LC); LAS unsigned* gat = (LAS unsigned*)(F.lds + MOE_GAT);
            SgOrder<FillMoe> S; S.init(nblk, 8, F.G, F.bid); S.f = FillMoe{(const LAS unsigned*)(F.lds + MOE_LBLK), 2048};
            { const int* TM = (const int*)(F.ws + WS_TM); const float* PG = (const float*)(F.ws + WS_PG); int* PS = (int*)(F.ws + WS_PS); float* SG = (float*)(F.ws + WS_SG);
              pg8::Unit u; int cursor = 0;
              for (int ui = 0; ui < MOE_MAXU && S.next(cursor, u); ++ui) {
                  if (F.tid < 256) { const int e = u.grp, rk = u.pm * 256 - lbs[e] + F.tid; const bool ok = rk < lcs[e];
                      const int id = ok ? TM[(size_t)e * NT + rk] : 0;
                      gat[ui * 256 + F.tid] = (unsigned)(id >> 2) * (unsigned)DM;
                      if (ok && u.pn == 0) { const int slot = u.pm * 256 + F.tid; PS[id] = slot; SG[slot] = PG[id]; } } } }
            __syncthreads();
            pg8::Gemm g{F.ws + WS_H8, F.ws + WS_WGU + (size_t)Lg * NEXP * 2048 * DM, DM, DM, OPQ(DM / 2)};
            EpiSwiglu E{(unsigned char*)(F.ws + WS_ACT), args.in[I_BGU] + (size_t)Lg * NEXP * 2048};
            pg8::gemm_phase<EpiSwiglu, SgOrder<FillMoe>, true, F8_ALIGN, F8_SP2, true>(F.lds, g, S, E, fresh_tid(F.wave), gat);
        } SEAM(pb + 9);
        if (PM(11) && IN(pb + 10)) for (int rep_ = 0; rep_ < NREP(11); ++rep_) { if (rep_) GRID_BAR(); const int Lg = OPQ(1); FRESH();
            const int nblk = moe_tables(F, Lg);
            pg8::Gemm g{F.ws + WS_ACT, F.ws + WS_WDN + (size_t)Lg * NEXP * DM * DM, DM, DM, OPQ(DM / 2)};
            SgOrder<FillMoe> S; S.init(nblk, 4, F.G, F.bid); S.f = FillMoe{(const LAS unsigned*)(F.lds + MOE_LBLK), 1024};
            EpiDown E{(bf16*)(F.ws + WS_Y), args.in[I_BDN] + (size_t)Lg * NEXP * DM, (const float*)(F.ws + WS_SG)};
            pg8::gemm_phase<EpiDown, SgOrder<FillMoe>, true, F8_ALIGN, F8_SP2>(F.lds, g, S, E, fresh_tid(F.wave));
        } SEAM(pb + 10);
        }
    {
        const int pb = 1 + 2 * NPH;
        const int mrows = (2 == DEPTH - 1) ? NLAT : NT;
        if (PM(1) && IN(pb + 0)) { FRESH(); p_norm1(F, args, OPQ(2)); }
#ifdef DUP_NORM1
        GRID_BAR(); if (PM(1) && IN(pb + 0)) { FRESH(); p_norm1(F, args, OPQ(2), true); }
#endif
 SEAM(pb + 0);
        if (PM(2) && IN(pb + 1)) for (int rep_ = 0; rep_ < NREP(2); ++rep_) { if (rep_) GRID_BAR(); const int Lg = OPQ(2);
            pg8::Gemm g{(const bf16*)(F.ws + WS_H), (const bf16*)(F.ws + WS_WIN) + (size_t)Lg * PW * DM, DM * 2, DM * 2, OPQ(DM)};
            SgOrder<FillPlain> S; S.init(NT / 256, PW / 256, F.G, F.bid); S.f = FillPlain{(size_t)256 * DM * 2, (size_t)256 * DM * 2};
            EpiInproj E{(bf16*)(F.ws + WS_PBUF), (bf16*)(F.ws + WS_A2)};
            pg8::gemm_phase(F.lds, g, S, E, fresh_tid(F.wave));
        }
#if defined(SHADOW_IN)
        if (PM(2) && IN(pb + 1)) { GRID_BAR(); const int Lg = OPQ(2);
            pg8::Gemm g{(const bf16*)(F.ws + WS_H), (const bf16*)(F.ws + WS_WIN) + (size_t)Lg * PW * DM, DM * 2, DM * 2, OPQ(DM)};
            SgOrder<FillPlain> S; S.init(NT / 256, PW / 256, F.G, F.bid); S.f = FillPlain{(size_t)256 * DM * 2, (size_t)256 * DM * 2};
            EpiNull E{(float*)(F.ws + WS_Y)};
            pg8::gemm_phase(F.lds, g, S, E, fresh_tid(F.wave));
        }
#endif
        SEAM(pb + 1);
        if (PM(3) && IN(pb + 2)) for (int rep_ = 0; rep_ < NREP(3); ++rep_) { if (rep_) GRID_BAR(); FRESH(); p_mix_a(F, args, OPQ(2), rep_); } SEAM(pb + 2);
        if (PM(4) && IN(pb + 3)) for (int rep_ = 0; rep_ < NREP(4); ++rep_) { if (rep_) GRID_BAR(); FRESH(); p_mix_b(F, args, OPQ(2), rep_); } SEAM(pb + 3);
        if (PM(5) && IN(pb + 4)) for (int rep_ = 0; rep_ < NREP(5); ++rep_) { if (rep_) GRID_BAR(); FRESH(); p_mix_c(F, args, OPQ(2), rep_); } SEAM(pb + 4);
        if (PM(6) && IN(pb + 5)) for (int rep_ = 0; rep_ < NREP(6); ++rep_) { if (rep_) GRID_BAR(); const int Lg = OPQ(2);
            pg8::Gemm g{(const bf16*)(F.ws + WS_ACT5), (const bf16*)(F.ws + WS_WGLU) + (size_t)Lg * 256 * 256, 512, 512, OPQ(256)};
            SgOrder<FillPlain> S; S.init(NT / 256, 1, F.G, F.bid); S.f = FillPlain{(size_t)256 * 256 * 2, 0};
            EpiGlu E{(const bf16*)(F.ws + WS_ACT5), (bf16*)(F.ws + WS_MIX)};
            pg8::gemm_phase(F.lds, g, S, E, fresh_tid(F.wave));
        } SEAM(pb + 5);
        if (PM(7) && IN(pb + 6)) { const int Lg = OPQ(2);
            pg8::Gemm g{(const bf16*)(F.ws + WS_MIX), (const bf16*)(F.ws + WS_WOUT) + (size_t)Lg * DM * MW, MW * 2, MW * 2, OPQ(MW)};
            SgOrder<FillPlain> S; S.init((Lg == DEPTH - 1 ? NLAT : NT) / 256, DM / 256, F.G, F.bid); S.f = FillPlain{(size_t)256 * MW * 2, (size_t)256 * MW * 2};
            EpiOutproj E{args.in[I_X], args.in[I_CTX], (bf16*)(F.ws + WS_XS), (const float*)(F.ws + WS_MOD) + (size_t)Lg * 9 * 6144, Lg == 0 ? 1 : 0};
            pg8::gemm_phase(F.lds, g, S, E, fresh_tid(F.wave));
        } SEAM(pb + 6);
        if (PM(8) && IN(pb + 7)) { FRESH(); p_norm2(F, args, OPQ(2), OPQ(mrows)); }
#ifdef DUP_NORM2
        GRID_BAR(); if (PM(8) && IN(pb + 7)) { FRESH(); p_norm2(F, args, OPQ(2), OPQ(mrows), 6400); }
#endif
 SEAM(pb + 7);
        if (PM(10) && IN(pb + 9)) { const int Lg = OPQ(2); FRESH();
            const int nblk = moe_tables(F, Lg);
            LAS int* lbs = (LAS int*)(F.lds + MOE_LB); LAS int* lcs = (LAS int*)(F.lds + MOE_LC); LAS unsigned* gat = (LAS unsigned*)(F.lds + MOE_GAT);
            SgOrder<FillMoe> S; S.init(nblk, 8, F.G, F.bid); S.f = FillMoe{(const LAS unsigned*)(F.lds + MOE_LBLK), 2048};
            { const int* TM = (const int*)(F.ws + WS_TM); const float* PG = (const float*)(F.ws + WS_PG); int* PS = (int*)(F.ws + WS_PS); float* SG = (float*)(F.ws + WS_SG);
              pg8::Unit u; int cursor = 0;
              for (int ui = 0; ui < MOE_MAXU && S.next(cursor, u); ++ui) {
                  if (F.tid < 256) { const int e = u.grp, rk = u.pm * 256 - lbs[e] + F.tid; const bool ok = rk < lcs[e];
                      const int id = ok ? TM[(size_t)e * NT + rk] : 0;
                      gat[ui * 256 + F.tid] = (unsigned)(id >> 2) * (unsigned)DM;
                      if (ok && u.pn == 0) { const int slot = u.pm * 256 + F.tid; PS[id] = slot; SG[slot] = PG[id]; } } } }
            __syncthreads();
            pg8::Gemm g{F.ws + WS_H8, F.ws + WS_WGU + (size_t)Lg * NEXP * 2048 * DM, DM, DM, OPQ(DM / 2)};
            EpiSwiglu E{(unsigned char*)(F.ws + WS_ACT), args.in[I_BGU] + (size_t)Lg * NEXP * 2048};
            pg8::gemm_phase<EpiSwiglu, SgOrder<FillMoe>, true, F8_ALIGN, F8_SP2, true>(F.lds, g, S, E, fresh_tid(F.wave), gat);
        } SEAM(pb + 9);
        if (PM(11) && IN(pb + 10)) for (int rep_ = 0; rep_ < NREP(11); ++rep_) { if (rep_) GRID_BAR(); const int Lg = OPQ(2); FRESH();
            const int nblk = moe_tables(F, Lg);
            pg8::Gemm g{F.ws + WS_ACT, F.ws + WS_WDN + (size_t)Lg * NEXP * DM * DM, DM, DM, OPQ(DM / 2)};
            SgOrder<FillMoe> S; S.init(nblk, 4, F.G, F.bid); S.f = FillMoe{(const LAS unsigned*)(F.lds + MOE_LBLK), 1024};
            EpiDown E{(bf16*)(F.ws + WS_Y), args.in[I_BDN] + (size_t)Lg * NEXP * DM, (const float*)(F.ws + WS_SG)};
            pg8::gemm_phase<EpiDown, SgOrder<FillMoe>, true, F8_ALIGN, F8_SP2>(F.lds, g, S, E, fresh_tid(F.wave));
        } SEAM(pb + 10);
        }
    {
        const int pb = 1 + 3 * NPH;
        const int mrows = (3 == DEPTH - 1) ? NLAT : NT;
        if (PM(1) && IN(pb + 0)) { FRESH(); p_norm1(F, args, OPQ(3)); }
#ifdef DUP_NORM1
        GRID_BAR(); if (PM(1) && IN(pb + 0)) { FRESH(); p_norm1(F, args, OPQ(3), true); }
#endif
 SEAM(pb + 0);
        if (PM(2) && IN(pb + 1)) for (int rep_ = 0; rep_ < NREP(2); ++rep_) { if (rep_) GRID_BAR(); const int Lg = OPQ(3);
            pg8::Gemm g{(const bf16*)(F.ws + WS_H), (const bf16*)(F.ws + WS_WIN) + (size_t)Lg * PW * DM, DM * 2, DM * 2, OPQ(DM)};
            SgOrder<FillPlain> S; S.init(NT / 256, PW / 256, F.G, F.bid); S.f = FillPlain{(size_t)256 * DM * 2, (size_t)256 * DM * 2};
            EpiInproj E{(bf16*)(F.ws + WS_PBUF), (bf16*)(F.ws + WS_A2)};
            pg8::gemm_phase(F.lds, g, S, E, fresh_tid(F.wave));
        }
#if defined(SHADOW_IN)
        if (PM(2) && IN(pb + 1)) { GRID_BAR(); const int Lg = OPQ(3);
            pg8::Gemm g{(const bf16*)(F.ws + WS_H), (const bf16*)(F.ws + WS_WIN) + (size_t)Lg * PW * DM, DM * 2, DM * 2, OPQ(DM)};
            SgOrder<FillPlain> S; S.init(NT / 256, PW / 256, F.G, F.bid); S.f = FillPlain{(size_t)256 * DM * 2, (size_t)256 * DM * 2};
            EpiNull E{(float*)(F.ws + WS_Y)};
            pg8::gemm_phase(F.lds, g, S, E, fresh_tid(F.wave));
        }
#endif
        SEAM(pb + 1);
        if (PM(3) && IN(pb + 2)) for (int rep_ = 0; rep_ < NREP(3); ++rep_) { if (rep_) GRID_BAR(); FRESH(); p_mix_a(F, args, OPQ(3), rep_); } SEAM(pb + 2);
        if (PM(4) && IN(pb + 3)) for (int rep_ = 0; rep_ < NREP(4); ++rep_) { if (rep_) GRID_BAR(); FRESH(); p_mix_b(F, args, OPQ(3), rep_); } SEAM(pb + 3);
        if (PM(5) && IN(pb + 4)) for (int rep_ = 0; rep_ < NREP(5); ++rep_) { if (rep_) GRID_BAR(); FRESH(); p_mix_c(F, args, OPQ(3), rep_); } SEAM(pb + 4);
        if (PM(6) && IN(pb + 5)) for (int rep_ = 0; rep_ < NREP(6); ++rep_) { if (rep_) GRID_BAR(); const int Lg = OPQ(3);
            pg8::Gemm g{(const bf16*)(F.ws + WS_ACT5), (const bf16*)(F.ws + WS_WGLU) + (size_t)Lg * 256 * 256, 512, 512, OPQ(256)};
            SgOrder<FillPlain> S; S.init(NT / 256, 1, F.G, F.bid); S.f = FillPlain{(size_t)256 * 256 * 2, 0};
            EpiGlu E{(const bf16*)(F.ws + WS_ACT5), (bf16*)(F.ws + WS_MIX)};
            pg8::gemm_phase(F.lds, g, S, E, fresh_tid(F.wave));
        } SEAM(pb + 5);
        if (PM(7) && IN(pb + 6)) { const int Lg = OPQ(3);
            pg8::Gemm g{(const bf16*)(F.ws + WS_MIX), (const bf16*)(F.ws + WS_WOUT) + (size_t)Lg * DM * MW, MW * 2, MW * 2, OPQ(MW)};
            SgOrder<FillPlain> S; S.init((Lg == DEPTH - 1 ? NLAT : NT) / 256, DM / 256, F.G, F.bid); S.f = FillPlain{(size_t)256 * MW * 2, (size_t)256 * MW * 2};
            EpiOutproj E{args.in[I_X], args.in[I_CTX], (bf16*)(F.ws + WS_XS), (const float*)(F.ws + WS_MOD) + (size_t)Lg * 9 * 6144, Lg == 0 ? 1 : 0};
            pg8::gemm_phase(F.lds, g, S, E, fresh_tid(F.wave));
        } SEAM(pb + 6);
        if (PM(8) && IN(pb + 7)) { FRESH(); p_norm2(F, args, OPQ(3), OPQ(mrows)); }
#ifdef DUP_NORM2
        GRID_BAR(); if (PM(8) && IN(pb + 7)) { FRESH(); p_norm2(F, args, OPQ(3), OPQ(mrows), 6400); }
#endif
 SEAM(pb + 7);
        if (PM(10) && IN(pb + 9)) { const int Lg = OPQ(3); FRESH();
            const int nblk = moe_tables(F, Lg);
            LAS int* lbs = (LAS int*)(F.lds + MOE_LB); LAS int* lcs = (LAS int*)(F.lds + MOE_LC); LAS unsigned* gat = (LAS unsigned*)(F.lds + MOE_GAT);
            SgOrder<FillMoe> S; S.init(nblk, 8, F.G, F.bid); S.f = FillMoe{(const LAS unsigned*)(F.lds + MOE_LBLK), 2048};
            { const int* TM = (const int*)(F.ws + WS_TM); const float* PG = (const float*)(F.ws + WS_PG); int* PS = (int*)(F.ws + WS_PS); float* SG = (float*)(F.ws + WS_SG);
              pg8::Unit u; int cursor = 0;
              for (int ui = 0; ui < MOE_MAXU && S.next(cursor, u); ++ui) {
                  if (F.tid < 256) { const int e = u.grp, rk = u.pm * 256 - lbs[e] + F.tid; const bool ok = rk < lcs[e];
                      const int id = ok ? TM[(size_t)e * NT + rk] : 0;
                      gat[ui * 256 + F.tid] = (unsigned)(id >> 2) * (unsigned)DM;
                      if (ok && u.pn == 0) { const int slot = u.pm * 256 + F.tid; PS[id] = slot; SG[slot] = PG[id]; } } } }
            __syncthreads();
            pg8::Gemm g{F.ws + WS_H8, F.ws + WS_WGU + (size_t)Lg * NEXP * 2048 * DM, DM, DM, OPQ(DM / 2)};
            EpiSwiglu E{(unsigned char*)(F.ws + WS_ACT), args.in[I_BGU] + (size_t)Lg * NEXP * 2048};
            pg8::gemm_phase<EpiSwiglu, SgOrder<FillMoe>, true, F8_ALIGN, F8_SP2, true>(F.lds, g, S, E, fresh_tid(F.wave), gat);
        } SEAM(pb + 9);
        if (PM(11) && IN(pb + 10)) for (int rep_ = 0; rep_ < NREP(11); ++rep_) { if (rep_) GRID_BAR(); const int Lg = OPQ(3); FRESH();
            const int nblk = moe_tables(F, Lg);
            pg8::Gemm g{F.ws + WS_ACT, F.ws + WS_WDN + (size_t)Lg * NEXP * DM * DM, DM, DM, OPQ(DM / 2)};
            SgOrder<FillMoe> S; S.init(nblk, 4, F.G, F.bid); S.f = FillMoe{(const LAS unsigned*)(F.lds + MOE_LBLK), 1024};
            EpiDown E{(bf16*)(F.ws + WS_Y), args.in[I_BDN] + (size_t)Lg * NEXP * DM, (const float*)(F.ws + WS_SG)};
            pg8::gemm_phase<EpiDown, SgOrder<FillMoe>, true, F8_ALIGN, F8_SP2>(F.lds, g, S, E, fresh_tid(F.wave));
        } SEAM(pb + 10);
        }
    if (PM(12) && IN(PH_TOTAL - 1)) { FRESH(); p_final(F, args); }
#undef IN
#undef SEAM
#undef args
}

extern "C" void kernel_launch(void* const* d_in, const int* in_sizes, int n_in, void* d_out, int out_size, void* d_ws, size_t ws_size, hipStream_t stream) {
    static int grid = 0;
    if (grid == 0) {
        if (n_in != N_IN || out_size != NLAT * DM || ws_size < WS_END) { fprintf(stderr, "kernel_launch: unexpected shapes (n_in %d, out %d, ws %zu < %zu); nothing launched\n", n_in, out_size, ws_size, (size_t)WS_END); grid = -1; return; }
        int dev = 0, cus = 0, per_cu = 0;
        if (hipGetDevice(&dev) != hipSuccess || hipDeviceGetAttribute(&cus, hipDeviceAttributeMultiprocessorCount, dev) != hipSuccess) { grid = -1; return; }
        if (hipFuncSetAttribute((const void*)mk_fwd, hipFuncAttributeMaxDynamicSharedMemorySize, LDS_BYTES) != hipSuccess) { fprintf(stderr, "kernel_launch: hipFuncSetAttribute failed\n"); grid = -1; return; }
        if (hipOccupancyMaxActiveBlocksPerMultiprocessor(&per_cu, (const void*)mk_fwd, NTHR, LDS_BYTES) != hipSuccess || per_cu < 1) fprintf(stderr, "kernel_launch: occupancy query says %d\n", per_cu);
        (void)hipGetLastError();
        grid = cus;
    }
    if (grid < 0) return;
    (void)hipMemsetAsync((char*)d_ws + WS_CTL, 0, CTL_BYTES, stream);
    Args a{};
    for (int i = 0; i < N_IN; ++i) a.in[i] = (const float*)d_in[i];
    a.out = (float*)d_out; a.ws = (unsigned char*)d_ws;
#if MK_ONE_LAUNCH
    a.ph_lo = 0; a.ph_hi = PH_TOTAL;
    hipLaunchKernelGGL(mk_fwd, dim3(grid), dim3(NTHR), LDS_BYTES, stream, a);
#else
    for (int p = 0; p < PH_TOTAL; ++p) { a.ph_lo = p; a.ph_hi = p + 1; hipLaunchKernelGGL(mk_fwd, dim3(grid), dim3(NTHR), LDS_BYTES, stream, a); }
#endif
}
```

```cpp
#define MK_ONE_LAUNCH 1
#define F8_ALIGN true
#define F8_SP2 true
#include <hip/hip_runtime.h>
#include <cstdio>
#include <cstdint>

#define GAS __attribute__((address_space(1)))
#define LAS __attribute__((address_space(3)))
typedef unsigned short bf16;
typedef short bf16x8 __attribute__((ext_vector_type(8)));
typedef short s16x4 __attribute__((ext_vector_type(4)));
typedef float f32x4 __attribute__((ext_vector_type(4)));
typedef float f32x2 __attribute__((ext_vector_type(2)));
typedef unsigned u32x4 __attribute__((ext_vector_type(4)));
typedef unsigned u32x2 __attribute__((ext_vector_type(2)));

namespace pg8 {
#define PG8_LAS __attribute__((address_space(3)))
typedef unsigned short bf16_t;
constexpr int BM = 256, BK = 64, HALF = 128, HTB = HALF * BK * 2  , STAGE_BYTES = 8 * HTB;

__host__ __device__ __forceinline__ int lds_byte(int r, int c) { const int st = (r >> 4) * 2 + (c >> 5), rr = r & 15, cc = c & 31, ob = rr * 64 + cc * 2; return st * 1024 + (ob ^ (((ob >> 9) & 1) << 5)); }
__host__ __device__ __forceinline__ void stage_rc(int b, int& R, int& C) { const int st = b / 1024, sb = b % 1024, swz = sb ^ (((sb >> 9) & 1) << 5); R = (st >> 1) * 16 + swz / 64; C = (st & 1) * 32 + (swz % 64) / 2; }
__host__ __device__ __forceinline__ int lds_byte_f8(int r, int c) { const int st = (r >> 4) * 2 + (c >> 5), rr = r & 15, cc = c & 31, ob = rr * 64 + cc * 2; return st * 1024 + (ob ^ (((ob >> 9) & 1) << 4)); }
__host__ __device__ __forceinline__ void stage_rc_f8(int b, int& R, int& C) { const int st = b / 1024, sb = b % 1024, swz = sb ^ (((sb >> 9) & 1) << 4); R = (st >> 1) * 16 + swz / 64; C = (st & 1) * 32 + (swz % 64) / 2; }
__host__ __device__ __forceinline__ int perm32(int rho) { const int n = rho >> 4, i = rho & 15; return 8 * (i >> 2) + 4 * n + (i & 3); }

struct Unit { int pm, pn, grp; size_t aoff, boff; };
struct Gemm { const void* A; const void* Bt; int lda, ldb, K; };

__device__ __forceinline__ unsigned cvt_pk_bf16(float lo, float hi) { unsigned r; asm volatile("v_cvt_pk_bf16_f32 %0, %1, %2" : "=v"(r) : "v"(lo), "v"(hi)); return r; }

typedef int v8i_t __attribute__((ext_vector_type(8)));
typedef int v4i_t __attribute__((ext_vector_type(4)));
template <class Epi, class Sched, bool F8 = false, bool ALIGN_EPI = true, bool SP2 = true, bool GATHER = false>
__device__ __forceinline__ void gemm_phase(PG8_LAS unsigned char* lds, const Gemm g, const Sched& S, const Epi& E, int tid_in, const PG8_LAS unsigned* gat = nullptr) {
    static_assert(!GATHER || SP2, "gather is written for the SP2 loop");
    int tid = tid_in; asm volatile("" : "+v"(tid));
    const int wid = __builtin_amdgcn_readfirstlane(tid >> 6), lane = tid & 63, wr = wid >> 2, wc = wid & 3, fr = lane & 15, fq = lane >> 4;
    const int K = g.K, nt = K / BK;
    unsigned voffA[2], voffB[2];
#pragma unroll
    for (int i = 0; i < 2; ++i) { int R, C; if constexpr (F8) stage_rc_f8(tid * 16 + i * 8192, R, C); else stage_rc(tid * 16 + i * 8192, R, C); const int Rb = Epi::PERM ? ((R & ~31) + perm32(R & 31)) : R;
        voffA[i] = GATHER ? (unsigned)(R * 65536 + C * 2) : (unsigned)(R * g.lda + C * 2); voffB[i] = (unsigned)(Rb * g.ldb + C * 2); }
    unsigned vA0[2], vA1[2];
    const size_t kstep = (size_t)(BK * 2);
    const size_t hstepA = (size_t)HALF * g.lda, hstepB = (size_t)HALF * g.ldb;
#define PG8_GLOAD(ui_) do { _Pragma("unroll") for (int _i = 0; _i < 2; ++_i) { const int r_ = (int)(voffA[_i] >> 16); const unsigned c_ = voffA[_i] & 0xffffu; \
        vA0[_i] = gat[(ui_) * 256 + r_] + c_; vA1[_i] = gat[(ui_) * 256 + 128 + r_] + c_; } } while (0)
    if constexpr (GATHER) PG8_GLOAD(0); else { vA0[0] = voffA[0]; vA0[1] = voffA[1]; vA1[0] = voffA[0] + (unsigned)hstepA; vA1[1] = voffA[1] + (unsigned)hstepA; }
    int ui = 0;
    const unsigned ldsw = (unsigned)wid * 1024u;
    const int aoff = F8 ? lds_byte_f8(wr * 64 + fr, fq * 16) : lds_byte(wr * 64 + fr, fq * 8), boff = F8 ? lds_byte_f8(wc * 32 + fr, fq * 16) : lds_byte(wc * 32 + fr, fq * 8);
    const int aoff1 = lds_byte_f8(wr * 64 + fr, fq * 16 + 8), boff1 = lds_byte_f8(wc * 32 + fr, fq * 16 + 8);
#define PG8_SA(b, h) (((b) * 2 + (h)) * HTB)
#define PG8_SB(b, h) ((4 + (b) * 2 + (h)) * HTB)
#define PG8_STAGE(bufoff, gbase, voff) do { _Pragma("unroll") for (int _i = 0; _i < 2; ++_i) \
        __builtin_amdgcn_global_load_lds((const unsigned*)((const char*)(gbase) + (voff)[_i]), (PG8_LAS unsigned*)(lds + (bufoff) + ldsw + _i * 8192), 16, 0, 0); } while (0)
#define PG8_LD16(off) (*(const PG8_LAS v4i_t*)(lds + (off)))
#define PG8_LDA(dst, b, h) do { if constexpr (F8) { _Pragma("unroll") for (int m = 0; m < 4; ++m) A8[m] = __builtin_shufflevector(PG8_LD16(PG8_SA(b, h) + aoff + m * 2048), PG8_LD16(PG8_SA(b, h) + aoff1 + m * 2048), 0, 1, 2, 3, 4, 5, 6, 7); } \
        else { _Pragma("unroll") for (int m = 0; m < 4; ++m) _Pragma("unroll") for (int k = 0; k < 2; ++k) dst[m][k] = *(const PG8_LAS bf16x8*)(lds + PG8_SA(b, h) + aoff + m * 2048 + k * 1024); } } while (0)
#define PG8_LDB(dst, b, h) do { if constexpr (F8) { _Pragma("unroll") for (int n = 0; n < 2; ++n) dst##8[n] = __builtin_shufflevector(PG8_LD16(PG8_SB(b, h) + boff + n * 2048), PG8_LD16(PG8_SB(b, h) + boff1 + n * 2048), 0, 1, 2, 3, 4, 5, 6, 7); } \
        else { _Pragma("unroll") for (int n = 0; n < 2; ++n) _Pragma("unroll") for (int k = 0; k < 2; ++k) dst[n][k] = *(const PG8_LAS bf16x8*)(lds + PG8_SB(b, h) + boff + n * 2048 + k * 1024); } } while (0)
#define PG8_MMA(ai, bj, At, Bt) do { __builtin_amdgcn_s_setprio(1); \
        if constexpr (F8) { _Pragma("unroll") for (int m = 0; m < 4; ++m) _Pragma("unroll") for (int n = 0; n < 2; ++n) \
            asm volatile("v_mfma_scale_f32_16x16x128_f8f6f4 %0, %1, %2, %0, %3, %3 op_sel_hi:[0,0,0]" : "+v"(acc[ai][bj][m][n]) : "v"(Bt##8[n]), "v"(A8[m]), "v"(one_scale)); } \
        else { _Pragma("unroll") for (int m = 0; m < 4; ++m) _Pragma("unroll") for (int n = 0; n < 2; ++n) _Pragma("unroll") for (int k = 0; k < 2; ++k) \
            acc[ai][bj][m][n] = __builtin_amdgcn_mfma_f32_16x16x32_bf16(Bt[n][k], At[m][k], acc[ai][bj][m][n], 0, 0, 0); } \
        __builtin_amdgcn_s_setprio(0); } while (0)
#define PG8_WAIT_V(n) asm volatile("s_waitcnt vmcnt(" #n ")" ::: "memory")
#define PG8_WAIT_L(n) asm volatile("s_waitcnt lgkmcnt(" #n ")" ::: "memory")
#define PG8_BAR __builtin_amdgcn_s_barrier()
#define PG8_SCHED __builtin_amdgcn_sched_barrier(0)
    Unit cur, nxt; int cursor = 0;
    if (!S.next(cursor, cur)) return;
    f32x4 acc[2][2][4][2];
#pragma unroll
    for (int a = 0; a < 2; ++a)
#pragma unroll
        for (int b = 0; b < 2; ++b)
#pragma unroll
            for (int m = 0; m < 4; ++m)
#pragma unroll
                for (int n = 0; n < 2; ++n) acc[a][b][m][n] = (f32x4){0.f, 0.f, 0.f, 0.f};
    bf16x8 At[4][2], B0[2][2], B1[2][2];
    v8i_t A8[4], B08[2], B18[2];
    int one_scale = 0x7F7F7F7F; asm volatile("" : "+v"(one_scale));
    const char* cA = (const char*)g.A + (GATHER ? (size_t)0 : cur.aoff); const char* cB = (const char*)g.Bt + cur.boff;
    if constexpr (SP2) {
        PG8_STAGE(PG8_SB(0, 0), cB, voffB); PG8_STAGE(PG8_SB(0, 1), cB + hstepB, voffB); PG8_STAGE(PG8_SA(0, 0), cA, vA0); PG8_STAGE(PG8_SA(0, 1), cA, vA1);
        if (wr == 1) PG8_BAR;
        PG8_WAIT_V(2); PG8_BAR;
        PG8_STAGE(PG8_SB(1, 0), cB + kstep, voffB); PG8_STAGE(PG8_SA(1, 0), cA + kstep, vA0); PG8_STAGE(PG8_SB(1, 1), cB + hstepB + kstep, voffB);
        PG8_WAIT_V(6); PG8_BAR;
    } else {
        PG8_STAGE(PG8_SB(0, 0), cB, voffB); PG8_STAGE(PG8_SA(0, 0), cA, voffA); PG8_STAGE(PG8_SB(0, 1), cB + hstepB, voffB); PG8_STAGE(PG8_SA(0, 1), cA + hstepA, voffA);
        if (wr == 1) PG8_BAR;
        PG8_WAIT_V(4); PG8_BAR;
        PG8_STAGE(PG8_SB(1, 0), cB + kstep, voffB); PG8_STAGE(PG8_SA(1, 0), cA + kstep, vA0); PG8_STAGE(PG8_SB(1, 1), cB + hstepB + kstep, voffB);
        PG8_WAIT_V(6); PG8_BAR;
    }
    for (;;) {
        const bool has_next = S.next(cursor, nxt);
        const char* nA = (has_next && !GATHER) ? (const char*)g.A + nxt.aoff : cA; const char* nB = has_next ? (const char*)g.Bt + nxt.boff : cB;
        for (int t = 0; t < nt; t += 2) {
            const bool last = (t == nt - 2);
            const char* a1 = cA + (size_t)(t + 1) * kstep;
            const char* a2 = last ? nA : cA + (size_t)(t + 2) * kstep; const char* b2 = last ? nB : cB + (size_t)(t + 2) * kstep;
            const char* a3 = a2 + kstep; const char* b3 = b2 + kstep;
            if constexpr (SP2) {
            PG8_LDB(B0, 0, 0); PG8_LDB(B1, 0, 1); PG8_SCHED; PG8_LDA(At, 0, 0); PG8_STAGE(PG8_SA(1, 1), a1, vA1);
            if constexpr (GATHER) { if (last && has_next) PG8_GLOAD(ui + 1); }
            PG8_WAIT_V(8); PG8_WAIT_L(0); PG8_BAR; PG8_MMA(0, 0, At, B0); PG8_MMA(0, 1, At, B1); PG8_BAR; PG8_SCHED;
            PG8_LDA(At, 0, 1); PG8_STAGE(PG8_SB(0, 0), b2, voffB); PG8_STAGE(PG8_SB(0, 1), b2 + hstepB, voffB); PG8_STAGE(PG8_SA(0, 0), a2, vA0);
            PG8_WAIT_V(8); PG8_WAIT_L(0); PG8_BAR; PG8_MMA(1, 0, At, B0); PG8_MMA(1, 1, At, B1); PG8_BAR; PG8_SCHED;
            PG8_LDB(B0, 1, 0); PG8_LDB(B1, 1, 1); PG8_SCHED; PG8_LDA(At, 1, 0); PG8_STAGE(PG8_SA(0, 1), a2, vA1);
            PG8_WAIT_V(8); PG8_WAIT_L(0); PG8_BAR; PG8_MMA(0, 0, At, B0); PG8_MMA(0, 1, At, B1); PG8_BAR; PG8_SCHED;
            PG8_LDA(At, 1, 1); PG8_STAGE(PG8_SB(1, 0), b3, voffB); PG8_STAGE(PG8_SB(1, 1), b3 + hstepB, voffB); PG8_STAGE(PG8_SA(1, 0), a3, vA0);
            PG8_WAIT_V(8); PG8_WAIT_L(0); PG8_BAR; PG8_MMA(1, 0, At, B0); PG8_MMA(1, 1, At, B1); PG8_BAR; PG8_SCHED;
            } else {
            PG8_LDB(B0, 0, 0); PG8_SCHED; PG8_LDA(At, 0, 0); PG8_STAGE(PG8_SA(1, 1), a1, vA1);
            PG8_WAIT_L(8); PG8_BAR; PG8_WAIT_L(0); PG8_MMA(0, 0, At, B0); PG8_BAR; PG8_SCHED;
            PG8_LDB(B1, 0, 1); PG8_STAGE(PG8_SB(0, 0), b2, voffB);
            PG8_BAR; PG8_WAIT_L(0); PG8_MMA(0, 1, At, B1); PG8_BAR;
            PG8_LDA(At, 0, 1); PG8_STAGE(PG8_SA(0, 0), a2, vA0);
            PG8_BAR; PG8_WAIT_L(0); PG8_MMA(1, 0, At, B0); PG8_BAR; PG8_SCHED;
            PG8_STAGE(PG8_SB(0, 1), b2 + hstepB, voffB);
            PG8_WAIT_V(6); PG8_BAR; PG8_MMA(1, 1, At, B1); PG8_BAR;
            PG8_LDB(B0, 1, 0); PG8_SCHED; PG8_LDA(At, 1, 0); PG8_STAGE(PG8_SA(0, 1), a2, vA1);
            PG8_WAIT_L(8); PG8_BAR; PG8_WAIT_L(0); PG8_MMA(0, 0, At, B0); PG8_BAR; PG8_SCHED;
            PG8_LDB(B1, 1, 1); PG8_STAGE(PG8_SB(1, 0), b3, voffB);
            PG8_BAR; PG8_WAIT_L(0); PG8_MMA(0, 1, At, B1); PG8_BAR;
            PG8_LDA(At, 1, 1); PG8_STAGE(PG8_SA(1, 0), a3, vA0);
            PG8_BAR; PG8_WAIT_L(0); PG8_MMA(1, 0, At, B0); PG8_BAR; PG8_SCHED;
            PG8_STAGE(PG8_SB(1, 1), b3 + hstepB, voffB);
            PG8_WAIT_V(6); PG8_BAR; PG8_MMA(1, 1, At, B1); PG8_BAR;
            }
        }
        if constexpr (F8) asm volatile("s_nop 15\n\ts_nop 15" ::: "memory");
        if constexpr (ALIGN_EPI) { if (wr == 0) PG8_BAR; }
        E(acc, cur, wr, wc, fr, fq);
        if (!has_next) break;
#pragma unroll
        for (int a = 0; a < 2; ++a)
#pragma unroll
            for (int b = 0; b < 2; ++b)
#pragma unroll
                for (int m = 0; m < 4; ++m)
#pragma unroll
                    for (int n = 0; n < 2; ++n) acc[a][b][m][n] = (f32x4){0.f, 0.f, 0.f, 0.f};
        cur = nxt; cA = nA; cB = nB; ++ui;
        if constexpr (ALIGN_EPI) { if (wr == 1) PG8_BAR; }
    }
    PG8_WAIT_V(0);
    if constexpr (!ALIGN_EPI) { if (wr == 0) PG8_BAR; }
    PG8_BAR;
#undef PG8_GLOAD
#undef PG8_SA
#undef PG8_SB
#undef PG8_STAGE
#undef PG8_LDA
#undef PG8_LDB
#undef PG8_MMA
#undef PG8_LD16
#undef PG8_WAIT_V
#undef PG8_WAIT_L
#undef PG8_BAR
#undef PG8_SCHED
}
}

#define XB_TMO      128
#define XB_XCNT(j)  (256  + 64 * (j))
#define XB_XSUB(j)  (1280 + 64 * (j))
#define XB_XGEN(j)  (2304 + 64 * (j))
#define XB_TOP      3328
#define XB_TOPGEN   3392
#define XCD_BAR_WORDS 3456
#define XB_SPIN_CAP (1u << 18)

__device__ __forceinline__ unsigned xb_ld(unsigned* p)              { return __hip_atomic_load(p, __ATOMIC_RELAXED, __HIP_MEMORY_SCOPE_AGENT); }
__device__ __forceinline__ unsigned xb_add(unsigned* p, unsigned v) { return __hip_atomic_fetch_add(p, v, __ATOMIC_RELAXED, __HIP_MEMORY_SCOPE_AGENT); }
__device__ __forceinline__ unsigned xb_xcc_id() { return (unsigned)__builtin_amdgcn_s_getreg((3 << 11) | 20) & 0xFu; }
#define XB_SPIN(cond, bar) do { unsigned _sp = 0; while (cond) { __builtin_amdgcn_s_sleep(1); \
    if ((++_sp & 255u) == 0u) { if (xb_ld(&(bar)[XB_TMO])) break; if (_sp > XB_SPIN_CAP) { atomicAdd(&(bar)[XB_TMO], 1u); break; } } } } while (0)

struct XcdBarrier {
    unsigned* bar; unsigned x;
    volatile LAS unsigned* st;
};

__device__ __forceinline__ XcdBarrier xcd_barrier_post(unsigned* bar, volatile LAS unsigned* st) {
    XcdBarrier b; b.bar = bar; b.x = xb_xcc_id(); b.st = st;
    if (threadIdx.x == 0) (void)xb_add(&bar[XB_XCNT(b.x)], 1u);
    return b;
}
__device__ __forceinline__ void xcd_barrier_complete(unsigned* bar, unsigned x, unsigned& nloc, unsigned& nx) {
    const unsigned G = gridDim.x * gridDim.y * gridDim.z;
    unsigned sum, cnt, mine, sp = 0u;
    for (;;) {
        sum = 0u; cnt = 0u; mine = 0u;
#pragma unroll
        for (unsigned j = 0; j < 16; ++j) { const unsigned c = xb_ld(&bar[XB_XCNT(j)]); sum += c; cnt += (c > 0u) ? 1u : 0u; mine = (j == x) ? c : mine; }
        if (sum == G) break;
        __builtin_amdgcn_s_sleep(1);
        if ((++sp & 255u) == 0u) { if (xb_ld(&bar[XB_TMO])) break; if (sp > XB_SPIN_CAP) { atomicAdd(&bar[XB_TMO], 1u); break; } }
    }
    nloc = mine > 0u ? mine : 1u; nx = cnt > 0u ? cnt : 1u;
}

__device__ __forceinline__ void xcd_barrier(const XcdBarrier& b) {
    asm volatile("s_waitcnt vmcnt(0)" ::: "memory");
    __syncthreads();
    if (threadIdx.x == 0) {
        unsigned* bar = b.bar;
        __builtin_amdgcn_s_waitcnt(0);
        unsigned nloc = b.st[0], nx = b.st[1];
        if (nloc == 0u) { xcd_barrier_complete(bar, b.x, nloc, nx); b.st[0] = nloc; b.st[1] = nx; }
        const unsigned old = xb_add(&bar[XB_XSUB(b.x)], 1u);
        const unsigned gen = old / nloc;
        if (old + 1u == (gen + 1u) * nloc) {
            __builtin_amdgcn_fence(__ATOMIC_RELEASE, "agent");
            asm volatile("s_waitcnt vmcnt(0)" ::: "memory");
            const unsigned og = xb_add(&bar[XB_TOP], 1u);
            const unsigned tg = og / nx;
            if (og + 1u == (tg + 1u) * nx) xb_add(&bar[XB_TOPGEN], 1u);
            else XB_SPIN(xb_ld(&bar[XB_TOPGEN]) == tg, bar);
            __builtin_amdgcn_fence(__ATOMIC_ACQUIRE, "agent");
            xb_add(&bar[XB_XGEN(b.x)], 1u);
            asm volatile("s_waitcnt vmcnt(0)" ::: "memory");
        } else {
            XB_SPIN(xb_ld(&bar[XB_XGEN(b.x)]) == gen, bar);
            __builtin_amdgcn_fence(__ATOMIC_ACQUIRE, "agent");
            asm volatile("s_waitcnt vmcnt(0)" ::: "memory");
        }
    }
    __syncthreads();
}

constexpr int NWAVES = 8, NTHR = 512;
constexpr int DM = 1024, NB = 8, SEQ = 4096, CTXL = 256, DEPTH = 4;
constexpr int NLAT = NB * SEQ, NCTX = NB * CTXL, NT = NLAT + NCTX;
constexpr int PW = 2304;
constexpr int MW = 1280;
constexpr int NEXP = 32, MAXBLK = 576;
constexpr int NCHK = 544;
constexpr int S5ROWS = 2304;
constexpr int PC_FU = 0, PC_S5 = 256, PC_Q = 512, PC_K = 640, PC_V = 768, PC_R = 1024, PC_Z = 1280, PC_XBC = 1536, PC_A1 = 2048, PC_DT = 2080;
enum { I_X = 0, I_C, I_CTX, I_CCTX, I_ADAW, I_ADAB, I_NMG, I_NFG, I_WIN, I_WOUT, I_FOURW, I_S5LRE, I_S5LIM, I_S5LDT, I_S5BRE, I_S5BIM, I_S5CRE, I_S5CIM, I_S5D, I_S5GLU,
       I_GLAA2, I_GLAAB, I_GLANG, I_SSDCW, I_SSDCB, I_SSDALOG, I_SSDDTB, I_SSDD, I_SSDNG, I_RW, I_RB, I_WGU, I_BGU, I_WDN, I_BDN, I_FING, N_IN };

constexpr size_t al256(size_t x) { return (x + 255) & ~(size_t)255; }
constexpr size_t WS_CTL = 0, CTL_BYTES = 1u << 20;
constexpr size_t WS_MOD = WS_CTL + CTL_BYTES;
constexpr size_t WS_TAB = WS_MOD + al256((size_t)DEPTH * 9 * 6144 * 4);
constexpr size_t TAB_F64 = 0, TAB_TW = 16384, TAB_D256 = 16384 + 32768, TAB_BYTES = 65536;
constexpr size_t WS_A16 = WS_TAB + TAB_BYTES;
constexpr size_t WS_WIN = WS_A16 + al256((size_t)DEPTH * 2 * 16 * 64 * 2 * 4);
constexpr size_t WS_WOUT = WS_WIN + (size_t)DEPTH * PW * DM * 2;
constexpr size_t WS_WGLU = WS_WOUT + (size_t)DEPTH * DM * MW * 2;
constexpr size_t WS_S5P = WS_WGLU + (size_t)DEPTH * 256 * 256 * 2;
constexpr size_t WS_S5B2 = WS_S5P + (size_t)DEPTH * 16 * 256 * 256 * 2;
constexpr size_t WS_WGU = WS_S5B2 + (size_t)DEPTH * 16 * 256 * 512 * 2;
constexpr size_t WS_WDN = WS_WGU + (size_t)DEPTH * NEXP * 2048 * DM;
constexpr size_t WS_XS = WS_WDN + (size_t)DEPTH * NEXP * DM * DM;
constexpr size_t WS_H = WS_XS + (size_t)NT * DM * 2;
constexpr size_t WS_PBUF = WS_H + (size_t)NT * DM * 2;
constexpr size_t WS_A2 = WS_PBUF + (size_t)NT * PW * 2;
constexpr size_t WS_S5S = WS_A2 + (size_t)16 * S5ROWS * 512 * 2;
constexpr size_t WS_ACT5 = WS_S5S + (size_t)16 * S5ROWS * 256 * 4;
constexpr size_t WS_MIX = WS_ACT5 + (size_t)NT * 256 * 2;
constexpr size_t WS_GDS = WS_MIX + (size_t)NT * MW * 2;
constexpr size_t WS_GDEC = WS_GDS + (size_t)NCHK * 8 * 2048 * 4;
constexpr size_t WS_GSE = WS_GDEC + al256((size_t)NCHK * 8 * 32 * 4);
constexpr size_t WS_SDS = WS_GSE + (size_t)NCHK * 8 * 2048 * 2;
constexpr size_t WS_SDEC = WS_SDS + (size_t)NCHK * 8 * 4096 * 4;
constexpr size_t WS_SSE = WS_SDEC + al256((size_t)NCHK * 8 * 4);
constexpr size_t WS_PE = WS_SSE + (size_t)NCHK * 8 * 4096 * 2;
constexpr size_t WS_PR = WS_PE + (size_t)NT * 4 * 4;
constexpr size_t WS_PG = WS_PR + (size_t)NT * 4 * 4;
constexpr size_t WS_PS = WS_PG + (size_t)NT * 4 * 4;
constexpr size_t WS_SG = WS_PS + (size_t)NT * 4 * 4;
constexpr size_t WS_H8 = WS_SG + (size_t)MAXBLK * 256 * 4;
constexpr size_t WS_TM = WS_H8 + (size_t)NT * DM;
constexpr size_t WS_ACT = WS_TM + (size_t)NEXP * NT * 4;
constexpr size_t WS_Y = WS_ACT + (size_t)MAXBLK * 256 * DM;
constexpr size_t WS_GQI = WS_Y + (size_t)MAXBLK * 256 * DM;
constexpr size_t WS_GOI = WS_GQI + (size_t)NT * 256 * 2;
constexpr size_t WS_SCB = WS_GOI + (size_t)NT * 256 * 2;
constexpr size_t WS_SCUM = WS_SCB + (size_t)NT * 128 * 2;
constexpr size_t WS_SYI = WS_SCUM + (size_t)NT * 8 * 4;
constexpr size_t WS_END = WS_SYI + (size_t)NT * 256 * 2;
constexpr int CW_QUEUE = 64;
constexpr int CW_CNT = 1024;
constexpr int CW_BLKE = 2048;
constexpr int CW_BAR = 8192;

constexpr int LDS_BYTES = 163840, MISC_OFF = LDS_BYTES - 256;

constexpr float W8_SCALE = 32.f, H8_SCALE = 8.f, A8_SCALE = 4.f, Y8_SCALE = 16.f;
__device__ __forceinline__ unsigned pk4f8(float a, float b, float c, float d) { int w = 0; w = __builtin_amdgcn_cvt_pk_fp8_f32(a, b, w, false); w = __builtin_amdgcn_cvt_pk_fp8_f32(c, d, w, true); return (unsigned)w; }
#define RLX_AGENT __ATOMIC_RELAXED, __HIP_MEMORY_SCOPE_AGENT
__device__ __forceinline__ int fresh_tid(int wave0) { int l = (int)__builtin_amdgcn_mbcnt_hi(~0u, __builtin_amdgcn_mbcnt_lo(~0u, 0u)); asm volatile("" : "+v"(l)); return wave0 * 64 + l; }
__device__ __forceinline__ unsigned f2bf(float f) { unsigned u = __builtin_bit_cast(unsigned, f); return (u + 0x7fffu + ((u >> 16) & 1u)) >> 16; }
__device__ __forceinline__ unsigned pk2(float lo, float hi) { return f2bf(lo) | (f2bf(hi) << 16); }
__device__ __forceinline__ float bf2f(unsigned short b) { return __builtin_bit_cast(float, (unsigned)b << 16); }
__device__ __forceinline__ f32x4 f8x4(unsigned w) { const f32x2 lo = __builtin_amdgcn_cvt_pk_f32_fp8((int)w, false), hi = __builtin_amdgcn_cvt_pk_f32_fp8((int)w, true); return (f32x4){lo.x, lo.y, hi.x, hi.y}; }
__device__ __forceinline__ f32x4 bf4(u32x2 w) { return (f32x4){__builtin_bit_cast(float, w.x << 16), __builtin_bit_cast(float, w.x & 0xffff0000u), __builtin_bit_cast(float, w.y << 16), __builtin_bit_cast(float, w.y & 0xffff0000u)}; }
__device__ __forceinline__ float bflo(unsigned w) { return __builtin_bit_cast(float, w << 16); }
__device__ __forceinline__ float bfhi(unsigned w) { return __builtin_bit_cast(float, w & 0xffff0000u); }
template <int M> __device__ __forceinline__ float swz_xor(float v) { return __builtin_bit_cast(float, __builtin_amdgcn_ds_swizzle(__builtin_bit_cast(int, v), (M << 10) | 0x1F)); }
__device__ __forceinline__ float xor32f(float v, int lane) { return __builtin_bit_cast(float, __builtin_amdgcn_ds_bpermute((lane ^ 32) << 2, __builtin_bit_cast(int, v))); }
__device__ __forceinline__ float wave_sum(float v, int lane) { v += swz_xor<1>(v); v += swz_xor<2>(v); v += swz_xor<4>(v); v += swz_xor<8>(v); v += swz_xor<16>(v); v += xor32f(v, lane); return v; }
__device__ __forceinline__ float wave_max(float v, int lane) { v = fmaxf(v, swz_xor<1>(v)); v = fmaxf(v, swz_xor<2>(v)); v = fmaxf(v, swz_xor<4>(v)); v = fmaxf(v, swz_xor<8>(v)); v = fmaxf(v, swz_xor<16>(v)); v = fmaxf(v, xor32f(v, lane)); return v; }
__device__ __forceinline__ float fexp_(float x) { return __builtin_amdgcn_exp2f(1.4426950408889634f * x); }
__device__ __forceinline__ float frcp_(float x) { return __builtin_amdgcn_rcpf(x); }
__device__ __forceinline__ float sigmoidf_(float x) { return frcp_(1.f + fexp_(-x)); }
__device__ __forceinline__ float siluf_(float x) { return x * frcp_(1.f + fexp_(-x)); }

struct Frame {
    LAS unsigned char* lds; volatile LAS unsigned* MISC; unsigned* ctl; unsigned char* ws;
    int tid, lane, wave, G, bid;
};


template <class Fill> struct SgOrder {
    int nblk, nN, R, r, lo, hi; Fill f;
    __device__ __forceinline__ void init(int nblk_, int nN_, int G, int c) { nblk = nblk_; nN = nN_; const int U = nblk * nN; int x, nx;
        if ((G & 7) == 0) { R = G >> 3; x = c & 7; r = c >> 3; nx = 8; } else { R = G; x = 0; r = c; nx = 1; }
        lo = (int)(((long)x * U) / nx); hi = (int)(((long)(x + 1) * U) / nx); }
    __device__ __forceinline__ bool next(int& cursor, pg8::Unit& u) const {
        const int q = lo + r + R * cursor; ++cursor;
        if (q >= hi) return false;
        const int ups = 8 * nN, sg = q / ups, ql = q - sg * ups, nb = (nblk - sg * 8) < 8 ? (nblk - sg * 8) : 8;
        u.pm = sg * 8 + ql % nb; u.pn = ql / nb; f(u); return true;
    }
};
struct FillPlain { size_t astep, bstep; __device__ __forceinline__ void operator()(pg8::Unit& u) const { u.grp = 0; u.aoff = (size_t)u.pm * astep; u.boff = (size_t)u.pn * bstep; } };
struct FillS5 { size_t bgrp; __device__ __forceinline__ void operator()(pg8::Unit& u) const { const int g = u.pm / 9, t = u.pm - g * 9; u.grp = g; u.pm = t; u.aoff = ((size_t)g * S5ROWS + (size_t)t * 256) * 512 * 2; u.boff = (size_t)g * bgrp; } };
struct FillMoe { const LAS unsigned* lblk; int erows; __device__ __forceinline__ void operator()(pg8::Unit& u) const { const int e = (int)lblk[u.pm]; u.grp = e; u.aoff = (size_t)u.pm * 256 * DM; u.boff = ((size_t)e * erows + (size_t)u.pn * 256) * DM; } };
constexpr int MOE_LB = 131072, MOE_LC = MOE_LB + 256, MOE_LBLK = MOE_LC + 256, MOE_GAT = MOE_LBLK + 2560, MOE_MAXU = 26;
static_assert(MOE_GAT + MOE_MAXU * 1024 <= MISC_OFF, "MoE LDS tables");
__device__ __forceinline__ int moe_tables(Frame& F, int L) {
    LAS int* lb = (LAS int*)(F.lds + MOE_LB); LAS int* lc = (LAS int*)(F.lds + MOE_LC); LAS unsigned* lblk = (LAS unsigned*)(F.lds + MOE_LBLK);
    const unsigned* cnt = F.ctl + CW_CNT + L * 64;
    __syncthreads();
    if (F.tid == 0) { int acc = 0; for (int e = 0; e < NEXP; ++e) { lb[e] = acc; const int c = (int)__hip_atomic_load(cnt + e, RLX_AGENT); lc[e] = c; acc += (c + 255) & ~255; } lb[32] = acc; }
    __syncthreads();
    const int nblk = lb[32] >> 8;
    for (int i = F.tid; i < nblk; i += NTHR) { int e = 0; for (int q = 1; q < NEXP; ++q) if (lb[q] <= i * 256) e = q; lblk[i] = (unsigned)e; }
    __syncthreads();
    return nblk;
}
using pg8::cvt_pk_bf16;
struct EpiInproj {
    static constexpr bool PERM = true;
    bf16* P; bf16* A2;
    __device__ __forceinline__ void operator()(const f32x4 (&acc)[2][2][4][2], const pg8::Unit& u, int wr, int wc, int fr, int fq) const {
        const int row0 = u.pm * 256 + wr * 64 + fr, col0 = u.pn * 256 + wc * 32 + 8 * fq;
#pragma unroll
        for (int ai = 0; ai < 2; ++ai)
#pragma unroll
            for (int m = 0; m < 4; ++m) {
                const int row = row0 + ai * 128 + m * 16;
#pragma unroll
                for (int bj = 0; bj < 2; ++bj) {
                    const f32x4 v0 = acc[ai][bj][m][0], v1 = acc[ai][bj][m][1];
                    u32x4 w; w.x = cvt_pk_bf16(v0[0], v0[1]); w.y = cvt_pk_bf16(v0[2], v0[3]); w.z = cvt_pk_bf16(v1[0], v1[1]); w.w = cvt_pk_bf16(v1[2], v1[3]);
                    const int col = col0 + bj * 128;
                    if (u.pn == 1) {
                        const int cc = col - 256, g = cc >> 4, hp = cc & 15;
                        const int crow = row < NLAT ? (row >> 4) : (2048 + ((row - NLAT) >> 4)), s = row & 15;
                        *(u32x4*)(A2 + ((size_t)g * S5ROWS + crow) * 512 + s * 16 + hp) = w;
                    } else if (col < 2088) *(u32x4*)(P + (size_t)row * PW + col) = w;
                }
            }
    }
};
struct EpiOutproj {
    static constexpr bool PERM = true;
    const float* xin; const float* ctxin; bf16* XS; const float* modL; int first;
    __device__ __forceinline__ void operator()(const f32x4 (&acc)[2][2][4][2], const pg8::Unit& u, int wr, int wc, int fr, int fq) const {
        const int rowt = u.pm * 256, bi = rowt < NLAT ? (rowt >> 12) : 8;
        const int row0 = rowt + wr * 64 + fr, col0 = u.pn * 256 + wc * 32 + 8 * fq;
        const float* gate = modL + (size_t)bi * 6144 + 2 * 1024;
        f32x4 gv[2][2];
#pragma unroll
        for (int bj = 0; bj < 2; ++bj)
#pragma unroll
            for (int n = 0; n < 2; ++n) gv[bj][n] = *(const f32x4*)(gate + col0 + bj * 128 + 4 * n);
#pragma unroll
        for (int ai = 0; ai < 2; ++ai)
#pragma unroll
            for (int m = 0; m < 4; ++m) {
                const int row = row0 + ai * 128 + m * 16;
                bf16* dst = XS + (size_t)row * DM;
#pragma unroll
                for (int bj = 0; bj < 2; ++bj) { const int c = col0 + bj * 128; f32x4 x0, x1;
                    if (first) { const float* src = (row < NLAT ? xin + (size_t)row * DM : ctxin + (size_t)(row - NLAT) * DM) + c; x0 = *(const f32x4*)src; x1 = *(const f32x4*)(src + 4); }
                    else { const u32x4 w = *(const u32x4*)(dst + c); x0 = bf4((u32x2){w.x, w.y}); x1 = bf4((u32x2){w.z, w.w}); }
                    x0 += gv[bj][0] * acc[ai][bj][m][0]; x1 += gv[bj][1] * acc[ai][bj][m][1];
                    u32x4 o; o.x = cvt_pk_bf16(x0[0], x0[1]); o.y = cvt_pk_bf16(x0[2], x0[3]); o.z = cvt_pk_bf16(x1[0], x1[1]); o.w = cvt_pk_bf16(x1[2], x1[3]);
                    *(u32x4*)(dst + c) = o; }
            }
    }
};
struct EpiSwiglu {
    static constexpr bool PERM = true;
    unsigned char* ACT; const float* bgu;
    __device__ __forceinline__ void operator()(const f32x4 (&acc)[2][2][4][2], const pg8::Unit& u, int wr, int wc, int fr, int fq) const {
        const int row0 = u.pm * 256 + wr * 64 + fr, i0 = u.pn * 128 + wc * 32 + 8 * fq;
        const float* bb = bgu + (size_t)u.grp * 2048 + 2 * i0;
        const f32x4 b0 = *(const f32x4*)(bb), b1 = *(const f32x4*)(bb + 4), b2 = *(const f32x4*)(bb + 8), b3 = *(const f32x4*)(bb + 12);
        const float bg[8] = {b0[0], b0[2], b1[0], b1[2], b2[0], b2[2], b3[0], b3[2]}, bu[8] = {b0[1], b0[3], b1[1], b1[3], b2[1], b2[3], b3[1], b3[3]};
        constexpr float inv = 1.f / (H8_SCALE * W8_SCALE);
#pragma unroll
        for (int ai = 0; ai < 2; ++ai)
#pragma unroll
            for (int m = 0; m < 4; ++m) {
                const int row = row0 + ai * 128 + m * 16;
                float o[8];
#pragma unroll
                for (int n = 0; n < 2; ++n)
#pragma unroll
                    for (int jp = 0; jp < 2; ++jp) {
                        const int q = 4 * n + 2 * jp;
                        f32x2 gt = (f32x2){acc[ai][0][m][n][2 * jp], acc[ai][0][m][n][2 * jp + 1]} * inv + (f32x2){bg[q], bg[q + 1]};
                        f32x2 up = (f32x2){acc[ai][1][m][n][2 * jp], acc[ai][1][m][n][2 * jp + 1]} * inv + (f32x2){bu[q], bu[q + 1]};
                        gt.x = fminf(gt.x, 7.0f); gt.y = fminf(gt.y, 7.0f);
                        up.x = __builtin_amdgcn_fmed3f(up.x, -7.0f, 7.0f); up.y = __builtin_amdgcn_fmed3f(up.y, -7.0f, 7.0f);
                        const f32x2 ea = gt * (-1.702f * 1.4426950408889634f);
                        f32x2 den; den.x = __builtin_amdgcn_exp2f(ea.x); den.y = __builtin_amdgcn_exp2f(ea.y); den = den + 1.0f;
                        f32x2 sg; sg.x = __builtin_amdgcn_rcpf(den.x); sg.y = __builtin_amdgcn_rcpf(den.y);
                        const f32x2 r = (up * A8_SCALE + A8_SCALE) * gt * sg;
                        o[q] = r.x; o[q + 1] = r.y;
                    }
                u32x2 w; w.x = pk4f8(o[0], o[1], o[2], o[3]); w.y = pk4f8(o[4], o[5], o[6], o[7]);
                *(u32x2*)(ACT + (size_t)row * DM + i0) = w;
            }
    }
};
struct EpiDown {
    static constexpr bool PERM = true;
    unsigned char* Y; const float* bdn; const float* sg;
    __device__ __forceinline__ void operator()(const f32x4 (&acc)[2][2][4][2], const pg8::Unit& u, int wr, int wc, int fr, int fq) const {
        const int row0 = u.pm * 256 + wr * 64 + fr, col0 = u.pn * 256 + wc * 32 + 8 * fq;
        const float* bb = bdn + (size_t)u.grp * DM + col0;
        constexpr float inv = 1.f / (A8_SCALE * W8_SCALE);
        f32x4 bv[2][2];
#pragma unroll
        for (int bj = 0; bj < 2; ++bj)
#pragma unroll
            for (int n = 0; n < 2; ++n) bv[bj][n] = *(const f32x4*)(bb + bj * 128 + 4 * n);
#pragma unroll
        for (int ai = 0; ai < 2; ++ai)
#pragma unroll
            for (int m = 0; m < 4; ++m) {
                const int row = row0 + ai * 128 + m * 16; const float gt = sg[row] * Y8_SCALE;
#pragma unroll
                for (int bj = 0; bj < 2; ++bj) {
                    const f32x4 v0 = (acc[ai][bj][m][0] * inv + bv[bj][0]) * gt, v1 = (acc[ai][bj][m][1] * inv + bv[bj][1]) * gt;
                    u32x2 w; w.x = pk4f8(v0[0], v0[1], v0[2], v0[3]); w.y = pk4f8(v1[0], v1[1], v1[2], v1[3]);
                    *(u32x2*)(Y + (size_t)row * DM + col0 + bj * 128) = w;
                }
            }
    }
};
struct EpiNull { static constexpr bool PERM = true; float* sink;
    __device__ __forceinline__ void operator()(const f32x4 (&acc)[2][2][4][2], const pg8::Unit& u, int wr, int wc, int fr, int fq) const { float s = 0.f;
#pragma unroll
        for (int ai = 0; ai < 2; ++ai)
#pragma unroll
            for (int bj = 0; bj < 2; ++bj)
#pragma unroll
                for (int m = 0; m < 4; ++m)
#pragma unroll
                    for (int n = 0; n < 2; ++n) s += acc[ai][bj][m][n][0];
        if (s == 12345.678f) sink[u.pm] = s; } };
struct EpiS5S {
    static constexpr bool PERM = false;
    float* S;
    __device__ __forceinline__ void operator()(const f32x4 (&acc)[2][2][4][2], const pg8::Unit& u, int wr, int wc, int fr, int fq) const {
        const int row0 = u.pm * 256 + wr * 64 + fr, col0 = wc * 32 + 4 * fq;
        float* base = S + (size_t)u.grp * S5ROWS * 256;
#pragma unroll
        for (int ai = 0; ai < 2; ++ai)
#pragma unroll
            for (int m = 0; m < 4; ++m) { float* rp = base + (size_t)(row0 + ai * 128 + m * 16) * 256 + col0;
#pragma unroll
                for (int bj = 0; bj < 2; ++bj)
#pragma unroll
                    for (int n = 0; n < 2; ++n) *(f32x4*)(rp + bj * 128 + n * 16) = acc[ai][bj][m][n]; }
    }
};
__device__ __forceinline__ float gelu_tanh(float x) { const float t = 0.7978845608f * (x + 0.044715f * x * x * x); return x * frcp_(1.f + fexp_(-2.f * t)); }
struct EpiS5Y {
    static constexpr bool PERM = true;
    bf16* ACT5;
    __device__ __forceinline__ void operator()(const f32x4 (&acc)[2][2][4][2], const pg8::Unit& u, int wr, int wc, int fr, int fq) const {
        const int row0 = u.pm * 256 + wr * 64 + fr, col0 = wc * 32 + 8 * fq;
#pragma unroll
        for (int ai = 0; ai < 2; ++ai)
#pragma unroll
            for (int m = 0; m < 4; ++m) {
                const int crow = row0 + ai * 128 + m * 16;
                if (crow >= 2176) continue;
                const int tok0 = crow < 2048 ? crow * 16 : NLAT + (crow - 2048) * 16;
#pragma unroll
                for (int bj = 0; bj < 2; ++bj) {
                    const int col = col0 + bj * 128, j = col >> 4, h = col & 15;
                    const f32x4 v0 = acc[ai][bj][m][0], v1 = acc[ai][bj][m][1];
                    u32x4 w; w.x = cvt_pk_bf16(gelu_tanh(v0[0]), gelu_tanh(v0[1])); w.y = cvt_pk_bf16(gelu_tanh(v0[2]), gelu_tanh(v0[3]));
                    w.z = cvt_pk_bf16(gelu_tanh(v1[0]), gelu_tanh(v1[1])); w.w = cvt_pk_bf16(gelu_tanh(v1[2]), gelu_tanh(v1[3]));
                    *(u32x4*)(ACT5 + (size_t)(tok0 + j) * 256 + u.grp * 16 + h) = w;
                }
            }
    }
};
struct EpiGlu {
    static constexpr bool PERM = true;
    const bf16* ACT5; bf16* MIX;
    __device__ __forceinline__ void operator()(const f32x4 (&acc)[2][2][4][2], const pg8::Unit& u, int wr, int wc, int fr, int fq) const {
        const int row0 = u.pm * 256 + wr * 64 + fr, col0 = wc * 32 + 8 * fq;
#pragma unroll
        for (int ai = 0; ai < 2; ++ai)
#pragma unroll
            for (int m = 0; m < 4; ++m) {
                const int row = row0 + ai * 128 + m * 16;
#pragma unroll
                for (int bj = 0; bj < 2; ++bj) {
                    const int col = col0 + bj * 128;
                    const u32x4 a = *(const u32x4*)(ACT5 + (size_t)row * 256 + col);
                    const f32x4 v0 = acc[ai][bj][m][0], v1 = acc[ai][bj][m][1];
                    u32x4 w;
                    w.x = cvt_pk_bf16(bflo(a.x) * sigmoidf_(v0[0]), bfhi(a.x) * sigmoidf_(v0[1])); w.y = cvt_pk_bf16(bflo(a.y) * sigmoidf_(v0[2]), bfhi(a.y) * sigmoidf_(v0[3]));
                    w.z = cvt_pk_bf16(bflo(a.z) * sigmoidf_(v1[0]), bfhi(a.z) * sigmoidf_(v1[1])); w.w = cvt_pk_bf16(bflo(a.w) * sigmoidf_(v1[2]), bfhi(a.w) * sigmoidf_(v1[3]));
                    *(u32x4*)(MIX + (size_t)row * MW + 512 + col) = w;
                }
            }
    }
};

struct Args { const float* in[N_IN]; float* out; unsigned char* ws; int ph_lo, ph_hi; };
typedef const __attribute__((address_space(4))) Args CArgs;
__device__ __forceinline__ CArgs* fresh_args() { CArgs* p = (CArgs*)__builtin_amdgcn_kernarg_segment_ptr(); asm volatile("" : "+s"(p)); return p; }

template <class Map> __device__ __forceinline__ void transpose_tile(const float* W, int ldw, int ncols, int k0, int n0, bf16* WT, int ldt, int kd0, const Map& map, LAS float* scr, int lane) {
    { const int c4 = (lane & 15) * 4, r4 = lane >> 4; const bool ok = n0 + c4 < ncols;
#pragma unroll
      for (int q = 0; q < 16; ++q) { const int kk = q * 4 + r4; const f32x4 v = ok ? *(const f32x4*)(W + (size_t)(k0 + kk) * ldw + n0 + c4) : (f32x4){0.f, 0.f, 0.f, 0.f};
          scr[kk * 65 + c4] = v[0]; scr[kk * 65 + c4 + 1] = v[1]; scr[kk * 65 + c4 + 2] = v[2]; scr[kk * 65 + c4 + 3] = v[3]; } }
    asm volatile("s_waitcnt lgkmcnt(0)" ::: "memory");
    const int c = lane & 7;
#pragma unroll
    for (int j = 0; j < 8; ++j) {
        const int n = (lane >> 3) + 8 * j; const LAS float* s = scr + (8 * c) * 65 + n;
        u32x4 o; o.x = pk2(s[0], s[65]); o.y = pk2(s[2 * 65], s[3 * 65]); o.z = pk2(s[4 * 65], s[5 * 65]); o.w = pk2(s[6 * 65], s[7 * 65]);
        const int dr = (n0 + n) < ncols ? map(n0 + n) : -1;
        if (dr >= 0) *(u32x4*)(WT + (size_t)dr * ldt + kd0 + 8 * c) = o;
    }
    asm volatile("s_waitcnt lgkmcnt(0)" ::: "memory");
}
struct MapId { __device__ __forceinline__ int operator()(int n) const { return n; } };
struct MapWin { __device__ __forceinline__ int operator()(int c) const { return c < 1280 ? c : (c < 1312 ? 2048 + (c - 1280) : (c < 2080 ? c - 32 : c)); } };
struct MapGu { __device__ __forceinline__ int operator()(int n) const { const int i = n >> 1; return (i >> 7) * 256 + (n & 1) * 128 + (i & 127); } };

template <class Map> __device__ __forceinline__ void transpose_tile_f8(const float* W, int ldw, int k0, int n0, unsigned char* WT, int ldt, const Map& map, LAS float* scr, int lane) {
    { const int c4 = (lane & 15) * 4, r4 = lane >> 4;
#pragma unroll
      for (int q = 0; q < 16; ++q) { const int kk = q * 4 + r4; const f32x4 v = *(const f32x4*)(W + (size_t)(k0 + kk) * ldw + n0 + c4);
          scr[kk * 65 + c4] = v[0]; scr[kk * 65 + c4 + 1] = v[1]; scr[kk * 65 + c4 + 2] = v[2]; scr[kk * 65 + c4 + 3] = v[3]; } }
    asm volatile("s_waitcnt lgkmcnt(0)" ::: "memory");
    const int c = lane & 7;
#pragma unroll
    for (int j = 0; j < 8; ++j) {
        const int n = (lane >> 3) + 8 * j; const LAS float* s = scr + (8 * c) * 65 + n;
        u32x2 o; o.x = pk4f8(s[0] * W8_SCALE, s[65] * W8_SCALE, s[2 * 65] * W8_SCALE, s[3 * 65] * W8_SCALE); o.y = pk4f8(s[4 * 65] * W8_SCALE, s[5 * 65] * W8_SCALE, s[6 * 65] * W8_SCALE, s[7 * 65] * W8_SCALE);
        *(u32x2*)(WT + (size_t)map(n0 + n) * ldt + k0 + 8 * c) = o;
    }
    asm volatile("s_waitcnt lgkmcnt(0)" ::: "memory");
}
constexpr int PI_ADA = 48, PI_TAB = 1, PI_S5 = 64, PI_FOLD = 256, PI_ZERO = 4;
constexpr int TW_WIN = 16 * 33, TW_GU = 32 * 16 * 32, TW_DN = 32 * 16 * 16, TW_WOUT = 12 * 16, TW_GLU = 16, TW_LAYER = TW_WIN + TW_GU + TW_DN + TW_WOUT + TW_GLU;
constexpr int PI_TR = (DEPTH * TW_LAYER + 7) / 8;
constexpr int PI_B_TAB = PI_ADA, PI_B_S5 = PI_B_TAB + PI_TAB, PI_B_FOLD = PI_B_S5 + PI_S5, PI_B_ZERO = PI_B_FOLD + PI_FOLD, PI_B_TR = PI_B_ZERO + PI_ZERO, PI_TOTAL = PI_B_TR + (PI_TR + 3) / 4;

__device__ __forceinline__ void pro_adaln(Frame& F, CArgs& a, int it) {
    const int L = it / 12, cb = it % 12;
    LAS float* cond = (LAS float*)F.lds;
    for (int i = F.tid; i < 9 * 1024; i += NTHR) { const int r = i >> 10, k = i & 1023; const float v = r < 8 ? a.in[I_C][r * 1024 + k] : a.in[I_CCTX][k]; cond[i] = siluf_(v); }
    __syncthreads();
    const int n = cb * 512 + F.tid;
    const float* w = a.in[I_ADAW] + (size_t)L * 1024 * 6144 + n;
    float acc[9];
    const float b = a.in[I_ADAB][L * 6144 + n];
#pragma unroll
    for (int r = 0; r < 9; ++r) acc[r] = b;
#pragma unroll 8
    for (int k = 0; k < 1024; k += 4) {
        const float w0 = w[(size_t)k * 6144], w1 = w[(size_t)(k + 1) * 6144], w2 = w[(size_t)(k + 2) * 6144], w3 = w[(size_t)(k + 3) * 6144];
#pragma unroll
        for (int r = 0; r < 9; ++r) { const f32x4 c4 = *(const LAS f32x4*)(cond + r * 1024 + k); acc[r] += c4[0] * w0 + c4[1] * w1 + c4[2] * w2 + c4[3] * w3; }
    }
    float* mod = (float*)(F.ws + WS_MOD) + (size_t)L * 9 * 6144 + n;
#pragma unroll
    for (int r = 0; r < 9; ++r) mod[(size_t)r * 6144] = acc[r];
    __syncthreads();
}
__device__ __forceinline__ void pro_tables(Frame& F) {
    bf16* f64 = (bf16*)(F.ws + WS_TAB + TAB_F64);
    for (int i = F.tid; i < 4096; i += NTHR) { const int k = i >> 6, n = i & 63; float s, c; sincospif((float)((k * n) & 63) / 32.f, &s, &c); f64[i] = (bf16)f2bf(c); f64[4096 + i] = (bf16)f2bf(s); }
    float* tw = (float*)(F.ws + WS_TAB + TAB_TW);
    for (int i = F.tid; i < 4096; i += NTHR) { float s, c; sincospif((float)i / 2048.f, &s, &c); tw[2 * i] = c; tw[2 * i + 1] = s; }
    float* d256 = (float*)(F.ws + WS_TAB + TAB_D256);
    for (int i = F.tid; i < 256; i += NTHR) { float s, c; sincospif((float)i / 128.f, &s, &c); d256[2 * i] = c; d256[2 * i + 1] = s; }
}
__device__ __forceinline__ void pro_fold(Frame& F, CArgs& a, int it) {
    const int L = it >> 6, h = (it >> 4) & 3, nb = it & 15, n0 = nb * 64;
    LAS float* fw = (LAS float*)F.lds;
    LAS float* ct = fw + 64 * 65;
    LAS float* swo = ct + 64;
    LAS float* sfo = swo + 256 * 64;
    if (F.tid < 64) ct[F.tid] = cospif((float)F.tid / 32.f);
    const float* four = a.in[I_FOURW] + (size_t)L * 256 * 256 + (size_t)h * 64 * 256, *wo = a.in[I_WOUT] + (size_t)L * 1024 * 1024 + n0;
    { f32x4 va[8], vb[8];
#pragma unroll
      for (int k = 0; k < 8; ++k) { const int i = F.tid + k * NTHR, j = i >> 4, c4 = (i & 15) * 4; va[k] = *(const f32x4*)(wo + (size_t)j * 1024 + c4); vb[k] = *(const f32x4*)(four + (size_t)i * 4); }
#pragma unroll
      for (int k = 0; k < 8; ++k) { const int i = F.tid + k * NTHR, j = i >> 4, c4 = (i & 15) * 4; *(LAS f32x4*)(swo + j * 64 + c4) = va[k]; *(LAS f32x4*)(sfo + i * 4) = vb[k]; } }
    __syncthreads();
    const int n = F.tid & 63, cg = F.tid >> 6;
    { float s[8];
#pragma unroll
      for (int i = 0; i < 8; ++i) s[i] = 0.f;
#pragma unroll 4
      for (int j = 0; j < 256; j += 4) { const float w0 = swo[j * 64 + n], w1 = swo[(j + 1) * 64 + n], w2 = swo[(j + 2) * 64 + n], w3 = swo[(j + 3) * 64 + n];
#pragma unroll
          for (int i = 0; i < 8; ++i) { const f32x4 f4 = *(const LAS f32x4*)(sfo + (cg * 8 + i) * 256 + j); s[i] += f4[0] * w0 + f4[1] * w1 + f4[2] * w2 + f4[3] * w3; } }
#pragma unroll
      for (int i = 0; i < 8; ++i) fw[(cg * 8 + i) * 65 + n] = s[i]; }
    __syncthreads();
    float oc[8], os[8];
#pragma unroll
    for (int i = 0; i < 8; ++i) { oc[i] = 0.f; os[i] = 0.f; }
    for (int kc = 0; kc < 64; ++kc) { const float v = fw[kc * 65 + n];
#pragma unroll
        for (int i = 0; i < 8; ++i) { const int mm = (kc * (cg * 8 + i)) & 63; oc[i] += ct[mm] * v; os[i] += ct[(mm + 48) & 63] * v; } }
    bf16* wt = (bf16*)(F.ws + WS_WOUT) + (size_t)L * DM * MW + (size_t)(n0 + n) * MW + h * 64 + cg * 8;
    u32x4 w; w.x = pk2(oc[0] * 0.125f, oc[1] * 0.125f); w.y = pk2(oc[2] * 0.125f, oc[3] * 0.125f); w.z = pk2(oc[4] * 0.125f, oc[5] * 0.125f); w.w = pk2(oc[6] * 0.125f, oc[7] * 0.125f);
    *(u32x4*)wt = w;
    w.x = pk2(os[0] * 0.125f, os[1] * 0.125f); w.y = pk2(os[2] * 0.125f, os[3] * 0.125f); w.z = pk2(os[4] * 0.125f, os[5] * 0.125f); w.w = pk2(os[6] * 0.125f, os[7] * 0.125f);
    *(u32x4*)(wt + 256) = w;
    __syncthreads();
}
__device__ __forceinline__ void pro_s5(Frame& F, CArgs& a, int it) {
    const int L = it >> 4, g = it & 15;
    LAS float* pw = (LAS float*)F.lds;
    LAS float* bb = pw + 2 * 64 * 17 * 2;
    LAS float* cm = bb + 2 * 64 * 16 * 2;
    LAS float* kt = cm + 2 * 16 * 64 * 2;
    for (int i = F.tid; i < 2 * 64 * 17; i += NTHR) {
        const int r = i / (64 * 17), p = (i / 17) & 63, e = i % 17; const size_t q = ((size_t)(L * 2 + r) * 16 + g) * 64 + p;
        const float dt = __expf(a.in[I_S5LDT][(L * 2 + r) * 16 + g]); const float lr = a.in[I_S5LRE][q] * dt, li = a.in[I_S5LIM][q] * dt;
        float s, c; sincosf(li * (float)e, &s, &c); const float m = expf(lr * (float)e); pw[2 * i] = m * c; pw[2 * i + 1] = m * s;
    }
    for (int i = F.tid; i < 2 * 64 * 16; i += NTHR) {
        const int r = i >> 10, p = (i >> 4) & 63, h = i & 15; const size_t q = ((size_t)(L * 2 + r) * 16 + g) * 64 + p;
        const float dt = __expf(a.in[I_S5LDT][(L * 2 + r) * 16 + g]); const float lre = a.in[I_S5LRE][q], lim = a.in[I_S5LIM][q];
        float s, c; sincosf(lim * dt, &s, &c); const float m = expf(lre * dt); const float ar = m * c - 1.f, ai = m * s;
        const float den = 1.f / (lre * lre + lim * lim); const float cr = (ar * lre + ai * lim) * den, ci = (ai * lre - ar * lim) * den;
        const float br = a.in[I_S5BRE][q * 16 + h], bi = a.in[I_S5BIM][q * 16 + h];
        bb[2 * i] = cr * br - ci * bi; bb[2 * i + 1] = cr * bi + ci * br;
    }
    for (int i = F.tid; i < 2 * 16 * 64; i += NTHR) {
        const int r = i >> 10, h = (i >> 6) & 15, p = i & 63; const size_t q = (((size_t)(L * 2 + r) * 16 + g) * 16 + h) * 64 + p;
        cm[2 * i] = a.in[I_S5CRE][q]; cm[2 * i + 1] = a.in[I_S5CIM][q];
    }
    __syncthreads();
    for (int i = F.tid; i < 2 * 16 * 256; i += NTHR) {
        const int r = i >> 12, tau = (i >> 8) & 15, h = (i >> 4) & 15, hp = i & 15; float s = 0.f;
        for (int p = 0; p < 64; ++p) { const float cr = cm[2 * ((r * 16 + h) * 64 + p)], ci = cm[2 * ((r * 16 + h) * 64 + p) + 1];
            const float ar = pw[2 * ((r * 64 + p) * 17 + tau)], ai = pw[2 * ((r * 64 + p) * 17 + tau) + 1]; const float br = bb[2 * ((r * 64 + p) * 16 + hp)], bi = bb[2 * ((r * 64 + p) * 16 + hp) + 1];
            const float tr = cr * ar - ci * ai, ti = cr * ai + ci * ar; s += tr * br - ti * bi; }
        kt[i] = s;
    }
    __syncthreads();
    bf16* pt = (bf16*)(F.ws + WS_S5P) + (size_t)(L * 16 + g) * 256 * 256;
    for (int i = F.tid; i < 65536; i += NTHR) {
        const int np = i >> 8, k = i & 255, r = np >> 7, cpx = (np >> 6) & 1, p = np & 63, s = k >> 4, hp = k & 15, e = r ? s : 15 - s;
        const float ar = pw[2 * ((r * 64 + p) * 17 + e)], ai = pw[2 * ((r * 64 + p) * 17 + e) + 1]; const float br = bb[2 * ((r * 64 + p) * 16 + hp)], bi = bb[2 * ((r * 64 + p) * 16 + hp) + 1];
        pt[i] = (bf16)f2bf(cpx ? ar * bi + ai * br : ar * br - ai * bi);
    }
    bf16* b2 = (bf16*)(F.ws + WS_S5B2) + (size_t)(L * 16 + g) * 256 * 512;
    const float* dsk = a.in[I_S5D] + L * 256 + g * 16;
    for (int i = F.tid; i < 131072; i += NTHR) {
        const int n = i >> 9, k = i & 511, j = n >> 4, h = n & 15; float v;
        if (k < 256) { const int s = k >> 4, hp = k & 15; v = 0.f;
            if (j >= s) v += kt[((0 * 16 + (j - s)) * 16 + h) * 16 + hp];
            if (j <= s) v += kt[((1 * 16 + (s - j)) * 16 + h) * 16 + hp];
            if (j == s && h == hp) v += dsk[h];
        } else { const int kk = k - 256, r = kk >> 7, cpx = (kk >> 6) & 1, p = kk & 63, e = r ? 16 - j : j + 1;
            const float cr = cm[2 * ((r * 16 + h) * 64 + p)], ci = cm[2 * ((r * 16 + h) * 64 + p) + 1]; const float ar = pw[2 * ((r * 64 + p) * 17 + e)], ai = pw[2 * ((r * 64 + p) * 17 + e) + 1];
            v = cpx ? -(cr * ai + ci * ar) : (cr * ar - ci * ai); }
        b2[i] = (bf16)f2bf(v);
    }
    float* a16 = (float*)(F.ws + WS_A16) + (size_t)((L * 2) * 16 + g) * 128;
    if (F.tid < 128) { const int r = F.tid >> 6, p = F.tid & 63; float* o = a16 + (size_t)r * 16 * 128 + p * 2; o[0] = pw[2 * ((r * 64 + p) * 17 + 16)]; o[1] = pw[2 * ((r * 64 + p) * 17 + 16) + 1]; }
    __syncthreads();
}
__device__ __forceinline__ void pro_transposes(Frame& F, CArgs& a, int wg_item) {
    LAS float* scr = (LAS float*)F.lds + F.wave * (64 * 65);
    const int wi = wg_item * 8 + F.wave;
    if (wi >= DEPTH * TW_LAYER) return;
    const int L = wi / TW_LAYER; int r = wi % TW_LAYER;
    if (r < TW_WIN) { const int kb = r / 33, nb = r % 33; transpose_tile(fresh_args()->in[I_WIN] + (size_t)L * DM * 2088, 2088, 2088, kb * 64, nb * 64, (bf16*)(F.ws + WS_WIN) + (size_t)L * PW * DM, DM, kb * 64, MapWin(), scr, F.lane); return; } r -= TW_WIN;
    if (r < TW_GU) { const int e = r >> 9, kb = (r >> 5) & 15, nb = r & 31; transpose_tile_f8(fresh_args()->in[I_WGU] + ((size_t)L * NEXP + e) * DM * 2048, 2048, kb * 64, nb * 64, (unsigned char*)(F.ws + WS_WGU) + ((size_t)L * NEXP + e) * 2048 * DM, DM, MapGu(), scr, F.lane); return; } r -= TW_GU;
    if (r < TW_DN) { const int e = r >> 8, kb = (r >> 4) & 15, nb = r & 15; transpose_tile_f8(fresh_args()->in[I_WDN] + ((size_t)L * NEXP + e) * DM * DM, DM, kb * 64, nb * 64, (unsigned char*)(F.ws + WS_WDN) + ((size_t)L * NEXP + e) * DM * DM, DM, MapId(), scr, F.lane); return; } r -= TW_DN;
    if (r < TW_WOUT) { const int kb = r >> 4, nb = r & 15; transpose_tile(fresh_args()->in[I_WOUT] + (size_t)L * DM * DM + (size_t)256 * DM, DM, DM, kb * 64, nb * 64, (bf16*)(F.ws + WS_WOUT) + (size_t)L * DM * MW, MW, 512 + kb * 64, MapId(), scr, F.lane); return; } r -= TW_WOUT;
    { const int kb = r >> 2, nb = r & 3; transpose_tile(fresh_args()->in[I_S5GLU] + (size_t)L * 256 * 256, 256, 256, kb * 64, nb * 64, (bf16*)(F.ws + WS_WGLU) + (size_t)L * 256 * 256, 256, kb * 64, MapId(), scr, F.lane); }
}
__device__ __forceinline__ void p_prologue(Frame& F0, CArgs& a, int qw = CW_QUEUE) {
    for (;;) {
        if (F0.tid == 0) F0.MISC[0] = __hip_atomic_fetch_add(F0.ctl + qw, 1u, RLX_AGENT);
        __syncthreads();
        const int it = (int)F0.MISC[0];
        __syncthreads();
        if (it >= PI_TOTAL) break;
        Frame F = F0; { const int t_ = fresh_tid(F.wave); F.tid = t_; F.lane = t_ & 63; }
        if (it < PI_B_TAB) pro_adaln(F, *fresh_args(), it);
        else if (it < PI_B_S5) pro_tables(F);
        else if (it < PI_B_FOLD) pro_s5(F, *fresh_args(), it - PI_B_S5);
        else if (it < PI_B_ZERO) pro_fold(F, *fresh_args(), it - PI_B_FOLD);
        else if (it < PI_B_TR) { const int L = it - PI_B_ZERO; u32x4* z = (u32x4*)((bf16*)(F.ws + WS_WIN) + (size_t)L * PW * DM + (size_t)2088 * DM); for (int i = F.tid; i < (PW - 2088) * DM / 8; i += NTHR) z[i] = (u32x4){0u, 0u, 0u, 0u}; }
        else { for (int q = 0; q < 4; ++q) pro_transposes(F, *fresh_args(), (it - PI_B_TR) * 4 + q); }
    }
}

__device__ __forceinline__ void p_norm1(Frame& F, CArgs& a, int L, bool dry = false) {
    const int gw = F.bid * NWAVES + F.wave, NGW = F.G * NWAVES;
    bf16* XS = (bf16*)(F.ws + WS_XS); bf16* H = (bf16*)(F.ws + WS_H);
    const float* mod = (const float*)(F.ws + WS_MOD) + (size_t)L * 9 * 6144; const float* modp = mod - 9 * 6144;
    const int* PS = (const int*)(F.ws + WS_PS); const unsigned char* Y = (const unsigned char*)(F.ws + WS_Y);
    const float* g = a.in[I_NMG] + L * DM;
    const float* xin = a.in[I_X]; const float* cin = a.in[I_CTX];
    f32x4 gv[4];
#pragma unroll
    for (int j = 0; j < 4; ++j) gv[j] = *(const f32x4*)(g + 4 * F.lane + 256 * j);
    f32x4 xn[4]; u32x2 xb[4]; unsigned yn[4][4]; int psn[4] = {0, 0, 0, 0};
#define N1_LOADX(dst, row) do { if (L == 0) { const float* s_ = (row) < NLAT ? xin + (size_t)(row) * DM : cin + (size_t)((row) - NLAT) * DM; _Pragma("unroll") for (int j = 0; j < 4; ++j) dst[j] = *(const f32x4*)(s_ + 4 * F.lane + 256 * j); } \
        else { const bf16* s_ = XS + (size_t)(row) * DM; _Pragma("unroll") for (int j = 0; j < 4; ++j) xb[j] = *(const u32x2*)(s_ + 4 * F.lane + 256 * j); } } while (0)
#define N1_LOADY(dst, ps) do { _Pragma("unroll") for (int k = 0; k < 4; ++k) { const unsigned char* yr_ = Y + (size_t)(ps)[k] * DM; _Pragma("unroll") for (int j = 0; j < 4; ++j) dst[k][j] = *(const unsigned*)(yr_ + 4 * F.lane + 256 * j); } } while (0)
#define N1_LOADPS(dst, row) do { const int4 p_ = *(const int4*)(PS + (size_t)(row) * 4); dst[0] = p_.x; dst[1] = p_.y; dst[2] = p_.z; dst[3] = p_.w; } while (0)
    int row = gw;
    if (row < NT) { N1_LOADX(xn, row); if (L > 0) { N1_LOADPS(psn, row); N1_LOADY(yn, psn); if (row + NGW < NT) N1_LOADPS(psn, row + NGW); } }
    while (row < NT) {
        const int nrow = row + NGW; const int bi = row < NLAT ? (row >> 12) : 8;
        f32x4 v[4]; unsigned yc[4][4];
#pragma unroll
        for (int j = 0; j < 4; ++j) { v[j] = (L == 0) ? xn[j] : bf4(xb[j]);
#pragma unroll
            for (int k = 0; k < 4; ++k) yc[k][j] = yn[k][j]; }
        if (nrow < NT) { N1_LOADX(xn, nrow); if (L > 0) { N1_LOADY(yn, psn); if (nrow + NGW < NT) N1_LOADPS(psn, nrow + NGW); } }
        if (L > 0) {
            bf16* xr = XS + (size_t)row * DM; const float* m5 = modp + (size_t)bi * 6144 + 5 * 1024;
#pragma unroll
            for (int j = 0; j < 4; ++j) { f32x4 s = (f32x4){0.f, 0.f, 0.f, 0.f};
#pragma unroll
                for (int k = 0; k < 4; ++k) s += f8x4(yc[k][j]);
                v[j] += *(const f32x4*)(m5 + 4 * F.lane + 256 * j) * (s * (1.f / Y8_SCALE)); if (!dry) { u32x2 w; w.x = pk2(v[j][0], v[j][1]); w.y = pk2(v[j][2], v[j][3]); *(u32x2*)(xr + 4 * F.lane + 256 * j) = w; } }
        }
        float ss = 0.f;
#pragma unroll
        for (int j = 0; j < 4; ++j) ss += v[j][0] * v[j][0] + v[j][1] * v[j][1] + v[j][2] * v[j][2] + v[j][3] * v[j][3];
        const float rs = rsqrtf(wave_sum(ss, F.lane) * (1.f / DM) + 1e-6f);
        const float* sh = mod + (size_t)bi * 6144, *sc = sh + 1024;
        bf16* hr = H + (size_t)row * DM;
#pragma unroll
        for (int j = 0; j < 4; ++j) { const f32x4 s4 = *(const f32x4*)(sc + 4 * F.lane + 256 * j), h4 = *(const f32x4*)(sh + 4 * F.lane + 256 * j);
            const f32x4 o = v[j] * rs * gv[j] * (s4 + 1.f) + h4; u32x2 w; w.x = pk2(o[0], o[1]); w.y = pk2(o[2], o[3]); if (!dry) *(u32x2*)(hr + 4 * F.lane + 256 * j) = w; else if (o[0] == 12345.678f) *(u32x2*)(hr + 4 * F.lane + 256 * j) = w; }
        row = nrow;
    }
#undef N1_LOADX
#undef N1_LOADY
#undef N1_LOADPS
}
__device__ __forceinline__ void p_norm2(Frame& F, CArgs& a, int L, int nrows, int cw = CW_CNT) {
    LAS float* rwt = (LAS float*)F.lds;
    LAS unsigned* lcnt = (LAS unsigned*)(F.lds + 32 * 1024 * 4);
    if (F.tid < 64) lcnt[F.tid] = 0u;
    const float* rw = a.in[I_RW] + (size_t)L * DM * NEXP;
    for (int i = F.tid; i < DM * NEXP; i += NTHR) { const int k = i >> 5, e = i & 31; rwt[e * 1024 + k] = rw[i]; }
    __syncthreads();
    const int gw = F.bid * NWAVES + F.wave, NGW = F.G * NWAVES;
    const bf16* XS = (const bf16*)(F.ws + WS_XS); unsigned char* H8 = (unsigned char*)(F.ws + WS_H8);
    const float* mod = (const float*)(F.ws + WS_MOD) + (size_t)L * 9 * 6144;
    int* PE = (int*)(F.ws + WS_PE); int* PR = (int*)(F.ws + WS_PR); float* PG = (float*)(F.ws + WS_PG);
    unsigned* cnt = F.ctl + cw + L * 64;
    const float* g = a.in[I_NFG] + L * DM;
    const float rb = a.in[I_RB][L * NEXP + (F.lane >> 1)];
    f32x4 gv[4];
#pragma unroll
    for (int j = 0; j < 4; ++j) gv[j] = *(const f32x4*)(g + 4 * F.lane + 256 * j);
    u32x2 xn[4];
    if (gw < nrows) {
#pragma unroll
        for (int j = 0; j < 4; ++j) xn[j] = *(const u32x2*)(XS + (size_t)gw * DM + 4 * F.lane + 256 * j); }
    for (int row = gw; row < nrows; row += NGW) {
        const int bi = row < NLAT ? (row >> 12) : 8;
        f32x4 v[4]; float ss = 0.f;
#pragma unroll
        for (int j = 0; j < 4; ++j) { v[j] = bf4(xn[j]); ss += v[j][0] * v[j][0] + v[j][1] * v[j][1] + v[j][2] * v[j][2] + v[j][3] * v[j][3]; }
        if (row + NGW < nrows) {
#pragma unroll
            for (int j = 0; j < 4; ++j) xn[j] = *(const u32x2*)(XS + (size_t)(row + NGW) * DM + 4 * F.lane + 256 * j); }
        const float rs = rsqrtf(wave_sum(ss, F.lane) * (1.f / DM) + 1e-6f);
        const float* sh = mod + (size_t)bi * 6144 + 3 * 1024, *sc = sh + 1024;
        unsigned char* hr = H8 + (size_t)row * DM;
#pragma unroll
        for (int j = 0; j < 4; ++j) { const f32x4 s4 = *(const f32x4*)(sc + 4 * F.lane + 256 * j), h4 = *(const f32x4*)(sh + 4 * F.lane + 256 * j);
            v[j] = v[j] * rs * gv[j] * (s4 + 1.f) + h4; *(unsigned*)(hr + 4 * F.lane + 256 * j) = pk4f8(v[j][0] * H8_SCALE, v[j][1] * H8_SCALE, v[j][2] * H8_SCALE, v[j][3] * H8_SCALE); }
        float p[32];
#pragma unroll
        for (int e = 0; e < 32; ++e) { float s = 0.f;
            f32x2 s2 = (f32x2){0.f, 0.f};
#pragma unroll
            for (int j = 0; j < 4; ++j) { const f32x4 w4 = *(const LAS f32x4*)(rwt + e * 1024 + 4 * F.lane + 256 * j);
                s2 += (f32x2){v[j][0], v[j][1]} * (f32x2){w4[0], w4[1]}; s2 += (f32x2){v[j][2], v[j][3]} * (f32x2){w4[2], w4[3]}; }
            s = s2.x + s2.y; p[e] = s; if ((e & 3) == 3) asm volatile("" : "+v"(p[e]), "+v"(p[e - 1]), "+v"(p[e - 2]), "+v"(p[e - 3]) :: "memory"); }
#define RED_LEVEL(NKEEP, BIT, XCH) { const bool hi = (F.lane & (BIT)) != 0; _Pragma("unroll") for (int e = 0; e < (NKEEP); ++e) { const float send = hi ? p[e] : p[e + (NKEEP)], keep = hi ? p[e + (NKEEP)] : p[e]; p[e] = keep + XCH; } }
        RED_LEVEL(16, 32, xor32f(send, F.lane)) RED_LEVEL(8, 16, swz_xor<16>(send)) RED_LEVEL(4, 8, swz_xor<8>(send)) RED_LEVEL(2, 4, swz_xor<4>(send)) RED_LEVEL(1, 2, swz_xor<2>(send))
#undef RED_LEVEL
        float logit = p[0] + swz_xor<1>(p[0]) + rb;
        int es[4]; float ls[4];
#pragma unroll
        for (int k = 0; k < 4; ++k) {
            const float m = wave_max(logit, F.lane);
            const unsigned long long bal = __ballot(logit == m);
            const int fl = __builtin_ctzll(bal); es[k] = fl >> 1; ls[k] = m;
            if ((F.lane >> 1) == es[k]) logit = -3.0e38f;
        }
        const float e1 = __expf(ls[1] - ls[0]), e2 = __expf(ls[2] - ls[0]), e3 = __expf(ls[3] - ls[0]); const float inv = 1.f / (1.f + e1 + e2 + e3);
        if (F.lane < 4) {
            const int e = F.lane == 0 ? es[0] : (F.lane == 1 ? es[1] : (F.lane == 2 ? es[2] : es[3]));
            const float gt = (F.lane == 0 ? 1.f : (F.lane == 1 ? e1 : (F.lane == 2 ? e2 : e3))) * inv;
            const unsigned rk = __hip_atomic_fetch_add(lcnt + e, 1u, __ATOMIC_RELAXED, __HIP_MEMORY_SCOPE_WORKGROUP);
            PE[row * 4 + F.lane] = e; PR[row * 4 + F.lane] = (int)rk; PG[row * 4 + F.lane] = gt;
        }
    }
    __syncthreads();
    if (F.tid < 32) lcnt[32 + F.tid] = __hip_atomic_fetch_add(cnt + F.tid, lcnt[F.tid], RLX_AGENT);
    __syncthreads();
    int* TM = (int*)(F.ws + WS_TM);
    for (int row = gw; row < nrows; row += NGW) { if (F.lane < 4) { const int i = row * 4 + F.lane, e = PE[i], rk = PR[i] + (int)lcnt[32 + e]; TM[(size_t)e * NT + rk] = i; } }
    __syncthreads();
}
__device__ __forceinline__ void p_final(Frame& F, CArgs& a) {
    const int gw = F.bid * NWAVES + F.wave, NGW = F.G * NWAVES;
    const bf16* XS = (const bf16*)(F.ws + WS_XS);
    const float* modp = (const float*)(F.ws + WS_MOD) + (size_t)(DEPTH - 1) * 9 * 6144;
    const int* PS = (const int*)(F.ws + WS_PS); const unsigned char* Y = (const unsigned char*)(F.ws + WS_Y);
    const float* g = a.in[I_FING];
    f32x4 gv[4];
#pragma unroll
    for (int j = 0; j < 4; ++j) gv[j] = *(const f32x4*)(g + 4 * F.lane + 256 * j);
    u32x2 xb[4]; unsigned yn[4][4]; int psn[4] = {0, 0, 0, 0};
#define FN_LOADX(row) do { const bf16* s_ = XS + (size_t)(row) * DM; _Pragma("unroll") for (int j = 0; j < 4; ++j) xb[j] = *(const u32x2*)(s_ + 4 * F.lane + 256 * j); } while (0)
#define FN_LOADY(ps) do { _Pragma("unroll") for (int k = 0; k < 4; ++k) { const unsigned char* yr_ = Y + (size_t)(ps)[k] * DM; _Pragma("unroll") for (int j = 0; j < 4; ++j) yn[k][j] = *(const unsigned*)(yr_ + 4 * F.lane + 256 * j); } } while (0)
#define FN_LOADPS(row) do { const int4 p_ = *(const int4*)(PS + (size_t)(row) * 4); psn[0] = p_.x; psn[1] = p_.y; psn[2] = p_.z; psn[3] = p_.w; } while (0)
    int row = gw;
    if (row < NLAT) { FN_LOADX(row); FN_LOADPS(row); FN_LOADY(psn); if (row + NGW < NLAT) FN_LOADPS(row + NGW); }
    while (row < NLAT) {
        const int nrow = row + NGW, bi = row >> 12;
        f32x4 v[4], s[4];
#pragma unroll
        for (int j = 0; j < 4; ++j) { v[j] = bf4(xb[j]); s[j] = (f32x4){0.f, 0.f, 0.f, 0.f};
#pragma unroll
            for (int k = 0; k < 4; ++k) s[j] += f8x4(yn[k][j]);
            s[j] = s[j] * (1.f / Y8_SCALE); }
        if (nrow < NLAT) { FN_LOADX(nrow); FN_LOADY(psn); if (nrow + NGW < NLAT) FN_LOADPS(nrow + NGW); }
        const float* m5 = modp + (size_t)bi * 6144 + 5 * 1024;
        float ss = 0.f;
#pragma unroll
        for (int j = 0; j < 4; ++j) { v[j] += *(const f32x4*)(m5 + 4 * F.lane + 256 * j) * s[j]; ss += v[j][0] * v[j][0] + v[j][1] * v[j][1] + v[j][2] * v[j][2] + v[j][3] * v[j][3]; }
        const float rs = rsqrtf(wave_sum(ss, F.lane) * (1.f / DM) + 1e-6f);
        float* orow = a.out + (size_t)row * DM;
#pragma unroll
        for (int j = 0; j < 4; ++j) *(f32x4*)(orow + 4 * F.lane + 256 * j) = v[j] * rs * gv[j];
        row = nrow;
    }
#undef FN_LOADX
#undef FN_LOADY
#undef FN_LOADPS
}

#ifndef MIX_P1
#define MIX_P1 1
#endif
#define MFMA16(a, b, c) __builtin_amdgcn_mfma_f32_16x16x32_bf16((a), (b), (c), 0, 0, 0)
typedef short v4i16_t __attribute__((ext_vector_type(4)));
__device__ __forceinline__ s16x4 trread(const LAS void* p) { return __builtin_bit_cast(s16x4, __builtin_amdgcn_ds_read_tr16_b64_v4i16((LAS v4i16_t*)p)); }
__device__ __forceinline__ bf16x8 cat8(s16x4 a, s16x4 b) { return __builtin_shufflevector(a, b, 0, 1, 2, 3, 4, 5, 6, 7); }
__device__ __forceinline__ bf16x8 pack8(const float* v) { u32x4 w; w.x = pg8::cvt_pk_bf16(v[0], v[1]); w.y = pg8::cvt_pk_bf16(v[2], v[3]); w.z = pg8::cvt_pk_bf16(v[4], v[5]); w.w = pg8::cvt_pk_bf16(v[6], v[7]); return __builtin_bit_cast(bf16x8, w); }
__device__ __forceinline__ void unpack8(bf16x8 x, float* v) { const u32x4 w = __builtin_bit_cast(u32x4, x); v[0] = bflo(w.x); v[1] = bfhi(w.x); v[2] = bflo(w.y); v[3] = bfhi(w.y); v[4] = bflo(w.z); v[5] = bfhi(w.z); v[6] = bflo(w.w); v[7] = bfhi(w.w); }
#define OPQ(x) ({ int o_ = (x); asm volatile("" : "+s"(o_)); o_; })
#define LAUNDER_F(F0) Frame F = F0; { const int t_ = fresh_tid(F.wave); F.tid = t_; F.lane = t_ & 63; }
__device__ __forceinline__ int chunk_tok0(int cid) { return cid < 512 ? cid * 64 : NLAT + (cid - 512) * 64; }

constexpr int GL_QS = 136, GL_VS = 264, GL_BS = 260;
constexpr int GL_Q = 0, GL_K = GL_Q + 64 * GL_QS * 2, GL_V = GL_K + 64 * GL_QS * 2, GL_A1 = GL_V + 64 * GL_VS * 2, GL_B = GL_A1 + 64 * 32 * 2, GL_END = GL_B + 64 * GL_BS * 4;
static_assert(GL_END <= MISC_OFF, "GLA LDS");
template <int MODE> __device__ __forceinline__ void gla_chunk(Frame& F0, CArgs& a, int L, int cid) {
    constexpr bool OUT = MODE == 1, DO_STATE = MODE == 0 || MODE == 2, DO_INTRA = MODE == 1 || MODE == 2;
    LAUNDER_F(F0)
    const int tok0 = chunk_tok0(cid);
    const bf16* P = (const bf16*)(F.ws + WS_PBUF) + (size_t)tok0 * PW;
    LAS bf16* sq = (LAS bf16*)(F.lds + GL_Q); LAS bf16* sk = (LAS bf16*)(F.lds + GL_K); LAS bf16* sv = (LAS bf16*)(F.lds + GL_V); LAS bf16* sa1 = (LAS bf16*)(F.lds + GL_A1); LAS float* sB = (LAS float*)(F.lds + GL_B);
    __syncthreads();
    u32x4 rgate[4]; bf16x8 sfr[4];
    if constexpr (OUT) {
#pragma unroll
        for (int k = 0; k < 4; ++k) { const int i = F.tid + k * NTHR, t = i >> 5, pc = i & 31; rgate[k] = *(const u32x4*)(P + (size_t)t * PW + PC_R + pc * 8); }
        const bf16* se = (const bf16*)(F.ws + WS_GSE) + (((size_t)cid * 4 + (F.wave & 3)) * 2 + (F.wave >> 2)) * 2048;
#pragma unroll
        for (int d = 0; d < 4; ++d) sfr[d] = *(const bf16x8*)(se + (16 * d + (F.lane & 15)) * 32 + 8 * (F.lane >> 4));
    }
    {   u32x4 rq[2], rk[2], rv[4], ra = (u32x4){0u, 0u, 0u, 0u};
#pragma unroll
        for (int k = 0; k < 2; ++k) { const int i = F.tid + k * NTHR, t = i >> 4, pc = i & 15; rq[k] = *(const u32x4*)(P + (size_t)t * PW + PC_Q + pc * 8); rk[k] = *(const u32x4*)(P + (size_t)t * PW + PC_K + pc * 8); }
#pragma unroll
        for (int k = 0; k < 4; ++k) { const int i = F.tid + k * NTHR, t = i >> 5, pc = i & 31; rv[k] = *(const u32x4*)(P + (size_t)t * PW + PC_V + pc * 8); }
        if (F.tid < 256) { const int t = F.tid >> 2, pc = F.tid & 3; ra = *(const u32x4*)(P + (size_t)t * PW + PC_A1 + pc * 8); }
#pragma unroll
        for (int k = 0; k < 2; ++k) { const int i = F.tid + k * NTHR, t = i >> 4, pc = i & 15; *(LAS u32x4*)(sq + t * GL_QS + pc * 8) = rq[k]; *(LAS u32x4*)(sk + t * GL_QS + pc * 8) = rk[k]; }
#pragma unroll
        for (int k = 0; k < 4; ++k) { const int i = F.tid + k * NTHR, t = i >> 5, pc = i & 31; *(LAS u32x4*)(sv + t * GL_VS + pc * 8) = rv[k]; }
        if (F.tid < 256) { const int t = F.tid >> 2, pc = F.tid & 3; *(LAS u32x4*)(sa1 + t * 32 + pc * 8) = ra; }
    }
    __syncthreads();
    {
        const int col = F.tid & 255, r = col >> 7, c = col & 127, th = F.tid >> 8;
        float a2v[16];
#pragma unroll
        for (int i = 0; i < 16; ++i) a2v[i] = a.in[I_GLAA2][((size_t)(L * 2 + r) * 16 + i) * 128 + c];
        const float ab = a.in[I_GLAAB][(L * 2 + r) * 128 + c];
#pragma unroll 4
        for (int i = 0; i < 32; ++i) { const int t = th * 32 + i; float z = ab; float av[8];
            unpack8(*(const LAS bf16x8*)(sa1 + t * 32 + r * 16), av);
#pragma unroll
            for (int q = 0; q < 8; ++q) z += av[q] * a2v[q];
            unpack8(*(const LAS bf16x8*)(sa1 + t * 32 + r * 16 + 8), av);
#pragma unroll
            for (int q = 0; q < 8; ++q) z += av[q] * a2v[8 + q];
            const float ls = fminf(z, 0.f) - __logf(1.f + __expf(-fabsf(z)));
            sB[t * GL_BS + col] = ls * (1.f / 16.f); }
    }
    __syncthreads();
    if (F.tid < 256) { const int col = F.tid, r = col >> 7; float bv[64];
#pragma unroll
        for (int i = 0; i < 64; ++i) bv[i] = sB[i * GL_BS + col];
        if (r == 0) {
#pragma unroll
            for (int i = 1; i < 64; ++i) bv[i] += bv[i - 1];
        } else {
#pragma unroll
            for (int i = 62; i >= 0; --i) bv[i] += bv[i + 1];
        }
#pragma unroll
        for (int i = 0; i < 64; ++i) sB[i * GL_BS + col] = bv[i]; }
    __syncthreads();
    const int hh = F.wave & 3, r = F.wave >> 2, lr = F.lane & 15, g = F.lane >> 4;
    const int bc = r * 128 + hh * 32;
    const size_t ub = ((size_t)cid * 4 + hh) * 2 + r;
    if constexpr (DO_STATE) {
        const int tl = r ? 0 : 63;
        f32x4 acc[2][4];
#pragma unroll
        for (int mc = 0; mc < 2; ++mc)
#pragma unroll
            for (int d = 0; d < 4; ++d) acc[mc][d] = (f32x4){0.f, 0.f, 0.f, 0.f};
#pragma unroll
        for (int sg = 0; sg < 2; ++sg) {
            bf16x8 vf[4];
#pragma unroll
            for (int d = 0; d < 4; ++d) { const LAS bf16* p0 = sv + (32 * sg + 8 * g + ((F.lane & 15) >> 2)) * GL_VS + hh * 64 + 16 * d + 4 * (F.lane & 3); vf[d] = cat8(trread(p0), trread(p0 + 4 * GL_VS)); }
#pragma unroll
            for (int mc = 0; mc < 2; ++mc) {
                const LAS bf16* p0 = sk + (32 * sg + 8 * g + ((F.lane & 15) >> 2)) * GL_QS + hh * 32 + 16 * mc + 4 * (F.lane & 3);
                const s16x4 k0 = trread(p0), k1 = trread(p0 + 4 * GL_QS);
                const int c = 16 * mc + lr; const float bl = sB[tl * GL_BS + bc + c];
                float kv[8];
#pragma unroll
                for (int e = 0; e < 4; ++e) { kv[e] = bf2f((unsigned short)k0[e]) * __expf(bl - sB[(32 * sg + 8 * g + e) * GL_BS + bc + c]); kv[4 + e] = bf2f((unsigned short)k1[e]) * __expf(bl - sB[(32 * sg + 8 * g + 4 + e) * GL_BS + bc + c]); }
                const bf16x8 kf = pack8(kv);
#pragma unroll
                for (int d = 0; d < 4; ++d) acc[mc][d] = MFMA16(kf, vf[d], acc[mc][d]);
            }
        }
        float* ds = (float*)(F.ws + WS_GDS) + ub * 2048;
#pragma unroll
        for (int mc = 0; mc < 2; ++mc)
#pragma unroll
            for (int d = 0; d < 4; ++d) *(f32x4*)(ds + (16 * d + lr) * 32 + 16 * mc + 4 * g) = acc[mc][d];
        if (F.lane < 32) ((float*)(F.ws + WS_GDEC))[ub * 32 + F.lane] = __expf(sB[tl * GL_BS + bc + F.lane]);
    }
    if constexpr (DO_INTRA) {
        bf16x8 qf[4], kf[4];
#pragma unroll
        for (int m = 0; m < 4; ++m) { const int t = 16 * m + lr; float qv[8], kv[8], bv[8];
            unpack8(*(const LAS bf16x8*)(sq + t * GL_QS + hh * 32 + 8 * g), qv); unpack8(*(const LAS bf16x8*)(sk + t * GL_QS + hh * 32 + 8 * g), kv);
            *(f32x4*)bv = *(const LAS f32x4*)(sB + t * GL_BS + bc + 8 * g); *(f32x4*)(bv + 4) = *(const LAS f32x4*)(sB + t * GL_BS + bc + 8 * g + 4);
#pragma unroll
            for (int e = 0; e < 8; ++e) { const float ex = __expf(bv[e]); qv[e] *= 0.17677669529663687f * ex; kv[e] *= __frcp_rn(ex); }
            qf[m] = pack8(qv); kf[m] = pack8(kv); }
        f32x4 o[4][4];
#pragma unroll
        for (int m = 0; m < 4; ++m)
#pragma unroll
            for (int d = 0; d < 4; ++d) o[m][d] = (f32x4){0.f, 0.f, 0.f, 0.f};
        if constexpr (OUT) {
#pragma unroll
            for (int d = 0; d < 4; ++d) {
#pragma unroll
                for (int m = 0; m < 4; ++m) o[m][d] = MFMA16(qf[m], sfr[d], o[m][d]); }
        }
        bf16x8 vf[2][4];
#pragma unroll
        for (int sg = 0; sg < 2; ++sg)
#pragma unroll
            for (int d = 0; d < 4; ++d) { const LAS bf16* p0 = sv + (32 * sg + 4 * g + ((F.lane & 15) >> 2)) * GL_VS + hh * 64 + 16 * d + 4 * (F.lane & 3); vf[sg][d] = cat8(trread(p0), trread(p0 + 16 * GL_VS)); }
        const f32x4 zero4 = (f32x4){0.f, 0.f, 0.f, 0.f};
#pragma unroll
        for (int m = 0; m < 4; ++m) {
            const int t = 16 * m + lr;
#pragma unroll
            for (int sg = 0; sg < 2; ++sg) {
                f32x4 p0 = MFMA16(kf[2 * sg], qf[m], zero4), p1 = MFMA16(kf[2 * sg + 1], qf[m], zero4);
                float pv[8];
#pragma unroll
                for (int j = 0; j < 4; ++j) { const int s0 = 32 * sg + 4 * g + j, s1 = s0 + 16; pv[j] = (r ? s0 >= t : s0 <= t) ? p0[j] : 0.f; pv[4 + j] = (r ? s1 >= t : s1 <= t) ? p1[j] : 0.f; }
                const bf16x8 pf = pack8(pv);
#pragma unroll
                for (int d = 0; d < 4; ++d) o[m][d] = MFMA16(pf, vf[sg][d], o[m][d]);
            }
        }
        if constexpr (OUT) {
        __syncthreads();
        LAS float* ox = (LAS float*)(F.lds + GL_B);
        LAS bf16* ot = (LAS bf16*)(F.lds + GL_Q);
        LAS bf16* srg = (LAS bf16*)(F.lds + GL_V);
#pragma unroll
        for (int k = 0; k < 4; ++k) { const int i = F.tid + k * NTHR, t = i >> 5, pc = i & 31; *(LAS u32x4*)(srg + t * GL_VS + pc * 8) = rgate[k]; }
        if (r == 1) {
#pragma unroll
            for (int m = 0; m < 4; ++m)
#pragma unroll
                for (int d = 0; d < 4; ++d)
#pragma unroll
                    for (int j = 0; j < 4; ++j) ox[(hh * 64 + 16 * m + 4 * g + j) * 65 + 16 * d + lr] = o[m][d][j];
        }
        __syncthreads();
        if (r == 0) {
            const float* ng = a.in[I_GLANG] + L * 64;
            float gn[4];
#pragma unroll
            for (int d = 0; d < 4; ++d) gn[d] = ng[16 * d + lr];
#pragma unroll
            for (int m = 0; m < 4; ++m)
#pragma unroll
                for (int j = 0; j < 4; ++j) {
                    const int t = 16 * m + 4 * g + j; float v[4], ss = 0.f;
#pragma unroll
                    for (int d = 0; d < 4; ++d) { v[d] = o[m][d][j] + ox[(hh * 64 + t) * 65 + 16 * d + lr]; ss += v[d] * v[d]; }
                    ss += swz_xor<1>(ss); ss += swz_xor<2>(ss); ss += swz_xor<4>(ss); ss += swz_xor<8>(ss);
                    const float rs = rsqrtf(ss * (1.f / 64.f) + 1e-6f);
#pragma unroll
                    for (int d = 0; d < 4; ++d) { const float rg = bf2f(srg[t * GL_VS + hh * 64 + 16 * d + lr]); ot[t * 264 + hh * 64 + 16 * d + lr] = (bf16)f2bf(v[d] * rs * gn[d] * siluf_(rg)); }
                }
        }
        __syncthreads();
        bf16* MX = (bf16*)(F.ws + WS_MIX) + (size_t)tok0 * MW + 768;
        for (int i = F.tid; i < 2048; i += NTHR) { const int t = i >> 5, pc = i & 31; *(u32x4*)(MX + (size_t)t * MW + pc * 8) = *(const LAS u32x4*)(ot + t * 264 + pc * 8); }
        } else {
            bf16* QI = (bf16*)(F.ws + WS_GQI) + (size_t)tok0 * 256;
#pragma unroll
            for (int m = 0; m < 4; ++m) *(bf16x8*)(QI + (size_t)(16 * m + lr) * 256 + r * 128 + hh * 32 + 8 * g) = qf[m];
            __syncthreads();
            LAS float* ox = (LAS float*)(F.lds + GL_B);
            LAS bf16* ot = (LAS bf16*)(F.lds + GL_Q);
            if (r == 1) {
#pragma unroll
                for (int m = 0; m < 4; ++m)
#pragma unroll
                    for (int d = 0; d < 4; ++d)
#pragma unroll
                        for (int j = 0; j < 4; ++j) ox[(hh * 64 + 16 * m + 4 * g + j) * 65 + 16 * d + lr] = o[m][d][j];
            }
            __syncthreads();
            if (r == 0) {
#pragma unroll
                for (int m = 0; m < 4; ++m)
#pragma unroll
                    for (int d = 0; d < 4; ++d)
#pragma unroll
                        for (int j = 0; j < 4; ++j) { const int t = 16 * m + 4 * g + j; ot[t * 264 + hh * 64 + 16 * d + lr] = (bf16)f2bf(o[m][d][j] + ox[(hh * 64 + t) * 65 + 16 * d + lr]); }
            }
            __syncthreads();
            bf16* OI = (bf16*)(F.ws + WS_GOI) + (size_t)tok0 * 256;
            for (int i = F.tid; i < 2048; i += NTHR) { const int t = i >> 5, pc = i & 31; *(u32x4*)(OI + (size_t)t * 256 + pc * 8) = *(const LAS u32x4*)(ot + t * 264 + pc * 8); }
        }
    }
}


__device__ __forceinline__ void gla_light(Frame& F0, CArgs& a, int L, int cid) {
    LAUNDER_F(F0)
    const int tok0 = chunk_tok0(cid), hh = F.wave & 3, r = F.wave >> 2, lr = F.lane & 15, g = F.lane >> 4;
    const bf16* P = (const bf16*)(F.ws + WS_PBUF) + (size_t)tok0 * PW;
    const bf16* QI = (const bf16*)(F.ws + WS_GQI) + (size_t)tok0 * 256; const bf16* OI = (const bf16*)(F.ws + WS_GOI) + (size_t)tok0 * 256;
    const bf16* se = (const bf16*)(F.ws + WS_GSE) + (((size_t)cid * 4 + hh) * 2 + r) * 2048;
    u32x4 rgate[4], roi[4]; bf16x8 qf[4], sfr[4];
#pragma unroll
    for (int m = 0; m < 4; ++m) qf[m] = *(const bf16x8*)(QI + (size_t)(16 * m + lr) * 256 + r * 128 + hh * 32 + 8 * g);
#pragma unroll
    for (int d = 0; d < 4; ++d) sfr[d] = *(const bf16x8*)(se + (16 * d + lr) * 32 + 8 * g);
#pragma unroll
    for (int k = 0; k < 4; ++k) { const int i = F.tid + k * NTHR, t = i >> 5, pc = i & 31; rgate[k] = *(const u32x4*)(P + (size_t)t * PW + PC_R + pc * 8); roi[k] = *(const u32x4*)(OI + (size_t)t * 256 + pc * 8); }
    f32x4 o[4][4];
#pragma unroll
    for (int m = 0; m < 4; ++m)
#pragma unroll
        for (int d = 0; d < 4; ++d) o[m][d] = MFMA16(qf[m], sfr[d], ((f32x4){0.f, 0.f, 0.f, 0.f}));
    LAS float* ox = (LAS float*)(F.lds + GL_B);
    LAS bf16* srg = (LAS bf16*)(F.lds + GL_V);
    LAS bf16* soi = (LAS bf16*)(F.lds + GL_Q);
    __syncthreads();
#pragma unroll
    for (int k = 0; k < 4; ++k) { const int i = F.tid + k * NTHR, t = i >> 5, pc = i & 31; *(LAS u32x4*)(srg + t * GL_VS + pc * 8) = rgate[k]; *(LAS u32x4*)(soi + t * 264 + pc * 8) = roi[k]; }
    if (r == 1) {
#pragma unroll
        for (int m = 0; m < 4; ++m)
#pragma unroll
            for (int d = 0; d < 4; ++d)
#pragma unroll
                for (int j = 0; j < 4; ++j) ox[(hh * 64 + 16 * m + 4 * g + j) * 65 + 16 * d + lr] = o[m][d][j];
    }
    __syncthreads();
    if (r == 0) {
        const float* ng = a.in[I_GLANG] + L * 64;
        float gn[4];
#pragma unroll
        for (int d = 0; d < 4; ++d) gn[d] = ng[16 * d + lr];
#pragma unroll
        for (int m = 0; m < 4; ++m)
#pragma unroll
            for (int j = 0; j < 4; ++j) {
                const int t = 16 * m + 4 * g + j; float v[4], ss = 0.f;
#pragma unroll
                for (int d = 0; d < 4; ++d) { v[d] = o[m][d][j] + ox[(hh * 64 + t) * 65 + 16 * d + lr] + bf2f(soi[t * 264 + hh * 64 + 16 * d + lr]); ss += v[d] * v[d]; }
                ss += swz_xor<1>(ss); ss += swz_xor<2>(ss); ss += swz_xor<4>(ss); ss += swz_xor<8>(ss);
                const float rs = rsqrtf(ss * (1.f / 64.f) + 1e-6f);
#pragma unroll
                for (int d = 0; d < 4; ++d) { const int q = t * GL_VS + hh * 64 + 16 * d + lr; const float rg = bf2f(srg[q]); srg[q] = (bf16)f2bf(v[d] * rs * gn[d] * siluf_(rg)); }
            }
    }
    __syncthreads();
    bf16* MX = (bf16*)(F.ws + WS_MIX) + (size_t)tok0 * MW + 768;
    for (int i = F.tid; i < 2048; i += NTHR) { const int t = i >> 5, pc = i & 31; *(u32x4*)(MX + (size_t)t * MW + pc * 8) = *(const LAS u32x4*)(srg + t * GL_VS + pc * 8); }
}

constexpr int SD_RS = 520;
constexpr int SD_RAW = 0, SD_XC = SD_RAW + 68 * SD_RS * 2, SD_DT = SD_XC + 64 * SD_RS * 2, SD_CUM = SD_DT + 64 * 8 * 4, SD_W = SD_CUM + 8 * 64 * 4, SD_END = SD_W + 8 * 64 * 4;
static_assert(SD_END <= MISC_OFF && 64 * 260 * 4 <= 68 * SD_RS * 2, "SSD LDS");
template <int MODE> __device__ __forceinline__ void ssd_chunk(Frame& F0, CArgs& a, int L, int cid) {
    constexpr bool OUT = MODE == 1, DO_STATE = MODE == 0 || MODE == 2, DO_INTRA = MODE == 1 || MODE == 2;
    LAUNDER_F(F0)
    const int tok0 = chunk_tok0(cid);
    const bf16* PB = (const bf16*)(F.ws + WS_PBUF);
    LAS bf16* raw = (LAS bf16*)(F.lds + SD_RAW); LAS bf16* xc = (LAS bf16*)(F.lds + SD_XC); LAS float* sdt = (LAS float*)(F.lds + SD_DT); LAS float* scum = (LAS float*)(F.lds + SD_CUM); LAS float* sw = (LAS float*)(F.lds + SD_W);
    bf16x8 sfr[4][2];
    if constexpr (OUT) { const bf16* se = (const bf16*)(F.ws + WS_SSE) + (((size_t)cid * 4 + (F.wave & 3)) * 2 + (F.wave >> 2)) * 4096;
#pragma unroll
        for (int d = 0; d < 4; ++d) { sfr[d][0] = *(const bf16x8*)(se + (16 * d + (F.lane & 15)) * 64 + 8 * (F.lane >> 4)); sfr[d][1] = *(const bf16x8*)(se + (16 * d + (F.lane & 15)) * 64 + 32 + 8 * (F.lane >> 4)); } }
    __syncthreads();
    {
        const int isctx = cid >= 512, c4 = (cid - 512) & 3;
        u32x4 rv[9];
#pragma unroll
        for (int k = 0; k < 9; ++k) { const int i = F.tid + k * NTHR, rr = i >> 6, pc = i & 63, t = rr - 2; rv[k] = (u32x4){0u, 0u, 0u, 0u};
            bool ok = t >= 0 && t < 64 && i < 68 * 64; if (isctx) { const int tt = c4 * 64 + t; ok = tt >= 0 && tt < 256 && i < 68 * 64; }
            if (ok) rv[k] = *(const u32x4*)(PB + (size_t)(tok0 + t) * PW + PC_XBC + pc * 8); }
#pragma unroll
        for (int k = 0; k < 9; ++k) { const int i = F.tid + k * NTHR, rr = i >> 6, pc = i & 63; if (i < 68 * 64) *(LAS u32x4*)(raw + rr * SD_RS + pc * 8) = rv[k]; }
        if (F.tid < 64) { float dv[8]; unpack8(*(const bf16x8*)(PB + (size_t)(tok0 + F.tid) * PW + PC_DT), dv);
#pragma unroll
            for (int q = 0; q < 8; ++q) { const float z = dv[q] + a.in[I_SSDDTB][L * 8 + q]; sdt[F.tid * 8 + q] = z > 20.f ? z : __logf(1.f + __expf(z)); } }
    }
    __syncthreads();
    {
        const int ch = F.tid; float w[5];
#pragma unroll
        for (int k = 0; k < 5; ++k) w[k] = a.in[I_SSDCW][((size_t)L * 5 + k) * 512 + ch];
        const float cb = a.in[I_SSDCB][L * 512 + ch];
        float x0 = bf2f(raw[0 * SD_RS + ch]), x1 = bf2f(raw[1 * SD_RS + ch]), x2 = bf2f(raw[2 * SD_RS + ch]), x3 = bf2f(raw[3 * SD_RS + ch]);
        for (int t0 = 0; t0 < 64; t0 += 16) { float xv[16];
#pragma unroll
            for (int k = 0; k < 16; ++k) xv[k] = bf2f(raw[(t0 + k + 4) * SD_RS + ch]);
#pragma unroll
            for (int k = 0; k < 16; ++k) { const float x4 = xv[k]; const float y = cb + w[0] * x0 + w[1] * x1 + w[2] * x2 + w[3] * x3 + w[4] * x4;
                xc[(t0 + k) * SD_RS + ch] = (bf16)f2bf(siluf_(y)); x0 = x1; x1 = x2; x2 = x3; x3 = x4; } }
    }
    {
        const int q = F.wave, rr = q >> 2, t = rr ? 63 - F.lane : F.lane;
        const float aa = -__expf(a.in[I_SSDALOG][L * 8 + q]); const float dtv = sdt[t * 8 + q];
        float c = dtv * aa;
        { float o;
          o = __builtin_bit_cast(float, __builtin_amdgcn_ds_bpermute((F.lane - 1) << 2, __builtin_bit_cast(int, c))); if (F.lane >= 1) c += o;
          o = __builtin_bit_cast(float, __builtin_amdgcn_ds_bpermute((F.lane - 2) << 2, __builtin_bit_cast(int, c))); if (F.lane >= 2) c += o;
          o = __builtin_bit_cast(float, __builtin_amdgcn_ds_bpermute((F.lane - 4) << 2, __builtin_bit_cast(int, c))); if (F.lane >= 4) c += o;
          o = __builtin_bit_cast(float, __builtin_amdgcn_ds_bpermute((F.lane - 8) << 2, __builtin_bit_cast(int, c))); if (F.lane >= 8) c += o;
          o = __builtin_bit_cast(float, __builtin_amdgcn_ds_bpermute((F.lane - 16) << 2, __builtin_bit_cast(int, c))); if (F.lane >= 16) c += o;
          o = __builtin_bit_cast(float, __builtin_amdgcn_ds_bpermute((F.lane - 32) << 2, __builtin_bit_cast(int, c))); if (F.lane >= 32) c += o; }
        const float cl = __builtin_bit_cast(float, __builtin_amdgcn_ds_bpermute(63 << 2, __builtin_bit_cast(int, c)));
        scum[q * 64 + t] = c; sw[q * 64 + t] = __expf(cl - c) * dtv;
    }
    __syncthreads();
    const int h = F.wave & 3, r = F.wave >> 2, lr = F.lane & 15, g = F.lane >> 4, gp = h >> 1, rh = r * 4 + h;
    const size_t ub = ((size_t)cid * 4 + h) * 2 + r;
    if constexpr (DO_STATE) {
        f32x4 acc[4][4];
#pragma unroll
        for (int ms = 0; ms < 4; ++ms)
#pragma unroll
            for (int d = 0; d < 4; ++d) acc[ms][d] = (f32x4){0.f, 0.f, 0.f, 0.f};
#pragma unroll
        for (int sg = 0; sg < 2; ++sg) {
            const int trow = 32 * sg + 8 * g;
            bf16x8 xf[4];
#pragma unroll
            for (int d = 0; d < 4; ++d) { const LAS bf16* p0 = xc + (trow + ((F.lane & 15) >> 2)) * SD_RS + h * 64 + 16 * d + 4 * (F.lane & 3); xf[d] = cat8(trread(p0), trread(p0 + 4 * SD_RS)); }
            float wv[8];
            *(f32x4*)wv = *(const LAS f32x4*)(sw + rh * 64 + trow); *(f32x4*)(wv + 4) = *(const LAS f32x4*)(sw + rh * 64 + trow + 4);
#pragma unroll
            for (int ms = 0; ms < 4; ++ms) {
                const LAS bf16* p0 = xc + (trow + ((F.lane & 15) >> 2)) * SD_RS + 256 + gp * 64 + 16 * ms + 4 * (F.lane & 3);
                const s16x4 b0 = trread(p0), b1 = trread(p0 + 4 * SD_RS);
                float bv[8];
#pragma unroll
                for (int e = 0; e < 4; ++e) { bv[e] = bf2f((unsigned short)b0[e]) * wv[e]; bv[4 + e] = bf2f((unsigned short)b1[e]) * wv[4 + e]; }
                const bf16x8 bf = pack8(bv);
#pragma unroll
                for (int d = 0; d < 4; ++d) acc[ms][d] = MFMA16(bf, xf[d], acc[ms][d]);
            }
        }
        float* ds = (float*)(F.ws + WS_SDS) + ub * 4096;
#pragma unroll
        for (int ms = 0; ms < 4; ++ms)
#pragma unroll
            for (int d = 0; d < 4; ++d) *(f32x4*)(ds + (16 * d + lr) * 64 + 16 * ms + 4 * g) = acc[ms][d];
        if (F.lane == 0) ((float*)(F.ws + WS_SDEC))[ub] = __expf(scum[rh * 64 + (r ? 0 : 63)]);
    }
    if constexpr (DO_INTRA) {
        bf16x8 bfr[4][2], cfr[4][2];
#pragma unroll
        for (int m = 0; m < 4; ++m)
#pragma unroll
            for (int ks = 0; ks < 2; ++ks) { bfr[m][ks] = *(const LAS bf16x8*)(xc + (16 * m + lr) * SD_RS + 256 + gp * 64 + 32 * ks + 8 * g); cfr[m][ks] = *(const LAS bf16x8*)(xc + (16 * m + lr) * SD_RS + 384 + gp * 64 + 32 * ks + 8 * g); }
        f32x4 y[4][4];
#pragma unroll
        for (int m = 0; m < 4; ++m)
#pragma unroll
            for (int d = 0; d < 4; ++d) y[m][d] = (f32x4){0.f, 0.f, 0.f, 0.f};
        if constexpr (OUT) {
            bf16x8 cs[4][2];
#pragma unroll
            for (int m = 0; m < 4; ++m) { const float ec = __expf(scum[rh * 64 + 16 * m + lr]);
#pragma unroll
                for (int ks = 0; ks < 2; ++ks) { float cv[8]; unpack8(cfr[m][ks], cv);
#pragma unroll
                    for (int e = 0; e < 8; ++e) cv[e] *= ec;
                    cs[m][ks] = pack8(cv); } }
#pragma unroll
            for (int d = 0; d < 4; ++d) {
#pragma unroll
                for (int m = 0; m < 4; ++m) { y[m][d] = MFMA16(cs[m][0], sfr[d][0], y[m][d]); y[m][d] = MFMA16(cs[m][1], sfr[d][1], y[m][d]); }
            }
        }
        asm volatile("" ::: "memory");
        bf16x8 xf[2][4];
#pragma unroll
        for (int sg = 0; sg < 2; ++sg)
#pragma unroll
            for (int d = 0; d < 4; ++d) { const LAS bf16* p0 = xc + (32 * sg + 4 * g + ((F.lane & 15) >> 2)) * SD_RS + h * 64 + 16 * d + 4 * (F.lane & 3); xf[sg][d] = cat8(trread(p0), trread(p0 + 16 * SD_RS)); }
        const f32x4 zero4 = (f32x4){0.f, 0.f, 0.f, 0.f};
#pragma unroll
        for (int m = 0; m < 4; ++m) {
            const int t = 16 * m + lr; const float ct = scum[rh * 64 + t];
#pragma unroll
            for (int sg = 0; sg < 2; ++sg) {
                f32x4 p0 = MFMA16(bfr[2 * sg][0], cfr[m][0], zero4), p1 = MFMA16(bfr[2 * sg + 1][0], cfr[m][0], zero4);
                p0 = MFMA16(bfr[2 * sg][1], cfr[m][1], p0); p1 = MFMA16(bfr[2 * sg + 1][1], cfr[m][1], p1);
                float pv[8];
#pragma unroll
                for (int j = 0; j < 4; ++j) { const int s0 = 32 * sg + 4 * g + j, s1 = s0 + 16;
                    pv[j] = (r ? s0 >= t : s0 <= t) ? p0[j] * __expf(ct - scum[rh * 64 + s0]) * sdt[s0 * 8 + rh] : 0.f;
                    pv[4 + j] = (r ? s1 >= t : s1 <= t) ? p1[j] * __expf(ct - scum[rh * 64 + s1]) * sdt[s1 * 8 + rh] : 0.f; }
                const bf16x8 pf = pack8(pv);
#pragma unroll
                for (int d = 0; d < 4; ++d) y[m][d] = MFMA16(pf, xf[sg][d], y[m][d]);
            }
        }
        __syncthreads();
        LAS float* yx = (LAS float*)(F.lds + SD_RAW);
        if (r == 1) {
#pragma unroll
            for (int m = 0; m < 4; ++m)
#pragma unroll
                for (int d = 0; d < 4; ++d)
#pragma unroll
                    for (int j = 0; j < 4; ++j) yx[(16 * m + 4 * g + j) * 260 + h * 64 + 16 * d + lr] = y[m][d][j];
        }
        __syncthreads();
        if (r == 0) { const float dsk = a.in[I_SSDD][L * 4 + h];
#pragma unroll
            for (int m = 0; m < 4; ++m)
#pragma unroll
                for (int d = 0; d < 4; ++d)
#pragma unroll
                    for (int j = 0; j < 4; ++j) { const int t = 16 * m + 4 * g + j, c = h * 64 + 16 * d + lr; yx[t * 260 + c] += y[m][d][j] + dsk * bf2f(xc[t * SD_RS + c]); asm volatile("" ::: "memory"); }
        }
        __syncthreads();
        if constexpr (OUT) {
        { const int t = F.tid >> 3, c0 = (F.tid & 7) * 32; const bf16* zr = PB + (size_t)(tok0 + t) * PW + PC_Z + c0; const float* ng = a.in[I_SSDNG] + L * 256 + c0;
          float v[32]; float ss = 0.f;
#pragma unroll
          for (int q = 0; q < 4; ++q) { float zv[8]; unpack8(*(const bf16x8*)(zr + 8 * q), zv);
#pragma unroll
              for (int e = 0; e < 8; ++e) { const float u = yx[t * 260 + c0 + 8 * q + e] * siluf_(zv[e]); v[8 * q + e] = u; ss += u * u; } }
          ss += swz_xor<1>(ss); ss += swz_xor<2>(ss); ss += swz_xor<4>(ss);
          const float rs = rsqrtf(ss * (1.f / 256.f) + 1e-6f);
          bf16* MX = (bf16*)(F.ws + WS_MIX) + (size_t)(tok0 + t) * MW + 1024 + c0;
#pragma unroll
          for (int q = 0; q < 4; ++q) { float o8[8];
#pragma unroll
              for (int e = 0; e < 8; ++e) o8[e] = v[8 * q + e] * rs * ng[8 * q + e];
              *(bf16x8*)(MX + 8 * q) = pack8(o8); } }
        } else {
            { const int t = F.tid >> 3, c0 = (F.tid & 7) * 32; bf16* yo = (bf16*)(F.ws + WS_SYI) + (size_t)(tok0 + t) * 256 + c0;
#pragma unroll
              for (int q = 0; q < 4; ++q) { float o8[8];
#pragma unroll
                  for (int e = 0; e < 8; ++e) o8[e] = yx[t * 260 + c0 + 8 * q + e];
                  *(bf16x8*)(yo + 8 * q) = pack8(o8); } }
            { bf16* cb = (bf16*)(F.ws + WS_SCB) + (size_t)tok0 * 128;
#pragma unroll
              for (int k = 0; k < 2; ++k) { const int i = F.tid + k * NTHR, t = i >> 4, pc = i & 15; *(u32x4*)(cb + (size_t)t * 128 + pc * 8) = *(const LAS u32x4*)(xc + t * SD_RS + 384 + pc * 8); } }
            { const int t = F.tid >> 3, q = F.tid & 7; ((float*)(F.ws + WS_SCUM))[(size_t)(tok0 + t) * 8 + q] = scum[q * 64 + t]; }
        }
    }
}


__device__ __forceinline__ void ssd_light(Frame& F0, CArgs& a, int L, int cid) {
    LAUNDER_F(F0)
    const int tok0 = chunk_tok0(cid), h = F.wave & 3, r = F.wave >> 2, lr = F.lane & 15, g = F.lane >> 4, gp = h >> 1, rh = r * 4 + h;
    const bf16* cb = (const bf16*)(F.ws + WS_SCB) + (size_t)tok0 * 128; const float* cum = (const float*)(F.ws + WS_SCUM) + (size_t)tok0 * 8;
    const bf16* se = (const bf16*)(F.ws + WS_SSE) + (((size_t)cid * 4 + h) * 2 + r) * 4096;
    bf16x8 cfr[4][2], sfr[4][2]; float ec[4];
#pragma unroll
    for (int m = 0; m < 4; ++m) { ec[m] = cum[(size_t)(16 * m + lr) * 8 + rh];
#pragma unroll
        for (int ks = 0; ks < 2; ++ks) cfr[m][ks] = *(const bf16x8*)(cb + (size_t)(16 * m + lr) * 128 + gp * 64 + 32 * ks + 8 * g); }
#pragma unroll
    for (int d = 0; d < 4; ++d) { sfr[d][0] = *(const bf16x8*)(se + (16 * d + lr) * 64 + 8 * g); sfr[d][1] = *(const bf16x8*)(se + (16 * d + lr) * 64 + 32 + 8 * g); }
    const int tt = F.tid >> 3, c0 = (F.tid & 7) * 32;
    bf16x8 zr[4], yi[4];
    { const bf16* zp = (const bf16*)(F.ws + WS_PBUF) + (size_t)(tok0 + tt) * PW + PC_Z + c0; const bf16* yp = (const bf16*)(F.ws + WS_SYI) + (size_t)(tok0 + tt) * 256 + c0;
#pragma unroll
      for (int q = 0; q < 4; ++q) { zr[q] = *(const bf16x8*)(zp + 8 * q); yi[q] = *(const bf16x8*)(yp + 8 * q); } }
    f32x4 y[4][4];
#pragma unroll
    for (int m = 0; m < 4; ++m) { const float e_ = __expf(ec[m]); bf16x8 cs[2];
#pragma unroll
        for (int ks = 0; ks < 2; ++ks) { float cv[8]; unpack8(cfr[m][ks], cv);
#pragma unroll
            for (int e = 0; e < 8; ++e) cv[e] *= e_;
            cs[ks] = pack8(cv); }
#pragma unroll
        for (int d = 0; d < 4; ++d) { y[m][d] = MFMA16(cs[0], sfr[d][0], ((f32x4){0.f, 0.f, 0.f, 0.f})); y[m][d] = MFMA16(cs[1], sfr[d][1], y[m][d]); } }
    LAS float* yx = (LAS float*)(F.lds + SD_RAW);
    __syncthreads();
    if (r == 1) {
#pragma unroll
        for (int m = 0; m < 4; ++m)
#pragma unroll
            for (int d = 0; d < 4; ++d)
#pragma unroll
                for (int j = 0; j < 4; ++j) yx[(16 * m + 4 * g + j) * 260 + h * 64 + 16 * d + lr] = y[m][d][j];
    }
    __syncthreads();
    if (r == 0) {
#pragma unroll
        for (int m = 0; m < 4; ++m)
#pragma unroll
            for (int d = 0; d < 4; ++d)
#pragma unroll
                for (int j = 0; j < 4; ++j) yx[(16 * m + 4 * g + j) * 260 + h * 64 + 16 * d + lr] += y[m][d][j];
    }
    __syncthreads();
    { const float* ng = a.in[I_SSDNG] + L * 256 + c0;
      float v[32]; float ss = 0.f;
#pragma unroll
      for (int q = 0; q < 4; ++q) { float zv[8], yv[8]; unpack8(zr[q], zv); unpack8(yi[q], yv);
#pragma unroll
          for (int e = 0; e < 8; ++e) { const float u = (yx[tt * 260 + c0 + 8 * q + e] + yv[e]) * siluf_(zv[e]); v[8 * q + e] = u; ss += u * u; } }
      ss += swz_xor<1>(ss); ss += swz_xor<2>(ss); ss += swz_xor<4>(ss);
      const float rs = rsqrtf(ss * (1.f / 256.f) + 1e-6f);
      bf16* MX = (bf16*)(F.ws + WS_MIX) + (size_t)(tok0 + tt) * MW + 1024 + c0;
#pragma unroll
      for (int q = 0; q < 4; ++q) { float o8[8];
#pragma unroll
          for (int e = 0; e < 8; ++e) o8[e] = v[8 * q + e] * rs * ng[8 * q + e];
          *(bf16x8*)(MX + 8 * q) = pack8(o8); } }
}

constexpr int FF_XP = 0, FF_TR = FF_XP + 16 * 64 * 16 * 2, FF_TI = FF_TR + 16 * 64 * 16 * 2, FF_END = FF_TI + 16 * 64 * 16 * 2;
__device__ __forceinline__ void fft_unit(Frame& F0, int u) {
    LAUNDER_F(F0)
    const int b = u >> 6, cg = (u >> 2) & 15, kb = u & 3, lr = F.lane & 15, g = F.lane >> 4;
    const bf16* PB = (const bf16*)(F.ws + WS_PBUF) + (size_t)b * SEQ * PW + PC_FU + 16 * cg;
    const bf16* f64 = (const bf16*)(F.ws + WS_TAB + TAB_F64); const float* tw = (const float*)(F.ws + WS_TAB + TAB_TW);
    LAS bf16* xp = (LAS bf16*)(F.lds + FF_XP); LAS bf16* tr = (LAS bf16*)(F.lds + FF_TR); LAS bf16* ti = (LAS bf16*)(F.lds + FF_TI);
    bf16x8 fc1[2], fs1[2];
#pragma unroll
    for (int ks = 0; ks < 2; ++ks) { fc1[ks] = *(const bf16x8*)(f64 + (16 * kb + lr) * 64 + 32 * ks + 8 * g); fs1[ks] = *(const bf16x8*)(f64 + 4096 + (16 * kb + lr) * 64 + 32 * ks + 8 * g); }
    const f32x4 zero4 = (f32x4){0.f, 0.f, 0.f, 0.f};
    u32x4 xr[4];
#pragma unroll
    for (int k = 0; k < 4; ++k) { const int i = F.tid + k * NTHR, n2l = i >> 7, n1 = (i >> 1) & 63, hf = i & 1; xr[k] = *(const u32x4*)(PB + (size_t)(64 * n1 + n2l) * PW + hf * 8); }
    for (int pa = 0; pa < 4; ++pa) {
        __syncthreads();
#pragma unroll
        for (int k = 0; k < 4; ++k) { const int i = F.tid + k * NTHR, n2l = i >> 7, n1 = (i >> 1) & 63, hf = i & 1; *(LAS u32x4*)(xp + (n2l * 64 + n1) * 16 + hf * 8) = xr[k]; }
        if (pa < 3) {
#pragma unroll
            for (int k = 0; k < 4; ++k) { const int i = F.tid + k * NTHR, n2l = i >> 7, n1 = (i >> 1) & 63, hf = i & 1; xr[k] = *(const u32x4*)(PB + (size_t)(64 * n1 + 16 * (pa + 1) + n2l) * PW + hf * 8); }
        }
        __syncthreads();
#pragma unroll
        for (int q = 0; q < 2; ++q) {
            const int n2l = 2 * F.wave + q, n2 = 16 * pa + n2l;
            f32x4 tc = zero4, ts = zero4;
#pragma unroll
            for (int ks = 0; ks < 2; ++ks) { const LAS bf16* p0 = xp + (n2l * 64 + 32 * ks + 8 * g + ((F.lane & 15) >> 2)) * 16 + 4 * (F.lane & 3); const bf16x8 xb = cat8(trread(p0), trread(p0 + 4 * 16));
                tc = MFMA16(fc1[ks], xb, tc); ts = MFMA16(fs1[ks], xb, ts); }
#pragma unroll
            for (int j = 0; j < 4; ++j) { const int k1l = 4 * g + j, k1 = 16 * kb + k1l; const f32x2 w = *(const f32x2*)(tw + 2 * (n2 * k1));
                tr[(k1l * 64 + n2) * 16 + lr] = (bf16)f2bf(tc[j] * w[0] - ts[j] * w[1]); ti[(k1l * 64 + n2) * 16 + lr] = (bf16)f2bf(-(tc[j] * w[1] + ts[j] * w[0])); }
        }
    }
    __syncthreads();
    bf16* MX = (bf16*)(F.ws + WS_MIX) + (size_t)b * SEQ * MW + 16 * cg + lr;
#pragma unroll
    for (int q = 0; q < 2; ++q) {
        const int k1l = 2 * F.wave + q, k1 = 16 * kb + k1l;
        bf16x8 br[2], bi[2];
#pragma unroll
        for (int ks = 0; ks < 2; ++ks) { const int off = (k1l * 64 + 32 * ks + 8 * g + ((F.lane & 15) >> 2)) * 16 + 4 * (F.lane & 3); br[ks] = cat8(trread(tr + off), trread(tr + off + 64)); bi[ks] = cat8(trread(ti + off), trread(ti + off + 64)); }
#pragma unroll
        for (int m = 0; m < 4; ++m) {
            f32x4 yr = zero4, y1 = zero4, y2 = zero4;
#pragma unroll
            for (int ks = 0; ks < 2; ++ks) { const bf16x8 fc = *(const bf16x8*)(f64 + (16 * m + lr) * 64 + 32 * ks + 8 * g), fs = *(const bf16x8*)(f64 + 4096 + (16 * m + lr) * 64 + 32 * ks + 8 * g);
                yr = MFMA16(fc, br[ks], yr); yr = MFMA16(fs, bi[ks], yr); y1 = MFMA16(fc, bi[ks], y1); y2 = MFMA16(fs, br[ks], y2); }
#pragma unroll
            for (int j = 0; j < 4; ++j) { const int k2 = 16 * m + 4 * g + j; bf16* o = MX + (size_t)(64 * k2 + k1) * MW; o[0] = (bf16)f2bf(yr[j] * (1.f / 64.f)); o[256] = (bf16)f2bf((y1[j] - y2[j]) * (1.f / 64.f)); }
        }
    }
}
__device__ __forceinline__ void dft_ctx_unit(Frame& F0, int u) {
    LAUNDER_F(F0)
    const int b = u >> 5, kblk = u & 31;
    LAS bf16* sl = (LAS bf16*)F.lds;
    const bf16* PB = (const bf16*)(F.ws + WS_PBUF) + (size_t)(NLAT + b * CTXL) * PW + PC_FU;
    __syncthreads();
#pragma unroll
    for (int h = 0; h < 2; ++h) { u32x4 v[8];
#pragma unroll
        for (int k = 0; k < 8; ++k) { const int i = F.tid + (h * 8 + k) * NTHR, n = i >> 5, pc = i & 31; v[k] = *(const u32x4*)(PB + (size_t)n * PW + pc * 8); }
#pragma unroll
        for (int k = 0; k < 8; ++k) { const int i = F.tid + (h * 8 + k) * NTHR, n = i >> 5, pc = i & 31; *(LAS u32x4*)(sl + n * 256 + pc * 8) = v[k]; } }
    __syncthreads();
    const int c = F.tid & 255, k0 = kblk * 8 + (F.tid >> 8) * 4;
    const float* d256 = (const float*)(F.ws + WS_TAB + TAB_D256);
    float wr[4], wi[4], sr[4], si[4], ar[4], ai[4];
#pragma unroll
    for (int i = 0; i < 4; ++i) { sr[i] = d256[2 * (k0 + i)]; si[i] = -d256[2 * (k0 + i) + 1]; wr[i] = 1.f; wi[i] = 0.f; ar[i] = 0.f; ai[i] = 0.f; }
#pragma unroll 4
    for (int n = 0; n < 256; ++n) { const float uv = bf2f(sl[n * 256 + c]);
#pragma unroll
        for (int i = 0; i < 4; ++i) { ar[i] += uv * wr[i]; ai[i] += uv * wi[i]; const float nr = wr[i] * sr[i] - wi[i] * si[i], ni = wr[i] * si[i] + wi[i] * sr[i]; wr[i] = nr; wi[i] = ni; } }
    bf16* MX = (bf16*)(F.ws + WS_MIX) + (size_t)(NLAT + b * CTXL + k0) * MW + c;
#pragma unroll
    for (int i = 0; i < 4; ++i) { MX[(size_t)i * MW] = (bf16)f2bf(ar[i] * (1.f / 16.f)); MX[(size_t)i * MW + 256] = (bf16)f2bf(ai[i] * (1.f / 16.f)); }
}

#ifndef SUBMASK
#define SUBMASK 0xFFFF
#endif
#define SUB(bit) (rep == 0 || ((SUBMASK >> (bit)) & 1))
__device__ __forceinline__ void p_mix_a(Frame& F, CArgs& a, int L, int rep = 0) {
    if (SUB(0)) {
        pg8::Gemm g{(const bf16*)(F.ws + WS_A2), (const bf16*)(F.ws + WS_S5P) + (size_t)L * 16 * 256 * 256, 1024, 512, OPQ(256)};
        SgOrder<FillS5> S; S.init(144, 1, F.G, F.bid); S.f = FillS5{(size_t)256 * 256 * 2};
        EpiS5S E{(float*)(F.ws + WS_S5S)};
        pg8::gemm_phase(F.lds, g, S, E, fresh_tid(F.wave));
    }
    const int og = F.G >= 208 ? 144 : 0, os = F.G >= 208 ? 176 : 32 % F.G;
    if (SUB(1)) for (int u = (F.bid + F.G - og) % F.G; u < NCHK; u += F.G) gla_chunk<MIX_P1 ? 2 : 0>(F, a, L, u);
    if (SUB(2)) for (int u = (F.bid + F.G - os) % F.G; u < NCHK; u += F.G) ssd_chunk<MIX_P1 ? 2 : 0>(F, a, L, u);
    __syncthreads();
}
__device__ __forceinline__ void p_mix_b(Frame& F, CArgs& a, int L, int rep = 0) {
    if (SUB(3)) for (int u = F.bid; u < 256; u += F.G) {
        const int vz = F.tid >> 9, uv = u + vz, wv = (F.tid >> 6);
        const int b = uv >> 5, g = (uv >> 1) & 15, r = uv & 1;
        const f32x2 a16 = *(const f32x2*)((const float*)(F.ws + WS_A16) + ((size_t)((L * 2 + r) * 16 + g) * 64 + F.lane) * 2);
        const float* S = (const float*)(F.ws + WS_S5S) + (size_t)g * S5ROWS * 256 + r * 128 + F.lane; bf16* A2 = (bf16*)(F.ws + WS_A2) + (size_t)g * S5ROWS * 512 + 256 + r * 128 + F.lane;
        LAS float* ex = (LAS float*)F.lds;
        LAS float* sl = ex + 17 * 128;
        __syncthreads();
#pragma unroll 1
        for (int sg = wv; sg < 17; sg += 8) {
            float sr[16], si[16];
#pragma unroll
            for (int n = 0; n < 16; ++n) { const int i = 16 * sg + n; const int row = i < 16 ? 2048 + 16 * b + (r ? 15 - i : i) : 256 * b + (r ? 271 - i : i - 16); sr[n] = S[(size_t)row * 256]; si[n] = S[(size_t)row * 256 + 64]; }
            float hr = 0.f, hi = 0.f;
#pragma unroll
            for (int n = 0; n < 16; ++n) { sl[((16 * sg + n) * 64 + F.lane) * 2] = sr[n]; sl[((16 * sg + n) * 64 + F.lane) * 2 + 1] = si[n];
                const float nr = a16[0] * hr - a16[1] * hi + sr[n], ni = a16[0] * hi + a16[1] * hr + si[n]; hr = nr; hi = ni; }
            ex[(sg * 64 + F.lane) * 2] = hr; ex[(sg * 64 + F.lane) * 2 + 1] = hi;
        }
        __syncthreads();
        float pr = a16[0], pi = a16[1];
#pragma unroll
        for (int q = 0; q < 4; ++q) { const float nr = pr * pr - pi * pi, ni = 2.f * pr * pi; pr = nr; pi = ni; }
#pragma unroll 1
        for (int sg = wv; sg < 17; sg += 8) {
            float hr = 0.f, hi = 0.f;
            for (int j = 0; j < sg; ++j) { const float er = ex[(j * 64 + F.lane) * 2], ei = ex[(j * 64 + F.lane) * 2 + 1]; const float nr = pr * hr - pi * hi + er, ni = pr * hi + pi * hr + ei; hr = nr; hi = ni; }
#pragma unroll 4
            for (int n = 0; n < 16; ++n) { const int i = 16 * sg + n; const int row = i < 16 ? 2048 + 16 * b + (r ? 15 - i : i) : 256 * b + (r ? 271 - i : i - 16);
                A2[(size_t)row * 512] = (bf16)f2bf(hr); A2[(size_t)row * 512 + 64] = (bf16)f2bf(hi);
                const float xr_ = sl[(i * 64 + F.lane) * 2], xi_ = sl[(i * 64 + F.lane) * 2 + 1];
                const float nr = a16[0] * hr - a16[1] * hi + xr_, ni = a16[0] * hi + a16[1] * hr + xi_; hr = nr; hi = ni; }
        }
    }
    if (SUB(3)) for (int u = F.bid; u < 256; u += F.G) { const int uv = u + (F.tid >> 9), sq = uv >> 2, b = sq >> 3, hh = (sq >> 1) & 3, r = sq & 1, e = (uv & 3) * 512 + F.tid, c = e & 31;
        const float* ds = (const float*)(F.ws + WS_GDS); const float* dc = (const float*)(F.ws + WS_GDEC); bf16* se = (bf16*)(F.ws + WS_GSE);
        float s = 0.f;
        for (int i0 = 0; i0 < 68; i0 += 17) { float dv[17], cv[17];
#pragma unroll
            for (int k = 0; k < 17; ++k) { const int i = i0 + k; const int cid = i < 4 ? 512 + b * 4 + (r ? 3 - i : i) : b * 64 + (r ? 67 - i : i - 4); const size_t ub = ((size_t)cid * 4 + hh) * 2 + r; dv[k] = ds[ub * 2048 + e]; cv[k] = dc[ub * 32 + c]; }
#pragma unroll
            for (int k = 0; k < 17; ++k) { const int i = i0 + k; const int cid = i < 4 ? 512 + b * 4 + (r ? 3 - i : i) : b * 64 + (r ? 67 - i : i - 4); const size_t ub = ((size_t)cid * 4 + hh) * 2 + r; se[ub * 2048 + e] = (bf16)f2bf(s); s = cv[k] * s + dv[k]; } } }
    if (SUB(3)) for (int u = F.bid; u < 512; u += F.G) { const int uv = u + (F.tid >> 9), sq = uv >> 3, b = sq >> 3, h = (sq >> 1) & 3, r = sq & 1, e = (uv & 7) * 512 + F.tid;
        const float* ds = (const float*)(F.ws + WS_SDS); const float* dc = (const float*)(F.ws + WS_SDEC); bf16* se = (bf16*)(F.ws + WS_SSE);
        float s = 0.f;
        for (int i0 = 0; i0 < 68; i0 += 17) { float dv[17], cv[17];
#pragma unroll
            for (int k = 0; k < 17; ++k) { const int i = i0 + k; const int cid = i < 4 ? 512 + b * 4 + (r ? 3 - i : i) : b * 64 + (r ? 67 - i : i - 4); const size_t ub = ((size_t)cid * 4 + h) * 2 + r; dv[k] = ds[ub * 4096 + e]; cv[k] = dc[ub]; }
#pragma unroll
            for (int k = 0; k < 17; ++k) { const int i = i0 + k; const int cid = i < 4 ? 512 + b * 4 + (r ? 3 - i : i) : b * 64 + (r ? 67 - i : i - 4); const size_t ub = ((size_t)cid * 4 + h) * 2 + r; se[ub * 4096 + e] = (bf16)f2bf(s); s = cv[k] * s + dv[k]; } } }
    if (SUB(4)) for (int u = F.bid; u < 512; u += F.G) fft_unit(F, u);
    if (SUB(5)) for (int u = F.bid; u < 256; u += F.G) dft_ctx_unit(F, u);
    __syncthreads();
}
__device__ __forceinline__ void p_mix_c(Frame& F, CArgs& a, int L, int rep = 0) {
#ifndef MIXC_PARTS
#define MIXC_PARTS 7
#endif
    if ((MIXC_PARTS & 1) && SUB(6)) {
        pg8::Gemm g{(const bf16*)(F.ws + WS_A2), (const bf16*)(F.ws + WS_S5B2) + (size_t)L * 16 * 256 * 512, 1024, 1024, OPQ(512)};
        SgOrder<FillS5> S; S.init(144, 1, F.G, F.bid); S.f = FillS5{(size_t)256 * 512 * 2};
        EpiS5Y E{(bf16*)(F.ws + WS_ACT5)};
        pg8::gemm_phase(F.lds, g, S, E, fresh_tid(F.wave));
    }
    const int nch = (L == DEPTH - 1) ? 512 : NCHK;
    const int og = F.G >= 208 ? 144 : 0, os = F.G >= 208 ? 176 : 32 % F.G;
    if ((MIXC_PARTS & 2) && SUB(7)) for (int u = (F.bid + F.G - og) % F.G; u < nch; u += F.G) { if constexpr (MIX_P1) gla_light(F, a, L, u); else gla_chunk<1>(F, a, L, u); }
    if ((MIXC_PARTS & 4) && SUB(8)) for (int u = (F.bid + F.G - os) % F.G; u < nch; u += F.G) { if constexpr (MIX_P1) ssd_light(F, a, L, u); else ssd_chunk<1>(F, a, L, u); }
    __syncthreads();
}

constexpr int NPH = 11, PH_TOTAL = 2 + DEPTH * NPH;
#ifndef PHASE_MASK
#define PHASE_MASK 0xFFFF
#endif
#define PM(i) ((PHASE_MASK >> (i)) & 1)
#ifndef DUP_MASK
#define DUP_MASK 0
#endif
#define NREP(k) (((DUP_MASK >> (k)) & 1) ? 2 : 1)
#ifndef MK_ONE_LAUNCH
#define MK_ONE_LAUNCH 0
#endif

__global__ void __launch_bounds__(NTHR, 2) mk_fwd(Args args_by_value) {
#define args (*fresh_args())
    extern __shared__ __attribute__((aligned(16))) unsigned char lds_raw[];
    Frame F;
    F.lds = (LAS unsigned char*)lds_raw; F.MISC = (volatile LAS unsigned*)(F.lds + MISC_OFF);
    F.tid = threadIdx.x; F.lane = F.tid & 63; F.wave = __builtin_amdgcn_readfirstlane(F.tid >> 6); F.G = gridDim.x; F.bid = blockIdx.x;
    F.ws = args_by_value.ws; F.ctl = (unsigned*)(args_by_value.ws + WS_CTL);
    if (F.tid < 64) F.MISC[F.tid] = 0u;
    __syncthreads();
#if MK_ONE_LAUNCH
    XcdBarrier bar = xcd_barrier_post(F.ctl + CW_BAR, F.MISC + 8);
#define GRID_BAR() xcd_barrier(bar)
#else
#define GRID_BAR() do { } while (0)
#endif
    const int lo = args_by_value.ph_lo, hi = args_by_value.ph_hi;
#define IN(k) (lo <= (k) && (k) < hi)
#define FRESH() do { const int t_ = fresh_tid(F.wave); F.tid = t_; F.lane = t_ & 63; } while (0)
#define SEAM(k) do { if (IN(k) && IN((k) + 1)) GRID_BAR(); } while (0)
    if (PM(0) && IN(0)) { FRESH(); p_prologue(F, args); }
#ifdef DUP_PROLOGUE
    GRID_BAR(); if (PM(0) && IN(0)) { FRESH(); p_prologue(F, args, CW_QUEUE + 64); }
#endif
    SEAM(0);
    {
        const int pb = 1 + 0 * NPH;
        const int mrows = (0 == DEPTH - 1) ? NLAT : NT;
        if (PM(1) && IN(pb + 0)) { FRESH(); p_norm1(F, args, OPQ(0)); }
#ifdef DUP_NORM1
        GRID_BAR(); if (PM(1) && IN(pb + 0)) { FRESH(); p_norm1(F, args, OPQ(0), true); }
#endif
 SEAM(pb + 0);
        if (PM(2) && IN(pb + 1)) for (int rep_ = 0; rep_ < NREP(2); ++rep_) { if (rep_) GRID_BAR(); const int Lg = OPQ(0);
            pg8::Gemm g{(const bf16*)(F.ws + WS_H), (const bf16*)(F.ws + WS_WIN) + (size_t)Lg * PW * DM, DM * 2, DM * 2, OPQ(DM)};
            SgOrder<FillPlain> S; S.init(NT / 256, PW / 256, F.G, F.bid); S.f = FillPlain{(size_t)256 * DM * 2, (size_t)256 * DM * 2};
            EpiInproj E{(bf16*)(F.ws + WS_PBUF), (bf16*)(F.ws + WS_A2)};
            pg8::gemm_phase(F.lds, g, S, E, fresh_tid(F.wave));
        }
#if defined(SHADOW_IN)
        if (PM(2) && IN(pb + 1)) { GRID_BAR(); const int Lg = OPQ(0);
            pg8::Gemm g{(const bf16*)(F.ws + WS_H), (const bf16*)(F.ws + WS_WIN) + (size_t)Lg * PW * DM, DM * 2, DM * 2, OPQ(DM)};
            SgOrder<FillPlain> S; S.init(NT / 256, PW / 256, F.G, F.bid); S.f = FillPlain{(size_t)256 * DM * 2, (size_t)256 * DM * 2};
            EpiNull E{(float*)(F.ws + WS_Y)};
            pg8::gemm_phase(F.lds, g, S, E, fresh_tid(F.wave));
        }
#endif
        SEAM(pb + 1);
        if (PM(3) && IN(pb + 2)) for (int rep_ = 0; rep_ < NREP(3); ++rep_) { if (rep_) GRID_BAR(); FRESH(); p_mix_a(F, args, OPQ(0), rep_); } SEAM(pb + 2);
        if (PM(4) && IN(pb + 3)) for (int rep_ = 0; rep_ < NREP(4); ++rep_) { if (rep_) GRID_BAR(); FRESH(); p_mix_b(F, args, OPQ(0), rep_); } SEAM(pb + 3);
        if (PM(5) && IN(pb + 4)) for (int rep_ = 0; rep_ < NREP(5); ++rep_) { if (rep_) GRID_BAR(); FRESH(); p_mix_c(F, args, OPQ(0), rep_); } SEAM(pb + 4);
        if (PM(6) && IN(pb + 5)) for (int rep_ = 0; rep_ < NREP(6); ++rep_) { if (rep_) GRID_BAR(); const int Lg = OPQ(0);
            pg8::Gemm g{(const bf16*)(F.ws + WS_ACT5), (const bf16*)(F.ws + WS_WGLU) + (size_t)Lg * 256 * 256, 512, 512, OPQ(256)};
            SgOrder<FillPlain> S; S.init(NT / 256, 1, F.G, F.bid); S.f = FillPlain{(size_t)256 * 256 * 2, 0};
            EpiGlu E{(const bf16*)(F.ws + WS_ACT5), (bf16*)(F.ws + WS_MIX)};
            pg8::gemm_phase(F.lds, g, S, E, fresh_tid(F.wave));
        } SEAM(pb + 5);
        if (PM(7) && IN(pb + 6)) { const int Lg = OPQ(0);
            pg8::Gemm g{(const bf16*)(F.ws + WS_MIX), (const bf16*)(F.ws + WS_WOUT) + (size_t)Lg * DM * MW, MW * 2, MW * 2, OPQ(MW)};
            SgOrder<FillPlain> S; S.init((Lg == DEPTH - 1 ? NLAT : NT) / 256, DM / 256, F.G, F.bid); S.f = FillPlain{(size_t)256 * MW * 2, (size_t)256 * MW * 2};
            EpiOutproj E{args.in[I_X], args.in[I_CTX], (bf16*)(F.ws + WS_XS), (const float*)(F.ws + WS_MOD) + (size_t)Lg * 9 * 6144, Lg == 0 ? 1 : 0};
            pg8::gemm_phase(F.lds, g, S, E, fresh_tid(F.wave));
        } SEAM(pb + 6);
        if (PM(8) && IN(pb + 7)) { FRESH(); p_norm2(F, args, OPQ(0), OPQ(mrows)); }
#ifdef DUP_NORM2
        GRID_BAR(); if (PM(8) && IN(pb + 7)) { FRESH(); p_norm2(F, args, OPQ(0), OPQ(mrows), 6400); }
#endif
 SEAM(pb + 7);
        if (PM(10) && IN(pb + 9)) { const int Lg = OPQ(0); FRESH();
            const int nblk = moe_tables(F, Lg);
            LAS int* lbs = (LAS int*)(F.lds + MOE_LB); LAS int* lcs = (LAS int*)(F.lds + MOE_LC); LAS unsigned* gat = (LAS unsigned*)(F.lds + MOE_GAT);
            SgOrder<FillMoe> S; S.init(nblk, 8, F.G, F.bid); S.f = FillMoe{(const LAS unsigned*)(F.lds + MOE_LBLK), 2048};
            { const int* TM = (const int*)(F.ws + WS_TM); const float* PG = (const float*)(F.ws + WS_PG); int* PS = (int*)(F.ws + WS_PS); float* SG = (float*)(F.ws + WS_SG);
              pg8::Unit u; int cursor = 0;
              for (int ui = 0; ui < MOE_MAXU && S.next(cursor, u); ++ui) {
                  if (F.tid < 256) { const int e = u.grp, rk = u.pm * 256 - lbs[e] + F.tid; const bool ok = rk < lcs[e];
                      const int id = ok ? TM[(size_t)e * NT + rk] : 0;
                      gat[ui * 256 + F.tid] = (unsigned)(id >> 2) * (unsigned)DM;
                      if (ok && u.pn == 0) { const int slot = u.pm * 256 + F.tid; PS[id] = slot; SG[slot] = PG[id]; } } } }
            __syncthreads();
            pg8::Gemm g{F.ws + WS_H8, F.ws + WS_WGU + (size_t)Lg * NEXP * 2048 * DM, DM, DM, OPQ(DM / 2)};
            EpiSwiglu E{(unsigned char*)(F.ws + WS_ACT), args.in[I_BGU] + (size_t)Lg * NEXP * 2048};
            pg8::gemm_phase<EpiSwiglu, SgOrder<FillMoe>, true, F8_ALIGN, F8_SP2, true>(F.lds, g, S, E, fresh_tid(F.wave), gat);
        } SEAM(pb + 9);
        if (PM(11) && IN(pb + 10)) for (int rep_ = 0; rep_ < NREP(11); ++rep_) { if (rep_) GRID_BAR(); const int Lg = OPQ(0); FRESH();
            const int nblk = moe_tables(F, Lg);
            pg8::Gemm g{F.ws + WS_ACT, F.ws + WS_WDN + (size_t)Lg * NEXP * DM * DM, DM, DM, OPQ(DM / 2)};
            SgOrder<FillMoe> S; S.init(nblk, 4, F.G, F.bid); S.f = FillMoe{(const LAS unsigned*)(F.lds + MOE_LBLK), 1024};
            EpiDown E{(unsigned char*)(F.ws + WS_Y), args.in[I_BDN] + (size_t)Lg * NEXP * DM, (const float*)(F.ws + WS_SG)};
            pg8::gemm_phase<EpiDown, SgOrder<FillMoe>, true, F8_ALIGN, F8_SP2>(F.lds, g, S, E, fresh_tid(F.wave));
        } SEAM(pb + 10);
        }
    {
        const int pb = 1 + 1 * NPH;
        const int mrows = (1 == DEPTH - 1) ? NLAT : NT;
        if (PM(1) && IN(pb + 0)) { FRESH(); p_norm1(F, args, OPQ(1)); }
#ifdef DUP_NORM1
        GRID_BAR(); if (PM(1) && IN(pb + 0)) { FRESH(); p_norm1(F, args, OPQ(1), true); }
#endif
 SEAM(pb + 0);
        if (PM(2) && IN(pb + 1)) for (int rep_ = 0; rep_ < NREP(2); ++rep_) { if (rep_) GRID_BAR(); const int Lg = OPQ(1);
            pg8::Gemm g{(const bf16*)(F.ws + WS_H), (const bf16*)(F.ws + WS_WIN) + (size_t)Lg * PW * DM, DM * 2, DM * 2, OPQ(DM)};
            SgOrder<FillPlain> S; S.init(NT / 256, PW / 256, F.G, F.bid); S.f = FillPlain{(size_t)256 * DM * 2, (size_t)256 * DM * 2};
            EpiInproj E{(bf16*)(F.ws + WS_PBUF), (bf16*)(F.ws + WS_A2)};
            pg8::gemm_phase(F.lds, g, S, E, fresh_tid(F.wave));
        }
#if defined(SHADOW_IN)
        if (PM(2) && IN(pb + 1)) { GRID_BAR(); const int Lg = OPQ(1);
            pg8::Gemm g{(const bf16*)(F.ws + WS_H), (const bf16*)(F.ws + WS_WIN) + (size_t)Lg * PW * DM, DM * 2, DM * 2, OPQ(DM)};
            SgOrder<FillPlain> S; S.init(NT / 256, PW / 256, F.G, F.bid); S.f = FillPlain{(size_t)256 * DM * 2, (size_t)256 * DM * 2};
            EpiNull E{(float*)(F.ws + WS_Y)};
            pg8::gemm_phase(F.lds, g, S, E, fresh_tid(F.wave));
        }
#endif
        SEAM(pb + 1);
        if (PM(3) && IN(pb + 2)) for (int rep_ = 0; rep_ < NREP(3); ++rep_) { if (rep_) GRID_BAR(); FRESH(); p_mix_a(F, args, OPQ(1), rep_); } SEAM(pb + 2);
        if (PM(4) && IN(pb + 3)) for (int rep_ = 0; rep_ < NREP(4); ++rep_) { if (rep_) GRID_BAR(); FRESH(); p_mix_b(F, args, OPQ(1), rep_); } SEAM(pb + 3);
        if (PM(5) && IN(pb + 4)) for (int rep_ = 0; rep_ < NREP(5); ++rep_) { if (rep_) GRID_BAR(); FRESH(); p_mix_c(F, args, OPQ(1), rep_); } SEAM(pb + 4);
        if (PM(6) && IN(pb + 5)) for (int rep_ = 0; rep_ < NREP(6); ++rep_) { if (rep_) GRID_BAR(); const int Lg = OPQ(1);
            pg8::Gemm g{(const bf16*)(F.ws + WS_ACT5), (const bf16*)(F.ws + WS_WGLU) + (size_t)Lg * 256 * 256, 512, 512, OPQ(256)};
            SgOrder<FillPlain> S; S.init(NT / 256, 1, F.G, F.bid); S.f = FillPlain{(size_t)256 * 256 * 2, 0};
            EpiGlu E{(const bf16*)(F.ws + WS_ACT5), (bf16*)(F.ws + WS_MIX)};
            pg8::gemm_phase(F.lds, g, S, E, fresh_tid(F.wave));
        } SEAM(pb + 5);
        if (PM(7) && IN(pb + 6)) { const int Lg = OPQ(1);
            pg8::Gemm g{(const bf16*)(F.ws + WS_MIX), (const bf16*)(F.ws + WS_WOUT) + (size_t)Lg * DM * MW, MW * 2, MW * 2, OPQ(MW)};
            SgOrder<FillPlain> S; S.init((Lg == DEPTH - 1 ? NLAT : NT) / 256, DM / 256, F.G, F.bid); S.f = FillPlain{(size_t)256 * MW * 2, (size_t)256 * MW * 2};
            EpiOutproj E{args.in[I_X], args.in[I_CTX], (bf16*)(F.ws + WS_XS), (const float*)(F.ws + WS_MOD) + (size_t)Lg * 9 * 6144, Lg == 0 ? 1 : 0};
            pg8::gemm_phase(F.lds, g, S, E, fresh_tid(F.wave));
        } SEAM(pb + 6);
        if (PM(8) && IN(pb + 7)) { FRESH(); p_norm2(F, args, OPQ(1), OPQ(mrows)); }
#ifdef DUP_NORM2
        GRID_BAR(); if (PM(8) && IN(pb + 7)) { FRESH(); p_norm2(F, args, OPQ(1), OPQ(mrows), 6400); }
#endif
 SEAM(pb + 7);
        if (PM(10) && IN(pb + 9)) { const int Lg = OPQ(1); FRESH();
            const int nblk = moe_tables(F, Lg);
            LAS int* lbs = (LAS int*)(F.lds + MOE_LB); LAS int* lcs = (LAS int*)(F.lds + MOE_LC); LAS unsigned* gat = (LAS unsigned*)(F.lds + MOE_GAT);
            SgOrder<FillMoe> S; S.init(nblk, 8, F.G, F.bid); S.f = FillMoe{(const LAS unsigned*)(F.lds + MOE_LBLK), 2048};
            { const int* TM = (const int*)(F.ws + WS_TM); const float* PG = (const float*)(F.ws + WS_PG); int* PS = (int*)(F.ws + WS_PS); float* SG = (float*)(F.ws + WS_SG);
              pg8::Unit u; int cursor = 0;
              for (int ui = 0; ui < MOE_MAXU && S.next(cursor, u); ++ui) {
                  if (F.tid < 256) { const int e = u.grp, rk = u.pm * 256 - lbs[e] + F.tid; const bool ok = rk < lcs[e];
                      const int id = ok ? TM[(size_t)e * NT + rk] : 0;
                      gat[ui * 256 + F.tid] = (unsigned)(id >> 2) * (unsigned)DM;
                      if (ok && u.pn == 0) { const int slot = u.pm * 256 + F.tid; PS[id] = slot; SG[slot] = PG[id]; } } } }
            __syncthreads();
            pg8::Gemm g{F.ws + WS_H8, F.ws + WS_WGU + (size_t)Lg * NEXP * 2048 * DM, DM, DM, OPQ(DM / 2)};
            EpiSwiglu E{(unsigned char*)(F.ws + WS_ACT), args.in[I_BGU] + (size_t)Lg * NEXP * 2048};
            pg8::gemm_phase<EpiSwiglu, SgOrder<FillMoe>, true, F8_ALIGN, F8_SP2, true>(F.lds, g, S, E, fresh_tid(F.wave), gat);
        } SEAM(pb + 9);
        if (PM(11) && IN(pb + 10)) for (int rep_ = 0; rep_ < NREP(11); ++rep_) { if (rep_) GRID_BAR(); const int Lg = OPQ(1); FRESH();
            const int nblk = moe_tables(F, Lg);
            pg8::Gemm g{F.ws + WS_ACT, F.ws + WS_WDN + (size_t)Lg * NEXP * DM * DM, DM, DM, OPQ(DM / 2)};
            SgOrder<FillMoe> S; S.init(nblk, 4, F.G, F.bid); S.f = FillMoe{(const LAS unsigned*)(F.lds + MOE_LBLK), 1024};
            EpiDown E{(unsigned char*)(F.ws + WS_Y), args.in[I_BDN] + (size_t)Lg * NEXP * DM, (const float*)(F.ws + WS_SG)};
            pg8::gemm_phase<EpiDown, SgOrder<FillMoe>, true, F8_ALIGN, F8_SP2>(F.lds, g, S, E, fresh_tid(F.wave));
        } SEAM(pb + 10);
        }
    {
        const int pb = 1 + 2 * NPH;
        const int mrows = (2 == DEPTH - 1) ? NLAT : NT;
        if (PM(1) && IN(pb + 0)) { FRESH(); p_norm1(F, args, OPQ(2)); }
#ifdef DUP_NORM1
        GRID_BAR(); if (PM(1) && IN(pb + 0)) { FRESH(); p_norm1(F, args, OPQ(2), true); }
#endif
 SEAM(pb + 0);
        if (PM(2) && IN(pb + 1)) for (int rep_ = 0; rep_ < NREP(2); ++rep_) { if (rep_) GRID_BAR(); const int Lg = OPQ(2);
            pg8::Gemm g{(const bf16*)(F.ws + WS_H), (const bf16*)(F.ws + WS_WIN) + (size_t)Lg * PW * DM, DM * 2, DM * 2, OPQ(DM)};
            SgOrder<FillPlain> S; S.init(NT / 256, PW / 256, F.G, F.bid); S.f = FillPlain{(size_t)256 * DM * 2, (size_t)256 * DM * 2};
            EpiInproj E{(bf16*)(F.ws + WS_PBUF), (bf16*)(F.ws + WS_A2)};
            pg8::gemm_phase(F.lds, g, S, E, fresh_tid(F.wave));
        }
#if defined(SHADOW_IN)
        if (PM(2) && IN(pb + 1)) { GRID_BAR(); const int Lg = OPQ(2);
            pg8::Gemm g{(const bf16*)(F.ws + WS_H), (const bf16*)(F.ws + WS_WIN) + (size_t)Lg * PW * DM, DM * 2, DM * 2, OPQ(DM)};
            SgOrder<FillPlain> S; S.init(NT / 256, PW / 256, F.G, F.bid); S.f = FillPlain{(size_t)256 * DM * 2, (size_t)256 * DM * 2};
            EpiNull E{(float*)(F.ws + WS_Y)};
            pg8::gemm_phase(F.lds, g, S, E, fresh_tid(F.wave));
        }
#endif
        SEAM(pb + 1);
        if (PM(3) && IN(pb + 2)) for (int rep_ = 0; rep_ < NREP(3); ++rep_) { if (rep_) GRID_BAR(); FRESH(); p_mix_a(F, args, OPQ(2), rep_); } SEAM(pb + 2);
        if (PM(4) && IN(pb + 3)) for (int rep_ = 0; rep_ < NREP(4); ++rep_) { if (rep_) GRID_BAR(); FRESH(); p_mix_b(F, args, OPQ(2), rep_); } SEAM(pb + 3);
        if (PM(5) && IN(pb + 4)) for (int rep_ = 0; rep_ < NREP(5); ++rep_) { if (rep_) GRID_BAR(); FRESH(); p_mix_c(F, args, OPQ(2), rep_); } SEAM(pb + 4);
        if (PM(6) && IN(pb + 5)) for (int rep_ = 0; rep_ < NREP(6); ++rep_) { if (rep_) GRID_BAR(); const int Lg = OPQ(2);
            pg8::Gemm g{(const bf16*)(F.ws + WS_ACT5), (const bf16*)(F.ws + WS_WGLU) + (size_t)Lg * 256 * 256, 512, 512, OPQ(256)};
            SgOrder<FillPlain> S; S.init(NT / 256, 1, F.G, F.bid); S.f = FillPlain{(size_t)256 * 256 * 2, 0};
            EpiGlu E{(const bf16*)(F.ws + WS_ACT5), (bf16*)(F.ws + WS_MIX)};
            pg8::gemm_phase(F.lds, g, S, E, fresh_tid(F.wave));
        } SEAM(pb + 5);
        if (PM(7) && IN(pb + 6)) { const int Lg = OPQ(2);
            pg8::Gemm g{(const bf16*)(F.ws + WS_MIX), (const bf16*)(F.ws + WS_WOUT) + (size_t)Lg * DM * MW, MW * 2, MW * 2, OPQ(MW)};
            SgOrder<FillPlain> S; S.init((Lg == DEPTH - 1 ? NLAT : NT) / 256, DM / 256, F.G, F.bid); S.f = FillPlain{(size_t)256 * MW * 2, (size_t)256 * MW * 2};
            EpiOutproj E{args.in[I_X], args.in[I_CTX], (bf16*)(F.ws + WS_XS), (const float*)(F.ws + WS_MOD) + (size_t)Lg * 9 * 6144, Lg == 0 ? 1 : 0};
            pg8::gemm_phase(F.lds, g, S, E, fresh_tid(F.wave));
        } SEAM(pb + 6);
        if (PM(8) && IN(pb + 7)) { FRESH(); p_norm2(F, args, OPQ(2), OPQ(mrows)); }
#ifdef DUP_NORM2
        GRID_BAR(); if (PM(8) && IN(pb + 7)) { FRESH(); p_norm2(F, args, OPQ(2), OPQ(mrows), 6400); }
#endif
 SEAM(pb + 7);
        if (PM(10) && IN(pb + 9)) { const int Lg = OPQ(2); FRESH();
            const int nblk = moe_tables(F, Lg);
            LAS int* lbs = (LAS int*)(F.lds + MOE_LB); LAS int* lcs = (LAS int*)(F.lds + MOE_LC); LAS unsigned* gat = (LAS unsigned*)(F.lds + MOE_GAT);
            SgOrder<FillMoe> S; S.init(nblk, 8, F.G, F.bid); S.f = FillMoe{(const LAS unsigned*)(F.lds + MOE_LBLK), 2048};
            { const int* TM = (const int*)(F.ws + WS_TM); const float* PG = (const float*)(F.ws + WS_PG); int* PS = (int*)(F.ws + WS_PS); float* SG = (float*)(F.ws + WS_SG);
              pg8::Unit u; int cursor = 0;
              for (int ui = 0; ui < MOE_MAXU && S.next(cursor, u); ++ui) {
                  if (F.tid < 256) { const int e = u.grp, rk = u.pm * 256 - lbs[e] + F.tid; const bool ok = rk < lcs[e];
                      const int id = ok ? TM[(size_t)e * NT + rk] : 0;
                      gat[ui * 256 + F.tid] = (unsigned)(id >> 2) * (unsigned)DM;
                      if (ok && u.pn == 0) { const int slot = u.pm * 256 + F.tid; PS[id] = slot; SG[slot] = PG[id]; } } } }
            __syncthreads();
            pg8::Gemm g{F.ws + WS_H8, F.ws + WS_WGU + (size_t)Lg * NEXP * 2048 * DM, DM, DM, OPQ(DM / 2)};
            EpiSwiglu E{(unsigned char*)(F.ws + WS_ACT), args.in[I_BGU] + (size_t)Lg * NEXP * 2048};
            pg8::gemm_phase<EpiSwiglu, SgOrder<FillMoe>, true, F8_ALIGN, F8_SP2, true>(F.lds, g, S, E, fresh_tid(F.wave), gat);
        } SEAM(pb + 9);
        if (PM(11) && IN(pb + 10)) for (int rep_ = 0; rep_ < NREP(11); ++rep_) { if (rep_) GRID_BAR(); const int Lg = OPQ(2); FRESH();
            const int nblk = moe_tables(F, Lg);
            pg8::Gemm g{F.ws + WS_ACT, F.ws + WS_WDN + (size_t)Lg * NEXP * DM * DM, DM, DM, OPQ(DM / 2)};
            SgOrder<FillMoe> S; S.init(nblk, 4, F.G, F.bid); S.f = FillMoe{(const LAS unsigned*)(F.lds + MOE_LBLK), 1024};
            EpiDown E{(unsigned char*)(F.ws + WS_Y), args.in[I_BDN] + (size_t)Lg * NEXP * DM, (const float*)(F.ws + WS_SG)};
            pg8::gemm_phase<EpiDown, SgOrder<FillMoe>, true, F8_ALIGN, F8_SP2>(F.lds, g, S, E, fresh_tid(F.wave));
        } SEAM(pb + 10);
        }
    {
        const int pb = 1 + 3 * NPH;
        const int mrows = (3 == DEPTH - 1) ? NLAT : NT;
        if (PM(1) && IN(pb + 0)) { FRESH(); p_norm1(F, args, OPQ(3)); }
#ifdef DUP_NORM1
        GRID_BAR(); if (PM(1) && IN(pb + 0)) { FRESH(); p_norm1(F, args, OPQ(3), true); }
#endif
 SEAM(pb + 0);
        if (PM(2) && IN(pb + 1)) for (int rep_ = 0; rep_ < NREP(2); ++rep_) { if (rep_) GRID_BAR(); const int Lg = OPQ(3);
            pg8::Gemm g{(const bf16*)(F.ws + WS_H), (const bf16*)(F.ws + WS_WIN) + (size_t)Lg * PW * DM, DM * 2, DM * 2, OPQ(DM)};
            SgOrder<FillPlain> S; S.init(NT / 256, PW / 256, F.G, F.bid); S.f = FillPlain{(size_t)256 * DM * 2, (size_t)256 * DM * 2};
            EpiInproj E{(bf16*)(F.ws + WS_PBUF), (bf16*)(F.ws + WS_A2)};
            pg8::gemm_phase(F.lds, g, S, E, fresh_tid(F.wave));
        }
#if defined(SHADOW_IN)
        if (PM(2) && IN(pb + 1)) { GRID_BAR(); const int Lg = OPQ(3);
            pg8::Gemm g{(const bf16*)(F.ws + WS_H), (const bf16*)(F.ws + WS_WIN) + (size_t)Lg * PW * DM, DM * 2, DM * 2, OPQ(DM)};
            SgOrder<FillPlain> S; S.init(NT / 256, PW / 256, F.G, F.bid); S.f = FillPlain{(size_t)256 * DM * 2, (size_t)256 * DM * 2};
            EpiNull E{(float*)(F.ws + WS_Y)};
            pg8::gemm_phase(F.lds, g, S, E, fresh_tid(F.wave));
        }
#endif
        SEAM(pb + 1);
        if (PM(3) && IN(pb + 2)) for (int rep_ = 0; rep_ < NREP(3); ++rep_) { if (rep_) GRID_BAR(); FRESH(); p_mix_a(F, args, OPQ(3), rep_); } SEAM(pb + 2);
        if (PM(4) && IN(pb + 3)) for (int rep_ = 0; rep_ < NREP(4); ++rep_) { if (rep_) GRID_BAR(); FRESH(); p_mix_b(F, args, OPQ(3), rep_); } SEAM(pb + 3);
        if (PM(5) && IN(pb + 4)) for (int rep_ = 0; rep_ < NREP(5); ++rep_) { if (rep_) GRID_BAR(); FRESH(); p_mix_c(F, args, OPQ(3), rep_); } SEAM(pb + 4);
        if (PM(6) && IN(pb + 5)) for (int rep_ = 0; rep_ < NREP(6); ++rep_) { if (rep_) GRID_BAR(); const int Lg = OPQ(3);
            pg8::Gemm g{(const bf16*)(F.ws + WS_ACT5), (const bf16*)(F.ws + WS_WGLU) + (size_t)Lg * 256 * 256, 512, 512, OPQ(256)};
            SgOrder<FillPlain> S; S.init(NT / 256, 1, F.G, F.bid); S.f = FillPlain{(size_t)256 * 256 * 2, 0};
            EpiGlu E{(const bf16*)(F.ws + WS_ACT5), (bf16*)(F.ws + WS_MIX)};
            pg8::gemm_phase(F.lds, g, S, E, fresh_tid(F.wave));
        } SEAM(pb + 5);
        if (PM(7) && IN(pb + 6)) { const int Lg = OPQ(3);
            pg8::Gemm g{(const bf16*)(F.ws + WS_MIX), (const bf16*)(F.ws + WS_WOUT) + (size_t)Lg * DM * MW, MW * 2, MW * 2, OPQ(MW)};
            SgOrder<FillPlain> S; S.init((Lg == DEPTH - 1 ? NLAT : NT) / 256, DM / 256, F.G, F.bid); S.f = FillPlain{(size_t)256 * MW * 2, (size_t)256 * MW * 2};
            EpiOutproj E{args.in[I_X], args.in[I_CTX], (bf16*)(F.ws + WS_XS), (const float*)(F.ws + WS_MOD) + (size_t)Lg * 9 * 6144, Lg == 0 ? 1 : 0};
            pg8::gemm_phase(F.lds, g, S, E, fresh_tid(F.wave));
        } SEAM(pb + 6);
        if (PM(8) && IN(pb + 7)) { FRESH(); p_norm2(F, args, OPQ(3), OPQ(mrows)); }
#ifdef DUP_NORM2
        GRID_BAR(); if (PM(8) && IN(pb + 7)) { FRESH(); p_norm2(F, args, OPQ(3), OPQ(mrows), 6400); }
#endif
 SEAM(pb + 7);
        if (PM(10) && IN(pb + 9)) { const int Lg = OPQ(3); FRESH();
            const int nblk = moe_tables(F, Lg);
            LAS int* lbs = (LAS int*)(F.lds + MOE_LB); LAS int* lcs = (LAS int*)(F.lds + MOE_LC); LAS unsigned* gat = (LAS unsigned*)(F.lds + MOE_GAT);
            SgOrder<FillMoe> S; S.init(nblk, 8, F.G, F.bid); S.f = FillMoe{(const LAS unsigned*)(F.lds + MOE_LBLK), 2048};
            { const int* TM = (const int*)(F.ws + WS_TM); const float* PG = (const float*)(F.ws + WS_PG); int* PS = (int*)(F.ws + WS_PS); float* SG = (float*)(F.ws + WS_SG);
              pg8::Unit u; int cursor = 0;
              for (int ui = 0; ui < MOE_MAXU && S.next(cursor, u); ++ui) {
                  if (F.tid < 256) { const int e = u.grp, rk = u.pm * 256 - lbs[e] + F.tid; const bool ok = rk < lcs[e];
                      const int id = ok ? TM[(size_t)e * NT + rk] : 0;
                      gat[ui * 256 + F.tid] = (unsigned)(id >> 2) * (unsigned)DM;
                      if (ok && u.pn == 0) { const int slot = u.pm * 256 + F.tid; PS[id] = slot; SG[slot] = PG[id]; } } } }
            __syncthreads();
            pg8::Gemm g{F.ws + WS_H8, F.ws + WS_WGU + (size_t)Lg * NEXP * 2048 * DM, DM, DM, OPQ(DM / 2)};
            EpiSwiglu E{(unsigned char*)(F.ws + WS_ACT), args.in[I_BGU] + (size_t)Lg * NEXP * 2048};
            pg8::gemm_phase<EpiSwiglu, SgOrder<FillMoe>, true, F8_ALIGN, F8_SP2, true>(F.lds, g, S, E, fresh_tid(F.wave), gat);
        } SEAM(pb + 9);
        if (PM(11) && IN(pb + 10)) for (int rep_ = 0; rep_ < NREP(11); ++rep_) { if (rep_) GRID_BAR(); const int Lg = OPQ(3); FRESH();
            const int nblk = moe_tables(F, Lg);
            pg8::Gemm g{F.ws + WS_ACT, F.ws + WS_WDN + (size_t)Lg * NEXP * DM * DM, DM, DM, OPQ(DM / 2)};
            SgOrder<FillMoe> S; S.init(nblk, 4, F.G, F.bid); S.f = FillMoe{(const LAS unsigned*)(F.lds + MOE_LBLK), 1024};
            EpiDown E{(unsigned char*)(F.ws + WS_Y), args.in[I_BDN] + (size_t)Lg * NEXP * DM, (const float*)(F.ws + WS_SG)};
            pg8::gemm_phase<EpiDown, SgOrder<FillMoe>, true, F8_ALIGN, F8_SP2>(F.lds, g, S, E, fresh_tid(F.wave));
        } SEAM(pb + 10);
        }
    if (PM(12) && IN(PH_TOTAL - 1)) { FRESH(); p_final(F, args); }
#undef IN
#undef SEAM
#undef args
}

extern "C" void kernel_launch(void* const* d_in, const int* in_sizes, int n_in, void* d_out, int out_size, void* d_ws, size_t ws_size, hipStream_t stream) {
    static int grid = 0;
    if (grid == 0) {
        if (n_in != N_IN || out_size != NLAT * DM || ws_size < WS_END) { fprintf(stderr, "kernel_launch: unexpected shapes (n_in %d, out %d, ws %zu < %zu); nothing launched\n", n_in, out_size, ws_size, (size_t)WS_END); grid = -1; return; }
        int dev = 0, cus = 0, per_cu = 0;
        if (hipGetDevice(&dev) != hipSuccess || hipDeviceGetAttribute(&cus, hipDeviceAttributeMultiprocessorCount, dev) != hipSuccess) { grid = -1; return; }
        if (hipFuncSetAttribute((const void*)mk_fwd, hipFuncAttributeMaxDynamicSharedMemorySize, LDS_BYTES) != hipSuccess) { fprintf(stderr, "kernel_launch: hipFuncSetAttribute failed\n"); grid = -1; return; }
        if (hipOccupancyMaxActiveBlocksPerMultiprocessor(&per_cu, (const void*)mk_fwd, NTHR, LDS_BYTES) != hipSuccess || per_cu < 1) fprintf(stderr, "kernel_launch: occupancy query says %d\n", per_cu);
        (void)hipGetLastError();
        grid = cus;
    }
    if (grid < 0) return;
    (void)hipMemsetAsync((char*)d_ws + WS_CTL, 0, CTL_BYTES, stream);
    Args a{};
    for (int i = 0; i < N_IN; ++i) a.in[i] = (const float*)d_in[i];
    a.out = (float*)d_out; a.ws = (unsigned char*)d_ws;
#if MK_ONE_LAUNCH
    a.ph_lo = 0; a.ph_hi = PH_TOTAL;
    hipLaunchKernelGGL(mk_fwd, dim3(grid), dim3(NTHR), LDS_BYTES, stream, a);
#else
    for (int p = 0; p < PH_TOTAL; ++p) { a.ph_lo = p; a.ph_hi = p + 1; hipLaunchKernelGGL(mk_fwd, dim3(grid), dim3(NTHR), LDS_BYTES, stream, a); }
#endif
}
```

```cpp
#define MK_ONE_LAUNCH 1
#define F8_ALIGN true
#define F8_SP2 true
#include <hip/hip_runtime.h>
#include <cstdio>
#include <cstdint>

#define GAS __attribute__((address_space(1)))
#define LAS __attribute__((address_space(3)))
typedef unsigned short bf16;
typedef short bf16x8 __attribute__((ext_vector_type(8)));
typedef short s16x4 __attribute__((ext_vector_type(4)));
typedef float f32x4 __attribute__((ext_vector_type(4)));
typedef float f32x2 __attribute__((ext_vector_type(2)));
typedef unsigned u32x4 __attribute__((ext_vector_type(4)));
typedef unsigned u32x2 __attribute__((ext_vector_type(2)));

namespace pg8 {
#define PG8_LAS __attribute__((address_space(3)))
typedef unsigned short bf16_t;
constexpr int BM = 256, BK = 64, HALF = 128, HTB = HALF * BK * 2  , STAGE_BYTES = 8 * HTB;

__host__ __device__ __forceinline__ int lds_byte(int r, int c) { const int st = (r >> 4) * 2 + (c >> 5), rr = r & 15, cc = c & 31, ob = rr * 64 + cc * 2; return st * 1024 + (ob ^ (((ob >> 9) & 1) << 5)); }
__host__ __device__ __forceinline__ void stage_rc(int b, int& R, int& C) { const int st = b / 1024, sb = b % 1024, swz = sb ^ (((sb >> 9) & 1) << 5); R = (st >> 1) * 16 + swz / 64; C = (st & 1) * 32 + (swz % 64) / 2; }
__host__ __device__ __forceinline__ int lds_byte_f8(int r, int c) { const int st = (r >> 4) * 2 + (c >> 5), rr = r & 15, cc = c & 31, ob = rr * 64 + cc * 2; return st * 1024 + (ob ^ (((ob >> 9) & 1) << 4)); }
__host__ __device__ __forceinline__ void stage_rc_f8(int b, int& R, int& C) { const int st = b / 1024, sb = b % 1024, swz = sb ^ (((sb >> 9) & 1) << 4); R = (st >> 1) * 16 + swz / 64; C = (st & 1) * 32 + (swz % 64) / 2; }
__host__ __device__ __forceinline__ int perm32(int rho) { const int n = rho >> 4, i = rho & 15; return 8 * (i >> 2) + 4 * n + (i & 3); }

struct Unit { int pm, pn, grp; size_t aoff, boff; };
struct Gemm { const void* A; const void* Bt; int lda, ldb, K; };

__device__ __forceinline__ unsigned cvt_pk_bf16(float lo, float hi) { unsigned r; asm volatile("v_cvt_pk_bf16_f32 %0, %1, %2" : "=v"(r) : "v"(lo), "v"(hi)); return r; }

typedef int v8i_t __attribute__((ext_vector_type(8)));
typedef int v4i_t __attribute__((ext_vector_type(4)));
template <class Epi, class Sched, bool F8 = false, bool ALIGN_EPI = true, bool SP2 = true, bool GATHER = false>
__device__ __forceinline__ void gemm_phase(PG8_LAS unsigned char* lds, const Gemm g, const Sched& S, const Epi& E, int tid_in, const PG8_LAS unsigned* gat = nullptr) {
    static_assert(!GATHER || SP2, "gather is written for the SP2 loop");
    int tid = tid_in; asm volatile("" : "+v"(tid));
    const int wid = __builtin_amdgcn_readfirstlane(tid >> 6), lane = tid & 63, wr = wid >> 2, wc = wid & 3, fr = lane & 15, fq = lane >> 4;
    const int K = g.K, nt = K / BK;
    unsigned voffA[2], voffB[2];
#pragma unroll
    for (int i = 0; i < 2; ++i) { int R, C; if constexpr (F8) stage_rc_f8(tid * 16 + i * 8192, R, C); else stage_rc(tid * 16 + i * 8192, R, C); const int Rb = Epi::PERM ? ((R & ~31) + perm32(R & 31)) : R;
        voffA[i] = GATHER ? (unsigned)(R * 65536 + C * 2) : (unsigned)(R * g.lda + C * 2); voffB[i] = (unsigned)(Rb * g.ldb + C * 2); }
    unsigned vA0[2], vA1[2];
    const size_t kstep = (size_t)(BK * 2);
    const size_t hstepA = (size_t)HALF * g.lda, hstepB = (size_t)HALF * g.ldb;
#define PG8_GLOAD(ui_) do { _Pragma("unroll") for (int _i = 0; _i < 2; ++_i) { const int r_ = (int)(voffA[_i] >> 16); const unsigned c_ = voffA[_i] & 0xffffu; \
        vA0[_i] = gat[(ui_) * 256 + r_] + c_; vA1[_i] = gat[(ui_) * 256 + 128 + r_] + c_; } } while (0)
    if constexpr (GATHER) PG8_GLOAD(0); else { vA0[0] = voffA[0]; vA0[1] = voffA[1]; vA1[0] = voffA[0] + (unsigned)hstepA; vA1[1] = voffA[1] + (unsigned)hstepA; }
    int ui = 0;
    const unsigned ldsw = (unsigned)wid * 1024u;
    const int aoff = F8 ? lds_byte_f8(wr * 64 + fr, fq * 16) : lds_byte(wr * 64 + fr, fq * 8), boff = F8 ? lds_byte_f8(wc * 32 + fr, fq * 16) : lds_byte(wc * 32 + fr, fq * 8);
    const int aoff1 = lds_byte_f8(wr * 64 + fr, fq * 16 + 8), boff1 = lds_byte_f8(wc * 32 + fr, fq * 16 + 8);
#define PG8_SA(b, h) (((b) * 2 + (h)) * HTB)
#define PG8_SB(b, h) ((4 + (b) * 2 + (h)) * HTB)
#define PG8_STAGE(bufoff, gbase, voff) do { _Pragma("unroll") for (int _i = 0; _i < 2; ++_i) \
        __builtin_amdgcn_global_load_lds((const unsigned*)((const char*)(gbase) + (voff)[_i]), (PG8_LAS unsigned*)(lds + (bufoff) + ldsw + _i * 8192), 16, 0, 0); } while (0)
#define PG8_LD16(off) (*(const PG8_LAS v4i_t*)(lds + (off)))
#define PG8_LDA(dst, b, h) do { if constexpr (F8) { _Pragma("unroll") for (int m = 0; m < 4; ++m) A8[m] = __builtin_shufflevector(PG8_LD16(PG8_SA(b, h) + aoff + m * 2048), PG8_LD16(PG8_SA(b, h) + aoff1 + m * 2048), 0, 1, 2, 3, 4, 5, 6, 7); } \
        else { _Pragma("unroll") for (int m = 0; m < 4; ++m) _Pragma("unroll") for (int k = 0; k < 2; ++k) dst[m][k] = *(const PG8_LAS bf16x8*)(lds + PG8_SA(b, h) + aoff + m * 2048 + k * 1024); } } while (0)
#define PG8_LDB(dst, b, h) do { if constexpr (F8) { _Pragma("unroll") for (int n = 0; n < 2; ++n) dst##8[n] = __builtin_shufflevector(PG8_LD16(PG8_SB(b, h) + boff + n * 2048), PG8_LD16(PG8_SB(b, h) + boff1 + n * 2048), 0, 1, 2, 3, 4, 5, 6, 7); } \
        else { _Pragma("unroll") for (int n = 0; n < 2; ++n) _Pragma("unroll") for (int k = 0; k < 2; ++k) dst[n][k] = *(const PG8_LAS bf16x8*)(lds + PG8_SB(b, h) + boff + n * 2048 + k * 1024); } } while (0)
#define PG8_MMA(ai, bj, At, Bt) do { __builtin_amdgcn_s_setprio(1); \
        if constexpr (F8) { _Pragma("unroll") for (int m = 0; m < 4; ++m) _Pragma("unroll") for (int n = 0; n < 2; ++n) \
            asm volatile("v_mfma_scale_f32_16x16x128_f8f6f4 %0, %1, %2, %0, %3, %3 op_sel_hi:[0,0,0]" : "+v"(acc[ai][bj][m][n]) : "v"(Bt##8[n]), "v"(A8[m]), "v"(one_scale)); } \
        else { _Pragma("unroll") for (int m = 0; m < 4; ++m) _Pragma("unroll") for (int n = 0; n < 2; ++n) _Pragma("unroll") for (int k = 0; k < 2; ++k) \
            acc[ai][bj][m][n] = __builtin_amdgcn_mfma_f32_16x16x32_bf16(Bt[n][k], At[m][k], acc[ai][bj][m][n], 0, 0, 0); } \
        __builtin_amdgcn_s_setprio(0); } while (0)
#define PG8_WAIT_V(n) asm volatile("s_waitcnt vmcnt(" #n ")" ::: "memory")
#define PG8_WAIT_L(n) asm volatile("s_waitcnt lgkmcnt(" #n ")" ::: "memory")
#define PG8_BAR __builtin_amdgcn_s_barrier()
#define PG8_SCHED __builtin_amdgcn_sched_barrier(0)
    Unit cur, nxt; int cursor = 0;
    if (!S.next(cursor, cur)) return;
    f32x4 acc[2][2][4][2];
#pragma unroll
    for (int a = 0; a < 2; ++a)
#pragma unroll
        for (int b = 0; b < 2; ++b)
#pragma unroll
            for (int m = 0; m < 4; ++m)
#pragma unroll
                for (int n = 0; n < 2; ++n) acc[a][b][m][n] = (f32x4){0.f, 0.f, 0.f, 0.f};
    bf16x8 At[4][2], B0[2][2], B1[2][2];
    v8i_t A8[4], B08[2], B18[2];
    int one_scale = 0x7F7F7F7F; asm volatile("" : "+v"(one_scale));
    const char* cA = (const char*)g.A + (GATHER ? (size_t)0 : cur.aoff); const char* cB = (const char*)g.Bt + cur.boff;
    if constexpr (SP2) {
        PG8_STAGE(PG8_SB(0, 0), cB, voffB); PG8_STAGE(PG8_SB(0, 1), cB + hstepB, voffB); PG8_STAGE(PG8_SA(0, 0), cA, vA0); PG8_STAGE(PG8_SA(0, 1), cA, vA1);
        if (wr == 1) PG8_BAR;
        PG8_WAIT_V(2); PG8_BAR;
        PG8_STAGE(PG8_SB(1, 0), cB + kstep, voffB); PG8_STAGE(PG8_SA(1, 0), cA + kstep, vA0); PG8_STAGE(PG8_SB(1, 1), cB + hstepB + kstep, voffB);
        PG8_WAIT_V(6); PG8_BAR;
    } else {
        PG8_STAGE(PG8_SB(0, 0), cB, voffB); PG8_STAGE(PG8_SA(0, 0), cA, voffA); PG8_STAGE(PG8_SB(0, 1), cB + hstepB, voffB); PG8_STAGE(PG8_SA(0, 1), cA + hstepA, voffA);
        if (wr == 1) PG8_BAR;
        PG8_WAIT_V(4); PG8_BAR;
        PG8_STAGE(PG8_SB(1, 0), cB + kstep, voffB); PG8_STAGE(PG8_SA(1, 0), cA + kstep, vA0); PG8_STAGE(PG8_SB(1, 1), cB + hstepB + kstep, voffB);
        PG8_WAIT_V(6); PG8_BAR;
    }
    for (;;) {
        const bool has_next = S.next(cursor, nxt);
        const char* nA = (has_next && !GATHER) ? (const char*)g.A + nxt.aoff : cA; const char* nB = has_next ? (const char*)g.Bt + nxt.boff : cB;
        for (int t = 0; t < nt; t += 2) {
            const bool last = (t == nt - 2);
            const char* a1 = cA + (size_t)(t + 1) * kstep;
            const char* a2 = last ? nA : cA + (size_t)(t + 2) * kstep; const char* b2 = last ? nB : cB + (size_t)(t + 2) * kstep;
            const char* a3 = a2 + kstep; const char* b3 = b2 + kstep;
            if constexpr (SP2) {
            PG8_LDB(B0, 0, 0); PG8_LDB(B1, 0, 1); PG8_SCHED; PG8_LDA(At, 0, 0); PG8_STAGE(PG8_SA(1, 1), a1, vA1);
            if constexpr (GATHER) { if (last && has_next) PG8_GLOAD(ui + 1); }
            PG8_WAIT_V(8); PG8_WAIT_L(0); PG8_BAR; PG8_MMA(0, 0, At, B0); PG8_MMA(0, 1, At, B1); PG8_BAR; PG8_SCHED;
            PG8_LDA(At, 0, 1); PG8_STAGE(PG8_SB(0, 0), b2, voffB); PG8_STAGE(PG8_SB(0, 1), b2 + hstepB, voffB); PG8_STAGE(PG8_SA(0, 0), a2, vA0);
            PG8_WAIT_V(8); PG8_WAIT_L(0); PG8_BAR; PG8_MMA(1, 0, At, B0); PG8_MMA(1, 1, At, B1); PG8_BAR; PG8_SCHED;
            PG8_LDB(B0, 1, 0); PG8_LDB(B1, 1, 1); PG8_SCHED; PG8_LDA(At, 1, 0); PG8_STAGE(PG8_SA(0, 1), a2, vA1);
            PG8_WAIT_V(8); PG8_WAIT_L(0); PG8_BAR; PG8_MMA(0, 0, At, B0); PG8_MMA(0, 1, At, B1); PG8_BAR; PG8_SCHED;
            PG8_LDA(At, 1, 1); PG8_STAGE(PG8_SB(1, 0), b3, voffB); PG8_STAGE(PG8_SB(1, 1), b3 + hstepB, voffB); PG8_STAGE(PG8_SA(1, 0), a3, vA0);
            PG8_WAIT_V(8); PG8_WAIT_L(0); PG8_BAR; PG8_MMA(1, 0, At, B0); PG8_MMA(1, 1, At, B1); PG8_BAR; PG8_SCHED;
            } else {
            PG8_LDB(B0, 0, 0); PG8_SCHED; PG8_LDA(At, 0, 0); PG8_STAGE(PG8_SA(1, 1), a1, vA1);
            PG8_WAIT_L(8); PG8_BAR; PG8_WAIT_L(0); PG8_MMA(0, 0, At, B0); PG8_BAR; PG8_SCHED;
            PG8_LDB(B1, 0, 1); PG8_STAGE(PG8_SB(0, 0), b2, voffB);
            PG8_BAR; PG8_WAIT_L(0); PG8_MMA(0, 1, At, B1); PG8_BAR;
            PG8_LDA(At, 0, 1); PG8_STAGE(PG8_SA(0, 0), a2, vA0);
            PG8_BAR; PG8_WAIT_L(0); PG8_MMA(1, 0, At, B0); PG8_BAR; PG8_SCHED;
            PG8_STAGE(PG8_SB(0, 1), b2 + hstepB, voffB);
            PG8_WAIT_V(6); PG8_BAR; PG8_MMA(1, 1, At, B1); PG8_BAR;
            PG8_LDB(B0, 1, 0); PG8_SCHED; PG8_LDA(At, 1, 0); PG8_STAGE(PG8_SA(0, 1), a2, vA1);
            PG8_WAIT_L(8); PG8_BAR; PG8_WAIT_L(0); PG8_MMA(0, 0, At, B0); PG8_BAR; PG8_SCHED;
            PG8_LDB(B1, 1, 1); PG8_STAGE(PG8_SB(1, 0), b3, voffB);
            PG8_BAR; PG8_WAIT_L(0); PG8_MMA(0, 1, At, B1); PG8_BAR;
            PG8_LDA(At, 1, 1); PG8_STAGE(PG8_SA(1, 0), a3, vA0);
            PG8_BAR; PG8_WAIT_L(0); PG8_MMA(1, 0, At, B0); PG8_BAR; PG8_SCHED;
            PG8_STAGE(PG8_SB(1, 1), b3 + hstepB, voffB);
            PG8_WAIT_V(6); PG8_BAR; PG8_MMA(1, 1, At, B1); PG8_BAR;
            }
        }
        if constexpr (F8) asm volatile("s_nop 15\n\ts_nop 15" ::: "memory");
        if constexpr (ALIGN_EPI) { if (wr == 0) PG8_BAR; }
        E(acc, cur, wr, wc, fr, fq);
        if (!has_next) break;
#pragma unroll
        for (int a = 0; a < 2; ++a)
#pragma unroll
            for (int b = 0; b < 2; ++b)
#pragma unroll
                for (int m = 0; m < 4; ++m)
#pragma unroll
                    for (int n = 0; n < 2; ++n) acc[a][b][m][n] = (f32x4){0.f, 0.f, 0.f, 0.f};
        cur = nxt; cA = nA; cB = nB; ++ui;
        if constexpr (ALIGN_EPI) { if (wr == 1) PG8_BAR; }
    }
    PG8_WAIT_V(0);
    if constexpr (!ALIGN_EPI) { if (wr == 0) PG8_BAR; }
    PG8_BAR;
#undef PG8_GLOAD
#undef PG8_SA
#undef PG8_SB
#undef PG8_STAGE
#undef PG8_LDA
#undef PG8_LDB
#undef PG8_MMA
#undef PG8_LD16
#undef PG8_WAIT_V
#undef PG8_WAIT_L
#undef PG8_BAR
#undef PG8_SCHED
}
}

#define XB_TMO      128
#define XB_XCNT(j)  (256  + 64 * (j))
#define XB_XSUB(j)  (1280 + 64 * (j))
#define XB_XGEN(j)  (2304 + 64 * (j))
#define XB_TOP      3328
#define XB_TOPGEN   3392
#define XCD_BAR_WORDS 3456
#define XB_SPIN_CAP (1u << 18)

__device__ __forceinline__ unsigned xb_ld(unsigned* p)              { return __hip_atomic_load(p, __ATOMIC_RELAXED, __HIP_MEMORY_SCOPE_AGENT); }
__device__ __forceinline__ unsigned xb_add(unsigned* p, unsigned v) { return __hip_atomic_fetch_add(p, v, __ATOMIC_RELAXED, __HIP_MEMORY_SCOPE_AGENT); }
__device__ __forceinline__ unsigned xb_xcc_id() { return (unsigned)__builtin_amdgcn_s_getreg((3 << 11) | 20) & 0xFu; }
#define XB_SPIN(cond, bar) do { unsigned _sp = 0; while (cond) { __builtin_amdgcn_s_sleep(1); \
    if ((++_sp & 255u) == 0u) { if (xb_ld(&(bar)[XB_TMO])) break; if (_sp > XB_SPIN_CAP) { atomicAdd(&(bar)[XB_TMO], 1u); break; } } } } while (0)

struct XcdBarrier {
    unsigned* bar; unsigned x;
    volatile LAS unsigned* st;
};

__device__ __forceinline__ XcdBarrier xcd_barrier_post(unsigned* bar, volatile LAS unsigned* st) {
    XcdBarrier b; b.bar = bar; b.x = xb_xcc_id(); b.st = st;
    if (threadIdx.x == 0) (void)xb_add(&bar[XB_XCNT(b.x)], 1u);
    return b;
}
__device__ __forceinline__ void xcd_barrier_complete(unsigned* bar, unsigned x, unsigned& nloc, unsigned& nx) {
    const unsigned G = gridDim.x * gridDim.y * gridDim.z;
    unsigned sum, cnt, mine, sp = 0u;
    for (;;) {
        sum = 0u; cnt = 0u; mine = 0u;
#pragma unroll
        for (unsigned j = 0; j < 16; ++j) { const unsigned c = xb_ld(&bar[XB_XCNT(j)]); sum += c; cnt += (c > 0u) ? 1u : 0u; mine = (j == x) ? c : mine; }
        if (sum == G) break;
        __builtin_amdgcn_s_sleep(1);
        if ((++sp & 255u) == 0u) { if (xb_ld(&bar[XB_TMO])) break; if (sp > XB_SPIN_CAP) { atomicAdd(&bar[XB_TMO], 1u); break; } }
    }
    nloc = mine > 0u ? mine : 1u; nx = cnt > 0u ? cnt : 1u;
}

__device__ __forceinline__ void xcd_barrier(const XcdBarrier& b) {
    asm volatile("s_waitcnt vmcnt(0)" ::: "memory");
    __syncthreads();
    if (threadIdx.x == 0) {
        unsigned* bar = b.bar;
        __builtin_amdgcn_s_waitcnt(0);
        unsigned nloc = b.st[0], nx = b.st[1];
        if (nloc == 0u) { xcd_barrier_complete(bar, b.x, nloc, nx); b.st[0] = nloc; b.st[1] = nx; }
        const unsigned old = xb_add(&bar[XB_XSUB(b.x)], 1u);
        const unsigned gen = old / nloc;
        if (old + 1u == (gen + 1u) * nloc) {
            __builtin_amdgcn_fence(__ATOMIC_RELEASE, "agent");
            asm volatile("s_waitcnt vmcnt(0)" ::: "memory");
            const unsigned og = xb_add(&bar[XB_TOP], 1u);
            const unsigned tg = og / nx;
            if (og + 1u == (tg + 1u) * nx) xb_add(&bar[XB_TOPGEN], 1u);
            else XB_SPIN(xb_ld(&bar[XB_TOPGEN]) == tg, bar);
            __builtin_amdgcn_fence(__ATOMIC_ACQUIRE, "agent");
            xb_add(&bar[XB_XGEN(b.x)], 1u);
            asm volatile("s_waitcnt vmcnt(0)" ::: "memory");
        } else {
            XB_SPIN(xb_ld(&bar[XB_XGEN(b.x)]) == gen, bar);
            __builtin_amdgcn_fence(__ATOMIC_ACQUIRE, "agent");
            asm volatile("s_waitcnt vmcnt(0)" ::: "memory");
        }
    }
    __syncthreads();
}

constexpr int NWAVES = 8, NTHR = 512;
constexpr int DM = 1024, NB = 8, SEQ = 4096, CTXL = 256, DEPTH = 4;
constexpr int NLAT = NB * SEQ, NCTX = NB * CTXL, NT = NLAT + NCTX;
constexpr int PW = 2304;
constexpr int MW = 1280;
constexpr int NEXP = 32, MAXBLK = 576;
constexpr int NCHK = 544;
constexpr int S5ROWS = 2304;
constexpr int PC_FU = 0, PC_S5 = 256, PC_Q = 512, PC_K = 640, PC_V = 768, PC_R = 1024, PC_Z = 1280, PC_XBC = 1536, PC_A1 = 2048, PC_DT = 2080;
enum { I_X = 0, I_C, I_CTX, I_CCTX, I_ADAW, I_ADAB, I_NMG, I_NFG, I_WIN, I_WOUT, I_FOURW, I_S5LRE, I_S5LIM, I_S5LDT, I_S5BRE, I_S5BIM, I_S5CRE, I_S5CIM, I_S5D, I_S5GLU,
       I_GLAA2, I_GLAAB, I_GLANG, I_SSDCW, I_SSDCB, I_SSDALOG, I_SSDDTB, I_SSDD, I_SSDNG, I_RW, I_RB, I_WGU, I_BGU, I_WDN, I_BDN, I_FING, N_IN };

constexpr size_t al256(size_t x) { return (x + 255) & ~(size_t)255; }
constexpr size_t WS_CTL = 0, CTL_BYTES = 1u << 20;
constexpr size_t WS_MOD = WS_CTL + CTL_BYTES;
constexpr size_t WS_TAB = WS_MOD + al256((size_t)DEPTH * 9 * 6144 * 4);
constexpr size_t TAB_F64 = 0, TAB_TW = 16384, TAB_D256 = 16384 + 32768, TAB_BYTES = 65536;
constexpr size_t WS_A16 = WS_TAB + TAB_BYTES;
constexpr size_t WS_WIN = WS_A16 + al256((size_t)DEPTH * 2 * 16 * 64 * 2 * 4);
constexpr size_t WS_WOUT = WS_WIN + (size_t)DEPTH * PW * DM * 2;
constexpr size_t WS_WGLU = WS_WOUT + (size_t)DEPTH * DM * MW * 2;
constexpr size_t WS_S5P = WS_WGLU + (size_t)DEPTH * 256 * 256 * 2;
constexpr size_t WS_S5B2 = WS_S5P + (size_t)DEPTH * 16 * 256 * 256 * 2;
constexpr size_t WS_WGU = WS_S5B2 + (size_t)DEPTH * 16 * 256 * 512 * 2;
constexpr size_t WS_WDN = WS_WGU + (size_t)DEPTH * NEXP * 2048 * DM;
constexpr size_t WS_XS = WS_WDN + (size_t)DEPTH * NEXP * DM * DM;
constexpr size_t WS_H = WS_XS + (size_t)NT * DM * 2;
constexpr size_t WS_PBUF = WS_H + (size_t)NT * DM * 2;
constexpr size_t WS_A2 = WS_PBUF + (size_t)NT * PW * 2;
constexpr size_t WS_S5S = WS_A2 + (size_t)16 * S5ROWS * 512 * 2;
constexpr size_t WS_ACT5 = WS_S5S + (size_t)16 * S5ROWS * 256 * 4;
constexpr size_t WS_MIX = WS_ACT5 + (size_t)NT * 256 * 2;
constexpr size_t WS_GDS = WS_MIX + (size_t)NT * MW * 2;
constexpr size_t WS_GDEC = WS_GDS + (size_t)NCHK * 8 * 2048 * 4;
constexpr size_t WS_GSE = WS_GDEC + al256((size_t)NCHK * 8 * 32 * 4);
constexpr size_t WS_SDS = WS_GSE + (size_t)NCHK * 8 * 2048 * 2;
constexpr size_t WS_SDEC = WS_SDS + (size_t)NCHK * 8 * 4096 * 4;
constexpr size_t WS_SSE = WS_SDEC + al256((size_t)NCHK * 8 * 4);
constexpr size_t WS_PE = WS_SSE + (size_t)NCHK * 8 * 4096 * 2;
constexpr size_t WS_PR = WS_PE + (size_t)NT * 4 * 4;
constexpr size_t WS_PG = WS_PR + (size_t)NT * 4 * 4;
constexpr size_t WS_PS = WS_PG + (size_t)NT * 4 * 4;
constexpr size_t WS_SG = WS_PS + (size_t)NT * 4 * 4;
constexpr size_t WS_H8 = WS_SG + (size_t)MAXBLK * 256 * 4;
constexpr size_t WS_TM = WS_H8 + (size_t)NT * DM;
constexpr size_t WS_ACT = WS_TM + (size_t)NEXP * NT * 4;
constexpr size_t WS_Y = WS_ACT + (size_t)MAXBLK * 256 * DM;
constexpr size_t WS_GQI = WS_Y + (size_t)MAXBLK * 256 * DM;
constexpr size_t WS_GOI = WS_GQI + (size_t)NT * 256 * 2;
constexpr size_t WS_SCB = WS_GOI + (size_t)NT * 256 * 2;
constexpr size_t WS_SCUM = WS_SCB + (size_t)NT * 128 * 2;
constexpr size_t WS_SYI = WS_SCUM + (size_t)NT * 8 * 4;
constexpr size_t WS_DFTC = WS_SYI + (size_t)NT * 256 * 2;
constexpr size_t WS_GA2T = WS_DFTC + 512 * 256 * 2;
constexpr size_t WS_END = WS_GA2T + (size_t)DEPTH * 256 * 32 * 2;
constexpr int CW_QUEUE = 64;
constexpr int CW_CNT = 1024;
constexpr int CW_BLKE = 2048;
constexpr int CW_BAR = 8192;

constexpr int LDS_BYTES = 163840, MISC_OFF = LDS_BYTES - 256;

constexpr float W8_SCALE = 32.f, H8_SCALE = 8.f, A8_SCALE = 4.f, Y8_SCALE = 16.f;
__device__ __forceinline__ unsigned pk4f8(float a, float b, float c, float d) { int w = 0; w = __builtin_amdgcn_cvt_pk_fp8_f32(a, b, w, false); w = __builtin_amdgcn_cvt_pk_fp8_f32(c, d, w, true); return (unsigned)w; }
#define RLX_AGENT __ATOMIC_RELAXED, __HIP_MEMORY_SCOPE_AGENT
__device__ __forceinline__ int fresh_tid(int wave0) { int l = (int)__builtin_amdgcn_mbcnt_hi(~0u, __builtin_amdgcn_mbcnt_lo(~0u, 0u)); asm volatile("" : "+v"(l)); return wave0 * 64 + l; }
__device__ __forceinline__ unsigned f2bf(float f) { unsigned u = __builtin_bit_cast(unsigned, f); return (u + 0x7fffu + ((u >> 16) & 1u)) >> 16; }
__device__ __forceinline__ unsigned pk2(float lo, float hi) { return f2bf(lo) | (f2bf(hi) << 16); }
__device__ __forceinline__ float bf2f(unsigned short b) { return __builtin_bit_cast(float, (unsigned)b << 16); }
__device__ __forceinline__ f32x4 f8x4(unsigned w) { const f32x2 lo = __builtin_amdgcn_cvt_pk_f32_fp8((int)w, false), hi = __builtin_amdgcn_cvt_pk_f32_fp8((int)w, true); return (f32x4){lo.x, lo.y, hi.x, hi.y}; }
__device__ __forceinline__ f32x4 bf4(u32x2 w) { return (f32x4){__builtin_bit_cast(float, w.x << 16), __builtin_bit_cast(float, w.x & 0xffff0000u), __builtin_bit_cast(float, w.y << 16), __builtin_bit_cast(float, w.y & 0xffff0000u)}; }
__device__ __forceinline__ float bflo(unsigned w) { return __builtin_bit_cast(float, w << 16); }
__device__ __forceinline__ float bfhi(unsigned w) { return __builtin_bit_cast(float, w & 0xffff0000u); }
template <int M> __device__ __forceinline__ float swz_xor(float v) { return __builtin_bit_cast(float, __builtin_amdgcn_ds_swizzle(__builtin_bit_cast(int, v), (M << 10) | 0x1F)); }
__device__ __forceinline__ float xor32f(float v, int lane) { return __builtin_bit_cast(float, __builtin_amdgcn_ds_bpermute((lane ^ 32) << 2, __builtin_bit_cast(int, v))); }
__device__ __forceinline__ float wave_sum(float v, int lane) { v += swz_xor<1>(v); v += swz_xor<2>(v); v += swz_xor<4>(v); v += swz_xor<8>(v); v += swz_xor<16>(v); v += xor32f(v, lane); return v; }
__device__ __forceinline__ float wave_max(float v, int lane) { v = fmaxf(v, swz_xor<1>(v)); v = fmaxf(v, swz_xor<2>(v)); v = fmaxf(v, swz_xor<4>(v)); v = fmaxf(v, swz_xor<8>(v)); v = fmaxf(v, swz_xor<16>(v)); v = fmaxf(v, xor32f(v, lane)); return v; }
__device__ __forceinline__ float fexp_(float x) { return __builtin_amdgcn_exp2f(1.4426950408889634f * x); }
__device__ __forceinline__ float frcp_(float x) { return __builtin_amdgcn_rcpf(x); }
__device__ __forceinline__ float sigmoidf_(float x) { return frcp_(1.f + fexp_(-x)); }
__device__ __forceinline__ float siluf_(float x) { return x * frcp_(1.f + fexp_(-x)); }

struct Frame {
    LAS unsigned char* lds; volatile LAS unsigned* MISC; unsigned* ctl; unsigned char* ws;
    int tid, lane, wave, G, bid;
};


template <class Fill> struct SgOrder {
    int nblk, nN, R, r, lo, hi; Fill f;
    __device__ __forceinline__ void init(int nblk_, int nN_, int G, int c) { nblk = nblk_; nN = nN_; const int U = nblk * nN; int x, nx;
        if ((G & 7) == 0) { R = G >> 3; x = c & 7; r = c >> 3; nx = 8; } else { R = G; x = 0; r = c; nx = 1; }
        lo = (int)(((long)x * U) / nx); hi = (int)(((long)(x + 1) * U) / nx); }
    __device__ __forceinline__ bool next(int& cursor, pg8::Unit& u) const {
        const int q = lo + r + R * cursor; ++cursor;
        if (q >= hi) return false;
        const int ups = 8 * nN, sg = q / ups, ql = q - sg * ups, nb = (nblk - sg * 8) < 8 ? (nblk - sg * 8) : 8;
        u.pm = sg * 8 + ql % nb; u.pn = ql / nb; f(u); return true;
    }
};
struct FillPlain { size_t astep, bstep; __device__ __forceinline__ void operator()(pg8::Unit& u) const { u.grp = 0; u.aoff = (size_t)u.pm * astep; u.boff = (size_t)u.pn * bstep; } };
struct FillS5 { size_t bgrp; __device__ __forceinline__ void operator()(pg8::Unit& u) const { const int g = u.pm / 9, t = u.pm - g * 9; u.grp = g; u.pm = t; u.aoff = ((size_t)g * S5ROWS + (size_t)t * 256) * 512 * 2; u.boff = (size_t)g * bgrp; } };
struct FillMoe { const LAS unsigned* lblk; int erows; __device__ __forceinline__ void operator()(pg8::Unit& u) const { const int e = (int)lblk[u.pm]; u.grp = e; u.aoff = (size_t)u.pm * 256 * DM; u.boff = ((size_t)e * erows + (size_t)u.pn * 256) * DM; } };
constexpr int MOE_LB = 131072, MOE_LC = MOE_LB + 256, MOE_LBLK = MOE_LC + 256, MOE_GAT = MOE_LBLK + 2560, MOE_MAXU = 26;
static_assert(MOE_GAT + MOE_MAXU * 1024 <= MISC_OFF, "MoE LDS tables");
__device__ __forceinline__ int moe_tables(Frame& F, int L) {
    LAS int* lb = (LAS int*)(F.lds + MOE_LB); LAS int* lc = (LAS int*)(F.lds + MOE_LC); LAS unsigned* lblk = (LAS unsigned*)(F.lds + MOE_LBLK);
    const unsigned* cnt = F.ctl + CW_CNT + L * 64;
    __syncthreads();
    if (F.tid == 0) { int acc = 0; for (int e = 0; e < NEXP; ++e) { lb[e] = acc; const int c = (int)__hip_atomic_load(cnt + e, RLX_AGENT); lc[e] = c; acc += (c + 255) & ~255; } lb[32] = acc; }
    __syncthreads();
    const int nblk = lb[32] >> 8;
    for (int i = F.tid; i < nblk; i += NTHR) { int e = 0; for (int q = 1; q < NEXP; ++q) if (lb[q] <= i * 256) e = q; lblk[i] = (unsigned)e; }
    __syncthreads();
    return nblk;
}
using pg8::cvt_pk_bf16;
struct EpiInproj {
    static constexpr bool PERM = true;
    bf16* P; bf16* A2;
    __device__ __forceinline__ void operator()(const f32x4 (&acc)[2][2][4][2], const pg8::Unit& u, int wr, int wc, int fr, int fq) const {
        const int row0 = u.pm * 256 + wr * 64 + fr, col0 = u.pn * 256 + wc * 32 + 8 * fq;
#pragma unroll
        for (int ai = 0; ai < 2; ++ai)
#pragma unroll
            for (int m = 0; m < 4; ++m) {
                const int row = row0 + ai * 128 + m * 16;
#pragma unroll
                for (int bj = 0; bj < 2; ++bj) {
                    const f32x4 v0 = acc[ai][bj][m][0], v1 = acc[ai][bj][m][1];
                    u32x4 w; w.x = cvt_pk_bf16(v0[0], v0[1]); w.y = cvt_pk_bf16(v0[2], v0[3]); w.z = cvt_pk_bf16(v1[0], v1[1]); w.w = cvt_pk_bf16(v1[2], v1[3]);
                    const int col = col0 + bj * 128;
                    if (u.pn == 1) {
                        const int cc = col - 256, g = cc >> 4, hp = cc & 15;
                        const int crow = row < NLAT ? (row >> 4) : (2048 + ((row - NLAT) >> 4)), s = row & 15;
                        *(u32x4*)(A2 + ((size_t)g * S5ROWS + crow) * 512 + s * 16 + hp) = w;
                    } else if (col < 2088) *(u32x4*)(P + (size_t)row * PW + col) = w;
                }
            }
    }
};
struct EpiOutproj {
    static constexpr bool PERM = true;
    const float* xin; const float* ctxin; bf16* XS; const float* modL; int first;
    __device__ __forceinline__ void operator()(const f32x4 (&acc)[2][2][4][2], const pg8::Unit& u, int wr, int wc, int fr, int fq) const {
        const int rowt = u.pm * 256, bi = rowt < NLAT ? (rowt >> 12) : 8;
        const int row0 = rowt + wr * 64 + fr, col0 = u.pn * 256 + wc * 32 + 8 * fq;
        const float* gate = modL + (size_t)bi * 6144 + 2 * 1024;
        f32x4 gv[2][2];
#pragma unroll
        for (int bj = 0; bj < 2; ++bj)
#pragma unroll
            for (int n = 0; n < 2; ++n) gv[bj][n] = *(const f32x4*)(gate + col0 + bj * 128 + 4 * n);
#pragma unroll
        for (int ai = 0; ai < 2; ++ai)
#pragma unroll
            for (int m = 0; m < 4; ++m) {
                const int row = row0 + ai * 128 + m * 16;
                bf16* dst = XS + (size_t)row * DM;
#pragma unroll
                for (int bj = 0; bj < 2; ++bj) { const int c = col0 + bj * 128; f32x4 x0, x1;
                    if (first) { const float* src = (row < NLAT ? xin + (size_t)row * DM : ctxin + (size_t)(row - NLAT) * DM) + c; x0 = *(const f32x4*)src; x1 = *(const f32x4*)(src + 4); }
                    else { const u32x4 w = *(const u32x4*)(dst + c); x0 = bf4((u32x2){w.x, w.y}); x1 = bf4((u32x2){w.z, w.w}); }
                    x0 += gv[bj][0] * acc[ai][bj][m][0]; x1 += gv[bj][1] * acc[ai][bj][m][1];
                    u32x4 o; o.x = cvt_pk_bf16(x0[0], x0[1]); o.y = cvt_pk_bf16(x0[2], x0[3]); o.z = cvt_pk_bf16(x1[0], x1[1]); o.w = cvt_pk_bf16(x1[2], x1[3]);
                    *(u32x4*)(dst + c) = o; }
            }
    }
};
struct EpiSwiglu {
    static constexpr bool PERM = true;
    unsigned char* ACT; const float* bgu;
    __device__ __forceinline__ void operator()(const f32x4 (&acc)[2][2][4][2], const pg8::Unit& u, int wr, int wc, int fr, int fq) const {
        const int row0 = u.pm * 256 + wr * 64 + fr, i0 = u.pn * 128 + wc * 32 + 8 * fq;
        const float* bb = bgu + (size_t)u.grp * 2048 + 2 * i0;
        const f32x4 b0 = *(const f32x4*)(bb), b1 = *(const f32x4*)(bb + 4), b2 = *(const f32x4*)(bb + 8), b3 = *(const f32x4*)(bb + 12);
        const float bg[8] = {b0[0], b0[2], b1[0], b1[2], b2[0], b2[2], b3[0], b3[2]}, bu[8] = {b0[1], b0[3], b1[1], b1[3], b2[1], b2[3], b3[1], b3[3]};
        constexpr float inv = 1.f / (H8_SCALE * W8_SCALE);
#pragma unroll
        for (int ai = 0; ai < 2; ++ai)
#pragma unroll
            for (int m = 0; m < 4; ++m) {
                const int row = row0 + ai * 128 + m * 16;
                float o[8];
#pragma unroll
                for (int n = 0; n < 2; ++n)
#pragma unroll
                    for (int jp = 0; jp < 2; ++jp) {
                        const int q = 4 * n + 2 * jp;
                        f32x2 gt = (f32x2){acc[ai][0][m][n][2 * jp], acc[ai][0][m][n][2 * jp + 1]} * inv + (f32x2){bg[q], bg[q + 1]};
                        f32x2 up = (f32x2){acc[ai][1][m][n][2 * jp], acc[ai][1][m][n][2 * jp + 1]} * inv + (f32x2){bu[q], bu[q + 1]};
                        gt.x = fminf(gt.x, 7.0f); gt.y = fminf(gt.y, 7.0f);
                        up.x = __builtin_amdgcn_fmed3f(up.x, -7.0f, 7.0f); up.y = __builtin_amdgcn_fmed3f(up.y, -7.0f, 7.0f);
                        const f32x2 ea = gt * (-1.702f * 1.4426950408889634f);
                        f32x2 den; den.x = __builtin_amdgcn_exp2f(ea.x); den.y = __builtin_amdgcn_exp2f(ea.y); den = den + 1.0f;
                        f32x2 sg; sg.x = __builtin_amdgcn_rcpf(den.x); sg.y = __builtin_amdgcn_rcpf(den.y);
                        const f32x2 r = (up * A8_SCALE + A8_SCALE) * gt * sg;
                        o[q] = r.x; o[q + 1] = r.y;
                    }
                u32x2 w; w.x = pk4f8(o[0], o[1], o[2], o[3]); w.y = pk4f8(o[4], o[5], o[6], o[7]);
                *(u32x2*)(ACT + (size_t)row * DM + i0) = w;
            }
    }
};
struct EpiDown {
    static constexpr bool PERM = true;
    unsigned char* Y; const float* bdn; const float* sg;
    __device__ __forceinline__ void operator()(const f32x4 (&acc)[2][2][4][2], const pg8::Unit& u, int wr, int wc, int fr, int fq) const {
        const int row0 = u.pm * 256 + wr * 64 + fr, col0 = u.pn * 256 + wc * 32 + 8 * fq;
        const float* bb = bdn + (size_t)u.grp * DM + col0;
        constexpr float inv = 1.f / (A8_SCALE * W8_SCALE);
        f32x4 bv[2][2];
#pragma unroll
        for (int bj = 0; bj < 2; ++bj)
#pragma unroll
            for (int n = 0; n < 2; ++n) bv[bj][n] = *(const f32x4*)(bb + bj * 128 + 4 * n);
#pragma unroll
        for (int ai = 0; ai < 2; ++ai)
#pragma unroll
            for (int m = 0; m < 4; ++m) {
                const int row = row0 + ai * 128 + m * 16; const float gt = sg[row] * Y8_SCALE;
#pragma unroll
                for (int bj = 0; bj < 2; ++bj) {
                    const f32x4 v0 = (acc[ai][bj][m][0] * inv + bv[bj][0]) * gt, v1 = (acc[ai][bj][m][1] * inv + bv[bj][1]) * gt;
                    u32x2 w; w.x = pk4f8(v0[0], v0[1], v0[2], v0[3]); w.y = pk4f8(v1[0], v1[1], v1[2], v1[3]);
                    *(u32x2*)(Y + (size_t)row * DM + col0 + bj * 128) = w;
                }
            }
    }
};
struct EpiNull { static constexpr bool PERM = true; float* sink;
    __device__ __forceinline__ void operator()(const f32x4 (&acc)[2][2][4][2], const pg8::Unit& u, int wr, int wc, int fr, int fq) const { float s = 0.f;
#pragma unroll
        for (int ai = 0; ai < 2; ++ai)
#pragma unroll
            for (int bj = 0; bj < 2; ++bj)
#pragma unroll
                for (int m = 0; m < 4; ++m)
#pragma unroll
                    for (int n = 0; n < 2; ++n) s += acc[ai][bj][m][n][0];
        if (s == 12345.678f) sink[u.pm] = s; } };
struct EpiS5S {
    static constexpr bool PERM = false;
    float* S;
    __device__ __forceinline__ void operator()(const f32x4 (&acc)[2][2][4][2], const pg8::Unit& u, int wr, int wc, int fr, int fq) const {
        const int row0 = u.pm * 256 + wr * 64 + fr, col0 = wc * 32 + 4 * fq;
        float* base = S + (size_t)u.grp * S5ROWS * 256;
#pragma unroll
        for (int ai = 0; ai < 2; ++ai)
#pragma unroll
            for (int m = 0; m < 4; ++m) { float* rp = base + (size_t)(row0 + ai * 128 + m * 16) * 256 + col0;
#pragma unroll
                for (int bj = 0; bj < 2; ++bj)
#pragma unroll
                    for (int n = 0; n < 2; ++n) *(f32x4*)(rp + bj * 128 + n * 16) = acc[ai][bj][m][n]; }
    }
};
__device__ __forceinline__ float gelu_tanh(float x) { const float t = 0.7978845608f * (x + 0.044715f * x * x * x); return x * frcp_(1.f + fexp_(-2.f * t)); }
struct EpiS5Y {
    static constexpr bool PERM = true;
    bf16* ACT5;
    __device__ __forceinline__ void operator()(const f32x4 (&acc)[2][2][4][2], const pg8::Unit& u, int wr, int wc, int fr, int fq) const {
        const int row0 = u.pm * 256 + wr * 64 + fr, col0 = wc * 32 + 8 * fq;
#pragma unroll
        for (int ai = 0; ai < 2; ++ai)
#pragma unroll
            for (int m = 0; m < 4; ++m) {
                const int crow = row0 + ai * 128 + m * 16;
                if (crow >= 2176) continue;
                const int tok0 = crow < 2048 ? crow * 16 : NLAT + (crow - 2048) * 16;
#pragma unroll
                for (int bj = 0; bj < 2; ++bj) {
                    const int col = col0 + bj * 128, j = col >> 4, h = col & 15;
                    const f32x4 v0 = acc[ai][bj][m][0], v1 = acc[ai][bj][m][1];
                    u32x4 w; w.x = cvt_pk_bf16(gelu_tanh(v0[0]), gelu_tanh(v0[1])); w.y = cvt_pk_bf16(gelu_tanh(v0[2]), gelu_tanh(v0[3]));
                    w.z = cvt_pk_bf16(gelu_tanh(v1[0]), gelu_tanh(v1[1])); w.w = cvt_pk_bf16(gelu_tanh(v1[2]), gelu_tanh(v1[3]));
                    *(u32x4*)(ACT5 + (size_t)(tok0 + j) * 256 + u.grp * 16 + h) = w;
                }
            }
    }
};
struct EpiGlu {
    static constexpr bool PERM = true;
    const bf16* ACT5; bf16* MIX;
    __device__ __forceinline__ void operator()(const f32x4 (&acc)[2][2][4][2], const pg8::Unit& u, int wr, int wc, int fr, int fq) const {
        const int row0 = u.pm * 256 + wr * 64 + fr, col0 = wc * 32 + 8 * fq;
#pragma unroll
        for (int ai = 0; ai < 2; ++ai)
#pragma unroll
            for (int m = 0; m < 4; ++m) {
                const int row = row0 + ai * 128 + m * 16;
#pragma unroll
                for (int bj = 0; bj < 2; ++bj) {
                    const int col = col0 + bj * 128;
                    const u32x4 a = *(const u32x4*)(ACT5 + (size_t)row * 256 + col);
                    const f32x4 v0 = acc[ai][bj][m][0], v1 = acc[ai][bj][m][1];
                    u32x4 w;
                    w.x = cvt_pk_bf16(bflo(a.x) * sigmoidf_(v0[0]), bfhi(a.x) * sigmoidf_(v0[1])); w.y = cvt_pk_bf16(bflo(a.y) * sigmoidf_(v0[2]), bfhi(a.y) * sigmoidf_(v0[3]));
                    w.z = cvt_pk_bf16(bflo(a.z) * sigmoidf_(v1[0]), bfhi(a.z) * sigmoidf_(v1[1])); w.w = cvt_pk_bf16(bflo(a.w) * sigmoidf_(v1[2]), bfhi(a.w) * sigmoidf_(v1[3]));
                    *(u32x4*)(MIX + (size_t)row * MW + 512 + col) = w;
                }
            }
    }
};

struct Args { const float* in[N_IN]; float* out; unsigned char* ws; int ph_lo, ph_hi; };
typedef const __attribute__((address_space(4))) Args CArgs;
__device__ __forceinline__ CArgs* fresh_args() { CArgs* p = (CArgs*)__builtin_amdgcn_kernarg_segment_ptr(); asm volatile("" : "+s"(p)); return p; }

template <class Map> __device__ __forceinline__ void transpose_tile(const float* W, int ldw, int ncols, int k0, int n0, bf16* WT, int ldt, int kd0, const Map& map, LAS float* scr, int lane) {
    { const int c4 = (lane & 15) * 4, r4 = lane >> 4; const bool ok = n0 + c4 < ncols;
#pragma unroll
      for (int q = 0; q < 16; ++q) { const int kk = q * 4 + r4; const f32x4 v = ok ? *(const f32x4*)(W + (size_t)(k0 + kk) * ldw + n0 + c4) : (f32x4){0.f, 0.f, 0.f, 0.f};
          scr[kk * 65 + c4] = v[0]; scr[kk * 65 + c4 + 1] = v[1]; scr[kk * 65 + c4 + 2] = v[2]; scr[kk * 65 + c4 + 3] = v[3]; } }
    asm volatile("s_waitcnt lgkmcnt(0)" ::: "memory");
    const int c = lane & 7;
#pragma unroll
    for (int j = 0; j < 8; ++j) {
        const int n = (lane >> 3) + 8 * j; const LAS float* s = scr + (8 * c) * 65 + n;
        u32x4 o; o.x = pk2(s[0], s[65]); o.y = pk2(s[2 * 65], s[3 * 65]); o.z = pk2(s[4 * 65], s[5 * 65]); o.w = pk2(s[6 * 65], s[7 * 65]);
        const int dr = (n0 + n) < ncols ? map(n0 + n) : -1;
        if (dr >= 0) *(u32x4*)(WT + (size_t)dr * ldt + kd0 + 8 * c) = o;
    }
    asm volatile("s_waitcnt lgkmcnt(0)" ::: "memory");
}
struct MapId { __device__ __forceinline__ int operator()(int n) const { return n; } };
struct MapWin { __device__ __forceinline__ int operator()(int c) const { return c < 1280 ? c : (c < 1312 ? 2048 + (c - 1280) : (c < 2080 ? c - 32 : c)); } };
struct MapGu { __device__ __forceinline__ int operator()(int n) const { const int i = n >> 1; return (i >> 7) * 256 + (n & 1) * 128 + (i & 127); } };

template <class Map> __device__ __forceinline__ void transpose_tile_f8(const float* W, int ldw, int k0, int n0, unsigned char* WT, int ldt, const Map& map, LAS float* scr, int lane) {
    { const int c4 = (lane & 15) * 4, r4 = lane >> 4;
#pragma unroll
      for (int q = 0; q < 16; ++q) { const int kk = q * 4 + r4; const f32x4 v = *(const f32x4*)(W + (size_t)(k0 + kk) * ldw + n0 + c4);
          scr[kk * 65 + c4] = v[0]; scr[kk * 65 + c4 + 1] = v[1]; scr[kk * 65 + c4 + 2] = v[2]; scr[kk * 65 + c4 + 3] = v[3]; } }
    asm volatile("s_waitcnt lgkmcnt(0)" ::: "memory");
    const int c = lane & 7;
#pragma unroll
    for (int j = 0; j < 8; ++j) {
        const int n = (lane >> 3) + 8 * j; const LAS float* s = scr + (8 * c) * 65 + n;
        u32x2 o; o.x = pk4f8(s[0] * W8_SCALE, s[65] * W8_SCALE, s[2 * 65] * W8_SCALE, s[3 * 65] * W8_SCALE); o.y = pk4f8(s[4 * 65] * W8_SCALE, s[5 * 65] * W8_SCALE, s[6 * 65] * W8_SCALE, s[7 * 65] * W8_SCALE);
        *(u32x2*)(WT + (size_t)map(n0 + n) * ldt + k0 + 8 * c) = o;
    }
    asm volatile("s_waitcnt lgkmcnt(0)" ::: "memory");
}
constexpr int PI_ADA = 48, PI_TAB = 1, PI_S5 = 64, PI_FOLD = 256, PI_ZERO = 4;
constexpr int TW_WIN = 16 * 33, TW_GU = 32 * 16 * 32, TW_DN = 32 * 16 * 16, TW_WOUT = 12 * 16, TW_GLU = 16, TW_LAYER = TW_WIN + TW_GU + TW_DN + TW_WOUT + TW_GLU;
constexpr int PI_TR = (DEPTH * TW_LAYER + 7) / 8;
constexpr int PI_B_TAB = PI_ADA, PI_B_S5 = PI_B_TAB + PI_TAB, PI_B_FOLD = PI_B_S5 + PI_S5, PI_B_ZERO = PI_B_FOLD + PI_FOLD, PI_B_TR = PI_B_ZERO + PI_ZERO, PI_TOTAL = PI_B_TR + (PI_TR + 3) / 4;

__device__ __forceinline__ void pro_adaln(Frame& F, CArgs& a, int it) {
    const int L = it / 12, cb = it % 12;
    LAS float* cond = (LAS float*)F.lds;
    for (int i = F.tid; i < 9 * 1024; i += NTHR) { const int r = i >> 10, k = i & 1023; const float v = r < 8 ? a.in[I_C][r * 1024 + k] : a.in[I_CCTX][k]; cond[i] = siluf_(v); }
    __syncthreads();
    const int n = cb * 512 + F.tid;
    const float* w = a.in[I_ADAW] + (size_t)L * 1024 * 6144 + n;
    float acc[9];
    const float b = a.in[I_ADAB][L * 6144 + n];
#pragma unroll
    for (int r = 0; r < 9; ++r) acc[r] = b;
#pragma unroll 8
    for (int k = 0; k < 1024; k += 4) {
        const float w0 = w[(size_t)k * 6144], w1 = w[(size_t)(k + 1) * 6144], w2 = w[(size_t)(k + 2) * 6144], w3 = w[(size_t)(k + 3) * 6144];
#pragma unroll
        for (int r = 0; r < 9; ++r) { const f32x4 c4 = *(const LAS f32x4*)(cond + r * 1024 + k); acc[r] += c4[0] * w0 + c4[1] * w1 + c4[2] * w2 + c4[3] * w3; }
    }
    float* mod = (float*)(F.ws + WS_MOD) + (size_t)L * 9 * 6144 + n;
#pragma unroll
    for (int r = 0; r < 9; ++r) mod[(size_t)r * 6144] = acc[r];
    __syncthreads();
}
__device__ __forceinline__ void pro_tables(Frame& F, CArgs& a) {
    { bf16* gt = (bf16*)(F.ws + WS_GA2T);
      for (int i = F.tid; i < DEPTH * 256 * 32; i += NTHR) { const int L = i >> 13, col = (i >> 5) & 255, k = i & 31, r = col >> 7, c = col & 127;
          gt[i] = (bf16)f2bf((k >> 4) == r ? a.in[I_GLAA2][((size_t)(L * 2 + r) * 16 + (k & 15)) * 128 + c] : 0.f); } }
    bf16* f64 = (bf16*)(F.ws + WS_TAB + TAB_F64);
    for (int i = F.tid; i < 4096; i += NTHR) { const int k = i >> 6, n = i & 63; float s, c; sincospif((float)((k * n) & 63) / 32.f, &s, &c); f64[i] = (bf16)f2bf(c); f64[4096 + i] = (bf16)f2bf(s); }
    float* tw = (float*)(F.ws + WS_TAB + TAB_TW);
    for (int i = F.tid; i < 4096; i += NTHR) { float s, c; sincospif((float)i / 2048.f, &s, &c); tw[2 * i] = c; tw[2 * i + 1] = s; }
    bf16* dc = (bf16*)(F.ws + WS_DFTC);
    for (int i = F.tid; i < 65536; i += NTHR) { const int k = i >> 8, n = i & 255; float s, c; sincospif((float)((k * n) & 255) / 128.f, &s, &c); dc[i] = (bf16)f2bf(c); dc[65536 + i] = (bf16)f2bf(-s); }
    float* d256 = (float*)(F.ws + WS_TAB + TAB_D256);
    for (int i = F.tid; i < 256; i += NTHR) { float s, c; sincospif((float)i / 128.f, &s, &c); d256[2 * i] = c; d256[2 * i + 1] = s; }
}
__device__ __forceinline__ void pro_fold(Frame& F, CArgs& a, int it) {
    const int L = it >> 6, h = (it >> 4) & 3, nb = it & 15, n0 = nb * 64;
    LAS float* fw = (LAS float*)F.lds;
    LAS float* ct = fw + 64 * 65;
    LAS float* swo = ct + 64;
    LAS float* sfo = swo + 256 * 64;
    if (F.tid < 64) ct[F.tid] = cospif((float)F.tid / 32.f);
    const float* four = a.in[I_FOURW] + (size_t)L * 256 * 256 + (size_t)h * 64 * 256, *wo = a.in[I_WOUT] + (size_t)L * 1024 * 1024 + n0;
    { f32x4 va[8], vb[8];
#pragma unroll
      for (int k = 0; k < 8; ++k) { const int i = F.tid + k * NTHR, j = i >> 4, c4 = (i & 15) * 4; va[k] = *(const f32x4*)(wo + (size_t)j * 1024 + c4); vb[k] = *(const f32x4*)(four + (size_t)i * 4); }
#pragma unroll
      for (int k = 0; k < 8; ++k) { const int i = F.tid + k * NTHR, j = i >> 4, c4 = (i & 15) * 4; *(LAS f32x4*)(swo + j * 64 + c4) = va[k]; *(LAS f32x4*)(sfo + i * 4) = vb[k]; } }
    __syncthreads();
    const int n = F.tid & 63, cg = F.tid >> 6;
    { float s[8];
#pragma unroll
      for (int i = 0; i < 8; ++i) s[i] = 0.f;
#pragma unroll 4
      for (int j = 0; j < 256; j += 4) { const float w0 = swo[j * 64 + n], w1 = swo[(j + 1) * 64 + n], w2 = swo[(j + 2) * 64 + n], w3 = swo[(j + 3) * 64 + n];
#pragma unroll
          for (int i = 0; i < 8; ++i) { const f32x4 f4 = *(const LAS f32x4*)(sfo + (cg * 8 + i) * 256 + j); s[i] += f4[0] * w0 + f4[1] * w1 + f4[2] * w2 + f4[3] * w3; } }
#pragma unroll
      for (int i = 0; i < 8; ++i) fw[(cg * 8 + i) * 65 + n] = s[i]; }
    __syncthreads();
    float oc[8], os[8];
#pragma unroll
    for (int i = 0; i < 8; ++i) { oc[i] = 0.f; os[i] = 0.f; }
    for (int kc = 0; kc < 64; ++kc) { const float v = fw[kc * 65 + n];
#pragma unroll
        for (int i = 0; i < 8; ++i) { const int mm = (kc * (cg * 8 + i)) & 63; oc[i] += ct[mm] * v; os[i] += ct[(mm + 48) & 63] * v; } }
    bf16* wt = (bf16*)(F.ws + WS_WOUT) + (size_t)L * DM * MW + (size_t)(n0 + n) * MW + h * 64 + cg * 8;
    u32x4 w; w.x = pk2(oc[0] * 0.125f, oc[1] * 0.125f); w.y = pk2(oc[2] * 0.125f, oc[3] * 0.125f); w.z = pk2(oc[4] * 0.125f, oc[5] * 0.125f); w.w = pk2(oc[6] * 0.125f, oc[7] * 0.125f);
    *(u32x4*)wt = w;
    w.x = pk2(os[0] * 0.125f, os[1] * 0.125f); w.y = pk2(os[2] * 0.125f, os[3] * 0.125f); w.z = pk2(os[4] * 0.125f, os[5] * 0.125f); w.w = pk2(os[6] * 0.125f, os[7] * 0.125f);
    *(u32x4*)(wt + 256) = w;
    __syncthreads();
}
__device__ __forceinline__ void pro_s5(Frame& F, CArgs& a, int it) {
    const int L = it >> 4, g = it & 15;
    LAS float* pw = (LAS float*)F.lds;
    LAS float* bb = pw + 2 * 64 * 17 * 2;
    LAS float* cm = bb + 2 * 64 * 16 * 2;
    LAS float* kt = cm + 2 * 16 * 64 * 2;
    for (int i = F.tid; i < 2 * 64 * 17; i += NTHR) {
        const int r = i / (64 * 17), p = (i / 17) & 63, e = i % 17; const size_t q = ((size_t)(L * 2 + r) * 16 + g) * 64 + p;
        const float dt = __expf(a.in[I_S5LDT][(L * 2 + r) * 16 + g]); const float lr = a.in[I_S5LRE][q] * dt, li = a.in[I_S5LIM][q] * dt;
        float s, c; sincosf(li * (float)e, &s, &c); const float m = expf(lr * (float)e); pw[2 * i] = m * c; pw[2 * i + 1] = m * s;
    }
    for (int i = F.tid; i < 2 * 64 * 16; i += NTHR) {
        const int r = i >> 10, p = (i >> 4) & 63, h = i & 15; const size_t q = ((size_t)(L * 2 + r) * 16 + g) * 64 + p;
        const float dt = __expf(a.in[I_S5LDT][(L * 2 + r) * 16 + g]); const float lre = a.in[I_S5LRE][q], lim = a.in[I_S5LIM][q];
        float s, c; sincosf(lim * dt, &s, &c); const float m = expf(lre * dt); const float ar = m * c - 1.f, ai = m * s;
        const float den = 1.f / (lre * lre + lim * lim); const float cr = (ar * lre + ai * lim) * den, ci = (ai * lre - ar * lim) * den;
        const float br = a.in[I_S5BRE][q * 16 + h], bi = a.in[I_S5BIM][q * 16 + h];
        bb[2 * i] = cr * br - ci * bi; bb[2 * i + 1] = cr * bi + ci * br;
    }
    for (int i = F.tid; i < 2 * 16 * 64; i += NTHR) {
        const int r = i >> 10, h = (i >> 6) & 15, p = i & 63; const size_t q = (((size_t)(L * 2 + r) * 16 + g) * 16 + h) * 64 + p;
        cm[2 * i] = a.in[I_S5CRE][q]; cm[2 * i + 1] = a.in[I_S5CIM][q];
    }
    __syncthreads();
    for (int i = F.tid; i < 2 * 16 * 256; i += NTHR) {
        const int r = i >> 12, tau = (i >> 8) & 15, h = (i >> 4) & 15, hp = i & 15; float s = 0.f;
        for (int p = 0; p < 64; ++p) { const float cr = cm[2 * ((r * 16 + h) * 64 + p)], ci = cm[2 * ((r * 16 + h) * 64 + p) + 1];
            const float ar = pw[2 * ((r * 64 + p) * 17 + tau)], ai = pw[2 * ((r * 64 + p) * 17 + tau) + 1]; const float br = bb[2 * ((r * 64 + p) * 16 + hp)], bi = bb[2 * ((r * 64 + p) * 16 + hp) + 1];
            const float tr = cr * ar - ci * ai, ti = cr * ai + ci * ar; s += tr * br - ti * bi; }
        kt[i] = s;
    }
    __syncthreads();
    bf16* pt = (bf16*)(F.ws + WS_S5P) + (size_t)(L * 16 + g) * 256 * 256;
    for (int i = F.tid; i < 65536; i += NTHR) {
        const int np = i >> 8, k = i & 255, r = np >> 7, cpx = (np >> 6) & 1, p = np & 63, s = k >> 4, hp = k & 15, e = r ? s : 15 - s;
        const float ar = pw[2 * ((r * 64 + p) * 17 + e)], ai = pw[2 * ((r * 64 + p) * 17 + e) + 1]; const float br = bb[2 * ((r * 64 + p) * 16 + hp)], bi = bb[2 * ((r * 64 + p) * 16 + hp) + 1];
        pt[i] = (bf16)f2bf(cpx ? ar * bi + ai * br : ar * br - ai * bi);
    }
    bf16* b2 = (bf16*)(F.ws + WS_S5B2) + (size_t)(L * 16 + g) * 256 * 512;
    const float* dsk = a.in[I_S5D] + L * 256 + g * 16;
    for (int i = F.tid; i < 131072; i += NTHR) {
        const int n = i >> 9, k = i & 511, j = n >> 4, h = n & 15; float v;
        if (k < 256) { const int s = k >> 4, hp = k & 15; v = 0.f;
            if (j >= s) v += kt[((0 * 16 + (j - s)) * 16 + h) * 16 + hp];
            if (j <= s) v += kt[((1 * 16 + (s - j)) * 16 + h) * 16 + hp];
            if (j == s && h == hp) v += dsk[h];
        } else { const int kk = k - 256, r = kk >> 7, cpx = (kk >> 6) & 1, p = kk & 63, e = r ? 16 - j : j + 1;
            const float cr = cm[2 * ((r * 16 + h) * 64 + p)], ci = cm[2 * ((r * 16 + h) * 64 + p) + 1]; const float ar = pw[2 * ((r * 64 + p) * 17 + e)], ai = pw[2 * ((r * 64 + p) * 17 + e) + 1];
            v = cpx ? -(cr * ai + ci * ar) : (cr * ar - ci * ai); }
        b2[i] = (bf16)f2bf(v);
    }
    float* a16 = (float*)(F.ws + WS_A16) + (size_t)((L * 2) * 16 + g) * 128;
    if (F.tid < 128) { const int r = F.tid >> 6, p = F.tid & 63; float* o = a16 + (size_t)r * 16 * 128 + p * 2; o[0] = pw[2 * ((r * 64 + p) * 17 + 16)]; o[1] = pw[2 * ((r * 64 + p) * 17 + 16) + 1]; }
    __syncthreads();
}
struct TDesc { const float* src; unsigned char* dst; int ldw, ncols, k0, n0, ldt, kd0, kind, valid; };
__device__ __forceinline__ TDesc tr_decode(Frame& F, int wi) {
    TDesc d; d.valid = wi < DEPTH * TW_LAYER; d.src = nullptr; d.dst = nullptr; d.ldw = d.ncols = d.k0 = d.n0 = d.ldt = d.kd0 = d.kind = 0;
    if (!d.valid) return d;
    const int L = wi / TW_LAYER; int r = wi % TW_LAYER;
    if (r < TW_WIN) { const int kb = r / 33, nb = r % 33; d.src = fresh_args()->in[I_WIN] + (size_t)L * DM * 2088; d.ldw = 2088; d.ncols = 2088; d.k0 = kb * 64; d.n0 = nb * 64; d.dst = F.ws + WS_WIN + (size_t)L * PW * DM * 2; d.ldt = DM; d.kd0 = kb * 64; d.kind = 0; return d; } r -= TW_WIN;
    if (r < TW_GU) { const int e = r >> 9, kb = (r >> 5) & 15, nb = r & 31; d.src = fresh_args()->in[I_WGU] + ((size_t)L * NEXP + e) * DM * 2048; d.ldw = 2048; d.ncols = 2048; d.k0 = kb * 64; d.n0 = nb * 64; d.dst = F.ws + WS_WGU + ((size_t)L * NEXP + e) * 2048 * DM; d.ldt = DM; d.kd0 = kb * 64; d.kind = 1; return d; } r -= TW_GU;
    if (r < TW_DN) { const int e = r >> 8, kb = (r >> 4) & 15, nb = r & 15; d.src = fresh_args()->in[I_WDN] + ((size_t)L * NEXP + e) * DM * DM; d.ldw = DM; d.ncols = DM; d.k0 = kb * 64; d.n0 = nb * 64; d.dst = F.ws + WS_WDN + ((size_t)L * NEXP + e) * DM * DM; d.ldt = DM; d.kd0 = kb * 64; d.kind = 2; return d; } r -= TW_DN;
    if (r < TW_WOUT) { const int kb = r >> 4, nb = r & 15; d.src = fresh_args()->in[I_WOUT] + (size_t)L * DM * DM + (size_t)256 * DM; d.ldw = DM; d.ncols = DM; d.k0 = kb * 64; d.n0 = nb * 64; d.dst = F.ws + WS_WOUT + (size_t)L * DM * MW * 2; d.ldt = MW; d.kd0 = 512 + kb * 64; d.kind = 3; return d; } r -= TW_WOUT;
    { const int kb = r >> 2, nb = r & 3; d.src = fresh_args()->in[I_S5GLU] + (size_t)L * 256 * 256; d.ldw = 256; d.ncols = 256; d.k0 = kb * 64; d.n0 = nb * 64; d.dst = F.ws + WS_WGLU + (size_t)L * 256 * 256 * 2; d.ldt = 256; d.kd0 = kb * 64; d.kind = 3; }
    return d;
}
__device__ __forceinline__ void tr_load(const TDesc& d, f32x4 (&v)[16], int lane) {
    if (!d.valid) return;
    const int c4 = (lane & 15) * 4, r4 = lane >> 4; const bool ok = d.n0 + c4 < d.ncols;
#pragma unroll
    for (int q = 0; q < 16; ++q) v[q] = ok ? *(const f32x4*)(d.src + (size_t)(d.k0 + q * 4 + r4) * d.ldw + d.n0 + c4) : (f32x4){0.f, 0.f, 0.f, 0.f};
}
__device__ __forceinline__ void tr_finish(const TDesc& d, const f32x4 (&v)[16], LAS float* scr, int lane) {
    if (!d.valid) return;
    { const int c4 = (lane & 15) * 4, r4 = lane >> 4;
#pragma unroll
      for (int q = 0; q < 16; ++q) { const int kk = q * 4 + r4; scr[kk * 65 + c4] = v[q][0]; scr[kk * 65 + c4 + 1] = v[q][1]; scr[kk * 65 + c4 + 2] = v[q][2]; scr[kk * 65 + c4 + 3] = v[q][3]; } }
    asm volatile("s_waitcnt lgkmcnt(0)" ::: "memory");
    const int c = lane & 7;
    if (d.kind == 1 || d.kind == 2) {
#pragma unroll
        for (int j = 0; j < 8; ++j) { const int n = (lane >> 3) + 8 * j; const LAS float* s = scr + (8 * c) * 65 + n;
            u32x2 o; o.x = pk4f8(s[0] * W8_SCALE, s[65] * W8_SCALE, s[2 * 65] * W8_SCALE, s[3 * 65] * W8_SCALE); o.y = pk4f8(s[4 * 65] * W8_SCALE, s[5 * 65] * W8_SCALE, s[6 * 65] * W8_SCALE, s[7 * 65] * W8_SCALE);
            const int nn = d.n0 + n, dr = d.kind == 1 ? MapGu()(nn) : nn;
            *(u32x2*)(d.dst + (size_t)dr * d.ldt + d.kd0 + 8 * c) = o; }
    } else {
#pragma unroll
        for (int j = 0; j < 8; ++j) { const int n = (lane >> 3) + 8 * j; const LAS float* s = scr + (8 * c) * 65 + n;
            u32x4 o; o.x = pk2(s[0], s[65]); o.y = pk2(s[2 * 65], s[3 * 65]); o.z = pk2(s[4 * 65], s[5 * 65]); o.w = pk2(s[6 * 65], s[7 * 65]);
            const int nn = d.n0 + n;
            if (nn < d.ncols) { const int dr = d.kind == 0 ? MapWin()(nn) : nn; *(u32x4*)((bf16*)d.dst + (size_t)dr * d.ldt + d.kd0 + 8 * c) = o; } }
    }
    asm volatile("s_waitcnt lgkmcnt(0)" ::: "memory");
}
__device__ __forceinline__ void pro_transposes4(Frame& F, int ticket) {
    LAS float* scr = (LAS float*)F.lds + F.wave * (64 * 65);
    const int w0 = ticket * 32 + F.wave;
    f32x4 va[16], vb[16];
    const TDesc d0 = tr_decode(F, w0); tr_load(d0, va, F.lane);
    const TDesc d1 = tr_decode(F, w0 + 8); tr_load(d1, vb, F.lane); tr_finish(d0, va, scr, F.lane);
    const TDesc d2 = tr_decode(F, w0 + 16); tr_load(d2, va, F.lane); tr_finish(d1, vb, scr, F.lane);
    const TDesc d3 = tr_decode(F, w0 + 24); tr_load(d3, vb, F.lane); tr_finish(d2, va, scr, F.lane);
    tr_finish(d3, vb, scr, F.lane);
}
__device__ __forceinline__ void p_prologue(Frame& F0, CArgs& a, int qw = CW_QUEUE) {
    for (;;) {
        if (F0.tid == 0) F0.MISC[0] = __hip_atomic_fetch_add(F0.ctl + qw, 1u, RLX_AGENT);
        __syncthreads();
        const int it = (int)F0.MISC[0];
        __syncthreads();
        if (it >= PI_TOTAL) break;
        Frame F = F0; { const int t_ = fresh_tid(F.wave); F.tid = t_; F.lane = t_ & 63; }
        if (it < PI_B_TAB) pro_adaln(F, *fresh_args(), it);
        else if (it < PI_B_S5) pro_tables(F, *fresh_args());
        else if (it < PI_B_FOLD) pro_s5(F, *fresh_args(), it - PI_B_S5);
        else if (it < PI_B_ZERO) pro_fold(F, *fresh_args(), it - PI_B_FOLD);
        else if (it < PI_B_TR) { const int L = it - PI_B_ZERO; u32x4* z = (u32x4*)((bf16*)(F.ws + WS_WIN) + (size_t)L * PW * DM + (size_t)2088 * DM); for (int i = F.tid; i < (PW - 2088) * DM / 8; i += NTHR) z[i] = (u32x4){0u, 0u, 0u, 0u}; }
        else pro_transposes4(F, it - PI_B_TR);
    }
}

__device__ __forceinline__ void p_norm1(Frame& F, CArgs& a, int L, bool dry = false) {
    const int gw = F.bid * NWAVES + F.wave, NGW = F.G * NWAVES;
    bf16* XS = (bf16*)(F.ws + WS_XS); bf16* H = (bf16*)(F.ws + WS_H);
    const float* mod = (const float*)(F.ws + WS_MOD) + (size_t)L * 9 * 6144; const float* modp = mod - 9 * 6144;
    const int* PS = (const int*)(F.ws + WS_PS); const unsigned char* Y = (const unsigned char*)(F.ws + WS_Y);
    const float* g = a.in[I_NMG] + L * DM;
    const float* xin = a.in[I_X]; const float* cin = a.in[I_CTX];
    f32x4 gv[4];
#pragma unroll
    for (int j = 0; j < 4; ++j) gv[j] = *(const f32x4*)(g + 4 * F.lane + 256 * j);
    f32x4 xn[4]; u32x2 xb[4]; unsigned yn[4][4]; int psn[4] = {0, 0, 0, 0};
#define N1_LOADX(dst, row) do { if (L == 0) { const float* s_ = (row) < NLAT ? xin + (size_t)(row) * DM : cin + (size_t)((row) - NLAT) * DM; _Pragma("unroll") for (int j = 0; j < 4; ++j) dst[j] = *(const f32x4*)(s_ + 4 * F.lane + 256 * j); } \
        else { const bf16* s_ = XS + (size_t)(row) * DM; _Pragma("unroll") for (int j = 0; j < 4; ++j) xb[j] = *(const u32x2*)(s_ + 4 * F.lane + 256 * j); } } while (0)
#define N1_LOADY(dst, ps) do { _Pragma("unroll") for (int k = 0; k < 4; ++k) { const unsigned char* yr_ = Y + (size_t)(ps)[k] * DM; _Pragma("unroll") for (int j = 0; j < 4; ++j) dst[k][j] = *(const unsigned*)(yr_ + 4 * F.lane + 256 * j); } } while (0)
#define N1_LOADPS(dst, row) do { const int4 p_ = *(const int4*)(PS + (size_t)(row) * 4); dst[0] = p_.x; dst[1] = p_.y; dst[2] = p_.z; dst[3] = p_.w; } while (0)
    int row = gw;
    if (row < NT) { N1_LOADX(xn, row); if (L > 0) { N1_LOADPS(psn, row); N1_LOADY(yn, psn); if (row + NGW < NT) N1_LOADPS(psn, row + NGW); } }
    while (row < NT) {
        const int nrow = row + NGW; const int bi = row < NLAT ? (row >> 12) : 8;
        f32x4 v[4]; unsigned yc[4][4];
#pragma unroll
        for (int j = 0; j < 4; ++j) { v[j] = (L == 0) ? xn[j] : bf4(xb[j]);
#pragma unroll
            for (int k = 0; k < 4; ++k) yc[k][j] = yn[k][j]; }
        if (nrow < NT) { N1_LOADX(xn, nrow); if (L > 0) { N1_LOADY(yn, psn); if (nrow + NGW < NT) N1_LOADPS(psn, nrow + NGW); } }
        if (L > 0) {
            bf16* xr = XS + (size_t)row * DM; const float* m5 = modp + (size_t)bi * 6144 + 5 * 1024;
#pragma unroll
            for (int j = 0; j < 4; ++j) { f32x4 s = (f32x4){0.f, 0.f, 0.f, 0.f};
#pragma unroll
                for (int k = 0; k < 4; ++k) s += f8x4(yc[k][j]);
                v[j] += *(const f32x4*)(m5 + 4 * F.lane + 256 * j) * (s * (1.f / Y8_SCALE)); if (!dry) { u32x2 w; w.x = pk2(v[j][0], v[j][1]); w.y = pk2(v[j][2], v[j][3]); *(u32x2*)(xr + 4 * F.lane + 256 * j) = w; } }
        }
        float ss = 0.f;
#pragma unroll
        for (int j = 0; j < 4; ++j) ss += v[j][0] * v[j][0] + v[j][1] * v[j][1] + v[j][2] * v[j][2] + v[j][3] * v[j][3];
        const float rs = rsqrtf(wave_sum(ss, F.lane) * (1.f / DM) + 1e-6f);
        const float* sh = mod + (size_t)bi * 6144, *sc = sh + 1024;
        bf16* hr = H + (size_t)row * DM;
#pragma unroll
        for (int j = 0; j < 4; ++j) { const f32x4 s4 = *(const f32x4*)(sc + 4 * F.lane + 256 * j), h4 = *(const f32x4*)(sh + 4 * F.lane + 256 * j);
            const f32x4 o = v[j] * rs * gv[j] * (s4 + 1.f) + h4; u32x2 w; w.x = pk2(o[0], o[1]); w.y = pk2(o[2], o[3]); if (!dry) *(u32x2*)(hr + 4 * F.lane + 256 * j) = w; else if (o[0] == 12345.678f) *(u32x2*)(hr + 4 * F.lane + 256 * j) = w; }
        row = nrow;
    }
#undef N1_LOADX
#undef N1_LOADY
#undef N1_LOADPS
}
__device__ __forceinline__ void p_norm2(Frame& F, CArgs& a, int L, int nrows, int cw = CW_CNT) {
    LAS float* rwt = (LAS float*)F.lds;
    LAS unsigned* lcnt = (LAS unsigned*)(F.lds + 32 * 1024 * 4);
    if (F.tid < 64) lcnt[F.tid] = 0u;
    const float* rw = a.in[I_RW] + (size_t)L * DM * NEXP;
    for (int i = F.tid; i < DM * NEXP; i += NTHR) { const int k = i >> 5, e = i & 31; rwt[e * 1024 + k] = rw[i]; }
    __syncthreads();
    const int gw = F.bid * NWAVES + F.wave, NGW = F.G * NWAVES;
    const bf16* XS = (const bf16*)(F.ws + WS_XS); unsigned char* H8 = (unsigned char*)(F.ws + WS_H8);
    const float* mod = (const float*)(F.ws + WS_MOD) + (size_t)L * 9 * 6144;
    int* PE = (int*)(F.ws + WS_PE); int* PR = (int*)(F.ws + WS_PR); float* PG = (float*)(F.ws + WS_PG);
    unsigned* cnt = F.ctl + cw + L * 64;
    const float* g = a.in[I_NFG] + L * DM;
    const float rb = a.in[I_RB][L * NEXP + (F.lane >> 1)];
    f32x4 gv[4];
#pragma unroll
    for (int j = 0; j < 4; ++j) gv[j] = *(const f32x4*)(g + 4 * F.lane + 256 * j);
    u32x2 xn[4];
    if (gw < nrows) {
#pragma unroll
        for (int j = 0; j < 4; ++j) xn[j] = *(const u32x2*)(XS + (size_t)gw * DM + 4 * F.lane + 256 * j); }
    for (int row = gw; row < nrows; row += NGW) {
        const int bi = row < NLAT ? (row >> 12) : 8;
        f32x4 v[4]; float ss = 0.f;
#pragma unroll
        for (int j = 0; j < 4; ++j) { v[j] = bf4(xn[j]); ss += v[j][0] * v[j][0] + v[j][1] * v[j][1] + v[j][2] * v[j][2] + v[j][3] * v[j][3]; }
        if (row + NGW < nrows) {
#pragma unroll
            for (int j = 0; j < 4; ++j) xn[j] = *(const u32x2*)(XS + (size_t)(row + NGW) * DM + 4 * F.lane + 256 * j); }
        const float rs = rsqrtf(wave_sum(ss, F.lane) * (1.f / DM) + 1e-6f);
        const float* sh = mod + (size_t)bi * 6144 + 3 * 1024, *sc = sh + 1024;
        unsigned char* hr = H8 + (size_t)row * DM;
#pragma unroll
        for (int j = 0; j < 4; ++j) { const f32x4 s4 = *(const f32x4*)(sc + 4 * F.lane + 256 * j), h4 = *(const f32x4*)(sh + 4 * F.lane + 256 * j);
            v[j] = v[j] * rs * gv[j] * (s4 + 1.f) + h4; *(unsigned*)(hr + 4 * F.lane + 256 * j) = pk4f8(v[j][0] * H8_SCALE, v[j][1] * H8_SCALE, v[j][2] * H8_SCALE, v[j][3] * H8_SCALE); }
        float p[32];
#pragma unroll
        for (int e = 0; e < 32; ++e) { float s = 0.f;
            f32x2 s2 = (f32x2){0.f, 0.f};
#pragma unroll
            for (int j = 0; j < 4; ++j) { const f32x4 w4 = *(const LAS f32x4*)(rwt + e * 1024 + 4 * F.lane + 256 * j);
                s2 += (f32x2){v[j][0], v[j][1]} * (f32x2){w4[0], w4[1]}; s2 += (f32x2){v[j][2], v[j][3]} * (f32x2){w4[2], w4[3]}; }
            s = s2.x + s2.y; p[e] = s; if ((e & 3) == 3) asm volatile("" : "+v"(p[e]), "+v"(p[e - 1]), "+v"(p[e - 2]), "+v"(p[e - 3]) :: "memory"); }
#define RED_LEVEL(NKEEP, BIT, XCH) { const bool hi = (F.lane & (BIT)) != 0; _Pragma("unroll") for (int e = 0; e < (NKEEP); ++e) { const float send = hi ? p[e] : p[e + (NKEEP)], keep = hi ? p[e + (NKEEP)] : p[e]; p[e] = keep + XCH; } }
        RED_LEVEL(16, 32, xor32f(send, F.lane)) RED_LEVEL(8, 16, swz_xor<16>(send)) RED_LEVEL(4, 8, swz_xor<8>(send)) RED_LEVEL(2, 4, swz_xor<4>(send)) RED_LEVEL(1, 2, swz_xor<2>(send))
#undef RED_LEVEL
        float logit = p[0] + swz_xor<1>(p[0]) + rb;
        int es[4]; float ls[4];
#pragma unroll
        for (int k = 0; k < 4; ++k) {
            const float m = wave_max(logit, F.lane);
            const unsigned long long bal = __ballot(logit == m);
            const int fl = __builtin_ctzll(bal); es[k] = fl >> 1; ls[k] = m;
            if ((F.lane >> 1) == es[k]) logit = -3.0e38f;
        }
        const float e1 = __expf(ls[1] - ls[0]), e2 = __expf(ls[2] - ls[0]), e3 = __expf(ls[3] - ls[0]); const float inv = 1.f / (1.f + e1 + e2 + e3);
        if (F.lane < 4) {
            const int e = F.lane == 0 ? es[0] : (F.lane == 1 ? es[1] : (F.lane == 2 ? es[2] : es[3]));
            const float gt = (F.lane == 0 ? 1.f : (F.lane == 1 ? e1 : (F.lane == 2 ? e2 : e3))) * inv;
            const unsigned rk = __hip_atomic_fetch_add(lcnt + e, 1u, __ATOMIC_RELAXED, __HIP_MEMORY_SCOPE_WORKGROUP);
            PE[row * 4 + F.lane] = e; PR[row * 4 + F.lane] = (int)rk; PG[row * 4 + F.lane] = gt;
        }
    }
    __syncthreads();
    if (F.tid < 32) lcnt[32 + F.tid] = __hip_atomic_fetch_add(cnt + F.tid, lcnt[F.tid], RLX_AGENT);
    __syncthreads();
    int* TM = (int*)(F.ws + WS_TM);
    for (int row = gw; row < nrows; row += NGW) { if (F.lane < 4) { const int i = row * 4 + F.lane, e = PE[i], rk = PR[i] + (int)lcnt[32 + e]; TM[(size_t)e * NT + rk] = i; } }
    __syncthreads();
}
__device__ __forceinline__ void p_final(Frame& F, CArgs& a) {
    const int gw = F.bid * NWAVES + F.wave, NGW = F.G * NWAVES;
    const bf16* XS = (const bf16*)(F.ws + WS_XS);
    const float* modp = (const float*)(F.ws + WS_MOD) + (size_t)(DEPTH - 1) * 9 * 6144;
    const int* PS = (const int*)(F.ws + WS_PS); const unsigned char* Y = (const unsigned char*)(F.ws + WS_Y);
    const float* g = a.in[I_FING];
    f32x4 gv[4];
#pragma unroll
    for (int j = 0; j < 4; ++j) gv[j] = *(const f32x4*)(g + 4 * F.lane + 256 * j);
    u32x2 xb[4]; unsigned yn[4][4]; int psn[4] = {0, 0, 0, 0};
#define FN_LOADX(row) do { const bf16* s_ = XS + (size_t)(row) * DM; _Pragma("unroll") for (int j = 0; j < 4; ++j) xb[j] = *(const u32x2*)(s_ + 4 * F.lane + 256 * j); } while (0)
#define FN_LOADY(ps) do { _Pragma("unroll") for (int k = 0; k < 4; ++k) { const unsigned char* yr_ = Y + (size_t)(ps)[k] * DM; _Pragma("unroll") for (int j = 0; j < 4; ++j) yn[k][j] = *(const unsigned*)(yr_ + 4 * F.lane + 256 * j); } } while (0)
#define FN_LOADPS(row) do { const int4 p_ = *(const int4*)(PS + (size_t)(row) * 4); psn[0] = p_.x; psn[1] = p_.y; psn[2] = p_.z; psn[3] = p_.w; } while (0)
    int row = gw;
    if (row < NLAT) { FN_LOADX(row); FN_LOADPS(row); FN_LOADY(psn); if (row + NGW < NLAT) FN_LOADPS(row + NGW); }
    while (row < NLAT) {
        const int nrow = row + NGW, bi = row >> 12;
        f32x4 v[4], s[4];
#pragma unroll
        for (int j = 0; j < 4; ++j) { v[j] = bf4(xb[j]); s[j] = (f32x4){0.f, 0.f, 0.f, 0.f};
#pragma unroll
            for (int k = 0; k < 4; ++k) s[j] += f8x4(yn[k][j]);
            s[j] = s[j] * (1.f / Y8_SCALE); }
        if (nrow < NLAT) { FN_LOADX(nrow); FN_LOADY(psn); if (nrow + NGW < NLAT) FN_LOADPS(nrow + NGW); }
        const float* m5 = modp + (size_t)bi * 6144 + 5 * 1024;
        float ss = 0.f;
#pragma unroll
        for (int j = 0; j < 4; ++j) { v[j] += *(const f32x4*)(m5 + 4 * F.lane + 256 * j) * s[j]; ss += v[j][0] * v[j][0] + v[j][1] * v[j][1] + v[j][2] * v[j][2] + v[j][3] * v[j][3]; }
        const float rs = rsqrtf(wave_sum(ss, F.lane) * (1.f / DM) + 1e-6f);
        float* orow = a.out + (size_t)row * DM;
#pragma unroll
        for (int j = 0; j < 4; ++j) *(f32x4*)(orow + 4 * F.lane + 256 * j) = v[j] * rs * gv[j];
        row = nrow;
    }
#undef FN_LOADX
#undef FN_LOADY
#undef FN_LOADPS
}

#ifndef MIX_P1
#define MIX_P1 1
#endif
#define MFMA16(a, b, c) __builtin_amdgcn_mfma_f32_16x16x32_bf16((a), (b), (c), 0, 0, 0)
typedef short v4i16_t __attribute__((ext_vector_type(4)));
__device__ __forceinline__ s16x4 trread(const LAS void* p) { return __builtin_bit_cast(s16x4, __builtin_amdgcn_ds_read_tr16_b64_v4i16((LAS v4i16_t*)p)); }
__device__ __forceinline__ bf16x8 cat8(s16x4 a, s16x4 b) { return __builtin_shufflevector(a, b, 0, 1, 2, 3, 4, 5, 6, 7); }
__device__ __forceinline__ bf16x8 pack8(const float* v) { u32x4 w; w.x = pg8::cvt_pk_bf16(v[0], v[1]); w.y = pg8::cvt_pk_bf16(v[2], v[3]); w.z = pg8::cvt_pk_bf16(v[4], v[5]); w.w = pg8::cvt_pk_bf16(v[6], v[7]); return __builtin_bit_cast(bf16x8, w); }
__device__ __forceinline__ void unpack8(bf16x8 x, float* v) { const u32x4 w = __builtin_bit_cast(u32x4, x); v[0] = bflo(w.x); v[1] = bfhi(w.x); v[2] = bflo(w.y); v[3] = bfhi(w.y); v[4] = bflo(w.z); v[5] = bfhi(w.z); v[6] = bflo(w.w); v[7] = bfhi(w.w); }
#define OPQ(x) ({ int o_ = (x); asm volatile("" : "+s"(o_)); o_; })
#define LAUNDER_F(F0) Frame F = F0; { const int t_ = fresh_tid(F.wave); F.tid = t_; F.lane = t_ & 63; }
__device__ __forceinline__ int chunk_tok0(int cid) { return cid < 512 ? cid * 64 : NLAT + (cid - 512) * 64; }

constexpr int GL_QS = 136, GL_VS = 264, GL_BS = 260;
constexpr int GL_Q = 0, GL_K = GL_Q + 64 * GL_QS * 2, GL_V = GL_K + 64 * GL_QS * 2, GL_A1 = GL_V + 64 * GL_VS * 2, GL_B = GL_A1 + 64 * 32 * 2, GL_END = GL_B + 64 * GL_BS * 4;
static_assert(GL_END <= MISC_OFF, "GLA LDS");
template <int MODE> __device__ __forceinline__ void gla_chunk(Frame& F0, CArgs& a, int L, int cid) {
    constexpr bool OUT = MODE == 1, DO_STATE = MODE == 0 || MODE == 2, DO_INTRA = MODE == 1 || MODE == 2;
    LAUNDER_F(F0)
    const int tok0 = chunk_tok0(cid);
    const bf16* P = (const bf16*)(F.ws + WS_PBUF) + (size_t)tok0 * PW;
    LAS bf16* sq = (LAS bf16*)(F.lds + GL_Q); LAS bf16* sk = (LAS bf16*)(F.lds + GL_K); LAS bf16* sv = (LAS bf16*)(F.lds + GL_V); LAS bf16* sa1 = (LAS bf16*)(F.lds + GL_A1); LAS float* sB = (LAS float*)(F.lds + GL_B);
    __syncthreads();
    u32x4 rgate[4]; bf16x8 sfr[4];
    if constexpr (OUT) {
#pragma unroll
        for (int k = 0; k < 4; ++k) { const int i = F.tid + k * NTHR, t = i >> 5, pc = i & 31; rgate[k] = *(const u32x4*)(P + (size_t)t * PW + PC_R + pc * 8); }
        const bf16* se = (const bf16*)(F.ws + WS_GSE) + (((size_t)cid * 4 + (F.wave & 3)) * 2 + (F.wave >> 2)) * 2048;
#pragma unroll
        for (int d = 0; d < 4; ++d) sfr[d] = *(const bf16x8*)(se + (16 * d + (F.lane & 15)) * 32 + 8 * (F.lane >> 4));
    }
    {   u32x4 rq[2], rk[2], rv[4], ra = (u32x4){0u, 0u, 0u, 0u};
#pragma unroll
        for (int k = 0; k < 2; ++k) { const int i = F.tid + k * NTHR, t = i >> 4, pc = i & 15; rq[k] = *(const u32x4*)(P + (size_t)t * PW + PC_Q + pc * 8); rk[k] = *(const u32x4*)(P + (size_t)t * PW + PC_K + pc * 8); }
#pragma unroll
        for (int k = 0; k < 4; ++k) { const int i = F.tid + k * NTHR, t = i >> 5, pc = i & 31; rv[k] = *(const u32x4*)(P + (size_t)t * PW + PC_V + pc * 8); }
        if (F.tid < 256) { const int t = F.tid >> 2, pc = F.tid & 3; ra = *(const u32x4*)(P + (size_t)t * PW + PC_A1 + pc * 8); }
#pragma unroll
        for (int k = 0; k < 2; ++k) { const int i = F.tid + k * NTHR, t = i >> 4, pc = i & 15; *(LAS u32x4*)(sq + t * GL_QS + pc * 8) = rq[k]; *(LAS u32x4*)(sk + t * GL_QS + pc * 8) = rk[k]; }
#pragma unroll
        for (int k = 0; k < 4; ++k) { const int i = F.tid + k * NTHR, t = i >> 5, pc = i & 31; *(LAS u32x4*)(sv + t * GL_VS + pc * 8) = rv[k]; }
        if (F.tid < 256) { const int t = F.tid >> 2, pc = F.tid & 3; *(LAS u32x4*)(sa1 + t * 32 + pc * 8) = ra; }
    }
    __syncthreads();
    {
        const int lr_ = F.lane & 15, g_ = F.lane >> 4;
        const bf16* gt = (const bf16*)(F.ws + WS_GA2T) + (size_t)L * 256 * 32;
        bf16x8 bz[2]; float abv[2];
#pragma unroll
        for (int nt = 0; nt < 2; ++nt) { const int col = 32 * F.wave + 16 * nt + lr_; bz[nt] = *(const bf16x8*)(gt + col * 32 + 8 * g_); abv[nt] = a.in[I_GLAAB][L * 256 + col]; }
#pragma unroll
        for (int m = 0; m < 4; ++m) { const bf16x8 az = *(const LAS bf16x8*)(sa1 + (16 * m + lr_) * 32 + 8 * g_);
#pragma unroll
            for (int nt = 0; nt < 2; ++nt) { const f32x4 zz = MFMA16(az, bz[nt], ((f32x4){0.f, 0.f, 0.f, 0.f})); const int col = 32 * F.wave + 16 * nt + lr_;
#pragma unroll
                for (int j = 0; j < 4; ++j) { const float z = zz[j] + abv[nt]; const float ls = fminf(z, 0.f) - __logf(1.f + __expf(-fabsf(z))); sB[(16 * m + 4 * g_ + j) * GL_BS + col] = ls * (1.f / 16.f); } } }
    }
    __syncthreads();
    if (F.tid < 256) { const int col = F.tid, r = col >> 7; float bv[64];
#pragma unroll
        for (int i = 0; i < 64; ++i) bv[i] = sB[i * GL_BS + col];
        if (r == 0) {
#pragma unroll
            for (int i = 1; i < 64; ++i) bv[i] += bv[i - 1];
        } else {
#pragma unroll
            for (int i = 62; i >= 0; --i) bv[i] += bv[i + 1];
        }
#pragma unroll
        for (int i = 0; i < 64; ++i) sB[i * GL_BS + col] = bv[i]; }
    __syncthreads();
    const int hh = F.wave & 3, r = F.wave >> 2, lr = F.lane & 15, g = F.lane >> 4;
    const int bc = r * 128 + hh * 32;
    const size_t ub = ((size_t)cid * 4 + hh) * 2 + r;
    if constexpr (DO_STATE) {
        const int tl = r ? 0 : 63;
        f32x4 acc[2][4];
#pragma unroll
        for (int mc = 0; mc < 2; ++mc)
#pragma unroll
            for (int d = 0; d < 4; ++d) acc[mc][d] = (f32x4){0.f, 0.f, 0.f, 0.f};
#pragma unroll
        for (int sg = 0; sg < 2; ++sg) {
            bf16x8 vf[4];
#pragma unroll
            for (int d = 0; d < 4; ++d) { const LAS bf16* p0 = sv + (32 * sg + 8 * g + ((F.lane & 15) >> 2)) * GL_VS + hh * 64 + 16 * d + 4 * (F.lane & 3); vf[d] = cat8(trread(p0), trread(p0 + 4 * GL_VS)); }
#pragma unroll
            for (int mc = 0; mc < 2; ++mc) {
                const LAS bf16* p0 = sk + (32 * sg + 8 * g + ((F.lane & 15) >> 2)) * GL_QS + hh * 32 + 16 * mc + 4 * (F.lane & 3);
                const s16x4 k0 = trread(p0), k1 = trread(p0 + 4 * GL_QS);
                const int c = 16 * mc + lr; const float bl = sB[tl * GL_BS + bc + c];
                float kv[8];
#pragma unroll
                for (int e = 0; e < 4; ++e) { kv[e] = bf2f((unsigned short)k0[e]) * __expf(bl - sB[(32 * sg + 8 * g + e) * GL_BS + bc + c]); kv[4 + e] = bf2f((unsigned short)k1[e]) * __expf(bl - sB[(32 * sg + 8 * g + 4 + e) * GL_BS + bc + c]); }
                const bf16x8 kf = pack8(kv);
#pragma unroll
                for (int d = 0; d < 4; ++d) acc[mc][d] = MFMA16(kf, vf[d], acc[mc][d]);
            }
        }
        float* ds = (float*)(F.ws + WS_GDS) + ub * 2048;
#pragma unroll
        for (int mc = 0; mc < 2; ++mc)
#pragma unroll
            for (int d = 0; d < 4; ++d) *(f32x4*)(ds + (16 * d + lr) * 32 + 16 * mc + 4 * g) = acc[mc][d];
        if (F.lane < 32) ((float*)(F.ws + WS_GDEC))[ub * 32 + F.lane] = __expf(sB[tl * GL_BS + bc + F.lane]);
    }
    if constexpr (DO_INTRA) {
        bf16x8 qf[4], kf[4];
#pragma unroll
        for (int m = 0; m < 4; ++m) { const int t = 16 * m + lr; float qv[8], kv[8], bv[8];
            unpack8(*(const LAS bf16x8*)(sq + t * GL_QS + hh * 32 + 8 * g), qv); unpack8(*(const LAS bf16x8*)(sk + t * GL_QS + hh * 32 + 8 * g), kv);
            *(f32x4*)bv = *(const LAS f32x4*)(sB + t * GL_BS + bc + 8 * g); *(f32x4*)(bv + 4) = *(const LAS f32x4*)(sB + t * GL_BS + bc + 8 * g + 4);
#pragma unroll
            for (int e = 0; e < 8; ++e) { const float ex = __expf(bv[e]); qv[e] *= 0.17677669529663687f * ex; kv[e] *= __frcp_rn(ex); }
            qf[m] = pack8(qv); kf[m] = pack8(kv); }
        f32x4 o[4][4];
#pragma unroll
        for (int m = 0; m < 4; ++m)
#pragma unroll
            for (int d = 0; d < 4; ++d) o[m][d] = (f32x4){0.f, 0.f, 0.f, 0.f};
        if constexpr (OUT) {
#pragma unroll
            for (int d = 0; d < 4; ++d) {
#pragma unroll
                for (int m = 0; m < 4; ++m) o[m][d] = MFMA16(qf[m], sfr[d], o[m][d]); }
        }
        bf16x8 vf[2][4];
#pragma unroll
        for (int sg = 0; sg < 2; ++sg)
#pragma unroll
            for (int d = 0; d < 4; ++d) { const LAS bf16* p0 = sv + (32 * sg + 4 * g + ((F.lane & 15) >> 2)) * GL_VS + hh * 64 + 16 * d + 4 * (F.lane & 3); vf[sg][d] = cat8(trread(p0), trread(p0 + 16 * GL_VS)); }
        const f32x4 zero4 = (f32x4){0.f, 0.f, 0.f, 0.f};
#pragma unroll
        for (int m = 0; m < 4; ++m) {
            const int t = 16 * m + lr;
#pragma unroll
            for (int sg = 0; sg < 2; ++sg) {
                f32x4 p0 = MFMA16(kf[2 * sg], qf[m], zero4), p1 = MFMA16(kf[2 * sg + 1], qf[m], zero4);
                float pv[8];
#pragma unroll
                for (int j = 0; j < 4; ++j) { const int s0 = 32 * sg + 4 * g + j, s1 = s0 + 16; pv[j] = (r ? s0 >= t : s0 <= t) ? p0[j] : 0.f; pv[4 + j] = (r ? s1 >= t : s1 <= t) ? p1[j] : 0.f; }
                const bf16x8 pf = pack8(pv);
#pragma unroll
                for (int d = 0; d < 4; ++d) o[m][d] = MFMA16(pf, vf[sg][d], o[m][d]);
            }
        }
        if constexpr (OUT) {
        __syncthreads();
        LAS float* ox = (LAS float*)(F.lds + GL_B);
        LAS bf16* ot = (LAS bf16*)(F.lds + GL_Q);
        LAS bf16* srg = (LAS bf16*)(F.lds + GL_V);
#pragma unroll
        for (int k = 0; k < 4; ++k) { const int i = F.tid + k * NTHR, t = i >> 5, pc = i & 31; *(LAS u32x4*)(srg + t * GL_VS + pc * 8) = rgate[k]; }
        if (r == 1) {
#pragma unroll
            for (int m = 0; m < 4; ++m)
#pragma unroll
                for (int d = 0; d < 4; ++d)
#pragma unroll
                    for (int j = 0; j < 4; ++j) ox[(hh * 64 + 16 * m + 4 * g + j) * 65 + 16 * d + lr] = o[m][d][j];
        }
        __syncthreads();
        if (r == 0) {
            const float* ng = a.in[I_GLANG] + L * 64;
            float gn[4];
#pragma unroll
            for (int d = 0; d < 4; ++d) gn[d] = ng[16 * d + lr];
#pragma unroll
            for (int m = 0; m < 4; ++m)
#pragma unroll
                for (int j = 0; j < 4; ++j) {
                    const int t = 16 * m + 4 * g + j; float v[4], ss = 0.f;
#pragma unroll
                    for (int d = 0; d < 4; ++d) { v[d] = o[m][d][j] + ox[(hh * 64 + t) * 65 + 16 * d + lr]; ss += v[d] * v[d]; }
                    ss += swz_xor<1>(ss); ss += swz_xor<2>(ss); ss += swz_xor<4>(ss); ss += swz_xor<8>(ss);
                    const float rs = rsqrtf(ss * (1.f / 64.f) + 1e-6f);
#pragma unroll
                    for (int d = 0; d < 4; ++d) { const float rg = bf2f(srg[t * GL_VS + hh * 64 + 16 * d + lr]); ot[t * 264 + hh * 64 + 16 * d + lr] = (bf16)f2bf(v[d] * rs * gn[d] * siluf_(rg)); }
                }
        }
        __syncthreads();
        bf16* MX = (bf16*)(F.ws + WS_MIX) + (size_t)tok0 * MW + 768;
        for (int i = F.tid; i < 2048; i += NTHR) { const int t = i >> 5, pc = i & 31; *(u32x4*)(MX + (size_t)t * MW + pc * 8) = *(const LAS u32x4*)(ot + t * 264 + pc * 8); }
        } else {
            bf16* QI = (bf16*)(F.ws + WS_GQI) + (size_t)tok0 * 256;
#pragma unroll
            for (int m = 0; m < 4; ++m) *(bf16x8*)(QI + (size_t)(16 * m + lr) * 256 + r * 128 + hh * 32 + 8 * g) = qf[m];
            __syncthreads();
            LAS float* ox = (LAS float*)(F.lds + GL_B);
            LAS bf16* ot = (LAS bf16*)(F.lds + GL_Q);
            if (r == 1) {
#pragma unroll
                for (int m = 0; m < 4; ++m)
#pragma unroll
                    for (int d = 0; d < 4; ++d)
#pragma unroll
                        for (int j = 0; j < 4; ++j) ox[(hh * 64 + 16 * m + 4 * g + j) * 65 + 16 * d + lr] = o[m][d][j];
            }
            __syncthreads();
            if (r == 0) {
#pragma unroll
                for (int m = 0; m < 4; ++m)
#pragma unroll
                    for (int d = 0; d < 4; ++d)
#pragma unroll
                        for (int j = 0; j < 4; ++j) { const int t = 16 * m + 4 * g + j; ot[t * 264 + hh * 64 + 16 * d + lr] = (bf16)f2bf(o[m][d][j] + ox[(hh * 64 + t) * 65 + 16 * d + lr]); }
            }
            __syncthreads();
            bf16* OI = (bf16*)(F.ws + WS_GOI) + (size_t)tok0 * 256;
            for (int i = F.tid; i < 2048; i += NTHR) { const int t = i >> 5, pc = i & 31; *(u32x4*)(OI + (size_t)t * 256 + pc * 8) = *(const LAS u32x4*)(ot + t * 264 + pc * 8); }
        }
    }
}


__device__ __forceinline__ void gla_light(Frame& F0, CArgs& a, int L, int cid) {
    LAUNDER_F(F0)
    const int tok0 = chunk_tok0(cid), hh = F.wave & 3, r = F.wave >> 2, lr = F.lane & 15, g = F.lane >> 4;
    const bf16* P = (const bf16*)(F.ws + WS_PBUF) + (size_t)tok0 * PW;
    const bf16* QI = (const bf16*)(F.ws + WS_GQI) + (size_t)tok0 * 256; const bf16* OI = (const bf16*)(F.ws + WS_GOI) + (size_t)tok0 * 256;
    const bf16* se = (const bf16*)(F.ws + WS_GSE) + (((size_t)cid * 4 + hh) * 2 + r) * 2048;
    u32x4 rgate[4], roi[4]; bf16x8 qf[4], sfr[4];
#pragma unroll
    for (int m = 0; m < 4; ++m) qf[m] = *(const bf16x8*)(QI + (size_t)(16 * m + lr) * 256 + r * 128 + hh * 32 + 8 * g);
#pragma unroll
    for (int d = 0; d < 4; ++d) sfr[d] = *(const bf16x8*)(se + (16 * d + lr) * 32 + 8 * g);
#pragma unroll
    for (int k = 0; k < 4; ++k) { const int i = F.tid + k * NTHR, t = i >> 5, pc = i & 31; rgate[k] = *(const u32x4*)(P + (size_t)t * PW + PC_R + pc * 8); roi[k] = *(const u32x4*)(OI + (size_t)t * 256 + pc * 8); }
    f32x4 o[4][4];
#pragma unroll
    for (int m = 0; m < 4; ++m)
#pragma unroll
        for (int d = 0; d < 4; ++d) o[m][d] = MFMA16(qf[m], sfr[d], ((f32x4){0.f, 0.f, 0.f, 0.f}));
    LAS float* ox = (LAS float*)(F.lds + GL_B);
    LAS bf16* srg = (LAS bf16*)(F.lds + GL_V);
    LAS bf16* soi = (LAS bf16*)(F.lds + GL_Q);
    __syncthreads();
#pragma unroll
    for (int k = 0; k < 4; ++k) { const int i = F.tid + k * NTHR, t = i >> 5, pc = i & 31; *(LAS u32x4*)(srg + t * GL_VS + pc * 8) = rgate[k]; *(LAS u32x4*)(soi + t * 264 + pc * 8) = roi[k]; }
    if (r == 1) {
#pragma unroll
        for (int m = 0; m < 4; ++m)
#pragma unroll
            for (int d = 0; d < 4; ++d)
#pragma unroll
                for (int j = 0; j < 4; ++j) ox[(hh * 64 + 16 * m + 4 * g + j) * 65 + 16 * d + lr] = o[m][d][j];
    }
    __syncthreads();
    if (r == 0) {
        const float* ng = a.in[I_GLANG] + L * 64;
        float gn[4];
#pragma unroll
        for (int d = 0; d < 4; ++d) gn[d] = ng[16 * d + lr];
#pragma unroll
        for (int m = 0; m < 4; ++m)
#pragma unroll
            for (int j = 0; j < 4; ++j) {
                const int t = 16 * m + 4 * g + j; float v[4], ss = 0.f;
#pragma unroll
                for (int d = 0; d < 4; ++d) { v[d] = o[m][d][j] + ox[(hh * 64 + t) * 65 + 16 * d + lr] + bf2f(soi[t * 264 + hh * 64 + 16 * d + lr]); ss += v[d] * v[d]; }
                ss += swz_xor<1>(ss); ss += swz_xor<2>(ss); ss += swz_xor<4>(ss); ss += swz_xor<8>(ss);
                const float rs = rsqrtf(ss * (1.f / 64.f) + 1e-6f);
#pragma unroll
                for (int d = 0; d < 4; ++d) { const int q = t * GL_VS + hh * 64 + 16 * d + lr; const float rg = bf2f(srg[q]); srg[q] = (bf16)f2bf(v[d] * rs * gn[d] * siluf_(rg)); }
            }
    }
    __syncthreads();
    bf16* MX = (bf16*)(F.ws + WS_MIX) + (size_t)tok0 * MW + 768;
    for (int i = F.tid; i < 2048; i += NTHR) { const int t = i >> 5, pc = i & 31; *(u32x4*)(MX + (size_t)t * MW + pc * 8) = *(const LAS u32x4*)(srg + t * GL_VS + pc * 8); }
}

constexpr int SD_RS = 520;
constexpr int SD_RAW = 0, SD_XC = SD_RAW + 68 * SD_RS * 2, SD_DT = SD_XC + 64 * SD_RS * 2, SD_CUM = SD_DT + 64 * 8 * 4, SD_W = SD_CUM + 8 * 64 * 4, SD_END = SD_W + 8 * 64 * 4;
static_assert(SD_END <= MISC_OFF && 64 * 260 * 4 <= 68 * SD_RS * 2, "SSD LDS");
template <int MODE> __device__ __forceinline__ void ssd_chunk(Frame& F0, CArgs& a, int L, int cid) {
    constexpr bool OUT = MODE == 1, DO_STATE = MODE == 0 || MODE == 2, DO_INTRA = MODE == 1 || MODE == 2;
    LAUNDER_F(F0)
    const int tok0 = chunk_tok0(cid);
    const bf16* PB = (const bf16*)(F.ws + WS_PBUF);
    LAS bf16* raw = (LAS bf16*)(F.lds + SD_RAW); LAS bf16* xc = (LAS bf16*)(F.lds + SD_XC); LAS float* sdt = (LAS float*)(F.lds + SD_DT); LAS float* scum = (LAS float*)(F.lds + SD_CUM); LAS float* sw = (LAS float*)(F.lds + SD_W);
    bf16x8 sfr[4][2];
    if constexpr (OUT) { const bf16* se = (const bf16*)(F.ws + WS_SSE) + (((size_t)cid * 4 + (F.wave & 3)) * 2 + (F.wave >> 2)) * 4096;
#pragma unroll
        for (int d = 0; d < 4; ++d) { sfr[d][0] = *(const bf16x8*)(se + (16 * d + (F.lane & 15)) * 64 + 8 * (F.lane >> 4)); sfr[d][1] = *(const bf16x8*)(se + (16 * d + (F.lane & 15)) * 64 + 32 + 8 * (F.lane >> 4)); } }
    __syncthreads();
    {
        const int isctx = cid >= 512, c4 = (cid - 512) & 3;
        u32x4 rv[9];
#pragma unroll
        for (int k = 0; k < 9; ++k) { const int i = F.tid + k * NTHR, rr = i >> 6, pc = i & 63, t = rr - 2; rv[k] = (u32x4){0u, 0u, 0u, 0u};
            bool ok = t >= 0 && t < 64 && i < 68 * 64; if (isctx) { const int tt = c4 * 64 + t; ok = tt >= 0 && tt < 256 && i < 68 * 64; }
            if (ok) rv[k] = *(const u32x4*)(PB + (size_t)(tok0 + t) * PW + PC_XBC + pc * 8); }
#pragma unroll
        for (int k = 0; k < 9; ++k) { const int i = F.tid + k * NTHR, rr = i >> 6, pc = i & 63; if (i < 68 * 64) *(LAS u32x4*)(raw + rr * SD_RS + pc * 8) = rv[k]; }
        if (F.tid < 64) { float dv[8]; unpack8(*(const bf16x8*)(PB + (size_t)(tok0 + F.tid) * PW + PC_DT), dv);
#pragma unroll
            for (int q = 0; q < 8; ++q) { const float z = dv[q] + a.in[I_SSDDTB][L * 8 + q]; sdt[F.tid * 8 + q] = z > 20.f ? z : __logf(1.f + __expf(z)); } }
    }
    __syncthreads();
    {
        const int ch = F.tid; float w[5];
#pragma unroll
        for (int k = 0; k < 5; ++k) w[k] = a.in[I_SSDCW][((size_t)L * 5 + k) * 512 + ch];
        const float cb = a.in[I_SSDCB][L * 512 + ch];
        float x0 = bf2f(raw[0 * SD_RS + ch]), x1 = bf2f(raw[1 * SD_RS + ch]), x2 = bf2f(raw[2 * SD_RS + ch]), x3 = bf2f(raw[3 * SD_RS + ch]);
        for (int t0 = 0; t0 < 64; t0 += 16) { float xv[16];
#pragma unroll
            for (int k = 0; k < 16; ++k) xv[k] = bf2f(raw[(t0 + k + 4) * SD_RS + ch]);
#pragma unroll
            for (int k = 0; k < 16; ++k) { const float x4 = xv[k]; const float y = cb + w[0] * x0 + w[1] * x1 + w[2] * x2 + w[3] * x3 + w[4] * x4;
                xc[(t0 + k) * SD_RS + ch] = (bf16)f2bf(siluf_(y)); x0 = x1; x1 = x2; x2 = x3; x3 = x4; } }
    }
    {
        const int q = F.wave, rr = q >> 2, t = rr ? 63 - F.lane : F.lane;
        const float aa = -__expf(a.in[I_SSDALOG][L * 8 + q]); const float dtv = sdt[t * 8 + q];
        float c = dtv * aa;
        { float o;
          o = __builtin_bit_cast(float, __builtin_amdgcn_ds_bpermute((F.lane - 1) << 2, __builtin_bit_cast(int, c))); if (F.lane >= 1) c += o;
          o = __builtin_bit_cast(float, __builtin_amdgcn_ds_bpermute((F.lane - 2) << 2, __builtin_bit_cast(int, c))); if (F.lane >= 2) c += o;
          o = __builtin_bit_cast(float, __builtin_amdgcn_ds_bpermute((F.lane - 4) << 2, __builtin_bit_cast(int, c))); if (F.lane >= 4) c += o;
          o = __builtin_bit_cast(float, __builtin_amdgcn_ds_bpermute((F.lane - 8) << 2, __builtin_bit_cast(int, c))); if (F.lane >= 8) c += o;
          o = __builtin_bit_cast(float, __builtin_amdgcn_ds_bpermute((F.lane - 16) << 2, __builtin_bit_cast(int, c))); if (F.lane >= 16) c += o;
          o = __builtin_bit_cast(float, __builtin_amdgcn_ds_bpermute((F.lane - 32) << 2, __builtin_bit_cast(int, c))); if (F.lane >= 32) c += o; }
        const float cl = __builtin_bit_cast(float, __builtin_amdgcn_ds_bpermute(63 << 2, __builtin_bit_cast(int, c)));
        scum[q * 64 + t] = c; sw[q * 64 + t] = __expf(cl - c) * dtv;
    }
    __syncthreads();
    const int h = F.wave & 3, r = F.wave >> 2, lr = F.lane & 15, g = F.lane >> 4, gp = h >> 1, rh = r * 4 + h;
    const size_t ub = ((size_t)cid * 4 + h) * 2 + r;
    if constexpr (DO_STATE) {
        f32x4 acc[4][4];
#pragma unroll
        for (int ms = 0; ms < 4; ++ms)
#pragma unroll
            for (int d = 0; d < 4; ++d) acc[ms][d] = (f32x4){0.f, 0.f, 0.f, 0.f};
#pragma unroll
        for (int sg = 0; sg < 2; ++sg) {
            const int trow = 32 * sg + 8 * g;
            bf16x8 xf[4];
#pragma unroll
            for (int d = 0; d < 4; ++d) { const LAS bf16* p0 = xc + (trow + ((F.lane & 15) >> 2)) * SD_RS + h * 64 + 16 * d + 4 * (F.lane & 3); xf[d] = cat8(trread(p0), trread(p0 + 4 * SD_RS)); }
            float wv[8];
            *(f32x4*)wv = *(const LAS f32x4*)(sw + rh * 64 + trow); *(f32x4*)(wv + 4) = *(const LAS f32x4*)(sw + rh * 64 + trow + 4);
#pragma unroll
            for (int ms = 0; ms < 4; ++ms) {
                const LAS bf16* p0 = xc + (trow + ((F.lane & 15) >> 2)) * SD_RS + 256 + gp * 64 + 16 * ms + 4 * (F.lane & 3);
                const s16x4 b0 = trread(p0), b1 = trread(p0 + 4 * SD_RS);
                float bv[8];
#pragma unroll
                for (int e = 0; e < 4; ++e) { bv[e] = bf2f((unsigned short)b0[e]) * wv[e]; bv[4 + e] = bf2f((unsigned short)b1[e]) * wv[4 + e]; }
                const bf16x8 bf = pack8(bv);
#pragma unroll
                for (int d = 0; d < 4; ++d) acc[ms][d] = MFMA16(bf, xf[d], acc[ms][d]);
            }
        }
        float* ds = (float*)(F.ws + WS_SDS) + ub * 4096;
#pragma unroll
        for (int ms = 0; ms < 4; ++ms)
#pragma unroll
            for (int d = 0; d < 4; ++d) *(f32x4*)(ds + (16 * d + lr) * 64 + 16 * ms + 4 * g) = acc[ms][d];
        if (F.lane == 0) ((float*)(F.ws + WS_SDEC))[ub] = __expf(scum[rh * 64 + (r ? 0 : 63)]);
    }
    if constexpr (DO_INTRA) {
        bf16x8 bfr[4][2], cfr[4][2];
#pragma unroll
        for (int m = 0; m < 4; ++m)
#pragma unroll
            for (int ks = 0; ks < 2; ++ks) { bfr[m][ks] = *(const LAS bf16x8*)(xc + (16 * m + lr) * SD_RS + 256 + gp * 64 + 32 * ks + 8 * g); cfr[m][ks] = *(const LAS bf16x8*)(xc + (16 * m + lr) * SD_RS + 384 + gp * 64 + 32 * ks + 8 * g); }
        f32x4 y[4][4];
#pragma unroll
        for (int m = 0; m < 4; ++m)
#pragma unroll
            for (int d = 0; d < 4; ++d) y[m][d] = (f32x4){0.f, 0.f, 0.f, 0.f};
        if constexpr (OUT) {
            bf16x8 cs[4][2];
#pragma unroll
            for (int m = 0; m < 4; ++m) { const float ec = __expf(scum[rh * 64 + 16 * m + lr]);
#pragma unroll
                for (int ks = 0; ks < 2; ++ks) { float cv[8]; unpack8(cfr[m][ks], cv);
#pragma unroll
                    for (int e = 0; e < 8; ++e) cv[e] *= ec;
                    cs[m][ks] = pack8(cv); } }
#pragma unroll
            for (int d = 0; d < 4; ++d) {
#pragma unroll
                for (int m = 0; m < 4; ++m) { y[m][d] = MFMA16(cs[m][0], sfr[d][0], y[m][d]); y[m][d] = MFMA16(cs[m][1], sfr[d][1], y[m][d]); }
            }
        }
        asm volatile("" ::: "memory");
        bf16x8 xf[2][4];
#pragma unroll
        for (int sg = 0; sg < 2; ++sg)
#pragma unroll
            for (int d = 0; d < 4; ++d) { const LAS bf16* p0 = xc + (32 * sg + 4 * g + ((F.lane & 15) >> 2)) * SD_RS + h * 64 + 16 * d + 4 * (F.lane & 3); xf[sg][d] = cat8(trread(p0), trread(p0 + 16 * SD_RS)); }
        const f32x4 zero4 = (f32x4){0.f, 0.f, 0.f, 0.f};
#pragma unroll
        for (int m = 0; m < 4; ++m) {
            const int t = 16 * m + lr; const float ct = scum[rh * 64 + t];
#pragma unroll
            for (int sg = 0; sg < 2; ++sg) {
                f32x4 p0 = MFMA16(bfr[2 * sg][0], cfr[m][0], zero4), p1 = MFMA16(bfr[2 * sg + 1][0], cfr[m][0], zero4);
                p0 = MFMA16(bfr[2 * sg][1], cfr[m][1], p0); p1 = MFMA16(bfr[2 * sg + 1][1], cfr[m][1], p1);
                float pv[8];
#pragma unroll
                for (int j = 0; j < 4; ++j) { const int s0 = 32 * sg + 4 * g + j, s1 = s0 + 16;
                    pv[j] = (r ? s0 >= t : s0 <= t) ? p0[j] * __expf(ct - scum[rh * 64 + s0]) * sdt[s0 * 8 + rh] : 0.f;
                    pv[4 + j] = (r ? s1 >= t : s1 <= t) ? p1[j] * __expf(ct - scum[rh * 64 + s1]) * sdt[s1 * 8 + rh] : 0.f; }
                const bf16x8 pf = pack8(pv);
#pragma unroll
                for (int d = 0; d < 4; ++d) y[m][d] = MFMA16(pf, xf[sg][d], y[m][d]);
            }
        }
        __syncthreads();
        LAS float* yx = (LAS float*)(F.lds + SD_RAW);
        if (r == 1) {
#pragma unroll
            for (int m = 0; m < 4; ++m)
#pragma unroll
                for (int d = 0; d < 4; ++d)
#pragma unroll
                    for (int j = 0; j < 4; ++j) yx[(16 * m + 4 * g + j) * 260 + h * 64 + 16 * d + lr] = y[m][d][j];
        }
        __syncthreads();
        if (r == 0) { const float dsk = a.in[I_SSDD][L * 4 + h];
#pragma unroll
            for (int m = 0; m < 4; ++m)
#pragma unroll
                for (int d = 0; d < 4; ++d)
#pragma unroll
                    for (int j = 0; j < 4; ++j) { const int t = 16 * m + 4 * g + j, c = h * 64 + 16 * d + lr; yx[t * 260 + c] += y[m][d][j] + dsk * bf2f(xc[t * SD_RS + c]); asm volatile("" ::: "memory"); }
        }
        __syncthreads();
        if constexpr (OUT) {
        { const int t = F.tid >> 3, c0 = (F.tid & 7) * 32; const bf16* zr = PB + (size_t)(tok0 + t) * PW + PC_Z + c0; const float* ng = a.in[I_SSDNG] + L * 256 + c0;
          float v[32]; float ss = 0.f;
#pragma unroll
          for (int q = 0; q < 4; ++q) { float zv[8]; unpack8(*(const bf16x8*)(zr + 8 * q), zv);
#pragma unroll
              for (int e = 0; e < 8; ++e) { const float u = yx[t * 260 + c0 + 8 * q + e] * siluf_(zv[e]); v[8 * q + e] = u; ss += u * u; } }
          ss += swz_xor<1>(ss); ss += swz_xor<2>(ss); ss += swz_xor<4>(ss);
          const float rs = rsqrtf(ss * (1.f / 256.f) + 1e-6f);
          bf16* MX = (bf16*)(F.ws + WS_MIX) + (size_t)(tok0 + t) * MW + 1024 + c0;
#pragma unroll
          for (int q = 0; q < 4; ++q) { float o8[8];
#pragma unroll
              for (int e = 0; e < 8; ++e) o8[e] = v[8 * q + e] * rs * ng[8 * q + e];
              *(bf16x8*)(MX + 8 * q) = pack8(o8); } }
        } else {
            { const int t = F.tid >> 3, c0 = (F.tid & 7) * 32; bf16* yo = (bf16*)(F.ws + WS_SYI) + (size_t)(tok0 + t) * 256 + c0;
#pragma unroll
              for (int q = 0; q < 4; ++q) { float o8[8];
#pragma unroll
                  for (int e = 0; e < 8; ++e) o8[e] = yx[t * 260 + c0 + 8 * q + e];
                  *(bf16x8*)(yo + 8 * q) = pack8(o8); } }
            { bf16* cb = (bf16*)(F.ws + WS_SCB) + (size_t)tok0 * 128;
#pragma unroll
              for (int k = 0; k < 2; ++k) { const int i = F.tid + k * NTHR, t = i >> 4, pc = i & 15; *(u32x4*)(cb + (size_t)t * 128 + pc * 8) = *(const LAS u32x4*)(xc + t * SD_RS + 384 + pc * 8); } }
            { const int t = F.tid >> 3, q = F.tid & 7; ((float*)(F.ws + WS_SCUM))[(size_t)(tok0 + t) * 8 + q] = scum[q * 64 + t]; }
        }
    }
}


__device__ __forceinline__ void ssd_light(Frame& F0, CArgs& a, int L, int cid) {
    LAUNDER_F(F0)
    const int tok0 = chunk_tok0(cid), h = F.wave & 3, r = F.wave >> 2, lr = F.lane & 15, g = F.lane >> 4, gp = h >> 1, rh = r * 4 + h;
    const bf16* cb = (const bf16*)(F.ws + WS_SCB) + (size_t)tok0 * 128; const float* cum = (const float*)(F.ws + WS_SCUM) + (size_t)tok0 * 8;
    const bf16* se = (const bf16*)(F.ws + WS_SSE) + (((size_t)cid * 4 + h) * 2 + r) * 4096;
    bf16x8 cfr[4][2], sfr[4][2]; float ec[4];
#pragma unroll
    for (int m = 0; m < 4; ++m) { ec[m] = cum[(size_t)(16 * m + lr) * 8 + rh];
#pragma unroll
        for (int ks = 0; ks < 2; ++ks) cfr[m][ks] = *(const bf16x8*)(cb + (size_t)(16 * m + lr) * 128 + gp * 64 + 32 * ks + 8 * g); }
#pragma unroll
    for (int d = 0; d < 4; ++d) { sfr[d][0] = *(const bf16x8*)(se + (16 * d + lr) * 64 + 8 * g); sfr[d][1] = *(const bf16x8*)(se + (16 * d + lr) * 64 + 32 + 8 * g); }
    const int tt = F.tid >> 3, c0 = (F.tid & 7) * 32;
    bf16x8 zr[4], yi[4];
    { const bf16* zp = (const bf16*)(F.ws + WS_PBUF) + (size_t)(tok0 + tt) * PW + PC_Z + c0; const bf16* yp = (const bf16*)(F.ws + WS_SYI) + (size_t)(tok0 + tt) * 256 + c0;
#pragma unroll
      for (int q = 0; q < 4; ++q) { zr[q] = *(const bf16x8*)(zp + 8 * q); yi[q] = *(const bf16x8*)(yp + 8 * q); } }
    f32x4 y[4][4];
#pragma unroll
    for (int m = 0; m < 4; ++m) { const float e_ = __expf(ec[m]); bf16x8 cs[2];
#pragma unroll
        for (int ks = 0; ks < 2; ++ks) { float cv[8]; unpack8(cfr[m][ks], cv);
#pragma unroll
            for (int e = 0; e < 8; ++e) cv[e] *= e_;
            cs[ks] = pack8(cv); }
#pragma unroll
        for (int d = 0; d < 4; ++d) { y[m][d] = MFMA16(cs[0], sfr[d][0], ((f32x4){0.f, 0.f, 0.f, 0.f})); y[m][d] = MFMA16(cs[1], sfr[d][1], y[m][d]); } }
    LAS float* yx = (LAS float*)(F.lds + SD_RAW);
    __syncthreads();
    if (r == 1) {
#pragma unroll
        for (int m = 0; m < 4; ++m)
#pragma unroll
            for (int d = 0; d < 4; ++d)
#pragma unroll
                for (int j = 0; j < 4; ++j) yx[(16 * m + 4 * g + j) * 260 + h * 64 + 16 * d + lr] = y[m][d][j];
    }
    __syncthreads();
    if (r == 0) {
#pragma unroll
        for (int m = 0; m < 4; ++m)
#pragma unroll
            for (int d = 0; d < 4; ++d)
#pragma unroll
                for (int j = 0; j < 4; ++j) yx[(16 * m + 4 * g + j) * 260 + h * 64 + 16 * d + lr] += y[m][d][j];
    }
    __syncthreads();
    { const float* ng = a.in[I_SSDNG] + L * 256 + c0;
      float v[32]; float ss = 0.f;
#pragma unroll
      for (int q = 0; q < 4; ++q) { float zv[8], yv[8]; unpack8(zr[q], zv); unpack8(yi[q], yv);
#pragma unroll
          for (int e = 0; e < 8; ++e) { const float u = (yx[tt * 260 + c0 + 8 * q + e] + yv[e]) * siluf_(zv[e]); v[8 * q + e] = u; ss += u * u; } }
      ss += swz_xor<1>(ss); ss += swz_xor<2>(ss); ss += swz_xor<4>(ss);
      const float rs = rsqrtf(ss * (1.f / 256.f) + 1e-6f);
      bf16* MX = (bf16*)(F.ws + WS_MIX) + (size_t)(tok0 + tt) * MW + 1024 + c0;
#pragma unroll
      for (int q = 0; q < 4; ++q) { float o8[8];
#pragma unroll
          for (int e = 0; e < 8; ++e) o8[e] = v[8 * q + e] * rs * ng[8 * q + e];
          *(bf16x8*)(MX + 8 * q) = pack8(o8); } }
}

constexpr int FF_XP = 0, FF_TR = FF_XP + 16 * 64 * 16 * 2, FF_TI = FF_TR + 16 * 64 * 16 * 2, FF_TW = FF_TI + 16 * 64 * 16 * 2, FF_FT = FF_TW + 64 * 16 * 8, FF_END = FF_FT + 2 * 64 * 72 * 2;
static_assert(FF_END <= MISC_OFF, "FFT LDS");
__device__ __forceinline__ void fft_unit(Frame& F0, int u) {
    LAUNDER_F(F0)
    const int b = u >> 6, cg = (u >> 2) & 15, kb = u & 3, lr = F.lane & 15, g = F.lane >> 4;
    const bf16* PB = (const bf16*)(F.ws + WS_PBUF) + (size_t)b * SEQ * PW + PC_FU + 16 * cg;
    const bf16* f64 = (const bf16*)(F.ws + WS_TAB + TAB_F64); const float* tw = (const float*)(F.ws + WS_TAB + TAB_TW);
    LAS bf16* xp = (LAS bf16*)(F.lds + FF_XP); LAS bf16* tr = (LAS bf16*)(F.lds + FF_TR); LAS bf16* ti = (LAS bf16*)(F.lds + FF_TI);
    LAS float* stw = (LAS float*)(F.lds + FF_TW);
    LAS bf16* sft = (LAS bf16*)(F.lds + FF_FT);
    bf16x8 fc1[2], fs1[2];
#pragma unroll
    for (int ks = 0; ks < 2; ++ks) { fc1[ks] = *(const bf16x8*)(f64 + (16 * kb + lr) * 64 + 32 * ks + 8 * g); fs1[ks] = *(const bf16x8*)(f64 + 4096 + (16 * kb + lr) * 64 + 32 * ks + 8 * g); }
    const f32x4 zero4 = (f32x4){0.f, 0.f, 0.f, 0.f};
    u32x4 xr[4], ft[2]; f32x2 twr[2];
#pragma unroll
    for (int k = 0; k < 4; ++k) { const int i = F.tid + k * NTHR, n2l = i >> 7, n1 = (i >> 1) & 63, hf = i & 1; xr[k] = *(const u32x4*)(PB + (size_t)(64 * n1 + n2l) * PW + hf * 8); }
#pragma unroll
    for (int k = 0; k < 2; ++k) { const int i = F.tid + k * NTHR; ft[k] = *(const u32x4*)(f64 + (size_t)i * 8); twr[k] = *(const f32x2*)(tw + 2 * ((i >> 4) * (16 * kb + (i & 15)))); }
    __syncthreads();
#pragma unroll
    for (int k = 0; k < 2; ++k) { const int i = F.tid + k * NTHR, row = i >> 3, pc = i & 7; *(LAS u32x4*)(sft + row * 72 + pc * 8) = ft[k]; stw[2 * i] = twr[k][0]; stw[2 * i + 1] = twr[k][1]; }
    for (int pa = 0; pa < 4; ++pa) {
        if (pa) __syncthreads();
#pragma unroll
        for (int k = 0; k < 4; ++k) { const int i = F.tid + k * NTHR, n2l = i >> 7, n1 = (i >> 1) & 63, hf = i & 1; *(LAS u32x4*)(xp + (n2l * 64 + n1) * 16 + hf * 8) = xr[k]; }
        if (pa < 3) {
#pragma unroll
            for (int k = 0; k < 4; ++k) { const int i = F.tid + k * NTHR, n2l = i >> 7, n1 = (i >> 1) & 63, hf = i & 1; xr[k] = *(const u32x4*)(PB + (size_t)(64 * n1 + 16 * (pa + 1) + n2l) * PW + hf * 8); }
        }
        __syncthreads();
#pragma unroll
        for (int q = 0; q < 2; ++q) {
            const int n2l = 2 * F.wave + q, n2 = 16 * pa + n2l;
            f32x4 tc = zero4, ts = zero4;
#pragma unroll
            for (int ks = 0; ks < 2; ++ks) { const LAS bf16* p0 = xp + (n2l * 64 + 32 * ks + 8 * g + ((F.lane & 15) >> 2)) * 16 + 4 * (F.lane & 3); const bf16x8 xb = cat8(trread(p0), trread(p0 + 4 * 16));
                tc = MFMA16(fc1[ks], xb, tc); ts = MFMA16(fs1[ks], xb, ts); }
#pragma unroll
            for (int j = 0; j < 4; ++j) { const int k1l = 4 * g + j; const f32x2 w = *(const LAS f32x2*)(stw + 2 * (n2 * 16 + k1l));
                tr[(k1l * 64 + n2) * 16 + lr] = (bf16)f2bf(tc[j] * w[0] - ts[j] * w[1]); ti[(k1l * 64 + n2) * 16 + lr] = (bf16)f2bf(-(tc[j] * w[1] + ts[j] * w[0])); }
        }
    }
    __syncthreads();
    bf16* MX0 = (bf16*)(F.ws + WS_MIX) + (size_t)b * SEQ * MW + 16 * cg;
    LAS bf16* so = xp + F.wave * 2048;
#pragma unroll
    for (int q = 0; q < 2; ++q) {
        const int k1l = 2 * F.wave + q, k1 = 16 * kb + k1l;
        bf16x8 br[2], bi[2];
#pragma unroll
        for (int ks = 0; ks < 2; ++ks) { const int off = (k1l * 64 + 32 * ks + 8 * g + ((F.lane & 15) >> 2)) * 16 + 4 * (F.lane & 3); br[ks] = cat8(trread(tr + off), trread(tr + off + 64)); bi[ks] = cat8(trread(ti + off), trread(ti + off + 64)); }
#pragma unroll
        for (int m = 0; m < 4; ++m) {
            f32x4 yr = zero4, y1 = zero4, y2 = zero4;
#pragma unroll
            for (int ks = 0; ks < 2; ++ks) { const bf16x8 fc = *(const LAS bf16x8*)(sft + (16 * m + lr) * 72 + 32 * ks + 8 * g), fs = *(const LAS bf16x8*)(sft + (64 + 16 * m + lr) * 72 + 32 * ks + 8 * g);
                yr = MFMA16(fc, br[ks], yr); yr = MFMA16(fs, bi[ks], yr); y1 = MFMA16(fc, bi[ks], y1); y2 = MFMA16(fs, br[ks], y2); }
#pragma unroll
            for (int j = 0; j < 4; ++j) { const int k2 = 16 * m + 4 * g + j; so[k2 * 32 + lr] = (bf16)f2bf(yr[j] * (1.f / 64.f)); so[k2 * 32 + 16 + lr] = (bf16)f2bf((y1[j] - y2[j]) * (1.f / 64.f)); }
        }
#pragma unroll
        for (int p = 0; p < 4; ++p) { const int pc = F.lane + 64 * p, k2 = pc >> 2, part = pc & 3;
            const u32x4 v = *(const LAS u32x4*)(so + k2 * 32 + (part >> 1) * 16 + (part & 1) * 8);
            *(u32x4*)(MX0 + (size_t)(64 * k2 + k1) * MW + (part >> 1) * 256 + (part & 1) * 8) = v; }
    }
}
constexpr int CD_RS = 264;
static_assert(256 * CD_RS * 2 <= MISC_OFF, "ctx DFT LDS");
__device__ __forceinline__ void dft_ctx_unit(Frame& F0, int u) {
    LAUNDER_F(F0)
    const int b = u >> 3, kb = u & 7, lr = F.lane & 15, g = F.lane >> 4;
    LAS bf16* sl = (LAS bf16*)F.lds;
    const bf16* PB = (const bf16*)(F.ws + WS_PBUF) + (size_t)(NLAT + b * CTXL) * PW + PC_FU;
    const bf16* dc = (const bf16*)(F.ws + WS_DFTC);
    __syncthreads();
#pragma unroll
    for (int h = 0; h < 2; ++h) { u32x4 v[8];
#pragma unroll
        for (int k = 0; k < 8; ++k) { const int i = F.tid + (h * 8 + k) * NTHR, n = i >> 5, pc = i & 31; v[k] = *(const u32x4*)(PB + (size_t)n * PW + pc * 8); }
#pragma unroll
        for (int k = 0; k < 8; ++k) { const int i = F.tid + (h * 8 + k) * NTHR, n = i >> 5, pc = i & 31; *(LAS u32x4*)(sl + n * CD_RS + pc * 8) = v[k]; } }
    __syncthreads();
    f32x4 acc[4][2];
#pragma unroll
    for (int mt = 0; mt < 4; ++mt)
#pragma unroll
        for (int nt = 0; nt < 2; ++nt) acc[mt][nt] = (f32x4){0.f, 0.f, 0.f, 0.f};
#pragma unroll 2
    for (int ks = 0; ks < 8; ++ks) {
        bf16x8 af[4], bfm[2];
#pragma unroll
        for (int mt = 0; mt < 4; ++mt) af[mt] = *(const bf16x8*)(dc + (size_t)((mt >> 1) * 256 + 32 * kb + 16 * (mt & 1) + lr) * 256 + 32 * ks + 8 * g);
#pragma unroll
        for (int nt = 0; nt < 2; ++nt) { const LAS bf16* p0 = sl + (32 * ks + 8 * g + ((F.lane & 15) >> 2)) * CD_RS + 32 * F.wave + 16 * nt + 4 * (F.lane & 3); bfm[nt] = cat8(trread(p0), trread(p0 + 4 * CD_RS)); }
#pragma unroll
        for (int mt = 0; mt < 4; ++mt)
#pragma unroll
            for (int nt = 0; nt < 2; ++nt) acc[mt][nt] = MFMA16(af[mt], bfm[nt], acc[mt][nt]);
    }
    bf16* MX = (bf16*)(F.ws + WS_MIX) + (size_t)(NLAT + b * CTXL + 32 * kb) * MW + 32 * F.wave + lr;
#pragma unroll
    for (int mt = 0; mt < 4; ++mt)
#pragma unroll
        for (int nt = 0; nt < 2; ++nt)
#pragma unroll
            for (int j = 0; j < 4; ++j) MX[(size_t)(16 * (mt & 1) + 4 * g + j) * MW + (mt >> 1) * 256 + 16 * nt] = (bf16)f2bf(acc[mt][nt][j] * (1.f / 16.f));
}

#ifndef SUBMASK
#define SUBMASK 0xFFFF
#endif
#define SUB(bit) (rep == 0 || ((SUBMASK >> (bit)) & 1))
__device__ __forceinline__ void p_mix_a(Frame& F, CArgs& a, int L, int rep = 0) {
    if (SUB(0)) {
        pg8::Gemm g{(const bf16*)(F.ws + WS_A2), (const bf16*)(F.ws + WS_S5P) + (size_t)L * 16 * 256 * 256, 1024, 512, OPQ(256)};
        SgOrder<FillS5> S; S.init(144, 1, F.G, F.bid); S.f = FillS5{(size_t)256 * 256 * 2};
        EpiS5S E{(float*)(F.ws + WS_S5S)};
        pg8::gemm_phase(F.lds, g, S, E, fresh_tid(F.wave));
    }
    const int og = F.G >= 208 ? 144 : 0, os = F.G >= 208 ? 176 : 32 % F.G;
    if (SUB(1)) for (int u = (F.bid + F.G - og) % F.G; u < NCHK; u += F.G) gla_chunk<MIX_P1 ? 2 : 0>(F, a, L, u);
    if (SUB(2)) for (int u = (F.bid + F.G - os) % F.G; u < NCHK; u += F.G) ssd_chunk<MIX_P1 ? 2 : 0>(F, a, L, u);
    __syncthreads();
}
__device__ __forceinline__ void p_mix_b(Frame& F, CArgs& a, int L, int rep = 0) {
    if (SUB(3)) for (int u = F.bid; u < 256; u += F.G) {
        const int vz = F.tid >> 9, uv = u + vz, wv = (F.tid >> 6);
        const int b = uv >> 5, g = (uv >> 1) & 15, r = uv & 1;
        const f32x2 a16 = *(const f32x2*)((const float*)(F.ws + WS_A16) + ((size_t)((L * 2 + r) * 16 + g) * 64 + F.lane) * 2);
        const float* S = (const float*)(F.ws + WS_S5S) + (size_t)g * S5ROWS * 256 + r * 128 + F.lane; bf16* A2 = (bf16*)(F.ws + WS_A2) + (size_t)g * S5ROWS * 512 + 256 + r * 128 + F.lane;
        LAS float* ex = (LAS float*)F.lds;
        LAS float* sl = ex + 17 * 128;
        __syncthreads();
#pragma unroll 1
        for (int sg = wv; sg < 17; sg += 8) {
            float sr[16], si[16];
#pragma unroll
            for (int n = 0; n < 16; ++n) { const int i = 16 * sg + n; const int row = i < 16 ? 2048 + 16 * b + (r ? 15 - i : i) : 256 * b + (r ? 271 - i : i - 16); sr[n] = S[(size_t)row * 256]; si[n] = S[(size_t)row * 256 + 64]; }
            float hr = 0.f, hi = 0.f;
#pragma unroll
            for (int n = 0; n < 16; ++n) { sl[((16 * sg + n) * 64 + F.lane) * 2] = sr[n]; sl[((16 * sg + n) * 64 + F.lane) * 2 + 1] = si[n];
                const float nr = a16[0] * hr - a16[1] * hi + sr[n], ni = a16[0] * hi + a16[1] * hr + si[n]; hr = nr; hi = ni; }
            ex[(sg * 64 + F.lane) * 2] = hr; ex[(sg * 64 + F.lane) * 2 + 1] = hi;
        }
        __syncthreads();
        float pr = a16[0], pi = a16[1];
#pragma unroll
        for (int q = 0; q < 4; ++q) { const float nr = pr * pr - pi * pi, ni = 2.f * pr * pi; pr = nr; pi = ni; }
#pragma unroll 1
        for (int sg = wv; sg < 17; sg += 8) {
            float hr = 0.f, hi = 0.f;
            for (int j = 0; j < sg; ++j) { const float er = ex[(j * 64 + F.lane) * 2], ei = ex[(j * 64 + F.lane) * 2 + 1]; const float nr = pr * hr - pi * hi + er, ni = pr * hi + pi * hr + ei; hr = nr; hi = ni; }
#pragma unroll 4
            for (int n = 0; n < 16; ++n) { const int i = 16 * sg + n; const int row = i < 16 ? 2048 + 16 * b + (r ? 15 - i : i) : 256 * b + (r ? 271 - i : i - 16);
                A2[(size_t)row * 512] = (bf16)f2bf(hr); A2[(size_t)row * 512 + 64] = (bf16)f2bf(hi);
                const float xr_ = sl[(i * 64 + F.lane) * 2], xi_ = sl[(i * 64 + F.lane) * 2 + 1];
                const float nr = a16[0] * hr - a16[1] * hi + xr_, ni = a16[0] * hi + a16[1] * hr + xi_; hr = nr; hi = ni; }
        }
    }
    if (SUB(3)) for (int u = F.bid; u < 256; u += F.G) { const int uv = u + (F.tid >> 9), sq = uv >> 2, b = sq >> 3, hh = (sq >> 1) & 3, r = sq & 1, e = (uv & 3) * 512 + F.tid, c = e & 31;
        const float* ds = (const float*)(F.ws + WS_GDS); const float* dc = (const float*)(F.ws + WS_GDEC); bf16* se = (bf16*)(F.ws + WS_GSE);
        float s = 0.f;
        for (int i0 = 0; i0 < 68; i0 += 17) { float dv[17], cv[17];
#pragma unroll
            for (int k = 0; k < 17; ++k) { const int i = i0 + k; const int cid = i < 4 ? 512 + b * 4 + (r ? 3 - i : i) : b * 64 + (r ? 67 - i : i - 4); const size_t ub = ((size_t)cid * 4 + hh) * 2 + r; dv[k] = ds[ub * 2048 + e]; cv[k] = dc[ub * 32 + c]; }
#pragma unroll
            for (int k = 0; k < 17; ++k) { const int i = i0 + k; const int cid = i < 4 ? 512 + b * 4 + (r ? 3 - i : i) : b * 64 + (r ? 67 - i : i - 4); const size_t ub = ((size_t)cid * 4 + hh) * 2 + r; se[ub * 2048 + e] = (bf16)f2bf(s); s = cv[k] * s + dv[k]; } } }
    if (SUB(3)) for (int u = F.bid; u < 512; u += F.G) { const int uv = u + (F.tid >> 9), sq = uv >> 3, b = sq >> 3, h = (sq >> 1) & 3, r = sq & 1, e = (uv & 7) * 512 + F.tid;
        const float* ds = (const float*)(F.ws + WS_SDS); const float* dc = (const float*)(F.ws + WS_SDEC); bf16* se = (bf16*)(F.ws + WS_SSE);
        float s = 0.f;
        for (int i0 = 0; i0 < 68; i0 += 17) { float dv[17], cv[17];
#pragma unroll
            for (int k = 0; k < 17; ++k) { const int i = i0 + k; const int cid = i < 4 ? 512 + b * 4 + (r ? 3 - i : i) : b * 64 + (r ? 67 - i : i - 4); const size_t ub = ((size_t)cid * 4 + h) * 2 + r; dv[k] = ds[ub * 4096 + e]; cv[k] = dc[ub]; }
#pragma unroll
            for (int k = 0; k < 17; ++k) { const int i = i0 + k; const int cid = i < 4 ? 512 + b * 4 + (r ? 3 - i : i) : b * 64 + (r ? 67 - i : i - 4); const size_t ub = ((size_t)cid * 4 + h) * 2 + r; se[ub * 4096 + e] = (bf16)f2bf(s); s = cv[k] * s + dv[k]; } } }
    if (SUB(4)) for (int u = F.bid; u < 512; u += F.G) fft_unit(F, u);
    if (SUB(5)) for (int u = (F.bid + 64) % F.G; u < 64; u += F.G) dft_ctx_unit(F, u);
    __syncthreads();
}
__device__ __forceinline__ void p_mix_c(Frame& F, CArgs& a, int L, int rep = 0) {
#ifndef MIXC_PARTS
#define MIXC_PARTS 7
#endif
    if ((MIXC_PARTS & 1) && SUB(6)) {
        pg8::Gemm g{(const bf16*)(F.ws + WS_A2), (const bf16*)(F.ws + WS_S5B2) + (size_t)L * 16 * 256 * 512, 1024, 1024, OPQ(512)};
        SgOrder<FillS5> S; S.init(144, 1, F.G, F.bid); S.f = FillS5{(size_t)256 * 512 * 2};
        EpiS5Y E{(bf16*)(F.ws + WS_ACT5)};
        pg8::gemm_phase(F.lds, g, S, E, fresh_tid(F.wave));
    }
    const int nch = (L == DEPTH - 1) ? 512 : NCHK;
    const int og = F.G >= 208 ? 144 : 0, os = F.G >= 208 ? 176 : 32 % F.G;
    if ((MIXC_PARTS & 2) && SUB(7)) for (int u = (F.bid + F.G - og) % F.G; u < nch; u += F.G) { if constexpr (MIX_P1) gla_light(F, a, L, u); else gla_chunk<1>(F, a, L, u); }
    if ((MIXC_PARTS & 4) && SUB(8)) for (int u = (F.bid + F.G - os) % F.G; u < nch; u += F.G) { if constexpr (MIX_P1) ssd_light(F, a, L, u); else ssd_chunk<1>(F, a, L, u); }
    __syncthreads();
}

constexpr int NPH = 11, PH_TOTAL = 2 + DEPTH * NPH;
#ifndef PHASE_MASK
#define PHASE_MASK 0xFFFF
#endif
#define PM(i) ((PHASE_MASK >> (i)) & 1)
#ifndef DUP_MASK
#define DUP_MASK 0
#endif
#define NREP(k) (((DUP_MASK >> (k)) & 1) ? 2 : 1)
#ifndef MK_ONE_LAUNCH
#define MK_ONE_LAUNCH 0
#endif

__global__ void __launch_bounds__(NTHR, 2) mk_fwd(Args args_by_value) {
#define args (*fresh_args())
    extern __shared__ __attribute__((aligned(16))) unsigned char lds_raw[];
    Frame F;
    F.lds = (LAS unsigned char*)lds_raw; F.MISC = (volatile LAS unsigned*)(F.lds + MISC_OFF);
    F.tid = threadIdx.x; F.lane = F.tid & 63; F.wave = __builtin_amdgcn_readfirstlane(F.tid >> 6); F.G = gridDim.x; F.bid = blockIdx.x;
    F.ws = args_by_value.ws; F.ctl = (unsigned*)(args_by_value.ws + WS_CTL);
    if (F.tid < 64) F.MISC[F.tid] = 0u;
    __syncthreads();
#if MK_ONE_LAUNCH
    XcdBarrier bar = xcd_barrier_post(F.ctl + CW_BAR, F.MISC + 8);
#define GRID_BAR() xcd_barrier(bar)
#else
#define GRID_BAR() do { } while (0)
#endif
    const int lo = args_by_value.ph_lo, hi = args_by_value.ph_hi;
#define IN(k) (lo <= (k) && (k) < hi)
#define FRESH() do { const int t_ = fresh_tid(F.wave); F.tid = t_; F.lane = t_ & 63; } while (0)
#define SEAM(k) do { if (IN(k) && IN((k) + 1)) GRID_BAR(); } while (0)
    if (PM(0) && IN(0)) { FRESH(); p_prologue(F, args); }
#ifdef DUP_PROLOGUE
    GRID_BAR(); if (PM(0) && IN(0)) { FRESH(); p_prologue(F, args, CW_QUEUE + 64); }
#endif
    SEAM(0);
    {
        const int pb = 1 + 0 * NPH;
        const int mrows = (0 == DEPTH - 1) ? NLAT : NT;
        if (PM(1) && IN(pb + 0)) { FRESH(); p_norm1(F, args, OPQ(0)); }
#ifdef DUP_NORM1
        GRID_BAR(); if (PM(1) && IN(pb + 0)) { FRESH(); p_norm1(F, args, OPQ(0), true); }
#endif
 SEAM(pb + 0);
        if (PM(2) && IN(pb + 1)) for (int rep_ = 0; rep_ < NREP(2); ++rep_) { if (rep_) GRID_BAR(); const int Lg = OPQ(0);
            pg8::Gemm g{(const bf16*)(F.ws + WS_H), (const bf16*)(F.ws + WS_WIN) + (size_t)Lg * PW * DM, DM * 2, DM * 2, OPQ(DM)};
            SgOrder<FillPlain> S; S.init(NT / 256, PW / 256, F.G, F.bid); S.f = FillPlain{(size_t)256 * DM * 2, (size_t)256 * DM * 2};
            EpiInproj E{(bf16*)(F.ws + WS_PBUF), (bf16*)(F.ws + WS_A2)};
            pg8::gemm_phase(F.lds, g, S, E, fresh_tid(F.wave));
        }
#if defined(SHADOW_IN)
        if (PM(2) && IN(pb + 1)) { GRID_BAR(); const int Lg = OPQ(0);
            pg8::Gemm g{(const bf16*)(F.ws + WS_H), (const bf16*)(F.ws + WS_WIN) + (size_t)Lg * PW * DM, DM * 2, DM * 2, OPQ(DM)};
            SgOrder<FillPlain> S; S.init(NT / 256, PW / 256, F.G, F.bid); S.f = FillPlain{(size_t)256 * DM * 2, (size_t)256 * DM * 2};
            EpiNull E{(float*)(F.ws + WS_Y)};
            pg8::gemm_phase(F.lds, g, S, E, fresh_tid(F.wave));
        }
#endif
        SEAM(pb + 1);
        if (PM(3) && IN(pb + 2)) for (int rep_ = 0; rep_ < NREP(3); ++rep_) { if (rep_) GRID_BAR(); FRESH(); p_mix_a(F, args, OPQ(0), rep_); } SEAM(pb + 2);
        if (PM(4) && IN(pb + 3)) for (int rep_ = 0; rep_ < NREP(4); ++rep_) { if (rep_) GRID_BAR(); FRESH(); p_mix_b(F, args, OPQ(0), rep_); } SEAM(pb + 3);
        if (PM(5) && IN(pb + 4)) for (int rep_ = 0; rep_ < NREP(5); ++rep_) { if (rep_) GRID_BAR(); FRESH(); p_mix_c(F, args, OPQ(0), rep_); } SEAM(pb + 4);
        if (PM(6) && IN(pb + 5)) for (int rep_ = 0; rep_ < NREP(6); ++rep_) { if (rep_) GRID_BAR(); const int Lg = OPQ(0);
            pg8::Gemm g{(const bf16*)(F.ws + WS_ACT5), (const bf16*)(F.ws + WS_WGLU) + (size_t)Lg * 256 * 256, 512, 512, OPQ(256)};
            SgOrder<FillPlain> S; S.init(NT / 256, 1, F.G, F.bid); S.f = FillPlain{(size_t)256 * 256 * 2, 0};
            EpiGlu E{(const bf16*)(F.ws + WS_ACT5), (bf16*)(F.ws + WS_MIX)};
            pg8::gemm_phase(F.lds, g, S, E, fresh_tid(F.wave));
        } SEAM(pb + 5);
        if (PM(7) && IN(pb + 6)) { const int Lg = OPQ(0);
            pg8::Gemm g{(const bf16*)(F.ws + WS_MIX), (const bf16*)(F.ws + WS_WOUT) + (size_t)Lg * DM * MW, MW * 2, MW * 2, OPQ(MW)};
            SgOrder<FillPlain> S; S.init((Lg == DEPTH - 1 ? NLAT : NT) / 256, DM / 256, F.G, F.bid); S.f = FillPlain{(size_t)256 * MW * 2, (size_t)256 * MW * 2};
            EpiOutproj E{args.in[I_X], args.in[I_CTX], (bf16*)(F.ws + WS_XS), (const float*)(F.ws + WS_MOD) + (size_t)Lg * 9 * 6144, Lg == 0 ? 1 : 0};
            pg8::gemm_phase(F.lds, g, S, E, fresh_tid(F.wave));
        } SEAM(pb + 6);
        if (PM(8) && IN(pb + 7)) { FRESH(); p_norm2(F, args, OPQ(0), OPQ(mrows)); }
#ifdef DUP_NORM2
        GRID_BAR(); if (PM(8) && IN(pb + 7)) { FRESH(); p_norm2(F, args, OPQ(0), OPQ(mrows), 6400); }
#endif
 SEAM(pb + 7);
        if (PM(10) && IN(pb + 9)) { const int Lg = OPQ(0); FRESH();
            const int nblk = moe_tables(F, Lg);
            LAS int* lbs = (LAS int*)(F.lds + MOE_LB); LAS int* lcs = (LAS int*)(F.lds + MOE_LC); LAS unsigned* gat = (LAS unsigned*)(F.lds + MOE_GAT);
            SgOrder<FillMoe> S; S.init(nblk, 8, F.G, F.bid); S.f = FillMoe{(const LAS unsigned*)(F.lds + MOE_LBLK), 2048};
            { const int* TM = (const int*)(F.ws + WS_TM); const float* PG = (const float*)(F.ws + WS_PG); int* PS = (int*)(F.ws + WS_PS); float* SG = (float*)(F.ws + WS_SG);
              pg8::Unit u; int cursor = 0;
              for (int ui = 0; ui < MOE_MAXU && S.next(cursor, u); ++ui) {
                  if (F.tid < 256) { const int e = u.grp, rk = u.pm * 256 - lbs[e] + F.tid; const bool ok = rk < lcs[e];
                      const int id = ok ? TM[(size_t)e * NT + rk] : 0;
                      gat[ui * 256 + F.tid] = (unsigned)(id >> 2) * (unsigned)DM;
                      if (ok && u.pn == 0) { const int slot = u.pm * 256 + F.tid; PS[id] = slot; SG[slot] = PG[id]; } } } }
            __syncthreads();
            pg8::Gemm g{F.ws + WS_H8, F.ws + WS_WGU + (size_t)Lg * NEXP * 2048 * DM, DM, DM, OPQ(DM / 2)};
            EpiSwiglu E{(unsigned char*)(F.ws + WS_ACT), args.in[I_BGU] + (size_t)Lg * NEXP * 2048};
            pg8::gemm_phase<EpiSwiglu, SgOrder<FillMoe>, true, F8_ALIGN, F8_SP2, true>(F.lds, g, S, E, fresh_tid(F.wave), gat);
        } SEAM(pb + 9);
        if (PM(11) && IN(pb + 10)) for (int rep_ = 0; rep_ < NREP(11); ++rep_) { if (rep_) GRID_BAR(); const int Lg = OPQ(0); FRESH();
            const int nblk = moe_tables(F, Lg);
            pg8::Gemm g{F.ws + WS_ACT, F.ws + WS_WDN + (size_t)Lg * NEXP * DM * DM, DM, DM, OPQ(DM / 2)};
            SgOrder<FillMoe> S; S.init(nblk, 4, F.G, F.bid); S.f = FillMoe{(const LAS unsigned*)(F.lds + MOE_LBLK), 1024};
            EpiDown E{(unsigned char*)(F.ws + WS_Y), args.in[I_BDN] + (size_t)Lg * NEXP * DM, (const float*)(F.ws + WS_SG)};
            pg8::gemm_phase<EpiDown, SgOrder<FillMoe>, true, F8_ALIGN, F8_SP2>(F.lds, g, S, E, fresh_tid(F.wave));
        } SEAM(pb + 10);
        }
    {
        const int pb = 1 + 1 * NPH;
        const int mrows = (1 == DEPTH - 1) ? NLAT : NT;
        if (PM(1) && IN(pb + 0)) { FRESH(); p_norm1(F, args, OPQ(1)); }
#ifdef DUP_NORM1
        GRID_BAR(); if (PM(1) && IN(pb + 0)) { FRESH(); p_norm1(F, args, OPQ(1), true); }
#endif
 SEAM(pb + 0);
        if (PM(2) && IN(pb + 1)) for (int rep_ = 0; rep_ < NREP(2); ++rep_) { if (rep_) GRID_BAR(); const int Lg = OPQ(1);
            pg8::Gemm g{(const bf16*)(F.ws + WS_H), (const bf16*)(F.ws + WS_WIN) + (size_t)Lg * PW * DM, DM * 2, DM * 2, OPQ(DM)};
            SgOrder<FillPlain> S; S.init(NT / 256, PW / 256, F.G, F.bid); S.f = FillPlain{(size_t)256 * DM * 2, (size_t)256 * DM * 2};
            EpiInproj E{(bf16*)(F.ws + WS_PBUF), (bf16*)(F.ws + WS_A2)};
            pg8::gemm_phase(F.lds, g, S, E, fresh_tid(F.wave));
        }
#if defined(SHADOW_IN)
        if (PM(2) && IN(pb + 1)) { GRID_BAR(); const int Lg = OPQ(1);
            pg8::Gemm g{(const bf16*)(F.ws + WS_H), (const bf16*)(F.ws + WS_WIN) + (size_t)Lg * PW * DM, DM * 2, DM * 2, OPQ(DM)};
            SgOrder<FillPlain> S; S.init(NT / 256, PW / 256, F.G, F.bid); S.f = FillPlain{(size_t)256 * DM * 2, (size_t)256 * DM * 2};
            EpiNull E{(float*)(F.ws + WS_Y)};
            pg8::gemm_phase(F.lds, g, S, E, fresh_tid(F.wave));
        }
#endif
        SEAM(pb + 1);
        if (PM(3) && IN(pb + 2)) for (int rep_ = 0; rep_ < NREP(3); ++rep_) { if (rep_) GRID_BAR(); FRESH(); p_mix_a(F, args, OPQ(1), rep_); } SEAM(pb + 2);
        if (PM(4) && IN(pb + 3)) for (int rep_ = 0; rep_ < NREP(4); ++rep_) { if (rep_) GRID_BAR(); FRESH(); p_mix_b(F, args, OPQ(1), rep_); } SEAM(pb + 3);
        if (PM(5) && IN(pb + 4)) for (int rep_ = 0; rep_ < NREP(5); ++rep_) { if (rep_) GRID_BAR(); FRESH(); p_mix_c(F, args, OPQ(1), rep_); } SEAM(pb + 4);
        if (PM(6) && IN(pb + 5)) for (int rep_ = 0; rep_ < NREP(6); ++rep_) { if (rep_) GRID_BAR(); const int Lg = OPQ(1);
            pg8::Gemm g{(const bf16*)(F.ws + WS_ACT5), (const bf16*)(F.ws + WS_WGLU) + (size_t)Lg * 256 * 256, 512, 512, OPQ(256)};
            SgOrder<FillPlain> S; S.init(NT / 256, 1, F.G, F.bid); S.f = FillPlain{(size_t)256 * 256 * 2, 0};
            EpiGlu E{(const bf16*)(F.ws + WS_ACT5), (bf16*)(F.ws + WS_MIX)};
            pg8::gemm_phase(F.lds, g, S, E, fresh_tid(F.wave));
        } SEAM(pb + 5);
        if (PM(7) && IN(pb + 6)) { const int Lg = OPQ(1);
            pg8::Gemm g{(const bf16*)(F.ws + WS_MIX), (const bf16*)(F.ws + WS_WOUT) + (size_t)Lg * DM * MW, MW * 2, MW * 2, OPQ(MW)};
            SgOrder<FillPlain> S; S.init((Lg == DEPTH - 1 ? NLAT : NT) / 256, DM / 256, F.G, F.bid); S.f = FillPlain{(size_t)256 * MW * 2, (size_t)256 * MW * 2};
            EpiOutproj E{args.in[I_X], args.in[I_CTX], (bf16*)(F.ws + WS_XS), (const float*)(F.ws + WS_MOD) + (size_t)Lg * 9 * 6144, Lg == 0 ? 1 : 0};
            pg8::gemm_phase(F.lds, g, S, E, fresh_tid(F.wave));
        } SEAM(pb + 6);
        if (PM(8) && IN(pb + 7)) { FRESH(); p_norm2(F, args, OPQ(1), OPQ(mrows)); }
#ifdef DUP_NORM2
        GRID_BAR(); if (PM(8) && IN(pb + 7)) { FRESH(); p_norm2(F, args, OPQ(1), OPQ(mrows), 6400); }
#endif
 SEAM(pb + 7);
        if (PM(10) && IN(pb + 9)) { const int Lg = OPQ(1); FRESH();
            const int nblk = moe_tables(F, Lg);
            LAS int* lbs = (LAS int*)(F.lds + MOE_LB); LAS int* lcs = (LAS int*)(F.lds + MOE_LC); LAS unsigned* gat = (LAS unsigned*)(F.lds + MOE_GAT);
            SgOrder<FillMoe> S; S.init(nblk, 8, F.G, F.bid); S.f = FillMoe{(const LAS unsigned*)(F.lds + MOE_LBLK), 2048};
            { const int* TM = (const int*)(F.ws + WS_TM); const float* PG = (const float*)(F.ws + WS_PG); int* PS = (int*)(F.ws + WS_PS); float* SG = (float*)(F.ws + WS_SG);
              pg8::Unit u; int cursor = 0;
              for (int ui = 0; ui < MOE_MAXU && S.next(cursor, u); ++ui) {
                  if (F.tid < 256) { const int e = u.grp, rk = u.pm * 256 - lbs[e] + F.tid; const bool ok = rk < lcs[e];
                      const int id = ok ? TM[(size_t)e * NT + rk] : 0;
                      gat[ui * 256 + F.tid] = (unsigned)(id >> 2) * (unsigned)DM;
                      if (ok && u.pn == 0) { const int slot = u.pm * 256 + F.tid; PS[id] = slot; SG[slot] = PG[id]; } } } }
            __syncthreads();
            pg8::Gemm g{F.ws + WS_H8, F.ws + WS_WGU + (size_t)Lg * NEXP * 2048 * DM, DM, DM, OPQ(DM / 2)};
            EpiSwiglu E{(unsigned char*)(F.ws + WS_ACT), args.in[I_BGU] + (size_t)Lg * NEXP * 2048};
            pg8::gemm_phase<EpiSwiglu, SgOrder<FillMoe>, true, F8_ALIGN, F8_SP2, true>(F.lds, g, S, E, fresh_tid(F.wave), gat);
        } SEAM(pb + 9);
        if (PM(11) && IN(pb + 10)) for (int rep_ = 0; rep_ < NREP(11); ++rep_) { if (rep_) GRID_BAR(); const int Lg = OPQ(1); FRESH();
            const int nblk = moe_tables(F, Lg);
            pg8::Gemm g{F.ws + WS_ACT, F.ws + WS_WDN + (size_t)Lg * NEXP * DM * DM, DM, DM, OPQ(DM / 2)};
            SgOrder<FillMoe> S; S.init(nblk, 4, F.G, F.bid); S.f = FillMoe{(const LAS unsigned*)(F.lds + MOE_LBLK), 1024};
            EpiDown E{(unsigned char*)(F.ws + WS_Y), args.in[I_BDN] + (size_t)Lg * NEXP * DM, (const float*)(F.ws + WS_SG)};
            pg8::gemm_phase<EpiDown, SgOrder<FillMoe>, true, F8_ALIGN, F8_SP2>(F.lds, g, S, E, fresh_tid(F.wave));
        } SEAM(pb + 10);
        }
    {
        const int pb = 1 + 2 * NPH;
        const int mrows = (2 == DEPTH - 1) ? NLAT : NT;
        if (PM(1) && IN(pb + 0)) { FRESH(); p_norm1(F, args, OPQ(2)); }
#ifdef DUP_NORM1
        GRID_BAR(); if (PM(1) && IN(pb + 0)) { FRESH(); p_norm1(F, args, OPQ(2), true); }
#endif
 SEAM(pb + 0);
        if (PM(2) && IN(pb + 1)) for (int rep_ = 0; rep_ < NREP(2); ++rep_) { if (rep_) GRID_BAR(); const int Lg = OPQ(2);
            pg8::Gemm g{(const bf16*)(F.ws + WS_H), (const bf16*)(F.ws + WS_WIN) + (size_t)Lg * PW * DM, DM * 2, DM * 2, OPQ(DM)};
            SgOrder<FillPlain> S; S.init(NT / 256, PW / 256, F.G, F.bid); S.f = FillPlain{(size_t)256 * DM * 2, (size_t)256 * DM * 2};
            EpiInproj E{(bf16*)(F.ws + WS_PBUF), (bf16*)(F.ws + WS_A2)};
            pg8::gemm_phase(F.lds, g, S, E, fresh_tid(F.wave));
        }
#if defined(SHADOW_IN)
        if (PM(2) && IN(pb + 1)) { GRID_BAR(); const int Lg = OPQ(2);
            pg8::Gemm g{(const bf16*)(F.ws + WS_H), (const bf16*)(F.ws + WS_WIN) + (size_t)Lg * PW * DM, DM * 2, DM * 2, OPQ(DM)};
            SgOrder<FillPlain> S; S.init(NT / 256, PW / 256, F.G, F.bid); S.f = FillPlain{(size_t)256 * DM * 2, (size_t)256 * DM * 2};
            EpiNull E{(float*)(F.ws + WS_Y)};
            pg8::gemm_phase(F.lds, g, S, E, fresh_tid(F.wave));
        }
#endif
        SEAM(pb + 1);
        if (PM(3) && IN(pb + 2)) for (int rep_ = 0; rep_ < NREP(3); ++rep_) { if (rep_) GRID_BAR(); FRESH(); p_mix_a(F, args, OPQ(2), rep_); } SEAM(pb + 2);
        if (PM(4) && IN(pb + 3)) for (int rep_ = 0; rep_ < NREP(4); ++rep_) { if (rep_) GRID_BAR(); FRESH(); p_mix_b(F, args, OPQ(2), rep_); } SEAM(pb + 3);
        if (PM(5) && IN(pb + 4)) for (int rep_ = 0; rep_ < NREP(5); ++rep_) { if (rep_) GRID_BAR(); FRESH(); p_mix_c(F, args, OPQ(2), rep_); } SEAM(pb + 4);
        if (PM(6) && IN(pb + 5)) for (int rep_ = 0; rep_ < NREP(6); ++rep_) { if (rep_) GRID_BAR(); const int Lg = OPQ(2);
            pg8::Gemm g{(const bf16*)(F.ws + WS_ACT5), (const bf16*)(F.ws + WS_WGLU) + (size_t)Lg * 256 * 256, 512, 512, OPQ(256)};
            SgOrder<FillPlain> S; S.init(NT / 256, 1, F.G, F.bid); S.f = FillPlain{(size_t)256 * 256 * 2, 0};
            EpiGlu E{(const bf16*)(F.ws + WS_ACT5), (bf16*)(F.ws + WS_MIX)};
            pg8::gemm_phase(F.lds, g, S, E, fresh_tid(F.wave));
        } SEAM(pb + 5);
        if (PM(7) && IN(pb + 6)) { const int Lg = OPQ(2);
            pg8::Gemm g{(const bf16*)(F.ws + WS_MIX), (const bf16*)(F.ws + WS_WOUT) + (size_t)Lg * DM * MW, MW * 2, MW * 2, OPQ(MW)};
            SgOrder<FillPlain> S; S.init((Lg == DEPTH - 1 ? NLAT : NT) / 256, DM / 256, F.G, F.bid); S.f = FillPlain{(size_t)256 * MW * 2, (size_t)256 * MW * 2};
            EpiOutproj E{args.in[I_X], args.in[I_CTX], (bf16*)(F.ws + WS_XS), (const float*)(F.ws + WS_MOD) + (size_t)Lg * 9 * 6144, Lg == 0 ? 1 : 0};
            pg8::gemm_phase(F.lds, g, S, E, fresh_tid(F.wave));
        } SEAM(pb + 6);
        if (PM(8) && IN(pb + 7)) { FRESH(); p_norm2(F, args, OPQ(2), OPQ(mrows)); }
#ifdef DUP_NORM2
        GRID_BAR(); if (PM(8) && IN(pb + 7)) { FRESH(); p_norm2(F, args, OPQ(2), OPQ(mrows), 6400); }
#endif
 SEAM(pb + 7);
        if (PM(10) && IN(pb + 9)) { const int Lg = OPQ(2); FRESH();
            const int nblk = moe_tables(F, Lg);
            LAS int* lbs = (LAS int*)(F.lds + MOE_LB); LAS int* lcs = (LAS int*)(F.lds + MOE_LC); LAS unsigned* gat = (LAS unsigned*)(F.lds + MOE_GAT);
            SgOrder<FillMoe> S; S.init(nblk, 8, F.G, F.bid); S.f = FillMoe{(const LAS unsigned*)(F.lds + MOE_LBLK), 2048};
            { const int* TM = (const int*)(F.ws + WS_TM); const float* PG = (const float*)(F.ws + WS_PG); int* PS = (int*)(F.ws + WS_PS); float* SG = (float*)(F.ws + WS_SG);
              pg8::Unit u; int cursor = 0;
              for (int ui = 0; ui < MOE_MAXU && S.next(cursor, u); ++ui) {
                  if (F.tid < 256) { const int e = u.grp, rk = u.pm * 256 - lbs[e] + F.tid; const bool ok = rk < lcs[e];
                      const int id = ok ? TM[(size_t)e * NT + rk] : 0;
                      gat[ui * 256 + F.tid] = (unsigned)(id >> 2) * (unsigned)DM;
                      if (ok && u.pn == 0) { const int slot = u.pm * 256 + F.tid; PS[id] = slot; SG[slot] = PG[id]; } } } }
            __syncthreads();
            pg8::Gemm g{F.ws + WS_H8, F.ws + WS_WGU + (size_t)Lg * NEXP * 2048 * DM, DM, DM, OPQ(DM / 2)};
            EpiSwiglu E{(unsigned char*)(F.ws + WS_ACT), args.in[I_BGU] + (size_t)Lg * NEXP * 2048};
            pg8::gemm_phase<EpiSwiglu, SgOrder<FillMoe>, true, F8_ALIGN, F8_SP2, true>(F.lds, g, S, E, fresh_tid(F.wave), gat);
        } SEAM(pb + 9);
        if (PM(11) && IN(pb + 10)) for (int rep_ = 0; rep_ < NREP(11); ++rep_) { if (rep_) GRID_BAR(); const int Lg = OPQ(2); FRESH();
            const int nblk = moe_tables(F, Lg);
            pg8::Gemm g{F.ws + WS_ACT, F.ws + WS_WDN + (size_t)Lg * NEXP * DM * DM, DM, DM, OPQ(DM / 2)};
            SgOrder<FillMoe> S; S.init(nblk, 4, F.G, F.bid); S.f = FillMoe{(const LAS unsigned*)(F.lds + MOE_LBLK), 1024};
            EpiDown E{(unsigned char*)(F.ws + WS_Y), args.in[I_BDN] + (size_t)Lg * NEXP * DM, (const float*)(F.ws + WS_SG)};
            pg8::gemm_phase<EpiDown, SgOrder<FillMoe>, true, F8_ALIGN, F8_SP2>(F.lds, g, S, E, fresh_tid(F.wave));
        } SEAM(pb + 10);
        }
    {
        const int pb = 1 + 3 * NPH;
        const int mrows = (3 == DEPTH - 1) ? NLAT : NT;
        if (PM(1) && IN(pb + 0)) { FRESH(); p_norm1(F, args, OPQ(3)); }
#ifdef DUP_NORM1
        GRID_BAR(); if (PM(1) && IN(pb + 0)) { FRESH(); p_norm1(F, args, OPQ(3), true); }
#endif
 SEAM(pb + 0);
        if (PM(2) && IN(pb + 1)) for (int rep_ = 0; rep_ < NREP(2); ++rep_) { if (rep_) GRID_BAR(); const int Lg = OPQ(3);
            pg8::Gemm g{(const bf16*)(F.ws + WS_H), (const bf16*)(F.ws + WS_WIN) + (size_t)Lg * PW * DM, DM * 2, DM * 2, OPQ(DM)};
            SgOrder<FillPlain> S; S.init(NT / 256, PW / 256, F.G, F.bid); S.f = FillPlain{(size_t)256 * DM * 2, (size_t)256 * DM * 2};
            EpiInproj E{(bf16*)(F.ws + WS_PBUF), (bf16*)(F.ws + WS_A2)};
            pg8::gemm_phase(F.lds, g, S, E, fresh_tid(F.wave));
        }
#if defined(SHADOW_IN)
        if (PM(2) && IN(pb + 1)) { GRID_BAR(); const int Lg = OPQ(3);
            pg8::Gemm g{(const bf16*)(F.ws + WS_H), (const bf16*)(F.ws + WS_WIN) + (size_t)Lg * PW * DM, DM * 2, DM * 2, OPQ(DM)};
            SgOrder<FillPlain> S; S.init(NT / 256, PW / 256, F.G, F.bid); S.f = FillPlain{(size_t)256 * DM * 2, (size_t)256 * DM * 2};
            EpiNull E{(float*)(F.ws + WS_Y)};
            pg8::gemm_phase(F.lds, g, S, E, fresh_tid(F.wave));
        }
#endif
        SEAM(pb + 1);
        if (PM(3) && IN(pb + 2)) for (int rep_ = 0; rep_ < NREP(3); ++rep_) { if (rep_) GRID_BAR(); FRESH(); p_mix_a(F, args, OPQ(3), rep_); } SEAM(pb + 2);
        if (PM(4) && IN(pb + 3)) for (int rep_ = 0; rep_ < NREP(4); ++rep_) { if (rep_) GRID_BAR(); FRESH(); p_mix_b(F, args, OPQ(3), rep_); } SEAM(pb + 3);
        if (PM(5) && IN(pb + 4)) for (int rep_ = 0; rep_ < NREP(5); ++rep_) { if (rep_) GRID_BAR(); FRESH(); p_mix_c(F, args, OPQ(3), rep_); } SEAM(pb + 4);
        if (PM(6) && IN(pb + 5)) for (int rep_ = 0; rep_ < NREP(6); ++rep_) { if (rep_) GRID_BAR(); const int Lg = OPQ(3);
            pg8::Gemm g{(const bf16*)(F.ws + WS_ACT5), (const bf16*)(F.ws + WS_WGLU) + (size_t)Lg * 256 * 256, 512, 512, OPQ(256)};
            SgOrder<FillPlain> S; S.init(NT / 256, 1, F.G, F.bid); S.f = FillPlain{(size_t)256 * 256 * 2, 0};
            EpiGlu E{(const bf16*)(F.ws + WS_ACT5), (bf16*)(F.ws + WS_MIX)};
            pg8::gemm_phase(F.lds, g, S, E, fresh_tid(F.wave));
        } SEAM(pb + 5);
        if (PM(7) && IN(pb + 6)) { const int Lg = OPQ(3);
            pg8::Gemm g{(const bf16*)(F.ws + WS_MIX), (const bf16*)(F.ws + WS_WOUT) + (size_t)Lg * DM * MW, MW * 2, MW * 2, OPQ(MW)};
            SgOrder<FillPlain> S; S.init((Lg == DEPTH - 1 ? NLAT : NT) / 256, DM / 256, F.G, F.bid); S.f = FillPlain{(size_t)256 * MW * 2, (size_t)256 * MW * 2};
            EpiOutproj E{args.in[I_X], args.in[I_CTX], (bf16*)(F.ws + WS_XS), (const float*)(F.ws + WS_MOD) + (size_t)Lg * 9 * 6144, Lg == 0 ? 1 : 0};
            pg8::gemm_phase(F.lds, g, S, E, fresh_tid(F.wave));
        } SEAM(pb + 6);
        if (PM(8) && IN(pb + 7)) { FRESH(); p_norm2(F, args, OPQ(3), OPQ(mrows)); }
#ifdef DUP_NORM2
        GRID_BAR(); if (PM(8) && IN(pb + 7)) { FRESH(); p_norm2(F, args, OPQ(3), OPQ(mrows), 6400); }
#endif
 SEAM(pb + 7);
        if (PM(10) && IN(pb + 9)) { const int Lg = OPQ(3); FRESH();
            const int nblk = moe_tables(F, Lg);
            LAS int* lbs = (LAS int*)(F.lds + MOE_LB); LAS int* lcs = (LAS int*)(F.lds + MOE_LC); LAS unsigned* gat = (LAS unsigned*)(F.lds + MOE_GAT);
            SgOrder<FillMoe> S; S.init(nblk, 8, F.G, F.bid); S.f = FillMoe{(const LAS unsigned*)(F.lds + MOE_LBLK), 2048};
            { const int* TM = (const int*)(F.ws + WS_TM); const float* PG = (const float*)(F.ws + WS_PG); int* PS = (int*)(F.ws + WS_PS); float* SG = (float*)(F.ws + WS_SG);
              pg8::Unit u; int cursor = 0;
              for (int ui = 0; ui < MOE_MAXU && S.next(cursor, u); ++ui) {
                  if (F.tid < 256) { const int e = u.grp, rk = u.pm * 256 - lbs[e] + F.tid; const bool ok = rk < lcs[e];
                      const int id = ok ? TM[(size_t)e * NT + rk] : 0;
                      gat[ui * 256 + F.tid] = (unsigned)(id >> 2) * (unsigned)DM;
                      if (ok && u.pn == 0) { const int slot = u.pm * 256 + F.tid; PS[id] = slot; SG[slot] = PG[id]; } } } }
            __syncthreads();
            pg8::Gemm g{F.ws + WS_H8, F.ws + WS_WGU + (size_t)Lg * NEXP * 2048 * DM, DM, DM, OPQ(DM / 2)};
            EpiSwiglu E{(unsigned char*)(F.ws + WS_ACT), args.in[I_BGU] + (size_t)Lg * NEXP * 2048};
            pg8::gemm_phase<EpiSwiglu, SgOrder<FillMoe>, true, F8_ALIGN, F8_SP2, true>(F.lds, g, S, E, fresh_tid(F.wave), gat);
        } SEAM(pb + 9);
        if (PM(11) && IN(pb + 10)) for (int rep_ = 0; rep_ < NREP(11); ++rep_) { if (rep_) GRID_BAR(); const int Lg = OPQ(3); FRESH();
            const int nblk = moe_tables(F, Lg);
            pg8::Gemm g{F.ws + WS_ACT, F.ws + WS_WDN + (size_t)Lg * NEXP * DM * DM, DM, DM, OPQ(DM / 2)};
            SgOrder<FillMoe> S; S.init(nblk, 4, F.G, F.bid); S.f = FillMoe{(const LAS unsigned*)(F.lds + MOE_LBLK), 1024};
            EpiDown E{(unsigned char*)(F.ws + WS_Y), args.in[I_BDN] + (size_t)Lg * NEXP * DM, (const float*)(F.ws + WS_SG)};
            pg8::gemm_phase<EpiDown, SgOrder<FillMoe>, true, F8_ALIGN, F8_SP2>(F.lds, g, S, E, fresh_tid(F.wave));
        } SEAM(pb + 10);
        }
    if (PM(12) && IN(PH_TOTAL - 1)) { FRESH(); p_final(F, args); }
#undef IN
#undef SEAM
#undef args
}

extern "C" void kernel_launch(void* const* d_in, const int* in_sizes, int n_in, void* d_out, int out_size, void* d_ws, size_t ws_size, hipStream_t stream) {
    static int grid = 0;
    if (grid == 0) {
        if (n_in != N_IN || out_size != NLAT * DM || ws_size < WS_END) { fprintf(stderr, "kernel_launch: unexpected shapes (n_in %d, out %d, ws %zu < %zu); nothing launched\n", n_in, out_size, ws_size, (size_t)WS_END); grid = -1; return; }
        int dev = 0, cus = 0, per_cu = 0;
        if (hipGetDevice(&dev) != hipSuccess || hipDeviceGetAttribute(&cus, hipDeviceAttributeMultiprocessorCount, dev) != hipSuccess) { grid = -1; return; }
        if (hipFuncSetAttribute((const void*)mk_fwd, hipFuncAttributeMaxDynamicSharedMemorySize, LDS_BYTES) != hipSuccess) { fprintf(stderr, "kernel_launch: hipFuncSetAttribute failed\n"); grid = -1; return; }
        if (hipOccupancyMaxActiveBlocksPerMultiprocessor(&per_cu, (const void*)mk_fwd, NTHR, LDS_BYTES) != hipSuccess || per_cu < 1) fprintf(stderr, "kernel_launch: occupancy query says %d\n", per_cu);
        (void)hipGetLastError();
        grid = cus;
    }
    if (grid < 0) return;
    (void)hipMemsetAsync((char*)d_ws + WS_CTL, 0, CTL_BYTES, stream);
    Args a{};
    for (int i = 0; i < N_IN; ++i) a.in[i] = (const float*)d_in[i];
    a.out = (float*)d_out; a.ws = (unsigned char*)d_ws;
#if MK_ONE_LAUNCH
    a.ph_lo = 0; a.ph_hi = PH_TOTAL;
    hipLaunchKernelGGL(mk_fwd, dim3(grid), dim3(NTHR), LDS_BYTES, stream, a);
#else
    for (int p = 0; p < PH_TOTAL; ++p) { a.ph_lo = p; a.ph_hi = p + 1; hipLaunchKernelGGL(mk_fwd, dim3(grid), dim3(NTHR), LDS_BYTES, stream, a); }
#endif
}
```

```cpp
#define MK_ONE_LAUNCH 1
#define F8_ALIGN true
#define F8_SP2 true
#include <hip/hip_runtime.h>
#include <cstdio>
#include <cstdint>

#define GAS __attribute__((address_space(1)))
#define LAS __attribute__((address_space(3)))
typedef unsigned short bf16;
typedef short bf16x8 __attribute__((ext_vector_type(8)));
typedef short s16x4 __attribute__((ext_vector_type(4)));
typedef float f32x4 __attribute__((ext_vector_type(4)));
typedef float f32x2 __attribute__((ext_vector_type(2)));
typedef unsigned u32x4 __attribute__((ext_vector_type(4)));
typedef unsigned u32x2 __attribute__((ext_vector_type(2)));

namespace pg8 {
#define PG8_LAS __attribute__((address_space(3)))
typedef unsigned short bf16_t;
constexpr int BM = 256, BK = 64, HALF = 128, HTB = HALF * BK * 2  , STAGE_BYTES = 8 * HTB;

__host__ __device__ __forceinline__ int lds_byte(int r, int c) { const int st = (r >> 4) * 2 + (c >> 5), rr = r & 15, cc = c & 31, ob = rr * 64 + cc * 2; return st * 1024 + (ob ^ (((ob >> 9) & 1) << 5)); }
__host__ __device__ __forceinline__ void stage_rc(int b, int& R, int& C) { const int st = b / 1024, sb = b % 1024, swz = sb ^ (((sb >> 9) & 1) << 5); R = (st >> 1) * 16 + swz / 64; C = (st & 1) * 32 + (swz % 64) / 2; }
__host__ __device__ __forceinline__ int lds_byte_f8(int r, int c) { const int st = (r >> 4) * 2 + (c >> 5), rr = r & 15, cc = c & 31, ob = rr * 64 + cc * 2; return st * 1024 + (ob ^ (((ob >> 9) & 1) << 4)); }
__host__ __device__ __forceinline__ void stage_rc_f8(int b, int& R, int& C) { const int st = b / 1024, sb = b % 1024, swz = sb ^ (((sb >> 9) & 1) << 4); R = (st >> 1) * 16 + swz / 64; C = (st & 1) * 32 + (swz % 64) / 2; }
__host__ __device__ __forceinline__ int perm32(int rho) { const int n = rho >> 4, i = rho & 15; return 8 * (i >> 2) + 4 * n + (i & 3); }

struct Unit { int pm, pn, grp; size_t aoff, boff; };
struct Gemm { const void* A; const void* Bt; int lda, ldb, K; };

__device__ __forceinline__ unsigned cvt_pk_bf16(float lo, float hi) { unsigned r; asm volatile("v_cvt_pk_bf16_f32 %0, %1, %2" : "=v"(r) : "v"(lo), "v"(hi)); return r; }

typedef int v8i_t __attribute__((ext_vector_type(8)));
typedef int v4i_t __attribute__((ext_vector_type(4)));
template <class Epi, class Sched, bool F8 = false, bool ALIGN_EPI = true, bool SP2 = true, bool GATHER = false>
__device__ __forceinline__ void gemm_phase(PG8_LAS unsigned char* lds, const Gemm g, const Sched& S, const Epi& E, int tid_in, const PG8_LAS unsigned* gat = nullptr) {
    static_assert(!GATHER || SP2, "gather is written for the SP2 loop");
    int tid = tid_in; asm volatile("" : "+v"(tid));
    const int wid = __builtin_amdgcn_readfirstlane(tid >> 6), lane = tid & 63, wr = wid >> 2, wc = wid & 3, fr = lane & 15, fq = lane >> 4;
    const int K = g.K, nt = K / BK;
    unsigned voffA[2], voffB[2];
#pragma unroll
    for (int i = 0; i < 2; ++i) { int R, C; if constexpr (F8) stage_rc_f8(tid * 16 + i * 8192, R, C); else stage_rc(tid * 16 + i * 8192, R, C); const int Rb = (int)Epi::PERM == 2 ? (64 * (R >> 5) + 16 * ((R >> 2) & 3) + 4 * ((R >> 4) & 1) + (R & 3)) : ((int)Epi::PERM == 1 ? ((R & ~31) + perm32(R & 31)) : R);
        voffA[i] = GATHER ? (unsigned)(R * 65536 + C * 2) : (unsigned)(R * g.lda + C * 2); voffB[i] = (unsigned)(Rb * g.ldb + C * 2); }
    unsigned vA0[2], vA1[2];
    const size_t kstep = (size_t)(BK * 2);
    const size_t hstepA = (size_t)HALF * g.lda, hstepB = (size_t)((int)Epi::PERM == 2 ? 8 : HALF) * g.ldb;
#define PG8_GLOAD(ui_) do { _Pragma("unroll") for (int _i = 0; _i < 2; ++_i) { const int r_ = (int)(voffA[_i] >> 16); const unsigned c_ = voffA[_i] & 0xffffu; \
        vA0[_i] = gat[(ui_) * 256 + r_] + c_; vA1[_i] = gat[(ui_) * 256 + 128 + r_] + c_; } } while (0)
    if constexpr (GATHER) PG8_GLOAD(0); else { vA0[0] = voffA[0]; vA0[1] = voffA[1]; vA1[0] = voffA[0] + (unsigned)hstepA; vA1[1] = voffA[1] + (unsigned)hstepA; }
    int ui = 0;
    const unsigned ldsw = (unsigned)wid * 1024u;
    const int aoff = F8 ? lds_byte_f8(wr * 64 + fr, fq * 16) : lds_byte(wr * 64 + fr, fq * 8), boff = F8 ? lds_byte_f8(wc * 32 + fr, fq * 16) : lds_byte(wc * 32 + fr, fq * 8);
    const int aoff1 = lds_byte_f8(wr * 64 + fr, fq * 16 + 8), boff1 = lds_byte_f8(wc * 32 + fr, fq * 16 + 8);
#define PG8_SA(b, h) (((b) * 2 + (h)) * HTB)
#define PG8_SB(b, h) ((4 + (b) * 2 + (h)) * HTB)
#define PG8_STAGE(bufoff, gbase, voff) do { _Pragma("unroll") for (int _i = 0; _i < 2; ++_i) \
        __builtin_amdgcn_global_load_lds((const unsigned*)((const char*)(gbase) + (voff)[_i]), (PG8_LAS unsigned*)(lds + (bufoff) + ldsw + _i * 8192), 16, 0, 0); } while (0)
#define PG8_LD16(off) (*(const PG8_LAS v4i_t*)(lds + (off)))
#define PG8_LDA(dst, b, h) do { if constexpr (F8) { _Pragma("unroll") for (int m = 0; m < 4; ++m) A8[m] = __builtin_shufflevector(PG8_LD16(PG8_SA(b, h) + aoff + m * 2048), PG8_LD16(PG8_SA(b, h) + aoff1 + m * 2048), 0, 1, 2, 3, 4, 5, 6, 7); } \
        else { _Pragma("unroll") for (int m = 0; m < 4; ++m) _Pragma("unroll") for (int k = 0; k < 2; ++k) dst[m][k] = *(const PG8_LAS bf16x8*)(lds + PG8_SA(b, h) + aoff + m * 2048 + k * 1024); } } while (0)
#define PG8_LDB(dst, b, h) do { if constexpr (F8) { _Pragma("unroll") for (int n = 0; n < 2; ++n) dst##8[n] = __builtin_shufflevector(PG8_LD16(PG8_SB(b, h) + boff + n * 2048), PG8_LD16(PG8_SB(b, h) + boff1 + n * 2048), 0, 1, 2, 3, 4, 5, 6, 7); } \
        else { _Pragma("unroll") for (int n = 0; n < 2; ++n) _Pragma("unroll") for (int k = 0; k < 2; ++k) dst[n][k] = *(const PG8_LAS bf16x8*)(lds + PG8_SB(b, h) + boff + n * 2048 + k * 1024); } } while (0)
#define PG8_MMA(ai, bj, At, Bt) do { __builtin_amdgcn_s_setprio(1); \
        if constexpr (F8) { _Pragma("unroll") for (int m = 0; m < 4; ++m) _Pragma("unroll") for (int n = 0; n < 2; ++n) \
            asm volatile("v_mfma_scale_f32_16x16x128_f8f6f4 %0, %1, %2, %0, %3, %3 op_sel_hi:[0,0,0]" : "+v"(acc[ai][bj][m][n]) : "v"(Bt##8[n]), "v"(A8[m]), "v"(one_scale)); } \
        else { _Pragma("unroll") for (int m = 0; m < 4; ++m) _Pragma("unroll") for (int n = 0; n < 2; ++n) _Pragma("unroll") for (int k = 0; k < 2; ++k) \
            acc[ai][bj][m][n] = __builtin_amdgcn_mfma_f32_16x16x32_bf16(Bt[n][k], At[m][k], acc[ai][bj][m][n], 0, 0, 0); } \
        __builtin_amdgcn_s_setprio(0); } while (0)
#define PG8_WAIT_V(n) asm volatile("s_waitcnt vmcnt(" #n ")" ::: "memory")
#define PG8_WAIT_L(n) asm volatile("s_waitcnt lgkmcnt(" #n ")" ::: "memory")
#define PG8_BAR __builtin_amdgcn_s_barrier()
#define PG8_SCHED __builtin_amdgcn_sched_barrier(0)
    Unit cur, nxt; int cursor = 0;
    if (!S.next(cursor, cur)) return;
    f32x4 acc[2][2][4][2];
#pragma unroll
    for (int a = 0; a < 2; ++a)
#pragma unroll
        for (int b = 0; b < 2; ++b)
#pragma unroll
            for (int m = 0; m < 4; ++m)
#pragma unroll
                for (int n = 0; n < 2; ++n) acc[a][b][m][n] = (f32x4){0.f, 0.f, 0.f, 0.f};
    bf16x8 At[4][2], B0[2][2], B1[2][2];
    v8i_t A8[4], B08[2], B18[2];
    int one_scale = 0x7F7F7F7F; asm volatile("" : "+v"(one_scale));
    const char* cA = (const char*)g.A + (GATHER ? (size_t)0 : cur.aoff); const char* cB = (const char*)g.Bt + cur.boff;
    if constexpr (SP2) {
        PG8_STAGE(PG8_SB(0, 0), cB, voffB); PG8_STAGE(PG8_SB(0, 1), cB + hstepB, voffB); PG8_STAGE(PG8_SA(0, 0), cA, vA0); PG8_STAGE(PG8_SA(0, 1), cA, vA1);
        if (wr == 1) PG8_BAR;
        PG8_WAIT_V(2); PG8_BAR;
        PG8_STAGE(PG8_SB(1, 0), cB + kstep, voffB); PG8_STAGE(PG8_SA(1, 0), cA + kstep, vA0); PG8_STAGE(PG8_SB(1, 1), cB + hstepB + kstep, voffB);
        PG8_WAIT_V(6); PG8_BAR;
    } else {
        PG8_STAGE(PG8_SB(0, 0), cB, voffB); PG8_STAGE(PG8_SA(0, 0), cA, voffA); PG8_STAGE(PG8_SB(0, 1), cB + hstepB, voffB); PG8_STAGE(PG8_SA(0, 1), cA + hstepA, voffA);
        if (wr == 1) PG8_BAR;
        PG8_WAIT_V(4); PG8_BAR;
        PG8_STAGE(PG8_SB(1, 0), cB + kstep, voffB); PG8_STAGE(PG8_SA(1, 0), cA + kstep, vA0); PG8_STAGE(PG8_SB(1, 1), cB + hstepB + kstep, voffB);
        PG8_WAIT_V(6); PG8_BAR;
    }
    for (;;) {
        const bool has_next = S.next(cursor, nxt);
        const char* nA = (has_next && !GATHER) ? (const char*)g.A + nxt.aoff : cA; const char* nB = has_next ? (const char*)g.Bt + nxt.boff : cB;
        for (int t = 0; t < nt; t += 2) {
            const bool last = (t == nt - 2);
            const char* a1 = cA + (size_t)(t + 1) * kstep;
            const char* a2 = last ? nA : cA + (size_t)(t + 2) * kstep; const char* b2 = last ? nB : cB + (size_t)(t + 2) * kstep;
            const char* a3 = a2 + kstep; const char* b3 = b2 + kstep;
            if constexpr (SP2) {
            PG8_LDB(B0, 0, 0); PG8_LDB(B1, 0, 1); PG8_SCHED; PG8_LDA(At, 0, 0); PG8_STAGE(PG8_SA(1, 1), a1, vA1);
            if constexpr (GATHER) { if (last && has_next) PG8_GLOAD(ui + 1); }
            PG8_WAIT_V(8); PG8_WAIT_L(0); PG8_BAR; PG8_MMA(0, 0, At, B0); PG8_MMA(0, 1, At, B1); PG8_BAR; PG8_SCHED;
            PG8_LDA(At, 0, 1); PG8_STAGE(PG8_SB(0, 0), b2, voffB); PG8_STAGE(PG8_SB(0, 1), b2 + hstepB, voffB); PG8_STAGE(PG8_SA(0, 0), a2, vA0);
            PG8_WAIT_V(8); PG8_WAIT_L(0); PG8_BAR; PG8_MMA(1, 0, At, B0); PG8_MMA(1, 1, At, B1); PG8_BAR; PG8_SCHED;
            PG8_LDB(B0, 1, 0); PG8_LDB(B1, 1, 1); PG8_SCHED; PG8_LDA(At, 1, 0); PG8_STAGE(PG8_SA(0, 1), a2, vA1);
            PG8_WAIT_V(8); PG8_WAIT_L(0); PG8_BAR; PG8_MMA(0, 0, At, B0); PG8_MMA(0, 1, At, B1); PG8_BAR; PG8_SCHED;
            PG8_LDA(At, 1, 1); PG8_STAGE(PG8_SB(1, 0), b3, voffB); PG8_STAGE(PG8_SB(1, 1), b3 + hstepB, voffB); PG8_STAGE(PG8_SA(1, 0), a3, vA0);
            PG8_WAIT_V(8); PG8_WAIT_L(0); PG8_BAR; PG8_MMA(1, 0, At, B0); PG8_MMA(1, 1, At, B1); PG8_BAR; PG8_SCHED;
            } else {
            PG8_LDB(B0, 0, 0); PG8_SCHED; PG8_LDA(At, 0, 0); PG8_STAGE(PG8_SA(1, 1), a1, vA1);
            PG8_WAIT_L(8); PG8_BAR; PG8_WAIT_L(0); PG8_MMA(0, 0, At, B0); PG8_BAR; PG8_SCHED;
            PG8_LDB(B1, 0, 1); PG8_STAGE(PG8_SB(0, 0), b2, voffB);
            PG8_BAR; PG8_WAIT_L(0); PG8_MMA(0, 1, At, B1); PG8_BAR;
            PG8_LDA(At, 0, 1); PG8_STAGE(PG8_SA(0, 0), a2, vA0);
            PG8_BAR; PG8_WAIT_L(0); PG8_MMA(1, 0, At, B0); PG8_BAR; PG8_SCHED;
            PG8_STAGE(PG8_SB(0, 1), b2 + hstepB, voffB);
            PG8_WAIT_V(6); PG8_BAR; PG8_MMA(1, 1, At, B1); PG8_BAR;
            PG8_LDB(B0, 1, 0); PG8_SCHED; PG8_LDA(At, 1, 0); PG8_STAGE(PG8_SA(0, 1), a2, vA1);
            PG8_WAIT_L(8); PG8_BAR; PG8_WAIT_L(0); PG8_MMA(0, 0, At, B0); PG8_BAR; PG8_SCHED;
            PG8_LDB(B1, 1, 1); PG8_STAGE(PG8_SB(1, 0), b3, voffB);
            PG8_BAR; PG8_WAIT_L(0); PG8_MMA(0, 1, At, B1); PG8_BAR;
            PG8_LDA(At, 1, 1); PG8_STAGE(PG8_SA(1, 0), a3, vA0);
            PG8_BAR; PG8_WAIT_L(0); PG8_MMA(1, 0, At, B0); PG8_BAR; PG8_SCHED;
            PG8_STAGE(PG8_SB(1, 1), b3 + hstepB, voffB);
            PG8_WAIT_V(6); PG8_BAR; PG8_MMA(1, 1, At, B1); PG8_BAR;
            }
        }
        if constexpr (F8) asm volatile("s_nop 15\n\ts_nop 15" ::: "memory");
        if constexpr (ALIGN_EPI) { if (wr == 0) PG8_BAR; }
        E(acc, cur, wr, wc, fr, fq);
        if (!has_next) break;
#pragma unroll
        for (int a = 0; a < 2; ++a)
#pragma unroll
            for (int b = 0; b < 2; ++b)
#pragma unroll
                for (int m = 0; m < 4; ++m)
#pragma unroll
                    for (int n = 0; n < 2; ++n) acc[a][b][m][n] = (f32x4){0.f, 0.f, 0.f, 0.f};
        cur = nxt; cA = nA; cB = nB; ++ui;
        if constexpr (ALIGN_EPI) { if (wr == 1) PG8_BAR; }
    }
    PG8_WAIT_V(0);
    if constexpr (!ALIGN_EPI) { if (wr == 0) PG8_BAR; }
    PG8_BAR;
#undef PG8_GLOAD
#undef PG8_SA
#undef PG8_SB
#undef PG8_STAGE
#undef PG8_LDA
#undef PG8_LDB
#undef PG8_MMA
#undef PG8_LD16
#undef PG8_WAIT_V
#undef PG8_WAIT_L
#undef PG8_BAR
#undef PG8_SCHED
}
}

#define XB_TMO      128
#define XB_XCNT(j)  (256  + 64 * (j))
#define XB_XSUB(j)  (1280 + 64 * (j))
#define XB_XGEN(j)  (2304 + 64 * (j))
#define XB_TOP      3328
#define XB_TOPGEN   3392
#define XCD_BAR_WORDS 3456
#define XB_SPIN_CAP (1u << 18)

__device__ __forceinline__ unsigned xb_ld(unsigned* p)              { return __hip_atomic_load(p, __ATOMIC_RELAXED, __HIP_MEMORY_SCOPE_AGENT); }
__device__ __forceinline__ unsigned xb_add(unsigned* p, unsigned v) { return __hip_atomic_fetch_add(p, v, __ATOMIC_RELAXED, __HIP_MEMORY_SCOPE_AGENT); }
__device__ __forceinline__ unsigned xb_xcc_id() { return (unsigned)__builtin_amdgcn_s_getreg((3 << 11) | 20) & 0xFu; }
#define XB_SPIN(cond, bar) do { unsigned _sp = 0; while (cond) { __builtin_amdgcn_s_sleep(1); \
    if ((++_sp & 255u) == 0u) { if (xb_ld(&(bar)[XB_TMO])) break; if (_sp > XB_SPIN_CAP) { atomicAdd(&(bar)[XB_TMO], 1u); break; } } } } while (0)

struct XcdBarrier {
    unsigned* bar; unsigned x;
    volatile LAS unsigned* st;
};

__device__ __forceinline__ XcdBarrier xcd_barrier_post(unsigned* bar, volatile LAS unsigned* st) {
    XcdBarrier b; b.bar = bar; b.x = xb_xcc_id(); b.st = st;
    if (threadIdx.x == 0) (void)xb_add(&bar[XB_XCNT(b.x)], 1u);
    return b;
}
__device__ __forceinline__ void xcd_barrier_complete(unsigned* bar, unsigned x, unsigned& nloc, unsigned& nx) {
    const unsigned G = gridDim.x * gridDim.y * gridDim.z;
    unsigned sum, cnt, mine, sp = 0u;
    for (;;) {
        sum = 0u; cnt = 0u; mine = 0u;
#pragma unroll
        for (unsigned j = 0; j < 16; ++j) { const unsigned c = xb_ld(&bar[XB_XCNT(j)]); sum += c; cnt += (c > 0u) ? 1u : 0u; mine = (j == x) ? c : mine; }
        if (sum == G) break;
        __builtin_amdgcn_s_sleep(1);
        if ((++sp & 255u) == 0u) { if (xb_ld(&bar[XB_TMO])) break; if (sp > XB_SPIN_CAP) { atomicAdd(&bar[XB_TMO], 1u); break; } }
    }
    nloc = mine > 0u ? mine : 1u; nx = cnt > 0u ? cnt : 1u;
}

__device__ __forceinline__ void xcd_barrier(const XcdBarrier& b) {
    asm volatile("s_waitcnt vmcnt(0)" ::: "memory");
    __syncthreads();
    if (threadIdx.x == 0) {
        unsigned* bar = b.bar;
        __builtin_amdgcn_s_waitcnt(0);
        unsigned nloc = b.st[0], nx = b.st[1];
        if (nloc == 0u) { xcd_barrier_complete(bar, b.x, nloc, nx); b.st[0] = nloc; b.st[1] = nx; }
        const unsigned old = xb_add(&bar[XB_XSUB(b.x)], 1u);
        const unsigned gen = old / nloc;
        if (old + 1u == (gen + 1u) * nloc) {
            __builtin_amdgcn_fence(__ATOMIC_RELEASE, "agent");
            asm volatile("s_waitcnt vmcnt(0)" ::: "memory");
            const unsigned og = xb_add(&bar[XB_TOP], 1u);
            const unsigned tg = og / nx;
            if (og + 1u == (tg + 1u) * nx) xb_add(&bar[XB_TOPGEN], 1u);
            else XB_SPIN(xb_ld(&bar[XB_TOPGEN]) == tg, bar);
            __builtin_amdgcn_fence(__ATOMIC_ACQUIRE, "agent");
            xb_add(&bar[XB_XGEN(b.x)], 1u);
            asm volatile("s_waitcnt vmcnt(0)" ::: "memory");
        } else {
            XB_SPIN(xb_ld(&bar[XB_XGEN(b.x)]) == gen, bar);
            __builtin_amdgcn_fence(__ATOMIC_ACQUIRE, "agent");
            asm volatile("s_waitcnt vmcnt(0)" ::: "memory");
        }
    }
    __syncthreads();
}

constexpr int NWAVES = 8, NTHR = 512;
constexpr int DM = 1024, NB = 8, SEQ = 4096, CTXL = 256, DEPTH = 4;
constexpr int NLAT = NB * SEQ, NCTX = NB * CTXL, NT = NLAT + NCTX;
constexpr int PW = 2304;
constexpr int MW = 1280;
constexpr int NEXP = 32, MAXBLK = 576;
constexpr int NCHK = 544;
constexpr int S5ROWS = 2304;
constexpr int PC_FU = 0, PC_S5 = 256, PC_Q = 512, PC_K = 640, PC_V = 768, PC_R = 1024, PC_Z = 1280, PC_XBC = 1536, PC_A1 = 2048, PC_DT = 2080;
enum { I_X = 0, I_C, I_CTX, I_CCTX, I_ADAW, I_ADAB, I_NMG, I_NFG, I_WIN, I_WOUT, I_FOURW, I_S5LRE, I_S5LIM, I_S5LDT, I_S5BRE, I_S5BIM, I_S5CRE, I_S5CIM, I_S5D, I_S5GLU,
       I_GLAA2, I_GLAAB, I_GLANG, I_SSDCW, I_SSDCB, I_SSDALOG, I_SSDDTB, I_SSDD, I_SSDNG, I_RW, I_RB, I_WGU, I_BGU, I_WDN, I_BDN, I_FING, N_IN };

constexpr size_t al256(size_t x) { return (x + 255) & ~(size_t)255; }
constexpr size_t WS_CTL = 0, CTL_BYTES = 1u << 20;
constexpr size_t WS_MOD = WS_CTL + CTL_BYTES;
constexpr size_t WS_TAB = WS_MOD + al256((size_t)DEPTH * 9 * 6144 * 4);
constexpr size_t TAB_F64 = 0, TAB_TW = 16384, TAB_D256 = 16384 + 32768, TAB_BYTES = 65536;
constexpr size_t WS_A16 = WS_TAB + TAB_BYTES;
constexpr size_t WS_WIN = WS_A16 + al256((size_t)DEPTH * 2 * 16 * 64 * 2 * 4);
constexpr size_t WS_WOUT = WS_WIN + (size_t)DEPTH * PW * DM * 2;
constexpr size_t WS_WGLU = WS_WOUT + (size_t)DEPTH * DM * MW * 2;
constexpr size_t WS_S5P = WS_WGLU + (size_t)DEPTH * 256 * 256 * 2;
constexpr size_t WS_S5B2 = WS_S5P + (size_t)DEPTH * 16 * 256 * 256 * 2;
constexpr size_t WS_WGU = WS_S5B2 + (size_t)DEPTH * 16 * 256 * 512 * 2;
constexpr size_t WS_WDN = WS_WGU + (size_t)DEPTH * NEXP * 2048 * DM;
constexpr size_t WS_XS = WS_WDN + (size_t)DEPTH * NEXP * DM * DM;
constexpr size_t WS_H = WS_XS + (size_t)NT * DM * 2;
constexpr size_t WS_PBUF = WS_H + (size_t)NT * DM * 2;
constexpr size_t WS_A2 = WS_PBUF + (size_t)NT * PW * 2;
constexpr size_t WS_S5S = WS_A2 + (size_t)16 * S5ROWS * 512 * 2;
constexpr size_t WS_ACT5 = WS_S5S + (size_t)16 * S5ROWS * 256 * 4;
constexpr size_t WS_MIX = WS_ACT5 + (size_t)NT * 256 * 2;
constexpr size_t WS_GDS = WS_MIX + (size_t)NT * MW * 2;
constexpr size_t WS_GDEC = WS_GDS + (size_t)NCHK * 8 * 2048 * 4;
constexpr size_t WS_GSE = WS_GDEC + al256((size_t)NCHK * 8 * 32 * 4);
constexpr size_t WS_SDS = WS_GSE + (size_t)NCHK * 8 * 2048 * 2;
constexpr size_t WS_SDEC = WS_SDS + (size_t)NCHK * 8 * 4096 * 4;
constexpr size_t WS_SSE = WS_SDEC + al256((size_t)NCHK * 8 * 4);
constexpr size_t WS_PE = WS_SSE + (size_t)NCHK * 8 * 4096 * 2;
constexpr size_t WS_PR = WS_PE + (size_t)NT * 4 * 4;
constexpr size_t WS_PG = WS_PR + (size_t)NT * 4 * 4;
constexpr size_t WS_PS = WS_PG + (size_t)NT * 4 * 4;
constexpr size_t WS_SG = WS_PS + (size_t)NT * 4 * 4;
constexpr size_t WS_H8 = WS_SG + (size_t)MAXBLK * 256 * 4;
constexpr size_t WS_TM = WS_H8 + (size_t)NT * DM;
constexpr size_t WS_ACT = WS_TM + (size_t)NEXP * NT * 4;
constexpr size_t WS_Y = WS_ACT + (size_t)MAXBLK * 256 * DM;
constexpr size_t WS_GQI = WS_Y + (size_t)MAXBLK * 256 * DM;
constexpr size_t WS_GOI = WS_GQI + (size_t)NT * 256 * 2;
constexpr size_t WS_SCB = WS_GOI + (size_t)NT * 256 * 2;
constexpr size_t WS_SCUM = WS_SCB + (size_t)NT * 128 * 2;
constexpr size_t WS_SYI = WS_SCUM + (size_t)NT * 8 * 4;
constexpr size_t WS_DFTC = WS_SYI + (size_t)NT * 256 * 2;
constexpr size_t WS_GA2T = WS_DFTC + 512 * 256 * 2;
constexpr size_t WS_RWT = WS_GA2T + (size_t)DEPTH * 256 * 32 * 2;
constexpr size_t WS_END = WS_RWT + (size_t)DEPTH * 2 * 32 * 1024 * 2;
constexpr int CW_QUEUE = 64;
constexpr int CW_CNT = 1024;
constexpr int CW_BLKE = 2048;
constexpr int CW_BAR = 8192;

constexpr int LDS_BYTES = 163840, MISC_OFF = LDS_BYTES - 256;

constexpr float W8_SCALE = 32.f, H8_SCALE = 8.f, A8_SCALE = 4.f, Y8_SCALE = 16.f;
__device__ __forceinline__ unsigned pk4f8(float a, float b, float c, float d) { int w = 0; w = __builtin_amdgcn_cvt_pk_fp8_f32(a, b, w, false); w = __builtin_amdgcn_cvt_pk_fp8_f32(c, d, w, true); return (unsigned)w; }
#define RLX_AGENT __ATOMIC_RELAXED, __HIP_MEMORY_SCOPE_AGENT
__device__ __forceinline__ int fresh_tid(int wave0) { int l = (int)__builtin_amdgcn_mbcnt_hi(~0u, __builtin_amdgcn_mbcnt_lo(~0u, 0u)); asm volatile("" : "+v"(l)); return wave0 * 64 + l; }
__device__ __forceinline__ unsigned f2bf(float f) { unsigned u = __builtin_bit_cast(unsigned, f); return (u + 0x7fffu + ((u >> 16) & 1u)) >> 16; }
__device__ __forceinline__ unsigned pk2(float lo, float hi) { return f2bf(lo) | (f2bf(hi) << 16); }
__device__ __forceinline__ float bf2f(unsigned short b) { return __builtin_bit_cast(float, (unsigned)b << 16); }
__device__ __forceinline__ f32x4 f8x4(unsigned w) { const f32x2 lo = __builtin_amdgcn_cvt_pk_f32_fp8((int)w, false), hi = __builtin_amdgcn_cvt_pk_f32_fp8((int)w, true); return (f32x4){lo.x, lo.y, hi.x, hi.y}; }
__device__ __forceinline__ f32x4 bf4(u32x2 w) { return (f32x4){__builtin_bit_cast(float, w.x << 16), __builtin_bit_cast(float, w.x & 0xffff0000u), __builtin_bit_cast(float, w.y << 16), __builtin_bit_cast(float, w.y & 0xffff0000u)}; }
__device__ __forceinline__ float bflo(unsigned w) { return __builtin_bit_cast(float, w << 16); }
__device__ __forceinline__ float bfhi(unsigned w) { return __builtin_bit_cast(float, w & 0xffff0000u); }
template <int M> __device__ __forceinline__ float swz_xor(float v) { return __builtin_bit_cast(float, __builtin_amdgcn_ds_swizzle(__builtin_bit_cast(int, v), (M << 10) | 0x1F)); }
__device__ __forceinline__ float xor32f(float v, int lane) { return __builtin_bit_cast(float, __builtin_amdgcn_ds_bpermute((lane ^ 32) << 2, __builtin_bit_cast(int, v))); }
__device__ __forceinline__ float wave_sum(float v, int lane) { v += swz_xor<1>(v); v += swz_xor<2>(v); v += swz_xor<4>(v); v += swz_xor<8>(v); v += swz_xor<16>(v); v += xor32f(v, lane); return v; }
__device__ __forceinline__ float wave_max(float v, int lane) { v = fmaxf(v, swz_xor<1>(v)); v = fmaxf(v, swz_xor<2>(v)); v = fmaxf(v, swz_xor<4>(v)); v = fmaxf(v, swz_xor<8>(v)); v = fmaxf(v, swz_xor<16>(v)); v = fmaxf(v, xor32f(v, lane)); return v; }
__device__ __forceinline__ float fexp_(float x) { return __builtin_amdgcn_exp2f(1.4426950408889634f * x); }
__device__ __forceinline__ float frcp_(float x) { return __builtin_amdgcn_rcpf(x); }
__device__ __forceinline__ float sigmoidf_(float x) { return frcp_(1.f + fexp_(-x)); }
__device__ __forceinline__ float siluf_(float x) { return x * frcp_(1.f + fexp_(-x)); }

struct Frame {
    LAS unsigned char* lds; volatile LAS unsigned* MISC; unsigned* ctl; unsigned char* ws;
    int tid, lane, wave, G, bid;
};


template <class Fill> struct SgOrder {
    int nblk, nN, R, r, lo, hi; Fill f;
    __device__ __forceinline__ void init(int nblk_, int nN_, int G, int c) { nblk = nblk_; nN = nN_; const int U = nblk * nN; int x, nx;
        if ((G & 7) == 0) { R = G >> 3; x = c & 7; r = c >> 3; nx = 8; } else { R = G; x = 0; r = c; nx = 1; }
        lo = (int)(((long)x * U) / nx); hi = (int)(((long)(x + 1) * U) / nx); }
    __device__ __forceinline__ bool next(int& cursor, pg8::Unit& u) const {
        const int q = lo + r + R * cursor; ++cursor;
        if (q >= hi) return false;
        const int ups = 8 * nN, sg = q / ups, ql = q - sg * ups, nb = (nblk - sg * 8) < 8 ? (nblk - sg * 8) : 8;
        u.pm = sg * 8 + ql % nb; u.pn = ql / nb; f(u); return true;
    }
};
struct FillPlain { size_t astep, bstep; __device__ __forceinline__ void operator()(pg8::Unit& u) const { u.grp = 0; u.aoff = (size_t)u.pm * astep; u.boff = (size_t)u.pn * bstep; } };
struct FillS5 { size_t bgrp; __device__ __forceinline__ void operator()(pg8::Unit& u) const { const int g = u.pm / 9, t = u.pm - g * 9; u.grp = g; u.pm = t; u.aoff = ((size_t)g * S5ROWS + (size_t)t * 256) * 512 * 2; u.boff = (size_t)g * bgrp; } };
struct FillMoe { const LAS unsigned* lblk; int erows; __device__ __forceinline__ void operator()(pg8::Unit& u) const { const int e = (int)lblk[u.pm]; u.grp = e; u.aoff = (size_t)u.pm * 256 * DM; u.boff = ((size_t)e * erows + (size_t)u.pn * 256) * DM; } };
constexpr int MOE_LB = 131072, MOE_LC = MOE_LB + 256, MOE_LBLK = MOE_LC + 256, MOE_GAT = MOE_LBLK + 2560, MOE_MAXU = 26;
static_assert(MOE_GAT + MOE_MAXU * 1024 <= MISC_OFF, "MoE LDS tables");
__device__ __forceinline__ int moe_tables(Frame& F, int L) {
    LAS int* lb = (LAS int*)(F.lds + MOE_LB); LAS int* lc = (LAS int*)(F.lds + MOE_LC); LAS unsigned* lblk = (LAS unsigned*)(F.lds + MOE_LBLK);
    const unsigned* cnt = F.ctl + CW_CNT + L * 64;
    __syncthreads();
    if (F.tid == 0) { int acc = 0; for (int e = 0; e < NEXP; ++e) { lb[e] = acc; const int c = (int)__hip_atomic_load(cnt + e, RLX_AGENT); lc[e] = c; acc += (c + 255) & ~255; } lb[32] = acc; }
    __syncthreads();
    const int nblk = lb[32] >> 8;
    for (int i = F.tid; i < nblk; i += NTHR) { int e = 0; for (int q = 1; q < NEXP; ++q) if (lb[q] <= i * 256) e = q; lblk[i] = (unsigned)e; }
    __syncthreads();
    return nblk;
}
using pg8::cvt_pk_bf16;
struct EpiInproj {
    static constexpr bool PERM = true;
    bf16* P; bf16* A2;
    __device__ __forceinline__ void operator()(const f32x4 (&acc)[2][2][4][2], const pg8::Unit& u, int wr, int wc, int fr, int fq) const {
        const int row0 = u.pm * 256 + wr * 64 + fr, col0 = u.pn * 256 + wc * 32 + 8 * fq;
#pragma unroll
        for (int ai = 0; ai < 2; ++ai)
#pragma unroll
            for (int m = 0; m < 4; ++m) {
                const int row = row0 + ai * 128 + m * 16;
#pragma unroll
                for (int bj = 0; bj < 2; ++bj) {
                    const f32x4 v0 = acc[ai][bj][m][0], v1 = acc[ai][bj][m][1];
                    u32x4 w; w.x = cvt_pk_bf16(v0[0], v0[1]); w.y = cvt_pk_bf16(v0[2], v0[3]); w.z = cvt_pk_bf16(v1[0], v1[1]); w.w = cvt_pk_bf16(v1[2], v1[3]);
                    const int col = col0 + bj * 128;
                    if (u.pn == 1) {
                        const int cc = col - 256, g = cc >> 4, hp = cc & 15;
                        const int crow = row < NLAT ? (row >> 4) : (2048 + ((row - NLAT) >> 4)), s = row & 15;
                        *(u32x4*)(A2 + ((size_t)g * S5ROWS + crow) * 512 + s * 16 + hp) = w;
                    } else if (col < 2088) *(u32x4*)(P + (size_t)row * PW + col) = w;
                }
            }
    }
};
struct EpiOutproj {
    static constexpr bool PERM = true;
    const float* xin; const float* ctxin; bf16* XS; const float* modL; int first;
    __device__ __forceinline__ void operator()(const f32x4 (&acc)[2][2][4][2], const pg8::Unit& u, int wr, int wc, int fr, int fq) const {
        const int rowt = u.pm * 256, bi = rowt < NLAT ? (rowt >> 12) : 8;
        const int row0 = rowt + wr * 64 + fr, col0 = u.pn * 256 + wc * 32 + 8 * fq;
        const float* gate = modL + (size_t)bi * 6144 + 2 * 1024;
        f32x4 gv[2][2];
#pragma unroll
        for (int bj = 0; bj < 2; ++bj)
#pragma unroll
            for (int n = 0; n < 2; ++n) gv[bj][n] = *(const f32x4*)(gate + col0 + bj * 128 + 4 * n);
#pragma unroll
        for (int ai = 0; ai < 2; ++ai)
#pragma unroll
            for (int m = 0; m < 4; ++m) {
                const int row = row0 + ai * 128 + m * 16;
                bf16* dst = XS + (size_t)row * DM;
#pragma unroll
                for (int bj = 0; bj < 2; ++bj) { const int c = col0 + bj * 128; f32x4 x0, x1;
                    if (first) { const float* src = (row < NLAT ? xin + (size_t)row * DM : ctxin + (size_t)(row - NLAT) * DM) + c; x0 = *(const f32x4*)src; x1 = *(const f32x4*)(src + 4); }
                    else { const u32x4 w = *(const u32x4*)(dst + c); x0 = bf4((u32x2){w.x, w.y}); x1 = bf4((u32x2){w.z, w.w}); }
                    x0 += gv[bj][0] * acc[ai][bj][m][0]; x1 += gv[bj][1] * acc[ai][bj][m][1];
                    u32x4 o; o.x = cvt_pk_bf16(x0[0], x0[1]); o.y = cvt_pk_bf16(x0[2], x0[3]); o.z = cvt_pk_bf16(x1[0], x1[1]); o.w = cvt_pk_bf16(x1[2], x1[3]);
                    *(u32x4*)(dst + c) = o; }
            }
    }
};
struct EpiSwiglu {
    static constexpr bool PERM = true;
    unsigned char* ACT; const float* bgu;
    __device__ __forceinline__ void operator()(const f32x4 (&acc)[2][2][4][2], const pg8::Unit& u, int wr, int wc, int fr, int fq) const {
        const int row0 = u.pm * 256 + wr * 64 + fr, i0 = u.pn * 128 + wc * 32 + 8 * fq;
        const float* bb = bgu + (size_t)u.grp * 2048 + 2 * i0;
        const f32x4 b0 = *(const f32x4*)(bb), b1 = *(const f32x4*)(bb + 4), b2 = *(const f32x4*)(bb + 8), b3 = *(const f32x4*)(bb + 12);
        const float bg[8] = {b0[0], b0[2], b1[0], b1[2], b2[0], b2[2], b3[0], b3[2]}, bu[8] = {b0[1], b0[3], b1[1], b1[3], b2[1], b2[3], b3[1], b3[3]};
        constexpr float inv = 1.f / (H8_SCALE * W8_SCALE);
#pragma unroll
        for (int ai = 0; ai < 2; ++ai)
#pragma unroll
            for (int m = 0; m < 4; ++m) {
                const int row = row0 + ai * 128 + m * 16;
                float o[8];
#pragma unroll
                for (int n = 0; n < 2; ++n)
#pragma unroll
                    for (int jp = 0; jp < 2; ++jp) {
                        const int q = 4 * n + 2 * jp;
                        f32x2 gt = (f32x2){acc[ai][0][m][n][2 * jp], acc[ai][0][m][n][2 * jp + 1]} * inv + (f32x2){bg[q], bg[q + 1]};
                        f32x2 up = (f32x2){acc[ai][1][m][n][2 * jp], acc[ai][1][m][n][2 * jp + 1]} * inv + (f32x2){bu[q], bu[q + 1]};
                        gt.x = fminf(gt.x, 7.0f); gt.y = fminf(gt.y, 7.0f);
                        up.x = __builtin_amdgcn_fmed3f(up.x, -7.0f, 7.0f); up.y = __builtin_amdgcn_fmed3f(up.y, -7.0f, 7.0f);
                        const f32x2 ea = gt * (-1.702f * 1.4426950408889634f);
                        f32x2 den; den.x = __builtin_amdgcn_exp2f(ea.x); den.y = __builtin_amdgcn_exp2f(ea.y); den = den + 1.0f;
                        f32x2 sg; sg.x = __builtin_amdgcn_rcpf(den.x); sg.y = __builtin_amdgcn_rcpf(den.y);
                        const f32x2 r = (up * A8_SCALE + A8_SCALE) * gt * sg;
                        o[q] = r.x; o[q + 1] = r.y;
                    }
                u32x2 w; w.x = pk4f8(o[0], o[1], o[2], o[3]); w.y = pk4f8(o[4], o[5], o[6], o[7]);
                *(u32x2*)(ACT + (size_t)row * DM + i0) = w;
            }
    }
};
struct EpiDown {
    static constexpr int PERM = 2;
    unsigned char* Y; const float* bdn; const float* sg;
    __device__ __forceinline__ void operator()(const f32x4 (&acc)[2][2][4][2], const pg8::Unit& u, int wr, int wc, int fr, int fq) const {
        const int row0 = u.pm * 256 + wr * 64 + fr, col0 = u.pn * 256 + wc * 64 + 16 * fq;
        const float* bb = bdn + (size_t)u.grp * DM + col0;
        constexpr float inv = 1.f / (A8_SCALE * W8_SCALE);
        f32x4 bv[2][2];
#pragma unroll
        for (int bj = 0; bj < 2; ++bj)
#pragma unroll
            for (int n = 0; n < 2; ++n) bv[bj][n] = *(const f32x4*)(bb + 8 * bj + 4 * n);
#pragma unroll
        for (int ai = 0; ai < 2; ++ai)
#pragma unroll
            for (int m = 0; m < 4; ++m) {
                const int row = row0 + ai * 128 + m * 16; const float gt = sg[row] * Y8_SCALE;
                u32x4 w;
                { const f32x4 v0 = (acc[ai][0][m][0] * inv + bv[0][0]) * gt, v1 = (acc[ai][0][m][1] * inv + bv[0][1]) * gt; w.x = pk4f8(v0[0], v0[1], v0[2], v0[3]); w.y = pk4f8(v1[0], v1[1], v1[2], v1[3]); }
                { const f32x4 v0 = (acc[ai][1][m][0] * inv + bv[1][0]) * gt, v1 = (acc[ai][1][m][1] * inv + bv[1][1]) * gt; w.z = pk4f8(v0[0], v0[1], v0[2], v0[3]); w.w = pk4f8(v1[0], v1[1], v1[2], v1[3]); }
                *(u32x4*)(Y + (size_t)row * DM + col0) = w;
            }
    }
};
struct EpiNull { static constexpr bool PERM = true; float* sink;
    __device__ __forceinline__ void operator()(const f32x4 (&acc)[2][2][4][2], const pg8::Unit& u, int wr, int wc, int fr, int fq) const { float s = 0.f;
#pragma unroll
        for (int ai = 0; ai < 2; ++ai)
#pragma unroll
            for (int bj = 0; bj < 2; ++bj)
#pragma unroll
                for (int m = 0; m < 4; ++m)
#pragma unroll
                    for (int n = 0; n < 2; ++n) s += acc[ai][bj][m][n][0];
        if (s == 12345.678f) sink[u.pm] = s; } };
struct EpiS5S {
    static constexpr bool PERM = false;
    float* S;
    __device__ __forceinline__ void operator()(const f32x4 (&acc)[2][2][4][2], const pg8::Unit& u, int wr, int wc, int fr, int fq) const {
        const int row0 = u.pm * 256 + wr * 64 + fr, col0 = wc * 32 + 4 * fq;
        float* base = S + (size_t)u.grp * S5ROWS * 256;
#pragma unroll
        for (int ai = 0; ai < 2; ++ai)
#pragma unroll
            for (int m = 0; m < 4; ++m) { float* rp = base + (size_t)(row0 + ai * 128 + m * 16) * 256 + col0;
#pragma unroll
                for (int bj = 0; bj < 2; ++bj)
#pragma unroll
                    for (int n = 0; n < 2; ++n) *(f32x4*)(rp + bj * 128 + n * 16) = acc[ai][bj][m][n]; }
    }
};
__device__ __forceinline__ float gelu_tanh(float x) { const float t = 0.7978845608f * (x + 0.044715f * x * x * x); return x * frcp_(1.f + fexp_(-2.f * t)); }
struct EpiS5Y {
    static constexpr bool PERM = true;
    bf16* ACT5;
    __device__ __forceinline__ void operator()(const f32x4 (&acc)[2][2][4][2], const pg8::Unit& u, int wr, int wc, int fr, int fq) const {
        const int row0 = u.pm * 256 + wr * 64 + fr, col0 = wc * 32 + 8 * fq;
#pragma unroll
        for (int ai = 0; ai < 2; ++ai)
#pragma unroll
            for (int m = 0; m < 4; ++m) {
                const int crow = row0 + ai * 128 + m * 16;
                if (crow >= 2176) continue;
                const int tok0 = crow < 2048 ? crow * 16 : NLAT + (crow - 2048) * 16;
#pragma unroll
                for (int bj = 0; bj < 2; ++bj) {
                    const int col = col0 + bj * 128, j = col >> 4, h = col & 15;
                    const f32x4 v0 = acc[ai][bj][m][0], v1 = acc[ai][bj][m][1];
                    u32x4 w; w.x = cvt_pk_bf16(gelu_tanh(v0[0]), gelu_tanh(v0[1])); w.y = cvt_pk_bf16(gelu_tanh(v0[2]), gelu_tanh(v0[3]));
                    w.z = cvt_pk_bf16(gelu_tanh(v1[0]), gelu_tanh(v1[1])); w.w = cvt_pk_bf16(gelu_tanh(v1[2]), gelu_tanh(v1[3]));
                    *(u32x4*)(ACT5 + (size_t)(tok0 + j) * 256 + u.grp * 16 + h) = w;
                }
            }
    }
};
struct EpiGlu {
    static constexpr bool PERM = true;
    const bf16* ACT5; bf16* MIX;
    __device__ __forceinline__ void operator()(const f32x4 (&acc)[2][2][4][2], const pg8::Unit& u, int wr, int wc, int fr, int fq) const {
        const int row0 = u.pm * 256 + wr * 64 + fr, col0 = wc * 32 + 8 * fq;
#pragma unroll
        for (int ai = 0; ai < 2; ++ai)
#pragma unroll
            for (int m = 0; m < 4; ++m) {
                const int row = row0 + ai * 128 + m * 16;
#pragma unroll
                for (int bj = 0; bj < 2; ++bj) {
                    const int col = col0 + bj * 128;
                    const u32x4 a = *(const u32x4*)(ACT5 + (size_t)row * 256 + col);
                    const f32x4 v0 = acc[ai][bj][m][0], v1 = acc[ai][bj][m][1];
                    u32x4 w;
                    w.x = cvt_pk_bf16(bflo(a.x) * sigmoidf_(v0[0]), bfhi(a.x) * sigmoidf_(v0[1])); w.y = cvt_pk_bf16(bflo(a.y) * sigmoidf_(v0[2]), bfhi(a.y) * sigmoidf_(v0[3]));
                    w.z = cvt_pk_bf16(bflo(a.z) * sigmoidf_(v1[0]), bfhi(a.z) * sigmoidf_(v1[1])); w.w = cvt_pk_bf16(bflo(a.w) * sigmoidf_(v1[2]), bfhi(a.w) * sigmoidf_(v1[3]));
                    *(u32x4*)(MIX + (size_t)row * MW + 512 + col) = w;
                }
            }
    }
};

struct Args { const float* in[N_IN]; float* out; unsigned char* ws; int ph_lo, ph_hi; };
typedef const __attribute__((address_space(4))) Args CArgs;
__device__ __forceinline__ CArgs* fresh_args() { CArgs* p = (CArgs*)__builtin_amdgcn_kernarg_segment_ptr(); asm volatile("" : "+s"(p)); return p; }

template <class Map> __device__ __forceinline__ void transpose_tile(const float* W, int ldw, int ncols, int k0, int n0, bf16* WT, int ldt, int kd0, const Map& map, LAS float* scr, int lane) {
    { const int c4 = (lane & 15) * 4, r4 = lane >> 4; const bool ok = n0 + c4 < ncols;
#pragma unroll
      for (int q = 0; q < 16; ++q) { const int kk = q * 4 + r4; const f32x4 v = ok ? *(const f32x4*)(W + (size_t)(k0 + kk) * ldw + n0 + c4) : (f32x4){0.f, 0.f, 0.f, 0.f};
          scr[kk * 65 + c4] = v[0]; scr[kk * 65 + c4 + 1] = v[1]; scr[kk * 65 + c4 + 2] = v[2]; scr[kk * 65 + c4 + 3] = v[3]; } }
    asm volatile("s_waitcnt lgkmcnt(0)" ::: "memory");
    const int c = lane & 7;
#pragma unroll
    for (int j = 0; j < 8; ++j) {
        const int n = (lane >> 3) + 8 * j; const LAS float* s = scr + (8 * c) * 65 + n;
        u32x4 o; o.x = pk2(s[0], s[65]); o.y = pk2(s[2 * 65], s[3 * 65]); o.z = pk2(s[4 * 65], s[5 * 65]); o.w = pk2(s[6 * 65], s[7 * 65]);
        const int dr = (n0 + n) < ncols ? map(n0 + n) : -1;
        if (dr >= 0) *(u32x4*)(WT + (size_t)dr * ldt + kd0 + 8 * c) = o;
    }
    asm volatile("s_waitcnt lgkmcnt(0)" ::: "memory");
}
struct MapId { __device__ __forceinline__ int operator()(int n) const { return n; } };
struct MapWin { __device__ __forceinline__ int operator()(int c) const { return c < 1280 ? c : (c < 1312 ? 2048 + (c - 1280) : (c < 2080 ? c - 32 : c)); } };
struct MapGu { __device__ __forceinline__ int operator()(int n) const { const int i = n >> 1; return (i >> 7) * 256 + (n & 1) * 128 + (i & 127); } };

template <class Map> __device__ __forceinline__ void transpose_tile_f8(const float* W, int ldw, int k0, int n0, unsigned char* WT, int ldt, const Map& map, LAS float* scr, int lane) {
    { const int c4 = (lane & 15) * 4, r4 = lane >> 4;
#pragma unroll
      for (int q = 0; q < 16; ++q) { const int kk = q * 4 + r4; const f32x4 v = *(const f32x4*)(W + (size_t)(k0 + kk) * ldw + n0 + c4);
          scr[kk * 65 + c4] = v[0]; scr[kk * 65 + c4 + 1] = v[1]; scr[kk * 65 + c4 + 2] = v[2]; scr[kk * 65 + c4 + 3] = v[3]; } }
    asm volatile("s_waitcnt lgkmcnt(0)" ::: "memory");
    const int c = lane & 7;
#pragma unroll
    for (int j = 0; j < 8; ++j) {
        const int n = (lane >> 3) + 8 * j; const LAS float* s = scr + (8 * c) * 65 + n;
        u32x2 o; o.x = pk4f8(s[0] * W8_SCALE, s[65] * W8_SCALE, s[2 * 65] * W8_SCALE, s[3 * 65] * W8_SCALE); o.y = pk4f8(s[4 * 65] * W8_SCALE, s[5 * 65] * W8_SCALE, s[6 * 65] * W8_SCALE, s[7 * 65] * W8_SCALE);
        *(u32x2*)(WT + (size_t)map(n0 + n) * ldt + k0 + 8 * c) = o;
    }
    asm volatile("s_waitcnt lgkmcnt(0)" ::: "memory");
}
constexpr int PI_ADA = 48, PI_TAB = 1, PI_S5 = 64, PI_FOLD = 256, PI_ZERO = 4;
constexpr int TW_WIN = 16 * 33, TW_GU = 32 * 16 * 32, TW_DN = 32 * 16 * 16, TW_WOUT = 12 * 16, TW_GLU = 16, TW_LAYER = TW_WIN + TW_GU + TW_DN + TW_WOUT + TW_GLU;
constexpr int PI_TR = (DEPTH * TW_LAYER + 7) / 8;
constexpr int PI_B_TAB = PI_ADA, PI_B_S5 = PI_B_TAB + PI_TAB, PI_B_FOLD = PI_B_S5 + PI_S5, PI_B_ZERO = PI_B_FOLD + PI_FOLD, PI_B_TR = PI_B_ZERO + PI_ZERO, PI_TOTAL = PI_B_TR + (PI_TR + 3) / 4;

__device__ __forceinline__ void pro_adaln(Frame& F, CArgs& a, int it) {
    const int L = it / 12, cb = it % 12;
    LAS float* cond = (LAS float*)F.lds;
    for (int i = F.tid; i < 9 * 1024; i += NTHR) { const int r = i >> 10, k = i & 1023; const float v = r < 8 ? a.in[I_C][r * 1024 + k] : a.in[I_CCTX][k]; cond[i] = siluf_(v); }
    __syncthreads();
    const int n = cb * 512 + F.tid;
    const float* w = a.in[I_ADAW] + (size_t)L * 1024 * 6144 + n;
    float acc[9];
    const float b = a.in[I_ADAB][L * 6144 + n];
#pragma unroll
    for (int r = 0; r < 9; ++r) acc[r] = b;
#pragma unroll 8
    for (int k = 0; k < 1024; k += 4) {
        const float w0 = w[(size_t)k * 6144], w1 = w[(size_t)(k + 1) * 6144], w2 = w[(size_t)(k + 2) * 6144], w3 = w[(size_t)(k + 3) * 6144];
#pragma unroll
        for (int r = 0; r < 9; ++r) { const f32x4 c4 = *(const LAS f32x4*)(cond + r * 1024 + k); acc[r] += c4[0] * w0 + c4[1] * w1 + c4[2] * w2 + c4[3] * w3; }
    }
    float* mod = (float*)(F.ws + WS_MOD) + (size_t)L * 9 * 6144 + n;
#pragma unroll
    for (int r = 0; r < 9; ++r) mod[(size_t)r * 6144] = acc[r];
    __syncthreads();
}
__device__ __forceinline__ void pro_tables(Frame& F, CArgs& a) {
    { bf16* gt = (bf16*)(F.ws + WS_GA2T);
      for (int i = F.tid; i < DEPTH * 256 * 32; i += NTHR) { const int L = i >> 13, col = (i >> 5) & 255, k = i & 31, r = col >> 7, c = col & 127;
          gt[i] = (bf16)f2bf((k >> 4) == r ? a.in[I_GLAA2][((size_t)(L * 2 + r) * 16 + (k & 15)) * 128 + c] : 0.f); } }
    { bf16* rt = (bf16*)(F.ws + WS_RWT);
      for (int i = F.tid; i < DEPTH * 32768; i += NTHR) { const int L = i >> 15, e = (i >> 10) & 31, k = i & 1023; const float w = a.in[I_RW][((size_t)L * DM + k) * NEXP + e];
          const unsigned hi = f2bf(w); rt[(size_t)L * 65536 + e * 1024 + k] = (bf16)hi; rt[(size_t)L * 65536 + 32768 + e * 1024 + k] = (bf16)f2bf(w - bf2f((unsigned short)hi)); } }
    bf16* f64 = (bf16*)(F.ws + WS_TAB + TAB_F64);
    for (int i = F.tid; i < 4096; i += NTHR) { const int k = i >> 6, n = i & 63; float s, c; sincospif((float)((k * n) & 63) / 32.f, &s, &c); f64[i] = (bf16)f2bf(c); f64[4096 + i] = (bf16)f2bf(s); }
    float* tw = (float*)(F.ws + WS_TAB + TAB_TW);
    for (int i = F.tid; i < 4096; i += NTHR) { float s, c; sincospif((float)i / 2048.f, &s, &c); tw[2 * i] = c; tw[2 * i + 1] = s; }
    bf16* dc = (bf16*)(F.ws + WS_DFTC);
    for (int i = F.tid; i < 65536; i += NTHR) { const int k = i >> 8, n = i & 255; float s, c; sincospif((float)((k * n) & 255) / 128.f, &s, &c); dc[i] = (bf16)f2bf(c); dc[65536 + i] = (bf16)f2bf(-s); }
    float* d256 = (float*)(F.ws + WS_TAB + TAB_D256);
    for (int i = F.tid; i < 256; i += NTHR) { float s, c; sincospif((float)i / 128.f, &s, &c); d256[2 * i] = c; d256[2 * i + 1] = s; }
}
__device__ __forceinline__ void pro_fold(Frame& F, CArgs& a, int it) {
    const int L = it >> 6, h = (it >> 4) & 3, nb = it & 15, n0 = nb * 64;
    LAS float* fw = (LAS float*)F.lds;
    LAS float* ct = fw + 64 * 65;
    LAS float* swo = ct + 64;
    LAS float* sfo = swo + 256 * 64;
    if (F.tid < 64) ct[F.tid] = cospif((float)F.tid / 32.f);
    const float* four = a.in[I_FOURW] + (size_t)L * 256 * 256 + (size_t)h * 64 * 256, *wo = a.in[I_WOUT] + (size_t)L * 1024 * 1024 + n0;
    { f32x4 va[8], vb[8];
#pragma unroll
      for (int k = 0; k < 8; ++k) { const int i = F.tid + k * NTHR, j = i >> 4, c4 = (i & 15) * 4; va[k] = *(const f32x4*)(wo + (size_t)j * 1024 + c4); vb[k] = *(const f32x4*)(four + (size_t)i * 4); }
#pragma unroll
      for (int k = 0; k < 8; ++k) { const int i = F.tid + k * NTHR, j = i >> 4, c4 = (i & 15) * 4; *(LAS f32x4*)(swo + j * 64 + c4) = va[k]; *(LAS f32x4*)(sfo + i * 4) = vb[k]; } }
    __syncthreads();
    const int n = F.tid & 63, cg = F.tid >> 6;
    { float s[8];
#pragma unroll
      for (int i = 0; i < 8; ++i) s[i] = 0.f;
#pragma unroll 4
      for (int j = 0; j < 256; j += 4) { const float w0 = swo[j * 64 + n], w1 = swo[(j + 1) * 64 + n], w2 = swo[(j + 2) * 64 + n], w3 = swo[(j + 3) * 64 + n];
#pragma unroll
          for (int i = 0; i < 8; ++i) { const f32x4 f4 = *(const LAS f32x4*)(sfo + (cg * 8 + i) * 256 + j); s[i] += f4[0] * w0 + f4[1] * w1 + f4[2] * w2 + f4[3] * w3; } }
#pragma unroll
      for (int i = 0; i < 8; ++i) fw[(cg * 8 + i) * 65 + n] = s[i]; }
    __syncthreads();
    float oc[8], os[8];
#pragma unroll
    for (int i = 0; i < 8; ++i) { oc[i] = 0.f; os[i] = 0.f; }
    for (int kc = 0; kc < 64; ++kc) { const float v = fw[kc * 65 + n];
#pragma unroll
        for (int i = 0; i < 8; ++i) { const int mm = (kc * (cg * 8 + i)) & 63; oc[i] += ct[mm] * v; os[i] += ct[(mm + 48) & 63] * v; } }
    bf16* wt = (bf16*)(F.ws + WS_WOUT) + (size_t)L * DM * MW + (size_t)(n0 + n) * MW + h * 64 + cg * 8;
    u32x4 w; w.x = pk2(oc[0] * 0.125f, oc[1] * 0.125f); w.y = pk2(oc[2] * 0.125f, oc[3] * 0.125f); w.z = pk2(oc[4] * 0.125f, oc[5] * 0.125f); w.w = pk2(oc[6] * 0.125f, oc[7] * 0.125f);
    *(u32x4*)wt = w;
    w.x = pk2(os[0] * 0.125f, os[1] * 0.125f); w.y = pk2(os[2] * 0.125f, os[3] * 0.125f); w.z = pk2(os[4] * 0.125f, os[5] * 0.125f); w.w = pk2(os[6] * 0.125f, os[7] * 0.125f);
    *(u32x4*)(wt + 256) = w;
    __syncthreads();
}
__device__ __forceinline__ void pro_s5(Frame& F, CArgs& a, int it) {
    const int L = it >> 4, g = it & 15;
    LAS float* pw = (LAS float*)F.lds;
    LAS float* bb = pw + 2 * 64 * 17 * 2;
    LAS float* cm = bb + 2 * 64 * 16 * 2;
    LAS float* kt = cm + 2 * 16 * 64 * 2;
    for (int i = F.tid; i < 2 * 64 * 17; i += NTHR) {
        const int r = i / (64 * 17), p = (i / 17) & 63, e = i % 17; const size_t q = ((size_t)(L * 2 + r) * 16 + g) * 64 + p;
        const float dt = __expf(a.in[I_S5LDT][(L * 2 + r) * 16 + g]); const float lr = a.in[I_S5LRE][q] * dt, li = a.in[I_S5LIM][q] * dt;
        float s, c; sincosf(li * (float)e, &s, &c); const float m = expf(lr * (float)e); pw[2 * i] = m * c; pw[2 * i + 1] = m * s;
    }
    for (int i = F.tid; i < 2 * 64 * 16; i += NTHR) {
        const int r = i >> 10, p = (i >> 4) & 63, h = i & 15; const size_t q = ((size_t)(L * 2 + r) * 16 + g) * 64 + p;
        const float dt = __expf(a.in[I_S5LDT][(L * 2 + r) * 16 + g]); const float lre = a.in[I_S5LRE][q], lim = a.in[I_S5LIM][q];
        float s, c; sincosf(lim * dt, &s, &c); const float m = expf(lre * dt); const float ar = m * c - 1.f, ai = m * s;
        const float den = 1.f / (lre * lre + lim * lim); const float cr = (ar * lre + ai * lim) * den, ci = (ai * lre - ar * lim) * den;
        const float br = a.in[I_S5BRE][q * 16 + h], bi = a.in[I_S5BIM][q * 16 + h];
        bb[2 * i] = cr * br - ci * bi; bb[2 * i + 1] = cr * bi + ci * br;
    }
    for (int i = F.tid; i < 2 * 16 * 64; i += NTHR) {
        const int r = i >> 10, h = (i >> 6) & 15, p = i & 63; const size_t q = (((size_t)(L * 2 + r) * 16 + g) * 16 + h) * 64 + p;
        cm[2 * i] = a.in[I_S5CRE][q]; cm[2 * i + 1] = a.in[I_S5CIM][q];
    }
    __syncthreads();
    for (int i = F.tid; i < 2 * 16 * 256; i += NTHR) {
        const int r = i >> 12, tau = (i >> 8) & 15, h = (i >> 4) & 15, hp = i & 15; float s = 0.f;
        for (int p = 0; p < 64; ++p) { const float cr = cm[2 * ((r * 16 + h) * 64 + p)], ci = cm[2 * ((r * 16 + h) * 64 + p) + 1];
            const float ar = pw[2 * ((r * 64 + p) * 17 + tau)], ai = pw[2 * ((r * 64 + p) * 17 + tau) + 1]; const float br = bb[2 * ((r * 64 + p) * 16 + hp)], bi = bb[2 * ((r * 64 + p) * 16 + hp) + 1];
            const float tr = cr * ar - ci * ai, ti = cr * ai + ci * ar; s += tr * br - ti * bi; }
        kt[i] = s;
    }
    __syncthreads();
    bf16* pt = (bf16*)(F.ws + WS_S5P) + (size_t)(L * 16 + g) * 256 * 256;
    for (int i = F.tid; i < 65536; i += NTHR) {
        const int np = i >> 8, k = i & 255, r = np >> 7, cpx = (np >> 6) & 1, p = np & 63, s = k >> 4, hp = k & 15, e = r ? s : 15 - s;
        const float ar = pw[2 * ((r * 64 + p) * 17 + e)], ai = pw[2 * ((r * 64 + p) * 17 + e) + 1]; const float br = bb[2 * ((r * 64 + p) * 16 + hp)], bi = bb[2 * ((r * 64 + p) * 16 + hp) + 1];
        pt[i] = (bf16)f2bf(cpx ? ar * bi + ai * br : ar * br - ai * bi);
    }
    bf16* b2 = (bf16*)(F.ws + WS_S5B2) + (size_t)(L * 16 + g) * 256 * 512;
    const float* dsk = a.in[I_S5D] + L * 256 + g * 16;
    for (int i = F.tid; i < 131072; i += NTHR) {
        const int n = i >> 9, k = i & 511, j = n >> 4, h = n & 15; float v;
        if (k < 256) { const int s = k >> 4, hp = k & 15; v = 0.f;
            if (j >= s) v += kt[((0 * 16 + (j - s)) * 16 + h) * 16 + hp];
            if (j <= s) v += kt[((1 * 16 + (s - j)) * 16 + h) * 16 + hp];
            if (j == s && h == hp) v += dsk[h];
        } else { const int kk = k - 256, r = kk >> 7, cpx = (kk >> 6) & 1, p = kk & 63, e = r ? 16 - j : j + 1;
            const float cr = cm[2 * ((r * 16 + h) * 64 + p)], ci = cm[2 * ((r * 16 + h) * 64 + p) + 1]; const float ar = pw[2 * ((r * 64 + p) * 17 + e)], ai = pw[2 * ((r * 64 + p) * 17 + e) + 1];
            v = cpx ? -(cr * ai + ci * ar) : (cr * ar - ci * ai); }
        b2[i] = (bf16)f2bf(v);
    }
    float* a16 = (float*)(F.ws + WS_A16) + (size_t)((L * 2) * 16 + g) * 128;
    if (F.tid < 128) { const int r = F.tid >> 6, p = F.tid & 63; float* o = a16 + (size_t)r * 16 * 128 + p * 2; o[0] = pw[2 * ((r * 64 + p) * 17 + 16)]; o[1] = pw[2 * ((r * 64 + p) * 17 + 16) + 1]; }
    __syncthreads();
}
struct TDesc { const float* src; unsigned char* dst; int ldw, ncols, k0, n0, ldt, kd0, kind, valid; };
__device__ __forceinline__ TDesc tr_decode(Frame& F, int wi) {
    TDesc d; d.valid = wi < DEPTH * TW_LAYER; d.src = nullptr; d.dst = nullptr; d.ldw = d.ncols = d.k0 = d.n0 = d.ldt = d.kd0 = d.kind = 0;
    if (!d.valid) return d;
    const int L = wi / TW_LAYER; int r = wi % TW_LAYER;
    if (r < TW_WIN) { const int kb = r / 33, nb = r % 33; d.src = fresh_args()->in[I_WIN] + (size_t)L * DM * 2088; d.ldw = 2088; d.ncols = 2088; d.k0 = kb * 64; d.n0 = nb * 64; d.dst = F.ws + WS_WIN + (size_t)L * PW * DM * 2; d.ldt = DM; d.kd0 = kb * 64; d.kind = 0; return d; } r -= TW_WIN;
    if (r < TW_GU) { const int e = r >> 9, kb = (r >> 5) & 15, nb = r & 31; d.src = fresh_args()->in[I_WGU] + ((size_t)L * NEXP + e) * DM * 2048; d.ldw = 2048; d.ncols = 2048; d.k0 = kb * 64; d.n0 = nb * 64; d.dst = F.ws + WS_WGU + ((size_t)L * NEXP + e) * 2048 * DM; d.ldt = DM; d.kd0 = kb * 64; d.kind = 1; return d; } r -= TW_GU;
    if (r < TW_DN) { const int e = r >> 8, kb = (r >> 4) & 15, nb = r & 15; d.src = fresh_args()->in[I_WDN] + ((size_t)L * NEXP + e) * DM * DM; d.ldw = DM; d.ncols = DM; d.k0 = kb * 64; d.n0 = nb * 64; d.dst = F.ws + WS_WDN + ((size_t)L * NEXP + e) * DM * DM; d.ldt = DM; d.kd0 = kb * 64; d.kind = 2; return d; } r -= TW_DN;
    if (r < TW_WOUT) { const int kb = r >> 4, nb = r & 15; d.src = fresh_args()->in[I_WOUT] + (size_t)L * DM * DM + (size_t)256 * DM; d.ldw = DM; d.ncols = DM; d.k0 = kb * 64; d.n0 = nb * 64; d.dst = F.ws + WS_WOUT + (size_t)L * DM * MW * 2; d.ldt = MW; d.kd0 = 512 + kb * 64; d.kind = 3; return d; } r -= TW_WOUT;
    { const int kb = r >> 2, nb = r & 3; d.src = fresh_args()->in[I_S5GLU] + (size_t)L * 256 * 256; d.ldw = 256; d.ncols = 256; d.k0 = kb * 64; d.n0 = nb * 64; d.dst = F.ws + WS_WGLU + (size_t)L * 256 * 256 * 2; d.ldt = 256; d.kd0 = kb * 64; d.kind = 3; }
    return d;
}
__device__ __forceinline__ void tr_load(const TDesc& d, f32x4 (&v)[16], int lane) {
    if (!d.valid) return;
    const int c4 = (lane & 15) * 4, r4 = lane >> 4; const bool ok = d.n0 + c4 < d.ncols;
#pragma unroll
    for (int q = 0; q < 16; ++q) v[q] = ok ? *(const f32x4*)(d.src + (size_t)(d.k0 + q * 4 + r4) * d.ldw + d.n0 + c4) : (f32x4){0.f, 0.f, 0.f, 0.f};
}
__device__ __forceinline__ void tr_finish(const TDesc& d, const f32x4 (&v)[16], LAS float* scr, int lane) {
    if (!d.valid) return;
    { const int c4 = (lane & 15) * 4, r4 = lane >> 4;
#pragma unroll
      for (int q = 0; q < 16; ++q) { const int kk = q * 4 + r4; scr[kk * 65 + c4] = v[q][0]; scr[kk * 65 + c4 + 1] = v[q][1]; scr[kk * 65 + c4 + 2] = v[q][2]; scr[kk * 65 + c4 + 3] = v[q][3]; } }
    asm volatile("s_waitcnt lgkmcnt(0)" ::: "memory");
    const int c = lane & 7;
    if (d.kind == 1 || d.kind == 2) {
#pragma unroll
        for (int j = 0; j < 8; ++j) { const int n = (lane >> 3) + 8 * j; const LAS float* s = scr + (8 * c) * 65 + n;
            u32x2 o; o.x = pk4f8(s[0] * W8_SCALE, s[65] * W8_SCALE, s[2 * 65] * W8_SCALE, s[3 * 65] * W8_SCALE); o.y = pk4f8(s[4 * 65] * W8_SCALE, s[5 * 65] * W8_SCALE, s[6 * 65] * W8_SCALE, s[7 * 65] * W8_SCALE);
            const int nn = d.n0 + n, dr = d.kind == 1 ? MapGu()(nn) : nn;
            *(u32x2*)(d.dst + (size_t)dr * d.ldt + d.kd0 + 8 * c) = o; }
    } else {
#pragma unroll
        for (int j = 0; j < 8; ++j) { const int n = (lane >> 3) + 8 * j; const LAS float* s = scr + (8 * c) * 65 + n;
            u32x4 o; o.x = pk2(s[0], s[65]); o.y = pk2(s[2 * 65], s[3 * 65]); o.z = pk2(s[4 * 65], s[5 * 65]); o.w = pk2(s[6 * 65], s[7 * 65]);
            const int nn = d.n0 + n;
            if (nn < d.ncols) { const int dr = d.kind == 0 ? MapWin()(nn) : nn; *(u32x4*)((bf16*)d.dst + (size_t)dr * d.ldt + d.kd0 + 8 * c) = o; } }
    }
    asm volatile("s_waitcnt lgkmcnt(0)" ::: "memory");
}
__device__ __forceinline__ void pro_transposes4(Frame& F, int ticket) {
    LAS float* scr = (LAS float*)F.lds + F.wave * (64 * 65);
    const int w0 = ticket * 32 + F.wave;
    f32x4 va[16], vb[16];
    const TDesc d0 = tr_decode(F, w0); tr_load(d0, va, F.lane);
    const TDesc d1 = tr_decode(F, w0 + 8); tr_load(d1, vb, F.lane); tr_finish(d0, va, scr, F.lane);
    const TDesc d2 = tr_decode(F, w0 + 16); tr_load(d2, va, F.lane); tr_finish(d1, vb, scr, F.lane);
    const TDesc d3 = tr_decode(F, w0 + 24); tr_load(d3, vb, F.lane); tr_finish(d2, va, scr, F.lane);
    tr_finish(d3, vb, scr, F.lane);
}
__device__ __forceinline__ void p_prologue(Frame& F0, CArgs& a, int qw = CW_QUEUE) {
    for (;;) {
        if (F0.tid == 0) F0.MISC[0] = __hip_atomic_fetch_add(F0.ctl + qw, 1u, RLX_AGENT);
        __syncthreads();
        const int it = (int)F0.MISC[0];
        __syncthreads();
        if (it >= PI_TOTAL) break;
        Frame F = F0; { const int t_ = fresh_tid(F.wave); F.tid = t_; F.lane = t_ & 63; }
        if (it < PI_B_TAB) pro_adaln(F, *fresh_args(), it);
        else if (it < PI_B_S5) pro_tables(F, *fresh_args());
        else if (it < PI_B_FOLD) pro_s5(F, *fresh_args(), it - PI_B_S5);
        else if (it < PI_B_ZERO) pro_fold(F, *fresh_args(), it - PI_B_FOLD);
        else if (it < PI_B_TR) { const int L = it - PI_B_ZERO; u32x4* z = (u32x4*)((bf16*)(F.ws + WS_WIN) + (size_t)L * PW * DM + (size_t)2088 * DM); for (int i = F.tid; i < (PW - 2088) * DM / 8; i += NTHR) z[i] = (u32x4){0u, 0u, 0u, 0u}; }
        else pro_transposes4(F, it - PI_B_TR);
    }
}

__device__ __forceinline__ void p_norm1(Frame& F, CArgs& a, int L, bool dry = false) {
    const int gw = F.bid * NWAVES + F.wave, NGW = F.G * NWAVES;
    bf16* XS = (bf16*)(F.ws + WS_XS); bf16* H = (bf16*)(F.ws + WS_H);
    const float* mod = (const float*)(F.ws + WS_MOD) + (size_t)L * 9 * 6144; const float* modp = mod - 9 * 6144;
    const int* PS = (const int*)(F.ws + WS_PS); const unsigned char* Y = (const unsigned char*)(F.ws + WS_Y);
    const float* g = a.in[I_NMG] + L * DM;
    const float* xin = a.in[I_X]; const float* cin = a.in[I_CTX];
    f32x4 gv[4];
#pragma unroll
    for (int j = 0; j < 4; ++j) gv[j] = *(const f32x4*)(g + 4 * F.lane + 256 * j);
    f32x4 xn[4]; u32x2 xb[4]; unsigned yn[4][4]; int psn[4] = {0, 0, 0, 0};
#define N1_LOADX(dst, row) do { if (L == 0) { const float* s_ = (row) < NLAT ? xin + (size_t)(row) * DM : cin + (size_t)((row) - NLAT) * DM; _Pragma("unroll") for (int j = 0; j < 4; ++j) dst[j] = *(const f32x4*)(s_ + 4 * F.lane + 256 * j); } \
        else { const bf16* s_ = XS + (size_t)(row) * DM; _Pragma("unroll") for (int j = 0; j < 4; ++j) xb[j] = *(const u32x2*)(s_ + 4 * F.lane + 256 * j); } } while (0)
#define N1_LOADY(dst, ps) do { _Pragma("unroll") for (int k = 0; k < 4; ++k) { const unsigned char* yr_ = Y + (size_t)(ps)[k] * DM; _Pragma("unroll") for (int j = 0; j < 4; ++j) dst[k][j] = *(const unsigned*)(yr_ + 4 * F.lane + 256 * j); } } while (0)
#define N1_LOADPS(dst, row) do { const int4 p_ = *(const int4*)(PS + (size_t)(row) * 4); dst[0] = p_.x; dst[1] = p_.y; dst[2] = p_.z; dst[3] = p_.w; } while (0)
    int row = gw;
    if (row < NT) { N1_LOADX(xn, row); if (L > 0) { N1_LOADPS(psn, row); N1_LOADY(yn, psn); if (row + NGW < NT) N1_LOADPS(psn, row + NGW); } }
    while (row < NT) {
        const int nrow = row + NGW; const int bi = row < NLAT ? (row >> 12) : 8;
        f32x4 v[4]; unsigned yc[4][4];
#pragma unroll
        for (int j = 0; j < 4; ++j) { v[j] = (L == 0) ? xn[j] : bf4(xb[j]);
#pragma unroll
            for (int k = 0; k < 4; ++k) yc[k][j] = yn[k][j]; }
        if (nrow < NT) { N1_LOADX(xn, nrow); if (L > 0) { N1_LOADY(yn, psn); if (nrow + NGW < NT) N1_LOADPS(psn, nrow + NGW); } }
        if (L > 0) {
            bf16* xr = XS + (size_t)row * DM; const float* m5 = modp + (size_t)bi * 6144 + 5 * 1024;
#pragma unroll
            for (int j = 0; j < 4; ++j) { f32x4 s = (f32x4){0.f, 0.f, 0.f, 0.f};
#pragma unroll
                for (int k = 0; k < 4; ++k) s += f8x4(yc[k][j]);
                v[j] += *(const f32x4*)(m5 + 4 * F.lane + 256 * j) * (s * (1.f / Y8_SCALE)); if (!dry) { u32x2 w; w.x = pk2(v[j][0], v[j][1]); w.y = pk2(v[j][2], v[j][3]); *(u32x2*)(xr + 4 * F.lane + 256 * j) = w; } }
        }
        float ss = 0.f;
#pragma unroll
        for (int j = 0; j < 4; ++j) ss += v[j][0] * v[j][0] + v[j][1] * v[j][1] + v[j][2] * v[j][2] + v[j][3] * v[j][3];
        const float rs = rsqrtf(wave_sum(ss, F.lane) * (1.f / DM) + 1e-6f);
        const float* sh = mod + (size_t)bi * 6144, *sc = sh + 1024;
        bf16* hr = H + (size_t)row * DM;
#pragma unroll
        for (int j = 0; j < 4; ++j) { const f32x4 s4 = *(const f32x4*)(sc + 4 * F.lane + 256 * j), h4 = *(const f32x4*)(sh + 4 * F.lane + 256 * j);
            const f32x4 o = v[j] * rs * gv[j] * (s4 + 1.f) + h4; u32x2 w; w.x = pk2(o[0], o[1]); w.y = pk2(o[2], o[3]); if (!dry) *(u32x2*)(hr + 4 * F.lane + 256 * j) = w; else if (o[0] == 12345.678f) *(u32x2*)(hr + 4 * F.lane + 256 * j) = w; }
        row = nrow;
    }
#undef N1_LOADX
#undef N1_LOADY
#undef N1_LOADPS
}
__device__ __forceinline__ void p_norm2(Frame& F, CArgs& a, int L, int nrows, int cw = CW_CNT) {
    constexpr int TS = 1032;
    LAS bf16* thi = (LAS bf16*)F.lds; LAS bf16* tlo = thi + 16 * TS;
    LAS float* part = (LAS float*)(tlo + 16 * TS);
    LAS unsigned* lcnt = (LAS unsigned*)(part + 8 * 16 * 33);
    if (F.tid < 64) lcnt[F.tid] = 0u;
    const int lr = F.lane & 15, g = F.lane >> 4, hf = F.lane >> 5;
    bf16x8 bh[4][2], bl[4][2];
    { const bf16* rwh = (const bf16*)(F.ws + WS_RWT) + (size_t)L * 65536; const bf16* rwl = rwh + 32768;
#pragma unroll
      for (int ks = 0; ks < 4; ++ks)
#pragma unroll
          for (int nt = 0; nt < 2; ++nt) { const int o = (16 * nt + lr) * 1024 + 128 * F.wave + 32 * ks + 8 * g; bh[ks][nt] = *(const bf16x8*)(rwh + o); bl[ks][nt] = *(const bf16x8*)(rwl + o); } }
    __syncthreads();
    const int gw = F.bid * NWAVES + F.wave, NGW = F.G * NWAVES, R = (nrows - gw + NGW - 1) / NGW;
    const int Rmax = (nrows - F.bid * NWAVES + NGW - 1) / NGW;
    const bf16* XS = (const bf16*)(F.ws + WS_XS); unsigned char* H8 = (unsigned char*)(F.ws + WS_H8);
    const float* mod = (const float*)(F.ws + WS_MOD) + (size_t)L * 9 * 6144;
    int* PE = (int*)(F.ws + WS_PE); int* PR = (int*)(F.ws + WS_PR); float* PG = (float*)(F.ws + WS_PG);
    unsigned* cnt = F.ctl + cw + L * 64;
    const float* gp = a.in[I_NFG] + L * DM;
    const float rbh = a.in[I_RB][L * NEXP + (F.lane & 31)];
    f32x4 gv[4];
#pragma unroll
    for (int j = 0; j < 4; ++j) gv[j] = *(const f32x4*)(gp + 4 * F.lane + 256 * j);
    u32x2 xn[4];
#pragma unroll
    for (int j = 0; j < 4; ++j) xn[j] = 0 < R ? *(const u32x2*)(XS + (size_t)gw * DM + 4 * F.lane + 256 * j) : (u32x2){0u, 0u};
    for (int bt = 0; 2 * bt < Rmax; ++bt) {
#pragma unroll
        for (int it = 0; it < 2; ++it) {
            const int ri = 2 * bt + it, row = gw + ri * NGW; const bool ok = ri < R; const int bi = row < NLAT ? (row >> 12) : 8;
            f32x4 v[4]; float ss = 0.f;
#pragma unroll
            for (int j = 0; j < 4; ++j) { v[j] = bf4(xn[j]); ss += v[j][0] * v[j][0] + v[j][1] * v[j][1] + v[j][2] * v[j][2] + v[j][3] * v[j][3]; }
#pragma unroll
            for (int j = 0; j < 4; ++j) xn[j] = ri + 1 < R ? *(const u32x2*)(XS + (size_t)(row + NGW) * DM + 4 * F.lane + 256 * j) : (u32x2){0u, 0u};
            const float rs = rsqrtf(wave_sum(ss, F.lane) * (1.f / DM) + 1e-6f);
            const float* sh = mod + (size_t)(ok ? bi : 0) * 6144 + 3 * 1024, *sc = sh + 1024;
            unsigned char* hr = H8 + (size_t)row * DM;
            LAS bf16* th = thi + (it * 8 + F.wave) * TS, *tl = tlo + (it * 8 + F.wave) * TS;
#pragma unroll
            for (int j = 0; j < 4; ++j) { const f32x4 s4 = *(const f32x4*)(sc + 4 * F.lane + 256 * j), h4 = *(const f32x4*)(sh + 4 * F.lane + 256 * j);
                v[j] = ok ? v[j] * rs * gv[j] * (s4 + 1.f) + h4 : (f32x4){0.f, 0.f, 0.f, 0.f};
                if (ok) *(unsigned*)(hr + 4 * F.lane + 256 * j) = pk4f8(v[j][0] * H8_SCALE, v[j][1] * H8_SCALE, v[j][2] * H8_SCALE, v[j][3] * H8_SCALE);
                u32x2 wh; wh.x = pk2(v[j][0], v[j][1]); wh.y = pk2(v[j][2], v[j][3]);
                const f32x4 hv = bf4(wh); const f32x4 dl = v[j] - hv; u32x2 wl; wl.x = pk2(dl[0], dl[1]); wl.y = pk2(dl[2], dl[3]);
                *(LAS u32x2*)(th + 4 * F.lane + 256 * j) = wh; *(LAS u32x2*)(tl + 4 * F.lane + 256 * j) = wl; }
        }
        __syncthreads();
        {   f32x4 acc[2] = {(f32x4){0.f, 0.f, 0.f, 0.f}, (f32x4){0.f, 0.f, 0.f, 0.f}};
#pragma unroll
            for (int ks = 0; ks < 4; ++ks) { const int o = lr * TS + 128 * F.wave + 32 * ks + 8 * g; const bf16x8 ah = *(const LAS bf16x8*)(thi + o), al = *(const LAS bf16x8*)(tlo + o);
#pragma unroll
                for (int nt = 0; nt < 2; ++nt) { acc[nt] = __builtin_amdgcn_mfma_f32_16x16x32_bf16(ah, bh[ks][nt], acc[nt], 0, 0, 0); acc[nt] = __builtin_amdgcn_mfma_f32_16x16x32_bf16(al, bh[ks][nt], acc[nt], 0, 0, 0); acc[nt] = __builtin_amdgcn_mfma_f32_16x16x32_bf16(ah, bl[ks][nt], acc[nt], 0, 0, 0); } }
#pragma unroll
            for (int nt = 0; nt < 2; ++nt)
#pragma unroll
                for (int j = 0; j < 4; ++j) part[(F.wave * 16 + 4 * g + j) * 33 + 16 * nt + lr] = acc[nt][j];
        }
        __syncthreads();
        {   const int s = 2 * F.wave + hf, e = F.lane & 31;
            float logit = rbh;
#pragma unroll
            for (int w = 0; w < 8; ++w) logit += part[(w * 16 + s) * 33 + e];
            const int ri = 2 * bt + (s >> 3), rowh = F.bid * NWAVES + (s & 7) + ri * NGW; const bool okh = rowh < nrows;
            int es[4]; float ls[4];
#pragma unroll
            for (int k = 0; k < 4; ++k) {
                float m = logit; m = fmaxf(m, swz_xor<1>(m)); m = fmaxf(m, swz_xor<2>(m)); m = fmaxf(m, swz_xor<4>(m)); m = fmaxf(m, swz_xor<8>(m)); m = fmaxf(m, swz_xor<16>(m));
                const unsigned long long bal = __ballot(logit == m);
                const unsigned mh = (unsigned)(bal >> (F.lane & 32));
                es[k] = __builtin_ctz(mh); ls[k] = m;
                if (e == es[k]) logit = -3.0e38f;
            }
            const float e1 = __expf(ls[1] - ls[0]), e2 = __expf(ls[2] - ls[0]), e3 = __expf(ls[3] - ls[0]); const float inv = 1.f / (1.f + e1 + e2 + e3);
            if (e < 4 && okh) {
                const int ex = e == 0 ? es[0] : (e == 1 ? es[1] : (e == 2 ? es[2] : es[3]));
                const float gt = (e == 0 ? 1.f : (e == 1 ? e1 : (e == 2 ? e2 : e3))) * inv;
                const unsigned rk = __hip_atomic_fetch_add(lcnt + ex, 1u, __ATOMIC_RELAXED, __HIP_MEMORY_SCOPE_WORKGROUP);
                PE[rowh * 4 + e] = ex; PR[rowh * 4 + e] = (int)rk; PG[rowh * 4 + e] = gt;
            }
        }
        __syncthreads();
    }
    if (F.tid < 32) lcnt[32 + F.tid] = __hip_atomic_fetch_add(cnt + F.tid, lcnt[F.tid], RLX_AGENT);
    __syncthreads();
    int* TM = (int*)(F.ws + WS_TM);
    for (int bt = 0; 2 * bt < Rmax; ++bt) {
        const int s = 2 * F.wave + hf, e = F.lane & 31, rowh = F.bid * NWAVES + (s & 7) + (2 * bt + (s >> 3)) * NGW;
        if (e < 4 && rowh < nrows) { const int i = rowh * 4 + e, ex = PE[i], rk = PR[i] + (int)lcnt[32 + ex]; TM[(size_t)ex * NT + rk] = i; }
    }
    __syncthreads();
}
__device__ __forceinline__ void p_final(Frame& F, CArgs& a) {
    const int gw = F.bid * NWAVES + F.wave, NGW = F.G * NWAVES;
    const bf16* XS = (const bf16*)(F.ws + WS_XS);
    const float* modp = (const float*)(F.ws + WS_MOD) + (size_t)(DEPTH - 1) * 9 * 6144;
    const int* PS = (const int*)(F.ws + WS_PS); const unsigned char* Y = (const unsigned char*)(F.ws + WS_Y);
    const float* g = a.in[I_FING];
    f32x4 gv[4];
#pragma unroll
    for (int j = 0; j < 4; ++j) gv[j] = *(const f32x4*)(g + 4 * F.lane + 256 * j);
    u32x2 xb[4]; unsigned yn[4][4]; int psn[4] = {0, 0, 0, 0};
#define FN_LOADX(row) do { const bf16* s_ = XS + (size_t)(row) * DM; _Pragma("unroll") for (int j = 0; j < 4; ++j) xb[j] = *(const u32x2*)(s_ + 4 * F.lane + 256 * j); } while (0)
#define FN_LOADY(ps) do { _Pragma("unroll") for (int k = 0; k < 4; ++k) { const unsigned char* yr_ = Y + (size_t)(ps)[k] * DM; _Pragma("unroll") for (int j = 0; j < 4; ++j) yn[k][j] = *(const unsigned*)(yr_ + 4 * F.lane + 256 * j); } } while (0)
#define FN_LOADPS(row) do { const int4 p_ = *(const int4*)(PS + (size_t)(row) * 4); psn[0] = p_.x; psn[1] = p_.y; psn[2] = p_.z; psn[3] = p_.w; } while (0)
    int row = gw;
    if (row < NLAT) { FN_LOADX(row); FN_LOADPS(row); FN_LOADY(psn); if (row + NGW < NLAT) FN_LOADPS(row + NGW); }
    while (row < NLAT) {
        const int nrow = row + NGW, bi = row >> 12;
        f32x4 v[4], s[4];
#pragma unroll
        for (int j = 0; j < 4; ++j) { v[j] = bf4(xb[j]); s[j] = (f32x4){0.f, 0.f, 0.f, 0.f};
#pragma unroll
            for (int k = 0; k < 4; ++k) s[j] += f8x4(yn[k][j]);
            s[j] = s[j] * (1.f / Y8_SCALE); }
        if (nrow < NLAT) { FN_LOADX(nrow); FN_LOADY(psn); if (nrow + NGW < NLAT) FN_LOADPS(nrow + NGW); }
        const float* m5 = modp + (size_t)bi * 6144 + 5 * 1024;
        float ss = 0.f;
#pragma unroll
        for (int j = 0; j < 4; ++j) { v[j] += *(const f32x4*)(m5 + 4 * F.lane + 256 * j) * s[j]; ss += v[j][0] * v[j][0] + v[j][1] * v[j][1] + v[j][2] * v[j][2] + v[j][3] * v[j][3]; }
        const float rs = rsqrtf(wave_sum(ss, F.lane) * (1.f / DM) + 1e-6f);
        float* orow = a.out + (size_t)row * DM;
#pragma unroll
        for (int j = 0; j < 4; ++j) *(f32x4*)(orow + 4 * F.lane + 256 * j) = v[j] * rs * gv[j];
        row = nrow;
    }
#undef FN_LOADX
#undef FN_LOADY
#undef FN_LOADPS
}

#ifndef MIX_P1
#define MIX_P1 1
#endif
#define MFMA16(a, b, c) __builtin_amdgcn_mfma_f32_16x16x32_bf16((a), (b), (c), 0, 0, 0)
typedef short v4i16_t __attribute__((ext_vector_type(4)));
__device__ __forceinline__ s16x4 trread(const LAS void* p) { return __builtin_bit_cast(s16x4, __builtin_amdgcn_ds_read_tr16_b64_v4i16((LAS v4i16_t*)p)); }
__device__ __forceinline__ bf16x8 cat8(s16x4 a, s16x4 b) { return __builtin_shufflevector(a, b, 0, 1, 2, 3, 4, 5, 6, 7); }
__device__ __forceinline__ bf16x8 pack8(const float* v) { u32x4 w; w.x = pg8::cvt_pk_bf16(v[0], v[1]); w.y = pg8::cvt_pk_bf16(v[2], v[3]); w.z = pg8::cvt_pk_bf16(v[4], v[5]); w.w = pg8::cvt_pk_bf16(v[6], v[7]); return __builtin_bit_cast(bf16x8, w); }
__device__ __forceinline__ void unpack8(bf16x8 x, float* v) { const u32x4 w = __builtin_bit_cast(u32x4, x); v[0] = bflo(w.x); v[1] = bfhi(w.x); v[2] = bflo(w.y); v[3] = bfhi(w.y); v[4] = bflo(w.z); v[5] = bfhi(w.z); v[6] = bflo(w.w); v[7] = bfhi(w.w); }
#define OPQ(x) ({ int o_ = (x); asm volatile("" : "+s"(o_)); o_; })
#define LAUNDER_F(F0) Frame F = F0; { const int t_ = fresh_tid(F.wave); F.tid = t_; F.lane = t_ & 63; }
__device__ __forceinline__ int chunk_tok0(int cid) { return cid < 512 ? cid * 64 : NLAT + (cid - 512) * 64; }

constexpr int GL_QS = 136, GL_VS = 264, GL_BS = 260;
constexpr int GL_Q = 0, GL_K = GL_Q + 64 * GL_QS * 2, GL_V = GL_K + 64 * GL_QS * 2, GL_A1 = GL_V + 64 * GL_VS * 2, GL_B = GL_A1 + 64 * 32 * 2, GL_END = GL_B + 64 * GL_BS * 4;
static_assert(GL_END <= MISC_OFF, "GLA LDS");
template <int MODE> __device__ __forceinline__ void gla_chunk(Frame& F0, CArgs& a, int L, int cid) {
    constexpr bool OUT = MODE == 1, DO_STATE = MODE == 0 || MODE == 2, DO_INTRA = MODE == 1 || MODE == 2;
    LAUNDER_F(F0)
    const int tok0 = chunk_tok0(cid);
    const bf16* P = (const bf16*)(F.ws + WS_PBUF) + (size_t)tok0 * PW;
    LAS bf16* sq = (LAS bf16*)(F.lds + GL_Q); LAS bf16* sk = (LAS bf16*)(F.lds + GL_K); LAS bf16* sv = (LAS bf16*)(F.lds + GL_V); LAS bf16* sa1 = (LAS bf16*)(F.lds + GL_A1); LAS float* sB = (LAS float*)(F.lds + GL_B);
    __syncthreads();
    u32x4 rgate[4]; bf16x8 sfr[4];
    if constexpr (OUT) {
#pragma unroll
        for (int k = 0; k < 4; ++k) { const int i = F.tid + k * NTHR, t = i >> 5, pc = i & 31; rgate[k] = *(const u32x4*)(P + (size_t)t * PW + PC_R + pc * 8); }
        const bf16* se = (const bf16*)(F.ws + WS_GSE) + (((size_t)cid * 4 + (F.wave & 3)) * 2 + (F.wave >> 2)) * 2048;
#pragma unroll
        for (int d = 0; d < 4; ++d) sfr[d] = *(const bf16x8*)(se + (16 * d + (F.lane & 15)) * 32 + 8 * (F.lane >> 4));
    }
    {   u32x4 rq[2], rk[2], rv[4], ra = (u32x4){0u, 0u, 0u, 0u};
#pragma unroll
        for (int k = 0; k < 2; ++k) { const int i = F.tid + k * NTHR, t = i >> 4, pc = i & 15; rq[k] = *(const u32x4*)(P + (size_t)t * PW + PC_Q + pc * 8); rk[k] = *(const u32x4*)(P + (size_t)t * PW + PC_K + pc * 8); }
#pragma unroll
        for (int k = 0; k < 4; ++k) { const int i = F.tid + k * NTHR, t = i >> 5, pc = i & 31; rv[k] = *(const u32x4*)(P + (size_t)t * PW + PC_V + pc * 8); }
        if (F.tid < 256) { const int t = F.tid >> 2, pc = F.tid & 3; ra = *(const u32x4*)(P + (size_t)t * PW + PC_A1 + pc * 8); }
#pragma unroll
        for (int k = 0; k < 2; ++k) { const int i = F.tid + k * NTHR, t = i >> 4, pc = i & 15; *(LAS u32x4*)(sq + t * GL_QS + pc * 8) = rq[k]; *(LAS u32x4*)(sk + t * GL_QS + pc * 8) = rk[k]; }
#pragma unroll
        for (int k = 0; k < 4; ++k) { const int i = F.tid + k * NTHR, t = i >> 5, pc = i & 31; *(LAS u32x4*)(sv + t * GL_VS + pc * 8) = rv[k]; }
        if (F.tid < 256) { const int t = F.tid >> 2, pc = F.tid & 3; *(LAS u32x4*)(sa1 + t * 32 + pc * 8) = ra; }
    }
    __syncthreads();
    {
        const int lr_ = F.lane & 15, g_ = F.lane >> 4;
        const bf16* gt = (const bf16*)(F.ws + WS_GA2T) + (size_t)L * 256 * 32;
        bf16x8 bz[2]; float abv[2];
#pragma unroll
        for (int nt = 0; nt < 2; ++nt) { const int col = 32 * F.wave + 16 * nt + lr_; bz[nt] = *(const bf16x8*)(gt + col * 32 + 8 * g_); abv[nt] = a.in[I_GLAAB][L * 256 + col]; }
#pragma unroll
        for (int m = 0; m < 4; ++m) { const bf16x8 az = *(const LAS bf16x8*)(sa1 + (16 * m + lr_) * 32 + 8 * g_);
#pragma unroll
            for (int nt = 0; nt < 2; ++nt) { const f32x4 zz = MFMA16(az, bz[nt], ((f32x4){0.f, 0.f, 0.f, 0.f})); const int col = 32 * F.wave + 16 * nt + lr_;
#pragma unroll
                for (int j = 0; j < 4; ++j) { const float z = zz[j] + abv[nt]; const float ls = fminf(z, 0.f) - __logf(1.f + __expf(-fabsf(z))); sB[(16 * m + 4 * g_ + j) * GL_BS + col] = ls * (1.f / 16.f); } } }
    }
    __syncthreads();
    if (F.tid < 256) { const int col = F.tid, r = col >> 7; float bv[64];
#pragma unroll
        for (int i = 0; i < 64; ++i) bv[i] = sB[i * GL_BS + col];
        if (r == 0) {
#pragma unroll
            for (int i = 1; i < 64; ++i) bv[i] += bv[i - 1];
        } else {
#pragma unroll
            for (int i = 62; i >= 0; --i) bv[i] += bv[i + 1];
        }
#pragma unroll
        for (int i = 0; i < 64; ++i) sB[i * GL_BS + col] = bv[i]; }
    __syncthreads();
    const int hh = F.wave & 3, r = F.wave >> 2, lr = F.lane & 15, g = F.lane >> 4;
    const int bc = r * 128 + hh * 32;
    const size_t ub = ((size_t)cid * 4 + hh) * 2 + r;
    if constexpr (DO_STATE) {
        const int tl = r ? 0 : 63;
        f32x4 acc[2][4];
#pragma unroll
        for (int mc = 0; mc < 2; ++mc)
#pragma unroll
            for (int d = 0; d < 4; ++d) acc[mc][d] = (f32x4){0.f, 0.f, 0.f, 0.f};
#pragma unroll
        for (int sg = 0; sg < 2; ++sg) {
            bf16x8 vf[4];
#pragma unroll
            for (int d = 0; d < 4; ++d) { const LAS bf16* p0 = sv + (32 * sg + 8 * g + ((F.lane & 15) >> 2)) * GL_VS + hh * 64 + 16 * d + 4 * (F.lane & 3); vf[d] = cat8(trread(p0), trread(p0 + 4 * GL_VS)); }
#pragma unroll
            for (int mc = 0; mc < 2; ++mc) {
                const LAS bf16* p0 = sk + (32 * sg + 8 * g + ((F.lane & 15) >> 2)) * GL_QS + hh * 32 + 16 * mc + 4 * (F.lane & 3);
                const s16x4 k0 = trread(p0), k1 = trread(p0 + 4 * GL_QS);
                const int c = 16 * mc + lr; const float bl = sB[tl * GL_BS + bc + c];
                float kv[8];
#pragma unroll
                for (int e = 0; e < 4; ++e) { kv[e] = bf2f((unsigned short)k0[e]) * __expf(bl - sB[(32 * sg + 8 * g + e) * GL_BS + bc + c]); kv[4 + e] = bf2f((unsigned short)k1[e]) * __expf(bl - sB[(32 * sg + 8 * g + 4 + e) * GL_BS + bc + c]); }
                const bf16x8 kf = pack8(kv);
#pragma unroll
                for (int d = 0; d < 4; ++d) acc[mc][d] = MFMA16(kf, vf[d], acc[mc][d]);
            }
        }
        float* ds = (float*)(F.ws + WS_GDS) + ub * 2048;
#pragma unroll
        for (int mc = 0; mc < 2; ++mc)
#pragma unroll
            for (int d = 0; d < 4; ++d) *(f32x4*)(ds + (16 * d + lr) * 32 + 16 * mc + 4 * g) = acc[mc][d];
        if (F.lane < 32) ((float*)(F.ws + WS_GDEC))[ub * 32 + F.lane] = __expf(sB[tl * GL_BS + bc + F.lane]);
    }
    if constexpr (DO_INTRA) {
        bf16x8 qf[4], kf[4];
#pragma unroll
        for (int m = 0; m < 4; ++m) { const int t = 16 * m + lr; float qv[8], kv[8], bv[8];
            unpack8(*(const LAS bf16x8*)(sq + t * GL_QS + hh * 32 + 8 * g), qv); unpack8(*(const LAS bf16x8*)(sk + t * GL_QS + hh * 32 + 8 * g), kv);
            *(f32x4*)bv = *(const LAS f32x4*)(sB + t * GL_BS + bc + 8 * g); *(f32x4*)(bv + 4) = *(const LAS f32x4*)(sB + t * GL_BS + bc + 8 * g + 4);
#pragma unroll
            for (int e = 0; e < 8; ++e) { const float ex = __expf(bv[e]); qv[e] *= 0.17677669529663687f * ex; kv[e] *= __frcp_rn(ex); }
            qf[m] = pack8(qv); kf[m] = pack8(kv); }
        f32x4 o[4][4];
#pragma unroll
        for (int m = 0; m < 4; ++m)
#pragma unroll
            for (int d = 0; d < 4; ++d) o[m][d] = (f32x4){0.f, 0.f, 0.f, 0.f};
        if constexpr (OUT) {
#pragma unroll
            for (int d = 0; d < 4; ++d) {
#pragma unroll
                for (int m = 0; m < 4; ++m) o[m][d] = MFMA16(qf[m], sfr[d], o[m][d]); }
        }
        bf16x8 vf[2][4];
#pragma unroll
        for (int sg = 0; sg < 2; ++sg)
#pragma unroll
            for (int d = 0; d < 4; ++d) { const LAS bf16* p0 = sv + (32 * sg + 4 * g + ((F.lane & 15) >> 2)) * GL_VS + hh * 64 + 16 * d + 4 * (F.lane & 3); vf[sg][d] = cat8(trread(p0), trread(p0 + 16 * GL_VS)); }
        const f32x4 zero4 = (f32x4){0.f, 0.f, 0.f, 0.f};
#pragma unroll
        for (int m = 0; m < 4; ++m) {
            const int t = 16 * m + lr;
#pragma unroll
            for (int sg = 0; sg < 2; ++sg) {
                f32x4 p0 = MFMA16(kf[2 * sg], qf[m], zero4), p1 = MFMA16(kf[2 * sg + 1], qf[m], zero4);
                float pv[8];
#pragma unroll
                for (int j = 0; j < 4; ++j) { const int s0 = 32 * sg + 4 * g + j, s1 = s0 + 16; pv[j] = (r ? s0 >= t : s0 <= t) ? p0[j] : 0.f; pv[4 + j] = (r ? s1 >= t : s1 <= t) ? p1[j] : 0.f; }
                const bf16x8 pf = pack8(pv);
#pragma unroll
                for (int d = 0; d < 4; ++d) o[m][d] = MFMA16(pf, vf[sg][d], o[m][d]);
            }
        }
        if constexpr (OUT) {
        __syncthreads();
        LAS float* ox = (LAS float*)(F.lds + GL_B);
        LAS bf16* ot = (LAS bf16*)(F.lds + GL_Q);
        LAS bf16* srg = (LAS bf16*)(F.lds + GL_V);
#pragma unroll
        for (int k = 0; k < 4; ++k) { const int i = F.tid + k * NTHR, t = i >> 5, pc = i & 31; *(LAS u32x4*)(srg + t * GL_VS + pc * 8) = rgate[k]; }
        if (r == 1) {
#pragma unroll
            for (int m = 0; m < 4; ++m)
#pragma unroll
                for (int d = 0; d < 4; ++d)
#pragma unroll
                    for (int j = 0; j < 4; ++j) ox[(hh * 64 + 16 * m + 4 * g + j) * 65 + 16 * d + lr] = o[m][d][j];
        }
        __syncthreads();
        if (r == 0) {
            const float* ng = a.in[I_GLANG] + L * 64;
            float gn[4];
#pragma unroll
            for (int d = 0; d < 4; ++d) gn[d] = ng[16 * d + lr];
#pragma unroll
            for (int m = 0; m < 4; ++m)
#pragma unroll
                for (int j = 0; j < 4; ++j) {
                    const int t = 16 * m + 4 * g + j; float v[4], ss = 0.f;
#pragma unroll
                    for (int d = 0; d < 4; ++d) { v[d] = o[m][d][j] + ox[(hh * 64 + t) * 65 + 16 * d + lr]; ss += v[d] * v[d]; }
                    ss += swz_xor<1>(ss); ss += swz_xor<2>(ss); ss += swz_xor<4>(ss); ss += swz_xor<8>(ss);
                    const float rs = rsqrtf(ss * (1.f / 64.f) + 1e-6f);
#pragma unroll
                    for (int d = 0; d < 4; ++d) { const float rg = bf2f(srg[t * GL_VS + hh * 64 + 16 * d + lr]); ot[t * 264 + hh * 64 + 16 * d + lr] = (bf16)f2bf(v[d] * rs * gn[d] * siluf_(rg)); }
                }
        }
        __syncthreads();
        bf16* MX = (bf16*)(F.ws + WS_MIX) + (size_t)tok0 * MW + 768;
        for (int i = F.tid; i < 2048; i += NTHR) { const int t = i >> 5, pc = i & 31; *(u32x4*)(MX + (size_t)t * MW + pc * 8) = *(const LAS u32x4*)(ot + t * 264 + pc * 8); }
        } else {
            bf16* QI = (bf16*)(F.ws + WS_GQI) + (size_t)tok0 * 256;
#pragma unroll
            for (int m = 0; m < 4; ++m) *(bf16x8*)(QI + (size_t)(16 * m + lr) * 256 + r * 128 + hh * 32 + 8 * g) = qf[m];
            __syncthreads();
            LAS float* ox = (LAS float*)(F.lds + GL_B);
            LAS bf16* ot = (LAS bf16*)(F.lds + GL_Q);
            if (r == 1) {
#pragma unroll
                for (int m = 0; m < 4; ++m)
#pragma unroll
                    for (int d = 0; d < 4; ++d)
#pragma unroll
                        for (int j = 0; j < 4; ++j) ox[(hh * 64 + 16 * m + 4 * g + j) * 65 + 16 * d + lr] = o[m][d][j];
            }
            __syncthreads();
            if (r == 0) {
#pragma unroll
                for (int m = 0; m < 4; ++m)
#pragma unroll
                    for (int d = 0; d < 4; ++d)
#pragma unroll
                        for (int j = 0; j < 4; ++j) { const int t = 16 * m + 4 * g + j; ot[t * 264 + hh * 64 + 16 * d + lr] = (bf16)f2bf(o[m][d][j] + ox[(hh * 64 + t) * 65 + 16 * d + lr]); }
            }
            __syncthreads();
            bf16* OI = (bf16*)(F.ws + WS_GOI) + (size_t)tok0 * 256;
            for (int i = F.tid; i < 2048; i += NTHR) { const int t = i >> 5, pc = i & 31; *(u32x4*)(OI + (size_t)t * 256 + pc * 8) = *(const LAS u32x4*)(ot + t * 264 + pc * 8); }
        }
    }
}


__device__ __forceinline__ void gla_light(Frame& F0, CArgs& a, int L, int cid) {
    LAUNDER_F(F0)
    const int tok0 = chunk_tok0(cid), hh = F.wave & 3, r = F.wave >> 2, lr = F.lane & 15, g = F.lane >> 4;
    const bf16* P = (const bf16*)(F.ws + WS_PBUF) + (size_t)tok0 * PW;
    const bf16* QI = (const bf16*)(F.ws + WS_GQI) + (size_t)tok0 * 256; const bf16* OI = (const bf16*)(F.ws + WS_GOI) + (size_t)tok0 * 256;
    const bf16* se = (const bf16*)(F.ws + WS_GSE) + (((size_t)cid * 4 + hh) * 2 + r) * 2048;
    u32x4 rgate[4], roi[4]; bf16x8 qf[4], sfr[4];
#pragma unroll
    for (int m = 0; m < 4; ++m) qf[m] = *(const bf16x8*)(QI + (size_t)(16 * m + lr) * 256 + r * 128 + hh * 32 + 8 * g);
#pragma unroll
    for (int d = 0; d < 4; ++d) sfr[d] = *(const bf16x8*)(se + (16 * d + lr) * 32 + 8 * g);
#pragma unroll
    for (int k = 0; k < 4; ++k) { const int i = F.tid + k * NTHR, t = i >> 5, pc = i & 31; rgate[k] = *(const u32x4*)(P + (size_t)t * PW + PC_R + pc * 8); roi[k] = *(const u32x4*)(OI + (size_t)t * 256 + pc * 8); }
    f32x4 o[4][4];
#pragma unroll
    for (int m = 0; m < 4; ++m)
#pragma unroll
        for (int d = 0; d < 4; ++d) o[m][d] = MFMA16(qf[m], sfr[d], ((f32x4){0.f, 0.f, 0.f, 0.f}));
    LAS float* ox = (LAS float*)(F.lds + GL_B);
    LAS bf16* srg = (LAS bf16*)(F.lds + GL_V);
    LAS bf16* soi = (LAS bf16*)(F.lds + GL_Q);
    __syncthreads();
#pragma unroll
    for (int k = 0; k < 4; ++k) { const int i = F.tid + k * NTHR, t = i >> 5, pc = i & 31; *(LAS u32x4*)(srg + t * GL_VS + pc * 8) = rgate[k]; *(LAS u32x4*)(soi + t * 264 + pc * 8) = roi[k]; }
    if (r == 1) {
#pragma unroll
        for (int m = 0; m < 4; ++m)
#pragma unroll
            for (int d = 0; d < 4; ++d)
#pragma unroll
                for (int j = 0; j < 4; ++j) ox[(hh * 64 + 16 * m + 4 * g + j) * 65 + 16 * d + lr] = o[m][d][j];
    }
    __syncthreads();
    if (r == 0) {
        const float* ng = a.in[I_GLANG] + L * 64;
        float gn[4];
#pragma unroll
        for (int d = 0; d < 4; ++d) gn[d] = ng[16 * d + lr];
#pragma unroll
        for (int m = 0; m < 4; ++m)
#pragma unroll
            for (int j = 0; j < 4; ++j) {
                const int t = 16 * m + 4 * g + j; float v[4], ss = 0.f;
#pragma unroll
                for (int d = 0; d < 4; ++d) { v[d] = o[m][d][j] + ox[(hh * 64 + t) * 65 + 16 * d + lr] + bf2f(soi[t * 264 + hh * 64 + 16 * d + lr]); ss += v[d] * v[d]; }
                ss += swz_xor<1>(ss); ss += swz_xor<2>(ss); ss += swz_xor<4>(ss); ss += swz_xor<8>(ss);
                const float rs = rsqrtf(ss * (1.f / 64.f) + 1e-6f);
#pragma unroll
                for (int d = 0; d < 4; ++d) { const int q = t * GL_VS + hh * 64 + 16 * d + lr; const float rg = bf2f(srg[q]); srg[q] = (bf16)f2bf(v[d] * rs * gn[d] * siluf_(rg)); }
            }
    }
    __syncthreads();
    bf16* MX = (bf16*)(F.ws + WS_MIX) + (size_t)tok0 * MW + 768;
    for (int i = F.tid; i < 2048; i += NTHR) { const int t = i >> 5, pc = i & 31; *(u32x4*)(MX + (size_t)t * MW + pc * 8) = *(const LAS u32x4*)(srg + t * GL_VS + pc * 8); }
}

constexpr int SD_RS = 520;
constexpr int SD_RAW = 0, SD_XC = SD_RAW + 68 * SD_RS * 2, SD_DT = SD_XC + 64 * SD_RS * 2, SD_CUM = SD_DT + 64 * 8 * 4, SD_W = SD_CUM + 8 * 64 * 4, SD_END = SD_W + 8 * 64 * 4;
static_assert(SD_END <= MISC_OFF && 64 * 260 * 4 <= 68 * SD_RS * 2, "SSD LDS");
template <int MODE> __device__ __forceinline__ void ssd_chunk(Frame& F0, CArgs& a, int L, int cid) {
    constexpr bool OUT = MODE == 1, DO_STATE = MODE == 0 || MODE == 2, DO_INTRA = MODE == 1 || MODE == 2;
    LAUNDER_F(F0)
    const int tok0 = chunk_tok0(cid);
    const bf16* PB = (const bf16*)(F.ws + WS_PBUF);
    LAS bf16* raw = (LAS bf16*)(F.lds + SD_RAW); LAS bf16* xc = (LAS bf16*)(F.lds + SD_XC); LAS float* sdt = (LAS float*)(F.lds + SD_DT); LAS float* scum = (LAS float*)(F.lds + SD_CUM); LAS float* sw = (LAS float*)(F.lds + SD_W);
    bf16x8 sfr[4][2];
    if constexpr (OUT) { const bf16* se = (const bf16*)(F.ws + WS_SSE) + (((size_t)cid * 4 + (F.wave & 3)) * 2 + (F.wave >> 2)) * 4096;
#pragma unroll
        for (int d = 0; d < 4; ++d) { sfr[d][0] = *(const bf16x8*)(se + (16 * d + (F.lane & 15)) * 64 + 8 * (F.lane >> 4)); sfr[d][1] = *(const bf16x8*)(se + (16 * d + (F.lane & 15)) * 64 + 32 + 8 * (F.lane >> 4)); } }
    __syncthreads();
    {
        const int isctx = cid >= 512, c4 = (cid - 512) & 3;
        u32x4 rv[9];
#pragma unroll
        for (int k = 0; k < 9; ++k) { const int i = F.tid + k * NTHR, rr = i >> 6, pc = i & 63, t = rr - 2; rv[k] = (u32x4){0u, 0u, 0u, 0u};
            bool ok = t >= 0 && t < 64 && i < 68 * 64; if (isctx) { const int tt = c4 * 64 + t; ok = tt >= 0 && tt < 256 && i < 68 * 64; }
            if (ok) rv[k] = *(const u32x4*)(PB + (size_t)(tok0 + t) * PW + PC_XBC + pc * 8); }
#pragma unroll
        for (int k = 0; k < 9; ++k) { const int i = F.tid + k * NTHR, rr = i >> 6, pc = i & 63; if (i < 68 * 64) *(LAS u32x4*)(raw + rr * SD_RS + pc * 8) = rv[k]; }
        if (F.tid < 64) { float dv[8]; unpack8(*(const bf16x8*)(PB + (size_t)(tok0 + F.tid) * PW + PC_DT), dv);
#pragma unroll
            for (int q = 0; q < 8; ++q) { const float z = dv[q] + a.in[I_SSDDTB][L * 8 + q]; sdt[F.tid * 8 + q] = z > 20.f ? z : __logf(1.f + __expf(z)); } }
    }
    __syncthreads();
    {
        const int ch = F.tid; float w[5];
#pragma unroll
        for (int k = 0; k < 5; ++k) w[k] = a.in[I_SSDCW][((size_t)L * 5 + k) * 512 + ch];
        const float cb = a.in[I_SSDCB][L * 512 + ch];
        float x0 = bf2f(raw[0 * SD_RS + ch]), x1 = bf2f(raw[1 * SD_RS + ch]), x2 = bf2f(raw[2 * SD_RS + ch]), x3 = bf2f(raw[3 * SD_RS + ch]);
        for (int t0 = 0; t0 < 64; t0 += 16) { float xv[16];
#pragma unroll
            for (int k = 0; k < 16; ++k) xv[k] = bf2f(raw[(t0 + k + 4) * SD_RS + ch]);
#pragma unroll
            for (int k = 0; k < 16; ++k) { const float x4 = xv[k]; const float y = cb + w[0] * x0 + w[1] * x1 + w[2] * x2 + w[3] * x3 + w[4] * x4;
                xc[(t0 + k) * SD_RS + ch] = (bf16)f2bf(siluf_(y)); x0 = x1; x1 = x2; x2 = x3; x3 = x4; } }
    }
    {
        const int q = F.wave, rr = q >> 2, t = rr ? 63 - F.lane : F.lane;
        const float aa = -__expf(a.in[I_SSDALOG][L * 8 + q]); const float dtv = sdt[t * 8 + q];
        float c = dtv * aa;
        { float o;
          o = __builtin_bit_cast(float, __builtin_amdgcn_ds_bpermute((F.lane - 1) << 2, __builtin_bit_cast(int, c))); if (F.lane >= 1) c += o;
          o = __builtin_bit_cast(float, __builtin_amdgcn_ds_bpermute((F.lane - 2) << 2, __builtin_bit_cast(int, c))); if (F.lane >= 2) c += o;
          o = __builtin_bit_cast(float, __builtin_amdgcn_ds_bpermute((F.lane - 4) << 2, __builtin_bit_cast(int, c))); if (F.lane >= 4) c += o;
          o = __builtin_bit_cast(float, __builtin_amdgcn_ds_bpermute((F.lane - 8) << 2, __builtin_bit_cast(int, c))); if (F.lane >= 8) c += o;
          o = __builtin_bit_cast(float, __builtin_amdgcn_ds_bpermute((F.lane - 16) << 2, __builtin_bit_cast(int, c))); if (F.lane >= 16) c += o;
          o = __builtin_bit_cast(float, __builtin_amdgcn_ds_bpermute((F.lane - 32) << 2, __builtin_bit_cast(int, c))); if (F.lane >= 32) c += o; }
        const float cl = __builtin_bit_cast(float, __builtin_amdgcn_ds_bpermute(63 << 2, __builtin_bit_cast(int, c)));
        scum[q * 64 + t] = c; sw[q * 64 + t] = __expf(cl - c) * dtv;
    }
    __syncthreads();
    const int h = F.wave & 3, r = F.wave >> 2, lr = F.lane & 15, g = F.lane >> 4, gp = h >> 1, rh = r * 4 + h;
    const size_t ub = ((size_t)cid * 4 + h) * 2 + r;
    if constexpr (DO_STATE) {
        f32x4 acc[4][4];
#pragma unroll
        for (int ms = 0; ms < 4; ++ms)
#pragma unroll
            for (int d = 0; d < 4; ++d) acc[ms][d] = (f32x4){0.f, 0.f, 0.f, 0.f};
#pragma unroll
        for (int sg = 0; sg < 2; ++sg) {
            const int trow = 32 * sg + 8 * g;
            bf16x8 xf[4];
#pragma unroll
            for (int d = 0; d < 4; ++d) { const LAS bf16* p0 = xc + (trow + ((F.lane & 15) >> 2)) * SD_RS + h * 64 + 16 * d + 4 * (F.lane & 3); xf[d] = cat8(trread(p0), trread(p0 + 4 * SD_RS)); }
            float wv[8];
            *(f32x4*)wv = *(const LAS f32x4*)(sw + rh * 64 + trow); *(f32x4*)(wv + 4) = *(const LAS f32x4*)(sw + rh * 64 + trow + 4);
#pragma unroll
            for (int ms = 0; ms < 4; ++ms) {
                const LAS bf16* p0 = xc + (trow + ((F.lane & 15) >> 2)) * SD_RS + 256 + gp * 64 + 16 * ms + 4 * (F.lane & 3);
                const s16x4 b0 = trread(p0), b1 = trread(p0 + 4 * SD_RS);
                float bv[8];
#pragma unroll
                for (int e = 0; e < 4; ++e) { bv[e] = bf2f((unsigned short)b0[e]) * wv[e]; bv[4 + e] = bf2f((unsigned short)b1[e]) * wv[4 + e]; }
                const bf16x8 bf = pack8(bv);
#pragma unroll
                for (int d = 0; d < 4; ++d) acc[ms][d] = MFMA16(bf, xf[d], acc[ms][d]);
            }
        }
        float* ds = (float*)(F.ws + WS_SDS) + ub * 4096;
#pragma unroll
        for (int ms = 0; ms < 4; ++ms)
#pragma unroll
            for (int d = 0; d < 4; ++d) *(f32x4*)(ds + (16 * d + lr) * 64 + 16 * ms + 4 * g) = acc[ms][d];
        if (F.lane == 0) ((float*)(F.ws + WS_SDEC))[ub] = __expf(scum[rh * 64 + (r ? 0 : 63)]);
    }
    if constexpr (DO_INTRA) {
        bf16x8 bfr[4][2], cfr[4][2];
#pragma unroll
        for (int m = 0; m < 4; ++m)
#pragma unroll
            for (int ks = 0; ks < 2; ++ks) { bfr[m][ks] = *(const LAS bf16x8*)(xc + (16 * m + lr) * SD_RS + 256 + gp * 64 + 32 * ks + 8 * g); cfr[m][ks] = *(const LAS bf16x8*)(xc + (16 * m + lr) * SD_RS + 384 + gp * 64 + 32 * ks + 8 * g); }
        f32x4 y[4][4];
#pragma unroll
        for (int m = 0; m < 4; ++m)
#pragma unroll
            for (int d = 0; d < 4; ++d) y[m][d] = (f32x4){0.f, 0.f, 0.f, 0.f};
        if constexpr (OUT) {
            bf16x8 cs[4][2];
#pragma unroll
            for (int m = 0; m < 4; ++m) { const float ec = __expf(scum[rh * 64 + 16 * m + lr]);
#pragma unroll
                for (int ks = 0; ks < 2; ++ks) { float cv[8]; unpack8(cfr[m][ks], cv);
#pragma unroll
                    for (int e = 0; e < 8; ++e) cv[e] *= ec;
                    cs[m][ks] = pack8(cv); } }
#pragma unroll
            for (int d = 0; d < 4; ++d) {
#pragma unroll
                for (int m = 0; m < 4; ++m) { y[m][d] = MFMA16(cs[m][0], sfr[d][0], y[m][d]); y[m][d] = MFMA16(cs[m][1], sfr[d][1], y[m][d]); }
            }
        }
        asm volatile("" ::: "memory");
        bf16x8 xf[2][4];
#pragma unroll
        for (int sg = 0; sg < 2; ++sg)
#pragma unroll
            for (int d = 0; d < 4; ++d) { const LAS bf16* p0 = xc + (32 * sg + 4 * g + ((F.lane & 15) >> 2)) * SD_RS + h * 64 + 16 * d + 4 * (F.lane & 3); xf[sg][d] = cat8(trread(p0), trread(p0 + 16 * SD_RS)); }
        const f32x4 zero4 = (f32x4){0.f, 0.f, 0.f, 0.f};
#pragma unroll
        for (int m = 0; m < 4; ++m) {
            const int t = 16 * m + lr; const float ct = scum[rh * 64 + t];
#pragma unroll
            for (int sg = 0; sg < 2; ++sg) {
                f32x4 p0 = MFMA16(bfr[2 * sg][0], cfr[m][0], zero4), p1 = MFMA16(bfr[2 * sg + 1][0], cfr[m][0], zero4);
                p0 = MFMA16(bfr[2 * sg][1], cfr[m][1], p0); p1 = MFMA16(bfr[2 * sg + 1][1], cfr[m][1], p1);
                float pv[8];
#pragma unroll
                for (int j = 0; j < 4; ++j) { const int s0 = 32 * sg + 4 * g + j, s1 = s0 + 16;
                    pv[j] = (r ? s0 >= t : s0 <= t) ? p0[j] * __expf(ct - scum[rh * 64 + s0]) * sdt[s0 * 8 + rh] : 0.f;
                    pv[4 + j] = (r ? s1 >= t : s1 <= t) ? p1[j] * __expf(ct - scum[rh * 64 + s1]) * sdt[s1 * 8 + rh] : 0.f; }
                const bf16x8 pf = pack8(pv);
#pragma unroll
                for (int d = 0; d < 4; ++d) y[m][d] = MFMA16(pf, xf[sg][d], y[m][d]);
            }
        }
        __syncthreads();
        LAS float* yx = (LAS float*)(F.lds + SD_RAW);
        if (r == 1) {
#pragma unroll
            for (int m = 0; m < 4; ++m)
#pragma unroll
                for (int d = 0; d < 4; ++d)
#pragma unroll
                    for (int j = 0; j < 4; ++j) yx[(16 * m + 4 * g + j) * 260 + h * 64 + 16 * d + lr] = y[m][d][j];
        }
        __syncthreads();
        if (r == 0) { const float dsk = a.in[I_SSDD][L * 4 + h];
#pragma unroll
            for (int m = 0; m < 4; ++m)
#pragma unroll
                for (int d = 0; d < 4; ++d)
#pragma unroll
                    for (int j = 0; j < 4; ++j) { const int t = 16 * m + 4 * g + j, c = h * 64 + 16 * d + lr; yx[t * 260 + c] += y[m][d][j] + dsk * bf2f(xc[t * SD_RS + c]); asm volatile("" ::: "memory"); }
        }
        __syncthreads();
        if constexpr (OUT) {
        { const int t = F.tid >> 3, c0 = (F.tid & 7) * 32; const bf16* zr = PB + (size_t)(tok0 + t) * PW + PC_Z + c0; const float* ng = a.in[I_SSDNG] + L * 256 + c0;
          float v[32]; float ss = 0.f;
#pragma unroll
          for (int q = 0; q < 4; ++q) { float zv[8]; unpack8(*(const bf16x8*)(zr + 8 * q), zv);
#pragma unroll
              for (int e = 0; e < 8; ++e) { const float u = yx[t * 260 + c0 + 8 * q + e] * siluf_(zv[e]); v[8 * q + e] = u; ss += u * u; } }
          ss += swz_xor<1>(ss); ss += swz_xor<2>(ss); ss += swz_xor<4>(ss);
          const float rs = rsqrtf(ss * (1.f / 256.f) + 1e-6f);
          bf16* MX = (bf16*)(F.ws + WS_MIX) + (size_t)(tok0 + t) * MW + 1024 + c0;
#pragma unroll
          for (int q = 0; q < 4; ++q) { float o8[8];
#pragma unroll
              for (int e = 0; e < 8; ++e) o8[e] = v[8 * q + e] * rs * ng[8 * q + e];
              *(bf16x8*)(MX + 8 * q) = pack8(o8); } }
        } else {
            { const int t = F.tid >> 3, c0 = (F.tid & 7) * 32; bf16* yo = (bf16*)(F.ws + WS_SYI) + (size_t)(tok0 + t) * 256 + c0;
#pragma unroll
              for (int q = 0; q < 4; ++q) { float o8[8];
#pragma unroll
                  for (int e = 0; e < 8; ++e) o8[e] = yx[t * 260 + c0 + 8 * q + e];
                  *(bf16x8*)(yo + 8 * q) = pack8(o8); } }
            { bf16* cb = (bf16*)(F.ws + WS_SCB) + (size_t)tok0 * 128;
#pragma unroll
              for (int k = 0; k < 2; ++k) { const int i = F.tid + k * NTHR, t = i >> 4, pc = i & 15; *(u32x4*)(cb + (size_t)t * 128 + pc * 8) = *(const LAS u32x4*)(xc + t * SD_RS + 384 + pc * 8); } }
            { const int t = F.tid >> 3, q = F.tid & 7; ((float*)(F.ws + WS_SCUM))[(size_t)(tok0 + t) * 8 + q] = scum[q * 64 + t]; }
        }
    }
}


__device__ __forceinline__ void ssd_light(Frame& F0, CArgs& a, int L, int cid) {
    LAUNDER_F(F0)
    const int tok0 = chunk_tok0(cid), h = F.wave & 3, r = F.wave >> 2, lr = F.lane & 15, g = F.lane >> 4, gp = h >> 1, rh = r * 4 + h;
    const bf16* cb = (const bf16*)(F.ws + WS_SCB) + (size_t)tok0 * 128; const float* cum = (const float*)(F.ws + WS_SCUM) + (size_t)tok0 * 8;
    const bf16* se = (const bf16*)(F.ws + WS_SSE) + (((size_t)cid * 4 + h) * 2 + r) * 4096;
    bf16x8 cfr[4][2], sfr[4][2]; float ec[4];
#pragma unroll
    for (int m = 0; m < 4; ++m) { ec[m] = cum[(size_t)(16 * m + lr) * 8 + rh];
#pragma unroll
        for (int ks = 0; ks < 2; ++ks) cfr[m][ks] = *(const bf16x8*)(cb + (size_t)(16 * m + lr) * 128 + gp * 64 + 32 * ks + 8 * g); }
#pragma unroll
    for (int d = 0; d < 4; ++d) { sfr[d][0] = *(const bf16x8*)(se + (16 * d + lr) * 64 + 8 * g); sfr[d][1] = *(const bf16x8*)(se + (16 * d + lr) * 64 + 32 + 8 * g); }
    const int tt = F.tid >> 3, c0 = (F.tid & 7) * 32;
    bf16x8 zr[4], yi[4];
    { const bf16* zp = (const bf16*)(F.ws + WS_PBUF) + (size_t)(tok0 + tt) * PW + PC_Z + c0; const bf16* yp = (const bf16*)(F.ws + WS_SYI) + (size_t)(tok0 + tt) * 256 + c0;
#pragma unroll
      for (int q = 0; q < 4; ++q) { zr[q] = *(const bf16x8*)(zp + 8 * q); yi[q] = *(const bf16x8*)(yp + 8 * q); } }
    f32x4 y[4][4];
#pragma unroll
    for (int m = 0; m < 4; ++m) { const float e_ = __expf(ec[m]); bf16x8 cs[2];
#pragma unroll
        for (int ks = 0; ks < 2; ++ks) { float cv[8]; unpack8(cfr[m][ks], cv);
#pragma unroll
            for (int e = 0; e < 8; ++e) cv[e] *= e_;
            cs[ks] = pack8(cv); }
#pragma unroll
        for (int d = 0; d < 4; ++d) { y[m][d] = MFMA16(cs[0], sfr[d][0], ((f32x4){0.f, 0.f, 0.f, 0.f})); y[m][d] = MFMA16(cs[1], sfr[d][1], y[m][d]); } }
    LAS float* yx = (LAS float*)(F.lds + SD_RAW);
    __syncthreads();
    if (r == 1) {
#pragma unroll
        for (int m = 0; m < 4; ++m)
#pragma unroll
            for (int d = 0; d < 4; ++d)
#pragma unroll
                for (int j = 0; j < 4; ++j) yx[(16 * m + 4 * g + j) * 260 + h * 64 + 16 * d + lr] = y[m][d][j];
    }
    __syncthreads();
    if (r == 0) {
#pragma unroll
        for (int m = 0; m < 4; ++m)
#pragma unroll
            for (int d = 0; d < 4; ++d)
#pragma unroll
                for (int j = 0; j < 4; ++j) yx[(16 * m + 4 * g + j) * 260 + h * 64 + 16 * d + lr] += y[m][d][j];
    }
    __syncthreads();
    { const float* ng = a.in[I_SSDNG] + L * 256 + c0;
      float v[32]; float ss = 0.f;
#pragma unroll
      for (int q = 0; q < 4; ++q) { float zv[8], yv[8]; unpack8(zr[q], zv); unpack8(yi[q], yv);
#pragma unroll
          for (int e = 0; e < 8; ++e) { const float u = (yx[tt * 260 + c0 + 8 * q + e] + yv[e]) * siluf_(zv[e]); v[8 * q + e] = u; ss += u * u; } }
      ss += swz_xor<1>(ss); ss += swz_xor<2>(ss); ss += swz_xor<4>(ss);
      const float rs = rsqrtf(ss * (1.f / 256.f) + 1e-6f);
      bf16* MX = (bf16*)(F.ws + WS_MIX) + (size_t)(tok0 + tt) * MW + 1024 + c0;
#pragma unroll
      for (int q = 0; q < 4; ++q) { float o8[8];
#pragma unroll
          for (int e = 0; e < 8; ++e) o8[e] = v[8 * q + e] * rs * ng[8 * q + e];
          *(bf16x8*)(MX + 8 * q) = pack8(o8); } }
}

constexpr int FF_XP = 0, FF_TR = FF_XP + 16 * 64 * 16 * 2, FF_TI = FF_TR + 16 * 64 * 16 * 2, FF_TW = FF_TI + 16 * 64 * 16 * 2, FF_FT = FF_TW + 64 * 16 * 8, FF_END = FF_FT + 2 * 64 * 72 * 2;
static_assert(FF_END <= MISC_OFF, "FFT LDS");
__device__ __forceinline__ void fft_unit(Frame& F0, int u) {
    LAUNDER_F(F0)
    const int b = u >> 6, cg = (u >> 2) & 15, kb = u & 3, lr = F.lane & 15, g = F.lane >> 4;
    const bf16* PB = (const bf16*)(F.ws + WS_PBUF) + (size_t)b * SEQ * PW + PC_FU + 16 * cg;
    const bf16* f64 = (const bf16*)(F.ws + WS_TAB + TAB_F64); const float* tw = (const float*)(F.ws + WS_TAB + TAB_TW);
    LAS bf16* xp = (LAS bf16*)(F.lds + FF_XP); LAS bf16* tr = (LAS bf16*)(F.lds + FF_TR); LAS bf16* ti = (LAS bf16*)(F.lds + FF_TI);
    LAS float* stw = (LAS float*)(F.lds + FF_TW);
    LAS bf16* sft = (LAS bf16*)(F.lds + FF_FT);
    bf16x8 fc1[2], fs1[2];
#pragma unroll
    for (int ks = 0; ks < 2; ++ks) { fc1[ks] = *(const bf16x8*)(f64 + (16 * kb + lr) * 64 + 32 * ks + 8 * g); fs1[ks] = *(const bf16x8*)(f64 + 4096 + (16 * kb + lr) * 64 + 32 * ks + 8 * g); }
    const f32x4 zero4 = (f32x4){0.f, 0.f, 0.f, 0.f};
    u32x4 xr[4], ft[2]; f32x2 twr[2];
#pragma unroll
    for (int k = 0; k < 4; ++k) { const int i = F.tid + k * NTHR, n2l = i >> 7, n1 = (i >> 1) & 63, hf = i & 1; xr[k] = *(const u32x4*)(PB + (size_t)(64 * n1 + n2l) * PW + hf * 8); }
#pragma unroll
    for (int k = 0; k < 2; ++k) { const int i = F.tid + k * NTHR; ft[k] = *(const u32x4*)(f64 + (size_t)i * 8); twr[k] = *(const f32x2*)(tw + 2 * ((i >> 4) * (16 * kb + (i & 15)))); }
    __syncthreads();
#pragma unroll
    for (int k = 0; k < 2; ++k) { const int i = F.tid + k * NTHR, row = i >> 3, pc = i & 7; *(LAS u32x4*)(sft + row * 72 + pc * 8) = ft[k]; stw[2 * i] = twr[k][0]; stw[2 * i + 1] = twr[k][1]; }
    for (int pa = 0; pa < 4; ++pa) {
        if (pa) __syncthreads();
#pragma unroll
        for (int k = 0; k < 4; ++k) { const int i = F.tid + k * NTHR, n2l = i >> 7, n1 = (i >> 1) & 63, hf = i & 1; *(LAS u32x4*)(xp + (n2l * 64 + n1) * 16 + hf * 8) = xr[k]; }
        if (pa < 3) {
#pragma unroll
            for (int k = 0; k < 4; ++k) { const int i = F.tid + k * NTHR, n2l = i >> 7, n1 = (i >> 1) & 63, hf = i & 1; xr[k] = *(const u32x4*)(PB + (size_t)(64 * n1 + 16 * (pa + 1) + n2l) * PW + hf * 8); }
        }
        __syncthreads();
#pragma unroll
        for (int q = 0; q < 2; ++q) {
            const int n2l = 2 * F.wave + q, n2 = 16 * pa + n2l;
            f32x4 tc = zero4, ts = zero4;
#pragma unroll
            for (int ks = 0; ks < 2; ++ks) { const LAS bf16* p0 = xp + (n2l * 64 + 32 * ks + 8 * g + ((F.lane & 15) >> 2)) * 16 + 4 * (F.lane & 3); const bf16x8 xb = cat8(trread(p0), trread(p0 + 4 * 16));
                tc = MFMA16(fc1[ks], xb, tc); ts = MFMA16(fs1[ks], xb, ts); }
#pragma unroll
            for (int j = 0; j < 4; ++j) { const int k1l = 4 * g + j; const f32x2 w = *(const LAS f32x2*)(stw + 2 * (n2 * 16 + k1l));
                tr[(k1l * 64 + n2) * 16 + lr] = (bf16)f2bf(tc[j] * w[0] - ts[j] * w[1]); ti[(k1l * 64 + n2) * 16 + lr] = (bf16)f2bf(-(tc[j] * w[1] + ts[j] * w[0])); }
        }
    }
    __syncthreads();
    bf16* MX0 = (bf16*)(F.ws + WS_MIX) + (size_t)b * SEQ * MW + 16 * cg;
    LAS bf16* so = xp + F.wave * 2048;
#pragma unroll
    for (int q = 0; q < 2; ++q) {
        const int k1l = 2 * F.wave + q, k1 = 16 * kb + k1l;
        bf16x8 br[2], bi[2];
#pragma unroll
        for (int ks = 0; ks < 2; ++ks) { const int off = (k1l * 64 + 32 * ks + 8 * g + ((F.lane & 15) >> 2)) * 16 + 4 * (F.lane & 3); br[ks] = cat8(trread(tr + off), trread(tr + off + 64)); bi[ks] = cat8(trread(ti + off), trread(ti + off + 64)); }
#pragma unroll
        for (int m = 0; m < 4; ++m) {
            f32x4 yr = zero4, y1 = zero4, y2 = zero4;
#pragma unroll
            for (int ks = 0; ks < 2; ++ks) { const bf16x8 fc = *(const LAS bf16x8*)(sft + (16 * m + lr) * 72 + 32 * ks + 8 * g), fs = *(const LAS bf16x8*)(sft + (64 + 16 * m + lr) * 72 + 32 * ks + 8 * g);
                yr = MFMA16(fc, br[ks], yr); yr = MFMA16(fs, bi[ks], yr); y1 = MFMA16(fc, bi[ks], y1); y2 = MFMA16(fs, br[ks], y2); }
#pragma unroll
            for (int j = 0; j < 4; ++j) { const int k2 = 16 * m + 4 * g + j; so[k2 * 32 + lr] = (bf16)f2bf(yr[j] * (1.f / 64.f)); so[k2 * 32 + 16 + lr] = (bf16)f2bf((y1[j] - y2[j]) * (1.f / 64.f)); }
        }
#pragma unroll
        for (int p = 0; p < 4; ++p) { const int pc = F.lane + 64 * p, k2 = pc >> 2, part = pc & 3;
            const u32x4 v = *(const LAS u32x4*)(so + k2 * 32 + (part >> 1) * 16 + (part & 1) * 8);
            *(u32x4*)(MX0 + (size_t)(64 * k2 + k1) * MW + (part >> 1) * 256 + (part & 1) * 8) = v; }
    }
}
constexpr int CD_RS = 264;
static_assert(256 * CD_RS * 2 <= MISC_OFF, "ctx DFT LDS");
__device__ __forceinline__ void dft_ctx_unit(Frame& F0, int u) {
    LAUNDER_F(F0)
    const int b = u >> 3, kb = u & 7, lr = F.lane & 15, g = F.lane >> 4;
    LAS bf16* sl = (LAS bf16*)F.lds;
    const bf16* PB = (const bf16*)(F.ws + WS_PBUF) + (size_t)(NLAT + b * CTXL) * PW + PC_FU;
    const bf16* dc = (const bf16*)(F.ws + WS_DFTC);
    __syncthreads();
#pragma unroll
    for (int h = 0; h < 2; ++h) { u32x4 v[8];
#pragma unroll
        for (int k = 0; k < 8; ++k) { const int i = F.tid + (h * 8 + k) * NTHR, n = i >> 5, pc = i & 31; v[k] = *(const u32x4*)(PB + (size_t)n * PW + pc * 8); }
#pragma unroll
        for (int k = 0; k < 8; ++k) { const int i = F.tid + (h * 8 + k) * NTHR, n = i >> 5, pc = i & 31; *(LAS u32x4*)(sl + n * CD_RS + pc * 8) = v[k]; } }
    __syncthreads();
    f32x4 acc[4][2];
#pragma unroll
    for (int mt = 0; mt < 4; ++mt)
#pragma unroll
        for (int nt = 0; nt < 2; ++nt) acc[mt][nt] = (f32x4){0.f, 0.f, 0.f, 0.f};
#pragma unroll 2
    for (int ks = 0; ks < 8; ++ks) {
        bf16x8 af[4], bfm[2];
#pragma unroll
        for (int mt = 0; mt < 4; ++mt) af[mt] = *(const bf16x8*)(dc + (size_t)((mt >> 1) * 256 + 32 * kb + 16 * (mt & 1) + lr) * 256 + 32 * ks + 8 * g);
#pragma unroll
        for (int nt = 0; nt < 2; ++nt) { const LAS bf16* p0 = sl + (32 * ks + 8 * g + ((F.lane & 15) >> 2)) * CD_RS + 32 * F.wave + 16 * nt + 4 * (F.lane & 3); bfm[nt] = cat8(trread(p0), trread(p0 + 4 * CD_RS)); }
#pragma unroll
        for (int mt = 0; mt < 4; ++mt)
#pragma unroll
            for (int nt = 0; nt < 2; ++nt) acc[mt][nt] = MFMA16(af[mt], bfm[nt], acc[mt][nt]);
    }
    bf16* MX = (bf16*)(F.ws + WS_MIX) + (size_t)(NLAT + b * CTXL + 32 * kb) * MW + 32 * F.wave + lr;
#pragma unroll
    for (int mt = 0; mt < 4; ++mt)
#pragma unroll
        for (int nt = 0; nt < 2; ++nt)
#pragma unroll
            for (int j = 0; j < 4; ++j) MX[(size_t)(16 * (mt & 1) + 4 * g + j) * MW + (mt >> 1) * 256 + 16 * nt] = (bf16)f2bf(acc[mt][nt][j] * (1.f / 16.f));
}

#ifndef SUBMASK
#define SUBMASK 0xFFFF
#endif
#define SUB(bit) (rep == 0 || ((SUBMASK >> (bit)) & 1))
__device__ __forceinline__ void p_mix_a(Frame& F, CArgs& a, int L, int rep = 0) {
    if (SUB(0)) {
        pg8::Gemm g{(const bf16*)(F.ws + WS_A2), (const bf16*)(F.ws + WS_S5P) + (size_t)L * 16 * 256 * 256, 1024, 512, OPQ(256)};
        SgOrder<FillS5> S; S.init(144, 1, F.G, F.bid); S.f = FillS5{(size_t)256 * 256 * 2};
        EpiS5S E{(float*)(F.ws + WS_S5S)};
        pg8::gemm_phase(F.lds, g, S, E, fresh_tid(F.wave));
    }
    const int og = F.G >= 208 ? 144 : 0, os = F.G >= 208 ? 176 : 32 % F.G;
    if (SUB(1)) for (int u = (F.bid + F.G - og) % F.G; u < NCHK; u += F.G) gla_chunk<MIX_P1 ? 2 : 0>(F, a, L, u);
    if (SUB(2)) for (int u = (F.bid + F.G - os) % F.G; u < NCHK; u += F.G) ssd_chunk<MIX_P1 ? 2 : 0>(F, a, L, u);
    __syncthreads();
}
__device__ __forceinline__ void p_mix_b(Frame& F, CArgs& a, int L, int rep = 0) {
    if (SUB(3)) for (int u = F.bid; u < 256; u += F.G) {
        const int vz = F.tid >> 9, uv = u + vz, wv = (F.tid >> 6);
        const int b = uv >> 5, g = (uv >> 1) & 15, r = uv & 1;
        const f32x2 a16 = *(const f32x2*)((const float*)(F.ws + WS_A16) + ((size_t)((L * 2 + r) * 16 + g) * 64 + F.lane) * 2);
        const float* S = (const float*)(F.ws + WS_S5S) + (size_t)g * S5ROWS * 256 + r * 128 + F.lane; bf16* A2 = (bf16*)(F.ws + WS_A2) + (size_t)g * S5ROWS * 512 + 256 + r * 128 + F.lane;
        LAS float* ex = (LAS float*)F.lds;
        LAS float* sl = ex + 17 * 128;
        __syncthreads();
#pragma unroll 1
        for (int sg = wv; sg < 17; sg += 8) {
            float sr[16], si[16];
#pragma unroll
            for (int n = 0; n < 16; ++n) { const int i = 16 * sg + n; const int row = i < 16 ? 2048 + 16 * b + (r ? 15 - i : i) : 256 * b + (r ? 271 - i : i - 16); sr[n] = S[(size_t)row * 256]; si[n] = S[(size_t)row * 256 + 64]; }
            float hr = 0.f, hi = 0.f;
#pragma unroll
            for (int n = 0; n < 16; ++n) { sl[((16 * sg + n) * 64 + F.lane) * 2] = sr[n]; sl[((16 * sg + n) * 64 + F.lane) * 2 + 1] = si[n];
                const float nr = a16[0] * hr - a16[1] * hi + sr[n], ni = a16[0] * hi + a16[1] * hr + si[n]; hr = nr; hi = ni; }
            ex[(sg * 64 + F.lane) * 2] = hr; ex[(sg * 64 + F.lane) * 2 + 1] = hi;
        }
        __syncthreads();
        float pr = a16[0], pi = a16[1];
#pragma unroll
        for (int q = 0; q < 4; ++q) { const float nr = pr * pr - pi * pi, ni = 2.f * pr * pi; pr = nr; pi = ni; }
#pragma unroll 1
        for (int sg = wv; sg < 17; sg += 8) {
            float hr = 0.f, hi = 0.f;
            for (int j = 0; j < sg; ++j) { const float er = ex[(j * 64 + F.lane) * 2], ei = ex[(j * 64 + F.lane) * 2 + 1]; const float nr = pr * hr - pi * hi + er, ni = pr * hi + pi * hr + ei; hr = nr; hi = ni; }
#pragma unroll 4
            for (int n = 0; n < 16; ++n) { const int i = 16 * sg + n; const int row = i < 16 ? 2048 + 16 * b + (r ? 15 - i : i) : 256 * b + (r ? 271 - i : i - 16);
                A2[(size_t)row * 512] = (bf16)f2bf(hr); A2[(size_t)row * 512 + 64] = (bf16)f2bf(hi);
                const float xr_ = sl[(i * 64 + F.lane) * 2], xi_ = sl[(i * 64 + F.lane) * 2 + 1];
                const float nr = a16[0] * hr - a16[1] * hi + xr_, ni = a16[0] * hi + a16[1] * hr + xi_; hr = nr; hi = ni; }
        }
    }
    if (F.G == 256) {
        if (SUB(3)) { const int vz = F.tid >> 9;
            const int ug = F.bid + vz, sqg = ug >> 2, bg = sqg >> 3, hg = (sqg >> 1) & 3, rg = sqg & 1, eg = (ug & 3) * 512 + F.tid, cg = eg & 31;
            const int u0 = F.bid + vz, s0q = u0 >> 3, b0 = s0q >> 3, h0 = (s0q >> 1) & 3, r0 = s0q & 1, e0 = (u0 & 7) * 512 + F.tid;
            const int u1 = F.bid + 256 + vz, s1q = u1 >> 3, b1 = s1q >> 3, h1 = (s1q >> 1) & 3, r1 = s1q & 1, e1 = (u1 & 7) * 512 + F.tid;
            const float* gds = (const float*)(F.ws + WS_GDS); const float* gdc = (const float*)(F.ws + WS_GDEC); bf16* gse = (bf16*)(F.ws + WS_GSE);
            const float* sds = (const float*)(F.ws + WS_SDS); const float* sdc = (const float*)(F.ws + WS_SDEC); bf16* sse = (bf16*)(F.ws + WS_SSE);
            float sg_ = 0.f, s0_ = 0.f, s1_ = 0.f;
#define SCAN_CID(i, b, r) ((i) < 4 ? 512 + (b) * 4 + ((r) ? 3 - (i) : (i)) : (b) * 64 + ((r) ? 67 - (i) : (i) - 4))
            for (int i0 = 0; i0 < 68; i0 += 17) { float gv_[17], gc_[17], av_[17], ac_[17], bv_[17], bc_[17];
#pragma unroll
                for (int k = 0; k < 17; ++k) { const int i = i0 + k;
                    { const size_t ub = ((size_t)SCAN_CID(i, bg, rg) * 4 + hg) * 2 + rg; gv_[k] = gds[ub * 2048 + eg]; gc_[k] = gdc[ub * 32 + cg]; }
                    { const size_t ub = ((size_t)SCAN_CID(i, b0, r0) * 4 + h0) * 2 + r0; av_[k] = sds[ub * 4096 + e0]; ac_[k] = sdc[ub]; }
                    { const size_t ub = ((size_t)SCAN_CID(i, b1, r1) * 4 + h1) * 2 + r1; bv_[k] = sds[ub * 4096 + e1]; bc_[k] = sdc[ub]; } }
#pragma unroll
                for (int k = 0; k < 17; ++k) { const int i = i0 + k;
                    { const size_t ub = ((size_t)SCAN_CID(i, bg, rg) * 4 + hg) * 2 + rg; gse[ub * 2048 + eg] = (bf16)f2bf(sg_); sg_ = gc_[k] * sg_ + gv_[k]; }
                    { const size_t ub = ((size_t)SCAN_CID(i, b0, r0) * 4 + h0) * 2 + r0; sse[ub * 4096 + e0] = (bf16)f2bf(s0_); s0_ = ac_[k] * s0_ + av_[k]; }
                    { const size_t ub = ((size_t)SCAN_CID(i, b1, r1) * 4 + h1) * 2 + r1; sse[ub * 4096 + e1] = (bf16)f2bf(s1_); s1_ = bc_[k] * s1_ + bv_[k]; } } }
#undef SCAN_CID
        }
    } else {
    if (SUB(3)) for (int u = F.bid; u < 256; u += F.G) { const int uv = u + (F.tid >> 9), sq = uv >> 2, b = sq >> 3, hh = (sq >> 1) & 3, r = sq & 1, e = (uv & 3) * 512 + F.tid, c = e & 31;
        const float* ds = (const float*)(F.ws + WS_GDS); const float* dc = (const float*)(F.ws + WS_GDEC); bf16* se = (bf16*)(F.ws + WS_GSE);
        float s = 0.f;
        for (int i0 = 0; i0 < 68; i0 += 17) { float dv[17], cv[17];
#pragma unroll
            for (int k = 0; k < 17; ++k) { const int i = i0 + k; const int cid = i < 4 ? 512 + b * 4 + (r ? 3 - i : i) : b * 64 + (r ? 67 - i : i - 4); const size_t ub = ((size_t)cid * 4 + hh) * 2 + r; dv[k] = ds[ub * 2048 + e]; cv[k] = dc[ub * 32 + c]; }
#pragma unroll
            for (int k = 0; k < 17; ++k) { const int i = i0 + k; const int cid = i < 4 ? 512 + b * 4 + (r ? 3 - i : i) : b * 64 + (r ? 67 - i : i - 4); const size_t ub = ((size_t)cid * 4 + hh) * 2 + r; se[ub * 2048 + e] = (bf16)f2bf(s); s = cv[k] * s + dv[k]; } } }
    if (SUB(3)) for (int u = F.bid; u < 512; u += F.G) { const int uv = u + (F.tid >> 9), sq = uv >> 3, b = sq >> 3, h = (sq >> 1) & 3, r = sq & 1, e = (uv & 7) * 512 + F.tid;
        const float* ds = (const float*)(F.ws + WS_SDS); const float* dc = (const float*)(F.ws + WS_SDEC); bf16* se = (bf16*)(F.ws + WS_SSE);
        float s = 0.f;
        for (int i0 = 0; i0 < 68; i0 += 17) { float dv[17], cv[17];
#pragma unroll
            for (int k = 0; k < 17; ++k) { const int i = i0 + k; const int cid = i < 4 ? 512 + b * 4 + (r ? 3 - i : i) : b * 64 + (r ? 67 - i : i - 4); const size_t ub = ((size_t)cid * 4 + h) * 2 + r; dv[k] = ds[ub * 4096 + e]; cv[k] = dc[ub]; }
#pragma unroll
            for (int k = 0; k < 17; ++k) { const int i = i0 + k; const int cid = i < 4 ? 512 + b * 4 + (r ? 3 - i : i) : b * 64 + (r ? 67 - i : i - 4); const size_t ub = ((size_t)cid * 4 + h) * 2 + r; se[ub * 4096 + e] = (bf16)f2bf(s); s = cv[k] * s + dv[k]; } } }
    }
    if (SUB(4)) for (int u = F.bid; u < 512; u += F.G) fft_unit(F, u);
    if (SUB(5)) for (int u = (F.bid + 64) % F.G; u < 64; u += F.G) dft_ctx_unit(F, u);
    __syncthreads();
}
__device__ __forceinline__ void p_mix_c(Frame& F, CArgs& a, int L, int rep = 0) {
#ifndef MIXC_PARTS
#define MIXC_PARTS 7
#endif
    if ((MIXC_PARTS & 1) && SUB(6)) {
        pg8::Gemm g{(const bf16*)(F.ws + WS_A2), (const bf16*)(F.ws + WS_S5B2) + (size_t)L * 16 * 256 * 512, 1024, 1024, OPQ(512)};
        SgOrder<FillS5> S; S.init(144, 1, F.G, F.bid); S.f = FillS5{(size_t)256 * 512 * 2};
        EpiS5Y E{(bf16*)(F.ws + WS_ACT5)};
        pg8::gemm_phase(F.lds, g, S, E, fresh_tid(F.wave));
    }
    const int nch = (L == DEPTH - 1) ? 512 : NCHK;
    const int og = F.G >= 208 ? 144 : 0, os = F.G >= 208 ? 176 : 32 % F.G;
    if ((MIXC_PARTS & 2) && SUB(7)) for (int u = (F.bid + F.G - og) % F.G; u < nch; u += F.G) { if constexpr (MIX_P1) gla_light(F, a, L, u); else gla_chunk<1>(F, a, L, u); }
    if ((MIXC_PARTS & 4) && SUB(8)) for (int u = (F.bid + F.G - os) % F.G; u < nch; u += F.G) { if constexpr (MIX_P1) ssd_light(F, a, L, u); else ssd_chunk<1>(F, a, L, u); }
    __syncthreads();
}

constexpr int NPH = 11, PH_TOTAL = 2 + DEPTH * NPH;
#ifndef PHASE_MASK
#define PHASE_MASK 0xFFFF
#endif
#define PM(i) ((PHASE_MASK >> (i)) & 1)
#ifndef DUP_MASK
#define DUP_MASK 0
#endif
#define NREP(k) (((DUP_MASK >> (k)) & 1) ? 2 : 1)
#ifndef MK_ONE_LAUNCH
#define MK_ONE_LAUNCH 0
#endif

__global__ void __launch_bounds__(NTHR, 2) mk_fwd(Args args_by_value) {
#define args (*fresh_args())
    extern __shared__ __attribute__((aligned(16))) unsigned char lds_raw[];
    Frame F;
    F.lds = (LAS unsigned char*)lds_raw; F.MISC = (volatile LAS unsigned*)(F.lds + MISC_OFF);
    F.tid = threadIdx.x; F.lane = F.tid & 63; F.wave = __builtin_amdgcn_readfirstlane(F.tid >> 6); F.G = gridDim.x; F.bid = blockIdx.x;
    F.ws = args_by_value.ws; F.ctl = (unsigned*)(args_by_value.ws + WS_CTL);
    if (F.tid < 64) F.MISC[F.tid] = 0u;
    __syncthreads();
#if MK_ONE_LAUNCH
    XcdBarrier bar = xcd_barrier_post(F.ctl + CW_BAR, F.MISC + 8);
#define GRID_BAR() xcd_barrier(bar)
#else
#define GRID_BAR() do { } while (0)
#endif
    const int lo = args_by_value.ph_lo, hi = args_by_value.ph_hi;
#define IN(k) (lo <= (k) && (k) < hi)
#define FRESH() do { const int t_ = fresh_tid(F.wave); F.tid = t_; F.lane = t_ & 63; } while (0)
#define SEAM(k) do { if (IN(k) && IN((k) + 1)) GRID_BAR(); } while (0)
    if (PM(0) && IN(0)) { FRESH(); p_prologue(F, args); }
#ifdef DUP_PROLOGUE
    GRID_BAR(); if (PM(0) && IN(0)) { FRESH(); p_prologue(F, args, CW_QUEUE + 64); }
#endif
    SEAM(0);
    {
        const int pb = 1 + 0 * NPH;
        const int mrows = (0 == DEPTH - 1) ? NLAT : NT;
        if (PM(1) && IN(pb + 0)) { FRESH(); p_norm1(F, args, OPQ(0)); }
#ifdef DUP_NORM1
        GRID_BAR(); if (PM(1) && IN(pb + 0)) { FRESH(); p_norm1(F, args, OPQ(0), true); }
#endif
 SEAM(pb + 0);
        if (PM(2) && IN(pb + 1)) for (int rep_ = 0; rep_ < NREP(2); ++rep_) { if (rep_) GRID_BAR(); const int Lg = OPQ(0);
            pg8::Gemm g{(const bf16*)(F.ws + WS_H), (const bf16*)(F.ws + WS_WIN) + (size_t)Lg * PW * DM, DM * 2, DM * 2, OPQ(DM)};
            SgOrder<FillPlain> S; S.init(NT / 256, PW / 256, F.G, F.bid); S.f = FillPlain{(size_t)256 * DM * 2, (size_t)256 * DM * 2};
            EpiInproj E{(bf16*)(F.ws + WS_PBUF), (bf16*)(F.ws + WS_A2)};
            pg8::gemm_phase(F.lds, g, S, E, fresh_tid(F.wave));
        }
#if defined(SHADOW_IN)
        if (PM(2) && IN(pb + 1)) { GRID_BAR(); const int Lg = OPQ(0);
            pg8::Gemm g{(const bf16*)(F.ws + WS_H), (const bf16*)(F.ws + WS_WIN) + (size_t)Lg * PW * DM, DM * 2, DM * 2, OPQ(DM)};
            SgOrder<FillPlain> S; S.init(NT / 256, PW / 256, F.G, F.bid); S.f = FillPlain{(size_t)256 * DM * 2, (size_t)256 * DM * 2};
            EpiNull E{(float*)(F.ws + WS_Y)};
            pg8::gemm_phase(F.lds, g, S, E, fresh_tid(F.wave));
        }
#endif
        SEAM(pb + 1);
        if (PM(3) && IN(pb + 2)) for (int rep_ = 0; rep_ < NREP(3); ++rep_) { if (rep_) GRID_BAR(); FRESH(); p_mix_a(F, args, OPQ(0), rep_); } SEAM(pb + 2);
        if (PM(4) && IN(pb + 3)) for (int rep_ = 0; rep_ < NREP(4); ++rep_) { if (rep_) GRID_BAR(); FRESH(); p_mix_b(F, args, OPQ(0), rep_); } SEAM(pb + 3);
        if (PM(5) && IN(pb + 4)) for (int rep_ = 0; rep_ < NREP(5); ++rep_) { if (rep_) GRID_BAR(); FRESH(); p_mix_c(F, args, OPQ(0), rep_); } SEAM(pb + 4);
        if (PM(6) && IN(pb + 5)) for (int rep_ = 0; rep_ < NREP(6); ++rep_) { if (rep_) GRID_BAR(); const int Lg = OPQ(0);
            pg8::Gemm g{(const bf16*)(F.ws + WS_ACT5), (const bf16*)(F.ws + WS_WGLU) + (size_t)Lg * 256 * 256, 512, 512, OPQ(256)};
            SgOrder<FillPlain> S; S.init(NT / 256, 1, F.G, F.bid); S.f = FillPlain{(size_t)256 * 256 * 2, 0};
            EpiGlu E{(const bf16*)(F.ws + WS_ACT5), (bf16*)(F.ws + WS_MIX)};
            pg8::gemm_phase(F.lds, g, S, E, fresh_tid(F.wave));
        } SEAM(pb + 5);
        if (PM(7) && IN(pb + 6)) { const int Lg = OPQ(0);
            pg8::Gemm g{(const bf16*)(F.ws + WS_MIX), (const bf16*)(F.ws + WS_WOUT) + (size_t)Lg * DM * MW, MW * 2, MW * 2, OPQ(MW)};
            SgOrder<FillPlain> S; S.init((Lg == DEPTH - 1 ? NLAT : NT) / 256, DM / 256, F.G, F.bid); S.f = FillPlain{(size_t)256 * MW * 2, (size_t)256 * MW * 2};
            EpiOutproj E{args.in[I_X], args.in[I_CTX], (bf16*)(F.ws + WS_XS), (const float*)(F.ws + WS_MOD) + (size_t)Lg * 9 * 6144, Lg == 0 ? 1 : 0};
            pg8::gemm_phase(F.lds, g, S, E, fresh_tid(F.wave));
        } SEAM(pb + 6);
        if (PM(8) && IN(pb + 7)) { FRESH(); p_norm2(F, args, OPQ(0), OPQ(mrows)); }
#ifdef DUP_NORM2
        GRID_BAR(); if (PM(8) && IN(pb + 7)) { FRESH(); p_norm2(F, args, OPQ(0), OPQ(mrows), 6400); }
#endif
 SEAM(pb + 7);
        if (PM(10) && IN(pb + 9)) { const int Lg = OPQ(0); FRESH();
            const int nblk = moe_tables(F, Lg);
            LAS int* lbs = (LAS int*)(F.lds + MOE_LB); LAS int* lcs = (LAS int*)(F.lds + MOE_LC); LAS unsigned* gat = (LAS unsigned*)(F.lds + MOE_GAT);
            SgOrder<FillMoe> S; S.init(nblk, 8, F.G, F.bid); S.f = FillMoe{(const LAS unsigned*)(F.lds + MOE_LBLK), 2048};
            { const int* TM = (const int*)(F.ws + WS_TM); const float* PG = (const float*)(F.ws + WS_PG); int* PS = (int*)(F.ws + WS_PS); float* SG = (float*)(F.ws + WS_SG);
              pg8::Unit u; int cursor = 0;
              for (int ui = 0; ui < MOE_MAXU && S.next(cursor, u); ++ui) {
                  if (F.tid < 256) { const int e = u.grp, rk = u.pm * 256 - lbs[e] + F.tid; const bool ok = rk < lcs[e];
                      const int id = ok ? TM[(size_t)e * NT + rk] : 0;
                      gat[ui * 256 + F.tid] = (unsigned)(id >> 2) * (unsigned)DM;
                      if (ok && u.pn == 0) { const int slot = u.pm * 256 + F.tid; PS[id] = slot; SG[slot] = PG[id]; } } } }
            __syncthreads();
            pg8::Gemm g{F.ws + WS_H8, F.ws + WS_WGU + (size_t)Lg * NEXP * 2048 * DM, DM, DM, OPQ(DM / 2)};
            EpiSwiglu E{(unsigned char*)(F.ws + WS_ACT), args.in[I_BGU] + (size_t)Lg * NEXP * 2048};
            pg8::gemm_phase<EpiSwiglu, SgOrder<FillMoe>, true, F8_ALIGN, F8_SP2, true>(F.lds, g, S, E, fresh_tid(F.wave), gat);
        } SEAM(pb + 9);
        if (PM(11) && IN(pb + 10)) for (int rep_ = 0; rep_ < NREP(11); ++rep_) { if (rep_) GRID_BAR(); const int Lg = OPQ(0); FRESH();
            const int nblk = moe_tables(F, Lg);
            pg8::Gemm g{F.ws + WS_ACT, F.ws + WS_WDN + (size_t)Lg * NEXP * DM * DM, DM, DM, OPQ(DM / 2)};
            SgOrder<FillMoe> S; S.init(nblk, 4, F.G, F.bid); S.f = FillMoe{(const LAS unsigned*)(F.lds + MOE_LBLK), 1024};
            EpiDown E{(unsigned char*)(F.ws + WS_Y), args.in[I_BDN] + (size_t)Lg * NEXP * DM, (const float*)(F.ws + WS_SG)};
            pg8::gemm_phase<EpiDown, SgOrder<FillMoe>, true, F8_ALIGN, F8_SP2>(F.lds, g, S, E, fresh_tid(F.wave));
        } SEAM(pb + 10);
        }
    {
        const int pb = 1 + 1 * NPH;
        const int mrows = (1 == DEPTH - 1) ? NLAT : NT;
        if (PM(1) && IN(pb + 0)) { FRESH(); p_norm1(F, args, OPQ(1)); }
#ifdef DUP_NORM1
        GRID_BAR(); if (PM(1) && IN(pb + 0)) { FRESH(); p_norm1(F, args, OPQ(1), true); }
#endif
 SEAM(pb + 0);
        if (PM(2) && IN(pb + 1)) for (int rep_ = 0; rep_ < NREP(2); ++rep_) { if (rep_) GRID_BAR(); const int Lg = OPQ(1);
            pg8::Gemm g{(const bf16*)(F.ws + WS_H), (const bf16*)(F.ws + WS_WIN) + (size_t)Lg * PW * DM, DM * 2, DM * 2, OPQ(DM)};
            SgOrder<FillPlain> S; S.init(NT / 256, PW / 256, F.G, F.bid); S.f = FillPlain{(size_t)256 * DM * 2, (size_t)256 * DM * 2};
            EpiInproj E{(bf16*)(F.ws + WS_PBUF), (bf16*)(F.ws + WS_A2)};
            pg8::gemm_phase(F.lds, g, S, E, fresh_tid(F.wave));
        }
#if defined(SHADOW_IN)
        if (PM(2) && IN(pb + 1)) { GRID_BAR(); const int Lg = OPQ(1);
            pg8::Gemm g{(const bf16*)(F.ws + WS_H), (const bf16*)(F.ws + WS_WIN) + (size_t)Lg * PW * DM, DM * 2, DM * 2, OPQ(DM)};
            SgOrder<FillPlain> S; S.init(NT / 256, PW / 256, F.G, F.bid); S.f = FillPlain{(size_t)256 * DM * 2, (size_t)256 * DM * 2};
            EpiNull E{(float*)(F.ws + WS_Y)};
            pg8::gemm_phase(F.lds, g, S, E, fresh_tid(F.wave));
        }
#endif
        SEAM(pb + 1);
        if (PM(3) && IN(pb + 2)) for (int rep_ = 0; rep_ < NREP(3); ++rep_) { if (rep_) GRID_BAR(); FRESH(); p_mix_a(F, args, OPQ(1), rep_); } SEAM(pb + 2);
        if (PM(4) && IN(pb + 3)) for (int rep_ = 0; rep_ < NREP(4); ++rep_) { if (rep_) GRID_BAR(); FRESH(); p_mix_b(F, args, OPQ(1), rep_); } SEAM(pb + 3);
        if (PM(5) && IN(pb + 4)) for (int rep_ = 0; rep_ < NREP(5); ++rep_) { if (rep_) GRID_BAR(); FRESH(); p_mix_c(F, args, OPQ(1), rep_); } SEAM(pb + 4);
        if (PM(6) && IN(pb + 5)) for (int rep_ = 0; rep_ < NREP(6); ++rep_) { if (rep_) GRID_BAR(); const int Lg = OPQ(1);
            pg8::Gemm g{(const bf16*)(F.ws + WS_ACT5), (const bf16*)(F.ws + WS_WGLU) + (size_t)Lg * 256 * 256, 512, 512, OPQ(256)};
            SgOrder<FillPlain> S; S.init(NT / 256, 1, F.G, F.bid); S.f = FillPlain{(size_t)256 * 256 * 2, 0};
            EpiGlu E{(const bf16*)(F.ws + WS_ACT5), (bf16*)(F.ws + WS_MIX)};
            pg8::gemm_phase(F.lds, g, S, E, fresh_tid(F.wave));
        } SEAM(pb + 5);
        if (PM(7) && IN(pb + 6)) { const int Lg = OPQ(1);
            pg8::Gemm g{(const bf16*)(F.ws + WS_MIX), (const bf16*)(F.ws + WS_WOUT) + (size_t)Lg * DM * MW, MW * 2, MW * 2, OPQ(MW)};
            SgOrder<FillPlain> S; S.init((Lg == DEPTH - 1 ? NLAT : NT) / 256, DM / 256, F.G, F.bid); S.f = FillPlain{(size_t)256 * MW * 2, (size_t)256 * MW * 2};
            EpiOutproj E{args.in[I_X], args.in[I_CTX], (bf16*)(F.ws + WS_XS), (const float*)(F.ws + WS_MOD) + (size_t)Lg * 9 * 6144, Lg == 0 ? 1 : 0};
            pg8::gemm_phase(F.lds, g, S, E, fresh_tid(F.wave));
        } SEAM(pb + 6);
        if (PM(8) && IN(pb + 7)) { FRESH(); p_norm2(F, args, OPQ(1), OPQ(mrows)); }
#ifdef DUP_NORM2
        GRID_BAR(); if (PM(8) && IN(pb + 7)) { FRESH(); p_norm2(F, args, OPQ(1), OPQ(mrows), 6400); }
#endif
 SEAM(pb + 7);
        if (PM(10) && IN(pb + 9)) { const int Lg = OPQ(1); FRESH();
            const int nblk = moe_tables(F, Lg);
            LAS int* lbs = (LAS int*)(F.lds + MOE_LB); LAS int* lcs = (LAS int*)(F.lds + MOE_LC); LAS unsigned* gat = (LAS unsigned*)(F.lds + MOE_GAT);
            SgOrder<FillMoe> S; S.init(nblk, 8, F.G, F.bid); S.f = FillMoe{(const LAS unsigned*)(F.lds + MOE_LBLK), 2048};
            { const int* TM = (const int*)(F.ws + WS_TM); const float* PG = (const float*)(F.ws + WS_PG); int* PS = (int*)(F.ws + WS_PS); float* SG = (float*)(F.ws + WS_SG);
              pg8::Unit u; int cursor = 0;
              for (int ui = 0; ui < MOE_MAXU && S.next(cursor, u); ++ui) {
                  if (F.tid < 256) { const int e = u.grp, rk = u.pm * 256 - lbs[e] + F.tid; const bool ok = rk < lcs[e];
                      const int id = ok ? TM[(size_t)e * NT + rk] : 0;
                      gat[ui * 256 + F.tid] = (unsigned)(id >> 2) * (unsigned)DM;
                      if (ok && u.pn == 0) { const int slot = u.pm * 256 + F.tid; PS[id] = slot; SG[slot] = PG[id]; } } } }
            __syncthreads();
            pg8::Gemm g{F.ws + WS_H8, F.ws + WS_WGU + (size_t)Lg * NEXP * 2048 * DM, DM, DM, OPQ(DM / 2)};
            EpiSwiglu E{(unsigned char*)(F.ws + WS_ACT), args.in[I_BGU] + (size_t)Lg * NEXP * 2048};
            pg8::gemm_phase<EpiSwiglu, SgOrder<FillMoe>, true, F8_ALIGN, F8_SP2, true>(F.lds, g, S, E, fresh_tid(F.wave), gat);
        } SEAM(pb + 9);
        if (PM(11) && IN(pb + 10)) for (int rep_ = 0; rep_ < NREP(11); ++rep_) { if (rep_) GRID_BAR(); const int Lg = OPQ(1); FRESH();
            const int nblk = moe_tables(F, Lg);
            pg8::Gemm g{F.ws + WS_ACT, F.ws + WS_WDN + (size_t)Lg * NEXP * DM * DM, DM, DM, OPQ(DM / 2)};
            SgOrder<FillMoe> S; S.init(nblk, 4, F.G, F.bid); S.f = FillMoe{(const LAS unsigned*)(F.lds + MOE_LBLK), 1024};
            EpiDown E{(unsigned char*)(F.ws + WS_Y), args.in[I_BDN] + (size_t)Lg * NEXP * DM, (const float*)(F.ws + WS_SG)};
            pg8::gemm_phase<EpiDown, SgOrder<FillMoe>, true, F8_ALIGN, F8_SP2>(F.lds, g, S, E, fresh_tid(F.wave));
        } SEAM(pb + 10);
        }
    {
        const int pb = 1 + 2 * NPH;
        const int mrows = (2 == DEPTH - 1) ? NLAT : NT;
        if (PM(1) && IN(pb + 0)) { FRESH(); p_norm1(F, args, OPQ(2)); }
#ifdef DUP_NORM1
        GRID_BAR(); if (PM(1) && IN(pb + 0)) { FRESH(); p_norm1(F, args, OPQ(2), true); }
#endif
 SEAM(pb + 0);
        if (PM(2) && IN(pb + 1)) for (int rep_ = 0; rep_ < NREP(2); ++rep_) { if (rep_) GRID_BAR(); const int Lg = OPQ(2);
            pg8::Gemm g{(const bf16*)(F.ws + WS_H), (const bf16*)(F.ws + WS_WIN) + (size_t)Lg * PW * DM, DM * 2, DM * 2, OPQ(DM)};
            SgOrder<FillPlain> S; S.init(NT / 256, PW / 256, F.G, F.bid); S.f = FillPlain{(size_t)256 * DM * 2, (size_t)256 * DM * 2};
            EpiInproj E{(bf16*)(F.ws + WS_PBUF), (bf16*)(F.ws + WS_A2)};
            pg8::gemm_phase(F.lds, g, S, E, fresh_tid(F.wave));
        }
#if defined(SHADOW_IN)
        if (PM(2) && IN(pb + 1)) { GRID_BAR(); const int Lg = OPQ(2);
            pg8::Gemm g{(const bf16*)(F.ws + WS_H), (const bf16*)(F.ws + WS_WIN) + (size_t)Lg * PW * DM, DM * 2, DM * 2, OPQ(DM)};
            SgOrder<FillPlain> S; S.init(NT / 256, PW / 256, F.G, F.bid); S.f = FillPlain{(size_t)256 * DM * 2, (size_t)256 * DM * 2};
            EpiNull E{(float*)(F.ws + WS_Y)};
            pg8::gemm_phase(F.lds, g, S, E, fresh_tid(F.wave));
        }
#endif
        SEAM(pb + 1);
        if (PM(3) && IN(pb + 2)) for (int rep_ = 0; rep_ < NREP(3); ++rep_) { if (rep_) GRID_BAR(); FRESH(); p_mix_a(F, args, OPQ(2), rep_); } SEAM(pb + 2);
        if (PM(4) && IN(pb + 3)) for (int rep_ = 0; rep_ < NREP(4); ++rep_) { if (rep_) GRID_BAR(); FRESH(); p_mix_b(F, args, OPQ(2), rep_); } SEAM(pb + 3);
        if (PM(5) && IN(pb + 4)) for (int rep_ = 0; rep_ < NREP(5); ++rep_) { if (rep_) GRID_BAR(); FRESH(); p_mix_c(F, args, OPQ(2), rep_); } SEAM(pb + 4);
        if (PM(6) && IN(pb + 5)) for (int rep_ = 0; rep_ < NREP(6); ++rep_) { if (rep_) GRID_BAR(); const int Lg = OPQ(2);
            pg8::Gemm g{(const bf16*)(F.ws + WS_ACT5), (const bf16*)(F.ws + WS_WGLU) + (size_t)Lg * 256 * 256, 512, 512, OPQ(256)};
            SgOrder<FillPlain> S; S.init(NT / 256, 1, F.G, F.bid); S.f = FillPlain{(size_t)256 * 256 * 2, 0};
            EpiGlu E{(const bf16*)(F.ws + WS_ACT5), (bf16*)(F.ws + WS_MIX)};
            pg8::gemm_phase(F.lds, g, S, E, fresh_tid(F.wave));
        } SEAM(pb + 5);
        if (PM(7) && IN(pb + 6)) { const int Lg = OPQ(2);
            pg8::Gemm g{(const bf16*)(F.ws + WS_MIX), (const bf16*)(F.ws + WS_WOUT) + (size_t)Lg * DM * MW, MW * 2, MW * 2, OPQ(MW)};
            SgOrder<FillPlain> S; S.init((Lg == DEPTH - 1 ? NLAT : NT) / 256, DM / 256, F.G, F.bid); S.f = FillPlain{(size_t)256 * MW * 2, (size_t)256 * MW * 2};
            EpiOutproj E{args.in[I_X], args.in[I_CTX], (bf16*)(F.ws + WS_XS), (const float*)(F.ws + WS_MOD) + (size_t)Lg * 9 * 6144, Lg == 0 ? 1 : 0};
            pg8::gemm_phase(F.lds, g, S, E, fresh_tid(F.wave));
        } SEAM(pb + 6);
        if (PM(8) && IN(pb + 7)) { FRESH(); p_norm2(F, args, OPQ(2), OPQ(mrows)); }
#ifdef DUP_NORM2
        GRID_BAR(); if (PM(8) && IN(pb + 7)) { FRESH(); p_norm2(F, args, OPQ(2), OPQ(mrows), 6400); }
#endif
 SEAM(pb + 7);
        if (PM(10) && IN(pb + 9)) { const int Lg = OPQ(2); FRESH();
            const int nblk = moe_tables(F, Lg);
            LAS int* lbs = (LAS int*)(F.lds + MOE_LB); LAS int* lcs = (LAS int*)(F.lds + MOE_LC); LAS unsigned* gat = (LAS unsigned*)(F.lds + MOE_GAT);
            SgOrder<FillMoe> S; S.init(nblk, 8, F.G, F.bid); S.f = FillMoe{(const LAS unsigned*)(F.lds + MOE_LBLK), 2048};
            { const int* TM = (const int*)(F.ws + WS_TM); const float* PG = (const float*)(F.ws + WS_PG); int* PS = (int*)(F.ws + WS_PS); float* SG = (float*)(F.ws + WS_SG);
              pg8::Unit u; int cursor = 0;
              for (int ui = 0; ui < MOE_MAXU && S.next(cursor, u); ++ui) {
                  if (F.tid < 256) { const int e = u.grp, rk = u.pm * 256 - lbs[e] + F.tid; const bool ok = rk < lcs[e];
                      const int id = ok ? TM[(size_t)e * NT + rk] : 0;
                      gat[ui * 256 + F.tid] = (unsigned)(id >> 2) * (unsigned)DM;
                      if (ok && u.pn == 0) { const int slot = u.pm * 256 + F.tid; PS[id] = slot; SG[slot] = PG[id]; } } } }
            __syncthreads();
            pg8::Gemm g{F.ws + WS_H8, F.ws + WS_WGU + (size_t)Lg * NEXP * 2048 * DM, DM, DM, OPQ(DM / 2)};
            EpiSwiglu E{(unsigned char*)(F.ws + WS_ACT), args.in[I_BGU] + (size_t)Lg * NEXP * 2048};
            pg8::gemm_phase<EpiSwiglu, SgOrder<FillMoe>, true, F8_ALIGN, F8_SP2, true>(F.lds, g, S, E, fresh_tid(F.wave), gat);
        } SEAM(pb + 9);
        if (PM(11) && IN(pb + 10)) for (int rep_ = 0; rep_ < NREP(11); ++rep_) { if (rep_) GRID_BAR(); const int Lg = OPQ(2); FRESH();
            const int nblk = moe_tables(F, Lg);
            pg8::Gemm g{F.ws + WS_ACT, F.ws + WS_WDN + (size_t)Lg * NEXP * DM * DM, DM, DM, OPQ(DM / 2)};
            SgOrder<FillMoe> S; S.init(nblk, 4, F.G, F.bid); S.f = FillMoe{(const LAS unsigned*)(F.lds + MOE_LBLK), 1024};
            EpiDown E{(unsigned char*)(F.ws + WS_Y), args.in[I_BDN] + (size_t)Lg * NEXP * DM, (const float*)(F.ws + WS_SG)};
            pg8::gemm_phase<EpiDown, SgOrder<FillMoe>, true, F8_ALIGN, F8_SP2>(F.lds, g, S, E, fresh_tid(F.wave));
        } SEAM(pb + 10);
        }
    {
        const int pb = 1 + 3 * NPH;
        const int mrows = (3 == DEPTH - 1) ? NLAT : NT;
        if (PM(1) && IN(pb + 0)) { FRESH(); p_norm1(F, args, OPQ(3)); }
#ifdef DUP_NORM1
        GRID_BAR(); if (PM(1) && IN(pb + 0)) { FRESH(); p_norm1(F, args, OPQ(3), true); }
#endif
 SEAM(pb + 0);
        if (PM(2) && IN(pb + 1)) for (int rep_ = 0; rep_ < NREP(2); ++rep_) { if (rep_) GRID_BAR(); const int Lg = OPQ(3);
            pg8::Gemm g{(const bf16*)(F.ws + WS_H), (const bf16*)(F.ws + WS_WIN) + (size_t)Lg * PW * DM, DM * 2, DM * 2, OPQ(DM)};
            SgOrder<FillPlain> S; S.init(NT / 256, PW / 256, F.G, F.bid); S.f = FillPlain{(size_t)256 * DM * 2, (size_t)256 * DM * 2};
            EpiInproj E{(bf16*)(F.ws + WS_PBUF), (bf16*)(F.ws + WS_A2)};
            pg8::gemm_phase(F.lds, g, S, E, fresh_tid(F.wave));
        }
#if defined(SHADOW_IN)
        if (PM(2) && IN(pb + 1)) { GRID_BAR(); const int Lg = OPQ(3);
            pg8::Gemm g{(const bf16*)(F.ws + WS_H), (const bf16*)(F.ws + WS_WIN) + (size_t)Lg * PW * DM, DM * 2, DM * 2, OPQ(DM)};
            SgOrder<FillPlain> S; S.init(NT / 256, PW / 256, F.G, F.bid); S.f = FillPlain{(size_t)256 * DM * 2, (size_t)256 * DM * 2};
            EpiNull E{(float*)(F.ws + WS_Y)};
            pg8::gemm_phase(F.lds, g, S, E, fresh_tid(F.wave));
        }
#endif
        SEAM(pb + 1);
        if (PM(3) && IN(pb + 2)) for (int rep_ = 0; rep_ < NREP(3); ++rep_) { if (rep_) GRID_BAR(); FRESH(); p_mix_a(F, args, OPQ(3), rep_); } SEAM(pb + 2);
        if (PM(4) && IN(pb + 3)) for (int rep_ = 0; rep_ < NREP(4); ++rep_) { if (rep_) GRID_BAR(); FRESH(); p_mix_b(F, args, OPQ(3), rep_); } SEAM(pb + 3);
        if (PM(5) && IN(pb + 4)) for (int rep_ = 0; rep_ < NREP(5); ++rep_) { if (rep_) GRID_BAR(); FRESH(); p_mix_c(F, args, OPQ(3), rep_); } SEAM(pb + 4);
        if (PM(6) && IN(pb + 5)) for (int rep_ = 0; rep_ < NREP(6); ++rep_) { if (rep_) GRID_BAR(); const int Lg = OPQ(3);
            pg8::Gemm g{(const bf16*)(F.ws + WS_ACT5), (const bf16*)(F.ws + WS_WGLU) + (size_t)Lg * 256 * 256, 512, 512, OPQ(256)};
            SgOrder<FillPlain> S; S.init(NT / 256, 1, F.G, F.bid); S.f = FillPlain{(size_t)256 * 256 * 2, 0};
            EpiGlu E{(const bf16*)(F.ws + WS_ACT5), (bf16*)(F.ws + WS_MIX)};
            pg8::gemm_phase(F.lds, g, S, E, fresh_tid(F.wave));
        } SEAM(pb + 5);
        if (PM(7) && IN(pb + 6)) { const int Lg = OPQ(3);
            pg8::Gemm g{(const bf16*)(F.ws + WS_MIX), (const bf16*)(F.ws + WS_WOUT) + (size_t)Lg * DM * MW, MW * 2, MW * 2, OPQ(MW)};
            SgOrder<FillPlain> S; S.init((Lg == DEPTH - 1 ? NLAT : NT) / 256, DM / 256, F.G, F.bid); S.f = FillPlain{(size_t)256 * MW * 2, (size_t)256 * MW * 2};
            EpiOutproj E{args.in[I_X], args.in[I_CTX], (bf16*)(F.ws + WS_XS), (const float*)(F.ws + WS_MOD) + (size_t)Lg * 9 * 6144, Lg == 0 ? 1 : 0};
            pg8::gemm_phase(F.lds, g, S, E, fresh_tid(F.wave));
        } SEAM(pb + 6);
        if (PM(8) && IN(pb + 7)) { FRESH(); p_norm2(F, args, OPQ(3), OPQ(mrows)); }
#ifdef DUP_NORM2
        GRID_BAR(); if (PM(8) && IN(pb + 7)) { FRESH(); p_norm2(F, args, OPQ(3), OPQ(mrows), 6400); }
#endif
 SEAM(pb + 7);
        if (PM(10) && IN(pb + 9)) { const int Lg = OPQ(3); FRESH();
            const int nblk = moe_tables(F, Lg);
            LAS int* lbs = (LAS int*)(F.lds + MOE_LB); LAS int* lcs = (LAS int*)(F.lds + MOE_LC); LAS unsigned* gat = (LAS unsigned*)(F.lds + MOE_GAT);
            SgOrder<FillMoe> S; S.init(nblk, 8, F.G, F.bid); S.f = FillMoe{(const LAS unsigned*)(F.lds + MOE_LBLK), 2048};
            { const int* TM = (const int*)(F.ws + WS_TM); const float* PG = (const float*)(F.ws + WS_PG); int* PS = (int*)(F.ws + WS_PS); float* SG = (float*)(F.ws + WS_SG);
              pg8::Unit u; int cursor = 0;
              for (int ui = 0; ui < MOE_MAXU && S.next(cursor, u); ++ui) {
                  if (F.tid < 256) { const int e = u.grp, rk = u.pm * 256 - lbs[e] + F.tid; const bool ok = rk < lcs[e];
                      const int id = ok ? TM[(size_t)e * NT + rk] : 0;
                      gat[ui * 256 + F.tid] = (unsigned)(id >> 2) * (unsigned)DM;
                      if (ok && u.pn == 0) { const int slot = u.pm * 256 + F.tid; PS[id] = slot; SG[slot] = PG[id]; } } } }
            __syncthreads();
            pg8::Gemm g{F.ws + WS_H8, F.ws + WS_WGU + (size_t)Lg * NEXP * 2048 * DM, DM, DM, OPQ(DM / 2)};
            EpiSwiglu E{(unsigned char*)(F.ws + WS_ACT), args.in[I_BGU] + (size_t)Lg * NEXP * 2048};
            pg8::gemm_phase<EpiSwiglu, SgOrder<FillMoe>, true, F8_ALIGN, F8_SP2, true>(F.lds, g, S, E, fresh_tid(F.wave), gat);
        } SEAM(pb + 9);
        if (PM(11) && IN(pb + 10)) for (int rep_ = 0; rep_ < NREP(11); ++rep_) { if (rep_) GRID_BAR(); const int Lg = OPQ(3); FRESH();
            const int nblk = moe_tables(F, Lg);
            pg8::Gemm g{F.ws + WS_ACT, F.ws + WS_WDN + (size_t)Lg * NEXP * DM * DM, DM, DM, OPQ(DM / 2)};
            SgOrder<FillMoe> S; S.init(nblk, 4, F.G, F.bid); S.f = FillMoe{(const LAS unsigned*)(F.lds + MOE_LBLK), 1024};
            EpiDown E{(unsigned char*)(F.ws + WS_Y), args.in[I_BDN] + (size_t)Lg * NEXP * DM, (const float*)(F.ws + WS_SG)};
            pg8::gemm_phase<EpiDown, SgOrder<FillMoe>, true, F8_ALIGN, F8_SP2>(F.lds, g, S, E, fresh_tid(F.wave));
        } SEAM(pb + 10);
        }
    if (PM(12) && IN(PH_TOTAL - 1)) { FRESH(); p_final(F, args); }
#undef IN
#undef SEAM
#undef args
}

extern "C" void kernel_launch(void* const* d_in, const int* in_sizes, int n_in, void* d_out, int out_size, void* d_ws, size_t ws_size, hipStream_t stream) {
    static int grid = 0;
    if (grid == 0) {
        if (n_in != N_IN || out_size != NLAT * DM || ws_size < WS_END) { fprintf(stderr, "kernel_launch: unexpected shapes (n_in %d, out %d, ws %zu < %zu); nothing launched\n", n_in, out_size, ws_size, (size_t)WS_END); grid = -1; return; }
        int dev = 0, cus = 0, per_cu = 0;
        if (hipGetDevice(&dev) != hipSuccess || hipDeviceGetAttribute(&cus, hipDeviceAttributeMultiprocessorCount, dev) != hipSuccess) { grid = -1; return; }
        if (hipFuncSetAttribute((const void*)mk_fwd, hipFuncAttributeMaxDynamicSharedMemorySize, LDS_BYTES) != hipSuccess) { fprintf(stderr, "kernel_launch: hipFuncSetAttribute failed\n"); grid = -1; return; }
        if (hipOccupancyMaxActiveBlocksPerMultiprocessor(&per_cu, (const void*)mk_fwd, NTHR, LDS_BYTES) != hipSuccess || per_cu < 1) fprintf(stderr, "kernel_launch: occupancy query says %d\n", per_cu);
        (void)hipGetLastError();
        grid = cus;
    }
    if (grid < 0) return;
    (void)hipMemsetAsync((char*)d_ws + WS_CTL, 0, CTL_BYTES, stream);
    Args a{};
    for (int i = 0; i < N_IN; ++i) a.in[i] = (const float*)d_in[i];
    a.out = (float*)d_out; a.ws = (unsigned char*)d_ws;
#if MK_ONE_LAUNCH
    a.ph_lo = 0; a.ph_hi = PH_TOTAL;
    hipLaunchKernelGGL(mk_fwd, dim3(grid), dim3(NTHR), LDS_BYTES, stream, a);
#else
    for (int p = 0; p < PH_TOTAL; ++p) { a.ph_lo = p; a.ph_hi = p + 1; hipLaunchKernelGGL(mk_fwd, dim3(grid), dim3(NTHR), LDS_BYTES, stream, a); }
#endif
}
```

```cpp
#define MK_ONE_LAUNCH 1
#define F8_ALIGN true
#define F8_SP2 true
#include <hip/hip_runtime.h>
#include <cstdio>
#include <cstdint>

#define GAS __attribute__((address_space(1)))
#define LAS __attribute__((address_space(3)))
typedef unsigned short bf16;
typedef short bf16x8 __attribute__((ext_vector_type(8)));
typedef short s16x4 __attribute__((ext_vector_type(4)));
typedef float f32x4 __attribute__((ext_vector_type(4)));
typedef float f32x2 __attribute__((ext_vector_type(2)));
typedef unsigned u32x4 __attribute__((ext_vector_type(4)));
typedef unsigned u32x2 __attribute__((ext_vector_type(2)));

namespace pg8 {
#define PG8_LAS __attribute__((address_space(3)))
typedef unsigned short bf16_t;
constexpr int BM = 256, BK = 64, HALF = 128, HTB = HALF * BK * 2  , STAGE_BYTES = 8 * HTB;

__host__ __device__ __forceinline__ int lds_byte(int r, int c) { const int st = (r >> 4) * 2 + (c >> 5), rr = r & 15, cc = c & 31, ob = rr * 64 + cc * 2; return st * 1024 + (ob ^ (((ob >> 9) & 1) << 5)); }
__host__ __device__ __forceinline__ void stage_rc(int b, int& R, int& C) { const int st = b / 1024, sb = b % 1024, swz = sb ^ (((sb >> 9) & 1) << 5); R = (st >> 1) * 16 + swz / 64; C = (st & 1) * 32 + (swz % 64) / 2; }
__host__ __device__ __forceinline__ int lds_byte_f8(int r, int c) { const int st = (r >> 4) * 2 + (c >> 5), rr = r & 15, cc = c & 31, ob = rr * 64 + cc * 2; return st * 1024 + (ob ^ (((ob >> 9) & 1) << 4)); }
__host__ __device__ __forceinline__ void stage_rc_f8(int b, int& R, int& C) { const int st = b / 1024, sb = b % 1024, swz = sb ^ (((sb >> 9) & 1) << 4); R = (st >> 1) * 16 + swz / 64; C = (st & 1) * 32 + (swz % 64) / 2; }
__host__ __device__ __forceinline__ int perm32(int rho) { const int n = rho >> 4, i = rho & 15; return 8 * (i >> 2) + 4 * n + (i & 3); }

struct Unit { int pm, pn, grp; size_t aoff, boff; };
struct Gemm { const void* A; const void* Bt; int lda, ldb, K; };

__device__ __forceinline__ unsigned cvt_pk_bf16(float lo, float hi) { unsigned r; asm volatile("v_cvt_pk_bf16_f32 %0, %1, %2" : "=v"(r) : "v"(lo), "v"(hi)); return r; }

typedef int v8i_t __attribute__((ext_vector_type(8)));
typedef int v4i_t __attribute__((ext_vector_type(4)));
template <class Epi, class Sched, bool F8 = false, bool ALIGN_EPI = true, bool SP2 = true, bool GATHER = false>
__device__ __forceinline__ void gemm_phase(PG8_LAS unsigned char* lds, const Gemm g, const Sched& S, const Epi& E, int tid_in, const PG8_LAS unsigned* gat = nullptr) {
    static_assert(!GATHER || SP2, "gather is written for the SP2 loop");
    int tid = tid_in; asm volatile("" : "+v"(tid));
    const int wid = __builtin_amdgcn_readfirstlane(tid >> 6), lane = tid & 63, wr = wid >> 2, wc = wid & 3, fr = lane & 15, fq = lane >> 4;
    const int K = g.K, nt = K / BK;
    unsigned voffA[2], voffB[2];
#pragma unroll
    for (int i = 0; i < 2; ++i) { int R, C; if constexpr (F8) stage_rc_f8(tid * 16 + i * 8192, R, C); else stage_rc(tid * 16 + i * 8192, R, C); const int Rb = (int)Epi::PERM == 2 ? (64 * (R >> 5) + 16 * ((R >> 2) & 3) + 4 * ((R >> 4) & 1) + (R & 3)) : ((int)Epi::PERM == 1 ? ((R & ~31) + perm32(R & 31)) : R);
        voffA[i] = GATHER ? (unsigned)(R * 65536 + C * 2) : (unsigned)(R * g.lda + C * 2); voffB[i] = (unsigned)(Rb * g.ldb + C * 2); }
    unsigned vA0[2], vA1[2];
    const size_t kstep = (size_t)(BK * 2);
    const size_t hstepA = (size_t)HALF * g.lda, hstepB = (size_t)((int)Epi::PERM == 2 ? 8 : HALF) * g.ldb;
#define PG8_GLOAD(ui_) do { _Pragma("unroll") for (int _i = 0; _i < 2; ++_i) { const int r_ = (int)(voffA[_i] >> 16); const unsigned c_ = voffA[_i] & 0xffffu; \
        vA0[_i] = gat[(ui_) * 256 + r_] + c_; vA1[_i] = gat[(ui_) * 256 + 128 + r_] + c_; } } while (0)
    if constexpr (GATHER) PG8_GLOAD(0); else { vA0[0] = voffA[0]; vA0[1] = voffA[1]; vA1[0] = voffA[0] + (unsigned)hstepA; vA1[1] = voffA[1] + (unsigned)hstepA; }
    int ui = 0;
    const unsigned ldsw = (unsigned)wid * 1024u;
    const int aoff = F8 ? lds_byte_f8(wr * 64 + fr, fq * 16) : lds_byte(wr * 64 + fr, fq * 8), boff = F8 ? lds_byte_f8(wc * 32 + fr, fq * 16) : lds_byte(wc * 32 + fr, fq * 8);
    const int aoff1 = lds_byte_f8(wr * 64 + fr, fq * 16 + 8), boff1 = lds_byte_f8(wc * 32 + fr, fq * 16 + 8);
#define PG8_SA(b, h) (((b) * 2 + (h)) * HTB)
#define PG8_SB(b, h) ((4 + (b) * 2 + (h)) * HTB)
#define PG8_STAGE(bufoff, gbase, voff) do { _Pragma("unroll") for (int _i = 0; _i < 2; ++_i) \
        __builtin_amdgcn_global_load_lds((const unsigned*)((const char*)(gbase) + (voff)[_i]), (PG8_LAS unsigned*)(lds + (bufoff) + ldsw + _i * 8192), 16, 0, 0); } while (0)
#define PG8_LD16(off) (*(const PG8_LAS v4i_t*)(lds + (off)))
#define PG8_LDA(dst, b, h) do { if constexpr (F8) { _Pragma("unroll") for (int m = 0; m < 4; ++m) A8[m] = __builtin_shufflevector(PG8_LD16(PG8_SA(b, h) + aoff + m * 2048), PG8_LD16(PG8_SA(b, h) + aoff1 + m * 2048), 0, 1, 2, 3, 4, 5, 6, 7); } \
        else { _Pragma("unroll") for (int m = 0; m < 4; ++m) _Pragma("unroll") for (int k = 0; k < 2; ++k) dst[m][k] = *(const PG8_LAS bf16x8*)(lds + PG8_SA(b, h) + aoff + m * 2048 + k * 1024); } } while (0)
#define PG8_LDB(dst, b, h) do { if constexpr (F8) { _Pragma("unroll") for (int n = 0; n < 2; ++n) dst##8[n] = __builtin_shufflevector(PG8_LD16(PG8_SB(b, h) + boff + n * 2048), PG8_LD16(PG8_SB(b, h) + boff1 + n * 2048), 0, 1, 2, 3, 4, 5, 6, 7); } \
        else { _Pragma("unroll") for (int n = 0; n < 2; ++n) _Pragma("unroll") for (int k = 0; k < 2; ++k) dst[n][k] = *(const PG8_LAS bf16x8*)(lds + PG8_SB(b, h) + boff + n * 2048 + k * 1024); } } while (0)
#define PG8_MMA(ai, bj, At, Bt) do { __builtin_amdgcn_s_setprio(1); \
        if constexpr (F8) { _Pragma("unroll") for (int m = 0; m < 4; ++m) _Pragma("unroll") for (int n = 0; n < 2; ++n) \
            asm volatile("v_mfma_scale_f32_16x16x128_f8f6f4 %0, %1, %2, %0, %3, %3 op_sel_hi:[0,0,0]" : "+v"(acc[ai][bj][m][n]) : "v"(Bt##8[n]), "v"(A8[m]), "v"(one_scale)); } \
        else { _Pragma("unroll") for (int m = 0; m < 4; ++m) _Pragma("unroll") for (int n = 0; n < 2; ++n) _Pragma("unroll") for (int k = 0; k < 2; ++k) \
            acc[ai][bj][m][n] = __builtin_amdgcn_mfma_f32_16x16x32_bf16(Bt[n][k], At[m][k], acc[ai][bj][m][n], 0, 0, 0); } \
        __builtin_amdgcn_s_setprio(0); } while (0)
#define PG8_WAIT_V(n) asm volatile("s_waitcnt vmcnt(" #n ")" ::: "memory")
#define PG8_WAIT_L(n) asm volatile("s_waitcnt lgkmcnt(" #n ")" ::: "memory")
#define PG8_BAR __builtin_amdgcn_s_barrier()
#define PG8_SCHED __builtin_amdgcn_sched_barrier(0)
    Unit cur, nxt; int cursor = 0;
    if (!S.next(cursor, cur)) return;
    f32x4 acc[2][2][4][2];
#pragma unroll
    for (int a = 0; a < 2; ++a)
#pragma unroll
        for (int b = 0; b < 2; ++b)
#pragma unroll
            for (int m = 0; m < 4; ++m)
#pragma unroll
                for (int n = 0; n < 2; ++n) acc[a][b][m][n] = (f32x4){0.f, 0.f, 0.f, 0.f};
    bf16x8 At[4][2], B0[2][2], B1[2][2];
    v8i_t A8[4], B08[2], B18[2];
    int one_scale = 0x7F7F7F7F; asm volatile("" : "+v"(one_scale));
    const char* cA = (const char*)g.A + (GATHER ? (size_t)0 : cur.aoff); const char* cB = (const char*)g.Bt + cur.boff;
    if constexpr (SP2) {
        PG8_STAGE(PG8_SB(0, 0), cB, voffB); PG8_STAGE(PG8_SB(0, 1), cB + hstepB, voffB); PG8_STAGE(PG8_SA(0, 0), cA, vA0); PG8_STAGE(PG8_SA(0, 1), cA, vA1);
        if (wr == 1) PG8_BAR;
        PG8_WAIT_V(2); PG8_BAR;
        PG8_STAGE(PG8_SB(1, 0), cB + kstep, voffB); PG8_STAGE(PG8_SA(1, 0), cA + kstep, vA0); PG8_STAGE(PG8_SB(1, 1), cB + hstepB + kstep, voffB);
        PG8_WAIT_V(6); PG8_BAR;
    } else {
        PG8_STAGE(PG8_SB(0, 0), cB, voffB); PG8_STAGE(PG8_SA(0, 0), cA, voffA); PG8_STAGE(PG8_SB(0, 1), cB + hstepB, voffB); PG8_STAGE(PG8_SA(0, 1), cA + hstepA, voffA);
        if (wr == 1) PG8_BAR;
        PG8_WAIT_V(4); PG8_BAR;
        PG8_STAGE(PG8_SB(1, 0), cB + kstep, voffB); PG8_STAGE(PG8_SA(1, 0), cA + kstep, vA0); PG8_STAGE(PG8_SB(1, 1), cB + hstepB + kstep, voffB);
        PG8_WAIT_V(6); PG8_BAR;
    }
    for (;;) {
        const bool has_next = S.next(cursor, nxt);
        const char* nA = (has_next && !GATHER) ? (const char*)g.A + nxt.aoff : cA; const char* nB = has_next ? (const char*)g.Bt + nxt.boff : cB;
        for (int t = 0; t < nt; t += 2) {
            const bool last = (t == nt - 2);
            const char* a1 = cA + (size_t)(t + 1) * kstep;
            const char* a2 = last ? nA : cA + (size_t)(t + 2) * kstep; const char* b2 = last ? nB : cB + (size_t)(t + 2) * kstep;
            const char* a3 = a2 + kstep; const char* b3 = b2 + kstep;
            if constexpr (SP2) {
            PG8_LDB(B0, 0, 0); PG8_LDB(B1, 0, 1); PG8_SCHED; PG8_LDA(At, 0, 0); PG8_STAGE(PG8_SA(1, 1), a1, vA1);
            if constexpr (GATHER) { if (last && has_next) PG8_GLOAD(ui + 1); }
            PG8_WAIT_V(8); PG8_WAIT_L(0); PG8_BAR; PG8_MMA(0, 0, At, B0); PG8_MMA(0, 1, At, B1); PG8_BAR; PG8_SCHED;
            PG8_LDA(At, 0, 1); PG8_STAGE(PG8_SB(0, 0), b2, voffB); PG8_STAGE(PG8_SB(0, 1), b2 + hstepB, voffB); PG8_STAGE(PG8_SA(0, 0), a2, vA0);
            PG8_WAIT_V(8); PG8_WAIT_L(0); PG8_BAR; PG8_MMA(1, 0, At, B0); PG8_MMA(1, 1, At, B1); PG8_BAR; PG8_SCHED;
            PG8_LDB(B0, 1, 0); PG8_LDB(B1, 1, 1); PG8_SCHED; PG8_LDA(At, 1, 0); PG8_STAGE(PG8_SA(0, 1), a2, vA1);
            PG8_WAIT_V(8); PG8_WAIT_L(0); PG8_BAR; PG8_MMA(0, 0, At, B0); PG8_MMA(0, 1, At, B1); PG8_BAR; PG8_SCHED;
            PG8_LDA(At, 1, 1); PG8_STAGE(PG8_SB(1, 0), b3, voffB); PG8_STAGE(PG8_SB(1, 1), b3 + hstepB, voffB); PG8_STAGE(PG8_SA(1, 0), a3, vA0);
            PG8_WAIT_V(8); PG8_WAIT_L(0); PG8_BAR; PG8_MMA(1, 0, At, B0); PG8_MMA(1, 1, At, B1); PG8_BAR; PG8_SCHED;
            } else {
            PG8_LDB(B0, 0, 0); PG8_SCHED; PG8_LDA(At, 0, 0); PG8_STAGE(PG8_SA(1, 1), a1, vA1);
            PG8_WAIT_L(8); PG8_BAR; PG8_WAIT_L(0); PG8_MMA(0, 0, At, B0); PG8_BAR; PG8_SCHED;
            PG8_LDB(B1, 0, 1); PG8_STAGE(PG8_SB(0, 0), b2, voffB);
            PG8_BAR; PG8_WAIT_L(0); PG8_MMA(0, 1, At, B1); PG8_BAR;
            PG8_LDA(At, 0, 1); PG8_STAGE(PG8_SA(0, 0), a2, vA0);
            PG8_BAR; PG8_WAIT_L(0); PG8_MMA(1, 0, At, B0); PG8_BAR; PG8_SCHED;
            PG8_STAGE(PG8_SB(0, 1), b2 + hstepB, voffB);
            PG8_WAIT_V(6); PG8_BAR; PG8_MMA(1, 1, At, B1); PG8_BAR;
            PG8_LDB(B0, 1, 0); PG8_SCHED; PG8_LDA(At, 1, 0); PG8_STAGE(PG8_SA(0, 1), a2, vA1);
            PG8_WAIT_L(8); PG8_BAR; PG8_WAIT_L(0); PG8_MMA(0, 0, At, B0); PG8_BAR; PG8_SCHED;
            PG8_LDB(B1, 1, 1); PG8_STAGE(PG8_SB(1, 0), b3, voffB);
            PG8_BAR; PG8_WAIT_L(0); PG8_MMA(0, 1, At, B1); PG8_BAR;
            PG8_LDA(At, 1, 1); PG8_STAGE(PG8_SA(1, 0), a3, vA0);
            PG8_BAR; PG8_WAIT_L(0); PG8_MMA(1, 0, At, B0); PG8_BAR; PG8_SCHED;
            PG8_STAGE(PG8_SB(1, 1), b3 + hstepB, voffB);
            PG8_WAIT_V(6); PG8_BAR; PG8_MMA(1, 1, At, B1); PG8_BAR;
            }
        }
        if constexpr (F8) asm volatile("s_nop 15\n\ts_nop 15" ::: "memory");
        if constexpr (ALIGN_EPI) { if (wr == 0) PG8_BAR; }
        E(acc, cur, wr, wc, fr, fq);
        if (!has_next) break;
#pragma unroll
        for (int a = 0; a < 2; ++a)
#pragma unroll
            for (int b = 0; b < 2; ++b)
#pragma unroll
                for (int m = 0; m < 4; ++m)
#pragma unroll
                    for (int n = 0; n < 2; ++n) acc[a][b][m][n] = (f32x4){0.f, 0.f, 0.f, 0.f};
        cur = nxt; cA = nA; cB = nB; ++ui;
        if constexpr (ALIGN_EPI) { if (wr == 1) PG8_BAR; }
    }
    PG8_WAIT_V(0);
    if constexpr (!ALIGN_EPI) { if (wr == 0) PG8_BAR; }
    PG8_BAR;
#undef PG8_GLOAD
#undef PG8_SA
#undef PG8_SB
#undef PG8_STAGE
#undef PG8_LDA
#undef PG8_LDB
#undef PG8_MMA
#undef PG8_LD16
#undef PG8_WAIT_V
#undef PG8_WAIT_L
#undef PG8_BAR
#undef PG8_SCHED
}
}

#define XB_TMO      128
#define XB_XCNT(j)  (256  + 64 * (j))
#define XB_XSUB(j)  (1280 + 64 * (j))
#define XB_XGEN(j)  (2304 + 64 * (j))
#define XB_TOP      3328
#define XB_TOPGEN   3392
#define XCD_BAR_WORDS 3456
#define XB_SPIN_CAP (1u << 18)

__device__ __forceinline__ unsigned xb_ld(unsigned* p)              { return __hip_atomic_load(p, __ATOMIC_RELAXED, __HIP_MEMORY_SCOPE_AGENT); }
__device__ __forceinline__ unsigned xb_add(unsigned* p, unsigned v) { return __hip_atomic_fetch_add(p, v, __ATOMIC_RELAXED, __HIP_MEMORY_SCOPE_AGENT); }
__device__ __forceinline__ unsigned xb_xcc_id() { return (unsigned)__builtin_amdgcn_s_getreg((3 << 11) | 20) & 0xFu; }
#define XB_SPIN(cond, bar) do { unsigned _sp = 0; while (cond) { __builtin_amdgcn_s_sleep(1); \
    if ((++_sp & 255u) == 0u) { if (xb_ld(&(bar)[XB_TMO])) break; if (_sp > XB_SPIN_CAP) { atomicAdd(&(bar)[XB_TMO], 1u); break; } } } } while (0)

struct XcdBarrier {
    unsigned* bar; unsigned x;
    volatile LAS unsigned* st;
};

__device__ __forceinline__ XcdBarrier xcd_barrier_post(unsigned* bar, volatile LAS unsigned* st) {
    XcdBarrier b; b.bar = bar; b.x = xb_xcc_id(); b.st = st;
    if (threadIdx.x == 0) (void)xb_add(&bar[XB_XCNT(b.x)], 1u);
    return b;
}
__device__ __forceinline__ void xcd_barrier_complete(unsigned* bar, unsigned x, unsigned& nloc, unsigned& nx) {
    const unsigned G = gridDim.x * gridDim.y * gridDim.z;
    unsigned sum, cnt, mine, sp = 0u;
    for (;;) {
        sum = 0u; cnt = 0u; mine = 0u;
#pragma unroll
        for (unsigned j = 0; j < 16; ++j) { const unsigned c = xb_ld(&bar[XB_XCNT(j)]); sum += c; cnt += (c > 0u) ? 1u : 0u; mine = (j == x) ? c : mine; }
        if (sum == G) break;
        __builtin_amdgcn_s_sleep(1);
        if ((++sp & 255u) == 0u) { if (xb_ld(&bar[XB_TMO])) break; if (sp > XB_SPIN_CAP) { atomicAdd(&bar[XB_TMO], 1u); break; } }
    }
    nloc = mine > 0u ? mine : 1u; nx = cnt > 0u ? cnt : 1u;
}

__device__ __forceinline__ void xcd_barrier(const XcdBarrier& b) {
    asm volatile("s_waitcnt vmcnt(0)" ::: "memory");
    __syncthreads();
    if (threadIdx.x == 0) {
        unsigned* bar = b.bar;
        __builtin_amdgcn_s_waitcnt(0);
        unsigned nloc = b.st[0], nx = b.st[1];
        if (nloc == 0u) { xcd_barrier_complete(bar, b.x, nloc, nx); b.st[0] = nloc; b.st[1] = nx; }
        const unsigned old = xb_add(&bar[XB_XSUB(b.x)], 1u);
        const unsigned gen = old / nloc;
        if (old + 1u == (gen + 1u) * nloc) {
            __builtin_amdgcn_fence(__ATOMIC_RELEASE, "agent");
            asm volatile("s_waitcnt vmcnt(0)" ::: "memory");
            const unsigned og = xb_add(&bar[XB_TOP], 1u);
            const unsigned tg = og / nx;
            if (og + 1u == (tg + 1u) * nx) xb_add(&bar[XB_TOPGEN], 1u);
            else XB_SPIN(xb_ld(&bar[XB_TOPGEN]) == tg, bar);
            __builtin_amdgcn_fence(__ATOMIC_ACQUIRE, "agent");
            xb_add(&bar[XB_XGEN(b.x)], 1u);
            asm volatile("s_waitcnt vmcnt(0)" ::: "memory");
        } else {
            XB_SPIN(xb_ld(&bar[XB_XGEN(b.x)]) == gen, bar);
            __builtin_amdgcn_fence(__ATOMIC_ACQUIRE, "agent");
            asm volatile("s_waitcnt vmcnt(0)" ::: "memory");
        }
    }
    __syncthreads();
}

constexpr int NWAVES = 8, NTHR = 512;
constexpr int DM = 1024, NB = 8, SEQ = 4096, CTXL = 256, DEPTH = 4;
constexpr int NLAT = NB * SEQ, NCTX = NB * CTXL, NT = NLAT + NCTX;
constexpr int PW = 2304;
constexpr int MW = 1280;
constexpr int NEXP = 32, MAXBLK = 576;
constexpr int NCHK = 544;
constexpr int S5ROWS = 2304;
constexpr int PC_FU = 0, PC_S5 = 256, PC_Q = 512, PC_K = 640, PC_V = 768, PC_R = 1024, PC_Z = 1280, PC_XBC = 1536, PC_A1 = 2048, PC_DT = 2080;
enum { I_X = 0, I_C, I_CTX, I_CCTX, I_ADAW, I_ADAB, I_NMG, I_NFG, I_WIN, I_WOUT, I_FOURW, I_S5LRE, I_S5LIM, I_S5LDT, I_S5BRE, I_S5BIM, I_S5CRE, I_S5CIM, I_S5D, I_S5GLU,
       I_GLAA2, I_GLAAB, I_GLANG, I_SSDCW, I_SSDCB, I_SSDALOG, I_SSDDTB, I_SSDD, I_SSDNG, I_RW, I_RB, I_WGU, I_BGU, I_WDN, I_BDN, I_FING, N_IN };

constexpr size_t al256(size_t x) { return (x + 255) & ~(size_t)255; }
constexpr size_t WS_CTL = 0, CTL_BYTES = 1u << 20;
constexpr size_t WS_MOD = WS_CTL + CTL_BYTES;
constexpr size_t WS_TAB = WS_MOD + al256((size_t)DEPTH * 9 * 6144 * 4);
constexpr size_t TAB_F64 = 0, TAB_TW = 16384, TAB_D256 = 16384 + 32768, TAB_BYTES = 65536;
constexpr size_t WS_A16 = WS_TAB + TAB_BYTES;
constexpr size_t WS_WIN = WS_A16 + al256((size_t)DEPTH * 2 * 16 * 64 * 2 * 4);
constexpr size_t WS_WOUT = WS_WIN + (size_t)DEPTH * PW * DM * 2;
constexpr size_t WS_WGLU = WS_WOUT + (size_t)DEPTH * DM * MW * 2;
constexpr size_t WS_S5P = WS_WGLU + (size_t)DEPTH * 256 * 256 * 2;
constexpr size_t WS_S5B2 = WS_S5P + (size_t)DEPTH * 16 * 256 * 256 * 2;
constexpr size_t WS_WGU = WS_S5B2 + (size_t)DEPTH * 16 * 256 * 512 * 2;
constexpr size_t WS_WDN = WS_WGU + (size_t)DEPTH * NEXP * 2048 * DM;
constexpr size_t WS_XS = WS_WDN + (size_t)DEPTH * NEXP * DM * DM;
constexpr size_t WS_H = WS_XS + (size_t)NT * DM * 2;
constexpr size_t WS_PBUF = WS_H + (size_t)NT * DM * 2;
constexpr size_t WS_A2 = WS_PBUF + (size_t)NT * PW * 2;
constexpr size_t WS_S5S = WS_A2 + (size_t)16 * S5ROWS * 512 * 2;
constexpr size_t WS_ACT5 = WS_S5S + (size_t)16 * S5ROWS * 256 * 4;
constexpr size_t WS_MIX = WS_ACT5 + (size_t)NT * 256 * 2;
constexpr size_t WS_GDS = WS_MIX + (size_t)NT * MW * 2;
constexpr size_t WS_GDEC = WS_GDS + (size_t)NCHK * 8 * 2048 * 4;
constexpr size_t WS_GSE = WS_GDEC + al256((size_t)NCHK * 8 * 32 * 4);
constexpr size_t WS_SDS = WS_GSE + (size_t)NCHK * 8 * 2048 * 2;
constexpr size_t WS_SDEC = WS_SDS + (size_t)NCHK * 8 * 4096 * 4;
constexpr size_t WS_SSE = WS_SDEC + al256((size_t)NCHK * 8 * 4);
constexpr size_t WS_PE = WS_SSE + (size_t)NCHK * 8 * 4096 * 2;
constexpr size_t WS_PR = WS_PE + (size_t)NT * 4 * 4;
constexpr size_t WS_PG = WS_PR + (size_t)NT * 4 * 4;
constexpr size_t WS_PS = WS_PG + (size_t)NT * 4 * 4;
constexpr size_t WS_SG = WS_PS + (size_t)NT * 4 * 4;
constexpr size_t WS_H8 = WS_SG + (size_t)MAXBLK * 256 * 4;
constexpr size_t WS_TM = WS_H8 + (size_t)NT * DM;
constexpr size_t WS_ACT = WS_TM + (size_t)NEXP * NT * 4;
constexpr size_t WS_Y = WS_ACT + (size_t)MAXBLK * 256 * DM;
constexpr size_t WS_GQI = WS_Y + (size_t)MAXBLK * 256 * DM;
constexpr size_t WS_GOI = WS_GQI + (size_t)NT * 256 * 2;
constexpr size_t WS_SCB = WS_GOI + (size_t)NT * 256 * 2;
constexpr size_t WS_SCUM = WS_SCB + (size_t)NT * 128 * 2;
constexpr size_t WS_SYI = WS_SCUM + (size_t)NT * 8 * 4;
constexpr size_t WS_DFTC = WS_SYI + (size_t)NT * 256 * 2;
constexpr size_t WS_GA2T = WS_DFTC + 512 * 256 * 2;
constexpr size_t WS_RWT = WS_GA2T + (size_t)DEPTH * 256 * 32 * 2;
constexpr size_t WS_END = WS_RWT + (size_t)DEPTH * 2 * 32 * 1024 * 2;
constexpr int CW_QUEUE = 64;
constexpr int CW_CNT = 1024;
constexpr int CW_BLKE = 2048;
constexpr int CW_BAR = 8192;

constexpr int LDS_BYTES = 163840, MISC_OFF = LDS_BYTES - 256;

#ifndef INPROJ_F8
#define INPROJ_F8 1
#endif
constexpr float W8_SCALE = 32.f, H8_SCALE = 8.f, A8_SCALE = 4.f, Y8_SCALE = 16.f;
__device__ __forceinline__ unsigned pk4f8(float a, float b, float c, float d) { int w = 0; w = __builtin_amdgcn_cvt_pk_fp8_f32(a, b, w, false); w = __builtin_amdgcn_cvt_pk_fp8_f32(c, d, w, true); return (unsigned)w; }
#define RLX_AGENT __ATOMIC_RELAXED, __HIP_MEMORY_SCOPE_AGENT
__device__ __forceinline__ int fresh_tid(int wave0) { int l = (int)__builtin_amdgcn_mbcnt_hi(~0u, __builtin_amdgcn_mbcnt_lo(~0u, 0u)); asm volatile("" : "+v"(l)); return wave0 * 64 + l; }
__device__ __forceinline__ unsigned f2bf(float f) { unsigned u = __builtin_bit_cast(unsigned, f); return (u + 0x7fffu + ((u >> 16) & 1u)) >> 16; }
__device__ __forceinline__ unsigned pk2(float lo, float hi) { return f2bf(lo) | (f2bf(hi) << 16); }
__device__ __forceinline__ float bf2f(unsigned short b) { return __builtin_bit_cast(float, (unsigned)b << 16); }
__device__ __forceinline__ f32x4 f8x4(unsigned w) { const f32x2 lo = __builtin_amdgcn_cvt_pk_f32_fp8((int)w, false), hi = __builtin_amdgcn_cvt_pk_f32_fp8((int)w, true); return (f32x4){lo.x, lo.y, hi.x, hi.y}; }
__device__ __forceinline__ f32x4 bf4(u32x2 w) { return (f32x4){__builtin_bit_cast(float, w.x << 16), __builtin_bit_cast(float, w.x & 0xffff0000u), __builtin_bit_cast(float, w.y << 16), __builtin_bit_cast(float, w.y & 0xffff0000u)}; }
__device__ __forceinline__ float bflo(unsigned w) { return __builtin_bit_cast(float, w << 16); }
__device__ __forceinline__ float bfhi(unsigned w) { return __builtin_bit_cast(float, w & 0xffff0000u); }
template <int M> __device__ __forceinline__ float swz_xor(float v) { return __builtin_bit_cast(float, __builtin_amdgcn_ds_swizzle(__builtin_bit_cast(int, v), (M << 10) | 0x1F)); }
__device__ __forceinline__ float xor32f(float v, int lane) { return __builtin_bit_cast(float, __builtin_amdgcn_ds_bpermute((lane ^ 32) << 2, __builtin_bit_cast(int, v))); }
__device__ __forceinline__ float wave_sum(float v, int lane) { v += swz_xor<1>(v); v += swz_xor<2>(v); v += swz_xor<4>(v); v += swz_xor<8>(v); v += swz_xor<16>(v); v += xor32f(v, lane); return v; }
__device__ __forceinline__ float wave_max(float v, int lane) { v = fmaxf(v, swz_xor<1>(v)); v = fmaxf(v, swz_xor<2>(v)); v = fmaxf(v, swz_xor<4>(v)); v = fmaxf(v, swz_xor<8>(v)); v = fmaxf(v, swz_xor<16>(v)); v = fmaxf(v, xor32f(v, lane)); return v; }
__device__ __forceinline__ float fexp_(float x) { return __builtin_amdgcn_exp2f(1.4426950408889634f * x); }
__device__ __forceinline__ float frcp_(float x) { return __builtin_amdgcn_rcpf(x); }
__device__ __forceinline__ float sigmoidf_(float x) { return frcp_(1.f + fexp_(-x)); }
__device__ __forceinline__ float siluf_(float x) { return x * frcp_(1.f + fexp_(-x)); }

struct Frame {
    LAS unsigned char* lds; volatile LAS unsigned* MISC; unsigned* ctl; unsigned char* ws;
    int tid, lane, wave, G, bid;
};


template <class Fill> struct SgOrder {
    int nblk, nN, R, r, lo, hi; Fill f;
    __device__ __forceinline__ void init(int nblk_, int nN_, int G, int c) { nblk = nblk_; nN = nN_; const int U = nblk * nN; int x, nx;
        if ((G & 7) == 0) { R = G >> 3; x = c & 7; r = c >> 3; nx = 8; } else { R = G; x = 0; r = c; nx = 1; }
        lo = (int)(((long)x * U) / nx); hi = (int)(((long)(x + 1) * U) / nx); }
    __device__ __forceinline__ bool next(int& cursor, pg8::Unit& u) const {
        const int q = lo + r + R * cursor; ++cursor;
        if (q >= hi) return false;
        const int ups = 8 * nN, sg = q / ups, ql = q - sg * ups, nb = (nblk - sg * 8) < 8 ? (nblk - sg * 8) : 8;
        u.pm = sg * 8 + ql % nb; u.pn = ql / nb; f(u); return true;
    }
};
struct FillPlain { size_t astep, bstep; __device__ __forceinline__ void operator()(pg8::Unit& u) const { u.grp = 0; u.aoff = (size_t)u.pm * astep; u.boff = (size_t)u.pn * bstep; } };
struct FillS5 { size_t bgrp; __device__ __forceinline__ void operator()(pg8::Unit& u) const { const int g = u.pm / 9, t = u.pm - g * 9; u.grp = g; u.pm = t; u.aoff = ((size_t)g * S5ROWS + (size_t)t * 256) * 512 * 2; u.boff = (size_t)g * bgrp; } };
struct FillMoe { const LAS unsigned* lblk; int erows; __device__ __forceinline__ void operator()(pg8::Unit& u) const { const int e = (int)lblk[u.pm]; u.grp = e; u.aoff = (size_t)u.pm * 256 * DM; u.boff = ((size_t)e * erows + (size_t)u.pn * 256) * DM; } };
constexpr int MOE_LB = 131072, MOE_LC = MOE_LB + 256, MOE_LBLK = MOE_LC + 256, MOE_GAT = MOE_LBLK + 2560, MOE_MAXU = 26;
static_assert(MOE_GAT + MOE_MAXU * 1024 <= MISC_OFF, "MoE LDS tables");
__device__ __forceinline__ int moe_tables(Frame& F, int L) {
    LAS int* lb = (LAS int*)(F.lds + MOE_LB); LAS int* lc = (LAS int*)(F.lds + MOE_LC); LAS unsigned* lblk = (LAS unsigned*)(F.lds + MOE_LBLK);
    const unsigned* cnt = F.ctl + CW_CNT + L * 64;
    __syncthreads();
    if (F.tid == 0) { int acc = 0; for (int e = 0; e < NEXP; ++e) { lb[e] = acc; const int c = (int)__hip_atomic_load(cnt + e, RLX_AGENT); lc[e] = c; acc += (c + 255) & ~255; } lb[32] = acc; }
    __syncthreads();
    const int nblk = lb[32] >> 8;
    for (int i = F.tid; i < nblk; i += NTHR) { int e = 0; for (int q = 1; q < NEXP; ++q) if (lb[q] <= i * 256) e = q; lblk[i] = (unsigned)e; }
    __syncthreads();
    return nblk;
}
using pg8::cvt_pk_bf16;
struct EpiInproj {
    static constexpr bool PERM = true;
    bf16* P; bf16* A2;
    __device__ __forceinline__ void operator()(const f32x4 (&acc)[2][2][4][2], const pg8::Unit& u, int wr, int wc, int fr, int fq) const {
        const int row0 = u.pm * 256 + wr * 64 + fr, col0 = u.pn * 256 + wc * 32 + 8 * fq;
#pragma unroll
        for (int ai = 0; ai < 2; ++ai)
#pragma unroll
            for (int m = 0; m < 4; ++m) {
                const int row = row0 + ai * 128 + m * 16;
#pragma unroll
                for (int bj = 0; bj < 2; ++bj) {
                    constexpr float SC = INPROJ_F8 ? 1.f / (W8_SCALE * H8_SCALE) : 1.f;
                    const f32x4 v0 = acc[ai][bj][m][0] * SC, v1 = acc[ai][bj][m][1] * SC;
                    u32x4 w; w.x = cvt_pk_bf16(v0[0], v0[1]); w.y = cvt_pk_bf16(v0[2], v0[3]); w.z = cvt_pk_bf16(v1[0], v1[1]); w.w = cvt_pk_bf16(v1[2], v1[3]);
                    const int col = col0 + bj * 128;
                    if (u.pn == 1) {
                        const int cc = col - 256, g = cc >> 4, hp = cc & 15;
                        const int crow = row < NLAT ? (row >> 4) : (2048 + ((row - NLAT) >> 4)), s = row & 15;
                        *(u32x4*)(A2 + ((size_t)g * S5ROWS + crow) * 512 + s * 16 + hp) = w;
                    } else if (col < 2088) *(u32x4*)(P + (size_t)row * PW + col) = w;
                }
            }
    }
};
struct EpiOutproj {
    static constexpr bool PERM = true;
    const float* xin; const float* ctxin; bf16* XS; const float* modL; int first;
    __device__ __forceinline__ void operator()(const f32x4 (&acc)[2][2][4][2], const pg8::Unit& u, int wr, int wc, int fr, int fq) const {
        const int rowt = u.pm * 256, bi = rowt < NLAT ? (rowt >> 12) : 8;
        const int row0 = rowt + wr * 64 + fr, col0 = u.pn * 256 + wc * 32 + 8 * fq;
        const float* gate = modL + (size_t)bi * 6144 + 2 * 1024;
        f32x4 gv[2][2];
#pragma unroll
        for (int bj = 0; bj < 2; ++bj)
#pragma unroll
            for (int n = 0; n < 2; ++n) gv[bj][n] = *(const f32x4*)(gate + col0 + bj * 128 + 4 * n);
#pragma unroll
        for (int ai = 0; ai < 2; ++ai)
#pragma unroll
            for (int m = 0; m < 4; ++m) {
                const int row = row0 + ai * 128 + m * 16;
                bf16* dst = XS + (size_t)row * DM;
#pragma unroll
                for (int bj = 0; bj < 2; ++bj) { const int c = col0 + bj * 128; f32x4 x0, x1;
                    if (first) { const float* src = (row < NLAT ? xin + (size_t)row * DM : ctxin + (size_t)(row - NLAT) * DM) + c; x0 = *(const f32x4*)src; x1 = *(const f32x4*)(src + 4); }
                    else { const u32x4 w = *(const u32x4*)(dst + c); x0 = bf4((u32x2){w.x, w.y}); x1 = bf4((u32x2){w.z, w.w}); }
                    x0 += gv[bj][0] * acc[ai][bj][m][0]; x1 += gv[bj][1] * acc[ai][bj][m][1];
                    u32x4 o; o.x = cvt_pk_bf16(x0[0], x0[1]); o.y = cvt_pk_bf16(x0[2], x0[3]); o.z = cvt_pk_bf16(x1[0], x1[1]); o.w = cvt_pk_bf16(x1[2], x1[3]);
                    *(u32x4*)(dst + c) = o; }
            }
    }
};
struct EpiSwiglu {
    static constexpr bool PERM = true;
    unsigned char* ACT; const float* bgu;
    __device__ __forceinline__ void operator()(const f32x4 (&acc)[2][2][4][2], const pg8::Unit& u, int wr, int wc, int fr, int fq) const {
        const int row0 = u.pm * 256 + wr * 64 + fr, i0 = u.pn * 128 + wc * 32 + 8 * fq;
        const float* bb = bgu + (size_t)u.grp * 2048 + 2 * i0;
        const f32x4 b0 = *(const f32x4*)(bb), b1 = *(const f32x4*)(bb + 4), b2 = *(const f32x4*)(bb + 8), b3 = *(const f32x4*)(bb + 12);
        const float bg[8] = {b0[0], b0[2], b1[0], b1[2], b2[0], b2[2], b3[0], b3[2]}, bu[8] = {b0[1], b0[3], b1[1], b1[3], b2[1], b2[3], b3[1], b3[3]};
        constexpr float inv = 1.f / (H8_SCALE * W8_SCALE);
#pragma unroll
        for (int ai = 0; ai < 2; ++ai)
#pragma unroll
            for (int m = 0; m < 4; ++m) {
                const int row = row0 + ai * 128 + m * 16;
                float o[8];
#pragma unroll
                for (int n = 0; n < 2; ++n)
#pragma unroll
                    for (int jp = 0; jp < 2; ++jp) {
                        const int q = 4 * n + 2 * jp;
                        f32x2 gt = (f32x2){acc[ai][0][m][n][2 * jp], acc[ai][0][m][n][2 * jp + 1]} * inv + (f32x2){bg[q], bg[q + 1]};
                        f32x2 up = (f32x2){acc[ai][1][m][n][2 * jp], acc[ai][1][m][n][2 * jp + 1]} * inv + (f32x2){bu[q], bu[q + 1]};
                        gt.x = fminf(gt.x, 7.0f); gt.y = fminf(gt.y, 7.0f);
                        up.x = __builtin_amdgcn_fmed3f(up.x, -7.0f, 7.0f); up.y = __builtin_amdgcn_fmed3f(up.y, -7.0f, 7.0f);
                        const f32x2 ea = gt * (-1.702f * 1.4426950408889634f);
                        f32x2 den; den.x = __builtin_amdgcn_exp2f(ea.x); den.y = __builtin_amdgcn_exp2f(ea.y); den = den + 1.0f;
                        f32x2 sg; sg.x = __builtin_amdgcn_rcpf(den.x); sg.y = __builtin_amdgcn_rcpf(den.y);
                        const f32x2 r = (up * A8_SCALE + A8_SCALE) * gt * sg;
                        o[q] = r.x; o[q + 1] = r.y;
                    }
                u32x2 w; w.x = pk4f8(o[0], o[1], o[2], o[3]); w.y = pk4f8(o[4], o[5], o[6], o[7]);
                *(u32x2*)(ACT + (size_t)row * DM + i0) = w;
            }
    }
};
struct EpiDown {
    static constexpr int PERM = 2;
    unsigned char* Y; const float* bdn; const float* sg;
    __device__ __forceinline__ void operator()(const f32x4 (&acc)[2][2][4][2], const pg8::Unit& u, int wr, int wc, int fr, int fq) const {
        const int row0 = u.pm * 256 + wr * 64 + fr, col0 = u.pn * 256 + wc * 64 + 16 * fq;
        const float* bb = bdn + (size_t)u.grp * DM + col0;
        constexpr float inv = 1.f / (A8_SCALE * W8_SCALE);
        f32x4 bv[2][2];
#pragma unroll
        for (int bj = 0; bj < 2; ++bj)
#pragma unroll
            for (int n = 0; n < 2; ++n) bv[bj][n] = *(const f32x4*)(bb + 8 * bj + 4 * n);
#pragma unroll
        for (int ai = 0; ai < 2; ++ai)
#pragma unroll
            for (int m = 0; m < 4; ++m) {
                const int row = row0 + ai * 128 + m * 16; const float gt = sg[row] * Y8_SCALE;
                u32x4 w;
                { const f32x4 v0 = (acc[ai][0][m][0] * inv + bv[0][0]) * gt, v1 = (acc[ai][0][m][1] * inv + bv[0][1]) * gt; w.x = pk4f8(v0[0], v0[1], v0[2], v0[3]); w.y = pk4f8(v1[0], v1[1], v1[2], v1[3]); }
                { const f32x4 v0 = (acc[ai][1][m][0] * inv + bv[1][0]) * gt, v1 = (acc[ai][1][m][1] * inv + bv[1][1]) * gt; w.z = pk4f8(v0[0], v0[1], v0[2], v0[3]); w.w = pk4f8(v1[0], v1[1], v1[2], v1[3]); }
                *(u32x4*)(Y + (size_t)row * DM + col0) = w;
            }
    }
};
struct EpiNull { static constexpr bool PERM = true; float* sink;
    __device__ __forceinline__ void operator()(const f32x4 (&acc)[2][2][4][2], const pg8::Unit& u, int wr, int wc, int fr, int fq) const { float s = 0.f;
#pragma unroll
        for (int ai = 0; ai < 2; ++ai)
#pragma unroll
            for (int bj = 0; bj < 2; ++bj)
#pragma unroll
                for (int m = 0; m < 4; ++m)
#pragma unroll
                    for (int n = 0; n < 2; ++n) s += acc[ai][bj][m][n][0];
        if (s == 12345.678f) sink[u.pm] = s; } };
struct EpiS5S {
    static constexpr bool PERM = false;
    float* S;
    __device__ __forceinline__ void operator()(const f32x4 (&acc)[2][2][4][2], const pg8::Unit& u, int wr, int wc, int fr, int fq) const {
        const int row0 = u.pm * 256 + wr * 64 + fr, col0 = wc * 32 + 4 * fq;
        float* base = S + (size_t)u.grp * S5ROWS * 256;
#pragma unroll
        for (int ai = 0; ai < 2; ++ai)
#pragma unroll
            for (int m = 0; m < 4; ++m) { float* rp = base + (size_t)(row0 + ai * 128 + m * 16) * 256 + col0;
#pragma unroll
                for (int bj = 0; bj < 2; ++bj)
#pragma unroll
                    for (int n = 0; n < 2; ++n) *(f32x4*)(rp + bj * 128 + n * 16) = acc[ai][bj][m][n]; }
    }
};
__device__ __forceinline__ float gelu_tanh(float x) { const float t = 0.7978845608f * (x + 0.044715f * x * x * x); return x * frcp_(1.f + fexp_(-2.f * t)); }
struct EpiS5Y {
    static constexpr bool PERM = true;
    bf16* ACT5;
    __device__ __forceinline__ void operator()(const f32x4 (&acc)[2][2][4][2], const pg8::Unit& u, int wr, int wc, int fr, int fq) const {
        const int row0 = u.pm * 256 + wr * 64 + fr, col0 = wc * 32 + 8 * fq;
#pragma unroll
        for (int ai = 0; ai < 2; ++ai)
#pragma unroll
            for (int m = 0; m < 4; ++m) {
                const int crow = row0 + ai * 128 + m * 16;
                if (crow >= 2176) continue;
                const int tok0 = crow < 2048 ? crow * 16 : NLAT + (crow - 2048) * 16;
#pragma unroll
                for (int bj = 0; bj < 2; ++bj) {
                    const int col = col0 + bj * 128, j = col >> 4, h = col & 15;
                    const f32x4 v0 = acc[ai][bj][m][0], v1 = acc[ai][bj][m][1];
                    u32x4 w; w.x = cvt_pk_bf16(gelu_tanh(v0[0]), gelu_tanh(v0[1])); w.y = cvt_pk_bf16(gelu_tanh(v0[2]), gelu_tanh(v0[3]));
                    w.z = cvt_pk_bf16(gelu_tanh(v1[0]), gelu_tanh(v1[1])); w.w = cvt_pk_bf16(gelu_tanh(v1[2]), gelu_tanh(v1[3]));
                    *(u32x4*)(ACT5 + (size_t)(tok0 + j) * 256 + u.grp * 16 + h) = w;
                }
            }
    }
};
struct EpiGlu {
    static constexpr bool PERM = true;
    const bf16* ACT5; bf16* MIX;
    __device__ __forceinline__ void operator()(const f32x4 (&acc)[2][2][4][2], const pg8::Unit& u, int wr, int wc, int fr, int fq) const {
        const int row0 = u.pm * 256 + wr * 64 + fr, col0 = wc * 32 + 8 * fq;
#pragma unroll
        for (int ai = 0; ai < 2; ++ai)
#pragma unroll
            for (int m = 0; m < 4; ++m) {
                const int row = row0 + ai * 128 + m * 16;
#pragma unroll
                for (int bj = 0; bj < 2; ++bj) {
                    const int col = col0 + bj * 128;
                    const u32x4 a = *(const u32x4*)(ACT5 + (size_t)row * 256 + col);
                    const f32x4 v0 = acc[ai][bj][m][0], v1 = acc[ai][bj][m][1];
                    u32x4 w;
                    w.x = cvt_pk_bf16(bflo(a.x) * sigmoidf_(v0[0]), bfhi(a.x) * sigmoidf_(v0[1])); w.y = cvt_pk_bf16(bflo(a.y) * sigmoidf_(v0[2]), bfhi(a.y) * sigmoidf_(v0[3]));
                    w.z = cvt_pk_bf16(bflo(a.z) * sigmoidf_(v1[0]), bfhi(a.z) * sigmoidf_(v1[1])); w.w = cvt_pk_bf16(bflo(a.w) * sigmoidf_(v1[2]), bfhi(a.w) * sigmoidf_(v1[3]));
                    *(u32x4*)(MIX + (size_t)row * MW + 512 + col) = w;
                }
            }
    }
};

struct Args { const float* in[N_IN]; float* out; unsigned char* ws; int ph_lo, ph_hi; };
typedef const __attribute__((address_space(4))) Args CArgs;
__device__ __forceinline__ CArgs* fresh_args() { CArgs* p = (CArgs*)__builtin_amdgcn_kernarg_segment_ptr(); asm volatile("" : "+s"(p)); return p; }

template <class Map> __device__ __forceinline__ void transpose_tile(const float* W, int ldw, int ncols, int k0, int n0, bf16* WT, int ldt, int kd0, const Map& map, LAS float* scr, int lane) {
    { const int c4 = (lane & 15) * 4, r4 = lane >> 4; const bool ok = n0 + c4 < ncols;
#pragma unroll
      for (int q = 0; q < 16; ++q) { const int kk = q * 4 + r4; const f32x4 v = ok ? *(const f32x4*)(W + (size_t)(k0 + kk) * ldw + n0 + c4) : (f32x4){0.f, 0.f, 0.f, 0.f};
          scr[kk * 65 + c4] = v[0]; scr[kk * 65 + c4 + 1] = v[1]; scr[kk * 65 + c4 + 2] = v[2]; scr[kk * 65 + c4 + 3] = v[3]; } }
    asm volatile("s_waitcnt lgkmcnt(0)" ::: "memory");
    const int c = lane & 7;
#pragma unroll
    for (int j = 0; j < 8; ++j) {
        const int n = (lane >> 3) + 8 * j; const LAS float* s = scr + (8 * c) * 65 + n;
        u32x4 o; o.x = pk2(s[0], s[65]); o.y = pk2(s[2 * 65], s[3 * 65]); o.z = pk2(s[4 * 65], s[5 * 65]); o.w = pk2(s[6 * 65], s[7 * 65]);
        const int dr = (n0 + n) < ncols ? map(n0 + n) : -1;
        if (dr >= 0) *(u32x4*)(WT + (size_t)dr * ldt + kd0 + 8 * c) = o;
    }
    asm volatile("s_waitcnt lgkmcnt(0)" ::: "memory");
}
struct MapId { __device__ __forceinline__ int operator()(int n) const { return n; } };
struct MapWin { __device__ __forceinline__ int operator()(int c) const { return c < 1280 ? c : (c < 1312 ? 2048 + (c - 1280) : (c < 2080 ? c - 32 : c)); } };
struct MapGu { __device__ __forceinline__ int operator()(int n) const { const int i = n >> 1; return (i >> 7) * 256 + (n & 1) * 128 + (i & 127); } };

template <class Map> __device__ __forceinline__ void transpose_tile_f8(const float* W, int ldw, int k0, int n0, unsigned char* WT, int ldt, const Map& map, LAS float* scr, int lane) {
    { const int c4 = (lane & 15) * 4, r4 = lane >> 4;
#pragma unroll
      for (int q = 0; q < 16; ++q) { const int kk = q * 4 + r4; const f32x4 v = *(const f32x4*)(W + (size_t)(k0 + kk) * ldw + n0 + c4);
          scr[kk * 65 + c4] = v[0]; scr[kk * 65 + c4 + 1] = v[1]; scr[kk * 65 + c4 + 2] = v[2]; scr[kk * 65 + c4 + 3] = v[3]; } }
    asm volatile("s_waitcnt lgkmcnt(0)" ::: "memory");
    const int c = lane & 7;
#pragma unroll
    for (int j = 0; j < 8; ++j) {
        const int n = (lane >> 3) + 8 * j; const LAS float* s = scr + (8 * c) * 65 + n;
        u32x2 o; o.x = pk4f8(s[0] * W8_SCALE, s[65] * W8_SCALE, s[2 * 65] * W8_SCALE, s[3 * 65] * W8_SCALE); o.y = pk4f8(s[4 * 65] * W8_SCALE, s[5 * 65] * W8_SCALE, s[6 * 65] * W8_SCALE, s[7 * 65] * W8_SCALE);
        *(u32x2*)(WT + (size_t)map(n0 + n) * ldt + k0 + 8 * c) = o;
    }
    asm volatile("s_waitcnt lgkmcnt(0)" ::: "memory");
}
constexpr int PI_ADA = 48, PI_TAB = 1, PI_S5 = 64, PI_FOLD = 256, PI_ZERO = 4;
constexpr int TW_WIN = 16 * 33, TW_GU = 32 * 16 * 32, TW_DN = 32 * 16 * 16, TW_WOUT = 12 * 16, TW_GLU = 16, TW_LAYER = TW_WIN + TW_GU + TW_DN + TW_WOUT + TW_GLU;
constexpr int PI_TR = (DEPTH * TW_LAYER + 7) / 8;
constexpr int PI_B_TAB = PI_ADA, PI_B_S5 = PI_B_TAB + PI_TAB, PI_B_FOLD = PI_B_S5 + PI_S5, PI_B_ZERO = PI_B_FOLD + PI_FOLD, PI_B_TR = PI_B_ZERO + PI_ZERO, PI_TOTAL = PI_B_TR + (PI_TR + 3) / 4;

__device__ __forceinline__ void pro_adaln(Frame& F, CArgs& a, int it) {
    const int L = it / 12, cb = it % 12;
    LAS float* cond = (LAS float*)F.lds;
    for (int i = F.tid; i < 9 * 1024; i += NTHR) { const int r = i >> 10, k = i & 1023; const float v = r < 8 ? a.in[I_C][r * 1024 + k] : a.in[I_CCTX][k]; cond[i] = siluf_(v); }
    __syncthreads();
    const int n = cb * 512 + F.tid;
    const float* w = a.in[I_ADAW] + (size_t)L * 1024 * 6144 + n;
    float acc[9];
    const float b = a.in[I_ADAB][L * 6144 + n];
#pragma unroll
    for (int r = 0; r < 9; ++r) acc[r] = b;
#pragma unroll 8
    for (int k = 0; k < 1024; k += 4) {
        const float w0 = w[(size_t)k * 6144], w1 = w[(size_t)(k + 1) * 6144], w2 = w[(size_t)(k + 2) * 6144], w3 = w[(size_t)(k + 3) * 6144];
#pragma unroll
        for (int r = 0; r < 9; ++r) { const f32x4 c4 = *(const LAS f32x4*)(cond + r * 1024 + k); acc[r] += c4[0] * w0 + c4[1] * w1 + c4[2] * w2 + c4[3] * w3; }
    }
    float* mod = (float*)(F.ws + WS_MOD) + (size_t)L * 9 * 6144 + n;
#pragma unroll
    for (int r = 0; r < 9; ++r) mod[(size_t)r * 6144] = acc[r];
    __syncthreads();
}
__device__ __forceinline__ void pro_tables(Frame& F, CArgs& a) {
    { bf16* gt = (bf16*)(F.ws + WS_GA2T);
      for (int i = F.tid; i < DEPTH * 256 * 32; i += NTHR) { const int L = i >> 13, col = (i >> 5) & 255, k = i & 31, r = col >> 7, c = col & 127;
          gt[i] = (bf16)f2bf((k >> 4) == r ? a.in[I_GLAA2][((size_t)(L * 2 + r) * 16 + (k & 15)) * 128 + c] : 0.f); } }
    { bf16* rt = (bf16*)(F.ws + WS_RWT);
      for (int i = F.tid; i < DEPTH * 32768; i += NTHR) { const int L = i >> 15, e = (i >> 10) & 31, k = i & 1023; const float w = a.in[I_RW][((size_t)L * DM + k) * NEXP + e];
          const unsigned hi = f2bf(w); rt[(size_t)L * 65536 + e * 1024 + k] = (bf16)hi; rt[(size_t)L * 65536 + 32768 + e * 1024 + k] = (bf16)f2bf(w - bf2f((unsigned short)hi)); } }
    bf16* f64 = (bf16*)(F.ws + WS_TAB + TAB_F64);
    for (int i = F.tid; i < 4096; i += NTHR) { const int k = i >> 6, n = i & 63; float s, c; sincospif((float)((k * n) & 63) / 32.f, &s, &c); f64[i] = (bf16)f2bf(c); f64[4096 + i] = (bf16)f2bf(s); }
    float* tw = (float*)(F.ws + WS_TAB + TAB_TW);
    for (int i = F.tid; i < 4096; i += NTHR) { float s, c; sincospif((float)i / 2048.f, &s, &c); tw[2 * i] = c; tw[2 * i + 1] = s; }
    bf16* dc = (bf16*)(F.ws + WS_DFTC);
    for (int i = F.tid; i < 65536; i += NTHR) { const int k = i >> 8, n = i & 255; float s, c; sincospif((float)((k * n) & 255) / 128.f, &s, &c); dc[i] = (bf16)f2bf(c); dc[65536 + i] = (bf16)f2bf(-s); }
    float* d256 = (float*)(F.ws + WS_TAB + TAB_D256);
    for (int i = F.tid; i < 256; i += NTHR) { float s, c; sincospif((float)i / 128.f, &s, &c); d256[2 * i] = c; d256[2 * i + 1] = s; }
}
__device__ __forceinline__ void pro_fold(Frame& F, CArgs& a, int it) {
    const int L = it >> 6, h = (it >> 4) & 3, nb = it & 15, n0 = nb * 64;
    LAS float* fw = (LAS float*)F.lds;
    LAS float* ct = fw + 64 * 65;
    LAS float* swo = ct + 64;
    LAS float* sfo = swo + 256 * 64;
    if (F.tid < 64) ct[F.tid] = cospif((float)F.tid / 32.f);
    const float* four = a.in[I_FOURW] + (size_t)L * 256 * 256 + (size_t)h * 64 * 256, *wo = a.in[I_WOUT] + (size_t)L * 1024 * 1024 + n0;
    { f32x4 va[8], vb[8];
#pragma unroll
      for (int k = 0; k < 8; ++k) { const int i = F.tid + k * NTHR, j = i >> 4, c4 = (i & 15) * 4; va[k] = *(const f32x4*)(wo + (size_t)j * 1024 + c4); vb[k] = *(const f32x4*)(four + (size_t)i * 4); }
#pragma unroll
      for (int k = 0; k < 8; ++k) { const int i = F.tid + k * NTHR, j = i >> 4, c4 = (i & 15) * 4; *(LAS f32x4*)(swo + j * 64 + c4) = va[k]; *(LAS f32x4*)(sfo + i * 4) = vb[k]; } }
    __syncthreads();
    const int n = F.tid & 63, cg = F.tid >> 6;
    { float s[8];
#pragma unroll
      for (int i = 0; i < 8; ++i) s[i] = 0.f;
#pragma unroll 4
      for (int j = 0; j < 256; j += 4) { const float w0 = swo[j * 64 + n], w1 = swo[(j + 1) * 64 + n], w2 = swo[(j + 2) * 64 + n], w3 = swo[(j + 3) * 64 + n];
#pragma unroll
          for (int i = 0; i < 8; ++i) { const f32x4 f4 = *(const LAS f32x4*)(sfo + (cg * 8 + i) * 256 + j); s[i] += f4[0] * w0 + f4[1] * w1 + f4[2] * w2 + f4[3] * w3; } }
#pragma unroll
      for (int i = 0; i < 8; ++i) fw[(cg * 8 + i) * 65 + n] = s[i]; }
    __syncthreads();
    float oc[8], os[8];
#pragma unroll
    for (int i = 0; i < 8; ++i) { oc[i] = 0.f; os[i] = 0.f; }
    for (int kc = 0; kc < 64; ++kc) { const float v = fw[kc * 65 + n];
#pragma unroll
        for (int i = 0; i < 8; ++i) { const int mm = (kc * (cg * 8 + i)) & 63; oc[i] += ct[mm] * v; os[i] += ct[(mm + 48) & 63] * v; } }
    bf16* wt = (bf16*)(F.ws + WS_WOUT) + (size_t)L * DM * MW + (size_t)(n0 + n) * MW + h * 64 + cg * 8;
    u32x4 w; w.x = pk2(oc[0] * 0.125f, oc[1] * 0.125f); w.y = pk2(oc[2] * 0.125f, oc[3] * 0.125f); w.z = pk2(oc[4] * 0.125f, oc[5] * 0.125f); w.w = pk2(oc[6] * 0.125f, oc[7] * 0.125f);
    *(u32x4*)wt = w;
    w.x = pk2(os[0] * 0.125f, os[1] * 0.125f); w.y = pk2(os[2] * 0.125f, os[3] * 0.125f); w.z = pk2(os[4] * 0.125f, os[5] * 0.125f); w.w = pk2(os[6] * 0.125f, os[7] * 0.125f);
    *(u32x4*)(wt + 256) = w;
    __syncthreads();
}
__device__ __forceinline__ void pro_s5(Frame& F, CArgs& a, int it) {
    const int L = it >> 4, g = it & 15;
    LAS float* pw = (LAS float*)F.lds;
    LAS float* bb = pw + 2 * 64 * 17 * 2;
    LAS float* cm = bb + 2 * 64 * 16 * 2;
    LAS float* kt = cm + 2 * 16 * 64 * 2;
    for (int i = F.tid; i < 2 * 64 * 17; i += NTHR) {
        const int r = i / (64 * 17), p = (i / 17) & 63, e = i % 17; const size_t q = ((size_t)(L * 2 + r) * 16 + g) * 64 + p;
        const float dt = __expf(a.in[I_S5LDT][(L * 2 + r) * 16 + g]); const float lr = a.in[I_S5LRE][q] * dt, li = a.in[I_S5LIM][q] * dt;
        float s, c; sincosf(li * (float)e, &s, &c); const float m = expf(lr * (float)e); pw[2 * i] = m * c; pw[2 * i + 1] = m * s;
    }
    for (int i = F.tid; i < 2 * 64 * 16; i += NTHR) {
        const int r = i >> 10, p = (i >> 4) & 63, h = i & 15; const size_t q = ((size_t)(L * 2 + r) * 16 + g) * 64 + p;
        const float dt = __expf(a.in[I_S5LDT][(L * 2 + r) * 16 + g]); const float lre = a.in[I_S5LRE][q], lim = a.in[I_S5LIM][q];
        float s, c; sincosf(lim * dt, &s, &c); const float m = expf(lre * dt); const float ar = m * c - 1.f, ai = m * s;
        const float den = 1.f / (lre * lre + lim * lim); const float cr = (ar * lre + ai * lim) * den, ci = (ai * lre - ar * lim) * den;
        const float br = a.in[I_S5BRE][q * 16 + h], bi = a.in[I_S5BIM][q * 16 + h];
        bb[2 * i] = cr * br - ci * bi; bb[2 * i + 1] = cr * bi + ci * br;
    }
    for (int i = F.tid; i < 2 * 16 * 64; i += NTHR) {
        const int r = i >> 10, h = (i >> 6) & 15, p = i & 63; const size_t q = (((size_t)(L * 2 + r) * 16 + g) * 16 + h) * 64 + p;
        cm[2 * i] = a.in[I_S5CRE][q]; cm[2 * i + 1] = a.in[I_S5CIM][q];
    }
    __syncthreads();
    for (int i = F.tid; i < 2 * 16 * 256; i += NTHR) {
        const int r = i >> 12, tau = (i >> 8) & 15, h = (i >> 4) & 15, hp = i & 15; float s = 0.f;
        for (int p = 0; p < 64; ++p) { const float cr = cm[2 * ((r * 16 + h) * 64 + p)], ci = cm[2 * ((r * 16 + h) * 64 + p) + 1];
            const float ar = pw[2 * ((r * 64 + p) * 17 + tau)], ai = pw[2 * ((r * 64 + p) * 17 + tau) + 1]; const float br = bb[2 * ((r * 64 + p) * 16 + hp)], bi = bb[2 * ((r * 64 + p) * 16 + hp) + 1];
            const float tr = cr * ar - ci * ai, ti = cr * ai + ci * ar; s += tr * br - ti * bi; }
        kt[i] = s;
    }
    __syncthreads();
    bf16* pt = (bf16*)(F.ws + WS_S5P) + (size_t)(L * 16 + g) * 256 * 256;
    for (int i = F.tid; i < 65536; i += NTHR) {
        const int np = i >> 8, k = i & 255, r = np >> 7, cpx = (np >> 6) & 1, p = np & 63, s = k >> 4, hp = k & 15, e = r ? s : 15 - s;
        const float ar = pw[2 * ((r * 64 + p) * 17 + e)], ai = pw[2 * ((r * 64 + p) * 17 + e) + 1]; const float br = bb[2 * ((r * 64 + p) * 16 + hp)], bi = bb[2 * ((r * 64 + p) * 16 + hp) + 1];
        pt[i] = (bf16)f2bf(cpx ? ar * bi + ai * br : ar * br - ai * bi);
    }
    bf16* b2 = (bf16*)(F.ws + WS_S5B2) + (size_t)(L * 16 + g) * 256 * 512;
    const float* dsk = a.in[I_S5D] + L * 256 + g * 16;
    for (int i = F.tid; i < 131072; i += NTHR) {
        const int n = i >> 9, k = i & 511, j = n >> 4, h = n & 15; float v;
        if (k < 256) { const int s = k >> 4, hp = k & 15; v = 0.f;
            if (j >= s) v += kt[((0 * 16 + (j - s)) * 16 + h) * 16 + hp];
            if (j <= s) v += kt[((1 * 16 + (s - j)) * 16 + h) * 16 + hp];
            if (j == s && h == hp) v += dsk[h];
        } else { const int kk = k - 256, r = kk >> 7, cpx = (kk >> 6) & 1, p = kk & 63, e = r ? 16 - j : j + 1;
            const float cr = cm[2 * ((r * 16 + h) * 64 + p)], ci = cm[2 * ((r * 16 + h) * 64 + p) + 1]; const float ar = pw[2 * ((r * 64 + p) * 17 + e)], ai = pw[2 * ((r * 64 + p) * 17 + e) + 1];
            v = cpx ? -(cr * ai + ci * ar) : (cr * ar - ci * ai); }
        b2[i] = (bf16)f2bf(v);
    }
    float* a16 = (float*)(F.ws + WS_A16) + (size_t)((L * 2) * 16 + g) * 128;
    if (F.tid < 128) { const int r = F.tid >> 6, p = F.tid & 63; float* o = a16 + (size_t)r * 16 * 128 + p * 2; o[0] = pw[2 * ((r * 64 + p) * 17 + 16)]; o[1] = pw[2 * ((r * 64 + p) * 17 + 16) + 1]; }
    __syncthreads();
}
struct TDesc { const float* src; unsigned char* dst; int ldw, ncols, k0, n0, ldt, kd0, kind, valid; };
__device__ __forceinline__ TDesc tr_decode(Frame& F, int wi) {
    TDesc d; d.valid = wi < DEPTH * TW_LAYER; d.src = nullptr; d.dst = nullptr; d.ldw = d.ncols = d.k0 = d.n0 = d.ldt = d.kd0 = d.kind = 0;
    if (!d.valid) return d;
    const int L = wi / TW_LAYER; int r = wi % TW_LAYER;
    if (r < TW_WIN) { const int kb = r / 33, nb = r % 33; d.src = fresh_args()->in[I_WIN] + (size_t)L * DM * 2088; d.ldw = 2088; d.ncols = 2088; d.k0 = kb * 64; d.n0 = nb * 64; d.dst = F.ws + WS_WIN + (size_t)L * PW * DM * (INPROJ_F8 ? 1 : 2); d.ldt = DM; d.kd0 = kb * 64; d.kind = INPROJ_F8 ? 4 : 0; return d; } r -= TW_WIN;
    if (r < TW_GU) { const int e = r >> 9, kb = (r >> 5) & 15, nb = r & 31; d.src = fresh_args()->in[I_WGU] + ((size_t)L * NEXP + e) * DM * 2048; d.ldw = 2048; d.ncols = 2048; d.k0 = kb * 64; d.n0 = nb * 64; d.dst = F.ws + WS_WGU + ((size_t)L * NEXP + e) * 2048 * DM; d.ldt = DM; d.kd0 = kb * 64; d.kind = 1; return d; } r -= TW_GU;
    if (r < TW_DN) { const int e = r >> 8, kb = (r >> 4) & 15, nb = r & 15; d.src = fresh_args()->in[I_WDN] + ((size_t)L * NEXP + e) * DM * DM; d.ldw = DM; d.ncols = DM; d.k0 = kb * 64; d.n0 = nb * 64; d.dst = F.ws + WS_WDN + ((size_t)L * NEXP + e) * DM * DM; d.ldt = DM; d.kd0 = kb * 64; d.kind = 2; return d; } r -= TW_DN;
    if (r < TW_WOUT) { const int kb = r >> 4, nb = r & 15; d.src = fresh_args()->in[I_WOUT] + (size_t)L * DM * DM + (size_t)256 * DM; d.ldw = DM; d.ncols = DM; d.k0 = kb * 64; d.n0 = nb * 64; d.dst = F.ws + WS_WOUT + (size_t)L * DM * MW * 2; d.ldt = MW; d.kd0 = 512 + kb * 64; d.kind = 3; return d; } r -= TW_WOUT;
    { const int kb = r >> 2, nb = r & 3; d.src = fresh_args()->in[I_S5GLU] + (size_t)L * 256 * 256; d.ldw = 256; d.ncols = 256; d.k0 = kb * 64; d.n0 = nb * 64; d.dst = F.ws + WS_WGLU + (size_t)L * 256 * 256 * 2; d.ldt = 256; d.kd0 = kb * 64; d.kind = 3; }
    return d;
}
__device__ __forceinline__ void tr_load(const TDesc& d, f32x4 (&v)[16], int lane) {
    if (!d.valid) return;
    const int c4 = (lane & 15) * 4, r4 = lane >> 4; const bool ok = d.n0 + c4 < d.ncols;
#pragma unroll
    for (int q = 0; q < 16; ++q) v[q] = ok ? *(const f32x4*)(d.src + (size_t)(d.k0 + q * 4 + r4) * d.ldw + d.n0 + c4) : (f32x4){0.f, 0.f, 0.f, 0.f};
}
__device__ __forceinline__ void tr_finish(const TDesc& d, const f32x4 (&v)[16], LAS float* scr, int lane) {
    if (!d.valid) return;
    { const int c4 = (lane & 15) * 4, r4 = lane >> 4;
#pragma unroll
      for (int q = 0; q < 16; ++q) { const int kk = q * 4 + r4; scr[kk * 65 + c4] = v[q][0]; scr[kk * 65 + c4 + 1] = v[q][1]; scr[kk * 65 + c4 + 2] = v[q][2]; scr[kk * 65 + c4 + 3] = v[q][3]; } }
    asm volatile("s_waitcnt lgkmcnt(0)" ::: "memory");
    const int c = lane & 7;
    if (d.kind == 1 || d.kind == 2 || d.kind == 4) {
#pragma unroll
        for (int j = 0; j < 8; ++j) { const int n = (lane >> 3) + 8 * j; const LAS float* s = scr + (8 * c) * 65 + n;
            u32x2 o; o.x = pk4f8(s[0] * W8_SCALE, s[65] * W8_SCALE, s[2 * 65] * W8_SCALE, s[3 * 65] * W8_SCALE); o.y = pk4f8(s[4 * 65] * W8_SCALE, s[5 * 65] * W8_SCALE, s[6 * 65] * W8_SCALE, s[7 * 65] * W8_SCALE);
            const int nn = d.n0 + n, dr = d.kind == 1 ? MapGu()(nn) : (d.kind == 4 ? MapWin()(nn) : nn);
            if (nn < d.ncols) *(u32x2*)(d.dst + (size_t)dr * d.ldt + d.kd0 + 8 * c) = o; }
    } else {
#pragma unroll
        for (int j = 0; j < 8; ++j) { const int n = (lane >> 3) + 8 * j; const LAS float* s = scr + (8 * c) * 65 + n;
            u32x4 o; o.x = pk2(s[0], s[65]); o.y = pk2(s[2 * 65], s[3 * 65]); o.z = pk2(s[4 * 65], s[5 * 65]); o.w = pk2(s[6 * 65], s[7 * 65]);
            const int nn = d.n0 + n;
            if (nn < d.ncols) { const int dr = d.kind == 0 ? MapWin()(nn) : nn; *(u32x4*)((bf16*)d.dst + (size_t)dr * d.ldt + d.kd0 + 8 * c) = o; } }
    }
    asm volatile("s_waitcnt lgkmcnt(0)" ::: "memory");
}
__device__ __forceinline__ void pro_transposes4(Frame& F, int ticket) {
    LAS float* scr = (LAS float*)F.lds + F.wave * (64 * 65);
    const int w0 = ticket * 32 + F.wave;
    f32x4 va[16], vb[16];
    const TDesc d0 = tr_decode(F, w0); tr_load(d0, va, F.lane);
    const TDesc d1 = tr_decode(F, w0 + 8); tr_load(d1, vb, F.lane); tr_finish(d0, va, scr, F.lane);
    const TDesc d2 = tr_decode(F, w0 + 16); tr_load(d2, va, F.lane); tr_finish(d1, vb, scr, F.lane);
    const TDesc d3 = tr_decode(F, w0 + 24); tr_load(d3, vb, F.lane); tr_finish(d2, va, scr, F.lane);
    tr_finish(d3, vb, scr, F.lane);
}
__device__ __forceinline__ void p_prologue(Frame& F0, CArgs& a, int qw = CW_QUEUE) {
    for (;;) {
        if (F0.tid == 0) F0.MISC[0] = __hip_atomic_fetch_add(F0.ctl + qw, 1u, RLX_AGENT);
        __syncthreads();
        const int it = (int)F0.MISC[0];
        __syncthreads();
        if (it >= PI_TOTAL) break;
        Frame F = F0; { const int t_ = fresh_tid(F.wave); F.tid = t_; F.lane = t_ & 63; }
        if (it < PI_B_TAB) pro_adaln(F, *fresh_args(), it);
        else if (it < PI_B_S5) pro_tables(F, *fresh_args());
        else if (it < PI_B_FOLD) pro_s5(F, *fresh_args(), it - PI_B_S5);
        else if (it < PI_B_ZERO) pro_fold(F, *fresh_args(), it - PI_B_FOLD);
        else if (it < PI_B_TR) { const int L = it - PI_B_ZERO; constexpr int EB = INPROJ_F8 ? 1 : 2; u32x4* z = (u32x4*)(F.ws + WS_WIN + ((size_t)L * PW * DM + (size_t)2088 * DM) * EB); for (int i = F.tid; i < (PW - 2088) * DM * EB / 16; i += NTHR) z[i] = (u32x4){0u, 0u, 0u, 0u}; }
        else pro_transposes4(F, it - PI_B_TR);
    }
}

__device__ __forceinline__ void p_norm1(Frame& F, CArgs& a, int L, bool dry = false) {
    const int gw = F.bid * NWAVES + F.wave, NGW = F.G * NWAVES;
    bf16* XS = (bf16*)(F.ws + WS_XS); bf16* H = (bf16*)(F.ws + WS_H);
    const float* mod = (const float*)(F.ws + WS_MOD) + (size_t)L * 9 * 6144; const float* modp = mod - 9 * 6144;
    const int* PS = (const int*)(F.ws + WS_PS); const unsigned char* Y = (const unsigned char*)(F.ws + WS_Y);
    const float* g = a.in[I_NMG] + L * DM;
    const float* xin = a.in[I_X]; const float* cin = a.in[I_CTX];
    f32x4 gv[4];
#pragma unroll
    for (int j = 0; j < 4; ++j) gv[j] = *(const f32x4*)(g + 4 * F.lane + 256 * j);
    f32x4 xn[4]; u32x2 xb[4]; unsigned yn[4][4]; int psn[4] = {0, 0, 0, 0};
#define N1_LOADX(dst, row) do { if (L == 0) { const float* s_ = (row) < NLAT ? xin + (size_t)(row) * DM : cin + (size_t)((row) - NLAT) * DM; _Pragma("unroll") for (int j = 0; j < 4; ++j) dst[j] = *(const f32x4*)(s_ + 4 * F.lane + 256 * j); } \
        else { const bf16* s_ = XS + (size_t)(row) * DM; _Pragma("unroll") for (int j = 0; j < 4; ++j) xb[j] = *(const u32x2*)(s_ + 4 * F.lane + 256 * j); } } while (0)
#define N1_LOADY(dst, ps) do { _Pragma("unroll") for (int k = 0; k < 4; ++k) { const unsigned char* yr_ = Y + (size_t)(ps)[k] * DM; _Pragma("unroll") for (int j = 0; j < 4; ++j) dst[k][j] = *(const unsigned*)(yr_ + 4 * F.lane + 256 * j); } } while (0)
#define N1_LOADPS(dst, row) do { const int4 p_ = *(const int4*)(PS + (size_t)(row) * 4); dst[0] = p_.x; dst[1] = p_.y; dst[2] = p_.z; dst[3] = p_.w; } while (0)
    int row = gw;
    if (row < NT) { N1_LOADX(xn, row); if (L > 0) { N1_LOADPS(psn, row); N1_LOADY(yn, psn); if (row + NGW < NT) N1_LOADPS(psn, row + NGW); } }
    while (row < NT) {
        const int nrow = row + NGW; const int bi = row < NLAT ? (row >> 12) : 8;
        f32x4 v[4]; unsigned yc[4][4];
#pragma unroll
        for (int j = 0; j < 4; ++j) { v[j] = (L == 0) ? xn[j] : bf4(xb[j]);
#pragma unroll
            for (int k = 0; k < 4; ++k) yc[k][j] = yn[k][j]; }
        if (nrow < NT) { N1_LOADX(xn, nrow); if (L > 0) { N1_LOADY(yn, psn); if (nrow + NGW < NT) N1_LOADPS(psn, nrow + NGW); } }
        if (L > 0) {
            bf16* xr = XS + (size_t)row * DM; const float* m5 = modp + (size_t)bi * 6144 + 5 * 1024;
#pragma unroll
            for (int j = 0; j < 4; ++j) { f32x4 s = (f32x4){0.f, 0.f, 0.f, 0.f};
#pragma unroll
                for (int k = 0; k < 4; ++k) s += f8x4(yc[k][j]);
                v[j] += *(const f32x4*)(m5 + 4 * F.lane + 256 * j) * (s * (1.f / Y8_SCALE)); if (!dry) { u32x2 w; w.x = pk2(v[j][0], v[j][1]); w.y = pk2(v[j][2], v[j][3]); *(u32x2*)(xr + 4 * F.lane + 256 * j) = w; } }
        }
        float ss = 0.f;
#pragma unroll
        for (int j = 0; j < 4; ++j) ss += v[j][0] * v[j][0] + v[j][1] * v[j][1] + v[j][2] * v[j][2] + v[j][3] * v[j][3];
        const float rs = rsqrtf(wave_sum(ss, F.lane) * (1.f / DM) + 1e-6f);
        const float* sh = mod + (size_t)bi * 6144, *sc = sh + 1024;
        bf16* hr = H + (size_t)row * DM;
#pragma unroll
        for (int j = 0; j < 4; ++j) { const f32x4 s4 = *(const f32x4*)(sc + 4 * F.lane + 256 * j), h4 = *(const f32x4*)(sh + 4 * F.lane + 256 * j);
            const f32x4 o = v[j] * rs * gv[j] * (s4 + 1.f) + h4;
#if INPROJ_F8
            if (!dry || o[0] == 12345.678f) *(unsigned*)((unsigned char*)(F.ws + WS_H8) + (size_t)row * DM + 4 * F.lane + 256 * j) = pk4f8(o[0] * H8_SCALE, o[1] * H8_SCALE, o[2] * H8_SCALE, o[3] * H8_SCALE);
#else
            u32x2 w; w.x = pk2(o[0], o[1]); w.y = pk2(o[2], o[3]); if (!dry) *(u32x2*)(hr + 4 * F.lane + 256 * j) = w; else if (o[0] == 12345.678f) *(u32x2*)(hr + 4 * F.lane + 256 * j) = w;
#endif
        }
        row = nrow;
    }
#undef N1_LOADX
#undef N1_LOADY
#undef N1_LOADPS
}
__device__ __forceinline__ void p_norm2(Frame& F, CArgs& a, int L, int nrows, int cw = CW_CNT) {
    constexpr int TS = 1032;
    LAS bf16* thi = (LAS bf16*)F.lds; LAS bf16* tlo = thi + 16 * TS;
    LAS float* part = (LAS float*)(tlo + 16 * TS);
    LAS unsigned* lcnt = (LAS unsigned*)(part + 8 * 16 * 33);
    if (F.tid < 64) lcnt[F.tid] = 0u;
    const int lr = F.lane & 15, g = F.lane >> 4, hf = F.lane >> 5;
    bf16x8 bh[4][2], bl[4][2];
    { const bf16* rwh = (const bf16*)(F.ws + WS_RWT) + (size_t)L * 65536; const bf16* rwl = rwh + 32768;
#pragma unroll
      for (int ks = 0; ks < 4; ++ks)
#pragma unroll
          for (int nt = 0; nt < 2; ++nt) { const int o = (16 * nt + lr) * 1024 + 128 * F.wave + 32 * ks + 8 * g; bh[ks][nt] = *(const bf16x8*)(rwh + o); bl[ks][nt] = *(const bf16x8*)(rwl + o); } }
    __syncthreads();
    const int gw = F.bid * NWAVES + F.wave, NGW = F.G * NWAVES, R = (nrows - gw + NGW - 1) / NGW;
    const int Rmax = (nrows - F.bid * NWAVES + NGW - 1) / NGW;
    const bf16* XS = (const bf16*)(F.ws + WS_XS); unsigned char* H8 = (unsigned char*)(F.ws + WS_H8);
    const float* mod = (const float*)(F.ws + WS_MOD) + (size_t)L * 9 * 6144;
    int* PE = (int*)(F.ws + WS_PE); int* PR = (int*)(F.ws + WS_PR); float* PG = (float*)(F.ws + WS_PG);
    unsigned* cnt = F.ctl + cw + L * 64;
    const float* gp = a.in[I_NFG] + L * DM;
    const float rbh = a.in[I_RB][L * NEXP + (F.lane & 31)];
    f32x4 gv[4];
#pragma unroll
    for (int j = 0; j < 4; ++j) gv[j] = *(const f32x4*)(gp + 4 * F.lane + 256 * j);
    u32x2 xn[4];
#pragma unroll
    for (int j = 0; j < 4; ++j) xn[j] = 0 < R ? *(const u32x2*)(XS + (size_t)gw * DM + 4 * F.lane + 256 * j) : (u32x2){0u, 0u};
    for (int bt = 0; 2 * bt < Rmax; ++bt) {
#pragma unroll
        for (int it = 0; it < 2; ++it) {
            const int ri = 2 * bt + it, row = gw + ri * NGW; const bool ok = ri < R; const int bi = row < NLAT ? (row >> 12) : 8;
            f32x4 v[4]; float ss = 0.f;
#pragma unroll
            for (int j = 0; j < 4; ++j) { v[j] = bf4(xn[j]); ss += v[j][0] * v[j][0] + v[j][1] * v[j][1] + v[j][2] * v[j][2] + v[j][3] * v[j][3]; }
#pragma unroll
            for (int j = 0; j < 4; ++j) xn[j] = ri + 1 < R ? *(const u32x2*)(XS + (size_t)(row + NGW) * DM + 4 * F.lane + 256 * j) : (u32x2){0u, 0u};
            const float rs = rsqrtf(wave_sum(ss, F.lane) * (1.f / DM) + 1e-6f);
            const float* sh = mod + (size_t)(ok ? bi : 0) * 6144 + 3 * 1024, *sc = sh + 1024;
            unsigned char* hr = H8 + (size_t)row * DM;
            LAS bf16* th = thi + (it * 8 + F.wave) * TS, *tl = tlo + (it * 8 + F.wave) * TS;
#pragma unroll
            for (int j = 0; j < 4; ++j) { const f32x4 s4 = *(const f32x4*)(sc + 4 * F.lane + 256 * j), h4 = *(const f32x4*)(sh + 4 * F.lane + 256 * j);
                v[j] = ok ? v[j] * rs * gv[j] * (s4 + 1.f) + h4 : (f32x4){0.f, 0.f, 0.f, 0.f};
                if (ok) *(unsigned*)(hr + 4 * F.lane + 256 * j) = pk4f8(v[j][0] * H8_SCALE, v[j][1] * H8_SCALE, v[j][2] * H8_SCALE, v[j][3] * H8_SCALE);
                u32x2 wh; wh.x = pk2(v[j][0], v[j][1]); wh.y = pk2(v[j][2], v[j][3]);
                const f32x4 hv = bf4(wh); const f32x4 dl = v[j] - hv; u32x2 wl; wl.x = pk2(dl[0], dl[1]); wl.y = pk2(dl[2], dl[3]);
                *(LAS u32x2*)(th + 4 * F.lane + 256 * j) = wh; *(LAS u32x2*)(tl + 4 * F.lane + 256 * j) = wl; }
        }
        __syncthreads();
        {   f32x4 acc[2] = {(f32x4){0.f, 0.f, 0.f, 0.f}, (f32x4){0.f, 0.f, 0.f, 0.f}};
#pragma unroll
            for (int ks = 0; ks < 4; ++ks) { const int o = lr * TS + 128 * F.wave + 32 * ks + 8 * g; const bf16x8 ah = *(const LAS bf16x8*)(thi + o), al = *(const LAS bf16x8*)(tlo + o);
#pragma unroll
                for (int nt = 0; nt < 2; ++nt) { acc[nt] = __builtin_amdgcn_mfma_f32_16x16x32_bf16(ah, bh[ks][nt], acc[nt], 0, 0, 0); acc[nt] = __builtin_amdgcn_mfma_f32_16x16x32_bf16(al, bh[ks][nt], acc[nt], 0, 0, 0); acc[nt] = __builtin_amdgcn_mfma_f32_16x16x32_bf16(ah, bl[ks][nt], acc[nt], 0, 0, 0); } }
#pragma unroll
            for (int nt = 0; nt < 2; ++nt)
#pragma unroll
                for (int j = 0; j < 4; ++j) part[(F.wave * 16 + 4 * g + j) * 33 + 16 * nt + lr] = acc[nt][j];
        }
        __syncthreads();
        {   const int s = 2 * F.wave + hf, e = F.lane & 31;
            float logit = rbh;
#pragma unroll
            for (int w = 0; w < 8; ++w) logit += part[(w * 16 + s) * 33 + e];
            const int ri = 2 * bt + (s >> 3), rowh = F.bid * NWAVES + (s & 7) + ri * NGW; const bool okh = rowh < nrows;
            int es[4]; float ls[4];
#pragma unroll
            for (int k = 0; k < 4; ++k) {
                float m = logit; m = fmaxf(m, swz_xor<1>(m)); m = fmaxf(m, swz_xor<2>(m)); m = fmaxf(m, swz_xor<4>(m)); m = fmaxf(m, swz_xor<8>(m)); m = fmaxf(m, swz_xor<16>(m));
                const unsigned long long bal = __ballot(logit == m);
                const unsigned mh = (unsigned)(bal >> (F.lane & 32));
                es[k] = __builtin_ctz(mh); ls[k] = m;
                if (e == es[k]) logit = -3.0e38f;
            }
            const float e1 = __expf(ls[1] - ls[0]), e2 = __expf(ls[2] - ls[0]), e3 = __expf(ls[3] - ls[0]); const float inv = 1.f / (1.f + e1 + e2 + e3);
            if (e < 4 && okh) {
                const int ex = e == 0 ? es[0] : (e == 1 ? es[1] : (e == 2 ? es[2] : es[3]));
                const float gt = (e == 0 ? 1.f : (e == 1 ? e1 : (e == 2 ? e2 : e3))) * inv;
                const unsigned rk = __hip_atomic_fetch_add(lcnt + ex, 1u, __ATOMIC_RELAXED, __HIP_MEMORY_SCOPE_WORKGROUP);
                PE[rowh * 4 + e] = ex; PR[rowh * 4 + e] = (int)rk; PG[rowh * 4 + e] = gt;
            }
        }
        __syncthreads();
    }
    if (F.tid < 32) lcnt[32 + F.tid] = __hip_atomic_fetch_add(cnt + F.tid, lcnt[F.tid], RLX_AGENT);
    __syncthreads();
    int* TM = (int*)(F.ws + WS_TM);
    for (int bt = 0; 2 * bt < Rmax; ++bt) {
        const int s = 2 * F.wave + hf, e = F.lane & 31, rowh = F.bid * NWAVES + (s & 7) + (2 * bt + (s >> 3)) * NGW;
        if (e < 4 && rowh < nrows) { const int i = rowh * 4 + e, ex = PE[i], rk = PR[i] + (int)lcnt[32 + ex]; TM[(size_t)ex * NT + rk] = i; }
    }
    __syncthreads();
}
__device__ __forceinline__ void p_final(Frame& F, CArgs& a) {
    const int gw = F.bid * NWAVES + F.wave, NGW = F.G * NWAVES;
    const bf16* XS = (const bf16*)(F.ws + WS_XS);
    const float* modp = (const float*)(F.ws + WS_MOD) + (size_t)(DEPTH - 1) * 9 * 6144;
    const int* PS = (const int*)(F.ws + WS_PS); const unsigned char* Y = (const unsigned char*)(F.ws + WS_Y);
    const float* g = a.in[I_FING];
    f32x4 gv[4];
#pragma unroll
    for (int j = 0; j < 4; ++j) gv[j] = *(const f32x4*)(g + 4 * F.lane + 256 * j);
    u32x2 xb[4]; unsigned yn[4][4]; int psn[4] = {0, 0, 0, 0};
#define FN_LOADX(row) do { const bf16* s_ = XS + (size_t)(row) * DM; _Pragma("unroll") for (int j = 0; j < 4; ++j) xb[j] = *(const u32x2*)(s_ + 4 * F.lane + 256 * j); } while (0)
#define FN_LOADY(ps) do { _Pragma("unroll") for (int k = 0; k < 4; ++k) { const unsigned char* yr_ = Y + (size_t)(ps)[k] * DM; _Pragma("unroll") for (int j = 0; j < 4; ++j) yn[k][j] = *(const unsigned*)(yr_ + 4 * F.lane + 256 * j); } } while (0)
#define FN_LOADPS(row) do { const int4 p_ = *(const int4*)(PS + (size_t)(row) * 4); psn[0] = p_.x; psn[1] = p_.y; psn[2] = p_.z; psn[3] = p_.w; } while (0)
    int row = gw;
    if (row < NLAT) { FN_LOADX(row); FN_LOADPS(row); FN_LOADY(psn); if (row + NGW < NLAT) FN_LOADPS(row + NGW); }
    while (row < NLAT) {
        const int nrow = row + NGW, bi = row >> 12;
        f32x4 v[4], s[4];
#pragma unroll
        for (int j = 0; j < 4; ++j) { v[j] = bf4(xb[j]); s[j] = (f32x4){0.f, 0.f, 0.f, 0.f};
#pragma unroll
            for (int k = 0; k < 4; ++k) s[j] += f8x4(yn[k][j]);
            s[j] = s[j] * (1.f / Y8_SCALE); }
        if (nrow < NLAT) { FN_LOADX(nrow); FN_LOADY(psn); if (nrow + NGW < NLAT) FN_LOADPS(nrow + NGW); }
        const float* m5 = modp + (size_t)bi * 6144 + 5 * 1024;
        float ss = 0.f;
#pragma unroll
        for (int j = 0; j < 4; ++j) { v[j] += *(const f32x4*)(m5 + 4 * F.lane + 256 * j) * s[j]; ss += v[j][0] * v[j][0] + v[j][1] * v[j][1] + v[j][2] * v[j][2] + v[j][3] * v[j][3]; }
        const float rs = rsqrtf(wave_sum(ss, F.lane) * (1.f / DM) + 1e-6f);
        float* orow = a.out + (size_t)row * DM;
#pragma unroll
        for (int j = 0; j < 4; ++j) *(f32x4*)(orow + 4 * F.lane + 256 * j) = v[j] * rs * gv[j];
        row = nrow;
    }
#undef FN_LOADX
#undef FN_LOADY
#undef FN_LOADPS
}

#ifndef MIX_P1
#define MIX_P1 1
#endif
#define MFMA16(a, b, c) __builtin_amdgcn_mfma_f32_16x16x32_bf16((a), (b), (c), 0, 0, 0)
typedef short v4i16_t __attribute__((ext_vector_type(4)));
__device__ __forceinline__ s16x4 trread(const LAS void* p) { return __builtin_bit_cast(s16x4, __builtin_amdgcn_ds_read_tr16_b64_v4i16((LAS v4i16_t*)p)); }
__device__ __forceinline__ bf16x8 cat8(s16x4 a, s16x4 b) { return __builtin_shufflevector(a, b, 0, 1, 2, 3, 4, 5, 6, 7); }
__device__ __forceinline__ bf16x8 pack8(const float* v) { u32x4 w; w.x = pg8::cvt_pk_bf16(v[0], v[1]); w.y = pg8::cvt_pk_bf16(v[2], v[3]); w.z = pg8::cvt_pk_bf16(v[4], v[5]); w.w = pg8::cvt_pk_bf16(v[6], v[7]); return __builtin_bit_cast(bf16x8, w); }
__device__ __forceinline__ void unpack8(bf16x8 x, float* v) { const u32x4 w = __builtin_bit_cast(u32x4, x); v[0] = bflo(w.x); v[1] = bfhi(w.x); v[2] = bflo(w.y); v[3] = bfhi(w.y); v[4] = bflo(w.z); v[5] = bfhi(w.z); v[6] = bflo(w.w); v[7] = bfhi(w.w); }
#define OPQ(x) ({ int o_ = (x); asm volatile("" : "+s"(o_)); o_; })
#define LAUNDER_F(F0) Frame F = F0; { const int t_ = fresh_tid(F.wave); F.tid = t_; F.lane = t_ & 63; }
__device__ __forceinline__ int chunk_tok0(int cid) { return cid < 512 ? cid * 64 : NLAT + (cid - 512) * 64; }

constexpr int GL_QS = 136, GL_VS = 264, GL_BS = 260;
constexpr int GL_Q = 0, GL_K = GL_Q + 64 * GL_QS * 2, GL_V = GL_K + 64 * GL_QS * 2, GL_A1 = GL_V + 64 * GL_VS * 2, GL_B = GL_A1 + 64 * 32 * 2, GL_END = GL_B + 64 * GL_BS * 4;
static_assert(GL_END <= MISC_OFF, "GLA LDS");
template <int MODE> __device__ __forceinline__ void gla_chunk(Frame& F0, CArgs& a, int L, int cid) {
    constexpr bool OUT = MODE == 1, DO_STATE = MODE == 0 || MODE == 2, DO_INTRA = MODE == 1 || MODE == 2;
    LAUNDER_F(F0)
    const int tok0 = chunk_tok0(cid);
    const bf16* P = (const bf16*)(F.ws + WS_PBUF) + (size_t)tok0 * PW;
    LAS bf16* sq = (LAS bf16*)(F.lds + GL_Q); LAS bf16* sk = (LAS bf16*)(F.lds + GL_K); LAS bf16* sv = (LAS bf16*)(F.lds + GL_V); LAS bf16* sa1 = (LAS bf16*)(F.lds + GL_A1); LAS float* sB = (LAS float*)(F.lds + GL_B);
    __syncthreads();
    u32x4 rgate[4]; bf16x8 sfr[4];
    if constexpr (OUT) {
#pragma unroll
        for (int k = 0; k < 4; ++k) { const int i = F.tid + k * NTHR, t = i >> 5, pc = i & 31; rgate[k] = *(const u32x4*)(P + (size_t)t * PW + PC_R + pc * 8); }
        const bf16* se = (const bf16*)(F.ws + WS_GSE) + (((size_t)cid * 4 + (F.wave & 3)) * 2 + (F.wave >> 2)) * 2048;
#pragma unroll
        for (int d = 0; d < 4; ++d) sfr[d] = *(const bf16x8*)(se + (16 * d + (F.lane & 15)) * 32 + 8 * (F.lane >> 4));
    }
    {   u32x4 rq[2], rk[2], rv[4], ra = (u32x4){0u, 0u, 0u, 0u};
#pragma unroll
        for (int k = 0; k < 2; ++k) { const int i = F.tid + k * NTHR, t = i >> 4, pc = i & 15; rq[k] = *(const u32x4*)(P + (size_t)t * PW + PC_Q + pc * 8); rk[k] = *(const u32x4*)(P + (size_t)t * PW + PC_K + pc * 8); }
#pragma unroll
        for (int k = 0; k < 4; ++k) { const int i = F.tid + k * NTHR, t = i >> 5, pc = i & 31; rv[k] = *(const u32x4*)(P + (size_t)t * PW + PC_V + pc * 8); }
        if (F.tid < 256) { const int t = F.tid >> 2, pc = F.tid & 3; ra = *(const u32x4*)(P + (size_t)t * PW + PC_A1 + pc * 8); }
#pragma unroll
        for (int k = 0; k < 2; ++k) { const int i = F.tid + k * NTHR, t = i >> 4, pc = i & 15; *(LAS u32x4*)(sq + t * GL_QS + pc * 8) = rq[k]; *(LAS u32x4*)(sk + t * GL_QS + pc * 8) = rk[k]; }
#pragma unroll
        for (int k = 0; k < 4; ++k) { const int i = F.tid + k * NTHR, t = i >> 5, pc = i & 31; *(LAS u32x4*)(sv + t * GL_VS + pc * 8) = rv[k]; }
        if (F.tid < 256) { const int t = F.tid >> 2, pc = F.tid & 3; *(LAS u32x4*)(sa1 + t * 32 + pc * 8) = ra; }
    }
    __syncthreads();
    {
        const int lr_ = F.lane & 15, g_ = F.lane >> 4;
        const bf16* gt = (const bf16*)(F.ws + WS_GA2T) + (size_t)L * 256 * 32;
        bf16x8 bz[2]; float abv[2];
#pragma unroll
        for (int nt = 0; nt < 2; ++nt) { const int col = 32 * F.wave + 16 * nt + lr_; bz[nt] = *(const bf16x8*)(gt + col * 32 + 8 * g_); abv[nt] = a.in[I_GLAAB][L * 256 + col]; }
#pragma unroll
        for (int m = 0; m < 4; ++m) { const bf16x8 az = *(const LAS bf16x8*)(sa1 + (16 * m + lr_) * 32 + 8 * g_);
#pragma unroll
            for (int nt = 0; nt < 2; ++nt) { const f32x4 zz = MFMA16(az, bz[nt], ((f32x4){0.f, 0.f, 0.f, 0.f})); const int col = 32 * F.wave + 16 * nt + lr_;
#pragma unroll
                for (int j = 0; j < 4; ++j) { const float z = zz[j] + abv[nt]; const float ls = fminf(z, 0.f) - __logf(1.f + __expf(-fabsf(z))); sB[(16 * m + 4 * g_ + j) * GL_BS + col] = ls * (1.f / 16.f); } } }
    }
    __syncthreads();
    if (F.tid < 256) { const int col = F.tid, r = col >> 7; float bv[64];
#pragma unroll
        for (int i = 0; i < 64; ++i) bv[i] = sB[i * GL_BS + col];
        if (r == 0) {
#pragma unroll
            for (int i = 1; i < 64; ++i) bv[i] += bv[i - 1];
        } else {
#pragma unroll
            for (int i = 62; i >= 0; --i) bv[i] += bv[i + 1];
        }
#pragma unroll
        for (int i = 0; i < 64; ++i) sB[i * GL_BS + col] = bv[i]; }
    __syncthreads();
    const int hh = F.wave & 3, r = F.wave >> 2, lr = F.lane & 15, g = F.lane >> 4;
    const int bc = r * 128 + hh * 32;
    const size_t ub = ((size_t)cid * 4 + hh) * 2 + r;
    if constexpr (DO_STATE) {
        const int tl = r ? 0 : 63;
        f32x4 acc[2][4];
#pragma unroll
        for (int mc = 0; mc < 2; ++mc)
#pragma unroll
            for (int d = 0; d < 4; ++d) acc[mc][d] = (f32x4){0.f, 0.f, 0.f, 0.f};
#pragma unroll
        for (int sg = 0; sg < 2; ++sg) {
            bf16x8 vf[4];
#pragma unroll
            for (int d = 0; d < 4; ++d) { const LAS bf16* p0 = sv + (32 * sg + 8 * g + ((F.lane & 15) >> 2)) * GL_VS + hh * 64 + 16 * d + 4 * (F.lane & 3); vf[d] = cat8(trread(p0), trread(p0 + 4 * GL_VS)); }
#pragma unroll
            for (int mc = 0; mc < 2; ++mc) {
                const LAS bf16* p0 = sk + (32 * sg + 8 * g + ((F.lane & 15) >> 2)) * GL_QS + hh * 32 + 16 * mc + 4 * (F.lane & 3);
                const s16x4 k0 = trread(p0), k1 = trread(p0 + 4 * GL_QS);
                const int c = 16 * mc + lr; const float bl = sB[tl * GL_BS + bc + c];
                float kv[8];
#pragma unroll
                for (int e = 0; e < 4; ++e) { kv[e] = bf2f((unsigned short)k0[e]) * __expf(bl - sB[(32 * sg + 8 * g + e) * GL_BS + bc + c]); kv[4 + e] = bf2f((unsigned short)k1[e]) * __expf(bl - sB[(32 * sg + 8 * g + 4 + e) * GL_BS + bc + c]); }
                const bf16x8 kf = pack8(kv);
#pragma unroll
                for (int d = 0; d < 4; ++d) acc[mc][d] = MFMA16(kf, vf[d], acc[mc][d]);
            }
        }
        float* ds = (float*)(F.ws + WS_GDS) + ub * 2048;
#pragma unroll
        for (int mc = 0; mc < 2; ++mc)
#pragma unroll
            for (int d = 0; d < 4; ++d) *(f32x4*)(ds + (16 * d + lr) * 32 + 16 * mc + 4 * g) = acc[mc][d];
        if (F.lane < 32) ((float*)(F.ws + WS_GDEC))[ub * 32 + F.lane] = __expf(sB[tl * GL_BS + bc + F.lane]);
    }
    if constexpr (DO_INTRA) {
        bf16x8 qf[4], kf[4];
#pragma unroll
        for (int m = 0; m < 4; ++m) { const int t = 16 * m + lr; float qv[8], kv[8], bv[8];
            unpack8(*(const LAS bf16x8*)(sq + t * GL_QS + hh * 32 + 8 * g), qv); unpack8(*(const LAS bf16x8*)(sk + t * GL_QS + hh * 32 + 8 * g), kv);
            *(f32x4*)bv = *(const LAS f32x4*)(sB + t * GL_BS + bc + 8 * g); *(f32x4*)(bv + 4) = *(const LAS f32x4*)(sB + t * GL_BS + bc + 8 * g + 4);
#pragma unroll
            for (int e = 0; e < 8; ++e) { const float ex = __expf(bv[e]); qv[e] *= 0.17677669529663687f * ex; kv[e] *= __frcp_rn(ex); }
            qf[m] = pack8(qv); kf[m] = pack8(kv); }
        f32x4 o[4][4];
#pragma unroll
        for (int m = 0; m < 4; ++m)
#pragma unroll
            for (int d = 0; d < 4; ++d) o[m][d] = (f32x4){0.f, 0.f, 0.f, 0.f};
        if constexpr (OUT) {
#pragma unroll
            for (int d = 0; d < 4; ++d) {
#pragma unroll
                for (int m = 0; m < 4; ++m) o[m][d] = MFMA16(qf[m], sfr[d], o[m][d]); }
        }
        bf16x8 vf[2][4];
#pragma unroll
        for (int sg = 0; sg < 2; ++sg)
#pragma unroll
            for (int d = 0; d < 4; ++d) { const LAS bf16* p0 = sv + (32 * sg + 4 * g + ((F.lane & 15) >> 2)) * GL_VS + hh * 64 + 16 * d + 4 * (F.lane & 3); vf[sg][d] = cat8(trread(p0), trread(p0 + 16 * GL_VS)); }
        const f32x4 zero4 = (f32x4){0.f, 0.f, 0.f, 0.f};
#pragma unroll
        for (int m = 0; m < 4; ++m) {
            const int t = 16 * m + lr;
#pragma unroll
            for (int sg = 0; sg < 2; ++sg) {
                f32x4 p0 = MFMA16(kf[2 * sg], qf[m], zero4), p1 = MFMA16(kf[2 * sg + 1], qf[m], zero4);
                float pv[8];
#pragma unroll
                for (int j = 0; j < 4; ++j) { const int s0 = 32 * sg + 4 * g + j, s1 = s0 + 16; pv[j] = (r ? s0 >= t : s0 <= t) ? p0[j] : 0.f; pv[4 + j] = (r ? s1 >= t : s1 <= t) ? p1[j] : 0.f; }
                const bf16x8 pf = pack8(pv);
#pragma unroll
                for (int d = 0; d < 4; ++d) o[m][d] = MFMA16(pf, vf[sg][d], o[m][d]);
            }
        }
        if constexpr (OUT) {
        __syncthreads();
        LAS float* ox = (LAS float*)(F.lds + GL_B);
        LAS bf16* ot = (LAS bf16*)(F.lds + GL_Q);
        LAS bf16* srg = (LAS bf16*)(F.lds + GL_V);
#pragma unroll
        for (int k = 0; k < 4; ++k) { const int i = F.tid + k * NTHR, t = i >> 5, pc = i & 31; *(LAS u32x4*)(srg + t * GL_VS + pc * 8) = rgate[k]; }
        if (r == 1) {
#pragma unroll
            for (int m = 0; m < 4; ++m)
#pragma unroll
                for (int d = 0; d < 4; ++d)
#pragma unroll
                    for (int j = 0; j < 4; ++j) ox[(hh * 64 + 16 * m + 4 * g + j) * 65 + 16 * d + lr] = o[m][d][j];
        }
        __syncthreads();
        if (r == 0) {
            const float* ng = a.in[I_GLANG] + L * 64;
            float gn[4];
#pragma unroll
            for (int d = 0; d < 4; ++d) gn[d] = ng[16 * d + lr];
#pragma unroll
            for (int m = 0; m < 4; ++m)
#pragma unroll
                for (int j = 0; j < 4; ++j) {
                    const int t = 16 * m + 4 * g + j; float v[4], ss = 0.f;
#pragma unroll
                    for (int d = 0; d < 4; ++d) { v[d] = o[m][d][j] + ox[(hh * 64 + t) * 65 + 16 * d + lr]; ss += v[d] * v[d]; }
                    ss += swz_xor<1>(ss); ss += swz_xor<2>(ss); ss += swz_xor<4>(ss); ss += swz_xor<8>(ss);
                    const float rs = rsqrtf(ss * (1.f / 64.f) + 1e-6f);
#pragma unroll
                    for (int d = 0; d < 4; ++d) { const float rg = bf2f(srg[t * GL_VS + hh * 64 + 16 * d + lr]); ot[t * 264 + hh * 64 + 16 * d + lr] = (bf16)f2bf(v[d] * rs * gn[d] * siluf_(rg)); }
                }
        }
        __syncthreads();
        bf16* MX = (bf16*)(F.ws + WS_MIX) + (size_t)tok0 * MW + 768;
        for (int i = F.tid; i < 2048; i += NTHR) { const int t = i >> 5, pc = i & 31; *(u32x4*)(MX + (size_t)t * MW + pc * 8) = *(const LAS u32x4*)(ot + t * 264 + pc * 8); }
        } else {
            bf16* QI = (bf16*)(F.ws + WS_GQI) + (size_t)tok0 * 256;
#pragma unroll
            for (int m = 0; m < 4; ++m) *(bf16x8*)(QI + (size_t)(16 * m + lr) * 256 + r * 128 + hh * 32 + 8 * g) = qf[m];
            __syncthreads();
            LAS float* ox = (LAS float*)(F.lds + GL_B);
            LAS bf16* ot = (LAS bf16*)(F.lds + GL_Q);
            if (r == 1) {
#pragma unroll
                for (int m = 0; m < 4; ++m)
#pragma unroll
                    for (int d = 0; d < 4; ++d)
#pragma unroll
                        for (int j = 0; j < 4; ++j) ox[(hh * 64 + 16 * m + 4 * g + j) * 65 + 16 * d + lr] = o[m][d][j];
            }
            __syncthreads();
            if (r == 0) {
#pragma unroll
                for (int m = 0; m < 4; ++m)
#pragma unroll
                    for (int d = 0; d < 4; ++d)
#pragma unroll
                        for (int j = 0; j < 4; ++j) { const int t = 16 * m + 4 * g + j; ot[t * 264 + hh * 64 + 16 * d + lr] = (bf16)f2bf(o[m][d][j] + ox[(hh * 64 + t) * 65 + 16 * d + lr]); }
            }
            __syncthreads();
            bf16* OI = (bf16*)(F.ws + WS_GOI) + (size_t)tok0 * 256;
            for (int i = F.tid; i < 2048; i += NTHR) { const int t = i >> 5, pc = i & 31; *(u32x4*)(OI + (size_t)t * 256 + pc * 8) = *(const LAS u32x4*)(ot + t * 264 + pc * 8); }
        }
    }
}


__device__ __forceinline__ void gla_light(Frame& F0, CArgs& a, int L, int cid) {
    LAUNDER_F(F0)
    const int tok0 = chunk_tok0(cid), hh = F.wave & 3, r = F.wave >> 2, lr = F.lane & 15, g = F.lane >> 4;
    const bf16* P = (const bf16*)(F.ws + WS_PBUF) + (size_t)tok0 * PW;
    const bf16* QI = (const bf16*)(F.ws + WS_GQI) + (size_t)tok0 * 256; const bf16* OI = (const bf16*)(F.ws + WS_GOI) + (size_t)tok0 * 256;
    const bf16* se = (const bf16*)(F.ws + WS_GSE) + (((size_t)cid * 4 + hh) * 2 + r) * 2048;
    u32x4 rgate[4], roi[4]; bf16x8 qf[4], sfr[4];
#pragma unroll
    for (int m = 0; m < 4; ++m) qf[m] = *(const bf16x8*)(QI + (size_t)(16 * m + lr) * 256 + r * 128 + hh * 32 + 8 * g);
#pragma unroll
    for (int d = 0; d < 4; ++d) sfr[d] = *(const bf16x8*)(se + (16 * d + lr) * 32 + 8 * g);
#pragma unroll
    for (int k = 0; k < 4; ++k) { const int i = F.tid + k * NTHR, t = i >> 5, pc = i & 31; rgate[k] = *(const u32x4*)(P + (size_t)t * PW + PC_R + pc * 8); roi[k] = *(const u32x4*)(OI + (size_t)t * 256 + pc * 8); }
    f32x4 o[4][4];
#pragma unroll
    for (int m = 0; m < 4; ++m)
#pragma unroll
        for (int d = 0; d < 4; ++d) o[m][d] = MFMA16(qf[m], sfr[d], ((f32x4){0.f, 0.f, 0.f, 0.f}));
    LAS float* ox = (LAS float*)(F.lds + GL_B);
    LAS bf16* srg = (LAS bf16*)(F.lds + GL_V);
    LAS bf16* soi = (LAS bf16*)(F.lds + GL_Q);
    __syncthreads();
#pragma unroll
    for (int k = 0; k < 4; ++k) { const int i = F.tid + k * NTHR, t = i >> 5, pc = i & 31; *(LAS u32x4*)(srg + t * GL_VS + pc * 8) = rgate[k]; *(LAS u32x4*)(soi + t * 264 + pc * 8) = roi[k]; }
    if (r == 1) {
#pragma unroll
        for (int m = 0; m < 4; ++m)
#pragma unroll
            for (int d = 0; d < 4; ++d)
#pragma unroll
                for (int j = 0; j < 4; ++j) ox[(hh * 64 + 16 * m + 4 * g + j) * 65 + 16 * d + lr] = o[m][d][j];
    }
    __syncthreads();
    if (r == 0) {
        const float* ng = a.in[I_GLANG] + L * 64;
        float gn[4];
#pragma unroll
        for (int d = 0; d < 4; ++d) gn[d] = ng[16 * d + lr];
#pragma unroll
        for (int m = 0; m < 4; ++m)
#pragma unroll
            for (int j = 0; j < 4; ++j) {
                const int t = 16 * m + 4 * g + j; float v[4], ss = 0.f;
#pragma unroll
                for (int d = 0; d < 4; ++d) { v[d] = o[m][d][j] + ox[(hh * 64 + t) * 65 + 16 * d + lr] + bf2f(soi[t * 264 + hh * 64 + 16 * d + lr]); ss += v[d] * v[d]; }
                ss += swz_xor<1>(ss); ss += swz_xor<2>(ss); ss += swz_xor<4>(ss); ss += swz_xor<8>(ss);
                const float rs = rsqrtf(ss * (1.f / 64.f) + 1e-6f);
#pragma unroll
                for (int d = 0; d < 4; ++d) { const int q = t * GL_VS + hh * 64 + 16 * d + lr; const float rg = bf2f(srg[q]); srg[q] = (bf16)f2bf(v[d] * rs * gn[d] * siluf_(rg)); }
            }
    }
    __syncthreads();
    bf16* MX = (bf16*)(F.ws + WS_MIX) + (size_t)tok0 * MW + 768;
    for (int i = F.tid; i < 2048; i += NTHR) { const int t = i >> 5, pc = i & 31; *(u32x4*)(MX + (size_t)t * MW + pc * 8) = *(const LAS u32x4*)(srg + t * GL_VS + pc * 8); }
}

constexpr int SD_RS = 520;
constexpr int SD_RAW = 0, SD_XC = SD_RAW + 68 * SD_RS * 2, SD_DT = SD_XC + 64 * SD_RS * 2, SD_CUM = SD_DT + 64 * 8 * 4, SD_W = SD_CUM + 8 * 64 * 4, SD_END = SD_W + 8 * 64 * 4;
static_assert(SD_END <= MISC_OFF && 64 * 260 * 4 <= 68 * SD_RS * 2, "SSD LDS");
template <int MODE> __device__ __forceinline__ void ssd_chunk(Frame& F0, CArgs& a, int L, int cid) {
    constexpr bool OUT = MODE == 1, DO_STATE = MODE == 0 || MODE == 2, DO_INTRA = MODE == 1 || MODE == 2;
    LAUNDER_F(F0)
    const int tok0 = chunk_tok0(cid);
    const bf16* PB = (const bf16*)(F.ws + WS_PBUF);
    LAS bf16* raw = (LAS bf16*)(F.lds + SD_RAW); LAS bf16* xc = (LAS bf16*)(F.lds + SD_XC); LAS float* sdt = (LAS float*)(F.lds + SD_DT); LAS float* scum = (LAS float*)(F.lds + SD_CUM); LAS float* sw = (LAS float*)(F.lds + SD_W);
    bf16x8 sfr[4][2];
    if constexpr (OUT) { const bf16* se = (const bf16*)(F.ws + WS_SSE) + (((size_t)cid * 4 + (F.wave & 3)) * 2 + (F.wave >> 2)) * 4096;
#pragma unroll
        for (int d = 0; d < 4; ++d) { sfr[d][0] = *(const bf16x8*)(se + (16 * d + (F.lane & 15)) * 64 + 8 * (F.lane >> 4)); sfr[d][1] = *(const bf16x8*)(se + (16 * d + (F.lane & 15)) * 64 + 32 + 8 * (F.lane >> 4)); } }
    __syncthreads();
    {
        const int isctx = cid >= 512, c4 = (cid - 512) & 3;
        u32x4 rv[9];
#pragma unroll
        for (int k = 0; k < 9; ++k) { const int i = F.tid + k * NTHR, rr = i >> 6, pc = i & 63, t = rr - 2; rv[k] = (u32x4){0u, 0u, 0u, 0u};
            bool ok = t >= 0 && t < 64 && i < 68 * 64; if (isctx) { const int tt = c4 * 64 + t; ok = tt >= 0 && tt < 256 && i < 68 * 64; }
            if (ok) rv[k] = *(const u32x4*)(PB + (size_t)(tok0 + t) * PW + PC_XBC + pc * 8); }
#pragma unroll
        for (int k = 0; k < 9; ++k) { const int i = F.tid + k * NTHR, rr = i >> 6, pc = i & 63; if (i < 68 * 64) *(LAS u32x4*)(raw + rr * SD_RS + pc * 8) = rv[k]; }
        if (F.tid < 64) { float dv[8]; unpack8(*(const bf16x8*)(PB + (size_t)(tok0 + F.tid) * PW + PC_DT), dv);
#pragma unroll
            for (int q = 0; q < 8; ++q) { const float z = dv[q] + a.in[I_SSDDTB][L * 8 + q]; sdt[F.tid * 8 + q] = z > 20.f ? z : __logf(1.f + __expf(z)); } }
    }
    __syncthreads();
    {
        const int ch = F.tid; float w[5];
#pragma unroll
        for (int k = 0; k < 5; ++k) w[k] = a.in[I_SSDCW][((size_t)L * 5 + k) * 512 + ch];
        const float cb = a.in[I_SSDCB][L * 512 + ch];
        float x0 = bf2f(raw[0 * SD_RS + ch]), x1 = bf2f(raw[1 * SD_RS + ch]), x2 = bf2f(raw[2 * SD_RS + ch]), x3 = bf2f(raw[3 * SD_RS + ch]);
        for (int t0 = 0; t0 < 64; t0 += 16) { float xv[16];
#pragma unroll
            for (int k = 0; k < 16; ++k) xv[k] = bf2f(raw[(t0 + k + 4) * SD_RS + ch]);
#pragma unroll
            for (int k = 0; k < 16; ++k) { const float x4 = xv[k]; const float y = cb + w[0] * x0 + w[1] * x1 + w[2] * x2 + w[3] * x3 + w[4] * x4;
                xc[(t0 + k) * SD_RS + ch] = (bf16)f2bf(siluf_(y)); x0 = x1; x1 = x2; x2 = x3; x3 = x4; } }
    }
    {
        const int q = F.wave, rr = q >> 2, t = rr ? 63 - F.lane : F.lane;
        const float aa = -__expf(a.in[I_SSDALOG][L * 8 + q]); const float dtv = sdt[t * 8 + q];
        float c = dtv * aa;
        { float o;
          o = __builtin_bit_cast(float, __builtin_amdgcn_ds_bpermute((F.lane - 1) << 2, __builtin_bit_cast(int, c))); if (F.lane >= 1) c += o;
          o = __builtin_bit_cast(float, __builtin_amdgcn_ds_bpermute((F.lane - 2) << 2, __builtin_bit_cast(int, c))); if (F.lane >= 2) c += o;
          o = __builtin_bit_cast(float, __builtin_amdgcn_ds_bpermute((F.lane - 4) << 2, __builtin_bit_cast(int, c))); if (F.lane >= 4) c += o;
          o = __builtin_bit_cast(float, __builtin_amdgcn_ds_bpermute((F.lane - 8) << 2, __builtin_bit_cast(int, c))); if (F.lane >= 8) c += o;
          o = __builtin_bit_cast(float, __builtin_amdgcn_ds_bpermute((F.lane - 16) << 2, __builtin_bit_cast(int, c))); if (F.lane >= 16) c += o;
          o = __builtin_bit_cast(float, __builtin_amdgcn_ds_bpermute((F.lane - 32) << 2, __builtin_bit_cast(int, c))); if (F.lane >= 32) c += o; }
        const float cl = __builtin_bit_cast(float, __builtin_amdgcn_ds_bpermute(63 << 2, __builtin_bit_cast(int, c)));
        scum[q * 64 + t] = c; sw[q * 64 + t] = __expf(cl - c) * dtv;
    }
    __syncthreads();
    const int h = F.wave & 3, r = F.wave >> 2, lr = F.lane & 15, g = F.lane >> 4, gp = h >> 1, rh = r * 4 + h;
    const size_t ub = ((size_t)cid * 4 + h) * 2 + r;
    if constexpr (DO_STATE) {
        f32x4 acc[4][4];
#pragma unroll
        for (int ms = 0; ms < 4; ++ms)
#pragma unroll
            for (int d = 0; d < 4; ++d) acc[ms][d] = (f32x4){0.f, 0.f, 0.f, 0.f};
#pragma unroll
        for (int sg = 0; sg < 2; ++sg) {
            const int trow = 32 * sg + 8 * g;
            bf16x8 xf[4];
#pragma unroll
            for (int d = 0; d < 4; ++d) { const LAS bf16* p0 = xc + (trow + ((F.lane & 15) >> 2)) * SD_RS + h * 64 + 16 * d + 4 * (F.lane & 3); xf[d] = cat8(trread(p0), trread(p0 + 4 * SD_RS)); }
            float wv[8];
            *(f32x4*)wv = *(const LAS f32x4*)(sw + rh * 64 + trow); *(f32x4*)(wv + 4) = *(const LAS f32x4*)(sw + rh * 64 + trow + 4);
#pragma unroll
            for (int ms = 0; ms < 4; ++ms) {
                const LAS bf16* p0 = xc + (trow + ((F.lane & 15) >> 2)) * SD_RS + 256 + gp * 64 + 16 * ms + 4 * (F.lane & 3);
                const s16x4 b0 = trread(p0), b1 = trread(p0 + 4 * SD_RS);
                float bv[8];
#pragma unroll
                for (int e = 0; e < 4; ++e) { bv[e] = bf2f((unsigned short)b0[e]) * wv[e]; bv[4 + e] = bf2f((unsigned short)b1[e]) * wv[4 + e]; }
                const bf16x8 bf = pack8(bv);
#pragma unroll
                for (int d = 0; d < 4; ++d) acc[ms][d] = MFMA16(bf, xf[d], acc[ms][d]);
            }
        }
        float* ds = (float*)(F.ws + WS_SDS) + ub * 4096;
#pragma unroll
        for (int ms = 0; ms < 4; ++ms)
#pragma unroll
            for (int d = 0; d < 4; ++d) *(f32x4*)(ds + (16 * d + lr) * 64 + 16 * ms + 4 * g) = acc[ms][d];
        if (F.lane == 0) ((float*)(F.ws + WS_SDEC))[ub] = __expf(scum[rh * 64 + (r ? 0 : 63)]);
    }
    if constexpr (DO_INTRA) {
        bf16x8 bfr[4][2], cfr[4][2];
#pragma unroll
        for (int m = 0; m < 4; ++m)
#pragma unroll
            for (int ks = 0; ks < 2; ++ks) { bfr[m][ks] = *(const LAS bf16x8*)(xc + (16 * m + lr) * SD_RS + 256 + gp * 64 + 32 * ks + 8 * g); cfr[m][ks] = *(const LAS bf16x8*)(xc + (16 * m + lr) * SD_RS + 384 + gp * 64 + 32 * ks + 8 * g); }
        f32x4 y[4][4];
#pragma unroll
        for (int m = 0; m < 4; ++m)
#pragma unroll
            for (int d = 0; d < 4; ++d) y[m][d] = (f32x4){0.f, 0.f, 0.f, 0.f};
        if constexpr (OUT) {
            bf16x8 cs[4][2];
#pragma unroll
            for (int m = 0; m < 4; ++m) { const float ec = __expf(scum[rh * 64 + 16 * m + lr]);
#pragma unroll
                for (int ks = 0; ks < 2; ++ks) { float cv[8]; unpack8(cfr[m][ks], cv);
#pragma unroll
                    for (int e = 0; e < 8; ++e) cv[e] *= ec;
                    cs[m][ks] = pack8(cv); } }
#pragma unroll
            for (int d = 0; d < 4; ++d) {
#pragma unroll
                for (int m = 0; m < 4; ++m) { y[m][d] = MFMA16(cs[m][0], sfr[d][0], y[m][d]); y[m][d] = MFMA16(cs[m][1], sfr[d][1], y[m][d]); }
            }
        }
        asm volatile("" ::: "memory");
        bf16x8 xf[2][4];
#pragma unroll
        for (int sg = 0; sg < 2; ++sg)
#pragma unroll
            for (int d = 0; d < 4; ++d) { const LAS bf16* p0 = xc + (32 * sg + 4 * g + ((F.lane & 15) >> 2)) * SD_RS + h * 64 + 16 * d + 4 * (F.lane & 3); xf[sg][d] = cat8(trread(p0), trread(p0 + 16 * SD_RS)); }
        const f32x4 zero4 = (f32x4){0.f, 0.f, 0.f, 0.f};
#pragma unroll
        for (int m = 0; m < 4; ++m) {
            const int t = 16 * m + lr; const float ct = scum[rh * 64 + t];
#pragma unroll
            for (int sg = 0; sg < 2; ++sg) {
                f32x4 p0 = MFMA16(bfr[2 * sg][0], cfr[m][0], zero4), p1 = MFMA16(bfr[2 * sg + 1][0], cfr[m][0], zero4);
                p0 = MFMA16(bfr[2 * sg][1], cfr[m][1], p0); p1 = MFMA16(bfr[2 * sg + 1][1], cfr[m][1], p1);
                float pv[8];
#pragma unroll
                for (int j = 0; j < 4; ++j) { const int s0 = 32 * sg + 4 * g + j, s1 = s0 + 16;
                    pv[j] = (r ? s0 >= t : s0 <= t) ? p0[j] * __expf(ct - scum[rh * 64 + s0]) * sdt[s0 * 8 + rh] : 0.f;
                    pv[4 + j] = (r ? s1 >= t : s1 <= t) ? p1[j] * __expf(ct - scum[rh * 64 + s1]) * sdt[s1 * 8 + rh] : 0.f; }
                const bf16x8 pf = pack8(pv);
#pragma unroll
                for (int d = 0; d < 4; ++d) y[m][d] = MFMA16(pf, xf[sg][d], y[m][d]);
            }
        }
        __syncthreads();
        LAS float* yx = (LAS float*)(F.lds + SD_RAW);
        if (r == 1) {
#pragma unroll
            for (int m = 0; m < 4; ++m)
#pragma unroll
                for (int d = 0; d < 4; ++d)
#pragma unroll
                    for (int j = 0; j < 4; ++j) yx[(16 * m + 4 * g + j) * 260 + h * 64 + 16 * d + lr] = y[m][d][j];
        }
        __syncthreads();
        if (r == 0) { const float dsk = a.in[I_SSDD][L * 4 + h];
#pragma unroll
            for (int m = 0; m < 4; ++m)
#pragma unroll
                for (int d = 0; d < 4; ++d)
#pragma unroll
                    for (int j = 0; j < 4; ++j) { const int t = 16 * m + 4 * g + j, c = h * 64 + 16 * d + lr; yx[t * 260 + c] += y[m][d][j] + dsk * bf2f(xc[t * SD_RS + c]); asm volatile("" ::: "memory"); }
        }
        __syncthreads();
        if constexpr (OUT) {
        { const int t = F.tid >> 3, c0 = (F.tid & 7) * 32; const bf16* zr = PB + (size_t)(tok0 + t) * PW + PC_Z + c0; const float* ng = a.in[I_SSDNG] + L * 256 + c0;
          float v[32]; float ss = 0.f;
#pragma unroll
          for (int q = 0; q < 4; ++q) { float zv[8]; unpack8(*(const bf16x8*)(zr + 8 * q), zv);
#pragma unroll
              for (int e = 0; e < 8; ++e) { const float u = yx[t * 260 + c0 + 8 * q + e] * siluf_(zv[e]); v[8 * q + e] = u; ss += u * u; } }
          ss += swz_xor<1>(ss); ss += swz_xor<2>(ss); ss += swz_xor<4>(ss);
          const float rs = rsqrtf(ss * (1.f / 256.f) + 1e-6f);
          bf16* MX = (bf16*)(F.ws + WS_MIX) + (size_t)(tok0 + t) * MW + 1024 + c0;
#pragma unroll
          for (int q = 0; q < 4; ++q) { float o8[8];
#pragma unroll
              for (int e = 0; e < 8; ++e) o8[e] = v[8 * q + e] * rs * ng[8 * q + e];
              *(bf16x8*)(MX + 8 * q) = pack8(o8); } }
        } else {
            { const int t = F.tid >> 3, c0 = (F.tid & 7) * 32; bf16* yo = (bf16*)(F.ws + WS_SYI) + (size_t)(tok0 + t) * 256 + c0;
#pragma unroll
              for (int q = 0; q < 4; ++q) { float o8[8];
#pragma unroll
                  for (int e = 0; e < 8; ++e) o8[e] = yx[t * 260 + c0 + 8 * q + e];
                  *(bf16x8*)(yo + 8 * q) = pack8(o8); } }
            { bf16* cb = (bf16*)(F.ws + WS_SCB) + (size_t)tok0 * 128;
#pragma unroll
              for (int k = 0; k < 2; ++k) { const int i = F.tid + k * NTHR, t = i >> 4, pc = i & 15; *(u32x4*)(cb + (size_t)t * 128 + pc * 8) = *(const LAS u32x4*)(xc + t * SD_RS + 384 + pc * 8); } }
            { const int t = F.tid >> 3, q = F.tid & 7; ((float*)(F.ws + WS_SCUM))[(size_t)(tok0 + t) * 8 + q] = scum[q * 64 + t]; }
        }
    }
}


__device__ __forceinline__ void ssd_light(Frame& F0, CArgs& a, int L, int cid) {
    LAUNDER_F(F0)
    const int tok0 = chunk_tok0(cid), h = F.wave & 3, r = F.wave >> 2, lr = F.lane & 15, g = F.lane >> 4, gp = h >> 1, rh = r * 4 + h;
    const bf16* cb = (const bf16*)(F.ws + WS_SCB) + (size_t)tok0 * 128; const float* cum = (const float*)(F.ws + WS_SCUM) + (size_t)tok0 * 8;
    const bf16* se = (const bf16*)(F.ws + WS_SSE) + (((size_t)cid * 4 + h) * 2 + r) * 4096;
    bf16x8 cfr[4][2], sfr[4][2]; float ec[4];
#pragma unroll
    for (int m = 0; m < 4; ++m) { ec[m] = cum[(size_t)(16 * m + lr) * 8 + rh];
#pragma unroll
        for (int ks = 0; ks < 2; ++ks) cfr[m][ks] = *(const bf16x8*)(cb + (size_t)(16 * m + lr) * 128 + gp * 64 + 32 * ks + 8 * g); }
#pragma unroll
    for (int d = 0; d < 4; ++d) { sfr[d][0] = *(const bf16x8*)(se + (16 * d + lr) * 64 + 8 * g); sfr[d][1] = *(const bf16x8*)(se + (16 * d + lr) * 64 + 32 + 8 * g); }
    const int tt = F.tid >> 3, c0 = (F.tid & 7) * 32;
    bf16x8 zr[4], yi[4];
    { const bf16* zp = (const bf16*)(F.ws + WS_PBUF) + (size_t)(tok0 + tt) * PW + PC_Z + c0; const bf16* yp = (const bf16*)(F.ws + WS_SYI) + (size_t)(tok0 + tt) * 256 + c0;
#pragma unroll
      for (int q = 0; q < 4; ++q) { zr[q] = *(const bf16x8*)(zp + 8 * q); yi[q] = *(const bf16x8*)(yp + 8 * q); } }
    f32x4 y[4][4];
#pragma unroll
    for (int m = 0; m < 4; ++m) { const float e_ = __expf(ec[m]); bf16x8 cs[2];
#pragma unroll
        for (int ks = 0; ks < 2; ++ks) { float cv[8]; unpack8(cfr[m][ks], cv);
#pragma unroll
            for (int e = 0; e < 8; ++e) cv[e] *= e_;
            cs[ks] = pack8(cv); }
#pragma unroll
        for (int d = 0; d < 4; ++d) { y[m][d] = MFMA16(cs[0], sfr[d][0], ((f32x4){0.f, 0.f, 0.f, 0.f})); y[m][d] = MFMA16(cs[1], sfr[d][1], y[m][d]); } }
    LAS float* yx = (LAS float*)(F.lds + SD_RAW);
    __syncthreads();
    if (r == 1) {
#pragma unroll
        for (int m = 0; m < 4; ++m)
#pragma unroll
            for (int d = 0; d < 4; ++d)
#pragma unroll
                for (int j = 0; j < 4; ++j) yx[(16 * m + 4 * g + j) * 260 + h * 64 + 16 * d + lr] = y[m][d][j];
    }
    __syncthreads();
    if (r == 0) {
#pragma unroll
        for (int m = 0; m < 4; ++m)
#pragma unroll
            for (int d = 0; d < 4; ++d)
#pragma unroll
                for (int j = 0; j < 4; ++j) yx[(16 * m + 4 * g + j) * 260 + h * 64 + 16 * d + lr] += y[m][d][j];
    }
    __syncthreads();
    { const float* ng = a.in[I_SSDNG] + L * 256 + c0;
      float v[32]; float ss = 0.f;
#pragma unroll
      for (int q = 0; q < 4; ++q) { float zv[8], yv[8]; unpack8(zr[q], zv); unpack8(yi[q], yv);
#pragma unroll
          for (int e = 0; e < 8; ++e) { const float u = (yx[tt * 260 + c0 + 8 * q + e] + yv[e]) * siluf_(zv[e]); v[8 * q + e] = u; ss += u * u; } }
      ss += swz_xor<1>(ss); ss += swz_xor<2>(ss); ss += swz_xor<4>(ss);
      const float rs = rsqrtf(ss * (1.f / 256.f) + 1e-6f);
      bf16* MX = (bf16*)(F.ws + WS_MIX) + (size_t)(tok0 + tt) * MW + 1024 + c0;
#pragma unroll
      for (int q = 0; q < 4; ++q) { float o8[8];
#pragma unroll
          for (int e = 0; e < 8; ++e) o8[e] = v[8 * q + e] * rs * ng[8 * q + e];
          *(bf16x8*)(MX + 8 * q) = pack8(o8); } }
}

constexpr int FF_XP = 0, FF_TR = FF_XP + 16 * 64 * 16 * 2, FF_TI = FF_TR + 16 * 64 * 16 * 2, FF_TW = FF_TI + 16 * 64 * 16 * 2, FF_FT = FF_TW + 64 * 16 * 8, FF_END = FF_FT + 2 * 64 * 72 * 2;
static_assert(FF_END <= MISC_OFF, "FFT LDS");
__device__ __forceinline__ void fft_unit(Frame& F0, int u) {
    LAUNDER_F(F0)
    const int b = u >> 6, cg = (u >> 2) & 15, kb = u & 3, lr = F.lane & 15, g = F.lane >> 4;
    const bf16* PB = (const bf16*)(F.ws + WS_PBUF) + (size_t)b * SEQ * PW + PC_FU + 16 * cg;
    const bf16* f64 = (const bf16*)(F.ws + WS_TAB + TAB_F64); const float* tw = (const float*)(F.ws + WS_TAB + TAB_TW);
    LAS bf16* xp = (LAS bf16*)(F.lds + FF_XP); LAS bf16* tr = (LAS bf16*)(F.lds + FF_TR); LAS bf16* ti = (LAS bf16*)(F.lds + FF_TI);
    LAS float* stw = (LAS float*)(F.lds + FF_TW);
    LAS bf16* sft = (LAS bf16*)(F.lds + FF_FT);
    bf16x8 fc1[2], fs1[2];
#pragma unroll
    for (int ks = 0; ks < 2; ++ks) { fc1[ks] = *(const bf16x8*)(f64 + (16 * kb + lr) * 64 + 32 * ks + 8 * g); fs1[ks] = *(const bf16x8*)(f64 + 4096 + (16 * kb + lr) * 64 + 32 * ks + 8 * g); }
    const f32x4 zero4 = (f32x4){0.f, 0.f, 0.f, 0.f};
    u32x4 xr[4], ft[2]; f32x2 twr[2];
#pragma unroll
    for (int k = 0; k < 4; ++k) { const int i = F.tid + k * NTHR, n2l = i >> 7, n1 = (i >> 1) & 63, hf = i & 1; xr[k] = *(const u32x4*)(PB + (size_t)(64 * n1 + n2l) * PW + hf * 8); }
#pragma unroll
    for (int k = 0; k < 2; ++k) { const int i = F.tid + k * NTHR; ft[k] = *(const u32x4*)(f64 + (size_t)i * 8); twr[k] = *(const f32x2*)(tw + 2 * ((i >> 4) * (16 * kb + (i & 15)))); }
    __syncthreads();
#pragma unroll
    for (int k = 0; k < 2; ++k) { const int i = F.tid + k * NTHR, row = i >> 3, pc = i & 7; *(LAS u32x4*)(sft + row * 72 + pc * 8) = ft[k]; stw[2 * i] = twr[k][0]; stw[2 * i + 1] = twr[k][1]; }
    for (int pa = 0; pa < 4; ++pa) {
        if (pa) __syncthreads();
#pragma unroll
        for (int k = 0; k < 4; ++k) { const int i = F.tid + k * NTHR, n2l = i >> 7, n1 = (i >> 1) & 63, hf = i & 1; *(LAS u32x4*)(xp + (n2l * 64 + n1) * 16 + hf * 8) = xr[k]; }
        if (pa < 3) {
#pragma unroll
            for (int k = 0; k < 4; ++k) { const int i = F.tid + k * NTHR, n2l = i >> 7, n1 = (i >> 1) & 63, hf = i & 1; xr[k] = *(const u32x4*)(PB + (size_t)(64 * n1 + 16 * (pa + 1) + n2l) * PW + hf * 8); }
        }
        __syncthreads();
#pragma unroll
        for (int q = 0; q < 2; ++q) {
            const int n2l = 2 * F.wave + q, n2 = 16 * pa + n2l;
            f32x4 tc = zero4, ts = zero4;
#pragma unroll
            for (int ks = 0; ks < 2; ++ks) { const LAS bf16* p0 = xp + (n2l * 64 + 32 * ks + 8 * g + ((F.lane & 15) >> 2)) * 16 + 4 * (F.lane & 3); const bf16x8 xb = cat8(trread(p0), trread(p0 + 4 * 16));
                tc = MFMA16(fc1[ks], xb, tc); ts = MFMA16(fs1[ks], xb, ts); }
#pragma unroll
            for (int j = 0; j < 4; ++j) { const int k1l = 4 * g + j; const f32x2 w = *(const LAS f32x2*)(stw + 2 * (n2 * 16 + k1l));
                tr[(k1l * 64 + n2) * 16 + lr] = (bf16)f2bf(tc[j] * w[0] - ts[j] * w[1]); ti[(k1l * 64 + n2) * 16 + lr] = (bf16)f2bf(-(tc[j] * w[1] + ts[j] * w[0])); }
        }
    }
    __syncthreads();
    bf16* MX0 = (bf16*)(F.ws + WS_MIX) + (size_t)b * SEQ * MW + 16 * cg;
    LAS bf16* so = xp + F.wave * 2048;
#pragma unroll
    for (int q = 0; q < 2; ++q) {
        const int k1l = 2 * F.wave + q, k1 = 16 * kb + k1l;
        bf16x8 br[2], bi[2];
#pragma unroll
        for (int ks = 0; ks < 2; ++ks) { const int off = (k1l * 64 + 32 * ks + 8 * g + ((F.lane & 15) >> 2)) * 16 + 4 * (F.lane & 3); br[ks] = cat8(trread(tr + off), trread(tr + off + 64)); bi[ks] = cat8(trread(ti + off), trread(ti + off + 64)); }
#pragma unroll
        for (int m = 0; m < 4; ++m) {
            f32x4 yr = zero4, y1 = zero4, y2 = zero4;
#pragma unroll
            for (int ks = 0; ks < 2; ++ks) { const bf16x8 fc = *(const LAS bf16x8*)(sft + (16 * m + lr) * 72 + 32 * ks + 8 * g), fs = *(const LAS bf16x8*)(sft + (64 + 16 * m + lr) * 72 + 32 * ks + 8 * g);
                yr = MFMA16(fc, br[ks], yr); yr = MFMA16(fs, bi[ks], yr); y1 = MFMA16(fc, bi[ks], y1); y2 = MFMA16(fs, br[ks], y2); }
#pragma unroll
            for (int j = 0; j < 4; ++j) { const int k2 = 16 * m + 4 * g + j; so[k2 * 32 + lr] = (bf16)f2bf(yr[j] * (1.f / 64.f)); so[k2 * 32 + 16 + lr] = (bf16)f2bf((y1[j] - y2[j]) * (1.f / 64.f)); }
        }
#pragma unroll
        for (int p = 0; p < 4; ++p) { const int pc = F.lane + 64 * p, k2 = pc >> 2, part = pc & 3;
            const u32x4 v = *(const LAS u32x4*)(so + k2 * 32 + (part >> 1) * 16 + (part & 1) * 8);
            *(u32x4*)(MX0 + (size_t)(64 * k2 + k1) * MW + (part >> 1) * 256 + (part & 1) * 8) = v; }
    }
}
constexpr int CD_RS = 264;
static_assert(256 * CD_RS * 2 <= MISC_OFF, "ctx DFT LDS");
__device__ __forceinline__ void dft_ctx_unit(Frame& F0, int u) {
    LAUNDER_F(F0)
    const int b = u >> 3, kb = u & 7, lr = F.lane & 15, g = F.lane >> 4;
    LAS bf16* sl = (LAS bf16*)F.lds;
    const bf16* PB = (const bf16*)(F.ws + WS_PBUF) + (size_t)(NLAT + b * CTXL) * PW + PC_FU;
    const bf16* dc = (const bf16*)(F.ws + WS_DFTC);
    __syncthreads();
#pragma unroll
    for (int h = 0; h < 2; ++h) { u32x4 v[8];
#pragma unroll
        for (int k = 0; k < 8; ++k) { const int i = F.tid + (h * 8 + k) * NTHR, n = i >> 5, pc = i & 31; v[k] = *(const u32x4*)(PB + (size_t)n * PW + pc * 8); }
#pragma unroll
        for (int k = 0; k < 8; ++k) { const int i = F.tid + (h * 8 + k) * NTHR, n = i >> 5, pc = i & 31; *(LAS u32x4*)(sl + n * CD_RS + pc * 8) = v[k]; } }
    __syncthreads();
    f32x4 acc[4][2];
#pragma unroll
    for (int mt = 0; mt < 4; ++mt)
#pragma unroll
        for (int nt = 0; nt < 2; ++nt) acc[mt][nt] = (f32x4){0.f, 0.f, 0.f, 0.f};
#pragma unroll 2
    for (int ks = 0; ks < 8; ++ks) {
        bf16x8 af[4], bfm[2];
#pragma unroll
        for (int mt = 0; mt < 4; ++mt) af[mt] = *(const bf16x8*)(dc + (size_t)((mt >> 1) * 256 + 32 * kb + 16 * (mt & 1) + lr) * 256 + 32 * ks + 8 * g);
#pragma unroll
        for (int nt = 0; nt < 2; ++nt) { const LAS bf16* p0 = sl + (32 * ks + 8 * g + ((F.lane & 15) >> 2)) * CD_RS + 32 * F.wave + 16 * nt + 4 * (F.lane & 3); bfm[nt] = cat8(trread(p0), trread(p0 + 4 * CD_RS)); }
#pragma unroll
        for (int mt = 0; mt < 4; ++mt)
#pragma unroll
            for (int nt = 0; nt < 2; ++nt) acc[mt][nt] = MFMA16(af[mt], bfm[nt], acc[mt][nt]);
    }
    bf16* MX = (bf16*)(F.ws + WS_MIX) + (size_t)(NLAT + b * CTXL + 32 * kb) * MW + 32 * F.wave + lr;
#pragma unroll
    for (int mt = 0; mt < 4; ++mt)
#pragma unroll
        for (int nt = 0; nt < 2; ++nt)
#pragma unroll
            for (int j = 0; j < 4; ++j) MX[(size_t)(16 * (mt & 1) + 4 * g + j) * MW + (mt >> 1) * 256 + 16 * nt] = (bf16)f2bf(acc[mt][nt][j] * (1.f / 16.f));
}

#ifndef SUBMASK
#define SUBMASK 0xFFFF
#endif
#define SUB(bit) (rep == 0 || ((SUBMASK >> (bit)) & 1))
__device__ __forceinline__ void p_mix_a(Frame& F, CArgs& a, int L, int rep = 0) {
    if (SUB(0)) {
        pg8::Gemm g{(const bf16*)(F.ws + WS_A2), (const bf16*)(F.ws + WS_S5P) + (size_t)L * 16 * 256 * 256, 1024, 512, OPQ(256)};
        SgOrder<FillS5> S; S.init(144, 1, F.G, F.bid); S.f = FillS5{(size_t)256 * 256 * 2};
        EpiS5S E{(float*)(F.ws + WS_S5S)};
        pg8::gemm_phase(F.lds, g, S, E, fresh_tid(F.wave));
    }
    const int og = F.G >= 208 ? 144 : 0, os = F.G >= 208 ? 176 : 32 % F.G;
    if (SUB(1)) for (int u = (F.bid + F.G - og) % F.G; u < NCHK; u += F.G) gla_chunk<MIX_P1 ? 2 : 0>(F, a, L, u);
    if (SUB(2)) for (int u = (F.bid + F.G - os) % F.G; u < NCHK; u += F.G) ssd_chunk<MIX_P1 ? 2 : 0>(F, a, L, u);
    __syncthreads();
}
__device__ __forceinline__ void p_mix_b(Frame& F, CArgs& a, int L, int rep = 0) {
    if (SUB(3)) for (int u = F.bid; u < 256; u += F.G) {
        const int vz = F.tid >> 9, uv = u + vz, wv = (F.tid >> 6);
        const int b = uv >> 5, g = (uv >> 1) & 15, r = uv & 1;
        const f32x2 a16 = *(const f32x2*)((const float*)(F.ws + WS_A16) + ((size_t)((L * 2 + r) * 16 + g) * 64 + F.lane) * 2);
        const float* S = (const float*)(F.ws + WS_S5S) + (size_t)g * S5ROWS * 256 + r * 128 + F.lane; bf16* A2 = (bf16*)(F.ws + WS_A2) + (size_t)g * S5ROWS * 512 + 256 + r * 128 + F.lane;
        LAS float* ex = (LAS float*)F.lds;
        LAS float* sl = ex + 17 * 128;
        __syncthreads();
#pragma unroll 1
        for (int sg = wv; sg < 17; sg += 8) {
            float sr[16], si[16];
#pragma unroll
            for (int n = 0; n < 16; ++n) { const int i = 16 * sg + n; const int row = i < 16 ? 2048 + 16 * b + (r ? 15 - i : i) : 256 * b + (r ? 271 - i : i - 16); sr[n] = S[(size_t)row * 256]; si[n] = S[(size_t)row * 256 + 64]; }
            float hr = 0.f, hi = 0.f;
#pragma unroll
            for (int n = 0; n < 16; ++n) { sl[((16 * sg + n) * 64 + F.lane) * 2] = sr[n]; sl[((16 * sg + n) * 64 + F.lane) * 2 + 1] = si[n];
                const float nr = a16[0] * hr - a16[1] * hi + sr[n], ni = a16[0] * hi + a16[1] * hr + si[n]; hr = nr; hi = ni; }
            ex[(sg * 64 + F.lane) * 2] = hr; ex[(sg * 64 + F.lane) * 2 + 1] = hi;
        }
        __syncthreads();
        float pr = a16[0], pi = a16[1];
#pragma unroll
        for (int q = 0; q < 4; ++q) { const float nr = pr * pr - pi * pi, ni = 2.f * pr * pi; pr = nr; pi = ni; }
#pragma unroll 1
        for (int sg = wv; sg < 17; sg += 8) {
            float hr = 0.f, hi = 0.f;
            for (int j = 0; j < sg; ++j) { const float er = ex[(j * 64 + F.lane) * 2], ei = ex[(j * 64 + F.lane) * 2 + 1]; const float nr = pr * hr - pi * hi + er, ni = pr * hi + pi * hr + ei; hr = nr; hi = ni; }
#pragma unroll 4
            for (int n = 0; n < 16; ++n) { const int i = 16 * sg + n; const int row = i < 16 ? 2048 + 16 * b + (r ? 15 - i : i) : 256 * b + (r ? 271 - i : i - 16);
                A2[(size_t)row * 512] = (bf16)f2bf(hr); A2[(size_t)row * 512 + 64] = (bf16)f2bf(hi);
                const float xr_ = sl[(i * 64 + F.lane) * 2], xi_ = sl[(i * 64 + F.lane) * 2 + 1];
                const float nr = a16[0] * hr - a16[1] * hi + xr_, ni = a16[0] * hi + a16[1] * hr + xi_; hr = nr; hi = ni; }
        }
    }
    if (F.G == 256) {
        if (SUB(3)) { const int vz = F.tid >> 9;
            const int ug = F.bid + vz, sqg = ug >> 2, bg = sqg >> 3, hg = (sqg >> 1) & 3, rg = sqg & 1, eg = (ug & 3) * 512 + F.tid, cg = eg & 31;
            const int u0 = F.bid + vz, s0q = u0 >> 3, b0 = s0q >> 3, h0 = (s0q >> 1) & 3, r0 = s0q & 1, e0 = (u0 & 7) * 512 + F.tid;
            const int u1 = F.bid + 256 + vz, s1q = u1 >> 3, b1 = s1q >> 3, h1 = (s1q >> 1) & 3, r1 = s1q & 1, e1 = (u1 & 7) * 512 + F.tid;
            const float* gds = (const float*)(F.ws + WS_GDS); const float* gdc = (const float*)(F.ws + WS_GDEC); bf16* gse = (bf16*)(F.ws + WS_GSE);
            const float* sds = (const float*)(F.ws + WS_SDS); const float* sdc = (const float*)(F.ws + WS_SDEC); bf16* sse = (bf16*)(F.ws + WS_SSE);
            float sg_ = 0.f, s0_ = 0.f, s1_ = 0.f;
#define SCAN_CID(i, b, r) ((i) < 4 ? 512 + (b) * 4 + ((r) ? 3 - (i) : (i)) : (b) * 64 + ((r) ? 67 - (i) : (i) - 4))
            for (int i0 = 0; i0 < 68; i0 += 17) { float gv_[17], gc_[17], av_[17], ac_[17], bv_[17], bc_[17];
#pragma unroll
                for (int k = 0; k < 17; ++k) { const int i = i0 + k;
                    { const size_t ub = ((size_t)SCAN_CID(i, bg, rg) * 4 + hg) * 2 + rg; gv_[k] = gds[ub * 2048 + eg]; gc_[k] = gdc[ub * 32 + cg]; }
                    { const size_t ub = ((size_t)SCAN_CID(i, b0, r0) * 4 + h0) * 2 + r0; av_[k] = sds[ub * 4096 + e0]; ac_[k] = sdc[ub]; }
                    { const size_t ub = ((size_t)SCAN_CID(i, b1, r1) * 4 + h1) * 2 + r1; bv_[k] = sds[ub * 4096 + e1]; bc_[k] = sdc[ub]; } }
#pragma unroll
                for (int k = 0; k < 17; ++k) { const int i = i0 + k;
                    { const size_t ub = ((size_t)SCAN_CID(i, bg, rg) * 4 + hg) * 2 + rg; gse[ub * 2048 + eg] = (bf16)f2bf(sg_); sg_ = gc_[k] * sg_ + gv_[k]; }
                    { const size_t ub = ((size_t)SCAN_CID(i, b0, r0) * 4 + h0) * 2 + r0; sse[ub * 4096 + e0] = (bf16)f2bf(s0_); s0_ = ac_[k] * s0_ + av_[k]; }
                    { const size_t ub = ((size_t)SCAN_CID(i, b1, r1) * 4 + h1) * 2 + r1; sse[ub * 4096 + e1] = (bf16)f2bf(s1_); s1_ = bc_[k] * s1_ + bv_[k]; } } }
#undef SCAN_CID
        }
    } else {
    if (SUB(3)) for (int u = F.bid; u < 256; u += F.G) { const int uv = u + (F.tid >> 9), sq = uv >> 2, b = sq >> 3, hh = (sq >> 1) & 3, r = sq & 1, e = (uv & 3) * 512 + F.tid, c = e & 31;
        const float* ds = (const float*)(F.ws + WS_GDS); const float* dc = (const float*)(F.ws + WS_GDEC); bf16* se = (bf16*)(F.ws + WS_GSE);
        float s = 0.f;
        for (int i0 = 0; i0 < 68; i0 += 17) { float dv[17], cv[17];
#pragma unroll
            for (int k = 0; k < 17; ++k) { const int i = i0 + k; const int cid = i < 4 ? 512 + b * 4 + (r ? 3 - i : i) : b * 64 + (r ? 67 - i : i - 4); const size_t ub = ((size_t)cid * 4 + hh) * 2 + r; dv[k] = ds[ub * 2048 + e]; cv[k] = dc[ub * 32 + c]; }
#pragma unroll
            for (int k = 0; k < 17; ++k) { const int i = i0 + k; const int cid = i < 4 ? 512 + b * 4 + (r ? 3 - i : i) : b * 64 + (r ? 67 - i : i - 4); const size_t ub = ((size_t)cid * 4 + hh) * 2 + r; se[ub * 2048 + e] = (bf16)f2bf(s); s = cv[k] * s + dv[k]; } } }
    if (SUB(3)) for (int u = F.bid; u < 512; u += F.G) { const int uv = u + (F.tid >> 9), sq = uv >> 3, b = sq >> 3, h = (sq >> 1) & 3, r = sq & 1, e = (uv & 7) * 512 + F.tid;
        const float* ds = (const float*)(F.ws + WS_SDS); const float* dc = (const float*)(F.ws + WS_SDEC); bf16* se = (bf16*)(F.ws + WS_SSE);
        float s = 0.f;
        for (int i0 = 0; i0 < 68; i0 += 17) { float dv[17], cv[17];
#pragma unroll
            for (int k = 0; k < 17; ++k) { const int i = i0 + k; const int cid = i < 4 ? 512 + b * 4 + (r ? 3 - i : i) : b * 64 + (r ? 67 - i : i - 4); const size_t ub = ((size_t)cid * 4 + h) * 2 + r; dv[k] = ds[ub * 4096 + e]; cv[k] = dc[ub]; }
#pragma unroll
            for (int k = 0; k < 17; ++k) { const int i = i0 + k; const int cid = i < 4 ? 512 + b * 4 + (r ? 3 - i : i) : b * 64 + (r ? 67 - i : i - 4); const size_t ub = ((size_t)cid * 4 + h) * 2 + r; se[ub * 4096 + e] = (bf16)f2bf(s); s = cv[k] * s + dv[k]; } } }
    }
    if (SUB(4)) for (int u = F.bid; u < 512; u += F.G) fft_unit(F, u);
    if (SUB(5)) for (int u = (F.bid + 64) % F.G; u < 64; u += F.G) dft_ctx_unit(F, u);
    __syncthreads();
}
__device__ __forceinline__ void p_mix_c(Frame& F, CArgs& a, int L, int rep = 0) {
#ifndef MIXC_PARTS
#define MIXC_PARTS 7
#endif
    if ((MIXC_PARTS & 1) && SUB(6)) {
        pg8::Gemm g{(const bf16*)(F.ws + WS_A2), (const bf16*)(F.ws + WS_S5B2) + (size_t)L * 16 * 256 * 512, 1024, 1024, OPQ(512)};
        SgOrder<FillS5> S; S.init(144, 1, F.G, F.bid); S.f = FillS5{(size_t)256 * 512 * 2};
        EpiS5Y E{(bf16*)(F.ws + WS_ACT5)};
        pg8::gemm_phase(F.lds, g, S, E, fresh_tid(F.wave));
    }
    const int nch = (L == DEPTH - 1) ? 512 : NCHK;
    const int og = F.G >= 208 ? 144 : 0, os = F.G >= 208 ? 176 : 32 % F.G;
    if ((MIXC_PARTS & 2) && SUB(7)) for (int u = (F.bid + F.G - og) % F.G; u < nch; u += F.G) { if constexpr (MIX_P1) gla_light(F, a, L, u); else gla_chunk<1>(F, a, L, u); }
    if ((MIXC_PARTS & 4) && SUB(8)) for (int u = (F.bid + F.G - os) % F.G; u < nch; u += F.G) { if constexpr (MIX_P1) ssd_light(F, a, L, u); else ssd_chunk<1>(F, a, L, u); }
    __syncthreads();
}

constexpr int NPH = 11, PH_TOTAL = 2 + DEPTH * NPH;
#ifndef PHASE_MASK
#define PHASE_MASK 0xFFFF
#endif
#define PM(i) ((PHASE_MASK >> (i)) & 1)
#ifndef DUP_MASK
#define DUP_MASK 0
#endif
#define NREP(k) (((DUP_MASK >> (k)) & 1) ? 2 : 1)
#ifndef MK_ONE_LAUNCH
#define MK_ONE_LAUNCH 0
#endif

__global__ void __launch_bounds__(NTHR, 2) mk_fwd(Args args_by_value) {
#define args (*fresh_args())
    extern __shared__ __attribute__((aligned(16))) unsigned char lds_raw[];
    Frame F;
    F.lds = (LAS unsigned char*)lds_raw; F.MISC = (volatile LAS unsigned*)(F.lds + MISC_OFF);
    F.tid = threadIdx.x; F.lane = F.tid & 63; F.wave = __builtin_amdgcn_readfirstlane(F.tid >> 6); F.G = gridDim.x; F.bid = blockIdx.x;
    F.ws = args_by_value.ws; F.ctl = (unsigned*)(args_by_value.ws + WS_CTL);
    if (F.tid < 64) F.MISC[F.tid] = 0u;
    __syncthreads();
#if MK_ONE_LAUNCH
    XcdBarrier bar = xcd_barrier_post(F.ctl + CW_BAR, F.MISC + 8);
#define GRID_BAR() xcd_barrier(bar)
#else
#define GRID_BAR() do { } while (0)
#endif
    const int lo = args_by_value.ph_lo, hi = args_by_value.ph_hi;
#define IN(k) (lo <= (k) && (k) < hi)
#define FRESH() do { const int t_ = fresh_tid(F.wave); F.tid = t_; F.lane = t_ & 63; } while (0)
#define SEAM(k) do { if (IN(k) && IN((k) + 1)) GRID_BAR(); } while (0)
    if (PM(0) && IN(0)) { FRESH(); p_prologue(F, args); }
#ifdef DUP_PROLOGUE
    GRID_BAR(); if (PM(0) && IN(0)) { FRESH(); p_prologue(F, args, CW_QUEUE + 64); }
#endif
    SEAM(0);
    {
        const int pb = 1 + 0 * NPH;
        const int mrows = (0 == DEPTH - 1) ? NLAT : NT;
        if (PM(1) && IN(pb + 0)) { FRESH(); p_norm1(F, args, OPQ(0)); }
#ifdef DUP_NORM1
        GRID_BAR(); if (PM(1) && IN(pb + 0)) { FRESH(); p_norm1(F, args, OPQ(0), true); }
#endif
 SEAM(pb + 0);
        if (PM(2) && IN(pb + 1)) for (int rep_ = 0; rep_ < NREP(2); ++rep_) { if (rep_) GRID_BAR(); const int Lg = OPQ(0);
#if INPROJ_F8
            pg8::Gemm g{F.ws + WS_H8, F.ws + WS_WIN + (size_t)Lg * PW * DM, DM, DM, OPQ(DM / 2)};
            SgOrder<FillPlain> S; S.init(NT / 256, PW / 256, F.G, F.bid); S.f = FillPlain{(size_t)256 * DM, (size_t)256 * DM};
            EpiInproj E{(bf16*)(F.ws + WS_PBUF), (bf16*)(F.ws + WS_A2)};
            pg8::gemm_phase<EpiInproj, SgOrder<FillPlain>, true, F8_ALIGN, F8_SP2>(F.lds, g, S, E, fresh_tid(F.wave));
#else
            pg8::Gemm g{(const bf16*)(F.ws + WS_H), (const bf16*)(F.ws + WS_WIN) + (size_t)Lg * PW * DM, DM * 2, DM * 2, OPQ(DM)};
            SgOrder<FillPlain> S; S.init(NT / 256, PW / 256, F.G, F.bid); S.f = FillPlain{(size_t)256 * DM * 2, (size_t)256 * DM * 2};
            EpiInproj E{(bf16*)(F.ws + WS_PBUF), (bf16*)(F.ws + WS_A2)};
            pg8::gemm_phase(F.lds, g, S, E, fresh_tid(F.wave));
#endif
        }
#if defined(SHADOW_IN)
        if (PM(2) && IN(pb + 1)) { GRID_BAR(); const int Lg = OPQ(0);
            pg8::Gemm g{(const bf16*)(F.ws + WS_H), (const bf16*)(F.ws + WS_WIN) + (size_t)Lg * PW * DM, DM * 2, DM * 2, OPQ(DM)};
            SgOrder<FillPlain> S; S.init(NT / 256, PW / 256, F.G, F.bid); S.f = FillPlain{(size_t)256 * DM * 2, (size_t)256 * DM * 2};
            EpiNull E{(float*)(F.ws + WS_Y)};
            pg8::gemm_phase(F.lds, g, S, E, fresh_tid(F.wave));
        }
#endif
        SEAM(pb + 1);
        if (PM(3) && IN(pb + 2)) for (int rep_ = 0; rep_ < NREP(3); ++rep_) { if (rep_) GRID_BAR(); FRESH(); p_mix_a(F, args, OPQ(0), rep_); } SEAM(pb + 2);
        if (PM(4) && IN(pb + 3)) for (int rep_ = 0; rep_ < NREP(4); ++rep_) { if (rep_) GRID_BAR(); FRESH(); p_mix_b(F, args, OPQ(0), rep_); } SEAM(pb + 3);
        if (PM(5) && IN(pb + 4)) for (int rep_ = 0; rep_ < NREP(5); ++rep_) { if (rep_) GRID_BAR(); FRESH(); p_mix_c(F, args, OPQ(0), rep_); } SEAM(pb + 4);
        if (PM(6) && IN(pb + 5)) for (int rep_ = 0; rep_ < NREP(6); ++rep_) { if (rep_) GRID_BAR(); const int Lg = OPQ(0);
            pg8::Gemm g{(const bf16*)(F.ws + WS_ACT5), (const bf16*)(F.ws + WS_WGLU) + (size_t)Lg * 256 * 256, 512, 512, OPQ(256)};
            SgOrder<FillPlain> S; S.init(NT / 256, 1, F.G, F.bid); S.f = FillPlain{(size_t)256 * 256 * 2, 0};
            EpiGlu E{(const bf16*)(F.ws + WS_ACT5), (bf16*)(F.ws + WS_MIX)};
            pg8::gemm_phase(F.lds, g, S, E, fresh_tid(F.wave));
        } SEAM(pb + 5);
        if (PM(7) && IN(pb + 6)) { const int Lg = OPQ(0);
            pg8::Gemm g{(const bf16*)(F.ws + WS_MIX), (const bf16*)(F.ws + WS_WOUT) + (size_t)Lg * DM * MW, MW * 2, MW * 2, OPQ(MW)};
            SgOrder<FillPlain> S; S.init((Lg == DEPTH - 1 ? NLAT : NT) / 256, DM / 256, F.G, F.bid); S.f = FillPlain{(size_t)256 * MW * 2, (size_t)256 * MW * 2};
            EpiOutproj E{args.in[I_X], args.in[I_CTX], (bf16*)(F.ws + WS_XS), (const float*)(F.ws + WS_MOD) + (size_t)Lg * 9 * 6144, Lg == 0 ? 1 : 0};
            pg8::gemm_phase(F.lds, g, S, E, fresh_tid(F.wave));
        } SEAM(pb + 6);
        if (PM(8) && IN(pb + 7)) { FRESH(); p_norm2(F, args, OPQ(0), OPQ(mrows)); }
#ifdef DUP_NORM2
        GRID_BAR(); if (PM(8) && IN(pb + 7)) { FRESH(); p_norm2(F, args, OPQ(0), OPQ(mrows), 6400); }
#endif
 SEAM(pb + 7);
        if (PM(10) && IN(pb + 9)) { const int Lg = OPQ(0); FRESH();
            const int nblk = moe_tables(F, Lg);
            LAS int* lbs = (LAS int*)(F.lds + MOE_LB); LAS int* lcs = (LAS int*)(F.lds + MOE_LC); LAS unsigned* gat = (LAS unsigned*)(F.lds + MOE_GAT);
            SgOrder<FillMoe> S; S.init(nblk, 8, F.G, F.bid); S.f = FillMoe{(const LAS unsigned*)(F.lds + MOE_LBLK), 2048};
            { const int* TM = (const int*)(F.ws + WS_TM); const float* PG = (const float*)(F.ws + WS_PG); int* PS = (int*)(F.ws + WS_PS); float* SG = (float*)(F.ws + WS_SG);
              pg8::Unit u; int cursor = 0;
              for (int ui = 0; ui < MOE_MAXU && S.next(cursor, u); ++ui) {
                  if (F.tid < 256) { const int e = u.grp, rk = u.pm * 256 - lbs[e] + F.tid; const bool ok = rk < lcs[e];
                      const int id = ok ? TM[(size_t)e * NT + rk] : 0;
                      gat[ui * 256 + F.tid] = (unsigned)(id >> 2) * (unsigned)DM;
                      if (ok && u.pn == 0) { const int slot = u.pm * 256 + F.tid; PS[id] = slot; SG[slot] = PG[id]; } } } }
            __syncthreads();
            pg8::Gemm g{F.ws + WS_H8, F.ws + WS_WGU + (size_t)Lg * NEXP * 2048 * DM, DM, DM, OPQ(DM / 2)};
            EpiSwiglu E{(unsigned char*)(F.ws + WS_ACT), args.in[I_BGU] + (size_t)Lg * NEXP * 2048};
            pg8::gemm_phase<EpiSwiglu, SgOrder<FillMoe>, true, F8_ALIGN, F8_SP2, true>(F.lds, g, S, E, fresh_tid(F.wave), gat);
        } SEAM(pb + 9);
        if (PM(11) && IN(pb + 10)) for (int rep_ = 0; rep_ < NREP(11); ++rep_) { if (rep_) GRID_BAR(); const int Lg = OPQ(0); FRESH();
            const int nblk = moe_tables(F, Lg);
            pg8::Gemm g{F.ws + WS_ACT, F.ws + WS_WDN + (size_t)Lg * NEXP * DM * DM, DM, DM, OPQ(DM / 2)};
            SgOrder<FillMoe> S; S.init(nblk, 4, F.G, F.bid); S.f = FillMoe{(const LAS unsigned*)(F.lds + MOE_LBLK), 1024};
            EpiDown E{(unsigned char*)(F.ws + WS_Y), args.in[I_BDN] + (size_t)Lg * NEXP * DM, (const float*)(F.ws + WS_SG)};
            pg8::gemm_phase<EpiDown, SgOrder<FillMoe>, true, F8_ALIGN, F8_SP2>(F.lds, g, S, E, fresh_tid(F.wave));
        } SEAM(pb + 10);
        }
    {
        const int pb = 1 + 1 * NPH;
        const int mrows = (1 == DEPTH - 1) ? NLAT : NT;
        if (PM(1) && IN(pb + 0)) { FRESH(); p_norm1(F, args, OPQ(1)); }
#ifdef DUP_NORM1
        GRID_BAR(); if (PM(1) && IN(pb + 0)) { FRESH(); p_norm1(F, args, OPQ(1), true); }
#endif
 SEAM(pb + 0);
        if (PM(2) && IN(pb + 1)) for (int rep_ = 0; rep_ < NREP(2); ++rep_) { if (rep_) GRID_BAR(); const int Lg = OPQ(1);
#if INPROJ_F8
            pg8::Gemm g{F.ws + WS_H8, F.ws + WS_WIN + (size_t)Lg * PW * DM, DM, DM, OPQ(DM / 2)};
            SgOrder<FillPlain> S; S.init(NT / 256, PW / 256, F.G, F.bid); S.f = FillPlain{(size_t)256 * DM, (size_t)256 * DM};
            EpiInproj E{(bf16*)(F.ws + WS_PBUF), (bf16*)(F.ws + WS_A2)};
            pg8::gemm_phase<EpiInproj, SgOrder<FillPlain>, true, F8_ALIGN, F8_SP2>(F.lds, g, S, E, fresh_tid(F.wave));
#else
            pg8::Gemm g{(const bf16*)(F.ws + WS_H), (const bf16*)(F.ws + WS_WIN) + (size_t)Lg * PW * DM, DM * 2, DM * 2, OPQ(DM)};
            SgOrder<FillPlain> S; S.init(NT / 256, PW / 256, F.G, F.bid); S.f = FillPlain{(size_t)256 * DM * 2, (size_t)256 * DM * 2};
            EpiInproj E{(bf16*)(F.ws + WS_PBUF), (bf16*)(F.ws + WS_A2)};
            pg8::gemm_phase(F.lds, g, S, E, fresh_tid(F.wave));
#endif
        }
#if defined(SHADOW_IN)
        if (PM(2) && IN(pb + 1)) { GRID_BAR(); const int Lg = OPQ(1);
            pg8::Gemm g{(const bf16*)(F.ws + WS_H), (const bf16*)(F.ws + WS_WIN) + (size_t)Lg * PW * DM, DM * 2, DM * 2, OPQ(DM)};
            SgOrder<FillPlain> S; S.init(NT / 256, PW / 256, F.G, F.bid); S.f = FillPlain{(size_t)256 * DM * 2, (size_t)256 * DM * 2};
            EpiNull E{(float*)(F.ws + WS_Y)};
            pg8::gemm_phase(F.lds, g, S, E, fresh_tid(F.wave));
        }
#endif
        SEAM(pb + 1);
        if (PM(3) && IN(pb + 2)) for (int rep_ = 0; rep_ < NREP(3); ++rep_) { if (rep_) GRID_BAR(); FRESH(); p_mix_a(F, args, OPQ(1), rep_); } SEAM(pb + 2);
        if (PM(4) && IN(pb + 3)) for (int rep_ = 0; rep_ < NREP(4); ++rep_) { if (rep_) GRID_BAR(); FRESH(); p_mix_b(F, args, OPQ(1), rep_); } SEAM(pb + 3);
        if (PM(5) && IN(pb + 4)) for (int rep_ = 0; rep_ < NREP(5); ++rep_) { if (rep_) GRID_BAR(); FRESH(); p_mix_c(F, args, OPQ(1), rep_); } SEAM(pb + 4);
        if (PM(6) && IN(pb + 5)) for (int rep_ = 0; rep_ < NREP(6); ++rep_) { if (rep_) GRID_BAR(); const int Lg = OPQ(1);
            pg8::Gemm g{(const bf16*)(F.ws + WS_ACT5), (const bf16*)(F.ws + WS_WGLU) + (size_t)Lg * 256 * 256, 512, 512, OPQ(256)};
            SgOrder<FillPlain> S; S.init(NT / 256, 1, F.G, F.bid); S.f = FillPlain{(size_t)256 * 256 * 2, 0};
            EpiGlu E{(const bf16*)(F.ws + WS_ACT5), (bf16*)(F.ws + WS_MIX)};
            pg8::gemm_phase(F.lds, g, S, E, fresh_tid(F.wave));
        } SEAM(pb + 5);
        if (PM(7) && IN(pb + 6)) { const int Lg = OPQ(1);
            pg8::Gemm g{(const bf16*)(F.ws + WS_MIX), (const bf16*)(F.ws + WS_WOUT) + (size_t)Lg * DM * MW, MW * 2, MW * 2, OPQ(MW)};
            SgOrder<FillPlain> S; S.init((Lg == DEPTH - 1 ? NLAT : NT) / 256, DM / 256, F.G, F.bid); S.f = FillPlain{(size_t)256 * MW * 2, (size_t)256 * MW * 2};
            EpiOutproj E{args.in[I_X], args.in[I_CTX], (bf16*)(F.ws + WS_XS), (const float*)(F.ws + WS_MOD) + (size_t)Lg * 9 * 6144, Lg == 0 ? 1 : 0};
            pg8::gemm_phase(F.lds, g, S, E, fresh_tid(F.wave));
        } SEAM(pb + 6);
        if (PM(8) && IN(pb + 7)) { FRESH(); p_norm2(F, args, OPQ(1), OPQ(mrows)); }
#ifdef DUP_NORM2
        GRID_BAR(); if (PM(8) && IN(pb + 7)) { FRESH(); p_norm2(F, args, OPQ(1), OPQ(mrows), 6400); }
#endif
 SEAM(pb + 7);
        if (PM(10) && IN(pb + 9)) { const int Lg = OPQ(1); FRESH();
            const int nblk = moe_tables(F, Lg);
            LAS int* lbs = (LAS int*)(F.lds + MOE_LB); LAS int* lcs = (LAS int*)(F.lds + MOE_LC); LAS unsigned* gat = (LAS unsigned*)(F.lds + MOE_GAT);
            SgOrder<FillMoe> S; S.init(nblk, 8, F.G, F.bid); S.f = FillMoe{(const LAS unsigned*)(F.lds + MOE_LBLK), 2048};
            { const int* TM = (const int*)(F.ws + WS_TM); const float* PG = (const float*)(F.ws + WS_PG); int* PS = (int*)(F.ws + WS_PS); float* SG = (float*)(F.ws + WS_SG);
              pg8::Unit u; int cursor = 0;
              for (int ui = 0; ui < MOE_MAXU && S.next(cursor, u); ++ui) {
                  if (F.tid < 256) { const int e = u.grp, rk = u.pm * 256 - lbs[e] + F.tid; const bool ok = rk < lcs[e];
                      const int id = ok ? TM[(size_t)e * NT + rk] : 0;
                      gat[ui * 256 + F.tid] = (unsigned)(id >> 2) * (unsigned)DM;
                      if (ok && u.pn == 0) { const int slot = u.pm * 256 + F.tid; PS[id] = slot; SG[slot] = PG[id]; } } } }
            __syncthreads();
            pg8::Gemm g{F.ws + WS_H8, F.ws + WS_WGU + (size_t)Lg * NEXP * 2048 * DM, DM, DM, OPQ(DM / 2)};
            EpiSwiglu E{(unsigned char*)(F.ws + WS_ACT), args.in[I_BGU] + (size_t)Lg * NEXP * 2048};
            pg8::gemm_phase<EpiSwiglu, SgOrder<FillMoe>, true, F8_ALIGN, F8_SP2, true>(F.lds, g, S, E, fresh_tid(F.wave), gat);
        } SEAM(pb + 9);
        if (PM(11) && IN(pb + 10)) for (int rep_ = 0; rep_ < NREP(11); ++rep_) { if (rep_) GRID_BAR(); const int Lg = OPQ(1); FRESH();
            const int nblk = moe_tables(F, Lg);
            pg8::Gemm g{F.ws + WS_ACT, F.ws + WS_WDN + (size_t)Lg * NEXP * DM * DM, DM, DM, OPQ(DM / 2)};
            SgOrder<FillMoe> S; S.init(nblk, 4, F.G, F.bid); S.f = FillMoe{(const LAS unsigned*)(F.lds + MOE_LBLK), 1024};
            EpiDown E{(unsigned char*)(F.ws + WS_Y), args.in[I_BDN] + (size_t)Lg * NEXP * DM, (const float*)(F.ws + WS_SG)};
            pg8::gemm_phase<EpiDown, SgOrder<FillMoe>, true, F8_ALIGN, F8_SP2>(F.lds, g, S, E, fresh_tid(F.wave));
        } SEAM(pb + 10);
        }
    {
        const int pb = 1 + 2 * NPH;
        const int mrows = (2 == DEPTH - 1) ? NLAT : NT;
        if (PM(1) && IN(pb + 0)) { FRESH(); p_norm1(F, args, OPQ(2)); }
#ifdef DUP_NORM1
        GRID_BAR(); if (PM(1) && IN(pb + 0)) { FRESH(); p_norm1(F, args, OPQ(2), true); }
#endif
 SEAM(pb + 0);
        if (PM(2) && IN(pb + 1)) for (int rep_ = 0; rep_ < NREP(2); ++rep_) { if (rep_) GRID_BAR(); const int Lg = OPQ(2);
#if INPROJ_F8
            pg8::Gemm g{F.ws + WS_H8, F.ws + WS_WIN + (size_t)Lg * PW * DM, DM, DM, OPQ(DM / 2)};
            SgOrder<FillPlain> S; S.init(NT / 256, PW / 256, F.G, F.bid); S.f = FillPlain{(size_t)256 * DM, (size_t)256 * DM};
            EpiInproj E{(bf16*)(F.ws + WS_PBUF), (bf16*)(F.ws + WS_A2)};
            pg8::gemm_phase<EpiInproj, SgOrder<FillPlain>, true, F8_ALIGN, F8_SP2>(F.lds, g, S, E, fresh_tid(F.wave));
#else
            pg8::Gemm g{(const bf16*)(F.ws + WS_H), (const bf16*)(F.ws + WS_WIN) + (size_t)Lg * PW * DM, DM * 2, DM * 2, OPQ(DM)};
            SgOrder<FillPlain> S; S.init(NT / 256, PW / 256, F.G, F.bid); S.f = FillPlain{(size_t)256 * DM * 2, (size_t)256 * DM * 2};
            EpiInproj E{(bf16*)(F.ws + WS_PBUF), (bf16*)(F.ws + WS_A2)};
            pg8::gemm_phase(F.lds, g, S, E, fresh_tid(F.wave));
#endif
        }
#if defined(SHADOW_IN)
        if (PM(2) && IN(pb + 1)) { GRID_BAR(); const int Lg = OPQ(2);
            pg8::Gemm g{(const bf16*)(F.ws + WS_H), (const bf16*)(F.ws + WS_WIN) + (size_t)Lg * PW * DM, DM * 2, DM * 2, OPQ(DM)};
            SgOrder<FillPlain> S; S.init(NT / 256, PW / 256, F.G, F.bid); S.f = FillPlain{(size_t)256 * DM * 2, (size_t)256 * DM * 2};
            EpiNull E{(float*)(F.ws + WS_Y)};
            pg8::gemm_phase(F.lds, g, S, E, fresh_tid(F.wave));
        }
#endif
        SEAM(pb + 1);
        if (PM(3) && IN(pb + 2)) for (int rep_ = 0; rep_ < NREP(3); ++rep_) { if (rep_) GRID_BAR(); FRESH(); p_mix_a(F, args, OPQ(2), rep_); } SEAM(pb + 2);
        if (PM(4) && IN(pb + 3)) for (int rep_ = 0; rep_ < NREP(4); ++rep_) { if (rep_) GRID_BAR(); FRESH(); p_mix_b(F, args, OPQ(2), rep_); } SEAM(pb + 3);
        if (PM(5) && IN(pb + 4)) for (int rep_ = 0; rep_ < NREP(5); ++rep_) { if (rep_) GRID_BAR(); FRESH(); p_mix_c(F, args, OPQ(2), rep_); } SEAM(pb + 4);
        if (PM(6) && IN(pb + 5)) for (int rep_ = 0; rep_ < NREP(6); ++rep_) { if (rep_) GRID_BAR(); const int Lg = OPQ(2);
            pg8::Gemm g{(const bf16*)(F.ws + WS_ACT5), (const bf16*)(F.ws + WS_WGLU) + (size_t)Lg * 256 * 256, 512, 512, OPQ(256)};
            SgOrder<FillPlain> S; S.init(NT / 256, 1, F.G, F.bid); S.f = FillPlain{(size_t)256 * 256 * 2, 0};
            EpiGlu E{(const bf16*)(F.ws + WS_ACT5), (bf16*)(F.ws + WS_MIX)};
            pg8::gemm_phase(F.lds, g, S, E, fresh_tid(F.wave));
        } SEAM(pb + 5);
        if (PM(7) && IN(pb + 6)) { const int Lg = OPQ(2);
            pg8::Gemm g{(const bf16*)(F.ws + WS_MIX), (const bf16*)(F.ws + WS_WOUT) + (size_t)Lg * DM * MW, MW * 2, MW * 2, OPQ(MW)};
            SgOrder<FillPlain> S; S.init((Lg == DEPTH - 1 ? NLAT : NT) / 256, DM / 256, F.G, F.bid); S.f = FillPlain{(size_t)256 * MW * 2, (size_t)256 * MW * 2};
            EpiOutproj E{args.in[I_X], args.in[I_CTX], (bf16*)(F.ws + WS_XS), (const float*)(F.ws + WS_MOD) + (size_t)Lg * 9 * 6144, Lg == 0 ? 1 : 0};
            pg8::gemm_phase(F.lds, g, S, E, fresh_tid(F.wave));
        } SEAM(pb + 6);
        if (PM(8) && IN(pb + 7)) { FRESH(); p_norm2(F, args, OPQ(2), OPQ(mrows)); }
#ifdef DUP_NORM2
        GRID_BAR(); if (PM(8) && IN(pb + 7)) { FRESH(); p_norm2(F, args, OPQ(2), OPQ(mrows), 6400); }
#endif
 SEAM(pb + 7);
        if (PM(10) && IN(pb + 9)) { const int Lg = OPQ(2); FRESH();
            const int nblk = moe_tables(F, Lg);
            LAS int* lbs = (LAS int*)(F.lds + MOE_LB); LAS int* lcs = (LAS int*)(F.lds + MOE_LC); LAS unsigned* gat = (LAS unsigned*)(F.lds + MOE_GAT);
            SgOrder<FillMoe> S; S.init(nblk, 8, F.G, F.bid); S.f = FillMoe{(const LAS unsigned*)(F.lds + MOE_LBLK), 2048};
            { const int* TM = (const int*)(F.ws + WS_TM); const float* PG = (const float*)(F.ws + WS_PG); int* PS = (int*)(F.ws + WS_PS); float* SG = (float*)(F.ws + WS_SG);
              pg8::Unit u; int cursor = 0;
              for (int ui = 0; ui < MOE_MAXU && S.next(cursor, u); ++ui) {
                  if (F.tid < 256) { const int e = u.grp, rk = u.pm * 256 - lbs[e] + F.tid; const bool ok = rk < lcs[e];
                      const int id = ok ? TM[(size_t)e * NT + rk] : 0;
                      gat[ui * 256 + F.tid] = (unsigned)(id >> 2) * (unsigned)DM;
                      if (ok && u.pn == 0) { const int slot = u.pm * 256 + F.tid; PS[id] = slot; SG[slot] = PG[id]; } } } }
            __syncthreads();
            pg8::Gemm g{F.ws + WS_H8, F.ws + WS_WGU + (size_t)Lg * NEXP * 2048 * DM, DM, DM, OPQ(DM / 2)};
            EpiSwiglu E{(unsigned char*)(F.ws + WS_ACT), args.in[I_BGU] + (size_t)Lg * NEXP * 2048};
            pg8::gemm_phase<EpiSwiglu, SgOrder<FillMoe>, true, F8_ALIGN, F8_SP2, true>(F.lds, g, S, E, fresh_tid(F.wave), gat);
        } SEAM(pb + 9);
        if (PM(11) && IN(pb + 10)) for (int rep_ = 0; rep_ < NREP(11); ++rep_) { if (rep_) GRID_BAR(); const int Lg = OPQ(2); FRESH();
            const int nblk = moe_tables(F, Lg);
            pg8::Gemm g{F.ws + WS_ACT, F.ws + WS_WDN + (size_t)Lg * NEXP * DM * DM, DM, DM, OPQ(DM / 2)};
            SgOrder<FillMoe> S; S.init(nblk, 4, F.G, F.bid); S.f = FillMoe{(const LAS unsigned*)(F.lds + MOE_LBLK), 1024};
            EpiDown E{(unsigned char*)(F.ws + WS_Y), args.in[I_BDN] + (size_t)Lg * NEXP * DM, (const float*)(F.ws + WS_SG)};
            pg8::gemm_phase<EpiDown, SgOrder<FillMoe>, true, F8_ALIGN, F8_SP2>(F.lds, g, S, E, fresh_tid(F.wave));
        } SEAM(pb + 10);
        }
    {
        const int pb = 1 + 3 * NPH;
        const int mrows = (3 == DEPTH - 1) ? NLAT : NT;
        if (PM(1) && IN(pb + 0)) { FRESH(); p_norm1(F, args, OPQ(3)); }
#ifdef DUP_NORM1
        GRID_BAR(); if (PM(1) && IN(pb + 0)) { FRESH(); p_norm1(F, args, OPQ(3), true); }
#endif
 SEAM(pb + 0);
        if (PM(2) && IN(pb + 1)) for (int rep_ = 0; rep_ < NREP(2); ++rep_) { if (rep_) GRID_BAR(); const int Lg = OPQ(3);
#if INPROJ_F8
            pg8::Gemm g{F.ws + WS_H8, F.ws + WS_WIN + (size_t)Lg * PW * DM, DM, DM, OPQ(DM / 2)};
            SgOrder<FillPlain> S; S.init(NT / 256, PW / 256, F.G, F.bid); S.f = FillPlain{(size_t)256 * DM, (size_t)256 * DM};
            EpiInproj E{(bf16*)(F.ws + WS_PBUF), (bf16*)(F.ws + WS_A2)};
            pg8::gemm_phase<EpiInproj, SgOrder<FillPlain>, true, F8_ALIGN, F8_SP2>(F.lds, g, S, E, fresh_tid(F.wave));
#else
            pg8::Gemm g{(const bf16*)(F.ws + WS_H), (const bf16*)(F.ws + WS_WIN) + (size_t)Lg * PW * DM, DM * 2, DM * 2, OPQ(DM)};
            SgOrder<FillPlain> S; S.init(NT / 256, PW / 256, F.G, F.bid); S.f = FillPlain{(size_t)256 * DM * 2, (size_t)256 * DM * 2};
            EpiInproj E{(bf16*)(F.ws + WS_PBUF), (bf16*)(F.ws + WS_A2)};
            pg8::gemm_phase(F.lds, g, S, E, fresh_tid(F.wave));
#endif
        }
#if defined(SHADOW_IN)
        if (PM(2) && IN(pb + 1)) { GRID_BAR(); const int Lg = OPQ(3);
            pg8::Gemm g{(const bf16*)(F.ws + WS_H), (const bf16*)(F.ws + WS_WIN) + (size_t)Lg * PW * DM, DM * 2, DM * 2, OPQ(DM)};
            SgOrder<FillPlain> S; S.init(NT / 256, PW / 256, F.G, F.bid); S.f = FillPlain{(size_t)256 * DM * 2, (size_t)256 * DM * 2};
            EpiNull E{(float*)(F.ws + WS_Y)};
            pg8::gemm_phase(F.lds, g, S, E, fresh_tid(F.wave));
        }
#endif
        SEAM(pb + 1);
        if (PM(3) && IN(pb + 2)) for (int rep_ = 0; rep_ < NREP(3); ++rep_) { if (rep_) GRID_BAR(); FRESH(); p_mix_a(F, args, OPQ(3), rep_); } SEAM(pb + 2);
        if (PM(4) && IN(pb + 3)) for (int rep_ = 0; rep_ < NREP(4); ++rep_) { if (rep_) GRID_BAR(); FRESH(); p_mix_b(F, args, OPQ(3), rep_); } SEAM(pb + 3);
        if (PM(5) && IN(pb + 4)) for (int rep_ = 0; rep_ < NREP(5); ++rep_) { if (rep_) GRID_BAR(); FRESH(); p_mix_c(F, args, OPQ(3), rep_); } SEAM(pb + 4);
        if (PM(6) && IN(pb + 5)) for (int rep_ = 0; rep_ < NREP(6); ++rep_) { if (rep_) GRID_BAR(); const int Lg = OPQ(3);
            pg8::Gemm g{(const bf16*)(F.ws + WS_ACT5), (const bf16*)(F.ws + WS_WGLU) + (size_t)Lg * 256 * 256, 512, 512, OPQ(256)};
            SgOrder<FillPlain> S; S.init(NT / 256, 1, F.G, F.bid); S.f = FillPlain{(size_t)256 * 256 * 2, 0};
            EpiGlu E{(const bf16*)(F.ws + WS_ACT5), (bf16*)(F.ws + WS_MIX)};
            pg8::gemm_phase(F.lds, g, S, E, fresh_tid(F.wave));
        } SEAM(pb + 5);
        if (PM(7) && IN(pb + 6)) { const int Lg = OPQ(3);
            pg8::Gemm g{(const bf16*)(F.ws + WS_MIX), (const bf16*)(F.ws + WS_WOUT) + (size_t)Lg * DM * MW, MW * 2, MW * 2, OPQ(MW)};
            SgOrder<FillPlain> S; S.init((Lg == DEPTH - 1 ? NLAT : NT) / 256, DM / 256, F.G, F.bid); S.f = FillPlain{(size_t)256 * MW * 2, (size_t)256 * MW * 2};
            EpiOutproj E{args.in[I_X], args.in[I_CTX], (bf16*)(F.ws + WS_XS), (const float*)(F.ws + WS_MOD) + (size_t)Lg * 9 * 6144, Lg == 0 ? 1 : 0};
            pg8::gemm_phase(F.lds, g, S, E, fresh_tid(F.wave));
        } SEAM(pb + 6);
        if (PM(8) && IN(pb + 7)) { FRESH(); p_norm2(F, args, OPQ(3), OPQ(mrows)); }
#ifdef DUP_NORM2
        GRID_BAR(); if (PM(8) && IN(pb + 7)) { FRESH(); p_norm2(F, args, OPQ(3), OPQ(mrows), 6400); }
#endif
 SEAM(pb + 7);
        if (PM(10) && IN(pb + 9)) { const int Lg = OPQ(3); FRESH();
            const int nblk = moe_tables(F, Lg);
            LAS int* lbs = (LAS int*)(F.lds + MOE_LB); LAS int* lcs = (LAS int*)(F.lds + MOE_LC); LAS unsigned* gat = (LAS unsigned*)(F.lds + MOE_GAT);
            SgOrder<FillMoe> S; S.init(nblk, 8, F.G, F.bid); S.f = FillMoe{(const LAS unsigned*)(F.lds + MOE_LBLK), 2048};
            { const int* TM = (const int*)(F.ws + WS_TM); const float* PG = (const float*)(F.ws + WS_PG); int* PS = (int*)(F.ws + WS_PS); float* SG = (float*)(F.ws + WS_SG);
              pg8::Unit u; int cursor = 0;
              for (int ui = 0; ui < MOE_MAXU && S.next(cursor, u); ++ui) {
                  if (F.tid < 256) { const int e = u.grp, rk = u.pm * 256 - lbs[e] + F.tid; const bool ok = rk < lcs[e];
                      const int id = ok ? TM[(size_t)e * NT + rk] : 0;
                      gat[ui * 256 + F.tid] = (unsigned)(id >> 2) * (unsigned)DM;
                      if (ok && u.pn == 0) { const int slot = u.pm * 256 + F.tid; PS[id] = slot; SG[slot] = PG[id]; } } } }
            __syncthreads();
            pg8::Gemm g{F.ws + WS_H8, F.ws + WS_WGU + (size_t)Lg * NEXP * 2048 * DM, DM, DM, OPQ(DM / 2)};
            EpiSwiglu E{(unsigned char*)(F.ws + WS_ACT), args.in[I_BGU] + (size_t)Lg * NEXP * 2048};
            pg8::gemm_phase<EpiSwiglu, SgOrder<FillMoe>, true, F8_ALIGN, F8_SP2, true>(F.lds, g, S, E, fresh_tid(F.wave), gat);
        } SEAM(pb + 9);
        if (PM(11) && IN(pb + 10)) for (int rep_ = 0; rep_ < NREP(11); ++rep_) { if (rep_) GRID_BAR(); const int Lg = OPQ(3); FRESH();
            const int nblk = moe_tables(F, Lg);
            pg8::Gemm g{F.ws + WS_ACT, F.ws + WS_WDN + (size_t)Lg * NEXP * DM * DM, DM, DM, OPQ(DM / 2)};
            SgOrder<FillMoe> S; S.init(nblk, 4, F.G, F.bid); S.f = FillMoe{(const LAS unsigned*)(F.lds + MOE_LBLK), 1024};
            EpiDown E{(unsigned char*)(F.ws + WS_Y), args.in[I_BDN] + (size_t)Lg * NEXP * DM, (const float*)(F.ws + WS_SG)};
            pg8::gemm_phase<EpiDown, SgOrder<FillMoe>, true, F8_ALIGN, F8_SP2>(F.lds, g, S, E, fresh_tid(F.wave));
        } SEAM(pb + 10);
        }
    if (PM(12) && IN(PH_TOTAL - 1)) { FRESH(); p_final(F, args); }
#undef IN
#undef SEAM
#undef args
}

extern "C" void kernel_launch(void* const* d_in, const int* in_sizes, int n_in, void* d_out, int out_size, void* d_ws, size_t ws_size, hipStream_t stream) {
    static int grid = 0;
    if (grid == 0) {
        if (n_in != N_IN || out_size != NLAT * DM || ws_size < WS_END) { fprintf(stderr, "kernel_launch: unexpected shapes (n_in %d, out %d, ws %zu < %zu); nothing launched\n", n_in, out_size, ws_size, (size_t)WS_END); grid = -1; return; }
        int dev = 0, cus = 0, per_cu = 0;
        if (hipGetDevice(&dev) != hipSuccess || hipDeviceGetAttribute(&cus, hipDeviceAttributeMultiprocessorCount, dev) != hipSuccess) { grid = -1; return; }
        if (hipFuncSetAttribute((const void*)mk_fwd, hipFuncAttributeMaxDynamicSharedMemorySize, LDS_BYTES) != hipSuccess) { fprintf(stderr, "kernel_launch: hipFuncSetAttribute failed\n"); grid = -1; return; }
        if (hipOccupancyMaxActiveBlocksPerMultiprocessor(&per_cu, (const void*)mk_fwd, NTHR, LDS_BYTES) != hipSuccess || per_cu < 1) fprintf(stderr, "kernel_launch: occupancy query says %d\n", per_cu);
        (void)hipGetLastError();
        grid = cus;
    }
    if (grid < 0) return;
    (void)hipMemsetAsync((char*)d_ws + WS_CTL, 0, CTL_BYTES, stream);
    Args a{};
    for (int i = 0; i < N_IN; ++i) a.in[i] = (const float*)d_in[i];
    a.out = (float*)d_out; a.ws = (unsigned char*)d_ws;
#if MK_ONE_LAUNCH
    a.ph_lo = 0; a.ph_hi = PH_TOTAL;
    hipLaunchKernelGGL(mk_fwd, dim3(grid), dim3(NTHR), LDS_BYTES, stream, a);
#else
    for (int p = 0; p < PH_TOTAL; ++p) { a.ph_lo = p; a.ph_hi = p + 1; hipLaunchKernelGGL(mk_fwd, dim3(grid), dim3(NTHR), LDS_BYTES, stream, a); }
#endif
}
```

```cpp
#define MK_ONE_LAUNCH 1
#define F8_ALIGN true
#define F8_SP2 true
#include <hip/hip_runtime.h>
#include <cstdio>
#include <cstdint>

#define GAS __attribute__((address_space(1)))
#define LAS __attribute__((address_space(3)))
typedef unsigned short bf16;
typedef short bf16x8 __attribute__((ext_vector_type(8)));
typedef short s16x4 __attribute__((ext_vector_type(4)));
typedef float f32x4 __attribute__((ext_vector_type(4)));
typedef float f32x2 __attribute__((ext_vector_type(2)));
typedef unsigned u32x4 __attribute__((ext_vector_type(4)));
typedef unsigned u32x2 __attribute__((ext_vector_type(2)));

namespace pg8 {
#define PG8_LAS __attribute__((address_space(3)))
typedef unsigned short bf16_t;
constexpr int BM = 256, BK = 64, HALF = 128, HTB = HALF * BK * 2  , STAGE_BYTES = 8 * HTB;

__host__ __device__ __forceinline__ int lds_byte(int r, int c) { const int st = (r >> 4) * 2 + (c >> 5), rr = r & 15, cc = c & 31, ob = rr * 64 + cc * 2; return st * 1024 + (ob ^ (((ob >> 9) & 1) << 5)); }
__host__ __device__ __forceinline__ void stage_rc(int b, int& R, int& C) { const int st = b / 1024, sb = b % 1024, swz = sb ^ (((sb >> 9) & 1) << 5); R = (st >> 1) * 16 + swz / 64; C = (st & 1) * 32 + (swz % 64) / 2; }
__host__ __device__ __forceinline__ int lds_byte_f8(int r, int c) { const int st = (r >> 4) * 2 + (c >> 5), rr = r & 15, cc = c & 31, ob = rr * 64 + cc * 2; return st * 1024 + (ob ^ (((ob >> 9) & 1) << 4)); }
__host__ __device__ __forceinline__ void stage_rc_f8(int b, int& R, int& C) { const int st = b / 1024, sb = b % 1024, swz = sb ^ (((sb >> 9) & 1) << 4); R = (st >> 1) * 16 + swz / 64; C = (st & 1) * 32 + (swz % 64) / 2; }
__host__ __device__ __forceinline__ int perm32(int rho) { const int n = rho >> 4, i = rho & 15; return 8 * (i >> 2) + 4 * n + (i & 3); }

struct Unit { int pm, pn, grp; size_t aoff, boff; };
struct Gemm { const void* A; const void* Bt; int lda, ldb, K; };

__device__ __forceinline__ unsigned cvt_pk_bf16(float lo, float hi) { unsigned r; asm volatile("v_cvt_pk_bf16_f32 %0, %1, %2" : "=v"(r) : "v"(lo), "v"(hi)); return r; }

typedef int v8i_t __attribute__((ext_vector_type(8)));
typedef int v4i_t __attribute__((ext_vector_type(4)));
template <class Epi, class Sched, bool F8 = false, bool ALIGN_EPI = true, bool SP2 = true, bool GATHER = false>
__device__ __forceinline__ void gemm_phase(PG8_LAS unsigned char* lds, const Gemm g, const Sched& S, const Epi& E, int tid_in, const PG8_LAS unsigned* gat = nullptr) {
    static_assert(!GATHER || SP2, "gather is written for the SP2 loop");
    int tid = tid_in; asm volatile("" : "+v"(tid));
    const int wid = __builtin_amdgcn_readfirstlane(tid >> 6), lane = tid & 63, wr = wid >> 2, wc = wid & 3, fr = lane & 15, fq = lane >> 4;
    const int K = g.K, nt = K / BK;
    unsigned voffA[2], voffB[2];
#pragma unroll
    for (int i = 0; i < 2; ++i) { int R, C; if constexpr (F8) stage_rc_f8(tid * 16 + i * 8192, R, C); else stage_rc(tid * 16 + i * 8192, R, C); const int Rb = (int)Epi::PERM == 2 ? (64 * (R >> 5) + 16 * ((R >> 2) & 3) + 4 * ((R >> 4) & 1) + (R & 3)) : ((int)Epi::PERM == 1 ? ((R & ~31) + perm32(R & 31)) : R);
        voffA[i] = GATHER ? (unsigned)(R * 65536 + C * 2) : (unsigned)(R * g.lda + C * 2); voffB[i] = (unsigned)(Rb * g.ldb + C * 2); }
    unsigned vA0[2], vA1[2];
    const size_t kstep = (size_t)(BK * 2);
    const size_t hstepA = (size_t)HALF * g.lda, hstepB = (size_t)((int)Epi::PERM == 2 ? 8 : HALF) * g.ldb;
#define PG8_GLOAD(ui_) do { _Pragma("unroll") for (int _i = 0; _i < 2; ++_i) { const int r_ = (int)(voffA[_i] >> 16); const unsigned c_ = voffA[_i] & 0xffffu; \
        vA0[_i] = gat[(ui_) * 256 + r_] + c_; vA1[_i] = gat[(ui_) * 256 + 128 + r_] + c_; } } while (0)
    if constexpr (GATHER) PG8_GLOAD(0); else { vA0[0] = voffA[0]; vA0[1] = voffA[1]; vA1[0] = voffA[0] + (unsigned)hstepA; vA1[1] = voffA[1] + (unsigned)hstepA; }
    int ui = 0;
    const unsigned ldsw = (unsigned)wid * 1024u;
    const int aoff = F8 ? lds_byte_f8(wr * 64 + fr, fq * 16) : lds_byte(wr * 64 + fr, fq * 8), boff = F8 ? lds_byte_f8(wc * 32 + fr, fq * 16) : lds_byte(wc * 32 + fr, fq * 8);
    const int aoff1 = lds_byte_f8(wr * 64 + fr, fq * 16 + 8), boff1 = lds_byte_f8(wc * 32 + fr, fq * 16 + 8);
#define PG8_SA(b, h) (((b) * 2 + (h)) * HTB)
#define PG8_SB(b, h) ((4 + (b) * 2 + (h)) * HTB)
#define PG8_STAGE(bufoff, gbase, voff) do { _Pragma("unroll") for (int _i = 0; _i < 2; ++_i) \
        __builtin_amdgcn_global_load_lds((const unsigned*)((const char*)(gbase) + (voff)[_i]), (PG8_LAS unsigned*)(lds + (bufoff) + ldsw + _i * 8192), 16, 0, 0); } while (0)
#define PG8_LD16(off) (*(const PG8_LAS v4i_t*)(lds + (off)))
#define PG8_LDA(dst, b, h) do { if constexpr (F8) { _Pragma("unroll") for (int m = 0; m < 4; ++m) A8[m] = __builtin_shufflevector(PG8_LD16(PG8_SA(b, h) + aoff + m * 2048), PG8_LD16(PG8_SA(b, h) + aoff1 + m * 2048), 0, 1, 2, 3, 4, 5, 6, 7); } \
        else { _Pragma("unroll") for (int m = 0; m < 4; ++m) _Pragma("unroll") for (int k = 0; k < 2; ++k) dst[m][k] = *(const PG8_LAS bf16x8*)(lds + PG8_SA(b, h) + aoff + m * 2048 + k * 1024); } } while (0)
#define PG8_LDB(dst, b, h) do { if constexpr (F8) { _Pragma("unroll") for (int n = 0; n < 2; ++n) dst##8[n] = __builtin_shufflevector(PG8_LD16(PG8_SB(b, h) + boff + n * 2048), PG8_LD16(PG8_SB(b, h) + boff1 + n * 2048), 0, 1, 2, 3, 4, 5, 6, 7); } \
        else { _Pragma("unroll") for (int n = 0; n < 2; ++n) _Pragma("unroll") for (int k = 0; k < 2; ++k) dst[n][k] = *(const PG8_LAS bf16x8*)(lds + PG8_SB(b, h) + boff + n * 2048 + k * 1024); } } while (0)
#define PG8_MMA(ai, bj, At, Bt) do { __builtin_amdgcn_s_setprio(1); \
        if constexpr (F8) { _Pragma("unroll") for (int m = 0; m < 4; ++m) _Pragma("unroll") for (int n = 0; n < 2; ++n) \
            asm volatile("v_mfma_scale_f32_16x16x128_f8f6f4 %0, %1, %2, %0, %3, %3 op_sel_hi:[0,0,0]" : "+v"(acc[ai][bj][m][n]) : "v"(Bt##8[n]), "v"(A8[m]), "v"(one_scale)); } \
        else { _Pragma("unroll") for (int m = 0; m < 4; ++m) _Pragma("unroll") for (int n = 0; n < 2; ++n) _Pragma("unroll") for (int k = 0; k < 2; ++k) \
            acc[ai][bj][m][n] = __builtin_amdgcn_mfma_f32_16x16x32_bf16(Bt[n][k], At[m][k], acc[ai][bj][m][n], 0, 0, 0); } \
        __builtin_amdgcn_s_setprio(0); } while (0)
#define PG8_WAIT_V(n) asm volatile("s_waitcnt vmcnt(" #n ")" ::: "memory")
#define PG8_WAIT_L(n) asm volatile("s_waitcnt lgkmcnt(" #n ")" ::: "memory")
#define PG8_BAR __builtin_amdgcn_s_barrier()
#define PG8_SCHED __builtin_amdgcn_sched_barrier(0)
    Unit cur, nxt; int cursor = 0;
    if (!S.next(cursor, cur)) return;
    f32x4 acc[2][2][4][2];
#pragma unroll
    for (int a = 0; a < 2; ++a)
#pragma unroll
        for (int b = 0; b < 2; ++b)
#pragma unroll
            for (int m = 0; m < 4; ++m)
#pragma unroll
                for (int n = 0; n < 2; ++n) acc[a][b][m][n] = (f32x4){0.f, 0.f, 0.f, 0.f};
    bf16x8 At[4][2], B0[2][2], B1[2][2];
    v8i_t A8[4], B08[2], B18[2];
    int one_scale = 0x7F7F7F7F; asm volatile("" : "+v"(one_scale));
    const char* cA = (const char*)g.A + (GATHER ? (size_t)0 : cur.aoff); const char* cB = (const char*)g.Bt + cur.boff;
    if constexpr (SP2) {
        PG8_STAGE(PG8_SB(0, 0), cB, voffB); PG8_STAGE(PG8_SB(0, 1), cB + hstepB, voffB); PG8_STAGE(PG8_SA(0, 0), cA, vA0); PG8_STAGE(PG8_SA(0, 1), cA, vA1);
        if (wr == 1) PG8_BAR;
        PG8_WAIT_V(2); PG8_BAR;
        PG8_STAGE(PG8_SB(1, 0), cB + kstep, voffB); PG8_STAGE(PG8_SA(1, 0), cA + kstep, vA0); PG8_STAGE(PG8_SB(1, 1), cB + hstepB + kstep, voffB);
        PG8_WAIT_V(6); PG8_BAR;
    } else {
        PG8_STAGE(PG8_SB(0, 0), cB, voffB); PG8_STAGE(PG8_SA(0, 0), cA, voffA); PG8_STAGE(PG8_SB(0, 1), cB + hstepB, voffB); PG8_STAGE(PG8_SA(0, 1), cA + hstepA, voffA);
        if (wr == 1) PG8_BAR;
        PG8_WAIT_V(4); PG8_BAR;
        PG8_STAGE(PG8_SB(1, 0), cB + kstep, voffB); PG8_STAGE(PG8_SA(1, 0), cA + kstep, vA0); PG8_STAGE(PG8_SB(1, 1), cB + hstepB + kstep, voffB);
        PG8_WAIT_V(6); PG8_BAR;
    }
    for (;;) {
        const bool has_next = S.next(cursor, nxt);
        const char* nA = (has_next && !GATHER) ? (const char*)g.A + nxt.aoff : cA; const char* nB = has_next ? (const char*)g.Bt + nxt.boff : cB;
        for (int t = 0; t < nt; t += 2) {
            const bool last = (t == nt - 2);
            const char* a1 = cA + (size_t)(t + 1) * kstep;
            const char* a2 = last ? nA : cA + (size_t)(t + 2) * kstep; const char* b2 = last ? nB : cB + (size_t)(t + 2) * kstep;
            const char* a3 = a2 + kstep; const char* b3 = b2 + kstep;
            if constexpr (SP2) {
            PG8_LDB(B0, 0, 0); PG8_LDB(B1, 0, 1); PG8_SCHED; PG8_LDA(At, 0, 0); PG8_STAGE(PG8_SA(1, 1), a1, vA1);
            if constexpr (GATHER) { if (last && has_next) PG8_GLOAD(ui + 1); }
            PG8_WAIT_V(8); PG8_WAIT_L(0); PG8_BAR; PG8_MMA(0, 0, At, B0); PG8_MMA(0, 1, At, B1); PG8_BAR; PG8_SCHED;
            PG8_LDA(At, 0, 1); PG8_STAGE(PG8_SB(0, 0), b2, voffB); PG8_STAGE(PG8_SB(0, 1), b2 + hstepB, voffB); PG8_STAGE(PG8_SA(0, 0), a2, vA0);
            PG8_WAIT_V(8); PG8_WAIT_L(0); PG8_BAR; PG8_MMA(1, 0, At, B0); PG8_MMA(1, 1, At, B1); PG8_BAR; PG8_SCHED;
            PG8_LDB(B0, 1, 0); PG8_LDB(B1, 1, 1); PG8_SCHED; PG8_LDA(At, 1, 0); PG8_STAGE(PG8_SA(0, 1), a2, vA1);
            PG8_WAIT_V(8); PG8_WAIT_L(0); PG8_BAR; PG8_MMA(0, 0, At, B0); PG8_MMA(0, 1, At, B1); PG8_BAR; PG8_SCHED;
            PG8_LDA(At, 1, 1); PG8_STAGE(PG8_SB(1, 0), b3, voffB); PG8_STAGE(PG8_SB(1, 1), b3 + hstepB, voffB); PG8_STAGE(PG8_SA(1, 0), a3, vA0);
            PG8_WAIT_V(8); PG8_WAIT_L(0); PG8_BAR; PG8_MMA(1, 0, At, B0); PG8_MMA(1, 1, At, B1); PG8_BAR; PG8_SCHED;
            } else {
            PG8_LDB(B0, 0, 0); PG8_SCHED; PG8_LDA(At, 0, 0); PG8_STAGE(PG8_SA(1, 1), a1, vA1);
            PG8_WAIT_L(8); PG8_BAR; PG8_WAIT_L(0); PG8_MMA(0, 0, At, B0); PG8_BAR; PG8_SCHED;
            PG8_LDB(B1, 0, 1); PG8_STAGE(PG8_SB(0, 0), b2, voffB);
            PG8_BAR; PG8_WAIT_L(0); PG8_MMA(0, 1, At, B1); PG8_BAR;
            PG8_LDA(At, 0, 1); PG8_STAGE(PG8_SA(0, 0), a2, vA0);
            PG8_BAR; PG8_WAIT_L(0); PG8_MMA(1, 0, At, B0); PG8_BAR; PG8_SCHED;
            PG8_STAGE(PG8_SB(0, 1), b2 + hstepB, voffB);
            PG8_WAIT_V(6); PG8_BAR; PG8_MMA(1, 1, At, B1); PG8_BAR;
            PG8_LDB(B0, 1, 0); PG8_SCHED; PG8_LDA(At, 1, 0); PG8_STAGE(PG8_SA(0, 1), a2, vA1);
            PG8_WAIT_L(8); PG8_BAR; PG8_WAIT_L(0); PG8_MMA(0, 0, At, B0); PG8_BAR; PG8_SCHED;
            PG8_LDB(B1, 1, 1); PG8_STAGE(PG8_SB(1, 0), b3, voffB);
            PG8_BAR; PG8_WAIT_L(0); PG8_MMA(0, 1, At, B1); PG8_BAR;
            PG8_LDA(At, 1, 1); PG8_STAGE(PG8_SA(1, 0), a3, vA0);
            PG8_BAR; PG8_WAIT_L(0); PG8_MMA(1, 0, At, B0); PG8_BAR; PG8_SCHED;
            PG8_STAGE(PG8_SB(1, 1), b3 + hstepB, voffB);
            PG8_WAIT_V(6); PG8_BAR; PG8_MMA(1, 1, At, B1); PG8_BAR;
            }
        }
        if constexpr (F8) asm volatile("s_nop 15\n\ts_nop 15" ::: "memory");
        if constexpr (ALIGN_EPI) { if (wr == 0) PG8_BAR; }
        E(acc, cur, wr, wc, fr, fq);
        if (!has_next) break;
#pragma unroll
        for (int a = 0; a < 2; ++a)
#pragma unroll
            for (int b = 0; b < 2; ++b)
#pragma unroll
                for (int m = 0; m < 4; ++m)
#pragma unroll
                    for (int n = 0; n < 2; ++n) acc[a][b][m][n] = (f32x4){0.f, 0.f, 0.f, 0.f};
        cur = nxt; cA = nA; cB = nB; ++ui;
        if constexpr (ALIGN_EPI) { if (wr == 1) PG8_BAR; }
    }
    PG8_WAIT_V(0);
    if constexpr (!ALIGN_EPI) { if (wr == 0) PG8_BAR; }
    PG8_BAR;
#undef PG8_GLOAD
#undef PG8_SA
#undef PG8_SB
#undef PG8_STAGE
#undef PG8_LDA
#undef PG8_LDB
#undef PG8_MMA
#undef PG8_LD16
#undef PG8_WAIT_V
#undef PG8_WAIT_L
#undef PG8_BAR
#undef PG8_SCHED
}
}

#define XB_TMO      128
#define XB_XCNT(j)  (256  + 64 * (j))
#define XB_XSUB(j)  (1280 + 64 * (j))
#define XB_XGEN(j)  (2304 + 64 * (j))
#define XB_TOP      3328
#define XB_TOPGEN   3392
#define XCD_BAR_WORDS 3456
#define XB_SPIN_CAP (1u << 18)

__device__ __forceinline__ unsigned xb_ld(unsigned* p)              { return __hip_atomic_load(p, __ATOMIC_RELAXED, __HIP_MEMORY_SCOPE_AGENT); }
__device__ __forceinline__ unsigned xb_add(unsigned* p, unsigned v) { return __hip_atomic_fetch_add(p, v, __ATOMIC_RELAXED, __HIP_MEMORY_SCOPE_AGENT); }
__device__ __forceinline__ unsigned xb_xcc_id() { return (unsigned)__builtin_amdgcn_s_getreg((3 << 11) | 20) & 0xFu; }
#define XB_SPIN(cond, bar) do { unsigned _sp = 0; while (cond) { __builtin_amdgcn_s_sleep(1); \
    if ((++_sp & 255u) == 0u) { if (xb_ld(&(bar)[XB_TMO])) break; if (_sp > XB_SPIN_CAP) { atomicAdd(&(bar)[XB_TMO], 1u); break; } } } } while (0)

struct XcdBarrier {
    unsigned* bar; unsigned x;
    volatile LAS unsigned* st;
};

__device__ __forceinline__ XcdBarrier xcd_barrier_post(unsigned* bar, volatile LAS unsigned* st) {
    XcdBarrier b; b.bar = bar; b.x = xb_xcc_id(); b.st = st;
    if (threadIdx.x == 0) (void)xb_add(&bar[XB_XCNT(b.x)], 1u);
    return b;
}
__device__ __forceinline__ void xcd_barrier_complete(unsigned* bar, unsigned x, unsigned& nloc, unsigned& nx) {
    const unsigned G = gridDim.x * gridDim.y * gridDim.z;
    unsigned sum, cnt, mine, sp = 0u;
    for (;;) {
        sum = 0u; cnt = 0u; mine = 0u;
#pragma unroll
        for (unsigned j = 0; j < 16; ++j) { const unsigned c = xb_ld(&bar[XB_XCNT(j)]); sum += c; cnt += (c > 0u) ? 1u : 0u; mine = (j == x) ? c : mine; }
        if (sum == G) break;
        __builtin_amdgcn_s_sleep(1);
        if ((++sp & 255u) == 0u) { if (xb_ld(&bar[XB_TMO])) break; if (sp > XB_SPIN_CAP) { atomicAdd(&bar[XB_TMO], 1u); break; } }
    }
    nloc = mine > 0u ? mine : 1u; nx = cnt > 0u ? cnt : 1u;
}

__device__ __forceinline__ void xcd_barrier(const XcdBarrier& b) {
    asm volatile("s_waitcnt vmcnt(0)" ::: "memory");
    __syncthreads();
    if (threadIdx.x == 0) {
        unsigned* bar = b.bar;
        __builtin_amdgcn_s_waitcnt(0);
        unsigned nloc = b.st[0], nx = b.st[1];
        if (nloc == 0u) { xcd_barrier_complete(bar, b.x, nloc, nx); b.st[0] = nloc; b.st[1] = nx; }
        const unsigned old = xb_add(&bar[XB_XSUB(b.x)], 1u);
        const unsigned gen = old / nloc;
        if (old + 1u == (gen + 1u) * nloc) {
            __builtin_amdgcn_fence(__ATOMIC_RELEASE, "agent");
            asm volatile("s_waitcnt vmcnt(0)" ::: "memory");
            const unsigned og = xb_add(&bar[XB_TOP], 1u);
            const unsigned tg = og / nx;
            if (og + 1u == (tg + 1u) * nx) xb_add(&bar[XB_TOPGEN], 1u);
            else XB_SPIN(xb_ld(&bar[XB_TOPGEN]) == tg, bar);
            __builtin_amdgcn_fence(__ATOMIC_ACQUIRE, "agent");
            xb_add(&bar[XB_XGEN(b.x)], 1u);
            asm volatile("s_waitcnt vmcnt(0)" ::: "memory");
        } else {
            XB_SPIN(xb_ld(&bar[XB_XGEN(b.x)]) == gen, bar);
            __builtin_amdgcn_fence(__ATOMIC_ACQUIRE, "agent");
            asm volatile("s_waitcnt vmcnt(0)" ::: "memory");
        }
    }
    __syncthreads();
}

constexpr int NWAVES = 8, NTHR = 512;
constexpr int DM = 1024, NB = 8, SEQ = 4096, CTXL = 256, DEPTH = 4;
constexpr int NLAT = NB * SEQ, NCTX = NB * CTXL, NT = NLAT + NCTX;
constexpr int PW = 2304;
constexpr int MW = 1280;
constexpr int NEXP = 32, MAXBLK = 576;
constexpr int NCHK = 544;
constexpr int S5ROWS = 2304;
constexpr int PC_FU = 0, PC_S5 = 256, PC_Q = 512, PC_K = 640, PC_V = 768, PC_R = 1024, PC_Z = 1280, PC_XBC = 1536, PC_A1 = 2048, PC_DT = 2080;
enum { I_X = 0, I_C, I_CTX, I_CCTX, I_ADAW, I_ADAB, I_NMG, I_NFG, I_WIN, I_WOUT, I_FOURW, I_S5LRE, I_S5LIM, I_S5LDT, I_S5BRE, I_S5BIM, I_S5CRE, I_S5CIM, I_S5D, I_S5GLU,
       I_GLAA2, I_GLAAB, I_GLANG, I_SSDCW, I_SSDCB, I_SSDALOG, I_SSDDTB, I_SSDD, I_SSDNG, I_RW, I_RB, I_WGU, I_BGU, I_WDN, I_BDN, I_FING, N_IN };

constexpr size_t al256(size_t x) { return (x + 255) & ~(size_t)255; }
constexpr size_t WS_CTL = 0, CTL_BYTES = 1u << 20;
constexpr size_t WS_MOD = WS_CTL + CTL_BYTES;
constexpr size_t WS_TAB = WS_MOD + al256((size_t)DEPTH * 9 * 6144 * 4);
constexpr size_t TAB_F64 = 0, TAB_TW = 16384, TAB_D256 = 16384 + 32768, TAB_BYTES = 65536;
constexpr size_t WS_A16 = WS_TAB + TAB_BYTES;
constexpr size_t WS_WIN = WS_A16 + al256((size_t)DEPTH * 2 * 16 * 64 * 2 * 4);
constexpr size_t WS_WOUT = WS_WIN + (size_t)DEPTH * PW * DM * 2;
constexpr size_t WS_WGLU = WS_WOUT + (size_t)DEPTH * DM * MW * 2;
constexpr size_t WS_S5P = WS_WGLU + (size_t)DEPTH * 256 * 256 * 2;
constexpr size_t WS_S5B2 = WS_S5P + (size_t)DEPTH * 16 * 256 * 256 * 2;
constexpr size_t WS_WGU = WS_S5B2 + (size_t)DEPTH * 16 * 256 * 512 * 2;
constexpr size_t WS_WDN = WS_WGU + (size_t)DEPTH * NEXP * 2048 * DM;
constexpr size_t WS_XS = WS_WDN + (size_t)DEPTH * NEXP * DM * DM;
constexpr size_t WS_H = WS_XS + (size_t)NT * DM * 2;
constexpr size_t WS_PBUF = WS_H + (size_t)NT * DM * 2;
constexpr size_t WS_A2 = WS_PBUF + (size_t)NT * PW * 2;
constexpr size_t WS_S5S = WS_A2 + (size_t)16 * S5ROWS * 512 * 2;
constexpr size_t WS_ACT5 = WS_S5S + (size_t)16 * S5ROWS * 256 * 4;
constexpr size_t WS_MIX = WS_ACT5 + (size_t)NT * 256 * 2;
constexpr size_t WS_GDS = WS_MIX + (size_t)NT * MW * 2;
constexpr size_t WS_GDEC = WS_GDS + (size_t)NCHK * 8 * 2048 * 4;
constexpr size_t WS_GSE = WS_GDEC + al256((size_t)NCHK * 8 * 32 * 4);
constexpr size_t WS_SDS = WS_GSE + (size_t)NCHK * 8 * 2048 * 2;
constexpr size_t WS_SDEC = WS_SDS + (size_t)NCHK * 8 * 4096 * 4;
constexpr size_t WS_SSE = WS_SDEC + al256((size_t)NCHK * 8 * 4);
constexpr size_t WS_PE = WS_SSE + (size_t)NCHK * 8 * 4096 * 2;
constexpr size_t WS_PR = WS_PE + (size_t)NT * 4 * 4;
constexpr size_t WS_PG = WS_PR + (size_t)NT * 4 * 4;
constexpr size_t WS_PS = WS_PG + (size_t)NT * 4 * 4;
constexpr size_t WS_SG = WS_PS + (size_t)NT * 4 * 4;
constexpr size_t WS_H8 = WS_SG + (size_t)MAXBLK * 256 * 4;
constexpr size_t WS_TM = WS_H8 + (size_t)NT * DM;
constexpr size_t WS_ACT = WS_TM + (size_t)NEXP * NT * 4;
constexpr size_t WS_Y = WS_ACT + (size_t)MAXBLK * 256 * DM;
constexpr size_t WS_GQI = WS_Y + (size_t)MAXBLK * 256 * DM;
constexpr size_t WS_GOI = WS_GQI + (size_t)NT * 256 * 2;
constexpr size_t WS_SCB = WS_GOI + (size_t)NT * 256 * 2;
constexpr size_t WS_SCUM = WS_SCB + (size_t)NT * 128 * 2;
constexpr size_t WS_SYI = WS_SCUM + (size_t)NT * 8 * 4;
constexpr size_t WS_DFTC = WS_SYI + (size_t)NT * 256 * 2;
constexpr size_t WS_GA2T = WS_DFTC + 512 * 256 * 2;
constexpr size_t WS_RWT = WS_GA2T + (size_t)DEPTH * 256 * 32 * 2;
constexpr size_t WS_END = WS_RWT + (size_t)DEPTH * 2 * 32 * 1024 * 2;
constexpr int CW_QUEUE = 64;
constexpr int CW_CNT = 1024;
constexpr int CW_BLKE = 2048;
constexpr int CW_BAR = 8192;

constexpr int LDS_BYTES = 163840, MISC_OFF = LDS_BYTES - 256;

#ifndef INPROJ_F8
#define INPROJ_F8 1
#endif
constexpr float W8_SCALE = 32.f, H8_SCALE = 8.f, A8_SCALE = 4.f, Y8_SCALE = 16.f;
__device__ __forceinline__ unsigned pk4f8(float a, float b, float c, float d) { int w = 0; w = __builtin_amdgcn_cvt_pk_fp8_f32(a, b, w, false); w = __builtin_amdgcn_cvt_pk_fp8_f32(c, d, w, true); return (unsigned)w; }
#define RLX_AGENT __ATOMIC_RELAXED, __HIP_MEMORY_SCOPE_AGENT
__device__ __forceinline__ int fresh_tid(int wave0) { int l = (int)__builtin_amdgcn_mbcnt_hi(~0u, __builtin_amdgcn_mbcnt_lo(~0u, 0u)); asm volatile("" : "+v"(l)); return wave0 * 64 + l; }
__device__ __forceinline__ unsigned f2bf(float f) { unsigned u = __builtin_bit_cast(unsigned, f); return (u + 0x7fffu + ((u >> 16) & 1u)) >> 16; }
__device__ __forceinline__ unsigned pk2(float lo, float hi) { return f2bf(lo) | (f2bf(hi) << 16); }
__device__ __forceinline__ float bf2f(unsigned short b) { return __builtin_bit_cast(float, (unsigned)b << 16); }
__device__ __forceinline__ f32x4 f8x4(unsigned w) { const f32x2 lo = __builtin_amdgcn_cvt_pk_f32_fp8((int)w, false), hi = __builtin_amdgcn_cvt_pk_f32_fp8((int)w, true); return (f32x4){lo.x, lo.y, hi.x, hi.y}; }
__device__ __forceinline__ f32x4 bf4(u32x2 w) { return (f32x4){__builtin_bit_cast(float, w.x << 16), __builtin_bit_cast(float, w.x & 0xffff0000u), __builtin_bit_cast(float, w.y << 16), __builtin_bit_cast(float, w.y & 0xffff0000u)}; }
__device__ __forceinline__ float bflo(unsigned w) { return __builtin_bit_cast(float, w << 16); }
__device__ __forceinline__ float bfhi(unsigned w) { return __builtin_bit_cast(float, w & 0xffff0000u); }
template <int M> __device__ __forceinline__ float swz_xor(float v) { return __builtin_bit_cast(float, __builtin_amdgcn_ds_swizzle(__builtin_bit_cast(int, v), (M << 10) | 0x1F)); }
__device__ __forceinline__ float xor32f(float v, int lane) { return __builtin_bit_cast(float, __builtin_amdgcn_ds_bpermute((lane ^ 32) << 2, __builtin_bit_cast(int, v))); }
__device__ __forceinline__ float wave_sum(float v, int lane) { v += swz_xor<1>(v); v += swz_xor<2>(v); v += swz_xor<4>(v); v += swz_xor<8>(v); v += swz_xor<16>(v); v += xor32f(v, lane); return v; }
__device__ __forceinline__ float wave_max(float v, int lane) { v = fmaxf(v, swz_xor<1>(v)); v = fmaxf(v, swz_xor<2>(v)); v = fmaxf(v, swz_xor<4>(v)); v = fmaxf(v, swz_xor<8>(v)); v = fmaxf(v, swz_xor<16>(v)); v = fmaxf(v, xor32f(v, lane)); return v; }
__device__ __forceinline__ float fexp_(float x) { return __builtin_amdgcn_exp2f(1.4426950408889634f * x); }
__device__ __forceinline__ float frcp_(float x) { return __builtin_amdgcn_rcpf(x); }
__device__ __forceinline__ float sigmoidf_(float x) { return frcp_(1.f + fexp_(-x)); }
__device__ __forceinline__ float siluf_(float x) { return x * frcp_(1.f + fexp_(-x)); }

struct Frame {
    LAS unsigned char* lds; volatile LAS unsigned* MISC; unsigned* ctl; unsigned char* ws;
    int tid, lane, wave, G, bid;
};


template <class Fill> struct SgOrder {
    int nblk, nN, R, r, lo, hi; Fill f;
    __device__ __forceinline__ void init(int nblk_, int nN_, int G, int c) { nblk = nblk_; nN = nN_; const int U = nblk * nN; int x, nx;
        if ((G & 7) == 0) { R = G >> 3; x = c & 7; r = c >> 3; nx = 8; } else { R = G; x = 0; r = c; nx = 1; }
        lo = (int)(((long)x * U) / nx); hi = (int)(((long)(x + 1) * U) / nx); }
    __device__ __forceinline__ bool next(int& cursor, pg8::Unit& u) const {
        const int q = lo + r + R * cursor; ++cursor;
        if (q >= hi) return false;
        const int ups = 8 * nN, sg = q / ups, ql = q - sg * ups, nb = (nblk - sg * 8) < 8 ? (nblk - sg * 8) : 8;
        u.pm = sg * 8 + ql % nb; u.pn = ql / nb; f(u); return true;
    }
};
struct FillPlain { size_t astep, bstep; __device__ __forceinline__ void operator()(pg8::Unit& u) const { u.grp = 0; u.aoff = (size_t)u.pm * astep; u.boff = (size_t)u.pn * bstep; } };
struct FillS5 { size_t bgrp; __device__ __forceinline__ void operator()(pg8::Unit& u) const { const int g = u.pm / 9, t = u.pm - g * 9; u.grp = g; u.pm = t; u.aoff = ((size_t)g * S5ROWS + (size_t)t * 256) * 512 * 2; u.boff = (size_t)g * bgrp; } };
struct FillMoe { const LAS unsigned* lblk; int erows; __device__ __forceinline__ void operator()(pg8::Unit& u) const { const int e = (int)lblk[u.pm]; u.grp = e; u.aoff = (size_t)u.pm * 256 * DM; u.boff = ((size_t)e * erows + (size_t)u.pn * 256) * DM; } };
constexpr int MOE_LB = 131072, MOE_LC = MOE_LB + 256, MOE_LBLK = MOE_LC + 256, MOE_GAT = MOE_LBLK + 2560, MOE_MAXU = 26;
static_assert(MOE_GAT + MOE_MAXU * 1024 <= MISC_OFF, "MoE LDS tables");
__device__ __forceinline__ int moe_tables(Frame& F, int L) {
    LAS int* lb = (LAS int*)(F.lds + MOE_LB); LAS int* lc = (LAS int*)(F.lds + MOE_LC); LAS unsigned* lblk = (LAS unsigned*)(F.lds + MOE_LBLK);
    const unsigned* cnt = F.ctl + CW_CNT + L * 64;
    __syncthreads();
    if (F.tid < 32) lc[F.tid] = (int)__hip_atomic_load(cnt + F.tid, RLX_AGENT);
    __syncthreads();
    if (F.tid == 0) { int acc = 0; for (int e = 0; e < NEXP; ++e) { lb[e] = acc; acc += (lc[e] + 255) & ~255; } lb[32] = acc; }
    __syncthreads();
    const int nblk = lb[32] >> 8;
    for (int i = F.tid; i < nblk; i += NTHR) { int e = 0; for (int q = 1; q < NEXP; ++q) if (lb[q] <= i * 256) e = q; lblk[i] = (unsigned)e; }
    __syncthreads();
    return nblk;
}
using pg8::cvt_pk_bf16;
struct EpiInproj {
    static constexpr bool PERM = true;
    bf16* P; bf16* A2;
    __device__ __forceinline__ void operator()(const f32x4 (&acc)[2][2][4][2], const pg8::Unit& u, int wr, int wc, int fr, int fq) const {
        const int row0 = u.pm * 256 + wr * 64 + fr, col0 = u.pn * 256 + wc * 32 + 8 * fq;
#pragma unroll
        for (int ai = 0; ai < 2; ++ai)
#pragma unroll
            for (int m = 0; m < 4; ++m) {
                const int row = row0 + ai * 128 + m * 16;
#pragma unroll
                for (int bj = 0; bj < 2; ++bj) {
                    constexpr float SC = INPROJ_F8 ? 1.f / (W8_SCALE * H8_SCALE) : 1.f;
                    const f32x4 v0 = acc[ai][bj][m][0] * SC, v1 = acc[ai][bj][m][1] * SC;
                    u32x4 w; w.x = cvt_pk_bf16(v0[0], v0[1]); w.y = cvt_pk_bf16(v0[2], v0[3]); w.z = cvt_pk_bf16(v1[0], v1[1]); w.w = cvt_pk_bf16(v1[2], v1[3]);
                    const int col = col0 + bj * 128;
                    if (u.pn == 1) {
                        const int cc = col - 256, g = cc >> 4, hp = cc & 15;
                        const int crow = row < NLAT ? (row >> 4) : (2048 + ((row - NLAT) >> 4)), s = row & 15;
                        *(u32x4*)(A2 + ((size_t)g * S5ROWS + crow) * 512 + s * 16 + hp) = w;
                    } else if (col < 2088) *(u32x4*)(P + (size_t)row * PW + col) = w;
                }
            }
    }
};
struct EpiOutproj {
    static constexpr bool PERM = true;
    const float* xin; const float* ctxin; bf16* XS; const float* modL; int first;
    __device__ __forceinline__ void operator()(const f32x4 (&acc)[2][2][4][2], const pg8::Unit& u, int wr, int wc, int fr, int fq) const {
        const int rowt = u.pm * 256, bi = rowt < NLAT ? (rowt >> 12) : 8;
        const int row0 = rowt + wr * 64 + fr, col0 = u.pn * 256 + wc * 32 + 8 * fq;
        const float* gate = modL + (size_t)bi * 6144 + 2 * 1024;
        f32x4 gv[2][2];
#pragma unroll
        for (int bj = 0; bj < 2; ++bj)
#pragma unroll
            for (int n = 0; n < 2; ++n) gv[bj][n] = *(const f32x4*)(gate + col0 + bj * 128 + 4 * n);
#pragma unroll
        for (int ai = 0; ai < 2; ++ai)
#pragma unroll
            for (int m = 0; m < 4; ++m) {
                const int row = row0 + ai * 128 + m * 16;
                bf16* dst = XS + (size_t)row * DM;
#pragma unroll
                for (int bj = 0; bj < 2; ++bj) { const int c = col0 + bj * 128; f32x4 x0, x1;
                    if (first) { const float* src = (row < NLAT ? xin + (size_t)row * DM : ctxin + (size_t)(row - NLAT) * DM) + c; x0 = *(const f32x4*)src; x1 = *(const f32x4*)(src + 4); }
                    else { const u32x4 w = *(const u32x4*)(dst + c); x0 = bf4((u32x2){w.x, w.y}); x1 = bf4((u32x2){w.z, w.w}); }
                    x0 += gv[bj][0] * acc[ai][bj][m][0]; x1 += gv[bj][1] * acc[ai][bj][m][1];
                    u32x4 o; o.x = cvt_pk_bf16(x0[0], x0[1]); o.y = cvt_pk_bf16(x0[2], x0[3]); o.z = cvt_pk_bf16(x1[0], x1[1]); o.w = cvt_pk_bf16(x1[2], x1[3]);
                    *(u32x4*)(dst + c) = o; }
            }
    }
};
struct EpiSwiglu {
    static constexpr bool PERM = true;
    unsigned char* ACT; const float* bgu;
    __device__ __forceinline__ void operator()(const f32x4 (&acc)[2][2][4][2], const pg8::Unit& u, int wr, int wc, int fr, int fq) const {
        const int row0 = u.pm * 256 + wr * 64 + fr, i0 = u.pn * 128 + wc * 32 + 8 * fq;
        const float* bb = bgu + (size_t)u.grp * 2048 + 2 * i0;
        const f32x4 b0 = *(const f32x4*)(bb), b1 = *(const f32x4*)(bb + 4), b2 = *(const f32x4*)(bb + 8), b3 = *(const f32x4*)(bb + 12);
        const float bg[8] = {b0[0], b0[2], b1[0], b1[2], b2[0], b2[2], b3[0], b3[2]}, bu[8] = {b0[1], b0[3], b1[1], b1[3], b2[1], b2[3], b3[1], b3[3]};
        constexpr float inv = 1.f / (H8_SCALE * W8_SCALE);
#pragma unroll
        for (int ai = 0; ai < 2; ++ai)
#pragma unroll
            for (int m = 0; m < 4; ++m) {
                const int row = row0 + ai * 128 + m * 16;
                float o[8];
#pragma unroll
                for (int n = 0; n < 2; ++n)
#pragma unroll
                    for (int jp = 0; jp < 2; ++jp) {
                        const int q = 4 * n + 2 * jp;
                        f32x2 gt = (f32x2){acc[ai][0][m][n][2 * jp], acc[ai][0][m][n][2 * jp + 1]} * inv + (f32x2){bg[q], bg[q + 1]};
                        f32x2 up = (f32x2){acc[ai][1][m][n][2 * jp], acc[ai][1][m][n][2 * jp + 1]} * inv + (f32x2){bu[q], bu[q + 1]};
                        gt.x = fminf(gt.x, 7.0f); gt.y = fminf(gt.y, 7.0f);
                        up.x = __builtin_amdgcn_fmed3f(up.x, -7.0f, 7.0f); up.y = __builtin_amdgcn_fmed3f(up.y, -7.0f, 7.0f);
                        const f32x2 ea = gt * (-1.702f * 1.4426950408889634f);
                        f32x2 den; den.x = __builtin_amdgcn_exp2f(ea.x); den.y = __builtin_amdgcn_exp2f(ea.y); den = den + 1.0f;
                        f32x2 sg; sg.x = __builtin_amdgcn_rcpf(den.x); sg.y = __builtin_amdgcn_rcpf(den.y);
                        const f32x2 r = (up * A8_SCALE + A8_SCALE) * gt * sg;
                        o[q] = r.x; o[q + 1] = r.y;
                    }
                u32x2 w; w.x = pk4f8(o[0], o[1], o[2], o[3]); w.y = pk4f8(o[4], o[5], o[6], o[7]);
                *(u32x2*)(ACT + (size_t)row * DM + i0) = w;
            }
    }
};
struct EpiDown {
    static constexpr int PERM = 2;
    unsigned char* Y; const float* bdn; const float* sg;
    __device__ __forceinline__ void operator()(const f32x4 (&acc)[2][2][4][2], const pg8::Unit& u, int wr, int wc, int fr, int fq) const {
        const int row0 = u.pm * 256 + wr * 64 + fr, col0 = u.pn * 256 + wc * 64 + 16 * fq;
        const float* bb = bdn + (size_t)u.grp * DM + col0;
        constexpr float inv = 1.f / (A8_SCALE * W8_SCALE);
        f32x4 bv[2][2];
#pragma unroll
        for (int bj = 0; bj < 2; ++bj)
#pragma unroll
            for (int n = 0; n < 2; ++n) bv[bj][n] = *(const f32x4*)(bb + 8 * bj + 4 * n);
#pragma unroll
        for (int ai = 0; ai < 2; ++ai)
#pragma unroll
            for (int m = 0; m < 4; ++m) {
                const int row = row0 + ai * 128 + m * 16; const float gt = sg[row] * Y8_SCALE;
                u32x4 w;
                { const f32x4 v0 = (acc[ai][0][m][0] * inv + bv[0][0]) * gt, v1 = (acc[ai][0][m][1] * inv + bv[0][1]) * gt; w.x = pk4f8(v0[0], v0[1], v0[2], v0[3]); w.y = pk4f8(v1[0], v1[1], v1[2], v1[3]); }
                { const f32x4 v0 = (acc[ai][1][m][0] * inv + bv[1][0]) * gt, v1 = (acc[ai][1][m][1] * inv + bv[1][1]) * gt; w.z = pk4f8(v0[0], v0[1], v0[2], v0[3]); w.w = pk4f8(v1[0], v1[1], v1[2], v1[3]); }
                *(u32x4*)(Y + (size_t)row * DM + col0) = w;
            }
    }
};
struct EpiNull { static constexpr bool PERM = true; float* sink;
    __device__ __forceinline__ void operator()(const f32x4 (&acc)[2][2][4][2], const pg8::Unit& u, int wr, int wc, int fr, int fq) const { float s = 0.f;
#pragma unroll
        for (int ai = 0; ai < 2; ++ai)
#pragma unroll
            for (int bj = 0; bj < 2; ++bj)
#pragma unroll
                for (int m = 0; m < 4; ++m)
#pragma unroll
                    for (int n = 0; n < 2; ++n) s += acc[ai][bj][m][n][0];
        if (s == 12345.678f) sink[u.pm] = s; } };
struct EpiS5S {
    static constexpr bool PERM = false;
    float* S;
    __device__ __forceinline__ void operator()(const f32x4 (&acc)[2][2][4][2], const pg8::Unit& u, int wr, int wc, int fr, int fq) const {
        const int row0 = u.pm * 256 + wr * 64 + fr, col0 = wc * 32 + 4 * fq;
        float* base = S + (size_t)u.grp * S5ROWS * 256;
#pragma unroll
        for (int ai = 0; ai < 2; ++ai)
#pragma unroll
            for (int m = 0; m < 4; ++m) { float* rp = base + (size_t)(row0 + ai * 128 + m * 16) * 256 + col0;
#pragma unroll
                for (int bj = 0; bj < 2; ++bj)
#pragma unroll
                    for (int n = 0; n < 2; ++n) *(f32x4*)(rp + bj * 128 + n * 16) = acc[ai][bj][m][n]; }
    }
};
__device__ __forceinline__ float gelu_tanh(float x) { const float t = 0.7978845608f * (x + 0.044715f * x * x * x); return x * frcp_(1.f + fexp_(-2.f * t)); }
struct EpiS5Y {
    static constexpr bool PERM = true;
    bf16* ACT5;
    __device__ __forceinline__ void operator()(const f32x4 (&acc)[2][2][4][2], const pg8::Unit& u, int wr, int wc, int fr, int fq) const {
        const int row0 = u.pm * 256 + wr * 64 + fr, col0 = wc * 32 + 8 * fq;
#pragma unroll
        for (int ai = 0; ai < 2; ++ai)
#pragma unroll
            for (int m = 0; m < 4; ++m) {
                const int crow = row0 + ai * 128 + m * 16;
                if (crow >= 2176) continue;
                const int tok0 = crow < 2048 ? crow * 16 : NLAT + (crow - 2048) * 16;
#pragma unroll
                for (int bj = 0; bj < 2; ++bj) {
                    const int col = col0 + bj * 128, j = col >> 4, h = col & 15;
                    const f32x4 v0 = acc[ai][bj][m][0], v1 = acc[ai][bj][m][1];
                    u32x4 w; w.x = cvt_pk_bf16(gelu_tanh(v0[0]), gelu_tanh(v0[1])); w.y = cvt_pk_bf16(gelu_tanh(v0[2]), gelu_tanh(v0[3]));
                    w.z = cvt_pk_bf16(gelu_tanh(v1[0]), gelu_tanh(v1[1])); w.w = cvt_pk_bf16(gelu_tanh(v1[2]), gelu_tanh(v1[3]));
                    *(u32x4*)(ACT5 + (size_t)(tok0 + j) * 256 + u.grp * 16 + h) = w;
                }
            }
    }
};
struct EpiGlu {
    static constexpr bool PERM = true;
    const bf16* ACT5; bf16* MIX;
    __device__ __forceinline__ void operator()(const f32x4 (&acc)[2][2][4][2], const pg8::Unit& u, int wr, int wc, int fr, int fq) const {
        const int row0 = u.pm * 256 + wr * 64 + fr, col0 = wc * 32 + 8 * fq;
#pragma unroll
        for (int ai = 0; ai < 2; ++ai)
#pragma unroll
            for (int m = 0; m < 4; ++m) {
                const int row = row0 + ai * 128 + m * 16;
#pragma unroll
                for (int bj = 0; bj < 2; ++bj) {
                    const int col = col0 + bj * 128;
                    const u32x4 a = *(const u32x4*)(ACT5 + (size_t)row * 256 + col);
                    const f32x4 v0 = acc[ai][bj][m][0], v1 = acc[ai][bj][m][1];
                    u32x4 w;
                    w.x = cvt_pk_bf16(bflo(a.x) * sigmoidf_(v0[0]), bfhi(a.x) * sigmoidf_(v0[1])); w.y = cvt_pk_bf16(bflo(a.y) * sigmoidf_(v0[2]), bfhi(a.y) * sigmoidf_(v0[3]));
                    w.z = cvt_pk_bf16(bflo(a.z) * sigmoidf_(v1[0]), bfhi(a.z) * sigmoidf_(v1[1])); w.w = cvt_pk_bf16(bflo(a.w) * sigmoidf_(v1[2]), bfhi(a.w) * sigmoidf_(v1[3]));
                    *(u32x4*)(MIX + (size_t)row * MW + 512 + col) = w;
                }
            }
    }
};

struct Args { const float* in[N_IN]; float* out; unsigned char* ws; int ph_lo, ph_hi; };
typedef const __attribute__((address_space(4))) Args CArgs;
__device__ __forceinline__ CArgs* fresh_args() { CArgs* p = (CArgs*)__builtin_amdgcn_kernarg_segment_ptr(); asm volatile("" : "+s"(p)); return p; }

template <class Map> __device__ __forceinline__ void transpose_tile(const float* W, int ldw, int ncols, int k0, int n0, bf16* WT, int ldt, int kd0, const Map& map, LAS float* scr, int lane) {
    { const int c4 = (lane & 15) * 4, r4 = lane >> 4; const bool ok = n0 + c4 < ncols;
#pragma unroll
      for (int q = 0; q < 16; ++q) { const int kk = q * 4 + r4; const f32x4 v = ok ? *(const f32x4*)(W + (size_t)(k0 + kk) * ldw + n0 + c4) : (f32x4){0.f, 0.f, 0.f, 0.f};
          scr[kk * 65 + c4] = v[0]; scr[kk * 65 + c4 + 1] = v[1]; scr[kk * 65 + c4 + 2] = v[2]; scr[kk * 65 + c4 + 3] = v[3]; } }
    asm volatile("s_waitcnt lgkmcnt(0)" ::: "memory");
    const int c = lane & 7;
#pragma unroll
    for (int j = 0; j < 8; ++j) {
        const int n = (lane >> 3) + 8 * j; const LAS float* s = scr + (8 * c) * 65 + n;
        u32x4 o; o.x = pk2(s[0], s[65]); o.y = pk2(s[2 * 65], s[3 * 65]); o.z = pk2(s[4 * 65], s[5 * 65]); o.w = pk2(s[6 * 65], s[7 * 65]);
        const int dr = (n0 + n) < ncols ? map(n0 + n) : -1;
        if (dr >= 0) *(u32x4*)(WT + (size_t)dr * ldt + kd0 + 8 * c) = o;
    }
    asm volatile("s_waitcnt lgkmcnt(0)" ::: "memory");
}
struct MapId { __device__ __forceinline__ int operator()(int n) const { return n; } };
struct MapWin { __device__ __forceinline__ int operator()(int c) const { return c < 1280 ? c : (c < 1312 ? 2048 + (c - 1280) : (c < 2080 ? c - 32 : c)); } };
struct MapGu { __device__ __forceinline__ int operator()(int n) const { const int i = n >> 1; return (i >> 7) * 256 + (n & 1) * 128 + (i & 127); } };

template <class Map> __device__ __forceinline__ void transpose_tile_f8(const float* W, int ldw, int k0, int n0, unsigned char* WT, int ldt, const Map& map, LAS float* scr, int lane) {
    { const int c4 = (lane & 15) * 4, r4 = lane >> 4;
#pragma unroll
      for (int q = 0; q < 16; ++q) { const int kk = q * 4 + r4; const f32x4 v = *(const f32x4*)(W + (size_t)(k0 + kk) * ldw + n0 + c4);
          scr[kk * 65 + c4] = v[0]; scr[kk * 65 + c4 + 1] = v[1]; scr[kk * 65 + c4 + 2] = v[2]; scr[kk * 65 + c4 + 3] = v[3]; } }
    asm volatile("s_waitcnt lgkmcnt(0)" ::: "memory");
    const int c = lane & 7;
#pragma unroll
    for (int j = 0; j < 8; ++j) {
        const int n = (lane >> 3) + 8 * j; const LAS float* s = scr + (8 * c) * 65 + n;
        u32x2 o; o.x = pk4f8(s[0] * W8_SCALE, s[65] * W8_SCALE, s[2 * 65] * W8_SCALE, s[3 * 65] * W8_SCALE); o.y = pk4f8(s[4 * 65] * W8_SCALE, s[5 * 65] * W8_SCALE, s[6 * 65] * W8_SCALE, s[7 * 65] * W8_SCALE);
        *(u32x2*)(WT + (size_t)map(n0 + n) * ldt + k0 + 8 * c) = o;
    }
    asm volatile("s_waitcnt lgkmcnt(0)" ::: "memory");
}
constexpr int PI_ADA = 48, PI_TAB = 1, PI_RWT = 16, PI_S5 = 64, PI_FOLD = 256, PI_ZERO = 4;
constexpr int TW_WIN = 16 * 33, TW_GU = 32 * 16 * 32, TW_DN = 32 * 16 * 16, TW_WOUT = 12 * 16, TW_GLU = 16, TW_LAYER = TW_WIN + TW_GU + TW_DN + TW_WOUT + TW_GLU;
constexpr int PI_TR = (DEPTH * TW_LAYER + 7) / 8;
constexpr int PI_B_TAB = PI_ADA, PI_B_RWT = PI_B_TAB + PI_TAB, PI_B_S5 = PI_B_RWT + PI_RWT, PI_B_FOLD = PI_B_S5 + PI_S5, PI_B_ZERO = PI_B_FOLD + PI_FOLD, PI_B_TR = PI_B_ZERO + PI_ZERO, PI_TOTAL = PI_B_TR + (PI_TR + 3) / 4;

__device__ __forceinline__ void pro_adaln(Frame& F, CArgs& a, int it) {
    const int L = it / 12, cb = it % 12;
    LAS float* cond = (LAS float*)F.lds;
    for (int i = F.tid; i < 9 * 1024; i += NTHR) { const int r = i >> 10, k = i & 1023; const float v = r < 8 ? a.in[I_C][r * 1024 + k] : a.in[I_CCTX][k]; cond[i] = siluf_(v); }
    __syncthreads();
    const int n = cb * 512 + F.tid;
    const float* w = a.in[I_ADAW] + (size_t)L * 1024 * 6144 + n;
    float acc[9];
    const float b = a.in[I_ADAB][L * 6144 + n];
#pragma unroll
    for (int r = 0; r < 9; ++r) acc[r] = b;
#pragma unroll 8
    for (int k = 0; k < 1024; k += 4) {
        const float w0 = w[(size_t)k * 6144], w1 = w[(size_t)(k + 1) * 6144], w2 = w[(size_t)(k + 2) * 6144], w3 = w[(size_t)(k + 3) * 6144];
#pragma unroll
        for (int r = 0; r < 9; ++r) { const f32x4 c4 = *(const LAS f32x4*)(cond + r * 1024 + k); acc[r] += c4[0] * w0 + c4[1] * w1 + c4[2] * w2 + c4[3] * w3; }
    }
    float* mod = (float*)(F.ws + WS_MOD) + (size_t)L * 9 * 6144 + n;
#pragma unroll
    for (int r = 0; r < 9; ++r) mod[(size_t)r * 6144] = acc[r];
    __syncthreads();
}
__device__ __forceinline__ void pro_tables(Frame& F, CArgs& a) {
    { bf16* gt = (bf16*)(F.ws + WS_GA2T);
      for (int i = F.tid; i < DEPTH * 256 * 32; i += NTHR) { const int L = i >> 13, col = (i >> 5) & 255, k = i & 31, r = col >> 7, c = col & 127;
          gt[i] = (bf16)f2bf((k >> 4) == r ? a.in[I_GLAA2][((size_t)(L * 2 + r) * 16 + (k & 15)) * 128 + c] : 0.f); } }
    bf16* f64 = (bf16*)(F.ws + WS_TAB + TAB_F64);
    for (int i = F.tid; i < 4096; i += NTHR) { const int k = i >> 6, n = i & 63; float s, c; sincospif((float)((k * n) & 63) / 32.f, &s, &c); f64[i] = (bf16)f2bf(c); f64[4096 + i] = (bf16)f2bf(s); }
    float* tw = (float*)(F.ws + WS_TAB + TAB_TW);
    for (int i = F.tid; i < 4096; i += NTHR) { float s, c; sincospif((float)i / 2048.f, &s, &c); tw[2 * i] = c; tw[2 * i + 1] = s; }
    bf16* dc = (bf16*)(F.ws + WS_DFTC);
    for (int i = F.tid; i < 65536; i += NTHR) { const int k = i >> 8, n = i & 255; float s, c; sincospif((float)((k * n) & 255) / 128.f, &s, &c); dc[i] = (bf16)f2bf(c); dc[65536 + i] = (bf16)f2bf(-s); }
    float* d256 = (float*)(F.ws + WS_TAB + TAB_D256);
    for (int i = F.tid; i < 256; i += NTHR) { float s, c; sincospif((float)i / 128.f, &s, &c); d256[2 * i] = c; d256[2 * i + 1] = s; }
}
__device__ __forceinline__ void pro_fold(Frame& F, CArgs& a, int it) {
    const int L = it >> 6, h = (it >> 4) & 3, nb = it & 15, n0 = nb * 64;
    LAS float* fw = (LAS float*)F.lds;
    LAS float* ct = fw + 64 * 65;
    LAS float* swo = ct + 64;
    LAS float* sfo = swo + 256 * 64;
    if (F.tid < 64) ct[F.tid] = cospif((float)F.tid / 32.f);
    const float* four = a.in[I_FOURW] + (size_t)L * 256 * 256 + (size_t)h * 64 * 256, *wo = a.in[I_WOUT] + (size_t)L * 1024 * 1024 + n0;
    { f32x4 va[8], vb[8];
#pragma unroll
      for (int k = 0; k < 8; ++k) { const int i = F.tid + k * NTHR, j = i >> 4, c4 = (i & 15) * 4; va[k] = *(const f32x4*)(wo + (size_t)j * 1024 + c4); vb[k] = *(const f32x4*)(four + (size_t)i * 4); }
#pragma unroll
      for (int k = 0; k < 8; ++k) { const int i = F.tid + k * NTHR, j = i >> 4, c4 = (i & 15) * 4; *(LAS f32x4*)(swo + j * 64 + c4) = va[k]; *(LAS f32x4*)(sfo + i * 4) = vb[k]; } }
    __syncthreads();
    const int n = F.tid & 63, cg = F.tid >> 6;
    { float s[8];
#pragma unroll
      for (int i = 0; i < 8; ++i) s[i] = 0.f;
#pragma unroll 4
      for (int j = 0; j < 256; j += 4) { const float w0 = swo[j * 64 + n], w1 = swo[(j + 1) * 64 + n], w2 = swo[(j + 2) * 64 + n], w3 = swo[(j + 3) * 64 + n];
#pragma unroll
          for (int i = 0; i < 8; ++i) { const f32x4 f4 = *(const LAS f32x4*)(sfo + (cg * 8 + i) * 256 + j); s[i] += f4[0] * w0 + f4[1] * w1 + f4[2] * w2 + f4[3] * w3; } }
#pragma unroll
      for (int i = 0; i < 8; ++i) fw[(cg * 8 + i) * 65 + n] = s[i]; }
    __syncthreads();
    float oc[8], os[8];
#pragma unroll
    for (int i = 0; i < 8; ++i) { oc[i] = 0.f; os[i] = 0.f; }
    for (int kc = 0; kc < 64; ++kc) { const float v = fw[kc * 65 + n];
#pragma unroll
        for (int i = 0; i < 8; ++i) { const int mm = (kc * (cg * 8 + i)) & 63; oc[i] += ct[mm] * v; os[i] += ct[(mm + 48) & 63] * v; } }
    bf16* wt = (bf16*)(F.ws + WS_WOUT) + (size_t)L * DM * MW + (size_t)(n0 + n) * MW + h * 64 + cg * 8;
    u32x4 w; w.x = pk2(oc[0] * 0.125f, oc[1] * 0.125f); w.y = pk2(oc[2] * 0.125f, oc[3] * 0.125f); w.z = pk2(oc[4] * 0.125f, oc[5] * 0.125f); w.w = pk2(oc[6] * 0.125f, oc[7] * 0.125f);
    *(u32x4*)wt = w;
    w.x = pk2(os[0] * 0.125f, os[1] * 0.125f); w.y = pk2(os[2] * 0.125f, os[3] * 0.125f); w.z = pk2(os[4] * 0.125f, os[5] * 0.125f); w.w = pk2(os[6] * 0.125f, os[7] * 0.125f);
    *(u32x4*)(wt + 256) = w;
    __syncthreads();
}
__device__ __forceinline__ void pro_s5(Frame& F, CArgs& a, int it) {
    const int L = it >> 4, g = it & 15;
    LAS float* pw = (LAS float*)F.lds;
    LAS float* bb = pw + 2 * 64 * 17 * 2;
    LAS float* cm = bb + 2 * 64 * 16 * 2;
    LAS float* kt = cm + 2 * 16 * 64 * 2;
    for (int i = F.tid; i < 2 * 64 * 17; i += NTHR) {
        const int r = i / (64 * 17), p = (i / 17) & 63, e = i % 17; const size_t q = ((size_t)(L * 2 + r) * 16 + g) * 64 + p;
        const float dt = __expf(a.in[I_S5LDT][(L * 2 + r) * 16 + g]); const float lr = a.in[I_S5LRE][q] * dt, li = a.in[I_S5LIM][q] * dt;
        float s, c; sincosf(li * (float)e, &s, &c); const float m = expf(lr * (float)e); pw[2 * i] = m * c; pw[2 * i + 1] = m * s;
    }
    for (int i = F.tid; i < 2 * 64 * 16; i += NTHR) {
        const int r = i >> 10, p = (i >> 4) & 63, h = i & 15; const size_t q = ((size_t)(L * 2 + r) * 16 + g) * 64 + p;
        const float dt = __expf(a.in[I_S5LDT][(L * 2 + r) * 16 + g]); const float lre = a.in[I_S5LRE][q], lim = a.in[I_S5LIM][q];
        float s, c; sincosf(lim * dt, &s, &c); const float m = expf(lre * dt); const float ar = m * c - 1.f, ai = m * s;
        const float den = 1.f / (lre * lre + lim * lim); const float cr = (ar * lre + ai * lim) * den, ci = (ai * lre - ar * lim) * den;
        const float br = a.in[I_S5BRE][q * 16 + h], bi = a.in[I_S5BIM][q * 16 + h];
        bb[2 * i] = cr * br - ci * bi; bb[2 * i + 1] = cr * bi + ci * br;
    }
    for (int i = F.tid; i < 2 * 16 * 64; i += NTHR) {
        const int r = i >> 10, h = (i >> 6) & 15, p = i & 63; const size_t q = (((size_t)(L * 2 + r) * 16 + g) * 16 + h) * 64 + p;
        cm[2 * i] = a.in[I_S5CRE][q]; cm[2 * i + 1] = a.in[I_S5CIM][q];
    }
    __syncthreads();
    for (int i = F.tid; i < 2 * 16 * 256; i += NTHR) {
        const int r = i >> 12, tau = (i >> 8) & 15, h = (i >> 4) & 15, hp = i & 15; float s = 0.f;
        for (int p = 0; p < 64; ++p) { const float cr = cm[2 * ((r * 16 + h) * 64 + p)], ci = cm[2 * ((r * 16 + h) * 64 + p) + 1];
            const float ar = pw[2 * ((r * 64 + p) * 17 + tau)], ai = pw[2 * ((r * 64 + p) * 17 + tau) + 1]; const float br = bb[2 * ((r * 64 + p) * 16 + hp)], bi = bb[2 * ((r * 64 + p) * 16 + hp) + 1];
            const float tr = cr * ar - ci * ai, ti = cr * ai + ci * ar; s += tr * br - ti * bi; }
        kt[i] = s;
    }
    __syncthreads();
    bf16* pt = (bf16*)(F.ws + WS_S5P) + (size_t)(L * 16 + g) * 256 * 256;
    for (int i = F.tid; i < 65536; i += NTHR) {
        const int np = i >> 8, k = i & 255, r = np >> 7, cpx = (np >> 6) & 1, p = np & 63, s = k >> 4, hp = k & 15, e = r ? s : 15 - s;
        const float ar = pw[2 * ((r * 64 + p) * 17 + e)], ai = pw[2 * ((r * 64 + p) * 17 + e) + 1]; const float br = bb[2 * ((r * 64 + p) * 16 + hp)], bi = bb[2 * ((r * 64 + p) * 16 + hp) + 1];
        pt[i] = (bf16)f2bf(cpx ? ar * bi + ai * br : ar * br - ai * bi);
    }
    bf16* b2 = (bf16*)(F.ws + WS_S5B2) + (size_t)(L * 16 + g) * 256 * 512;
    const float* dsk = a.in[I_S5D] + L * 256 + g * 16;
    for (int i = F.tid; i < 131072; i += NTHR) {
        const int n = i >> 9, k = i & 511, j = n >> 4, h = n & 15; float v;
        if (k < 256) { const int s = k >> 4, hp = k & 15; v = 0.f;
            if (j >= s) v += kt[((0 * 16 + (j - s)) * 16 + h) * 16 + hp];
            if (j <= s) v += kt[((1 * 16 + (s - j)) * 16 + h) * 16 + hp];
            if (j == s && h == hp) v += dsk[h];
        } else { const int kk = k - 256, r = kk >> 7, cpx = (kk >> 6) & 1, p = kk & 63, e = r ? 16 - j : j + 1;
            const float cr = cm[2 * ((r * 16 + h) * 64 + p)], ci = cm[2 * ((r * 16 + h) * 64 + p) + 1]; const float ar = pw[2 * ((r * 64 + p) * 17 + e)], ai = pw[2 * ((r * 64 + p) * 17 + e) + 1];
            v = cpx ? -(cr * ai + ci * ar) : (cr * ar - ci * ai); }
        b2[i] = (bf16)f2bf(v);
    }
    float* a16 = (float*)(F.ws + WS_A16) + (size_t)((L * 2) * 16 + g) * 128;
    if (F.tid < 128) { const int r = F.tid >> 6, p = F.tid & 63; float* o = a16 + (size_t)r * 16 * 128 + p * 2; o[0] = pw[2 * ((r * 64 + p) * 17 + 16)]; o[1] = pw[2 * ((r * 64 + p) * 17 + 16) + 1]; }
    __syncthreads();
}
struct TDesc { const float* src; unsigned char* dst; int ldw, ncols, k0, n0, ldt, kd0, kind, valid; };
__device__ __forceinline__ TDesc tr_decode(Frame& F, int wi) {
    TDesc d; d.valid = wi < DEPTH * TW_LAYER; d.src = nullptr; d.dst = nullptr; d.ldw = d.ncols = d.k0 = d.n0 = d.ldt = d.kd0 = d.kind = 0;
    if (!d.valid) return d;
    const int L = wi / TW_LAYER; int r = wi % TW_LAYER;
    if (r < TW_GU) { const int t = r >> 5, li = r & 31, e = t >> 4, kb = 4 * ((t >> 2) & 3) + (li >> 3), nb = 8 * (t & 3) + (li & 7); d.src = fresh_args()->in[I_WGU] + ((size_t)L * NEXP + e) * DM * 2048; d.ldw = 2048; d.ncols = 2048; d.k0 = kb * 64; d.n0 = nb * 64; d.dst = F.ws + WS_WGU + ((size_t)L * NEXP + e) * 2048 * DM; d.ldt = DM; d.kd0 = kb * 64; d.kind = 1; return d; } r -= TW_GU;
    if (r < TW_DN) { const int t = r >> 5, li = r & 31, e = t >> 3, kb = 4 * ((t >> 1) & 3) + (li >> 3), nb = 8 * (t & 1) + (li & 7); d.src = fresh_args()->in[I_WDN] + ((size_t)L * NEXP + e) * DM * DM; d.ldw = DM; d.ncols = DM; d.k0 = kb * 64; d.n0 = nb * 64; d.dst = F.ws + WS_WDN + ((size_t)L * NEXP + e) * DM * DM; d.ldt = DM; d.kd0 = kb * 64; d.kind = 2; return d; } r -= TW_DN;
    if (r < TW_WIN) { const int kb = r / 33, nb = r % 33; d.src = fresh_args()->in[I_WIN] + (size_t)L * DM * 2088; d.ldw = 2088; d.ncols = 2088; d.k0 = kb * 64; d.n0 = nb * 64; d.dst = F.ws + WS_WIN + (size_t)L * PW * DM * (INPROJ_F8 ? 1 : 2); d.ldt = DM; d.kd0 = kb * 64; d.kind = INPROJ_F8 ? 4 : 0; return d; } r -= TW_WIN;
    if (r < TW_WOUT) { const int kb = r >> 4, nb = r & 15; d.src = fresh_args()->in[I_WOUT] + (size_t)L * DM * DM + (size_t)256 * DM; d.ldw = DM; d.ncols = DM; d.k0 = kb * 64; d.n0 = nb * 64; d.dst = F.ws + WS_WOUT + (size_t)L * DM * MW * 2; d.ldt = MW; d.kd0 = 512 + kb * 64; d.kind = 3; return d; } r -= TW_WOUT;
    { const int kb = r >> 2, nb = r & 3; d.src = fresh_args()->in[I_S5GLU] + (size_t)L * 256 * 256; d.ldw = 256; d.ncols = 256; d.k0 = kb * 64; d.n0 = nb * 64; d.dst = F.ws + WS_WGLU + (size_t)L * 256 * 256 * 2; d.ldt = 256; d.kd0 = kb * 64; d.kind = 3; }
    return d;
}
__device__ __forceinline__ void tr_load(const TDesc& d, f32x4 (&v)[16], int lane) {
    if (!d.valid) return;
    const int c4 = (lane & 15) * 4, r4 = lane >> 4; const bool ok = d.n0 + c4 < d.ncols;
#pragma unroll
    for (int q = 0; q < 16; ++q) v[q] = ok ? __builtin_nontemporal_load((const f32x4*)(d.src + (size_t)(d.k0 + 16 * r4 + q) * d.ldw + d.n0 + c4)) : (f32x4){0.f, 0.f, 0.f, 0.f};
}
__device__ __forceinline__ void tr_finish(const TDesc& d, const f32x4 (&v)[16], LAS float* scr, int lane) {
    if (!d.valid) return;
    const int c4 = (lane & 15) * 4, r4 = lane >> 4;
    if (d.n0 + c4 >= d.ncols) return;
    if (d.kind == 1 || d.kind == 2 || d.kind == 4) {
#pragma unroll
        for (int i = 0; i < 4; ++i) { const int nn = d.n0 + c4 + i, dr = d.kind == 1 ? MapGu()(nn) : (d.kind == 4 ? MapWin()(nn) : nn);
            u32x4 o; o.x = pk4f8(v[0][i] * W8_SCALE, v[1][i] * W8_SCALE, v[2][i] * W8_SCALE, v[3][i] * W8_SCALE); o.y = pk4f8(v[4][i] * W8_SCALE, v[5][i] * W8_SCALE, v[6][i] * W8_SCALE, v[7][i] * W8_SCALE);
            o.z = pk4f8(v[8][i] * W8_SCALE, v[9][i] * W8_SCALE, v[10][i] * W8_SCALE, v[11][i] * W8_SCALE); o.w = pk4f8(v[12][i] * W8_SCALE, v[13][i] * W8_SCALE, v[14][i] * W8_SCALE, v[15][i] * W8_SCALE);
            *(u32x4*)(d.dst + (size_t)dr * d.ldt + d.kd0 + 16 * r4) = o; }
    } else {
#pragma unroll
        for (int i = 0; i < 4; ++i) { const int nn = d.n0 + c4 + i, dr = d.kind == 0 ? MapWin()(nn) : nn;
            u32x4 o0, o1; o0.x = pk2(v[0][i], v[1][i]); o0.y = pk2(v[2][i], v[3][i]); o0.z = pk2(v[4][i], v[5][i]); o0.w = pk2(v[6][i], v[7][i]);
            o1.x = pk2(v[8][i], v[9][i]); o1.y = pk2(v[10][i], v[11][i]); o1.z = pk2(v[12][i], v[13][i]); o1.w = pk2(v[14][i], v[15][i]);
            bf16* p = (bf16*)d.dst + (size_t)dr * d.ldt + d.kd0 + 16 * r4; *(u32x4*)p = o0; *(u32x4*)(p + 8) = o1; }
    }
}
__device__ __forceinline__ void pro_transposes4(Frame& F, int ticket) {
    LAS float* scr = (LAS float*)F.lds + F.wave * (64 * 65);
    const int w0 = ticket * 32 + F.wave;
    f32x4 va[16], vb[16];
    const TDesc d0 = tr_decode(F, w0); tr_load(d0, va, F.lane);
    const TDesc d1 = tr_decode(F, w0 + 8); tr_load(d1, vb, F.lane); tr_finish(d0, va, scr, F.lane);
    const TDesc d2 = tr_decode(F, w0 + 16); tr_load(d2, va, F.lane); tr_finish(d1, vb, scr, F.lane);
    const TDesc d3 = tr_decode(F, w0 + 24); tr_load(d3, vb, F.lane); tr_finish(d2, va, scr, F.lane);
    tr_finish(d3, vb, scr, F.lane);
}
__device__ __forceinline__ void pro_rwt(Frame& F, CArgs& a, int it) {
    const int L = it >> 2, kb = (it & 3) * 256; bf16* rt = (bf16*)(F.ws + WS_RWT) + (size_t)L * 65536;
    for (int i = F.tid; i < 256 * 32; i += NTHR) { const int e = i & 31, k = kb + (i >> 5); const float w = a.in[I_RW][((size_t)L * DM + k) * NEXP + e];
        const unsigned hi = f2bf(w); rt[e * 1024 + k] = (bf16)hi; rt[32768 + e * 1024 + k] = (bf16)f2bf(w - bf2f((unsigned short)hi)); }
}
__device__ __forceinline__ void p_prologue(Frame& F0, CArgs& a, int qw = CW_QUEUE) {
    constexpr int NTICK = (PI_TR + 3) / 4;
    const bool prefer_tab = ((F0.bid >> 3) & 1) == 0;
    if (F0.tid == 0) F0.MISC[1] = 0u;
    for (;;) {
        if (F0.tid == 0) {
            unsigned st = F0.MISC[1]; int it = -1;
            while (it < 0 && st != 3u) {
                const bool tab = !(st & 1u) && (prefer_tab || (st & 2u));
                if (tab) { const unsigned t = __hip_atomic_fetch_add(F0.ctl + qw, 1u, RLX_AGENT); if (t < (unsigned)PI_B_TR) it = (int)t; else st |= 1u; }
                else { const unsigned t = __hip_atomic_fetch_add(F0.ctl + qw + 1, 1u, RLX_AGENT); if (t < (unsigned)NTICK) it = PI_B_TR + (int)t; else st |= 2u; }
#ifdef DUP_PRO_HEAVY
                if (qw != CW_QUEUE) st |= 2u;
#endif
            }
            F0.MISC[0] = (unsigned)it; F0.MISC[1] = st;
        }
        __syncthreads();
        const int it = (int)F0.MISC[0];
        __syncthreads();
        if (it < 0) break;
        Frame F = F0; { const int t_ = fresh_tid(F.wave); F.tid = t_; F.lane = t_ & 63; }
        if (it < PI_B_TAB) pro_adaln(F, *fresh_args(), it);
        else if (it < PI_B_RWT) pro_tables(F, *fresh_args());
        else if (it < PI_B_S5) pro_rwt(F, *fresh_args(), it - PI_B_RWT);
        else if (it < PI_B_FOLD) pro_s5(F, *fresh_args(), it - PI_B_S5);
        else if (it < PI_B_ZERO) pro_fold(F, *fresh_args(), it - PI_B_FOLD);
        else if (it < PI_B_TR) { const int L = it - PI_B_ZERO; constexpr int EB = INPROJ_F8 ? 1 : 2; u32x4* z = (u32x4*)(F.ws + WS_WIN + ((size_t)L * PW * DM + (size_t)2088 * DM) * EB); for (int i = F.tid; i < (PW - 2088) * DM * EB / 16; i += NTHR) z[i] = (u32x4){0u, 0u, 0u, 0u}; }
        else pro_transposes4(F, it - PI_B_TR);
    }
}

__device__ __forceinline__ void p_norm1(Frame& F, CArgs& a, int L, bool dry = false) {
    const int gw = F.bid * NWAVES + F.wave, NGW = F.G * NWAVES;
    bf16* XS = (bf16*)(F.ws + WS_XS); bf16* H = (bf16*)(F.ws + WS_H);
    const float* mod = (const float*)(F.ws + WS_MOD) + (size_t)L * 9 * 6144; const float* modp = mod - 9 * 6144;
    const int* PS = (const int*)(F.ws + WS_PS); const unsigned char* Y = (const unsigned char*)(F.ws + WS_Y);
    const float* g = a.in[I_NMG] + L * DM;
    const float* xin = a.in[I_X]; const float* cin = a.in[I_CTX];
    f32x4 gv[4];
#pragma unroll
    for (int j = 0; j < 4; ++j) gv[j] = *(const f32x4*)(g + 4 * F.lane + 256 * j);
    f32x4 xn[4]; u32x2 xb[4]; unsigned yn[4][4]; int psn[4] = {0, 0, 0, 0};
#define N1_LOADX(dst, row) do { if (L == 0) { const float* s_ = (row) < NLAT ? xin + (size_t)(row) * DM : cin + (size_t)((row) - NLAT) * DM; _Pragma("unroll") for (int j = 0; j < 4; ++j) dst[j] = *(const f32x4*)(s_ + 4 * F.lane + 256 * j); } \
        else { const bf16* s_ = XS + (size_t)(row) * DM; _Pragma("unroll") for (int j = 0; j < 4; ++j) xb[j] = *(const u32x2*)(s_ + 4 * F.lane + 256 * j); } } while (0)
#define N1_LOADY(dst, ps) do { _Pragma("unroll") for (int k = 0; k < 4; ++k) { const unsigned char* yr_ = Y + (size_t)(ps)[k] * DM; _Pragma("unroll") for (int j = 0; j < 4; ++j) dst[k][j] = *(const unsigned*)(yr_ + 4 * F.lane + 256 * j); } } while (0)
#define N1_LOADPS(dst, row) do { const int4 p_ = *(const int4*)(PS + (size_t)(row) * 4); dst[0] = p_.x; dst[1] = p_.y; dst[2] = p_.z; dst[3] = p_.w; } while (0)
    int row = gw;
    if (row < NT) { N1_LOADX(xn, row); if (L > 0) { N1_LOADPS(psn, row); N1_LOADY(yn, psn); if (row + NGW < NT) N1_LOADPS(psn, row + NGW); } }
    while (row < NT) {
        const int nrow = row + NGW; const int bi = row < NLAT ? (row >> 12) : 8;
        f32x4 v[4]; unsigned yc[4][4];
#pragma unroll
        for (int j = 0; j < 4; ++j) { v[j] = (L == 0) ? xn[j] : bf4(xb[j]);
#pragma unroll
            for (int k = 0; k < 4; ++k) yc[k][j] = yn[k][j]; }
        if (nrow < NT) { N1_LOADX(xn, nrow); if (L > 0) { N1_LOADY(yn, psn); if (nrow + NGW < NT) N1_LOADPS(psn, nrow + NGW); } }
        if (L > 0) {
            bf16* xr = XS + (size_t)row * DM; const float* m5 = modp + (size_t)bi * 6144 + 5 * 1024;
#pragma unroll
            for (int j = 0; j < 4; ++j) { f32x4 s = (f32x4){0.f, 0.f, 0.f, 0.f};
#pragma unroll
                for (int k = 0; k < 4; ++k) s += f8x4(yc[k][j]);
                v[j] += *(const f32x4*)(m5 + 4 * F.lane + 256 * j) * (s * (1.f / Y8_SCALE)); if (!dry) { u32x2 w; w.x = pk2(v[j][0], v[j][1]); w.y = pk2(v[j][2], v[j][3]); *(u32x2*)(xr + 4 * F.lane + 256 * j) = w; } }
        }
        float ss = 0.f;
#pragma unroll
        for (int j = 0; j < 4; ++j) ss += v[j][0] * v[j][0] + v[j][1] * v[j][1] + v[j][2] * v[j][2] + v[j][3] * v[j][3];
        const float rs = rsqrtf(wave_sum(ss, F.lane) * (1.f / DM) + 1e-6f);
        const float* sh = mod + (size_t)bi * 6144, *sc = sh + 1024;
        bf16* hr = H + (size_t)row * DM;
#pragma unroll
        for (int j = 0; j < 4; ++j) { const f32x4 s4 = *(const f32x4*)(sc + 4 * F.lane + 256 * j), h4 = *(const f32x4*)(sh + 4 * F.lane + 256 * j);
            const f32x4 o = v[j] * rs * gv[j] * (s4 + 1.f) + h4;
#if INPROJ_F8
            if (!dry || o[0] == 12345.678f) *(unsigned*)((unsigned char*)(F.ws + WS_H8) + (size_t)row * DM + 4 * F.lane + 256 * j) = pk4f8(o[0] * H8_SCALE, o[1] * H8_SCALE, o[2] * H8_SCALE, o[3] * H8_SCALE);
#else
            u32x2 w; w.x = pk2(o[0], o[1]); w.y = pk2(o[2], o[3]); if (!dry) *(u32x2*)(hr + 4 * F.lane + 256 * j) = w; else if (o[0] == 12345.678f) *(u32x2*)(hr + 4 * F.lane + 256 * j) = w;
#endif
        }
        row = nrow;
    }
#undef N1_LOADX
#undef N1_LOADY
#undef N1_LOADPS
}
__device__ __forceinline__ void p_norm2(Frame& F, CArgs& a, int L, int nrows, int cw = CW_CNT) {
    constexpr int TS = 1032;
    LAS bf16* thi = (LAS bf16*)F.lds; LAS bf16* tlo = thi + 16 * TS;
    LAS float* part = (LAS float*)(tlo + 16 * TS);
    LAS unsigned* lcnt = (LAS unsigned*)(part + 8 * 16 * 33);
    if (F.tid < 64) lcnt[F.tid] = 0u;
    const int lr = F.lane & 15, g = F.lane >> 4, hf = F.lane >> 5;
    bf16x8 bh[4][2], bl[4][2];
    { const bf16* rwh = (const bf16*)(F.ws + WS_RWT) + (size_t)L * 65536; const bf16* rwl = rwh + 32768;
#pragma unroll
      for (int ks = 0; ks < 4; ++ks)
#pragma unroll
          for (int nt = 0; nt < 2; ++nt) { const int o = (16 * nt + lr) * 1024 + 128 * F.wave + 32 * ks + 8 * g; bh[ks][nt] = *(const bf16x8*)(rwh + o); bl[ks][nt] = *(const bf16x8*)(rwl + o); } }
    __syncthreads();
    const int gw = F.bid * NWAVES + F.wave, NGW = F.G * NWAVES, R = (nrows - gw + NGW - 1) / NGW;
    const int Rmax = (nrows - F.bid * NWAVES + NGW - 1) / NGW;
    const bf16* XS = (const bf16*)(F.ws + WS_XS); unsigned char* H8 = (unsigned char*)(F.ws + WS_H8);
    const float* mod = (const float*)(F.ws + WS_MOD) + (size_t)L * 9 * 6144;
    int* PE = (int*)(F.ws + WS_PE); int* PR = (int*)(F.ws + WS_PR); float* PG = (float*)(F.ws + WS_PG);
    unsigned* cnt = F.ctl + cw + L * 64;
    const float* gp = a.in[I_NFG] + L * DM;
    const float rbh = a.in[I_RB][L * NEXP + (F.lane & 31)];
    f32x4 gv[4];
#pragma unroll
    for (int j = 0; j < 4; ++j) gv[j] = *(const f32x4*)(gp + 4 * F.lane + 256 * j);
    u32x2 xn[4];
#pragma unroll
    for (int j = 0; j < 4; ++j) xn[j] = 0 < R ? *(const u32x2*)(XS + (size_t)gw * DM + 4 * F.lane + 256 * j) : (u32x2){0u, 0u};
    for (int bt = 0; 2 * bt < Rmax; ++bt) {
#pragma unroll
        for (int it = 0; it < 2; ++it) {
            const int ri = 2 * bt + it, row = gw + ri * NGW; const bool ok = ri < R; const int bi = row < NLAT ? (row >> 12) : 8;
            f32x4 v[4]; float ss = 0.f;
#pragma unroll
            for (int j = 0; j < 4; ++j) { v[j] = bf4(xn[j]); ss += v[j][0] * v[j][0] + v[j][1] * v[j][1] + v[j][2] * v[j][2] + v[j][3] * v[j][3]; }
#pragma unroll
            for (int j = 0; j < 4; ++j) xn[j] = ri + 1 < R ? *(const u32x2*)(XS + (size_t)(row + NGW) * DM + 4 * F.lane + 256 * j) : (u32x2){0u, 0u};
            const float rs = rsqrtf(wave_sum(ss, F.lane) * (1.f / DM) + 1e-6f);
            const float* sh = mod + (size_t)(ok ? bi : 0) * 6144 + 3 * 1024, *sc = sh + 1024;
            unsigned char* hr = H8 + (size_t)row * DM;
            LAS bf16* th = thi + (it * 8 + F.wave) * TS, *tl = tlo + (it * 8 + F.wave) * TS;
#pragma unroll
            for (int j = 0; j < 4; ++j) { const f32x4 s4 = *(const f32x4*)(sc + 4 * F.lane + 256 * j), h4 = *(const f32x4*)(sh + 4 * F.lane + 256 * j);
                v[j] = ok ? v[j] * rs * gv[j] * (s4 + 1.f) + h4 : (f32x4){0.f, 0.f, 0.f, 0.f};
                if (ok) *(unsigned*)(hr + 4 * F.lane + 256 * j) = pk4f8(v[j][0] * H8_SCALE, v[j][1] * H8_SCALE, v[j][2] * H8_SCALE, v[j][3] * H8_SCALE);
                u32x2 wh; wh.x = pk2(v[j][0], v[j][1]); wh.y = pk2(v[j][2], v[j][3]);
                const f32x4 hv = bf4(wh); const f32x4 dl = v[j] - hv; u32x2 wl; wl.x = pk2(dl[0], dl[1]); wl.y = pk2(dl[2], dl[3]);
                *(LAS u32x2*)(th + 4 * F.lane + 256 * j) = wh; *(LAS u32x2*)(tl + 4 * F.lane + 256 * j) = wl; }
        }
        __syncthreads();
        {   f32x4 acc[2] = {(f32x4){0.f, 0.f, 0.f, 0.f}, (f32x4){0.f, 0.f, 0.f, 0.f}};
#pragma unroll
            for (int ks = 0; ks < 4; ++ks) { const int o = lr * TS + 128 * F.wave + 32 * ks + 8 * g; const bf16x8 ah = *(const LAS bf16x8*)(thi + o), al = *(const LAS bf16x8*)(tlo + o);
#pragma unroll
                for (int nt = 0; nt < 2; ++nt) { acc[nt] = __builtin_amdgcn_mfma_f32_16x16x32_bf16(ah, bh[ks][nt], acc[nt], 0, 0, 0); acc[nt] = __builtin_amdgcn_mfma_f32_16x16x32_bf16(al, bh[ks][nt], acc[nt], 0, 0, 0); acc[nt] = __builtin_amdgcn_mfma_f32_16x16x32_bf16(ah, bl[ks][nt], acc[nt], 0, 0, 0); } }
#pragma unroll
            for (int nt = 0; nt < 2; ++nt)
#pragma unroll
                for (int j = 0; j < 4; ++j) part[(F.wave * 16 + 4 * g + j) * 33 + 16 * nt + lr] = acc[nt][j];
        }
        __syncthreads();
        {   const int s = 2 * F.wave + hf, e = F.lane & 31;
            float logit = rbh;
#pragma unroll
            for (int w = 0; w < 8; ++w) logit += part[(w * 16 + s) * 33 + e];
            const int ri = 2 * bt + (s >> 3), rowh = F.bid * NWAVES + (s & 7) + ri * NGW; const bool okh = rowh < nrows;
            int es[4]; float ls[4];
#pragma unroll
            for (int k = 0; k < 4; ++k) {
                float m = logit; m = fmaxf(m, swz_xor<1>(m)); m = fmaxf(m, swz_xor<2>(m)); m = fmaxf(m, swz_xor<4>(m)); m = fmaxf(m, swz_xor<8>(m)); m = fmaxf(m, swz_xor<16>(m));
                const unsigned long long bal = __ballot(logit == m);
                const unsigned mh = (unsigned)(bal >> (F.lane & 32));
                es[k] = __builtin_ctz(mh); ls[k] = m;
                if (e == es[k]) logit = -3.0e38f;
            }
            const float e1 = __expf(ls[1] - ls[0]), e2 = __expf(ls[2] - ls[0]), e3 = __expf(ls[3] - ls[0]); const float inv = 1.f / (1.f + e1 + e2 + e3);
            if (e < 4 && okh) {
                const int ex = e == 0 ? es[0] : (e == 1 ? es[1] : (e == 2 ? es[2] : es[3]));
                const float gt = (e == 0 ? 1.f : (e == 1 ? e1 : (e == 2 ? e2 : e3))) * inv;
                const unsigned rk = __hip_atomic_fetch_add(lcnt + ex, 1u, __ATOMIC_RELAXED, __HIP_MEMORY_SCOPE_WORKGROUP);
                PE[rowh * 4 + e] = ex; PR[rowh * 4 + e] = (int)rk; PG[rowh * 4 + e] = gt;
            }
        }
        __syncthreads();
    }
    if (F.tid < 32) lcnt[32 + F.tid] = __hip_atomic_fetch_add(cnt + F.tid, lcnt[F.tid], RLX_AGENT);
    __syncthreads();
    int* TM = (int*)(F.ws + WS_TM);
    for (int bt = 0; 2 * bt < Rmax; ++bt) {
        const int s = 2 * F.wave + hf, e = F.lane & 31, rowh = F.bid * NWAVES + (s & 7) + (2 * bt + (s >> 3)) * NGW;
        if (e < 4 && rowh < nrows) { const int i = rowh * 4 + e, ex = PE[i], rk = PR[i] + (int)lcnt[32 + ex]; TM[(size_t)ex * NT + rk] = i; }
    }
    __syncthreads();
}
__device__ __forceinline__ void p_final(Frame& F, CArgs& a) {
    const int gw = F.bid * NWAVES + F.wave, NGW = F.G * NWAVES;
    const bf16* XS = (const bf16*)(F.ws + WS_XS);
    const float* modp = (const float*)(F.ws + WS_MOD) + (size_t)(DEPTH - 1) * 9 * 6144;
    const int* PS = (const int*)(F.ws + WS_PS); const unsigned char* Y = (const unsigned char*)(F.ws + WS_Y);
    const float* g = a.in[I_FING];
    f32x4 gv[4];
#pragma unroll
    for (int j = 0; j < 4; ++j) gv[j] = *(const f32x4*)(g + 4 * F.lane + 256 * j);
    u32x2 xb[4]; unsigned yn[4][4]; int psn[4] = {0, 0, 0, 0};
#define FN_LOADX(row) do { const bf16* s_ = XS + (size_t)(row) * DM; _Pragma("unroll") for (int j = 0; j < 4; ++j) xb[j] = *(const u32x2*)(s_ + 4 * F.lane + 256 * j); } while (0)
#define FN_LOADY(ps) do { _Pragma("unroll") for (int k = 0; k < 4; ++k) { const unsigned char* yr_ = Y + (size_t)(ps)[k] * DM; _Pragma("unroll") for (int j = 0; j < 4; ++j) yn[k][j] = *(const unsigned*)(yr_ + 4 * F.lane + 256 * j); } } while (0)
#define FN_LOADPS(row) do { const int4 p_ = *(const int4*)(PS + (size_t)(row) * 4); psn[0] = p_.x; psn[1] = p_.y; psn[2] = p_.z; psn[3] = p_.w; } while (0)
    int row = gw;
    if (row < NLAT) { FN_LOADX(row); FN_LOADPS(row); FN_LOADY(psn); if (row + NGW < NLAT) FN_LOADPS(row + NGW); }
    while (row < NLAT) {
        const int nrow = row + NGW, bi = row >> 12;
        f32x4 v[4], s[4];
#pragma unroll
        for (int j = 0; j < 4; ++j) { v[j] = bf4(xb[j]); s[j] = (f32x4){0.f, 0.f, 0.f, 0.f};
#pragma unroll
            for (int k = 0; k < 4; ++k) s[j] += f8x4(yn[k][j]);
            s[j] = s[j] * (1.f / Y8_SCALE); }
        if (nrow < NLAT) { FN_LOADX(nrow); FN_LOADY(psn); if (nrow + NGW < NLAT) FN_LOADPS(nrow + NGW); }
        const float* m5 = modp + (size_t)bi * 6144 + 5 * 1024;
        float ss = 0.f;
#pragma unroll
        for (int j = 0; j < 4; ++j) { v[j] += *(const f32x4*)(m5 + 4 * F.lane + 256 * j) * s[j]; ss += v[j][0] * v[j][0] + v[j][1] * v[j][1] + v[j][2] * v[j][2] + v[j][3] * v[j][3]; }
        const float rs = rsqrtf(wave_sum(ss, F.lane) * (1.f / DM) + 1e-6f);
        float* orow = a.out + (size_t)row * DM;
#pragma unroll
        for (int j = 0; j < 4; ++j) *(f32x4*)(orow + 4 * F.lane + 256 * j) = v[j] * rs * gv[j];
        row = nrow;
    }
#undef FN_LOADX
#undef FN_LOADY
#undef FN_LOADPS
}

#ifndef MIX_P1
#define MIX_P1 1
#endif
#define MFMA16(a, b, c) __builtin_amdgcn_mfma_f32_16x16x32_bf16((a), (b), (c), 0, 0, 0)
typedef short v4i16_t __attribute__((ext_vector_type(4)));
__device__ __forceinline__ s16x4 trread(const LAS void* p) { return __builtin_bit_cast(s16x4, __builtin_amdgcn_ds_read_tr16_b64_v4i16((LAS v4i16_t*)p)); }
__device__ __forceinline__ bf16x8 cat8(s16x4 a, s16x4 b) { return __builtin_shufflevector(a, b, 0, 1, 2, 3, 4, 5, 6, 7); }
__device__ __forceinline__ bf16x8 pack8(const float* v) { u32x4 w; w.x = pg8::cvt_pk_bf16(v[0], v[1]); w.y = pg8::cvt_pk_bf16(v[2], v[3]); w.z = pg8::cvt_pk_bf16(v[4], v[5]); w.w = pg8::cvt_pk_bf16(v[6], v[7]); return __builtin_bit_cast(bf16x8, w); }
__device__ __forceinline__ void unpack8(bf16x8 x, float* v) { const u32x4 w = __builtin_bit_cast(u32x4, x); v[0] = bflo(w.x); v[1] = bfhi(w.x); v[2] = bflo(w.y); v[3] = bfhi(w.y); v[4] = bflo(w.z); v[5] = bfhi(w.z); v[6] = bflo(w.w); v[7] = bfhi(w.w); }
#define OPQ(x) ({ int o_ = (x); asm volatile("" : "+s"(o_)); o_; })
#define LAUNDER_F(F0) Frame F = F0; { const int t_ = fresh_tid(F.wave); F.tid = t_; F.lane = t_ & 63; }
__device__ __forceinline__ int chunk_tok0(int cid) { return cid < 512 ? cid * 64 : NLAT + (cid - 512) * 64; }

constexpr int GL_QS = 136, GL_VS = 264, GL_BS = 260;
constexpr int GL_Q = 0, GL_K = GL_Q + 64 * GL_QS * 2, GL_V = GL_K + 64 * GL_QS * 2, GL_A1 = GL_V + 64 * GL_VS * 2, GL_B = GL_A1 + 64 * 32 * 2, GL_END = GL_B + 64 * GL_BS * 4;
static_assert(GL_END <= MISC_OFF, "GLA LDS");
template <int MODE> __device__ __forceinline__ void gla_chunk(Frame& F0, CArgs& a, int L, int cid) {
    constexpr bool OUT = MODE == 1, DO_STATE = MODE == 0 || MODE == 2, DO_INTRA = MODE == 1 || MODE == 2;
    LAUNDER_F(F0)
    const int tok0 = chunk_tok0(cid);
    const bf16* P = (const bf16*)(F.ws + WS_PBUF) + (size_t)tok0 * PW;
    LAS bf16* sq = (LAS bf16*)(F.lds + GL_Q); LAS bf16* sk = (LAS bf16*)(F.lds + GL_K); LAS bf16* sv = (LAS bf16*)(F.lds + GL_V); LAS bf16* sa1 = (LAS bf16*)(F.lds + GL_A1); LAS float* sB = (LAS float*)(F.lds + GL_B);
    __syncthreads();
    u32x4 rgate[4]; bf16x8 sfr[4];
    if constexpr (OUT) {
#pragma unroll
        for (int k = 0; k < 4; ++k) { const int i = F.tid + k * NTHR, t = i >> 5, pc = i & 31; rgate[k] = *(const u32x4*)(P + (size_t)t * PW + PC_R + pc * 8); }
        const bf16* se = (const bf16*)(F.ws + WS_GSE) + (((size_t)cid * 4 + (F.wave & 3)) * 2 + (F.wave >> 2)) * 2048;
#pragma unroll
        for (int d = 0; d < 4; ++d) sfr[d] = *(const bf16x8*)(se + (16 * d + (F.lane & 15)) * 32 + 8 * (F.lane >> 4));
    }
    {   u32x4 rq[2], rk[2], rv[4], ra = (u32x4){0u, 0u, 0u, 0u};
#pragma unroll
        for (int k = 0; k < 2; ++k) { const int i = F.tid + k * NTHR, t = i >> 4, pc = i & 15; rq[k] = *(const u32x4*)(P + (size_t)t * PW + PC_Q + pc * 8); rk[k] = *(const u32x4*)(P + (size_t)t * PW + PC_K + pc * 8); }
#pragma unroll
        for (int k = 0; k < 4; ++k) { const int i = F.tid + k * NTHR, t = i >> 5, pc = i & 31; rv[k] = *(const u32x4*)(P + (size_t)t * PW + PC_V + pc * 8); }
        if (F.tid < 256) { const int t = F.tid >> 2, pc = F.tid & 3; ra = *(const u32x4*)(P + (size_t)t * PW + PC_A1 + pc * 8); }
#pragma unroll
        for (int k = 0; k < 2; ++k) { const int i = F.tid + k * NTHR, t = i >> 4, pc = i & 15; *(LAS u32x4*)(sq + t * GL_QS + pc * 8) = rq[k]; *(LAS u32x4*)(sk + t * GL_QS + pc * 8) = rk[k]; }
#pragma unroll
        for (int k = 0; k < 4; ++k) { const int i = F.tid + k * NTHR, t = i >> 5, pc = i & 31; *(LAS u32x4*)(sv + t * GL_VS + pc * 8) = rv[k]; }
        if (F.tid < 256) { const int t = F.tid >> 2, pc = F.tid & 3; *(LAS u32x4*)(sa1 + t * 32 + pc * 8) = ra; }
    }
    __syncthreads();
    {
        const int lr_ = F.lane & 15, g_ = F.lane >> 4;
        const bf16* gt = (const bf16*)(F.ws + WS_GA2T) + (size_t)L * 256 * 32;
        bf16x8 bz[2]; float abv[2];
#pragma unroll
        for (int nt = 0; nt < 2; ++nt) { const int col = 32 * F.wave + 16 * nt + lr_; bz[nt] = *(const bf16x8*)(gt + col * 32 + 8 * g_); abv[nt] = a.in[I_GLAAB][L * 256 + col]; }
#pragma unroll
        for (int m = 0; m < 4; ++m) { const bf16x8 az = *(const LAS bf16x8*)(sa1 + (16 * m + lr_) * 32 + 8 * g_);
#pragma unroll
            for (int nt = 0; nt < 2; ++nt) { const f32x4 zz = MFMA16(az, bz[nt], ((f32x4){0.f, 0.f, 0.f, 0.f})); const int col = 32 * F.wave + 16 * nt + lr_;
#pragma unroll
                for (int j = 0; j < 4; ++j) { const float z = zz[j] + abv[nt]; const float ls = fminf(z, 0.f) - __logf(1.f + __expf(-fabsf(z))); sB[(16 * m + 4 * g_ + j) * GL_BS + col] = ls * (1.f / 16.f); } } }
    }
    __syncthreads();
    if (F.tid < 256) { const int col = F.tid, r = col >> 7; float bv[64];
#pragma unroll
        for (int i = 0; i < 64; ++i) bv[i] = sB[i * GL_BS + col];
        if (r == 0) {
#pragma unroll
            for (int i = 1; i < 64; ++i) bv[i] += bv[i - 1];
        } else {
#pragma unroll
            for (int i = 62; i >= 0; --i) bv[i] += bv[i + 1];
        }
#pragma unroll
        for (int i = 0; i < 64; ++i) sB[i * GL_BS + col] = bv[i]; }
    __syncthreads();
    const int hh = F.wave & 3, r = F.wave >> 2, lr = F.lane & 15, g = F.lane >> 4;
    const int bc = r * 128 + hh * 32;
    const size_t ub = ((size_t)cid * 4 + hh) * 2 + r;
    if constexpr (DO_STATE) {
        const int tl = r ? 0 : 63;
        f32x4 acc[2][4];
#pragma unroll
        for (int mc = 0; mc < 2; ++mc)
#pragma unroll
            for (int d = 0; d < 4; ++d) acc[mc][d] = (f32x4){0.f, 0.f, 0.f, 0.f};
#pragma unroll
        for (int sg = 0; sg < 2; ++sg) {
            bf16x8 vf[4];
#pragma unroll
            for (int d = 0; d < 4; ++d) { const LAS bf16* p0 = sv + (32 * sg + 8 * g + ((F.lane & 15) >> 2)) * GL_VS + hh * 64 + 16 * d + 4 * (F.lane & 3); vf[d] = cat8(trread(p0), trread(p0 + 4 * GL_VS)); }
#pragma unroll
            for (int mc = 0; mc < 2; ++mc) {
                const LAS bf16* p0 = sk + (32 * sg + 8 * g + ((F.lane & 15) >> 2)) * GL_QS + hh * 32 + 16 * mc + 4 * (F.lane & 3);
                const s16x4 k0 = trread(p0), k1 = trread(p0 + 4 * GL_QS);
                const int c = 16 * mc + lr; const float bl = sB[tl * GL_BS + bc + c];
                float kv[8];
#pragma unroll
                for (int e = 0; e < 4; ++e) { kv[e] = bf2f((unsigned short)k0[e]) * __expf(bl - sB[(32 * sg + 8 * g + e) * GL_BS + bc + c]); kv[4 + e] = bf2f((unsigned short)k1[e]) * __expf(bl - sB[(32 * sg + 8 * g + 4 + e) * GL_BS + bc + c]); }
                const bf16x8 kf = pack8(kv);
#pragma unroll
                for (int d = 0; d < 4; ++d) acc[mc][d] = MFMA16(kf, vf[d], acc[mc][d]);
            }
        }
        float* ds = (float*)(F.ws + WS_GDS) + ub * 2048;
#pragma unroll
        for (int mc = 0; mc < 2; ++mc)
#pragma unroll
            for (int d = 0; d < 4; ++d) *(f32x4*)(ds + (16 * d + lr) * 32 + 16 * mc + 4 * g) = acc[mc][d];
        if (F.lane < 32) ((float*)(F.ws + WS_GDEC))[ub * 32 + F.lane] = __expf(sB[tl * GL_BS + bc + F.lane]);
    }
    if constexpr (DO_INTRA) {
        bf16x8 qf[4], kf[4];
#pragma unroll
        for (int m = 0; m < 4; ++m) { const int t = 16 * m + lr; float qv[8], kv[8], bv[8];
            unpack8(*(const LAS bf16x8*)(sq + t * GL_QS + hh * 32 + 8 * g), qv); unpack8(*(const LAS bf16x8*)(sk + t * GL_QS + hh * 32 + 8 * g), kv);
            *(f32x4*)bv = *(const LAS f32x4*)(sB + t * GL_BS + bc + 8 * g); *(f32x4*)(bv + 4) = *(const LAS f32x4*)(sB + t * GL_BS + bc + 8 * g + 4);
#pragma unroll
            for (int e = 0; e < 8; ++e) { const float ex = __expf(bv[e]); qv[e] *= 0.17677669529663687f * ex; kv[e] *= __frcp_rn(ex); }
            qf[m] = pack8(qv); kf[m] = pack8(kv); }
        f32x4 o[4][4];
#pragma unroll
        for (int m = 0; m < 4; ++m)
#pragma unroll
            for (int d = 0; d < 4; ++d) o[m][d] = (f32x4){0.f, 0.f, 0.f, 0.f};
        if constexpr (OUT) {
#pragma unroll
            for (int d = 0; d < 4; ++d) {
#pragma unroll
                for (int m = 0; m < 4; ++m) o[m][d] = MFMA16(qf[m], sfr[d], o[m][d]); }
        }
        bf16x8 vf[2][4];
#pragma unroll
        for (int sg = 0; sg < 2; ++sg)
#pragma unroll
            for (int d = 0; d < 4; ++d) { const LAS bf16* p0 = sv + (32 * sg + 4 * g + ((F.lane & 15) >> 2)) * GL_VS + hh * 64 + 16 * d + 4 * (F.lane & 3); vf[sg][d] = cat8(trread(p0), trread(p0 + 16 * GL_VS)); }
        const f32x4 zero4 = (f32x4){0.f, 0.f, 0.f, 0.f};
#pragma unroll
        for (int m = 0; m < 4; ++m) {
            const int t = 16 * m + lr;
#pragma unroll
            for (int sg = 0; sg < 2; ++sg) {
                f32x4 p0 = MFMA16(kf[2 * sg], qf[m], zero4), p1 = MFMA16(kf[2 * sg + 1], qf[m], zero4);
                float pv[8];
#pragma unroll
                for (int j = 0; j < 4; ++j) { const int s0 = 32 * sg + 4 * g + j, s1 = s0 + 16; pv[j] = (r ? s0 >= t : s0 <= t) ? p0[j] : 0.f; pv[4 + j] = (r ? s1 >= t : s1 <= t) ? p1[j] : 0.f; }
                const bf16x8 pf = pack8(pv);
#pragma unroll
                for (int d = 0; d < 4; ++d) o[m][d] = MFMA16(pf, vf[sg][d], o[m][d]);
            }
        }
        if constexpr (OUT) {
        __syncthreads();
        LAS float* ox = (LAS float*)(F.lds + GL_B);
        LAS bf16* ot = (LAS bf16*)(F.lds + GL_Q);
        LAS bf16* srg = (LAS bf16*)(F.lds + GL_V);
#pragma unroll
        for (int k = 0; k < 4; ++k) { const int i = F.tid + k * NTHR, t = i >> 5, pc = i & 31; *(LAS u32x4*)(srg + t * GL_VS + pc * 8) = rgate[k]; }
        if (r == 1) {
#pragma unroll
            for (int m = 0; m < 4; ++m)
#pragma unroll
                for (int d = 0; d < 4; ++d)
#pragma unroll
                    for (int j = 0; j < 4; ++j) ox[(hh * 64 + 16 * m + 4 * g + j) * 65 + 16 * d + lr] = o[m][d][j];
        }
        __syncthreads();
        if (r == 0) {
            const float* ng = a.in[I_GLANG] + L * 64;
            float gn[4];
#pragma unroll
            for (int d = 0; d < 4; ++d) gn[d] = ng[16 * d + lr];
#pragma unroll
            for (int m = 0; m < 4; ++m)
#pragma unroll
                for (int j = 0; j < 4; ++j) {
                    const int t = 16 * m + 4 * g + j; float v[4], ss = 0.f;
#pragma unroll
                    for (int d = 0; d < 4; ++d) { v[d] = o[m][d][j] + ox[(hh * 64 + t) * 65 + 16 * d + lr]; ss += v[d] * v[d]; }
                    ss += swz_xor<1>(ss); ss += swz_xor<2>(ss); ss += swz_xor<4>(ss); ss += swz_xor<8>(ss);
                    const float rs = rsqrtf(ss * (1.f / 64.f) + 1e-6f);
#pragma unroll
                    for (int d = 0; d < 4; ++d) { const float rg = bf2f(srg[t * GL_VS + hh * 64 + 16 * d + lr]); ot[t * 264 + hh * 64 + 16 * d + lr] = (bf16)f2bf(v[d] * rs * gn[d] * siluf_(rg)); }
                }
        }
        __syncthreads();
        bf16* MX = (bf16*)(F.ws + WS_MIX) + (size_t)tok0 * MW + 768;
        for (int i = F.tid; i < 2048; i += NTHR) { const int t = i >> 5, pc = i & 31; *(u32x4*)(MX + (size_t)t * MW + pc * 8) = *(const LAS u32x4*)(ot + t * 264 + pc * 8); }
        } else {
            bf16* QI = (bf16*)(F.ws + WS_GQI) + (size_t)tok0 * 256;
#pragma unroll
            for (int m = 0; m < 4; ++m) *(bf16x8*)(QI + (size_t)(16 * m + lr) * 256 + r * 128 + hh * 32 + 8 * g) = qf[m];
            __syncthreads();
            LAS float* ox = (LAS float*)(F.lds + GL_B);
            LAS bf16* ot = (LAS bf16*)(F.lds + GL_Q);
            if (r == 1) {
#pragma unroll
                for (int m = 0; m < 4; ++m)
#pragma unroll
                    for (int d = 0; d < 4; ++d)
#pragma unroll
                        for (int j = 0; j < 4; ++j) ox[(hh * 64 + 16 * m + 4 * g + j) * 65 + 16 * d + lr] = o[m][d][j];
            }
            __syncthreads();
            if (r == 0) {
#pragma unroll
                for (int m = 0; m < 4; ++m)
#pragma unroll
                    for (int d = 0; d < 4; ++d)
#pragma unroll
                        for (int j = 0; j < 4; ++j) { const int t = 16 * m + 4 * g + j; ot[t * 264 + hh * 64 + 16 * d + lr] = (bf16)f2bf(o[m][d][j] + ox[(hh * 64 + t) * 65 + 16 * d + lr]); }
            }
            __syncthreads();
            bf16* OI = (bf16*)(F.ws + WS_GOI) + (size_t)tok0 * 256;
            for (int i = F.tid; i < 2048; i += NTHR) { const int t = i >> 5, pc = i & 31; *(u32x4*)(OI + (size_t)t * 256 + pc * 8) = *(const LAS u32x4*)(ot + t * 264 + pc * 8); }
        }
    }
}


__device__ __forceinline__ void gla_light(Frame& F0, CArgs& a, int L, int cid) {
    LAUNDER_F(F0)
    const int tok0 = chunk_tok0(cid), hh = F.wave & 3, r = F.wave >> 2, lr = F.lane & 15, g = F.lane >> 4;
    const bf16* P = (const bf16*)(F.ws + WS_PBUF) + (size_t)tok0 * PW;
    const bf16* QI = (const bf16*)(F.ws + WS_GQI) + (size_t)tok0 * 256; const bf16* OI = (const bf16*)(F.ws + WS_GOI) + (size_t)tok0 * 256;
    const bf16* se = (const bf16*)(F.ws + WS_GSE) + (((size_t)cid * 4 + hh) * 2 + r) * 2048;
    u32x4 rgate[4], roi[4]; bf16x8 qf[4], sfr[4];
#pragma unroll
    for (int m = 0; m < 4; ++m) qf[m] = *(const bf16x8*)(QI + (size_t)(16 * m + lr) * 256 + r * 128 + hh * 32 + 8 * g);
#pragma unroll
    for (int d = 0; d < 4; ++d) sfr[d] = *(const bf16x8*)(se + (16 * d + lr) * 32 + 8 * g);
#pragma unroll
    for (int k = 0; k < 4; ++k) { const int i = F.tid + k * NTHR, t = i >> 5, pc = i & 31; rgate[k] = *(const u32x4*)(P + (size_t)t * PW + PC_R + pc * 8); roi[k] = *(const u32x4*)(OI + (size_t)t * 256 + pc * 8); }
    f32x4 o[4][4];
#pragma unroll
    for (int m = 0; m < 4; ++m)
#pragma unroll
        for (int d = 0; d < 4; ++d) o[m][d] = MFMA16(qf[m], sfr[d], ((f32x4){0.f, 0.f, 0.f, 0.f}));
    LAS float* ox = (LAS float*)(F.lds + GL_B);
    LAS bf16* srg = (LAS bf16*)(F.lds + GL_V);
    LAS bf16* soi = (LAS bf16*)(F.lds + GL_Q);
    __syncthreads();
#pragma unroll
    for (int k = 0; k < 4; ++k) { const int i = F.tid + k * NTHR, t = i >> 5, pc = i & 31; *(LAS u32x4*)(srg + t * GL_VS + pc * 8) = rgate[k]; *(LAS u32x4*)(soi + t * 264 + pc * 8) = roi[k]; }
    if (r == 1) {
#pragma unroll
        for (int m = 0; m < 4; ++m)
#pragma unroll
            for (int d = 0; d < 4; ++d)
#pragma unroll
                for (int j = 0; j < 4; ++j) ox[(hh * 64 + 16 * m + 4 * g + j) * 65 + 16 * d + lr] = o[m][d][j];
    }
    __syncthreads();
    if (r == 0) {
        const float* ng = a.in[I_GLANG] + L * 64;
        float gn[4];
#pragma unroll
        for (int d = 0; d < 4; ++d) gn[d] = ng[16 * d + lr];
#pragma unroll
        for (int m = 0; m < 4; ++m)
#pragma unroll
            for (int j = 0; j < 4; ++j) {
                const int t = 16 * m + 4 * g + j; float v[4], ss = 0.f;
#pragma unroll
                for (int d = 0; d < 4; ++d) { v[d] = o[m][d][j] + ox[(hh * 64 + t) * 65 + 16 * d + lr] + bf2f(soi[t * 264 + hh * 64 + 16 * d + lr]); ss += v[d] * v[d]; }
                ss += swz_xor<1>(ss); ss += swz_xor<2>(ss); ss += swz_xor<4>(ss); ss += swz_xor<8>(ss);
                const float rs = rsqrtf(ss * (1.f / 64.f) + 1e-6f);
#pragma unroll
                for (int d = 0; d < 4; ++d) { const int q = t * GL_VS + hh * 64 + 16 * d + lr; const float rg = bf2f(srg[q]); srg[q] = (bf16)f2bf(v[d] * rs * gn[d] * siluf_(rg)); }
            }
    }
    __syncthreads();
    bf16* MX = (bf16*)(F.ws + WS_MIX) + (size_t)tok0 * MW + 768;
    for (int i = F.tid; i < 2048; i += NTHR) { const int t = i >> 5, pc = i & 31; *(u32x4*)(MX + (size_t)t * MW + pc * 8) = *(const LAS u32x4*)(srg + t * GL_VS + pc * 8); }
}

constexpr int SD_RS = 520;
constexpr int SD_RAW = 0, SD_XC = SD_RAW + 68 * SD_RS * 2, SD_DT = SD_XC + 64 * SD_RS * 2, SD_CUM = SD_DT + 64 * 8 * 4, SD_W = SD_CUM + 8 * 64 * 4, SD_END = SD_W + 8 * 64 * 4;
static_assert(SD_END <= MISC_OFF && 64 * 260 * 4 <= 68 * SD_RS * 2, "SSD LDS");
template <int MODE> __device__ __forceinline__ void ssd_chunk(Frame& F0, CArgs& a, int L, int cid) {
    constexpr bool OUT = MODE == 1, DO_STATE = MODE == 0 || MODE == 2, DO_INTRA = MODE == 1 || MODE == 2;
    LAUNDER_F(F0)
    const int tok0 = chunk_tok0(cid);
    const bf16* PB = (const bf16*)(F.ws + WS_PBUF);
    LAS bf16* raw = (LAS bf16*)(F.lds + SD_RAW); LAS bf16* xc = (LAS bf16*)(F.lds + SD_XC); LAS float* sdt = (LAS float*)(F.lds + SD_DT); LAS float* scum = (LAS float*)(F.lds + SD_CUM); LAS float* sw = (LAS float*)(F.lds + SD_W);
    bf16x8 sfr[4][2];
    if constexpr (OUT) { const bf16* se = (const bf16*)(F.ws + WS_SSE) + (((size_t)cid * 4 + (F.wave & 3)) * 2 + (F.wave >> 2)) * 4096;
#pragma unroll
        for (int d = 0; d < 4; ++d) { sfr[d][0] = *(const bf16x8*)(se + (16 * d + (F.lane & 15)) * 64 + 8 * (F.lane >> 4)); sfr[d][1] = *(const bf16x8*)(se + (16 * d + (F.lane & 15)) * 64 + 32 + 8 * (F.lane >> 4)); } }
    __syncthreads();
    {
        const int isctx = cid >= 512, c4 = (cid - 512) & 3;
        u32x4 rv[9];
#pragma unroll
        for (int k = 0; k < 9; ++k) { const int i = F.tid + k * NTHR, rr = i >> 6, pc = i & 63, t = rr - 2; rv[k] = (u32x4){0u, 0u, 0u, 0u};
            bool ok = t >= 0 && t < 64 && i < 68 * 64; if (isctx) { const int tt = c4 * 64 + t; ok = tt >= 0 && tt < 256 && i < 68 * 64; }
            if (ok) rv[k] = *(const u32x4*)(PB + (size_t)(tok0 + t) * PW + PC_XBC + pc * 8); }
#pragma unroll
        for (int k = 0; k < 9; ++k) { const int i = F.tid + k * NTHR, rr = i >> 6, pc = i & 63; if (i < 68 * 64) *(LAS u32x4*)(raw + rr * SD_RS + pc * 8) = rv[k]; }
        if (F.tid < 64) { float dv[8]; unpack8(*(const bf16x8*)(PB + (size_t)(tok0 + F.tid) * PW + PC_DT), dv);
#pragma unroll
            for (int q = 0; q < 8; ++q) { const float z = dv[q] + a.in[I_SSDDTB][L * 8 + q]; sdt[F.tid * 8 + q] = z > 20.f ? z : __logf(1.f + __expf(z)); } }
    }
    __syncthreads();
    {
        const int ch = F.tid; float w[5];
#pragma unroll
        for (int k = 0; k < 5; ++k) w[k] = a.in[I_SSDCW][((size_t)L * 5 + k) * 512 + ch];
        const float cb = a.in[I_SSDCB][L * 512 + ch];
        float x0 = bf2f(raw[0 * SD_RS + ch]), x1 = bf2f(raw[1 * SD_RS + ch]), x2 = bf2f(raw[2 * SD_RS + ch]), x3 = bf2f(raw[3 * SD_RS + ch]);
        for (int t0 = 0; t0 < 64; t0 += 16) { float xv[16];
#pragma unroll
            for (int k = 0; k < 16; ++k) xv[k] = bf2f(raw[(t0 + k + 4) * SD_RS + ch]);
#pragma unroll
            for (int k = 0; k < 16; ++k) { const float x4 = xv[k]; const float y = cb + w[0] * x0 + w[1] * x1 + w[2] * x2 + w[3] * x3 + w[4] * x4;
                xc[(t0 + k) * SD_RS + ch] = (bf16)f2bf(siluf_(y)); x0 = x1; x1 = x2; x2 = x3; x3 = x4; } }
    }
    {
        const int q = F.wave, rr = q >> 2, t = rr ? 63 - F.lane : F.lane;
        const float aa = -__expf(a.in[I_SSDALOG][L * 8 + q]); const float dtv = sdt[t * 8 + q];
        float c = dtv * aa;
        { float o;
          o = __builtin_bit_cast(float, __builtin_amdgcn_ds_bpermute((F.lane - 1) << 2, __builtin_bit_cast(int, c))); if (F.lane >= 1) c += o;
          o = __builtin_bit_cast(float, __builtin_amdgcn_ds_bpermute((F.lane - 2) << 2, __builtin_bit_cast(int, c))); if (F.lane >= 2) c += o;
          o = __builtin_bit_cast(float, __builtin_amdgcn_ds_bpermute((F.lane - 4) << 2, __builtin_bit_cast(int, c))); if (F.lane >= 4) c += o;
          o = __builtin_bit_cast(float, __builtin_amdgcn_ds_bpermute((F.lane - 8) << 2, __builtin_bit_cast(int, c))); if (F.lane >= 8) c += o;
          o = __builtin_bit_cast(float, __builtin_amdgcn_ds_bpermute((F.lane - 16) << 2, __builtin_bit_cast(int, c))); if (F.lane >= 16) c += o;
          o = __builtin_bit_cast(float, __builtin_amdgcn_ds_bpermute((F.lane - 32) << 2, __builtin_bit_cast(int, c))); if (F.lane >= 32) c += o; }
        const float cl = __builtin_bit_cast(float, __builtin_amdgcn_ds_bpermute(63 << 2, __builtin_bit_cast(int, c)));
        scum[q * 64 + t] = c; sw[q * 64 + t] = __expf(cl - c) * dtv;
    }
    __syncthreads();
    const int h = F.wave & 3, r = F.wave >> 2, lr = F.lane & 15, g = F.lane >> 4, gp = h >> 1, rh = r * 4 + h;
    const size_t ub = ((size_t)cid * 4 + h) * 2 + r;
    if constexpr (DO_STATE) {
        f32x4 acc[4][4];
#pragma unroll
        for (int ms = 0; ms < 4; ++ms)
#pragma unroll
            for (int d = 0; d < 4; ++d) acc[ms][d] = (f32x4){0.f, 0.f, 0.f, 0.f};
#pragma unroll
        for (int sg = 0; sg < 2; ++sg) {
            const int trow = 32 * sg + 8 * g;
            bf16x8 xf[4];
#pragma unroll
            for (int d = 0; d < 4; ++d) { const LAS bf16* p0 = xc + (trow + ((F.lane & 15) >> 2)) * SD_RS + h * 64 + 16 * d + 4 * (F.lane & 3); xf[d] = cat8(trread(p0), trread(p0 + 4 * SD_RS)); }
            float wv[8];
            *(f32x4*)wv = *(const LAS f32x4*)(sw + rh * 64 + trow); *(f32x4*)(wv + 4) = *(const LAS f32x4*)(sw + rh * 64 + trow + 4);
#pragma unroll
            for (int ms = 0; ms < 4; ++ms) {
                const LAS bf16* p0 = xc + (trow + ((F.lane & 15) >> 2)) * SD_RS + 256 + gp * 64 + 16 * ms + 4 * (F.lane & 3);
                const s16x4 b0 = trread(p0), b1 = trread(p0 + 4 * SD_RS);
                float bv[8];
#pragma unroll
                for (int e = 0; e < 4; ++e) { bv[e] = bf2f((unsigned short)b0[e]) * wv[e]; bv[4 + e] = bf2f((unsigned short)b1[e]) * wv[4 + e]; }
                const bf16x8 bf = pack8(bv);
#pragma unroll
                for (int d = 0; d < 4; ++d) acc[ms][d] = MFMA16(bf, xf[d], acc[ms][d]);
            }
        }
        float* ds = (float*)(F.ws + WS_SDS) + ub * 4096;
#pragma unroll
        for (int ms = 0; ms < 4; ++ms)
#pragma unroll
            for (int d = 0; d < 4; ++d) *(f32x4*)(ds + (16 * d + lr) * 64 + 16 * ms + 4 * g) = acc[ms][d];
        if (F.lane == 0) ((float*)(F.ws + WS_SDEC))[ub] = __expf(scum[rh * 64 + (r ? 0 : 63)]);
    }
    if constexpr (DO_INTRA) {
        bf16x8 bfr[4][2], cfr[4][2];
#pragma unroll
        for (int m = 0; m < 4; ++m)
#pragma unroll
            for (int ks = 0; ks < 2; ++ks) { bfr[m][ks] = *(const LAS bf16x8*)(xc + (16 * m + lr) * SD_RS + 256 + gp * 64 + 32 * ks + 8 * g); cfr[m][ks] = *(const LAS bf16x8*)(xc + (16 * m + lr) * SD_RS + 384 + gp * 64 + 32 * ks + 8 * g); }
        f32x4 y[4][4];
#pragma unroll
        for (int m = 0; m < 4; ++m)
#pragma unroll
            for (int d = 0; d < 4; ++d) y[m][d] = (f32x4){0.f, 0.f, 0.f, 0.f};
        if constexpr (OUT) {
            bf16x8 cs[4][2];
#pragma unroll
            for (int m = 0; m < 4; ++m) { const float ec = __expf(scum[rh * 64 + 16 * m + lr]);
#pragma unroll
                for (int ks = 0; ks < 2; ++ks) { float cv[8]; unpack8(cfr[m][ks], cv);
#pragma unroll
                    for (int e = 0; e < 8; ++e) cv[e] *= ec;
                    cs[m][ks] = pack8(cv); } }
#pragma unroll
            for (int d = 0; d < 4; ++d) {
#pragma unroll
                for (int m = 0; m < 4; ++m) { y[m][d] = MFMA16(cs[m][0], sfr[d][0], y[m][d]); y[m][d] = MFMA16(cs[m][1], sfr[d][1], y[m][d]); }
            }
        }
        asm volatile("" ::: "memory");
        bf16x8 xf[2][4];
#pragma unroll
        for (int sg = 0; sg < 2; ++sg)
#pragma unroll
            for (int d = 0; d < 4; ++d) { const LAS bf16* p0 = xc + (32 * sg + 4 * g + ((F.lane & 15) >> 2)) * SD_RS + h * 64 + 16 * d + 4 * (F.lane & 3); xf[sg][d] = cat8(trread(p0), trread(p0 + 16 * SD_RS)); }
        const f32x4 zero4 = (f32x4){0.f, 0.f, 0.f, 0.f};
#pragma unroll
        for (int m = 0; m < 4; ++m) {
            const int t = 16 * m + lr; const float ct = scum[rh * 64 + t];
#pragma unroll
            for (int sg = 0; sg < 2; ++sg) {
                f32x4 p0 = MFMA16(bfr[2 * sg][0], cfr[m][0], zero4), p1 = MFMA16(bfr[2 * sg + 1][0], cfr[m][0], zero4);
                p0 = MFMA16(bfr[2 * sg][1], cfr[m][1], p0); p1 = MFMA16(bfr[2 * sg + 1][1], cfr[m][1], p1);
                float pv[8];
#pragma unroll
                for (int j = 0; j < 4; ++j) { const int s0 = 32 * sg + 4 * g + j, s1 = s0 + 16;
                    pv[j] = (r ? s0 >= t : s0 <= t) ? p0[j] * __expf(ct - scum[rh * 64 + s0]) * sdt[s0 * 8 + rh] : 0.f;
                    pv[4 + j] = (r ? s1 >= t : s1 <= t) ? p1[j] * __expf(ct - scum[rh * 64 + s1]) * sdt[s1 * 8 + rh] : 0.f; }
                const bf16x8 pf = pack8(pv);
#pragma unroll
                for (int d = 0; d < 4; ++d) y[m][d] = MFMA16(pf, xf[sg][d], y[m][d]);
            }
        }
        __syncthreads();
        LAS float* yx = (LAS float*)(F.lds + SD_RAW);
        if (r == 1) {
#pragma unroll
            for (int m = 0; m < 4; ++m)
#pragma unroll
                for (int d = 0; d < 4; ++d)
#pragma unroll
                    for (int j = 0; j < 4; ++j) yx[(16 * m + 4 * g + j) * 260 + h * 64 + 16 * d + lr] = y[m][d][j];
        }
        __syncthreads();
        if (r == 0) { const float dsk = a.in[I_SSDD][L * 4 + h];
#pragma unroll
            for (int m = 0; m < 4; ++m)
#pragma unroll
                for (int d = 0; d < 4; ++d)
#pragma unroll
                    for (int j = 0; j < 4; ++j) { const int t = 16 * m + 4 * g + j, c = h * 64 + 16 * d + lr; yx[t * 260 + c] += y[m][d][j] + dsk * bf2f(xc[t * SD_RS + c]); asm volatile("" ::: "memory"); }
        }
        __syncthreads();
        if constexpr (OUT) {
        { const int t = F.tid >> 3, c0 = (F.tid & 7) * 32; const bf16* zr = PB + (size_t)(tok0 + t) * PW + PC_Z + c0; const float* ng = a.in[I_SSDNG] + L * 256 + c0;
          float v[32]; float ss = 0.f;
#pragma unroll
          for (int q = 0; q < 4; ++q) { float zv[8]; unpack8(*(const bf16x8*)(zr + 8 * q), zv);
#pragma unroll
              for (int e = 0; e < 8; ++e) { const float u = yx[t * 260 + c0 + 8 * q + e] * siluf_(zv[e]); v[8 * q + e] = u; ss += u * u; } }
          ss += swz_xor<1>(ss); ss += swz_xor<2>(ss); ss += swz_xor<4>(ss);
          const float rs = rsqrtf(ss * (1.f / 256.f) + 1e-6f);
          bf16* MX = (bf16*)(F.ws + WS_MIX) + (size_t)(tok0 + t) * MW + 1024 + c0;
#pragma unroll
          for (int q = 0; q < 4; ++q) { float o8[8];
#pragma unroll
              for (int e = 0; e < 8; ++e) o8[e] = v[8 * q + e] * rs * ng[8 * q + e];
              *(bf16x8*)(MX + 8 * q) = pack8(o8); } }
        } else {
            { const int t = F.tid >> 3, c0 = (F.tid & 7) * 32; bf16* yo = (bf16*)(F.ws + WS_SYI) + (size_t)(tok0 + t) * 256 + c0;
#pragma unroll
              for (int q = 0; q < 4; ++q) { float o8[8];
#pragma unroll
                  for (int e = 0; e < 8; ++e) o8[e] = yx[t * 260 + c0 + 8 * q + e];
                  *(bf16x8*)(yo + 8 * q) = pack8(o8); } }
            { bf16* cb = (bf16*)(F.ws + WS_SCB) + (size_t)tok0 * 128;
#pragma unroll
              for (int k = 0; k < 2; ++k) { const int i = F.tid + k * NTHR, t = i >> 4, pc = i & 15; *(u32x4*)(cb + (size_t)t * 128 + pc * 8) = *(const LAS u32x4*)(xc + t * SD_RS + 384 + pc * 8); } }
            { const int t = F.tid >> 3, q = F.tid & 7; ((float*)(F.ws + WS_SCUM))[(size_t)(tok0 + t) * 8 + q] = scum[q * 64 + t]; }
        }
    }
}


__device__ __forceinline__ void ssd_light(Frame& F0, CArgs& a, int L, int cid) {
    LAUNDER_F(F0)
    const int tok0 = chunk_tok0(cid), h = F.wave & 3, r = F.wave >> 2, lr = F.lane & 15, g = F.lane >> 4, gp = h >> 1, rh = r * 4 + h;
    const bf16* cb = (const bf16*)(F.ws + WS_SCB) + (size_t)tok0 * 128; const float* cum = (const float*)(F.ws + WS_SCUM) + (size_t)tok0 * 8;
    const bf16* se = (const bf16*)(F.ws + WS_SSE) + (((size_t)cid * 4 + h) * 2 + r) * 4096;
    bf16x8 cfr[4][2], sfr[4][2]; float ec[4];
#pragma unroll
    for (int m = 0; m < 4; ++m) { ec[m] = cum[(size_t)(16 * m + lr) * 8 + rh];
#pragma unroll
        for (int ks = 0; ks < 2; ++ks) cfr[m][ks] = *(const bf16x8*)(cb + (size_t)(16 * m + lr) * 128 + gp * 64 + 32 * ks + 8 * g); }
#pragma unroll
    for (int d = 0; d < 4; ++d) { sfr[d][0] = *(const bf16x8*)(se + (16 * d + lr) * 64 + 8 * g); sfr[d][1] = *(const bf16x8*)(se + (16 * d + lr) * 64 + 32 + 8 * g); }
    const int tt = F.tid >> 3, c0 = (F.tid & 7) * 32;
    bf16x8 zr[4], yi[4];
    { const bf16* zp = (const bf16*)(F.ws + WS_PBUF) + (size_t)(tok0 + tt) * PW + PC_Z + c0; const bf16* yp = (const bf16*)(F.ws + WS_SYI) + (size_t)(tok0 + tt) * 256 + c0;
#pragma unroll
      for (int q = 0; q < 4; ++q) { zr[q] = *(const bf16x8*)(zp + 8 * q); yi[q] = *(const bf16x8*)(yp + 8 * q); } }
    f32x4 y[4][4];
#pragma unroll
    for (int m = 0; m < 4; ++m) { const float e_ = __expf(ec[m]); bf16x8 cs[2];
#pragma unroll
        for (int ks = 0; ks < 2; ++ks) { float cv[8]; unpack8(cfr[m][ks], cv);
#pragma unroll
            for (int e = 0; e < 8; ++e) cv[e] *= e_;
            cs[ks] = pack8(cv); }
#pragma unroll
        for (int d = 0; d < 4; ++d) { y[m][d] = MFMA16(cs[0], sfr[d][0], ((f32x4){0.f, 0.f, 0.f, 0.f})); y[m][d] = MFMA16(cs[1], sfr[d][1], y[m][d]); } }
    LAS float* yx = (LAS float*)(F.lds + SD_RAW);
    __syncthreads();
    if (r == 1) {
#pragma unroll
        for (int m = 0; m < 4; ++m)
#pragma unroll
            for (int d = 0; d < 4; ++d)
#pragma unroll
                for (int j = 0; j < 4; ++j) yx[(16 * m + 4 * g + j) * 260 + h * 64 + 16 * d + lr] = y[m][d][j];
    }
    __syncthreads();
    if (r == 0) {
#pragma unroll
        for (int m = 0; m < 4; ++m)
#pragma unroll
            for (int d = 0; d < 4; ++d)
#pragma unroll
                for (int j = 0; j < 4; ++j) yx[(16 * m + 4 * g + j) * 260 + h * 64 + 16 * d + lr] += y[m][d][j];
    }
    __syncthreads();
    { const float* ng = a.in[I_SSDNG] + L * 256 + c0;
      float v[32]; float ss = 0.f;
#pragma unroll
      for (int q = 0; q < 4; ++q) { float zv[8], yv[8]; unpack8(zr[q], zv); unpack8(yi[q], yv);
#pragma unroll
          for (int e = 0; e < 8; ++e) { const float u = (yx[tt * 260 + c0 + 8 * q + e] + yv[e]) * siluf_(zv[e]); v[8 * q + e] = u; ss += u * u; } }
      ss += swz_xor<1>(ss); ss += swz_xor<2>(ss); ss += swz_xor<4>(ss);
      const float rs = rsqrtf(ss * (1.f / 256.f) + 1e-6f);
      bf16* MX = (bf16*)(F.ws + WS_MIX) + (size_t)(tok0 + tt) * MW + 1024 + c0;
#pragma unroll
      for (int q = 0; q < 4; ++q) { float o8[8];
#pragma unroll
          for (int e = 0; e < 8; ++e) o8[e] = v[8 * q + e] * rs * ng[8 * q + e];
          *(bf16x8*)(MX + 8 * q) = pack8(o8); } }
}

constexpr int FF_XP = 0, FF_TR = FF_XP + 16 * 64 * 16 * 2, FF_TI = FF_TR + 16 * 64 * 16 * 2, FF_TW = FF_TI + 16 * 64 * 16 * 2, FF_FT = FF_TW + 64 * 16 * 8, FF_END = FF_FT + 2 * 64 * 72 * 2;
static_assert(FF_END <= MISC_OFF, "FFT LDS");
__device__ __forceinline__ void fft_unit(Frame& F0, int u) {
    LAUNDER_F(F0)
    const int b = u >> 6, cg = (u >> 2) & 15, kb = u & 3, lr = F.lane & 15, g = F.lane >> 4;
    const bf16* PB = (const bf16*)(F.ws + WS_PBUF) + (size_t)b * SEQ * PW + PC_FU + 16 * cg;
    const bf16* f64 = (const bf16*)(F.ws + WS_TAB + TAB_F64); const float* tw = (const float*)(F.ws + WS_TAB + TAB_TW);
    LAS bf16* xp = (LAS bf16*)(F.lds + FF_XP); LAS bf16* tr = (LAS bf16*)(F.lds + FF_TR); LAS bf16* ti = (LAS bf16*)(F.lds + FF_TI);
    LAS float* stw = (LAS float*)(F.lds + FF_TW);
    LAS bf16* sft = (LAS bf16*)(F.lds + FF_FT);
    bf16x8 fc1[2], fs1[2];
#pragma unroll
    for (int ks = 0; ks < 2; ++ks) { fc1[ks] = *(const bf16x8*)(f64 + (16 * kb + lr) * 64 + 32 * ks + 8 * g); fs1[ks] = *(const bf16x8*)(f64 + 4096 + (16 * kb + lr) * 64 + 32 * ks + 8 * g); }
    const f32x4 zero4 = (f32x4){0.f, 0.f, 0.f, 0.f};
    u32x4 xr[4], ft[2]; f32x2 twr[2];
#pragma unroll
    for (int k = 0; k < 4; ++k) { const int i = F.tid + k * NTHR, n2l = i >> 7, n1 = (i >> 1) & 63, hf = i & 1; xr[k] = *(const u32x4*)(PB + (size_t)(64 * n1 + n2l) * PW + hf * 8); }
#pragma unroll
    for (int k = 0; k < 2; ++k) { const int i = F.tid + k * NTHR; ft[k] = *(const u32x4*)(f64 + (size_t)i * 8); twr[k] = *(const f32x2*)(tw + 2 * ((i >> 4) * (16 * kb + (i & 15)))); }
    __syncthreads();
#pragma unroll
    for (int k = 0; k < 2; ++k) { const int i = F.tid + k * NTHR, row = i >> 3, pc = i & 7; *(LAS u32x4*)(sft + row * 72 + pc * 8) = ft[k]; stw[2 * i] = twr[k][0]; stw[2 * i + 1] = twr[k][1]; }
    for (int pa = 0; pa < 4; ++pa) {
        if (pa) __syncthreads();
#pragma unroll
        for (int k = 0; k < 4; ++k) { const int i = F.tid + k * NTHR, n2l = i >> 7, n1 = (i >> 1) & 63, hf = i & 1; *(LAS u32x4*)(xp + (n2l * 64 + n1) * 16 + hf * 8) = xr[k]; }
        if (pa < 3) {
#pragma unroll
            for (int k = 0; k < 4; ++k) { const int i = F.tid + k * NTHR, n2l = i >> 7, n1 = (i >> 1) & 63, hf = i & 1; xr[k] = *(const u32x4*)(PB + (size_t)(64 * n1 + 16 * (pa + 1) + n2l) * PW + hf * 8); }
        }
        __syncthreads();
#pragma unroll
        for (int q = 0; q < 2; ++q) {
            const int n2l = 2 * F.wave + q, n2 = 16 * pa + n2l;
            f32x4 tc = zero4, ts = zero4;
#pragma unroll
            for (int ks = 0; ks < 2; ++ks) { const LAS bf16* p0 = xp + (n2l * 64 + 32 * ks + 8 * g + ((F.lane & 15) >> 2)) * 16 + 4 * (F.lane & 3); const bf16x8 xb = cat8(trread(p0), trread(p0 + 4 * 16));
                tc = MFMA16(fc1[ks], xb, tc); ts = MFMA16(fs1[ks], xb, ts); }
#pragma unroll
            for (int j = 0; j < 4; ++j) { const int k1l = 4 * g + j; const f32x2 w = *(const LAS f32x2*)(stw + 2 * (n2 * 16 + k1l));
                tr[(k1l * 64 + n2) * 16 + lr] = (bf16)f2bf(tc[j] * w[0] - ts[j] * w[1]); ti[(k1l * 64 + n2) * 16 + lr] = (bf16)f2bf(-(tc[j] * w[1] + ts[j] * w[0])); }
        }
    }
    __syncthreads();
    bf16* MX0 = (bf16*)(F.ws + WS_MIX) + (size_t)b * SEQ * MW + 16 * cg;
    LAS bf16* so = xp + F.wave * 2048;
#pragma unroll
    for (int q = 0; q < 2; ++q) {
        const int k1l = 2 * F.wave + q, k1 = 16 * kb + k1l;
        bf16x8 br[2], bi[2];
#pragma unroll
        for (int ks = 0; ks < 2; ++ks) { const int off = (k1l * 64 + 32 * ks + 8 * g + ((F.lane & 15) >> 2)) * 16 + 4 * (F.lane & 3); br[ks] = cat8(trread(tr + off), trread(tr + off + 64)); bi[ks] = cat8(trread(ti + off), trread(ti + off + 64)); }
#pragma unroll
        for (int m = 0; m < 4; ++m) {
            f32x4 yr = zero4, y1 = zero4, y2 = zero4;
#pragma unroll
            for (int ks = 0; ks < 2; ++ks) { const bf16x8 fc = *(const LAS bf16x8*)(sft + (16 * m + lr) * 72 + 32 * ks + 8 * g), fs = *(const LAS bf16x8*)(sft + (64 + 16 * m + lr) * 72 + 32 * ks + 8 * g);
                yr = MFMA16(fc, br[ks], yr); yr = MFMA16(fs, bi[ks], yr); y1 = MFMA16(fc, bi[ks], y1); y2 = MFMA16(fs, br[ks], y2); }
#pragma unroll
            for (int j = 0; j < 4; ++j) { const int k2 = 16 * m + 4 * g + j; so[k2 * 32 + lr] = (bf16)f2bf(yr[j] * (1.f / 64.f)); so[k2 * 32 + 16 + lr] = (bf16)f2bf((y1[j] - y2[j]) * (1.f / 64.f)); }
        }
#pragma unroll
        for (int p = 0; p < 4; ++p) { const int pc = F.lane + 64 * p, k2 = pc >> 2, part = pc & 3;
            const u32x4 v = *(const LAS u32x4*)(so + k2 * 32 + (part >> 1) * 16 + (part & 1) * 8);
            *(u32x4*)(MX0 + (size_t)(64 * k2 + k1) * MW + (part >> 1) * 256 + (part & 1) * 8) = v; }
    }
}
constexpr int CD_RS = 264;
static_assert(256 * CD_RS * 2 <= MISC_OFF, "ctx DFT LDS");
__device__ __forceinline__ void dft_ctx_unit(Frame& F0, int u) {
    LAUNDER_F(F0)
    const int b = u >> 3, kb = u & 7, lr = F.lane & 15, g = F.lane >> 4;
    LAS bf16* sl = (LAS bf16*)F.lds;
    const bf16* PB = (const bf16*)(F.ws + WS_PBUF) + (size_t)(NLAT + b * CTXL) * PW + PC_FU;
    const bf16* dc = (const bf16*)(F.ws + WS_DFTC);
    __syncthreads();
#pragma unroll
    for (int h = 0; h < 2; ++h) { u32x4 v[8];
#pragma unroll
        for (int k = 0; k < 8; ++k) { const int i = F.tid + (h * 8 + k) * NTHR, n = i >> 5, pc = i & 31; v[k] = *(const u32x4*)(PB + (size_t)n * PW + pc * 8); }
#pragma unroll
        for (int k = 0; k < 8; ++k) { const int i = F.tid + (h * 8 + k) * NTHR, n = i >> 5, pc = i & 31; *(LAS u32x4*)(sl + n * CD_RS + pc * 8) = v[k]; } }
    __syncthreads();
    f32x4 acc[4][2];
#pragma unroll
    for (int mt = 0; mt < 4; ++mt)
#pragma unroll
        for (int nt = 0; nt < 2; ++nt) acc[mt][nt] = (f32x4){0.f, 0.f, 0.f, 0.f};
#pragma unroll 2
    for (int ks = 0; ks < 8; ++ks) {
        bf16x8 af[4], bfm[2];
#pragma unroll
        for (int mt = 0; mt < 4; ++mt) af[mt] = *(const bf16x8*)(dc + (size_t)((mt >> 1) * 256 + 32 * kb + 16 * (mt & 1) + lr) * 256 + 32 * ks + 8 * g);
#pragma unroll
        for (int nt = 0; nt < 2; ++nt) { const LAS bf16* p0 = sl + (32 * ks + 8 * g + ((F.lane & 15) >> 2)) * CD_RS + 32 * F.wave + 16 * nt + 4 * (F.lane & 3); bfm[nt] = cat8(trread(p0), trread(p0 + 4 * CD_RS)); }
#pragma unroll
        for (int mt = 0; mt < 4; ++mt)
#pragma unroll
            for (int nt = 0; nt < 2; ++nt) acc[mt][nt] = MFMA16(af[mt], bfm[nt], acc[mt][nt]);
    }
    bf16* MX = (bf16*)(F.ws + WS_MIX) + (size_t)(NLAT + b * CTXL + 32 * kb) * MW + 32 * F.wave + lr;
#pragma unroll
    for (int mt = 0; mt < 4; ++mt)
#pragma unroll
        for (int nt = 0; nt < 2; ++nt)
#pragma unroll
            for (int j = 0; j < 4; ++j) MX[(size_t)(16 * (mt & 1) + 4 * g + j) * MW + (mt >> 1) * 256 + 16 * nt] = (bf16)f2bf(acc[mt][nt][j] * (1.f / 16.f));
}

#ifndef SUBMASK
#define SUBMASK 0xFFFF
#endif
#define SUB(bit) (rep == 0 || ((SUBMASK >> (bit)) & 1))
__device__ __forceinline__ void p_mix_a(Frame& F, CArgs& a, int L, int rep = 0) {
    if (SUB(0)) {
        pg8::Gemm g{(const bf16*)(F.ws + WS_A2), (const bf16*)(F.ws + WS_S5P) + (size_t)L * 16 * 256 * 256, 1024, 512, OPQ(256)};
        SgOrder<FillS5> S; S.init(144, 1, F.G, F.bid); S.f = FillS5{(size_t)256 * 256 * 2};
        EpiS5S E{(float*)(F.ws + WS_S5S)};
        pg8::gemm_phase(F.lds, g, S, E, fresh_tid(F.wave));
    }
    const int og = F.G >= 208 ? 144 : 0, os = F.G >= 208 ? 176 : 32 % F.G;
    if (SUB(1)) for (int u = (F.bid + F.G - og) % F.G; u < NCHK; u += F.G) gla_chunk<MIX_P1 ? 2 : 0>(F, a, L, u);
    if (SUB(2)) for (int u = (F.bid + F.G - os) % F.G; u < NCHK; u += F.G) ssd_chunk<MIX_P1 ? 2 : 0>(F, a, L, u);
    __syncthreads();
}
__device__ __forceinline__ void p_mix_b(Frame& F, CArgs& a, int L, int rep = 0) {
    if (SUB(3)) for (int u = F.bid; u < 256; u += F.G) {
        const int vz = F.tid >> 9, uv = u + vz, wv = (F.tid >> 6);
        const int b = uv >> 5, g = (uv >> 1) & 15, r = uv & 1;
        const f32x2 a16 = *(const f32x2*)((const float*)(F.ws + WS_A16) + ((size_t)((L * 2 + r) * 16 + g) * 64 + F.lane) * 2);
        const float* S = (const float*)(F.ws + WS_S5S) + (size_t)g * S5ROWS * 256 + r * 128 + F.lane; bf16* A2 = (bf16*)(F.ws + WS_A2) + (size_t)g * S5ROWS * 512 + 256 + r * 128 + F.lane;
        LAS float* ex = (LAS float*)F.lds;
        LAS float* sl = ex + 17 * 128;
        __syncthreads();
#pragma unroll 1
        for (int sg = wv; sg < 17; sg += 8) {
            float sr[16], si[16];
#pragma unroll
            for (int n = 0; n < 16; ++n) { const int i = 16 * sg + n; const int row = i < 16 ? 2048 + 16 * b + (r ? 15 - i : i) : 256 * b + (r ? 271 - i : i - 16); sr[n] = S[(size_t)row * 256]; si[n] = S[(size_t)row * 256 + 64]; }
            float hr = 0.f, hi = 0.f;
#pragma unroll
            for (int n = 0; n < 16; ++n) { sl[((16 * sg + n) * 64 + F.lane) * 2] = sr[n]; sl[((16 * sg + n) * 64 + F.lane) * 2 + 1] = si[n];
                const float nr = a16[0] * hr - a16[1] * hi + sr[n], ni = a16[0] * hi + a16[1] * hr + si[n]; hr = nr; hi = ni; }
            ex[(sg * 64 + F.lane) * 2] = hr; ex[(sg * 64 + F.lane) * 2 + 1] = hi;
        }
        __syncthreads();
        float pr = a16[0], pi = a16[1];
#pragma unroll
        for (int q = 0; q < 4; ++q) { const float nr = pr * pr - pi * pi, ni = 2.f * pr * pi; pr = nr; pi = ni; }
#pragma unroll 1
        for (int sg = wv; sg < 17; sg += 8) {
            float hr = 0.f, hi = 0.f;
            for (int j = 0; j < sg; ++j) { const float er = ex[(j * 64 + F.lane) * 2], ei = ex[(j * 64 + F.lane) * 2 + 1]; const float nr = pr * hr - pi * hi + er, ni = pr * hi + pi * hr + ei; hr = nr; hi = ni; }
#pragma unroll 4
            for (int n = 0; n < 16; ++n) { const int i = 16 * sg + n; const int row = i < 16 ? 2048 + 16 * b + (r ? 15 - i : i) : 256 * b + (r ? 271 - i : i - 16);
                A2[(size_t)row * 512] = (bf16)f2bf(hr); A2[(size_t)row * 512 + 64] = (bf16)f2bf(hi);
                const float xr_ = sl[(i * 64 + F.lane) * 2], xi_ = sl[(i * 64 + F.lane) * 2 + 1];
                const float nr = a16[0] * hr - a16[1] * hi + xr_, ni = a16[0] * hi + a16[1] * hr + xi_; hr = nr; hi = ni; }
        }
    }
    if (F.G == 256) {
        if (SUB(3)) { const int vz = F.tid >> 9;
            const int ug = F.bid + vz, sqg = ug >> 2, bg = sqg >> 3, hg = (sqg >> 1) & 3, rg = sqg & 1, eg = (ug & 3) * 512 + F.tid, cg = eg & 31;
            const int u0 = F.bid + vz, s0q = u0 >> 3, b0 = s0q >> 3, h0 = (s0q >> 1) & 3, r0 = s0q & 1, e0 = (u0 & 7) * 512 + F.tid;
            const int u1 = F.bid + 256 + vz, s1q = u1 >> 3, b1 = s1q >> 3, h1 = (s1q >> 1) & 3, r1 = s1q & 1, e1 = (u1 & 7) * 512 + F.tid;
            const float* gds = (const float*)(F.ws + WS_GDS); const float* gdc = (const float*)(F.ws + WS_GDEC); bf16* gse = (bf16*)(F.ws + WS_GSE);
            const float* sds = (const float*)(F.ws + WS_SDS); const float* sdc = (const float*)(F.ws + WS_SDEC); bf16* sse = (bf16*)(F.ws + WS_SSE);
            float sg_ = 0.f, s0_ = 0.f, s1_ = 0.f;
#define SCAN_CID(i, b, r) ((i) < 4 ? 512 + (b) * 4 + ((r) ? 3 - (i) : (i)) : (b) * 64 + ((r) ? 67 - (i) : (i) - 4))
            for (int i0 = 0; i0 < 68; i0 += 17) { float gv_[17], gc_[17], av_[17], ac_[17], bv_[17], bc_[17];
#pragma unroll
                for (int k = 0; k < 17; ++k) { const int i = i0 + k;
                    { const size_t ub = ((size_t)SCAN_CID(i, bg, rg) * 4 + hg) * 2 + rg; gv_[k] = gds[ub * 2048 + eg]; gc_[k] = gdc[ub * 32 + cg]; }
                    { const size_t ub = ((size_t)SCAN_CID(i, b0, r0) * 4 + h0) * 2 + r0; av_[k] = sds[ub * 4096 + e0]; ac_[k] = sdc[ub]; }
                    { const size_t ub = ((size_t)SCAN_CID(i, b1, r1) * 4 + h1) * 2 + r1; bv_[k] = sds[ub * 4096 + e1]; bc_[k] = sdc[ub]; } }
#pragma unroll
                for (int k = 0; k < 17; ++k) { const int i = i0 + k;
                    { const size_t ub = ((size_t)SCAN_CID(i, bg, rg) * 4 + hg) * 2 + rg; gse[ub * 2048 + eg] = (bf16)f2bf(sg_); sg_ = gc_[k] * sg_ + gv_[k]; }
                    { const size_t ub = ((size_t)SCAN_CID(i, b0, r0) * 4 + h0) * 2 + r0; sse[ub * 4096 + e0] = (bf16)f2bf(s0_); s0_ = ac_[k] * s0_ + av_[k]; }
                    { const size_t ub = ((size_t)SCAN_CID(i, b1, r1) * 4 + h1) * 2 + r1; sse[ub * 4096 + e1] = (bf16)f2bf(s1_); s1_ = bc_[k] * s1_ + bv_[k]; } } }
#undef SCAN_CID
        }
    } else {
    if (SUB(3)) for (int u = F.bid; u < 256; u += F.G) { const int uv = u + (F.tid >> 9), sq = uv >> 2, b = sq >> 3, hh = (sq >> 1) & 3, r = sq & 1, e = (uv & 3) * 512 + F.tid, c = e & 31;
        const float* ds = (const float*)(F.ws + WS_GDS); const float* dc = (const float*)(F.ws + WS_GDEC); bf16* se = (bf16*)(F.ws + WS_GSE);
        float s = 0.f;
        for (int i0 = 0; i0 < 68; i0 += 17) { float dv[17], cv[17];
#pragma unroll
            for (int k = 0; k < 17; ++k) { const int i = i0 + k; const int cid = i < 4 ? 512 + b * 4 + (r ? 3 - i : i) : b * 64 + (r ? 67 - i : i - 4); const size_t ub = ((size_t)cid * 4 + hh) * 2 + r; dv[k] = ds[ub * 2048 + e]; cv[k] = dc[ub * 32 + c]; }
#pragma unroll
            for (int k = 0; k < 17; ++k) { const int i = i0 + k; const int cid = i < 4 ? 512 + b * 4 + (r ? 3 - i : i) : b * 64 + (r ? 67 - i : i - 4); const size_t ub = ((size_t)cid * 4 + hh) * 2 + r; se[ub * 2048 + e] = (bf16)f2bf(s); s = cv[k] * s + dv[k]; } } }
    if (SUB(3)) for (int u = F.bid; u < 512; u += F.G) { const int uv = u + (F.tid >> 9), sq = uv >> 3, b = sq >> 3, h = (sq >> 1) & 3, r = sq & 1, e = (uv & 7) * 512 + F.tid;
        const float* ds = (const float*)(F.ws + WS_SDS); const float* dc = (const float*)(F.ws + WS_SDEC); bf16* se = (bf16*)(F.ws + WS_SSE);
        float s = 0.f;
        for (int i0 = 0; i0 < 68; i0 += 17) { float dv[17], cv[17];
#pragma unroll
            for (int k = 0; k < 17; ++k) { const int i = i0 + k; const int cid = i < 4 ? 512 + b * 4 + (r ? 3 - i : i) : b * 64 + (r ? 67 - i : i - 4); const size_t ub = ((size_t)cid * 4 + h) * 2 + r; dv[k] = ds[ub * 4096 + e]; cv[k] = dc[ub]; }
#pragma unroll
            for (int k = 0; k < 17; ++k) { const int i = i0 + k; const int cid = i < 4 ? 512 + b * 4 + (r ? 3 - i : i) : b * 64 + (r ? 67 - i : i - 4); const size_t ub = ((size_t)cid * 4 + h) * 2 + r; se[ub * 4096 + e] = (bf16)f2bf(s); s = cv[k] * s + dv[k]; } } }
    }
    if (SUB(4)) for (int u = F.bid; u < 512; u += F.G) fft_unit(F, u);
    if (SUB(5)) for (int u = (F.bid + 64) % F.G; u < 64; u += F.G) dft_ctx_unit(F, u);
    __syncthreads();
}
__device__ __forceinline__ void p_mix_c(Frame& F, CArgs& a, int L, int rep = 0) {
#ifndef MIXC_PARTS
#define MIXC_PARTS 7
#endif
    if ((MIXC_PARTS & 1) && SUB(6)) {
        pg8::Gemm g{(const bf16*)(F.ws + WS_A2), (const bf16*)(F.ws + WS_S5B2) + (size_t)L * 16 * 256 * 512, 1024, 1024, OPQ(512)};
        SgOrder<FillS5> S; S.init(144, 1, F.G, F.bid); S.f = FillS5{(size_t)256 * 512 * 2};
        EpiS5Y E{(bf16*)(F.ws + WS_ACT5)};
        pg8::gemm_phase(F.lds, g, S, E, fresh_tid(F.wave));
    }
    const int nch = (L == DEPTH - 1) ? 512 : NCHK;
    const int og = F.G >= 208 ? 144 : 0, os = F.G >= 208 ? 176 : 32 % F.G;
    if ((MIXC_PARTS & 2) && SUB(7)) for (int u = (F.bid + F.G - og) % F.G; u < nch; u += F.G) { if constexpr (MIX_P1) gla_light(F, a, L, u); else gla_chunk<1>(F, a, L, u); }
    if ((MIXC_PARTS & 4) && SUB(8)) for (int u = (F.bid + F.G - os) % F.G; u < nch; u += F.G) { if constexpr (MIX_P1) ssd_light(F, a, L, u); else ssd_chunk<1>(F, a, L, u); }
    __syncthreads();
}

constexpr int NPH = 11, PH_TOTAL = 2 + DEPTH * NPH;
#ifndef PHASE_MASK
#define PHASE_MASK 0xFFFF
#endif
#define PM(i) ((PHASE_MASK >> (i)) & 1)
#ifndef DUP_MASK
#define DUP_MASK 0
#endif
#define NREP(k) (((DUP_MASK >> (k)) & 1) ? 2 : 1)
#ifndef MK_ONE_LAUNCH
#define MK_ONE_LAUNCH 0
#endif

__global__ void __launch_bounds__(NTHR, 2) mk_fwd(Args args_by_value) {
#define args (*fresh_args())
    extern __shared__ __attribute__((aligned(16))) unsigned char lds_raw[];
    Frame F;
    F.lds = (LAS unsigned char*)lds_raw; F.MISC = (volatile LAS unsigned*)(F.lds + MISC_OFF);
    F.tid = threadIdx.x; F.lane = F.tid & 63; F.wave = __builtin_amdgcn_readfirstlane(F.tid >> 6); F.G = gridDim.x; F.bid = blockIdx.x;
    F.ws = args_by_value.ws; F.ctl = (unsigned*)(args_by_value.ws + WS_CTL);
    if (F.tid < 64) F.MISC[F.tid] = 0u;
    __syncthreads();
#if MK_ONE_LAUNCH
    XcdBarrier bar = xcd_barrier_post(F.ctl + CW_BAR, F.MISC + 8);
#define GRID_BAR() xcd_barrier(bar)
#else
#define GRID_BAR() do { } while (0)
#endif
    const int lo = args_by_value.ph_lo, hi = args_by_value.ph_hi;
#define IN(k) (lo <= (k) && (k) < hi)
#define FRESH() do { const int t_ = fresh_tid(F.wave); F.tid = t_; F.lane = t_ & 63; } while (0)
#define SEAM(k) do { if (IN(k) && IN((k) + 1)) GRID_BAR(); } while (0)
    if (PM(0) && IN(0)) { FRESH(); p_prologue(F, args); }
#ifdef DUP_PROLOGUE
    GRID_BAR(); if (PM(0) && IN(0)) { FRESH(); p_prologue(F, args, CW_QUEUE + 64); }
#endif
    SEAM(0);
    {
        const int pb = 1 + 0 * NPH;
        const int mrows = (0 == DEPTH - 1) ? NLAT : NT;
        if (PM(1) && IN(pb + 0)) { FRESH(); p_norm1(F, args, OPQ(0)); }
#ifdef DUP_NORM1
        GRID_BAR(); if (PM(1) && IN(pb + 0)) { FRESH(); p_norm1(F, args, OPQ(0), true); }
#endif
 SEAM(pb + 0);
        if (PM(2) && IN(pb + 1)) for (int rep_ = 0; rep_ < NREP(2); ++rep_) { if (rep_) GRID_BAR(); const int Lg = OPQ(0);
#if INPROJ_F8
            pg8::Gemm g{F.ws + WS_H8, F.ws + WS_WIN + (size_t)Lg * PW * DM, DM, DM, OPQ(DM / 2)};
            SgOrder<FillPlain> S; S.init(NT / 256, PW / 256, F.G, F.bid); S.f = FillPlain{(size_t)256 * DM, (size_t)256 * DM};
            EpiInproj E{(bf16*)(F.ws + WS_PBUF), (bf16*)(F.ws + WS_A2)};
            pg8::gemm_phase<EpiInproj, SgOrder<FillPlain>, true, F8_ALIGN, F8_SP2>(F.lds, g, S, E, fresh_tid(F.wave));
#else
            pg8::Gemm g{(const bf16*)(F.ws + WS_H), (const bf16*)(F.ws + WS_WIN) + (size_t)Lg * PW * DM, DM * 2, DM * 2, OPQ(DM)};
            SgOrder<FillPlain> S; S.init(NT / 256, PW / 256, F.G, F.bid); S.f = FillPlain{(size_t)256 * DM * 2, (size_t)256 * DM * 2};
            EpiInproj E{(bf16*)(F.ws + WS_PBUF), (bf16*)(F.ws + WS_A2)};
            pg8::gemm_phase(F.lds, g, S, E, fresh_tid(F.wave));
#endif
        }
#if defined(SHADOW_IN)
        if (PM(2) && IN(pb + 1)) { GRID_BAR(); const int Lg = OPQ(0);
            pg8::Gemm g{(const bf16*)(F.ws + WS_H), (const bf16*)(F.ws + WS_WIN) + (size_t)Lg * PW * DM, DM * 2, DM * 2, OPQ(DM)};
            SgOrder<FillPlain> S; S.init(NT / 256, PW / 256, F.G, F.bid); S.f = FillPlain{(size_t)256 * DM * 2, (size_t)256 * DM * 2};
            EpiNull E{(float*)(F.ws + WS_Y)};
            pg8::gemm_phase(F.lds, g, S, E, fresh_tid(F.wave));
        }
#endif
        SEAM(pb + 1);
        if (PM(3) && IN(pb + 2)) for (int rep_ = 0; rep_ < NREP(3); ++rep_) { if (rep_) GRID_BAR(); FRESH(); p_mix_a(F, args, OPQ(0), rep_); } SEAM(pb + 2);
        if (PM(4) && IN(pb + 3)) for (int rep_ = 0; rep_ < NREP(4); ++rep_) { if (rep_) GRID_BAR(); FRESH(); p_mix_b(F, args, OPQ(0), rep_); } SEAM(pb + 3);
        if (PM(5) && IN(pb + 4)) for (int rep_ = 0; rep_ < NREP(5); ++rep_) { if (rep_) GRID_BAR(); FRESH(); p_mix_c(F, args, OPQ(0), rep_); } SEAM(pb + 4);
        if (PM(6) && IN(pb + 5)) for (int rep_ = 0; rep_ < NREP(6); ++rep_) { if (rep_) GRID_BAR(); const int Lg = OPQ(0);
            pg8::Gemm g{(const bf16*)(F.ws + WS_ACT5), (const bf16*)(F.ws + WS_WGLU) + (size_t)Lg * 256 * 256, 512, 512, OPQ(256)};
            SgOrder<FillPlain> S; S.init(NT / 256, 1, F.G, F.bid); S.f = FillPlain{(size_t)256 * 256 * 2, 0};
            EpiGlu E{(const bf16*)(F.ws + WS_ACT5), (bf16*)(F.ws + WS_MIX)};
            pg8::gemm_phase(F.lds, g, S, E, fresh_tid(F.wave));
        } SEAM(pb + 5);
        if (PM(7) && IN(pb + 6)) { const int Lg = OPQ(0);
            pg8::Gemm g{(const bf16*)(F.ws + WS_MIX), (const bf16*)(F.ws + WS_WOUT) + (size_t)Lg * DM * MW, MW * 2, MW * 2, OPQ(MW)};
            SgOrder<FillPlain> S; S.init((Lg == DEPTH - 1 ? NLAT : NT) / 256, DM / 256, F.G, F.bid); S.f = FillPlain{(size_t)256 * MW * 2, (size_t)256 * MW * 2};
            EpiOutproj E{args.in[I_X], args.in[I_CTX], (bf16*)(F.ws + WS_XS), (const float*)(F.ws + WS_MOD) + (size_t)Lg * 9 * 6144, Lg == 0 ? 1 : 0};
            pg8::gemm_phase(F.lds, g, S, E, fresh_tid(F.wave));
        } SEAM(pb + 6);
        if (PM(8) && IN(pb + 7)) { FRESH(); p_norm2(F, args, OPQ(0), OPQ(mrows)); }
#ifdef DUP_NORM2
        GRID_BAR(); if (PM(8) && IN(pb + 7)) { FRESH(); p_norm2(F, args, OPQ(0), OPQ(mrows), 6400); }
#endif
 SEAM(pb + 7);
        if (PM(10) && IN(pb + 9)) { const int Lg = OPQ(0); FRESH();
            const int nblk = moe_tables(F, Lg);
            LAS int* lbs = (LAS int*)(F.lds + MOE_LB); LAS int* lcs = (LAS int*)(F.lds + MOE_LC); LAS unsigned* gat = (LAS unsigned*)(F.lds + MOE_GAT);
            SgOrder<FillMoe> S; S.init(nblk, 8, F.G, F.bid); S.f = FillMoe{(const LAS unsigned*)(F.lds + MOE_LBLK), 2048};
            { const int* TM = (const int*)(F.ws + WS_TM); const float* PG = (const float*)(F.ws + WS_PG); int* PS = (int*)(F.ws + WS_PS); float* SG = (float*)(F.ws + WS_SG);
              const int half = F.tid >> 8, rowi = F.tid & 255; int ids[MOE_MAXU / 2];
              { int cursor = 0;
#pragma unroll
                for (int k = 0; k < MOE_MAXU / 2; ++k) { pg8::Unit ua, ub; ua.pm = ua.pn = ua.grp = 0; ub = ua; const bool va = S.next(cursor, ua); const bool vb = S.next(cursor, ub) && va;
                    const bool v = half ? vb : va; const int e = half ? ub.grp : ua.grp, pm = half ? ub.pm : ua.pm;
                    const int rk = pm * 256 - lbs[e] + rowi; const bool ok = v && rk < lcs[e];
                    ids[k] = ok ? TM[(size_t)e * NT + rk] : -1; } }
              { int cursor = 0;
#pragma unroll
                for (int k = 0; k < MOE_MAXU / 2; ++k) { pg8::Unit ua, ub; ua.pm = ua.pn = ua.grp = 0; ub = ua; const bool va = S.next(cursor, ua); const bool vb = S.next(cursor, ub) && va;
                    const bool v = half ? vb : va; const int pm = half ? ub.pm : ua.pm, pn = half ? ub.pn : ua.pn; const int id = ids[k];
                    if (v) { gat[(2 * k + half) * 256 + rowi] = (unsigned)((id < 0 ? 0 : id) >> 2) * (unsigned)DM;
                        if (id >= 0 && pn == 0) { const int slot = pm * 256 + rowi; PS[id] = slot; SG[slot] = PG[id]; } } } } }
            __syncthreads();
            pg8::Gemm g{F.ws + WS_H8, F.ws + WS_WGU + (size_t)Lg * NEXP * 2048 * DM, DM, DM, OPQ(DM / 2)};
            EpiSwiglu E{(unsigned char*)(F.ws + WS_ACT), args.in[I_BGU] + (size_t)Lg * NEXP * 2048};
            pg8::gemm_phase<EpiSwiglu, SgOrder<FillMoe>, true, F8_ALIGN, F8_SP2, true>(F.lds, g, S, E, fresh_tid(F.wave), gat);
        } SEAM(pb + 9);
        if (PM(11) && IN(pb + 10)) for (int rep_ = 0; rep_ < NREP(11); ++rep_) { if (rep_) GRID_BAR(); const int Lg = OPQ(0); FRESH();
            const int nblk = moe_tables(F, Lg);
            pg8::Gemm g{F.ws + WS_ACT, F.ws + WS_WDN + (size_t)Lg * NEXP * DM * DM, DM, DM, OPQ(DM / 2)};
            SgOrder<FillMoe> S; S.init(nblk, 4, F.G, F.bid); S.f = FillMoe{(const LAS unsigned*)(F.lds + MOE_LBLK), 1024};
            EpiDown E{(unsigned char*)(F.ws + WS_Y), args.in[I_BDN] + (size_t)Lg * NEXP * DM, (const float*)(F.ws + WS_SG)};
            pg8::gemm_phase<EpiDown, SgOrder<FillMoe>, true, F8_ALIGN, F8_SP2>(F.lds, g, S, E, fresh_tid(F.wave));
        } SEAM(pb + 10);
        }
    {
        const int pb = 1 + 1 * NPH;
        const int mrows = (1 == DEPTH - 1) ? NLAT : NT;
        if (PM(1) && IN(pb + 0)) { FRESH(); p_norm1(F, args, OPQ(1)); }
#ifdef DUP_NORM1
        GRID_BAR(); if (PM(1) && IN(pb + 0)) { FRESH(); p_norm1(F, args, OPQ(1), true); }
#endif
 SEAM(pb + 0);
        if (PM(2) && IN(pb + 1)) for (int rep_ = 0; rep_ < NREP(2); ++rep_) { if (rep_) GRID_BAR(); const int Lg = OPQ(1);
#if INPROJ_F8
            pg8::Gemm g{F.ws + WS_H8, F.ws + WS_WIN + (size_t)Lg * PW * DM, DM, DM, OPQ(DM / 2)};
            SgOrder<FillPlain> S; S.init(NT / 256, PW / 256, F.G, F.bid); S.f = FillPlain{(size_t)256 * DM, (size_t)256 * DM};
            EpiInproj E{(bf16*)(F.ws + WS_PBUF), (bf16*)(F.ws + WS_A2)};
            pg8::gemm_phase<EpiInproj, SgOrder<FillPlain>, true, F8_ALIGN, F8_SP2>(F.lds, g, S, E, fresh_tid(F.wave));
#else
            pg8::Gemm g{(const bf16*)(F.ws + WS_H), (const bf16*)(F.ws + WS_WIN) + (size_t)Lg * PW * DM, DM * 2, DM * 2, OPQ(DM)};
            SgOrder<FillPlain> S; S.init(NT / 256, PW / 256, F.G, F.bid); S.f = FillPlain{(size_t)256 * DM * 2, (size_t)256 * DM * 2};
            EpiInproj E{(bf16*)(F.ws + WS_PBUF), (bf16*)(F.ws + WS_A2)};
            pg8::gemm_phase(F.lds, g, S, E, fresh_tid(F.wave));
#endif
        }
#if defined(SHADOW_IN)
        if (PM(2) && IN(pb + 1)) { GRID_BAR(); const int Lg = OPQ(1);
            pg8::Gemm g{(const bf16*)(F.ws + WS_H), (const bf16*)(F.ws + WS_WIN) + (size_t)Lg * PW * DM, DM * 2, DM * 2, OPQ(DM)};
            SgOrder<FillPlain> S; S.init(NT / 256, PW / 256, F.G, F.bid); S.f = FillPlain{(size_t)256 * DM * 2, (size_t)256 * DM * 2};
            EpiNull E{(float*)(F.ws + WS_Y)};
            pg8::gemm_phase(F.lds, g, S, E, fresh_tid(F.wave));
        }
#endif
        SEAM(pb + 1);
        if (PM(3) && IN(pb + 2)) for (int rep_ = 0; rep_ < NREP(3); ++rep_) { if (rep_) GRID_BAR(); FRESH(); p_mix_a(F, args, OPQ(1), rep_); } SEAM(pb + 2);
        if (PM(4) && IN(pb + 3)) for (int rep_ = 0; rep_ < NREP(4); ++rep_) { if (rep_) GRID_BAR(); FRESH(); p_mix_b(F, args, OPQ(1), rep_); } SEAM(pb + 3);
        if (PM(5) && IN(pb + 4)) for (int rep_ = 0; rep_ < NREP(5); ++rep_) { if (rep_) GRID_BAR(); FRESH(); p_mix_c(F, args, OPQ(1), rep_); } SEAM(pb + 4);
        if (PM(6) && IN(pb + 5)) for (int rep_ = 0; rep_ < NREP(6); ++rep_) { if (rep_) GRID_BAR(); const int Lg = OPQ(1);
            pg8::Gemm g{(const bf16*)(F.ws + WS_ACT5), (const bf16*)(F.ws + WS_WGLU) + (size_t)Lg * 256 * 256, 512, 512, OPQ(256)};
            SgOrder<FillPlain> S; S.init(NT / 256, 1, F.G, F.bid); S.f = FillPlain{(size_t)256 * 256 * 2, 0};
            EpiGlu E{(const bf16*)(F.ws + WS_ACT5), (bf16*)(F.ws + WS_MIX)};
            pg8::gemm_phase(F.lds, g, S, E, fresh_tid(F.wave));
        } SEAM(pb + 5);
        if (PM(7) && IN(pb + 6)) { const int Lg = OPQ(1);
            pg8::Gemm g{(const bf16*)(F.ws + WS_MIX), (const bf16*)(F.ws + WS_WOUT) + (size_t)Lg * DM * MW, MW * 2, MW * 2, OPQ(MW)};
            SgOrder<FillPlain> S; S.init((Lg == DEPTH - 1 ? NLAT : NT) / 256, DM / 256, F.G, F.bid); S.f = FillPlain{(size_t)256 * MW * 2, (size_t)256 * MW * 2};
            EpiOutproj E{args.in[I_X], args.in[I_CTX], (bf16*)(F.ws + WS_XS), (const float*)(F.ws + WS_MOD) + (size_t)Lg * 9 * 6144, Lg == 0 ? 1 : 0};
            pg8::gemm_phase(F.lds, g, S, E, fresh_tid(F.wave));
        } SEAM(pb + 6);
        if (PM(8) && IN(pb + 7)) { FRESH(); p_norm2(F, args, OPQ(1), OPQ(mrows)); }
#ifdef DUP_NORM2
        GRID_BAR(); if (PM(8) && IN(pb + 7)) { FRESH(); p_norm2(F, args, OPQ(1), OPQ(mrows), 6400); }
#endif
 SEAM(pb + 7);
        if (PM(10) && IN(pb + 9)) { const int Lg = OPQ(1); FRESH();
            const int nblk = moe_tables(F, Lg);
            LAS int* lbs = (LAS int*)(F.lds + MOE_LB); LAS int* lcs = (LAS int*)(F.lds + MOE_LC); LAS unsigned* gat = (LAS unsigned*)(F.lds + MOE_GAT);
            SgOrder<FillMoe> S; S.init(nblk, 8, F.G, F.bid); S.f = FillMoe{(const LAS unsigned*)(F.lds + MOE_LBLK), 2048};
            { const int* TM = (const int*)(F.ws + WS_TM); const float* PG = (const float*)(F.ws + WS_PG); int* PS = (int*)(F.ws + WS_PS); float* SG = (float*)(F.ws + WS_SG);
              const int half = F.tid >> 8, rowi = F.tid & 255; int ids[MOE_MAXU / 2];
              { int cursor = 0;
#pragma unroll
                for (int k = 0; k < MOE_MAXU / 2; ++k) { pg8::Unit ua, ub; ua.pm = ua.pn = ua.grp = 0; ub = ua; const bool va = S.next(cursor, ua); const bool vb = S.next(cursor, ub) && va;
                    const bool v = half ? vb : va; const int e = half ? ub.grp : ua.grp, pm = half ? ub.pm : ua.pm;
                    const int rk = pm * 256 - lbs[e] + rowi; const bool ok = v && rk < lcs[e];
                    ids[k] = ok ? TM[(size_t)e * NT + rk] : -1; } }
              { int cursor = 0;
#pragma unroll
                for (int k = 0; k < MOE_MAXU / 2; ++k) { pg8::Unit ua, ub; ua.pm = ua.pn = ua.grp = 0; ub = ua; const bool va = S.next(cursor, ua); const bool vb = S.next(cursor, ub) && va;
                    const bool v = half ? vb : va; const int pm = half ? ub.pm : ua.pm, pn = half ? ub.pn : ua.pn; const int id = ids[k];
                    if (v) { gat[(2 * k + half) * 256 + rowi] = (unsigned)((id < 0 ? 0 : id) >> 2) * (unsigned)DM;
                        if (id >= 0 && pn == 0) { const int slot = pm * 256 + rowi; PS[id] = slot; SG[slot] = PG[id]; } } } } }
            __syncthreads();
            pg8::Gemm g{F.ws + WS_H8, F.ws + WS_WGU + (size_t)Lg * NEXP * 2048 * DM, DM, DM, OPQ(DM / 2)};
            EpiSwiglu E{(unsigned char*)(F.ws + WS_ACT), args.in[I_BGU] + (size_t)Lg * NEXP * 2048};
            pg8::gemm_phase<EpiSwiglu, SgOrder<FillMoe>, true, F8_ALIGN, F8_SP2, true>(F.lds, g, S, E, fresh_tid(F.wave), gat);
        } SEAM(pb + 9);
        if (PM(11) && IN(pb + 10)) for (int rep_ = 0; rep_ < NREP(11); ++rep_) { if (rep_) GRID_BAR(); const int Lg = OPQ(1); FRESH();
            const int nblk = moe_tables(F, Lg);
            pg8::Gemm g{F.ws + WS_ACT, F.ws + WS_WDN + (size_t)Lg * NEXP * DM * DM, DM, DM, OPQ(DM / 2)};
            SgOrder<FillMoe> S; S.init(nblk, 4, F.G, F.bid); S.f = FillMoe{(const LAS unsigned*)(F.lds + MOE_LBLK), 1024};
            EpiDown E{(unsigned char*)(F.ws + WS_Y), args.in[I_BDN] + (size_t)Lg * NEXP * DM, (const float*)(F.ws + WS_SG)};
            pg8::gemm_phase<EpiDown, SgOrder<FillMoe>, true, F8_ALIGN, F8_SP2>(F.lds, g, S, E, fresh_tid(F.wave));
        } SEAM(pb + 10);
        }
    {
        const int pb = 1 + 2 * NPH;
        const int mrows = (2 == DEPTH - 1) ? NLAT : NT;
        if (PM(1) && IN(pb + 0)) { FRESH(); p_norm1(F, args, OPQ(2)); }
#ifdef DUP_NORM1
        GRID_BAR(); if (PM(1) && IN(pb + 0)) { FRESH(); p_norm1(F, args, OPQ(2), true); }
#endif
 SEAM(pb + 0);
        if (PM(2) && IN(pb + 1)) for (int rep_ = 0; rep_ < NREP(2); ++rep_) { if (rep_) GRID_BAR(); const int Lg = OPQ(2);
#if INPROJ_F8
            pg8::Gemm g{F.ws + WS_H8, F.ws + WS_WIN + (size_t)Lg * PW * DM, DM, DM, OPQ(DM / 2)};
            SgOrder<FillPlain> S; S.init(NT / 256, PW / 256, F.G, F.bid); S.f = FillPlain{(size_t)256 * DM, (size_t)256 * DM};
            EpiInproj E{(bf16*)(F.ws + WS_PBUF), (bf16*)(F.ws + WS_A2)};
            pg8::gemm_phase<EpiInproj, SgOrder<FillPlain>, true, F8_ALIGN, F8_SP2>(F.lds, g, S, E, fresh_tid(F.wave));
#else
            pg8::Gemm g{(const bf16*)(F.ws + WS_H), (const bf16*)(F.ws + WS_WIN) + (size_t)Lg * PW * DM, DM * 2, DM * 2, OPQ(DM)};
            SgOrder<FillPlain> S; S.init(NT / 256, PW / 256, F.G, F.bid); S.f = FillPlain{(size_t)256 * DM * 2, (size_t)256 * DM * 2};
            EpiInproj E{(bf16*)(F.ws + WS_PBUF), (bf16*)(F.ws + WS_A2)};
            pg8::gemm_phase(F.lds, g, S, E, fresh_tid(F.wave));
#endif
        }
#if defined(SHADOW_IN)
        if (PM(2) && IN(pb + 1)) { GRID_BAR(); const int Lg = OPQ(2);
            pg8::Gemm g{(const bf16*)(F.ws + WS_H), (const bf16*)(F.ws + WS_WIN) + (size_t)Lg * PW * DM, DM * 2, DM * 2, OPQ(DM)};
            SgOrder<FillPlain> S; S.init(NT / 256, PW / 256, F.G, F.bid); S.f = FillPlain{(size_t)256 * DM * 2, (size_t)256 * DM * 2};
            EpiNull E{(float*)(F.ws + WS_Y)};
            pg8::gemm_phase(F.lds, g, S, E, fresh_tid(F.wave));
        }
#endif
        SEAM(pb + 1);
        if (PM(3) && IN(pb + 2)) for (int rep_ = 0; rep_ < NREP(3); ++rep_) { if (rep_) GRID_BAR(); FRESH(); p_mix_a(F, args, OPQ(2), rep_); } SEAM(pb + 2);
        if (PM(4) && IN(pb + 3)) for (int rep_ = 0; rep_ < NREP(4); ++rep_) { if (rep_) GRID_BAR(); FRESH(); p_mix_b(F, args, OPQ(2), rep_); } SEAM(pb + 3);
        if (PM(5) && IN(pb + 4)) for (int rep_ = 0; rep_ < NREP(5); ++rep_) { if (rep_) GRID_BAR(); FRESH(); p_mix_c(F, args, OPQ(2), rep_); } SEAM(pb + 4);
        if (PM(6) && IN(pb + 5)) for (int rep_ = 0; rep_ < NREP(6); ++rep_) { if (rep_) GRID_BAR(); const int Lg = OPQ(2);
            pg8::Gemm g{(const bf16*)(F.ws + WS_ACT5), (const bf16*)(F.ws + WS_WGLU) + (size_t)Lg * 256 * 256, 512, 512, OPQ(256)};
            SgOrder<FillPlain> S; S.init(NT / 256, 1, F.G, F.bid); S.f = FillPlain{(size_t)256 * 256 * 2, 0};
            EpiGlu E{(const bf16*)(F.ws + WS_ACT5), (bf16*)(F.ws + WS_MIX)};
            pg8::gemm_phase(F.lds, g, S, E, fresh_tid(F.wave));
        } SEAM(pb + 5);
        if (PM(7) && IN(pb + 6)) { const int Lg = OPQ(2);
            pg8::Gemm g{(const bf16*)(F.ws + WS_MIX), (const bf16*)(F.ws + WS_WOUT) + (size_t)Lg * DM * MW, MW * 2, MW * 2, OPQ(MW)};
            SgOrder<FillPlain> S; S.init((Lg == DEPTH - 1 ? NLAT : NT) / 256, DM / 256, F.G, F.bid); S.f = FillPlain{(size_t)256 * MW * 2, (size_t)256 * MW * 2};
            EpiOutproj E{args.in[I_X], args.in[I_CTX], (bf16*)(F.ws + WS_XS), (const float*)(F.ws + WS_MOD) + (size_t)Lg * 9 * 6144, Lg == 0 ? 1 : 0};
            pg8::gemm_phase(F.lds, g, S, E, fresh_tid(F.wave));
        } SEAM(pb + 6);
        if (PM(8) && IN(pb + 7)) { FRESH(); p_norm2(F, args, OPQ(2), OPQ(mrows)); }
#ifdef DUP_NORM2
        GRID_BAR(); if (PM(8) && IN(pb + 7)) { FRESH(); p_norm2(F, args, OPQ(2), OPQ(mrows), 6400); }
#endif
 SEAM(pb + 7);
        if (PM(10) && IN(pb + 9)) { const int Lg = OPQ(2); FRESH();
            const int nblk = moe_tables(F, Lg);
            LAS int* lbs = (LAS int*)(F.lds + MOE_LB); LAS int* lcs = (LAS int*)(F.lds + MOE_LC); LAS unsigned* gat = (LAS unsigned*)(F.lds + MOE_GAT);
            SgOrder<FillMoe> S; S.init(nblk, 8, F.G, F.bid); S.f = FillMoe{(const LAS unsigned*)(F.lds + MOE_LBLK), 2048};
            { const int* TM = (const int*)(F.ws + WS_TM); const float* PG = (const float*)(F.ws + WS_PG); int* PS = (int*)(F.ws + WS_PS); float* SG = (float*)(F.ws + WS_SG);
              const int half = F.tid >> 8, rowi = F.tid & 255; int ids[MOE_MAXU / 2];
              { int cursor = 0;
#pragma unroll
                for (int k = 0; k < MOE_MAXU / 2; ++k) { pg8::Unit ua, ub; ua.pm = ua.pn = ua.grp = 0; ub = ua; const bool va = S.next(cursor, ua); const bool vb = S.next(cursor, ub) && va;
                    const bool v = half ? vb : va; const int e = half ? ub.grp : ua.grp, pm = half ? ub.pm : ua.pm;
                    const int rk = pm * 256 - lbs[e] + rowi; const bool ok = v && rk < lcs[e];
                    ids[k] = ok ? TM[(size_t)e * NT + rk] : -1; } }
              { int cursor = 0;
#pragma unroll
                for (int k = 0; k < MOE_MAXU / 2; ++k) { pg8::Unit ua, ub; ua.pm = ua.pn = ua.grp = 0; ub = ua; const bool va = S.next(cursor, ua); const bool vb = S.next(cursor, ub) && va;
                    const bool v = half ? vb : va; const int pm = half ? ub.pm : ua.pm, pn = half ? ub.pn : ua.pn; const int id = ids[k];
                    if (v) { gat[(2 * k + half) * 256 + rowi] = (unsigned)((id < 0 ? 0 : id) >> 2) * (unsigned)DM;
                        if (id >= 0 && pn == 0) { const int slot = pm * 256 + rowi; PS[id] = slot; SG[slot] = PG[id]; } } } } }
            __syncthreads();
            pg8::Gemm g{F.ws + WS_H8, F.ws + WS_WGU + (size_t)Lg * NEXP * 2048 * DM, DM, DM, OPQ(DM / 2)};
            EpiSwiglu E{(unsigned char*)(F.ws + WS_ACT), args.in[I_BGU] + (size_t)Lg * NEXP * 2048};
            pg8::gemm_phase<EpiSwiglu, SgOrder<FillMoe>, true, F8_ALIGN, F8_SP2, true>(F.lds, g, S, E, fresh_tid(F.wave), gat);
        } SEAM(pb + 9);
        if (PM(11) && IN(pb + 10)) for (int rep_ = 0; rep_ < NREP(11); ++rep_) { if (rep_) GRID_BAR(); const int Lg = OPQ(2); FRESH();
            const int nblk = moe_tables(F, Lg);
            pg8::Gemm g{F.ws + WS_ACT, F.ws + WS_WDN + (size_t)Lg * NEXP * DM * DM, DM, DM, OPQ(DM / 2)};
            SgOrder<FillMoe> S; S.init(nblk, 4, F.G, F.bid); S.f = FillMoe{(const LAS unsigned*)(F.lds + MOE_LBLK), 1024};
            EpiDown E{(unsigned char*)(F.ws + WS_Y), args.in[I_BDN] + (size_t)Lg * NEXP * DM, (const float*)(F.ws + WS_SG)};
            pg8::gemm_phase<EpiDown, SgOrder<FillMoe>, true, F8_ALIGN, F8_SP2>(F.lds, g, S, E, fresh_tid(F.wave));
        } SEAM(pb + 10);
        }
    {
        const int pb = 1 + 3 * NPH;
        const int mrows = (3 == DEPTH - 1) ? NLAT : NT;
        if (PM(1) && IN(pb + 0)) { FRESH(); p_norm1(F, args, OPQ(3)); }
#ifdef DUP_NORM1
        GRID_BAR(); if (PM(1) && IN(pb + 0)) { FRESH(); p_norm1(F, args, OPQ(3), true); }
#endif
 SEAM(pb + 0);
        if (PM(2) && IN(pb + 1)) for (int rep_ = 0; rep_ < NREP(2); ++rep_) { if (rep_) GRID_BAR(); const int Lg = OPQ(3);
#if INPROJ_F8
            pg8::Gemm g{F.ws + WS_H8, F.ws + WS_WIN + (size_t)Lg * PW * DM, DM, DM, OPQ(DM / 2)};
            SgOrder<FillPlain> S; S.init(NT / 256, PW / 256, F.G, F.bid); S.f = FillPlain{(size_t)256 * DM, (size_t)256 * DM};
            EpiInproj E{(bf16*)(F.ws + WS_PBUF), (bf16*)(F.ws + WS_A2)};
            pg8::gemm_phase<EpiInproj, SgOrder<FillPlain>, true, F8_ALIGN, F8_SP2>(F.lds, g, S, E, fresh_tid(F.wave));
#else
            pg8::Gemm g{(const bf16*)(F.ws + WS_H), (const bf16*)(F.ws + WS_WIN) + (size_t)Lg * PW * DM, DM * 2, DM * 2, OPQ(DM)};
            SgOrder<FillPlain> S; S.init(NT / 256, PW / 256, F.G, F.bid); S.f = FillPlain{(size_t)256 * DM * 2, (size_t)256 * DM * 2};
            EpiInproj E{(bf16*)(F.ws + WS_PBUF), (bf16*)(F.ws + WS_A2)};
            pg8::gemm_phase(F.lds, g, S, E, fresh_tid(F.wave));
#endif
        }
#if defined(SHADOW_IN)
        if (PM(2) && IN(pb + 1)) { GRID_BAR(); const int Lg = OPQ(3);
            pg8::Gemm g{(const bf16*)(F.ws + WS_H), (const bf16*)(F.ws + WS_WIN) + (size_t)Lg * PW * DM, DM * 2, DM * 2, OPQ(DM)};
            SgOrder<FillPlain> S; S.init(NT / 256, PW / 256, F.G, F.bid); S.f = FillPlain{(size_t)256 * DM * 2, (size_t)256 * DM * 2};
            EpiNull E{(float*)(F.ws + WS_Y)};
            pg8::gemm_phase(F.lds, g, S, E, fresh_tid(F.wave));
        }
#endif
        SEAM(pb + 1);
        if (PM(3) && IN(pb + 2)) for (int rep_ = 0; rep_ < NREP(3); ++rep_) { if (rep_) GRID_BAR(); FRESH(); p_mix_a(F, args, OPQ(3), rep_); } SEAM(pb + 2);
        if (PM(4) && IN(pb + 3)) for (int rep_ = 0; rep_ < NREP(4); ++rep_) { if (rep_) GRID_BAR(); FRESH(); p_mix_b(F, args, OPQ(3), rep_); } SEAM(pb + 3);
        if (PM(5) && IN(pb + 4)) for (int rep_ = 0; rep_ < NREP(5); ++rep_) { if (rep_) GRID_BAR(); FRESH(); p_mix_c(F, args, OPQ(3), rep_); } SEAM(pb + 4);
        if (PM(6) && IN(pb + 5)) for (int rep_ = 0; rep_ < NREP(6); ++rep_) { if (rep_) GRID_BAR(); const int Lg = OPQ(3);
            pg8::Gemm g{(const bf16*)(F.ws + WS_ACT5), (const bf16*)(F.ws + WS_WGLU) + (size_t)Lg * 256 * 256, 512, 512, OPQ(256)};
            SgOrder<FillPlain> S; S.init(NT / 256, 1, F.G, F.bid); S.f = FillPlain{(size_t)256 * 256 * 2, 0};
            EpiGlu E{(const bf16*)(F.ws + WS_ACT5), (bf16*)(F.ws + WS_MIX)};
            pg8::gemm_phase(F.lds, g, S, E, fresh_tid(F.wave));
        } SEAM(pb + 5);
        if (PM(7) && IN(pb + 6)) { const int Lg = OPQ(3);
            pg8::Gemm g{(const bf16*)(F.ws + WS_MIX), (const bf16*)(F.ws + WS_WOUT) + (size_t)Lg * DM * MW, MW * 2, MW * 2, OPQ(MW)};
            SgOrder<FillPlain> S; S.init((Lg == DEPTH - 1 ? NLAT : NT) / 256, DM / 256, F.G, F.bid); S.f = FillPlain{(size_t)256 * MW * 2, (size_t)256 * MW * 2};
            EpiOutproj E{args.in[I_X], args.in[I_CTX], (bf16*)(F.ws + WS_XS), (const float*)(F.ws + WS_MOD) + (size_t)Lg * 9 * 6144, Lg == 0 ? 1 : 0};
            pg8::gemm_phase(F.lds, g, S, E, fresh_tid(F.wave));
        } SEAM(pb + 6);
        if (PM(8) && IN(pb + 7)) { FRESH(); p_norm2(F, args, OPQ(3), OPQ(mrows)); }
#ifdef DUP_NORM2
        GRID_BAR(); if (PM(8) && IN(pb + 7)) { FRESH(); p_norm2(F, args, OPQ(3), OPQ(mrows), 6400); }
#endif
 SEAM(pb + 7);
        if (PM(10) && IN(pb + 9)) { const int Lg = OPQ(3); FRESH();
            const int nblk = moe_tables(F, Lg);
            LAS int* lbs = (LAS int*)(F.lds + MOE_LB); LAS int* lcs = (LAS int*)(F.lds + MOE_LC); LAS unsigned* gat = (LAS unsigned*)(F.lds + MOE_GAT);
            SgOrder<FillMoe> S; S.init(nblk, 8, F.G, F.bid); S.f = FillMoe{(const LAS unsigned*)(F.lds + MOE_LBLK), 2048};
            { const int* TM = (const int*)(F.ws + WS_TM); const float* PG = (const float*)(F.ws + WS_PG); int* PS = (int*)(F.ws + WS_PS); float* SG = (float*)(F.ws + WS_SG);
              const int half = F.tid >> 8, rowi = F.tid & 255; int ids[MOE_MAXU / 2];
              { int cursor = 0;
#pragma unroll
                for (int k = 0; k < MOE_MAXU / 2; ++k) { pg8::Unit ua, ub; ua.pm = ua.pn = ua.grp = 0; ub = ua; const bool va = S.next(cursor, ua); const bool vb = S.next(cursor, ub) && va;
                    const bool v = half ? vb : va; const int e = half ? ub.grp : ua.grp, pm = half ? ub.pm : ua.pm;
                    const int rk = pm * 256 - lbs[e] + rowi; const bool ok = v && rk < lcs[e];
                    ids[k] = ok ? TM[(size_t)e * NT + rk] : -1; } }
              { int cursor = 0;
#pragma unroll
                for (int k = 0; k < MOE_MAXU / 2; ++k) { pg8::Unit ua, ub; ua.pm = ua.pn = ua.grp = 0; ub = ua; const bool va = S.next(cursor, ua); const bool vb = S.next(cursor, ub) && va;
                    const bool v = half ? vb : va; const int pm = half ? ub.pm : ua.pm, pn = half ? ub.pn : ua.pn; const int id = ids[k];
                    if (v) { gat[(2 * k + half) * 256 + rowi] = (unsigned)((id < 0 ? 0 : id) >> 2) * (unsigned)DM;
                        if (id >= 0 && pn == 0) { const int slot = pm * 256 + rowi; PS[id] = slot; SG[slot] = PG[id]; } } } } }
            __syncthreads();
            pg8::Gemm g{F.ws + WS_H8, F.ws + WS_WGU + (size_t)Lg * NEXP * 2048 * DM, DM, DM, OPQ(DM / 2)};
            EpiSwiglu E{(unsigned char*)(F.ws + WS_ACT), args.in[I_BGU] + (size_t)Lg * NEXP * 2048};
            pg8::gemm_phase<EpiSwiglu, SgOrder<FillMoe>, true, F8_ALIGN, F8_SP2, true>(F.lds, g, S, E, fresh_tid(F.wave), gat);
        } SEAM(pb + 9);
        if (PM(11) && IN(pb + 10)) for (int rep_ = 0; rep_ < NREP(11); ++rep_) { if (rep_) GRID_BAR(); const int Lg = OPQ(3); FRESH();
            const int nblk = moe_tables(F, Lg);
            pg8::Gemm g{F.ws + WS_ACT, F.ws + WS_WDN + (size_t)Lg * NEXP * DM * DM, DM, DM, OPQ(DM / 2)};
            SgOrder<FillMoe> S; S.init(nblk, 4, F.G, F.bid); S.f = FillMoe{(const LAS unsigned*)(F.lds + MOE_LBLK), 1024};
            EpiDown E{(unsigned char*)(F.ws + WS_Y), args.in[I_BDN] + (size_t)Lg * NEXP * DM, (const float*)(F.ws + WS_SG)};
            pg8::gemm_phase<EpiDown, SgOrder<FillMoe>, true, F8_ALIGN, F8_SP2>(F.lds, g, S, E, fresh_tid(F.wave));
        } SEAM(pb + 10);
        }
    if (PM(12) && IN(PH_TOTAL - 1)) { FRESH(); p_final(F, args); }
#undef IN
#undef SEAM
#undef args
}

extern "C" void kernel_launch(void* const* d_in, const int* in_sizes, int n_in, void* d_out, int out_size, void* d_ws, size_t ws_size, hipStream_t stream) {
    static int grid = 0;
    if (grid == 0) {
        if (n_in != N_IN || out_size != NLAT * DM || ws_size < WS_END) { fprintf(stderr, "kernel_launch: unexpected shapes (n_in %d, out %d, ws %zu < %zu); nothing launched\n", n_in, out_size, ws_size, (size_t)WS_END); grid = -1; return; }
        int dev = 0, cus = 0, per_cu = 0;
        if (hipGetDevice(&dev) != hipSuccess || hipDeviceGetAttribute(&cus, hipDeviceAttributeMultiprocessorCount, dev) != hipSuccess) { grid = -1; return; }
        if (hipFuncSetAttribute((const void*)mk_fwd, hipFuncAttributeMaxDynamicSharedMemorySize, LDS_BYTES) != hipSuccess) { fprintf(stderr, "kernel_launch: hipFuncSetAttribute failed\n"); grid = -1; return; }
        if (hipOccupancyMaxActiveBlocksPerMultiprocessor(&per_cu, (const void*)mk_fwd, NTHR, LDS_BYTES) != hipSuccess || per_cu < 1) fprintf(stderr, "kernel_launch: occupancy query says %d\n", per_cu);
        (void)hipGetLastError();
        grid = cus;
    }
    if (grid < 0) return;
    (void)hipMemsetAsync((char*)d_ws + WS_CTL, 0, CTL_BYTES, stream);
    Args a{};
    for (int i = 0; i < N_IN; ++i) a.in[i] = (const float*)d_in[i];
    a.out = (float*)d_out; a.ws = (unsigned char*)d_ws;
#if MK_ONE_LAUNCH
    a.ph_lo = 0; a.ph_hi = PH_TOTAL;
    hipLaunchKernelGGL(mk_fwd, dim3(grid), dim3(NTHR), LDS_BYTES, stream, a);
#else
    for (int p = 0; p < PH_TOTAL; ++p) { a.ph_lo = p; a.ph_hi = p + 1; hipLaunchKernelGGL(mk_fwd, dim3(grid), dim3(NTHR), LDS_BYTES, stream, a); }
#endif
}
```

```cpp
#define MK_ONE_LAUNCH 1
#define F8_ALIGN true
#define F8_SP2 true
#include <hip/hip_runtime.h>
#include <cstdio>
#include <cstdint>

#define GAS __attribute__((address_space(1)))
#define LAS __attribute__((address_space(3)))
typedef unsigned short bf16;
typedef short bf16x8 __attribute__((ext_vector_type(8)));
typedef short s16x4 __attribute__((ext_vector_type(4)));
typedef float f32x4 __attribute__((ext_vector_type(4)));
typedef float f32x2 __attribute__((ext_vector_type(2)));
typedef unsigned u32x4 __attribute__((ext_vector_type(4)));
typedef unsigned u32x2 __attribute__((ext_vector_type(2)));

namespace pg8 {
#define PG8_LAS __attribute__((address_space(3)))
typedef unsigned short bf16_t;
constexpr int BM = 256, BK = 64, HALF = 128, HTB = HALF * BK * 2  , STAGE_BYTES = 8 * HTB;

__host__ __device__ __forceinline__ int lds_byte(int r, int c) { const int st = (r >> 4) * 2 + (c >> 5), rr = r & 15, cc = c & 31, ob = rr * 64 + cc * 2; return st * 1024 + (ob ^ (((ob >> 9) & 1) << 5)); }
__host__ __device__ __forceinline__ void stage_rc(int b, int& R, int& C) { const int st = b / 1024, sb = b % 1024, swz = sb ^ (((sb >> 9) & 1) << 5); R = (st >> 1) * 16 + swz / 64; C = (st & 1) * 32 + (swz % 64) / 2; }
__host__ __device__ __forceinline__ int lds_byte_f8(int r, int c) { const int st = (r >> 4) * 2 + (c >> 5), rr = r & 15, cc = c & 31, ob = rr * 64 + cc * 2; return st * 1024 + (ob ^ (((ob >> 9) & 1) << 4)); }
__host__ __device__ __forceinline__ void stage_rc_f8(int b, int& R, int& C) { const int st = b / 1024, sb = b % 1024, swz = sb ^ (((sb >> 9) & 1) << 4); R = (st >> 1) * 16 + swz / 64; C = (st & 1) * 32 + (swz % 64) / 2; }
__host__ __device__ __forceinline__ int perm32(int rho) { const int n = rho >> 4, i = rho & 15; return 8 * (i >> 2) + 4 * n + (i & 3); }

struct Unit { int pm, pn, grp; size_t aoff, boff; };
struct Gemm { const void* A; const void* Bt; int lda, ldb, K; };

__device__ __forceinline__ unsigned cvt_pk_bf16(float lo, float hi) { unsigned r; asm volatile("v_cvt_pk_bf16_f32 %0, %1, %2" : "=v"(r) : "v"(lo), "v"(hi)); return r; }

typedef int v8i_t __attribute__((ext_vector_type(8)));
typedef int v4i_t __attribute__((ext_vector_type(4)));
template <class...> using pg8_void_t = void;
template <class E, class = void> struct epi_npre { static constexpr int value = 0; };
template <class E> struct epi_npre<E, pg8_void_t<decltype(E::NPRE)>> { static constexpr int value = E::NPRE; };
template <class Epi, class Sched, bool F8 = false, bool ALIGN_EPI = true, bool SP2 = true, bool GATHER = false>
__device__ __forceinline__ void gemm_phase(PG8_LAS unsigned char* lds, const Gemm g, const Sched& S, const Epi& E, int tid_in, const PG8_LAS unsigned* gat = nullptr) {
    static_assert(!GATHER || SP2, "gather is written for the SP2 loop");
    int tid = tid_in; asm volatile("" : "+v"(tid));
    const int wid = __builtin_amdgcn_readfirstlane(tid >> 6), lane = tid & 63, wr = wid >> 2, wc = wid & 3, fr = lane & 15, fq = lane >> 4;
    const int K = g.K, nt = K / BK;
    unsigned voffA[2], voffB[2];
#pragma unroll
    for (int i = 0; i < 2; ++i) { int R, C; if constexpr (F8) stage_rc_f8(tid * 16 + i * 8192, R, C); else stage_rc(tid * 16 + i * 8192, R, C); const int Rb = (int)Epi::PERM == 2 ? (64 * (R >> 5) + 16 * ((R >> 2) & 3) + 4 * ((R >> 4) & 1) + (R & 3)) : ((int)Epi::PERM == 1 ? ((R & ~31) + perm32(R & 31)) : R);
        voffA[i] = GATHER ? (unsigned)(R * 65536 + C * 2) : (unsigned)(R * g.lda + C * 2); voffB[i] = (unsigned)(Rb * g.ldb + C * 2); }
    unsigned vA0[2], vA1[2];
    const size_t kstep = (size_t)(BK * 2);
    const size_t hstepA = (size_t)HALF * g.lda, hstepB = (size_t)((int)Epi::PERM == 2 ? 8 : HALF) * g.ldb;
#define PG8_GLOAD(ui_) do { _Pragma("unroll") for (int _i = 0; _i < 2; ++_i) { const int r_ = (int)(voffA[_i] >> 16); const unsigned c_ = voffA[_i] & 0xffffu; \
        vA0[_i] = gat[(ui_) * 256 + r_] + c_; vA1[_i] = gat[(ui_) * 256 + 128 + r_] + c_; } } while (0)
    if constexpr (GATHER) PG8_GLOAD(0); else { vA0[0] = voffA[0]; vA0[1] = voffA[1]; vA1[0] = voffA[0] + (unsigned)hstepA; vA1[1] = voffA[1] + (unsigned)hstepA; }
    int ui = 0;
    const unsigned ldsw = (unsigned)wid * 1024u;
    const int aoff = F8 ? lds_byte_f8(wr * 64 + fr, fq * 16) : lds_byte(wr * 64 + fr, fq * 8), boff = F8 ? lds_byte_f8(wc * 32 + fr, fq * 16) : lds_byte(wc * 32 + fr, fq * 8);
    const int aoff1 = lds_byte_f8(wr * 64 + fr, fq * 16 + 8), boff1 = lds_byte_f8(wc * 32 + fr, fq * 16 + 8);
#define PG8_SA(b, h) (((b) * 2 + (h)) * HTB)
#define PG8_SB(b, h) ((4 + (b) * 2 + (h)) * HTB)
#define PG8_STAGE(bufoff, gbase, voff) do { _Pragma("unroll") for (int _i = 0; _i < 2; ++_i) \
        __builtin_amdgcn_global_load_lds((const unsigned*)((const char*)(gbase) + (voff)[_i]), (PG8_LAS unsigned*)(lds + (bufoff) + ldsw + _i * 8192), 16, 0, 0); } while (0)
#define PG8_LD16(off) (*(const PG8_LAS v4i_t*)(lds + (off)))
#define PG8_LDA(dst, b, h) do { if constexpr (F8) { _Pragma("unroll") for (int m = 0; m < 4; ++m) A8[m] = __builtin_shufflevector(PG8_LD16(PG8_SA(b, h) + aoff + m * 2048), PG8_LD16(PG8_SA(b, h) + aoff1 + m * 2048), 0, 1, 2, 3, 4, 5, 6, 7); } \
        else { _Pragma("unroll") for (int m = 0; m < 4; ++m) _Pragma("unroll") for (int k = 0; k < 2; ++k) dst[m][k] = *(const PG8_LAS bf16x8*)(lds + PG8_SA(b, h) + aoff + m * 2048 + k * 1024); } } while (0)
#define PG8_LDB(dst, b, h) do { if constexpr (F8) { _Pragma("unroll") for (int n = 0; n < 2; ++n) dst##8[n] = __builtin_shufflevector(PG8_LD16(PG8_SB(b, h) + boff + n * 2048), PG8_LD16(PG8_SB(b, h) + boff1 + n * 2048), 0, 1, 2, 3, 4, 5, 6, 7); } \
        else { _Pragma("unroll") for (int n = 0; n < 2; ++n) _Pragma("unroll") for (int k = 0; k < 2; ++k) dst[n][k] = *(const PG8_LAS bf16x8*)(lds + PG8_SB(b, h) + boff + n * 2048 + k * 1024); } } while (0)
#define PG8_MMA(ai, bj, At, Bt) do { __builtin_amdgcn_s_setprio(1); \
        if constexpr (F8) { _Pragma("unroll") for (int m = 0; m < 4; ++m) _Pragma("unroll") for (int n = 0; n < 2; ++n) \
            asm volatile("v_mfma_scale_f32_16x16x128_f8f6f4 %0, %1, %2, %0, %3, %3 op_sel_hi:[0,0,0]" : "+v"(acc[ai][bj][m][n]) : "v"(Bt##8[n]), "v"(A8[m]), "v"(one_scale)); } \
        else { _Pragma("unroll") for (int m = 0; m < 4; ++m) _Pragma("unroll") for (int n = 0; n < 2; ++n) _Pragma("unroll") for (int k = 0; k < 2; ++k) \
            acc[ai][bj][m][n] = __builtin_amdgcn_mfma_f32_16x16x32_bf16(Bt[n][k], At[m][k], acc[ai][bj][m][n], 0, 0, 0); } \
        __builtin_amdgcn_s_setprio(0); } while (0)
#define PG8_WAIT_V(n) asm volatile("s_waitcnt vmcnt(" #n ")" ::: "memory")
#define PG8_WAIT_L(n) asm volatile("s_waitcnt lgkmcnt(" #n ")" ::: "memory")
#define PG8_BAR __builtin_amdgcn_s_barrier()
#define PG8_SCHED __builtin_amdgcn_sched_barrier(0)
    Unit cur, nxt; int cursor = 0;
    if (!S.next(cursor, cur)) return;
    f32x4 acc[2][2][4][2];
#pragma unroll
    for (int a = 0; a < 2; ++a)
#pragma unroll
        for (int b = 0; b < 2; ++b)
#pragma unroll
            for (int m = 0; m < 4; ++m)
#pragma unroll
                for (int n = 0; n < 2; ++n) acc[a][b][m][n] = (f32x4){0.f, 0.f, 0.f, 0.f};
    bf16x8 At[4][2], B0[2][2], B1[2][2];
    v8i_t A8[4], B08[2], B18[2];
    int one_scale = 0x7F7F7F7F; asm volatile("" : "+v"(one_scale));
    const char* cA = (const char*)g.A + (GATHER ? (size_t)0 : cur.aoff); const char* cB = (const char*)g.Bt + cur.boff;
    if constexpr (SP2) {
        PG8_STAGE(PG8_SB(0, 0), cB, voffB); PG8_STAGE(PG8_SB(0, 1), cB + hstepB, voffB); PG8_STAGE(PG8_SA(0, 0), cA, vA0); PG8_STAGE(PG8_SA(0, 1), cA, vA1);
        if (wr == 1) PG8_BAR;
        PG8_WAIT_V(2); PG8_BAR;
        PG8_STAGE(PG8_SB(1, 0), cB + kstep, voffB); PG8_STAGE(PG8_SA(1, 0), cA + kstep, vA0); PG8_STAGE(PG8_SB(1, 1), cB + hstepB + kstep, voffB);
        PG8_WAIT_V(6); PG8_BAR;
    } else {
        PG8_STAGE(PG8_SB(0, 0), cB, voffB); PG8_STAGE(PG8_SA(0, 0), cA, voffA); PG8_STAGE(PG8_SB(0, 1), cB + hstepB, voffB); PG8_STAGE(PG8_SA(0, 1), cA + hstepA, voffA);
        if (wr == 1) PG8_BAR;
        PG8_WAIT_V(4); PG8_BAR;
        PG8_STAGE(PG8_SB(1, 0), cB + kstep, voffB); PG8_STAGE(PG8_SA(1, 0), cA + kstep, vA0); PG8_STAGE(PG8_SB(1, 1), cB + hstepB + kstep, voffB);
        PG8_WAIT_V(6); PG8_BAR;
    }
    for (;;) {
        const bool has_next = S.next(cursor, nxt);
        const char* nA = (has_next && !GATHER) ? (const char*)g.A + nxt.aoff : cA; const char* nB = has_next ? (const char*)g.Bt + nxt.boff : cB;
        for (int t = 0; t < nt; t += 2) {
            const bool last = (t == nt - 2);
            const char* a1 = cA + (size_t)(t + 1) * kstep;
            const char* a2 = last ? nA : cA + (size_t)(t + 2) * kstep; const char* b2 = last ? nB : cB + (size_t)(t + 2) * kstep;
            const char* a3 = a2 + kstep; const char* b3 = b2 + kstep;
            if constexpr (SP2) {
            if constexpr (epi_npre<Epi>::value > 0) { if (t == 0 && wid < epi_npre<Epi>::value) __builtin_amdgcn_global_load_lds((const unsigned*)((const char*)E.pre_src(wid, cur) + lane * 16), (PG8_LAS unsigned*)(lds + Epi::PRE_OFF + ((ui & 1) * epi_npre<Epi>::value + wid) * 1024), 16, 0, 0); }
            PG8_LDB(B0, 0, 0); PG8_LDB(B1, 0, 1); PG8_SCHED; PG8_LDA(At, 0, 0); PG8_STAGE(PG8_SA(1, 1), a1, vA1);
            if constexpr (GATHER) { if (last && has_next) PG8_GLOAD(ui + 1); }
            PG8_WAIT_V(8); PG8_WAIT_L(0); PG8_BAR; PG8_MMA(0, 0, At, B0); PG8_MMA(0, 1, At, B1); PG8_BAR; PG8_SCHED;
            PG8_LDA(At, 0, 1); PG8_STAGE(PG8_SB(0, 0), b2, voffB); PG8_STAGE(PG8_SB(0, 1), b2 + hstepB, voffB); PG8_STAGE(PG8_SA(0, 0), a2, vA0);
            PG8_WAIT_V(8); PG8_WAIT_L(0); PG8_BAR; PG8_MMA(1, 0, At, B0); PG8_MMA(1, 1, At, B1); PG8_BAR; PG8_SCHED;
            PG8_LDB(B0, 1, 0); PG8_LDB(B1, 1, 1); PG8_SCHED; PG8_LDA(At, 1, 0); PG8_STAGE(PG8_SA(0, 1), a2, vA1);
            PG8_WAIT_V(8); PG8_WAIT_L(0); PG8_BAR; PG8_MMA(0, 0, At, B0); PG8_MMA(0, 1, At, B1); PG8_BAR; PG8_SCHED;
            PG8_LDA(At, 1, 1); PG8_STAGE(PG8_SB(1, 0), b3, voffB); PG8_STAGE(PG8_SB(1, 1), b3 + hstepB, voffB); PG8_STAGE(PG8_SA(1, 0), a3, vA0);
            PG8_WAIT_V(8); PG8_WAIT_L(0); PG8_BAR; PG8_MMA(1, 0, At, B0); PG8_MMA(1, 1, At, B1); PG8_BAR; PG8_SCHED;
            } else {
            PG8_LDB(B0, 0, 0); PG8_SCHED; PG8_LDA(At, 0, 0); PG8_STAGE(PG8_SA(1, 1), a1, vA1);
            PG8_WAIT_L(8); PG8_BAR; PG8_WAIT_L(0); PG8_MMA(0, 0, At, B0); PG8_BAR; PG8_SCHED;
            PG8_LDB(B1, 0, 1); PG8_STAGE(PG8_SB(0, 0), b2, voffB);
            PG8_BAR; PG8_WAIT_L(0); PG8_MMA(0, 1, At, B1); PG8_BAR;
            PG8_LDA(At, 0, 1); PG8_STAGE(PG8_SA(0, 0), a2, vA0);
            PG8_BAR; PG8_WAIT_L(0); PG8_MMA(1, 0, At, B0); PG8_BAR; PG8_SCHED;
            PG8_STAGE(PG8_SB(0, 1), b2 + hstepB, voffB);
            PG8_WAIT_V(6); PG8_BAR; PG8_MMA(1, 1, At, B1); PG8_BAR;
            PG8_LDB(B0, 1, 0); PG8_SCHED; PG8_LDA(At, 1, 0); PG8_STAGE(PG8_SA(0, 1), a2, vA1);
            PG8_WAIT_L(8); PG8_BAR; PG8_WAIT_L(0); PG8_MMA(0, 0, At, B0); PG8_BAR; PG8_SCHED;
            PG8_LDB(B1, 1, 1); PG8_STAGE(PG8_SB(1, 0), b3, voffB);
            PG8_BAR; PG8_WAIT_L(0); PG8_MMA(0, 1, At, B1); PG8_BAR;
            PG8_LDA(At, 1, 1); PG8_STAGE(PG8_SA(1, 0), a3, vA0);
            PG8_BAR; PG8_WAIT_L(0); PG8_MMA(1, 0, At, B0); PG8_BAR; PG8_SCHED;
            PG8_STAGE(PG8_SB(1, 1), b3 + hstepB, voffB);
            PG8_WAIT_V(6); PG8_BAR; PG8_MMA(1, 1, At, B1); PG8_BAR;
            }
        }
        if constexpr (F8) asm volatile("s_nop 15\n\ts_nop 15" ::: "memory");
        if constexpr (ALIGN_EPI) { if (wr == 0) PG8_BAR; }
        if constexpr (epi_npre<Epi>::value > 0) E(acc, cur, wr, wc, fr, fq, (const PG8_LAS float*)(lds + Epi::PRE_OFF + (ui & 1) * epi_npre<Epi>::value * 1024)); else E(acc, cur, wr, wc, fr, fq);
        if (!has_next) break;
#pragma unroll
        for (int a = 0; a < 2; ++a)
#pragma unroll
            for (int b = 0; b < 2; ++b)
#pragma unroll
                for (int m = 0; m < 4; ++m)
#pragma unroll
                    for (int n = 0; n < 2; ++n) acc[a][b][m][n] = (f32x4){0.f, 0.f, 0.f, 0.f};
        cur = nxt; cA = nA; cB = nB; ++ui;
        if constexpr (ALIGN_EPI) { if (wr == 1) PG8_BAR; }
    }
    PG8_WAIT_V(0);
    if constexpr (!ALIGN_EPI) { if (wr == 0) PG8_BAR; }
    PG8_BAR;
#undef PG8_GLOAD
#undef PG8_SA
#undef PG8_SB
#undef PG8_STAGE
#undef PG8_LDA
#undef PG8_LDB
#undef PG8_MMA
#undef PG8_LD16
#undef PG8_WAIT_V
#undef PG8_WAIT_L
#undef PG8_BAR
#undef PG8_SCHED
}
}

#define XB_TMO      128
#define XB_XCNT(j)  (256  + 64 * (j))
#define XB_XSUB(j)  (1280 + 64 * (j))
#define XB_XGEN(j)  (2304 + 64 * (j))
#define XB_TOP      3328
#define XB_TOPGEN   3392
#define XCD_BAR_WORDS 3456
#define XB_SPIN_CAP (1u << 18)

__device__ __forceinline__ unsigned xb_ld(unsigned* p)              { return __hip_atomic_load(p, __ATOMIC_RELAXED, __HIP_MEMORY_SCOPE_AGENT); }
__device__ __forceinline__ unsigned xb_add(unsigned* p, unsigned v) { return __hip_atomic_fetch_add(p, v, __ATOMIC_RELAXED, __HIP_MEMORY_SCOPE_AGENT); }
__device__ __forceinline__ unsigned xb_xcc_id() { return (unsigned)__builtin_amdgcn_s_getreg((3 << 11) | 20) & 0xFu; }
#define XB_SPIN(cond, bar) do { unsigned _sp = 0; while (cond) { __builtin_amdgcn_s_sleep(1); \
    if ((++_sp & 255u) == 0u) { if (xb_ld(&(bar)[XB_TMO])) break; if (_sp > XB_SPIN_CAP) { atomicAdd(&(bar)[XB_TMO], 1u); break; } } } } while (0)

struct XcdBarrier {
    unsigned* bar; unsigned x;
    volatile LAS unsigned* st;
};

__device__ __forceinline__ XcdBarrier xcd_barrier_post(unsigned* bar, volatile LAS unsigned* st) {
    XcdBarrier b; b.bar = bar; b.x = xb_xcc_id(); b.st = st;
    if (threadIdx.x == 0) (void)xb_add(&bar[XB_XCNT(b.x)], 1u);
    return b;
}
__device__ __forceinline__ void xcd_barrier_complete(unsigned* bar, unsigned x, unsigned& nloc, unsigned& nx) {
    const unsigned G = gridDim.x * gridDim.y * gridDim.z;
    unsigned sum, cnt, mine, sp = 0u;
    for (;;) {
        sum = 0u; cnt = 0u; mine = 0u;
#pragma unroll
        for (unsigned j = 0; j < 16; ++j) { const unsigned c = xb_ld(&bar[XB_XCNT(j)]); sum += c; cnt += (c > 0u) ? 1u : 0u; mine = (j == x) ? c : mine; }
        if (sum == G) break;
        __builtin_amdgcn_s_sleep(1);
        if ((++sp & 255u) == 0u) { if (xb_ld(&bar[XB_TMO])) break; if (sp > XB_SPIN_CAP) { atomicAdd(&bar[XB_TMO], 1u); break; } }
    }
    nloc = mine > 0u ? mine : 1u; nx = cnt > 0u ? cnt : 1u;
}

__device__ __forceinline__ void xcd_barrier(const XcdBarrier& b) {
    asm volatile("s_waitcnt vmcnt(0)" ::: "memory");
    __syncthreads();
    if (threadIdx.x == 0) {
        unsigned* bar = b.bar;
        __builtin_amdgcn_s_waitcnt(0);
        unsigned nloc = b.st[0], nx = b.st[1];
        if (nloc == 0u) { xcd_barrier_complete(bar, b.x, nloc, nx); b.st[0] = nloc; b.st[1] = nx; }
        const unsigned old = xb_add(&bar[XB_XSUB(b.x)], 1u);
        const unsigned gen = old / nloc;
        if (old + 1u == (gen + 1u) * nloc) {
            __builtin_amdgcn_fence(__ATOMIC_RELEASE, "agent");
            asm volatile("s_waitcnt vmcnt(0)" ::: "memory");
            const unsigned og = xb_add(&bar[XB_TOP], 1u);
            const unsigned tg = og / nx;
            if (og + 1u == (tg + 1u) * nx) xb_add(&bar[XB_TOPGEN], 1u);
            else XB_SPIN(xb_ld(&bar[XB_TOPGEN]) == tg, bar);
            __builtin_amdgcn_fence(__ATOMIC_ACQUIRE, "agent");
            xb_add(&bar[XB_XGEN(b.x)], 1u);
            asm volatile("s_waitcnt vmcnt(0)" ::: "memory");
        } else {
            XB_SPIN(xb_ld(&bar[XB_XGEN(b.x)]) == gen, bar);
            __builtin_amdgcn_fence(__ATOMIC_ACQUIRE, "agent");
            asm volatile("s_waitcnt vmcnt(0)" ::: "memory");
        }
    }
    __syncthreads();
}

constexpr int NWAVES = 8, NTHR = 512;
constexpr int DM = 1024, NB = 8, SEQ = 4096, CTXL = 256, DEPTH = 4;
constexpr int NLAT = NB * SEQ, NCTX = NB * CTXL, NT = NLAT + NCTX;
constexpr int PW = 2304;
constexpr int MW = 1280;
constexpr int NEXP = 32, MAXBLK = 576;
constexpr int NCHK = 544;
constexpr int S5ROWS = 2304;
constexpr int PC_FU = 0, PC_S5 = 256, PC_Q = 512, PC_K = 640, PC_V = 768, PC_R = 1024, PC_Z = 1280, PC_XBC = 1536, PC_A1 = 2048, PC_DT = 2080;
enum { I_X = 0, I_C, I_CTX, I_CCTX, I_ADAW, I_ADAB, I_NMG, I_NFG, I_WIN, I_WOUT, I_FOURW, I_S5LRE, I_S5LIM, I_S5LDT, I_S5BRE, I_S5BIM, I_S5CRE, I_S5CIM, I_S5D, I_S5GLU,
       I_GLAA2, I_GLAAB, I_GLANG, I_SSDCW, I_SSDCB, I_SSDALOG, I_SSDDTB, I_SSDD, I_SSDNG, I_RW, I_RB, I_WGU, I_BGU, I_WDN, I_BDN, I_FING, N_IN };

constexpr size_t al256(size_t x) { return (x + 255) & ~(size_t)255; }
constexpr size_t WS_CTL = 0, CTL_BYTES = 1u << 20;
constexpr size_t WS_MOD = WS_CTL + CTL_BYTES;
constexpr size_t WS_TAB = WS_MOD + al256((size_t)DEPTH * 9 * 6144 * 4);
constexpr size_t TAB_F64 = 0, TAB_TW = 16384, TAB_D256 = 16384 + 32768, TAB_BYTES = 65536;
constexpr size_t WS_A16 = WS_TAB + TAB_BYTES;
constexpr size_t WS_WIN = WS_A16 + al256((size_t)DEPTH * 2 * 16 * 64 * 2 * 4);
constexpr size_t WS_WOUT = WS_WIN + (size_t)DEPTH * PW * DM * 2;
constexpr size_t WS_WGLU = WS_WOUT + (size_t)DEPTH * DM * MW * 2;
constexpr size_t WS_S5P = WS_WGLU + (size_t)DEPTH * 256 * 256 * 2;
constexpr size_t WS_S5B2 = WS_S5P + (size_t)DEPTH * 16 * 256 * 256 * 2;
constexpr size_t WS_WGU = WS_S5B2 + (size_t)DEPTH * 16 * 256 * 512 * 2;
constexpr size_t WS_WDN = WS_WGU + (size_t)DEPTH * NEXP * 2048 * DM;
constexpr size_t WS_XS = WS_WDN + (size_t)DEPTH * NEXP * DM * DM;
constexpr size_t WS_H = WS_XS + (size_t)NT * DM * 2;
constexpr size_t WS_PBUF = WS_H + (size_t)NT * DM * 2;
constexpr size_t WS_A2 = WS_PBUF + (size_t)NT * PW * 2;
constexpr size_t WS_S5S = WS_A2 + (size_t)16 * S5ROWS * 512 * 2;
constexpr size_t WS_ACT5 = WS_S5S + (size_t)16 * S5ROWS * 256 * 4;
constexpr size_t WS_MIX = WS_ACT5 + (size_t)NT * 256 * 2;
constexpr size_t WS_GDS = WS_MIX + (size_t)NT * MW * 2;
constexpr size_t WS_GDEC = WS_GDS + (size_t)NCHK * 8 * 2048 * 4;
constexpr size_t WS_GSE = WS_GDEC + al256((size_t)NCHK * 8 * 32 * 4);
constexpr size_t WS_SDS = WS_GSE + (size_t)NCHK * 8 * 2048 * 2;
constexpr size_t WS_SDEC = WS_SDS + (size_t)NCHK * 8 * 4096 * 4;
constexpr size_t WS_SSE = WS_SDEC + al256((size_t)NCHK * 8 * 4);
constexpr size_t WS_PE = WS_SSE + (size_t)NCHK * 8 * 4096 * 2;
constexpr size_t WS_PR = WS_PE + (size_t)NT * 4 * 4;
constexpr size_t WS_PG = WS_PR + (size_t)NT * 4 * 4;
constexpr size_t WS_PS = WS_PG + (size_t)NT * 4 * 4;
constexpr size_t WS_SG = WS_PS + (size_t)NT * 4 * 4;
constexpr size_t WS_H8 = WS_SG + (size_t)MAXBLK * 256 * 4;
constexpr size_t WS_TM = WS_H8 + (size_t)NT * DM;
constexpr size_t WS_ACT = WS_TM + (size_t)NEXP * NT * 4;
constexpr size_t WS_Y = WS_ACT + (size_t)MAXBLK * 256 * DM;
constexpr size_t WS_GQI = WS_Y + (size_t)MAXBLK * 256 * DM;
constexpr size_t WS_GOI = WS_GQI + (size_t)NT * 256 * 2;
constexpr size_t WS_SCB = WS_GOI + (size_t)NT * 256 * 2;
constexpr size_t WS_SCUM = WS_SCB + (size_t)NT * 128 * 2;
constexpr size_t WS_SYI = WS_SCUM + (size_t)NT * 8 * 4;
constexpr size_t WS_DFTC = WS_SYI + (size_t)NT * 256 * 2;
constexpr size_t WS_GA2T = WS_DFTC + 512 * 256 * 2;
constexpr size_t WS_RWT = WS_GA2T + (size_t)DEPTH * 256 * 32 * 2;
constexpr size_t WS_END = WS_RWT + (size_t)DEPTH * 2 * 32 * 1024 * 2;
constexpr int CW_QUEUE = 64;
constexpr int CW_CNT = 1024;
constexpr int CW_BLKE = 2048;
constexpr int CW_BAR = 8192;

constexpr int LDS_BYTES = 163840, MISC_OFF = LDS_BYTES - 256;

#ifndef INPROJ_F8
#define INPROJ_F8 1
#endif
constexpr float W8_SCALE = 32.f, H8_SCALE = 8.f, A8_SCALE = 4.f, Y8_SCALE = 16.f;
__device__ __forceinline__ unsigned pk4f8(float a, float b, float c, float d) { int w = 0; w = __builtin_amdgcn_cvt_pk_fp8_f32(a, b, w, false); w = __builtin_amdgcn_cvt_pk_fp8_f32(c, d, w, true); return (unsigned)w; }
#define RLX_AGENT __ATOMIC_RELAXED, __HIP_MEMORY_SCOPE_AGENT
__device__ __forceinline__ int fresh_tid(int wave0) { int l = (int)__builtin_amdgcn_mbcnt_hi(~0u, __builtin_amdgcn_mbcnt_lo(~0u, 0u)); asm volatile("" : "+v"(l)); return wave0 * 64 + l; }
__device__ __forceinline__ unsigned f2bf(float f) { unsigned u = __builtin_bit_cast(unsigned, f); return (u + 0x7fffu + ((u >> 16) & 1u)) >> 16; }
__device__ __forceinline__ unsigned pk2(float lo, float hi) { return f2bf(lo) | (f2bf(hi) << 16); }
__device__ __forceinline__ float bf2f(unsigned short b) { return __builtin_bit_cast(float, (unsigned)b << 16); }
__device__ __forceinline__ f32x4 f8x4(unsigned w) { const f32x2 lo = __builtin_amdgcn_cvt_pk_f32_fp8((int)w, false), hi = __builtin_amdgcn_cvt_pk_f32_fp8((int)w, true); return (f32x4){lo.x, lo.y, hi.x, hi.y}; }
__device__ __forceinline__ f32x4 bf4(u32x2 w) { return (f32x4){__builtin_bit_cast(float, w.x << 16), __builtin_bit_cast(float, w.x & 0xffff0000u), __builtin_bit_cast(float, w.y << 16), __builtin_bit_cast(float, w.y & 0xffff0000u)}; }
__device__ __forceinline__ float bflo(unsigned w) { return __builtin_bit_cast(float, w << 16); }
__device__ __forceinline__ float bfhi(unsigned w) { return __builtin_bit_cast(float, w & 0xffff0000u); }
template <int M> __device__ __forceinline__ float swz_xor(float v) { return __builtin_bit_cast(float, __builtin_amdgcn_ds_swizzle(__builtin_bit_cast(int, v), (M << 10) | 0x1F)); }
__device__ __forceinline__ float xor32f(float v, int lane) { return __builtin_bit_cast(float, __builtin_amdgcn_ds_bpermute((lane ^ 32) << 2, __builtin_bit_cast(int, v))); }
__device__ __forceinline__ float wave_sum(float v, int lane) { v += swz_xor<1>(v); v += swz_xor<2>(v); v += swz_xor<4>(v); v += swz_xor<8>(v); v += swz_xor<16>(v); v += xor32f(v, lane); return v; }
__device__ __forceinline__ float wave_max(float v, int lane) { v = fmaxf(v, swz_xor<1>(v)); v = fmaxf(v, swz_xor<2>(v)); v = fmaxf(v, swz_xor<4>(v)); v = fmaxf(v, swz_xor<8>(v)); v = fmaxf(v, swz_xor<16>(v)); v = fmaxf(v, xor32f(v, lane)); return v; }
__device__ __forceinline__ float fexp_(float x) { return __builtin_amdgcn_exp2f(1.4426950408889634f * x); }
__device__ __forceinline__ float frcp_(float x) { return __builtin_amdgcn_rcpf(x); }
__device__ __forceinline__ float sigmoidf_(float x) { return frcp_(1.f + fexp_(-x)); }
__device__ __forceinline__ float siluf_(float x) { return x * frcp_(1.f + fexp_(-x)); }

struct Frame {
    LAS unsigned char* lds; volatile LAS unsigned* MISC; unsigned* ctl; unsigned char* ws;
    int tid, lane, wave, G, bid;
};


template <class Fill> struct SgOrder {
    int nblk, nN, R, r, lo, hi; Fill f;
    __device__ __forceinline__ void init(int nblk_, int nN_, int G, int c) { nblk = nblk_; nN = nN_; const int U = nblk * nN; int x, nx;
        if ((G & 7) == 0) { R = G >> 3; x = c & 7; r = c >> 3; nx = 8; } else { R = G; x = 0; r = c; nx = 1; }
        lo = (int)(((long)x * U) / nx); hi = (int)(((long)(x + 1) * U) / nx); }
    __device__ __forceinline__ bool next(int& cursor, pg8::Unit& u) const {
        const int q = lo + r + R * cursor; ++cursor;
        if (q >= hi) return false;
        const int ups = 8 * nN, sg = q / ups, ql = q - sg * ups, nb = (nblk - sg * 8) < 8 ? (nblk - sg * 8) : 8;
        u.pm = sg * 8 + ql % nb; u.pn = ql / nb; f(u); return true;
    }
};
struct FillPlain { size_t astep, bstep; __device__ __forceinline__ void operator()(pg8::Unit& u) const { u.grp = 0; u.aoff = (size_t)u.pm * astep; u.boff = (size_t)u.pn * bstep; } };
struct FillS5 { size_t bgrp; __device__ __forceinline__ void operator()(pg8::Unit& u) const { const int g = u.pm / 9, t = u.pm - g * 9; u.grp = g; u.pm = t; u.aoff = ((size_t)g * S5ROWS + (size_t)t * 256) * 512 * 2; u.boff = (size_t)g * bgrp; } };
struct FillMoe { const LAS unsigned* lblk; int erows; __device__ __forceinline__ void operator()(pg8::Unit& u) const { const int e = (int)lblk[u.pm]; u.grp = e; u.aoff = (size_t)u.pm * 256 * DM; u.boff = ((size_t)e * erows + (size_t)u.pn * 256) * DM; } };
constexpr int MOE_LB = 131072, MOE_LC = MOE_LB + 256, MOE_LBLK = MOE_LC + 256, MOE_GAT = MOE_LBLK + 2560, MOE_MAXU = 26;
static_assert(MOE_GAT + MOE_MAXU * 1024 <= MISC_OFF, "MoE LDS tables");
__device__ __forceinline__ int moe_tables(Frame& F, int L) {
    LAS int* lb = (LAS int*)(F.lds + MOE_LB); LAS int* lc = (LAS int*)(F.lds + MOE_LC); LAS unsigned* lblk = (LAS unsigned*)(F.lds + MOE_LBLK);
    const unsigned* cnt = F.ctl + CW_CNT + L * 64;
    __syncthreads();
    if (F.tid < 32) lc[F.tid] = (int)__hip_atomic_load(cnt + F.tid, RLX_AGENT);
    __syncthreads();
    if (F.tid == 0) { int acc = 0; for (int e = 0; e < NEXP; ++e) { lb[e] = acc; acc += (lc[e] + 255) & ~255; } lb[32] = acc; }
    __syncthreads();
    const int nblk = lb[32] >> 8;
    for (int i = F.tid; i < nblk; i += NTHR) { int e = 0; for (int q = 1; q < NEXP; ++q) if (lb[q] <= i * 256) e = q; lblk[i] = (unsigned)e; }
    __syncthreads();
    return nblk;
}
using pg8::cvt_pk_bf16;
struct EpiInproj {
    static constexpr bool PERM = true;
    bf16* P; bf16* A2;
    __device__ __forceinline__ void operator()(const f32x4 (&acc)[2][2][4][2], const pg8::Unit& u, int wr, int wc, int fr, int fq) const {
        const int row0 = u.pm * 256 + wr * 64 + fr, col0 = u.pn * 256 + wc * 32 + 8 * fq;
#pragma unroll
        for (int ai = 0; ai < 2; ++ai)
#pragma unroll
            for (int m = 0; m < 4; ++m) {
                const int row = row0 + ai * 128 + m * 16;
#pragma unroll
                for (int bj = 0; bj < 2; ++bj) {
                    constexpr float SC = INPROJ_F8 ? 1.f / (W8_SCALE * H8_SCALE) : 1.f;
                    const f32x4 v0 = acc[ai][bj][m][0] * SC, v1 = acc[ai][bj][m][1] * SC;
                    u32x4 w; w.x = cvt_pk_bf16(v0[0], v0[1]); w.y = cvt_pk_bf16(v0[2], v0[3]); w.z = cvt_pk_bf16(v1[0], v1[1]); w.w = cvt_pk_bf16(v1[2], v1[3]);
                    const int col = col0 + bj * 128;
                    if (u.pn == 1) {
                        const int cc = col - 256, g = cc >> 4, hp = cc & 15;
                        const int crow = row < NLAT ? (row >> 4) : (2048 + ((row - NLAT) >> 4)), s = row & 15;
                        *(u32x4*)(A2 + ((size_t)g * S5ROWS + crow) * 512 + s * 16 + hp) = w;
                    } else if (col < 2088) *(u32x4*)(P + (size_t)row * PW + col) = w;
                }
            }
    }
};
struct EpiOutproj {
    static constexpr bool PERM = true;
    const float* xin; const float* ctxin; bf16* XS; const float* modL; int first;
    __device__ __forceinline__ void operator()(const f32x4 (&acc)[2][2][4][2], const pg8::Unit& u, int wr, int wc, int fr, int fq) const {
        const int rowt = u.pm * 256, bi = rowt < NLAT ? (rowt >> 12) : 8;
        const int row0 = rowt + wr * 64 + fr, col0 = u.pn * 256 + wc * 32 + 8 * fq;
        const float* gate = modL + (size_t)bi * 6144 + 2 * 1024;
        f32x4 gv[2][2];
#pragma unroll
        for (int bj = 0; bj < 2; ++bj)
#pragma unroll
            for (int n = 0; n < 2; ++n) gv[bj][n] = *(const f32x4*)(gate + col0 + bj * 128 + 4 * n);
#pragma unroll
        for (int ai = 0; ai < 2; ++ai)
#pragma unroll
            for (int m = 0; m < 4; ++m) {
                const int row = row0 + ai * 128 + m * 16;
                bf16* dst = XS + (size_t)row * DM;
#pragma unroll
                for (int bj = 0; bj < 2; ++bj) { const int c = col0 + bj * 128; f32x4 x0, x1;
                    if (first) { const float* src = (row < NLAT ? xin + (size_t)row * DM : ctxin + (size_t)(row - NLAT) * DM) + c; x0 = *(const f32x4*)src; x1 = *(const f32x4*)(src + 4); }
                    else { const u32x4 w = *(const u32x4*)(dst + c); x0 = bf4((u32x2){w.x, w.y}); x1 = bf4((u32x2){w.z, w.w}); }
                    x0 += gv[bj][0] * acc[ai][bj][m][0]; x1 += gv[bj][1] * acc[ai][bj][m][1];
                    u32x4 o; o.x = cvt_pk_bf16(x0[0], x0[1]); o.y = cvt_pk_bf16(x0[2], x0[3]); o.z = cvt_pk_bf16(x1[0], x1[1]); o.w = cvt_pk_bf16(x1[2], x1[3]);
                    *(u32x4*)(dst + c) = o; }
            }
    }
};
struct EpiSwiglu {
    static constexpr bool PERM = true;
    unsigned char* ACT; const float* bgu;
    static constexpr int NPRE = 1, PRE_OFF = MOE_GAT + MOE_MAXU * 1024;
    __device__ __forceinline__ const void* pre_src(int, const pg8::Unit& u) const { return bgu + (size_t)u.grp * 2048 + u.pn * 256; }
    __device__ __forceinline__ void operator()(const f32x4 (&acc)[2][2][4][2], const pg8::Unit& u, int wr, int wc, int fr, int fq, const LAS float* pre) const {
        const int row0 = u.pm * 256 + wr * 64 + fr, i0 = u.pn * 128 + wc * 32 + 8 * fq;
        const LAS float* bb = pre + wc * 64 + 16 * fq;
        const f32x4 b0 = *(const LAS f32x4*)(bb), b1 = *(const LAS f32x4*)(bb + 4), b2 = *(const LAS f32x4*)(bb + 8), b3 = *(const LAS f32x4*)(bb + 12);
        const float bg[8] = {b0[0], b0[2], b1[0], b1[2], b2[0], b2[2], b3[0], b3[2]}, bu[8] = {b0[1], b0[3], b1[1], b1[3], b2[1], b2[3], b3[1], b3[3]};
        constexpr float inv = 1.f / (H8_SCALE * W8_SCALE);
#pragma unroll
        for (int ai = 0; ai < 2; ++ai)
#pragma unroll
            for (int m = 0; m < 4; ++m) {
                const int row = row0 + ai * 128 + m * 16;
                float o[8];
#pragma unroll
                for (int n = 0; n < 2; ++n)
#pragma unroll
                    for (int jp = 0; jp < 2; ++jp) {
                        const int q = 4 * n + 2 * jp;
                        f32x2 gt = (f32x2){acc[ai][0][m][n][2 * jp], acc[ai][0][m][n][2 * jp + 1]} * inv + (f32x2){bg[q], bg[q + 1]};
                        f32x2 up = (f32x2){acc[ai][1][m][n][2 * jp], acc[ai][1][m][n][2 * jp + 1]} * inv + (f32x2){bu[q], bu[q + 1]};
                        gt.x = fminf(gt.x, 7.0f); gt.y = fminf(gt.y, 7.0f);
                        up.x = __builtin_amdgcn_fmed3f(up.x, -7.0f, 7.0f); up.y = __builtin_amdgcn_fmed3f(up.y, -7.0f, 7.0f);
                        const f32x2 ea = gt * (-1.702f * 1.4426950408889634f);
                        f32x2 den; den.x = __builtin_amdgcn_exp2f(ea.x); den.y = __builtin_amdgcn_exp2f(ea.y); den = den + 1.0f;
                        f32x2 sg; sg.x = __builtin_amdgcn_rcpf(den.x); sg.y = __builtin_amdgcn_rcpf(den.y);
                        const f32x2 r = (up * A8_SCALE + A8_SCALE) * gt * sg;
                        o[q] = r.x; o[q + 1] = r.y;
                    }
                u32x2 w; w.x = pk4f8(o[0], o[1], o[2], o[3]); w.y = pk4f8(o[4], o[5], o[6], o[7]);
                *(u32x2*)(ACT + (size_t)row * DM + i0) = w;
            }
    }
};
struct EpiDown {
    static constexpr int PERM = 2;
    unsigned char* Y; const float* bdn; const float* sg;
    static constexpr int NPRE = 2, PRE_OFF = MOE_GAT;
    __device__ __forceinline__ const void* pre_src(int i, const pg8::Unit& u) const { return i == 0 ? (const void*)(bdn + (size_t)u.grp * DM + u.pn * 256) : (const void*)(sg + (size_t)u.pm * 256); }
    __device__ __forceinline__ void operator()(const f32x4 (&acc)[2][2][4][2], const pg8::Unit& u, int wr, int wc, int fr, int fq, const LAS float* pre) const {
        const int row0 = u.pm * 256 + wr * 64 + fr, col0 = u.pn * 256 + wc * 64 + 16 * fq;
        const LAS float* bb = pre + wc * 64 + 16 * fq;
        constexpr float inv = 1.f / (A8_SCALE * W8_SCALE);
        f32x4 bv[2][2];
#pragma unroll
        for (int bj = 0; bj < 2; ++bj)
#pragma unroll
            for (int n = 0; n < 2; ++n) bv[bj][n] = *(const LAS f32x4*)(bb + 8 * bj + 4 * n);
#pragma unroll
        for (int ai = 0; ai < 2; ++ai)
#pragma unroll
            for (int m = 0; m < 4; ++m) {
                const int row = row0 + ai * 128 + m * 16; const float gt = pre[256 + wr * 64 + fr + ai * 128 + m * 16] * Y8_SCALE;
                u32x4 w;
                { const f32x4 v0 = (acc[ai][0][m][0] * inv + bv[0][0]) * gt, v1 = (acc[ai][0][m][1] * inv + bv[0][1]) * gt; w.x = pk4f8(v0[0], v0[1], v0[2], v0[3]); w.y = pk4f8(v1[0], v1[1], v1[2], v1[3]); }
                { const f32x4 v0 = (acc[ai][1][m][0] * inv + bv[1][0]) * gt, v1 = (acc[ai][1][m][1] * inv + bv[1][1]) * gt; w.z = pk4f8(v0[0], v0[1], v0[2], v0[3]); w.w = pk4f8(v1[0], v1[1], v1[2], v1[3]); }
                *(u32x4*)(Y + (size_t)row * DM + col0) = w;
            }
    }
};
struct EpiNull { static constexpr bool PERM = true; float* sink;
    __device__ __forceinline__ void operator()(const f32x4 (&acc)[2][2][4][2], const pg8::Unit& u, int wr, int wc, int fr, int fq) const { float s = 0.f;
#pragma unroll
        for (int ai = 0; ai < 2; ++ai)
#pragma unroll
            for (int bj = 0; bj < 2; ++bj)
#pragma unroll
                for (int m = 0; m < 4; ++m)
#pragma unroll
                    for (int n = 0; n < 2; ++n) s += acc[ai][bj][m][n][0];
        if (s == 12345.678f) sink[u.pm] = s; } };
struct EpiS5S {
    static constexpr bool PERM = false;
    float* S;
    __device__ __forceinline__ void operator()(const f32x4 (&acc)[2][2][4][2], const pg8::Unit& u, int wr, int wc, int fr, int fq) const {
        const int row0 = u.pm * 256 + wr * 64 + fr, col0 = wc * 32 + 4 * fq;
        float* base = S + (size_t)u.grp * S5ROWS * 256;
#pragma unroll
        for (int ai = 0; ai < 2; ++ai)
#pragma unroll
            for (int m = 0; m < 4; ++m) { float* rp = base + (size_t)(row0 + ai * 128 + m * 16) * 256 + col0;
#pragma unroll
                for (int bj = 0; bj < 2; ++bj)
#pragma unroll
                    for (int n = 0; n < 2; ++n) *(f32x4*)(rp + bj * 128 + n * 16) = acc[ai][bj][m][n]; }
    }
};
__device__ __forceinline__ float gelu_tanh(float x) { const float t = 0.7978845608f * (x + 0.044715f * x * x * x); return x * frcp_(1.f + fexp_(-2.f * t)); }
struct EpiS5Y {
    static constexpr bool PERM = true;
    bf16* ACT5;
    __device__ __forceinline__ void operator()(const f32x4 (&acc)[2][2][4][2], const pg8::Unit& u, int wr, int wc, int fr, int fq) const {
        const int row0 = u.pm * 256 + wr * 64 + fr, col0 = wc * 32 + 8 * fq;
#pragma unroll
        for (int ai = 0; ai < 2; ++ai)
#pragma unroll
            for (int m = 0; m < 4; ++m) {
                const int crow = row0 + ai * 128 + m * 16;
                if (crow >= 2176) continue;
                const int tok0 = crow < 2048 ? crow * 16 : NLAT + (crow - 2048) * 16;
#pragma unroll
                for (int bj = 0; bj < 2; ++bj) {
                    const int col = col0 + bj * 128, j = col >> 4, h = col & 15;
                    const f32x4 v0 = acc[ai][bj][m][0], v1 = acc[ai][bj][m][1];
                    u32x4 w; w.x = cvt_pk_bf16(gelu_tanh(v0[0]), gelu_tanh(v0[1])); w.y = cvt_pk_bf16(gelu_tanh(v0[2]), gelu_tanh(v0[3]));
                    w.z = cvt_pk_bf16(gelu_tanh(v1[0]), gelu_tanh(v1[1])); w.w = cvt_pk_bf16(gelu_tanh(v1[2]), gelu_tanh(v1[3]));
                    *(u32x4*)(ACT5 + (size_t)(tok0 + j) * 256 + u.grp * 16 + h) = w;
                }
            }
    }
};
struct EpiGlu {
    static constexpr bool PERM = true;
    const bf16* ACT5; bf16* MIX;
    __device__ __forceinline__ void operator()(const f32x4 (&acc)[2][2][4][2], const pg8::Unit& u, int wr, int wc, int fr, int fq) const {
        const int row0 = u.pm * 256 + wr * 64 + fr, col0 = wc * 32 + 8 * fq;
#pragma unroll
        for (int ai = 0; ai < 2; ++ai)
#pragma unroll
            for (int m = 0; m < 4; ++m) {
                const int row = row0 + ai * 128 + m * 16;
#pragma unroll
                for (int bj = 0; bj < 2; ++bj) {
                    const int col = col0 + bj * 128;
                    const u32x4 a = *(const u32x4*)(ACT5 + (size_t)row * 256 + col);
                    const f32x4 v0 = acc[ai][bj][m][0], v1 = acc[ai][bj][m][1];
                    u32x4 w;
                    w.x = cvt_pk_bf16(bflo(a.x) * sigmoidf_(v0[0]), bfhi(a.x) * sigmoidf_(v0[1])); w.y = cvt_pk_bf16(bflo(a.y) * sigmoidf_(v0[2]), bfhi(a.y) * sigmoidf_(v0[3]));
                    w.z = cvt_pk_bf16(bflo(a.z) * sigmoidf_(v1[0]), bfhi(a.z) * sigmoidf_(v1[1])); w.w = cvt_pk_bf16(bflo(a.w) * sigmoidf_(v1[2]), bfhi(a.w) * sigmoidf_(v1[3]));
                    *(u32x4*)(MIX + (size_t)row * MW + 512 + col) = w;
                }
            }
    }
};

struct Args { const float* in[N_IN]; float* out; unsigned char* ws; int ph_lo, ph_hi; };
typedef const __attribute__((address_space(4))) Args CArgs;
__device__ __forceinline__ CArgs* fresh_args() { CArgs* p = (CArgs*)__builtin_amdgcn_kernarg_segment_ptr(); asm volatile("" : "+s"(p)); return p; }

template <class Map> __device__ __forceinline__ void transpose_tile(const float* W, int ldw, int ncols, int k0, int n0, bf16* WT, int ldt, int kd0, const Map& map, LAS float* scr, int lane) {
    { const int c4 = (lane & 15) * 4, r4 = lane >> 4; const bool ok = n0 + c4 < ncols;
#pragma unroll
      for (int q = 0; q < 16; ++q) { const int kk = q * 4 + r4; const f32x4 v = ok ? *(const f32x4*)(W + (size_t)(k0 + kk) * ldw + n0 + c4) : (f32x4){0.f, 0.f, 0.f, 0.f};
          scr[kk * 65 + c4] = v[0]; scr[kk * 65 + c4 + 1] = v[1]; scr[kk * 65 + c4 + 2] = v[2]; scr[kk * 65 + c4 + 3] = v[3]; } }
    asm volatile("s_waitcnt lgkmcnt(0)" ::: "memory");
    const int c = lane & 7;
#pragma unroll
    for (int j = 0; j < 8; ++j) {
        const int n = (lane >> 3) + 8 * j; const LAS float* s = scr + (8 * c) * 65 + n;
        u32x4 o; o.x = pk2(s[0], s[65]); o.y = pk2(s[2 * 65], s[3 * 65]); o.z = pk2(s[4 * 65], s[5 * 65]); o.w = pk2(s[6 * 65], s[7 * 65]);
        const int dr = (n0 + n) < ncols ? map(n0 + n) : -1;
        if (dr >= 0) *(u32x4*)(WT + (size_t)dr * ldt + kd0 + 8 * c) = o;
    }
    asm volatile("s_waitcnt lgkmcnt(0)" ::: "memory");
}
struct MapId { __device__ __forceinline__ int operator()(int n) const { return n; } };
struct MapWin { __device__ __forceinline__ int operator()(int c) const { return c < 1280 ? c : (c < 1312 ? 2048 + (c - 1280) : (c < 2080 ? c - 32 : c)); } };
struct MapGu { __device__ __forceinline__ int operator()(int n) const { const int i = n >> 1; return (i >> 7) * 256 + (n & 1) * 128 + (i & 127); } };

template <class Map> __device__ __forceinline__ void transpose_tile_f8(const float* W, int ldw, int k0, int n0, unsigned char* WT, int ldt, const Map& map, LAS float* scr, int lane) {
    { const int c4 = (lane & 15) * 4, r4 = lane >> 4;
#pragma unroll
      for (int q = 0; q < 16; ++q) { const int kk = q * 4 + r4; const f32x4 v = *(const f32x4*)(W + (size_t)(k0 + kk) * ldw + n0 + c4);
          scr[kk * 65 + c4] = v[0]; scr[kk * 65 + c4 + 1] = v[1]; scr[kk * 65 + c4 + 2] = v[2]; scr[kk * 65 + c4 + 3] = v[3]; } }
    asm volatile("s_waitcnt lgkmcnt(0)" ::: "memory");
    const int c = lane & 7;
#pragma unroll
    for (int j = 0; j < 8; ++j) {
        const int n = (lane >> 3) + 8 * j; const LAS float* s = scr + (8 * c) * 65 + n;
        u32x2 o; o.x = pk4f8(s[0] * W8_SCALE, s[65] * W8_SCALE, s[2 * 65] * W8_SCALE, s[3 * 65] * W8_SCALE); o.y = pk4f8(s[4 * 65] * W8_SCALE, s[5 * 65] * W8_SCALE, s[6 * 65] * W8_SCALE, s[7 * 65] * W8_SCALE);
        *(u32x2*)(WT + (size_t)map(n0 + n) * ldt + k0 + 8 * c) = o;
    }
    asm volatile("s_waitcnt lgkmcnt(0)" ::: "memory");
}
constexpr int PI_ADA = 48, PI_TAB = 1, PI_RWT = 16, PI_S5 = 64, PI_FOLD = 256, PI_ZERO = 4;
constexpr int TW_WIN = 16 * 33, TW_GU = 32 * 16 * 32, TW_DN = 32 * 16 * 16, TW_WOUT = 12 * 16, TW_GLU = 16, TW_LAYER = TW_WIN + TW_GU + TW_DN + TW_WOUT + TW_GLU;
constexpr int PI_TR = (DEPTH * TW_LAYER + 7) / 8;
constexpr int PI_B_TAB = PI_ADA, PI_B_RWT = PI_B_TAB + PI_TAB, PI_B_S5 = PI_B_RWT + PI_RWT, PI_B_FOLD = PI_B_S5 + PI_S5, PI_B_ZERO = PI_B_FOLD + PI_FOLD, PI_B_TR = PI_B_ZERO + PI_ZERO, PI_TOTAL = PI_B_TR + (PI_TR + 3) / 4;

__device__ __forceinline__ void pro_adaln(Frame& F, CArgs& a, int it) {
    const int L = it / 12, cb = it % 12;
    LAS float* cond = (LAS float*)F.lds;
    for (int i = F.tid; i < 9 * 1024; i += NTHR) { const int r = i >> 10, k = i & 1023; const float v = r < 8 ? a.in[I_C][r * 1024 + k] : a.in[I_CCTX][k]; cond[i] = siluf_(v); }
    __syncthreads();
    const int n = cb * 512 + F.tid;
    const float* w = a.in[I_ADAW] + (size_t)L * 1024 * 6144 + n;
    float acc[9];
    const float b = a.in[I_ADAB][L * 6144 + n];
#pragma unroll
    for (int r = 0; r < 9; ++r) acc[r] = b;
#pragma unroll 8
    for (int k = 0; k < 1024; k += 4) {
        const float w0 = w[(size_t)k * 6144], w1 = w[(size_t)(k + 1) * 6144], w2 = w[(size_t)(k + 2) * 6144], w3 = w[(size_t)(k + 3) * 6144];
#pragma unroll
        for (int r = 0; r < 9; ++r) { const f32x4 c4 = *(const LAS f32x4*)(cond + r * 1024 + k); acc[r] += c4[0] * w0 + c4[1] * w1 + c4[2] * w2 + c4[3] * w3; }
    }
    float* mod = (float*)(F.ws + WS_MOD) + (size_t)L * 9 * 6144 + n;
#pragma unroll
    for (int r = 0; r < 9; ++r) mod[(size_t)r * 6144] = acc[r];
    __syncthreads();
}
__device__ __forceinline__ void pro_tables(Frame& F, CArgs& a) {
    { bf16* gt = (bf16*)(F.ws + WS_GA2T);
      for (int i = F.tid; i < DEPTH * 256 * 32; i += NTHR) { const int L = i >> 13, col = (i >> 5) & 255, k = i & 31, r = col >> 7, c = col & 127;
          gt[i] = (bf16)f2bf((k >> 4) == r ? a.in[I_GLAA2][((size_t)(L * 2 + r) * 16 + (k & 15)) * 128 + c] : 0.f); } }
    bf16* f64 = (bf16*)(F.ws + WS_TAB + TAB_F64);
    for (int i = F.tid; i < 4096; i += NTHR) { const int k = i >> 6, n = i & 63; float s, c; sincospif((float)((k * n) & 63) / 32.f, &s, &c); f64[i] = (bf16)f2bf(c); f64[4096 + i] = (bf16)f2bf(s); }
    float* tw = (float*)(F.ws + WS_TAB + TAB_TW);
    for (int i = F.tid; i < 4096; i += NTHR) { float s, c; sincospif((float)i / 2048.f, &s, &c); tw[2 * i] = c; tw[2 * i + 1] = s; }
    bf16* dc = (bf16*)(F.ws + WS_DFTC);
    for (int i = F.tid; i < 65536; i += NTHR) { const int k = i >> 8, n = i & 255; float s, c; sincospif((float)((k * n) & 255) / 128.f, &s, &c); dc[i] = (bf16)f2bf(c); dc[65536 + i] = (bf16)f2bf(-s); }
    float* d256 = (float*)(F.ws + WS_TAB + TAB_D256);
    for (int i = F.tid; i < 256; i += NTHR) { float s, c; sincospif((float)i / 128.f, &s, &c); d256[2 * i] = c; d256[2 * i + 1] = s; }
}
__device__ __forceinline__ void pro_fold(Frame& F, CArgs& a, int it) {
    const int L = it >> 6, h = (it >> 4) & 3, nb = it & 15, n0 = nb * 64;
    LAS float* fw = (LAS float*)F.lds;
    LAS float* ct = fw + 64 * 65;
    LAS float* swo = ct + 64;
    LAS float* sfo = swo + 256 * 64;
    if (F.tid < 64) ct[F.tid] = cospif((float)F.tid / 32.f);
    const float* four = a.in[I_FOURW] + (size_t)L * 256 * 256 + (size_t)h * 64 * 256, *wo = a.in[I_WOUT] + (size_t)L * 1024 * 1024 + n0;
    { f32x4 va[8], vb[8];
#pragma unroll
      for (int k = 0; k < 8; ++k) { const int i = F.tid + k * NTHR, j = i >> 4, c4 = (i & 15) * 4; va[k] = *(const f32x4*)(wo + (size_t)j * 1024 + c4); vb[k] = *(const f32x4*)(four + (size_t)i * 4); }
#pragma unroll
      for (int k = 0; k < 8; ++k) { const int i = F.tid + k * NTHR, j = i >> 4, c4 = (i & 15) * 4; *(LAS f32x4*)(swo + j * 64 + c4) = va[k]; *(LAS f32x4*)(sfo + i * 4) = vb[k]; } }
    __syncthreads();
    const int n = F.tid & 63, cg = F.tid >> 6;
    { float s[8];
#pragma unroll
      for (int i = 0; i < 8; ++i) s[i] = 0.f;
#pragma unroll 4
      for (int j = 0; j < 256; j += 4) { const float w0 = swo[j * 64 + n], w1 = swo[(j + 1) * 64 + n], w2 = swo[(j + 2) * 64 + n], w3 = swo[(j + 3) * 64 + n];
#pragma unroll
          for (int i = 0; i < 8; ++i) { const f32x4 f4 = *(const LAS f32x4*)(sfo + (cg * 8 + i) * 256 + j); s[i] += f4[0] * w0 + f4[1] * w1 + f4[2] * w2 + f4[3] * w3; } }
#pragma unroll
      for (int i = 0; i < 8; ++i) fw[(cg * 8 + i) * 65 + n] = s[i]; }
    __syncthreads();
    float oc[8], os[8];
#pragma unroll
    for (int i = 0; i < 8; ++i) { oc[i] = 0.f; os[i] = 0.f; }
    for (int kc = 0; kc < 64; ++kc) { const float v = fw[kc * 65 + n];
#pragma unroll
        for (int i = 0; i < 8; ++i) { const int mm = (kc * (cg * 8 + i)) & 63; oc[i] += ct[mm] * v; os[i] += ct[(mm + 48) & 63] * v; } }
    bf16* wt = (bf16*)(F.ws + WS_WOUT) + (size_t)L * DM * MW + (size_t)(n0 + n) * MW + h * 64 + cg * 8;
    u32x4 w; w.x = pk2(oc[0] * 0.125f, oc[1] * 0.125f); w.y = pk2(oc[2] * 0.125f, oc[3] * 0.125f); w.z = pk2(oc[4] * 0.125f, oc[5] * 0.125f); w.w = pk2(oc[6] * 0.125f, oc[7] * 0.125f);
    *(u32x4*)wt = w;
    w.x = pk2(os[0] * 0.125f, os[1] * 0.125f); w.y = pk2(os[2] * 0.125f, os[3] * 0.125f); w.z = pk2(os[4] * 0.125f, os[5] * 0.125f); w.w = pk2(os[6] * 0.125f, os[7] * 0.125f);
    *(u32x4*)(wt + 256) = w;
    __syncthreads();
}
__device__ __forceinline__ void pro_s5(Frame& F, CArgs& a, int it) {
    const int L = it >> 4, g = it & 15;
    LAS float* pw = (LAS float*)F.lds;
    LAS float* bb = pw + 2 * 64 * 17 * 2;
    LAS float* cm = bb + 2 * 64 * 16 * 2;
    LAS float* kt = cm + 2 * 16 * 64 * 2;
    for (int i = F.tid; i < 2 * 64 * 17; i += NTHR) {
        const int r = i / (64 * 17), p = (i / 17) & 63, e = i % 17; const size_t q = ((size_t)(L * 2 + r) * 16 + g) * 64 + p;
        const float dt = __expf(a.in[I_S5LDT][(L * 2 + r) * 16 + g]); const float lr = a.in[I_S5LRE][q] * dt, li = a.in[I_S5LIM][q] * dt;
        float s, c; sincosf(li * (float)e, &s, &c); const float m = expf(lr * (float)e); pw[2 * i] = m * c; pw[2 * i + 1] = m * s;
    }
    for (int i = F.tid; i < 2 * 64 * 16; i += NTHR) {
        const int r = i >> 10, p = (i >> 4) & 63, h = i & 15; const size_t q = ((size_t)(L * 2 + r) * 16 + g) * 64 + p;
        const float dt = __expf(a.in[I_S5LDT][(L * 2 + r) * 16 + g]); const float lre = a.in[I_S5LRE][q], lim = a.in[I_S5LIM][q];
        float s, c; sincosf(lim * dt, &s, &c); const float m = expf(lre * dt); const float ar = m * c - 1.f, ai = m * s;
        const float den = 1.f / (lre * lre + lim * lim); const float cr = (ar * lre + ai * lim) * den, ci = (ai * lre - ar * lim) * den;
        const float br = a.in[I_S5BRE][q * 16 + h], bi = a.in[I_S5BIM][q * 16 + h];
        bb[2 * i] = cr * br - ci * bi; bb[2 * i + 1] = cr * bi + ci * br;
    }
    for (int i = F.tid; i < 2 * 16 * 64; i += NTHR) {
        const int r = i >> 10, h = (i >> 6) & 15, p = i & 63; const size_t q = (((size_t)(L * 2 + r) * 16 + g) * 16 + h) * 64 + p;
        cm[2 * i] = a.in[I_S5CRE][q]; cm[2 * i + 1] = a.in[I_S5CIM][q];
    }
    __syncthreads();
    for (int i = F.tid; i < 2 * 16 * 256; i += NTHR) {
        const int r = i >> 12, tau = (i >> 8) & 15, h = (i >> 4) & 15, hp = i & 15; float s = 0.f;
        for (int p = 0; p < 64; ++p) { const float cr = cm[2 * ((r * 16 + h) * 64 + p)], ci = cm[2 * ((r * 16 + h) * 64 + p) + 1];
            const float ar = pw[2 * ((r * 64 + p) * 17 + tau)], ai = pw[2 * ((r * 64 + p) * 17 + tau) + 1]; const float br = bb[2 * ((r * 64 + p) * 16 + hp)], bi = bb[2 * ((r * 64 + p) * 16 + hp) + 1];
            const float tr = cr * ar - ci * ai, ti = cr * ai + ci * ar; s += tr * br - ti * bi; }
        kt[i] = s;
    }
    __syncthreads();
    bf16* pt = (bf16*)(F.ws + WS_S5P) + (size_t)(L * 16 + g) * 256 * 256;
    for (int i = F.tid; i < 65536; i += NTHR) {
        const int np = i >> 8, k = i & 255, r = np >> 7, cpx = (np >> 6) & 1, p = np & 63, s = k >> 4, hp = k & 15, e = r ? s : 15 - s;
        const float ar = pw[2 * ((r * 64 + p) * 17 + e)], ai = pw[2 * ((r * 64 + p) * 17 + e) + 1]; const float br = bb[2 * ((r * 64 + p) * 16 + hp)], bi = bb[2 * ((r * 64 + p) * 16 + hp) + 1];
        pt[i] = (bf16)f2bf(cpx ? ar * bi + ai * br : ar * br - ai * bi);
    }
    bf16* b2 = (bf16*)(F.ws + WS_S5B2) + (size_t)(L * 16 + g) * 256 * 512;
    const float* dsk = a.in[I_S5D] + L * 256 + g * 16;
    for (int i = F.tid; i < 131072; i += NTHR) {
        const int n = i >> 9, k = i & 511, j = n >> 4, h = n & 15; float v;
        if (k < 256) { const int s = k >> 4, hp = k & 15; v = 0.f;
            if (j >= s) v += kt[((0 * 16 + (j - s)) * 16 + h) * 16 + hp];
            if (j <= s) v += kt[((1 * 16 + (s - j)) * 16 + h) * 16 + hp];
            if (j == s && h == hp) v += dsk[h];
        } else { const int kk = k - 256, r = kk >> 7, cpx = (kk >> 6) & 1, p = kk & 63, e = r ? 16 - j : j + 1;
            const float cr = cm[2 * ((r * 16 + h) * 64 + p)], ci = cm[2 * ((r * 16 + h) * 64 + p) + 1]; const float ar = pw[2 * ((r * 64 + p) * 17 + e)], ai = pw[2 * ((r * 64 + p) * 17 + e) + 1];
            v = cpx ? -(cr * ai + ci * ar) : (cr * ar - ci * ai); }
        b2[i] = (bf16)f2bf(v);
    }
    float* a16 = (float*)(F.ws + WS_A16) + (size_t)((L * 2) * 16 + g) * 128;
    if (F.tid < 128) { const int r = F.tid >> 6, p = F.tid & 63; float* o = a16 + (size_t)r * 16 * 128 + p * 2; o[0] = pw[2 * ((r * 64 + p) * 17 + 16)]; o[1] = pw[2 * ((r * 64 + p) * 17 + 16) + 1]; }
    __syncthreads();
}
struct TDesc { const float* src; unsigned char* dst; int ldw, ncols, k0, n0, ldt, kd0, kind, valid; };
__device__ __forceinline__ TDesc tr_decode(Frame& F, int wi) {
    TDesc d; d.valid = wi < DEPTH * TW_LAYER; d.src = nullptr; d.dst = nullptr; d.ldw = d.ncols = d.k0 = d.n0 = d.ldt = d.kd0 = d.kind = 0;
    if (!d.valid) return d;
    const int L = wi / TW_LAYER; int r = wi % TW_LAYER;
    if (r < TW_GU) { const int t = r >> 5, li = r & 31, e = t >> 4, kb = 4 * ((t >> 2) & 3) + (li >> 3), nb = 8 * (t & 3) + (li & 7); d.src = fresh_args()->in[I_WGU] + ((size_t)L * NEXP + e) * DM * 2048; d.ldw = 2048; d.ncols = 2048; d.k0 = kb * 64; d.n0 = nb * 64; d.dst = F.ws + WS_WGU + ((size_t)L * NEXP + e) * 2048 * DM; d.ldt = DM; d.kd0 = kb * 64; d.kind = 1; return d; } r -= TW_GU;
    if (r < TW_DN) { const int t = r >> 5, li = r & 31, e = t >> 3, kb = 4 * ((t >> 1) & 3) + (li >> 3), nb = 8 * (t & 1) + (li & 7); d.src = fresh_args()->in[I_WDN] + ((size_t)L * NEXP + e) * DM * DM; d.ldw = DM; d.ncols = DM; d.k0 = kb * 64; d.n0 = nb * 64; d.dst = F.ws + WS_WDN + ((size_t)L * NEXP + e) * DM * DM; d.ldt = DM; d.kd0 = kb * 64; d.kind = 2; return d; } r -= TW_DN;
    if (r < TW_WIN) { const int kb = r / 33, nb = r % 33; d.src = fresh_args()->in[I_WIN] + (size_t)L * DM * 2088; d.ldw = 2088; d.ncols = 2088; d.k0 = kb * 64; d.n0 = nb * 64; d.dst = F.ws + WS_WIN + (size_t)L * PW * DM * (INPROJ_F8 ? 1 : 2); d.ldt = DM; d.kd0 = kb * 64; d.kind = INPROJ_F8 ? 4 : 0; return d; } r -= TW_WIN;
    if (r < TW_WOUT) { const int kb = r >> 4, nb = r & 15; d.src = fresh_args()->in[I_WOUT] + (size_t)L * DM * DM + (size_t)256 * DM; d.ldw = DM; d.ncols = DM; d.k0 = kb * 64; d.n0 = nb * 64; d.dst = F.ws + WS_WOUT + (size_t)L * DM * MW * 2; d.ldt = MW; d.kd0 = 512 + kb * 64; d.kind = 3; return d; } r -= TW_WOUT;
    { const int kb = r >> 2, nb = r & 3; d.src = fresh_args()->in[I_S5GLU] + (size_t)L * 256 * 256; d.ldw = 256; d.ncols = 256; d.k0 = kb * 64; d.n0 = nb * 64; d.dst = F.ws + WS_WGLU + (size_t)L * 256 * 256 * 2; d.ldt = 256; d.kd0 = kb * 64; d.kind = 3; }
    return d;
}
__device__ __forceinline__ void tr_load(const TDesc& d, f32x4 (&v)[16], int lane) {
    if (!d.valid) return;
    const int c4 = (lane & 15) * 4, r4 = lane >> 4; const bool ok = d.n0 + c4 < d.ncols;
#pragma unroll
    for (int q = 0; q < 16; ++q) v[q] = ok ? __builtin_nontemporal_load((const f32x4*)(d.src + (size_t)(d.k0 + 16 * r4 + q) * d.ldw + d.n0 + c4)) : (f32x4){0.f, 0.f, 0.f, 0.f};
}
__device__ __forceinline__ void tr_finish(const TDesc& d, const f32x4 (&v)[16], LAS float* scr, int lane) {
    if (!d.valid) return;
    const int c4 = (lane & 15) * 4, r4 = lane >> 4;
    if (d.n0 + c4 >= d.ncols) return;
    if (d.kind == 1 || d.kind == 2 || d.kind == 4) {
#pragma unroll
        for (int i = 0; i < 4; ++i) { const int nn = d.n0 + c4 + i, dr = d.kind == 1 ? MapGu()(nn) : (d.kind == 4 ? MapWin()(nn) : nn);
            u32x4 o; o.x = pk4f8(v[0][i] * W8_SCALE, v[1][i] * W8_SCALE, v[2][i] * W8_SCALE, v[3][i] * W8_SCALE); o.y = pk4f8(v[4][i] * W8_SCALE, v[5][i] * W8_SCALE, v[6][i] * W8_SCALE, v[7][i] * W8_SCALE);
            o.z = pk4f8(v[8][i] * W8_SCALE, v[9][i] * W8_SCALE, v[10][i] * W8_SCALE, v[11][i] * W8_SCALE); o.w = pk4f8(v[12][i] * W8_SCALE, v[13][i] * W8_SCALE, v[14][i] * W8_SCALE, v[15][i] * W8_SCALE);
            *(u32x4*)(d.dst + (size_t)dr * d.ldt + d.kd0 + 16 * r4) = o; }
    } else {
#pragma unroll
        for (int i = 0; i < 4; ++i) { const int nn = d.n0 + c4 + i, dr = d.kind == 0 ? MapWin()(nn) : nn;
            u32x4 o0, o1; o0.x = pk2(v[0][i], v[1][i]); o0.y = pk2(v[2][i], v[3][i]); o0.z = pk2(v[4][i], v[5][i]); o0.w = pk2(v[6][i], v[7][i]);
            o1.x = pk2(v[8][i], v[9][i]); o1.y = pk2(v[10][i], v[11][i]); o1.z = pk2(v[12][i], v[13][i]); o1.w = pk2(v[14][i], v[15][i]);
            bf16* p = (bf16*)d.dst + (size_t)dr * d.ldt + d.kd0 + 16 * r4; *(u32x4*)p = o0; *(u32x4*)(p + 8) = o1; }
    }
}
__device__ __forceinline__ void pro_transposes4(Frame& F, int ticket) {
    LAS float* scr = (LAS float*)F.lds + F.wave * (64 * 65);
    const int w0 = ticket * 32 + F.wave;
    f32x4 va[16], vb[16];
    const TDesc d0 = tr_decode(F, w0); tr_load(d0, va, F.lane);
    const TDesc d1 = tr_decode(F, w0 + 8); tr_load(d1, vb, F.lane); tr_finish(d0, va, scr, F.lane);
    const TDesc d2 = tr_decode(F, w0 + 16); tr_load(d2, va, F.lane); tr_finish(d1, vb, scr, F.lane);
    const TDesc d3 = tr_decode(F, w0 + 24); tr_load(d3, vb, F.lane); tr_finish(d2, va, scr, F.lane);
    tr_finish(d3, vb, scr, F.lane);
}
__device__ __forceinline__ void pro_rwt(Frame& F, CArgs& a, int it) {
    const int L = it >> 2, kb = (it & 3) * 256; bf16* rt = (bf16*)(F.ws + WS_RWT) + (size_t)L * 65536;
    for (int i = F.tid; i < 256 * 32; i += NTHR) { const int e = i & 31, k = kb + (i >> 5); const float w = a.in[I_RW][((size_t)L * DM + k) * NEXP + e];
        const unsigned hi = f2bf(w); rt[e * 1024 + k] = (bf16)hi; rt[32768 + e * 1024 + k] = (bf16)f2bf(w - bf2f((unsigned short)hi)); }
}
__device__ __forceinline__ void p_prologue(Frame& F0, CArgs& a, int qw = CW_QUEUE) {
    constexpr int NTICK = (PI_TR + 3) / 4;
    const bool prefer_tab = ((F0.bid >> 3) & 1) == 0;
    if (F0.tid == 0) F0.MISC[1] = 0u;
    for (;;) {
        if (F0.tid == 0) {
            unsigned st = F0.MISC[1]; int it = -1;
            while (it < 0 && st != 3u) {
                const bool tab = !(st & 1u) && (prefer_tab || (st & 2u));
                if (tab) { const unsigned t = __hip_atomic_fetch_add(F0.ctl + qw, 1u, RLX_AGENT); if (t < (unsigned)PI_B_TR) it = (int)t; else st |= 1u; }
                else { const unsigned t = __hip_atomic_fetch_add(F0.ctl + qw + 1, 1u, RLX_AGENT); if (t < (unsigned)NTICK) it = PI_B_TR + (int)t; else st |= 2u; }
#ifdef DUP_PRO_HEAVY
                if (qw != CW_QUEUE) st |= 2u;
#endif
            }
            F0.MISC[0] = (unsigned)it; F0.MISC[1] = st;
        }
        __syncthreads();
        const int it = (int)F0.MISC[0];
        __syncthreads();
        if (it < 0) break;
        Frame F = F0; { const int t_ = fresh_tid(F.wave); F.tid = t_; F.lane = t_ & 63; }
        if (it < PI_B_TAB) pro_adaln(F, *fresh_args(), it);
        else if (it < PI_B_RWT) pro_tables(F, *fresh_args());
        else if (it < PI_B_S5) pro_rwt(F, *fresh_args(), it - PI_B_RWT);
        else if (it < PI_B_FOLD) pro_s5(F, *fresh_args(), it - PI_B_S5);
        else if (it < PI_B_ZERO) pro_fold(F, *fresh_args(), it - PI_B_FOLD);
        else if (it < PI_B_TR) { const int L = it - PI_B_ZERO; constexpr int EB = INPROJ_F8 ? 1 : 2; u32x4* z = (u32x4*)(F.ws + WS_WIN + ((size_t)L * PW * DM + (size_t)2088 * DM) * EB); for (int i = F.tid; i < (PW - 2088) * DM * EB / 16; i += NTHR) z[i] = (u32x4){0u, 0u, 0u, 0u}; }
        else pro_transposes4(F, it - PI_B_TR);
    }
}

__device__ __forceinline__ void p_norm1(Frame& F, CArgs& a, int L, bool dry = false) {
    const int gw = F.bid * NWAVES + F.wave, NGW = F.G * NWAVES;
    bf16* XS = (bf16*)(F.ws + WS_XS); bf16* H = (bf16*)(F.ws + WS_H);
    const float* mod = (const float*)(F.ws + WS_MOD) + (size_t)L * 9 * 6144; const float* modp = mod - 9 * 6144;
    const int* PS = (const int*)(F.ws + WS_PS); const unsigned char* Y = (const unsigned char*)(F.ws + WS_Y);
    const float* g = a.in[I_NMG] + L * DM;
    const float* xin = a.in[I_X]; const float* cin = a.in[I_CTX];
    f32x4 gv[4];
#pragma unroll
    for (int j = 0; j < 4; ++j) gv[j] = *(const f32x4*)(g + 4 * F.lane + 256 * j);
    f32x4 xn[4]; u32x2 xb[4]; unsigned yn[4][4]; int psn[4] = {0, 0, 0, 0};
#define N1_LOADX(dst, row) do { if (L == 0) { const float* s_ = (row) < NLAT ? xin + (size_t)(row) * DM : cin + (size_t)((row) - NLAT) * DM; _Pragma("unroll") for (int j = 0; j < 4; ++j) dst[j] = *(const f32x4*)(s_ + 4 * F.lane + 256 * j); } \
        else { const bf16* s_ = XS + (size_t)(row) * DM; _Pragma("unroll") for (int j = 0; j < 4; ++j) xb[j] = *(const u32x2*)(s_ + 4 * F.lane + 256 * j); } } while (0)
#define N1_LOADY(dst, ps) do { _Pragma("unroll") for (int k = 0; k < 4; ++k) { const unsigned char* yr_ = Y + (size_t)(ps)[k] * DM; _Pragma("unroll") for (int j = 0; j < 4; ++j) dst[k][j] = *(const unsigned*)(yr_ + 4 * F.lane + 256 * j); } } while (0)
#define N1_LOADPS(dst, row) do { const int4 p_ = *(const int4*)(PS + (size_t)(row) * 4); dst[0] = p_.x; dst[1] = p_.y; dst[2] = p_.z; dst[3] = p_.w; } while (0)
    int row = gw;
    if (row < NT) { N1_LOADX(xn, row); if (L > 0) { N1_LOADPS(psn, row); N1_LOADY(yn, psn); if (row + NGW < NT) N1_LOADPS(psn, row + NGW); } }
    while (row < NT) {
        const int nrow = row + NGW; const int bi = row < NLAT ? (row >> 12) : 8;
        f32x4 v[4]; unsigned yc[4][4];
#pragma unroll
        for (int j = 0; j < 4; ++j) { v[j] = (L == 0) ? xn[j] : bf4(xb[j]);
#pragma unroll
            for (int k = 0; k < 4; ++k) yc[k][j] = yn[k][j]; }
        if (nrow < NT) { N1_LOADX(xn, nrow); if (L > 0) { N1_LOADY(yn, psn); if (nrow + NGW < NT) N1_LOADPS(psn, nrow + NGW); } }
        if (L > 0) {
            bf16* xr = XS + (size_t)row * DM; const float* m5 = modp + (size_t)bi * 6144 + 5 * 1024;
#pragma unroll
            for (int j = 0; j < 4; ++j) { f32x4 s = (f32x4){0.f, 0.f, 0.f, 0.f};
#pragma unroll
                for (int k = 0; k < 4; ++k) s += f8x4(yc[k][j]);
                v[j] += *(const f32x4*)(m5 + 4 * F.lane + 256 * j) * (s * (1.f / Y8_SCALE)); if (!dry) { u32x2 w; w.x = pk2(v[j][0], v[j][1]); w.y = pk2(v[j][2], v[j][3]); *(u32x2*)(xr + 4 * F.lane + 256 * j) = w; } }
        }
        float ss = 0.f;
#pragma unroll
        for (int j = 0; j < 4; ++j) ss += v[j][0] * v[j][0] + v[j][1] * v[j][1] + v[j][2] * v[j][2] + v[j][3] * v[j][3];
        const float rs = rsqrtf(wave_sum(ss, F.lane) * (1.f / DM) + 1e-6f);
        const float* sh = mod + (size_t)bi * 6144, *sc = sh + 1024;
        bf16* hr = H + (size_t)row * DM;
#pragma unroll
        for (int j = 0; j < 4; ++j) { const f32x4 s4 = *(const f32x4*)(sc + 4 * F.lane + 256 * j), h4 = *(const f32x4*)(sh + 4 * F.lane + 256 * j);
            const f32x4 o = v[j] * rs * gv[j] * (s4 + 1.f) + h4;
#if INPROJ_F8
            if (!dry || o[0] == 12345.678f) *(unsigned*)((unsigned char*)(F.ws + WS_H8) + (size_t)row * DM + 4 * F.lane + 256 * j) = pk4f8(o[0] * H8_SCALE, o[1] * H8_SCALE, o[2] * H8_SCALE, o[3] * H8_SCALE);
#else
            u32x2 w; w.x = pk2(o[0], o[1]); w.y = pk2(o[2], o[3]); if (!dry) *(u32x2*)(hr + 4 * F.lane + 256 * j) = w; else if (o[0] == 12345.678f) *(u32x2*)(hr + 4 * F.lane + 256 * j) = w;
#endif
        }
        row = nrow;
    }
#undef N1_LOADX
#undef N1_LOADY
#undef N1_LOADPS
}
__device__ __forceinline__ void p_norm2(Frame& F, CArgs& a, int L, int nrows, int cw = CW_CNT) {
    constexpr int TS = 1032;
    LAS bf16* thi = (LAS bf16*)F.lds; LAS bf16* tlo = thi + 16 * TS;
    LAS float* part = (LAS float*)(tlo + 16 * TS);
    LAS unsigned* lcnt = (LAS unsigned*)(part + 8 * 16 * 33);
    if (F.tid < 64) lcnt[F.tid] = 0u;
    const int lr = F.lane & 15, g = F.lane >> 4, hf = F.lane >> 5;
    bf16x8 bh[4][2], bl[4][2];
    { const bf16* rwh = (const bf16*)(F.ws + WS_RWT) + (size_t)L * 65536; const bf16* rwl = rwh + 32768;
#pragma unroll
      for (int ks = 0; ks < 4; ++ks)
#pragma unroll
          for (int nt = 0; nt < 2; ++nt) { const int o = (16 * nt + lr) * 1024 + 128 * F.wave + 32 * ks + 8 * g; bh[ks][nt] = *(const bf16x8*)(rwh + o); bl[ks][nt] = *(const bf16x8*)(rwl + o); } }
    __syncthreads();
    const int gw = F.bid * NWAVES + F.wave, NGW = F.G * NWAVES, R = (nrows - gw + NGW - 1) / NGW;
    const int Rmax = (nrows - F.bid * NWAVES + NGW - 1) / NGW;
    const bf16* XS = (const bf16*)(F.ws + WS_XS); unsigned char* H8 = (unsigned char*)(F.ws + WS_H8);
    const float* mod = (const float*)(F.ws + WS_MOD) + (size_t)L * 9 * 6144;
    int* PE = (int*)(F.ws + WS_PE); int* PR = (int*)(F.ws + WS_PR); float* PG = (float*)(F.ws + WS_PG);
    unsigned* cnt = F.ctl + cw + L * 64;
    const float* gp = a.in[I_NFG] + L * DM;
    const float rbh = a.in[I_RB][L * NEXP + (F.lane & 31)];
    f32x4 gv[4];
#pragma unroll
    for (int j = 0; j < 4; ++j) gv[j] = *(const f32x4*)(gp + 4 * F.lane + 256 * j);
    u32x2 xn[4];
#pragma unroll
    for (int j = 0; j < 4; ++j) xn[j] = 0 < R ? *(const u32x2*)(XS + (size_t)gw * DM + 4 * F.lane + 256 * j) : (u32x2){0u, 0u};
    for (int bt = 0; 2 * bt < Rmax; ++bt) {
#pragma unroll
        for (int it = 0; it < 2; ++it) {
            const int ri = 2 * bt + it, row = gw + ri * NGW; const bool ok = ri < R; const int bi = row < NLAT ? (row >> 12) : 8;
            f32x4 v[4]; float ss = 0.f;
#pragma unroll
            for (int j = 0; j < 4; ++j) { v[j] = bf4(xn[j]); ss += v[j][0] * v[j][0] + v[j][1] * v[j][1] + v[j][2] * v[j][2] + v[j][3] * v[j][3]; }
#pragma unroll
            for (int j = 0; j < 4; ++j) xn[j] = ri + 1 < R ? *(const u32x2*)(XS + (size_t)(row + NGW) * DM + 4 * F.lane + 256 * j) : (u32x2){0u, 0u};
            const float rs = rsqrtf(wave_sum(ss, F.lane) * (1.f / DM) + 1e-6f);
            const float* sh = mod + (size_t)(ok ? bi : 0) * 6144 + 3 * 1024, *sc = sh + 1024;
            unsigned char* hr = H8 + (size_t)row * DM;
            LAS bf16* th = thi + (it * 8 + F.wave) * TS, *tl = tlo + (it * 8 + F.wave) * TS;
#pragma unroll
            for (int j = 0; j < 4; ++j) { const f32x4 s4 = *(const f32x4*)(sc + 4 * F.lane + 256 * j), h4 = *(const f32x4*)(sh + 4 * F.lane + 256 * j);
                v[j] = ok ? v[j] * rs * gv[j] * (s4 + 1.f) + h4 : (f32x4){0.f, 0.f, 0.f, 0.f};
                if (ok) *(unsigned*)(hr + 4 * F.lane + 256 * j) = pk4f8(v[j][0] * H8_SCALE, v[j][1] * H8_SCALE, v[j][2] * H8_SCALE, v[j][3] * H8_SCALE);
                u32x2 wh; wh.x = pk2(v[j][0], v[j][1]); wh.y = pk2(v[j][2], v[j][3]);
                const f32x4 hv = bf4(wh); const f32x4 dl = v[j] - hv; u32x2 wl; wl.x = pk2(dl[0], dl[1]); wl.y = pk2(dl[2], dl[3]);
                *(LAS u32x2*)(th + 4 * F.lane + 256 * j) = wh; *(LAS u32x2*)(tl + 4 * F.lane + 256 * j) = wl; }
        }
        __syncthreads();
        {   f32x4 acc[2] = {(f32x4){0.f, 0.f, 0.f, 0.f}, (f32x4){0.f, 0.f, 0.f, 0.f}};
#pragma unroll
            for (int ks = 0; ks < 4; ++ks) { const int o = lr * TS + 128 * F.wave + 32 * ks + 8 * g; const bf16x8 ah = *(const LAS bf16x8*)(thi + o), al = *(const LAS bf16x8*)(tlo + o);
#pragma unroll
                for (int nt = 0; nt < 2; ++nt) { acc[nt] = __builtin_amdgcn_mfma_f32_16x16x32_bf16(ah, bh[ks][nt], acc[nt], 0, 0, 0); acc[nt] = __builtin_amdgcn_mfma_f32_16x16x32_bf16(al, bh[ks][nt], acc[nt], 0, 0, 0); acc[nt] = __builtin_amdgcn_mfma_f32_16x16x32_bf16(ah, bl[ks][nt], acc[nt], 0, 0, 0); } }
#pragma unroll
            for (int nt = 0; nt < 2; ++nt)
#pragma unroll
                for (int j = 0; j < 4; ++j) part[(F.wave * 16 + 4 * g + j) * 33 + 16 * nt + lr] = acc[nt][j];
        }
        __syncthreads();
        {   const int s = 2 * F.wave + hf, e = F.lane & 31;
            float logit = rbh;
#pragma unroll
            for (int w = 0; w < 8; ++w) logit += part[(w * 16 + s) * 33 + e];
            const int ri = 2 * bt + (s >> 3), rowh = F.bid * NWAVES + (s & 7) + ri * NGW; const bool okh = rowh < nrows;
            int es[4]; float ls[4];
#pragma unroll
            for (int k = 0; k < 4; ++k) {
                float m = logit; m = fmaxf(m, swz_xor<1>(m)); m = fmaxf(m, swz_xor<2>(m)); m = fmaxf(m, swz_xor<4>(m)); m = fmaxf(m, swz_xor<8>(m)); m = fmaxf(m, swz_xor<16>(m));
                const unsigned long long bal = __ballot(logit == m);
                const unsigned mh = (unsigned)(bal >> (F.lane & 32));
                es[k] = __builtin_ctz(mh); ls[k] = m;
                if (e == es[k]) logit = -3.0e38f;
            }
            const float e1 = __expf(ls[1] - ls[0]), e2 = __expf(ls[2] - ls[0]), e3 = __expf(ls[3] - ls[0]); const float inv = 1.f / (1.f + e1 + e2 + e3);
            if (e < 4 && okh) {
                const int ex = e == 0 ? es[0] : (e == 1 ? es[1] : (e == 2 ? es[2] : es[3]));
                const float gt = (e == 0 ? 1.f : (e == 1 ? e1 : (e == 2 ? e2 : e3))) * inv;
                const unsigned rk = __hip_atomic_fetch_add(lcnt + ex, 1u, __ATOMIC_RELAXED, __HIP_MEMORY_SCOPE_WORKGROUP);
                PE[rowh * 4 + e] = ex; PR[rowh * 4 + e] = (int)rk; PG[rowh * 4 + e] = gt;
            }
        }
        __syncthreads();
    }
    if (F.tid < 32) lcnt[32 + F.tid] = __hip_atomic_fetch_add(cnt + F.tid, lcnt[F.tid], RLX_AGENT);
    __syncthreads();
    int* TM = (int*)(F.ws + WS_TM);
    for (int bt = 0; 2 * bt < Rmax; ++bt) {
        const int s = 2 * F.wave + hf, e = F.lane & 31, rowh = F.bid * NWAVES + (s & 7) + (2 * bt + (s >> 3)) * NGW;
        if (e < 4 && rowh < nrows) { const int i = rowh * 4 + e, ex = PE[i], rk = PR[i] + (int)lcnt[32 + ex]; TM[(size_t)ex * NT + rk] = i; }
    }
    __syncthreads();
}
__device__ __forceinline__ void p_final(Frame& F, CArgs& a) {
    const int gw = F.bid * NWAVES + F.wave, NGW = F.G * NWAVES;
    const bf16* XS = (const bf16*)(F.ws + WS_XS);
    const float* modp = (const float*)(F.ws + WS_MOD) + (size_t)(DEPTH - 1) * 9 * 6144;
    const int* PS = (const int*)(F.ws + WS_PS); const unsigned char* Y = (const unsigned char*)(F.ws + WS_Y);
    const float* g = a.in[I_FING];
    f32x4 gv[4];
#pragma unroll
    for (int j = 0; j < 4; ++j) gv[j] = *(const f32x4*)(g + 4 * F.lane + 256 * j);
    u32x2 xb[4]; unsigned yn[4][4]; int psn[4] = {0, 0, 0, 0};
#define FN_LOADX(row) do { const bf16* s_ = XS + (size_t)(row) * DM; _Pragma("unroll") for (int j = 0; j < 4; ++j) xb[j] = *(const u32x2*)(s_ + 4 * F.lane + 256 * j); } while (0)
#define FN_LOADY(ps) do { _Pragma("unroll") for (int k = 0; k < 4; ++k) { const unsigned char* yr_ = Y + (size_t)(ps)[k] * DM; _Pragma("unroll") for (int j = 0; j < 4; ++j) yn[k][j] = *(const unsigned*)(yr_ + 4 * F.lane + 256 * j); } } while (0)
#define FN_LOADPS(row) do { const int4 p_ = *(const int4*)(PS + (size_t)(row) * 4); psn[0] = p_.x; psn[1] = p_.y; psn[2] = p_.z; psn[3] = p_.w; } while (0)
    int row = gw;
    if (row < NLAT) { FN_LOADX(row); FN_LOADPS(row); FN_LOADY(psn); if (row + NGW < NLAT) FN_LOADPS(row + NGW); }
    while (row < NLAT) {
        const int nrow = row + NGW, bi = row >> 12;
        f32x4 v[4], s[4];
#pragma unroll
        for (int j = 0; j < 4; ++j) { v[j] = bf4(xb[j]); s[j] = (f32x4){0.f, 0.f, 0.f, 0.f};
#pragma unroll
            for (int k = 0; k < 4; ++k) s[j] += f8x4(yn[k][j]);
            s[j] = s[j] * (1.f / Y8_SCALE); }
        if (nrow < NLAT) { FN_LOADX(nrow); FN_LOADY(psn); if (nrow + NGW < NLAT) FN_LOADPS(nrow + NGW); }
        const float* m5 = modp + (size_t)bi * 6144 + 5 * 1024;
        float ss = 0.f;
#pragma unroll
        for (int j = 0; j < 4; ++j) { v[j] += *(const f32x4*)(m5 + 4 * F.lane + 256 * j) * s[j]; ss += v[j][0] * v[j][0] + v[j][1] * v[j][1] + v[j][2] * v[j][2] + v[j][3] * v[j][3]; }
        const float rs = rsqrtf(wave_sum(ss, F.lane) * (1.f / DM) + 1e-6f);
        float* orow = a.out + (size_t)row * DM;
#pragma unroll
        for (int j = 0; j < 4; ++j) *(f32x4*)(orow + 4 * F.lane + 256 * j) = v[j] * rs * gv[j];
        row = nrow;
    }
#undef FN_LOADX
#undef FN_LOADY
#undef FN_LOADPS
}

#ifndef MIX_P1
#define MIX_P1 1
#endif
#define MFMA16(a, b, c) __builtin_amdgcn_mfma_f32_16x16x32_bf16((a), (b), (c), 0, 0, 0)
typedef short v4i16_t __attribute__((ext_vector_type(4)));
__device__ __forceinline__ s16x4 trread(const LAS void* p) { return __builtin_bit_cast(s16x4, __builtin_amdgcn_ds_read_tr16_b64_v4i16((LAS v4i16_t*)p)); }
__device__ __forceinline__ bf16x8 cat8(s16x4 a, s16x4 b) { return __builtin_shufflevector(a, b, 0, 1, 2, 3, 4, 5, 6, 7); }
__device__ __forceinline__ bf16x8 pack8(const float* v) { u32x4 w; w.x = pg8::cvt_pk_bf16(v[0], v[1]); w.y = pg8::cvt_pk_bf16(v[2], v[3]); w.z = pg8::cvt_pk_bf16(v[4], v[5]); w.w = pg8::cvt_pk_bf16(v[6], v[7]); return __builtin_bit_cast(bf16x8, w); }
__device__ __forceinline__ void unpack8(bf16x8 x, float* v) { const u32x4 w = __builtin_bit_cast(u32x4, x); v[0] = bflo(w.x); v[1] = bfhi(w.x); v[2] = bflo(w.y); v[3] = bfhi(w.y); v[4] = bflo(w.z); v[5] = bfhi(w.z); v[6] = bflo(w.w); v[7] = bfhi(w.w); }
#define OPQ(x) ({ int o_ = (x); asm volatile("" : "+s"(o_)); o_; })
#define LAUNDER_F(F0) Frame F = F0; { const int t_ = fresh_tid(F.wave); F.tid = t_; F.lane = t_ & 63; }
__device__ __forceinline__ int chunk_tok0(int cid) { return cid < 512 ? cid * 64 : NLAT + (cid - 512) * 64; }

constexpr int GL_QS = 136, GL_VS = 264, GL_BS = 260;
constexpr int GL_Q = 0, GL_K = GL_Q + 64 * GL_QS * 2, GL_V = GL_K + 64 * GL_QS * 2, GL_A1 = GL_V + 64 * GL_VS * 2, GL_B = GL_A1 + 64 * 32 * 2, GL_END = GL_B + 64 * GL_BS * 4;
static_assert(GL_END <= MISC_OFF, "GLA LDS");
template <int MODE> __device__ __forceinline__ void gla_chunk(Frame& F0, CArgs& a, int L, int cid) {
    constexpr bool OUT = MODE == 1, DO_STATE = MODE == 0 || MODE == 2, DO_INTRA = MODE == 1 || MODE == 2;
    LAUNDER_F(F0)
    const int tok0 = chunk_tok0(cid);
    const bf16* P = (const bf16*)(F.ws + WS_PBUF) + (size_t)tok0 * PW;
    LAS bf16* sq = (LAS bf16*)(F.lds + GL_Q); LAS bf16* sk = (LAS bf16*)(F.lds + GL_K); LAS bf16* sv = (LAS bf16*)(F.lds + GL_V); LAS bf16* sa1 = (LAS bf16*)(F.lds + GL_A1); LAS float* sB = (LAS float*)(F.lds + GL_B);
    __syncthreads();
    u32x4 rgate[4]; bf16x8 sfr[4];
    if constexpr (OUT) {
#pragma unroll
        for (int k = 0; k < 4; ++k) { const int i = F.tid + k * NTHR, t = i >> 5, pc = i & 31; rgate[k] = *(const u32x4*)(P + (size_t)t * PW + PC_R + pc * 8); }
        const bf16* se = (const bf16*)(F.ws + WS_GSE) + (((size_t)cid * 4 + (F.wave & 3)) * 2 + (F.wave >> 2)) * 2048;
#pragma unroll
        for (int d = 0; d < 4; ++d) sfr[d] = *(const bf16x8*)(se + (16 * d + (F.lane & 15)) * 32 + 8 * (F.lane >> 4));
    }
    {   u32x4 rq[2], rk[2], rv[4], ra = (u32x4){0u, 0u, 0u, 0u};
#pragma unroll
        for (int k = 0; k < 2; ++k) { const int i = F.tid + k * NTHR, t = i >> 4, pc = i & 15; rq[k] = *(const u32x4*)(P + (size_t)t * PW + PC_Q + pc * 8); rk[k] = *(const u32x4*)(P + (size_t)t * PW + PC_K + pc * 8); }
#pragma unroll
        for (int k = 0; k < 4; ++k) { const int i = F.tid + k * NTHR, t = i >> 5, pc = i & 31; rv[k] = *(const u32x4*)(P + (size_t)t * PW + PC_V + pc * 8); }
        if (F.tid < 256) { const int t = F.tid >> 2, pc = F.tid & 3; ra = *(const u32x4*)(P + (size_t)t * PW + PC_A1 + pc * 8); }
#pragma unroll
        for (int k = 0; k < 2; ++k) { const int i = F.tid + k * NTHR, t = i >> 4, pc = i & 15; *(LAS u32x4*)(sq + t * GL_QS + pc * 8) = rq[k]; *(LAS u32x4*)(sk + t * GL_QS + pc * 8) = rk[k]; }
#pragma unroll
        for (int k = 0; k < 4; ++k) { const int i = F.tid + k * NTHR, t = i >> 5, pc = i & 31; *(LAS u32x4*)(sv + t * GL_VS + pc * 8) = rv[k]; }
        if (F.tid < 256) { const int t = F.tid >> 2, pc = F.tid & 3; *(LAS u32x4*)(sa1 + t * 32 + pc * 8) = ra; }
    }
    __syncthreads();
    {
        const int lr_ = F.lane & 15, g_ = F.lane >> 4;
        const bf16* gt = (const bf16*)(F.ws + WS_GA2T) + (size_t)L * 256 * 32;
        bf16x8 bz[2]; float abv[2];
#pragma unroll
        for (int nt = 0; nt < 2; ++nt) { const int col = 32 * F.wave + 16 * nt + lr_; bz[nt] = *(const bf16x8*)(gt + col * 32 + 8 * g_); abv[nt] = a.in[I_GLAAB][L * 256 + col]; }
#pragma unroll
        for (int m = 0; m < 4; ++m) { const bf16x8 az = *(const LAS bf16x8*)(sa1 + (16 * m + lr_) * 32 + 8 * g_);
#pragma unroll
            for (int nt = 0; nt < 2; ++nt) { const f32x4 zz = MFMA16(az, bz[nt], ((f32x4){0.f, 0.f, 0.f, 0.f})); const int col = 32 * F.wave + 16 * nt + lr_;
#pragma unroll
                for (int j = 0; j < 4; ++j) { const float z = zz[j] + abv[nt]; const float ls = fminf(z, 0.f) - __logf(1.f + __expf(-fabsf(z))); sB[(16 * m + 4 * g_ + j) * GL_BS + col] = ls * (1.f / 16.f); } } }
    }
    __syncthreads();
    if (F.tid < 256) { const int col = F.tid, r = col >> 7; float bv[64];
#pragma unroll
        for (int i = 0; i < 64; ++i) bv[i] = sB[i * GL_BS + col];
        if (r == 0) {
#pragma unroll
            for (int i = 1; i < 64; ++i) bv[i] += bv[i - 1];
        } else {
#pragma unroll
            for (int i = 62; i >= 0; --i) bv[i] += bv[i + 1];
        }
#pragma unroll
        for (int i = 0; i < 64; ++i) sB[i * GL_BS + col] = bv[i]; }
    __syncthreads();
    const int hh = F.wave & 3, r = F.wave >> 2, lr = F.lane & 15, g = F.lane >> 4;
    const int bc = r * 128 + hh * 32;
    const size_t ub = ((size_t)cid * 4 + hh) * 2 + r;
    if constexpr (DO_STATE) {
        const int tl = r ? 0 : 63;
        f32x4 acc[2][4];
#pragma unroll
        for (int mc = 0; mc < 2; ++mc)
#pragma unroll
            for (int d = 0; d < 4; ++d) acc[mc][d] = (f32x4){0.f, 0.f, 0.f, 0.f};
#pragma unroll
        for (int sg = 0; sg < 2; ++sg) {
            bf16x8 vf[4];
#pragma unroll
            for (int d = 0; d < 4; ++d) { const LAS bf16* p0 = sv + (32 * sg + 8 * g + ((F.lane & 15) >> 2)) * GL_VS + hh * 64 + 16 * d + 4 * (F.lane & 3); vf[d] = cat8(trread(p0), trread(p0 + 4 * GL_VS)); }
#pragma unroll
            for (int mc = 0; mc < 2; ++mc) {
                const LAS bf16* p0 = sk + (32 * sg + 8 * g + ((F.lane & 15) >> 2)) * GL_QS + hh * 32 + 16 * mc + 4 * (F.lane & 3);
                const s16x4 k0 = trread(p0), k1 = trread(p0 + 4 * GL_QS);
                const int c = 16 * mc + lr; const float bl = sB[tl * GL_BS + bc + c];
                float kv[8];
#pragma unroll
                for (int e = 0; e < 4; ++e) { kv[e] = bf2f((unsigned short)k0[e]) * __expf(bl - sB[(32 * sg + 8 * g + e) * GL_BS + bc + c]); kv[4 + e] = bf2f((unsigned short)k1[e]) * __expf(bl - sB[(32 * sg + 8 * g + 4 + e) * GL_BS + bc + c]); }
                const bf16x8 kf = pack8(kv);
#pragma unroll
                for (int d = 0; d < 4; ++d) acc[mc][d] = MFMA16(kf, vf[d], acc[mc][d]);
            }
        }
        float* ds = (float*)(F.ws + WS_GDS) + ub * 2048;
#pragma unroll
        for (int mc = 0; mc < 2; ++mc)
#pragma unroll
            for (int d = 0; d < 4; ++d) *(f32x4*)(ds + (16 * d + lr) * 32 + 16 * mc + 4 * g) = acc[mc][d];
        if (F.lane < 32) ((float*)(F.ws + WS_GDEC))[ub * 32 + F.lane] = __expf(sB[tl * GL_BS + bc + F.lane]);
    }
    if constexpr (DO_INTRA) {
        bf16x8 qf[4], kf[4];
#pragma unroll
        for (int m = 0; m < 4; ++m) { const int t = 16 * m + lr; float qv[8], kv[8], bv[8];
            unpack8(*(const LAS bf16x8*)(sq + t * GL_QS + hh * 32 + 8 * g), qv); unpack8(*(const LAS bf16x8*)(sk + t * GL_QS + hh * 32 + 8 * g), kv);
            *(f32x4*)bv = *(const LAS f32x4*)(sB + t * GL_BS + bc + 8 * g); *(f32x4*)(bv + 4) = *(const LAS f32x4*)(sB + t * GL_BS + bc + 8 * g + 4);
#pragma unroll
            for (int e = 0; e < 8; ++e) { const float ex = __expf(bv[e]); qv[e] *= 0.17677669529663687f * ex; kv[e] *= __frcp_rn(ex); }
            qf[m] = pack8(qv); kf[m] = pack8(kv); }
        f32x4 o[4][4];
#pragma unroll
        for (int m = 0; m < 4; ++m)
#pragma unroll
            for (int d = 0; d < 4; ++d) o[m][d] = (f32x4){0.f, 0.f, 0.f, 0.f};
        if constexpr (OUT) {
#pragma unroll
            for (int d = 0; d < 4; ++d) {
#pragma unroll
                for (int m = 0; m < 4; ++m) o[m][d] = MFMA16(qf[m], sfr[d], o[m][d]); }
        }
        bf16x8 vf[2][4];
#pragma unroll
        for (int sg = 0; sg < 2; ++sg)
#pragma unroll
            for (int d = 0; d < 4; ++d) { const LAS bf16* p0 = sv + (32 * sg + 4 * g + ((F.lane & 15) >> 2)) * GL_VS + hh * 64 + 16 * d + 4 * (F.lane & 3); vf[sg][d] = cat8(trread(p0), trread(p0 + 16 * GL_VS)); }
        const f32x4 zero4 = (f32x4){0.f, 0.f, 0.f, 0.f};
#pragma unroll
        for (int m = 0; m < 4; ++m) {
            const int t = 16 * m + lr;
#pragma unroll
            for (int sg = 0; sg < 2; ++sg) {
                f32x4 p0 = MFMA16(kf[2 * sg], qf[m], zero4), p1 = MFMA16(kf[2 * sg + 1], qf[m], zero4);
                float pv[8];
#pragma unroll
                for (int j = 0; j < 4; ++j) { const int s0 = 32 * sg + 4 * g + j, s1 = s0 + 16; pv[j] = (r ? s0 >= t : s0 <= t) ? p0[j] : 0.f; pv[4 + j] = (r ? s1 >= t : s1 <= t) ? p1[j] : 0.f; }
                const bf16x8 pf = pack8(pv);
#pragma unroll
                for (int d = 0; d < 4; ++d) o[m][d] = MFMA16(pf, vf[sg][d], o[m][d]);
            }
        }
        if constexpr (OUT) {
        __syncthreads();
        LAS float* ox = (LAS float*)(F.lds + GL_B);
        LAS bf16* ot = (LAS bf16*)(F.lds + GL_Q);
        LAS bf16* srg = (LAS bf16*)(F.lds + GL_V);
#pragma unroll
        for (int k = 0; k < 4; ++k) { const int i = F.tid + k * NTHR, t = i >> 5, pc = i & 31; *(LAS u32x4*)(srg + t * GL_VS + pc * 8) = rgate[k]; }
        if (r == 1) {
#pragma unroll
            for (int m = 0; m < 4; ++m)
#pragma unroll
                for (int d = 0; d < 4; ++d)
#pragma unroll
                    for (int j = 0; j < 4; ++j) ox[(hh * 64 + 16 * m + 4 * g + j) * 65 + 16 * d + lr] = o[m][d][j];
        }
        __syncthreads();
        if (r == 0) {
            const float* ng = a.in[I_GLANG] + L * 64;
            float gn[4];
#pragma unroll
            for (int d = 0; d < 4; ++d) gn[d] = ng[16 * d + lr];
#pragma unroll
            for (int m = 0; m < 4; ++m)
#pragma unroll
                for (int j = 0; j < 4; ++j) {
                    const int t = 16 * m + 4 * g + j; float v[4], ss = 0.f;
#pragma unroll
                    for (int d = 0; d < 4; ++d) { v[d] = o[m][d][j] + ox[(hh * 64 + t) * 65 + 16 * d + lr]; ss += v[d] * v[d]; }
                    ss += swz_xor<1>(ss); ss += swz_xor<2>(ss); ss += swz_xor<4>(ss); ss += swz_xor<8>(ss);
                    const float rs = rsqrtf(ss * (1.f / 64.f) + 1e-6f);
#pragma unroll
                    for (int d = 0; d < 4; ++d) { const float rg = bf2f(srg[t * GL_VS + hh * 64 + 16 * d + lr]); ot[t * 264 + hh * 64 + 16 * d + lr] = (bf16)f2bf(v[d] * rs * gn[d] * siluf_(rg)); }
                }
        }
        __syncthreads();
        bf16* MX = (bf16*)(F.ws + WS_MIX) + (size_t)tok0 * MW + 768;
        for (int i = F.tid; i < 2048; i += NTHR) { const int t = i >> 5, pc = i & 31; *(u32x4*)(MX + (size_t)t * MW + pc * 8) = *(const LAS u32x4*)(ot + t * 264 + pc * 8); }
        } else {
            bf16* QI = (bf16*)(F.ws + WS_GQI) + (size_t)tok0 * 256;
#pragma unroll
            for (int m = 0; m < 4; ++m) *(bf16x8*)(QI + (size_t)(16 * m + lr) * 256 + r * 128 + hh * 32 + 8 * g) = qf[m];
            __syncthreads();
            LAS float* ox = (LAS float*)(F.lds + GL_B);
            LAS bf16* ot = (LAS bf16*)(F.lds + GL_Q);
            if (r == 1) {
#pragma unroll
                for (int m = 0; m < 4; ++m)
#pragma unroll
                    for (int d = 0; d < 4; ++d)
#pragma unroll
                        for (int j = 0; j < 4; ++j) ox[(hh * 64 + 16 * m + 4 * g + j) * 65 + 16 * d + lr] = o[m][d][j];
            }
            __syncthreads();
            if (r == 0) {
#pragma unroll
                for (int m = 0; m < 4; ++m)
#pragma unroll
                    for (int d = 0; d < 4; ++d)
#pragma unroll
                        for (int j = 0; j < 4; ++j) { const int t = 16 * m + 4 * g + j; ot[t * 264 + hh * 64 + 16 * d + lr] = (bf16)f2bf(o[m][d][j] + ox[(hh * 64 + t) * 65 + 16 * d + lr]); }
            }
            __syncthreads();
            bf16* OI = (bf16*)(F.ws + WS_GOI) + (size_t)tok0 * 256;
            for (int i = F.tid; i < 2048; i += NTHR) { const int t = i >> 5, pc = i & 31; *(u32x4*)(OI + (size_t)t * 256 + pc * 8) = *(const LAS u32x4*)(ot + t * 264 + pc * 8); }
        }
    }
}


__device__ __forceinline__ void gla_light(Frame& F0, CArgs& a, int L, int cid) {
    LAUNDER_F(F0)
    const int tok0 = chunk_tok0(cid), hh = F.wave & 3, r = F.wave >> 2, lr = F.lane & 15, g = F.lane >> 4;
    const bf16* P = (const bf16*)(F.ws + WS_PBUF) + (size_t)tok0 * PW;
    const bf16* QI = (const bf16*)(F.ws + WS_GQI) + (size_t)tok0 * 256; const bf16* OI = (const bf16*)(F.ws + WS_GOI) + (size_t)tok0 * 256;
    const bf16* se = (const bf16*)(F.ws + WS_GSE) + (((size_t)cid * 4 + hh) * 2 + r) * 2048;
    u32x4 rgate[4], roi[4]; bf16x8 qf[4], sfr[4];
#pragma unroll
    for (int m = 0; m < 4; ++m) qf[m] = *(const bf16x8*)(QI + (size_t)(16 * m + lr) * 256 + r * 128 + hh * 32 + 8 * g);
#pragma unroll
    for (int d = 0; d < 4; ++d) sfr[d] = *(const bf16x8*)(se + (16 * d + lr) * 32 + 8 * g);
#pragma unroll
    for (int k = 0; k < 4; ++k) { const int i = F.tid + k * NTHR, t = i >> 5, pc = i & 31; rgate[k] = *(const u32x4*)(P + (size_t)t * PW + PC_R + pc * 8); roi[k] = *(const u32x4*)(OI + (size_t)t * 256 + pc * 8); }
    f32x4 o[4][4];
#pragma unroll
    for (int m = 0; m < 4; ++m)
#pragma unroll
        for (int d = 0; d < 4; ++d) o[m][d] = MFMA16(qf[m], sfr[d], ((f32x4){0.f, 0.f, 0.f, 0.f}));
    LAS float* ox = (LAS float*)(F.lds + GL_B);
    LAS bf16* srg = (LAS bf16*)(F.lds + GL_V);
    LAS bf16* soi = (LAS bf16*)(F.lds + GL_Q);
    __syncthreads();
#pragma unroll
    for (int k = 0; k < 4; ++k) { const int i = F.tid + k * NTHR, t = i >> 5, pc = i & 31; *(LAS u32x4*)(srg + t * GL_VS + pc * 8) = rgate[k]; *(LAS u32x4*)(soi + t * 264 + pc * 8) = roi[k]; }
    if (r == 1) {
#pragma unroll
        for (int m = 0; m < 4; ++m)
#pragma unroll
            for (int d = 0; d < 4; ++d)
#pragma unroll
                for (int j = 0; j < 4; ++j) ox[(hh * 64 + 16 * m + 4 * g + j) * 65 + 16 * d + lr] = o[m][d][j];
    }
    __syncthreads();
    if (r == 0) {
        const float* ng = a.in[I_GLANG] + L * 64;
        float gn[4];
#pragma unroll
        for (int d = 0; d < 4; ++d) gn[d] = ng[16 * d + lr];
#pragma unroll
        for (int m = 0; m < 4; ++m)
#pragma unroll
            for (int j = 0; j < 4; ++j) {
                const int t = 16 * m + 4 * g + j; float v[4], ss = 0.f;
#pragma unroll
                for (int d = 0; d < 4; ++d) { v[d] = o[m][d][j] + ox[(hh * 64 + t) * 65 + 16 * d + lr] + bf2f(soi[t * 264 + hh * 64 + 16 * d + lr]); ss += v[d] * v[d]; }
                ss += swz_xor<1>(ss); ss += swz_xor<2>(ss); ss += swz_xor<4>(ss); ss += swz_xor<8>(ss);
                const float rs = rsqrtf(ss * (1.f / 64.f) + 1e-6f);
#pragma unroll
                for (int d = 0; d < 4; ++d) { const int q = t * GL_VS + hh * 64 + 16 * d + lr; const float rg = bf2f(srg[q]); srg[q] = (bf16)f2bf(v[d] * rs * gn[d] * siluf_(rg)); }
            }
    }
    __syncthreads();
    bf16* MX = (bf16*)(F.ws + WS_MIX) + (size_t)tok0 * MW + 768;
    for (int i = F.tid; i < 2048; i += NTHR) { const int t = i >> 5, pc = i & 31; *(u32x4*)(MX + (size_t)t * MW + pc * 8) = *(const LAS u32x4*)(srg + t * GL_VS + pc * 8); }
}

constexpr int SD_RS = 520;
constexpr int SD_RAW = 0, SD_XC = SD_RAW + 68 * SD_RS * 2, SD_DT = SD_XC + 64 * SD_RS * 2, SD_CUM = SD_DT + 64 * 8 * 4, SD_W = SD_CUM + 8 * 64 * 4, SD_END = SD_W + 8 * 64 * 4;
static_assert(SD_END <= MISC_OFF && 64 * 260 * 4 <= 68 * SD_RS * 2, "SSD LDS");
template <int MODE> __device__ __forceinline__ void ssd_chunk(Frame& F0, CArgs& a, int L, int cid) {
    constexpr bool OUT = MODE == 1, DO_STATE = MODE == 0 || MODE == 2, DO_INTRA = MODE == 1 || MODE == 2;
    LAUNDER_F(F0)
    const int tok0 = chunk_tok0(cid);
    const bf16* PB = (const bf16*)(F.ws + WS_PBUF);
    LAS bf16* raw = (LAS bf16*)(F.lds + SD_RAW); LAS bf16* xc = (LAS bf16*)(F.lds + SD_XC); LAS float* sdt = (LAS float*)(F.lds + SD_DT); LAS float* scum = (LAS float*)(F.lds + SD_CUM); LAS float* sw = (LAS float*)(F.lds + SD_W);
    bf16x8 sfr[4][2];
    if constexpr (OUT) { const bf16* se = (const bf16*)(F.ws + WS_SSE) + (((size_t)cid * 4 + (F.wave & 3)) * 2 + (F.wave >> 2)) * 4096;
#pragma unroll
        for (int d = 0; d < 4; ++d) { sfr[d][0] = *(const bf16x8*)(se + (16 * d + (F.lane & 15)) * 64 + 8 * (F.lane >> 4)); sfr[d][1] = *(const bf16x8*)(se + (16 * d + (F.lane & 15)) * 64 + 32 + 8 * (F.lane >> 4)); } }
    __syncthreads();
    {
        const int isctx = cid >= 512, c4 = (cid - 512) & 3;
        u32x4 rv[9];
#pragma unroll
        for (int k = 0; k < 9; ++k) { const int i = F.tid + k * NTHR, rr = i >> 6, pc = i & 63, t = rr - 2; rv[k] = (u32x4){0u, 0u, 0u, 0u};
            bool ok = t >= 0 && t < 64 && i < 68 * 64; if (isctx) { const int tt = c4 * 64 + t; ok = tt >= 0 && tt < 256 && i < 68 * 64; }
            if (ok) rv[k] = *(const u32x4*)(PB + (size_t)(tok0 + t) * PW + PC_XBC + pc * 8); }
#pragma unroll
        for (int k = 0; k < 9; ++k) { const int i = F.tid + k * NTHR, rr = i >> 6, pc = i & 63; if (i < 68 * 64) *(LAS u32x4*)(raw + rr * SD_RS + pc * 8) = rv[k]; }
        if (F.tid < 64) { float dv[8]; unpack8(*(const bf16x8*)(PB + (size_t)(tok0 + F.tid) * PW + PC_DT), dv);
#pragma unroll
            for (int q = 0; q < 8; ++q) { const float z = dv[q] + a.in[I_SSDDTB][L * 8 + q]; sdt[F.tid * 8 + q] = z > 20.f ? z : __logf(1.f + __expf(z)); } }
    }
    __syncthreads();
    {
        const int ch = F.tid; float w[5];
#pragma unroll
        for (int k = 0; k < 5; ++k) w[k] = a.in[I_SSDCW][((size_t)L * 5 + k) * 512 + ch];
        const float cb = a.in[I_SSDCB][L * 512 + ch];
        float x0 = bf2f(raw[0 * SD_RS + ch]), x1 = bf2f(raw[1 * SD_RS + ch]), x2 = bf2f(raw[2 * SD_RS + ch]), x3 = bf2f(raw[3 * SD_RS + ch]);
        for (int t0 = 0; t0 < 64; t0 += 16) { float xv[16];
#pragma unroll
            for (int k = 0; k < 16; ++k) xv[k] = bf2f(raw[(t0 + k + 4) * SD_RS + ch]);
#pragma unroll
            for (int k = 0; k < 16; ++k) { const float x4 = xv[k]; const float y = cb + w[0] * x0 + w[1] * x1 + w[2] * x2 + w[3] * x3 + w[4] * x4;
                xc[(t0 + k) * SD_RS + ch] = (bf16)f2bf(siluf_(y)); x0 = x1; x1 = x2; x2 = x3; x3 = x4; } }
    }
    {
        const int q = F.wave, rr = q >> 2, t = rr ? 63 - F.lane : F.lane;
        const float aa = -__expf(a.in[I_SSDALOG][L * 8 + q]); const float dtv = sdt[t * 8 + q];
        float c = dtv * aa;
        { float o;
          o = __builtin_bit_cast(float, __builtin_amdgcn_ds_bpermute((F.lane - 1) << 2, __builtin_bit_cast(int, c))); if (F.lane >= 1) c += o;
          o = __builtin_bit_cast(float, __builtin_amdgcn_ds_bpermute((F.lane - 2) << 2, __builtin_bit_cast(int, c))); if (F.lane >= 2) c += o;
          o = __builtin_bit_cast(float, __builtin_amdgcn_ds_bpermute((F.lane - 4) << 2, __builtin_bit_cast(int, c))); if (F.lane >= 4) c += o;
          o = __builtin_bit_cast(float, __builtin_amdgcn_ds_bpermute((F.lane - 8) << 2, __builtin_bit_cast(int, c))); if (F.lane >= 8) c += o;
          o = __builtin_bit_cast(float, __builtin_amdgcn_ds_bpermute((F.lane - 16) << 2, __builtin_bit_cast(int, c))); if (F.lane >= 16) c += o;
          o = __builtin_bit_cast(float, __builtin_amdgcn_ds_bpermute((F.lane - 32) << 2, __builtin_bit_cast(int, c))); if (F.lane >= 32) c += o; }
        const float cl = __builtin_bit_cast(float, __builtin_amdgcn_ds_bpermute(63 << 2, __builtin_bit_cast(int, c)));
        scum[q * 64 + t] = c; sw[q * 64 + t] = __expf(cl - c) * dtv;
    }
    __syncthreads();
    const int h = F.wave & 3, r = F.wave >> 2, lr = F.lane & 15, g = F.lane >> 4, gp = h >> 1, rh = r * 4 + h;
    const size_t ub = ((size_t)cid * 4 + h) * 2 + r;
    if constexpr (DO_STATE) {
        f32x4 acc[4][4];
#pragma unroll
        for (int ms = 0; ms < 4; ++ms)
#pragma unroll
            for (int d = 0; d < 4; ++d) acc[ms][d] = (f32x4){0.f, 0.f, 0.f, 0.f};
#pragma unroll
        for (int sg = 0; sg < 2; ++sg) {
            const int trow = 32 * sg + 8 * g;
            bf16x8 xf[4];
#pragma unroll
            for (int d = 0; d < 4; ++d) { const LAS bf16* p0 = xc + (trow + ((F.lane & 15) >> 2)) * SD_RS + h * 64 + 16 * d + 4 * (F.lane & 3); xf[d] = cat8(trread(p0), trread(p0 + 4 * SD_RS)); }
            float wv[8];
            *(f32x4*)wv = *(const LAS f32x4*)(sw + rh * 64 + trow); *(f32x4*)(wv + 4) = *(const LAS f32x4*)(sw + rh * 64 + trow + 4);
#pragma unroll
            for (int ms = 0; ms < 4; ++ms) {
                const LAS bf16* p0 = xc + (trow + ((F.lane & 15) >> 2)) * SD_RS + 256 + gp * 64 + 16 * ms + 4 * (F.lane & 3);
                const s16x4 b0 = trread(p0), b1 = trread(p0 + 4 * SD_RS);
                float bv[8];
#pragma unroll
                for (int e = 0; e < 4; ++e) { bv[e] = bf2f((unsigned short)b0[e]) * wv[e]; bv[4 + e] = bf2f((unsigned short)b1[e]) * wv[4 + e]; }
                const bf16x8 bf = pack8(bv);
#pragma unroll
                for (int d = 0; d < 4; ++d) acc[ms][d] = MFMA16(bf, xf[d], acc[ms][d]);
            }
        }
        float* ds = (float*)(F.ws + WS_SDS) + ub * 4096;
#pragma unroll
        for (int ms = 0; ms < 4; ++ms)
#pragma unroll
            for (int d = 0; d < 4; ++d) *(f32x4*)(ds + (16 * d + lr) * 64 + 16 * ms + 4 * g) = acc[ms][d];
        if (F.lane == 0) ((float*)(F.ws + WS_SDEC))[ub] = __expf(scum[rh * 64 + (r ? 0 : 63)]);
    }
    if constexpr (DO_INTRA) {
        bf16x8 bfr[4][2], cfr[4][2];
#pragma unroll
        for (int m = 0; m < 4; ++m)
#pragma unroll
            for (int ks = 0; ks < 2; ++ks) { bfr[m][ks] = *(const LAS bf16x8*)(xc + (16 * m + lr) * SD_RS + 256 + gp * 64 + 32 * ks + 8 * g); cfr[m][ks] = *(const LAS bf16x8*)(xc + (16 * m + lr) * SD_RS + 384 + gp * 64 + 32 * ks + 8 * g); }
        f32x4 y[4][4];
#pragma unroll
        for (int m = 0; m < 4; ++m)
#pragma unroll
            for (int d = 0; d < 4; ++d) y[m][d] = (f32x4){0.f, 0.f, 0.f, 0.f};
        if constexpr (OUT) {
            bf16x8 cs[4][2];
#pragma unroll
            for (int m = 0; m < 4; ++m) { const float ec = __expf(scum[rh * 64 + 16 * m + lr]);
#pragma unroll
                for (int ks = 0; ks < 2; ++ks) { float cv[8]; unpack8(cfr[m][ks], cv);
#pragma unroll
                    for (int e = 0; e < 8; ++e) cv[e] *= ec;
                    cs[m][ks] = pack8(cv); } }
#pragma unroll
            for (int d = 0; d < 4; ++d) {
#pragma unroll
                for (int m = 0; m < 4; ++m) { y[m][d] = MFMA16(cs[m][0], sfr[d][0], y[m][d]); y[m][d] = MFMA16(cs[m][1], sfr[d][1], y[m][d]); }
            }
        }
        asm volatile("" ::: "memory");
        bf16x8 xf[2][4];
#pragma unroll
        for (int sg = 0; sg < 2; ++sg)
#pragma unroll
            for (int d = 0; d < 4; ++d) { const LAS bf16* p0 = xc + (32 * sg + 4 * g + ((F.lane & 15) >> 2)) * SD_RS + h * 64 + 16 * d + 4 * (F.lane & 3); xf[sg][d] = cat8(trread(p0), trread(p0 + 16 * SD_RS)); }
        const f32x4 zero4 = (f32x4){0.f, 0.f, 0.f, 0.f};
#pragma unroll
        for (int m = 0; m < 4; ++m) {
            const int t = 16 * m + lr; const float ct = scum[rh * 64 + t];
#pragma unroll
            for (int sg = 0; sg < 2; ++sg) {
                f32x4 p0 = MFMA16(bfr[2 * sg][0], cfr[m][0], zero4), p1 = MFMA16(bfr[2 * sg + 1][0], cfr[m][0], zero4);
                p0 = MFMA16(bfr[2 * sg][1], cfr[m][1], p0); p1 = MFMA16(bfr[2 * sg + 1][1], cfr[m][1], p1);
                float pv[8];
#pragma unroll
                for (int j = 0; j < 4; ++j) { const int s0 = 32 * sg + 4 * g + j, s1 = s0 + 16;
                    pv[j] = (r ? s0 >= t : s0 <= t) ? p0[j] * __expf(ct - scum[rh * 64 + s0]) * sdt[s0 * 8 + rh] : 0.f;
                    pv[4 + j] = (r ? s1 >= t : s1 <= t) ? p1[j] * __expf(ct - scum[rh * 64 + s1]) * sdt[s1 * 8 + rh] : 0.f; }
                const bf16x8 pf = pack8(pv);
#pragma unroll
                for (int d = 0; d < 4; ++d) y[m][d] = MFMA16(pf, xf[sg][d], y[m][d]);
            }
        }
        __syncthreads();
        LAS float* yx = (LAS float*)(F.lds + SD_RAW);
        if (r == 1) {
#pragma unroll
            for (int m = 0; m < 4; ++m)
#pragma unroll
                for (int d = 0; d < 4; ++d)
#pragma unroll
                    for (int j = 0; j < 4; ++j) yx[(16 * m + 4 * g + j) * 260 + h * 64 + 16 * d + lr] = y[m][d][j];
        }
        __syncthreads();
        if (r == 0) { const float dsk = a.in[I_SSDD][L * 4 + h];
#pragma unroll
            for (int m = 0; m < 4; ++m)
#pragma unroll
                for (int d = 0; d < 4; ++d)
#pragma unroll
                    for (int j = 0; j < 4; ++j) { const int t = 16 * m + 4 * g + j, c = h * 64 + 16 * d + lr; yx[t * 260 + c] += y[m][d][j] + dsk * bf2f(xc[t * SD_RS + c]); asm volatile("" ::: "memory"); }
        }
        __syncthreads();
        if constexpr (OUT) {
        { const int t = F.tid >> 3, c0 = (F.tid & 7) * 32; const bf16* zr = PB + (size_t)(tok0 + t) * PW + PC_Z + c0; const float* ng = a.in[I_SSDNG] + L * 256 + c0;
          float v[32]; float ss = 0.f;
#pragma unroll
          for (int q = 0; q < 4; ++q) { float zv[8]; unpack8(*(const bf16x8*)(zr + 8 * q), zv);
#pragma unroll
              for (int e = 0; e < 8; ++e) { const float u = yx[t * 260 + c0 + 8 * q + e] * siluf_(zv[e]); v[8 * q + e] = u; ss += u * u; } }
          ss += swz_xor<1>(ss); ss += swz_xor<2>(ss); ss += swz_xor<4>(ss);
          const float rs = rsqrtf(ss * (1.f / 256.f) + 1e-6f);
          bf16* MX = (bf16*)(F.ws + WS_MIX) + (size_t)(tok0 + t) * MW + 1024 + c0;
#pragma unroll
          for (int q = 0; q < 4; ++q) { float o8[8];
#pragma unroll
              for (int e = 0; e < 8; ++e) o8[e] = v[8 * q + e] * rs * ng[8 * q + e];
              *(bf16x8*)(MX + 8 * q) = pack8(o8); } }
        } else {
            { const int t = F.tid >> 3, c0 = (F.tid & 7) * 32; bf16* yo = (bf16*)(F.ws + WS_SYI) + (size_t)(tok0 + t) * 256 + c0;
#pragma unroll
              for (int q = 0; q < 4; ++q) { float o8[8];
#pragma unroll
                  for (int e = 0; e < 8; ++e) o8[e] = yx[t * 260 + c0 + 8 * q + e];
                  *(bf16x8*)(yo + 8 * q) = pack8(o8); } }
            { bf16* cb = (bf16*)(F.ws + WS_SCB) + (size_t)tok0 * 128;
#pragma unroll
              for (int k = 0; k < 2; ++k) { const int i = F.tid + k * NTHR, t = i >> 4, pc = i & 15; *(u32x4*)(cb + (size_t)t * 128 + pc * 8) = *(const LAS u32x4*)(xc + t * SD_RS + 384 + pc * 8); } }
            { const int t = F.tid >> 3, q = F.tid & 7; ((float*)(F.ws + WS_SCUM))[(size_t)(tok0 + t) * 8 + q] = scum[q * 64 + t]; }
        }
    }
}


__device__ __forceinline__ void ssd_light(Frame& F0, CArgs& a, int L, int cid) {
    LAUNDER_F(F0)
    const int tok0 = chunk_tok0(cid), h = F.wave & 3, r = F.wave >> 2, lr = F.lane & 15, g = F.lane >> 4, gp = h >> 1, rh = r * 4 + h;
    const bf16* cb = (const bf16*)(F.ws + WS_SCB) + (size_t)tok0 * 128; const float* cum = (const float*)(F.ws + WS_SCUM) + (size_t)tok0 * 8;
    const bf16* se = (const bf16*)(F.ws + WS_SSE) + (((size_t)cid * 4 + h) * 2 + r) * 4096;
    bf16x8 cfr[4][2], sfr[4][2]; float ec[4];
#pragma unroll
    for (int m = 0; m < 4; ++m) { ec[m] = cum[(size_t)(16 * m + lr) * 8 + rh];
#pragma unroll
        for (int ks = 0; ks < 2; ++ks) cfr[m][ks] = *(const bf16x8*)(cb + (size_t)(16 * m + lr) * 128 + gp * 64 + 32 * ks + 8 * g); }
#pragma unroll
    for (int d = 0; d < 4; ++d) { sfr[d][0] = *(const bf16x8*)(se + (16 * d + lr) * 64 + 8 * g); sfr[d][1] = *(const bf16x8*)(se + (16 * d + lr) * 64 + 32 + 8 * g); }
    const int tt = F.tid >> 3, c0 = (F.tid & 7) * 32;
    bf16x8 zr[4], yi[4];
    { const bf16* zp = (const bf16*)(F.ws + WS_PBUF) + (size_t)(tok0 + tt) * PW + PC_Z + c0; const bf16* yp = (const bf16*)(F.ws + WS_SYI) + (size_t)(tok0 + tt) * 256 + c0;
#pragma unroll
      for (int q = 0; q < 4; ++q) { zr[q] = *(const bf16x8*)(zp + 8 * q); yi[q] = *(const bf16x8*)(yp + 8 * q); } }
    f32x4 y[4][4];
#pragma unroll
    for (int m = 0; m < 4; ++m) { const float e_ = __expf(ec[m]); bf16x8 cs[2];
#pragma unroll
        for (int ks = 0; ks < 2; ++ks) { float cv[8]; unpack8(cfr[m][ks], cv);
#pragma unroll
            for (int e = 0; e < 8; ++e) cv[e] *= e_;
            cs[ks] = pack8(cv); }
#pragma unroll
        for (int d = 0; d < 4; ++d) { y[m][d] = MFMA16(cs[0], sfr[d][0], ((f32x4){0.f, 0.f, 0.f, 0.f})); y[m][d] = MFMA16(cs[1], sfr[d][1], y[m][d]); } }
    LAS float* yx = (LAS float*)(F.lds + SD_RAW);
    __syncthreads();
    if (r == 1) {
#pragma unroll
        for (int m = 0; m < 4; ++m)
#pragma unroll
            for (int d = 0; d < 4; ++d)
#pragma unroll
                for (int j = 0; j < 4; ++j) yx[(16 * m + 4 * g + j) * 260 + h * 64 + 16 * d + lr] = y[m][d][j];
    }
    __syncthreads();
    if (r == 0) {
#pragma unroll
        for (int m = 0; m < 4; ++m)
#pragma unroll
            for (int d = 0; d < 4; ++d)
#pragma unroll
                for (int j = 0; j < 4; ++j) yx[(16 * m + 4 * g + j) * 260 + h * 64 + 16 * d + lr] += y[m][d][j];
    }
    __syncthreads();
    { const float* ng = a.in[I_SSDNG] + L * 256 + c0;
      float v[32]; float ss = 0.f;
#pragma unroll
      for (int q = 0; q < 4; ++q) { float zv[8], yv[8]; unpack8(zr[q], zv); unpack8(yi[q], yv);
#pragma unroll
          for (int e = 0; e < 8; ++e) { const float u = (yx[tt * 260 + c0 + 8 * q + e] + yv[e]) * siluf_(zv[e]); v[8 * q + e] = u; ss += u * u; } }
      ss += swz_xor<1>(ss); ss += swz_xor<2>(ss); ss += swz_xor<4>(ss);
      const float rs = rsqrtf(ss * (1.f / 256.f) + 1e-6f);
      bf16* MX = (bf16*)(F.ws + WS_MIX) + (size_t)(tok0 + tt) * MW + 1024 + c0;
#pragma unroll
      for (int q = 0; q < 4; ++q) { float o8[8];
#pragma unroll
          for (int e = 0; e < 8; ++e) o8[e] = v[8 * q + e] * rs * ng[8 * q + e];
          *(bf16x8*)(MX + 8 * q) = pack8(o8); } }
}

constexpr int FF_XP = 0, FF_TR = FF_XP + 16 * 64 * 16 * 2, FF_TI = FF_TR + 16 * 64 * 16 * 2, FF_TW = FF_TI + 16 * 64 * 16 * 2, FF_FT = FF_TW + 64 * 16 * 8, FF_END = FF_FT + 2 * 64 * 72 * 2;
static_assert(FF_END <= MISC_OFF, "FFT LDS");
__device__ __forceinline__ void fft_unit(Frame& F0, int u) {
    LAUNDER_F(F0)
    const int b = u >> 6, cg = (u >> 2) & 15, kb = u & 3, lr = F.lane & 15, g = F.lane >> 4;
    const bf16* PB = (const bf16*)(F.ws + WS_PBUF) + (size_t)b * SEQ * PW + PC_FU + 16 * cg;
    const bf16* f64 = (const bf16*)(F.ws + WS_TAB + TAB_F64); const float* tw = (const float*)(F.ws + WS_TAB + TAB_TW);
    LAS bf16* xp = (LAS bf16*)(F.lds + FF_XP); LAS bf16* tr = (LAS bf16*)(F.lds + FF_TR); LAS bf16* ti = (LAS bf16*)(F.lds + FF_TI);
    LAS float* stw = (LAS float*)(F.lds + FF_TW);
    LAS bf16* sft = (LAS bf16*)(F.lds + FF_FT);
    bf16x8 fc1[2], fs1[2];
#pragma unroll
    for (int ks = 0; ks < 2; ++ks) { fc1[ks] = *(const bf16x8*)(f64 + (16 * kb + lr) * 64 + 32 * ks + 8 * g); fs1[ks] = *(const bf16x8*)(f64 + 4096 + (16 * kb + lr) * 64 + 32 * ks + 8 * g); }
    const f32x4 zero4 = (f32x4){0.f, 0.f, 0.f, 0.f};
    u32x4 xr[4], ft[2]; f32x2 twr[2];
#pragma unroll
    for (int k = 0; k < 4; ++k) { const int i = F.tid + k * NTHR, n2l = i >> 7, n1 = (i >> 1) & 63, hf = i & 1; xr[k] = *(const u32x4*)(PB + (size_t)(64 * n1 + n2l) * PW + hf * 8); }
#pragma unroll
    for (int k = 0; k < 2; ++k) { const int i = F.tid + k * NTHR; ft[k] = *(const u32x4*)(f64 + (size_t)i * 8); twr[k] = *(const f32x2*)(tw + 2 * ((i >> 4) * (16 * kb + (i & 15)))); }
    __syncthreads();
#pragma unroll
    for (int k = 0; k < 2; ++k) { const int i = F.tid + k * NTHR, row = i >> 3, pc = i & 7; *(LAS u32x4*)(sft + row * 72 + pc * 8) = ft[k]; stw[2 * i] = twr[k][0]; stw[2 * i + 1] = twr[k][1]; }
    for (int pa = 0; pa < 4; ++pa) {
        if (pa) __syncthreads();
#pragma unroll
        for (int k = 0; k < 4; ++k) { const int i = F.tid + k * NTHR, n2l = i >> 7, n1 = (i >> 1) & 63, hf = i & 1; *(LAS u32x4*)(xp + (n2l * 64 + n1) * 16 + hf * 8) = xr[k]; }
        if (pa < 3) {
#pragma unroll
            for (int k = 0; k < 4; ++k) { const int i = F.tid + k * NTHR, n2l = i >> 7, n1 = (i >> 1) & 63, hf = i & 1; xr[k] = *(const u32x4*)(PB + (size_t)(64 * n1 + 16 * (pa + 1) + n2l) * PW + hf * 8); }
        }
        __syncthreads();
#pragma unroll
        for (int q = 0; q < 2; ++q) {
            const int n2l = 2 * F.wave + q, n2 = 16 * pa + n2l;
            f32x4 tc = zero4, ts = zero4;
#pragma unroll
            for (int ks = 0; ks < 2; ++ks) { const LAS bf16* p0 = xp + (n2l * 64 + 32 * ks + 8 * g + ((F.lane & 15) >> 2)) * 16 + 4 * (F.lane & 3); const bf16x8 xb = cat8(trread(p0), trread(p0 + 4 * 16));
                tc = MFMA16(fc1[ks], xb, tc); ts = MFMA16(fs1[ks], xb, ts); }
#pragma unroll
            for (int j = 0; j < 4; ++j) { const int k1l = 4 * g + j; const f32x2 w = *(const LAS f32x2*)(stw + 2 * (n2 * 16 + k1l));
                tr[(k1l * 64 + n2) * 16 + lr] = (bf16)f2bf(tc[j] * w[0] - ts[j] * w[1]); ti[(k1l * 64 + n2) * 16 + lr] = (bf16)f2bf(-(tc[j] * w[1] + ts[j] * w[0])); }
        }
    }
    __syncthreads();
    bf16* MX0 = (bf16*)(F.ws + WS_MIX) + (size_t)b * SEQ * MW + 16 * cg;
    LAS bf16* so = xp + F.wave * 2048;
#pragma unroll
    for (int q = 0; q < 2; ++q) {
        const int k1l = 2 * F.wave + q, k1 = 16 * kb + k1l;
        bf16x8 br[2], bi[2];
#pragma unroll
        for (int ks = 0; ks < 2; ++ks) { const int off = (k1l * 64 + 32 * ks + 8 * g + ((F.lane & 15) >> 2)) * 16 + 4 * (F.lane & 3); br[ks] = cat8(trread(tr + off), trread(tr + off + 64)); bi[ks] = cat8(trread(ti + off), trread(ti + off + 64)); }
#pragma unroll
        for (int m = 0; m < 4; ++m) {
            f32x4 yr = zero4, y1 = zero4, y2 = zero4;
#pragma unroll
            for (int ks = 0; ks < 2; ++ks) { const bf16x8 fc = *(const LAS bf16x8*)(sft + (16 * m + lr) * 72 + 32 * ks + 8 * g), fs = *(const LAS bf16x8*)(sft + (64 + 16 * m + lr) * 72 + 32 * ks + 8 * g);
                yr = MFMA16(fc, br[ks], yr); yr = MFMA16(fs, bi[ks], yr); y1 = MFMA16(fc, bi[ks], y1); y2 = MFMA16(fs, br[ks], y2); }
#pragma unroll
            for (int j = 0; j < 4; ++j) { const int k2 = 16 * m + 4 * g + j; so[k2 * 32 + lr] = (bf16)f2bf(yr[j] * (1.f / 64.f)); so[k2 * 32 + 16 + lr] = (bf16)f2bf((y1[j] - y2[j]) * (1.f / 64.f)); }
        }
#pragma unroll
        for (int p = 0; p < 4; ++p) { const int pc = F.lane + 64 * p, k2 = pc >> 2, part = pc & 3;
            const u32x4 v = *(const LAS u32x4*)(so + k2 * 32 + (part >> 1) * 16 + (part & 1) * 8);
            *(u32x4*)(MX0 + (size_t)(64 * k2 + k1) * MW + (part >> 1) * 256 + (part & 1) * 8) = v; }
    }
}
constexpr int CD_RS = 264;
static_assert(256 * CD_RS * 2 <= MISC_OFF, "ctx DFT LDS");
__device__ __forceinline__ void dft_ctx_unit(Frame& F0, int u) {
    LAUNDER_F(F0)
    const int b = u >> 3, kb = u & 7, lr = F.lane & 15, g = F.lane >> 4;
    LAS bf16* sl = (LAS bf16*)F.lds;
    const bf16* PB = (const bf16*)(F.ws + WS_PBUF) + (size_t)(NLAT + b * CTXL) * PW + PC_FU;
    const bf16* dc = (const bf16*)(F.ws + WS_DFTC);
    __syncthreads();
#pragma unroll
    for (int h = 0; h < 2; ++h) { u32x4 v[8];
#pragma unroll
        for (int k = 0; k < 8; ++k) { const int i = F.tid + (h * 8 + k) * NTHR, n = i >> 5, pc = i & 31; v[k] = *(const u32x4*)(PB + (size_t)n * PW + pc * 8); }
#pragma unroll
        for (int k = 0; k < 8; ++k) { const int i = F.tid + (h * 8 + k) * NTHR, n = i >> 5, pc = i & 31; *(LAS u32x4*)(sl + n * CD_RS + pc * 8) = v[k]; } }
    __syncthreads();
    f32x4 acc[4][2];
#pragma unroll
    for (int mt = 0; mt < 4; ++mt)
#pragma unroll
        for (int nt = 0; nt < 2; ++nt) acc[mt][nt] = (f32x4){0.f, 0.f, 0.f, 0.f};
#pragma unroll 2
    for (int ks = 0; ks < 8; ++ks) {
        bf16x8 af[4], bfm[2];
#pragma unroll
        for (int mt = 0; mt < 4; ++mt) af[mt] = *(const bf16x8*)(dc + (size_t)((mt >> 1) * 256 + 32 * kb + 16 * (mt & 1) + lr) * 256 + 32 * ks + 8 * g);
#pragma unroll
        for (int nt = 0; nt < 2; ++nt) { const LAS bf16* p0 = sl + (32 * ks + 8 * g + ((F.lane & 15) >> 2)) * CD_RS + 32 * F.wave + 16 * nt + 4 * (F.lane & 3); bfm[nt] = cat8(trread(p0), trread(p0 + 4 * CD_RS)); }
#pragma unroll
        for (int mt = 0; mt < 4; ++mt)
#pragma unroll
            for (int nt = 0; nt < 2; ++nt) acc[mt][nt] = MFMA16(af[mt], bfm[nt], acc[mt][nt]);
    }
    bf16* MX = (bf16*)(F.ws + WS_MIX) + (size_t)(NLAT + b * CTXL + 32 * kb) * MW + 32 * F.wave + lr;
#pragma unroll
    for (int mt = 0; mt < 4; ++mt)
#pragma unroll
        for (int nt = 0; nt < 2; ++nt)
#pragma unroll
            for (int j = 0; j < 4; ++j) MX[(size_t)(16 * (mt & 1) + 4 * g + j) * MW + (mt >> 1) * 256 + 16 * nt] = (bf16)f2bf(acc[mt][nt][j] * (1.f / 16.f));
}

#ifndef SUBMASK
#define SUBMASK 0xFFFF
#endif
#define SUB(bit) (rep == 0 || ((SUBMASK >> (bit)) & 1))
__device__ __forceinline__ void p_mix_a(Frame& F, CArgs& a, int L, int rep = 0) {
    if (SUB(0)) {
        pg8::Gemm g{(const bf16*)(F.ws + WS_A2), (const bf16*)(F.ws + WS_S5P) + (size_t)L * 16 * 256 * 256, 1024, 512, OPQ(256)};
        SgOrder<FillS5> S; S.init(144, 1, F.G, F.bid); S.f = FillS5{(size_t)256 * 256 * 2};
        EpiS5S E{(float*)(F.ws + WS_S5S)};
        pg8::gemm_phase(F.lds, g, S, E, fresh_tid(F.wave));
    }
    const int og = F.G >= 208 ? 144 : 0, os = F.G >= 208 ? 176 : 32 % F.G;
    if (SUB(1)) for (int u = (F.bid + F.G - og) % F.G; u < NCHK; u += F.G) gla_chunk<MIX_P1 ? 2 : 0>(F, a, L, u);
    if (SUB(2)) for (int u = (F.bid + F.G - os) % F.G; u < NCHK; u += F.G) ssd_chunk<MIX_P1 ? 2 : 0>(F, a, L, u);
    __syncthreads();
}
__device__ __forceinline__ void p_mix_b(Frame& F, CArgs& a, int L, int rep = 0) {
    if (SUB(3)) for (int u = F.bid; u < 256; u += F.G) {
        const int vz = F.tid >> 9, uv = u + vz, wv = (F.tid >> 6);
        const int b = uv >> 5, g = (uv >> 1) & 15, r = uv & 1;
        const f32x2 a16 = *(const f32x2*)((const float*)(F.ws + WS_A16) + ((size_t)((L * 2 + r) * 16 + g) * 64 + F.lane) * 2);
        const float* S = (const float*)(F.ws + WS_S5S) + (size_t)g * S5ROWS * 256 + r * 128 + F.lane; bf16* A2 = (bf16*)(F.ws + WS_A2) + (size_t)g * S5ROWS * 512 + 256 + r * 128 + F.lane;
        LAS float* ex = (LAS float*)F.lds;
        LAS float* sl = ex + 17 * 128;
        __syncthreads();
#pragma unroll 1
        for (int sg = wv; sg < 17; sg += 8) {
            float sr[16], si[16];
#pragma unroll
            for (int n = 0; n < 16; ++n) { const int i = 16 * sg + n; const int row = i < 16 ? 2048 + 16 * b + (r ? 15 - i : i) : 256 * b + (r ? 271 - i : i - 16); sr[n] = S[(size_t)row * 256]; si[n] = S[(size_t)row * 256 + 64]; }
            float hr = 0.f, hi = 0.f;
#pragma unroll
            for (int n = 0; n < 16; ++n) { sl[((16 * sg + n) * 64 + F.lane) * 2] = sr[n]; sl[((16 * sg + n) * 64 + F.lane) * 2 + 1] = si[n];
                const float nr = a16[0] * hr - a16[1] * hi + sr[n], ni = a16[0] * hi + a16[1] * hr + si[n]; hr = nr; hi = ni; }
            ex[(sg * 64 + F.lane) * 2] = hr; ex[(sg * 64 + F.lane) * 2 + 1] = hi;
        }
        __syncthreads();
        float pr = a16[0], pi = a16[1];
#pragma unroll
        for (int q = 0; q < 4; ++q) { const float nr = pr * pr - pi * pi, ni = 2.f * pr * pi; pr = nr; pi = ni; }
#pragma unroll 1
        for (int sg = wv; sg < 17; sg += 8) {
            float hr = 0.f, hi = 0.f;
            for (int j = 0; j < sg; ++j) { const float er = ex[(j * 64 + F.lane) * 2], ei = ex[(j * 64 + F.lane) * 2 + 1]; const float nr = pr * hr - pi * hi + er, ni = pr * hi + pi * hr + ei; hr = nr; hi = ni; }
#pragma unroll 4
            for (int n = 0; n < 16; ++n) { const int i = 16 * sg + n; const int row = i < 16 ? 2048 + 16 * b + (r ? 15 - i : i) : 256 * b + (r ? 271 - i : i - 16);
                A2[(size_t)row * 512] = (bf16)f2bf(hr); A2[(size_t)row * 512 + 64] = (bf16)f2bf(hi);
                const float xr_ = sl[(i * 64 + F.lane) * 2], xi_ = sl[(i * 64 + F.lane) * 2 + 1];
                const float nr = a16[0] * hr - a16[1] * hi + xr_, ni = a16[0] * hi + a16[1] * hr + xi_; hr = nr; hi = ni; }
        }
    }
    if (F.G == 256) {
        if (SUB(3)) { const int vz = F.tid >> 9;
            const int ug = F.bid + vz, sqg = ug >> 2, bg = sqg >> 3, hg = (sqg >> 1) & 3, rg = sqg & 1, eg = (ug & 3) * 512 + F.tid, cg = eg & 31;
            const int u0 = F.bid + vz, s0q = u0 >> 3, b0 = s0q >> 3, h0 = (s0q >> 1) & 3, r0 = s0q & 1, e0 = (u0 & 7) * 512 + F.tid;
            const int u1 = F.bid + 256 + vz, s1q = u1 >> 3, b1 = s1q >> 3, h1 = (s1q >> 1) & 3, r1 = s1q & 1, e1 = (u1 & 7) * 512 + F.tid;
            const float* gds = (const float*)(F.ws + WS_GDS); const float* gdc = (const float*)(F.ws + WS_GDEC); bf16* gse = (bf16*)(F.ws + WS_GSE);
            const float* sds = (const float*)(F.ws + WS_SDS); const float* sdc = (const float*)(F.ws + WS_SDEC); bf16* sse = (bf16*)(F.ws + WS_SSE);
            float sg_ = 0.f, s0_ = 0.f, s1_ = 0.f;
#define SCAN_CID(i, b, r) ((i) < 4 ? 512 + (b) * 4 + ((r) ? 3 - (i) : (i)) : (b) * 64 + ((r) ? 67 - (i) : (i) - 4))
            for (int i0 = 0; i0 < 68; i0 += 17) { float gv_[17], gc_[17], av_[17], ac_[17], bv_[17], bc_[17];
#pragma unroll
                for (int k = 0; k < 17; ++k) { const int i = i0 + k;
                    { const size_t ub = ((size_t)SCAN_CID(i, bg, rg) * 4 + hg) * 2 + rg; gv_[k] = gds[ub * 2048 + eg]; gc_[k] = gdc[ub * 32 + cg]; }
                    { const size_t ub = ((size_t)SCAN_CID(i, b0, r0) * 4 + h0) * 2 + r0; av_[k] = sds[ub * 4096 + e0]; ac_[k] = sdc[ub]; }
                    { const size_t ub = ((size_t)SCAN_CID(i, b1, r1) * 4 + h1) * 2 + r1; bv_[k] = sds[ub * 4096 + e1]; bc_[k] = sdc[ub]; } }
#pragma unroll
                for (int k = 0; k < 17; ++k) { const int i = i0 + k;
                    { const size_t ub = ((size_t)SCAN_CID(i, bg, rg) * 4 + hg) * 2 + rg; gse[ub * 2048 + eg] = (bf16)f2bf(sg_); sg_ = gc_[k] * sg_ + gv_[k]; }
                    { const size_t ub = ((size_t)SCAN_CID(i, b0, r0) * 4 + h0) * 2 + r0; sse[ub * 4096 + e0] = (bf16)f2bf(s0_); s0_ = ac_[k] * s0_ + av_[k]; }
                    { const size_t ub = ((size_t)SCAN_CID(i, b1, r1) * 4 + h1) * 2 + r1; sse[ub * 4096 + e1] = (bf16)f2bf(s1_); s1_ = bc_[k] * s1_ + bv_[k]; } } }
#undef SCAN_CID
        }
    } else {
    if (SUB(3)) for (int u = F.bid; u < 256; u += F.G) { const int uv = u + (F.tid >> 9), sq = uv >> 2, b = sq >> 3, hh = (sq >> 1) & 3, r = sq & 1, e = (uv & 3) * 512 + F.tid, c = e & 31;
        const float* ds = (const float*)(F.ws + WS_GDS); const float* dc = (const float*)(F.ws + WS_GDEC); bf16* se = (bf16*)(F.ws + WS_GSE);
        float s = 0.f;
        for (int i0 = 0; i0 < 68; i0 += 17) { float dv[17], cv[17];
#pragma unroll
            for (int k = 0; k < 17; ++k) { const int i = i0 + k; const int cid = i < 4 ? 512 + b * 4 + (r ? 3 - i : i) : b * 64 + (r ? 67 - i : i - 4); const size_t ub = ((size_t)cid * 4 + hh) * 2 + r; dv[k] = ds[ub * 2048 + e]; cv[k] = dc[ub * 32 + c]; }
#pragma unroll
            for (int k = 0; k < 17; ++k) { const int i = i0 + k; const int cid = i < 4 ? 512 + b * 4 + (r ? 3 - i : i) : b * 64 + (r ? 67 - i : i - 4); const size_t ub = ((size_t)cid * 4 + hh) * 2 + r; se[ub * 2048 + e] = (bf16)f2bf(s); s = cv[k] * s + dv[k]; } } }
    if (SUB(3)) for (int u = F.bid; u < 512; u += F.G) { const int uv = u + (F.tid >> 9), sq = uv >> 3, b = sq >> 3, h = (sq >> 1) & 3, r = sq & 1, e = (uv & 7) * 512 + F.tid;
        const float* ds = (const float*)(F.ws + WS_SDS); const float* dc = (const float*)(F.ws + WS_SDEC); bf16* se = (bf16*)(F.ws + WS_SSE);
        float s = 0.f;
        for (int i0 = 0; i0 < 68; i0 += 17) { float dv[17], cv[17];
#pragma unroll
            for (int k = 0; k < 17; ++k) { const int i = i0 + k; const int cid = i < 4 ? 512 + b * 4 + (r ? 3 - i : i) : b * 64 + (r ? 67 - i : i - 4); const size_t ub = ((size_t)cid * 4 + h) * 2 + r; dv[k] = ds[ub * 4096 + e]; cv[k] = dc[ub]; }
#pragma unroll
            for (int k = 0; k < 17; ++k) { const int i = i0 + k; const int cid = i < 4 ? 512 + b * 4 + (r ? 3 - i : i) : b * 64 + (r ? 67 - i : i - 4); const size_t ub = ((size_t)cid * 4 + h) * 2 + r; se[ub * 4096 + e] = (bf16)f2bf(s); s = cv[k] * s + dv[k]; } } }
    }
    if (SUB(4)) for (int u = F.bid; u < 512; u += F.G) fft_unit(F, u);
    if (SUB(5)) for (int u = (F.bid + 64) % F.G; u < 64; u += F.G) dft_ctx_unit(F, u);
    __syncthreads();
}
__device__ __forceinline__ void p_mix_c(Frame& F, CArgs& a, int L, int rep = 0) {
#ifndef MIXC_PARTS
#define MIXC_PARTS 7
#endif
    if ((MIXC_PARTS & 1) && SUB(6)) {
        pg8::Gemm g{(const bf16*)(F.ws + WS_A2), (const bf16*)(F.ws + WS_S5B2) + (size_t)L * 16 * 256 * 512, 1024, 1024, OPQ(512)};
        SgOrder<FillS5> S; S.init(144, 1, F.G, F.bid); S.f = FillS5{(size_t)256 * 512 * 2};
        EpiS5Y E{(bf16*)(F.ws + WS_ACT5)};
        pg8::gemm_phase(F.lds, g, S, E, fresh_tid(F.wave));
    }
    const int nch = (L == DEPTH - 1) ? 512 : NCHK;
    const int og = F.G >= 208 ? 144 : 0, os = F.G >= 208 ? 176 : 32 % F.G;
    if ((MIXC_PARTS & 2) && SUB(7)) for (int u = (F.bid + F.G - og) % F.G; u < nch; u += F.G) { if constexpr (MIX_P1) gla_light(F, a, L, u); else gla_chunk<1>(F, a, L, u); }
    if ((MIXC_PARTS & 4) && SUB(8)) for (int u = (F.bid + F.G - os) % F.G; u < nch; u += F.G) { if constexpr (MIX_P1) ssd_light(F, a, L, u); else ssd_chunk<1>(F, a, L, u); }
    __syncthreads();
}

constexpr int NPH = 11, PH_TOTAL = 2 + DEPTH * NPH;
#ifndef PHASE_MASK
#define PHASE_MASK 0xFFFF
#endif
#define PM(i) ((PHASE_MASK >> (i)) & 1)
#ifndef DUP_MASK
#define DUP_MASK 0
#endif
#define NREP(k) (((DUP_MASK >> (k)) & 1) ? 2 : 1)
#ifndef MK_ONE_LAUNCH
#define MK_ONE_LAUNCH 0
#endif

__global__ void __launch_bounds__(NTHR, 2) mk_fwd(Args args_by_value) {
#define args (*fresh_args())
    extern __shared__ __attribute__((aligned(16))) unsigned char lds_raw[];
    Frame F;
    F.lds = (LAS unsigned char*)lds_raw; F.MISC = (volatile LAS unsigned*)(F.lds + MISC_OFF);
    F.tid = threadIdx.x; F.lane = F.tid & 63; F.wave = __builtin_amdgcn_readfirstlane(F.tid >> 6); F.G = gridDim.x; F.bid = blockIdx.x;
    F.ws = args_by_value.ws; F.ctl = (unsigned*)(args_by_value.ws + WS_CTL);
    if (F.tid < 64) F.MISC[F.tid] = 0u;
    __syncthreads();
#if MK_ONE_LAUNCH
    XcdBarrier bar = xcd_barrier_post(F.ctl + CW_BAR, F.MISC + 8);
#define GRID_BAR() xcd_barrier(bar)
#else
#define GRID_BAR() do { } while (0)
#endif
    const int lo = args_by_value.ph_lo, hi = args_by_value.ph_hi;
#define IN(k) (lo <= (k) && (k) < hi)
#define FRESH() do { const int t_ = fresh_tid(F.wave); F.tid = t_; F.lane = t_ & 63; } while (0)
#define SEAM(k) do { if (IN(k) && IN((k) + 1)) GRID_BAR(); } while (0)
    if (PM(0) && IN(0)) { FRESH(); p_prologue(F, args); }
#ifdef DUP_PROLOGUE
    GRID_BAR(); if (PM(0) && IN(0)) { FRESH(); p_prologue(F, args, CW_QUEUE + 64); }
#endif
    SEAM(0);
    {
        const int pb = 1 + 0 * NPH;
        const int mrows = (0 == DEPTH - 1) ? NLAT : NT;
        if (PM(1) && IN(pb + 0)) { FRESH(); p_norm1(F, args, OPQ(0)); }
#ifdef DUP_NORM1
        GRID_BAR(); if (PM(1) && IN(pb + 0)) { FRESH(); p_norm1(F, args, OPQ(0), true); }
#endif
 SEAM(pb + 0);
        if (PM(2) && IN(pb + 1)) for (int rep_ = 0; rep_ < NREP(2); ++rep_) { if (rep_) GRID_BAR(); const int Lg = OPQ(0);
#if INPROJ_F8
            pg8::Gemm g{F.ws + WS_H8, F.ws + WS_WIN + (size_t)Lg * PW * DM, DM, DM, OPQ(DM / 2)};
            SgOrder<FillPlain> S; S.init(NT / 256, PW / 256, F.G, F.bid); S.f = FillPlain{(size_t)256 * DM, (size_t)256 * DM};
            EpiInproj E{(bf16*)(F.ws + WS_PBUF), (bf16*)(F.ws + WS_A2)};
            pg8::gemm_phase<EpiInproj, SgOrder<FillPlain>, true, F8_ALIGN, F8_SP2>(F.lds, g, S, E, fresh_tid(F.wave));
#else
            pg8::Gemm g{(const bf16*)(F.ws + WS_H), (const bf16*)(F.ws + WS_WIN) + (size_t)Lg * PW * DM, DM * 2, DM * 2, OPQ(DM)};
            SgOrder<FillPlain> S; S.init(NT / 256, PW / 256, F.G, F.bid); S.f = FillPlain{(size_t)256 * DM * 2, (size_t)256 * DM * 2};
            EpiInproj E{(bf16*)(F.ws + WS_PBUF), (bf16*)(F.ws + WS_A2)};
            pg8::gemm_phase(F.lds, g, S, E, fresh_tid(F.wave));
#endif
        }
#if defined(SHADOW_IN)
        if (PM(2) && IN(pb + 1)) { GRID_BAR(); const int Lg = OPQ(0);
            pg8::Gemm g{(const bf16*)(F.ws + WS_H), (const bf16*)(F.ws + WS_WIN) + (size_t)Lg * PW * DM, DM * 2, DM * 2, OPQ(DM)};
            SgOrder<FillPlain> S; S.init(NT / 256, PW / 256, F.G, F.bid); S.f = FillPlain{(size_t)256 * DM * 2, (size_t)256 * DM * 2};
            EpiNull E{(float*)(F.ws + WS_Y)};
            pg8::gemm_phase(F.lds, g, S, E, fresh_tid(F.wave));
        }
#endif
        SEAM(pb + 1);
        if (PM(3) && IN(pb + 2)) for (int rep_ = 0; rep_ < NREP(3); ++rep_) { if (rep_) GRID_BAR(); FRESH(); p_mix_a(F, args, OPQ(0), rep_); } SEAM(pb + 2);
        if (PM(4) && IN(pb + 3)) for (int rep_ = 0; rep_ < NREP(4); ++rep_) { if (rep_) GRID_BAR(); FRESH(); p_mix_b(F, args, OPQ(0), rep_); } SEAM(pb + 3);
        if (PM(5) && IN(pb + 4)) for (int rep_ = 0; rep_ < NREP(5); ++rep_) { if (rep_) GRID_BAR(); FRESH(); p_mix_c(F, args, OPQ(0), rep_); } SEAM(pb + 4);
        if (PM(6) && IN(pb + 5)) for (int rep_ = 0; rep_ < NREP(6); ++rep_) { if (rep_) GRID_BAR(); const int Lg = OPQ(0);
            pg8::Gemm g{(const bf16*)(F.ws + WS_ACT5), (const bf16*)(F.ws + WS_WGLU) + (size_t)Lg * 256 * 256, 512, 512, OPQ(256)};
            SgOrder<FillPlain> S; S.init(NT / 256, 1, F.G, F.bid); S.f = FillPlain{(size_t)256 * 256 * 2, 0};
            EpiGlu E{(const bf16*)(F.ws + WS_ACT5), (bf16*)(F.ws + WS_MIX)};
            pg8::gemm_phase(F.lds, g, S, E, fresh_tid(F.wave));
        } SEAM(pb + 5);
        if (PM(7) && IN(pb + 6)) { const int Lg = OPQ(0);
            pg8::Gemm g{(const bf16*)(F.ws + WS_MIX), (const bf16*)(F.ws + WS_WOUT) + (size_t)Lg * DM * MW, MW * 2, MW * 2, OPQ(MW)};
            SgOrder<FillPlain> S; S.init((Lg == DEPTH - 1 ? NLAT : NT) / 256, DM / 256, F.G, F.bid); S.f = FillPlain{(size_t)256 * MW * 2, (size_t)256 * MW * 2};
            EpiOutproj E{args.in[I_X], args.in[I_CTX], (bf16*)(F.ws + WS_XS), (const float*)(F.ws + WS_MOD) + (size_t)Lg * 9 * 6144, Lg == 0 ? 1 : 0};
            pg8::gemm_phase(F.lds, g, S, E, fresh_tid(F.wave));
        } SEAM(pb + 6);
        if (PM(8) && IN(pb + 7)) { FRESH(); p_norm2(F, args, OPQ(0), OPQ(mrows)); }
#ifdef DUP_NORM2
        GRID_BAR(); if (PM(8) && IN(pb + 7)) { FRESH(); p_norm2(F, args, OPQ(0), OPQ(mrows), 6400); }
#endif
 SEAM(pb + 7);
        if (PM(10) && IN(pb + 9)) { const int Lg = OPQ(0); FRESH();
            const int nblk = moe_tables(F, Lg);
            LAS int* lbs = (LAS int*)(F.lds + MOE_LB); LAS int* lcs = (LAS int*)(F.lds + MOE_LC); LAS unsigned* gat = (LAS unsigned*)(F.lds + MOE_GAT);
            SgOrder<FillMoe> S; S.init(nblk, 8, F.G, F.bid); S.f = FillMoe{(const LAS unsigned*)(F.lds + MOE_LBLK), 2048};
            { const int* TM = (const int*)(F.ws + WS_TM); const float* PG = (const float*)(F.ws + WS_PG); int* PS = (int*)(F.ws + WS_PS); float* SG = (float*)(F.ws + WS_SG);
              const int half = F.tid >> 8, rowi = F.tid & 255; int ids[MOE_MAXU / 2];
              { int cursor = 0;
#pragma unroll
                for (int k = 0; k < MOE_MAXU / 2; ++k) { pg8::Unit ua, ub; ua.pm = ua.pn = ua.grp = 0; ub = ua; const bool va = S.next(cursor, ua); const bool vb = S.next(cursor, ub) && va;
                    const bool v = half ? vb : va; const int e = half ? ub.grp : ua.grp, pm = half ? ub.pm : ua.pm;
                    const int rk = pm * 256 - lbs[e] + rowi; const bool ok = v && rk < lcs[e];
                    ids[k] = ok ? TM[(size_t)e * NT + rk] : -1; } }
              { int cursor = 0;
#pragma unroll
                for (int k = 0; k < MOE_MAXU / 2; ++k) { pg8::Unit ua, ub; ua.pm = ua.pn = ua.grp = 0; ub = ua; const bool va = S.next(cursor, ua); const bool vb = S.next(cursor, ub) && va;
                    const bool v = half ? vb : va; const int pm = half ? ub.pm : ua.pm, pn = half ? ub.pn : ua.pn; const int id = ids[k];
                    if (v) { gat[(2 * k + half) * 256 + rowi] = (unsigned)((id < 0 ? 0 : id) >> 2) * (unsigned)DM;
                        if (id >= 0 && pn == 0) { const int slot = pm * 256 + rowi; PS[id] = slot; SG[slot] = PG[id]; } } } } }
            __syncthreads();
            pg8::Gemm g{F.ws + WS_H8, F.ws + WS_WGU + (size_t)Lg * NEXP * 2048 * DM, DM, DM, OPQ(DM / 2)};
            EpiSwiglu E{(unsigned char*)(F.ws + WS_ACT), args.in[I_BGU] + (size_t)Lg * NEXP * 2048};
            pg8::gemm_phase<EpiSwiglu, SgOrder<FillMoe>, true, F8_ALIGN, F8_SP2, true>(F.lds, g, S, E, fresh_tid(F.wave), gat);
        } SEAM(pb + 9);
        if (PM(11) && IN(pb + 10)) for (int rep_ = 0; rep_ < NREP(11); ++rep_) { if (rep_) GRID_BAR(); const int Lg = OPQ(0); FRESH();
            const int nblk = moe_tables(F, Lg);
            pg8::Gemm g{F.ws + WS_ACT, F.ws + WS_WDN + (size_t)Lg * NEXP * DM * DM, DM, DM, OPQ(DM / 2)};
            SgOrder<FillMoe> S; S.init(nblk, 4, F.G, F.bid); S.f = FillMoe{(const LAS unsigned*)(F.lds + MOE_LBLK), 1024};
            EpiDown E{(unsigned char*)(F.ws + WS_Y), args.in[I_BDN] + (size_t)Lg * NEXP * DM, (const float*)(F.ws + WS_SG)};
            pg8::gemm_phase<EpiDown, SgOrder<FillMoe>, true, F8_ALIGN, F8_SP2>(F.lds, g, S, E, fresh_tid(F.wave));
        } SEAM(pb + 10);
        }
    {
        const int pb = 1 + 1 * NPH;
        const int mrows = (1 == DEPTH - 1) ? NLAT : NT;
        if (PM(1) && IN(pb + 0)) { FRESH(); p_norm1(F, args, OPQ(1)); }
#ifdef DUP_NORM1
        GRID_BAR(); if (PM(1) && IN(pb + 0)) { FRESH(); p_norm1(F, args, OPQ(1), true); }
#endif
 SEAM(pb + 0);
        if (PM(2) && IN(pb + 1)) for (int rep_ = 0; rep_ < NREP(2); ++rep_) { if (rep_) GRID_BAR(); const int Lg = OPQ(1);
#if INPROJ_F8
            pg8::Gemm g{F.ws + WS_H8, F.ws + WS_WIN + (size_t)Lg * PW * DM, DM, DM, OPQ(DM / 2)};
            SgOrder<FillPlain> S; S.init(NT / 256, PW / 256, F.G, F.bid); S.f = FillPlain{(size_t)256 * DM, (size_t)256 * DM};
            EpiInproj E{(bf16*)(F.ws + WS_PBUF), (bf16*)(F.ws + WS_A2)};
            pg8::gemm_phase<EpiInproj, SgOrder<FillPlain>, true, F8_ALIGN, F8_SP2>(F.lds, g, S, E, fresh_tid(F.wave));
#else
            pg8::Gemm g{(const bf16*)(F.ws + WS_H), (const bf16*)(F.ws + WS_WIN) + (size_t)Lg * PW * DM, DM * 2, DM * 2, OPQ(DM)};
            SgOrder<FillPlain> S; S.init(NT / 256, PW / 256, F.G, F.bid); S.f = FillPlain{(size_t)256 * DM * 2, (size_t)256 * DM * 2};
            EpiInproj E{(bf16*)(F.ws + WS_PBUF), (bf16*)(F.ws + WS_A2)};
            pg8::gemm_phase(F.lds, g, S, E, fresh_tid(F.wave));
#endif
        }
#if defined(SHADOW_IN)
        if (PM(2) && IN(pb + 1)) { GRID_BAR(); const int Lg = OPQ(1);
            pg8::Gemm g{(const bf16*)(F.ws + WS_H), (const bf16*)(F.ws + WS_WIN) + (size_t)Lg * PW * DM, DM * 2, DM * 2, OPQ(DM)};
            SgOrder<FillPlain> S; S.init(NT / 256, PW / 256, F.G, F.bid); S.f = FillPlain{(size_t)256 * DM * 2, (size_t)256 * DM * 2};
            EpiNull E{(float*)(F.ws + WS_Y)};
            pg8::gemm_phase(F.lds, g, S, E, fresh_tid(F.wave));
        }
#endif
        SEAM(pb + 1);
        if (PM(3) && IN(pb + 2)) for (int rep_ = 0; rep_ < NREP(3); ++rep_) { if (rep_) GRID_BAR(); FRESH(); p_mix_a(F, args, OPQ(1), rep_); } SEAM(pb + 2);
        if (PM(4) && IN(pb + 3)) for (int rep_ = 0; rep_ < NREP(4); ++rep_) { if (rep_) GRID_BAR(); FRESH(); p_mix_b(F, args, OPQ(1), rep_); } SEAM(pb + 3);
        if (PM(5) && IN(pb + 4)) for (int rep_ = 0; rep_ < NREP(5); ++rep_) { if (rep_) GRID_BAR(); FRESH(); p_mix_c(F, args, OPQ(1), rep_); } SEAM(pb + 4);
        if (PM(6) && IN(pb + 5)) for (int rep_ = 0; rep_ < NREP(6); ++rep_) { if (rep_) GRID_BAR(); const int Lg = OPQ(1);
            pg8::Gemm g{(const bf16*)(F.ws + WS_ACT5), (const bf16*)(F.ws + WS_WGLU) + (size_t)Lg * 256 * 256, 512, 512, OPQ(256)};
            SgOrder<FillPlain> S; S.init(NT / 256, 1, F.G, F.bid); S.f = FillPlain{(size_t)256 * 256 * 2, 0};
            EpiGlu E{(const bf16*)(F.ws + WS_ACT5), (bf16*)(F.ws + WS_MIX)};
            pg8::gemm_phase(F.lds, g, S, E, fresh_tid(F.wave));
        } SEAM(pb + 5);
        if (PM(7) && IN(pb + 6)) { const int Lg = OPQ(1);
            pg8::Gemm g{(const bf16*)(F.ws + WS_MIX), (const bf16*)(F.ws + WS_WOUT) + (size_t)Lg * DM * MW, MW * 2, MW * 2, OPQ(MW)};
            SgOrder<FillPlain> S; S.init((Lg == DEPTH - 1 ? NLAT : NT) / 256, DM / 256, F.G, F.bid); S.f = FillPlain{(size_t)256 * MW * 2, (size_t)256 * MW * 2};
            EpiOutproj E{args.in[I_X], args.in[I_CTX], (bf16*)(F.ws + WS_XS), (const float*)(F.ws + WS_MOD) + (size_t)Lg * 9 * 6144, Lg == 0 ? 1 : 0};
            pg8::gemm_phase(F.lds, g, S, E, fresh_tid(F.wave));
        } SEAM(pb + 6);
        if (PM(8) && IN(pb + 7)) { FRESH(); p_norm2(F, args, OPQ(1), OPQ(mrows)); }
#ifdef DUP_NORM2
        GRID_BAR(); if (PM(8) && IN(pb + 7)) { FRESH(); p_norm2(F, args, OPQ(1), OPQ(mrows), 6400); }
#endif
 SEAM(pb + 7);
        if (PM(10) && IN(pb + 9)) { const int Lg = OPQ(1); FRESH();
            const int nblk = moe_tables(F, Lg);
            LAS int* lbs = (LAS int*)(F.lds + MOE_LB); LAS int* lcs = (LAS int*)(F.lds + MOE_LC); LAS unsigned* gat = (LAS unsigned*)(F.lds + MOE_GAT);
            SgOrder<FillMoe> S; S.init(nblk, 8, F.G, F.bid); S.f = FillMoe{(const LAS unsigned*)(F.lds + MOE_LBLK), 2048};
            { const int* TM = (const int*)(F.ws + WS_TM); const float* PG = (const float*)(F.ws + WS_PG); int* PS = (int*)(F.ws + WS_PS); float* SG = (float*)(F.ws + WS_SG);
              const int half = F.tid >> 8, rowi = F.tid & 255; int ids[MOE_MAXU / 2];
              { int cursor = 0;
#pragma unroll
                for (int k = 0; k < MOE_MAXU / 2; ++k) { pg8::Unit ua, ub; ua.pm = ua.pn = ua.grp = 0; ub = ua; const bool va = S.next(cursor, ua); const bool vb = S.next(cursor, ub) && va;
                    const bool v = half ? vb : va; const int e = half ? ub.grp : ua.grp, pm = half ? ub.pm : ua.pm;
                    const int rk = pm * 256 - lbs[e] + rowi; const bool ok = v && rk < lcs[e];
                    ids[k] = ok ? TM[(size_t)e * NT + rk] : -1; } }
              { int cursor = 0;
#pragma unroll
                for (int k = 0; k < MOE_MAXU / 2; ++k) { pg8::Unit ua, ub; ua.pm = ua.pn = ua.grp = 0; ub = ua; const bool va = S.next(cursor, ua); const bool vb = S.next(cursor, ub) && va;
                    const bool v = half ? vb : va; const int pm = half ? ub.pm : ua.pm, pn = half ? ub.pn : ua.pn; const int id = ids[k];
                    if (v) { gat[(2 * k + half) * 256 + rowi] = (unsigned)((id < 0 ? 0 : id) >> 2) * (unsigned)DM;
                        if (id >= 0 && pn == 0) { const int slot = pm * 256 + rowi; PS[id] = slot; SG[slot] = PG[id]; } } } } }
            __syncthreads();
            pg8::Gemm g{F.ws + WS_H8, F.ws + WS_WGU + (size_t)Lg * NEXP * 2048 * DM, DM, DM, OPQ(DM / 2)};
            EpiSwiglu E{(unsigned char*)(F.ws + WS_ACT), args.in[I_BGU] + (size_t)Lg * NEXP * 2048};
            pg8::gemm_phase<EpiSwiglu, SgOrder<FillMoe>, true, F8_ALIGN, F8_SP2, true>(F.lds, g, S, E, fresh_tid(F.wave), gat);
        } SEAM(pb + 9);
        if (PM(11) && IN(pb + 10)) for (int rep_ = 0; rep_ < NREP(11); ++rep_) { if (rep_) GRID_BAR(); const int Lg = OPQ(1); FRESH();
            const int nblk = moe_tables(F, Lg);
            pg8::Gemm g{F.ws + WS_ACT, F.ws + WS_WDN + (size_t)Lg * NEXP * DM * DM, DM, DM, OPQ(DM / 2)};
            SgOrder<FillMoe> S; S.init(nblk, 4, F.G, F.bid); S.f = FillMoe{(const LAS unsigned*)(F.lds + MOE_LBLK), 1024};
            EpiDown E{(unsigned char*)(F.ws + WS_Y), args.in[I_BDN] + (size_t)Lg * NEXP * DM, (const float*)(F.ws + WS_SG)};
            pg8::gemm_phase<EpiDown, SgOrder<FillMoe>, true, F8_ALIGN, F8_SP2>(F.lds, g, S, E, fresh_tid(F.wave));
        } SEAM(pb + 10);
        }
    {
        const int pb = 1 + 2 * NPH;
        const int mrows = (2 == DEPTH - 1) ? NLAT : NT;
        if (PM(1) && IN(pb + 0)) { FRESH(); p_norm1(F, args, OPQ(2)); }
#ifdef DUP_NORM1
        GRID_BAR(); if (PM(1) && IN(pb + 0)) { FRESH(); p_norm1(F, args, OPQ(2), true); }
#endif
 SEAM(pb + 0);
        if (PM(2) && IN(pb + 1)) for (int rep_ = 0; rep_ < NREP(2); ++rep_) { if (rep_) GRID_BAR(); const int Lg = OPQ(2);
#if INPROJ_F8
            pg8::Gemm g{F.ws + WS_H8, F.ws + WS_WIN + (size_t)Lg * PW * DM, DM, DM, OPQ(DM / 2)};
            SgOrder<FillPlain> S; S.init(NT / 256, PW / 256, F.G, F.bid); S.f = FillPlain{(size_t)256 * DM, (size_t)256 * DM};
            EpiInproj E{(bf16*)(F.ws + WS_PBUF), (bf16*)(F.ws + WS_A2)};
            pg8::gemm_phase<EpiInproj, SgOrder<FillPlain>, true, F8_ALIGN, F8_SP2>(F.lds, g, S, E, fresh_tid(F.wave));
#else
            pg8::Gemm g{(const bf16*)(F.ws + WS_H), (const bf16*)(F.ws + WS_WIN) + (size_t)Lg * PW * DM, DM * 2, DM * 2, OPQ(DM)};
            SgOrder<FillPlain> S; S.init(NT / 256, PW / 256, F.G, F.bid); S.f = FillPlain{(size_t)256 * DM * 2, (size_t)256 * DM * 2};
            EpiInproj E{(bf16*)(F.ws + WS_PBUF), (bf16*)(F.ws + WS_A2)};
            pg8::gemm_phase(F.lds, g, S, E, fresh_tid(F.wave));
#endif
        }
#if defined(SHADOW_IN)
        if (PM(2) && IN(pb + 1)) { GRID_BAR(); const int Lg = OPQ(2);
            pg8::Gemm g{(const bf16*)(F.ws + WS_H), (const bf16*)(F.ws + WS_WIN) + (size_t)Lg * PW * DM, DM * 2, DM * 2, OPQ(DM)};
            SgOrder<FillPlain> S; S.init(NT / 256, PW / 256, F.G, F.bid); S.f = FillPlain{(size_t)256 * DM * 2, (size_t)256 * DM * 2};
            EpiNull E{(float*)(F.ws + WS_Y)};
            pg8::gemm_phase(F.lds, g, S, E, fresh_tid(F.wave));
        }
#endif
        SEAM(pb + 1);
        if (PM(3) && IN(pb + 2)) for (int rep_ = 0; rep_ < NREP(3); ++rep_) { if (rep_) GRID_BAR(); FRESH(); p_mix_a(F, args, OPQ(2), rep_); } SEAM(pb + 2);
        if (PM(4) && IN(pb + 3)) for (int rep_ = 0; rep_ < NREP(4); ++rep_) { if (rep_) GRID_BAR(); FRESH(); p_mix_b(F, args, OPQ(2), rep_); } SEAM(pb + 3);
        if (PM(5) && IN(pb + 4)) for (int rep_ = 0; rep_ < NREP(5); ++rep_) { if (rep_) GRID_BAR(); FRESH(); p_mix_c(F, args, OPQ(2), rep_); } SEAM(pb + 4);
        if (PM(6) && IN(pb + 5)) for (int rep_ = 0; rep_ < NREP(6); ++rep_) { if (rep_) GRID_BAR(); const int Lg = OPQ(2);
            pg8::Gemm g{(const bf16*)(F.ws + WS_ACT5), (const bf16*)(F.ws + WS_WGLU) + (size_t)Lg * 256 * 256, 512, 512, OPQ(256)};
            SgOrder<FillPlain> S; S.init(NT / 256, 1, F.G, F.bid); S.f = FillPlain{(size_t)256 * 256 * 2, 0};
            EpiGlu E{(const bf16*)(F.ws + WS_ACT5), (bf16*)(F.ws + WS_MIX)};
            pg8::gemm_phase(F.lds, g, S, E, fresh_tid(F.wave));
        } SEAM(pb + 5);
        if (PM(7) && IN(pb + 6)) { const int Lg = OPQ(2);
            pg8::Gemm g{(const bf16*)(F.ws + WS_MIX), (const bf16*)(F.ws + WS_WOUT) + (size_t)Lg * DM * MW, MW * 2, MW * 2, OPQ(MW)};
            SgOrder<FillPlain> S; S.init((Lg == DEPTH - 1 ? NLAT : NT) / 256, DM / 256, F.G, F.bid); S.f = FillPlain{(size_t)256 * MW * 2, (size_t)256 * MW * 2};
            EpiOutproj E{args.in[I_X], args.in[I_CTX], (bf16*)(F.ws + WS_XS), (const float*)(F.ws + WS_MOD) + (size_t)Lg * 9 * 6144, Lg == 0 ? 1 : 0};
            pg8::gemm_phase(F.lds, g, S, E, fresh_tid(F.wave));
        } SEAM(pb + 6);
        if (PM(8) && IN(pb + 7)) { FRESH(); p_norm2(F, args, OPQ(2), OPQ(mrows)); }
#ifdef DUP_NORM2
        GRID_BAR(); if (PM(8) && IN(pb + 7)) { FRESH(); p_norm2(F, args, OPQ(2), OPQ(mrows), 6400); }
#endif
 SEAM(pb + 7);
        if (PM(10) && IN(pb + 9)) { const int Lg = OPQ(2); FRESH();
            const int nblk = moe_tables(F, Lg);
            LAS int* lbs = (LAS int*)(F.lds + MOE_LB); LAS int* lcs = (LAS int*)(F.lds + MOE_LC); LAS unsigned* gat = (LAS unsigned*)(F.lds + MOE_GAT);
            SgOrder<FillMoe> S; S.init(nblk, 8, F.G, F.bid); S.f = FillMoe{(const LAS unsigned*)(F.lds + MOE_LBLK), 2048};
            { const int* TM = (const int*)(F.ws + WS_TM); const float* PG = (const float*)(F.ws + WS_PG); int* PS = (int*)(F.ws + WS_PS); float* SG = (float*)(F.ws + WS_SG);
              const int half = F.tid >> 8, rowi = F.tid & 255; int ids[MOE_MAXU / 2];
              { int cursor = 0;
#pragma unroll
                for (int k = 0; k < MOE_MAXU / 2; ++k) { pg8::Unit ua, ub; ua.pm = ua.pn = ua.grp = 0; ub = ua; const bool va = S.next(cursor, ua); const bool vb = S.next(cursor, ub) && va;
                    const bool v = half ? vb : va; const int e = half ? ub.grp : ua.grp, pm = half ? ub.pm : ua.pm;
                    const int rk = pm * 256 - lbs[e] + rowi; const bool ok = v && rk < lcs[e];
                    ids[k] = ok ? TM[(size_t)e * NT + rk] : -1; } }
              { int cursor = 0;
#pragma unroll
                for (int k = 0; k < MOE_MAXU / 2; ++k) { pg8::Unit ua, ub; ua.pm = ua.pn = ua.grp = 0; ub = ua; const bool va = S.next(cursor, ua); const bool vb = S.next(cursor, ub) && va;
                    const bool v = half ? vb : va; const int pm = half ? ub.pm : ua.pm, pn = half ? ub.pn : ua.pn; const int id = ids[k];
                    if (v) { gat[(2 * k + half) * 256 + rowi] = (unsigned)((id < 0 ? 0 : id) >> 2) * (unsigned)DM;
                        if (id >= 0 && pn == 0) { const int slot = pm * 256 + rowi; PS[id] = slot; SG[slot] = PG[id]; } } } } }
            __syncthreads();
            pg8::Gemm g{F.ws + WS_H8, F.ws + WS_WGU + (size_t)Lg * NEXP * 2048 * DM, DM, DM, OPQ(DM / 2)};
            EpiSwiglu E{(unsigned char*)(F.ws + WS_ACT), args.in[I_BGU] + (size_t)Lg * NEXP * 2048};
            pg8::gemm_phase<EpiSwiglu, SgOrder<FillMoe>, true, F8_ALIGN, F8_SP2, true>(F.lds, g, S, E, fresh_tid(F.wave), gat);
        } SEAM(pb + 9);
        if (PM(11) && IN(pb + 10)) for (int rep_ = 0; rep_ < NREP(11); ++rep_) { if (rep_) GRID_BAR(); const int Lg = OPQ(2); FRESH();
            const int nblk = moe_tables(F, Lg);
            pg8::Gemm g{F.ws + WS_ACT, F.ws + WS_WDN + (size_t)Lg * NEXP * DM * DM, DM, DM, OPQ(DM / 2)};
            SgOrder<FillMoe> S; S.init(nblk, 4, F.G, F.bid); S.f = FillMoe{(const LAS unsigned*)(F.lds + MOE_LBLK), 1024};
            EpiDown E{(unsigned char*)(F.ws + WS_Y), args.in[I_BDN] + (size_t)Lg * NEXP * DM, (const float*)(F.ws + WS_SG)};
            pg8::gemm_phase<EpiDown, SgOrder<FillMoe>, true, F8_ALIGN, F8_SP2>(F.lds, g, S, E, fresh_tid(F.wave));
        } SEAM(pb + 10);
        }
    {
        const int pb = 1 + 3 * NPH;
        const int mrows = (3 == DEPTH - 1) ? NLAT : NT;
        if (PM(1) && IN(pb + 0)) { FRESH(); p_norm1(F, args, OPQ(3)); }
#ifdef DUP_NORM1
        GRID_BAR(); if (PM(1) && IN(pb + 0)) { FRESH(); p_norm1(F, args, OPQ(3), true); }
#endif
 SEAM(pb + 0);
        if (PM(2) && IN(pb + 1)) for (int rep_ = 0; rep_ < NREP(2); ++rep_) { if (rep_) GRID_BAR(); const int Lg = OPQ(3);
#if INPROJ_F8
            pg8::Gemm g{F.ws + WS_H8, F.ws + WS_WIN + (size_t)Lg * PW * DM, DM, DM, OPQ(DM / 2)};
            SgOrder<FillPlain> S; S.init(NT / 256, PW / 256, F.G, F.bid); S.f = FillPlain{(size_t)256 * DM, (size_t)256 * DM};
            EpiInproj E{(bf16*)(F.ws + WS_PBUF), (bf16*)(F.ws + WS_A2)};
            pg8::gemm_phase<EpiInproj, SgOrder<FillPlain>, true, F8_ALIGN, F8_SP2>(F.lds, g, S, E, fresh_tid(F.wave));
#else
            pg8::Gemm g{(const bf16*)(F.ws + WS_H), (const bf16*)(F.ws + WS_WIN) + (size_t)Lg * PW * DM, DM * 2, DM * 2, OPQ(DM)};
            SgOrder<FillPlain> S; S.init(NT / 256, PW / 256, F.G, F.bid); S.f = FillPlain{(size_t)256 * DM * 2, (size_t)256 * DM * 2};
            EpiInproj E{(bf16*)(F.ws + WS_PBUF), (bf16*)(F.ws + WS_A2)};
            pg8::gemm_phase(F.lds, g, S, E, fresh_tid(F.wave));
#endif
        }
#if defined(SHADOW_IN)
        if (PM(2) && IN(pb + 1)) { GRID_BAR(); const int Lg = OPQ(3);
            pg8::Gemm g{(const bf16*)(F.ws + WS_H), (const bf16*)(F.ws + WS_WIN) + (size_t)Lg * PW * DM, DM * 2, DM * 2, OPQ(DM)};
            SgOrder<FillPlain> S; S.init(NT / 256, PW / 256, F.G, F.bid); S.f = FillPlain{(size_t)256 * DM * 2, (size_t)256 * DM * 2};
            EpiNull E{(float*)(F.ws + WS_Y)};
            pg8::gemm_phase(F.lds, g, S, E, fresh_tid(F.wave));
        }
#endif
        SEAM(pb + 1);
        if (PM(3) && IN(pb + 2)) for (int rep_ = 0; rep_ < NREP(3); ++rep_) { if (rep_) GRID_BAR(); FRESH(); p_mix_a(F, args, OPQ(3), rep_); } SEAM(pb + 2);
        if (PM(4) && IN(pb + 3)) for (int rep_ = 0; rep_ < NREP(4); ++rep_) { if (rep_) GRID_BAR(); FRESH(); p_mix_b(F, args, OPQ(3), rep_); } SEAM(pb + 3);
        if (PM(5) && IN(pb + 4)) for (int rep_ = 0; rep_ < NREP(5); ++rep_) { if (rep_) GRID_BAR(); FRESH(); p_mix_c(F, args, OPQ(3), rep_); } SEAM(pb + 4);
        if (PM(6) && IN(pb + 5)) for (int rep_ = 0; rep_ < NREP(6); ++rep_) { if (rep_) GRID_BAR(); const int Lg = OPQ(3);
            pg8::Gemm g{(const bf16*)(F.ws + WS_ACT5), (const bf16*)(F.ws + WS_WGLU) + (size_t)Lg * 256 * 256, 512, 512, OPQ(256)};
            SgOrder<FillPlain> S; S.init(NT / 256, 1, F.G, F.bid); S.f = FillPlain{(size_t)256 * 256 * 2, 0};
            EpiGlu E{(const bf16*)(F.ws + WS_ACT5), (bf16*)(F.ws + WS_MIX)};
            pg8::gemm_phase(F.lds, g, S, E, fresh_tid(F.wave));
        } SEAM(pb + 5);
        if (PM(7) && IN(pb + 6)) { const int Lg = OPQ(3);
            pg8::Gemm g{(const bf16*)(F.ws + WS_MIX), (const bf16*)(F.ws + WS_WOUT) + (size_t)Lg * DM * MW, MW * 2, MW * 2, OPQ(MW)};
            SgOrder<FillPlain> S; S.init((Lg == DEPTH - 1 ? NLAT : NT) / 256, DM / 256, F.G, F.bid); S.f = FillPlain{(size_t)256 * MW * 2, (size_t)256 * MW * 2};
            EpiOutproj E{args.in[I_X], args.in[I_CTX], (bf16*)(F.ws + WS_XS), (const float*)(F.ws + WS_MOD) + (size_t)Lg * 9 * 6144, Lg == 0 ? 1 : 0};
            pg8::gemm_phase(F.lds, g, S, E, fresh_tid(F.wave));
        } SEAM(pb + 6);
        if (PM(8) && IN(pb + 7)) { FRESH(); p_norm2(F, args, OPQ(3), OPQ(mrows)); }
#ifdef DUP_NORM2
        GRID_BAR(); if (PM(8) && IN(pb + 7)) { FRESH(); p_norm2(F, args, OPQ(3), OPQ(mrows), 6400); }
#endif
 SEAM(pb + 7);
        if (PM(10) && IN(pb + 9)) { const int Lg = OPQ(3); FRESH();
            const int nblk = moe_tables(F, Lg);
            LAS int* lbs = (LAS int*)(F.lds + MOE_LB); LAS int* lcs = (LAS int*)(F.lds + MOE_LC); LAS unsigned* gat = (LAS unsigned*)(F.lds + MOE_GAT);
            SgOrder<FillMoe> S; S.init(nblk, 8, F.G, F.bid); S.f = FillMoe{(const LAS unsigned*)(F.lds + MOE_LBLK), 2048};
            { const int* TM = (const int*)(F.ws + WS_TM); const float* PG = (const float*)(F.ws + WS_PG); int* PS = (int*)(F.ws + WS_PS); float* SG = (float*)(F.ws + WS_SG);
              const int half = F.tid >> 8, rowi = F.tid & 255; int ids[MOE_MAXU / 2];
              { int cursor = 0;
#pragma unroll
                for (int k = 0; k < MOE_MAXU / 2; ++k) { pg8::Unit ua, ub; ua.pm = ua.pn = ua.grp = 0; ub = ua; const bool va = S.next(cursor, ua); const bool vb = S.next(cursor, ub) && va;
                    const bool v = half ? vb : va; const int e = half ? ub.grp : ua.grp, pm = half ? ub.pm : ua.pm;
                    const int rk = pm * 256 - lbs[e] + rowi; const bool ok = v && rk < lcs[e];
                    ids[k] = ok ? TM[(size_t)e * NT + rk] : -1; } }
              { int cursor = 0;
#pragma unroll
                for (int k = 0; k < MOE_MAXU / 2; ++k) { pg8::Unit ua, ub; ua.pm = ua.pn = ua.grp = 0; ub = ua; const bool va = S.next(cursor, ua); const bool vb = S.next(cursor, ub) && va;
                    const bool v = half ? vb : va; const int pm = half ? ub.pm : ua.pm, pn = half ? ub.pn : ua.pn; const int id = ids[k];
                    if (v) { gat[(2 * k + half) * 256 + rowi] = (unsigned)((id < 0 ? 0 : id) >> 2) * (unsigned)DM;
                        if (id >= 0 && pn == 0) { const int slot = pm * 256 + rowi; PS[id] = slot; SG[slot] = PG[id]; } } } } }
            __syncthreads();
            pg8::Gemm g{F.ws + WS_H8, F.ws + WS_WGU + (size_t)Lg * NEXP * 2048 * DM, DM, DM, OPQ(DM / 2)};
            EpiSwiglu E{(unsigned char*)(F.ws + WS_ACT), args.in[I_BGU] + (size_t)Lg * NEXP * 2048};
            pg8::gemm_phase<EpiSwiglu, SgOrder<FillMoe>, true, F8_ALIGN, F8_SP2, true>(F.lds, g, S, E, fresh_tid(F.wave), gat);
        } SEAM(pb + 9);
        if (PM(11) && IN(pb + 10)) for (int rep_ = 0; rep_ < NREP(11); ++rep_) { if (rep_) GRID_BAR(); const int Lg = OPQ(3); FRESH();
            const int nblk = moe_tables(F, Lg);
            pg8::Gemm g{F.ws + WS_ACT, F.ws + WS_WDN + (size_t)Lg * NEXP * DM * DM, DM, DM, OPQ(DM / 2)};
            SgOrder<FillMoe> S; S.init(nblk, 4, F.G, F.bid); S.f = FillMoe{(const LAS unsigned*)(F.lds + MOE_LBLK), 1024};
            EpiDown E{(unsigned char*)(F.ws + WS_Y), args.in[I_BDN] + (size_t)Lg * NEXP * DM, (const float*)(F.ws + WS_SG)};
            pg8::gemm_phase<EpiDown, SgOrder<FillMoe>, true, F8_ALIGN, F8_SP2>(F.lds, g, S, E, fresh_tid(F.wave));
        } SEAM(pb + 10);
        }
    if (PM(12) && IN(PH_TOTAL - 1)) { FRESH(); p_final(F, args); }
#undef IN
#undef SEAM
#undef args
}

extern "C" void kernel_launch(void* const* d_in, const int* in_sizes, int n_in, void* d_out, int out_size, void* d_ws, size_t ws_size, hipStream_t stream) {
    static int grid = 0;
    if (grid == 0) {
        if (n_in != N_IN || out_size != NLAT * DM || ws_size < WS_END) { fprintf(stderr, "kernel_launch: unexpected shapes (n_in %d, out %d, ws %zu < %zu); nothing launched\n", n_in, out_size, ws_size, (size_t)WS_END); grid = -1; return; }
        int dev = 0, cus = 0, per_cu = 0;
        if (hipGetDevice(&dev) != hipSuccess || hipDeviceGetAttribute(&cus, hipDeviceAttributeMultiprocessorCount, dev) != hipSuccess) { grid = -1; return; }
        if (hipFuncSetAttribute((const void*)mk_fwd, hipFuncAttributeMaxDynamicSharedMemorySize, LDS_BYTES) != hipSuccess) { fprintf(stderr, "kernel_launch: hipFuncSetAttribute failed\n"); grid = -1; return; }
        if (hipOccupancyMaxActiveBlocksPerMultiprocessor(&per_cu, (const void*)mk_fwd, NTHR, LDS_BYTES) != hipSuccess || per_cu < 1) fprintf(stderr, "kernel_launch: occupancy query says %d\n", per_cu);
        (void)hipGetLastError();
        grid = cus;
    }
    if (grid < 0) return;
    (void)hipMemsetAsync((char*)d_ws + WS_CTL, 0, CTL_BYTES, stream);
    Args a{};
    for (int i = 0; i < N_IN; ++i) a.in[i] = (const float*)d_in[i];
    a.out = (float*)d_out; a.ws = (unsigned char*)d_ws;
#if MK_ONE_LAUNCH
    a.ph_lo = 0; a.ph_hi = PH_TOTAL;
    hipLaunchKernelGGL(mk_fwd, dim3(grid), dim3(NTHR), LDS_BYTES, stream, a);
#else
    for (int p = 0; p < PH_TOTAL; ++p) { a.ph_lo = p; a.ph_hi = p + 1; hipLaunchKernelGGL(mk_fwd, dim3(grid), dim3(NTHR), LDS_BYTES, stream, a); }
#endif
}
```
